# Optimizing an MI355X kernel written in HIP

```python
import math
import jax, jax.numpy as jnp
from jax import lax
import numpy as np

D_MODEL = 1024
BATCH = 1
SEQ = 16384
DEPTH = 1

N_META = 16
EPS = 1e-6
GDN_HEADS = 8
GDN_DK = 64
GDN_DV = 64
CONV_K = 4
CHUNK = 64
GDN_QK_W = GDN_HEADS * GDN_DK
GDN_V_W = GDN_HEADS * GDN_DV
GDN_QKV_W = 2 * GDN_QK_W + GDN_V_W
MLA_HEADS = 8
Q_LORA = 256
KV_LORA = 128
QK_NOPE = 64
QK_ROPE = 32
QK_DIM = QK_NOPE + QK_ROPE
V_DIM = 64
ROPE_THETA = 10000.0
Q_BLOCK = 128
MIX_WIDTH = GDN_V_W + MLA_HEADS * V_DIM
IN_SPLITS = (GDN_QKV_W, GDN_V_W, GDN_HEADS, GDN_HEADS, Q_LORA, KV_LORA, QK_ROPE)
IN_WIDTH = sum(IN_SPLITS)
PEER_HEADS = 8
N_KEYS = 128
N_EXPERTS = N_KEYS * N_KEYS
PEER_QDIM = 256
PEER_HALF = PEER_QDIM // 2
PEER_TOPK = 16
PEER_BLOCK = 256

kernel_name = "hybrid_gdn_mla_peer_block"


def rms_norm(x, w):
    xf = x.astype(jnp.float32)
    y = xf * lax.rsqrt(jnp.mean(xf * xf, axis=-1, keepdims=True) + EPS)
    return (y * w.astype(jnp.float32)).astype(x.dtype)


def l2_norm(x):
    xf = x.astype(jnp.float32)
    return (xf * lax.rsqrt(jnp.sum(xf * xf, axis=-1, keepdims=True) + EPS)).astype(x.dtype)


def causal_depthwise_conv(x, w):
    K, C = w.shape
    return lax.conv_general_dilated(x, w[:, None, :].astype(x.dtype), window_strides=(1,), padding=[(K - 1, 0)], dimension_numbers=('NWC', 'WIO', 'NWC'), feature_group_count=C)


def apply_rope(x, pos):
    R = x.shape[-1]
    half = R // 2
    inv = jnp.exp(-math.log(ROPE_THETA) * jnp.arange(half, dtype=jnp.float32) * (2.0 / R))
    ang = pos.astype(jnp.float32)[:, None] * inv[None, :]
    cos = jnp.cos(ang)[:, None, :]
    sin = jnp.sin(ang)[:, None, :]
    xf = x.astype(jnp.float32)
    x1, x2 = xf[..., :half], xf[..., half:]
    return jnp.concatenate([x1 * cos - x2 * sin, x2 * cos + x1 * sin], axis=-1).astype(x.dtype)


def gated_delta_chunked(q, k, v, g, beta):
    out_dtype = v.dtype
    B, T, H, dk = q.shape
    n = T // CHUNK
    f32 = jnp.float32

    def to_chunks(t):
        return t.astype(f32).reshape(B, n, CHUNK, H, -1).transpose(1, 0, 3, 2, 4)

    q = to_chunks(q) * (dk ** -0.5)
    k = to_chunks(k)
    v = to_chunks(v)
    g = g.astype(f32).reshape(B, n, CHUNK, H).transpose(1, 0, 3, 2)
    beta = beta.astype(f32).reshape(B, n, CHUNK, H).transpose(1, 0, 3, 2)
    gc = jnp.cumsum(g, axis=-1)
    tril = jnp.tril(jnp.ones((CHUNK, CHUNK), dtype=bool))
    strict = jnp.tril(jnp.ones((CHUNK, CHUNK), dtype=bool), k=-1)
    decay = jnp.exp(jnp.where(tril, gc[..., :, None] - gc[..., None, :], -jnp.inf))
    kb = k * beta[..., None]
    vb = v * beta[..., None]
    m = jnp.where(strict, jnp.einsum('nbhid,nbhjd->nbhij', kb, k) * decay, 0.0)
    a_mat = m + jnp.eye(CHUNK, dtype=f32)
    rhs = jnp.concatenate([vb, kb * jnp.exp(gc)[..., None]], axis=-1)
    sol = lax.linalg.triangular_solve(a_mat, rhs, left_side=True, lower=True, unit_diagonal=True)
    u = sol[..., :v.shape[-1]]
    w = sol[..., v.shape[-1]:]
    qk = jnp.einsum('nbhid,nbhjd->nbhij', q, k) * decay
    qg = q * jnp.exp(gc)[..., None]
    kd = k * jnp.exp(gc[..., -1:] - gc)[..., None]
    gl = jnp.exp(gc[..., -1])

    def step(S, inp):
        qk_c, qg_c, u_c, w_c, kd_c, gl_c = inp
        v_new = u_c - jnp.einsum('bhcd,bhde->bhce', w_c, S)
        o = jnp.einsum('bhcd,bhde->bhce', qg_c, S) + jnp.einsum('bhij,bhje->bhie', qk_c, v_new)
        S = S * gl_c[..., None, None] + jnp.einsum('bhcd,bhce->bhde', kd_c, v_new)
        return S, o

    S0 = jnp.zeros((B, H, dk, v.shape[-1]), f32)
    _, o = lax.scan(step, S0, (qk, qg, u, w, kd, gl))
    return o.transpose(1, 0, 3, 2, 4).reshape(B, T, H, -1).astype(out_dtype)


def gdn_mixer(qkv_raw, z, b, a, conv_w, a_log, dt_bias, gdn_norm):
    B, L, _ = qkv_raw.shape
    qkv = jax.nn.silu(causal_depthwise_conv(qkv_raw, conv_w))
    q, k, v = jnp.split(qkv, [GDN_QK_W, 2 * GDN_QK_W], axis=-1)
    q = l2_norm(q.reshape(B, L, GDN_HEADS, GDN_DK))
    k = l2_norm(k.reshape(B, L, GDN_HEADS, GDN_DK))
    v = v.reshape(B, L, GDN_HEADS, GDN_DV)
    beta = jax.nn.sigmoid(b.astype(jnp.float32))
    g = -jnp.exp(a_log.astype(jnp.float32)) * jax.nn.softplus(a.astype(jnp.float32) + dt_bias.astype(jnp.float32))
    pad = (-N_META) % CHUNK

    def lpad(t):
        return jnp.pad(t, ((0, 0), (pad, 0)) + ((0, 0),) * (t.ndim - 2))

    o = gated_delta_chunked(lpad(q), lpad(k), lpad(v), lpad(g), lpad(beta))[:, pad:]
    o = rms_norm(o, gdn_norm) * jax.nn.silu(z.reshape(B, L, GDN_HEADS, GDN_DV))
    return o.reshape(B, L, GDN_V_W)


def blocked_causal_attention(q, k, v):
    B, L, H, dq = q.shape
    Lp = -(-L // Q_BLOCK) * Q_BLOCK

    def rpad(t):
        return jnp.pad(t, ((0, 0), (0, Lp - L), (0, 0), (0, 0)))

    q, k, v = rpad(q), rpad(k), rpad(v)
    scale = dq ** -0.5
    kpos = jnp.arange(Lp)

    def block(i):
        start = i * Q_BLOCK
        qb = lax.dynamic_slice_in_dim(q, start, Q_BLOCK, axis=1)
        s = jnp.einsum('bqhd,bkhd->bhqk', qb, k).astype(jnp.float32) * scale
        qpos = start + jnp.arange(Q_BLOCK)
        s = jnp.where(kpos[None, :] <= qpos[:, None], s, -jnp.inf)
        p = jax.nn.softmax(s, axis=-1).astype(v.dtype)
        return jnp.einsum('bhqk,bkhd->bqhd', p, v)

    o = lax.map(block, jnp.arange(Lp // Q_BLOCK))
    return o.transpose(1, 0, 2, 3, 4).reshape(B, Lp, H, -1)[:, :L]


def mla_mixer(cq, ckv, kpe, q_a_norm, kv_a_norm, w_uq, w_ukv, q_norm, k_norm, pos):
    B, L, _ = cq.shape
    qh = (rms_norm(cq, q_a_norm) @ w_uq).reshape(B, L, MLA_HEADS, QK_DIM)
    kv = (rms_norm(ckv, kv_a_norm) @ w_ukv).reshape(B, L, MLA_HEADS, QK_NOPE + V_DIM)
    k_nope, v = kv[..., :QK_NOPE], kv[..., QK_NOPE:]
    k_pe = jnp.broadcast_to(kpe[:, :, None, :], (B, L, MLA_HEADS, QK_ROPE))
    kh = jnp.concatenate([k_nope, k_pe], axis=-1)
    qh = rms_norm(qh, q_norm)
    kh = rms_norm(kh, k_norm)
    qh = jnp.concatenate([qh[..., :QK_NOPE], apply_rope(qh[..., QK_NOPE:], pos)], axis=-1)
    kh = jnp.concatenate([kh[..., :QK_NOPE], apply_rope(kh[..., QK_NOPE:], pos)], axis=-1)
    o = blocked_causal_attention(qh, kh, v)
    return o.reshape(B, L, MLA_HEADS * V_DIM)


def peer(xn, w_pq, sub_keys, expert_u, expert_v):
    B, L, D = xn.shape
    q = (xn @ w_pq).reshape(B, L, PEER_HEADS, 2, PEER_HALF).astype(jnp.float32)
    s = jnp.einsum('blhpc,hpkc->blhpk', q, sub_keys.astype(jnp.float32))
    sv, si = lax.top_k(s, PEER_TOPK)
    cand = (sv[..., 0, :, None] + sv[..., 1, None, :]).reshape(B, L, PEER_HEADS, PEER_TOPK * PEER_TOPK)
    cv, ci = lax.top_k(cand, PEER_TOPK)
    i1 = jnp.take_along_axis(si[..., 0, :], ci // PEER_TOPK, axis=-1)
    i2 = jnp.take_along_axis(si[..., 1, :], ci % PEER_TOPK, axis=-1)
    experts = i1 * N_KEYS + i2
    gates = jax.nn.softmax(cv, axis=-1)
    T = B * L
    E = PEER_HEADS * PEER_TOPK
    Tp = -(-T // PEER_BLOCK) * PEER_BLOCK
    nb = Tp // PEER_BLOCK
    x_flat = jnp.pad(xn.reshape(T, D), ((0, Tp - T), (0, 0))).reshape(nb, PEER_BLOCK, D)
    e_flat = jnp.pad(experts.reshape(T, E), ((0, Tp - T), (0, 0))).reshape(nb, PEER_BLOCK, E)
    g_flat = jnp.pad(gates.reshape(T, E).astype(xn.dtype), ((0, Tp - T), (0, 0))).reshape(nb, PEER_BLOCK, E)

    def block(args):
        xb, eb, gb = args
        h = jnp.einsum('ped,pd->pe', expert_u[eb], xb)
        return jnp.einsum('pe,ped->pd', jax.nn.gelu(h, approximate=False) * gb, expert_v[eb])

    y = lax.map(block, (x_flat, e_flat, g_flat))
    return y.reshape(Tp, D)[:T].reshape(B, L, D)


def setup_inputs(seed: int = 0) -> dict:
    key = jax.random.key(seed)
    ks = jax.random.split(key, 24)
    f32 = jnp.float32

    def nrm(k, shape, s):
        return jax.random.normal(k, shape, f32) * s

    def gain(k, shape):
        return 1.0 + 0.02 * jax.random.normal(k, shape, f32)

    dt = jnp.exp(jax.random.uniform(ks[6], (DEPTH, GDN_HEADS), f32, math.log(1e-3), math.log(1e-1)))
    return {
        'x': nrm(ks[0], (BATCH, SEQ, D_MODEL), 1.0),
        'meta_tokens': nrm(ks[1], (N_META, D_MODEL), 1.0),
        'attn_norm': gain(ks[2], (DEPTH, D_MODEL)),
        'w_in': nrm(ks[3], (DEPTH, D_MODEL, IN_WIDTH), D_MODEL ** -0.5),
        'conv_w': nrm(ks[4], (DEPTH, CONV_K, GDN_QKV_W), 0.5),
        'a_log': jnp.log(jax.random.uniform(ks[5], (DEPTH, GDN_HEADS), f32, 1.0, 16.0)),
        'dt_bias': dt + jnp.log(-jnp.expm1(-dt)),
        'gdn_norm': gain(ks[7], (DEPTH, GDN_DV)),
        'q_a_norm': gain(ks[8], (DEPTH, Q_LORA)),
        'kv_a_norm': gain(ks[9], (DEPTH, KV_LORA)),
        'w_uq': nrm(ks[10], (DEPTH, Q_LORA, MLA_HEADS * QK_DIM), Q_LORA ** -0.5),
        'w_ukv': nrm(ks[11], (DEPTH, KV_LORA, MLA_HEADS * (QK_NOPE + V_DIM)), KV_LORA ** -0.5),
        'q_norm': gain(ks[12], (DEPTH, QK_DIM)),
        'k_norm': gain(ks[13], (DEPTH, QK_DIM)),
        'w_out': nrm(ks[14], (DEPTH, MIX_WIDTH, D_MODEL), MIX_WIDTH ** -0.5),
        'ffn_norm': gain(ks[15], (DEPTH, D_MODEL)),
        'w_pq': nrm(ks[16], (DEPTH, D_MODEL, PEER_HEADS * PEER_QDIM), D_MODEL ** -0.5),
        'sub_keys': nrm(ks[17], (DEPTH, PEER_HEADS, 2, N_KEYS, PEER_HALF), PEER_HALF ** -0.5),
        'expert_u': nrm(ks[18], (DEPTH, N_EXPERTS, D_MODEL), D_MODEL ** -0.5),
        'expert_v': nrm(ks[19], (DEPTH, N_EXPERTS, D_MODEL), 0.5),
    }


def reference(x, meta_tokens, attn_norm, w_in, conv_w, a_log, dt_bias, gdn_norm, q_a_norm, kv_a_norm, w_uq, w_ukv, q_norm, k_norm, w_out, ffn_norm, w_pq, sub_keys, expert_u, expert_v):
    B = x.shape[0]
    meta = jnp.broadcast_to(meta_tokens[None].astype(x.dtype), (B, N_META, D_MODEL))
    h = jnp.concatenate([meta, x], axis=1)
    L = h.shape[1]
    pos = jnp.arange(L, dtype=jnp.int32)
    split_at = np.cumsum(IN_SPLITS)[:-1]
    for l in range(DEPTH):
        hn = rms_norm(h, attn_norm[l])
        proj = hn @ w_in[l]
        qkv_raw, z, b, a, cq, ckv, kpe = jnp.split(proj, split_at, axis=-1)
        y_gdn = gdn_mixer(qkv_raw, z, b, a, conv_w[l], a_log[l], dt_bias[l], gdn_norm[l])
        y_mla = mla_mixer(cq, ckv, kpe, q_a_norm[l], kv_a_norm[l], w_uq[l], w_ukv[l], q_norm[l], k_norm[l], pos)
        h = h + jnp.concatenate([y_gdn, y_mla], axis=-1) @ w_out[l]
        h = h + peer(rms_norm(h, ffn_norm[l]), w_pq[l], sub_keys[l], expert_u[l], expert_v[l])
    return h[:, N_META:]
```

```cpp
#include <hip/hip_runtime.h>
#include <hip/hip_bf16.h>
#include <cstdio>
#include <cstdint>

#define DI __device__ __forceinline__
#define LAS __attribute__((address_space(3)))
#define GAS __attribute__((address_space(1)))

typedef unsigned short bf16_t;
typedef short bf16x8 __attribute__((ext_vector_type(8)));
typedef short s16x4 __attribute__((ext_vector_type(4)));
typedef float f32x4 __attribute__((ext_vector_type(4)));
typedef float f32x16 __attribute__((ext_vector_type(16)));
typedef unsigned u32x4 __attribute__((ext_vector_type(4)));
typedef unsigned u32x2 __attribute__((ext_vector_type(2)));

namespace pg8 {
#define PG8_LAS __attribute__((address_space(3)))
constexpr int BM = 256, BK = 64, HALF = 128, HTB = HALF * BK * 2  , STAGE_BYTES = 8 * HTB, NXCD = 8, WGM = 8;

__host__ __device__ __forceinline__ int lds_byte(int r, int c) { const int st = (r >> 4) * 2 + (c >> 5), rr = r & 15, cc = c & 31, ob = rr * 64 + cc * 2; return st * 1024 + (ob ^ (((ob >> 9) & 1) << 5)); }
__host__ __device__ __forceinline__ void stage_rc(int b, int& R, int& C) { const int st = b / 1024, sb = b % 1024, swz = sb ^ (((sb >> 9) & 1) << 5); R = (st >> 1) * 16 + swz / 64; C = (st & 1) * 32 + (swz % 64) / 2; }
__host__ __device__ __forceinline__ int perm32(int rho) { const int n = rho >> 4, i = rho & 15; return 8 * (i >> 2) + 4 * n + (i & 3); }

struct Unit { int pm, pn; };
struct Gemm { const bf16_t* A; const bf16_t* Bt; int M, N, K, lda, ldb, a_pn_off; };

struct StaticOrder {
    int nM, nN, nwg, G, c;
    __host__ __device__ void init(int M, int N, int G_, int c_) { nM = M / BM; nN = N / BM; nwg = nM * nN; G = G_; c = c_; }
    __host__ __device__ bool next(int i, Unit& u) const {
        const long L = (long)i * G + c; if (L >= nwg) return false;
        int wgid = (int)L; { const int q = nwg / NXCD, r = nwg % NXCD, xcd = wgid % NXCD, off = wgid / NXCD; wgid = (xcd < r ? xcd * (q + 1) : r * (q + 1) + (xcd - r) * q) + off; }
        const int nig = WGM * nN, gid = wgid / nig, fm = gid * WGM, gsz = (nM - fm) < WGM ? (nM - fm) : WGM;
        u.pm = fm + ((wgid % nig) % gsz); u.pn = (wgid % nig) / gsz; return true;
    }
    __device__ __forceinline__ void a_ready(const Unit&) const {}
    __device__ __forceinline__ void done(const Unit&) const {}
};

__device__ __forceinline__ unsigned cvt_pk_bf16(float lo, float hi) { unsigned r; asm volatile("v_cvt_pk_bf16_f32 %0, %1, %2" : "=v"(r) : "v"(lo), "v"(hi)); return r; }

template <class Epi, class Sched, bool ALIGN_EPI = false, bool SP2 = false>
__device__ __forceinline__ void gemm_phase(PG8_LAS unsigned char* lds, const Gemm g, const Sched& S, const Epi& E) {
    const int tid = threadIdx.x, wid = __builtin_amdgcn_readfirstlane(tid >> 6), lane = tid & 63, wr = wid >> 2, wc = wid & 3, fr = lane & 15, fq = lane >> 4;
    const int K = g.K, nt = K / BK;
    unsigned voffA[2], voffB[2];
#pragma unroll
    for (int i = 0; i < 2; ++i) { int R, C; stage_rc(tid * 16 + i * 8192, R, C); const int Rb = Epi::PERM ? ((R & ~31) + perm32(R & 31)) : R;
        voffA[i] = (unsigned)(R * g.lda + C) * 2u; voffB[i] = (unsigned)(Rb * g.ldb + C) * 2u; }
    const size_t kstep = (size_t)(BK * 2);
    const size_t hstepA = (size_t)HALF * g.lda * 2, hstepB = (size_t)HALF * g.ldb * 2;
    const size_t tstepA = 2 * hstepA, tstepB = 2 * hstepB;
    const size_t pnoffA = (size_t)g.a_pn_off * 2;
    const unsigned ldsw = (unsigned)wid * 1024u;
    const int aoff = lds_byte(wr * 64 + fr, fq * 8), boff = lds_byte(wc * 32 + fr, fq * 8);
#define PG8_SA(b, h) (((b) * 2 + (h)) * HTB)
#define PG8_SB(b, h) ((4 + (b) * 2 + (h)) * HTB)
#define PG8_STAGE(bufoff, gbase, voff) do { _Pragma("unroll") for (int _i = 0; _i < 2; ++_i) \
        __builtin_amdgcn_global_load_lds((const unsigned*)((const char*)(gbase) + (voff)[_i]), (PG8_LAS unsigned*)(lds + (bufoff) + ldsw + _i * 8192), 16, 0, 0); } while (0)
#define PG8_LDA(dst, b, h) do { _Pragma("unroll") for (int m = 0; m < 4; ++m) _Pragma("unroll") for (int k = 0; k < 2; ++k) dst[m][k] = *(const PG8_LAS bf16x8*)(lds + PG8_SA(b, h) + aoff + m * 2048 + k * 1024); } while (0)
#define PG8_LDB(dst, b, h) do { _Pragma("unroll") for (int n = 0; n < 2; ++n) _Pragma("unroll") for (int k = 0; k < 2; ++k) dst[n][k] = *(const PG8_LAS bf16x8*)(lds + PG8_SB(b, h) + boff + n * 2048 + k * 1024); } while (0)
#define PG8_MMA(ai, bj, At, Bt) do { __builtin_amdgcn_s_setprio(1); _Pragma("unroll") for (int m = 0; m < 4; ++m) _Pragma("unroll") for (int n = 0; n < 2; ++n) _Pragma("unroll") for (int k = 0; k < 2; ++k) \
        acc[ai][bj][m][n] = __builtin_amdgcn_mfma_f32_16x16x32_bf16(Bt[n][k], At[m][k], acc[ai][bj][m][n], 0, 0, 0); __builtin_amdgcn_s_setprio(0); } while (0)
#define PG8_WAIT_V(n) asm volatile("s_waitcnt vmcnt(" #n ")" ::: "memory")
#define PG8_WAIT_L(n) asm volatile("s_waitcnt lgkmcnt(" #n ")" ::: "memory")
#define PG8_BAR __builtin_amdgcn_s_barrier()
#define PG8_SCHED __builtin_amdgcn_sched_barrier(0)
    Unit cur, nxt; int ui = 0;
    if (!S.next(0, cur)) return;
    f32x4 acc[2][2][4][2];
#pragma unroll
    for (int a = 0; a < 2; ++a)
#pragma unroll
        for (int b = 0; b < 2; ++b)
#pragma unroll
            for (int m = 0; m < 4; ++m)
#pragma unroll
                for (int n = 0; n < 2; ++n) acc[a][b][m][n] = (f32x4){0.f, 0.f, 0.f, 0.f};
    bf16x8 At[4][2], B0[2][2], B1[2][2];
    const char* cA = (const char*)g.A + (size_t)cur.pm * tstepA + (size_t)cur.pn * pnoffA; const char* cB = (const char*)g.Bt + (size_t)cur.pn * tstepB;
    S.a_ready(cur);
    if constexpr (SP2) {
        PG8_STAGE(PG8_SB(0, 0), cB, voffB); PG8_STAGE(PG8_SB(0, 1), cB + hstepB, voffB); PG8_STAGE(PG8_SA(0, 0), cA, voffA); PG8_STAGE(PG8_SA(0, 1), cA + hstepA, voffA);
        if (wr == 1) PG8_BAR;
        PG8_WAIT_V(2); PG8_BAR;
        PG8_STAGE(PG8_SB(1, 0), cB + kstep, voffB); PG8_STAGE(PG8_SA(1, 0), cA + kstep, voffA); PG8_STAGE(PG8_SB(1, 1), cB + hstepB + kstep, voffB);
        PG8_WAIT_V(6); PG8_BAR;
    } else {
        PG8_STAGE(PG8_SB(0, 0), cB, voffB); PG8_STAGE(PG8_SA(0, 0), cA, voffA); PG8_STAGE(PG8_SB(0, 1), cB + hstepB, voffB); PG8_STAGE(PG8_SA(0, 1), cA + hstepA, voffA);
        if (wr == 1) PG8_BAR;
        PG8_WAIT_V(4); PG8_BAR;
        PG8_STAGE(PG8_SB(1, 0), cB + kstep, voffB); PG8_STAGE(PG8_SA(1, 0), cA + kstep, voffA); PG8_STAGE(PG8_SB(1, 1), cB + hstepB + kstep, voffB);
        PG8_WAIT_V(6); PG8_BAR;
    }
    for (;;) {
        const bool has_next = S.next(ui + 1, nxt);
        const char* nA = has_next ? (const char*)g.A + (size_t)nxt.pm * tstepA + (size_t)nxt.pn * pnoffA : cA; const char* nB = has_next ? (const char*)g.Bt + (size_t)nxt.pn * tstepB : cB;
        for (int t = 0; t < nt; t += 2) {
            const bool last = (t == nt - 2);
            const char* a1 = cA + (size_t)(t + 1) * kstep;
            const char* a2 = last ? nA : cA + (size_t)(t + 2) * kstep; const char* b2 = last ? nB : cB + (size_t)(t + 2) * kstep;
            const char* a3 = a2 + kstep; const char* b3 = b2 + kstep;
            if (last && has_next) S.a_ready(nxt);
            if constexpr (SP2) {
            PG8_LDB(B0, 0, 0); PG8_LDB(B1, 0, 1); PG8_SCHED; PG8_LDA(At, 0, 0); PG8_STAGE(PG8_SA(1, 1), a1 + hstepA, voffA);
            PG8_WAIT_V(8); PG8_WAIT_L(0); PG8_BAR; PG8_MMA(0, 0, At, B0); PG8_MMA(0, 1, At, B1); PG8_BAR; PG8_SCHED;
            PG8_LDA(At, 0, 1); PG8_STAGE(PG8_SB(0, 0), b2, voffB); PG8_STAGE(PG8_SB(0, 1), b2 + hstepB, voffB); PG8_STAGE(PG8_SA(0, 0), a2, voffA);
            PG8_WAIT_V(8); PG8_WAIT_L(0); PG8_BAR; PG8_MMA(1, 0, At, B0); PG8_MMA(1, 1, At, B1); PG8_BAR; PG8_SCHED;
            PG8_LDB(B0, 1, 0); PG8_LDB(B1, 1, 1); PG8_SCHED; PG8_LDA(At, 1, 0); PG8_STAGE(PG8_SA(0, 1), a2 + hstepA, voffA);
            PG8_WAIT_V(8); PG8_WAIT_L(0); PG8_BAR; PG8_MMA(0, 0, At, B0); PG8_MMA(0, 1, At, B1); PG8_BAR; PG8_SCHED;
            PG8_LDA(At, 1, 1); PG8_STAGE(PG8_SB(1, 0), b3, voffB); PG8_STAGE(PG8_SB(1, 1), b3 + hstepB, voffB); PG8_STAGE(PG8_SA(1, 0), a3, voffA);
            PG8_WAIT_V(8); PG8_WAIT_L(0); PG8_BAR; PG8_MMA(1, 0, At, B0); PG8_MMA(1, 1, At, B1); PG8_BAR; PG8_SCHED;
            } else {
            PG8_LDB(B0, 0, 0); PG8_SCHED; PG8_LDA(At, 0, 0); PG8_STAGE(PG8_SA(1, 1), a1 + hstepA, voffA);
            PG8_WAIT_L(8); PG8_BAR; PG8_WAIT_L(0); PG8_MMA(0, 0, At, B0); PG8_BAR; PG8_SCHED;
            PG8_LDB(B1, 0, 1); PG8_STAGE(PG8_SB(0, 0), b2, voffB);
            PG8_BAR; PG8_WAIT_L(0); PG8_MMA(0, 1, At, B1); PG8_BAR;
            PG8_LDA(At, 0, 1); PG8_STAGE(PG8_SA(0, 0), a2, voffA);
            PG8_BAR; PG8_WAIT_L(0); PG8_MMA(1, 0, At, B0); PG8_BAR; PG8_SCHED;
            PG8_STAGE(PG8_SB(0, 1), b2 + hstepB, voffB);
            PG8_WAIT_V(6); PG8_BAR; PG8_MMA(1, 1, At, B1); PG8_BAR;
            PG8_LDB(B0, 1, 0); PG8_SCHED; PG8_LDA(At, 1, 0); PG8_STAGE(PG8_SA(0, 1), a2 + hstepA, voffA);
            PG8_WAIT_L(8); PG8_BAR; PG8_WAIT_L(0); PG8_MMA(0, 0, At, B0); PG8_BAR; PG8_SCHED;
            PG8_LDB(B1, 1, 1); PG8_STAGE(PG8_SB(1, 0), b3, voffB);
            PG8_BAR; PG8_WAIT_L(0); PG8_MMA(0, 1, At, B1); PG8_BAR;
            PG8_LDA(At, 1, 1); PG8_STAGE(PG8_SA(1, 0), a3, voffA);
            PG8_BAR; PG8_WAIT_L(0); PG8_MMA(1, 0, At, B0); PG8_BAR; PG8_SCHED;
            PG8_STAGE(PG8_SB(1, 1), b3 + hstepB, voffB);
            PG8_WAIT_V(6); PG8_BAR; PG8_MMA(1, 1, At, B1); PG8_BAR;
            }
        }
        if constexpr (ALIGN_EPI) { if (wr == 0) PG8_BAR; }
        E(acc, cur, wr, wc, fr, fq); S.done(cur);
        if (!has_next) break;
#pragma unroll
        for (int a = 0; a < 2; ++a)
#pragma unroll
            for (int b = 0; b < 2; ++b)
#pragma unroll
                for (int m = 0; m < 4; ++m)
#pragma unroll
                    for (int n = 0; n < 2; ++n) acc[a][b][m][n] = (f32x4){0.f, 0.f, 0.f, 0.f};
        cur = nxt; cA = nA; cB = nB; ++ui;
        if constexpr (ALIGN_EPI) { if (wr == 1) PG8_BAR; }
    }
    PG8_WAIT_V(0);
    if constexpr (!ALIGN_EPI) { if (wr == 0) PG8_BAR; }
    PG8_BAR;
#undef PG8_SA
#undef PG8_SB
#undef PG8_STAGE
#undef PG8_LDA
#undef PG8_LDB
#undef PG8_MMA
#undef PG8_WAIT_V
#undef PG8_WAIT_L
#undef PG8_BAR
#undef PG8_SCHED
}
}

constexpr int DM = 1024;
constexpr int NTOK = 16400;
constexpr int PADL = 48;
constexpr int LPV = 16448;
constexpr int MP = 16640;
constexpr int MU = 16384;
constexpr int NCHUNK = 257;
constexpr int NHEAD = 8;
constexpr int NPROJ = 2560;
constexpr int KVROWS = 16512;
constexpr float EPS = 1e-6f;

constexpr size_t MiB = 1u << 20;
constexpr size_t WS_CTL = 0, CTL_ZERO_BYTES = 64 * 1024;
constexpr size_t WS_WIN = 1 * MiB;
constexpr size_t WS_WUQ = 6 * MiB;
constexpr size_t WS_WUKV = 6 * MiB + 512 * 1024;
constexpr size_t WS_WOUT = 7 * MiB;
constexpr size_t WS_WPQ = 9 * MiB;
constexpr size_t WS_SKB = 13 * MiB;
constexpr size_t WS_IDX = 16 * MiB;
constexpr size_t WS_GATE = 24 * MiB;
constexpr size_t WS_HN = 32 * MiB;
constexpr size_t WS_QKVR = 96 * MiB;
constexpr size_t WS_Z = 96 * MiB + 49 * MiB;
constexpr size_t WS_P32 = 162 * MiB;
constexpr size_t WS_GA = 195 * MiB;
constexpr size_t WS_GQ = 212 * MiB;
constexpr size_t WS_GS = 229 * MiB;
constexpr size_t WS_GB = 32 * MiB;
constexpr size_t WS_GO = 65 * MiB;
constexpr size_t WS_MIX = 96 * MiB;
constexpr size_t WS_CQN = 128 * MiB;
constexpr size_t WS_CKVN = 136 * MiB + 512 * 1024;
constexpr size_t WS_QH = 32 * MiB;
constexpr size_t WS_KVB = 57 * MiB;
constexpr size_t WS_Q = 195 * MiB;
constexpr size_t WS_K = 220 * MiB;
constexpr size_t WS_VT = 145 * MiB;
constexpr size_t WS_XN = 32 * MiB;
constexpr size_t WS_PQ = 64 * MiB;
constexpr size_t WS_SC = 128 * MiB;
constexpr size_t WS_EU = 96 * MiB;
constexpr size_t WS_EV = 112 * MiB;
constexpr size_t WS_CW = 64 * MiB;
constexpr size_t WS_HP = 128 * MiB;
constexpr size_t WS_END = 256 * MiB;

constexpr int LDS_BYTES = 147456;
constexpr int MISC_OFF = 131072 + 12288;

DI unsigned f2bf(float f) { unsigned u = __builtin_bit_cast(unsigned, f); return (u + 0x7fffu + ((u >> 16) & 1u)) >> 16; }
DI unsigned pk2(float lo, float hi) { return f2bf(lo) | (f2bf(hi) << 16); }
DI float bf2f(unsigned b) { return __builtin_bit_cast(float, b << 16); }
DI float bflo(unsigned w) { return __builtin_bit_cast(float, w << 16); }
DI float bfhi(unsigned w) { return __builtin_bit_cast(float, w & 0xffff0000u); }
DI float wave_sum(float v) {
#pragma unroll
    for (int o = 1; o < 64; o <<= 1) v += __shfl_xor(v, o);
    return v;
}
DI float sigmoidf_(float x) { return 1.f / (1.f + __expf(-x)); }
DI float siluf_(float x) { return x / (1.f + __expf(-x)); }

#define XB_TMO      128
#define XB_XCNT(j)  (256  + 64 * (j))
#define XB_XSUB(j)  (1280 + 64 * (j))
#define XB_XGEN(j)  (2304 + 64 * (j))
#define XB_TOP      3328
#define XB_TOPGEN   3392
#define XCD_BAR_WORDS 3456
#define XB_SPIN_CAP (1u << 22)
DI unsigned xb_ld(unsigned* p)              { return __hip_atomic_load(p, __ATOMIC_RELAXED, __HIP_MEMORY_SCOPE_AGENT); }
DI unsigned xb_add(unsigned* p, unsigned v) { return __hip_atomic_fetch_add(p, v, __ATOMIC_RELAXED, __HIP_MEMORY_SCOPE_AGENT); }
DI unsigned xb_xcc_id() { return (unsigned)__builtin_amdgcn_s_getreg((3 << 11) | 20) & 0xFu; }
#define XB_SPIN(cond, bar) do { unsigned _sp = 0; while (cond) { __builtin_amdgcn_s_sleep(1); \
    if ((++_sp & 255u) == 0u) { if (xb_ld(&(bar)[XB_TMO])) break; if (_sp > XB_SPIN_CAP) { atomicAdd(&(bar)[XB_TMO], 1u); break; } } } } while (0)
struct XcdBarrier { unsigned* bar; unsigned x; volatile LAS unsigned* st; };
DI XcdBarrier xcd_barrier_post(unsigned* bar, volatile LAS unsigned* st) {
    XcdBarrier b; b.bar = bar; b.x = xb_xcc_id(); b.st = st;
    if (threadIdx.x == 0) (void)xb_add(&bar[XB_XCNT(b.x)], 1u);
    return b;
}
DI void xcd_barrier_complete(unsigned* bar, unsigned x, unsigned& nloc, unsigned& nx) {
    const unsigned G = gridDim.x * gridDim.y * gridDim.z;
    unsigned sum, cnt, mine, sp = 0u;
    for (;;) {
        sum = 0u; cnt = 0u; mine = 0u;
#pragma unroll
        for (unsigned j = 0; j < 16; ++j) { const unsigned c = xb_ld(&bar[XB_XCNT(j)]); sum += c; cnt += (c > 0u) ? 1u : 0u; mine = (j == x) ? c : mine; }
        if (sum == G) break;
        __builtin_amdgcn_s_sleep(1);
        if ((++sp & 255u) == 0u) { if (xb_ld(&bar[XB_TMO])) break; if (sp > XB_SPIN_CAP) { atomicAdd(&bar[XB_TMO], 1u); break; } }
    }
    nloc = mine > 0u ? mine : 1u; nx = cnt > 0u ? cnt : 1u;
}
DI void xcd_barrier(const XcdBarrier& b) {
    asm volatile("s_waitcnt vmcnt(0)" ::: "memory");
    __syncthreads();
    if (threadIdx.x == 0) {
        unsigned* bar = b.bar;
        __builtin_amdgcn_s_waitcnt(0);
        unsigned nloc = b.st[0], nx = b.st[1];
        if (nloc == 0u) { xcd_barrier_complete(bar, b.x, nloc, nx); b.st[0] = nloc; b.st[1] = nx; }
        const unsigned old = xb_add(&bar[XB_XSUB(b.x)], 1u);
        const unsigned gen = old / nloc;
        if (old + 1u == (gen + 1u) * nloc) {
            __builtin_amdgcn_fence(__ATOMIC_RELEASE, "agent");
            asm volatile("s_waitcnt vmcnt(0)" ::: "memory");
            const unsigned og = xb_add(&bar[XB_TOP], 1u);
            const unsigned tg = og / nx;
            if (og + 1u == (tg + 1u) * nx) xb_add(&bar[XB_TOPGEN], 1u);
            else XB_SPIN(xb_ld(&bar[XB_TOPGEN]) == tg, bar);
            __builtin_amdgcn_fence(__ATOMIC_ACQUIRE, "agent");
            xb_add(&bar[XB_XGEN(b.x)], 1u);
            asm volatile("s_waitcnt vmcnt(0)" ::: "memory");
        } else {
            XB_SPIN(xb_ld(&bar[XB_XGEN(b.x)]) == gen, bar);
            __builtin_amdgcn_fence(__ATOMIC_ACQUIRE, "agent");
            asm volatile("s_waitcnt vmcnt(0)" ::: "memory");
        }
    }
    __syncthreads();
}

struct Args {
    const float* in[20];
    float* out; unsigned char* ws;
    int ph_lo, ph_hi;
};
struct Frame {
    unsigned char* lds;
    int tid, lane, wave, G, gw, NGW;
};

template <class Map>
DI void transpose_item(const float* __restrict__ W, int Nsrc, bf16_t* __restrict__ WT, int ldk, float* scr, int item, int nblk, int lane, Map srcmap) {
    const int kb = item / nblk, nb = item % nblk, k0 = 64 * kb, n0 = 32 * nb;
    const int ns = srcmap(n0 + (lane & 31));
#pragma unroll 8
    for (int i = 0; i < 32; ++i) { const int kk = 2 * i + (lane >> 5); scr[kk * 33 + (lane & 31)] = (ns >= 0) ? W[(size_t)(k0 + kk) * Nsrc + ns] : 0.f; }
    __builtin_amdgcn_s_waitcnt(0); __builtin_amdgcn_wave_barrier();
    const int c = lane & 7;
#pragma unroll
    for (int j = 0; j < 4; ++j) { const int n = (lane >> 3) + 8 * j; const float* s = scr + (8 * c) * 33 + n;
        u32x4 o; o.x = pk2(s[0 * 33], s[1 * 33]); o.y = pk2(s[2 * 33], s[3 * 33]); o.z = pk2(s[4 * 33], s[5 * 33]); o.w = pk2(s[6 * 33], s[7 * 33]);
        *(u32x4*)(WT + (size_t)(n0 + n) * ldk + k0 + 8 * c) = o; }
    __builtin_amdgcn_s_waitcnt(0); __builtin_amdgcn_wave_barrier();
}
struct MapId { DI int operator()(int n) const { return n; } };
struct MapWin {
    DI int operator()(int n) const {
        if (n < 2048) return n;
        if (n < 2304) return n + 16;
        if (n < 2432) return n + 16;
        if (n < 2464) return n + 16;
        if (n < 2472) return n - 416;
        if (n < 2480) return n - 416;
        return -1;
    }
};

DI void p0_prologue(const Frame& F, const Args& A) {
    unsigned char* ws = A.ws;
    float* scr = (float*)(F.lds + F.wave * 16384);
    const float* w_in = A.in[3]; const float* w_uq = A.in[10]; const float* w_ukv = A.in[11]; const float* w_out = A.in[14]; const float* w_pq = A.in[16]; const float* sub_keys = A.in[17];
    constexpr int I_IN = 16 * 80, I_UQ = 4 * 24, I_UKV = 2 * 32, I_OUT = 16 * 32, I_PQ = 16 * 64;
    constexpr int NITEMS = I_IN + I_UQ + I_UKV + I_OUT + I_PQ;
    for (int it = F.gw; it < NITEMS; it += F.NGW) {
        int r = it;
        if (r < I_IN) { transpose_item(w_in, 2480, (bf16_t*)(ws + WS_WIN), 1024, scr, r, 80, F.lane, MapWin()); continue; } r -= I_IN;
        if (r < I_UQ) { transpose_item(w_uq, 768, (bf16_t*)(ws + WS_WUQ), 256, scr, r, 24, F.lane, MapId()); continue; } r -= I_UQ;
        if (r < I_UKV) { transpose_item(w_ukv, 1024, (bf16_t*)(ws + WS_WUKV), 256, scr, r, 32, F.lane, MapId()); continue; } r -= I_UKV;
        if (r < I_OUT) { transpose_item(w_out, 1024, (bf16_t*)(ws + WS_WOUT), 1024, scr, r, 32, F.lane, MapId()); continue; } r -= I_OUT;
        transpose_item(w_pq, 2048, (bf16_t*)(ws + WS_WPQ), 1024, scr, r, 64, F.lane, MapId());
    }
    const int gt = blockIdx.x * 512 + F.tid, NGT = F.G * 512;
    for (int i = gt; i < 1024 * 16; i += NGT) { const int n = i >> 4, c = i & 15; *(u32x4*)((bf16_t*)(ws + WS_WUKV) + (size_t)n * 256 + 128 + c * 8) = (u32x4){0u, 0u, 0u, 0u}; }
    for (int i = gt; i < 2048 * 32; i += NGT) {
        const int n = i >> 5, c8 = (i & 31) * 8; const int p = (n >> 7) & 1;
        u32x4 o = (u32x4){0u, 0u, 0u, 0u};
        if ((c8 >> 7) == p) { const float* s = sub_keys + (size_t)n * 128 + (c8 & 127); const f32x4 a = *(const f32x4*)s, b = *(const f32x4*)(s + 4);
            o.x = pk2(a.x, a.y); o.y = pk2(a.z, a.w); o.z = pk2(b.x, b.y); o.w = pk2(b.z, b.w); }
        *(u32x4*)((bf16_t*)(ws + WS_SKB) + (size_t)n * 256 + c8) = o;
    }
    const float* x = A.in[0]; const float* meta = A.in[1]; const float* anorm = A.in[2];
    bf16_t* HN = (bf16_t*)(ws + WS_HN);
    for (int p = F.gw; p < MP; p += F.NGW) {
        unsigned long long* o8 = (unsigned long long*)(HN + (size_t)p * DM) + F.lane;
        const int t = p - PADL;
        if (t < 0 || t >= NTOK) {
#pragma unroll
            for (int j = 0; j < 4; ++j) o8[64 * j] = 0ull;
            continue;
        }
        const float* src = (t < 16) ? meta + (size_t)t * DM : x + (size_t)(t - 16) * DM;
        const f32x4* xr = (const f32x4*)src + F.lane;
        f32x4 v[4]; float s = 0.f;
#pragma unroll
        for (int j = 0; j < 4; ++j) { v[j] = xr[64 * j]; s += (v[j].x * v[j].x + v[j].y * v[j].y) + (v[j].z * v[j].z + v[j].w * v[j].w); }
        const float rstd = 1.f / sqrtf(wave_sum(s) * (1.f / DM) + EPS);
#pragma unroll
        for (int j = 0; j < 4; ++j) { const f32x4 w = ((const f32x4*)anorm)[64 * j + F.lane];
            o8[64 * j] = (unsigned long long)pk2(v[j].x * rstd * w.x, v[j].y * rstd * w.y) | ((unsigned long long)pk2(v[j].z * rstd * w.z, v[j].w * rstd * w.w) << 32); }
    }
}

struct EpiProj {
    static constexpr bool PERM = true;
    bf16_t* QKVR; bf16_t* Z; float* P32;
    DI void operator()(const f32x4 (&acc)[2][2][4][2], const pg8::Unit& u, int wr, int wc, int fr, int fq) const {
        const int row0 = u.pm * 256 + wr * 64 + fr;
        if (u.pn < 8) {
            bf16_t* base; int ld, colt;
            if (u.pn < 6) { base = QKVR; ld = 1536; colt = u.pn * 256; } else { base = Z; ld = 512; colt = (u.pn - 6) * 256; }
            const int col0 = colt + wc * 32 + 8 * fq;
#pragma unroll
            for (int ai = 0; ai < 2; ++ai)
#pragma unroll
                for (int m = 0; m < 4; ++m) { bf16_t* rowp = base + (size_t)(row0 + ai * 128 + m * 16) * ld + col0;
#pragma unroll
                    for (int bj = 0; bj < 2; ++bj) { const f32x4 v0 = acc[ai][bj][m][0], v1 = acc[ai][bj][m][1];
                        u32x4 w; w.x = pg8::cvt_pk_bf16(v0[0], v0[1]); w.y = pg8::cvt_pk_bf16(v0[2], v0[3]); w.z = pg8::cvt_pk_bf16(v1[0], v1[1]); w.w = pg8::cvt_pk_bf16(v1[2], v1[3]);
                        *(u32x4*)(rowp + bj * 128) = w; } }
        } else {
            const int col0 = (u.pn - 8) * 256 + wc * 32 + 8 * fq;
#pragma unroll
            for (int ai = 0; ai < 2; ++ai)
#pragma unroll
                for (int m = 0; m < 4; ++m) { float* rowp = P32 + (size_t)(row0 + ai * 128 + m * 16) * 512 + col0;
#pragma unroll
                    for (int bj = 0; bj < 2; ++bj) { *(f32x4*)(rowp + bj * 128) = acc[ai][bj][m][0]; *(f32x4*)(rowp + bj * 128 + 4) = acc[ai][bj][m][1]; } }
        }
    }
};
struct EpiB16 {
    static constexpr bool PERM = true;
    bf16_t* O; int ldc;
    DI void operator()(const f32x4 (&acc)[2][2][4][2], const pg8::Unit& u, int wr, int wc, int fr, int fq) const {
        const int row0 = u.pm * 256 + wr * 64 + fr, col0 = u.pn * 256 + wc * 32 + 8 * fq;
#pragma unroll
        for (int ai = 0; ai < 2; ++ai)
#pragma unroll
            for (int m = 0; m < 4; ++m) { bf16_t* rowp = O + (size_t)(row0 + ai * 128 + m * 16) * ldc + col0;
#pragma unroll
                for (int bj = 0; bj < 2; ++bj) { const f32x4 v0 = acc[ai][bj][m][0], v1 = acc[ai][bj][m][1];
                    u32x4 w; w.x = pg8::cvt_pk_bf16(v0[0], v0[1]); w.y = pg8::cvt_pk_bf16(v0[2], v0[3]); w.z = pg8::cvt_pk_bf16(v1[0], v1[1]); w.w = pg8::cvt_pk_bf16(v1[2], v1[3]);
                    *(u32x4*)(rowp + bj * 128) = w; } }
    }
};
struct EpiF32 {
    static constexpr bool PERM = true;
    float* C; int ldc; const float* res;
    DI void operator()(const f32x4 (&acc)[2][2][4][2], const pg8::Unit& u, int wr, int wc, int fr, int fq) const {
        const int row0 = u.pm * 256 + wr * 64 + fr, col0 = u.pn * 256 + wc * 32 + 8 * fq;
#pragma unroll
        for (int ai = 0; ai < 2; ++ai)
#pragma unroll
            for (int m = 0; m < 4; ++m) { const size_t off = (size_t)(row0 + ai * 128 + m * 16) * ldc + col0;
#pragma unroll
                for (int bj = 0; bj < 2; ++bj) { f32x4 v0 = acc[ai][bj][m][0], v1 = acc[ai][bj][m][1];
                    if (res) { v0 += *(const f32x4*)(res + off + bj * 128); v1 += *(const f32x4*)(res + off + bj * 128 + 4); }
                    *(f32x4*)(C + off + bj * 128) = v0; *(f32x4*)(C + off + bj * 128 + 4) = v1; } }
    }
};

DI f32x16 mfma32(bf16x8 a, bf16x8 b, f32x16 c) { return __builtin_amdgcn_mfma_f32_32x32x16_bf16(a, b, c, 0, 0, 0); }
DI f32x4 mfma16(bf16x8 a, bf16x8 b, f32x4 c) { return __builtin_amdgcn_mfma_f32_16x16x32_bf16(a, b, c, 0, 0, 0); }
DI int crow(int r, int hi) { return (r & 3) + 8 * (r >> 2) + 4 * hi; }
DI f32x16 zero16() { f32x16 z;
#pragma unroll
    for (int i = 0; i < 16; ++i) z[i] = 0.f; return z; }

constexpr int G_KF = 0, G_VF = 16384, G_MF = 32768;
constexpr int G_QB = 50176, G_KB = 59392, G_KBB = 68608;
constexpr int G_QKB = 77824, G_UT = 87040, G_WT = 96256, G_KDT = 105472;
constexpr int G_VEC = 114688;
constexpr int G_RAW = G_QKB;
constexpr int GST = 72;

DI f32x16 mm_quad(const unsigned char* A, const unsigned char* Bt, int qr, int qc, int lane) {
    const int r32 = lane & 31, hh = lane >> 5;
    const unsigned char* ap = A + (32 * qr + r32) * (GST * 2) + hh * 16;
    const unsigned char* bp = Bt + (32 * qc + r32) * (GST * 2) + hh * 16;
    f32x16 acc = zero16();
#pragma unroll
    for (int s = 0; s < 4; ++s) acc = mfma32(*(const bf16x8*)(ap + s * 32), *(const bf16x8*)(bp + s * 32), acc);
    return acc;
}

constexpr int G_RAW2 = 115712;
static_assert(G_RAW2 + 67 * 400 <= 143360, "GDN prep LDS map");
constexpr int G_CONVW = 143360 + 512;

DI void gdn_prep_phase(const Frame& F, const Args& A) {
    unsigned char* ws = A.ws; unsigned char* lds = F.lds;
    const int tid = F.tid, lane = F.lane, wave = F.wave;
    const bf16_t* QKVR = (const bf16_t*)(ws + WS_QKVR); const float* P32 = (const float*)(ws + WS_P32);
    float* KF = (float*)(lds + G_KF); float* VF = (float*)(lds + G_VF); float* MF = (float*)(lds + G_MF);
    float* VEC = (float*)(lds + G_VEC);
    const int NIT = NCHUNK * 8;
#define LBAR() do { asm volatile("s_waitcnt lgkmcnt(0)" ::: "memory"); __builtin_amdgcn_s_barrier(); asm volatile("" ::: "memory"); } while (0)
#define LAUNDER(dst, src) int dst = (src); asm volatile("" : "+v"(dst))
    int item = blockIdx.x;
    if (item >= NIT) return;
    u32x4 pr[4]; float nb = 0.f, na = 0.f;
    auto raw_fetch = [&](int it) {
        const int c = it >> 3, h = it & 7; LAUNDER(tl, tid);
#pragma unroll
        for (int i = 0; i < 4; ++i) { const int q = tl + 512 * i; pr[i] = (u32x4){0u, 0u, 0u, 0u};
            if (q < 67 * 24) { const int r = q / 24, cc = q % 24, seg = cc >> 3, c8 = cc & 7; const int p = 64 * c - 3 + r;
                if (p >= 0) pr[i] = *(const u32x4*)(QKVR + (size_t)p * 1536 + seg * 512 + h * 64 + c8 * 8); } }
        if (wave == 0) { const int p = 64 * c + lane; nb = P32[(size_t)p * 512 + 416 + h]; na = P32[(size_t)p * 512 + 424 + h]; }
    };
    auto raw_park = [&]() {
        LAUNDER(tl, tid);
#pragma unroll
        for (int i = 0; i < 4; ++i) { const int q = tl + 512 * i;
            if (q < 67 * 24) { const int r = q / 24, cc = q % 24, seg = cc >> 3, c8 = cc & 7; *(u32x4*)(lds + G_RAW2 + r * 400 + (seg * 64 + c8 * 8) * 2) = pr[i]; } }
    };
    raw_fetch(item); raw_park();
    float cb = nb, ca = na;
    float* CWL = (float*)(lds + G_CONVW);
    int cw_h = -1;
#pragma unroll 1
    for (; item < NIT; item += F.G) {
        const int c = item >> 3, h = item & 7;
        if (h != cw_h) { cw_h = h;
            if (tid < 192) { LAUNDER(t0, tid); const int sg = t0 >> 6, jt = (t0 >> 4) & 3, c4 = t0 & 15; *(f32x4*)(CWL + (sg * 4 + jt) * 64 + 4 * c4) = *(const f32x4*)(A.in[4] + jt * 1536 + sg * 512 + h * 64 + 4 * c4); } }
        const int nxt = item + F.G;
        if (nxt < NIT) raw_fetch(nxt);
        if (wave == 0) {
            const int p = 64 * c + lane;
            const float alog = A.in[5][h], dtb = A.in[6][h];
            float beta = sigmoidf_(cb);
            const float xx = ca + dtb; const float sp = xx > 20.f ? xx : log1pf(__expf(xx));
            float g = -__expf(alog) * sp;
            if (p < PADL) { beta = 0.f; g = 0.f; }
            float gc = g;
#pragma unroll
            for (int o = 1; o < 64; o <<= 1) { const float t = __shfl_up(gc, o); if (lane >= o) gc += t; }
            const float glast = __shfl(gc, 63);
            VEC[lane] = gc; VEC[64 + lane] = beta; VEC[128 + lane] = __expf(gc); VEC[192 + lane] = __expf(glast - gc);
        }
        LBAR();
        LAUNDER(t1, tid); const int sub = t1 & 15, grp = t1 >> 4;
#pragma unroll
        for (int sg = 0; sg < 3; ++sg) {
#pragma unroll 1
            for (int ps = 0; ps < 2; ++ps) {
                const int i = grp + 32 * ps;
                float acc[4] = {0.f, 0.f, 0.f, 0.f};
#pragma unroll
                for (int jt = 0; jt < 4; ++jt) {
                    const f32x4 w = *(const f32x4*)(CWL + (sg * 4 + jt) * 64 + 4 * sub);
                    const u32x2 rv = *(const u32x2*)(lds + G_RAW2 + (i + jt) * 400 + (sg * 64 + 4 * sub) * 2);
                    acc[0] += w.x * bflo(rv.x); acc[1] += w.y * bfhi(rv.x); acc[2] += w.z * bflo(rv.y); acc[3] += w.w * bfhi(rv.y);
                }
                float y[4];
#pragma unroll
                for (int k = 0; k < 4; ++k) y[k] = siluf_(acc[k]);
                if (sg < 2) {
                    float ss = (y[0] * y[0] + y[1] * y[1]) + (y[2] * y[2] + y[3] * y[3]);
                    ss += __shfl_xor(ss, 1); ss += __shfl_xor(ss, 2); ss += __shfl_xor(ss, 4); ss += __shfl_xor(ss, 8);
                    const float rn = 1.f / sqrtf(ss + EPS);
#pragma unroll
                    for (int k = 0; k < 4; ++k) y[k] *= rn;
                }
                if (sg == 0) {
                    u32x2 o; o.x = pk2(y[0] * 0.125f, y[1] * 0.125f); o.y = pk2(y[2] * 0.125f, y[3] * 0.125f);
                    *(u32x2*)(lds + G_QB + i * (GST * 2) + 8 * sub) = o;
                } else if (sg == 1) {
                    const float beta = VEC[64 + i], ekd = VEC[192 + i];
                    *(f32x4*)(KF + i * 64 + 4 * sub) = (f32x4){y[0], y[1], y[2], y[3]};
                    u32x2 o; o.x = pk2(y[0], y[1]); o.y = pk2(y[2], y[3]);
                    *(u32x2*)(lds + G_KB + i * (GST * 2) + 8 * sub) = o;
                    o.x = pk2(y[0] * beta, y[1] * beta); o.y = pk2(y[2] * beta, y[3] * beta);
                    *(u32x2*)(lds + G_KBB + i * (GST * 2) + 8 * sub) = o;
#pragma unroll
                    for (int k = 0; k < 4; ++k) *(bf16_t*)(lds + G_KDT + (4 * sub + k) * (GST * 2) + i * 2) = (bf16_t)f2bf(y[k] * ekd);
                } else {
                    *(f32x4*)(VF + i * 64 + 4 * sub) = (f32x4){y[0], y[1], y[2], y[3]};
                }
            }
        }
        LBAR();
        {
            LAUNDER(l3, lane);
            const int prod = wave >> 2, quad = wave & 3, qr = quad >> 1, qc = quad & 1, r32 = l3 & 31, hh = l3 >> 5;
            const f32x16 acc = mm_quad(lds + (prod ? G_QB : G_KBB), lds + G_KB, qr, qc, l3);
            const int j = 32 * qc + r32; const float gcj = VEC[j];
#pragma unroll
            for (int r = 0; r < 16; ++r) {
                const int i = 32 * qr + crow(r, hh);
                if (prod == 0) { MF[i * 68 + j] = (j < i) ? acc[r] * __expf(VEC[i] - gcj) : 0.f; }
                else { *(bf16_t*)(lds + G_QKB + i * (GST * 2) + j * 2) = (bf16_t)f2bf((j <= i) ? acc[r] * __expf(VEC[i] - gcj) : 0.f); }
            }
        }
        LBAR();
        if (tid < 128) {
            LAUNDER(col, tid); const bool isU = col < 64;
            const float* src = isU ? (VF + col) : (KF + (col - 64));
            float x[64];
#pragma unroll
            for (int i = 0; i < 64; ++i) {
                float rhs = src[i * 64] * VEC[64 + i]; if (!isU) rhs *= VEC[128 + i];
                float a0 = 0.f, a1 = 0.f, a2 = 0.f, a3 = 0.f;
#pragma unroll
                for (int j = 0; j + 3 < i; j += 4) { const f32x4 m = *(const f32x4*)(MF + i * 68 + j); a0 += m.x * x[j]; a1 += m.y * x[j + 1]; a2 += m.z * x[j + 2]; a3 += m.w * x[j + 3]; }
#pragma unroll
                for (int j = (i & ~3); j < i; ++j) a0 += MF[i * 68 + j] * x[j];
                x[i] = rhs - ((a0 + a1) + (a2 + a3));
                asm volatile("" : "+v"(x[i]) :: "memory");
            }
            unsigned char* dst = lds + (isU ? G_UT : G_WT) + (isU ? col : col - 64) * (GST * 2);
#pragma unroll
            for (int i = 0; i < 64; i += 8) {
                u32x4 o; o.x = pk2(x[i], x[i + 1]); o.y = pk2(x[i + 2], x[i + 3]); o.z = pk2(x[i + 4], x[i + 5]); o.w = pk2(x[i + 6], x[i + 7]);
                *(u32x4*)(dst + i * 2) = o;
            }
        }
        LBAR();
        {
            const float gl = VEC[128 + 63];
            float* GB = (float*)(ws + WS_GB) + (size_t)item * 4096;
            bf16_t* GQ = (bf16_t*)(ws + WS_GQ) + (size_t)item * 4096; bf16_t* GO = (bf16_t*)(ws + WS_GO) + (size_t)item * 4096;
            bf16_t* GAL = (bf16_t*)(lds + G_MF);
            LAUNDER(l5, lane); const int r32 = l5 & 31, hh = l5 >> 5;
#pragma unroll 1
            for (int it = 0; it < 2; ++it) {
                const int task = wave + 8 * it, prod = task >> 2, quad = task & 3, qr = quad >> 1, qc = quad & 1;
                const f32x16 acc = mm_quad(lds + (prod < 2 ? G_KDT : G_QKB), lds + ((prod & 1) ? G_UT : G_WT), qr, qc, l5);
                const int Cc = 32 * qc + r32;
                if (prod == 0) {
#pragma unroll
                    for (int r = 0; r < 16; ++r) {
                        const int R = 32 * qr + crow(r, hh);
                        const float val = ((R == Cc) ? gl : 0.f) - acc[r];
                        const int rb = R >> 4, m = R & 15, q4 = Cc >> 4, g = (Cc >> 2) & 3, rr = Cc & 3, ks = q4 >> 1, jj = 4 * (q4 & 1) + rr, ls = 16 * g + m;
                        GAL[((rb * 2 + ks) * 64 + ls) * 8 + jj] = (bf16_t)f2bf(val);
                    }
                } else if (prod == 1) {
                    const int eslab = Cc >> 4, n = Cc & 15;
#pragma unroll
                    for (int a = 0; a < 4; ++a) {
                        const int R0 = 32 * qr + 8 * a + 4 * hh; const int rb = R0 >> 4, g = (R0 >> 2) & 3, ls = 16 * g + n;
                        *(f32x4*)(GB + ((eslab * 4 + rb) * 64 + ls) * 4) = (f32x4){acc[4 * a], acc[4 * a + 1], acc[4 * a + 2], acc[4 * a + 3]};
                    }
                } else if (prod == 2) {
#pragma unroll
                    for (int r = 0; r < 16; ++r) {
                        const int R = 32 * qr + crow(r, hh);
                        const float qv = bf2f(*(const bf16_t*)(lds + G_QB + R * (GST * 2) + Cc * 2));
                        GQ[R * 64 + Cc] = (bf16_t)f2bf(qv * VEC[128 + R] - acc[r]);
                    }
                } else {
#pragma unroll
                    for (int r = 0; r < 16; ++r) GO[(quad * 16 + r) * 64 + l5] = (bf16_t)f2bf(acc[r]);
                }
            }
        }
        if (nxt < NIT) { raw_park(); cb = nb; ca = na; }
        LBAR();
        { LAUNDER(t6, tid); *(u32x4*)((bf16_t*)(ws + WS_GA) + (size_t)item * 4096 + t6 * 8) = *(const u32x4*)(lds + G_MF + t6 * 16); }
    }
}

constexpr int SC_D = 8, SC_PD = 6, SC_SLOT = 12288;
DI void gdn_scan(const Frame& F, const Args& A) {
    if (blockIdx.x >= 32) return;
    unsigned char* ws = A.ws;
    const int h = blockIdx.x & 7, eslab = blockIdx.x >> 3, lane = F.lane, wave = F.wave, n = lane & 15, g = lane >> 4;
    const unsigned char* GA = ws + WS_GA; const unsigned char* GB = ws + WS_GB; bf16_t* GS = (bf16_t*)(ws + WS_GS);
    LAS unsigned char* ring = (LAS unsigned char*)F.lds;
    const int np = (wave == 0) ? 0 : ((wave - 1 < 5) ? 2 : 1);
    auto issue = [&](int c) {
        const int cc = c < NCHUNK ? c : NCHUNK - 1;
        const size_t item = (size_t)cc * 8 + h;
        LAS unsigned char* slot = ring + (c % SC_D) * SC_SLOT;
#pragma unroll
        for (int i = 0; i < 2; ++i) if (i < np) {
            const int q = (wave - 1) + 7 * i;
            const unsigned char* src = (q < 8) ? GA + item * 8192 + q * 1024 : GB + item * 16384 + eslab * 4096 + (q - 8) * 1024;
            LAS unsigned char* dst = slot + ((q < 8) ? q * 1024 : 8192 + (q - 8) * 1024);
            __builtin_amdgcn_global_load_lds((const unsigned*)(src + lane * 16), (LAS unsigned*)dst, 16, 0, 0);
        }
    };
    for (int c = 0; c < SC_PD; ++c) issue(c);
    f32x4 S[4];
#pragma unroll
    for (int rb = 0; rb < 4; ++rb) S[rb] = (f32x4){0.f, 0.f, 0.f, 0.f};
#pragma unroll 1
    for (int c = 0; c < NCHUNK; ++c) {
        issue(c + SC_PD);
        if (np == 2) asm volatile("s_waitcnt vmcnt(12)" ::: "memory");
        else if (np == 1) asm volatile("s_waitcnt vmcnt(6)" ::: "memory");
        asm volatile("s_waitcnt lgkmcnt(0)" ::: "memory");
        __builtin_amdgcn_s_barrier();
        asm volatile("" ::: "memory");
        if (wave == 0) {
            const LAS unsigned char* slot = ring + (c % SC_D) * SC_SLOT;
            bf16x8 ac[8]; f32x4 bc[4];
#pragma unroll
            for (int q = 0; q < 8; ++q) ac[q] = *(const LAS bf16x8*)(slot + q * 1024 + lane * 16);
#pragma unroll
            for (int rb = 0; rb < 4; ++rb) bc[rb] = *(const LAS f32x4*)(slot + 8192 + rb * 1024 + lane * 16);
            const size_t item = (size_t)c * 8 + h;
            u32x4 p0, p1;
            p0.x = pk2(S[0][0], S[0][1]); p0.y = pk2(S[0][2], S[0][3]); p0.z = pk2(S[1][0], S[1][1]); p0.w = pk2(S[1][2], S[1][3]);
            p1.x = pk2(S[2][0], S[2][1]); p1.y = pk2(S[2][2], S[2][3]); p1.z = pk2(S[3][0], S[3][1]); p1.w = pk2(S[3][2], S[3][3]);
            {
                bf16_t* st = GS + item * 4096 + (16 * eslab + n) * 64 + 4 * g;
                *(u32x2*)(st + 0) = (u32x2){p0.x, p0.y}; *(u32x2*)(st + 16) = (u32x2){p0.z, p0.w};
                *(u32x2*)(st + 32) = (u32x2){p1.x, p1.y}; *(u32x2*)(st + 48) = (u32x2){p1.z, p1.w};
            }
            const bf16x8 b0 = __builtin_bit_cast(bf16x8, p0), b1 = __builtin_bit_cast(bf16x8, p1);
#pragma unroll
            for (int rb = 0; rb < 4; ++rb) {
                f32x4 acc = bc[rb];
                acc = mfma16(ac[rb * 2 + 0], b0, acc);
                acc = mfma16(ac[rb * 2 + 1], b1, acc);
                S[rb] = acc;
            }
        }
    }
    asm volatile("s_waitcnt vmcnt(0) lgkmcnt(0)" ::: "memory");
    __builtin_amdgcn_s_barrier();
}

DI void gdn_out_task(const Frame& F, const Args& A, int task) {
    unsigned char* ws = A.ws;
    const int ihalf = task & 1, item = (task >> 1) + 8, c = item >> 3, h = item & 7, lane = F.lane, r32 = lane & 31, hh = lane >> 5;
    const bf16_t* GQ = (const bf16_t*)(ws + WS_GQ) + (size_t)item * 4096; const bf16_t* GS = (const bf16_t*)(ws + WS_GS) + (size_t)item * 4096;
    const bf16_t* GO = (const bf16_t*)(ws + WS_GO) + (size_t)item * 4096;
    const bf16_t* Z = (const bf16_t*)(ws + WS_Z); bf16_t* MIX = (bf16_t*)(ws + WS_MIX);
    f32x16 acc[2];
#pragma unroll
    for (int eh = 0; eh < 2; ++eh)
#pragma unroll
        for (int r = 0; r < 16; ++r) acc[eh][r] = bf2f(GO[((ihalf * 2 + eh) * 16 + r) * 64 + lane]);
#pragma unroll
    for (int s = 0; s < 4; ++s) {
        const bf16x8 a = *(const bf16x8*)(GQ + (32 * ihalf + r32) * 64 + 16 * s + 8 * hh);
#pragma unroll
        for (int eh = 0; eh < 2; ++eh) {
            const bf16x8 b = *(const bf16x8*)(GS + (32 * eh + r32) * 64 + 16 * s + 8 * hh);
            acc[eh] = mfma32(a, b, acc[eh]);
        }
    }
    const float* gnorm = A.in[7];
    const float w0 = gnorm[r32], w1 = gnorm[32 + r32];
#pragma unroll
    for (int r = 0; r < 16; ++r) {
        float ss = acc[0][r] * acc[0][r] + acc[1][r] * acc[1][r];
        ss += __shfl_xor(ss, 1); ss += __shfl_xor(ss, 2); ss += __shfl_xor(ss, 4); ss += __shfl_xor(ss, 8); ss += __shfl_xor(ss, 16);
        const float rstd = 1.f / sqrtf(ss * (1.f / 64.f) + EPS);
        const int i = 32 * ihalf + crow(r, hh); const int p = 64 * c + i;
        const float z0 = bf2f(Z[(size_t)p * 512 + h * 64 + r32]), z1 = bf2f(Z[(size_t)p * 512 + h * 64 + 32 + r32]);
        bf16_t* o = MIX + (size_t)(p - 64) * 1024 + h * 64;
        o[r32] = (bf16_t)f2bf(acc[0][r] * rstd * w0 * siluf_(z0));
        o[32 + r32] = (bf16_t)f2bf(acc[1][r] * rstd * w1 * siluf_(z1));
    }
}

DI void mla_prep1_row(const Frame& F, const Args& A, int p) {
    unsigned char* ws = A.ws; const int lane = F.lane;
    const float* P32 = (const float*)(ws + WS_P32) + (size_t)p * 512;
    bf16_t* CQN = (bf16_t*)(ws + WS_CQN) + (size_t)p * 256; bf16_t* CKVN = (bf16_t*)(ws + WS_CKVN) + (size_t)p * 256;
    const f32x4 q = *(const f32x4*)(P32 + 4 * lane);
    const float sq = wave_sum((q.x * q.x + q.y * q.y) + (q.z * q.z + q.w * q.w));
    const float rq = 1.f / sqrtf(sq * (1.f / 256.f) + EPS);
    const f32x4 wq = *(const f32x4*)(A.in[8] + 4 * lane);
    *(u32x2*)(CQN + 4 * lane) = (u32x2){pk2(q.x * rq * wq.x, q.y * rq * wq.y), pk2(q.z * rq * wq.z, q.w * rq * wq.w)};
    const float k0 = P32[256 + 2 * lane], k1 = P32[256 + 2 * lane + 1];
    const float sk = wave_sum(k0 * k0 + k1 * k1);
    const float rk = 1.f / sqrtf(sk * (1.f / 128.f) + EPS);
    const float wk0 = A.in[9][2 * lane], wk1 = A.in[9][2 * lane + 1];
    *(unsigned*)(CKVN + 2 * lane) = pk2(k0 * rk * wk0, k1 * rk * wk1);
    *(unsigned*)(CKVN + 128 + 2 * lane) = 0u;
}

constexpr float QSCALE = 0.10206207261596577f * 1.4426950408889634f;
DI double rope_inv_rev(int i) {
    const double t8[8] = {0.15915494309189535, 0.08949940160889101, 0.050329212104487035, 0.0283021958306234, 0.015915494309189534, 0.008949940160889102, 0.005032921210448704, 0.00283021958306234};
    double v = t8[0];
#pragma unroll
    for (int k = 1; k < 8; ++k) v = ((i & 7) == k) ? t8[k] : v;
    return (i & 8) ? v * 0.01 : v;
}
DI void mla_prep2_row(const Frame& F, const Args& A, int p) {
    unsigned char* ws = A.ws; const int lane = F.lane, h = lane >> 3, s8 = lane & 7;
    bf16_t* Q = (bf16_t*)(ws + WS_Q) + ((size_t)h * KVROWS + p) * 96;
    bf16_t* K = (bf16_t*)(ws + WS_K) + ((size_t)h * KVROWS + p) * 96;
    bf16_t* VT = (bf16_t*)(ws + WS_VT) + (size_t)h * 64 * KVROWS + p;
    if (p < PADL || p >= LPV) {
#pragma unroll
        for (int m = 0; m < 12; ++m) { Q[s8 + 8 * m] = 0; K[s8 + 8 * m] = 0; }
#pragma unroll
        for (int m = 0; m < 8; ++m) VT[(size_t)(s8 + 8 * m) * KVROWS] = 0;
        return;
    }
    const bf16_t* QH = (const bf16_t*)(ws + WS_QH) + (size_t)p * 768 + h * 96;
    const bf16_t* KV = (const bf16_t*)(ws + WS_KVB) + (size_t)p * 1024 + h * 128;
    const float* kpe = (const float*)(ws + WS_P32) + (size_t)p * 512 + 384;
    const float* qn = A.in[12]; const float* kn = A.in[13];
    float q[12], k[12];
    float sq = 0.f, sk = 0.f;
#pragma unroll
    for (int m = 0; m < 12; ++m) { q[m] = bf2f(QH[s8 + 8 * m]); sq += q[m] * q[m]; }
#pragma unroll
    for (int m = 0; m < 8; ++m) k[m] = bf2f(KV[s8 + 8 * m]);
#pragma unroll
    for (int m = 8; m < 12; ++m) k[m] = kpe[s8 + 8 * (m - 8)];
#pragma unroll
    for (int m = 0; m < 12; ++m) sk += k[m] * k[m];
    sq += __shfl_xor(sq, 1); sq += __shfl_xor(sq, 2); sq += __shfl_xor(sq, 4);
    sk += __shfl_xor(sk, 1); sk += __shfl_xor(sk, 2); sk += __shfl_xor(sk, 4);
    const float rq = 1.f / sqrtf(sq * (1.f / 96.f) + EPS), rk = 1.f / sqrtf(sk * (1.f / 96.f) + EPS);
#pragma unroll
    for (int m = 0; m < 12; ++m) { q[m] *= rq * qn[s8 + 8 * m]; k[m] *= rk * kn[s8 + 8 * m]; }
    const double pos = (double)(p - PADL);
#pragma unroll
    for (int t = 0; t < 2; ++t) {
        const int i = s8 + 8 * t;
        const double rev = pos * rope_inv_rev(i);
        const float fr = (float)(rev - floor(rev));
        const float sn = __builtin_amdgcn_sinf(fr), cs = __builtin_amdgcn_cosf(fr);
        const float q1 = q[8 + t], q2 = q[10 + t]; q[8 + t] = q1 * cs - q2 * sn; q[10 + t] = q2 * cs + q1 * sn;
        const float k1 = k[8 + t], k2 = k[10 + t]; k[8 + t] = k1 * cs - k2 * sn; k[10 + t] = k2 * cs + k1 * sn;
    }
#pragma unroll
    for (int m = 0; m < 12; ++m) { Q[s8 + 8 * m] = (bf16_t)f2bf(q[m] * QSCALE); K[s8 + 8 * m] = (bf16_t)f2bf(k[m]); }
#pragma unroll
    for (int m = 0; m < 8; ++m) VT[(size_t)(s8 + 8 * m) * KVROWS] = KV[64 + s8 + 8 * m];
}

constexpr int A_KSTR = 208;
constexpr int A_VSTR = 136;
constexpr int A_KBYTES = 64 * A_KSTR;
constexpr int A_VBYTES = 64 * A_VSTR;
constexpr int A_BUF = A_KBYTES + A_VBYTES;
DI unsigned cvtpk_s(float lo, float hi) { typedef float f2 __attribute__((ext_vector_type(2))); typedef __bf16 b2 __attribute__((ext_vector_type(2))); f2 v = {lo, hi}; b2 b = __builtin_convertvector(v, b2); return __builtin_bit_cast(unsigned, b); }

DI void attn_item(const Frame& F, const Args& A, int h, int qb) {
    unsigned char* ws = A.ws; unsigned char* lds = F.lds;
    const int tid = F.tid, lane = F.lane, wave = F.wave, r32 = lane & 31, hh = lane >> 5;
    const bf16_t* Qg = (const bf16_t*)(ws + WS_Q) + (size_t)h * KVROWS * 96;
    const bf16_t* Kg = (const bf16_t*)(ws + WS_K) + (size_t)h * KVROWS * 96;
    const bf16_t* Vg = (const bf16_t*)(ws + WS_VT) + (size_t)h * 64 * KVROWS;
    const int p0w = 64 + 256 * qb + 32 * wave;
    const int qp = p0w + r32;
    const int ntile = 4 * qb + 5;
    const int mylast = 1 + 4 * qb + (wave >> 1);
    bf16x8 qf[6];
#pragma unroll
    for (int s = 0; s < 6; ++s) qf[s] = *(const bf16x8*)(Qg + (size_t)qp * 96 + 16 * s + 8 * hh);
    f32x16 ot[2]; ot[0] = zero16(); ot[1] = zero16();
    float mrun = -1e30f, lrun = 0.f;
    const int kr0 = tid / 12, kc0 = tid % 12, kr1 = (tid + 512) / 12, kc1 = (tid + 512) % 12; const bool k1ok = tid < 256;
    const int vr = tid >> 3, vc = tid & 7;
    u32x4 sk0, sk1, sv;
    auto gload = [&](int j) {
        const int kv0 = 64 * j;
        sk0 = *(const u32x4*)(Kg + (size_t)(kv0 + kr0) * 96 + kc0 * 8);
        if (k1ok) sk1 = *(const u32x4*)(Kg + (size_t)(kv0 + kr1) * 96 + kc1 * 8);
        sv = *(const u32x4*)(Vg + (size_t)vr * KVROWS + kv0 + vc * 8);
    };
    auto lstore = [&](int b) {
        unsigned char* kb = lds + b * A_BUF; unsigned char* vb = kb + A_KBYTES;
        *(u32x4*)(kb + kr0 * A_KSTR + kc0 * 16) = sk0;
        if (k1ok) *(u32x4*)(kb + kr1 * A_KSTR + kc1 * 16) = sk1;
        *(u32x2*)(vb + vr * A_VSTR + vc * 16) = (u32x2){sv.x, sv.y};
        *(u32x2*)(vb + vr * A_VSTR + vc * 16 + 8) = (u32x2){sv.z, sv.w};
    };
    gload(0); lstore(0);
    __syncthreads();
#pragma unroll 1
    for (int j = 0; j < ntile; ++j) {
        const int b = j & 1;
        if (j + 1 < ntile) gload(j + 1);
        if (j <= mylast) {
            const unsigned char* kb = lds + b * A_BUF; const unsigned char* vb = kb + A_KBYTES;
            f32x16 sc[2];
#pragma unroll
            for (int kh = 0; kh < 2; ++kh) {
                f32x16 acc = zero16();
                const unsigned char* kp = kb + (32 * kh + r32) * A_KSTR + hh * 16;
#pragma unroll
                for (int s = 0; s < 6; ++s) acc = mfma32(*(const bf16x8*)(kp + s * 32), qf[s], acc);
                sc[kh] = acc;
            }
            if (j == 0) {
#pragma unroll
                for (int kh = 0; kh < 2; ++kh)
#pragma unroll
                    for (int r = 0; r < 16; ++r) { const int kv = 32 * kh + crow(r, hh); if (kv < PADL) sc[kh][r] = -INFINITY; }
            }
            if (j == mylast) {
#pragma unroll
                for (int kh = 0; kh < 2; ++kh)
#pragma unroll
                    for (int r = 0; r < 16; ++r) { const int kv = 64 * j + 32 * kh + crow(r, hh); if (kv > qp) sc[kh][r] = -INFINITY; }
            }
            float mx = sc[0][0];
#pragma unroll
            for (int r = 1; r < 16; ++r) mx = fmaxf(mx, sc[0][r]);
#pragma unroll
            for (int r = 0; r < 16; ++r) mx = fmaxf(mx, sc[1][r]);
            mx = fmaxf(mx, __shfl_xor(mx, 32));
            const float mnew = fmaxf(mrun, mx);
            const float alpha = __builtin_amdgcn_exp2f(mrun - mnew);
            mrun = mnew;
            float ps = 0.f;
#pragma unroll
            for (int kh = 0; kh < 2; ++kh)
#pragma unroll
                for (int r = 0; r < 16; ++r) { const float e = __builtin_amdgcn_exp2f(sc[kh][r] - mnew); sc[kh][r] = e; ps += e; }
            lrun = lrun * alpha + ps;
#pragma unroll
            for (int eh = 0; eh < 2; ++eh)
#pragma unroll
                for (int r = 0; r < 16; ++r) ot[eh][r] *= alpha;
#pragma unroll
            for (int kh = 0; kh < 2; ++kh)
#pragma unroll
                for (int s2 = 0; s2 < 2; ++s2) {
                    u32x4 pw; pw.x = cvtpk_s(sc[kh][8 * s2 + 0], sc[kh][8 * s2 + 1]); pw.y = cvtpk_s(sc[kh][8 * s2 + 2], sc[kh][8 * s2 + 3]);
                    pw.z = cvtpk_s(sc[kh][8 * s2 + 4], sc[kh][8 * s2 + 5]); pw.w = cvtpk_s(sc[kh][8 * s2 + 6], sc[kh][8 * s2 + 7]);
                    const bf16x8 pf = __builtin_bit_cast(bf16x8, pw);
#pragma unroll
                    for (int eh = 0; eh < 2; ++eh) {
                        const unsigned char* vp = vb + (32 * eh + r32) * A_VSTR + (32 * kh + 16 * s2 + 4 * hh) * 2;
                        const u32x2 lo = *(const u32x2*)vp, hi2 = *(const u32x2*)(vp + 16);
                        const bf16x8 vf = __builtin_bit_cast(bf16x8, (u32x4){lo.x, lo.y, hi2.x, hi2.y});
                        ot[eh] = mfma32(vf, pf, ot[eh]);
                    }
                }
        }
        if (j + 1 < ntile) lstore(b ^ 1);
        __syncthreads();
    }
    const float ltot = lrun + __shfl_xor(lrun, 32);
    const float rl = 1.f / ltot;
    bf16_t* o = (bf16_t*)(ws + WS_MIX) + (size_t)(qp - 64) * 1024 + 512 + h * 64;
#pragma unroll
    for (int eh = 0; eh < 2; ++eh)
#pragma unroll
        for (int a = 0; a < 4; ++a) {
            const int e = 32 * eh + 8 * a + 4 * hh;
            *(u32x2*)(o + e) = (u32x2){pk2(ot[eh][4 * a] * rl, ot[eh][4 * a + 1] * rl), pk2(ot[eh][4 * a + 2] * rl, ot[eh][4 * a + 3] * rl)};
        }
}

DI void xn_row(const Frame& F, const Args& A, int u) {
    const f32x4* xr = (const f32x4*)(A.out + (size_t)u * DM) + F.lane;
    f32x4 v[4]; float s = 0.f;
#pragma unroll
    for (int j = 0; j < 4; ++j) { v[j] = xr[64 * j]; s += (v[j].x * v[j].x + v[j].y * v[j].y) + (v[j].z * v[j].z + v[j].w * v[j].w); }
    const float rstd = 1.f / sqrtf(wave_sum(s) * (1.f / DM) + EPS);
    unsigned long long* o8 = (unsigned long long*)((bf16_t*)(A.ws + WS_XN) + (size_t)u * DM) + F.lane;
#pragma unroll
    for (int j = 0; j < 4; ++j) { const f32x4 w = ((const f32x4*)A.in[15])[64 * j + F.lane];
        o8[64 * j] = (unsigned long long)pk2(v[j].x * rstd * w.x, v[j].y * rstd * w.y) | ((unsigned long long)pk2(v[j].z * rstd * w.z, v[j].w * rstd * w.w) << 32); }
}

DI unsigned fkey(float v, int idx) { unsigned u = __builtin_bit_cast(unsigned, v); u = (u & 0x80000000u) ? ~u : (u | 0x80000000u); return (u & ~127u) | (unsigned)(127 - idx); }
DI float keyval(unsigned k) { unsigned u = k & ~127u; u = (u & 0x80000000u) ? (u & 0x7fffffffu) : ~u; return __builtin_bit_cast(float, u); }

__device__ const unsigned char PAIR_A[50] = {0,0,0,0,0,0,0,0,0,0,0,0,0,0,0,0, 1,1,1,1,1,1,1,1, 2,2,2,2,2, 3,3,3,3, 4,4,4, 5,5, 6,6, 7,7, 8,9,10,11,12,13,14,15};
__device__ const unsigned char PAIR_B[50] = {0,1,2,3,4,5,6,7,8,9,10,11,12,13,14,15, 0,1,2,3,4,5,6,7, 0,1,2,3,4, 0,1,2,3, 0,1,2, 0,1, 0,1, 0,1, 0,0,0,0,0,0,0,0};

DI void topk_task(const Frame& F, const Args& A, int task) {
    unsigned char* ws = A.ws; const int tid = F.tid;
    const int u = task >> 3, h = task & 7;
    LAS unsigned* sk = (LAS unsigned*)(LAS unsigned char*)F.lds;
    LAS unsigned* pkk = sk + 16384;
    const float* SC = (const float*)(ws + WS_SC) + (size_t)u * 2048 + h * 256;
#pragma unroll 1
    for (int half = 0; half < 2; ++half) {
        unsigned key[128];
#pragma unroll
        for (int i = 0; i < 32; ++i) { const f32x4 v = *(const f32x4*)(SC + half * 128 + 4 * i);
            key[4 * i] = fkey(v.x, 4 * i); key[4 * i + 1] = fkey(v.y, 4 * i + 1); key[4 * i + 2] = fkey(v.z, 4 * i + 2); key[4 * i + 3] = fkey(v.w, 4 * i + 3); }
        unsigned prev = 0xffffffffu;
#pragma unroll 1
        for (int r = 0; r < 16; ++r) {
            unsigned best = 0u;
#pragma unroll
            for (int i = 0; i < 128; ++i) { const unsigned c = key[i] < prev ? key[i] : 0u; best = c > best ? c : best; }
            asm volatile("" : "+v"(best));
            sk[(half * 16 + r) * 512 + tid] = best; prev = best;
        }
    }
    float v1[16], v2[16];
#pragma unroll
    for (int r = 0; r < 16; ++r) { v1[r] = keyval(sk[r * 512 + tid]); v2[r] = keyval(sk[(16 + r) * 512 + tid]); }
    unsigned ck[50];
#pragma unroll
    for (int a = 0; a < 16; ++a) {
        const int off = a == 0 ? 0 : a == 1 ? 16 : a == 2 ? 24 : a == 3 ? 29 : a == 4 ? 33 : a == 5 ? 36 : a == 6 ? 38 : a == 7 ? 40 : 42 + (a - 8);
#pragma unroll
        for (int b = 0; b < 16; ++b) if ((a + 1) * (b + 1) <= 16) ck[off + b] = fkey(v1[a] + v2[b], off + b);
    }
    unsigned prev = 0xffffffffu;
#pragma unroll 1
    for (int r = 0; r < 16; ++r) {
        unsigned best = 0u;
#pragma unroll
        for (int c = 0; c < 50; ++c) { const unsigned x = ck[c] < prev ? ck[c] : 0u; best = x > best ? x : best; }
        asm volatile("" : "+v"(best));
        pkk[r * 512 + tid] = best; prev = best;
    }
    const float cmax = keyval(pkk[tid]);
    float ev[16]; float esum = 0.f; int ex[16];
#pragma unroll
    for (int r = 0; r < 16; ++r) {
        const unsigned k = pkk[r * 512 + tid]; const int c = 127 - (int)(k & 127u);
        ev[r] = __expf(keyval(k) - cmax); esum += ev[r];
        const int a = PAIR_A[c], b = PAIR_B[c];
        const int i1 = 127 - (int)(sk[a * 512 + tid] & 127u), i2 = 127 - (int)(sk[(16 + b) * 512 + tid] & 127u);
        ex[r] = i1 * 128 + i2;
    }
    const float rs = 1.f / esum;
    int* IDX = (int*)(ws + WS_IDX) + (size_t)u * 128 + h * 16; float* GATE = (float*)(ws + WS_GATE) + (size_t)u * 128 + h * 16;
#pragma unroll
    for (int r = 0; r < 16; r += 4) {
        *(int4*)(IDX + r) = make_int4(ex[r], ex[r + 1], ex[r + 2], ex[r + 3]);
        *(f32x4*)(GATE + r) = (f32x4){ev[r] * rs, ev[r + 1] * rs, ev[r + 2] * rs, ev[r + 3] * rs};
    }
}

constexpr float EU_SCALE = 64.f, EV_SCALE = 16.f;
DI unsigned pk4_fp8(float a, float b, float c, float d) { int w = 0; w = __builtin_amdgcn_cvt_pk_fp8_f32(a, b, w, false); w = __builtin_amdgcn_cvt_pk_fp8_f32(c, d, w, true); return (unsigned)w; }
DI void convert_tables(const Frame& F, const Args& A) {
    const size_t n16 = (size_t)16384 * 1024 / 16;
    const size_t gt = (size_t)blockIdx.x * 512 + F.tid, NGT = (size_t)F.G * 512;
#pragma unroll 1
    for (int t = 0; t < 2; ++t) {
        const float* src = A.in[18 + t]; unsigned char* dst = A.ws + (t ? WS_EV : WS_EU); const float sc = t ? EV_SCALE : EU_SCALE;
        for (size_t i = gt; i < n16; i += NGT) {
            const f32x4 a = *(const f32x4*)(src + i * 16) * sc, b = *(const f32x4*)(src + i * 16 + 4) * sc, c = *(const f32x4*)(src + i * 16 + 8) * sc, d = *(const f32x4*)(src + i * 16 + 12) * sc;
            const size_t e_ = i >> 6, c16_ = i & 63;
            *(u32x4*)(dst + (c16_ >> 3) * ((size_t)16384 * 128) + e_ * 128 + (c16_ & 7) * 16) = (u32x4){pk4_fp8(a.x, a.y, a.z, a.w), pk4_fp8(b.x, b.y, b.z, b.w), pk4_fp8(c.x, c.y, c.z, c.w), pk4_fp8(d.x, d.y, d.z, d.w)};
        }
    }
}

DI float gelu_exact(float x) { return 0.5f * x * (1.f + erff(x * 0.70710678118654752f)); }
typedef float f32x2 __attribute__((ext_vector_type(2)));
#define UNPK16(dst, W_) do { f32x2 _t; \
    _t = __builtin_amdgcn_cvt_pk_f32_fp8((int)(W_).x, false); dst[0] = _t.x; dst[1] = _t.y; _t = __builtin_amdgcn_cvt_pk_f32_fp8((int)(W_).x, true); dst[2] = _t.x; dst[3] = _t.y; \
    _t = __builtin_amdgcn_cvt_pk_f32_fp8((int)(W_).y, false); dst[4] = _t.x; dst[5] = _t.y; _t = __builtin_amdgcn_cvt_pk_f32_fp8((int)(W_).y, true); dst[6] = _t.x; dst[7] = _t.y; \
    _t = __builtin_amdgcn_cvt_pk_f32_fp8((int)(W_).z, false); dst[8] = _t.x; dst[9] = _t.y; _t = __builtin_amdgcn_cvt_pk_f32_fp8((int)(W_).z, true); dst[10] = _t.x; dst[11] = _t.y; \
    _t = __builtin_amdgcn_cvt_pk_f32_fp8((int)(W_).w, false); dst[12] = _t.x; dst[13] = _t.y; _t = __builtin_amdgcn_cvt_pk_f32_fp8((int)(W_).w, true); dst[14] = _t.x; dst[15] = _t.y; } while (0)

template <bool UPH>
DI void expert_phase(const Frame& F, const Args& A, int xv, int wq, int nw) {
    unsigned char* ws = A.ws; const int lane = F.lane, grp = lane >> 3, j = lane & 7;
    const unsigned char* TBL = ws + (UPH ? WS_EU : WS_EV) + (size_t)xv * ((size_t)16384 * 128) + 16 * j;
    const int* IDX = (const int*)(ws + WS_IDX); const float* CW = (const float*)(ws + WS_CW);
    const bf16_t* XN = (const bf16_t*)(ws + WS_XN) + 128 * xv + 16 * j;
    float* HP = (float*)(ws + WS_HP);
    LAS unsigned* ring = (LAS unsigned*)((LAS unsigned char*)F.lds + F.wave * 4096);
    const int nt = (MU - wq + nw - 1) / nw;
    if (nt <= 0) return;
    auto tok = [&](int k) { return __builtin_amdgcn_readfirstlane(wq + (k < nt ? k : nt - 1) * nw); };
    int mi0, mi1; u32x4 mx0, mx1; float mh0, mh1;
    auto meta_load = [&](int k) {
        const int u = tok(k);
        mi0 = IDX[(size_t)u * 128 + lane]; mi1 = IDX[(size_t)u * 128 + 64 + lane];
        if constexpr (UPH) { mx0 = *(const u32x4*)(XN + (size_t)u * DM); mx1 = *(const u32x4*)(XN + (size_t)u * DM + 8); }
        else { mh0 = CW[(size_t)u * 128 + lane]; mh1 = CW[(size_t)u * 128 + 64 + lane]; }
    };
    auto meta_store = [&](int k) {
        LAS unsigned* sl = ring + (k & 3) * 256;
        sl[lane] = (unsigned)mi0; sl[64 + lane] = (unsigned)mi1;
        if constexpr (UPH) { if (grp == 0) { *(LAS u32x4*)(sl + 128 + 8 * j) = mx0; *(LAS u32x4*)(sl + 128 + 8 * j + 4) = mx1; } }
        else { sl[128 + lane] = __builtin_bit_cast(unsigned, mh0); sl[192 + lane] = __builtin_bit_cast(unsigned, mh1); }
    };
    auto gather = [&](u32x4 (&buf)[8], int n) {
        const LAS unsigned* sl = ring + ((n >> 1) & 3) * 256 + 64 * (n & 1) + grp;
#pragma unroll
        for (int i = 0; i < 8; ++i) { const int e = (int)sl[8 * i]; buf[i] = *(const u32x4*)(TBL + (size_t)e * 128); }
    };
    const int ocol = 128 * xv + 16 * j + ((lane & 32) ? 8 : 0) + ((lane & 16) ? 4 : 0) + ((lane & 8) ? 2 : 0);
    f32x2 ocur = (f32x2){0.f, 0.f};
    float acc[16];
    float xn[16];
    auto compute = [&](u32x4 (&buf)[8], int n) {
        const int k = n >> 1, hf = n & 1;
        const LAS unsigned* sl = ring + (k & 3) * 256;
        if (hf == 0) {
            if constexpr (UPH) {
                const u32x4 x0 = *(const LAS u32x4*)(sl + 128 + 8 * j), x1 = *(const LAS u32x4*)(sl + 128 + 8 * j + 4);
                xn[0] = bflo(x0.x); xn[1] = bfhi(x0.x); xn[2] = bflo(x0.y); xn[3] = bfhi(x0.y); xn[4] = bflo(x0.z); xn[5] = bfhi(x0.z); xn[6] = bflo(x0.w); xn[7] = bfhi(x0.w);
                xn[8] = bflo(x1.x); xn[9] = bfhi(x1.x); xn[10] = bflo(x1.y); xn[11] = bfhi(x1.y); xn[12] = bflo(x1.z); xn[13] = bfhi(x1.z); xn[14] = bflo(x1.w); xn[15] = bfhi(x1.w);
            } else {
#pragma unroll
                for (int c = 0; c < 16; ++c) acc[c] = 0.f;
                ocur = *(const f32x2*)(A.out + (size_t)tok(k) * DM + ocol);
            }
        }
#pragma unroll
        for (int i = 0; i < 8; ++i) {
            float f[16]; UNPK16(f, buf[i]);
            if constexpr (UPH) {
                float a0 = 0.f, a1 = 0.f;
#pragma unroll
                for (int c = 0; c < 16; c += 2) { a0 += f[c] * xn[c]; a1 += f[c + 1] * xn[c + 1]; }
                if (hf == 0) acc[i] = a0 + a1; else acc[8 + i] = a0 + a1;
                if (i < 7) { if (hf == 0) asm volatile("" : "+v"(buf[i + 1].x), "+v"(buf[i + 1].y), "+v"(buf[i + 1].z), "+v"(buf[i + 1].w), "+v"(acc[i]));
                             else asm volatile("" : "+v"(buf[i + 1].x), "+v"(buf[i + 1].y), "+v"(buf[i + 1].z), "+v"(buf[i + 1].w), "+v"(acc[8 + i])); }
            } else {
                const float cw = __builtin_bit_cast(float, sl[128 + 64 * hf + 8 * i + grp]);
#pragma unroll
                for (int c = 0; c < 16; ++c) acc[c] += cw * f[c];
                if (i < 7) asm volatile("" : "+v"(buf[i + 1].x), "+v"(buf[i + 1].y), "+v"(buf[i + 1].z), "+v"(buf[i + 1].w),
                                             "+v"(acc[0]), "+v"(acc[1]), "+v"(acc[2]), "+v"(acc[3]), "+v"(acc[4]), "+v"(acc[5]), "+v"(acc[6]), "+v"(acc[7]),
                                             "+v"(acc[8]), "+v"(acc[9]), "+v"(acc[10]), "+v"(acc[11]), "+v"(acc[12]), "+v"(acc[13]), "+v"(acc[14]), "+v"(acc[15]));
            }
            __builtin_amdgcn_sched_barrier(0);
        }
        if (hf == 1 && k < nt) {
            const int u = tok(k);
            float r8[8], r4[4], r2[2];
            if constexpr (UPH) {
                { const bool up = lane & 4;
#pragma unroll
                  for (int i = 0; i < 8; ++i) { const float send = up ? acc[i] : acc[i + 8], keep = up ? acc[i + 8] : acc[i]; r8[i] = keep + __shfl_xor(send, 4); } }
                { const bool up = lane & 2;
#pragma unroll
                  for (int i = 0; i < 4; ++i) { const float send = up ? r8[i] : r8[i + 4], keep = up ? r8[i + 4] : r8[i]; r4[i] = keep + __shfl_xor(send, 2); } }
                { const bool up = lane & 1;
#pragma unroll
                  for (int i = 0; i < 2; ++i) { const float send = up ? r4[i] : r4[i + 2], keep = up ? r4[i + 2] : r4[i]; r2[i] = keep + __shfl_xor(send, 1); } }
                const int st = ((lane & 4) ? 8 : 0) + ((lane & 2) ? 4 : 0) + ((lane & 1) ? 2 : 0);
                float* hp = HP + ((size_t)xv * MU + u) * 128 + grp;
                hp[8 * st] = r2[0]; hp[8 * (st + 1)] = r2[1];
            } else {
                { const bool up = lane & 32;
#pragma unroll
                  for (int c = 0; c < 8; ++c) { const float send = up ? acc[c] : acc[c + 8], keep = up ? acc[c + 8] : acc[c]; r8[c] = keep + __shfl_xor(send, 32); } }
                { const bool up = lane & 16;
#pragma unroll
                  for (int c = 0; c < 4; ++c) { const float send = up ? r8[c] : r8[c + 4], keep = up ? r8[c + 4] : r8[c]; r4[c] = keep + __shfl_xor(send, 16); } }
                { const bool up = lane & 8;
#pragma unroll
                  for (int c = 0; c < 2; ++c) { const float send = up ? r4[c] : r4[c + 2], keep = up ? r4[c + 2] : r4[c]; r2[c] = keep + __shfl_xor(send, 8); } }
                f32x2* o = (f32x2*)(A.out + (size_t)u * DM + ocol);
                f32x2 cur = ocur; cur.x += r2[0]; cur.y += r2[1]; *o = cur;
            }
        }
    };
    meta_load(0); meta_store(0); meta_load(1); meta_store(1); meta_load(2); meta_store(2);
    u32x4 b0[8], b1[8], b2[8];
    gather(b0, 0); gather(b1, 1); gather(b2, 2);
#pragma unroll 1
    for (int k0 = 0; k0 < nt; k0 += 3) {
        const int n0 = 2 * k0;
        meta_load(k0 + 3);
        compute(b0, n0);     gather(b0, n0 + 3);
        compute(b1, n0 + 1); meta_store(k0 + 3); gather(b1, n0 + 4);
        meta_load(k0 + 4);
        compute(b2, n0 + 2); gather(b2, n0 + 5);
        compute(b0, n0 + 3); meta_store(k0 + 4); gather(b0, n0 + 6);
        meta_load(k0 + 5);
        compute(b1, n0 + 4); gather(b1, n0 + 7);
        compute(b2, n0 + 5); meta_store(k0 + 5); gather(b2, n0 + 8);
    }
}


DI void expert_c_pass(const Frame& F, const Args& A) {
    unsigned char* ws = A.ws;
    const float* HP = (const float*)(ws + WS_HP); const float* GATE = (const float*)(ws + WS_GATE); float* CW = (float*)(ws + WS_CW);
    const size_t n4 = (size_t)MU * 128 / 4;
    for (size_t i = (size_t)blockIdx.x * 512 + F.tid; i < n4; i += (size_t)F.G * 512) {
        f32x4 h = *(const f32x4*)(HP + i * 4);
#pragma unroll
        for (int x = 1; x < 8; ++x) h += *(const f32x4*)(HP + (size_t)x * MU * 128 + i * 4);
        const f32x4 g = *(const f32x4*)(GATE + i * 4);
        f32x4 c;
        c.x = gelu_exact(h.x * (1.f / EU_SCALE)) * g.x * (1.f / EV_SCALE); c.y = gelu_exact(h.y * (1.f / EU_SCALE)) * g.y * (1.f / EV_SCALE);
        c.z = gelu_exact(h.z * (1.f / EU_SCALE)) * g.z * (1.f / EV_SCALE); c.w = gelu_exact(h.w * (1.f / EU_SCALE)) * g.w * (1.f / EV_SCALE);
        *(f32x4*)(CW + i * 4) = c;
    }
}
template <int PH> DI void run_phase(const Frame& F, const Args& args, PG8_LAS unsigned char* lds3) {
    unsigned char* ws = args.ws;
    if constexpr (PH == 0) { p0_prologue(F, args); }
    if constexpr (PH == 1) {
        pg8::Gemm g{(const bf16_t*)(ws + WS_HN), (const bf16_t*)(ws + WS_WIN), MP, NPROJ, 1024, 1024, 1024, 0};
        pg8::StaticOrder S; S.init(MP, NPROJ, F.G, (int)blockIdx.x);
        EpiProj E{(bf16_t*)(ws + WS_QKVR), (bf16_t*)(ws + WS_Z), (float*)(ws + WS_P32)};
        pg8::gemm_phase<EpiProj, pg8::StaticOrder, true, true>(lds3, g, S, E);
    }
    if constexpr (PH == 2) { gdn_prep_phase(F, args); }
    if constexpr (PH == 3) { gdn_scan(F, args); }
    if constexpr (PH == 4) {
        for (int t = F.gw; t < 2048 * 2; t += F.NGW) gdn_out_task(F, args, t);
        for (int p = F.gw; p < MP; p += F.NGW) mla_prep1_row(F, args, p);
    }
    if constexpr (PH == 5) {
        { pg8::Gemm g{(const bf16_t*)(ws + WS_CQN), (const bf16_t*)(ws + WS_WUQ), MP, 768, 256, 256, 256, 0};
          pg8::StaticOrder S; S.init(MP, 768, F.G, (int)blockIdx.x); EpiB16 E{(bf16_t*)(ws + WS_QH), 768};
          pg8::gemm_phase<EpiB16, pg8::StaticOrder, true, true>(lds3, g, S, E); }
        { pg8::Gemm g{(const bf16_t*)(ws + WS_CKVN), (const bf16_t*)(ws + WS_WUKV), MP, 1024, 256, 256, 256, 0};
          pg8::StaticOrder S; S.init(MP, 1024, F.G, (int)blockIdx.x); EpiB16 E{(bf16_t*)(ws + WS_KVB), 1024};
          pg8::gemm_phase<EpiB16, pg8::StaticOrder, true, true>(lds3, g, S, E); }
    }
    if constexpr (PH == 6) { for (int p = F.gw; p < KVROWS; p += F.NGW) mla_prep2_row(F, args, p); }
    if constexpr (PH == 7) {
        for (int rep = 0; rep < 2; ++rep) {
            for (int k0 = blockIdx.x; k0 < 256; k0 += F.G) {
                const int k = rep == 0 ? k0 : 511 - k0;
                attn_item(F, args, k & 7, 63 - (k >> 3));
            }
        }
    }
    if constexpr (PH == 8) {
        pg8::Gemm g{(const bf16_t*)(ws + WS_MIX), (const bf16_t*)(ws + WS_WOUT), MU, 1024, 1024, 1024, 1024, 0};
        pg8::StaticOrder S; S.init(MU, 1024, F.G, (int)blockIdx.x); EpiF32 E{args.out, 1024, args.in[0]};
        pg8::gemm_phase<EpiF32, pg8::StaticOrder, true, true>(lds3, g, S, E);
    }
    if constexpr (PH == 9) { for (int u = F.gw; u < MU; u += F.NGW) xn_row(F, args, u); }
    if constexpr (PH == 10) {
        pg8::Gemm g{(const bf16_t*)(ws + WS_XN), (const bf16_t*)(ws + WS_WPQ), MU, 2048, 1024, 1024, 1024, 0};
        pg8::StaticOrder S; S.init(MU, 2048, F.G, (int)blockIdx.x); EpiB16 E{(bf16_t*)(ws + WS_PQ), 2048};
        pg8::gemm_phase<EpiB16, pg8::StaticOrder, true, true>(lds3, g, S, E);
    }
    if constexpr (PH == 11) {
        pg8::Gemm g{(const bf16_t*)(ws + WS_PQ), (const bf16_t*)(ws + WS_SKB), MU, 2048, 256, 2048, 256, 256};
        pg8::StaticOrder S; S.init(MU, 2048, F.G, (int)blockIdx.x); EpiF32 E{(float*)(ws + WS_SC), 2048, nullptr};
        pg8::gemm_phase<EpiF32, pg8::StaticOrder, true, true>(lds3, g, S, E);
    }
    if constexpr (PH == 12) {
        convert_tables(F, args);
        for (int t = blockIdx.x * 512 + F.tid; t < MU * 8; t += F.G * 512) topk_task(F, args, t);
    }
    if constexpr (PH == 14) { expert_c_pass(F, args); }
    if constexpr (PH == 13 || PH == 15) {
        volatile LAS unsigned* MISC = (volatile LAS unsigned*)(lds3 + MISC_OFF);
        const unsigned x = MISC[16], rank = MISC[17];
        unsigned* bar = (unsigned*)(ws + WS_CTL);
        unsigned nloc = 0, nx = 0, myidx = 0;
#pragma unroll
        for (unsigned j = 0; j < 16; ++j) { const unsigned c = xb_ld(&bar[XB_XCNT(j)]); nx += (c > 0u) ? 1u : 0u; myidx += (c > 0u && j < x) ? 1u : 0u; nloc = (j == x) ? c : nloc; }
        const int wq = __builtin_amdgcn_readfirstlane((int)rank * 8 + F.wave), nw = __builtin_amdgcn_readfirstlane((int)nloc * 8);
        const int xstep = __builtin_amdgcn_readfirstlane((int)nx);
        for (int xv = __builtin_amdgcn_readfirstlane((int)myidx); xv < 8; xv += xstep)
            { if constexpr (PH == 13) expert_phase<true>(F, args, xv, wq, nw); else expert_phase<false>(F, args, xv, wq, nw); }
    }
}
constexpr int NPHASE = 16;
__global__ void __launch_bounds__(512, 2) fwd_kernel(Args args) {
    extern __shared__ __attribute__((aligned(16))) unsigned char lds[];
    Frame F;
    F.lds = lds; F.tid = threadIdx.x; F.lane = F.tid & 63; F.wave = __builtin_amdgcn_readfirstlane(F.tid >> 6);
    F.G = gridDim.x; F.gw = blockIdx.x * 8 + F.wave; F.NGW = F.G * 8;
    volatile LAS unsigned* MISC = (volatile LAS unsigned*)((LAS unsigned char*)lds + MISC_OFF);
    if (F.tid < 32) MISC[F.tid] = 0u;
    __syncthreads();
    unsigned char* ws = args.ws;
    const int lo = args.ph_lo, hi = args.ph_hi;
    XcdBarrier bar; bar.bar = (unsigned*)(ws + WS_CTL); bar.x = 0; bar.st = nullptr;
    if (hi - lo > 1) bar = xcd_barrier_post((unsigned*)(ws + WS_CTL), MISC + 8);
    if (F.tid == 0) { const unsigned x = xb_xcc_id(); MISC[16] = x; MISC[17] = xb_add((unsigned*)(ws + WS_CTL) + 3520 + 64 * x, 1u); }
    __syncthreads();
#define IN(k) (lo <= (k) && (k) < hi)
#define SEAM(k) do { if (IN(k) && IN((k) + 1)) xcd_barrier(bar); } while (0)
    PG8_LAS unsigned char* lds3 = (PG8_LAS unsigned char*)lds;

#ifndef PROBE_REPEAT
#define PROBE_REPEAT -1
#endif
#define PHASE(k) do { if (IN(k)) { run_phase<k>(F, args, lds3); if (PROBE_REPEAT == (k)) { xcd_barrier(bar); run_phase<k>(F, args, lds3); } } SEAM(k); } while (0)
    PHASE(0); PHASE(1); PHASE(2); PHASE(3); PHASE(4); PHASE(5); PHASE(6); PHASE(7); PHASE(8); PHASE(9); PHASE(10); PHASE(11); PHASE(12); PHASE(13); PHASE(14); PHASE(15);
#undef PHASE
#undef IN
#undef SEAM
}

#ifndef N_LAUNCHES
#define N_LAUNCHES 1
#endif
extern "C" void kernel_launch(void* const* d_in, const int* in_sizes, int n_in, void* d_out, int out_size, void* d_ws, size_t ws_size, hipStream_t stream) {
    static int grid = 0;
    if (grid == 0) {
        if (n_in != 20 || out_size != MU * DM || ws_size < WS_END) { fprintf(stderr, "kernel_launch: unexpected shapes (n_in %d out %d ws %zu)\n", n_in, out_size, ws_size); grid = -1; return; }
        int dev = 0, cus = 0, per_cu = 0;
        if (hipGetDevice(&dev) != hipSuccess || hipDeviceGetAttribute(&cus, hipDeviceAttributeMultiprocessorCount, dev) != hipSuccess) { grid = -1; return; }
        if (hipFuncSetAttribute((const void*)fwd_kernel, hipFuncAttributeMaxDynamicSharedMemorySize, LDS_BYTES) != hipSuccess) { fprintf(stderr, "kernel_launch: hipFuncSetAttribute failed\n"); grid = -1; return; }
        if (hipOccupancyMaxActiveBlocksPerMultiprocessor(&per_cu, (const void*)fwd_kernel, 512, LDS_BYTES) != hipSuccess || per_cu < 1) { fprintf(stderr, "kernel_launch: occupancy query says %d\n", per_cu); (void)hipGetLastError(); per_cu = 1; }
        grid = cus;
    }
    if (grid < 0) return;
    (void)hipMemsetAsync((char*)d_ws + WS_CTL, 0, CTL_ZERO_BYTES, stream);
    Args a{};
    for (int i = 0; i < 20; ++i) a.in[i] = (const float*)d_in[i];
    a.out = (float*)d_out; a.ws = (unsigned char*)d_ws;
    for (int li = 0; li < N_LAUNCHES; ++li) {
        a.ph_lo = li * NPHASE / N_LAUNCHES; a.ph_hi = (li + 1) * NPHASE / N_LAUNCHES;
        if (N_LAUNCHES == 1) {
            void* kargs[] = {&a};
            hipError_t e = hipLaunchCooperativeKernel((const void*)fwd_kernel, dim3(grid), dim3(512), kargs, LDS_BYTES, stream);
            if (e != hipSuccess) fprintf(stderr, "cooperative launch failed: %s (grid %d)\n", hipGetErrorString(e), grid);
        } else {
            hipLaunchKernelGGL(fwd_kernel, dim3(grid), dim3(512), LDS_BYTES, stream, a);
        }
    }
}
```

```cpp
#include <hip/hip_runtime.h>
#include <hip/hip_bf16.h>
#include <cstdio>
#include <cstdint>

#define DI __device__ __forceinline__
#define LAS __attribute__((address_space(3)))
#define GAS __attribute__((address_space(1)))

typedef unsigned short bf16_t;
typedef short bf16x8 __attribute__((ext_vector_type(8)));
typedef short s16x4 __attribute__((ext_vector_type(4)));
typedef float f32x4 __attribute__((ext_vector_type(4)));
typedef float f32x16 __attribute__((ext_vector_type(16)));
typedef unsigned u32x4 __attribute__((ext_vector_type(4)));
typedef unsigned u32x2 __attribute__((ext_vector_type(2)));

namespace pg8 {
#define PG8_LAS __attribute__((address_space(3)))
constexpr int BM = 256, BK = 64, HALF = 128, HTB = HALF * BK * 2  , STAGE_BYTES = 8 * HTB, NXCD = 8, WGM = 8;

__host__ __device__ __forceinline__ int lds_byte(int r, int c) { const int st = (r >> 4) * 2 + (c >> 5), rr = r & 15, cc = c & 31, ob = rr * 64 + cc * 2; return st * 1024 + (ob ^ (((ob >> 9) & 1) << 5)); }
__host__ __device__ __forceinline__ void stage_rc(int b, int& R, int& C) { const int st = b / 1024, sb = b % 1024, swz = sb ^ (((sb >> 9) & 1) << 5); R = (st >> 1) * 16 + swz / 64; C = (st & 1) * 32 + (swz % 64) / 2; }
__host__ __device__ __forceinline__ int perm32(int rho) { const int n = rho >> 4, i = rho & 15; return 8 * (i >> 2) + 4 * n + (i & 3); }

struct Unit { int pm, pn; };
struct Gemm { const bf16_t* A; const bf16_t* Bt; int M, N, K, lda, ldb, a_pn_off; };

struct StaticOrder {
    int nM, nN, nwg, G, c;
    __host__ __device__ void init(int M, int N, int G_, int c_) { nM = M / BM; nN = N / BM; nwg = nM * nN; G = G_; c = c_; }
    __host__ __device__ bool next(int i, Unit& u) const {
        const long L = (long)i * G + c; if (L >= nwg) return false;
        int wgid = (int)L; { const int q = nwg / NXCD, r = nwg % NXCD, xcd = wgid % NXCD, off = wgid / NXCD; wgid = (xcd < r ? xcd * (q + 1) : r * (q + 1) + (xcd - r) * q) + off; }
        const int nig = WGM * nN, gid = wgid / nig, fm = gid * WGM, gsz = (nM - fm) < WGM ? (nM - fm) : WGM;
        u.pm = fm + ((wgid % nig) % gsz); u.pn = (wgid % nig) / gsz; return true;
    }
    __device__ __forceinline__ void a_ready(const Unit&) const {}
    __device__ __forceinline__ void done(const Unit&) const {}
};

__device__ __forceinline__ unsigned cvt_pk_bf16(float lo, float hi) { unsigned r; asm volatile("v_cvt_pk_bf16_f32 %0, %1, %2" : "=v"(r) : "v"(lo), "v"(hi)); return r; }

template <class Epi, class Sched, bool ALIGN_EPI = false, bool SP2 = false>
__device__ __forceinline__ void gemm_phase(PG8_LAS unsigned char* lds, const Gemm g, const Sched& S, const Epi& E) {
    const int tid = threadIdx.x, wid = __builtin_amdgcn_readfirstlane(tid >> 6), lane = tid & 63, wr = wid >> 2, wc = wid & 3, fr = lane & 15, fq = lane >> 4;
    const int K = g.K, nt = K / BK;
    unsigned voffA[2], voffB[2];
#pragma unroll
    for (int i = 0; i < 2; ++i) { int R, C; stage_rc(tid * 16 + i * 8192, R, C); const int Rb = Epi::PERM ? ((R & ~31) + perm32(R & 31)) : R;
        voffA[i] = (unsigned)(R * g.lda + C) * 2u; voffB[i] = (unsigned)(Rb * g.ldb + C) * 2u; }
    const size_t kstep = (size_t)(BK * 2);
    const size_t hstepA = (size_t)HALF * g.lda * 2, hstepB = (size_t)HALF * g.ldb * 2;
    const size_t tstepA = 2 * hstepA, tstepB = 2 * hstepB;
    const size_t pnoffA = (size_t)g.a_pn_off * 2;
    const unsigned ldsw = (unsigned)wid * 1024u;
    const int aoff = lds_byte(wr * 64 + fr, fq * 8), boff = lds_byte(wc * 32 + fr, fq * 8);
#define PG8_SA(b, h) (((b) * 2 + (h)) * HTB)
#define PG8_SB(b, h) ((4 + (b) * 2 + (h)) * HTB)
#define PG8_STAGE(bufoff, gbase, voff) do { _Pragma("unroll") for (int _i = 0; _i < 2; ++_i) \
        __builtin_amdgcn_global_load_lds((const unsigned*)((const char*)(gbase) + (voff)[_i]), (PG8_LAS unsigned*)(lds + (bufoff) + ldsw + _i * 8192), 16, 0, 0); } while (0)
#define PG8_LDA(dst, b, h) do { _Pragma("unroll") for (int m = 0; m < 4; ++m) _Pragma("unroll") for (int k = 0; k < 2; ++k) dst[m][k] = *(const PG8_LAS bf16x8*)(lds + PG8_SA(b, h) + aoff + m * 2048 + k * 1024); } while (0)
#define PG8_LDB(dst, b, h) do { _Pragma("unroll") for (int n = 0; n < 2; ++n) _Pragma("unroll") for (int k = 0; k < 2; ++k) dst[n][k] = *(const PG8_LAS bf16x8*)(lds + PG8_SB(b, h) + boff + n * 2048 + k * 1024); } while (0)
#define PG8_MMA(ai, bj, At, Bt) do { __builtin_amdgcn_s_setprio(1); _Pragma("unroll") for (int m = 0; m < 4; ++m) _Pragma("unroll") for (int n = 0; n < 2; ++n) _Pragma("unroll") for (int k = 0; k < 2; ++k) \
        acc[ai][bj][m][n] = __builtin_amdgcn_mfma_f32_16x16x32_bf16(Bt[n][k], At[m][k], acc[ai][bj][m][n], 0, 0, 0); __builtin_amdgcn_s_setprio(0); } while (0)
#define PG8_WAIT_V(n) asm volatile("s_waitcnt vmcnt(" #n ")" ::: "memory")
#define PG8_WAIT_L(n) asm volatile("s_waitcnt lgkmcnt(" #n ")" ::: "memory")
#define PG8_BAR __builtin_amdgcn_s_barrier()
#define PG8_SCHED __builtin_amdgcn_sched_barrier(0)
    Unit cur, nxt; int ui = 0;
    if (!S.next(0, cur)) return;
    f32x4 acc[2][2][4][2];
#pragma unroll
    for (int a = 0; a < 2; ++a)
#pragma unroll
        for (int b = 0; b < 2; ++b)
#pragma unroll
            for (int m = 0; m < 4; ++m)
#pragma unroll
                for (int n = 0; n < 2; ++n) acc[a][b][m][n] = (f32x4){0.f, 0.f, 0.f, 0.f};
    bf16x8 At[4][2], B0[2][2], B1[2][2];
    const char* cA = (const char*)g.A + (size_t)cur.pm * tstepA + (size_t)cur.pn * pnoffA; const char* cB = (const char*)g.Bt + (size_t)cur.pn * tstepB;
    S.a_ready(cur);
    if constexpr (SP2) {
        PG8_STAGE(PG8_SB(0, 0), cB, voffB); PG8_STAGE(PG8_SB(0, 1), cB + hstepB, voffB); PG8_STAGE(PG8_SA(0, 0), cA, voffA); PG8_STAGE(PG8_SA(0, 1), cA + hstepA, voffA);
        if (wr == 1) PG8_BAR;
        PG8_WAIT_V(2); PG8_BAR;
        PG8_STAGE(PG8_SB(1, 0), cB + kstep, voffB); PG8_STAGE(PG8_SA(1, 0), cA + kstep, voffA); PG8_STAGE(PG8_SB(1, 1), cB + hstepB + kstep, voffB);
        PG8_WAIT_V(6); PG8_BAR;
    } else {
        PG8_STAGE(PG8_SB(0, 0), cB, voffB); PG8_STAGE(PG8_SA(0, 0), cA, voffA); PG8_STAGE(PG8_SB(0, 1), cB + hstepB, voffB); PG8_STAGE(PG8_SA(0, 1), cA + hstepA, voffA);
        if (wr == 1) PG8_BAR;
        PG8_WAIT_V(4); PG8_BAR;
        PG8_STAGE(PG8_SB(1, 0), cB + kstep, voffB); PG8_STAGE(PG8_SA(1, 0), cA + kstep, voffA); PG8_STAGE(PG8_SB(1, 1), cB + hstepB + kstep, voffB);
        PG8_WAIT_V(6); PG8_BAR;
    }
    for (;;) {
        const bool has_next = S.next(ui + 1, nxt);
        const char* nA = has_next ? (const char*)g.A + (size_t)nxt.pm * tstepA + (size_t)nxt.pn * pnoffA : cA; const char* nB = has_next ? (const char*)g.Bt + (size_t)nxt.pn * tstepB : cB;
        for (int t = 0; t < nt; t += 2) {
            const bool last = (t == nt - 2);
            const char* a1 = cA + (size_t)(t + 1) * kstep;
            const char* a2 = last ? nA : cA + (size_t)(t + 2) * kstep; const char* b2 = last ? nB : cB + (size_t)(t + 2) * kstep;
            const char* a3 = a2 + kstep; const char* b3 = b2 + kstep;
            if (last && has_next) S.a_ready(nxt);
            if constexpr (SP2) {
            PG8_LDB(B0, 0, 0); PG8_LDB(B1, 0, 1); PG8_SCHED; PG8_LDA(At, 0, 0); PG8_STAGE(PG8_SA(1, 1), a1 + hstepA, voffA);
            PG8_WAIT_V(8); PG8_WAIT_L(0); PG8_BAR; PG8_MMA(0, 0, At, B0); PG8_MMA(0, 1, At, B1); PG8_BAR; PG8_SCHED;
            PG8_LDA(At, 0, 1); PG8_STAGE(PG8_SB(0, 0), b2, voffB); PG8_STAGE(PG8_SB(0, 1), b2 + hstepB, voffB); PG8_STAGE(PG8_SA(0, 0), a2, voffA);
            PG8_WAIT_V(8); PG8_WAIT_L(0); PG8_BAR; PG8_MMA(1, 0, At, B0); PG8_MMA(1, 1, At, B1); PG8_BAR; PG8_SCHED;
            PG8_LDB(B0, 1, 0); PG8_LDB(B1, 1, 1); PG8_SCHED; PG8_LDA(At, 1, 0); PG8_STAGE(PG8_SA(0, 1), a2 + hstepA, voffA);
            PG8_WAIT_V(8); PG8_WAIT_L(0); PG8_BAR; PG8_MMA(0, 0, At, B0); PG8_MMA(0, 1, At, B1); PG8_BAR; PG8_SCHED;
            PG8_LDA(At, 1, 1); PG8_STAGE(PG8_SB(1, 0), b3, voffB); PG8_STAGE(PG8_SB(1, 1), b3 + hstepB, voffB); PG8_STAGE(PG8_SA(1, 0), a3, voffA);
            PG8_WAIT_V(8); PG8_WAIT_L(0); PG8_BAR; PG8_MMA(1, 0, At, B0); PG8_MMA(1, 1, At, B1); PG8_BAR; PG8_SCHED;
            } else {
            PG8_LDB(B0, 0, 0); PG8_SCHED; PG8_LDA(At, 0, 0); PG8_STAGE(PG8_SA(1, 1), a1 + hstepA, voffA);
            PG8_WAIT_L(8); PG8_BAR; PG8_WAIT_L(0); PG8_MMA(0, 0, At, B0); PG8_BAR; PG8_SCHED;
            PG8_LDB(B1, 0, 1); PG8_STAGE(PG8_SB(0, 0), b2, voffB);
            PG8_BAR; PG8_WAIT_L(0); PG8_MMA(0, 1, At, B1); PG8_BAR;
            PG8_LDA(At, 0, 1); PG8_STAGE(PG8_SA(0, 0), a2, voffA);
            PG8_BAR; PG8_WAIT_L(0); PG8_MMA(1, 0, At, B0); PG8_BAR; PG8_SCHED;
            PG8_STAGE(PG8_SB(0, 1), b2 + hstepB, voffB);
            PG8_WAIT_V(6); PG8_BAR; PG8_MMA(1, 1, At, B1); PG8_BAR;
            PG8_LDB(B0, 1, 0); PG8_SCHED; PG8_LDA(At, 1, 0); PG8_STAGE(PG8_SA(0, 1), a2 + hstepA, voffA);
            PG8_WAIT_L(8); PG8_BAR; PG8_WAIT_L(0); PG8_MMA(0, 0, At, B0); PG8_BAR; PG8_SCHED;
            PG8_LDB(B1, 1, 1); PG8_STAGE(PG8_SB(1, 0), b3, voffB);
            PG8_BAR; PG8_WAIT_L(0); PG8_MMA(0, 1, At, B1); PG8_BAR;
            PG8_LDA(At, 1, 1); PG8_STAGE(PG8_SA(1, 0), a3, voffA);
            PG8_BAR; PG8_WAIT_L(0); PG8_MMA(1, 0, At, B0); PG8_BAR; PG8_SCHED;
            PG8_STAGE(PG8_SB(1, 1), b3 + hstepB, voffB);
            PG8_WAIT_V(6); PG8_BAR; PG8_MMA(1, 1, At, B1); PG8_BAR;
            }
        }
        if constexpr (ALIGN_EPI) { if (wr == 0) PG8_BAR; }
        E(acc, cur, wr, wc, fr, fq); S.done(cur);
        if (!has_next) break;
#pragma unroll
        for (int a = 0; a < 2; ++a)
#pragma unroll
            for (int b = 0; b < 2; ++b)
#pragma unroll
                for (int m = 0; m < 4; ++m)
#pragma unroll
                    for (int n = 0; n < 2; ++n) acc[a][b][m][n] = (f32x4){0.f, 0.f, 0.f, 0.f};
        cur = nxt; cA = nA; cB = nB; ++ui;
        if constexpr (ALIGN_EPI) { if (wr == 1) PG8_BAR; }
    }
    PG8_WAIT_V(0);
    if constexpr (!ALIGN_EPI) { if (wr == 0) PG8_BAR; }
    PG8_BAR;
#undef PG8_SA
#undef PG8_SB
#undef PG8_STAGE
#undef PG8_LDA
#undef PG8_LDB
#undef PG8_MMA
#undef PG8_WAIT_V
#undef PG8_WAIT_L
#undef PG8_BAR
#undef PG8_SCHED
}
}

constexpr int DM = 1024;
constexpr int NTOK = 16400;
constexpr int PADL = 48;
constexpr int LPV = 16448;
constexpr int MP = 16640;
constexpr int MU = 16384;
constexpr int NCHUNK = 257;
constexpr int NHEAD = 8;
constexpr int NPROJ = 2560;
constexpr int KVROWS = 16512;
constexpr float EPS = 1e-6f;

constexpr size_t MiB = 1u << 20;
constexpr size_t WS_CTL = 0, CTL_ZERO_BYTES = 64 * 1024;
constexpr size_t WS_WIN = 1 * MiB;
constexpr size_t WS_WUQ = 6 * MiB;
constexpr size_t WS_WUKV = 6 * MiB + 512 * 1024;
constexpr size_t WS_WOUT = 7 * MiB;
constexpr size_t WS_WPQ = 9 * MiB;
constexpr size_t WS_SKB = 13 * MiB;
constexpr size_t WS_IDX = 16 * MiB;
constexpr size_t WS_GATE = 24 * MiB;
constexpr size_t WS_HN = 32 * MiB;
constexpr size_t WS_QKVR = 96 * MiB;
constexpr size_t WS_Z = 96 * MiB + 49 * MiB;
constexpr size_t WS_P32 = 162 * MiB;
constexpr size_t WS_GA = 195 * MiB;
constexpr size_t WS_GQ = 212 * MiB;
constexpr size_t WS_GS = 229 * MiB;
constexpr size_t WS_GB = 32 * MiB;
constexpr size_t WS_GO = 65 * MiB;
constexpr size_t WS_MIX = 96 * MiB;
constexpr size_t WS_CQN = 128 * MiB;
constexpr size_t WS_CKVN = 136 * MiB + 512 * 1024;
constexpr size_t WS_QH = 32 * MiB;
constexpr size_t WS_KVB = 57 * MiB;
constexpr size_t WS_Q = 195 * MiB;
constexpr size_t WS_K = 220 * MiB;
constexpr size_t WS_VT = 145 * MiB;
constexpr size_t WS_XN = 32 * MiB;
constexpr size_t WS_PQ = 64 * MiB;
constexpr size_t WS_SC = 128 * MiB;
constexpr size_t WS_EU = 96 * MiB;
constexpr size_t WS_EV = 112 * MiB;
constexpr size_t WS_CW = 64 * MiB;
constexpr size_t WS_HP = 128 * MiB;
constexpr size_t WS_END = 256 * MiB;

constexpr int LDS_BYTES = 147456;
constexpr int MISC_OFF = 131072 + 12288;

DI unsigned f2bf(float f) { unsigned u = __builtin_bit_cast(unsigned, f); return (u + 0x7fffu + ((u >> 16) & 1u)) >> 16; }
DI unsigned pk2(float lo, float hi) { return f2bf(lo) | (f2bf(hi) << 16); }
DI float bf2f(unsigned b) { return __builtin_bit_cast(float, b << 16); }
DI float bflo(unsigned w) { return __builtin_bit_cast(float, w << 16); }
DI float bfhi(unsigned w) { return __builtin_bit_cast(float, w & 0xffff0000u); }
DI float wave_sum(float v) {
#pragma unroll
    for (int o = 1; o < 64; o <<= 1) v += __shfl_xor(v, o);
    return v;
}
DI float sigmoidf_(float x) { return 1.f / (1.f + __expf(-x)); }
DI float siluf_(float x) { return x / (1.f + __expf(-x)); }

#define XB_TMO      128
#define XB_XCNT(j)  (256  + 64 * (j))
#define XB_XSUB(j)  (1280 + 64 * (j))
#define XB_XGEN(j)  (2304 + 64 * (j))
#define XB_TOP      3328
#define XB_TOPGEN   3392
#define XCD_BAR_WORDS 3456
#define XB_SPIN_CAP (1u << 22)
DI unsigned xb_ld(unsigned* p)              { return __hip_atomic_load(p, __ATOMIC_RELAXED, __HIP_MEMORY_SCOPE_AGENT); }
DI unsigned xb_add(unsigned* p, unsigned v) { return __hip_atomic_fetch_add(p, v, __ATOMIC_RELAXED, __HIP_MEMORY_SCOPE_AGENT); }
DI unsigned xb_xcc_id() { return (unsigned)__builtin_amdgcn_s_getreg((3 << 11) | 20) & 0xFu; }
#define XB_SPIN(cond, bar) do { unsigned _sp = 0; while (cond) { __builtin_amdgcn_s_sleep(1); \
    if ((++_sp & 255u) == 0u) { if (xb_ld(&(bar)[XB_TMO])) break; if (_sp > XB_SPIN_CAP) { atomicAdd(&(bar)[XB_TMO], 1u); break; } } } } while (0)
struct XcdBarrier { unsigned* bar; unsigned x; volatile LAS unsigned* st; };
DI XcdBarrier xcd_barrier_post(unsigned* bar, volatile LAS unsigned* st) {
    XcdBarrier b; b.bar = bar; b.x = xb_xcc_id(); b.st = st;
    if (threadIdx.x == 0) (void)xb_add(&bar[XB_XCNT(b.x)], 1u);
    return b;
}
DI void xcd_barrier_complete(unsigned* bar, unsigned x, unsigned& nloc, unsigned& nx) {
    const unsigned G = gridDim.x * gridDim.y * gridDim.z;
    unsigned sum, cnt, mine, sp = 0u;
    for (;;) {
        sum = 0u; cnt = 0u; mine = 0u;
#pragma unroll
        for (unsigned j = 0; j < 16; ++j) { const unsigned c = xb_ld(&bar[XB_XCNT(j)]); sum += c; cnt += (c > 0u) ? 1u : 0u; mine = (j == x) ? c : mine; }
        if (sum == G) break;
        __builtin_amdgcn_s_sleep(1);
        if ((++sp & 255u) == 0u) { if (xb_ld(&bar[XB_TMO])) break; if (sp > XB_SPIN_CAP) { atomicAdd(&bar[XB_TMO], 1u); break; } }
    }
    nloc = mine > 0u ? mine : 1u; nx = cnt > 0u ? cnt : 1u;
}
DI void xcd_barrier(const XcdBarrier& b) {
    asm volatile("s_waitcnt vmcnt(0)" ::: "memory");
    __syncthreads();
    if (threadIdx.x == 0) {
        unsigned* bar = b.bar;
        __builtin_amdgcn_s_waitcnt(0);
        unsigned nloc = b.st[0], nx = b.st[1];
        if (nloc == 0u) { xcd_barrier_complete(bar, b.x, nloc, nx); b.st[0] = nloc; b.st[1] = nx; }
        const unsigned old = xb_add(&bar[XB_XSUB(b.x)], 1u);
        const unsigned gen = old / nloc;
        if (old + 1u == (gen + 1u) * nloc) {
            __builtin_amdgcn_fence(__ATOMIC_RELEASE, "agent");
            asm volatile("s_waitcnt vmcnt(0)" ::: "memory");
            const unsigned og = xb_add(&bar[XB_TOP], 1u);
            const unsigned tg = og / nx;
            if (og + 1u == (tg + 1u) * nx) xb_add(&bar[XB_TOPGEN], 1u);
            else XB_SPIN(xb_ld(&bar[XB_TOPGEN]) == tg, bar);
            __builtin_amdgcn_fence(__ATOMIC_ACQUIRE, "agent");
            xb_add(&bar[XB_XGEN(b.x)], 1u);
            asm volatile("s_waitcnt vmcnt(0)" ::: "memory");
        } else {
            XB_SPIN(xb_ld(&bar[XB_XGEN(b.x)]) == gen, bar);
            __builtin_amdgcn_fence(__ATOMIC_ACQUIRE, "agent");
            asm volatile("s_waitcnt vmcnt(0)" ::: "memory");
        }
    }
    __syncthreads();
}

struct Args {
    const float* in[20];
    float* out; unsigned char* ws;
    int ph_lo, ph_hi;
};
struct Frame {
    unsigned char* lds;
    int tid, lane, wave, G, gw, NGW;
};

template <class Map>
DI void transpose_item(const float* __restrict__ W, int Nsrc, bf16_t* __restrict__ WT, int ldk, float* scr, int item, int nblk, int lane, Map srcmap) {
    const int kb = item / nblk, nb = item % nblk, k0 = 64 * kb, n0 = 32 * nb;
    const int ns = srcmap(n0 + (lane & 31));
#pragma unroll 8
    for (int i = 0; i < 32; ++i) { const int kk = 2 * i + (lane >> 5); scr[kk * 33 + (lane & 31)] = (ns >= 0) ? W[(size_t)(k0 + kk) * Nsrc + ns] : 0.f; }
    __builtin_amdgcn_s_waitcnt(0); __builtin_amdgcn_wave_barrier();
    const int c = lane & 7;
#pragma unroll
    for (int j = 0; j < 4; ++j) { const int n = (lane >> 3) + 8 * j; const float* s = scr + (8 * c) * 33 + n;
        u32x4 o; o.x = pk2(s[0 * 33], s[1 * 33]); o.y = pk2(s[2 * 33], s[3 * 33]); o.z = pk2(s[4 * 33], s[5 * 33]); o.w = pk2(s[6 * 33], s[7 * 33]);
        *(u32x4*)(WT + (size_t)(n0 + n) * ldk + k0 + 8 * c) = o; }
    __builtin_amdgcn_s_waitcnt(0); __builtin_amdgcn_wave_barrier();
}
struct MapId { DI int operator()(int n) const { return n; } };
struct MapWin {
    DI int operator()(int n) const {
        if (n < 2048) return n;
        if (n < 2304) return n + 16;
        if (n < 2432) return n + 16;
        if (n < 2464) return n + 16;
        if (n < 2472) return n - 416;
        if (n < 2480) return n - 416;
        return -1;
    }
};

DI void p0_prologue(const Frame& F, const Args& A) {
    unsigned char* ws = A.ws;
    float* scr = (float*)(F.lds + F.wave * 16384);
    const float* w_in = A.in[3]; const float* w_uq = A.in[10]; const float* w_ukv = A.in[11]; const float* w_out = A.in[14]; const float* w_pq = A.in[16]; const float* sub_keys = A.in[17];
    constexpr int I_IN = 16 * 80, I_UQ = 4 * 24, I_UKV = 2 * 32, I_OUT = 16 * 32, I_PQ = 16 * 64;
    constexpr int NITEMS = I_IN + I_UQ + I_UKV + I_OUT + I_PQ;
    for (int it = F.gw; it < NITEMS; it += F.NGW) {
        int r = it;
        if (r < I_IN) { transpose_item(w_in, 2480, (bf16_t*)(ws + WS_WIN), 1024, scr, r, 80, F.lane, MapWin()); continue; } r -= I_IN;
        if (r < I_UQ) { transpose_item(w_uq, 768, (bf16_t*)(ws + WS_WUQ), 256, scr, r, 24, F.lane, MapId()); continue; } r -= I_UQ;
        if (r < I_UKV) { transpose_item(w_ukv, 1024, (bf16_t*)(ws + WS_WUKV), 256, scr, r, 32, F.lane, MapId()); continue; } r -= I_UKV;
        if (r < I_OUT) { transpose_item(w_out, 1024, (bf16_t*)(ws + WS_WOUT), 1024, scr, r, 32, F.lane, MapId()); continue; } r -= I_OUT;
        transpose_item(w_pq, 2048, (bf16_t*)(ws + WS_WPQ), 1024, scr, r, 64, F.lane, MapId());
    }
    const int gt = blockIdx.x * 512 + F.tid, NGT = F.G * 512;
    for (int i = gt; i < 1024 * 16; i += NGT) { const int n = i >> 4, c = i & 15; *(u32x4*)((bf16_t*)(ws + WS_WUKV) + (size_t)n * 256 + 128 + c * 8) = (u32x4){0u, 0u, 0u, 0u}; }
    for (int i = gt; i < 2048 * 32; i += NGT) {
        const int n = i >> 5, c8 = (i & 31) * 8; const int p = (n >> 7) & 1;
        u32x4 o = (u32x4){0u, 0u, 0u, 0u};
        if ((c8 >> 7) == p) { const float* s = sub_keys + (size_t)n * 128 + (c8 & 127); const f32x4 a = *(const f32x4*)s, b = *(const f32x4*)(s + 4);
            o.x = pk2(a.x, a.y); o.y = pk2(a.z, a.w); o.z = pk2(b.x, b.y); o.w = pk2(b.z, b.w); }
        *(u32x4*)((bf16_t*)(ws + WS_SKB) + (size_t)n * 256 + c8) = o;
    }
    const float* x = A.in[0]; const float* meta = A.in[1]; const float* anorm = A.in[2];
    bf16_t* HN = (bf16_t*)(ws + WS_HN);
    for (int p = F.gw; p < MP; p += F.NGW) {
        unsigned long long* o8 = (unsigned long long*)(HN + (size_t)p * DM) + F.lane;
        const int t = p - PADL;
        if (t < 0 || t >= NTOK) {
#pragma unroll
            for (int j = 0; j < 4; ++j) o8[64 * j] = 0ull;
            continue;
        }
        const float* src = (t < 16) ? meta + (size_t)t * DM : x + (size_t)(t - 16) * DM;
        const f32x4* xr = (const f32x4*)src + F.lane;
        f32x4 v[4]; float s = 0.f;
#pragma unroll
        for (int j = 0; j < 4; ++j) { v[j] = xr[64 * j]; s += (v[j].x * v[j].x + v[j].y * v[j].y) + (v[j].z * v[j].z + v[j].w * v[j].w); }
        const float rstd = 1.f / sqrtf(wave_sum(s) * (1.f / DM) + EPS);
#pragma unroll
        for (int j = 0; j < 4; ++j) { const f32x4 w = ((const f32x4*)anorm)[64 * j + F.lane];
            o8[64 * j] = (unsigned long long)pk2(v[j].x * rstd * w.x, v[j].y * rstd * w.y) | ((unsigned long long)pk2(v[j].z * rstd * w.z, v[j].w * rstd * w.w) << 32); }
    }
}

struct EpiProj {
    static constexpr bool PERM = true;
    bf16_t* QKVR; bf16_t* Z; float* P32;
    DI void operator()(const f32x4 (&acc)[2][2][4][2], const pg8::Unit& u, int wr, int wc, int fr, int fq) const {
        const int row0 = u.pm * 256 + wr * 64 + fr;
        if (u.pn < 8) {
            bf16_t* base; int ld, colt;
            if (u.pn < 6) { base = QKVR; ld = 1536; colt = u.pn * 256; } else { base = Z; ld = 512; colt = (u.pn - 6) * 256; }
            const int col0 = colt + wc * 32 + 8 * fq;
#pragma unroll
            for (int ai = 0; ai < 2; ++ai)
#pragma unroll
                for (int m = 0; m < 4; ++m) { bf16_t* rowp = base + (size_t)(row0 + ai * 128 + m * 16) * ld + col0;
#pragma unroll
                    for (int bj = 0; bj < 2; ++bj) { const f32x4 v0 = acc[ai][bj][m][0], v1 = acc[ai][bj][m][1];
                        u32x4 w; w.x = pg8::cvt_pk_bf16(v0[0], v0[1]); w.y = pg8::cvt_pk_bf16(v0[2], v0[3]); w.z = pg8::cvt_pk_bf16(v1[0], v1[1]); w.w = pg8::cvt_pk_bf16(v1[2], v1[3]);
                        *(u32x4*)(rowp + bj * 128) = w; } }
        } else {
            const int col0 = (u.pn - 8) * 256 + wc * 32 + 8 * fq;
#pragma unroll
            for (int ai = 0; ai < 2; ++ai)
#pragma unroll
                for (int m = 0; m < 4; ++m) { float* rowp = P32 + (size_t)(row0 + ai * 128 + m * 16) * 512 + col0;
#pragma unroll
                    for (int bj = 0; bj < 2; ++bj) { *(f32x4*)(rowp + bj * 128) = acc[ai][bj][m][0]; *(f32x4*)(rowp + bj * 128 + 4) = acc[ai][bj][m][1]; } }
        }
    }
};
struct EpiB16 {
    static constexpr bool PERM = true;
    bf16_t* O; int ldc;
    DI void operator()(const f32x4 (&acc)[2][2][4][2], const pg8::Unit& u, int wr, int wc, int fr, int fq) const {
        const int row0 = u.pm * 256 + wr * 64 + fr, col0 = u.pn * 256 + wc * 32 + 8 * fq;
#pragma unroll
        for (int ai = 0; ai < 2; ++ai)
#pragma unroll
            for (int m = 0; m < 4; ++m) { bf16_t* rowp = O + (size_t)(row0 + ai * 128 + m * 16) * ldc + col0;
#pragma unroll
                for (int bj = 0; bj < 2; ++bj) { const f32x4 v0 = acc[ai][bj][m][0], v1 = acc[ai][bj][m][1];
                    u32x4 w; w.x = pg8::cvt_pk_bf16(v0[0], v0[1]); w.y = pg8::cvt_pk_bf16(v0[2], v0[3]); w.z = pg8::cvt_pk_bf16(v1[0], v1[1]); w.w = pg8::cvt_pk_bf16(v1[2], v1[3]);
                    *(u32x4*)(rowp + bj * 128) = w; } }
    }
};
struct EpiF32 {
    static constexpr bool PERM = true;
    float* C; int ldc; const float* res;
    DI void operator()(const f32x4 (&acc)[2][2][4][2], const pg8::Unit& u, int wr, int wc, int fr, int fq) const {
        const int row0 = u.pm * 256 + wr * 64 + fr, col0 = u.pn * 256 + wc * 32 + 8 * fq;
#pragma unroll
        for (int ai = 0; ai < 2; ++ai)
#pragma unroll
            for (int m = 0; m < 4; ++m) { const size_t off = (size_t)(row0 + ai * 128 + m * 16) * ldc + col0;
#pragma unroll
                for (int bj = 0; bj < 2; ++bj) { f32x4 v0 = acc[ai][bj][m][0], v1 = acc[ai][bj][m][1];
                    if (res) { v0 += *(const f32x4*)(res + off + bj * 128); v1 += *(const f32x4*)(res + off + bj * 128 + 4); }
                    *(f32x4*)(C + off + bj * 128) = v0; *(f32x4*)(C + off + bj * 128 + 4) = v1; } }
    }
};

DI f32x16 mfma32(bf16x8 a, bf16x8 b, f32x16 c) { return __builtin_amdgcn_mfma_f32_32x32x16_bf16(a, b, c, 0, 0, 0); }
DI f32x4 mfma16(bf16x8 a, bf16x8 b, f32x4 c) { return __builtin_amdgcn_mfma_f32_16x16x32_bf16(a, b, c, 0, 0, 0); }
DI int crow(int r, int hi) { return (r & 3) + 8 * (r >> 2) + 4 * hi; }
DI f32x16 zero16() { f32x16 z;
#pragma unroll
    for (int i = 0; i < 16; ++i) z[i] = 0.f; return z; }

constexpr int G_KF = 0, G_VF = 16384, G_MF = 32768;
constexpr int G_QB = 50176, G_KB = 59392, G_KBB = 68608;
constexpr int G_QKB = 77824, G_UT = 87040, G_WT = 96256, G_KDT = 105472;
constexpr int G_VEC = 114688;
constexpr int G_RAW = G_QKB;
constexpr int GST = 72;

DI f32x16 mm_quad(const unsigned char* A, const unsigned char* Bt, int qr, int qc, int lane) {
    const int r32 = lane & 31, hh = lane >> 5;
    const unsigned char* ap = A + (32 * qr + r32) * (GST * 2) + hh * 16;
    const unsigned char* bp = Bt + (32 * qc + r32) * (GST * 2) + hh * 16;
    f32x16 acc = zero16();
#pragma unroll
    for (int s = 0; s < 4; ++s) acc = mfma32(*(const bf16x8*)(ap + s * 32), *(const bf16x8*)(bp + s * 32), acc);
    return acc;
}

constexpr int G_RAW2 = 115712;
static_assert(G_RAW2 + 67 * 400 <= 143360, "GDN prep LDS map");
constexpr int G_CONVW = 143360 + 512;

DI void gdn_prep_phase(const Frame& F, const Args& A) {
    unsigned char* ws = A.ws; unsigned char* lds = F.lds;
    const int tid = F.tid, lane = F.lane, wave = F.wave;
    const bf16_t* QKVR = (const bf16_t*)(ws + WS_QKVR); const float* P32 = (const float*)(ws + WS_P32);
    float* KF = (float*)(lds + G_KF); float* VF = (float*)(lds + G_VF); float* MF = (float*)(lds + G_MF);
    float* VEC = (float*)(lds + G_VEC);
    const int NIT = NCHUNK * 8;
#define LBAR() do { asm volatile("s_waitcnt lgkmcnt(0)" ::: "memory"); __builtin_amdgcn_s_barrier(); asm volatile("" ::: "memory"); } while (0)
#define LAUNDER(dst, src) int dst = (src); asm volatile("" : "+v"(dst))
    int item = blockIdx.x;
    if (item >= NIT) return;
    u32x4 pr[4]; float nb = 0.f, na = 0.f;
    auto raw_fetch = [&](int it) {
        const int c = it >> 3, h = it & 7; LAUNDER(tl, tid);
#pragma unroll
        for (int i = 0; i < 4; ++i) { const int q = tl + 512 * i; pr[i] = (u32x4){0u, 0u, 0u, 0u};
            if (q < 67 * 24) { const int r = q / 24, cc = q % 24, seg = cc >> 3, c8 = cc & 7; const int p = 64 * c - 3 + r;
                if (p >= 0) pr[i] = *(const u32x4*)(QKVR + (size_t)p * 1536 + seg * 512 + h * 64 + c8 * 8); } }
        if (wave == 0) { const int p = 64 * c + lane; nb = P32[(size_t)p * 512 + 416 + h]; na = P32[(size_t)p * 512 + 424 + h]; }
    };
    auto raw_park = [&]() {
        LAUNDER(tl, tid);
#pragma unroll
        for (int i = 0; i < 4; ++i) { const int q = tl + 512 * i;
            if (q < 67 * 24) { const int r = q / 24, cc = q % 24, seg = cc >> 3, c8 = cc & 7; *(u32x4*)(lds + G_RAW2 + r * 400 + (seg * 64 + c8 * 8) * 2) = pr[i]; } }
    };
    raw_fetch(item); raw_park();
    float cb = nb, ca = na;
    float* CWL = (float*)(lds + G_CONVW);
    int cw_h = -1;
#pragma unroll 1
    for (; item < NIT; item += F.G) {
        const int c = item >> 3, h = item & 7;
        if (h != cw_h) { cw_h = h;
            if (tid < 192) { LAUNDER(t0, tid); const int sg = t0 >> 6, jt = (t0 >> 4) & 3, c4 = t0 & 15; *(f32x4*)(CWL + (sg * 4 + jt) * 64 + 4 * c4) = *(const f32x4*)(A.in[4] + jt * 1536 + sg * 512 + h * 64 + 4 * c4); } }
        const int nxt = item + F.G;
        if (nxt < NIT) raw_fetch(nxt);
        if (wave == 0) {
            const int p = 64 * c + lane;
            const float alog = A.in[5][h], dtb = A.in[6][h];
            float beta = sigmoidf_(cb);
            const float xx = ca + dtb; const float sp = xx > 20.f ? xx : log1pf(__expf(xx));
            float g = -__expf(alog) * sp;
            if (p < PADL) { beta = 0.f; g = 0.f; }
            float gc = g;
#pragma unroll
            for (int o = 1; o < 64; o <<= 1) { const float t = __shfl_up(gc, o); if (lane >= o) gc += t; }
            const float glast = __shfl(gc, 63);
            VEC[lane] = gc; VEC[64 + lane] = beta; VEC[128 + lane] = __expf(gc); VEC[192 + lane] = __expf(glast - gc);
        }
        LBAR();
        LAUNDER(t1, tid); const int sub = t1 & 15, grp = t1 >> 4;
#pragma unroll
        for (int sg = 0; sg < 3; ++sg) {
#pragma unroll 1
            for (int ps = 0; ps < 2; ++ps) {
                const int i = grp + 32 * ps;
                float acc[4] = {0.f, 0.f, 0.f, 0.f};
#pragma unroll
                for (int jt = 0; jt < 4; ++jt) {
                    const f32x4 w = *(const f32x4*)(CWL + (sg * 4 + jt) * 64 + 4 * sub);
                    const u32x2 rv = *(const u32x2*)(lds + G_RAW2 + (i + jt) * 400 + (sg * 64 + 4 * sub) * 2);
                    acc[0] += w.x * bflo(rv.x); acc[1] += w.y * bfhi(rv.x); acc[2] += w.z * bflo(rv.y); acc[3] += w.w * bfhi(rv.y);
                }
                float y[4];
#pragma unroll
                for (int k = 0; k < 4; ++k) y[k] = siluf_(acc[k]);
                if (sg < 2) {
                    float ss = (y[0] * y[0] + y[1] * y[1]) + (y[2] * y[2] + y[3] * y[3]);
                    ss += __shfl_xor(ss, 1); ss += __shfl_xor(ss, 2); ss += __shfl_xor(ss, 4); ss += __shfl_xor(ss, 8);
                    const float rn = 1.f / sqrtf(ss + EPS);
#pragma unroll
                    for (int k = 0; k < 4; ++k) y[k] *= rn;
                }
                if (sg == 0) {
                    u32x2 o; o.x = pk2(y[0] * 0.125f, y[1] * 0.125f); o.y = pk2(y[2] * 0.125f, y[3] * 0.125f);
                    *(u32x2*)(lds + G_QB + i * (GST * 2) + 8 * sub) = o;
                } else if (sg == 1) {
                    const float beta = VEC[64 + i], ekd = VEC[192 + i];
                    *(f32x4*)(KF + i * 64 + 4 * sub) = (f32x4){y[0], y[1], y[2], y[3]};
                    u32x2 o; o.x = pk2(y[0], y[1]); o.y = pk2(y[2], y[3]);
                    *(u32x2*)(lds + G_KB + i * (GST * 2) + 8 * sub) = o;
                    o.x = pk2(y[0] * beta, y[1] * beta); o.y = pk2(y[2] * beta, y[3] * beta);
                    *(u32x2*)(lds + G_KBB + i * (GST * 2) + 8 * sub) = o;
#pragma unroll
                    for (int k = 0; k < 4; ++k) *(bf16_t*)(lds + G_KDT + (4 * sub + k) * (GST * 2) + i * 2) = (bf16_t)f2bf(y[k] * ekd);
                } else {
                    *(f32x4*)(VF + i * 64 + 4 * sub) = (f32x4){y[0], y[1], y[2], y[3]};
                }
            }
        }
        LBAR();
        {
            LAUNDER(l3, lane);
            const int prod = wave >> 2, quad = wave & 3, qr = quad >> 1, qc = quad & 1, r32 = l3 & 31, hh = l3 >> 5;
            const f32x16 acc = mm_quad(lds + (prod ? G_QB : G_KBB), lds + G_KB, qr, qc, l3);
            const int j = 32 * qc + r32; const float gcj = VEC[j];
#pragma unroll
            for (int r = 0; r < 16; ++r) {
                const int i = 32 * qr + crow(r, hh);
                if (prod == 0) { MF[i * 68 + j] = (j < i) ? acc[r] * __expf(VEC[i] - gcj) : 0.f; }
                else { *(bf16_t*)(lds + G_QKB + i * (GST * 2) + j * 2) = (bf16_t)f2bf((j <= i) ? acc[r] * __expf(VEC[i] - gcj) : 0.f); }
            }
        }
        LBAR();
        if (tid < 128) {
            LAUNDER(col, tid); const bool isU = col < 64;
            const float* src = isU ? (VF + col) : (KF + (col - 64));
            float x[64];
#pragma unroll
            for (int i = 0; i < 64; ++i) {
                float rhs = src[i * 64] * VEC[64 + i]; if (!isU) rhs *= VEC[128 + i];
                float a0 = 0.f, a1 = 0.f, a2 = 0.f, a3 = 0.f;
#pragma unroll
                for (int j = 0; j + 3 < i; j += 4) { const f32x4 m = *(const f32x4*)(MF + i * 68 + j); a0 += m.x * x[j]; a1 += m.y * x[j + 1]; a2 += m.z * x[j + 2]; a3 += m.w * x[j + 3]; }
#pragma unroll
                for (int j = (i & ~3); j < i; ++j) a0 += MF[i * 68 + j] * x[j];
                x[i] = rhs - ((a0 + a1) + (a2 + a3));
                asm volatile("" : "+v"(x[i]) :: "memory");
            }
            unsigned char* dst = lds + (isU ? G_UT : G_WT) + (isU ? col : col - 64) * (GST * 2);
#pragma unroll
            for (int i = 0; i < 64; i += 8) {
                u32x4 o; o.x = pk2(x[i], x[i + 1]); o.y = pk2(x[i + 2], x[i + 3]); o.z = pk2(x[i + 4], x[i + 5]); o.w = pk2(x[i + 6], x[i + 7]);
                *(u32x4*)(dst + i * 2) = o;
            }
        }
        LBAR();
        {
            const float gl = VEC[128 + 63];
            float* GB = (float*)(ws + WS_GB) + (size_t)item * 4096;
            bf16_t* GQ = (bf16_t*)(ws + WS_GQ) + (size_t)item * 4096; bf16_t* GO = (bf16_t*)(ws + WS_GO) + (size_t)item * 4096;
            bf16_t* GAL = (bf16_t*)(lds + G_MF);
            LAUNDER(l5, lane); const int r32 = l5 & 31, hh = l5 >> 5;
#pragma unroll 1
            for (int it = 0; it < 2; ++it) {
                const int task = wave + 8 * it, prod = task >> 2, quad = task & 3, qr = quad >> 1, qc = quad & 1;
                const f32x16 acc = mm_quad(lds + (prod < 2 ? G_KDT : G_QKB), lds + ((prod & 1) ? G_UT : G_WT), qr, qc, l5);
                const int Cc = 32 * qc + r32;
                if (prod == 0) {
#pragma unroll
                    for (int r = 0; r < 16; ++r) {
                        const int R = 32 * qr + crow(r, hh);
                        const float val = ((R == Cc) ? gl : 0.f) - acc[r];
                        const int rb = R >> 4, m = R & 15, q4 = Cc >> 4, g = (Cc >> 2) & 3, rr = Cc & 3, ks = q4 >> 1, jj = 4 * (q4 & 1) + rr, ls = 16 * g + m;
                        GAL[((rb * 2 + ks) * 64 + ls) * 8 + jj] = (bf16_t)f2bf(val);
                    }
                } else if (prod == 1) {
                    const int eslab = Cc >> 4, n = Cc & 15;
#pragma unroll
                    for (int a = 0; a < 4; ++a) {
                        const int R0 = 32 * qr + 8 * a + 4 * hh; const int rb = R0 >> 4, g = (R0 >> 2) & 3, ls = 16 * g + n;
                        *(f32x4*)(GB + ((eslab * 4 + rb) * 64 + ls) * 4) = (f32x4){acc[4 * a], acc[4 * a + 1], acc[4 * a + 2], acc[4 * a + 3]};
                    }
                } else if (prod == 2) {
#pragma unroll
                    for (int r = 0; r < 16; ++r) {
                        const int R = 32 * qr + crow(r, hh);
                        const float qv = bf2f(*(const bf16_t*)(lds + G_QB + R * (GST * 2) + Cc * 2));
                        GQ[R * 64 + Cc] = (bf16_t)f2bf(qv * VEC[128 + R] - acc[r]);
                    }
                } else {
#pragma unroll
                    for (int r = 0; r < 16; ++r) GO[(quad * 16 + r) * 64 + l5] = (bf16_t)f2bf(acc[r]);
                }
            }
        }
        if (nxt < NIT) { raw_park(); cb = nb; ca = na; }
        LBAR();
        { LAUNDER(t6, tid); *(u32x4*)((bf16_t*)(ws + WS_GA) + (size_t)item * 4096 + t6 * 8) = *(const u32x4*)(lds + G_MF + t6 * 16); }
    }
}

constexpr int SC_D = 8, SC_PD = 6, SC_SLOT = 12288;
DI void gdn_scan(const Frame& F, const Args& A) {
    if (blockIdx.x >= 32) return;
    unsigned char* ws = A.ws;
    const int h = blockIdx.x & 7, eslab = blockIdx.x >> 3, lane = F.lane, wave = F.wave, n = lane & 15, g = lane >> 4;
    const unsigned char* GA = ws + WS_GA; const unsigned char* GB = ws + WS_GB; bf16_t* GS = (bf16_t*)(ws + WS_GS);
    LAS unsigned char* ring = (LAS unsigned char*)F.lds;
    const int np = (wave == 0) ? 0 : ((wave - 1 < 5) ? 2 : 1);
    auto issue = [&](int c) {
        const int cc = c < NCHUNK ? c : NCHUNK - 1;
        const size_t item = (size_t)cc * 8 + h;
        LAS unsigned char* slot = ring + (c % SC_D) * SC_SLOT;
#pragma unroll
        for (int i = 0; i < 2; ++i) if (i < np) {
            const int q = (wave - 1) + 7 * i;
            const unsigned char* src = (q < 8) ? GA + item * 8192 + q * 1024 : GB + item * 16384 + eslab * 4096 + (q - 8) * 1024;
            LAS unsigned char* dst = slot + ((q < 8) ? q * 1024 : 8192 + (q - 8) * 1024);
            __builtin_amdgcn_global_load_lds((const unsigned*)(src + lane * 16), (LAS unsigned*)dst, 16, 0, 0);
        }
    };
    for (int c = 0; c < SC_PD; ++c) issue(c);
    f32x4 S[4];
#pragma unroll
    for (int rb = 0; rb < 4; ++rb) S[rb] = (f32x4){0.f, 0.f, 0.f, 0.f};
#pragma unroll 1
    for (int c = 0; c < NCHUNK; ++c) {
        issue(c + SC_PD);
        if (np == 2) asm volatile("s_waitcnt vmcnt(12)" ::: "memory");
        else if (np == 1) asm volatile("s_waitcnt vmcnt(6)" ::: "memory");
        asm volatile("s_waitcnt lgkmcnt(0)" ::: "memory");
        __builtin_amdgcn_s_barrier();
        asm volatile("" ::: "memory");
        if (wave == 0) {
            const LAS unsigned char* slot = ring + (c % SC_D) * SC_SLOT;
            bf16x8 ac[8]; f32x4 bc[4];
#pragma unroll
            for (int q = 0; q < 8; ++q) ac[q] = *(const LAS bf16x8*)(slot + q * 1024 + lane * 16);
#pragma unroll
            for (int rb = 0; rb < 4; ++rb) bc[rb] = *(const LAS f32x4*)(slot + 8192 + rb * 1024 + lane * 16);
            const size_t item = (size_t)c * 8 + h;
            u32x4 p0, p1;
            p0.x = pk2(S[0][0], S[0][1]); p0.y = pk2(S[0][2], S[0][3]); p0.z = pk2(S[1][0], S[1][1]); p0.w = pk2(S[1][2], S[1][3]);
            p1.x = pk2(S[2][0], S[2][1]); p1.y = pk2(S[2][2], S[2][3]); p1.z = pk2(S[3][0], S[3][1]); p1.w = pk2(S[3][2], S[3][3]);
            {
                bf16_t* st = GS + item * 4096 + (16 * eslab + n) * 64 + 4 * g;
                *(u32x2*)(st + 0) = (u32x2){p0.x, p0.y}; *(u32x2*)(st + 16) = (u32x2){p0.z, p0.w};
                *(u32x2*)(st + 32) = (u32x2){p1.x, p1.y}; *(u32x2*)(st + 48) = (u32x2){p1.z, p1.w};
            }
            const bf16x8 b0 = __builtin_bit_cast(bf16x8, p0), b1 = __builtin_bit_cast(bf16x8, p1);
#pragma unroll
            for (int rb = 0; rb < 4; ++rb) {
                f32x4 acc = bc[rb];
                acc = mfma16(ac[rb * 2 + 0], b0, acc);
                acc = mfma16(ac[rb * 2 + 1], b1, acc);
                S[rb] = acc;
            }
        }
    }
    asm volatile("s_waitcnt vmcnt(0) lgkmcnt(0)" ::: "memory");
    __builtin_amdgcn_s_barrier();
}

DI void gdn_out_task(const Frame& F, const Args& A, int task) {
    unsigned char* ws = A.ws;
    const int ihalf = task & 1, item = (task >> 1) + 8, c = item >> 3, h = item & 7, lane = F.lane, r32 = lane & 31, hh = lane >> 5;
    const bf16_t* GQ = (const bf16_t*)(ws + WS_GQ) + (size_t)item * 4096; const bf16_t* GS = (const bf16_t*)(ws + WS_GS) + (size_t)item * 4096;
    const bf16_t* GO = (const bf16_t*)(ws + WS_GO) + (size_t)item * 4096;
    const bf16_t* Z = (const bf16_t*)(ws + WS_Z); bf16_t* MIX = (bf16_t*)(ws + WS_MIX);
    f32x16 acc[2];
#pragma unroll
    for (int eh = 0; eh < 2; ++eh)
#pragma unroll
        for (int r = 0; r < 16; ++r) acc[eh][r] = bf2f(GO[((ihalf * 2 + eh) * 16 + r) * 64 + lane]);
#pragma unroll
    for (int s = 0; s < 4; ++s) {
        const bf16x8 a = *(const bf16x8*)(GQ + (32 * ihalf + r32) * 64 + 16 * s + 8 * hh);
#pragma unroll
        for (int eh = 0; eh < 2; ++eh) {
            const bf16x8 b = *(const bf16x8*)(GS + (32 * eh + r32) * 64 + 16 * s + 8 * hh);
            acc[eh] = mfma32(a, b, acc[eh]);
        }
    }
    const float* gnorm = A.in[7];
    const float w0 = gnorm[r32], w1 = gnorm[32 + r32];
#pragma unroll
    for (int r = 0; r < 16; ++r) {
        float ss = acc[0][r] * acc[0][r] + acc[1][r] * acc[1][r];
        ss += __shfl_xor(ss, 1); ss += __shfl_xor(ss, 2); ss += __shfl_xor(ss, 4); ss += __shfl_xor(ss, 8); ss += __shfl_xor(ss, 16);
        const float rstd = 1.f / sqrtf(ss * (1.f / 64.f) + EPS);
        const int i = 32 * ihalf + crow(r, hh); const int p = 64 * c + i;
        const float z0 = bf2f(Z[(size_t)p * 512 + h * 64 + r32]), z1 = bf2f(Z[(size_t)p * 512 + h * 64 + 32 + r32]);
        bf16_t* o = MIX + (size_t)(p - 64) * 1024 + h * 64;
        o[r32] = (bf16_t)f2bf(acc[0][r] * rstd * w0 * siluf_(z0));
        o[32 + r32] = (bf16_t)f2bf(acc[1][r] * rstd * w1 * siluf_(z1));
    }
}

DI void mla_prep1_row(const Frame& F, const Args& A, int p) {
    unsigned char* ws = A.ws; const int lane = F.lane;
    const float* P32 = (const float*)(ws + WS_P32) + (size_t)p * 512;
    bf16_t* CQN = (bf16_t*)(ws + WS_CQN) + (size_t)p * 256; bf16_t* CKVN = (bf16_t*)(ws + WS_CKVN) + (size_t)p * 256;
    const f32x4 q = *(const f32x4*)(P32 + 4 * lane);
    const float sq = wave_sum((q.x * q.x + q.y * q.y) + (q.z * q.z + q.w * q.w));
    const float rq = 1.f / sqrtf(sq * (1.f / 256.f) + EPS);
    const f32x4 wq = *(const f32x4*)(A.in[8] + 4 * lane);
    *(u32x2*)(CQN + 4 * lane) = (u32x2){pk2(q.x * rq * wq.x, q.y * rq * wq.y), pk2(q.z * rq * wq.z, q.w * rq * wq.w)};
    const float k0 = P32[256 + 2 * lane], k1 = P32[256 + 2 * lane + 1];
    const float sk = wave_sum(k0 * k0 + k1 * k1);
    const float rk = 1.f / sqrtf(sk * (1.f / 128.f) + EPS);
    const float wk0 = A.in[9][2 * lane], wk1 = A.in[9][2 * lane + 1];
    *(unsigned*)(CKVN + 2 * lane) = pk2(k0 * rk * wk0, k1 * rk * wk1);
    *(unsigned*)(CKVN + 128 + 2 * lane) = 0u;
}

constexpr float QSCALE = 0.10206207261596577f * 1.4426950408889634f;
DI double rope_inv_rev(int i) {
    const double t8[8] = {0.15915494309189535, 0.08949940160889101, 0.050329212104487035, 0.0283021958306234, 0.015915494309189534, 0.008949940160889102, 0.005032921210448704, 0.00283021958306234};
    double v = t8[0];
#pragma unroll
    for (int k = 1; k < 8; ++k) v = ((i & 7) == k) ? t8[k] : v;
    return (i & 8) ? v * 0.01 : v;
}
DI void mla_prep2_row(const Frame& F, const Args& A, int p) {
    unsigned char* ws = A.ws; const int lane = F.lane, h = lane >> 3, s8 = lane & 7;
    bf16_t* Q = (bf16_t*)(ws + WS_Q) + ((size_t)h * KVROWS + p) * 96;
    bf16_t* K = (bf16_t*)(ws + WS_K) + ((size_t)h * KVROWS + p) * 96;
    bf16_t* VT = (bf16_t*)(ws + WS_VT) + (size_t)h * 64 * KVROWS + p;
    if (p < PADL || p >= LPV) {
#pragma unroll
        for (int m = 0; m < 12; ++m) { Q[s8 + 8 * m] = 0; K[s8 + 8 * m] = 0; }
#pragma unroll
        for (int m = 0; m < 8; ++m) VT[(size_t)(s8 + 8 * m) * KVROWS] = 0;
        return;
    }
    const bf16_t* QH = (const bf16_t*)(ws + WS_QH) + (size_t)p * 768 + h * 96;
    const bf16_t* KV = (const bf16_t*)(ws + WS_KVB) + (size_t)p * 1024 + h * 128;
    const float* kpe = (const float*)(ws + WS_P32) + (size_t)p * 512 + 384;
    const float* qn = A.in[12]; const float* kn = A.in[13];
    float q[12], k[12];
    float sq = 0.f, sk = 0.f;
#pragma unroll
    for (int m = 0; m < 12; ++m) { q[m] = bf2f(QH[s8 + 8 * m]); sq += q[m] * q[m]; }
#pragma unroll
    for (int m = 0; m < 8; ++m) k[m] = bf2f(KV[s8 + 8 * m]);
#pragma unroll
    for (int m = 8; m < 12; ++m) k[m] = kpe[s8 + 8 * (m - 8)];
#pragma unroll
    for (int m = 0; m < 12; ++m) sk += k[m] * k[m];
    sq += __shfl_xor(sq, 1); sq += __shfl_xor(sq, 2); sq += __shfl_xor(sq, 4);
    sk += __shfl_xor(sk, 1); sk += __shfl_xor(sk, 2); sk += __shfl_xor(sk, 4);
    const float rq = 1.f / sqrtf(sq * (1.f / 96.f) + EPS), rk = 1.f / sqrtf(sk * (1.f / 96.f) + EPS);
#pragma unroll
    for (int m = 0; m < 12; ++m) { q[m] *= rq * qn[s8 + 8 * m]; k[m] *= rk * kn[s8 + 8 * m]; }
    const double pos = (double)(p - PADL);
#pragma unroll
    for (int t = 0; t < 2; ++t) {
        const int i = s8 + 8 * t;
        const double rev = pos * rope_inv_rev(i);
        const float fr = (float)(rev - floor(rev));
        const float sn = __builtin_amdgcn_sinf(fr), cs = __builtin_amdgcn_cosf(fr);
        const float q1 = q[8 + t], q2 = q[10 + t]; q[8 + t] = q1 * cs - q2 * sn; q[10 + t] = q2 * cs + q1 * sn;
        const float k1 = k[8 + t], k2 = k[10 + t]; k[8 + t] = k1 * cs - k2 * sn; k[10 + t] = k2 * cs + k1 * sn;
    }
#pragma unroll
    for (int m = 0; m < 12; ++m) { Q[s8 + 8 * m] = (bf16_t)f2bf(q[m] * QSCALE); K[s8 + 8 * m] = (bf16_t)f2bf(k[m]); }
#pragma unroll
    for (int m = 0; m < 8; ++m) VT[(size_t)(s8 + 8 * m) * KVROWS] = KV[64 + s8 + 8 * m];
}

constexpr int A_KSTR = 208;
constexpr int A_VSTR = 136;
constexpr int A_KBYTES = 64 * A_KSTR;
constexpr int A_VBYTES = 64 * A_VSTR;
constexpr int A_BUF = A_KBYTES + A_VBYTES;
DI unsigned cvtpk_s(float lo, float hi) { typedef float f2 __attribute__((ext_vector_type(2))); typedef __bf16 b2 __attribute__((ext_vector_type(2))); f2 v = {lo, hi}; b2 b = __builtin_convertvector(v, b2); return __builtin_bit_cast(unsigned, b); }

DI void attn_item(const Frame& F, const Args& A, int h, int qb) {
    unsigned char* ws = A.ws; unsigned char* lds = F.lds;
    const int tid = F.tid, lane = F.lane, wave = F.wave, r32 = lane & 31, hh = lane >> 5;
    const bf16_t* Qg = (const bf16_t*)(ws + WS_Q) + (size_t)h * KVROWS * 96;
    const bf16_t* Kg = (const bf16_t*)(ws + WS_K) + (size_t)h * KVROWS * 96;
    const bf16_t* Vg = (const bf16_t*)(ws + WS_VT) + (size_t)h * 64 * KVROWS;
    const int p0w = 64 + 256 * qb + 32 * wave;
    const int qp = p0w + r32;
    const int ntile = 4 * qb + 5;
    const int mylast = 1 + 4 * qb + (wave >> 1);
    bf16x8 qf[6];
#pragma unroll
    for (int s = 0; s < 6; ++s) qf[s] = *(const bf16x8*)(Qg + (size_t)qp * 96 + 16 * s + 8 * hh);
    f32x16 ot[2]; ot[0] = zero16(); ot[1] = zero16();
    float mrun = -1e30f, lrun = 0.f;
    const int kr0 = tid / 12, kc0 = tid % 12, kr1 = (tid + 512) / 12, kc1 = (tid + 512) % 12; const bool k1ok = tid < 256;
    const int vr = tid >> 3, vc = tid & 7;
    u32x4 sk0, sk1, sv;
    auto gload = [&](int j) {
        const int kv0 = 64 * j;
        sk0 = *(const u32x4*)(Kg + (size_t)(kv0 + kr0) * 96 + kc0 * 8);
        if (k1ok) sk1 = *(const u32x4*)(Kg + (size_t)(kv0 + kr1) * 96 + kc1 * 8);
        sv = *(const u32x4*)(Vg + (size_t)vr * KVROWS + kv0 + vc * 8);
    };
    auto lstore = [&](int b) {
        unsigned char* kb = lds + b * A_BUF; unsigned char* vb = kb + A_KBYTES;
        *(u32x4*)(kb + kr0 * A_KSTR + kc0 * 16) = sk0;
        if (k1ok) *(u32x4*)(kb + kr1 * A_KSTR + kc1 * 16) = sk1;
        *(u32x2*)(vb + vr * A_VSTR + vc * 16) = (u32x2){sv.x, sv.y};
        *(u32x2*)(vb + vr * A_VSTR + vc * 16 + 8) = (u32x2){sv.z, sv.w};
    };
    gload(0); lstore(0);
    __syncthreads();
#pragma unroll 1
    for (int j = 0; j < ntile; ++j) {
        const int b = j & 1;
        if (j + 1 < ntile) gload(j + 1);
        if (j <= mylast) {
            const unsigned char* kb = lds + b * A_BUF; const unsigned char* vb = kb + A_KBYTES;
            f32x16 sc[2];
#pragma unroll
            for (int kh = 0; kh < 2; ++kh) {
                f32x16 acc = zero16();
                const unsigned char* kp = kb + (32 * kh + r32) * A_KSTR + hh * 16;
#pragma unroll
                for (int s = 0; s < 6; ++s) acc = mfma32(*(const bf16x8*)(kp + s * 32), qf[s], acc);
                sc[kh] = acc;
            }
            if (j == 0) {
#pragma unroll
                for (int kh = 0; kh < 2; ++kh)
#pragma unroll
                    for (int r = 0; r < 16; ++r) { const int kv = 32 * kh + crow(r, hh); if (kv < PADL) sc[kh][r] = -INFINITY; }
            }
            if (j == mylast) {
#pragma unroll
                for (int kh = 0; kh < 2; ++kh)
#pragma unroll
                    for (int r = 0; r < 16; ++r) { const int kv = 64 * j + 32 * kh + crow(r, hh); if (kv > qp) sc[kh][r] = -INFINITY; }
            }
            float mx = sc[0][0];
#pragma unroll
            for (int r = 1; r < 16; ++r) mx = fmaxf(mx, sc[0][r]);
#pragma unroll
            for (int r = 0; r < 16; ++r) mx = fmaxf(mx, sc[1][r]);
            mx = fmaxf(mx, __shfl_xor(mx, 32));
            const float mnew = fmaxf(mrun, mx);
            const float alpha = __builtin_amdgcn_exp2f(mrun - mnew);
            mrun = mnew;
            float ps = 0.f;
#pragma unroll
            for (int kh = 0; kh < 2; ++kh)
#pragma unroll
                for (int r = 0; r < 16; ++r) { const float e = __builtin_amdgcn_exp2f(sc[kh][r] - mnew); sc[kh][r] = e; ps += e; }
            lrun = lrun * alpha + ps;
#pragma unroll
            for (int eh = 0; eh < 2; ++eh)
#pragma unroll
                for (int r = 0; r < 16; ++r) ot[eh][r] *= alpha;
#pragma unroll
            for (int kh = 0; kh < 2; ++kh)
#pragma unroll
                for (int s2 = 0; s2 < 2; ++s2) {
                    u32x4 pw; pw.x = cvtpk_s(sc[kh][8 * s2 + 0], sc[kh][8 * s2 + 1]); pw.y = cvtpk_s(sc[kh][8 * s2 + 2], sc[kh][8 * s2 + 3]);
                    pw.z = cvtpk_s(sc[kh][8 * s2 + 4], sc[kh][8 * s2 + 5]); pw.w = cvtpk_s(sc[kh][8 * s2 + 6], sc[kh][8 * s2 + 7]);
                    const bf16x8 pf = __builtin_bit_cast(bf16x8, pw);
#pragma unroll
                    for (int eh = 0; eh < 2; ++eh) {
                        const unsigned char* vp = vb + (32 * eh + r32) * A_VSTR + (32 * kh + 16 * s2 + 4 * hh) * 2;
                        const u32x2 lo = *(const u32x2*)vp, hi2 = *(const u32x2*)(vp + 16);
                        const bf16x8 vf = __builtin_bit_cast(bf16x8, (u32x4){lo.x, lo.y, hi2.x, hi2.y});
                        ot[eh] = mfma32(vf, pf, ot[eh]);
                    }
                }
        }
        if (j + 1 < ntile) lstore(b ^ 1);
        __syncthreads();
    }
    const float ltot = lrun + __shfl_xor(lrun, 32);
    const float rl = 1.f / ltot;
    bf16_t* o = (bf16_t*)(ws + WS_MIX) + (size_t)(qp - 64) * 1024 + 512 + h * 64;
#pragma unroll
    for (int eh = 0; eh < 2; ++eh)
#pragma unroll
        for (int a = 0; a < 4; ++a) {
            const int e = 32 * eh + 8 * a + 4 * hh;
            *(u32x2*)(o + e) = (u32x2){pk2(ot[eh][4 * a] * rl, ot[eh][4 * a + 1] * rl), pk2(ot[eh][4 * a + 2] * rl, ot[eh][4 * a + 3] * rl)};
        }
}

DI void xn_row(const Frame& F, const Args& A, int u) {
    const f32x4* xr = (const f32x4*)(A.out + (size_t)u * DM) + F.lane;
    f32x4 v[4]; float s = 0.f;
#pragma unroll
    for (int j = 0; j < 4; ++j) { v[j] = xr[64 * j]; s += (v[j].x * v[j].x + v[j].y * v[j].y) + (v[j].z * v[j].z + v[j].w * v[j].w); }
    const float rstd = 1.f / sqrtf(wave_sum(s) * (1.f / DM) + EPS);
    unsigned long long* o8 = (unsigned long long*)((bf16_t*)(A.ws + WS_XN) + (size_t)u * DM) + F.lane;
#pragma unroll
    for (int j = 0; j < 4; ++j) { const f32x4 w = ((const f32x4*)A.in[15])[64 * j + F.lane];
        o8[64 * j] = (unsigned long long)pk2(v[j].x * rstd * w.x, v[j].y * rstd * w.y) | ((unsigned long long)pk2(v[j].z * rstd * w.z, v[j].w * rstd * w.w) << 32); }
}

DI unsigned fkey(float v, int idx) { unsigned u = __builtin_bit_cast(unsigned, v); u = (u & 0x80000000u) ? ~u : (u | 0x80000000u); return (u & ~127u) | (unsigned)(127 - idx); }
DI float keyval(unsigned k) { unsigned u = k & ~127u; u = (u & 0x80000000u) ? (u & 0x7fffffffu) : ~u; return __builtin_bit_cast(float, u); }

__device__ const unsigned char PAIR_A[50] = {0,0,0,0,0,0,0,0,0,0,0,0,0,0,0,0, 1,1,1,1,1,1,1,1, 2,2,2,2,2, 3,3,3,3, 4,4,4, 5,5, 6,6, 7,7, 8,9,10,11,12,13,14,15};
__device__ const unsigned char PAIR_B[50] = {0,1,2,3,4,5,6,7,8,9,10,11,12,13,14,15, 0,1,2,3,4,5,6,7, 0,1,2,3,4, 0,1,2,3, 0,1,2, 0,1, 0,1, 0,1, 0,0,0,0,0,0,0,0};

DI void ce_desc(unsigned& a, unsigned& b) { const unsigned mx = a > b ? a : b, mn = a > b ? b : a; a = mx; b = mn; }
template <int BASE, int NK> DI void bitonic_sort16_desc(unsigned (&x)[NK]) {
#pragma unroll
    for (int k = 2; k <= 16; k <<= 1)
#pragma unroll
        for (int j = k >> 1; j > 0; j >>= 1)
#pragma unroll
            for (int i = 0; i < 16; ++i) { const int l = i ^ j; if (l > i) { if ((i & k) == 0) ce_desc(x[BASE + i], x[BASE + l]); else ce_desc(x[BASE + l], x[BASE + i]); } }
}
template <int A0, int B0, int NK> DI void merge_top16(unsigned (&x)[NK]) {
#pragma unroll
    for (int i = 0; i < 16; ++i) { const unsigned p = x[A0 + i], q = x[B0 + 15 - i]; x[A0 + i] = p > q ? p : q; }
#pragma unroll
    for (int j = 8; j > 0; j >>= 1)
#pragma unroll
        for (int i = 0; i < 16; ++i) { const int l = i ^ j; if (l > i) ce_desc(x[A0 + i], x[A0 + l]); }
}
template <int NK> DI void top16_of_128(unsigned (&key)[NK]) {
    bitonic_sort16_desc<0, NK>(key); bitonic_sort16_desc<16, NK>(key); bitonic_sort16_desc<32, NK>(key); bitonic_sort16_desc<48, NK>(key);
    bitonic_sort16_desc<64, NK>(key); bitonic_sort16_desc<80, NK>(key); bitonic_sort16_desc<96, NK>(key); bitonic_sort16_desc<112, NK>(key);
    merge_top16<0, 16, NK>(key); merge_top16<32, 48, NK>(key); merge_top16<64, 80, NK>(key); merge_top16<96, 112, NK>(key);
    merge_top16<0, 32, NK>(key); merge_top16<64, 96, NK>(key);
    merge_top16<0, 64, NK>(key);
}

DI void topk_task(const Frame& F, const Args& A, int task) {
    unsigned char* ws = A.ws; const int tid = F.tid;
    const int u = task >> 3, h = task & 7;
    LAS unsigned* sk = (LAS unsigned*)(LAS unsigned char*)F.lds;
    LAS unsigned* pkk = sk + 16384;
    const float* SC = (const float*)(ws + WS_SC) + (size_t)u * 2048 + h * 256;
#pragma unroll 1
    for (int half = 0; half < 2; ++half) {
        unsigned key[128];
#pragma unroll
        for (int i = 0; i < 32; ++i) { const f32x4 v = *(const f32x4*)(SC + half * 128 + 4 * i);
            key[4 * i] = fkey(v.x, 4 * i); key[4 * i + 1] = fkey(v.y, 4 * i + 1); key[4 * i + 2] = fkey(v.z, 4 * i + 2); key[4 * i + 3] = fkey(v.w, 4 * i + 3); }
        top16_of_128(key);
#pragma unroll
        for (int r = 0; r < 16; ++r) sk[(half * 16 + r) * 512 + tid] = key[r];
    }
    float v1[16], v2[16];
#pragma unroll
    for (int r = 0; r < 16; ++r) { v1[r] = keyval(sk[r * 512 + tid]); v2[r] = keyval(sk[(16 + r) * 512 + tid]); }
    unsigned ck[64];
#pragma unroll
    for (int c = 50; c < 64; ++c) ck[c] = 0u;
#pragma unroll
    for (int a = 0; a < 16; ++a) {
        const int off = a == 0 ? 0 : a == 1 ? 16 : a == 2 ? 24 : a == 3 ? 29 : a == 4 ? 33 : a == 5 ? 36 : a == 6 ? 38 : a == 7 ? 40 : 42 + (a - 8);
#pragma unroll
        for (int b = 0; b < 16; ++b) if ((a + 1) * (b + 1) <= 16) ck[off + b] = fkey(v1[a] + v2[b], off + b);
    }
    bitonic_sort16_desc<0, 64>(ck); bitonic_sort16_desc<16, 64>(ck); bitonic_sort16_desc<32, 64>(ck); bitonic_sort16_desc<48, 64>(ck);
    merge_top16<0, 16, 64>(ck); merge_top16<32, 48, 64>(ck); merge_top16<0, 32, 64>(ck);
#pragma unroll
    for (int r = 0; r < 16; ++r) pkk[r * 512 + tid] = ck[r];
    const float cmax = keyval(pkk[tid]);
    float ev[16]; float esum = 0.f; int ex[16];
#pragma unroll
    for (int r = 0; r < 16; ++r) {
        const unsigned k = pkk[r * 512 + tid]; const int c = 127 - (int)(k & 127u);
        ev[r] = __expf(keyval(k) - cmax); esum += ev[r];
        const int a = PAIR_A[c], b = PAIR_B[c];
        const int i1 = 127 - (int)(sk[a * 512 + tid] & 127u), i2 = 127 - (int)(sk[(16 + b) * 512 + tid] & 127u);
        ex[r] = i1 * 128 + i2;
    }
    const float rs = 1.f / esum;
    int* IDX = (int*)(ws + WS_IDX) + (size_t)u * 128 + h * 16; float* GATE = (float*)(ws + WS_GATE) + (size_t)u * 128 + h * 16;
#pragma unroll
    for (int r = 0; r < 16; r += 4) {
        *(int4*)(IDX + r) = make_int4(ex[r], ex[r + 1], ex[r + 2], ex[r + 3]);
        *(f32x4*)(GATE + r) = (f32x4){ev[r] * rs, ev[r + 1] * rs, ev[r + 2] * rs, ev[r + 3] * rs};
    }
}

constexpr float EU_SCALE = 64.f, EV_SCALE = 16.f;
DI unsigned pk4_fp8(float a, float b, float c, float d) { int w = 0; w = __builtin_amdgcn_cvt_pk_fp8_f32(a, b, w, false); w = __builtin_amdgcn_cvt_pk_fp8_f32(c, d, w, true); return (unsigned)w; }
DI void convert_tables(const Frame& F, const Args& A) {
    const size_t n16 = (size_t)16384 * 1024 / 16;
    const size_t gt = (size_t)blockIdx.x * 512 + F.tid, NGT = (size_t)F.G * 512;
#pragma unroll 1
    for (int t = 0; t < 2; ++t) {
        const float* src = A.in[18 + t]; unsigned char* dst = A.ws + (t ? WS_EV : WS_EU); const float sc = t ? EV_SCALE : EU_SCALE;
        for (size_t i = gt; i < n16; i += NGT) {
            const f32x4 a = *(const f32x4*)(src + i * 16) * sc, b = *(const f32x4*)(src + i * 16 + 4) * sc, c = *(const f32x4*)(src + i * 16 + 8) * sc, d = *(const f32x4*)(src + i * 16 + 12) * sc;
            const size_t e_ = i >> 6, c16_ = i & 63;
            *(u32x4*)(dst + (c16_ >> 3) * ((size_t)16384 * 128) + e_ * 128 + (c16_ & 7) * 16) = (u32x4){pk4_fp8(a.x, a.y, a.z, a.w), pk4_fp8(b.x, b.y, b.z, b.w), pk4_fp8(c.x, c.y, c.z, c.w), pk4_fp8(d.x, d.y, d.z, d.w)};
        }
    }
}

DI float gelu_exact(float x) { return 0.5f * x * (1.f + erff(x * 0.70710678118654752f)); }
typedef float f32x2 __attribute__((ext_vector_type(2)));
#define UNPK16(dst, W_) do { f32x2 _t; \
    _t = __builtin_amdgcn_cvt_pk_f32_fp8((int)(W_).x, false); dst[0] = _t.x; dst[1] = _t.y; _t = __builtin_amdgcn_cvt_pk_f32_fp8((int)(W_).x, true); dst[2] = _t.x; dst[3] = _t.y; \
    _t = __builtin_amdgcn_cvt_pk_f32_fp8((int)(W_).y, false); dst[4] = _t.x; dst[5] = _t.y; _t = __builtin_amdgcn_cvt_pk_f32_fp8((int)(W_).y, true); dst[6] = _t.x; dst[7] = _t.y; \
    _t = __builtin_amdgcn_cvt_pk_f32_fp8((int)(W_).z, false); dst[8] = _t.x; dst[9] = _t.y; _t = __builtin_amdgcn_cvt_pk_f32_fp8((int)(W_).z, true); dst[10] = _t.x; dst[11] = _t.y; \
    _t = __builtin_amdgcn_cvt_pk_f32_fp8((int)(W_).w, false); dst[12] = _t.x; dst[13] = _t.y; _t = __builtin_amdgcn_cvt_pk_f32_fp8((int)(W_).w, true); dst[14] = _t.x; dst[15] = _t.y; } while (0)

template <bool UPH>
DI void expert_phase(const Frame& F, const Args& A, int xv, int wq, int nw) {
    unsigned char* ws = A.ws; const int lane = F.lane, grp = lane >> 3, j = lane & 7;
    const unsigned char* TBL = ws + (UPH ? WS_EU : WS_EV) + (size_t)xv * ((size_t)16384 * 128) + 16 * j;
    const int* IDX = (const int*)(ws + WS_IDX); const float* CW = (const float*)(ws + WS_CW);
    const bf16_t* XN = (const bf16_t*)(ws + WS_XN) + 128 * xv + 16 * j;
    float* HP = (float*)(ws + WS_HP);
    LAS unsigned* ring = (LAS unsigned*)((LAS unsigned char*)F.lds + F.wave * 4096);
    const int nt = (MU - wq + nw - 1) / nw;
    if (nt <= 0) return;
    auto tok = [&](int k) { return __builtin_amdgcn_readfirstlane(wq + (k < nt ? k : nt - 1) * nw); };
    int mi0, mi1; u32x4 mx0, mx1; float mh0, mh1;
    auto meta_load = [&](int k) {
        const int u = tok(k);
        mi0 = IDX[(size_t)u * 128 + lane]; mi1 = IDX[(size_t)u * 128 + 64 + lane];
        if constexpr (UPH) { mx0 = *(const u32x4*)(XN + (size_t)u * DM); mx1 = *(const u32x4*)(XN + (size_t)u * DM + 8); }
        else { mh0 = CW[(size_t)u * 128 + lane]; mh1 = CW[(size_t)u * 128 + 64 + lane]; }
    };
    auto meta_store = [&](int k) {
        LAS unsigned* sl = ring + (k & 3) * 256;
        sl[lane] = (unsigned)mi0; sl[64 + lane] = (unsigned)mi1;
        if constexpr (UPH) { if (grp == 0) { *(LAS u32x4*)(sl + 128 + 8 * j) = mx0; *(LAS u32x4*)(sl + 128 + 8 * j + 4) = mx1; } }
        else { sl[128 + lane] = __builtin_bit_cast(unsigned, mh0); sl[192 + lane] = __builtin_bit_cast(unsigned, mh1); }
    };
    auto gather = [&](u32x4 (&buf)[8], int n) {
        const LAS unsigned* sl = ring + ((n >> 1) & 3) * 256 + 64 * (n & 1) + grp;
#pragma unroll
        for (int i = 0; i < 8; ++i) { const int e = (int)sl[8 * i]; buf[i] = *(const u32x4*)(TBL + (size_t)e * 128); }
    };
    const int ocol = 128 * xv + 16 * j + ((lane & 32) ? 8 : 0) + ((lane & 16) ? 4 : 0) + ((lane & 8) ? 2 : 0);
    f32x2 ocur = (f32x2){0.f, 0.f};
    float acc[16];
    float xn[16];
    auto compute = [&](u32x4 (&buf)[8], int n) {
        const int k = n >> 1, hf = n & 1;
        const LAS unsigned* sl = ring + (k & 3) * 256;
        if (hf == 0) {
            if constexpr (UPH) {
                const u32x4 x0 = *(const LAS u32x4*)(sl + 128 + 8 * j), x1 = *(const LAS u32x4*)(sl + 128 + 8 * j + 4);
                xn[0] = bflo(x0.x); xn[1] = bfhi(x0.x); xn[2] = bflo(x0.y); xn[3] = bfhi(x0.y); xn[4] = bflo(x0.z); xn[5] = bfhi(x0.z); xn[6] = bflo(x0.w); xn[7] = bfhi(x0.w);
                xn[8] = bflo(x1.x); xn[9] = bfhi(x1.x); xn[10] = bflo(x1.y); xn[11] = bfhi(x1.y); xn[12] = bflo(x1.z); xn[13] = bfhi(x1.z); xn[14] = bflo(x1.w); xn[15] = bfhi(x1.w);
            } else {
#pragma unroll
                for (int c = 0; c < 16; ++c) acc[c] = 0.f;
                ocur = *(const f32x2*)(A.out + (size_t)tok(k) * DM + ocol);
            }
        }
#pragma unroll
        for (int i = 0; i < 8; ++i) {
            float f[16]; UNPK16(f, buf[i]);
            if constexpr (UPH) {
                float a0 = 0.f, a1 = 0.f;
#pragma unroll
                for (int c = 0; c < 16; c += 2) { a0 += f[c] * xn[c]; a1 += f[c + 1] * xn[c + 1]; }
                if (hf == 0) acc[i] = a0 + a1; else acc[8 + i] = a0 + a1;
                if (i < 7) { if (hf == 0) asm volatile("" : "+v"(buf[i + 1].x), "+v"(buf[i + 1].y), "+v"(buf[i + 1].z), "+v"(buf[i + 1].w), "+v"(acc[i]));
                             else asm volatile("" : "+v"(buf[i + 1].x), "+v"(buf[i + 1].y), "+v"(buf[i + 1].z), "+v"(buf[i + 1].w), "+v"(acc[8 + i])); }
            } else {
                const float cw = __builtin_bit_cast(float, sl[128 + 64 * hf + 8 * i + grp]);
#pragma unroll
                for (int c = 0; c < 16; ++c) acc[c] += cw * f[c];
                if (i < 7) asm volatile("" : "+v"(buf[i + 1].x), "+v"(buf[i + 1].y), "+v"(buf[i + 1].z), "+v"(buf[i + 1].w),
                                             "+v"(acc[0]), "+v"(acc[1]), "+v"(acc[2]), "+v"(acc[3]), "+v"(acc[4]), "+v"(acc[5]), "+v"(acc[6]), "+v"(acc[7]),
                                             "+v"(acc[8]), "+v"(acc[9]), "+v"(acc[10]), "+v"(acc[11]), "+v"(acc[12]), "+v"(acc[13]), "+v"(acc[14]), "+v"(acc[15]));
            }
            __builtin_amdgcn_sched_barrier(0);
        }
        if (hf == 1 && k < nt) {
            const int u = tok(k);
            float r8[8], r4[4], r2[2];
            if constexpr (UPH) {
                { const bool up = lane & 4;
#pragma unroll
                  for (int i = 0; i < 8; ++i) { const float send = up ? acc[i] : acc[i + 8], keep = up ? acc[i + 8] : acc[i]; r8[i] = keep + __shfl_xor(send, 4); } }
                { const bool up = lane & 2;
#pragma unroll
                  for (int i = 0; i < 4; ++i) { const float send = up ? r8[i] : r8[i + 4], keep = up ? r8[i + 4] : r8[i]; r4[i] = keep + __shfl_xor(send, 2); } }
                { const bool up = lane & 1;
#pragma unroll
                  for (int i = 0; i < 2; ++i) { const float send = up ? r4[i] : r4[i + 2], keep = up ? r4[i + 2] : r4[i]; r2[i] = keep + __shfl_xor(send, 1); } }
                const int st = ((lane & 4) ? 8 : 0) + ((lane & 2) ? 4 : 0) + ((lane & 1) ? 2 : 0);
                float* hp = HP + ((size_t)xv * MU + u) * 128 + grp;
                hp[8 * st] = r2[0]; hp[8 * (st + 1)] = r2[1];
            } else {
                { const bool up = lane & 32;
#pragma unroll
                  for (int c = 0; c < 8; ++c) { const float send = up ? acc[c] : acc[c + 8], keep = up ? acc[c + 8] : acc[c]; r8[c] = keep + __shfl_xor(send, 32); } }
                { const bool up = lane & 16;
#pragma unroll
                  for (int c = 0; c < 4; ++c) { const float send = up ? r8[c] : r8[c + 4], keep = up ? r8[c + 4] : r8[c]; r4[c] = keep + __shfl_xor(send, 16); } }
                { const bool up = lane & 8;
#pragma unroll
                  for (int c = 0; c < 2; ++c) { const float send = up ? r4[c] : r4[c + 2], keep = up ? r4[c + 2] : r4[c]; r2[c] = keep + __shfl_xor(send, 8); } }
                f32x2* o = (f32x2*)(A.out + (size_t)u * DM + ocol);
                f32x2 cur = ocur; cur.x += r2[0]; cur.y += r2[1]; *o = cur;
            }
        }
    };
    meta_load(0); meta_store(0); meta_load(1); meta_store(1); meta_load(2); meta_store(2);
    u32x4 b0[8], b1[8], b2[8];
    gather(b0, 0); gather(b1, 1); gather(b2, 2);
#pragma unroll 1
    for (int k0 = 0; k0 < nt; k0 += 3) {
        const int n0 = 2 * k0;
        meta_load(k0 + 3);
        compute(b0, n0);     gather(b0, n0 + 3);
        compute(b1, n0 + 1); meta_store(k0 + 3); gather(b1, n0 + 4);
        meta_load(k0 + 4);
        compute(b2, n0 + 2); gather(b2, n0 + 5);
        compute(b0, n0 + 3); meta_store(k0 + 4); gather(b0, n0 + 6);
        meta_load(k0 + 5);
        compute(b1, n0 + 4); gather(b1, n0 + 7);
        compute(b2, n0 + 5); meta_store(k0 + 5); gather(b2, n0 + 8);
    }
}


DI void expert_c_pass(const Frame& F, const Args& A) {
    unsigned char* ws = A.ws;
    const float* HP = (const float*)(ws + WS_HP); const float* GATE = (const float*)(ws + WS_GATE); float* CW = (float*)(ws + WS_CW);
    const size_t n4 = (size_t)MU * 128 / 4;
    for (size_t i = (size_t)blockIdx.x * 512 + F.tid; i < n4; i += (size_t)F.G * 512) {
        f32x4 h = *(const f32x4*)(HP + i * 4);
#pragma unroll
        for (int x = 1; x < 8; ++x) h += *(const f32x4*)(HP + (size_t)x * MU * 128 + i * 4);
        const f32x4 g = *(const f32x4*)(GATE + i * 4);
        f32x4 c;
        c.x = gelu_exact(h.x * (1.f / EU_SCALE)) * g.x * (1.f / EV_SCALE); c.y = gelu_exact(h.y * (1.f / EU_SCALE)) * g.y * (1.f / EV_SCALE);
        c.z = gelu_exact(h.z * (1.f / EU_SCALE)) * g.z * (1.f / EV_SCALE); c.w = gelu_exact(h.w * (1.f / EU_SCALE)) * g.w * (1.f / EV_SCALE);
        *(f32x4*)(CW + i * 4) = c;
    }
}
template <int PH> DI void run_phase(const Frame& F, const Args& args, PG8_LAS unsigned char* lds3) {
    unsigned char* ws = args.ws;
    if constexpr (PH == 0) { p0_prologue(F, args); }
    if constexpr (PH == 1) {
        pg8::Gemm g{(const bf16_t*)(ws + WS_HN), (const bf16_t*)(ws + WS_WIN), MP, NPROJ, 1024, 1024, 1024, 0};
        pg8::StaticOrder S; S.init(MP, NPROJ, F.G, (int)blockIdx.x);
        EpiProj E{(bf16_t*)(ws + WS_QKVR), (bf16_t*)(ws + WS_Z), (float*)(ws + WS_P32)};
        pg8::gemm_phase<EpiProj, pg8::StaticOrder, true, true>(lds3, g, S, E);
    }
    if constexpr (PH == 2) { gdn_prep_phase(F, args); }
    if constexpr (PH == 3) { gdn_scan(F, args); }
    if constexpr (PH == 4) {
        for (int t = F.gw; t < 2048 * 2; t += F.NGW) gdn_out_task(F, args, t);
        for (int p = F.gw; p < MP; p += F.NGW) mla_prep1_row(F, args, p);
    }
    if constexpr (PH == 5) {
        { pg8::Gemm g{(const bf16_t*)(ws + WS_CQN), (const bf16_t*)(ws + WS_WUQ), MP, 768, 256, 256, 256, 0};
          pg8::StaticOrder S; S.init(MP, 768, F.G, (int)blockIdx.x); EpiB16 E{(bf16_t*)(ws + WS_QH), 768};
          pg8::gemm_phase<EpiB16, pg8::StaticOrder, true, true>(lds3, g, S, E); }
        { pg8::Gemm g{(const bf16_t*)(ws + WS_CKVN), (const bf16_t*)(ws + WS_WUKV), MP, 1024, 256, 256, 256, 0};
          pg8::StaticOrder S; S.init(MP, 1024, F.G, (int)blockIdx.x); EpiB16 E{(bf16_t*)(ws + WS_KVB), 1024};
          pg8::gemm_phase<EpiB16, pg8::StaticOrder, true, true>(lds3, g, S, E); }
    }
    if constexpr (PH == 6) { for (int p = F.gw; p < KVROWS; p += F.NGW) mla_prep2_row(F, args, p); }
    if constexpr (PH == 7) {
        for (int rep = 0; rep < 2; ++rep) {
            for (int k0 = blockIdx.x; k0 < 256; k0 += F.G) {
                const int k = rep == 0 ? k0 : 511 - k0;
                attn_item(F, args, k & 7, 63 - (k >> 3));
            }
        }
    }
    if constexpr (PH == 8) {
        pg8::Gemm g{(const bf16_t*)(ws + WS_MIX), (const bf16_t*)(ws + WS_WOUT), MU, 1024, 1024, 1024, 1024, 0};
        pg8::StaticOrder S; S.init(MU, 1024, F.G, (int)blockIdx.x); EpiF32 E{args.out, 1024, args.in[0]};
        pg8::gemm_phase<EpiF32, pg8::StaticOrder, true, true>(lds3, g, S, E);
    }
    if constexpr (PH == 9) { for (int u = F.gw; u < MU; u += F.NGW) xn_row(F, args, u); }
    if constexpr (PH == 10) {
        pg8::Gemm g{(const bf16_t*)(ws + WS_XN), (const bf16_t*)(ws + WS_WPQ), MU, 2048, 1024, 1024, 1024, 0};
        pg8::StaticOrder S; S.init(MU, 2048, F.G, (int)blockIdx.x); EpiB16 E{(bf16_t*)(ws + WS_PQ), 2048};
        pg8::gemm_phase<EpiB16, pg8::StaticOrder, true, true>(lds3, g, S, E);
    }
    if constexpr (PH == 11) {
        pg8::Gemm g{(const bf16_t*)(ws + WS_PQ), (const bf16_t*)(ws + WS_SKB), MU, 2048, 256, 2048, 256, 256};
        pg8::StaticOrder S; S.init(MU, 2048, F.G, (int)blockIdx.x); EpiF32 E{(float*)(ws + WS_SC), 2048, nullptr};
        pg8::gemm_phase<EpiF32, pg8::StaticOrder, true, true>(lds3, g, S, E);
    }
    if constexpr (PH == 12) {
        convert_tables(F, args);
        for (int t = blockIdx.x * 512 + F.tid; t < MU * 8; t += F.G * 512) topk_task(F, args, t);
    }
    if constexpr (PH == 14) { expert_c_pass(F, args); }
    if constexpr (PH == 13 || PH == 15) {
        volatile LAS unsigned* MISC = (volatile LAS unsigned*)(lds3 + MISC_OFF);
        const unsigned x = MISC[16], rank = MISC[17];
        unsigned* bar = (unsigned*)(ws + WS_CTL);
        unsigned nloc = 0, nx = 0, myidx = 0;
#pragma unroll
        for (unsigned j = 0; j < 16; ++j) { const unsigned c = xb_ld(&bar[XB_XCNT(j)]); nx += (c > 0u) ? 1u : 0u; myidx += (c > 0u && j < x) ? 1u : 0u; nloc = (j == x) ? c : nloc; }
        const int wq = __builtin_amdgcn_readfirstlane((int)rank * 8 + F.wave), nw = __builtin_amdgcn_readfirstlane((int)nloc * 8);
        const int xstep = __builtin_amdgcn_readfirstlane((int)nx);
        for (int xv = __builtin_amdgcn_readfirstlane((int)myidx); xv < 8; xv += xstep)
            { if constexpr (PH == 13) expert_phase<true>(F, args, xv, wq, nw); else expert_phase<false>(F, args, xv, wq, nw); }
    }
}
constexpr int NPHASE = 16;
__global__ void __launch_bounds__(512, 2) fwd_kernel(Args args) {
    extern __shared__ __attribute__((aligned(16))) unsigned char lds[];
    Frame F;
    F.lds = lds; F.tid = threadIdx.x; F.lane = F.tid & 63; F.wave = __builtin_amdgcn_readfirstlane(F.tid >> 6);
    F.G = gridDim.x; F.gw = blockIdx.x * 8 + F.wave; F.NGW = F.G * 8;
    volatile LAS unsigned* MISC = (volatile LAS unsigned*)((LAS unsigned char*)lds + MISC_OFF);
    if (F.tid < 32) MISC[F.tid] = 0u;
    __syncthreads();
    unsigned char* ws = args.ws;
    const int lo = args.ph_lo, hi = args.ph_hi;
    XcdBarrier bar; bar.bar = (unsigned*)(ws + WS_CTL); bar.x = 0; bar.st = nullptr;
    if (hi - lo > 1) bar = xcd_barrier_post((unsigned*)(ws + WS_CTL), MISC + 8);
    if (F.tid == 0) { const unsigned x = xb_xcc_id(); MISC[16] = x; MISC[17] = xb_add((unsigned*)(ws + WS_CTL) + 3520 + 64 * x, 1u); }
    __syncthreads();
#define IN(k) (lo <= (k) && (k) < hi)
#define SEAM(k) do { if (IN(k) && IN((k) + 1)) xcd_barrier(bar); } while (0)
    PG8_LAS unsigned char* lds3 = (PG8_LAS unsigned char*)lds;

#ifndef PROBE_REPEAT
#define PROBE_REPEAT -1
#endif
#define PHASE(k) do { if (IN(k)) { run_phase<k>(F, args, lds3); if (PROBE_REPEAT == (k)) { xcd_barrier(bar); run_phase<k>(F, args, lds3); } } SEAM(k); } while (0)
    PHASE(0); PHASE(1); PHASE(2); PHASE(3); PHASE(4); PHASE(5); PHASE(6); PHASE(7); PHASE(8); PHASE(9); PHASE(10); PHASE(11); PHASE(12); PHASE(13); PHASE(14); PHASE(15);
#undef PHASE
#undef IN
#undef SEAM
}

#ifndef N_LAUNCHES
#define N_LAUNCHES 1
#endif
extern "C" void kernel_launch(void* const* d_in, const int* in_sizes, int n_in, void* d_out, int out_size, void* d_ws, size_t ws_size, hipStream_t stream) {
    static int grid = 0;
    if (grid == 0) {
        if (n_in != 20 || out_size != MU * DM || ws_size < WS_END) { fprintf(stderr, "kernel_launch: unexpected shapes (n_in %d out %d ws %zu)\n", n_in, out_size, ws_size); grid = -1; return; }
        int dev = 0, cus = 0, per_cu = 0;
        if (hipGetDevice(&dev) != hipSuccess || hipDeviceGetAttribute(&cus, hipDeviceAttributeMultiprocessorCount, dev) != hipSuccess) { grid = -1; return; }
        if (hipFuncSetAttribute((const void*)fwd_kernel, hipFuncAttributeMaxDynamicSharedMemorySize, LDS_BYTES) != hipSuccess) { fprintf(stderr, "kernel_launch: hipFuncSetAttribute failed\n"); grid = -1; return; }
        if (hipOccupancyMaxActiveBlocksPerMultiprocessor(&per_cu, (const void*)fwd_kernel, 512, LDS_BYTES) != hipSuccess || per_cu < 1) { fprintf(stderr, "kernel_launch: occupancy query says %d\n", per_cu); (void)hipGetLastError(); per_cu = 1; }
        grid = cus;
    }
    if (grid < 0) return;
    (void)hipMemsetAsync((char*)d_ws + WS_CTL, 0, CTL_ZERO_BYTES, stream);
    Args a{};
    for (int i = 0; i < 20; ++i) a.in[i] = (const float*)d_in[i];
    a.out = (float*)d_out; a.ws = (unsigned char*)d_ws;
    for (int li = 0; li < N_LAUNCHES; ++li) {
        a.ph_lo = li * NPHASE / N_LAUNCHES; a.ph_hi = (li + 1) * NPHASE / N_LAUNCHES;
        if (N_LAUNCHES == 1) {
            void* kargs[] = {&a};
            hipError_t e = hipLaunchCooperativeKernel((const void*)fwd_kernel, dim3(grid), dim3(512), kargs, LDS_BYTES, stream);
            if (e != hipSuccess) fprintf(stderr, "cooperative launch failed: %s (grid %d)\n", hipGetErrorString(e), grid);
        } else {
            hipLaunchKernelGGL(fwd_kernel, dim3(grid), dim3(512), LDS_BYTES, stream, a);
        }
    }
}
```

```cpp
#include <hip/hip_runtime.h>
#include <hip/hip_bf16.h>
#include <cstdio>
#include <cstdint>

#define DI __device__ __forceinline__
#define LAS __attribute__((address_space(3)))
#define GAS __attribute__((address_space(1)))

typedef unsigned short bf16_t;
typedef short bf16x8 __attribute__((ext_vector_type(8)));
typedef short s16x4 __attribute__((ext_vector_type(4)));
typedef float f32x4 __attribute__((ext_vector_type(4)));
typedef float f32x16 __attribute__((ext_vector_type(16)));
typedef unsigned u32x4 __attribute__((ext_vector_type(4)));
typedef unsigned u32x2 __attribute__((ext_vector_type(2)));

namespace pg8 {
#define PG8_LAS __attribute__((address_space(3)))
constexpr int BM = 256, BK = 64, HALF = 128, HTB = HALF * BK * 2  , STAGE_BYTES = 8 * HTB, NXCD = 8, WGM = 8;

__host__ __device__ __forceinline__ int lds_byte(int r, int c) { const int st = (r >> 4) * 2 + (c >> 5), rr = r & 15, cc = c & 31, ob = rr * 64 + cc * 2; return st * 1024 + (ob ^ (((ob >> 9) & 1) << 5)); }
__host__ __device__ __forceinline__ void stage_rc(int b, int& R, int& C) { const int st = b / 1024, sb = b % 1024, swz = sb ^ (((sb >> 9) & 1) << 5); R = (st >> 1) * 16 + swz / 64; C = (st & 1) * 32 + (swz % 64) / 2; }
__host__ __device__ __forceinline__ int perm32(int rho) { const int n = rho >> 4, i = rho & 15; return 8 * (i >> 2) + 4 * n + (i & 3); }

struct Unit { int pm, pn; };
struct Gemm { const bf16_t* A; const bf16_t* Bt; int M, N, K, lda, ldb, a_pn_off; };

struct StaticOrder {
    int nM, nN, nwg, G, c;
    __host__ __device__ void init(int M, int N, int G_, int c_) { nM = M / BM; nN = N / BM; nwg = nM * nN; G = G_; c = c_; }
    __host__ __device__ bool next(int i, Unit& u) const {
        const long L = (long)i * G + c; if (L >= nwg) return false;
        int wgid = (int)L; { const int q = nwg / NXCD, r = nwg % NXCD, xcd = wgid % NXCD, off = wgid / NXCD; wgid = (xcd < r ? xcd * (q + 1) : r * (q + 1) + (xcd - r) * q) + off; }
        const int nig = WGM * nN, gid = wgid / nig, fm = gid * WGM, gsz = (nM - fm) < WGM ? (nM - fm) : WGM;
        u.pm = fm + ((wgid % nig) % gsz); u.pn = (wgid % nig) / gsz; return true;
    }
    __device__ __forceinline__ void a_ready(const Unit&) const {}
    __device__ __forceinline__ void done(const Unit&) const {}
};

__device__ __forceinline__ unsigned cvt_pk_bf16(float lo, float hi) { unsigned r; asm volatile("v_cvt_pk_bf16_f32 %0, %1, %2" : "=v"(r) : "v"(lo), "v"(hi)); return r; }

template <class Epi, class Sched, bool ALIGN_EPI = false, bool SP2 = false>
__device__ __forceinline__ void gemm_phase(PG8_LAS unsigned char* lds, const Gemm g, const Sched& S, const Epi& E) {
    const int tid = threadIdx.x, wid = __builtin_amdgcn_readfirstlane(tid >> 6), lane = tid & 63, wr = wid >> 2, wc = wid & 3, fr = lane & 15, fq = lane >> 4;
    const int K = g.K, nt = K / BK;
    unsigned voffA[2], voffB[2];
#pragma unroll
    for (int i = 0; i < 2; ++i) { int R, C; stage_rc(tid * 16 + i * 8192, R, C); const int Rb = Epi::PERM ? ((R & ~31) + perm32(R & 31)) : R;
        voffA[i] = (unsigned)(R * g.lda + C) * 2u; voffB[i] = (unsigned)(Rb * g.ldb + C) * 2u; }
    const size_t kstep = (size_t)(BK * 2);
    const size_t hstepA = (size_t)HALF * g.lda * 2, hstepB = (size_t)HALF * g.ldb * 2;
    const size_t tstepA = 2 * hstepA, tstepB = 2 * hstepB;
    const size_t pnoffA = (size_t)g.a_pn_off * 2;
    const unsigned ldsw = (unsigned)wid * 1024u;
    const int aoff = lds_byte(wr * 64 + fr, fq * 8), boff = lds_byte(wc * 32 + fr, fq * 8);
#define PG8_SA(b, h) (((b) * 2 + (h)) * HTB)
#define PG8_SB(b, h) ((4 + (b) * 2 + (h)) * HTB)
#define PG8_STAGE(bufoff, gbase, voff) do { _Pragma("unroll") for (int _i = 0; _i < 2; ++_i) \
        __builtin_amdgcn_global_load_lds((const unsigned*)((const char*)(gbase) + (voff)[_i]), (PG8_LAS unsigned*)(lds + (bufoff) + ldsw + _i * 8192), 16, 0, 0); } while (0)
#define PG8_LDA(dst, b, h) do { _Pragma("unroll") for (int m = 0; m < 4; ++m) _Pragma("unroll") for (int k = 0; k < 2; ++k) dst[m][k] = *(const PG8_LAS bf16x8*)(lds + PG8_SA(b, h) + aoff + m * 2048 + k * 1024); } while (0)
#define PG8_LDB(dst, b, h) do { _Pragma("unroll") for (int n = 0; n < 2; ++n) _Pragma("unroll") for (int k = 0; k < 2; ++k) dst[n][k] = *(const PG8_LAS bf16x8*)(lds + PG8_SB(b, h) + boff + n * 2048 + k * 1024); } while (0)
#define PG8_MMA(ai, bj, At, Bt) do { __builtin_amdgcn_s_setprio(1); _Pragma("unroll") for (int m = 0; m < 4; ++m) _Pragma("unroll") for (int n = 0; n < 2; ++n) _Pragma("unroll") for (int k = 0; k < 2; ++k) \
        acc[ai][bj][m][n] = __builtin_amdgcn_mfma_f32_16x16x32_bf16(Bt[n][k], At[m][k], acc[ai][bj][m][n], 0, 0, 0); __builtin_amdgcn_s_setprio(0); } while (0)
#define PG8_WAIT_V(n) asm volatile("s_waitcnt vmcnt(" #n ")" ::: "memory")
#define PG8_WAIT_L(n) asm volatile("s_waitcnt lgkmcnt(" #n ")" ::: "memory")
#define PG8_BAR __builtin_amdgcn_s_barrier()
#define PG8_SCHED __builtin_amdgcn_sched_barrier(0)
    Unit cur, nxt; int ui = 0;
    if (!S.next(0, cur)) return;
    f32x4 acc[2][2][4][2];
#pragma unroll
    for (int a = 0; a < 2; ++a)
#pragma unroll
        for (int b = 0; b < 2; ++b)
#pragma unroll
            for (int m = 0; m < 4; ++m)
#pragma unroll
                for (int n = 0; n < 2; ++n) acc[a][b][m][n] = (f32x4){0.f, 0.f, 0.f, 0.f};
    bf16x8 At[4][2], B0[2][2], B1[2][2];
    const char* cA = (const char*)g.A + (size_t)cur.pm * tstepA + (size_t)cur.pn * pnoffA; const char* cB = (const char*)g.Bt + (size_t)cur.pn * tstepB;
    S.a_ready(cur);
    if constexpr (SP2) {
        PG8_STAGE(PG8_SB(0, 0), cB, voffB); PG8_STAGE(PG8_SB(0, 1), cB + hstepB, voffB); PG8_STAGE(PG8_SA(0, 0), cA, voffA); PG8_STAGE(PG8_SA(0, 1), cA + hstepA, voffA);
        if (wr == 1) PG8_BAR;
        PG8_WAIT_V(2); PG8_BAR;
        PG8_STAGE(PG8_SB(1, 0), cB + kstep, voffB); PG8_STAGE(PG8_SA(1, 0), cA + kstep, voffA); PG8_STAGE(PG8_SB(1, 1), cB + hstepB + kstep, voffB);
        PG8_WAIT_V(6); PG8_BAR;
    } else {
        PG8_STAGE(PG8_SB(0, 0), cB, voffB); PG8_STAGE(PG8_SA(0, 0), cA, voffA); PG8_STAGE(PG8_SB(0, 1), cB + hstepB, voffB); PG8_STAGE(PG8_SA(0, 1), cA + hstepA, voffA);
        if (wr == 1) PG8_BAR;
        PG8_WAIT_V(4); PG8_BAR;
        PG8_STAGE(PG8_SB(1, 0), cB + kstep, voffB); PG8_STAGE(PG8_SA(1, 0), cA + kstep, voffA); PG8_STAGE(PG8_SB(1, 1), cB + hstepB + kstep, voffB);
        PG8_WAIT_V(6); PG8_BAR;
    }
    for (;;) {
        const bool has_next = S.next(ui + 1, nxt);
        const char* nA = has_next ? (const char*)g.A + (size_t)nxt.pm * tstepA + (size_t)nxt.pn * pnoffA : cA; const char* nB = has_next ? (const char*)g.Bt + (size_t)nxt.pn * tstepB : cB;
        for (int t = 0; t < nt; t += 2) {
            const bool last = (t == nt - 2);
            const char* a1 = cA + (size_t)(t + 1) * kstep;
            const char* a2 = last ? nA : cA + (size_t)(t + 2) * kstep; const char* b2 = last ? nB : cB + (size_t)(t + 2) * kstep;
            const char* a3 = a2 + kstep; const char* b3 = b2 + kstep;
            if (last && has_next) S.a_ready(nxt);
            if constexpr (SP2) {
            PG8_LDB(B0, 0, 0); PG8_LDB(B1, 0, 1); PG8_SCHED; PG8_LDA(At, 0, 0); PG8_STAGE(PG8_SA(1, 1), a1 + hstepA, voffA);
            PG8_WAIT_V(8); PG8_WAIT_L(0); PG8_BAR; PG8_MMA(0, 0, At, B0); PG8_MMA(0, 1, At, B1); PG8_BAR; PG8_SCHED;
            PG8_LDA(At, 0, 1); PG8_STAGE(PG8_SB(0, 0), b2, voffB); PG8_STAGE(PG8_SB(0, 1), b2 + hstepB, voffB); PG8_STAGE(PG8_SA(0, 0), a2, voffA);
            PG8_WAIT_V(8); PG8_WAIT_L(0); PG8_BAR; PG8_MMA(1, 0, At, B0); PG8_MMA(1, 1, At, B1); PG8_BAR; PG8_SCHED;
            PG8_LDB(B0, 1, 0); PG8_LDB(B1, 1, 1); PG8_SCHED; PG8_LDA(At, 1, 0); PG8_STAGE(PG8_SA(0, 1), a2 + hstepA, voffA);
            PG8_WAIT_V(8); PG8_WAIT_L(0); PG8_BAR; PG8_MMA(0, 0, At, B0); PG8_MMA(0, 1, At, B1); PG8_BAR; PG8_SCHED;
            PG8_LDA(At, 1, 1); PG8_STAGE(PG8_SB(1, 0), b3, voffB); PG8_STAGE(PG8_SB(1, 1), b3 + hstepB, voffB); PG8_STAGE(PG8_SA(1, 0), a3, voffA);
            PG8_WAIT_V(8); PG8_WAIT_L(0); PG8_BAR; PG8_MMA(1, 0, At, B0); PG8_MMA(1, 1, At, B1); PG8_BAR; PG8_SCHED;
            } else {
            PG8_LDB(B0, 0, 0); PG8_SCHED; PG8_LDA(At, 0, 0); PG8_STAGE(PG8_SA(1, 1), a1 + hstepA, voffA);
            PG8_WAIT_L(8); PG8_BAR; PG8_WAIT_L(0); PG8_MMA(0, 0, At, B0); PG8_BAR; PG8_SCHED;
            PG8_LDB(B1, 0, 1); PG8_STAGE(PG8_SB(0, 0), b2, voffB);
            PG8_BAR; PG8_WAIT_L(0); PG8_MMA(0, 1, At, B1); PG8_BAR;
            PG8_LDA(At, 0, 1); PG8_STAGE(PG8_SA(0, 0), a2, voffA);
            PG8_BAR; PG8_WAIT_L(0); PG8_MMA(1, 0, At, B0); PG8_BAR; PG8_SCHED;
            PG8_STAGE(PG8_SB(0, 1), b2 + hstepB, voffB);
            PG8_WAIT_V(6); PG8_BAR; PG8_MMA(1, 1, At, B1); PG8_BAR;
            PG8_LDB(B0, 1, 0); PG8_SCHED; PG8_LDA(At, 1, 0); PG8_STAGE(PG8_SA(0, 1), a2 + hstepA, voffA);
            PG8_WAIT_L(8); PG8_BAR; PG8_WAIT_L(0); PG8_MMA(0, 0, At, B0); PG8_BAR; PG8_SCHED;
            PG8_LDB(B1, 1, 1); PG8_STAGE(PG8_SB(1, 0), b3, voffB);
            PG8_BAR; PG8_WAIT_L(0); PG8_MMA(0, 1, At, B1); PG8_BAR;
            PG8_LDA(At, 1, 1); PG8_STAGE(PG8_SA(1, 0), a3, voffA);
            PG8_BAR; PG8_WAIT_L(0); PG8_MMA(1, 0, At, B0); PG8_BAR; PG8_SCHED;
            PG8_STAGE(PG8_SB(1, 1), b3 + hstepB, voffB);
            PG8_WAIT_V(6); PG8_BAR; PG8_MMA(1, 1, At, B1); PG8_BAR;
            }
        }
        if constexpr (ALIGN_EPI) { if (wr == 0) PG8_BAR; }
        E(acc, cur, wr, wc, fr, fq); S.done(cur);
        if (!has_next) break;
#pragma unroll
        for (int a = 0; a < 2; ++a)
#pragma unroll
            for (int b = 0; b < 2; ++b)
#pragma unroll
                for (int m = 0; m < 4; ++m)
#pragma unroll
                    for (int n = 0; n < 2; ++n) acc[a][b][m][n] = (f32x4){0.f, 0.f, 0.f, 0.f};
        cur = nxt; cA = nA; cB = nB; ++ui;
        if constexpr (ALIGN_EPI) { if (wr == 1) PG8_BAR; }
    }
    PG8_WAIT_V(0);
    if constexpr (!ALIGN_EPI) { if (wr == 0) PG8_BAR; }
    PG8_BAR;
#undef PG8_SA
#undef PG8_SB
#undef PG8_STAGE
#undef PG8_LDA
#undef PG8_LDB
#undef PG8_MMA
#undef PG8_WAIT_V
#undef PG8_WAIT_L
#undef PG8_BAR
#undef PG8_SCHED
}
}

constexpr int DM = 1024;
constexpr int NTOK = 16400;
constexpr int PADL = 48;
constexpr int LPV = 16448;
constexpr int MP = 16640;
constexpr int MU = 16384;
constexpr int NCHUNK = 257;
constexpr int NHEAD = 8;
constexpr int NPROJ = 2560;
constexpr int KVROWS = 16512;
constexpr float EPS = 1e-6f;

constexpr size_t MiB = 1u << 20;
constexpr size_t WS_CTL = 0, CTL_ZERO_BYTES = 64 * 1024;
constexpr size_t WS_WIN = 1 * MiB;
constexpr size_t WS_WUQ = 6 * MiB;
constexpr size_t WS_WUKV = 6 * MiB + 512 * 1024;
constexpr size_t WS_WOUT = 7 * MiB;
constexpr size_t WS_WPQ = 9 * MiB;
constexpr size_t WS_SKB = 13 * MiB;
constexpr size_t WS_IDX = 16 * MiB;
constexpr size_t WS_GATE = 24 * MiB;
constexpr size_t WS_HN = 32 * MiB;
constexpr size_t WS_QKVR = 96 * MiB;
constexpr size_t WS_Z = 96 * MiB + 49 * MiB;
constexpr size_t WS_P32 = 162 * MiB;
constexpr size_t WS_GA = 195 * MiB;
constexpr size_t WS_GQ = 212 * MiB;
constexpr size_t WS_GS = 229 * MiB;
constexpr size_t WS_GB = 32 * MiB;
constexpr size_t WS_GO = 65 * MiB;
constexpr size_t WS_MIX = 96 * MiB;
constexpr size_t WS_CQN = 128 * MiB;
constexpr size_t WS_CKVN = 136 * MiB + 512 * 1024;
constexpr size_t WS_QH = 32 * MiB;
constexpr size_t WS_KVB = 57 * MiB;
constexpr size_t WS_Q = 195 * MiB;
constexpr size_t WS_K = 220 * MiB;
constexpr size_t WS_VT = 145 * MiB;
constexpr size_t WS_XN = 32 * MiB;
constexpr size_t WS_PQ = 64 * MiB;
constexpr size_t WS_SC = 128 * MiB;
constexpr size_t WS_EU = 96 * MiB;
constexpr size_t WS_EV = 112 * MiB;
constexpr size_t WS_CW = 64 * MiB;
constexpr size_t WS_HP = 128 * MiB;
constexpr size_t WS_END = 256 * MiB;

constexpr int LDS_BYTES = 147456;
constexpr int MISC_OFF = 131072 + 12288;

DI unsigned f2bf(float f) { unsigned u = __builtin_bit_cast(unsigned, f); return (u + 0x7fffu + ((u >> 16) & 1u)) >> 16; }
DI unsigned pk2(float lo, float hi) { return f2bf(lo) | (f2bf(hi) << 16); }
DI float bf2f(unsigned b) { return __builtin_bit_cast(float, b << 16); }
DI float bflo(unsigned w) { return __builtin_bit_cast(float, w << 16); }
DI float bfhi(unsigned w) { return __builtin_bit_cast(float, w & 0xffff0000u); }
DI float wave_sum(float v) {
#pragma unroll
    for (int o = 1; o < 64; o <<= 1) v += __shfl_xor(v, o);
    return v;
}
DI float sigmoidf_(float x) { return 1.f / (1.f + __expf(-x)); }
DI float siluf_(float x) { return x / (1.f + __expf(-x)); }

#define XB_TMO      128
#define XB_XCNT(j)  (256  + 64 * (j))
#define XB_XSUB(j)  (1280 + 64 * (j))
#define XB_XGEN(j)  (2304 + 64 * (j))
#define XB_TOP      3328
#define XB_TOPGEN   3392
#define XCD_BAR_WORDS 3456
#define XB_SPIN_CAP (1u << 22)
DI unsigned xb_ld(unsigned* p)              { return __hip_atomic_load(p, __ATOMIC_RELAXED, __HIP_MEMORY_SCOPE_AGENT); }
DI unsigned xb_add(unsigned* p, unsigned v) { return __hip_atomic_fetch_add(p, v, __ATOMIC_RELAXED, __HIP_MEMORY_SCOPE_AGENT); }
DI unsigned xb_xcc_id() { return (unsigned)__builtin_amdgcn_s_getreg((3 << 11) | 20) & 0xFu; }
#define XB_SPIN(cond, bar) do { unsigned _sp = 0; while (cond) { __builtin_amdgcn_s_sleep(1); \
    if ((++_sp & 255u) == 0u) { if (xb_ld(&(bar)[XB_TMO])) break; if (_sp > XB_SPIN_CAP) { atomicAdd(&(bar)[XB_TMO], 1u); break; } } } } while (0)
struct XcdBarrier { unsigned* bar; unsigned x; volatile LAS unsigned* st; };
DI XcdBarrier xcd_barrier_post(unsigned* bar, volatile LAS unsigned* st) {
    XcdBarrier b; b.bar = bar; b.x = xb_xcc_id(); b.st = st;
    if (threadIdx.x == 0) (void)xb_add(&bar[XB_XCNT(b.x)], 1u);
    return b;
}
DI void xcd_barrier_complete(unsigned* bar, unsigned x, unsigned& nloc, unsigned& nx) {
    const unsigned G = gridDim.x * gridDim.y * gridDim.z;
    unsigned sum, cnt, mine, sp = 0u;
    for (;;) {
        sum = 0u; cnt = 0u; mine = 0u;
#pragma unroll
        for (unsigned j = 0; j < 16; ++j) { const unsigned c = xb_ld(&bar[XB_XCNT(j)]); sum += c; cnt += (c > 0u) ? 1u : 0u; mine = (j == x) ? c : mine; }
        if (sum == G) break;
        __builtin_amdgcn_s_sleep(1);
        if ((++sp & 255u) == 0u) { if (xb_ld(&bar[XB_TMO])) break; if (sp > XB_SPIN_CAP) { atomicAdd(&bar[XB_TMO], 1u); break; } }
    }
    nloc = mine > 0u ? mine : 1u; nx = cnt > 0u ? cnt : 1u;
}
DI void xcd_barrier(const XcdBarrier& b) {
    asm volatile("s_waitcnt vmcnt(0)" ::: "memory");
    __syncthreads();
    if (threadIdx.x == 0) {
        unsigned* bar = b.bar;
        __builtin_amdgcn_s_waitcnt(0);
        unsigned nloc = b.st[0], nx = b.st[1];
        if (nloc == 0u) { xcd_barrier_complete(bar, b.x, nloc, nx); b.st[0] = nloc; b.st[1] = nx; }
        const unsigned old = xb_add(&bar[XB_XSUB(b.x)], 1u);
        const unsigned gen = old / nloc;
        if (old + 1u == (gen + 1u) * nloc) {
            __builtin_amdgcn_fence(__ATOMIC_RELEASE, "agent");
            asm volatile("s_waitcnt vmcnt(0)" ::: "memory");
            const unsigned og = xb_add(&bar[XB_TOP], 1u);
            const unsigned tg = og / nx;
            if (og + 1u == (tg + 1u) * nx) xb_add(&bar[XB_TOPGEN], 1u);
            else XB_SPIN(xb_ld(&bar[XB_TOPGEN]) == tg, bar);
            __builtin_amdgcn_fence(__ATOMIC_ACQUIRE, "agent");
            xb_add(&bar[XB_XGEN(b.x)], 1u);
            asm volatile("s_waitcnt vmcnt(0)" ::: "memory");
        } else {
            XB_SPIN(xb_ld(&bar[XB_XGEN(b.x)]) == gen, bar);
            __builtin_amdgcn_fence(__ATOMIC_ACQUIRE, "agent");
            asm volatile("s_waitcnt vmcnt(0)" ::: "memory");
        }
    }
    __syncthreads();
}

struct Args {
    const float* in[20];
    float* out; unsigned char* ws;
    int ph_lo, ph_hi;
};
struct Frame {
    unsigned char* lds;
    int tid, lane, wave, G, gw, NGW;
};

template <class Map>
DI void transpose_item(const float* __restrict__ W, int Nsrc, bf16_t* __restrict__ WT, int ldk, float* scr, int item, int nblk, int lane, Map srcmap) {
    const int kb = item / nblk, nb = item % nblk, k0 = 64 * kb, n0 = 32 * nb;
    const int ns = srcmap(n0 + (lane & 31));
#pragma unroll 8
    for (int i = 0; i < 32; ++i) { const int kk = 2 * i + (lane >> 5); scr[kk * 33 + (lane & 31)] = (ns >= 0) ? W[(size_t)(k0 + kk) * Nsrc + ns] : 0.f; }
    __builtin_amdgcn_s_waitcnt(0); __builtin_amdgcn_wave_barrier();
    const int c = lane & 7;
#pragma unroll
    for (int j = 0; j < 4; ++j) { const int n = (lane >> 3) + 8 * j; const float* s = scr + (8 * c) * 33 + n;
        u32x4 o; o.x = pk2(s[0 * 33], s[1 * 33]); o.y = pk2(s[2 * 33], s[3 * 33]); o.z = pk2(s[4 * 33], s[5 * 33]); o.w = pk2(s[6 * 33], s[7 * 33]);
        *(u32x4*)(WT + (size_t)(n0 + n) * ldk + k0 + 8 * c) = o; }
    __builtin_amdgcn_s_waitcnt(0); __builtin_amdgcn_wave_barrier();
}
struct MapId { DI int operator()(int n) const { return n; } };
struct MapWin {
    DI int operator()(int n) const {
        if (n < 2048) return n;
        if (n < 2304) return n + 16;
        if (n < 2432) return n + 16;
        if (n < 2464) return n + 16;
        if (n < 2472) return n - 416;
        if (n < 2480) return n - 416;
        return -1;
    }
};

DI void p0_prologue(const Frame& F, const Args& A) {
    unsigned char* ws = A.ws;
    float* scr = (float*)(F.lds + F.wave * 16384);
    const float* w_in = A.in[3]; const float* w_uq = A.in[10]; const float* w_ukv = A.in[11]; const float* w_out = A.in[14]; const float* w_pq = A.in[16]; const float* sub_keys = A.in[17];
    constexpr int I_IN = 16 * 80, I_UQ = 4 * 24, I_UKV = 2 * 32, I_OUT = 16 * 32, I_PQ = 16 * 64;
    constexpr int NITEMS = I_IN + I_UQ + I_UKV + I_OUT + I_PQ;
    for (int it = F.gw; it < NITEMS; it += F.NGW) {
        int r = it;
        if (r < I_IN) { transpose_item(w_in, 2480, (bf16_t*)(ws + WS_WIN), 1024, scr, r, 80, F.lane, MapWin()); continue; } r -= I_IN;
        if (r < I_UQ) { transpose_item(w_uq, 768, (bf16_t*)(ws + WS_WUQ), 256, scr, r, 24, F.lane, MapId()); continue; } r -= I_UQ;
        if (r < I_UKV) { transpose_item(w_ukv, 1024, (bf16_t*)(ws + WS_WUKV), 256, scr, r, 32, F.lane, MapId()); continue; } r -= I_UKV;
        if (r < I_OUT) { transpose_item(w_out, 1024, (bf16_t*)(ws + WS_WOUT), 1024, scr, r, 32, F.lane, MapId()); continue; } r -= I_OUT;
        transpose_item(w_pq, 2048, (bf16_t*)(ws + WS_WPQ), 1024, scr, r, 64, F.lane, MapId());
    }
    const int gt = blockIdx.x * 512 + F.tid, NGT = F.G * 512;
    for (int i = gt; i < 1024 * 16; i += NGT) { const int n = i >> 4, c = i & 15; *(u32x4*)((bf16_t*)(ws + WS_WUKV) + (size_t)n * 256 + 128 + c * 8) = (u32x4){0u, 0u, 0u, 0u}; }
    for (int i = gt; i < 2048 * 32; i += NGT) {
        const int n = i >> 5, c8 = (i & 31) * 8; const int p = (n >> 7) & 1;
        u32x4 o = (u32x4){0u, 0u, 0u, 0u};
        if ((c8 >> 7) == p) { const float* s = sub_keys + (size_t)n * 128 + (c8 & 127); const f32x4 a = *(const f32x4*)s, b = *(const f32x4*)(s + 4);
            o.x = pk2(a.x, a.y); o.y = pk2(a.z, a.w); o.z = pk2(b.x, b.y); o.w = pk2(b.z, b.w); }
        *(u32x4*)((bf16_t*)(ws + WS_SKB) + (size_t)n * 256 + c8) = o;
    }
    const float* x = A.in[0]; const float* meta = A.in[1]; const float* anorm = A.in[2];
    bf16_t* HN = (bf16_t*)(ws + WS_HN);
    for (int p = F.gw; p < MP; p += F.NGW) {
        unsigned long long* o8 = (unsigned long long*)(HN + (size_t)p * DM) + F.lane;
        const int t = p - PADL;
        if (t < 0 || t >= NTOK) {
#pragma unroll
            for (int j = 0; j < 4; ++j) o8[64 * j] = 0ull;
            continue;
        }
        const float* src = (t < 16) ? meta + (size_t)t * DM : x + (size_t)(t - 16) * DM;
        const f32x4* xr = (const f32x4*)src + F.lane;
        f32x4 v[4]; float s = 0.f;
#pragma unroll
        for (int j = 0; j < 4; ++j) { v[j] = xr[64 * j]; s += (v[j].x * v[j].x + v[j].y * v[j].y) + (v[j].z * v[j].z + v[j].w * v[j].w); }
        const float rstd = 1.f / sqrtf(wave_sum(s) * (1.f / DM) + EPS);
#pragma unroll
        for (int j = 0; j < 4; ++j) { const f32x4 w = ((const f32x4*)anorm)[64 * j + F.lane];
            o8[64 * j] = (unsigned long long)pk2(v[j].x * rstd * w.x, v[j].y * rstd * w.y) | ((unsigned long long)pk2(v[j].z * rstd * w.z, v[j].w * rstd * w.w) << 32); }
    }
}

struct EpiProj {
    static constexpr bool PERM = true;
    bf16_t* QKVR; bf16_t* Z; float* P32;
    DI void operator()(const f32x4 (&acc)[2][2][4][2], const pg8::Unit& u, int wr, int wc, int fr, int fq) const {
        const int row0 = u.pm * 256 + wr * 64 + fr;
        if (u.pn < 8) {
            bf16_t* base; int ld, colt;
            if (u.pn < 6) { base = QKVR; ld = 1536; colt = u.pn * 256; } else { base = Z; ld = 512; colt = (u.pn - 6) * 256; }
            const int col0 = colt + wc * 32 + 8 * fq;
#pragma unroll
            for (int ai = 0; ai < 2; ++ai)
#pragma unroll
                for (int m = 0; m < 4; ++m) { bf16_t* rowp = base + (size_t)(row0 + ai * 128 + m * 16) * ld + col0;
#pragma unroll
                    for (int bj = 0; bj < 2; ++bj) { const f32x4 v0 = acc[ai][bj][m][0], v1 = acc[ai][bj][m][1];
                        u32x4 w; w.x = pg8::cvt_pk_bf16(v0[0], v0[1]); w.y = pg8::cvt_pk_bf16(v0[2], v0[3]); w.z = pg8::cvt_pk_bf16(v1[0], v1[1]); w.w = pg8::cvt_pk_bf16(v1[2], v1[3]);
                        *(u32x4*)(rowp + bj * 128) = w; } }
        } else {
            const int col0 = (u.pn - 8) * 256 + wc * 32 + 8 * fq;
#pragma unroll
            for (int ai = 0; ai < 2; ++ai)
#pragma unroll
                for (int m = 0; m < 4; ++m) { float* rowp = P32 + (size_t)(row0 + ai * 128 + m * 16) * 512 + col0;
#pragma unroll
                    for (int bj = 0; bj < 2; ++bj) { *(f32x4*)(rowp + bj * 128) = acc[ai][bj][m][0]; *(f32x4*)(rowp + bj * 128 + 4) = acc[ai][bj][m][1]; } }
        }
    }
};
struct EpiB16 {
    static constexpr bool PERM = true;
    bf16_t* O; int ldc;
    DI void operator()(const f32x4 (&acc)[2][2][4][2], const pg8::Unit& u, int wr, int wc, int fr, int fq) const {
        const int row0 = u.pm * 256 + wr * 64 + fr, col0 = u.pn * 256 + wc * 32 + 8 * fq;
#pragma unroll
        for (int ai = 0; ai < 2; ++ai)
#pragma unroll
            for (int m = 0; m < 4; ++m) { bf16_t* rowp = O + (size_t)(row0 + ai * 128 + m * 16) * ldc + col0;
#pragma unroll
                for (int bj = 0; bj < 2; ++bj) { const f32x4 v0 = acc[ai][bj][m][0], v1 = acc[ai][bj][m][1];
                    u32x4 w; w.x = pg8::cvt_pk_bf16(v0[0], v0[1]); w.y = pg8::cvt_pk_bf16(v0[2], v0[3]); w.z = pg8::cvt_pk_bf16(v1[0], v1[1]); w.w = pg8::cvt_pk_bf16(v1[2], v1[3]);
                    *(u32x4*)(rowp + bj * 128) = w; } }
    }
};
struct EpiF32 {
    static constexpr bool PERM = true;
    float* C; int ldc; const float* res;
    DI void operator()(const f32x4 (&acc)[2][2][4][2], const pg8::Unit& u, int wr, int wc, int fr, int fq) const {
        const int row0 = u.pm * 256 + wr * 64 + fr, col0 = u.pn * 256 + wc * 32 + 8 * fq;
#pragma unroll
        for (int ai = 0; ai < 2; ++ai)
#pragma unroll
            for (int m = 0; m < 4; ++m) { const size_t off = (size_t)(row0 + ai * 128 + m * 16) * ldc + col0;
#pragma unroll
                for (int bj = 0; bj < 2; ++bj) { f32x4 v0 = acc[ai][bj][m][0], v1 = acc[ai][bj][m][1];
                    if (res) { v0 += *(const f32x4*)(res + off + bj * 128); v1 += *(const f32x4*)(res + off + bj * 128 + 4); }
                    *(f32x4*)(C + off + bj * 128) = v0; *(f32x4*)(C + off + bj * 128 + 4) = v1; } }
    }
};

DI f32x16 mfma32(bf16x8 a, bf16x8 b, f32x16 c) { return __builtin_amdgcn_mfma_f32_32x32x16_bf16(a, b, c, 0, 0, 0); }
DI f32x4 mfma16(bf16x8 a, bf16x8 b, f32x4 c) { return __builtin_amdgcn_mfma_f32_16x16x32_bf16(a, b, c, 0, 0, 0); }
DI int crow(int r, int hi) { return (r & 3) + 8 * (r >> 2) + 4 * hi; }
DI f32x16 zero16() { f32x16 z;
#pragma unroll
    for (int i = 0; i < 16; ++i) z[i] = 0.f; return z; }

constexpr int G_KF = 0, G_VF = 16384, G_MF = 32768;
constexpr int G_QB = 50176, G_KB = 59392, G_KBB = 68608;
constexpr int G_QKB = 77824, G_UT = 87040, G_WT = 96256, G_KDT = 105472;
constexpr int G_VEC = 114688;
constexpr int G_RAW = G_QKB;
constexpr int GST = 72;

DI f32x16 mm_quad(const unsigned char* A, const unsigned char* Bt, int qr, int qc, int lane) {
    const int r32 = lane & 31, hh = lane >> 5;
    const unsigned char* ap = A + (32 * qr + r32) * (GST * 2) + hh * 16;
    const unsigned char* bp = Bt + (32 * qc + r32) * (GST * 2) + hh * 16;
    f32x16 acc = zero16();
#pragma unroll
    for (int s = 0; s < 4; ++s) acc = mfma32(*(const bf16x8*)(ap + s * 32), *(const bf16x8*)(bp + s * 32), acc);
    return acc;
}

constexpr int G_RAW2 = 115712;
static_assert(G_RAW2 + 67 * 400 <= 143360, "GDN prep LDS map");
constexpr int G_CONVW = 143360 + 512;

DI void gdn_prep_phase(const Frame& F, const Args& A) {
    unsigned char* ws = A.ws; unsigned char* lds = F.lds;
    const int tid = F.tid, lane = F.lane, wave = F.wave;
    const bf16_t* QKVR = (const bf16_t*)(ws + WS_QKVR); const float* P32 = (const float*)(ws + WS_P32);
    float* KF = (float*)(lds + G_KF); float* VF = (float*)(lds + G_VF); float* MF = (float*)(lds + G_MF);
    float* VEC = (float*)(lds + G_VEC);
    const int NIT = NCHUNK * 8;
#define LBAR() do { asm volatile("s_waitcnt lgkmcnt(0)" ::: "memory"); __builtin_amdgcn_s_barrier(); asm volatile("" ::: "memory"); } while (0)
#define LAUNDER(dst, src) int dst = (src); asm volatile("" : "+v"(dst))
    int item = blockIdx.x;
    if (item >= NIT) return;
    u32x4 pr[4]; float nb = 0.f, na = 0.f;
    auto raw_fetch = [&](int it) {
        const int c = it >> 3, h = it & 7; LAUNDER(tl, tid);
#pragma unroll
        for (int i = 0; i < 4; ++i) { const int q = tl + 512 * i; pr[i] = (u32x4){0u, 0u, 0u, 0u};
            if (q < 67 * 24) { const int r = q / 24, cc = q % 24, seg = cc >> 3, c8 = cc & 7; const int p = 64 * c - 3 + r;
                if (p >= 0) pr[i] = *(const u32x4*)(QKVR + (size_t)p * 1536 + seg * 512 + h * 64 + c8 * 8); } }
        if (wave == 0) { const int p = 64 * c + lane; nb = P32[(size_t)p * 512 + 416 + h]; na = P32[(size_t)p * 512 + 424 + h]; }
    };
    auto raw_park = [&]() {
        LAUNDER(tl, tid);
#pragma unroll
        for (int i = 0; i < 4; ++i) { const int q = tl + 512 * i;
            if (q < 67 * 24) { const int r = q / 24, cc = q % 24, seg = cc >> 3, c8 = cc & 7; *(u32x4*)(lds + G_RAW2 + r * 400 + (seg * 64 + c8 * 8) * 2) = pr[i]; } }
    };
    raw_fetch(item); raw_park();
    float cb = nb, ca = na;
    float* CWL = (float*)(lds + G_CONVW);
    int cw_h = -1;
#pragma unroll 1
    for (; item < NIT; item += F.G) {
        const int c = item >> 3, h = item & 7;
        if (h != cw_h) { cw_h = h;
            if (tid < 192) { LAUNDER(t0, tid); const int sg = t0 >> 6, jt = (t0 >> 4) & 3, c4 = t0 & 15; *(f32x4*)(CWL + (sg * 4 + jt) * 64 + 4 * c4) = *(const f32x4*)(A.in[4] + jt * 1536 + sg * 512 + h * 64 + 4 * c4); } }
        const int nxt = item + F.G;
        if (nxt < NIT) raw_fetch(nxt);
        if (wave == 0) {
            const int p = 64 * c + lane;
            const float alog = A.in[5][h], dtb = A.in[6][h];
            float beta = sigmoidf_(cb);
            const float xx = ca + dtb; const float sp = xx > 20.f ? xx : log1pf(__expf(xx));
            float g = -__expf(alog) * sp;
            if (p < PADL) { beta = 0.f; g = 0.f; }
            float gc = g;
#pragma unroll
            for (int o = 1; o < 64; o <<= 1) { const float t = __shfl_up(gc, o); if (lane >= o) gc += t; }
            const float glast = __shfl(gc, 63);
            VEC[lane] = gc; VEC[64 + lane] = beta; VEC[128 + lane] = __expf(gc); VEC[192 + lane] = __expf(glast - gc);
        }
        LBAR();
        LAUNDER(t1, tid); const int sub = t1 & 15, grp = t1 >> 4;
#pragma unroll
        for (int sg = 0; sg < 3; ++sg) {
#pragma unroll 1
            for (int ps = 0; ps < 2; ++ps) {
                const int i = grp + 32 * ps;
                float acc[4] = {0.f, 0.f, 0.f, 0.f};
#pragma unroll
                for (int jt = 0; jt < 4; ++jt) {
                    const f32x4 w = *(const f32x4*)(CWL + (sg * 4 + jt) * 64 + 4 * sub);
                    const u32x2 rv = *(const u32x2*)(lds + G_RAW2 + (i + jt) * 400 + (sg * 64 + 4 * sub) * 2);
                    acc[0] += w.x * bflo(rv.x); acc[1] += w.y * bfhi(rv.x); acc[2] += w.z * bflo(rv.y); acc[3] += w.w * bfhi(rv.y);
                }
                float y[4];
#pragma unroll
                for (int k = 0; k < 4; ++k) y[k] = siluf_(acc[k]);
                if (sg < 2) {
                    float ss = (y[0] * y[0] + y[1] * y[1]) + (y[2] * y[2] + y[3] * y[3]);
                    ss += __shfl_xor(ss, 1); ss += __shfl_xor(ss, 2); ss += __shfl_xor(ss, 4); ss += __shfl_xor(ss, 8);
                    const float rn = 1.f / sqrtf(ss + EPS);
#pragma unroll
                    for (int k = 0; k < 4; ++k) y[k] *= rn;
                }
                if (sg == 0) {
                    u32x2 o; o.x = pk2(y[0] * 0.125f, y[1] * 0.125f); o.y = pk2(y[2] * 0.125f, y[3] * 0.125f);
                    *(u32x2*)(lds + G_QB + i * (GST * 2) + 8 * sub) = o;
                } else if (sg == 1) {
                    const float beta = VEC[64 + i], ekd = VEC[192 + i];
                    *(f32x4*)(KF + i * 64 + 4 * sub) = (f32x4){y[0], y[1], y[2], y[3]};
                    u32x2 o; o.x = pk2(y[0], y[1]); o.y = pk2(y[2], y[3]);
                    *(u32x2*)(lds + G_KB + i * (GST * 2) + 8 * sub) = o;
                    o.x = pk2(y[0] * beta, y[1] * beta); o.y = pk2(y[2] * beta, y[3] * beta);
                    *(u32x2*)(lds + G_KBB + i * (GST * 2) + 8 * sub) = o;
#pragma unroll
                    for (int k = 0; k < 4; ++k) *(bf16_t*)(lds + G_KDT + (4 * sub + k) * (GST * 2) + i * 2) = (bf16_t)f2bf(y[k] * ekd);
                } else {
                    *(f32x4*)(VF + i * 64 + 4 * sub) = (f32x4){y[0], y[1], y[2], y[3]};
                }
            }
        }
        LBAR();
        {
            LAUNDER(l3, lane);
            const int prod = wave >> 2, quad = wave & 3, qr = quad >> 1, qc = quad & 1, r32 = l3 & 31, hh = l3 >> 5;
            const f32x16 acc = mm_quad(lds + (prod ? G_QB : G_KBB), lds + G_KB, qr, qc, l3);
            const int j = 32 * qc + r32; const float gcj = VEC[j];
#pragma unroll
            for (int r = 0; r < 16; ++r) {
                const int i = 32 * qr + crow(r, hh);
                if (prod == 0) { MF[i * 68 + j] = (j < i) ? acc[r] * __expf(VEC[i] - gcj) : 0.f; }
                else { *(bf16_t*)(lds + G_QKB + i * (GST * 2) + j * 2) = (bf16_t)f2bf((j <= i) ? acc[r] * __expf(VEC[i] - gcj) : 0.f); }
            }
        }
        LBAR();
        if (tid < 128) {
            LAUNDER(col, tid); const bool isU = col < 64;
            const float* src = isU ? (VF + col) : (KF + (col - 64));
            float x[64];
#pragma unroll
            for (int i = 0; i < 64; ++i) {
                float rhs = src[i * 64] * VEC[64 + i]; if (!isU) rhs *= VEC[128 + i];
                float a0 = 0.f, a1 = 0.f, a2 = 0.f, a3 = 0.f;
#pragma unroll
                for (int j = 0; j + 3 < i; j += 4) { const f32x4 m = *(const f32x4*)(MF + i * 68 + j); a0 += m.x * x[j]; a1 += m.y * x[j + 1]; a2 += m.z * x[j + 2]; a3 += m.w * x[j + 3]; }
#pragma unroll
                for (int j = (i & ~3); j < i; ++j) a0 += MF[i * 68 + j] * x[j];
                x[i] = rhs - ((a0 + a1) + (a2 + a3));
                asm volatile("" : "+v"(x[i]) :: "memory");
            }
            unsigned char* dst = lds + (isU ? G_UT : G_WT) + (isU ? col : col - 64) * (GST * 2);
#pragma unroll
            for (int i = 0; i < 64; i += 8) {
                u32x4 o; o.x = pk2(x[i], x[i + 1]); o.y = pk2(x[i + 2], x[i + 3]); o.z = pk2(x[i + 4], x[i + 5]); o.w = pk2(x[i + 6], x[i + 7]);
                *(u32x4*)(dst + i * 2) = o;
            }
        }
        LBAR();
        {
            const float gl = VEC[128 + 63];
            float* GB = (float*)(ws + WS_GB) + (size_t)item * 4096;
            bf16_t* GQ = (bf16_t*)(ws + WS_GQ) + (size_t)item * 4096; bf16_t* GO = (bf16_t*)(ws + WS_GO) + (size_t)item * 4096;
            bf16_t* GAL = (bf16_t*)(lds + G_MF);
            LAUNDER(l5, lane); const int r32 = l5 & 31, hh = l5 >> 5;
#pragma unroll 1
            for (int it = 0; it < 2; ++it) {
                const int task = wave + 8 * it, prod = task >> 2, quad = task & 3, qr = quad >> 1, qc = quad & 1;
                const f32x16 acc = mm_quad(lds + (prod < 2 ? G_KDT : G_QKB), lds + ((prod & 1) ? G_UT : G_WT), qr, qc, l5);
                const int Cc = 32 * qc + r32;
                if (prod == 0) {
#pragma unroll
                    for (int r = 0; r < 16; ++r) {
                        const int R = 32 * qr + crow(r, hh);
                        const float val = ((R == Cc) ? gl : 0.f) - acc[r];
                        const int rb = R >> 4, m = R & 15, q4 = Cc >> 4, g = (Cc >> 2) & 3, rr = Cc & 3, ks = q4 >> 1, jj = 4 * (q4 & 1) + rr, ls = 16 * g + m;
                        GAL[((rb * 2 + ks) * 64 + ls) * 8 + jj] = (bf16_t)f2bf(val);
                    }
                } else if (prod == 1) {
                    const int eslab = Cc >> 4, n = Cc & 15;
#pragma unroll
                    for (int a = 0; a < 4; ++a) {
                        const int R0 = 32 * qr + 8 * a + 4 * hh; const int rb = R0 >> 4, g = (R0 >> 2) & 3, ls = 16 * g + n;
                        *(f32x4*)(GB + ((eslab * 4 + rb) * 64 + ls) * 4) = (f32x4){acc[4 * a], acc[4 * a + 1], acc[4 * a + 2], acc[4 * a + 3]};
                    }
                } else if (prod == 2) {
#pragma unroll
                    for (int r = 0; r < 16; ++r) {
                        const int R = 32 * qr + crow(r, hh);
                        const float qv = bf2f(*(const bf16_t*)(lds + G_QB + R * (GST * 2) + Cc * 2));
                        GQ[R * 64 + Cc] = (bf16_t)f2bf(qv * VEC[128 + R] - acc[r]);
                    }
                } else {
#pragma unroll
                    for (int r = 0; r < 16; ++r) GO[(quad * 16 + r) * 64 + l5] = (bf16_t)f2bf(acc[r]);
                }
            }
        }
        if (nxt < NIT) { raw_park(); cb = nb; ca = na; }
        LBAR();
        { LAUNDER(t6, tid); *(u32x4*)((bf16_t*)(ws + WS_GA) + (size_t)item * 4096 + t6 * 8) = *(const u32x4*)(lds + G_MF + t6 * 16); }
    }
}

constexpr int SC_D = 8, SC_PD = 6, SC_SLOT = 12288;
DI void gdn_scan(const Frame& F, const Args& A) {
    if (blockIdx.x >= 32) return;
    unsigned char* ws = A.ws;
    const int h = blockIdx.x & 7, eslab = blockIdx.x >> 3, lane = F.lane, wave = F.wave, n = lane & 15, g = lane >> 4;
    const unsigned char* GA = ws + WS_GA; const unsigned char* GB = ws + WS_GB; bf16_t* GS = (bf16_t*)(ws + WS_GS);
    LAS unsigned char* ring = (LAS unsigned char*)F.lds;
    const int np = (wave == 0) ? 0 : ((wave - 1 < 5) ? 2 : 1);
    auto issue = [&](int c) {
        const int cc = c < NCHUNK ? c : NCHUNK - 1;
        const size_t item = (size_t)cc * 8 + h;
        LAS unsigned char* slot = ring + (c % SC_D) * SC_SLOT;
#pragma unroll
        for (int i = 0; i < 2; ++i) if (i < np) {
            const int q = (wave - 1) + 7 * i;
            const unsigned char* src = (q < 8) ? GA + item * 8192 + q * 1024 : GB + item * 16384 + eslab * 4096 + (q - 8) * 1024;
            LAS unsigned char* dst = slot + ((q < 8) ? q * 1024 : 8192 + (q - 8) * 1024);
            __builtin_amdgcn_global_load_lds((const unsigned*)(src + lane * 16), (LAS unsigned*)dst, 16, 0, 0);
        }
    };
    for (int c = 0; c < SC_PD; ++c) issue(c);
    f32x4 S[4];
#pragma unroll
    for (int rb = 0; rb < 4; ++rb) S[rb] = (f32x4){0.f, 0.f, 0.f, 0.f};
#pragma unroll 1
    for (int c = 0; c < NCHUNK; ++c) {
        issue(c + SC_PD);
        if (np == 2) asm volatile("s_waitcnt vmcnt(12)" ::: "memory");
        else if (np == 1) asm volatile("s_waitcnt vmcnt(6)" ::: "memory");
        asm volatile("s_waitcnt lgkmcnt(0)" ::: "memory");
        __builtin_amdgcn_s_barrier();
        asm volatile("" ::: "memory");
        if (wave == 0) {
            const LAS unsigned char* slot = ring + (c % SC_D) * SC_SLOT;
            bf16x8 ac[8]; f32x4 bc[4];
#pragma unroll
            for (int q = 0; q < 8; ++q) ac[q] = *(const LAS bf16x8*)(slot + q * 1024 + lane * 16);
#pragma unroll
            for (int rb = 0; rb < 4; ++rb) bc[rb] = *(const LAS f32x4*)(slot + 8192 + rb * 1024 + lane * 16);
            const size_t item = (size_t)c * 8 + h;
            u32x4 p0, p1;
            p0.x = pk2(S[0][0], S[0][1]); p0.y = pk2(S[0][2], S[0][3]); p0.z = pk2(S[1][0], S[1][1]); p0.w = pk2(S[1][2], S[1][3]);
            p1.x = pk2(S[2][0], S[2][1]); p1.y = pk2(S[2][2], S[2][3]); p1.z = pk2(S[3][0], S[3][1]); p1.w = pk2(S[3][2], S[3][3]);
            {
                bf16_t* st = GS + item * 4096 + (16 * eslab + n) * 64 + 4 * g;
                *(u32x2*)(st + 0) = (u32x2){p0.x, p0.y}; *(u32x2*)(st + 16) = (u32x2){p0.z, p0.w};
                *(u32x2*)(st + 32) = (u32x2){p1.x, p1.y}; *(u32x2*)(st + 48) = (u32x2){p1.z, p1.w};
            }
            const bf16x8 b0 = __builtin_bit_cast(bf16x8, p0), b1 = __builtin_bit_cast(bf16x8, p1);
#pragma unroll
            for (int rb = 0; rb < 4; ++rb) {
                f32x4 acc = bc[rb];
                acc = mfma16(ac[rb * 2 + 0], b0, acc);
                acc = mfma16(ac[rb * 2 + 1], b1, acc);
                S[rb] = acc;
            }
        }
    }
    asm volatile("s_waitcnt vmcnt(0) lgkmcnt(0)" ::: "memory");
    __builtin_amdgcn_s_barrier();
}

DI void gdn_out_task(const Frame& F, const Args& A, int task) {
    unsigned char* ws = A.ws;
    const int ihalf = task & 1, item = (task >> 1) + 8, c = item >> 3, h = item & 7, lane = F.lane, r32 = lane & 31, hh = lane >> 5;
    const bf16_t* GQ = (const bf16_t*)(ws + WS_GQ) + (size_t)item * 4096; const bf16_t* GS = (const bf16_t*)(ws + WS_GS) + (size_t)item * 4096;
    const bf16_t* GO = (const bf16_t*)(ws + WS_GO) + (size_t)item * 4096;
    const bf16_t* Z = (const bf16_t*)(ws + WS_Z); bf16_t* MIX = (bf16_t*)(ws + WS_MIX);
    f32x16 acc[2];
#pragma unroll
    for (int eh = 0; eh < 2; ++eh)
#pragma unroll
        for (int r = 0; r < 16; ++r) acc[eh][r] = bf2f(GO[((ihalf * 2 + eh) * 16 + r) * 64 + lane]);
#pragma unroll
    for (int s = 0; s < 4; ++s) {
        const bf16x8 a = *(const bf16x8*)(GQ + (32 * ihalf + r32) * 64 + 16 * s + 8 * hh);
#pragma unroll
        for (int eh = 0; eh < 2; ++eh) {
            const bf16x8 b = *(const bf16x8*)(GS + (32 * eh + r32) * 64 + 16 * s + 8 * hh);
            acc[eh] = mfma32(a, b, acc[eh]);
        }
    }
    const float* gnorm = A.in[7];
    const float w0 = gnorm[r32], w1 = gnorm[32 + r32];
#pragma unroll
    for (int r = 0; r < 16; ++r) {
        float ss = acc[0][r] * acc[0][r] + acc[1][r] * acc[1][r];
        ss += __shfl_xor(ss, 1); ss += __shfl_xor(ss, 2); ss += __shfl_xor(ss, 4); ss += __shfl_xor(ss, 8); ss += __shfl_xor(ss, 16);
        const float rstd = 1.f / sqrtf(ss * (1.f / 64.f) + EPS);
        const int i = 32 * ihalf + crow(r, hh); const int p = 64 * c + i;
        const float z0 = bf2f(Z[(size_t)p * 512 + h * 64 + r32]), z1 = bf2f(Z[(size_t)p * 512 + h * 64 + 32 + r32]);
        bf16_t* o = MIX + (size_t)(p - 64) * 1024 + h * 64;
        o[r32] = (bf16_t)f2bf(acc[0][r] * rstd * w0 * siluf_(z0));
        o[32 + r32] = (bf16_t)f2bf(acc[1][r] * rstd * w1 * siluf_(z1));
    }
}

DI void mla_prep1_row(const Frame& F, const Args& A, int p) {
    unsigned char* ws = A.ws; const int lane = F.lane;
    const float* P32 = (const float*)(ws + WS_P32) + (size_t)p * 512;
    bf16_t* CQN = (bf16_t*)(ws + WS_CQN) + (size_t)p * 256; bf16_t* CKVN = (bf16_t*)(ws + WS_CKVN) + (size_t)p * 256;
    const f32x4 q = *(const f32x4*)(P32 + 4 * lane);
    const float sq = wave_sum((q.x * q.x + q.y * q.y) + (q.z * q.z + q.w * q.w));
    const float rq = 1.f / sqrtf(sq * (1.f / 256.f) + EPS);
    const f32x4 wq = *(const f32x4*)(A.in[8] + 4 * lane);
    *(u32x2*)(CQN + 4 * lane) = (u32x2){pk2(q.x * rq * wq.x, q.y * rq * wq.y), pk2(q.z * rq * wq.z, q.w * rq * wq.w)};
    const float k0 = P32[256 + 2 * lane], k1 = P32[256 + 2 * lane + 1];
    const float sk = wave_sum(k0 * k0 + k1 * k1);
    const float rk = 1.f / sqrtf(sk * (1.f / 128.f) + EPS);
    const float wk0 = A.in[9][2 * lane], wk1 = A.in[9][2 * lane + 1];
    *(unsigned*)(CKVN + 2 * lane) = pk2(k0 * rk * wk0, k1 * rk * wk1);
    *(unsigned*)(CKVN + 128 + 2 * lane) = 0u;
}

constexpr float QSCALE = 0.10206207261596577f * 1.4426950408889634f;
DI double rope_inv_rev(int i) {
    const double t8[8] = {0.15915494309189535, 0.08949940160889101, 0.050329212104487035, 0.0283021958306234, 0.015915494309189534, 0.008949940160889102, 0.005032921210448704, 0.00283021958306234};
    double v = t8[0];
#pragma unroll
    for (int k = 1; k < 8; ++k) v = ((i & 7) == k) ? t8[k] : v;
    return (i & 8) ? v * 0.01 : v;
}
DI void mla_prep2_row(const Frame& F, const Args& A, int p) {
    unsigned char* ws = A.ws; const int lane = F.lane, h = lane >> 3, s8 = lane & 7;
    bf16_t* Q = (bf16_t*)(ws + WS_Q) + ((size_t)h * KVROWS + p) * 96;
    bf16_t* K = (bf16_t*)(ws + WS_K) + ((size_t)h * KVROWS + p) * 96;
    bf16_t* VT = (bf16_t*)(ws + WS_VT) + (size_t)h * 64 * KVROWS + p;
    if (p < PADL || p >= LPV) {
#pragma unroll
        for (int m = 0; m < 12; ++m) { Q[s8 + 8 * m] = 0; K[s8 + 8 * m] = 0; }
#pragma unroll
        for (int m = 0; m < 8; ++m) VT[(size_t)(s8 + 8 * m) * KVROWS] = 0;
        return;
    }
    const bf16_t* QH = (const bf16_t*)(ws + WS_QH) + (size_t)p * 768 + h * 96;
    const bf16_t* KV = (const bf16_t*)(ws + WS_KVB) + (size_t)p * 1024 + h * 128;
    const float* kpe = (const float*)(ws + WS_P32) + (size_t)p * 512 + 384;
    const float* qn = A.in[12]; const float* kn = A.in[13];
    float q[12], k[12];
    float sq = 0.f, sk = 0.f;
#pragma unroll
    for (int m = 0; m < 12; ++m) { q[m] = bf2f(QH[s8 + 8 * m]); sq += q[m] * q[m]; }
#pragma unroll
    for (int m = 0; m < 8; ++m) k[m] = bf2f(KV[s8 + 8 * m]);
#pragma unroll
    for (int m = 8; m < 12; ++m) k[m] = kpe[s8 + 8 * (m - 8)];
#pragma unroll
    for (int m = 0; m < 12; ++m) sk += k[m] * k[m];
    sq += __shfl_xor(sq, 1); sq += __shfl_xor(sq, 2); sq += __shfl_xor(sq, 4);
    sk += __shfl_xor(sk, 1); sk += __shfl_xor(sk, 2); sk += __shfl_xor(sk, 4);
    const float rq = 1.f / sqrtf(sq * (1.f / 96.f) + EPS), rk = 1.f / sqrtf(sk * (1.f / 96.f) + EPS);
#pragma unroll
    for (int m = 0; m < 12; ++m) { q[m] *= rq * qn[s8 + 8 * m]; k[m] *= rk * kn[s8 + 8 * m]; }
    const double pos = (double)(p - PADL);
#pragma unroll
    for (int t = 0; t < 2; ++t) {
        const int i = s8 + 8 * t;
        const double rev = pos * rope_inv_rev(i);
        const float fr = (float)(rev - floor(rev));
        const float sn = __builtin_amdgcn_sinf(fr), cs = __builtin_amdgcn_cosf(fr);
        const float q1 = q[8 + t], q2 = q[10 + t]; q[8 + t] = q1 * cs - q2 * sn; q[10 + t] = q2 * cs + q1 * sn;
        const float k1 = k[8 + t], k2 = k[10 + t]; k[8 + t] = k1 * cs - k2 * sn; k[10 + t] = k2 * cs + k1 * sn;
    }
#pragma unroll
    for (int m = 0; m < 12; ++m) { Q[s8 + 8 * m] = (bf16_t)f2bf(q[m] * QSCALE); K[s8 + 8 * m] = (bf16_t)f2bf(k[m]); }
#pragma unroll
    for (int m = 0; m < 8; ++m) VT[(size_t)(s8 + 8 * m) * KVROWS] = KV[64 + s8 + 8 * m];
}

constexpr int A_KSTR = 208;
constexpr int A_VSTR = 136;
constexpr int A_KBYTES = 64 * A_KSTR;
constexpr int A_VBYTES = 64 * A_VSTR;
constexpr int A_BUF = A_KBYTES + A_VBYTES;
DI unsigned cvtpk_s(float lo, float hi) { typedef float f2 __attribute__((ext_vector_type(2))); typedef __bf16 b2 __attribute__((ext_vector_type(2))); f2 v = {lo, hi}; b2 b = __builtin_convertvector(v, b2); return __builtin_bit_cast(unsigned, b); }

DI void attn_item(const Frame& F, const Args& A, int h, int qb) {
    unsigned char* ws = A.ws; unsigned char* lds = F.lds;
    const int tid = F.tid, lane = F.lane, wave = F.wave, r32 = lane & 31, hh = lane >> 5;
    const bf16_t* Qg = (const bf16_t*)(ws + WS_Q) + (size_t)h * KVROWS * 96;
    const bf16_t* Kg = (const bf16_t*)(ws + WS_K) + (size_t)h * KVROWS * 96;
    const bf16_t* Vg = (const bf16_t*)(ws + WS_VT) + (size_t)h * 64 * KVROWS;
    const int p0w = 64 + 256 * qb + 32 * wave;
    const int qp = p0w + r32;
    const int ntile = 4 * qb + 5;
    const int mylast = 1 + 4 * qb + (wave >> 1);
    bf16x8 qf[6];
#pragma unroll
    for (int s = 0; s < 6; ++s) qf[s] = *(const bf16x8*)(Qg + (size_t)qp * 96 + 16 * s + 8 * hh);
    f32x16 ot[2]; ot[0] = zero16(); ot[1] = zero16();
    float mrun = -1e30f, lrun = 0.f;
    const int kr0 = tid / 12, kc0 = tid % 12, kr1 = (tid + 512) / 12, kc1 = (tid + 512) % 12; const bool k1ok = tid < 256;
    const int vr = tid >> 3, vc = tid & 7;
    u32x4 sk0, sk1, sv;
    auto gload = [&](int j) {
        const int kv0 = 64 * j;
        sk0 = *(const u32x4*)(Kg + (size_t)(kv0 + kr0) * 96 + kc0 * 8);
        if (k1ok) sk1 = *(const u32x4*)(Kg + (size_t)(kv0 + kr1) * 96 + kc1 * 8);
        sv = *(const u32x4*)(Vg + (size_t)vr * KVROWS + kv0 + vc * 8);
    };
    auto lstore = [&](int b) {
        unsigned char* kb = lds + b * A_BUF; unsigned char* vb = kb + A_KBYTES;
        *(u32x4*)(kb + kr0 * A_KSTR + kc0 * 16) = sk0;
        if (k1ok) *(u32x4*)(kb + kr1 * A_KSTR + kc1 * 16) = sk1;
        *(u32x2*)(vb + vr * A_VSTR + vc * 16) = (u32x2){sv.x, sv.y};
        *(u32x2*)(vb + vr * A_VSTR + vc * 16 + 8) = (u32x2){sv.z, sv.w};
    };
    gload(0); lstore(0);
    __syncthreads();
#pragma unroll 1
    for (int j = 0; j < ntile; ++j) {
        const int b = j & 1;
        if (j + 1 < ntile) gload(j + 1);
        if (j <= mylast) {
            const unsigned char* kb = lds + b * A_BUF; const unsigned char* vb = kb + A_KBYTES;
            f32x16 sc[2];
#pragma unroll
            for (int kh = 0; kh < 2; ++kh) {
                f32x16 acc = zero16();
                const unsigned char* kp = kb + (32 * kh + r32) * A_KSTR + hh * 16;
#pragma unroll
                for (int s = 0; s < 6; ++s) acc = mfma32(*(const bf16x8*)(kp + s * 32), qf[s], acc);
                sc[kh] = acc;
            }
            if (j == 0) {
#pragma unroll
                for (int kh = 0; kh < 2; ++kh)
#pragma unroll
                    for (int r = 0; r < 16; ++r) { const int kv = 32 * kh + crow(r, hh); if (kv < PADL) sc[kh][r] = -INFINITY; }
            }
            if (j == mylast) {
#pragma unroll
                for (int kh = 0; kh < 2; ++kh)
#pragma unroll
                    for (int r = 0; r < 16; ++r) { const int kv = 64 * j + 32 * kh + crow(r, hh); if (kv > qp) sc[kh][r] = -INFINITY; }
            }
            float mx = sc[0][0];
#pragma unroll
            for (int r = 1; r < 16; ++r) mx = fmaxf(mx, sc[0][r]);
#pragma unroll
            for (int r = 0; r < 16; ++r) mx = fmaxf(mx, sc[1][r]);
            mx = fmaxf(mx, __shfl_xor(mx, 32));
            const float mnew = fmaxf(mrun, mx);
            const float alpha = __builtin_amdgcn_exp2f(mrun - mnew);
            mrun = mnew;
            float ps = 0.f;
#pragma unroll
            for (int kh = 0; kh < 2; ++kh)
#pragma unroll
                for (int r = 0; r < 16; ++r) { const float e = __builtin_amdgcn_exp2f(sc[kh][r] - mnew); sc[kh][r] = e; ps += e; }
            lrun = lrun * alpha + ps;
#pragma unroll
            for (int eh = 0; eh < 2; ++eh)
#pragma unroll
                for (int r = 0; r < 16; ++r) ot[eh][r] *= alpha;
#pragma unroll
            for (int kh = 0; kh < 2; ++kh)
#pragma unroll
                for (int s2 = 0; s2 < 2; ++s2) {
                    u32x4 pw; pw.x = cvtpk_s(sc[kh][8 * s2 + 0], sc[kh][8 * s2 + 1]); pw.y = cvtpk_s(sc[kh][8 * s2 + 2], sc[kh][8 * s2 + 3]);
                    pw.z = cvtpk_s(sc[kh][8 * s2 + 4], sc[kh][8 * s2 + 5]); pw.w = cvtpk_s(sc[kh][8 * s2 + 6], sc[kh][8 * s2 + 7]);
                    const bf16x8 pf = __builtin_bit_cast(bf16x8, pw);
#pragma unroll
                    for (int eh = 0; eh < 2; ++eh) {
                        const unsigned char* vp = vb + (32 * eh + r32) * A_VSTR + (32 * kh + 16 * s2 + 4 * hh) * 2;
                        const u32x2 lo = *(const u32x2*)vp, hi2 = *(const u32x2*)(vp + 16);
                        const bf16x8 vf = __builtin_bit_cast(bf16x8, (u32x4){lo.x, lo.y, hi2.x, hi2.y});
                        ot[eh] = mfma32(vf, pf, ot[eh]);
                    }
                }
        }
        if (j + 1 < ntile) lstore(b ^ 1);
        __syncthreads();
    }
    const float ltot = lrun + __shfl_xor(lrun, 32);
    const float rl = 1.f / ltot;
    bf16_t* o = (bf16_t*)(ws + WS_MIX) + (size_t)(qp - 64) * 1024 + 512 + h * 64;
#pragma unroll
    for (int eh = 0; eh < 2; ++eh)
#pragma unroll
        for (int a = 0; a < 4; ++a) {
            const int e = 32 * eh + 8 * a + 4 * hh;
            *(u32x2*)(o + e) = (u32x2){pk2(ot[eh][4 * a] * rl, ot[eh][4 * a + 1] * rl), pk2(ot[eh][4 * a + 2] * rl, ot[eh][4 * a + 3] * rl)};
        }
}

DI void xn_row(const Frame& F, const Args& A, int u) {
    const f32x4* xr = (const f32x4*)(A.out + (size_t)u * DM) + F.lane;
    f32x4 v[4]; float s = 0.f;
#pragma unroll
    for (int j = 0; j < 4; ++j) { v[j] = xr[64 * j]; s += (v[j].x * v[j].x + v[j].y * v[j].y) + (v[j].z * v[j].z + v[j].w * v[j].w); }
    const float rstd = 1.f / sqrtf(wave_sum(s) * (1.f / DM) + EPS);
    unsigned long long* o8 = (unsigned long long*)((bf16_t*)(A.ws + WS_XN) + (size_t)u * DM) + F.lane;
#pragma unroll
    for (int j = 0; j < 4; ++j) { const f32x4 w = ((const f32x4*)A.in[15])[64 * j + F.lane];
        o8[64 * j] = (unsigned long long)pk2(v[j].x * rstd * w.x, v[j].y * rstd * w.y) | ((unsigned long long)pk2(v[j].z * rstd * w.z, v[j].w * rstd * w.w) << 32); }
}

DI unsigned fkey(float v, int idx) { unsigned u = __builtin_bit_cast(unsigned, v); u = (u & 0x80000000u) ? ~u : (u | 0x80000000u); return (u & ~127u) | (unsigned)(127 - idx); }
DI float keyval(unsigned k) { unsigned u = k & ~127u; u = (u & 0x80000000u) ? (u & 0x7fffffffu) : ~u; return __builtin_bit_cast(float, u); }

__device__ const unsigned char PAIR_A[50] = {0,0,0,0,0,0,0,0,0,0,0,0,0,0,0,0, 1,1,1,1,1,1,1,1, 2,2,2,2,2, 3,3,3,3, 4,4,4, 5,5, 6,6, 7,7, 8,9,10,11,12,13,14,15};
__device__ const unsigned char PAIR_B[50] = {0,1,2,3,4,5,6,7,8,9,10,11,12,13,14,15, 0,1,2,3,4,5,6,7, 0,1,2,3,4, 0,1,2,3, 0,1,2, 0,1, 0,1, 0,1, 0,0,0,0,0,0,0,0};

DI void ce_desc(unsigned& a, unsigned& b) { const unsigned mx = a > b ? a : b, mn = a > b ? b : a; a = mx; b = mn; }
template <int BASE, int NK> DI void bitonic_sort16_desc(unsigned (&x)[NK]) {
#pragma unroll
    for (int k = 2; k <= 16; k <<= 1)
#pragma unroll
        for (int j = k >> 1; j > 0; j >>= 1)
#pragma unroll
            for (int i = 0; i < 16; ++i) { const int l = i ^ j; if (l > i) { if ((i & k) == 0) ce_desc(x[BASE + i], x[BASE + l]); else ce_desc(x[BASE + l], x[BASE + i]); } }
}
template <int A0, int B0, int NK> DI void merge_top16(unsigned (&x)[NK]) {
#pragma unroll
    for (int i = 0; i < 16; ++i) { const unsigned p = x[A0 + i], q = x[B0 + 15 - i]; x[A0 + i] = p > q ? p : q; }
#pragma unroll
    for (int j = 8; j > 0; j >>= 1)
#pragma unroll
        for (int i = 0; i < 16; ++i) { const int l = i ^ j; if (l > i) ce_desc(x[A0 + i], x[A0 + l]); }
}
template <int NK> DI void top16_of_128(unsigned (&key)[NK]) {
    bitonic_sort16_desc<0, NK>(key); bitonic_sort16_desc<16, NK>(key); bitonic_sort16_desc<32, NK>(key); bitonic_sort16_desc<48, NK>(key);
    bitonic_sort16_desc<64, NK>(key); bitonic_sort16_desc<80, NK>(key); bitonic_sort16_desc<96, NK>(key); bitonic_sort16_desc<112, NK>(key);
    merge_top16<0, 16, NK>(key); merge_top16<32, 48, NK>(key); merge_top16<64, 80, NK>(key); merge_top16<96, 112, NK>(key);
    merge_top16<0, 32, NK>(key); merge_top16<64, 96, NK>(key);
    merge_top16<0, 64, NK>(key);
}

DI void topk_task(const Frame& F, const Args& A, int task) {
    unsigned char* ws = A.ws; const int tid = F.tid;
    const int u = task >> 3, h = task & 7;
    LAS unsigned* sk = (LAS unsigned*)(LAS unsigned char*)F.lds;
    LAS unsigned* pkk = sk + 16384;
    LAS float* stg = (LAS float*)(sk + 16384);
    const float* SCb = (const float*)(ws + WS_SC) + (size_t)(task & ~511) * 256;
#pragma unroll 1
    for (int half = 0; half < 2; ++half) {
        unsigned key[128];
#pragma unroll
        for (int qb = 0; qb < 4; ++qb) {
            u32x4 pf[8];
#pragma unroll
            for (int k = 0; k < 8; ++k) { const int c = tid + 512 * k; pf[k] = *(const u32x4*)(SCb + (size_t)(c >> 3) * 256 + half * 128 + qb * 32 + (c & 7) * 4); }
#pragma unroll
            for (int k = 0; k < 8; ++k) { const int c = tid + 512 * k; *(LAS u32x4*)(stg + (c >> 3) * 36 + (c & 7) * 4) = pf[k]; }
            __syncthreads();
#pragma unroll
            for (int i = 0; i < 8; ++i) { const f32x4 v = *(const LAS f32x4*)(stg + tid * 36 + 4 * i);
                key[32 * qb + 4 * i] = fkey(v.x, 32 * qb + 4 * i); key[32 * qb + 4 * i + 1] = fkey(v.y, 32 * qb + 4 * i + 1);
                key[32 * qb + 4 * i + 2] = fkey(v.z, 32 * qb + 4 * i + 2); key[32 * qb + 4 * i + 3] = fkey(v.w, 32 * qb + 4 * i + 3); }
            __syncthreads();
        }
        top16_of_128(key);
#pragma unroll
        for (int r = 0; r < 16; ++r) sk[(half * 16 + r) * 512 + tid] = key[r];
    }
    float v1[16], v2[16];
#pragma unroll
    for (int r = 0; r < 16; ++r) { v1[r] = keyval(sk[r * 512 + tid]); v2[r] = keyval(sk[(16 + r) * 512 + tid]); }
    unsigned ck[64];
#pragma unroll
    for (int c = 50; c < 64; ++c) ck[c] = 0u;
#pragma unroll
    for (int a = 0; a < 16; ++a) {
        const int off = a == 0 ? 0 : a == 1 ? 16 : a == 2 ? 24 : a == 3 ? 29 : a == 4 ? 33 : a == 5 ? 36 : a == 6 ? 38 : a == 7 ? 40 : 42 + (a - 8);
#pragma unroll
        for (int b = 0; b < 16; ++b) if ((a + 1) * (b + 1) <= 16) ck[off + b] = fkey(v1[a] + v2[b], off + b);
    }
    bitonic_sort16_desc<0, 64>(ck); bitonic_sort16_desc<16, 64>(ck); bitonic_sort16_desc<32, 64>(ck); bitonic_sort16_desc<48, 64>(ck);
    merge_top16<0, 16, 64>(ck); merge_top16<32, 48, 64>(ck); merge_top16<0, 32, 64>(ck);
#pragma unroll
    for (int r = 0; r < 16; ++r) pkk[r * 512 + tid] = ck[r];
    const float cmax = keyval(pkk[tid]);
    float ev[16]; float esum = 0.f; int ex[16];
#pragma unroll
    for (int r = 0; r < 16; ++r) {
        const unsigned k = pkk[r * 512 + tid]; const int c = 127 - (int)(k & 127u);
        ev[r] = __expf(keyval(k) - cmax); esum += ev[r];
        const int a = PAIR_A[c], b = PAIR_B[c];
        const int i1 = 127 - (int)(sk[a * 512 + tid] & 127u), i2 = 127 - (int)(sk[(16 + b) * 512 + tid] & 127u);
        ex[r] = i1 * 128 + i2;
    }
    const float rs = 1.f / esum;
    int* IDX = (int*)(ws + WS_IDX) + (size_t)u * 128 + h * 16; float* GATE = (float*)(ws + WS_GATE) + (size_t)u * 128 + h * 16;
#pragma unroll
    for (int r = 0; r < 16; r += 4) {
        *(int4*)(IDX + r) = make_int4(ex[r], ex[r + 1], ex[r + 2], ex[r + 3]);
        *(f32x4*)(GATE + r) = (f32x4){ev[r] * rs, ev[r + 1] * rs, ev[r + 2] * rs, ev[r + 3] * rs};
    }
}

constexpr float EU_SCALE = 64.f, EV_SCALE = 16.f;
DI unsigned pk4_fp8(float a, float b, float c, float d) { int w = 0; w = __builtin_amdgcn_cvt_pk_fp8_f32(a, b, w, false); w = __builtin_amdgcn_cvt_pk_fp8_f32(c, d, w, true); return (unsigned)w; }
DI void convert_tables(const Frame& F, const Args& A) {
    const size_t n16 = (size_t)16384 * 1024 / 16;
    const size_t gt = (size_t)blockIdx.x * 512 + F.tid, NGT = (size_t)F.G * 512;
#pragma unroll 1
    for (int t = 0; t < 2; ++t) {
        const float* src = A.in[18 + t]; unsigned char* dst = A.ws + (t ? WS_EV : WS_EU); const float sc = t ? EV_SCALE : EU_SCALE;
        for (size_t i = gt; i < n16; i += NGT) {
            const f32x4 a = *(const f32x4*)(src + i * 16) * sc, b = *(const f32x4*)(src + i * 16 + 4) * sc, c = *(const f32x4*)(src + i * 16 + 8) * sc, d = *(const f32x4*)(src + i * 16 + 12) * sc;
            const size_t e_ = i >> 6, c16_ = i & 63;
            *(u32x4*)(dst + (c16_ >> 3) * ((size_t)16384 * 128) + e_ * 128 + (c16_ & 7) * 16) = (u32x4){pk4_fp8(a.x, a.y, a.z, a.w), pk4_fp8(b.x, b.y, b.z, b.w), pk4_fp8(c.x, c.y, c.z, c.w), pk4_fp8(d.x, d.y, d.z, d.w)};
        }
    }
}

DI float gelu_exact(float x) { return 0.5f * x * (1.f + erff(x * 0.70710678118654752f)); }
typedef float f32x2 __attribute__((ext_vector_type(2)));
#define UNPK16(dst, W_) do { f32x2 _t; \
    _t = __builtin_amdgcn_cvt_pk_f32_fp8((int)(W_).x, false); dst[0] = _t.x; dst[1] = _t.y; _t = __builtin_amdgcn_cvt_pk_f32_fp8((int)(W_).x, true); dst[2] = _t.x; dst[3] = _t.y; \
    _t = __builtin_amdgcn_cvt_pk_f32_fp8((int)(W_).y, false); dst[4] = _t.x; dst[5] = _t.y; _t = __builtin_amdgcn_cvt_pk_f32_fp8((int)(W_).y, true); dst[6] = _t.x; dst[7] = _t.y; \
    _t = __builtin_amdgcn_cvt_pk_f32_fp8((int)(W_).z, false); dst[8] = _t.x; dst[9] = _t.y; _t = __builtin_amdgcn_cvt_pk_f32_fp8((int)(W_).z, true); dst[10] = _t.x; dst[11] = _t.y; \
    _t = __builtin_amdgcn_cvt_pk_f32_fp8((int)(W_).w, false); dst[12] = _t.x; dst[13] = _t.y; _t = __builtin_amdgcn_cvt_pk_f32_fp8((int)(W_).w, true); dst[14] = _t.x; dst[15] = _t.y; } while (0)

template <bool UPH>
DI void expert_phase(const Frame& F, const Args& A, int xv, int wq, int nw) {
    unsigned char* ws = A.ws; const int lane = F.lane, grp = lane >> 3, j = lane & 7;
    const unsigned char* TBL = ws + (UPH ? WS_EU : WS_EV) + (size_t)xv * ((size_t)16384 * 128) + 16 * j;
    const int* IDX = (const int*)(ws + WS_IDX); const float* CW = (const float*)(ws + WS_CW);
    const bf16_t* XN = (const bf16_t*)(ws + WS_XN) + 128 * xv + 16 * j;
    float* HP = (float*)(ws + WS_HP);
    LAS unsigned* ring = (LAS unsigned*)((LAS unsigned char*)F.lds + F.wave * 4096);
    const int nt = (MU - wq + nw - 1) / nw;
    if (nt <= 0) return;
    auto tok = [&](int k) { return __builtin_amdgcn_readfirstlane(wq + (k < nt ? k : nt - 1) * nw); };
    int mi0, mi1; u32x4 mx0, mx1; float mh0, mh1;
    auto meta_load = [&](int k) {
        const int u = tok(k);
        mi0 = IDX[(size_t)u * 128 + lane]; mi1 = IDX[(size_t)u * 128 + 64 + lane];
        if constexpr (UPH) { mx0 = *(const u32x4*)(XN + (size_t)u * DM); mx1 = *(const u32x4*)(XN + (size_t)u * DM + 8); }
        else { mh0 = CW[(size_t)u * 128 + lane]; mh1 = CW[(size_t)u * 128 + 64 + lane]; }
    };
    auto meta_store = [&](int k) {
        LAS unsigned* sl = ring + (k & 3) * 256;
        sl[lane] = (unsigned)mi0; sl[64 + lane] = (unsigned)mi1;
        if constexpr (UPH) { if (grp == 0) { *(LAS u32x4*)(sl + 128 + 8 * j) = mx0; *(LAS u32x4*)(sl + 128 + 8 * j + 4) = mx1; } }
        else { sl[128 + lane] = __builtin_bit_cast(unsigned, mh0); sl[192 + lane] = __builtin_bit_cast(unsigned, mh1); }
    };
    auto gather = [&](u32x4 (&buf)[8], int n) {
        const LAS unsigned* sl = ring + ((n >> 1) & 3) * 256 + 64 * (n & 1) + grp;
#pragma unroll
        for (int i = 0; i < 8; ++i) { const int e = (int)sl[8 * i]; buf[i] = *(const u32x4*)(TBL + (size_t)e * 128); }
    };
    const int ocol = 128 * xv + 16 * j + ((lane & 32) ? 8 : 0) + ((lane & 16) ? 4 : 0) + ((lane & 8) ? 2 : 0);
    f32x2 ocur = (f32x2){0.f, 0.f};
    float acc[16];
    float xn[16];
    auto compute = [&](u32x4 (&buf)[8], int n) {
        const int k = n >> 1, hf = n & 1;
        const LAS unsigned* sl = ring + (k & 3) * 256;
        if (hf == 0) {
            if constexpr (UPH) {
                const u32x4 x0 = *(const LAS u32x4*)(sl + 128 + 8 * j), x1 = *(const LAS u32x4*)(sl + 128 + 8 * j + 4);
                xn[0] = bflo(x0.x); xn[1] = bfhi(x0.x); xn[2] = bflo(x0.y); xn[3] = bfhi(x0.y); xn[4] = bflo(x0.z); xn[5] = bfhi(x0.z); xn[6] = bflo(x0.w); xn[7] = bfhi(x0.w);
                xn[8] = bflo(x1.x); xn[9] = bfhi(x1.x); xn[10] = bflo(x1.y); xn[11] = bfhi(x1.y); xn[12] = bflo(x1.z); xn[13] = bfhi(x1.z); xn[14] = bflo(x1.w); xn[15] = bfhi(x1.w);
            } else {
#pragma unroll
                for (int c = 0; c < 16; ++c) acc[c] = 0.f;
                ocur = *(const f32x2*)(A.out + (size_t)tok(k) * DM + ocol);
            }
        }
#pragma unroll
        for (int i = 0; i < 8; ++i) {
            float f[16]; UNPK16(f, buf[i]);
            if constexpr (UPH) {
                float a0 = 0.f, a1 = 0.f;
#pragma unroll
                for (int c = 0; c < 16; c += 2) { a0 += f[c] * xn[c]; a1 += f[c + 1] * xn[c + 1]; }
                if (hf == 0) acc[i] = a0 + a1; else acc[8 + i] = a0 + a1;
                if (i < 7) { if (hf == 0) asm volatile("" : "+v"(buf[i + 1].x), "+v"(buf[i + 1].y), "+v"(buf[i + 1].z), "+v"(buf[i + 1].w), "+v"(acc[i]));
                             else asm volatile("" : "+v"(buf[i + 1].x), "+v"(buf[i + 1].y), "+v"(buf[i + 1].z), "+v"(buf[i + 1].w), "+v"(acc[8 + i])); }
            } else {
                const float cw = __builtin_bit_cast(float, sl[128 + 64 * hf + 8 * i + grp]);
#pragma unroll
                for (int c = 0; c < 16; ++c) acc[c] += cw * f[c];
                if (i < 7) asm volatile("" : "+v"(buf[i + 1].x), "+v"(buf[i + 1].y), "+v"(buf[i + 1].z), "+v"(buf[i + 1].w),
                                             "+v"(acc[0]), "+v"(acc[1]), "+v"(acc[2]), "+v"(acc[3]), "+v"(acc[4]), "+v"(acc[5]), "+v"(acc[6]), "+v"(acc[7]),
                                             "+v"(acc[8]), "+v"(acc[9]), "+v"(acc[10]), "+v"(acc[11]), "+v"(acc[12]), "+v"(acc[13]), "+v"(acc[14]), "+v"(acc[15]));
            }
            __builtin_amdgcn_sched_barrier(0);
        }
        if (hf == 1 && k < nt) {
            const int u = tok(k);
            float r8[8], r4[4], r2[2];
            if constexpr (UPH) {
                { const bool up = lane & 4;
#pragma unroll
                  for (int i = 0; i < 8; ++i) { const float send = up ? acc[i] : acc[i + 8], keep = up ? acc[i + 8] : acc[i]; r8[i] = keep + __shfl_xor(send, 4); } }
                { const bool up = lane & 2;
#pragma unroll
                  for (int i = 0; i < 4; ++i) { const float send = up ? r8[i] : r8[i + 4], keep = up ? r8[i + 4] : r8[i]; r4[i] = keep + __shfl_xor(send, 2); } }
                { const bool up = lane & 1;
#pragma unroll
                  for (int i = 0; i < 2; ++i) { const float send = up ? r4[i] : r4[i + 2], keep = up ? r4[i + 2] : r4[i]; r2[i] = keep + __shfl_xor(send, 1); } }
                const int st = ((lane & 4) ? 8 : 0) + ((lane & 2) ? 4 : 0) + ((lane & 1) ? 2 : 0);
                float* hp = HP + ((size_t)xv * MU + u) * 128 + grp;
                hp[8 * st] = r2[0]; hp[8 * (st + 1)] = r2[1];
            } else {
                { const bool up = lane & 32;
#pragma unroll
                  for (int c = 0; c < 8; ++c) { const float send = up ? acc[c] : acc[c + 8], keep = up ? acc[c + 8] : acc[c]; r8[c] = keep + __shfl_xor(send, 32); } }
                { const bool up = lane & 16;
#pragma unroll
                  for (int c = 0; c < 4; ++c) { const float send = up ? r8[c] : r8[c + 4], keep = up ? r8[c + 4] : r8[c]; r4[c] = keep + __shfl_xor(send, 16); } }
                { const bool up = lane & 8;
#pragma unroll
                  for (int c = 0; c < 2; ++c) { const float send = up ? r4[c] : r4[c + 2], keep = up ? r4[c + 2] : r4[c]; r2[c] = keep + __shfl_xor(send, 8); } }
                f32x2* o = (f32x2*)(A.out + (size_t)u * DM + ocol);
                f32x2 cur = ocur; cur.x += r2[0]; cur.y += r2[1]; *o = cur;
            }
        }
    };
    meta_load(0); meta_store(0); meta_load(1); meta_store(1); meta_load(2); meta_store(2);
    u32x4 b0[8], b1[8], b2[8];
    gather(b0, 0); gather(b1, 1); gather(b2, 2);
#pragma unroll 1
    for (int k0 = 0; k0 < nt; k0 += 3) {
        const int n0 = 2 * k0;
        meta_load(k0 + 3);
        compute(b0, n0);     gather(b0, n0 + 3);
        compute(b1, n0 + 1); meta_store(k0 + 3); gather(b1, n0 + 4);
        meta_load(k0 + 4);
        compute(b2, n0 + 2); gather(b2, n0 + 5);
        compute(b0, n0 + 3); meta_store(k0 + 4); gather(b0, n0 + 6);
        meta_load(k0 + 5);
        compute(b1, n0 + 4); gather(b1, n0 + 7);
        compute(b2, n0 + 5); meta_store(k0 + 5); gather(b2, n0 + 8);
    }
}


DI void expert_c_pass(const Frame& F, const Args& A) {
    unsigned char* ws = A.ws;
    const float* HP = (const float*)(ws + WS_HP); const float* GATE = (const float*)(ws + WS_GATE); float* CW = (float*)(ws + WS_CW);
    const size_t n4 = (size_t)MU * 128 / 4;
    for (size_t i = (size_t)blockIdx.x * 512 + F.tid; i < n4; i += (size_t)F.G * 512) {
        f32x4 h = *(const f32x4*)(HP + i * 4);
#pragma unroll
        for (int x = 1; x < 8; ++x) h += *(const f32x4*)(HP + (size_t)x * MU * 128 + i * 4);
        const f32x4 g = *(const f32x4*)(GATE + i * 4);
        f32x4 c;
        c.x = gelu_exact(h.x * (1.f / EU_SCALE)) * g.x * (1.f / EV_SCALE); c.y = gelu_exact(h.y * (1.f / EU_SCALE)) * g.y * (1.f / EV_SCALE);
        c.z = gelu_exact(h.z * (1.f / EU_SCALE)) * g.z * (1.f / EV_SCALE); c.w = gelu_exact(h.w * (1.f / EU_SCALE)) * g.w * (1.f / EV_SCALE);
        *(f32x4*)(CW + i * 4) = c;
    }
}
template <int PH> DI void run_phase(const Frame& F, const Args& args, PG8_LAS unsigned char* lds3) {
    unsigned char* ws = args.ws;
    if constexpr (PH == 0) { p0_prologue(F, args); }
    if constexpr (PH == 1) {
        pg8::Gemm g{(const bf16_t*)(ws + WS_HN), (const bf16_t*)(ws + WS_WIN), MP, NPROJ, 1024, 1024, 1024, 0};
        pg8::StaticOrder S; S.init(MP, NPROJ, F.G, (int)blockIdx.x);
        EpiProj E{(bf16_t*)(ws + WS_QKVR), (bf16_t*)(ws + WS_Z), (float*)(ws + WS_P32)};
        pg8::gemm_phase<EpiProj, pg8::StaticOrder, true, true>(lds3, g, S, E);
    }
    if constexpr (PH == 2) { gdn_prep_phase(F, args); }
    if constexpr (PH == 3) { gdn_scan(F, args); }
    if constexpr (PH == 4) {
        for (int t = F.gw; t < 2048 * 2; t += F.NGW) gdn_out_task(F, args, t);
        for (int p = F.gw; p < MP; p += F.NGW) mla_prep1_row(F, args, p);
    }
    if constexpr (PH == 5) {
        { pg8::Gemm g{(const bf16_t*)(ws + WS_CQN), (const bf16_t*)(ws + WS_WUQ), MP, 768, 256, 256, 256, 0};
          pg8::StaticOrder S; S.init(MP, 768, F.G, (int)blockIdx.x); EpiB16 E{(bf16_t*)(ws + WS_QH), 768};
          pg8::gemm_phase<EpiB16, pg8::StaticOrder, true, true>(lds3, g, S, E); }
        { pg8::Gemm g{(const bf16_t*)(ws + WS_CKVN), (const bf16_t*)(ws + WS_WUKV), MP, 1024, 256, 256, 256, 0};
          pg8::StaticOrder S; S.init(MP, 1024, F.G, (int)blockIdx.x); EpiB16 E{(bf16_t*)(ws + WS_KVB), 1024};
          pg8::gemm_phase<EpiB16, pg8::StaticOrder, true, true>(lds3, g, S, E); }
    }
    if constexpr (PH == 6) { for (int p = F.gw; p < KVROWS; p += F.NGW) mla_prep2_row(F, args, p); }
    if constexpr (PH == 7) {
        for (int rep = 0; rep < 2; ++rep) {
            for (int k0 = blockIdx.x; k0 < 256; k0 += F.G) {
                const int k = rep == 0 ? k0 : 511 - k0;
                attn_item(F, args, k & 7, 63 - (k >> 3));
            }
        }
    }
    if constexpr (PH == 8) {
        pg8::Gemm g{(const bf16_t*)(ws + WS_MIX), (const bf16_t*)(ws + WS_WOUT), MU, 1024, 1024, 1024, 1024, 0};
        pg8::StaticOrder S; S.init(MU, 1024, F.G, (int)blockIdx.x); EpiF32 E{args.out, 1024, args.in[0]};
        pg8::gemm_phase<EpiF32, pg8::StaticOrder, true, true>(lds3, g, S, E);
    }
    if constexpr (PH == 9) { for (int u = F.gw; u < MU; u += F.NGW) xn_row(F, args, u); }
    if constexpr (PH == 10) {
        pg8::Gemm g{(const bf16_t*)(ws + WS_XN), (const bf16_t*)(ws + WS_WPQ), MU, 2048, 1024, 1024, 1024, 0};
        pg8::StaticOrder S; S.init(MU, 2048, F.G, (int)blockIdx.x); EpiB16 E{(bf16_t*)(ws + WS_PQ), 2048};
        pg8::gemm_phase<EpiB16, pg8::StaticOrder, true, true>(lds3, g, S, E);
    }
    if constexpr (PH == 11) {
        pg8::Gemm g{(const bf16_t*)(ws + WS_PQ), (const bf16_t*)(ws + WS_SKB), MU, 2048, 256, 2048, 256, 256};
        pg8::StaticOrder S; S.init(MU, 2048, F.G, (int)blockIdx.x); EpiF32 E{(float*)(ws + WS_SC), 2048, nullptr};
        pg8::gemm_phase<EpiF32, pg8::StaticOrder, true, true>(lds3, g, S, E);
    }
    if constexpr (PH == 12) {
        convert_tables(F, args);
        for (int t = blockIdx.x * 512 + F.tid; t < MU * 8; t += F.G * 512) topk_task(F, args, t);
    }
    if constexpr (PH == 14) { expert_c_pass(F, args); }
    if constexpr (PH == 13 || PH == 15) {
        volatile LAS unsigned* MISC = (volatile LAS unsigned*)(lds3 + MISC_OFF);
        const unsigned x = MISC[16], rank = MISC[17];
        unsigned* bar = (unsigned*)(ws + WS_CTL);
        unsigned nloc = 0, nx = 0, myidx = 0;
#pragma unroll
        for (unsigned j = 0; j < 16; ++j) { const unsigned c = xb_ld(&bar[XB_XCNT(j)]); nx += (c > 0u) ? 1u : 0u; myidx += (c > 0u && j < x) ? 1u : 0u; nloc = (j == x) ? c : nloc; }
        const int wq = __builtin_amdgcn_readfirstlane((int)rank * 8 + F.wave), nw = __builtin_amdgcn_readfirstlane((int)nloc * 8);
        const int xstep = __builtin_amdgcn_readfirstlane((int)nx);
        for (int xv = __builtin_amdgcn_readfirstlane((int)myidx); xv < 8; xv += xstep)
            { if constexpr (PH == 13) expert_phase<true>(F, args, xv, wq, nw); else expert_phase<false>(F, args, xv, wq, nw); }
    }
}
constexpr int NPHASE = 16;
__global__ void __launch_bounds__(512, 2) fwd_kernel(Args args) {
    extern __shared__ __attribute__((aligned(16))) unsigned char lds[];
    Frame F;
    F.lds = lds; F.tid = threadIdx.x; F.lane = F.tid & 63; F.wave = __builtin_amdgcn_readfirstlane(F.tid >> 6);
    F.G = gridDim.x; F.gw = blockIdx.x * 8 + F.wave; F.NGW = F.G * 8;
    volatile LAS unsigned* MISC = (volatile LAS unsigned*)((LAS unsigned char*)lds + MISC_OFF);
    if (F.tid < 32) MISC[F.tid] = 0u;
    __syncthreads();
    unsigned char* ws = args.ws;
    const int lo = args.ph_lo, hi = args.ph_hi;
    XcdBarrier bar; bar.bar = (unsigned*)(ws + WS_CTL); bar.x = 0; bar.st = nullptr;
    if (hi - lo > 1) bar = xcd_barrier_post((unsigned*)(ws + WS_CTL), MISC + 8);
    if (F.tid == 0) { const unsigned x = xb_xcc_id(); MISC[16] = x; MISC[17] = xb_add((unsigned*)(ws + WS_CTL) + 3520 + 64 * x, 1u); }
    __syncthreads();
#define IN(k) (lo <= (k) && (k) < hi)
#define SEAM(k) do { if (IN(k) && IN((k) + 1)) xcd_barrier(bar); } while (0)
    PG8_LAS unsigned char* lds3 = (PG8_LAS unsigned char*)lds;

#ifndef PROBE_REPEAT
#define PROBE_REPEAT -1
#endif
#define PHASE(k) do { if (IN(k)) { run_phase<k>(F, args, lds3); if (PROBE_REPEAT == (k)) { xcd_barrier(bar); run_phase<k>(F, args, lds3); } } SEAM(k); } while (0)
    PHASE(0); PHASE(1); PHASE(2); PHASE(3); PHASE(4); PHASE(5); PHASE(6); PHASE(7); PHASE(8); PHASE(9); PHASE(10); PHASE(11); PHASE(12); PHASE(13); PHASE(14); PHASE(15);
#undef PHASE
#undef IN
#undef SEAM
}

#ifndef N_LAUNCHES
#define N_LAUNCHES 1
#endif
extern "C" void kernel_launch(void* const* d_in, const int* in_sizes, int n_in, void* d_out, int out_size, void* d_ws, size_t ws_size, hipStream_t stream) {
    static int grid = 0;
    if (grid == 0) {
        if (n_in != 20 || out_size != MU * DM || ws_size < WS_END) { fprintf(stderr, "kernel_launch: unexpected shapes (n_in %d out %d ws %zu)\n", n_in, out_size, ws_size); grid = -1; return; }
        int dev = 0, cus = 0, per_cu = 0;
        if (hipGetDevice(&dev) != hipSuccess || hipDeviceGetAttribute(&cus, hipDeviceAttributeMultiprocessorCount, dev) != hipSuccess) { grid = -1; return; }
        if (hipFuncSetAttribute((const void*)fwd_kernel, hipFuncAttributeMaxDynamicSharedMemorySize, LDS_BYTES) != hipSuccess) { fprintf(stderr, "kernel_launch: hipFuncSetAttribute failed\n"); grid = -1; return; }
        if (hipOccupancyMaxActiveBlocksPerMultiprocessor(&per_cu, (const void*)fwd_kernel, 512, LDS_BYTES) != hipSuccess || per_cu < 1) { fprintf(stderr, "kernel_launch: occupancy query says %d\n", per_cu); (void)hipGetLastError(); per_cu = 1; }
        grid = cus;
    }
    if (grid < 0) return;
    (void)hipMemsetAsync((char*)d_ws + WS_CTL, 0, CTL_ZERO_BYTES, stream);
    Args a{};
    for (int i = 0; i < 20; ++i) a.in[i] = (const float*)d_in[i];
    a.out = (float*)d_out; a.ws = (unsigned char*)d_ws;
    for (int li = 0; li < N_LAUNCHES; ++li) {
        a.ph_lo = li * NPHASE / N_LAUNCHES; a.ph_hi = (li + 1) * NPHASE / N_LAUNCHES;
        if (N_LAUNCHES == 1) {
            void* kargs[] = {&a};
            hipError_t e = hipLaunchCooperativeKernel((const void*)fwd_kernel, dim3(grid), dim3(512), kargs, LDS_BYTES, stream);
            if (e != hipSuccess) fprintf(stderr, "cooperative launch failed: %s (grid %d)\n", hipGetErrorString(e), grid);
        } else {
            hipLaunchKernelGGL(fwd_kernel, dim3(grid), dim3(512), LDS_BYTES, stream, a);
        }
    }
}
```

```cpp
#include <hip/hip_runtime.h>
#include <hip/hip_bf16.h>
#include <cstdio>
#include <cstdint>

#define DI __device__ __forceinline__
#define LAS __attribute__((address_space(3)))
#define GAS __attribute__((address_space(1)))

typedef unsigned short bf16_t;
typedef short bf16x8 __attribute__((ext_vector_type(8)));
typedef short s16x4 __attribute__((ext_vector_type(4)));
typedef float f32x4 __attribute__((ext_vector_type(4)));
typedef float f32x16 __attribute__((ext_vector_type(16)));
typedef unsigned u32x4 __attribute__((ext_vector_type(4)));
typedef unsigned u32x2 __attribute__((ext_vector_type(2)));

namespace pg8 {
#define PG8_LAS __attribute__((address_space(3)))
constexpr int BM = 256, BK = 64, HALF = 128, HTB = HALF * BK * 2  , STAGE_BYTES = 8 * HTB, NXCD = 8, WGM = 8;

__host__ __device__ __forceinline__ int lds_byte(int r, int c) { const int st = (r >> 4) * 2 + (c >> 5), rr = r & 15, cc = c & 31, ob = rr * 64 + cc * 2; return st * 1024 + (ob ^ (((ob >> 9) & 1) << 5)); }
__host__ __device__ __forceinline__ void stage_rc(int b, int& R, int& C) { const int st = b / 1024, sb = b % 1024, swz = sb ^ (((sb >> 9) & 1) << 5); R = (st >> 1) * 16 + swz / 64; C = (st & 1) * 32 + (swz % 64) / 2; }
__host__ __device__ __forceinline__ int perm32(int rho) { const int n = rho >> 4, i = rho & 15; return 8 * (i >> 2) + 4 * n + (i & 3); }

struct Unit { int pm, pn; };
struct Gemm { const bf16_t* A; const bf16_t* Bt; int M, N, K, lda, ldb, a_pn_off; };

struct StaticOrder {
    int nM, nN, nwg, G, c;
    __host__ __device__ void init(int M, int N, int G_, int c_) { nM = M / BM; nN = N / BM; nwg = nM * nN; G = G_; c = c_; }
    __host__ __device__ bool next(int i, Unit& u) const {
        const long L = (long)i * G + c; if (L >= nwg) return false;
        int wgid = (int)L; { const int q = nwg / NXCD, r = nwg % NXCD, xcd = wgid % NXCD, off = wgid / NXCD; wgid = (xcd < r ? xcd * (q + 1) : r * (q + 1) + (xcd - r) * q) + off; }
        const int nig = WGM * nN, gid = wgid / nig, fm = gid * WGM, gsz = (nM - fm) < WGM ? (nM - fm) : WGM;
        u.pm = fm + ((wgid % nig) % gsz); u.pn = (wgid % nig) / gsz; return true;
    }
    __device__ __forceinline__ void a_ready(const Unit&) const {}
    __device__ __forceinline__ void done(const Unit&) const {}
};

__device__ __forceinline__ unsigned cvt_pk_bf16(float lo, float hi) { unsigned r; asm volatile("v_cvt_pk_bf16_f32 %0, %1, %2" : "=v"(r) : "v"(lo), "v"(hi)); return r; }

template <class Epi, class Sched, bool ALIGN_EPI = false, bool SP2 = false>
__device__ __forceinline__ void gemm_phase(PG8_LAS unsigned char* lds, const Gemm g, const Sched& S, const Epi& E) {
    const int tid = threadIdx.x, wid = __builtin_amdgcn_readfirstlane(tid >> 6), lane = tid & 63, wr = wid >> 2, wc = wid & 3, fr = lane & 15, fq = lane >> 4;
    const int K = g.K, nt = K / BK;
    unsigned voffA[2], voffB[2];
#pragma unroll
    for (int i = 0; i < 2; ++i) { int R, C; stage_rc(tid * 16 + i * 8192, R, C); const int Rb = Epi::PERM ? ((R & ~31) + perm32(R & 31)) : R;
        voffA[i] = (unsigned)(R * g.lda + C) * 2u; voffB[i] = (unsigned)(Rb * g.ldb + C) * 2u; }
    const size_t kstep = (size_t)(BK * 2);
    const size_t hstepA = (size_t)HALF * g.lda * 2, hstepB = (size_t)HALF * g.ldb * 2;
    const size_t tstepA = 2 * hstepA, tstepB = 2 * hstepB;
    const size_t pnoffA = (size_t)g.a_pn_off * 2;
    const unsigned ldsw = (unsigned)wid * 1024u;
    const int aoff = lds_byte(wr * 64 + fr, fq * 8), boff = lds_byte(wc * 32 + fr, fq * 8);
#define PG8_SA(b, h) (((b) * 2 + (h)) * HTB)
#define PG8_SB(b, h) ((4 + (b) * 2 + (h)) * HTB)
#define PG8_STAGE(bufoff, gbase, voff) do { _Pragma("unroll") for (int _i = 0; _i < 2; ++_i) \
        __builtin_amdgcn_global_load_lds((const unsigned*)((const char*)(gbase) + (voff)[_i]), (PG8_LAS unsigned*)(lds + (bufoff) + ldsw + _i * 8192), 16, 0, 0); } while (0)
#define PG8_LDA(dst, b, h) do { _Pragma("unroll") for (int m = 0; m < 4; ++m) _Pragma("unroll") for (int k = 0; k < 2; ++k) dst[m][k] = *(const PG8_LAS bf16x8*)(lds + PG8_SA(b, h) + aoff + m * 2048 + k * 1024); } while (0)
#define PG8_LDB(dst, b, h) do { _Pragma("unroll") for (int n = 0; n < 2; ++n) _Pragma("unroll") for (int k = 0; k < 2; ++k) dst[n][k] = *(const PG8_LAS bf16x8*)(lds + PG8_SB(b, h) + boff + n * 2048 + k * 1024); } while (0)
#define PG8_MMA(ai, bj, At, Bt) do { __builtin_amdgcn_s_setprio(1); _Pragma("unroll") for (int m = 0; m < 4; ++m) _Pragma("unroll") for (int n = 0; n < 2; ++n) _Pragma("unroll") for (int k = 0; k < 2; ++k) \
        acc[ai][bj][m][n] = __builtin_amdgcn_mfma_f32_16x16x32_bf16(Bt[n][k], At[m][k], acc[ai][bj][m][n], 0, 0, 0); __builtin_amdgcn_s_setprio(0); } while (0)
#define PG8_WAIT_V(n) asm volatile("s_waitcnt vmcnt(" #n ")" ::: "memory")
#define PG8_WAIT_L(n) asm volatile("s_waitcnt lgkmcnt(" #n ")" ::: "memory")
#define PG8_BAR __builtin_amdgcn_s_barrier()
#define PG8_SCHED __builtin_amdgcn_sched_barrier(0)
    Unit cur, nxt; int ui = 0;
    if (!S.next(0, cur)) return;
    f32x4 acc[2][2][4][2];
#pragma unroll
    for (int a = 0; a < 2; ++a)
#pragma unroll
        for (int b = 0; b < 2; ++b)
#pragma unroll
            for (int m = 0; m < 4; ++m)
#pragma unroll
                for (int n = 0; n < 2; ++n) acc[a][b][m][n] = (f32x4){0.f, 0.f, 0.f, 0.f};
    bf16x8 At[4][2], B0[2][2], B1[2][2];
    const char* cA = (const char*)g.A + (size_t)cur.pm * tstepA + (size_t)cur.pn * pnoffA; const char* cB = (const char*)g.Bt + (size_t)cur.pn * tstepB;
    S.a_ready(cur);
    if constexpr (SP2) {
        PG8_STAGE(PG8_SB(0, 0), cB, voffB); PG8_STAGE(PG8_SB(0, 1), cB + hstepB, voffB); PG8_STAGE(PG8_SA(0, 0), cA, voffA); PG8_STAGE(PG8_SA(0, 1), cA + hstepA, voffA);
        if (wr == 1) PG8_BAR;
        PG8_WAIT_V(2); PG8_BAR;
        PG8_STAGE(PG8_SB(1, 0), cB + kstep, voffB); PG8_STAGE(PG8_SA(1, 0), cA + kstep, voffA); PG8_STAGE(PG8_SB(1, 1), cB + hstepB + kstep, voffB);
        PG8_WAIT_V(6); PG8_BAR;
    } else {
        PG8_STAGE(PG8_SB(0, 0), cB, voffB); PG8_STAGE(PG8_SA(0, 0), cA, voffA); PG8_STAGE(PG8_SB(0, 1), cB + hstepB, voffB); PG8_STAGE(PG8_SA(0, 1), cA + hstepA, voffA);
        if (wr == 1) PG8_BAR;
        PG8_WAIT_V(4); PG8_BAR;
        PG8_STAGE(PG8_SB(1, 0), cB + kstep, voffB); PG8_STAGE(PG8_SA(1, 0), cA + kstep, voffA); PG8_STAGE(PG8_SB(1, 1), cB + hstepB + kstep, voffB);
        PG8_WAIT_V(6); PG8_BAR;
    }
    for (;;) {
        const bool has_next = S.next(ui + 1, nxt);
        const char* nA = has_next ? (const char*)g.A + (size_t)nxt.pm * tstepA + (size_t)nxt.pn * pnoffA : cA; const char* nB = has_next ? (const char*)g.Bt + (size_t)nxt.pn * tstepB : cB;
        for (int t = 0; t < nt; t += 2) {
            const bool last = (t == nt - 2);
            const char* a1 = cA + (size_t)(t + 1) * kstep;
            const char* a2 = last ? nA : cA + (size_t)(t + 2) * kstep; const char* b2 = last ? nB : cB + (size_t)(t + 2) * kstep;
            const char* a3 = a2 + kstep; const char* b3 = b2 + kstep;
            if (last && has_next) S.a_ready(nxt);
            if constexpr (SP2) {
            PG8_LDB(B0, 0, 0); PG8_LDB(B1, 0, 1); PG8_SCHED; PG8_LDA(At, 0, 0); PG8_STAGE(PG8_SA(1, 1), a1 + hstepA, voffA);
            PG8_WAIT_V(8); PG8_WAIT_L(0); PG8_BAR; PG8_MMA(0, 0, At, B0); PG8_MMA(0, 1, At, B1); PG8_BAR; PG8_SCHED;
            PG8_LDA(At, 0, 1); PG8_STAGE(PG8_SB(0, 0), b2, voffB); PG8_STAGE(PG8_SB(0, 1), b2 + hstepB, voffB); PG8_STAGE(PG8_SA(0, 0), a2, voffA);
            PG8_WAIT_V(8); PG8_WAIT_L(0); PG8_BAR; PG8_MMA(1, 0, At, B0); PG8_MMA(1, 1, At, B1); PG8_BAR; PG8_SCHED;
            PG8_LDB(B0, 1, 0); PG8_LDB(B1, 1, 1); PG8_SCHED; PG8_LDA(At, 1, 0); PG8_STAGE(PG8_SA(0, 1), a2 + hstepA, voffA);
            PG8_WAIT_V(8); PG8_WAIT_L(0); PG8_BAR; PG8_MMA(0, 0, At, B0); PG8_MMA(0, 1, At, B1); PG8_BAR; PG8_SCHED;
            PG8_LDA(At, 1, 1); PG8_STAGE(PG8_SB(1, 0), b3, voffB); PG8_STAGE(PG8_SB(1, 1), b3 + hstepB, voffB); PG8_STAGE(PG8_SA(1, 0), a3, voffA);
            PG8_WAIT_V(8); PG8_WAIT_L(0); PG8_BAR; PG8_MMA(1, 0, At, B0); PG8_MMA(1, 1, At, B1); PG8_BAR; PG8_SCHED;
            } else {
            PG8_LDB(B0, 0, 0); PG8_SCHED; PG8_LDA(At, 0, 0); PG8_STAGE(PG8_SA(1, 1), a1 + hstepA, voffA);
            PG8_WAIT_L(8); PG8_BAR; PG8_WAIT_L(0); PG8_MMA(0, 0, At, B0); PG8_BAR; PG8_SCHED;
            PG8_LDB(B1, 0, 1); PG8_STAGE(PG8_SB(0, 0), b2, voffB);
            PG8_BAR; PG8_WAIT_L(0); PG8_MMA(0, 1, At, B1); PG8_BAR;
            PG8_LDA(At, 0, 1); PG8_STAGE(PG8_SA(0, 0), a2, voffA);
            PG8_BAR; PG8_WAIT_L(0); PG8_MMA(1, 0, At, B0); PG8_BAR; PG8_SCHED;
            PG8_STAGE(PG8_SB(0, 1), b2 + hstepB, voffB);
            PG8_WAIT_V(6); PG8_BAR; PG8_MMA(1, 1, At, B1); PG8_BAR;
            PG8_LDB(B0, 1, 0); PG8_SCHED; PG8_LDA(At, 1, 0); PG8_STAGE(PG8_SA(0, 1), a2 + hstepA, voffA);
            PG8_WAIT_L(8); PG8_BAR; PG8_WAIT_L(0); PG8_MMA(0, 0, At, B0); PG8_BAR; PG8_SCHED;
            PG8_LDB(B1, 1, 1); PG8_STAGE(PG8_SB(1, 0), b3, voffB);
            PG8_BAR; PG8_WAIT_L(0); PG8_MMA(0, 1, At, B1); PG8_BAR;
            PG8_LDA(At, 1, 1); PG8_STAGE(PG8_SA(1, 0), a3, voffA);
            PG8_BAR; PG8_WAIT_L(0); PG8_MMA(1, 0, At, B0); PG8_BAR; PG8_SCHED;
            PG8_STAGE(PG8_SB(1, 1), b3 + hstepB, voffB);
            PG8_WAIT_V(6); PG8_BAR; PG8_MMA(1, 1, At, B1); PG8_BAR;
            }
        }
        if constexpr (ALIGN_EPI) { if (wr == 0) PG8_BAR; }
        E(acc, cur, wr, wc, fr, fq); S.done(cur);
        if (!has_next) break;
#pragma unroll
        for (int a = 0; a < 2; ++a)
#pragma unroll
            for (int b = 0; b < 2; ++b)
#pragma unroll
                for (int m = 0; m < 4; ++m)
#pragma unroll
                    for (int n = 0; n < 2; ++n) acc[a][b][m][n] = (f32x4){0.f, 0.f, 0.f, 0.f};
        cur = nxt; cA = nA; cB = nB; ++ui;
        if constexpr (ALIGN_EPI) { if (wr == 1) PG8_BAR; }
    }
    PG8_WAIT_V(0);
    if constexpr (!ALIGN_EPI) { if (wr == 0) PG8_BAR; }
    PG8_BAR;
#undef PG8_SA
#undef PG8_SB
#undef PG8_STAGE
#undef PG8_LDA
#undef PG8_LDB
#undef PG8_MMA
#undef PG8_WAIT_V
#undef PG8_WAIT_L
#undef PG8_BAR
#undef PG8_SCHED
}
}

constexpr int DM = 1024;
constexpr int NTOK = 16400;
constexpr int PADL = 48;
constexpr int LPV = 16448;
constexpr int MP = 16640;
constexpr int MU = 16384;
constexpr int NCHUNK = 257;
constexpr int NHEAD = 8;
constexpr int NPROJ = 2560;
constexpr int KVROWS = 16512;
constexpr float EPS = 1e-6f;

constexpr size_t MiB = 1u << 20;
constexpr size_t WS_CTL = 0, CTL_ZERO_BYTES = 64 * 1024;
constexpr size_t WS_WIN = 1 * MiB;
constexpr size_t WS_WUQ = 6 * MiB;
constexpr size_t WS_WUKV = 6 * MiB + 512 * 1024;
constexpr size_t WS_WOUT = 7 * MiB;
constexpr size_t WS_WPQ = 9 * MiB;
constexpr size_t WS_SKB = 13 * MiB;
constexpr size_t WS_IDX = 16 * MiB;
constexpr size_t WS_GATE = 24 * MiB;
constexpr size_t WS_HN = 32 * MiB;
constexpr size_t WS_QKVR = 96 * MiB;
constexpr size_t WS_Z = 96 * MiB + 49 * MiB;
constexpr size_t WS_P32 = 162 * MiB;
constexpr size_t WS_GA = 195 * MiB;
constexpr size_t WS_GQ = 212 * MiB;
constexpr size_t WS_GS = 229 * MiB;
constexpr size_t WS_GB = 32 * MiB;
constexpr size_t WS_GO = 65 * MiB;
constexpr size_t WS_MIX = 96 * MiB;
constexpr size_t WS_CQN = 128 * MiB;
constexpr size_t WS_CKVN = 136 * MiB + 512 * 1024;
constexpr size_t WS_QH = 32 * MiB;
constexpr size_t WS_KVB = 57 * MiB;
constexpr size_t WS_Q = 195 * MiB;
constexpr size_t WS_K = 220 * MiB;
constexpr size_t WS_VT = 145 * MiB;
constexpr size_t WS_XN = 32 * MiB;
constexpr size_t WS_PQ = 64 * MiB;
constexpr size_t WS_SC = 128 * MiB;
constexpr size_t WS_EU = 96 * MiB;
constexpr size_t WS_EV = 112 * MiB;
constexpr size_t WS_CW = 64 * MiB;
constexpr size_t WS_HP = 128 * MiB;
constexpr size_t WS_END = 256 * MiB;

constexpr int LDS_BYTES = 147456;
constexpr int MISC_OFF = 131072 + 12288;

DI unsigned f2bf(float f) { unsigned u = __builtin_bit_cast(unsigned, f); return (u + 0x7fffu + ((u >> 16) & 1u)) >> 16; }
DI unsigned pk2(float lo, float hi) { return f2bf(lo) | (f2bf(hi) << 16); }
DI float bf2f(unsigned b) { return __builtin_bit_cast(float, b << 16); }
DI float bflo(unsigned w) { return __builtin_bit_cast(float, w << 16); }
DI float bfhi(unsigned w) { return __builtin_bit_cast(float, w & 0xffff0000u); }
DI float wave_sum(float v) {
#pragma unroll
    for (int o = 1; o < 64; o <<= 1) v += __shfl_xor(v, o);
    return v;
}
DI float sigmoidf_(float x) { return 1.f / (1.f + __expf(-x)); }
DI float siluf_(float x) { return x / (1.f + __expf(-x)); }

#define XB_TMO      128
#define XB_XCNT(j)  (256  + 64 * (j))
#define XB_XSUB(j)  (1280 + 64 * (j))
#define XB_XGEN(j)  (2304 + 64 * (j))
#define XB_TOP      3328
#define XB_TOPGEN   3392
#define XCD_BAR_WORDS 3456
#define XB_SPIN_CAP (1u << 22)
DI unsigned xb_ld(unsigned* p)              { return __hip_atomic_load(p, __ATOMIC_RELAXED, __HIP_MEMORY_SCOPE_AGENT); }
DI unsigned xb_add(unsigned* p, unsigned v) { return __hip_atomic_fetch_add(p, v, __ATOMIC_RELAXED, __HIP_MEMORY_SCOPE_AGENT); }
DI unsigned xb_xcc_id() { return (unsigned)__builtin_amdgcn_s_getreg((3 << 11) | 20) & 0xFu; }
#define XB_SPIN(cond, bar) do { unsigned _sp = 0; while (cond) { __builtin_amdgcn_s_sleep(1); \
    if ((++_sp & 255u) == 0u) { if (xb_ld(&(bar)[XB_TMO])) break; if (_sp > XB_SPIN_CAP) { atomicAdd(&(bar)[XB_TMO], 1u); break; } } } } while (0)
struct XcdBarrier { unsigned* bar; unsigned x; volatile LAS unsigned* st; };
DI XcdBarrier xcd_barrier_post(unsigned* bar, volatile LAS unsigned* st) {
    XcdBarrier b; b.bar = bar; b.x = xb_xcc_id(); b.st = st;
    if (threadIdx.x == 0) (void)xb_add(&bar[XB_XCNT(b.x)], 1u);
    return b;
}
DI void xcd_barrier_complete(unsigned* bar, unsigned x, unsigned& nloc, unsigned& nx) {
    const unsigned G = gridDim.x * gridDim.y * gridDim.z;
    unsigned sum, cnt, mine, sp = 0u;
    for (;;) {
        sum = 0u; cnt = 0u; mine = 0u;
#pragma unroll
        for (unsigned j = 0; j < 16; ++j) { const unsigned c = xb_ld(&bar[XB_XCNT(j)]); sum += c; cnt += (c > 0u) ? 1u : 0u; mine = (j == x) ? c : mine; }
        if (sum == G) break;
        __builtin_amdgcn_s_sleep(1);
        if ((++sp & 255u) == 0u) { if (xb_ld(&bar[XB_TMO])) break; if (sp > XB_SPIN_CAP) { atomicAdd(&bar[XB_TMO], 1u); break; } }
    }
    nloc = mine > 0u ? mine : 1u; nx = cnt > 0u ? cnt : 1u;
}
DI void xcd_barrier(const XcdBarrier& b) {
    asm volatile("s_waitcnt vmcnt(0)" ::: "memory");
    __syncthreads();
    if (threadIdx.x == 0) {
        unsigned* bar = b.bar;
        __builtin_amdgcn_s_waitcnt(0);
        unsigned nloc = b.st[0], nx = b.st[1];
        if (nloc == 0u) { xcd_barrier_complete(bar, b.x, nloc, nx); b.st[0] = nloc; b.st[1] = nx; }
        const unsigned old = xb_add(&bar[XB_XSUB(b.x)], 1u);
        const unsigned gen = old / nloc;
        if (old + 1u == (gen + 1u) * nloc) {
            __builtin_amdgcn_fence(__ATOMIC_RELEASE, "agent");
            asm volatile("s_waitcnt vmcnt(0)" ::: "memory");
            const unsigned og = xb_add(&bar[XB_TOP], 1u);
            const unsigned tg = og / nx;
            if (og + 1u == (tg + 1u) * nx) xb_add(&bar[XB_TOPGEN], 1u);
            else XB_SPIN(xb_ld(&bar[XB_TOPGEN]) == tg, bar);
            __builtin_amdgcn_fence(__ATOMIC_ACQUIRE, "agent");
            xb_add(&bar[XB_XGEN(b.x)], 1u);
            asm volatile("s_waitcnt vmcnt(0)" ::: "memory");
        } else {
            XB_SPIN(xb_ld(&bar[XB_XGEN(b.x)]) == gen, bar);
            __builtin_amdgcn_fence(__ATOMIC_ACQUIRE, "agent");
            asm volatile("s_waitcnt vmcnt(0)" ::: "memory");
        }
    }
    __syncthreads();
}

struct Args {
    const float* in[20];
    float* out; unsigned char* ws;
    int ph_lo, ph_hi;
};
struct Frame {
    unsigned char* lds;
    int tid, lane, wave, G, gw, NGW;
};

template <class Map>
DI void transpose_item(const float* __restrict__ W, int Nsrc, bf16_t* __restrict__ WT, int ldk, float* scr, int item, int nblk, int lane, Map srcmap) {
    const int kb = item / nblk, nb = item % nblk, k0 = 64 * kb, n0 = 32 * nb;
    const int ns = srcmap(n0 + (lane & 31));
#pragma unroll 8
    for (int i = 0; i < 32; ++i) { const int kk = 2 * i + (lane >> 5); scr[kk * 33 + (lane & 31)] = (ns >= 0) ? W[(size_t)(k0 + kk) * Nsrc + ns] : 0.f; }
    __builtin_amdgcn_s_waitcnt(0); __builtin_amdgcn_wave_barrier();
    const int c = lane & 7;
#pragma unroll
    for (int j = 0; j < 4; ++j) { const int n = (lane >> 3) + 8 * j; const float* s = scr + (8 * c) * 33 + n;
        u32x4 o; o.x = pk2(s[0 * 33], s[1 * 33]); o.y = pk2(s[2 * 33], s[3 * 33]); o.z = pk2(s[4 * 33], s[5 * 33]); o.w = pk2(s[6 * 33], s[7 * 33]);
        *(u32x4*)(WT + (size_t)(n0 + n) * ldk + k0 + 8 * c) = o; }
    __builtin_amdgcn_s_waitcnt(0); __builtin_amdgcn_wave_barrier();
}
struct MapId { DI int operator()(int n) const { return n; } };
struct MapWin {
    DI int operator()(int n) const {
        if (n < 2048) return n;
        if (n < 2304) return n + 16;
        if (n < 2432) return n + 16;
        if (n < 2464) return n + 16;
        if (n < 2472) return n - 416;
        if (n < 2480) return n - 416;
        return -1;
    }
};

DI void p0_prologue(const Frame& F, const Args& A) {
    unsigned char* ws = A.ws;
    float* scr = (float*)(F.lds + F.wave * 16384);
    const float* w_in = A.in[3]; const float* w_uq = A.in[10]; const float* w_ukv = A.in[11]; const float* w_out = A.in[14]; const float* w_pq = A.in[16]; const float* sub_keys = A.in[17];
    constexpr int I_IN = 16 * 80, I_UQ = 4 * 24, I_UKV = 2 * 32, I_OUT = 16 * 32, I_PQ = 16 * 64;
    constexpr int NITEMS = I_IN + I_UQ + I_UKV + I_OUT + I_PQ;
    for (int it = F.gw; it < NITEMS; it += F.NGW) {
        int r = it;
        if (r < I_IN) { transpose_item(w_in, 2480, (bf16_t*)(ws + WS_WIN), 1024, scr, r, 80, F.lane, MapWin()); continue; } r -= I_IN;
        if (r < I_UQ) { transpose_item(w_uq, 768, (bf16_t*)(ws + WS_WUQ), 256, scr, r, 24, F.lane, MapId()); continue; } r -= I_UQ;
        if (r < I_UKV) { transpose_item(w_ukv, 1024, (bf16_t*)(ws + WS_WUKV), 256, scr, r, 32, F.lane, MapId()); continue; } r -= I_UKV;
        if (r < I_OUT) { transpose_item(w_out, 1024, (bf16_t*)(ws + WS_WOUT), 1024, scr, r, 32, F.lane, MapId()); continue; } r -= I_OUT;
        transpose_item(w_pq, 2048, (bf16_t*)(ws + WS_WPQ), 1024, scr, r, 64, F.lane, MapId());
    }
    const int gt = blockIdx.x * 512 + F.tid, NGT = F.G * 512;
    for (int i = gt; i < 1024 * 16; i += NGT) { const int n = i >> 4, c = i & 15; *(u32x4*)((bf16_t*)(ws + WS_WUKV) + (size_t)n * 256 + 128 + c * 8) = (u32x4){0u, 0u, 0u, 0u}; }
    for (int i = gt; i < 2048 * 32; i += NGT) {
        const int n = i >> 5, c8 = (i & 31) * 8; const int p = (n >> 7) & 1;
        u32x4 o = (u32x4){0u, 0u, 0u, 0u};
        if ((c8 >> 7) == p) { const float* s = sub_keys + (size_t)n * 128 + (c8 & 127); const f32x4 a = *(const f32x4*)s, b = *(const f32x4*)(s + 4);
            o.x = pk2(a.x, a.y); o.y = pk2(a.z, a.w); o.z = pk2(b.x, b.y); o.w = pk2(b.z, b.w); }
        *(u32x4*)((bf16_t*)(ws + WS_SKB) + (size_t)n * 256 + c8) = o;
    }
    const float* x = A.in[0]; const float* meta = A.in[1]; const float* anorm = A.in[2];
    bf16_t* HN = (bf16_t*)(ws + WS_HN);
    for (int p = F.gw; p < MP; p += F.NGW) {
        unsigned long long* o8 = (unsigned long long*)(HN + (size_t)p * DM) + F.lane;
        const int t = p - PADL;
        if (t < 0 || t >= NTOK) {
#pragma unroll
            for (int j = 0; j < 4; ++j) o8[64 * j] = 0ull;
            continue;
        }
        const float* src = (t < 16) ? meta + (size_t)t * DM : x + (size_t)(t - 16) * DM;
        const f32x4* xr = (const f32x4*)src + F.lane;
        f32x4 v[4]; float s = 0.f;
#pragma unroll
        for (int j = 0; j < 4; ++j) { v[j] = xr[64 * j]; s += (v[j].x * v[j].x + v[j].y * v[j].y) + (v[j].z * v[j].z + v[j].w * v[j].w); }
        const float rstd = 1.f / sqrtf(wave_sum(s) * (1.f / DM) + EPS);
#pragma unroll
        for (int j = 0; j < 4; ++j) { const f32x4 w = ((const f32x4*)anorm)[64 * j + F.lane];
            o8[64 * j] = (unsigned long long)pk2(v[j].x * rstd * w.x, v[j].y * rstd * w.y) | ((unsigned long long)pk2(v[j].z * rstd * w.z, v[j].w * rstd * w.w) << 32); }
    }
}

struct EpiProj {
    static constexpr bool PERM = true;
    bf16_t* QKVR; bf16_t* Z; float* P32;
    DI void operator()(const f32x4 (&acc)[2][2][4][2], const pg8::Unit& u, int wr, int wc, int fr, int fq) const {
        const int row0 = u.pm * 256 + wr * 64 + fr;
        if (u.pn < 8) {
            bf16_t* base; int ld, colt;
            if (u.pn < 6) { base = QKVR; ld = 1536; colt = u.pn * 256; } else { base = Z; ld = 512; colt = (u.pn - 6) * 256; }
            const int col0 = colt + wc * 32 + 8 * fq;
#pragma unroll
            for (int ai = 0; ai < 2; ++ai)
#pragma unroll
                for (int m = 0; m < 4; ++m) { bf16_t* rowp = base + (size_t)(row0 + ai * 128 + m * 16) * ld + col0;
#pragma unroll
                    for (int bj = 0; bj < 2; ++bj) { const f32x4 v0 = acc[ai][bj][m][0], v1 = acc[ai][bj][m][1];
                        u32x4 w; w.x = pg8::cvt_pk_bf16(v0[0], v0[1]); w.y = pg8::cvt_pk_bf16(v0[2], v0[3]); w.z = pg8::cvt_pk_bf16(v1[0], v1[1]); w.w = pg8::cvt_pk_bf16(v1[2], v1[3]);
                        *(u32x4*)(rowp + bj * 128) = w; } }
        } else {
            const int col0 = (u.pn - 8) * 256 + wc * 32 + 8 * fq;
#pragma unroll
            for (int ai = 0; ai < 2; ++ai)
#pragma unroll
                for (int m = 0; m < 4; ++m) { float* rowp = P32 + (size_t)(row0 + ai * 128 + m * 16) * 512 + col0;
#pragma unroll
                    for (int bj = 0; bj < 2; ++bj) { *(f32x4*)(rowp + bj * 128) = acc[ai][bj][m][0]; *(f32x4*)(rowp + bj * 128 + 4) = acc[ai][bj][m][1]; } }
        }
    }
};
struct EpiB16 {
    static constexpr bool PERM = true;
    bf16_t* O; int ldc;
    DI void operator()(const f32x4 (&acc)[2][2][4][2], const pg8::Unit& u, int wr, int wc, int fr, int fq) const {
        const int row0 = u.pm * 256 + wr * 64 + fr, col0 = u.pn * 256 + wc * 32 + 8 * fq;
#pragma unroll
        for (int ai = 0; ai < 2; ++ai)
#pragma unroll
            for (int m = 0; m < 4; ++m) { bf16_t* rowp = O + (size_t)(row0 + ai * 128 + m * 16) * ldc + col0;
#pragma unroll
                for (int bj = 0; bj < 2; ++bj) { const f32x4 v0 = acc[ai][bj][m][0], v1 = acc[ai][bj][m][1];
                    u32x4 w; w.x = pg8::cvt_pk_bf16(v0[0], v0[1]); w.y = pg8::cvt_pk_bf16(v0[2], v0[3]); w.z = pg8::cvt_pk_bf16(v1[0], v1[1]); w.w = pg8::cvt_pk_bf16(v1[2], v1[3]);
                    *(u32x4*)(rowp + bj * 128) = w; } }
    }
};
struct EpiF32 {
    static constexpr bool PERM = true;
    float* C; int ldc; const float* res;
    DI void operator()(const f32x4 (&acc)[2][2][4][2], const pg8::Unit& u, int wr, int wc, int fr, int fq) const {
        const int row0 = u.pm * 256 + wr * 64 + fr, col0 = u.pn * 256 + wc * 32 + 8 * fq;
#pragma unroll
        for (int ai = 0; ai < 2; ++ai)
#pragma unroll
            for (int m = 0; m < 4; ++m) { const size_t off = (size_t)(row0 + ai * 128 + m * 16) * ldc + col0;
#pragma unroll
                for (int bj = 0; bj < 2; ++bj) { f32x4 v0 = acc[ai][bj][m][0], v1 = acc[ai][bj][m][1];
                    if (res) { v0 += *(const f32x4*)(res + off + bj * 128); v1 += *(const f32x4*)(res + off + bj * 128 + 4); }
                    *(f32x4*)(C + off + bj * 128) = v0; *(f32x4*)(C + off + bj * 128 + 4) = v1; } }
    }
};

DI f32x16 mfma32(bf16x8 a, bf16x8 b, f32x16 c) { return __builtin_amdgcn_mfma_f32_32x32x16_bf16(a, b, c, 0, 0, 0); }
DI f32x4 mfma16(bf16x8 a, bf16x8 b, f32x4 c) { return __builtin_amdgcn_mfma_f32_16x16x32_bf16(a, b, c, 0, 0, 0); }
DI int crow(int r, int hi) { return (r & 3) + 8 * (r >> 2) + 4 * hi; }
DI f32x16 zero16() { f32x16 z;
#pragma unroll
    for (int i = 0; i < 16; ++i) z[i] = 0.f; return z; }

constexpr int G_KF = 0, G_VF = 16384, G_MF = 32768;
constexpr int G_QB = 50176, G_KB = 59392, G_KBB = 68608;
constexpr int G_QKB = 77824, G_UT = 87040, G_WT = 96256, G_KDT = 105472;
constexpr int G_VEC = 114688;
constexpr int G_RAW = G_QKB;
constexpr int GST = 72;

DI f32x16 mm_quad(const unsigned char* A, const unsigned char* Bt, int qr, int qc, int lane) {
    const int r32 = lane & 31, hh = lane >> 5;
    const unsigned char* ap = A + (32 * qr + r32) * (GST * 2) + hh * 16;
    const unsigned char* bp = Bt + (32 * qc + r32) * (GST * 2) + hh * 16;
    f32x16 acc = zero16();
#pragma unroll
    for (int s = 0; s < 4; ++s) acc = mfma32(*(const bf16x8*)(ap + s * 32), *(const bf16x8*)(bp + s * 32), acc);
    return acc;
}

constexpr int G_RAW2 = 115712;
static_assert(G_RAW2 + 67 * 400 <= 143360, "GDN prep LDS map");
constexpr int G_CONVW = 143360 + 512;

#ifndef PROBE_STAGE
#define PROBE_STAGE -1
#endif
template <int VAR> DI void gdn_prep_phase(const Frame& F, const Args& A) {
    unsigned long long stg_t = 0ull, stg_acc = 0ull;
#define STG(n) do { if (PROBE_STAGE >= 0) { const unsigned long long now_ = __builtin_amdgcn_s_memrealtime(); if (PROBE_STAGE == (n)) stg_acc += now_ - stg_t; stg_t = now_; } } while (0)
    unsigned char* ws = A.ws; unsigned char* lds = F.lds;
    const int tid = F.tid, lane = F.lane, wave = F.wave;
    const bf16_t* QKVR = (const bf16_t*)(ws + WS_QKVR); const float* P32 = (const float*)(ws + WS_P32);
    float* KF = (float*)(lds + G_KF); float* VF = (float*)(lds + G_VF); float* MF = (float*)(lds + G_MF);
    float* VEC = (float*)(lds + G_VEC);
    if (VAR == 6) return;
    const int NIT = NCHUNK * 8;
#define LBAR() do { asm volatile("s_waitcnt lgkmcnt(0)" ::: "memory"); __builtin_amdgcn_s_barrier(); asm volatile("" ::: "memory"); } while (0)
#define LAUNDER(dst, src) int dst = (src); asm volatile("" : "+v"(dst))
    int item = blockIdx.x;
    if (item >= NIT) return;
    u32x4 pr[4]; float nb = 0.f, na = 0.f;
    auto raw_fetch = [&](int it) {
        const int c = it >> 3, h = it & 7; LAUNDER(tl, tid);
#pragma unroll
        for (int i = 0; i < 4; ++i) { const int q = tl + 512 * i; pr[i] = (u32x4){0u, 0u, 0u, 0u};
            if (q < 67 * 24) { const int r = q / 24, cc = q % 24, seg = cc >> 3, c8 = cc & 7; const int p = 64 * c - 3 + r;
                if (p >= 0) pr[i] = *(const u32x4*)(QKVR + (size_t)p * 1536 + seg * 512 + h * 64 + c8 * 8); } }
        if (wave == 0) { const int p = 64 * c + lane; nb = P32[(size_t)p * 512 + 416 + h]; na = P32[(size_t)p * 512 + 424 + h]; }
    };
    auto raw_park = [&]() {
        LAUNDER(tl, tid);
#pragma unroll
        for (int i = 0; i < 4; ++i) { const int q = tl + 512 * i;
            if (q < 67 * 24) { const int r = q / 24, cc = q % 24, seg = cc >> 3, c8 = cc & 7; *(u32x4*)(lds + G_RAW2 + r * 400 + (seg * 64 + c8 * 8) * 2) = pr[i]; } }
    };
    raw_fetch(item); raw_park();
    float cb = nb, ca = na;
    float* CWL = (float*)(lds + G_CONVW);
    int cw_h = -1;
#pragma unroll 1
    for (; item < NIT; item += F.G) {
        if (PROBE_STAGE >= 0 && stg_t == 0ull) stg_t = __builtin_amdgcn_s_memrealtime();
        const int c = item >> 3, h = item & 7;
        if (h != cw_h) { cw_h = h;
            if (tid < 192) { LAUNDER(t0, tid); const int sg = t0 >> 6, jt = (t0 >> 4) & 3, c4 = t0 & 15; *(f32x4*)(CWL + (sg * 4 + jt) * 64 + 4 * c4) = *(const f32x4*)(A.in[4] + jt * 1536 + sg * 512 + h * 64 + 4 * c4); } }
        const int nxt = item + F.G;
        if (VAR != 5 && nxt < NIT) raw_fetch(nxt);
        if (wave == 0) {
            const int p = 64 * c + lane;
            const float alog = A.in[5][h], dtb = A.in[6][h];
            float beta = sigmoidf_(cb);
            const float xx = ca + dtb; const float sp = xx > 20.f ? xx : log1pf(__expf(xx));
            float g = -__expf(alog) * sp;
            if (p < PADL) { beta = 0.f; g = 0.f; }
            float gc = g;
#pragma unroll
            for (int o = 1; o < 64; o <<= 1) { const float t = __shfl_up(gc, o); if (lane >= o) gc += t; }
            const float glast = __shfl(gc, 63);
            VEC[lane] = gc; VEC[64 + lane] = beta; VEC[128 + lane] = __expf(gc); VEC[192 + lane] = __expf(glast - gc);
        }
        LBAR(); STG(0);
        LAUNDER(t1, tid); const int sub = t1 & 15, grp = t1 >> 4;
#pragma unroll
        for (int sg = 0; sg < ((VAR == 2 || VAR >= 4) ? 0 : 3); ++sg) {
#pragma unroll 1
            for (int ps = 0; ps < 2; ++ps) {
                const int i = grp + 32 * ps;
                float acc[4] = {0.f, 0.f, 0.f, 0.f};
#pragma unroll
                for (int jt = 0; jt < 4; ++jt) {
                    const f32x4 w = *(const f32x4*)(CWL + (sg * 4 + jt) * 64 + 4 * sub);
                    const u32x2 rv = *(const u32x2*)(lds + G_RAW2 + (i + jt) * 400 + (sg * 64 + 4 * sub) * 2);
                    acc[0] += w.x * bflo(rv.x); acc[1] += w.y * bfhi(rv.x); acc[2] += w.z * bflo(rv.y); acc[3] += w.w * bfhi(rv.y);
                }
                float y[4];
#pragma unroll
                for (int k = 0; k < 4; ++k) y[k] = siluf_(acc[k]);
                if (sg < 2) {
                    float ss = (y[0] * y[0] + y[1] * y[1]) + (y[2] * y[2] + y[3] * y[3]);
                    ss += __shfl_xor(ss, 1); ss += __shfl_xor(ss, 2); ss += __shfl_xor(ss, 4); ss += __shfl_xor(ss, 8);
                    const float rn = 1.f / sqrtf(ss + EPS);
#pragma unroll
                    for (int k = 0; k < 4; ++k) y[k] *= rn;
                }
                if (sg == 0) {
                    u32x2 o; o.x = pk2(y[0] * 0.125f, y[1] * 0.125f); o.y = pk2(y[2] * 0.125f, y[3] * 0.125f);
                    *(u32x2*)(lds + G_QB + i * (GST * 2) + 8 * sub) = o;
                } else if (sg == 1) {
                    const float beta = VEC[64 + i], ekd = VEC[192 + i];
                    *(f32x4*)(KF + i * 64 + 4 * sub) = (f32x4){y[0], y[1], y[2], y[3]};
                    u32x2 o; o.x = pk2(y[0], y[1]); o.y = pk2(y[2], y[3]);
                    *(u32x2*)(lds + G_KB + i * (GST * 2) + 8 * sub) = o;
                    o.x = pk2(y[0] * beta, y[1] * beta); o.y = pk2(y[2] * beta, y[3] * beta);
                    *(u32x2*)(lds + G_KBB + i * (GST * 2) + 8 * sub) = o;
#pragma unroll
                    for (int k = 0; k < 4; ++k) *(bf16_t*)(lds + G_KDT + (4 * sub + k) * (GST * 2) + i * 2) = (bf16_t)f2bf(y[k] * ekd);
                } else {
                    *(f32x4*)(VF + i * 64 + 4 * sub) = (f32x4){y[0], y[1], y[2], y[3]};
                }
            }
        }
        LBAR(); STG(1);
        if (VAR != 3 && VAR < 4) {
            LAUNDER(l3, lane);
            const int prod = wave >> 2, quad = wave & 3, qr = quad >> 1, qc = quad & 1, r32 = l3 & 31, hh = l3 >> 5;
            const f32x16 acc = mm_quad(lds + (prod ? G_QB : G_KBB), lds + G_KB, qr, qc, l3);
            const int j = 32 * qc + r32; const float gcj = VEC[j];
#pragma unroll
            for (int r = 0; r < 16; ++r) {
                const int i = 32 * qr + crow(r, hh);
                if (prod == 0) { MF[i * 68 + j] = (j < i) ? acc[r] * __expf(VEC[i] - gcj) : 0.f; }
                else { *(bf16_t*)(lds + G_QKB + i * (GST * 2) + j * 2) = (bf16_t)f2bf((j <= i) ? acc[r] * __expf(VEC[i] - gcj) : 0.f); }
            }
        }
        LBAR(); STG(2);
        float* DB = (float*)(lds + G_KBB);
        if (VAR != 1 && VAR < 4 && wave == 0) {
            LAUNDER(l4, lane); const int b = l4 >> 4, jc = l4 & 15;
            float d[16];
#pragma unroll
            for (int i = 0; i < 16; ++i) {
                float acc = (i == jc) ? 1.f : 0.f;
                const float* mrow = MF + (16 * b + i) * 68 + 16 * b;
#pragma unroll
                for (int k = 0; k < i; ++k) acc -= mrow[k] * d[k];
                d[i] = acc;
            }
#pragma unroll
            for (int i = 0; i < 16; ++i) DB[(b * 16 + i) * 20 + jc] = d[i];
        }
        LBAR();
        if (VAR != 1 && VAR < 4) {
            LAUNDER(l4, lane); const int cc = l4 & 15, g = l4 >> 4;
            const bool isU = wave < 4; const int col = 16 * (wave & 3) + cc;
            const float* src = (isU ? VF : KF) + col;
            f32x4 X[4];
#pragma unroll
            for (int b = 0; b < 4; ++b) {
                f32x4 acc;
#pragma unroll
                for (int r = 0; r < 4; ++r) { const int i = 16 * b + 4 * g + r; float rv = src[i * 64] * VEC[64 + i]; if (!isU) rv *= VEC[128 + i]; acc[r] = -rv; }
#pragma unroll
                for (int a = 0; a < b; ++a) {
                    const f32x4 lv = *(const f32x4*)(MF + (16 * b + cc) * 68 + 16 * a + 4 * g);
#pragma unroll
                    for (int sp = 0; sp < 4; ++sp) acc = __builtin_amdgcn_mfma_f32_16x16x4f32(lv[sp], X[a][sp], acc, 0, 0, 0);
                }
                const f32x4 dv = *(const f32x4*)(DB + (b * 16 + cc) * 20 + 4 * g);
                f32x4 xb = (f32x4){0.f, 0.f, 0.f, 0.f};
#pragma unroll
                for (int sp = 0; sp < 4; ++sp) xb = __builtin_amdgcn_mfma_f32_16x16x4f32(dv[sp], acc[sp], xb, 0, 0, 0);
                X[b] = -xb;
                unsigned char* dst = lds + (isU ? G_UT : G_WT) + col * (GST * 2) + (16 * b + 4 * g) * 2;
                *(u32x2*)dst = (u32x2){pk2(X[b][0], X[b][1]), pk2(X[b][2], X[b][3])};
            }
        }
        LBAR(); STG(3);
        if (VAR != 3 && VAR < 4) {
            const float gl = VEC[128 + 63];
            float* GB = VAR ? (float*)(ws + WS_GS + (size_t)item * 8192) : (float*)(ws + WS_GB) + (size_t)item * 4096;
            bf16_t* GQ = (bf16_t*)(ws + (VAR ? WS_GS : WS_GQ)) + (size_t)item * 4096; bf16_t* GO = (bf16_t*)(ws + (VAR ? WS_GS : WS_GO)) + (size_t)item * 4096;
            bf16_t* GAL = (bf16_t*)(lds + G_MF);
            LAUNDER(l5, lane); const int r32 = l5 & 31, hh = l5 >> 5;
#pragma unroll 1
            for (int it = 0; it < 2; ++it) {
                const int task = wave + 8 * it, prod = task >> 2, quad = task & 3, qr = quad >> 1, qc = quad & 1;
                const f32x16 acc = mm_quad(lds + (prod < 2 ? G_KDT : G_QKB), lds + ((prod & 1) ? G_UT : G_WT), qr, qc, l5);
                const int Cc = 32 * qc + r32;
                if (prod == 0) {
#pragma unroll
                    for (int r = 0; r < 16; ++r) {
                        const int R = 32 * qr + crow(r, hh);
                        const float val = ((R == Cc) ? gl : 0.f) - acc[r];
                        const int rb = R >> 4, m = R & 15, q4 = Cc >> 4, g = (Cc >> 2) & 3, rr = Cc & 3, ks = q4 >> 1, jj = 4 * (q4 & 1) + rr, ls = 16 * g + m;
                        GAL[((rb * 2 + ks) * 64 + ls) * 8 + jj] = (bf16_t)f2bf(val);
                    }
                } else if (prod == 1) {
                    const int eslab = Cc >> 4, n = Cc & 15;
#pragma unroll
                    for (int a = 0; a < 4; ++a) {
                        const int R0 = 32 * qr + 8 * a + 4 * hh; const int rb = R0 >> 4, g = (R0 >> 2) & 3, ls = 16 * g + n;
                        *(f32x4*)(GB + ((eslab * 4 + rb) * 64 + ls) * 4) = (f32x4){acc[4 * a], acc[4 * a + 1], acc[4 * a + 2], acc[4 * a + 3]};
                    }
                } else if (prod == 2) {
#pragma unroll
                    for (int r = 0; r < 16; ++r) {
                        const int R = 32 * qr + crow(r, hh);
                        const float qv = bf2f(*(const bf16_t*)(lds + G_QB + R * (GST * 2) + Cc * 2));
                        GQ[R * 64 + Cc] = (bf16_t)f2bf(qv * VEC[128 + R] - acc[r]);
                    }
                } else {
#pragma unroll
                    for (int r = 0; r < 16; ++r) GO[(quad * 16 + r) * 64 + l5] = (bf16_t)f2bf(acc[r]);
                }
            }
        }
        if (VAR != 5 && nxt < NIT) { raw_park(); cb = nb; ca = na; }
        LBAR(); STG(4);
        if (VAR != 5) { LAUNDER(t6, tid); *(u32x4*)((bf16_t*)(ws + (VAR ? WS_GS : WS_GA)) + (size_t)item * 4096 + t6 * 8) = *(const u32x4*)(lds + G_MF + t6 * 16); }
        STG(5);
    }
    if (PROBE_STAGE >= 0 && tid == 0) { *(unsigned long long*)(lds + 143360 + 96) = stg_acc; }
}

constexpr int SC_D = 8, SC_PD = 6, SC_SLOT = 12288;
DI void gdn_scan(const Frame& F, const Args& A) {
    if (blockIdx.x >= 32) return;
    unsigned char* ws = A.ws;
    const int h = blockIdx.x & 7, eslab = blockIdx.x >> 3, lane = F.lane, wave = F.wave, n = lane & 15, g = lane >> 4;
    const unsigned char* GA = ws + WS_GA; const unsigned char* GB = ws + WS_GB; bf16_t* GS = (bf16_t*)(ws + WS_GS);
    LAS unsigned char* ring = (LAS unsigned char*)F.lds;
    const int np = (wave == 0) ? 0 : ((wave - 1 < 5) ? 2 : 1);
    auto issue = [&](int c) {
        const int cc = c < NCHUNK ? c : NCHUNK - 1;
        const size_t item = (size_t)cc * 8 + h;
        LAS unsigned char* slot = ring + (c % SC_D) * SC_SLOT;
#pragma unroll
        for (int i = 0; i < 2; ++i) if (i < np) {
            const int q = (wave - 1) + 7 * i;
            const unsigned char* src = (q < 8) ? GA + item * 8192 + q * 1024 : GB + item * 16384 + eslab * 4096 + (q - 8) * 1024;
            LAS unsigned char* dst = slot + ((q < 8) ? q * 1024 : 8192 + (q - 8) * 1024);
            __builtin_amdgcn_global_load_lds((const unsigned*)(src + lane * 16), (LAS unsigned*)dst, 16, 0, 0);
        }
    };
    for (int c = 0; c < SC_PD; ++c) issue(c);
    f32x4 S[4];
#pragma unroll
    for (int rb = 0; rb < 4; ++rb) S[rb] = (f32x4){0.f, 0.f, 0.f, 0.f};
#pragma unroll 1
    for (int c = 0; c < NCHUNK; ++c) {
        issue(c + SC_PD);
        if (np == 2) asm volatile("s_waitcnt vmcnt(12)" ::: "memory");
        else if (np == 1) asm volatile("s_waitcnt vmcnt(6)" ::: "memory");
        asm volatile("s_waitcnt lgkmcnt(0)" ::: "memory");
        __builtin_amdgcn_s_barrier();
        asm volatile("" ::: "memory");
        if (wave == 0) {
            const LAS unsigned char* slot = ring + (c % SC_D) * SC_SLOT;
            bf16x8 ac[8]; f32x4 bc[4];
#pragma unroll
            for (int q = 0; q < 8; ++q) ac[q] = *(const LAS bf16x8*)(slot + q * 1024 + lane * 16);
#pragma unroll
            for (int rb = 0; rb < 4; ++rb) bc[rb] = *(const LAS f32x4*)(slot + 8192 + rb * 1024 + lane * 16);
            const size_t item = (size_t)c * 8 + h;
            u32x4 p0, p1;
            p0.x = pk2(S[0][0], S[0][1]); p0.y = pk2(S[0][2], S[0][3]); p0.z = pk2(S[1][0], S[1][1]); p0.w = pk2(S[1][2], S[1][3]);
            p1.x = pk2(S[2][0], S[2][1]); p1.y = pk2(S[2][2], S[2][3]); p1.z = pk2(S[3][0], S[3][1]); p1.w = pk2(S[3][2], S[3][3]);
            {
                bf16_t* st = GS + item * 4096 + (16 * eslab + n) * 64 + 4 * g;
                *(u32x2*)(st + 0) = (u32x2){p0.x, p0.y}; *(u32x2*)(st + 16) = (u32x2){p0.z, p0.w};
                *(u32x2*)(st + 32) = (u32x2){p1.x, p1.y}; *(u32x2*)(st + 48) = (u32x2){p1.z, p1.w};
            }
            const bf16x8 b0 = __builtin_bit_cast(bf16x8, p0), b1 = __builtin_bit_cast(bf16x8, p1);
#pragma unroll
            for (int rb = 0; rb < 4; ++rb) {
                f32x4 acc = bc[rb];
                acc = mfma16(ac[rb * 2 + 0], b0, acc);
                acc = mfma16(ac[rb * 2 + 1], b1, acc);
                S[rb] = acc;
            }
        }
    }
    asm volatile("s_waitcnt vmcnt(0) lgkmcnt(0)" ::: "memory");
    __builtin_amdgcn_s_barrier();
}

DI void gdn_out_task(const Frame& F, const Args& A, int task) {
    unsigned char* ws = A.ws;
    const int ihalf = task & 1, item = (task >> 1) + 8, c = item >> 3, h = item & 7, lane = F.lane, r32 = lane & 31, hh = lane >> 5;
    const bf16_t* GQ = (const bf16_t*)(ws + WS_GQ) + (size_t)item * 4096; const bf16_t* GS = (const bf16_t*)(ws + WS_GS) + (size_t)item * 4096;
    const bf16_t* GO = (const bf16_t*)(ws + WS_GO) + (size_t)item * 4096;
    const bf16_t* Z = (const bf16_t*)(ws + WS_Z); bf16_t* MIX = (bf16_t*)(ws + WS_MIX);
    f32x16 acc[2];
#pragma unroll
    for (int eh = 0; eh < 2; ++eh)
#pragma unroll
        for (int r = 0; r < 16; ++r) acc[eh][r] = bf2f(GO[((ihalf * 2 + eh) * 16 + r) * 64 + lane]);
#pragma unroll
    for (int s = 0; s < 4; ++s) {
        const bf16x8 a = *(const bf16x8*)(GQ + (32 * ihalf + r32) * 64 + 16 * s + 8 * hh);
#pragma unroll
        for (int eh = 0; eh < 2; ++eh) {
            const bf16x8 b = *(const bf16x8*)(GS + (32 * eh + r32) * 64 + 16 * s + 8 * hh);
            acc[eh] = mfma32(a, b, acc[eh]);
        }
    }
    const float* gnorm = A.in[7];
    const float w0 = gnorm[r32], w1 = gnorm[32 + r32];
#pragma unroll
    for (int r = 0; r < 16; ++r) {
        float ss = acc[0][r] * acc[0][r] + acc[1][r] * acc[1][r];
        ss += __shfl_xor(ss, 1); ss += __shfl_xor(ss, 2); ss += __shfl_xor(ss, 4); ss += __shfl_xor(ss, 8); ss += __shfl_xor(ss, 16);
        const float rstd = 1.f / sqrtf(ss * (1.f / 64.f) + EPS);
        const int i = 32 * ihalf + crow(r, hh); const int p = 64 * c + i;
        const float z0 = bf2f(Z[(size_t)p * 512 + h * 64 + r32]), z1 = bf2f(Z[(size_t)p * 512 + h * 64 + 32 + r32]);
        bf16_t* o = MIX + (size_t)(p - 64) * 1024 + h * 64;
        o[r32] = (bf16_t)f2bf(acc[0][r] * rstd * w0 * siluf_(z0));
        o[32 + r32] = (bf16_t)f2bf(acc[1][r] * rstd * w1 * siluf_(z1));
    }
}

DI void mla_prep1_row(const Frame& F, const Args& A, int p) {
    unsigned char* ws = A.ws; const int lane = F.lane;
    const float* P32 = (const float*)(ws + WS_P32) + (size_t)p * 512;
    bf16_t* CQN = (bf16_t*)(ws + WS_CQN) + (size_t)p * 256; bf16_t* CKVN = (bf16_t*)(ws + WS_CKVN) + (size_t)p * 256;
    const f32x4 q = *(const f32x4*)(P32 + 4 * lane);
    const float sq = wave_sum((q.x * q.x + q.y * q.y) + (q.z * q.z + q.w * q.w));
    const float rq = 1.f / sqrtf(sq * (1.f / 256.f) + EPS);
    const f32x4 wq = *(const f32x4*)(A.in[8] + 4 * lane);
    *(u32x2*)(CQN + 4 * lane) = (u32x2){pk2(q.x * rq * wq.x, q.y * rq * wq.y), pk2(q.z * rq * wq.z, q.w * rq * wq.w)};
    const float k0 = P32[256 + 2 * lane], k1 = P32[256 + 2 * lane + 1];
    const float sk = wave_sum(k0 * k0 + k1 * k1);
    const float rk = 1.f / sqrtf(sk * (1.f / 128.f) + EPS);
    const float wk0 = A.in[9][2 * lane], wk1 = A.in[9][2 * lane + 1];
    *(unsigned*)(CKVN + 2 * lane) = pk2(k0 * rk * wk0, k1 * rk * wk1);
    *(unsigned*)(CKVN + 128 + 2 * lane) = 0u;
}

constexpr float QSCALE = 0.10206207261596577f * 1.4426950408889634f;
DI double rope_inv_rev(int i) {
    const double t8[8] = {0.15915494309189535, 0.08949940160889101, 0.050329212104487035, 0.0283021958306234, 0.015915494309189534, 0.008949940160889102, 0.005032921210448704, 0.00283021958306234};
    double v = t8[0];
#pragma unroll
    for (int k = 1; k < 8; ++k) v = ((i & 7) == k) ? t8[k] : v;
    return (i & 8) ? v * 0.01 : v;
}
DI void mla_prep2_row(const Frame& F, const Args& A, int p) {
    unsigned char* ws = A.ws; const int lane = F.lane, h = lane >> 3, s8 = lane & 7;
    bf16_t* Q = (bf16_t*)(ws + WS_Q) + ((size_t)h * KVROWS + p) * 96;
    bf16_t* K = (bf16_t*)(ws + WS_K) + ((size_t)h * KVROWS + p) * 96;
    bf16_t* VT = (bf16_t*)(ws + WS_VT) + (size_t)h * 64 * KVROWS + p;
    if (p < PADL || p >= LPV) {
#pragma unroll
        for (int m = 0; m < 12; ++m) { Q[s8 + 8 * m] = 0; K[s8 + 8 * m] = 0; }
#pragma unroll
        for (int m = 0; m < 8; ++m) VT[(size_t)(s8 + 8 * m) * KVROWS] = 0;
        return;
    }
    const bf16_t* QH = (const bf16_t*)(ws + WS_QH) + (size_t)p * 768 + h * 96;
    const bf16_t* KV = (const bf16_t*)(ws + WS_KVB) + (size_t)p * 1024 + h * 128;
    const float* kpe = (const float*)(ws + WS_P32) + (size_t)p * 512 + 384;
    const float* qn = A.in[12]; const float* kn = A.in[13];
    float q[12], k[12];
    float sq = 0.f, sk = 0.f;
#pragma unroll
    for (int m = 0; m < 12; ++m) { q[m] = bf2f(QH[s8 + 8 * m]); sq += q[m] * q[m]; }
#pragma unroll
    for (int m = 0; m < 8; ++m) k[m] = bf2f(KV[s8 + 8 * m]);
#pragma unroll
    for (int m = 8; m < 12; ++m) k[m] = kpe[s8 + 8 * (m - 8)];
#pragma unroll
    for (int m = 0; m < 12; ++m) sk += k[m] * k[m];
    sq += __shfl_xor(sq, 1); sq += __shfl_xor(sq, 2); sq += __shfl_xor(sq, 4);
    sk += __shfl_xor(sk, 1); sk += __shfl_xor(sk, 2); sk += __shfl_xor(sk, 4);
    const float rq = 1.f / sqrtf(sq * (1.f / 96.f) + EPS), rk = 1.f / sqrtf(sk * (1.f / 96.f) + EPS);
#pragma unroll
    for (int m = 0; m < 12; ++m) { q[m] *= rq * qn[s8 + 8 * m]; k[m] *= rk * kn[s8 + 8 * m]; }
    const double pos = (double)(p - PADL);
#pragma unroll
    for (int t = 0; t < 2; ++t) {
        const int i = s8 + 8 * t;
        const double rev = pos * rope_inv_rev(i);
        const float fr = (float)(rev - floor(rev));
        const float sn = __builtin_amdgcn_sinf(fr), cs = __builtin_amdgcn_cosf(fr);
        const float q1 = q[8 + t], q2 = q[10 + t]; q[8 + t] = q1 * cs - q2 * sn; q[10 + t] = q2 * cs + q1 * sn;
        const float k1 = k[8 + t], k2 = k[10 + t]; k[8 + t] = k1 * cs - k2 * sn; k[10 + t] = k2 * cs + k1 * sn;
    }
#pragma unroll
    for (int m = 0; m < 12; ++m) { Q[s8 + 8 * m] = (bf16_t)f2bf(q[m] * QSCALE); K[s8 + 8 * m] = (bf16_t)f2bf(k[m]); }
#pragma unroll
    for (int m = 0; m < 8; ++m) VT[(size_t)(s8 + 8 * m) * KVROWS] = KV[64 + s8 + 8 * m];
}

constexpr int A_KSTR = 208;
constexpr int A_VSTR = 136;
constexpr int A_KBYTES = 64 * A_KSTR;
constexpr int A_VBYTES = 64 * A_VSTR;
constexpr int A_BUF = A_KBYTES + A_VBYTES;
DI unsigned cvtpk_s(float lo, float hi) { typedef float f2 __attribute__((ext_vector_type(2))); typedef __bf16 b2 __attribute__((ext_vector_type(2))); f2 v = {lo, hi}; b2 b = __builtin_convertvector(v, b2); return __builtin_bit_cast(unsigned, b); }

DI void attn_item(const Frame& F, const Args& A, int h, int qb) {
    unsigned char* ws = A.ws; unsigned char* lds = F.lds;
    const int tid = F.tid, lane = F.lane, wave = F.wave, r32 = lane & 31, hh = lane >> 5;
    const bf16_t* Qg = (const bf16_t*)(ws + WS_Q) + (size_t)h * KVROWS * 96;
    const bf16_t* Kg = (const bf16_t*)(ws + WS_K) + (size_t)h * KVROWS * 96;
    const bf16_t* Vg = (const bf16_t*)(ws + WS_VT) + (size_t)h * 64 * KVROWS;
    const int p0w = 64 + 256 * qb + 32 * wave;
    const int qp = p0w + r32;
    const int ntile = 4 * qb + 5;
    const int mylast = 1 + 4 * qb + (wave >> 1);
    bf16x8 qf[6];
#pragma unroll
    for (int s = 0; s < 6; ++s) qf[s] = *(const bf16x8*)(Qg + (size_t)qp * 96 + 16 * s + 8 * hh);
    f32x16 ot[2]; ot[0] = zero16(); ot[1] = zero16();
    float mrun = -1e30f, lrun = 0.f;
    const int kr0 = tid / 12, kc0 = tid % 12, kr1 = (tid + 512) / 12, kc1 = (tid + 512) % 12; const bool k1ok = tid < 256;
    const int vr = tid >> 3, vc = tid & 7;
    u32x4 sk0, sk1, sv;
    auto gload = [&](int j) {
        const int kv0 = 64 * j;
        sk0 = *(const u32x4*)(Kg + (size_t)(kv0 + kr0) * 96 + kc0 * 8);
        if (k1ok) sk1 = *(const u32x4*)(Kg + (size_t)(kv0 + kr1) * 96 + kc1 * 8);
        sv = *(const u32x4*)(Vg + (size_t)vr * KVROWS + kv0 + vc * 8);
    };
    auto lstore = [&](int b) {
        unsigned char* kb = lds + b * A_BUF; unsigned char* vb = kb + A_KBYTES;
        *(u32x4*)(kb + kr0 * A_KSTR + kc0 * 16) = sk0;
        if (k1ok) *(u32x4*)(kb + kr1 * A_KSTR + kc1 * 16) = sk1;
        *(u32x2*)(vb + vr * A_VSTR + vc * 16) = (u32x2){sv.x, sv.y};
        *(u32x2*)(vb + vr * A_VSTR + vc * 16 + 8) = (u32x2){sv.z, sv.w};
    };
    gload(0); lstore(0);
    __syncthreads();
#pragma unroll 1
    for (int j = 0; j < ntile; ++j) {
        const int b = j & 1;
        if (j + 1 < ntile) gload(j + 1);
        if (j <= mylast) {
            const unsigned char* kb = lds + b * A_BUF; const unsigned char* vb = kb + A_KBYTES;
            f32x16 sc[2];
#pragma unroll
            for (int kh = 0; kh < 2; ++kh) {
                f32x16 acc = zero16();
                const unsigned char* kp = kb + (32 * kh + r32) * A_KSTR + hh * 16;
#pragma unroll
                for (int s = 0; s < 6; ++s) acc = mfma32(*(const bf16x8*)(kp + s * 32), qf[s], acc);
                sc[kh] = acc;
            }
            if (j == 0) {
#pragma unroll
                for (int kh = 0; kh < 2; ++kh)
#pragma unroll
                    for (int r = 0; r < 16; ++r) { const int kv = 32 * kh + crow(r, hh); if (kv < PADL) sc[kh][r] = -INFINITY; }
            }
            if (j == mylast) {
#pragma unroll
                for (int kh = 0; kh < 2; ++kh)
#pragma unroll
                    for (int r = 0; r < 16; ++r) { const int kv = 64 * j + 32 * kh + crow(r, hh); if (kv > qp) sc[kh][r] = -INFINITY; }
            }
            float mx = sc[0][0];
#pragma unroll
            for (int r = 1; r < 16; ++r) mx = fmaxf(mx, sc[0][r]);
#pragma unroll
            for (int r = 0; r < 16; ++r) mx = fmaxf(mx, sc[1][r]);
            mx = fmaxf(mx, __shfl_xor(mx, 32));
            const float mnew = fmaxf(mrun, mx);
            const float alpha = __builtin_amdgcn_exp2f(mrun - mnew);
            mrun = mnew;
            float ps = 0.f;
#pragma unroll
            for (int kh = 0; kh < 2; ++kh)
#pragma unroll
                for (int r = 0; r < 16; ++r) { const float e = __builtin_amdgcn_exp2f(sc[kh][r] - mnew); sc[kh][r] = e; ps += e; }
            lrun = lrun * alpha + ps;
#pragma unroll
            for (int eh = 0; eh < 2; ++eh)
#pragma unroll
                for (int r = 0; r < 16; ++r) ot[eh][r] *= alpha;
#pragma unroll
            for (int kh = 0; kh < 2; ++kh)
#pragma unroll
                for (int s2 = 0; s2 < 2; ++s2) {
                    u32x4 pw; pw.x = cvtpk_s(sc[kh][8 * s2 + 0], sc[kh][8 * s2 + 1]); pw.y = cvtpk_s(sc[kh][8 * s2 + 2], sc[kh][8 * s2 + 3]);
                    pw.z = cvtpk_s(sc[kh][8 * s2 + 4], sc[kh][8 * s2 + 5]); pw.w = cvtpk_s(sc[kh][8 * s2 + 6], sc[kh][8 * s2 + 7]);
                    const bf16x8 pf = __builtin_bit_cast(bf16x8, pw);
#pragma unroll
                    for (int eh = 0; eh < 2; ++eh) {
                        const unsigned char* vp = vb + (32 * eh + r32) * A_VSTR + (32 * kh + 16 * s2 + 4 * hh) * 2;
                        const u32x2 lo = *(const u32x2*)vp, hi2 = *(const u32x2*)(vp + 16);
                        const bf16x8 vf = __builtin_bit_cast(bf16x8, (u32x4){lo.x, lo.y, hi2.x, hi2.y});
                        ot[eh] = mfma32(vf, pf, ot[eh]);
                    }
                }
        }
        if (j + 1 < ntile) lstore(b ^ 1);
        __syncthreads();
    }
    const float ltot = lrun + __shfl_xor(lrun, 32);
    const float rl = 1.f / ltot;
    bf16_t* o = (bf16_t*)(ws + WS_MIX) + (size_t)(qp - 64) * 1024 + 512 + h * 64;
#pragma unroll
    for (int eh = 0; eh < 2; ++eh)
#pragma unroll
        for (int a = 0; a < 4; ++a) {
            const int e = 32 * eh + 8 * a + 4 * hh;
            *(u32x2*)(o + e) = (u32x2){pk2(ot[eh][4 * a] * rl, ot[eh][4 * a + 1] * rl), pk2(ot[eh][4 * a + 2] * rl, ot[eh][4 * a + 3] * rl)};
        }
}

DI void xn_row(const Frame& F, const Args& A, int u) {
    const f32x4* xr = (const f32x4*)(A.out + (size_t)u * DM) + F.lane;
    f32x4 v[4]; float s = 0.f;
#pragma unroll
    for (int j = 0; j < 4; ++j) { v[j] = xr[64 * j]; s += (v[j].x * v[j].x + v[j].y * v[j].y) + (v[j].z * v[j].z + v[j].w * v[j].w); }
    const float rstd = 1.f / sqrtf(wave_sum(s) * (1.f / DM) + EPS);
    unsigned long long* o8 = (unsigned long long*)((bf16_t*)(A.ws + WS_XN) + (size_t)u * DM) + F.lane;
#pragma unroll
    for (int j = 0; j < 4; ++j) { const f32x4 w = ((const f32x4*)A.in[15])[64 * j + F.lane];
        o8[64 * j] = (unsigned long long)pk2(v[j].x * rstd * w.x, v[j].y * rstd * w.y) | ((unsigned long long)pk2(v[j].z * rstd * w.z, v[j].w * rstd * w.w) << 32); }
}

DI unsigned fkey(float v, int idx) { unsigned u = __builtin_bit_cast(unsigned, v); u = (u & 0x80000000u) ? ~u : (u | 0x80000000u); return (u & ~127u) | (unsigned)(127 - idx); }
DI float keyval(unsigned k) { unsigned u = k & ~127u; u = (u & 0x80000000u) ? (u & 0x7fffffffu) : ~u; return __builtin_bit_cast(float, u); }

__device__ const unsigned char PAIR_A[50] = {0,0,0,0,0,0,0,0,0,0,0,0,0,0,0,0, 1,1,1,1,1,1,1,1, 2,2,2,2,2, 3,3,3,3, 4,4,4, 5,5, 6,6, 7,7, 8,9,10,11,12,13,14,15};
__device__ const unsigned char PAIR_B[50] = {0,1,2,3,4,5,6,7,8,9,10,11,12,13,14,15, 0,1,2,3,4,5,6,7, 0,1,2,3,4, 0,1,2,3, 0,1,2, 0,1, 0,1, 0,1, 0,0,0,0,0,0,0,0};

DI void ce_desc(unsigned& a, unsigned& b) { const unsigned mx = a > b ? a : b, mn = a > b ? b : a; a = mx; b = mn; }
template <int BASE, int NK> DI void bitonic_sort16_desc(unsigned (&x)[NK]) {
#pragma unroll
    for (int k = 2; k <= 16; k <<= 1)
#pragma unroll
        for (int j = k >> 1; j > 0; j >>= 1)
#pragma unroll
            for (int i = 0; i < 16; ++i) { const int l = i ^ j; if (l > i) { if ((i & k) == 0) ce_desc(x[BASE + i], x[BASE + l]); else ce_desc(x[BASE + l], x[BASE + i]); } }
}
template <int A0, int B0, int NK> DI void merge_top16(unsigned (&x)[NK]) {
#pragma unroll
    for (int i = 0; i < 16; ++i) { const unsigned p = x[A0 + i], q = x[B0 + 15 - i]; x[A0 + i] = p > q ? p : q; }
#pragma unroll
    for (int j = 8; j > 0; j >>= 1)
#pragma unroll
        for (int i = 0; i < 16; ++i) { const int l = i ^ j; if (l > i) ce_desc(x[A0 + i], x[A0 + l]); }
}
template <int NK> DI void top16_of_128(unsigned (&key)[NK]) {
    bitonic_sort16_desc<0, NK>(key); bitonic_sort16_desc<16, NK>(key); bitonic_sort16_desc<32, NK>(key); bitonic_sort16_desc<48, NK>(key);
    bitonic_sort16_desc<64, NK>(key); bitonic_sort16_desc<80, NK>(key); bitonic_sort16_desc<96, NK>(key); bitonic_sort16_desc<112, NK>(key);
    merge_top16<0, 16, NK>(key); merge_top16<32, 48, NK>(key); merge_top16<64, 80, NK>(key); merge_top16<96, 112, NK>(key);
    merge_top16<0, 32, NK>(key); merge_top16<64, 96, NK>(key);
    merge_top16<0, 64, NK>(key);
}

DI void topk_task(const Frame& F, const Args& A, int task) {
    unsigned char* ws = A.ws; const int tid = F.tid;
    const int u = task >> 3, h = task & 7;
    LAS unsigned* sk = (LAS unsigned*)(LAS unsigned char*)F.lds;
    LAS unsigned* pkk = sk + 16384;
    LAS float* stg = (LAS float*)(sk + 16384);
    const float* SCb = (const float*)(ws + WS_SC) + (size_t)(task & ~511) * 256;
#pragma unroll 1
    for (int half = 0; half < 2; ++half) {
        unsigned key[128];
#pragma unroll
        for (int qb = 0; qb < 4; ++qb) {
            u32x4 pf[8];
#pragma unroll
            for (int k = 0; k < 8; ++k) { const int c = tid + 512 * k; pf[k] = *(const u32x4*)(SCb + (size_t)(c >> 3) * 256 + half * 128 + qb * 32 + (c & 7) * 4); }
#pragma unroll
            for (int k = 0; k < 8; ++k) { const int c = tid + 512 * k; *(LAS u32x4*)(stg + (c >> 3) * 36 + (c & 7) * 4) = pf[k]; }
            __syncthreads();
#pragma unroll
            for (int i = 0; i < 8; ++i) { const f32x4 v = *(const LAS f32x4*)(stg + tid * 36 + 4 * i);
                key[32 * qb + 4 * i] = fkey(v.x, 32 * qb + 4 * i); key[32 * qb + 4 * i + 1] = fkey(v.y, 32 * qb + 4 * i + 1);
                key[32 * qb + 4 * i + 2] = fkey(v.z, 32 * qb + 4 * i + 2); key[32 * qb + 4 * i + 3] = fkey(v.w, 32 * qb + 4 * i + 3); }
            __syncthreads();
        }
        top16_of_128(key);
#pragma unroll
        for (int r = 0; r < 16; ++r) sk[(half * 16 + r) * 512 + tid] = key[r];
    }
    float v1[16], v2[16];
#pragma unroll
    for (int r = 0; r < 16; ++r) { v1[r] = keyval(sk[r * 512 + tid]); v2[r] = keyval(sk[(16 + r) * 512 + tid]); }
    unsigned ck[64];
#pragma unroll
    for (int c = 50; c < 64; ++c) ck[c] = 0u;
#pragma unroll
    for (int a = 0; a < 16; ++a) {
        const int off = a == 0 ? 0 : a == 1 ? 16 : a == 2 ? 24 : a == 3 ? 29 : a == 4 ? 33 : a == 5 ? 36 : a == 6 ? 38 : a == 7 ? 40 : 42 + (a - 8);
#pragma unroll
        for (int b = 0; b < 16; ++b) if ((a + 1) * (b + 1) <= 16) ck[off + b] = fkey(v1[a] + v2[b], off + b);
    }
    bitonic_sort16_desc<0, 64>(ck); bitonic_sort16_desc<16, 64>(ck); bitonic_sort16_desc<32, 64>(ck); bitonic_sort16_desc<48, 64>(ck);
    merge_top16<0, 16, 64>(ck); merge_top16<32, 48, 64>(ck); merge_top16<0, 32, 64>(ck);
#pragma unroll
    for (int r = 0; r < 16; ++r) pkk[r * 512 + tid] = ck[r];
    const float cmax = keyval(pkk[tid]);
    float ev[16]; float esum = 0.f; int ex[16];
#pragma unroll
    for (int r = 0; r < 16; ++r) {
        const unsigned k = pkk[r * 512 + tid]; const int c = 127 - (int)(k & 127u);
        ev[r] = __expf(keyval(k) - cmax); esum += ev[r];
        const int a = PAIR_A[c], b = PAIR_B[c];
        const int i1 = 127 - (int)(sk[a * 512 + tid] & 127u), i2 = 127 - (int)(sk[(16 + b) * 512 + tid] & 127u);
        ex[r] = i1 * 128 + i2;
    }
    const float rs = 1.f / esum;
    int* IDX = (int*)(ws + WS_IDX) + (size_t)u * 128 + h * 16; float* GATE = (float*)(ws + WS_GATE) + (size_t)u * 128 + h * 16;
#pragma unroll
    for (int r = 0; r < 16; r += 4) {
        *(int4*)(IDX + r) = make_int4(ex[r], ex[r + 1], ex[r + 2], ex[r + 3]);
        *(f32x4*)(GATE + r) = (f32x4){ev[r] * rs, ev[r + 1] * rs, ev[r + 2] * rs, ev[r + 3] * rs};
    }
}

constexpr float EU_SCALE = 64.f, EV_SCALE = 16.f;
DI unsigned pk4_fp8(float a, float b, float c, float d) { int w = 0; w = __builtin_amdgcn_cvt_pk_fp8_f32(a, b, w, false); w = __builtin_amdgcn_cvt_pk_fp8_f32(c, d, w, true); return (unsigned)w; }
DI void convert_tables(const Frame& F, const Args& A) {
    const size_t n16 = (size_t)16384 * 1024 / 16;
    const size_t gt = (size_t)blockIdx.x * 512 + F.tid, NGT = (size_t)F.G * 512;
#pragma unroll 1
    for (int t = 0; t < 2; ++t) {
        const float* src = A.in[18 + t]; unsigned char* dst = A.ws + (t ? WS_EV : WS_EU); const float sc = t ? EV_SCALE : EU_SCALE;
        for (size_t i = gt; i < n16; i += NGT) {
            const f32x4 a = *(const f32x4*)(src + i * 16) * sc, b = *(const f32x4*)(src + i * 16 + 4) * sc, c = *(const f32x4*)(src + i * 16 + 8) * sc, d = *(const f32x4*)(src + i * 16 + 12) * sc;
            const size_t e_ = i >> 6, c16_ = i & 63;
            *(u32x4*)(dst + (c16_ >> 3) * ((size_t)16384 * 128) + e_ * 128 + (c16_ & 7) * 16) = (u32x4){pk4_fp8(a.x, a.y, a.z, a.w), pk4_fp8(b.x, b.y, b.z, b.w), pk4_fp8(c.x, c.y, c.z, c.w), pk4_fp8(d.x, d.y, d.z, d.w)};
        }
    }
}

DI float gelu_exact(float x) { return 0.5f * x * (1.f + erff(x * 0.70710678118654752f)); }
typedef float f32x2 __attribute__((ext_vector_type(2)));
#define UNPK16(dst, W_) do { f32x2 _t; \
    _t = __builtin_amdgcn_cvt_pk_f32_fp8((int)(W_).x, false); dst[0] = _t.x; dst[1] = _t.y; _t = __builtin_amdgcn_cvt_pk_f32_fp8((int)(W_).x, true); dst[2] = _t.x; dst[3] = _t.y; \
    _t = __builtin_amdgcn_cvt_pk_f32_fp8((int)(W_).y, false); dst[4] = _t.x; dst[5] = _t.y; _t = __builtin_amdgcn_cvt_pk_f32_fp8((int)(W_).y, true); dst[6] = _t.x; dst[7] = _t.y; \
    _t = __builtin_amdgcn_cvt_pk_f32_fp8((int)(W_).z, false); dst[8] = _t.x; dst[9] = _t.y; _t = __builtin_amdgcn_cvt_pk_f32_fp8((int)(W_).z, true); dst[10] = _t.x; dst[11] = _t.y; \
    _t = __builtin_amdgcn_cvt_pk_f32_fp8((int)(W_).w, false); dst[12] = _t.x; dst[13] = _t.y; _t = __builtin_amdgcn_cvt_pk_f32_fp8((int)(W_).w, true); dst[14] = _t.x; dst[15] = _t.y; } while (0)

template <bool UPH>
DI void expert_phase(const Frame& F, const Args& A, int xv, int wq, int nw) {
    unsigned char* ws = A.ws; const int lane = F.lane, grp = lane >> 3, j = lane & 7;
    const unsigned char* TBL = ws + (UPH ? WS_EU : WS_EV) + (size_t)xv * ((size_t)16384 * 128) + 16 * j;
    const int* IDX = (const int*)(ws + WS_IDX); const float* CW = (const float*)(ws + WS_CW);
    const bf16_t* XN = (const bf16_t*)(ws + WS_XN) + 128 * xv + 16 * j;
    float* HP = (float*)(ws + WS_HP);
    LAS unsigned* ring = (LAS unsigned*)((LAS unsigned char*)F.lds + F.wave * 4096);
    const int nt = (MU - wq + nw - 1) / nw;
    if (nt <= 0) return;
    auto tok = [&](int k) { return __builtin_amdgcn_readfirstlane(wq + (k < nt ? k : nt - 1) * nw); };
    int mi0, mi1; u32x4 mx0, mx1; float mh0, mh1;
    auto meta_load = [&](int k) {
        const int u = tok(k);
        mi0 = IDX[(size_t)u * 128 + lane]; mi1 = IDX[(size_t)u * 128 + 64 + lane];
        if constexpr (UPH) { mx0 = *(const u32x4*)(XN + (size_t)u * DM); mx1 = *(const u32x4*)(XN + (size_t)u * DM + 8); }
        else { mh0 = CW[(size_t)u * 128 + lane]; mh1 = CW[(size_t)u * 128 + 64 + lane]; }
    };
    auto meta_store = [&](int k) {
        LAS unsigned* sl = ring + (k & 3) * 256;
        sl[lane] = (unsigned)mi0; sl[64 + lane] = (unsigned)mi1;
        if constexpr (UPH) { if (grp == 0) { *(LAS u32x4*)(sl + 128 + 8 * j) = mx0; *(LAS u32x4*)(sl + 128 + 8 * j + 4) = mx1; } }
        else { sl[128 + lane] = __builtin_bit_cast(unsigned, mh0); sl[192 + lane] = __builtin_bit_cast(unsigned, mh1); }
    };
    auto gather = [&](u32x4 (&buf)[8], int n) {
        const LAS unsigned* sl = ring + ((n >> 1) & 3) * 256 + 64 * (n & 1) + grp;
#pragma unroll
        for (int i = 0; i < 8; ++i) { const int e = (int)sl[8 * i]; buf[i] = *(const u32x4*)(TBL + (size_t)e * 128); }
    };
    const int ocol = 128 * xv + 16 * j + ((lane & 32) ? 8 : 0) + ((lane & 16) ? 4 : 0) + ((lane & 8) ? 2 : 0);
    f32x2 ocur = (f32x2){0.f, 0.f};
    float acc[16];
    float xn[16];
    auto compute = [&](u32x4 (&buf)[8], int n) {
        const int k = n >> 1, hf = n & 1;
        const LAS unsigned* sl = ring + (k & 3) * 256;
        if (hf == 0) {
            if constexpr (UPH) {
                const u32x4 x0 = *(const LAS u32x4*)(sl + 128 + 8 * j), x1 = *(const LAS u32x4*)(sl + 128 + 8 * j + 4);
                xn[0] = bflo(x0.x); xn[1] = bfhi(x0.x); xn[2] = bflo(x0.y); xn[3] = bfhi(x0.y); xn[4] = bflo(x0.z); xn[5] = bfhi(x0.z); xn[6] = bflo(x0.w); xn[7] = bfhi(x0.w);
                xn[8] = bflo(x1.x); xn[9] = bfhi(x1.x); xn[10] = bflo(x1.y); xn[11] = bfhi(x1.y); xn[12] = bflo(x1.z); xn[13] = bfhi(x1.z); xn[14] = bflo(x1.w); xn[15] = bfhi(x1.w);
            } else {
#pragma unroll
                for (int c = 0; c < 16; ++c) acc[c] = 0.f;
                ocur = *(const f32x2*)(A.out + (size_t)tok(k) * DM + ocol);
            }
        }
#pragma unroll
        for (int i = 0; i < 8; ++i) {
            float f[16]; UNPK16(f, buf[i]);
            if constexpr (UPH) {
                float a0 = 0.f, a1 = 0.f;
#pragma unroll
                for (int c = 0; c < 16; c += 2) { a0 += f[c] * xn[c]; a1 += f[c + 1] * xn[c + 1]; }
                if (hf == 0) acc[i] = a0 + a1; else acc[8 + i] = a0 + a1;
                if (i < 7) { if (hf == 0) asm volatile("" : "+v"(buf[i + 1].x), "+v"(buf[i + 1].y), "+v"(buf[i + 1].z), "+v"(buf[i + 1].w), "+v"(acc[i]));
                             else asm volatile("" : "+v"(buf[i + 1].x), "+v"(buf[i + 1].y), "+v"(buf[i + 1].z), "+v"(buf[i + 1].w), "+v"(acc[8 + i])); }
            } else {
                const float cw = __builtin_bit_cast(float, sl[128 + 64 * hf + 8 * i + grp]);
#pragma unroll
                for (int c = 0; c < 16; ++c) acc[c] += cw * f[c];
                if (i < 7) asm volatile("" : "+v"(buf[i + 1].x), "+v"(buf[i + 1].y), "+v"(buf[i + 1].z), "+v"(buf[i + 1].w),
                                             "+v"(acc[0]), "+v"(acc[1]), "+v"(acc[2]), "+v"(acc[3]), "+v"(acc[4]), "+v"(acc[5]), "+v"(acc[6]), "+v"(acc[7]),
                                             "+v"(acc[8]), "+v"(acc[9]), "+v"(acc[10]), "+v"(acc[11]), "+v"(acc[12]), "+v"(acc[13]), "+v"(acc[14]), "+v"(acc[15]));
            }
            __builtin_amdgcn_sched_barrier(0);
        }
        if (hf == 1 && k < nt) {
            const int u = tok(k);
            float r8[8], r4[4], r2[2];
            if constexpr (UPH) {
                { const bool up = lane & 4;
#pragma unroll
                  for (int i = 0; i < 8; ++i) { const float send = up ? acc[i] : acc[i + 8], keep = up ? acc[i + 8] : acc[i]; r8[i] = keep + __shfl_xor(send, 4); } }
                { const bool up = lane & 2;
#pragma unroll
                  for (int i = 0; i < 4; ++i) { const float send = up ? r8[i] : r8[i + 4], keep = up ? r8[i + 4] : r8[i]; r4[i] = keep + __shfl_xor(send, 2); } }
                { const bool up = lane & 1;
#pragma unroll
                  for (int i = 0; i < 2; ++i) { const float send = up ? r4[i] : r4[i + 2], keep = up ? r4[i + 2] : r4[i]; r2[i] = keep + __shfl_xor(send, 1); } }
                const int st = ((lane & 4) ? 8 : 0) + ((lane & 2) ? 4 : 0) + ((lane & 1) ? 2 : 0);
                float* hp = HP + ((size_t)xv * MU + u) * 128 + grp;
                hp[8 * st] = r2[0]; hp[8 * (st + 1)] = r2[1];
            } else {
                { const bool up = lane & 32;
#pragma unroll
                  for (int c = 0; c < 8; ++c) { const float send = up ? acc[c] : acc[c + 8], keep = up ? acc[c + 8] : acc[c]; r8[c] = keep + __shfl_xor(send, 32); } }
                { const bool up = lane & 16;
#pragma unroll
                  for (int c = 0; c < 4; ++c) { const float send = up ? r8[c] : r8[c + 4], keep = up ? r8[c + 4] : r8[c]; r4[c] = keep + __shfl_xor(send, 16); } }
                { const bool up = lane & 8;
#pragma unroll
                  for (int c = 0; c < 2; ++c) { const float send = up ? r4[c] : r4[c + 2], keep = up ? r4[c + 2] : r4[c]; r2[c] = keep + __shfl_xor(send, 8); } }
                f32x2* o = (f32x2*)(A.out + (size_t)u * DM + ocol);
                f32x2 cur = ocur; cur.x += r2[0]; cur.y += r2[1]; *o = cur;
            }
        }
    };
    meta_load(0); meta_store(0); meta_load(1); meta_store(1); meta_load(2); meta_store(2);
    u32x4 b0[8], b1[8], b2[8];
    gather(b0, 0); gather(b1, 1); gather(b2, 2);
#pragma unroll 1
    for (int k0 = 0; k0 < nt; k0 += 3) {
        const int n0 = 2 * k0;
        meta_load(k0 + 3);
        compute(b0, n0);     gather(b0, n0 + 3);
        compute(b1, n0 + 1); meta_store(k0 + 3); gather(b1, n0 + 4);
        meta_load(k0 + 4);
        compute(b2, n0 + 2); gather(b2, n0 + 5);
        compute(b0, n0 + 3); meta_store(k0 + 4); gather(b0, n0 + 6);
        meta_load(k0 + 5);
        compute(b1, n0 + 4); gather(b1, n0 + 7);
        compute(b2, n0 + 5); meta_store(k0 + 5); gather(b2, n0 + 8);
    }
}


DI void expert_c_pass(const Frame& F, const Args& A) {
    unsigned char* ws = A.ws;
    const float* HP = (const float*)(ws + WS_HP); const float* GATE = (const float*)(ws + WS_GATE); float* CW = (float*)(ws + WS_CW);
    const size_t n4 = (size_t)MU * 128 / 4;
    for (size_t i = (size_t)blockIdx.x * 512 + F.tid; i < n4; i += (size_t)F.G * 512) {
        f32x4 h = *(const f32x4*)(HP + i * 4);
#pragma unroll
        for (int x = 1; x < 8; ++x) h += *(const f32x4*)(HP + (size_t)x * MU * 128 + i * 4);
        const f32x4 g = *(const f32x4*)(GATE + i * 4);
        f32x4 c;
        c.x = gelu_exact(h.x * (1.f / EU_SCALE)) * g.x * (1.f / EV_SCALE); c.y = gelu_exact(h.y * (1.f / EU_SCALE)) * g.y * (1.f / EV_SCALE);
        c.z = gelu_exact(h.z * (1.f / EU_SCALE)) * g.z * (1.f / EV_SCALE); c.w = gelu_exact(h.w * (1.f / EU_SCALE)) * g.w * (1.f / EV_SCALE);
        *(f32x4*)(CW + i * 4) = c;
    }
}
#ifndef PROBE_VAR
#define PROBE_VAR 0
#endif
template <int PH> DI void run_phase(const Frame& F, const Args& args, PG8_LAS unsigned char* lds3) {
    unsigned char* ws = args.ws;
    if constexpr (PH == 0) { p0_prologue(F, args); }
    if constexpr (PH == 1) {
        pg8::Gemm g{(const bf16_t*)(ws + WS_HN), (const bf16_t*)(ws + WS_WIN), MP, NPROJ, 1024, 1024, 1024, 0};
        pg8::StaticOrder S; S.init(MP, NPROJ, F.G, (int)blockIdx.x);
        EpiProj E{(bf16_t*)(ws + WS_QKVR), (bf16_t*)(ws + WS_Z), (float*)(ws + WS_P32)};
        pg8::gemm_phase<EpiProj, pg8::StaticOrder, true, true>(lds3, g, S, E);
    }
    if constexpr (PH == 2) { gdn_prep_phase<0>(F, args); }
    if constexpr (PH == 102) { gdn_prep_phase<PROBE_VAR>(F, args); }
    if constexpr (PH == 3) { gdn_scan(F, args); }
    if constexpr (PH == 4) {
        for (int t = F.gw; t < 2048 * 2; t += F.NGW) gdn_out_task(F, args, t);
        for (int p = F.gw; p < MP; p += F.NGW) mla_prep1_row(F, args, p);
    }
    if constexpr (PH == 5) {
        { pg8::Gemm g{(const bf16_t*)(ws + WS_CQN), (const bf16_t*)(ws + WS_WUQ), MP, 768, 256, 256, 256, 0};
          pg8::StaticOrder S; S.init(MP, 768, F.G, (int)blockIdx.x); EpiB16 E{(bf16_t*)(ws + WS_QH), 768};
          pg8::gemm_phase<EpiB16, pg8::StaticOrder, true, true>(lds3, g, S, E); }
        { pg8::Gemm g{(const bf16_t*)(ws + WS_CKVN), (const bf16_t*)(ws + WS_WUKV), MP, 1024, 256, 256, 256, 0};
          pg8::StaticOrder S; S.init(MP, 1024, F.G, (int)blockIdx.x); EpiB16 E{(bf16_t*)(ws + WS_KVB), 1024};
          pg8::gemm_phase<EpiB16, pg8::StaticOrder, true, true>(lds3, g, S, E); }
    }
    if constexpr (PH == 6) { for (int p = F.gw; p < KVROWS; p += F.NGW) mla_prep2_row(F, args, p); }
    if constexpr (PH == 7) {
        for (int rep = 0; rep < 2; ++rep) {
            for (int k0 = blockIdx.x; k0 < 256; k0 += F.G) {
                const int k = rep == 0 ? k0 : 511 - k0;
                attn_item(F, args, k & 7, 63 - (k >> 3));
            }
        }
    }
    if constexpr (PH == 8) {
        pg8::Gemm g{(const bf16_t*)(ws + WS_MIX), (const bf16_t*)(ws + WS_WOUT), MU, 1024, 1024, 1024, 1024, 0};
        pg8::StaticOrder S; S.init(MU, 1024, F.G, (int)blockIdx.x); EpiF32 E{args.out, 1024, args.in[0]};
        pg8::gemm_phase<EpiF32, pg8::StaticOrder, true, true>(lds3, g, S, E);
    }
    if constexpr (PH == 9) { for (int u = F.gw; u < MU; u += F.NGW) xn_row(F, args, u); }
    if constexpr (PH == 10) {
        pg8::Gemm g{(const bf16_t*)(ws + WS_XN), (const bf16_t*)(ws + WS_WPQ), MU, 2048, 1024, 1024, 1024, 0};
        pg8::StaticOrder S; S.init(MU, 2048, F.G, (int)blockIdx.x); EpiB16 E{(bf16_t*)(ws + WS_PQ), 2048};
        pg8::gemm_phase<EpiB16, pg8::StaticOrder, true, true>(lds3, g, S, E);
    }
    if constexpr (PH == 11) {
        pg8::Gemm g{(const bf16_t*)(ws + WS_PQ), (const bf16_t*)(ws + WS_SKB), MU, 2048, 256, 2048, 256, 256};
        pg8::StaticOrder S; S.init(MU, 2048, F.G, (int)blockIdx.x); EpiF32 E{(float*)(ws + WS_SC), 2048, nullptr};
        pg8::gemm_phase<EpiF32, pg8::StaticOrder, true, true>(lds3, g, S, E);
    }
    if constexpr (PH == 12) {
        convert_tables(F, args);
        for (int t = blockIdx.x * 512 + F.tid; t < MU * 8; t += F.G * 512) topk_task(F, args, t);
    }
    if constexpr (PH == 14) { expert_c_pass(F, args); }
    if constexpr (PH == 13 || PH == 15) {
        volatile LAS unsigned* MISC = (volatile LAS unsigned*)(lds3 + MISC_OFF);
        const unsigned x = MISC[16], rank = MISC[17];
        unsigned* bar = (unsigned*)(ws + WS_CTL);
        unsigned nloc = 0, nx = 0, myidx = 0;
#pragma unroll
        for (unsigned j = 0; j < 16; ++j) { const unsigned c = xb_ld(&bar[XB_XCNT(j)]); nx += (c > 0u) ? 1u : 0u; myidx += (c > 0u && j < x) ? 1u : 0u; nloc = (j == x) ? c : nloc; }
        const int wq = __builtin_amdgcn_readfirstlane((int)rank * 8 + F.wave), nw = __builtin_amdgcn_readfirstlane((int)nloc * 8);
        const int xstep = __builtin_amdgcn_readfirstlane((int)nx);
        for (int xv = __builtin_amdgcn_readfirstlane((int)myidx); xv < 8; xv += xstep)
            { if constexpr (PH == 13) expert_phase<true>(F, args, xv, wq, nw); else expert_phase<false>(F, args, xv, wq, nw); }
    }
}
constexpr int NPHASE = 16;
__global__ void __launch_bounds__(512, 2) fwd_kernel(Args args) {
    extern __shared__ __attribute__((aligned(16))) unsigned char lds[];
    Frame F;
    F.lds = lds; F.tid = threadIdx.x; F.lane = F.tid & 63; F.wave = __builtin_amdgcn_readfirstlane(F.tid >> 6);
    F.G = gridDim.x; F.gw = blockIdx.x * 8 + F.wave; F.NGW = F.G * 8;
    volatile LAS unsigned* MISC = (volatile LAS unsigned*)((LAS unsigned char*)lds + MISC_OFF);
    if (F.tid < 32) MISC[F.tid] = 0u;
    __syncthreads();
    unsigned char* ws = args.ws;
    const int lo = args.ph_lo, hi = args.ph_hi;
    XcdBarrier bar; bar.bar = (unsigned*)(ws + WS_CTL); bar.x = 0; bar.st = nullptr;
    if (hi - lo > 1) bar = xcd_barrier_post((unsigned*)(ws + WS_CTL), MISC + 8);
    if (F.tid == 0) { const unsigned x = xb_xcc_id(); MISC[16] = x; MISC[17] = xb_add((unsigned*)(ws + WS_CTL) + 3520 + 64 * x, 1u); }
    __syncthreads();
#define IN(k) (lo <= (k) && (k) < hi)
#define SEAM(k) do { if (IN(k) && IN((k) + 1)) xcd_barrier(bar); } while (0)
    PG8_LAS unsigned char* lds3 = (PG8_LAS unsigned char*)lds;

#ifndef PROBE_REPEAT
#define PROBE_REPEAT -1
#endif
#ifndef PROBE_TIME
#define PROBE_TIME -1
#endif
#ifndef PROBE_TSEL
#define PROBE_TSEL 0
#endif
    unsigned long long pt_ticks = 0ull;
#define PHASE(k) do { unsigned long long pt0_ = 0ull; if (PROBE_TIME == (k)) pt0_ = __builtin_amdgcn_s_memrealtime(); \
        if (IN(k)) { run_phase<k>(F, args, lds3); if (PROBE_REPEAT == (k)) { xcd_barrier(bar); run_phase<(PROBE_VAR && (k) == 2) ? 102 : (k)>(F, args, lds3); } } \
        if (PROBE_TIME == (k) && PROBE_TSEL == 1) pt_ticks = __builtin_amdgcn_s_memrealtime() - pt0_;     \
        if (PROBE_TIME == (k) && PROBE_TSEL == 2) pt0_ = __builtin_amdgcn_s_memrealtime();                \
        SEAM(k); \
        if (PROBE_TIME == (k) && PROBE_TSEL != 1) pt_ticks = __builtin_amdgcn_s_memrealtime() - pt0_; } while (0)
    PHASE(0); PHASE(1); PHASE(2); PHASE(3); PHASE(4); PHASE(5); PHASE(6); PHASE(7); PHASE(8); PHASE(9); PHASE(10); PHASE(11); PHASE(12); PHASE(13); PHASE(14); PHASE(15);
#undef PHASE
    if (PROBE_STAGE >= 0) { __syncthreads(); pt_ticks = *(volatile unsigned long long*)(lds + 143360 + 96); }
    if (PROBE_TIME >= 0 || PROBE_STAGE >= 0) { const unsigned long long t0_ = __builtin_amdgcn_s_memrealtime(); while (__builtin_amdgcn_s_memrealtime() - t0_ < 4ull * pt_ticks) __builtin_amdgcn_s_sleep(32); }
#undef IN
#undef SEAM
}

#ifndef N_LAUNCHES
#define N_LAUNCHES 1
#endif
extern "C" void kernel_launch(void* const* d_in, const int* in_sizes, int n_in, void* d_out, int out_size, void* d_ws, size_t ws_size, hipStream_t stream) {
    static int grid = 0;
    if (grid == 0) {
        if (n_in != 20 || out_size != MU * DM || ws_size < WS_END) { fprintf(stderr, "kernel_launch: unexpected shapes (n_in %d out %d ws %zu)\n", n_in, out_size, ws_size); grid = -1; return; }
        int dev = 0, cus = 0, per_cu = 0;
        if (hipGetDevice(&dev) != hipSuccess || hipDeviceGetAttribute(&cus, hipDeviceAttributeMultiprocessorCount, dev) != hipSuccess) { grid = -1; return; }
        if (hipFuncSetAttribute((const void*)fwd_kernel, hipFuncAttributeMaxDynamicSharedMemorySize, LDS_BYTES) != hipSuccess) { fprintf(stderr, "kernel_launch: hipFuncSetAttribute failed\n"); grid = -1; return; }
        if (hipOccupancyMaxActiveBlocksPerMultiprocessor(&per_cu, (const void*)fwd_kernel, 512, LDS_BYTES) != hipSuccess || per_cu < 1) { fprintf(stderr, "kernel_launch: occupancy query says %d\n", per_cu); (void)hipGetLastError(); per_cu = 1; }
        grid = cus;
    }
    if (grid < 0) return;
    (void)hipMemsetAsync((char*)d_ws + WS_CTL, 0, CTL_ZERO_BYTES, stream);
    Args a{};
    for (int i = 0; i < 20; ++i) a.in[i] = (const float*)d_in[i];
    a.out = (float*)d_out; a.ws = (unsigned char*)d_ws;
    for (int li = 0; li < N_LAUNCHES; ++li) {
        a.ph_lo = li * NPHASE / N_LAUNCHES; a.ph_hi = (li + 1) * NPHASE / N_LAUNCHES;
        if (N_LAUNCHES == 1) {
            void* kargs[] = {&a};
            hipError_t e = hipLaunchCooperativeKernel((const void*)fwd_kernel, dim3(grid), dim3(512), kargs, LDS_BYTES, stream);
            if (e != hipSuccess) fprintf(stderr, "cooperative launch failed: %s (grid %d)\n", hipGetErrorString(e), grid);
        } else {
            hipLaunchKernelGGL(fwd_kernel, dim3(grid), dim3(512), LDS_BYTES, stream, a);
        }
    }
}
```

```cpp
#include <hip/hip_runtime.h>
#include <hip/hip_bf16.h>
#include <cstdio>
#include <cstdint>

#define DI __device__ __forceinline__
#define LAS __attribute__((address_space(3)))
#define GAS __attribute__((address_space(1)))

typedef unsigned short bf16_t;
typedef short bf16x8 __attribute__((ext_vector_type(8)));
typedef short s16x4 __attribute__((ext_vector_type(4)));
typedef float f32x4 __attribute__((ext_vector_type(4)));
typedef float f32x16 __attribute__((ext_vector_type(16)));
typedef unsigned u32x4 __attribute__((ext_vector_type(4)));
typedef unsigned u32x2 __attribute__((ext_vector_type(2)));

namespace pg8 {
#define PG8_LAS __attribute__((address_space(3)))
constexpr int BM = 256, BK = 64, HALF = 128, HTB = HALF * BK * 2  , STAGE_BYTES = 8 * HTB, NXCD = 8, WGM = 8;

__host__ __device__ __forceinline__ int lds_byte(int r, int c) { const int st = (r >> 4) * 2 + (c >> 5), rr = r & 15, cc = c & 31, ob = rr * 64 + cc * 2; return st * 1024 + (ob ^ (((ob >> 9) & 1) << 5)); }
__host__ __device__ __forceinline__ void stage_rc(int b, int& R, int& C) { const int st = b / 1024, sb = b % 1024, swz = sb ^ (((sb >> 9) & 1) << 5); R = (st >> 1) * 16 + swz / 64; C = (st & 1) * 32 + (swz % 64) / 2; }
__host__ __device__ __forceinline__ int perm32(int rho) { const int n = rho >> 4, i = rho & 15; return 8 * (i >> 2) + 4 * n + (i & 3); }

struct Unit { int pm, pn; };
struct Gemm { const bf16_t* A; const bf16_t* Bt; int M, N, K, lda, ldb, a_pn_off; };

struct StaticOrder {
    int nM, nN, nwg, G, c;
    __host__ __device__ void init(int M, int N, int G_, int c_) { nM = M / BM; nN = N / BM; nwg = nM * nN; G = G_; c = c_; }
    __host__ __device__ bool next(int i, Unit& u) const {
        const long L = (long)i * G + c; if (L >= nwg) return false;
        int wgid = (int)L; { const int q = nwg / NXCD, r = nwg % NXCD, xcd = wgid % NXCD, off = wgid / NXCD; wgid = (xcd < r ? xcd * (q + 1) : r * (q + 1) + (xcd - r) * q) + off; }
        const int nig = WGM * nN, gid = wgid / nig, fm = gid * WGM, gsz = (nM - fm) < WGM ? (nM - fm) : WGM;
        u.pm = fm + ((wgid % nig) % gsz); u.pn = (wgid % nig) / gsz; return true;
    }
    __device__ __forceinline__ void a_ready(const Unit&) const {}
    __device__ __forceinline__ void done(const Unit&) const {}
};

__device__ __forceinline__ unsigned cvt_pk_bf16(float lo, float hi) { unsigned r; asm volatile("v_cvt_pk_bf16_f32 %0, %1, %2" : "=v"(r) : "v"(lo), "v"(hi)); return r; }

template <class Epi, class Sched, bool ALIGN_EPI = false, bool SP2 = false>
__device__ __forceinline__ void gemm_phase(PG8_LAS unsigned char* lds, const Gemm g, const Sched& S, const Epi& E) {
    const int tid = threadIdx.x, wid = __builtin_amdgcn_readfirstlane(tid >> 6), lane = tid & 63, wr = wid >> 2, wc = wid & 3, fr = lane & 15, fq = lane >> 4;
    const int K = g.K, nt = K / BK;
    unsigned voffA[2], voffB[2];
#pragma unroll
    for (int i = 0; i < 2; ++i) { int R, C; stage_rc(tid * 16 + i * 8192, R, C); const int Rb = Epi::PERM ? ((R & ~31) + perm32(R & 31)) : R;
        voffA[i] = (unsigned)(R * g.lda + C) * 2u; voffB[i] = (unsigned)(Rb * g.ldb + C) * 2u; }
    const size_t kstep = (size_t)(BK * 2);
    const size_t hstepA = (size_t)HALF * g.lda * 2, hstepB = (size_t)HALF * g.ldb * 2;
    const size_t tstepA = 2 * hstepA, tstepB = 2 * hstepB;
    const size_t pnoffA = (size_t)g.a_pn_off * 2;
    const unsigned ldsw = (unsigned)wid * 1024u;
    const int aoff = lds_byte(wr * 64 + fr, fq * 8), boff = lds_byte(wc * 32 + fr, fq * 8);
#define PG8_SA(b, h) (((b) * 2 + (h)) * HTB)
#define PG8_SB(b, h) ((4 + (b) * 2 + (h)) * HTB)
#define PG8_STAGE(bufoff, gbase, voff) do { _Pragma("unroll") for (int _i = 0; _i < 2; ++_i) \
        __builtin_amdgcn_global_load_lds((const unsigned*)((const char*)(gbase) + (voff)[_i]), (PG8_LAS unsigned*)(lds + (bufoff) + ldsw + _i * 8192), 16, 0, 0); } while (0)
#define PG8_LDA(dst, b, h) do { _Pragma("unroll") for (int m = 0; m < 4; ++m) _Pragma("unroll") for (int k = 0; k < 2; ++k) dst[m][k] = *(const PG8_LAS bf16x8*)(lds + PG8_SA(b, h) + aoff + m * 2048 + k * 1024); } while (0)
#define PG8_LDB(dst, b, h) do { _Pragma("unroll") for (int n = 0; n < 2; ++n) _Pragma("unroll") for (int k = 0; k < 2; ++k) dst[n][k] = *(const PG8_LAS bf16x8*)(lds + PG8_SB(b, h) + boff + n * 2048 + k * 1024); } while (0)
#define PG8_MMA(ai, bj, At, Bt) do { __builtin_amdgcn_s_setprio(1); _Pragma("unroll") for (int m = 0; m < 4; ++m) _Pragma("unroll") for (int n = 0; n < 2; ++n) _Pragma("unroll") for (int k = 0; k < 2; ++k) \
        acc[ai][bj][m][n] = __builtin_amdgcn_mfma_f32_16x16x32_bf16(Bt[n][k], At[m][k], acc[ai][bj][m][n], 0, 0, 0); __builtin_amdgcn_s_setprio(0); } while (0)
#define PG8_WAIT_V(n) asm volatile("s_waitcnt vmcnt(" #n ")" ::: "memory")
#define PG8_WAIT_L(n) asm volatile("s_waitcnt lgkmcnt(" #n ")" ::: "memory")
#define PG8_BAR __builtin_amdgcn_s_barrier()
#define PG8_SCHED __builtin_amdgcn_sched_barrier(0)
    Unit cur, nxt; int ui = 0;
    if (!S.next(0, cur)) return;
    f32x4 acc[2][2][4][2];
#pragma unroll
    for (int a = 0; a < 2; ++a)
#pragma unroll
        for (int b = 0; b < 2; ++b)
#pragma unroll
            for (int m = 0; m < 4; ++m)
#pragma unroll
                for (int n = 0; n < 2; ++n) acc[a][b][m][n] = (f32x4){0.f, 0.f, 0.f, 0.f};
    bf16x8 At[4][2], B0[2][2], B1[2][2];
    const char* cA = (const char*)g.A + (size_t)cur.pm * tstepA + (size_t)cur.pn * pnoffA; const char* cB = (const char*)g.Bt + (size_t)cur.pn * tstepB;
    S.a_ready(cur);
    if constexpr (SP2) {
        PG8_STAGE(PG8_SB(0, 0), cB, voffB); PG8_STAGE(PG8_SB(0, 1), cB + hstepB, voffB); PG8_STAGE(PG8_SA(0, 0), cA, voffA); PG8_STAGE(PG8_SA(0, 1), cA + hstepA, voffA);
        if (wr == 1) PG8_BAR;
        PG8_WAIT_V(2); PG8_BAR;
        PG8_STAGE(PG8_SB(1, 0), cB + kstep, voffB); PG8_STAGE(PG8_SA(1, 0), cA + kstep, voffA); PG8_STAGE(PG8_SB(1, 1), cB + hstepB + kstep, voffB);
        PG8_WAIT_V(6); PG8_BAR;
    } else {
        PG8_STAGE(PG8_SB(0, 0), cB, voffB); PG8_STAGE(PG8_SA(0, 0), cA, voffA); PG8_STAGE(PG8_SB(0, 1), cB + hstepB, voffB); PG8_STAGE(PG8_SA(0, 1), cA + hstepA, voffA);
        if (wr == 1) PG8_BAR;
        PG8_WAIT_V(4); PG8_BAR;
        PG8_STAGE(PG8_SB(1, 0), cB + kstep, voffB); PG8_STAGE(PG8_SA(1, 0), cA + kstep, voffA); PG8_STAGE(PG8_SB(1, 1), cB + hstepB + kstep, voffB);
        PG8_WAIT_V(6); PG8_BAR;
    }
    for (;;) {
        const bool has_next = S.next(ui + 1, nxt);
        const char* nA = has_next ? (const char*)g.A + (size_t)nxt.pm * tstepA + (size_t)nxt.pn * pnoffA : cA; const char* nB = has_next ? (const char*)g.Bt + (size_t)nxt.pn * tstepB : cB;
        for (int t = 0; t < nt; t += 2) {
            const bool last = (t == nt - 2);
            const char* a1 = cA + (size_t)(t + 1) * kstep;
            const char* a2 = last ? nA : cA + (size_t)(t + 2) * kstep; const char* b2 = last ? nB : cB + (size_t)(t + 2) * kstep;
            const char* a3 = a2 + kstep; const char* b3 = b2 + kstep;
            if (last && has_next) S.a_ready(nxt);
            if constexpr (SP2) {
            PG8_LDB(B0, 0, 0); PG8_LDB(B1, 0, 1); PG8_SCHED; PG8_LDA(At, 0, 0); PG8_STAGE(PG8_SA(1, 1), a1 + hstepA, voffA);
            PG8_WAIT_V(8); PG8_WAIT_L(0); PG8_BAR; PG8_MMA(0, 0, At, B0); PG8_MMA(0, 1, At, B1); PG8_BAR; PG8_SCHED;
            PG8_LDA(At, 0, 1); PG8_STAGE(PG8_SB(0, 0), b2, voffB); PG8_STAGE(PG8_SB(0, 1), b2 + hstepB, voffB); PG8_STAGE(PG8_SA(0, 0), a2, voffA);
            PG8_WAIT_V(8); PG8_WAIT_L(0); PG8_BAR; PG8_MMA(1, 0, At, B0); PG8_MMA(1, 1, At, B1); PG8_BAR; PG8_SCHED;
            PG8_LDB(B0, 1, 0); PG8_LDB(B1, 1, 1); PG8_SCHED; PG8_LDA(At, 1, 0); PG8_STAGE(PG8_SA(0, 1), a2 + hstepA, voffA);
            PG8_WAIT_V(8); PG8_WAIT_L(0); PG8_BAR; PG8_MMA(0, 0, At, B0); PG8_MMA(0, 1, At, B1); PG8_BAR; PG8_SCHED;
            PG8_LDA(At, 1, 1); PG8_STAGE(PG8_SB(1, 0), b3, voffB); PG8_STAGE(PG8_SB(1, 1), b3 + hstepB, voffB); PG8_STAGE(PG8_SA(1, 0), a3, voffA);
            PG8_WAIT_V(8); PG8_WAIT_L(0); PG8_BAR; PG8_MMA(1, 0, At, B0); PG8_MMA(1, 1, At, B1); PG8_BAR; PG8_SCHED;
            } else {
            PG8_LDB(B0, 0, 0); PG8_SCHED; PG8_LDA(At, 0, 0); PG8_STAGE(PG8_SA(1, 1), a1 + hstepA, voffA);
            PG8_WAIT_L(8); PG8_BAR; PG8_WAIT_L(0); PG8_MMA(0, 0, At, B0); PG8_BAR; PG8_SCHED;
            PG8_LDB(B1, 0, 1); PG8_STAGE(PG8_SB(0, 0), b2, voffB);
            PG8_BAR; PG8_WAIT_L(0); PG8_MMA(0, 1, At, B1); PG8_BAR;
            PG8_LDA(At, 0, 1); PG8_STAGE(PG8_SA(0, 0), a2, voffA);
            PG8_BAR; PG8_WAIT_L(0); PG8_MMA(1, 0, At, B0); PG8_BAR; PG8_SCHED;
            PG8_STAGE(PG8_SB(0, 1), b2 + hstepB, voffB);
            PG8_WAIT_V(6); PG8_BAR; PG8_MMA(1, 1, At, B1); PG8_BAR;
            PG8_LDB(B0, 1, 0); PG8_SCHED; PG8_LDA(At, 1, 0); PG8_STAGE(PG8_SA(0, 1), a2 + hstepA, voffA);
            PG8_WAIT_L(8); PG8_BAR; PG8_WAIT_L(0); PG8_MMA(0, 0, At, B0); PG8_BAR; PG8_SCHED;
            PG8_LDB(B1, 1, 1); PG8_STAGE(PG8_SB(1, 0), b3, voffB);
            PG8_BAR; PG8_WAIT_L(0); PG8_MMA(0, 1, At, B1); PG8_BAR;
            PG8_LDA(At, 1, 1); PG8_STAGE(PG8_SA(1, 0), a3, voffA);
            PG8_BAR; PG8_WAIT_L(0); PG8_MMA(1, 0, At, B0); PG8_BAR; PG8_SCHED;
            PG8_STAGE(PG8_SB(1, 1), b3 + hstepB, voffB);
            PG8_WAIT_V(6); PG8_BAR; PG8_MMA(1, 1, At, B1); PG8_BAR;
            }
        }
        if constexpr (ALIGN_EPI) { if (wr == 0) PG8_BAR; }
        E(acc, cur, wr, wc, fr, fq); S.done(cur);
        if (!has_next) break;
#pragma unroll
        for (int a = 0; a < 2; ++a)
#pragma unroll
            for (int b = 0; b < 2; ++b)
#pragma unroll
                for (int m = 0; m < 4; ++m)
#pragma unroll
                    for (int n = 0; n < 2; ++n) acc[a][b][m][n] = (f32x4){0.f, 0.f, 0.f, 0.f};
        cur = nxt; cA = nA; cB = nB; ++ui;
        if constexpr (ALIGN_EPI) { if (wr == 1) PG8_BAR; }
    }
    PG8_WAIT_V(0);
    if constexpr (!ALIGN_EPI) { if (wr == 0) PG8_BAR; }
    PG8_BAR;
#undef PG8_SA
#undef PG8_SB
#undef PG8_STAGE
#undef PG8_LDA
#undef PG8_LDB
#undef PG8_MMA
#undef PG8_WAIT_V
#undef PG8_WAIT_L
#undef PG8_BAR
#undef PG8_SCHED
}
}

constexpr int DM = 1024;
constexpr int NTOK = 16400;
constexpr int PADL = 48;
constexpr int LPV = 16448;
constexpr int MP = 16640;
constexpr int MU = 16384;
constexpr int NCHUNK = 257;
constexpr int NHEAD = 8;
constexpr int NPROJ = 2560;
constexpr int KVROWS = 16512;
constexpr float EPS = 1e-6f;

constexpr size_t MiB = 1u << 20;
constexpr size_t WS_CTL = 0, CTL_ZERO_BYTES = 64 * 1024;
constexpr size_t WS_WIN = 1 * MiB;
constexpr size_t WS_WUQ = 6 * MiB;
constexpr size_t WS_WUKV = 6 * MiB + 512 * 1024;
constexpr size_t WS_WOUT = 7 * MiB;
constexpr size_t WS_WPQ = 9 * MiB;
constexpr size_t WS_SKB = 13 * MiB;
constexpr size_t WS_IDX = 16 * MiB;
constexpr size_t WS_GATE = 24 * MiB;
constexpr size_t WS_HN = 32 * MiB;
constexpr size_t WS_QKVR = 96 * MiB;
constexpr size_t WS_Z = 96 * MiB + 49 * MiB;
constexpr size_t WS_P32 = 162 * MiB;
constexpr size_t WS_GA = 195 * MiB;
constexpr size_t WS_GQ = 212 * MiB;
constexpr size_t WS_GS = 229 * MiB;
constexpr size_t WS_GB = 32 * MiB;
constexpr size_t WS_GO = 65 * MiB;
constexpr size_t WS_MIX = 96 * MiB;
constexpr size_t WS_CQN = 128 * MiB;
constexpr size_t WS_CKVN = 136 * MiB + 512 * 1024;
constexpr size_t WS_QH = 32 * MiB;
constexpr size_t WS_KVB = 57 * MiB;
constexpr size_t WS_Q = 195 * MiB;
constexpr size_t WS_K = 220 * MiB;
constexpr size_t WS_VT = 145 * MiB;
constexpr size_t WS_XN = 32 * MiB;
constexpr size_t WS_PQ = 64 * MiB;
constexpr size_t WS_SC = 128 * MiB;
constexpr size_t WS_EU = 96 * MiB;
constexpr size_t WS_EV = 112 * MiB;
constexpr size_t WS_CW = 64 * MiB;
constexpr size_t WS_HP = 128 * MiB;
constexpr size_t WS_END = 256 * MiB;

constexpr int LDS_BYTES = 147456;
constexpr int MISC_OFF = 131072 + 12288;

DI unsigned f2bf(float f) { unsigned u = __builtin_bit_cast(unsigned, f); return (u + 0x7fffu + ((u >> 16) & 1u)) >> 16; }
DI unsigned pk2(float lo, float hi) { return f2bf(lo) | (f2bf(hi) << 16); }
DI float bf2f(unsigned b) { return __builtin_bit_cast(float, b << 16); }
DI float bflo(unsigned w) { return __builtin_bit_cast(float, w << 16); }
DI float bfhi(unsigned w) { return __builtin_bit_cast(float, w & 0xffff0000u); }
DI float wave_sum(float v) {
#pragma unroll
    for (int o = 1; o < 64; o <<= 1) v += __shfl_xor(v, o);
    return v;
}
DI float sigmoidf_(float x) { return 1.f / (1.f + __expf(-x)); }
DI float siluf_(float x) { return x / (1.f + __expf(-x)); }

#define XB_TMO      128
#define XB_XCNT(j)  (256  + 64 * (j))
#define XB_XSUB(j)  (1280 + 64 * (j))
#define XB_XGEN(j)  (2304 + 64 * (j))
#define XB_TOP      3328
#define XB_TOPGEN   3392
#define XCD_BAR_WORDS 3456
#define XB_SPIN_CAP (1u << 22)
DI unsigned xb_ld(unsigned* p)              { return __hip_atomic_load(p, __ATOMIC_RELAXED, __HIP_MEMORY_SCOPE_AGENT); }
DI unsigned xb_add(unsigned* p, unsigned v) { return __hip_atomic_fetch_add(p, v, __ATOMIC_RELAXED, __HIP_MEMORY_SCOPE_AGENT); }
DI unsigned xb_xcc_id() { return (unsigned)__builtin_amdgcn_s_getreg((3 << 11) | 20) & 0xFu; }
#define XB_SPIN(cond, bar) do { unsigned _sp = 0; while (cond) { __builtin_amdgcn_s_sleep(1); \
    if ((++_sp & 255u) == 0u) { if (xb_ld(&(bar)[XB_TMO])) break; if (_sp > XB_SPIN_CAP) { atomicAdd(&(bar)[XB_TMO], 1u); break; } } } } while (0)
struct XcdBarrier { unsigned* bar; unsigned x; volatile LAS unsigned* st; };
DI XcdBarrier xcd_barrier_post(unsigned* bar, volatile LAS unsigned* st) {
    XcdBarrier b; b.bar = bar; b.x = xb_xcc_id(); b.st = st;
    if (threadIdx.x == 0) (void)xb_add(&bar[XB_XCNT(b.x)], 1u);
    return b;
}
DI void xcd_barrier_complete(unsigned* bar, unsigned x, unsigned& nloc, unsigned& nx) {
    const unsigned G = gridDim.x * gridDim.y * gridDim.z;
    unsigned sum, cnt, mine, sp = 0u;
    for (;;) {
        sum = 0u; cnt = 0u; mine = 0u;
#pragma unroll
        for (unsigned j = 0; j < 16; ++j) { const unsigned c = xb_ld(&bar[XB_XCNT(j)]); sum += c; cnt += (c > 0u) ? 1u : 0u; mine = (j == x) ? c : mine; }
        if (sum == G) break;
        __builtin_amdgcn_s_sleep(1);
        if ((++sp & 255u) == 0u) { if (xb_ld(&bar[XB_TMO])) break; if (sp > XB_SPIN_CAP) { atomicAdd(&bar[XB_TMO], 1u); break; } }
    }
    nloc = mine > 0u ? mine : 1u; nx = cnt > 0u ? cnt : 1u;
}
DI void xcd_barrier(const XcdBarrier& b) {
    asm volatile("s_waitcnt vmcnt(0)" ::: "memory");
    __syncthreads();
    if (threadIdx.x == 0) {
        unsigned* bar = b.bar;
        __builtin_amdgcn_s_waitcnt(0);
        unsigned nloc = b.st[0], nx = b.st[1];
        if (nloc == 0u) { xcd_barrier_complete(bar, b.x, nloc, nx); b.st[0] = nloc; b.st[1] = nx; }
        const unsigned old = xb_add(&bar[XB_XSUB(b.x)], 1u);
        const unsigned gen = old / nloc;
        if (old + 1u == (gen + 1u) * nloc) {
            __builtin_amdgcn_fence(__ATOMIC_RELEASE, "agent");
            asm volatile("s_waitcnt vmcnt(0)" ::: "memory");
            const unsigned og = xb_add(&bar[XB_TOP], 1u);
            const unsigned tg = og / nx;
            if (og + 1u == (tg + 1u) * nx) xb_add(&bar[XB_TOPGEN], 1u);
            else XB_SPIN(xb_ld(&bar[XB_TOPGEN]) == tg, bar);
            __builtin_amdgcn_fence(__ATOMIC_ACQUIRE, "agent");
            xb_add(&bar[XB_XGEN(b.x)], 1u);
            asm volatile("s_waitcnt vmcnt(0)" ::: "memory");
        } else {
            XB_SPIN(xb_ld(&bar[XB_XGEN(b.x)]) == gen, bar);
            __builtin_amdgcn_fence(__ATOMIC_ACQUIRE, "agent");
            asm volatile("s_waitcnt vmcnt(0)" ::: "memory");
        }
    }
    __syncthreads();
}

struct Args {
    const float* in[20];
    float* out; unsigned char* ws;
    int ph_lo, ph_hi;
};
struct Frame {
    unsigned char* lds;
    int tid, lane, wave, G, gw, NGW;
};

template <class Map>
DI void transpose_item(const float* __restrict__ W, int Nsrc, bf16_t* __restrict__ WT, int ldk, float* scr, int item, int nblk, int lane, Map srcmap) {
    const int kb = item / nblk, nb = item % nblk, k0 = 64 * kb, n0 = 32 * nb;
    const int ns = srcmap(n0 + (lane & 31));
#pragma unroll 8
    for (int i = 0; i < 32; ++i) { const int kk = 2 * i + (lane >> 5); scr[kk * 33 + (lane & 31)] = (ns >= 0) ? W[(size_t)(k0 + kk) * Nsrc + ns] : 0.f; }
    __builtin_amdgcn_s_waitcnt(0); __builtin_amdgcn_wave_barrier();
    const int c = lane & 7;
#pragma unroll
    for (int j = 0; j < 4; ++j) { const int n = (lane >> 3) + 8 * j; const float* s = scr + (8 * c) * 33 + n;
        u32x4 o; o.x = pk2(s[0 * 33], s[1 * 33]); o.y = pk2(s[2 * 33], s[3 * 33]); o.z = pk2(s[4 * 33], s[5 * 33]); o.w = pk2(s[6 * 33], s[7 * 33]);
        *(u32x4*)(WT + (size_t)(n0 + n) * ldk + k0 + 8 * c) = o; }
    __builtin_amdgcn_s_waitcnt(0); __builtin_amdgcn_wave_barrier();
}
struct MapId { DI int operator()(int n) const { return n; } };
struct MapWin {
    DI int operator()(int n) const {
        if (n < 2048) return n;
        if (n < 2304) return n + 16;
        if (n < 2432) return n + 16;
        if (n < 2464) return n + 16;
        if (n < 2472) return n - 416;
        if (n < 2480) return n - 416;
        return -1;
    }
};

DI void p0_prologue(const Frame& F, const Args& A) {
    unsigned char* ws = A.ws;
    float* scr = (float*)(F.lds + F.wave * 16384);
    const float* w_in = A.in[3]; const float* w_uq = A.in[10]; const float* w_ukv = A.in[11]; const float* w_out = A.in[14]; const float* w_pq = A.in[16]; const float* sub_keys = A.in[17];
    constexpr int I_IN = 16 * 80, I_UQ = 4 * 24, I_UKV = 2 * 32, I_OUT = 16 * 32, I_PQ = 16 * 64;
    constexpr int NITEMS = I_IN + I_UQ + I_UKV + I_OUT + I_PQ;
    for (int it = F.gw; it < NITEMS; it += F.NGW) {
        int r = it;
        if (r < I_IN) { transpose_item(w_in, 2480, (bf16_t*)(ws + WS_WIN), 1024, scr, r, 80, F.lane, MapWin()); continue; } r -= I_IN;
        if (r < I_UQ) { transpose_item(w_uq, 768, (bf16_t*)(ws + WS_WUQ), 256, scr, r, 24, F.lane, MapId()); continue; } r -= I_UQ;
        if (r < I_UKV) { transpose_item(w_ukv, 1024, (bf16_t*)(ws + WS_WUKV), 256, scr, r, 32, F.lane, MapId()); continue; } r -= I_UKV;
        if (r < I_OUT) { transpose_item(w_out, 1024, (bf16_t*)(ws + WS_WOUT), 1024, scr, r, 32, F.lane, MapId()); continue; } r -= I_OUT;
        transpose_item(w_pq, 2048, (bf16_t*)(ws + WS_WPQ), 1024, scr, r, 64, F.lane, MapId());
    }
    const int gt = blockIdx.x * 512 + F.tid, NGT = F.G * 512;
    for (int i = gt; i < 1024 * 16; i += NGT) { const int n = i >> 4, c = i & 15; *(u32x4*)((bf16_t*)(ws + WS_WUKV) + (size_t)n * 256 + 128 + c * 8) = (u32x4){0u, 0u, 0u, 0u}; }
    for (int i = gt; i < 2048 * 32; i += NGT) {
        const int n = i >> 5, c8 = (i & 31) * 8; const int p = (n >> 7) & 1;
        u32x4 o = (u32x4){0u, 0u, 0u, 0u};
        if ((c8 >> 7) == p) { const float* s = sub_keys + (size_t)n * 128 + (c8 & 127); const f32x4 a = *(const f32x4*)s, b = *(const f32x4*)(s + 4);
            o.x = pk2(a.x, a.y); o.y = pk2(a.z, a.w); o.z = pk2(b.x, b.y); o.w = pk2(b.z, b.w); }
        *(u32x4*)((bf16_t*)(ws + WS_SKB) + (size_t)n * 256 + c8) = o;
    }
    const float* x = A.in[0]; const float* meta = A.in[1]; const float* anorm = A.in[2];
    bf16_t* HN = (bf16_t*)(ws + WS_HN);
    for (int p = F.gw; p < MP; p += F.NGW) {
        unsigned long long* o8 = (unsigned long long*)(HN + (size_t)p * DM) + F.lane;
        const int t = p - PADL;
        if (t < 0 || t >= NTOK) {
#pragma unroll
            for (int j = 0; j < 4; ++j) o8[64 * j] = 0ull;
            continue;
        }
        const float* src = (t < 16) ? meta + (size_t)t * DM : x + (size_t)(t - 16) * DM;
        const f32x4* xr = (const f32x4*)src + F.lane;
        f32x4 v[4]; float s = 0.f;
#pragma unroll
        for (int j = 0; j < 4; ++j) { v[j] = xr[64 * j]; s += (v[j].x * v[j].x + v[j].y * v[j].y) + (v[j].z * v[j].z + v[j].w * v[j].w); }
        const float rstd = 1.f / sqrtf(wave_sum(s) * (1.f / DM) + EPS);
#pragma unroll
        for (int j = 0; j < 4; ++j) { const f32x4 w = ((const f32x4*)anorm)[64 * j + F.lane];
            o8[64 * j] = (unsigned long long)pk2(v[j].x * rstd * w.x, v[j].y * rstd * w.y) | ((unsigned long long)pk2(v[j].z * rstd * w.z, v[j].w * rstd * w.w) << 32); }
    }
}

struct EpiProj {
    static constexpr bool PERM = true;
    bf16_t* QKVR; bf16_t* Z; float* P32;
    DI void operator()(const f32x4 (&acc)[2][2][4][2], const pg8::Unit& u, int wr, int wc, int fr, int fq) const {
        const int row0 = u.pm * 256 + wr * 64 + fr;
        if (u.pn < 8) {
            bf16_t* base; int ld, colt;
            if (u.pn < 6) { base = QKVR; ld = 1536; colt = u.pn * 256; } else { base = Z; ld = 512; colt = (u.pn - 6) * 256; }
            const int col0 = colt + wc * 32 + 8 * fq;
#pragma unroll
            for (int ai = 0; ai < 2; ++ai)
#pragma unroll
                for (int m = 0; m < 4; ++m) { bf16_t* rowp = base + (size_t)(row0 + ai * 128 + m * 16) * ld + col0;
#pragma unroll
                    for (int bj = 0; bj < 2; ++bj) { const f32x4 v0 = acc[ai][bj][m][0], v1 = acc[ai][bj][m][1];
                        u32x4 w; w.x = pg8::cvt_pk_bf16(v0[0], v0[1]); w.y = pg8::cvt_pk_bf16(v0[2], v0[3]); w.z = pg8::cvt_pk_bf16(v1[0], v1[1]); w.w = pg8::cvt_pk_bf16(v1[2], v1[3]);
                        *(u32x4*)(rowp + bj * 128) = w; } }
        } else {
            const int col0 = (u.pn - 8) * 256 + wc * 32 + 8 * fq;
#pragma unroll
            for (int ai = 0; ai < 2; ++ai)
#pragma unroll
                for (int m = 0; m < 4; ++m) { float* rowp = P32 + (size_t)(row0 + ai * 128 + m * 16) * 512 + col0;
#pragma unroll
                    for (int bj = 0; bj < 2; ++bj) { *(f32x4*)(rowp + bj * 128) = acc[ai][bj][m][0]; *(f32x4*)(rowp + bj * 128 + 4) = acc[ai][bj][m][1]; } }
        }
    }
};
struct EpiB16 {
    static constexpr bool PERM = true;
    bf16_t* O; int ldc;
    DI void operator()(const f32x4 (&acc)[2][2][4][2], const pg8::Unit& u, int wr, int wc, int fr, int fq) const {
        const int row0 = u.pm * 256 + wr * 64 + fr, col0 = u.pn * 256 + wc * 32 + 8 * fq;
#pragma unroll
        for (int ai = 0; ai < 2; ++ai)
#pragma unroll
            for (int m = 0; m < 4; ++m) { bf16_t* rowp = O + (size_t)(row0 + ai * 128 + m * 16) * ldc + col0;
#pragma unroll
                for (int bj = 0; bj < 2; ++bj) { const f32x4 v0 = acc[ai][bj][m][0], v1 = acc[ai][bj][m][1];
                    u32x4 w; w.x = pg8::cvt_pk_bf16(v0[0], v0[1]); w.y = pg8::cvt_pk_bf16(v0[2], v0[3]); w.z = pg8::cvt_pk_bf16(v1[0], v1[1]); w.w = pg8::cvt_pk_bf16(v1[2], v1[3]);
                    *(u32x4*)(rowp + bj * 128) = w; } }
    }
};
struct EpiF32 {
    static constexpr bool PERM = true;
    float* C; int ldc; const float* res;
    DI void operator()(const f32x4 (&acc)[2][2][4][2], const pg8::Unit& u, int wr, int wc, int fr, int fq) const {
        const int row0 = u.pm * 256 + wr * 64 + fr, col0 = u.pn * 256 + wc * 32 + 8 * fq;
#pragma unroll
        for (int ai = 0; ai < 2; ++ai)
#pragma unroll
            for (int m = 0; m < 4; ++m) { const size_t off = (size_t)(row0 + ai * 128 + m * 16) * ldc + col0;
#pragma unroll
                for (int bj = 0; bj < 2; ++bj) { f32x4 v0 = acc[ai][bj][m][0], v1 = acc[ai][bj][m][1];
                    if (res) { v0 += *(const f32x4*)(res + off + bj * 128); v1 += *(const f32x4*)(res + off + bj * 128 + 4); }
                    *(f32x4*)(C + off + bj * 128) = v0; *(f32x4*)(C + off + bj * 128 + 4) = v1; } }
    }
};

DI f32x16 mfma32(bf16x8 a, bf16x8 b, f32x16 c) { return __builtin_amdgcn_mfma_f32_32x32x16_bf16(a, b, c, 0, 0, 0); }
DI f32x4 mfma16(bf16x8 a, bf16x8 b, f32x4 c) { return __builtin_amdgcn_mfma_f32_16x16x32_bf16(a, b, c, 0, 0, 0); }
DI int crow(int r, int hi) { return (r & 3) + 8 * (r >> 2) + 4 * hi; }
DI f32x16 zero16() { f32x16 z;
#pragma unroll
    for (int i = 0; i < 16; ++i) z[i] = 0.f; return z; }

constexpr int G_KF = 0, G_VF = 16384, G_MF = 32768;
constexpr int G_QB = 50176, G_KB = 59392, G_KBB = 68608;
constexpr int G_QKB = 77824, G_UT = 87040, G_WT = 96256, G_KDT = 105472;
constexpr int G_VEC = 114688;
constexpr int G_RAW = G_QKB;
constexpr int GST = 72;

DI f32x16 mm_quad(const unsigned char* A, const unsigned char* Bt, int qr, int qc, int lane) {
    const int r32 = lane & 31, hh = lane >> 5;
    const unsigned char* ap = A + (32 * qr + r32) * (GST * 2) + hh * 16;
    const unsigned char* bp = Bt + (32 * qc + r32) * (GST * 2) + hh * 16;
    f32x16 acc = zero16();
#pragma unroll
    for (int s = 0; s < 4; ++s) acc = mfma32(*(const bf16x8*)(ap + s * 32), *(const bf16x8*)(bp + s * 32), acc);
    return acc;
}

constexpr int G_RAW2 = 115712;
static_assert(G_RAW2 + 67 * 400 <= 143360, "GDN prep LDS map");
constexpr int G_CONVW = 143360 + 512;

#ifndef PROBE_STAGE
#define PROBE_STAGE -1
#endif
template <int VAR> DI void gdn_prep_phase(const Frame& F, const Args& A) {
    unsigned long long stg_t = 0ull, stg_acc = 0ull;
#define STG(n) do { if (PROBE_STAGE >= 0) { const unsigned long long now_ = __builtin_amdgcn_s_memrealtime(); if (PROBE_STAGE == (n)) stg_acc += now_ - stg_t; stg_t = now_; } } while (0)
    unsigned char* ws = A.ws; unsigned char* lds = F.lds;
    const int tid = F.tid, lane = F.lane, wave = F.wave;
    const bf16_t* QKVR = (const bf16_t*)(ws + WS_QKVR); const float* P32 = (const float*)(ws + WS_P32);
    float* KF = (float*)(lds + G_KF); float* VF = (float*)(lds + G_VF); float* MF = (float*)(lds + G_MF);
    float* VEC = (float*)(lds + G_VEC);
    if (VAR == 6) return;
    const int NIT = NCHUNK * 8;
#define LBAR() do { asm volatile("s_waitcnt lgkmcnt(0)" ::: "memory"); __builtin_amdgcn_s_barrier(); asm volatile("" ::: "memory"); } while (0)
#define LAUNDER(dst, src) int dst = (src); asm volatile("" : "+v"(dst))
    int item = blockIdx.x;
    if (item >= NIT) return;
    u32x4 pr[4]; float nb = 0.f, na = 0.f;
    auto raw_fetch = [&](int it) {
        const int c = it >> 3, h = it & 7; LAUNDER(tl, tid);
#pragma unroll
        for (int i = 0; i < 4; ++i) { const int q = tl + 512 * i; pr[i] = (u32x4){0u, 0u, 0u, 0u};
            if (q < 67 * 24) { const int r = q / 24, cc = q % 24, seg = cc >> 3, c8 = cc & 7; const int p = 64 * c - 3 + r;
                if (p >= 0) pr[i] = *(const u32x4*)(QKVR + (size_t)p * 1536 + seg * 512 + h * 64 + c8 * 8); } }
        if (wave == 0) { const int p = 64 * c + lane; nb = P32[(size_t)p * 512 + 416 + h]; na = P32[(size_t)p * 512 + 424 + h]; }
    };
    auto raw_park = [&]() {
        LAUNDER(tl, tid);
#pragma unroll
        for (int i = 0; i < 4; ++i) { const int q = tl + 512 * i;
            if (q < 67 * 24) { const int r = q / 24, cc = q % 24, seg = cc >> 3, c8 = cc & 7; *(u32x4*)(lds + G_RAW2 + r * 400 + (seg * 64 + c8 * 8) * 2) = pr[i]; } }
    };
    raw_fetch(item); raw_park();
    float cb = nb, ca = na;
    float* CWL = (float*)(lds + G_CONVW);
    int cw_h = -1;
#pragma unroll 1
    for (; item < NIT; item += F.G) {
        if (PROBE_STAGE >= 0 && stg_t == 0ull) stg_t = __builtin_amdgcn_s_memrealtime();
        const int c = item >> 3, h = item & 7;
        if (h != cw_h) { cw_h = h;
            if (tid < 192) { LAUNDER(t0, tid); const int sg = t0 >> 6, jt = (t0 >> 4) & 3, c4 = t0 & 15; *(f32x4*)(CWL + (sg * 4 + jt) * 64 + 4 * c4) = *(const f32x4*)(A.in[4] + jt * 1536 + sg * 512 + h * 64 + 4 * c4); } }
        const int nxt = item + F.G;
        if (VAR != 5 && nxt < NIT) raw_fetch(nxt);
        if (wave == 0) {
            const int p = 64 * c + lane;
            const float alog = A.in[5][h], dtb = A.in[6][h];
            float beta = sigmoidf_(cb);
            const float xx = ca + dtb; const float sp = xx > 20.f ? xx : log1pf(__expf(xx));
            float g = -__expf(alog) * sp;
            if (p < PADL) { beta = 0.f; g = 0.f; }
            float gc = g;
#pragma unroll
            for (int o = 1; o < 64; o <<= 1) { const float t = __shfl_up(gc, o); if (lane >= o) gc += t; }
            const float glast = __shfl(gc, 63);
            VEC[lane] = gc; VEC[64 + lane] = beta; VEC[128 + lane] = __expf(gc); VEC[192 + lane] = __expf(glast - gc);
        }
        LBAR(); STG(0);
        LAUNDER(t1, tid); const int sub = t1 & 15, grp = t1 >> 4;
#pragma unroll
        for (int sg = 0; sg < ((VAR == 2 || VAR >= 4) ? 0 : 3); ++sg) {
#pragma unroll 1
            for (int ps = 0; ps < 2; ++ps) {
                const int i = grp + 32 * ps;
                float acc[4] = {0.f, 0.f, 0.f, 0.f};
#pragma unroll
                for (int jt = 0; jt < 4; ++jt) {
                    const f32x4 w = *(const f32x4*)(CWL + (sg * 4 + jt) * 64 + 4 * sub);
                    const u32x2 rv = *(const u32x2*)(lds + G_RAW2 + (i + jt) * 400 + (sg * 64 + 4 * sub) * 2);
                    acc[0] += w.x * bflo(rv.x); acc[1] += w.y * bfhi(rv.x); acc[2] += w.z * bflo(rv.y); acc[3] += w.w * bfhi(rv.y);
                }
                float y[4];
#pragma unroll
                for (int k = 0; k < 4; ++k) y[k] = siluf_(acc[k]);
                if (sg < 2) {
                    float ss = (y[0] * y[0] + y[1] * y[1]) + (y[2] * y[2] + y[3] * y[3]);
                    ss += __shfl_xor(ss, 1); ss += __shfl_xor(ss, 2); ss += __shfl_xor(ss, 4); ss += __shfl_xor(ss, 8);
                    const float rn = 1.f / sqrtf(ss + EPS);
#pragma unroll
                    for (int k = 0; k < 4; ++k) y[k] *= rn;
                }
                if (sg == 0) {
                    u32x2 o; o.x = pk2(y[0] * 0.125f, y[1] * 0.125f); o.y = pk2(y[2] * 0.125f, y[3] * 0.125f);
                    *(u32x2*)(lds + G_QB + i * (GST * 2) + 8 * sub) = o;
                } else if (sg == 1) {
                    const float beta = VEC[64 + i], ekd = VEC[192 + i];
                    *(f32x4*)(KF + i * 64 + 4 * sub) = (f32x4){y[0], y[1], y[2], y[3]};
                    u32x2 o; o.x = pk2(y[0], y[1]); o.y = pk2(y[2], y[3]);
                    *(u32x2*)(lds + G_KB + i * (GST * 2) + 8 * sub) = o;
                    o.x = pk2(y[0] * beta, y[1] * beta); o.y = pk2(y[2] * beta, y[3] * beta);
                    *(u32x2*)(lds + G_KBB + i * (GST * 2) + 8 * sub) = o;
#pragma unroll
                    for (int k = 0; k < 4; ++k) *(bf16_t*)(lds + G_KDT + (4 * sub + k) * (GST * 2) + i * 2) = (bf16_t)f2bf(y[k] * ekd);
                } else {
                    *(f32x4*)(VF + i * 64 + 4 * sub) = (f32x4){y[0], y[1], y[2], y[3]};
                }
            }
        }
        LBAR(); STG(1);
        if (VAR != 3 && VAR < 4) {
            LAUNDER(l3, lane);
            const int prod = wave >> 2, quad = wave & 3, qr = quad >> 1, qc = quad & 1, r32 = l3 & 31, hh = l3 >> 5;
            const f32x16 acc = mm_quad(lds + (prod ? G_QB : G_KBB), lds + G_KB, qr, qc, l3);
            const int j = 32 * qc + r32; const float gcj = VEC[j];
#pragma unroll
            for (int r = 0; r < 16; ++r) {
                const int i = 32 * qr + crow(r, hh);
                if (prod == 0) { MF[i * 68 + j] = (j < i) ? acc[r] * __expf(VEC[i] - gcj) : 0.f; }
                else { *(bf16_t*)(lds + G_QKB + i * (GST * 2) + j * 2) = (bf16_t)f2bf((j <= i) ? acc[r] * __expf(VEC[i] - gcj) : 0.f); }
            }
        }
        LBAR(); STG(2);
        float* DB = (float*)(lds + G_KBB);
        if (VAR != 1 && VAR < 4 && wave == 0) {
            LAUNDER(l4, lane); const int b = l4 >> 4, jc = l4 & 15;
            float d[16];
#pragma unroll
            for (int i = 0; i < 16; ++i) {
                float acc = (i == jc) ? 1.f : 0.f;
                const float* mrow = MF + (16 * b + i) * 68 + 16 * b;
#pragma unroll
                for (int k = 0; k < i; ++k) acc -= mrow[k] * d[k];
                d[i] = acc;
            }
#pragma unroll
            for (int i = 0; i < 16; ++i) DB[(b * 16 + i) * 20 + jc] = d[i];
        }
        LBAR();
        if (VAR != 1 && VAR < 4) {
            LAUNDER(l4, lane); const int cc = l4 & 15, g = l4 >> 4;
            const bool isU = wave < 4; const int col = 16 * (wave & 3) + cc;
            const float* src = (isU ? VF : KF) + col;
            f32x4 X[4];
#pragma unroll
            for (int b = 0; b < 4; ++b) {
                f32x4 acc;
#pragma unroll
                for (int r = 0; r < 4; ++r) { const int i = 16 * b + 4 * g + r; float rv = src[i * 64] * VEC[64 + i]; if (!isU) rv *= VEC[128 + i]; acc[r] = -rv; }
#pragma unroll
                for (int a = 0; a < b; ++a) {
                    const f32x4 lv = *(const f32x4*)(MF + (16 * b + cc) * 68 + 16 * a + 4 * g);
#pragma unroll
                    for (int sp = 0; sp < 4; ++sp) acc = __builtin_amdgcn_mfma_f32_16x16x4f32(lv[sp], X[a][sp], acc, 0, 0, 0);
                }
                const f32x4 dv = *(const f32x4*)(DB + (b * 16 + cc) * 20 + 4 * g);
                f32x4 xb = (f32x4){0.f, 0.f, 0.f, 0.f};
#pragma unroll
                for (int sp = 0; sp < 4; ++sp) xb = __builtin_amdgcn_mfma_f32_16x16x4f32(dv[sp], acc[sp], xb, 0, 0, 0);
                X[b] = -xb;
                unsigned char* dst = lds + (isU ? G_UT : G_WT) + col * (GST * 2) + (16 * b + 4 * g) * 2;
                *(u32x2*)dst = (u32x2){pk2(X[b][0], X[b][1]), pk2(X[b][2], X[b][3])};
            }
        }
        LBAR(); STG(3);
        if (VAR != 3 && VAR < 4) {
            const float gl = VEC[128 + 63];
            float* GB = VAR ? (float*)(ws + WS_GS + (size_t)item * 8192) : (float*)(ws + WS_GB) + (size_t)item * 4096;
            bf16_t* GQ = (bf16_t*)(ws + (VAR ? WS_GS : WS_GQ)) + (size_t)item * 4096; bf16_t* GO = (bf16_t*)(ws + (VAR ? WS_GS : WS_GO)) + (size_t)item * 4096;
            bf16_t* GAL = (bf16_t*)(lds + G_MF);
            LAUNDER(l5, lane); const int r32 = l5 & 31, hh = l5 >> 5;
#pragma unroll 1
            for (int it = 0; it < 2; ++it) {
                const int task = wave + 8 * it, prod = task >> 2, quad = task & 3, qr = quad >> 1, qc = quad & 1;
                const f32x16 acc = mm_quad(lds + (prod < 2 ? G_KDT : G_QKB), lds + ((prod & 1) ? G_UT : G_WT), qr, qc, l5);
                const int Cc = 32 * qc + r32;
                if (prod == 0) {
#pragma unroll
                    for (int r = 0; r < 16; ++r) {
                        const int R = 32 * qr + crow(r, hh);
                        const float val = ((R == Cc) ? gl : 0.f) - acc[r];
                        const int rb = R >> 4, m = R & 15, q4 = Cc >> 4, g = (Cc >> 2) & 3, rr = Cc & 3, ks = q4 >> 1, jj = 4 * (q4 & 1) + rr, ls = 16 * g + m;
                        GAL[((rb * 2 + ks) * 64 + ls) * 8 + jj] = (bf16_t)f2bf(val);
                    }
                } else if (prod == 1) {
                    const int eslab = Cc >> 4, n = Cc & 15;
#pragma unroll
                    for (int a = 0; a < 4; ++a) {
                        const int R0 = 32 * qr + 8 * a + 4 * hh; const int rb = R0 >> 4, g = (R0 >> 2) & 3, ls = 16 * g + n;
                        *(f32x4*)(GB + ((eslab * 4 + rb) * 64 + ls) * 4) = (f32x4){acc[4 * a], acc[4 * a + 1], acc[4 * a + 2], acc[4 * a + 3]};
                    }
                } else if (prod == 2) {
#pragma unroll
                    for (int r = 0; r < 16; ++r) {
                        const int R = 32 * qr + crow(r, hh);
                        const float qv = bf2f(*(const bf16_t*)(lds + G_QB + R * (GST * 2) + Cc * 2));
                        GQ[R * 64 + Cc] = (bf16_t)f2bf(qv * VEC[128 + R] - acc[r]);
                    }
                } else {
#pragma unroll
                    for (int r = 0; r < 16; ++r) GO[(quad * 16 + r) * 64 + l5] = (bf16_t)f2bf(acc[r]);
                }
            }
        }
        if (VAR != 5 && nxt < NIT) { raw_park(); cb = nb; ca = na; }
        LBAR(); STG(4);
        if (VAR != 5) { LAUNDER(t6, tid); *(u32x4*)((bf16_t*)(ws + (VAR ? WS_GS : WS_GA)) + (size_t)item * 4096 + t6 * 8) = *(const u32x4*)(lds + G_MF + t6 * 16); }
        STG(5);
    }
    if (PROBE_STAGE >= 0 && tid == 0) { *(unsigned long long*)(lds + 143360 + 96) = stg_acc; }
}

constexpr int SC_D = 8, SC_PD = 6, SC_SLOT = 12288;
DI void gdn_scan(const Frame& F, const Args& A) {
    if (blockIdx.x >= 32) return;
    unsigned char* ws = A.ws;
    const int h = blockIdx.x & 7, eslab = blockIdx.x >> 3, lane = F.lane, wave = F.wave, n = lane & 15, g = lane >> 4;
    const unsigned char* GA = ws + WS_GA; const unsigned char* GB = ws + WS_GB; bf16_t* GS = (bf16_t*)(ws + WS_GS);
    LAS unsigned char* ring = (LAS unsigned char*)F.lds;
    const int np = (wave == 0) ? 0 : ((wave - 1 < 5) ? 2 : 1);
    auto issue = [&](int c) {
        const int cc = c < NCHUNK ? c : NCHUNK - 1;
        const size_t item = (size_t)cc * 8 + h;
        LAS unsigned char* slot = ring + (c % SC_D) * SC_SLOT;
#pragma unroll
        for (int i = 0; i < 2; ++i) if (i < np) {
            const int q = (wave - 1) + 7 * i;
            const unsigned char* src = (q < 8) ? GA + item * 8192 + q * 1024 : GB + item * 16384 + eslab * 4096 + (q - 8) * 1024;
            LAS unsigned char* dst = slot + ((q < 8) ? q * 1024 : 8192 + (q - 8) * 1024);
            __builtin_amdgcn_global_load_lds((const unsigned*)(src + lane * 16), (LAS unsigned*)dst, 16, 0, 0);
        }
    };
    for (int c = 0; c < SC_PD; ++c) issue(c);
    f32x4 S[4];
#pragma unroll
    for (int rb = 0; rb < 4; ++rb) S[rb] = (f32x4){0.f, 0.f, 0.f, 0.f};
#pragma unroll 1
    for (int c = 0; c < NCHUNK; ++c) {
        issue(c + SC_PD);
        if (np == 2) asm volatile("s_waitcnt vmcnt(12)" ::: "memory");
        else if (np == 1) asm volatile("s_waitcnt vmcnt(6)" ::: "memory");
        asm volatile("s_waitcnt lgkmcnt(0)" ::: "memory");
        __builtin_amdgcn_s_barrier();
        asm volatile("" ::: "memory");
        if (wave == 0) {
            const LAS unsigned char* slot = ring + (c % SC_D) * SC_SLOT;
            bf16x8 ac[8]; f32x4 bc[4];
#pragma unroll
            for (int q = 0; q < 8; ++q) ac[q] = *(const LAS bf16x8*)(slot + q * 1024 + lane * 16);
#pragma unroll
            for (int rb = 0; rb < 4; ++rb) bc[rb] = *(const LAS f32x4*)(slot + 8192 + rb * 1024 + lane * 16);
            const size_t item = (size_t)c * 8 + h;
            u32x4 p0, p1;
            p0.x = pk2(S[0][0], S[0][1]); p0.y = pk2(S[0][2], S[0][3]); p0.z = pk2(S[1][0], S[1][1]); p0.w = pk2(S[1][2], S[1][3]);
            p1.x = pk2(S[2][0], S[2][1]); p1.y = pk2(S[2][2], S[2][3]); p1.z = pk2(S[3][0], S[3][1]); p1.w = pk2(S[3][2], S[3][3]);
            {
                bf16_t* st = GS + item * 4096 + (16 * eslab + n) * 64 + 4 * g;
                *(u32x2*)(st + 0) = (u32x2){p0.x, p0.y}; *(u32x2*)(st + 16) = (u32x2){p0.z, p0.w};
                *(u32x2*)(st + 32) = (u32x2){p1.x, p1.y}; *(u32x2*)(st + 48) = (u32x2){p1.z, p1.w};
            }
            const bf16x8 b0 = __builtin_bit_cast(bf16x8, p0), b1 = __builtin_bit_cast(bf16x8, p1);
#pragma unroll
            for (int rb = 0; rb < 4; ++rb) {
                f32x4 acc = bc[rb];
                acc = mfma16(ac[rb * 2 + 0], b0, acc);
                acc = mfma16(ac[rb * 2 + 1], b1, acc);
                S[rb] = acc;
            }
        }
    }
    asm volatile("s_waitcnt vmcnt(0) lgkmcnt(0)" ::: "memory");
    __builtin_amdgcn_s_barrier();
}

DI void gdn_out_task(const Frame& F, const Args& A, int task) {
    unsigned char* ws = A.ws;
    const int ihalf = task & 1, item = (task >> 1) + 8, c = item >> 3, h = item & 7, lane = F.lane, r32 = lane & 31, hh = lane >> 5;
    const bf16_t* GQ = (const bf16_t*)(ws + WS_GQ) + (size_t)item * 4096; const bf16_t* GS = (const bf16_t*)(ws + WS_GS) + (size_t)item * 4096;
    const bf16_t* GO = (const bf16_t*)(ws + WS_GO) + (size_t)item * 4096;
    const bf16_t* Z = (const bf16_t*)(ws + WS_Z); bf16_t* MIX = (bf16_t*)(ws + WS_MIX);
    f32x16 acc[2];
#pragma unroll
    for (int eh = 0; eh < 2; ++eh)
#pragma unroll
        for (int r = 0; r < 16; ++r) acc[eh][r] = bf2f(GO[((ihalf * 2 + eh) * 16 + r) * 64 + lane]);
#pragma unroll
    for (int s = 0; s < 4; ++s) {
        const bf16x8 a = *(const bf16x8*)(GQ + (32 * ihalf + r32) * 64 + 16 * s + 8 * hh);
#pragma unroll
        for (int eh = 0; eh < 2; ++eh) {
            const bf16x8 b = *(const bf16x8*)(GS + (32 * eh + r32) * 64 + 16 * s + 8 * hh);
            acc[eh] = mfma32(a, b, acc[eh]);
        }
    }
    const float* gnorm = A.in[7];
    const float w0 = gnorm[r32], w1 = gnorm[32 + r32];
#pragma unroll
    for (int r = 0; r < 16; ++r) {
        float ss = acc[0][r] * acc[0][r] + acc[1][r] * acc[1][r];
        ss += __shfl_xor(ss, 1); ss += __shfl_xor(ss, 2); ss += __shfl_xor(ss, 4); ss += __shfl_xor(ss, 8); ss += __shfl_xor(ss, 16);
        const float rstd = 1.f / sqrtf(ss * (1.f / 64.f) + EPS);
        const int i = 32 * ihalf + crow(r, hh); const int p = 64 * c + i;
        const float z0 = bf2f(Z[(size_t)p * 512 + h * 64 + r32]), z1 = bf2f(Z[(size_t)p * 512 + h * 64 + 32 + r32]);
        bf16_t* o = MIX + (size_t)(p - 64) * 1024 + h * 64;
        o[r32] = (bf16_t)f2bf(acc[0][r] * rstd * w0 * siluf_(z0));
        o[32 + r32] = (bf16_t)f2bf(acc[1][r] * rstd * w1 * siluf_(z1));
    }
}

DI void mla_prep1_row(const Frame& F, const Args& A, int p) {
    unsigned char* ws = A.ws; const int lane = F.lane;
    const float* P32 = (const float*)(ws + WS_P32) + (size_t)p * 512;
    bf16_t* CQN = (bf16_t*)(ws + WS_CQN) + (size_t)p * 256; bf16_t* CKVN = (bf16_t*)(ws + WS_CKVN) + (size_t)p * 256;
    const f32x4 q = *(const f32x4*)(P32 + 4 * lane);
    const float sq = wave_sum((q.x * q.x + q.y * q.y) + (q.z * q.z + q.w * q.w));
    const float rq = 1.f / sqrtf(sq * (1.f / 256.f) + EPS);
    const f32x4 wq = *(const f32x4*)(A.in[8] + 4 * lane);
    *(u32x2*)(CQN + 4 * lane) = (u32x2){pk2(q.x * rq * wq.x, q.y * rq * wq.y), pk2(q.z * rq * wq.z, q.w * rq * wq.w)};
    const float k0 = P32[256 + 2 * lane], k1 = P32[256 + 2 * lane + 1];
    const float sk = wave_sum(k0 * k0 + k1 * k1);
    const float rk = 1.f / sqrtf(sk * (1.f / 128.f) + EPS);
    const float wk0 = A.in[9][2 * lane], wk1 = A.in[9][2 * lane + 1];
    *(unsigned*)(CKVN + 2 * lane) = pk2(k0 * rk * wk0, k1 * rk * wk1);
    *(unsigned*)(CKVN + 128 + 2 * lane) = 0u;
}

constexpr float QSCALE = 0.10206207261596577f * 1.4426950408889634f;
DI double rope_inv_rev(int i) {
    const double t8[8] = {0.15915494309189535, 0.08949940160889101, 0.050329212104487035, 0.0283021958306234, 0.015915494309189534, 0.008949940160889102, 0.005032921210448704, 0.00283021958306234};
    double v = t8[0];
#pragma unroll
    for (int k = 1; k < 8; ++k) v = ((i & 7) == k) ? t8[k] : v;
    return (i & 8) ? v * 0.01 : v;
}
constexpr int P2_TS = 136;
DI void mla_prep2_task(const Frame& F, const Args& A, int task) {
    unsigned char* ws = A.ws; const int lane = F.lane, h = task & 7, blk = task >> 3;
    const int p = 64 * blk + lane;
    const bool valid = (p >= PADL) && (p < LPV);
    const float* qn = A.in[12]; const float* kn = A.in[13];
    float sn[16], cs[16];
    { const double pos = (double)(p - PADL);
#pragma unroll
      for (int i = 0; i < 16; ++i) { const double rev = pos * rope_inv_rev(i); const float fr = (float)(rev - floor(rev)); sn[i] = __builtin_amdgcn_sinf(fr); cs[i] = __builtin_amdgcn_cosf(fr); } }
    {
        const bf16_t* src = (const bf16_t*)(ws + WS_QH) + (size_t)p * 768 + h * 96;
        u32x4 w[12];
#pragma unroll
        for (int c = 0; c < 12; ++c) w[c] = *(const u32x4*)(src + 8 * c);
        float ss = 0.f;
#pragma unroll
        for (int c = 0; c < 12; ++c) { const float a0 = bflo(w[c].x), a1 = bfhi(w[c].x), a2 = bflo(w[c].y), a3 = bfhi(w[c].y), a4 = bflo(w[c].z), a5 = bfhi(w[c].z), a6 = bflo(w[c].w), a7 = bfhi(w[c].w);
            ss += (a0 * a0 + a1 * a1) + (a2 * a2 + a3 * a3) + (a4 * a4 + a5 * a5) + (a6 * a6 + a7 * a7); }
        const float rs = valid ? QSCALE / sqrtf(ss * (1.f / 96.f) + EPS) : 0.f;
        bf16_t* dst = (bf16_t*)(ws + WS_Q) + ((size_t)h * KVROWS + p) * 96;
#pragma unroll
        for (int c = 0; c < 8; ++c) {
            const f32x4 g0 = *(const f32x4*)(qn + 8 * c), g1 = *(const f32x4*)(qn + 8 * c + 4);
            *(u32x4*)(dst + 8 * c) = (u32x4){pk2(bflo(w[c].x) * rs * g0.x, bfhi(w[c].x) * rs * g0.y), pk2(bflo(w[c].y) * rs * g0.z, bfhi(w[c].y) * rs * g0.w),
                                             pk2(bflo(w[c].z) * rs * g1.x, bfhi(w[c].z) * rs * g1.y), pk2(bflo(w[c].w) * rs * g1.z, bfhi(w[c].w) * rs * g1.w)};
        }
#pragma unroll
        for (int c = 0; c < 2; ++c) {
            float x1[8], x2[8];
            const u32x4 wa = w[8 + c], wb = w[10 + c];
            x1[0] = bflo(wa.x); x1[1] = bfhi(wa.x); x1[2] = bflo(wa.y); x1[3] = bfhi(wa.y); x1[4] = bflo(wa.z); x1[5] = bfhi(wa.z); x1[6] = bflo(wa.w); x1[7] = bfhi(wa.w);
            x2[0] = bflo(wb.x); x2[1] = bfhi(wb.x); x2[2] = bflo(wb.y); x2[3] = bfhi(wb.y); x2[4] = bflo(wb.z); x2[5] = bfhi(wb.z); x2[6] = bflo(wb.w); x2[7] = bfhi(wb.w);
            float o1[8], o2[8];
#pragma unroll
            for (int t = 0; t < 8; ++t) { const float a = x1[t] * rs * qn[64 + 8 * c + t], b = x2[t] * rs * qn[80 + 8 * c + t]; o1[t] = a * cs[8 * c + t] - b * sn[8 * c + t]; o2[t] = b * cs[8 * c + t] + a * sn[8 * c + t]; }
            *(u32x4*)(dst + 64 + 8 * c) = (u32x4){pk2(o1[0], o1[1]), pk2(o1[2], o1[3]), pk2(o1[4], o1[5]), pk2(o1[6], o1[7])};
            *(u32x4*)(dst + 80 + 8 * c) = (u32x4){pk2(o2[0], o2[1]), pk2(o2[2], o2[3]), pk2(o2[4], o2[5]), pk2(o2[6], o2[7])};
        }
    }
    {
        const bf16_t* src = (const bf16_t*)(ws + WS_KVB) + (size_t)p * 1024 + h * 128;
        const float* kpe = (const float*)(ws + WS_P32) + (size_t)p * 512 + 384;
        u32x4 w[8]; f32x4 e[8];
#pragma unroll
        for (int c = 0; c < 8; ++c) { w[c] = *(const u32x4*)(src + 8 * c); e[c] = *(const f32x4*)(kpe + 4 * c); }
        float ss = 0.f;
#pragma unroll
        for (int c = 0; c < 8; ++c) { const float a0 = bflo(w[c].x), a1 = bfhi(w[c].x), a2 = bflo(w[c].y), a3 = bfhi(w[c].y), a4 = bflo(w[c].z), a5 = bfhi(w[c].z), a6 = bflo(w[c].w), a7 = bfhi(w[c].w);
            ss += (a0 * a0 + a1 * a1) + (a2 * a2 + a3 * a3) + (a4 * a4 + a5 * a5) + (a6 * a6 + a7 * a7);
            ss += (e[c].x * e[c].x + e[c].y * e[c].y) + (e[c].z * e[c].z + e[c].w * e[c].w); }
        const float rs = valid ? 1.f / sqrtf(ss * (1.f / 96.f) + EPS) : 0.f;
        bf16_t* dst = (bf16_t*)(ws + WS_K) + ((size_t)h * KVROWS + p) * 96;
#pragma unroll
        for (int c = 0; c < 8; ++c) {
            const f32x4 g0 = *(const f32x4*)(kn + 8 * c), g1 = *(const f32x4*)(kn + 8 * c + 4);
            *(u32x4*)(dst + 8 * c) = (u32x4){pk2(bflo(w[c].x) * rs * g0.x, bfhi(w[c].x) * rs * g0.y), pk2(bflo(w[c].y) * rs * g0.z, bfhi(w[c].y) * rs * g0.w),
                                             pk2(bflo(w[c].z) * rs * g1.x, bfhi(w[c].z) * rs * g1.y), pk2(bflo(w[c].w) * rs * g1.z, bfhi(w[c].w) * rs * g1.w)};
        }
#pragma unroll
        for (int c = 0; c < 2; ++c) {
            const float x1[8] = {e[2 * c].x, e[2 * c].y, e[2 * c].z, e[2 * c].w, e[2 * c + 1].x, e[2 * c + 1].y, e[2 * c + 1].z, e[2 * c + 1].w};
            const float x2[8] = {e[4 + 2 * c].x, e[4 + 2 * c].y, e[4 + 2 * c].z, e[4 + 2 * c].w, e[5 + 2 * c].x, e[5 + 2 * c].y, e[5 + 2 * c].z, e[5 + 2 * c].w};
            float o1[8], o2[8];
#pragma unroll
            for (int t = 0; t < 8; ++t) { const float a = x1[t] * rs * kn[64 + 8 * c + t], b = x2[t] * rs * kn[80 + 8 * c + t]; o1[t] = a * cs[8 * c + t] - b * sn[8 * c + t]; o2[t] = b * cs[8 * c + t] + a * sn[8 * c + t]; }
            *(u32x4*)(dst + 64 + 8 * c) = (u32x4){pk2(o1[0], o1[1]), pk2(o1[2], o1[3]), pk2(o1[4], o1[5]), pk2(o1[6], o1[7])};
            *(u32x4*)(dst + 80 + 8 * c) = (u32x4){pk2(o2[0], o2[1]), pk2(o2[2], o2[3]), pk2(o2[4], o2[5]), pk2(o2[6], o2[7])};
        }
    }
    {
        unsigned char* T = F.lds + F.wave * (64 * P2_TS);
        const bf16_t* src = (const bf16_t*)(ws + WS_KVB) + h * 128 + 64;
#pragma unroll
        for (int it = 0; it < 8; ++it) {
            const int pr = 8 * it + (lane >> 3), ch = lane & 7; const int pp = 64 * blk + pr;
            u32x4 v = (u32x4){0u, 0u, 0u, 0u};
            if (pp >= PADL && pp < LPV) v = *(const u32x4*)(src + (size_t)pp * 1024 + 8 * ch);
            unsigned char* tp = T + (8 * ch) * P2_TS + pr * 2;
            *(bf16_t*)(tp + 0 * P2_TS) = (bf16_t)(v.x & 0xffffu); *(bf16_t*)(tp + 1 * P2_TS) = (bf16_t)(v.x >> 16);
            *(bf16_t*)(tp + 2 * P2_TS) = (bf16_t)(v.y & 0xffffu); *(bf16_t*)(tp + 3 * P2_TS) = (bf16_t)(v.y >> 16);
            *(bf16_t*)(tp + 4 * P2_TS) = (bf16_t)(v.z & 0xffffu); *(bf16_t*)(tp + 5 * P2_TS) = (bf16_t)(v.z >> 16);
            *(bf16_t*)(tp + 6 * P2_TS) = (bf16_t)(v.w & 0xffffu); *(bf16_t*)(tp + 7 * P2_TS) = (bf16_t)(v.w >> 16);
        }
        __builtin_amdgcn_s_waitcnt(0); __builtin_amdgcn_wave_barrier();
        bf16_t* VT = (bf16_t*)(ws + WS_VT) + (size_t)h * 64 * KVROWS + 64 * blk;
#pragma unroll
        for (int it = 0; it < 8; ++it) {
            const int e = 8 * it + (lane >> 3), ch = lane & 7;
            const u32x2 lo = *(const u32x2*)(T + e * P2_TS + 16 * ch), hi = *(const u32x2*)(T + e * P2_TS + 16 * ch + 8);
            *(u32x4*)(VT + (size_t)e * KVROWS + 8 * ch) = (u32x4){lo.x, lo.y, hi.x, hi.y};
        }
        __builtin_amdgcn_s_waitcnt(0); __builtin_amdgcn_wave_barrier();
    }
}

constexpr int A_KSTR = 208;
constexpr int A_VSTR = 136;
constexpr int A_KBYTES = 64 * A_KSTR;
constexpr int A_VBYTES = 64 * A_VSTR;
constexpr int A_BUF = A_KBYTES + A_VBYTES;
DI unsigned cvtpk_s(float lo, float hi) { typedef float f2 __attribute__((ext_vector_type(2))); typedef __bf16 b2 __attribute__((ext_vector_type(2))); f2 v = {lo, hi}; b2 b = __builtin_convertvector(v, b2); return __builtin_bit_cast(unsigned, b); }

DI void attn_item(const Frame& F, const Args& A, int h, int qb) {
    unsigned char* ws = A.ws; unsigned char* lds = F.lds;
    const int tid = F.tid, lane = F.lane, wave = F.wave, r32 = lane & 31, hh = lane >> 5;
    const bf16_t* Qg = (const bf16_t*)(ws + WS_Q) + (size_t)h * KVROWS * 96;
    const bf16_t* Kg = (const bf16_t*)(ws + WS_K) + (size_t)h * KVROWS * 96;
    const bf16_t* Vg = (const bf16_t*)(ws + WS_VT) + (size_t)h * 64 * KVROWS;
    const int p0w = 64 + 256 * qb + 32 * wave;
    const int qp = p0w + r32;
    const int ntile = 4 * qb + 5;
    const int mylast = 1 + 4 * qb + (wave >> 1);
    bf16x8 qf[6];
#pragma unroll
    for (int s = 0; s < 6; ++s) qf[s] = *(const bf16x8*)(Qg + (size_t)qp * 96 + 16 * s + 8 * hh);
    f32x16 ot[2]; ot[0] = zero16(); ot[1] = zero16();
    float mrun = -1e30f, lrun = 0.f;
    const int kr0 = tid / 12, kc0 = tid % 12, kr1 = (tid + 512) / 12, kc1 = (tid + 512) % 12; const bool k1ok = tid < 256;
    const int vr = tid >> 3, vc = tid & 7;
    u32x4 sk0, sk1, sv;
    auto gload = [&](int j) {
        const int kv0 = 64 * j;
        sk0 = *(const u32x4*)(Kg + (size_t)(kv0 + kr0) * 96 + kc0 * 8);
        if (k1ok) sk1 = *(const u32x4*)(Kg + (size_t)(kv0 + kr1) * 96 + kc1 * 8);
        sv = *(const u32x4*)(Vg + (size_t)vr * KVROWS + kv0 + vc * 8);
    };
    auto lstore = [&](int b) {
        unsigned char* kb = lds + b * A_BUF; unsigned char* vb = kb + A_KBYTES;
        *(u32x4*)(kb + kr0 * A_KSTR + kc0 * 16) = sk0;
        if (k1ok) *(u32x4*)(kb + kr1 * A_KSTR + kc1 * 16) = sk1;
        *(u32x2*)(vb + vr * A_VSTR + vc * 16) = (u32x2){sv.x, sv.y};
        *(u32x2*)(vb + vr * A_VSTR + vc * 16 + 8) = (u32x2){sv.z, sv.w};
    };
    gload(0); lstore(0);
    __syncthreads();
#pragma unroll 1
    for (int j = 0; j < ntile; ++j) {
        const int b = j & 1;
        if (j + 1 < ntile) gload(j + 1);
        if (j <= mylast) {
            const unsigned char* kb = lds + b * A_BUF; const unsigned char* vb = kb + A_KBYTES;
            f32x16 sc[2];
#pragma unroll
            for (int kh = 0; kh < 2; ++kh) {
                f32x16 acc = zero16();
                const unsigned char* kp = kb + (32 * kh + r32) * A_KSTR + hh * 16;
#pragma unroll
                for (int s = 0; s < 6; ++s) acc = mfma32(*(const bf16x8*)(kp + s * 32), qf[s], acc);
                sc[kh] = acc;
            }
            if (j == 0) {
#pragma unroll
                for (int kh = 0; kh < 2; ++kh)
#pragma unroll
                    for (int r = 0; r < 16; ++r) { const int kv = 32 * kh + crow(r, hh); if (kv < PADL) sc[kh][r] = -INFINITY; }
            }
            if (j == mylast) {
#pragma unroll
                for (int kh = 0; kh < 2; ++kh)
#pragma unroll
                    for (int r = 0; r < 16; ++r) { const int kv = 64 * j + 32 * kh + crow(r, hh); if (kv > qp) sc[kh][r] = -INFINITY; }
            }
            float mx = sc[0][0];
#pragma unroll
            for (int r = 1; r < 16; ++r) mx = fmaxf(mx, sc[0][r]);
#pragma unroll
            for (int r = 0; r < 16; ++r) mx = fmaxf(mx, sc[1][r]);
            mx = fmaxf(mx, __shfl_xor(mx, 32));
            const float mnew = fmaxf(mrun, mx);
            const float alpha = __builtin_amdgcn_exp2f(mrun - mnew);
            mrun = mnew;
            float ps = 0.f;
#pragma unroll
            for (int kh = 0; kh < 2; ++kh)
#pragma unroll
                for (int r = 0; r < 16; ++r) { const float e = __builtin_amdgcn_exp2f(sc[kh][r] - mnew); sc[kh][r] = e; ps += e; }
            lrun = lrun * alpha + ps;
#pragma unroll
            for (int eh = 0; eh < 2; ++eh)
#pragma unroll
                for (int r = 0; r < 16; ++r) ot[eh][r] *= alpha;
#pragma unroll
            for (int kh = 0; kh < 2; ++kh)
#pragma unroll
                for (int s2 = 0; s2 < 2; ++s2) {
                    u32x4 pw; pw.x = cvtpk_s(sc[kh][8 * s2 + 0], sc[kh][8 * s2 + 1]); pw.y = cvtpk_s(sc[kh][8 * s2 + 2], sc[kh][8 * s2 + 3]);
                    pw.z = cvtpk_s(sc[kh][8 * s2 + 4], sc[kh][8 * s2 + 5]); pw.w = cvtpk_s(sc[kh][8 * s2 + 6], sc[kh][8 * s2 + 7]);
                    const bf16x8 pf = __builtin_bit_cast(bf16x8, pw);
#pragma unroll
                    for (int eh = 0; eh < 2; ++eh) {
                        const unsigned char* vp = vb + (32 * eh + r32) * A_VSTR + (32 * kh + 16 * s2 + 4 * hh) * 2;
                        const u32x2 lo = *(const u32x2*)vp, hi2 = *(const u32x2*)(vp + 16);
                        const bf16x8 vf = __builtin_bit_cast(bf16x8, (u32x4){lo.x, lo.y, hi2.x, hi2.y});
                        ot[eh] = mfma32(vf, pf, ot[eh]);
                    }
                }
        }
        if (j + 1 < ntile) lstore(b ^ 1);
        __syncthreads();
    }
    const float ltot = lrun + __shfl_xor(lrun, 32);
    const float rl = 1.f / ltot;
    bf16_t* o = (bf16_t*)(ws + WS_MIX) + (size_t)(qp - 64) * 1024 + 512 + h * 64;
#pragma unroll
    for (int eh = 0; eh < 2; ++eh)
#pragma unroll
        for (int a = 0; a < 4; ++a) {
            const int e = 32 * eh + 8 * a + 4 * hh;
            *(u32x2*)(o + e) = (u32x2){pk2(ot[eh][4 * a] * rl, ot[eh][4 * a + 1] * rl), pk2(ot[eh][4 * a + 2] * rl, ot[eh][4 * a + 3] * rl)};
        }
}

DI void xn_row(const Frame& F, const Args& A, int u) {
    const f32x4* xr = (const f32x4*)(A.out + (size_t)u * DM) + F.lane;
    f32x4 v[4]; float s = 0.f;
#pragma unroll
    for (int j = 0; j < 4; ++j) { v[j] = xr[64 * j]; s += (v[j].x * v[j].x + v[j].y * v[j].y) + (v[j].z * v[j].z + v[j].w * v[j].w); }
    const float rstd = 1.f / sqrtf(wave_sum(s) * (1.f / DM) + EPS);
    unsigned long long* o8 = (unsigned long long*)((bf16_t*)(A.ws + WS_XN) + (size_t)u * DM) + F.lane;
#pragma unroll
    for (int j = 0; j < 4; ++j) { const f32x4 w = ((const f32x4*)A.in[15])[64 * j + F.lane];
        o8[64 * j] = (unsigned long long)pk2(v[j].x * rstd * w.x, v[j].y * rstd * w.y) | ((unsigned long long)pk2(v[j].z * rstd * w.z, v[j].w * rstd * w.w) << 32); }
}

DI unsigned fkey(float v, int idx) { unsigned u = __builtin_bit_cast(unsigned, v); u = (u & 0x80000000u) ? ~u : (u | 0x80000000u); return (u & ~127u) | (unsigned)(127 - idx); }
DI float keyval(unsigned k) { unsigned u = k & ~127u; u = (u & 0x80000000u) ? (u & 0x7fffffffu) : ~u; return __builtin_bit_cast(float, u); }

__device__ const unsigned char PAIR_A[50] = {0,0,0,0,0,0,0,0,0,0,0,0,0,0,0,0, 1,1,1,1,1,1,1,1, 2,2,2,2,2, 3,3,3,3, 4,4,4, 5,5, 6,6, 7,7, 8,9,10,11,12,13,14,15};
__device__ const unsigned char PAIR_B[50] = {0,1,2,3,4,5,6,7,8,9,10,11,12,13,14,15, 0,1,2,3,4,5,6,7, 0,1,2,3,4, 0,1,2,3, 0,1,2, 0,1, 0,1, 0,1, 0,0,0,0,0,0,0,0};

DI void ce_desc(unsigned& a, unsigned& b) { const unsigned mx = a > b ? a : b, mn = a > b ? b : a; a = mx; b = mn; }
template <int BASE, int NK> DI void bitonic_sort16_desc(unsigned (&x)[NK]) {
#pragma unroll
    for (int k = 2; k <= 16; k <<= 1)
#pragma unroll
        for (int j = k >> 1; j > 0; j >>= 1)
#pragma unroll
            for (int i = 0; i < 16; ++i) { const int l = i ^ j; if (l > i) { if ((i & k) == 0) ce_desc(x[BASE + i], x[BASE + l]); else ce_desc(x[BASE + l], x[BASE + i]); } }
}
template <int A0, int B0, int NK> DI void merge_top16(unsigned (&x)[NK]) {
#pragma unroll
    for (int i = 0; i < 16; ++i) { const unsigned p = x[A0 + i], q = x[B0 + 15 - i]; x[A0 + i] = p > q ? p : q; }
#pragma unroll
    for (int j = 8; j > 0; j >>= 1)
#pragma unroll
        for (int i = 0; i < 16; ++i) { const int l = i ^ j; if (l > i) ce_desc(x[A0 + i], x[A0 + l]); }
}
template <int NK> DI void top16_of_128(unsigned (&key)[NK]) {
    bitonic_sort16_desc<0, NK>(key); bitonic_sort16_desc<16, NK>(key); bitonic_sort16_desc<32, NK>(key); bitonic_sort16_desc<48, NK>(key);
    bitonic_sort16_desc<64, NK>(key); bitonic_sort16_desc<80, NK>(key); bitonic_sort16_desc<96, NK>(key); bitonic_sort16_desc<112, NK>(key);
    merge_top16<0, 16, NK>(key); merge_top16<32, 48, NK>(key); merge_top16<64, 80, NK>(key); merge_top16<96, 112, NK>(key);
    merge_top16<0, 32, NK>(key); merge_top16<64, 96, NK>(key);
    merge_top16<0, 64, NK>(key);
}

DI void topk_task(const Frame& F, const Args& A, int task) {
    unsigned char* ws = A.ws; const int tid = F.tid;
    const int u = task >> 3, h = task & 7;
    LAS unsigned* sk = (LAS unsigned*)(LAS unsigned char*)F.lds;
    LAS unsigned* pkk = sk + 16384;
    LAS float* stg = (LAS float*)(sk + 16384);
    const float* SCb = (const float*)(ws + WS_SC) + (size_t)(task & ~511) * 256;
#pragma unroll 1
    for (int half = 0; half < 2; ++half) {
        unsigned key[128];
#pragma unroll
        for (int qb = 0; qb < 4; ++qb) {
            u32x4 pf[8];
#pragma unroll
            for (int k = 0; k < 8; ++k) { const int c = tid + 512 * k; pf[k] = *(const u32x4*)(SCb + (size_t)(c >> 3) * 256 + half * 128 + qb * 32 + (c & 7) * 4); }
#pragma unroll
            for (int k = 0; k < 8; ++k) { const int c = tid + 512 * k; *(LAS u32x4*)(stg + (c >> 3) * 36 + (c & 7) * 4) = pf[k]; }
            __syncthreads();
#pragma unroll
            for (int i = 0; i < 8; ++i) { const f32x4 v = *(const LAS f32x4*)(stg + tid * 36 + 4 * i);
                key[32 * qb + 4 * i] = fkey(v.x, 32 * qb + 4 * i); key[32 * qb + 4 * i + 1] = fkey(v.y, 32 * qb + 4 * i + 1);
                key[32 * qb + 4 * i + 2] = fkey(v.z, 32 * qb + 4 * i + 2); key[32 * qb + 4 * i + 3] = fkey(v.w, 32 * qb + 4 * i + 3); }
            __syncthreads();
        }
        top16_of_128(key);
#pragma unroll
        for (int r = 0; r < 16; ++r) sk[(half * 16 + r) * 512 + tid] = key[r];
    }
    float v1[16], v2[16];
#pragma unroll
    for (int r = 0; r < 16; ++r) { v1[r] = keyval(sk[r * 512 + tid]); v2[r] = keyval(sk[(16 + r) * 512 + tid]); }
    unsigned ck[64];
#pragma unroll
    for (int c = 50; c < 64; ++c) ck[c] = 0u;
#pragma unroll
    for (int a = 0; a < 16; ++a) {
        const int off = a == 0 ? 0 : a == 1 ? 16 : a == 2 ? 24 : a == 3 ? 29 : a == 4 ? 33 : a == 5 ? 36 : a == 6 ? 38 : a == 7 ? 40 : 42 + (a - 8);
#pragma unroll
        for (int b = 0; b < 16; ++b) if ((a + 1) * (b + 1) <= 16) ck[off + b] = fkey(v1[a] + v2[b], off + b);
    }
    bitonic_sort16_desc<0, 64>(ck); bitonic_sort16_desc<16, 64>(ck); bitonic_sort16_desc<32, 64>(ck); bitonic_sort16_desc<48, 64>(ck);
    merge_top16<0, 16, 64>(ck); merge_top16<32, 48, 64>(ck); merge_top16<0, 32, 64>(ck);
#pragma unroll
    for (int r = 0; r < 16; ++r) pkk[r * 512 + tid] = ck[r];
    const float cmax = keyval(pkk[tid]);
    float ev[16]; float esum = 0.f; int ex[16];
#pragma unroll
    for (int r = 0; r < 16; ++r) {
        const unsigned k = pkk[r * 512 + tid]; const int c = 127 - (int)(k & 127u);
        ev[r] = __expf(keyval(k) - cmax); esum += ev[r];
        const int a = PAIR_A[c], b = PAIR_B[c];
        const int i1 = 127 - (int)(sk[a * 512 + tid] & 127u), i2 = 127 - (int)(sk[(16 + b) * 512 + tid] & 127u);
        ex[r] = i1 * 128 + i2;
    }
    const float rs = 1.f / esum;
    int* IDX = (int*)(ws + WS_IDX) + (size_t)u * 128 + h * 16; float* GATE = (float*)(ws + WS_GATE) + (size_t)u * 128 + h * 16;
#pragma unroll
    for (int r = 0; r < 16; r += 4) {
        *(int4*)(IDX + r) = make_int4(ex[r], ex[r + 1], ex[r + 2], ex[r + 3]);
        *(f32x4*)(GATE + r) = (f32x4){ev[r] * rs, ev[r + 1] * rs, ev[r + 2] * rs, ev[r + 3] * rs};
    }
}

constexpr float EU_SCALE = 64.f, EV_SCALE = 16.f;
DI unsigned pk4_fp8(float a, float b, float c, float d) { int w = 0; w = __builtin_amdgcn_cvt_pk_fp8_f32(a, b, w, false); w = __builtin_amdgcn_cvt_pk_fp8_f32(c, d, w, true); return (unsigned)w; }
DI void convert_tables(const Frame& F, const Args& A) {
    const size_t n16 = (size_t)16384 * 1024 / 16;
    const size_t gt = (size_t)blockIdx.x * 512 + F.tid, NGT = (size_t)F.G * 512;
#pragma unroll 1
    for (int t = 0; t < 2; ++t) {
        const float* src = A.in[18 + t]; unsigned char* dst = A.ws + (t ? WS_EV : WS_EU); const float sc = t ? EV_SCALE : EU_SCALE;
        for (size_t i = gt; i < n16; i += NGT) {
            const f32x4 a = *(const f32x4*)(src + i * 16) * sc, b = *(const f32x4*)(src + i * 16 + 4) * sc, c = *(const f32x4*)(src + i * 16 + 8) * sc, d = *(const f32x4*)(src + i * 16 + 12) * sc;
            const size_t e_ = i >> 6, c16_ = i & 63;
            *(u32x4*)(dst + (c16_ >> 3) * ((size_t)16384 * 128) + e_ * 128 + (c16_ & 7) * 16) = (u32x4){pk4_fp8(a.x, a.y, a.z, a.w), pk4_fp8(b.x, b.y, b.z, b.w), pk4_fp8(c.x, c.y, c.z, c.w), pk4_fp8(d.x, d.y, d.z, d.w)};
        }
    }
}

DI float gelu_exact(float x) { return 0.5f * x * (1.f + erff(x * 0.70710678118654752f)); }
typedef float f32x2 __attribute__((ext_vector_type(2)));
#define UNPK16(dst, W_) do { f32x2 _t; \
    _t = __builtin_amdgcn_cvt_pk_f32_fp8((int)(W_).x, false); dst[0] = _t.x; dst[1] = _t.y; _t = __builtin_amdgcn_cvt_pk_f32_fp8((int)(W_).x, true); dst[2] = _t.x; dst[3] = _t.y; \
    _t = __builtin_amdgcn_cvt_pk_f32_fp8((int)(W_).y, false); dst[4] = _t.x; dst[5] = _t.y; _t = __builtin_amdgcn_cvt_pk_f32_fp8((int)(W_).y, true); dst[6] = _t.x; dst[7] = _t.y; \
    _t = __builtin_amdgcn_cvt_pk_f32_fp8((int)(W_).z, false); dst[8] = _t.x; dst[9] = _t.y; _t = __builtin_amdgcn_cvt_pk_f32_fp8((int)(W_).z, true); dst[10] = _t.x; dst[11] = _t.y; \
    _t = __builtin_amdgcn_cvt_pk_f32_fp8((int)(W_).w, false); dst[12] = _t.x; dst[13] = _t.y; _t = __builtin_amdgcn_cvt_pk_f32_fp8((int)(W_).w, true); dst[14] = _t.x; dst[15] = _t.y; } while (0)

template <bool UPH>
DI void expert_phase(const Frame& F, const Args& A, int xv, int wq, int nw) {
    unsigned char* ws = A.ws; const int lane = F.lane, grp = lane >> 3, j = lane & 7;
    const unsigned char* TBL = ws + (UPH ? WS_EU : WS_EV) + (size_t)xv * ((size_t)16384 * 128) + 16 * j;
    const int* IDX = (const int*)(ws + WS_IDX); const float* CW = (const float*)(ws + WS_CW);
    const bf16_t* XN = (const bf16_t*)(ws + WS_XN) + 128 * xv + 16 * j;
    float* HP = (float*)(ws + WS_HP);
    LAS unsigned* ring = (LAS unsigned*)((LAS unsigned char*)F.lds + F.wave * 4096);
    const int nt = (MU - wq + nw - 1) / nw;
    if (nt <= 0) return;
    auto tok = [&](int k) { return __builtin_amdgcn_readfirstlane(wq + (k < nt ? k : nt - 1) * nw); };
    int mi0, mi1; u32x4 mx0, mx1; float mh0, mh1;
    auto meta_load = [&](int k) {
        const int u = tok(k);
        mi0 = IDX[(size_t)u * 128 + lane]; mi1 = IDX[(size_t)u * 128 + 64 + lane];
        if constexpr (UPH) { mx0 = *(const u32x4*)(XN + (size_t)u * DM); mx1 = *(const u32x4*)(XN + (size_t)u * DM + 8); }
        else { mh0 = CW[(size_t)u * 128 + lane]; mh1 = CW[(size_t)u * 128 + 64 + lane]; }
    };
    auto meta_store = [&](int k) {
        LAS unsigned* sl = ring + (k & 3) * 256;
        sl[lane] = (unsigned)mi0; sl[64 + lane] = (unsigned)mi1;
        if constexpr (UPH) { if (grp == 0) { *(LAS u32x4*)(sl + 128 + 8 * j) = mx0; *(LAS u32x4*)(sl + 128 + 8 * j + 4) = mx1; } }
        else { sl[128 + lane] = __builtin_bit_cast(unsigned, mh0); sl[192 + lane] = __builtin_bit_cast(unsigned, mh1); }
    };
    auto gather = [&](u32x4 (&buf)[8], int n) {
        const LAS unsigned* sl = ring + ((n >> 1) & 3) * 256 + 64 * (n & 1) + grp;
#pragma unroll
        for (int i = 0; i < 8; ++i) { const int e = (int)sl[8 * i]; buf[i] = *(const u32x4*)(TBL + (size_t)e * 128); }
    };
    const int ocol = 128 * xv + 16 * j + ((lane & 32) ? 8 : 0) + ((lane & 16) ? 4 : 0) + ((lane & 8) ? 2 : 0);
    f32x2 ocur = (f32x2){0.f, 0.f};
    float acc[16];
    float xn[16];
    auto compute = [&](u32x4 (&buf)[8], int n) {
        const int k = n >> 1, hf = n & 1;
        const LAS unsigned* sl = ring + (k & 3) * 256;
        if (hf == 0) {
            if constexpr (UPH) {
                const u32x4 x0 = *(const LAS u32x4*)(sl + 128 + 8 * j), x1 = *(const LAS u32x4*)(sl + 128 + 8 * j + 4);
                xn[0] = bflo(x0.x); xn[1] = bfhi(x0.x); xn[2] = bflo(x0.y); xn[3] = bfhi(x0.y); xn[4] = bflo(x0.z); xn[5] = bfhi(x0.z); xn[6] = bflo(x0.w); xn[7] = bfhi(x0.w);
                xn[8] = bflo(x1.x); xn[9] = bfhi(x1.x); xn[10] = bflo(x1.y); xn[11] = bfhi(x1.y); xn[12] = bflo(x1.z); xn[13] = bfhi(x1.z); xn[14] = bflo(x1.w); xn[15] = bfhi(x1.w);
            } else {
#pragma unroll
                for (int c = 0; c < 16; ++c) acc[c] = 0.f;
                ocur = *(const f32x2*)(A.out + (size_t)tok(k) * DM + ocol);
            }
        }
#pragma unroll
        for (int i = 0; i < 8; ++i) {
            float f[16]; UNPK16(f, buf[i]);
            if constexpr (UPH) {
                float a0 = 0.f, a1 = 0.f;
#pragma unroll
                for (int c = 0; c < 16; c += 2) { a0 += f[c] * xn[c]; a1 += f[c + 1] * xn[c + 1]; }
                if (hf == 0) acc[i] = a0 + a1; else acc[8 + i] = a0 + a1;
                if (i < 7) { if (hf == 0) asm volatile("" : "+v"(buf[i + 1].x), "+v"(buf[i + 1].y), "+v"(buf[i + 1].z), "+v"(buf[i + 1].w), "+v"(acc[i]));
                             else asm volatile("" : "+v"(buf[i + 1].x), "+v"(buf[i + 1].y), "+v"(buf[i + 1].z), "+v"(buf[i + 1].w), "+v"(acc[8 + i])); }
            } else {
                const float cw = __builtin_bit_cast(float, sl[128 + 64 * hf + 8 * i + grp]);
#pragma unroll
                for (int c = 0; c < 16; ++c) acc[c] += cw * f[c];
                if (i < 7) asm volatile("" : "+v"(buf[i + 1].x), "+v"(buf[i + 1].y), "+v"(buf[i + 1].z), "+v"(buf[i + 1].w),
                                             "+v"(acc[0]), "+v"(acc[1]), "+v"(acc[2]), "+v"(acc[3]), "+v"(acc[4]), "+v"(acc[5]), "+v"(acc[6]), "+v"(acc[7]),
                                             "+v"(acc[8]), "+v"(acc[9]), "+v"(acc[10]), "+v"(acc[11]), "+v"(acc[12]), "+v"(acc[13]), "+v"(acc[14]), "+v"(acc[15]));
            }
            __builtin_amdgcn_sched_barrier(0);
        }
        if (hf == 1 && k < nt) {
            const int u = tok(k);
            float r8[8], r4[4], r2[2];
            if constexpr (UPH) {
                { const bool up = lane & 4;
#pragma unroll
                  for (int i = 0; i < 8; ++i) { const float send = up ? acc[i] : acc[i + 8], keep = up ? acc[i + 8] : acc[i]; r8[i] = keep + __shfl_xor(send, 4); } }
                { const bool up = lane & 2;
#pragma unroll
                  for (int i = 0; i < 4; ++i) { const float send = up ? r8[i] : r8[i + 4], keep = up ? r8[i + 4] : r8[i]; r4[i] = keep + __shfl_xor(send, 2); } }
                { const bool up = lane & 1;
#pragma unroll
                  for (int i = 0; i < 2; ++i) { const float send = up ? r4[i] : r4[i + 2], keep = up ? r4[i + 2] : r4[i]; r2[i] = keep + __shfl_xor(send, 1); } }
                const int st = ((lane & 4) ? 8 : 0) + ((lane & 2) ? 4 : 0) + ((lane & 1) ? 2 : 0);
                float* hp = HP + ((size_t)xv * MU + u) * 128 + grp;
                hp[8 * st] = r2[0]; hp[8 * (st + 1)] = r2[1];
            } else {
                { const bool up = lane & 32;
#pragma unroll
                  for (int c = 0; c < 8; ++c) { const float send = up ? acc[c] : acc[c + 8], keep = up ? acc[c + 8] : acc[c]; r8[c] = keep + __shfl_xor(send, 32); } }
                { const bool up = lane & 16;
#pragma unroll
                  for (int c = 0; c < 4; ++c) { const float send = up ? r8[c] : r8[c + 4], keep = up ? r8[c + 4] : r8[c]; r4[c] = keep + __shfl_xor(send, 16); } }
                { const bool up = lane & 8;
#pragma unroll
                  for (int c = 0; c < 2; ++c) { const float send = up ? r4[c] : r4[c + 2], keep = up ? r4[c + 2] : r4[c]; r2[c] = keep + __shfl_xor(send, 8); } }
                f32x2* o = (f32x2*)(A.out + (size_t)u * DM + ocol);
                f32x2 cur = ocur; cur.x += r2[0]; cur.y += r2[1]; *o = cur;
            }
        }
    };
    meta_load(0); meta_store(0); meta_load(1); meta_store(1); meta_load(2); meta_store(2);
    u32x4 b0[8], b1[8], b2[8];
    gather(b0, 0); gather(b1, 1); gather(b2, 2);
#pragma unroll 1
    for (int k0 = 0; k0 < nt; k0 += 3) {
        const int n0 = 2 * k0;
        meta_load(k0 + 3);
        compute(b0, n0);     gather(b0, n0 + 3);
        compute(b1, n0 + 1); meta_store(k0 + 3); gather(b1, n0 + 4);
        meta_load(k0 + 4);
        compute(b2, n0 + 2); gather(b2, n0 + 5);
        compute(b0, n0 + 3); meta_store(k0 + 4); gather(b0, n0 + 6);
        meta_load(k0 + 5);
        compute(b1, n0 + 4); gather(b1, n0 + 7);
        compute(b2, n0 + 5); meta_store(k0 + 5); gather(b2, n0 + 8);
    }
}


DI void expert_c_pass(const Frame& F, const Args& A) {
    unsigned char* ws = A.ws;
    const float* HP = (const float*)(ws + WS_HP); const float* GATE = (const float*)(ws + WS_GATE); float* CW = (float*)(ws + WS_CW);
    const size_t n4 = (size_t)MU * 128 / 4;
    for (size_t i = (size_t)blockIdx.x * 512 + F.tid; i < n4; i += (size_t)F.G * 512) {
        f32x4 h = *(const f32x4*)(HP + i * 4);
#pragma unroll
        for (int x = 1; x < 8; ++x) h += *(const f32x4*)(HP + (size_t)x * MU * 128 + i * 4);
        const f32x4 g = *(const f32x4*)(GATE + i * 4);
        f32x4 c;
        c.x = gelu_exact(h.x * (1.f / EU_SCALE)) * g.x * (1.f / EV_SCALE); c.y = gelu_exact(h.y * (1.f / EU_SCALE)) * g.y * (1.f / EV_SCALE);
        c.z = gelu_exact(h.z * (1.f / EU_SCALE)) * g.z * (1.f / EV_SCALE); c.w = gelu_exact(h.w * (1.f / EU_SCALE)) * g.w * (1.f / EV_SCALE);
        *(f32x4*)(CW + i * 4) = c;
    }
}
#ifndef PROBE_VAR
#define PROBE_VAR 0
#endif
template <int PH> DI void run_phase(const Frame& F, const Args& args, PG8_LAS unsigned char* lds3) {
    unsigned char* ws = args.ws;
    if constexpr (PH == 0) { p0_prologue(F, args); }
    if constexpr (PH == 1) {
        pg8::Gemm g{(const bf16_t*)(ws + WS_HN), (const bf16_t*)(ws + WS_WIN), MP, NPROJ, 1024, 1024, 1024, 0};
        pg8::StaticOrder S; S.init(MP, NPROJ, F.G, (int)blockIdx.x);
        EpiProj E{(bf16_t*)(ws + WS_QKVR), (bf16_t*)(ws + WS_Z), (float*)(ws + WS_P32)};
        pg8::gemm_phase<EpiProj, pg8::StaticOrder, true, true>(lds3, g, S, E);
    }
    if constexpr (PH == 2) { gdn_prep_phase<0>(F, args); }
    if constexpr (PH == 102) { gdn_prep_phase<PROBE_VAR>(F, args); }
    if constexpr (PH == 3) { gdn_scan(F, args); }
    if constexpr (PH == 4) {
        for (int t = F.gw; t < 2048 * 2; t += F.NGW) gdn_out_task(F, args, t);
        for (int p = F.gw; p < MP; p += F.NGW) mla_prep1_row(F, args, p);
    }
    if constexpr (PH == 5) {
        { pg8::Gemm g{(const bf16_t*)(ws + WS_CQN), (const bf16_t*)(ws + WS_WUQ), MP, 768, 256, 256, 256, 0};
          pg8::StaticOrder S; S.init(MP, 768, F.G, (int)blockIdx.x); EpiB16 E{(bf16_t*)(ws + WS_QH), 768};
          pg8::gemm_phase<EpiB16, pg8::StaticOrder, true, true>(lds3, g, S, E); }
        { pg8::Gemm g{(const bf16_t*)(ws + WS_CKVN), (const bf16_t*)(ws + WS_WUKV), MP, 1024, 256, 256, 256, 0};
          pg8::StaticOrder S; S.init(MP, 1024, F.G, (int)blockIdx.x); EpiB16 E{(bf16_t*)(ws + WS_KVB), 1024};
          pg8::gemm_phase<EpiB16, pg8::StaticOrder, true, true>(lds3, g, S, E); }
    }
    if constexpr (PH == 6) { for (int t = F.gw; t < (KVROWS / 64) * 8; t += F.NGW) mla_prep2_task(F, args, t); }
    if constexpr (PH == 7) {
        for (int rep = 0; rep < 2; ++rep) {
            for (int k0 = blockIdx.x; k0 < 256; k0 += F.G) {
                const int k = rep == 0 ? k0 : 511 - k0;
                attn_item(F, args, k & 7, 63 - (k >> 3));
            }
        }
    }
    if constexpr (PH == 8) {
        pg8::Gemm g{(const bf16_t*)(ws + WS_MIX), (const bf16_t*)(ws + WS_WOUT), MU, 1024, 1024, 1024, 1024, 0};
        pg8::StaticOrder S; S.init(MU, 1024, F.G, (int)blockIdx.x); EpiF32 E{args.out, 1024, args.in[0]};
        pg8::gemm_phase<EpiF32, pg8::StaticOrder, true, true>(lds3, g, S, E);
    }
    if constexpr (PH == 9) { for (int u = F.gw; u < MU; u += F.NGW) xn_row(F, args, u); }
    if constexpr (PH == 10) {
        pg8::Gemm g{(const bf16_t*)(ws + WS_XN), (const bf16_t*)(ws + WS_WPQ), MU, 2048, 1024, 1024, 1024, 0};
        pg8::StaticOrder S; S.init(MU, 2048, F.G, (int)blockIdx.x); EpiB16 E{(bf16_t*)(ws + WS_PQ), 2048};
        pg8::gemm_phase<EpiB16, pg8::StaticOrder, true, true>(lds3, g, S, E);
    }
    if constexpr (PH == 11) {
        pg8::Gemm g{(const bf16_t*)(ws + WS_PQ), (const bf16_t*)(ws + WS_SKB), MU, 2048, 256, 2048, 256, 256};
        pg8::StaticOrder S; S.init(MU, 2048, F.G, (int)blockIdx.x); EpiF32 E{(float*)(ws + WS_SC), 2048, nullptr};
        pg8::gemm_phase<EpiF32, pg8::StaticOrder, true, true>(lds3, g, S, E);
    }
    if constexpr (PH == 12) {
        convert_tables(F, args);
        for (int t = blockIdx.x * 512 + F.tid; t < MU * 8; t += F.G * 512) topk_task(F, args, t);
    }
    if constexpr (PH == 14) { expert_c_pass(F, args); }
    if constexpr (PH == 13 || PH == 15) {
        volatile LAS unsigned* MISC = (volatile LAS unsigned*)(lds3 + MISC_OFF);
        const unsigned x = MISC[16], rank = MISC[17];
        unsigned* bar = (unsigned*)(ws + WS_CTL);
        unsigned nloc = 0, nx = 0, myidx = 0;
#pragma unroll
        for (unsigned j = 0; j < 16; ++j) { const unsigned c = xb_ld(&bar[XB_XCNT(j)]); nx += (c > 0u) ? 1u : 0u; myidx += (c > 0u && j < x) ? 1u : 0u; nloc = (j == x) ? c : nloc; }
        const int wq = __builtin_amdgcn_readfirstlane((int)rank * 8 + F.wave), nw = __builtin_amdgcn_readfirstlane((int)nloc * 8);
        const int xstep = __builtin_amdgcn_readfirstlane((int)nx);
        for (int xv = __builtin_amdgcn_readfirstlane((int)myidx); xv < 8; xv += xstep)
            { if constexpr (PH == 13) expert_phase<true>(F, args, xv, wq, nw); else expert_phase<false>(F, args, xv, wq, nw); }
    }
}
constexpr int NPHASE = 16;
__global__ void __launch_bounds__(512, 2) fwd_kernel(Args args) {
    extern __shared__ __attribute__((aligned(16))) unsigned char lds[];
    Frame F;
    F.lds = lds; F.tid = threadIdx.x; F.lane = F.tid & 63; F.wave = __builtin_amdgcn_readfirstlane(F.tid >> 6);
    F.G = gridDim.x; F.gw = blockIdx.x * 8 + F.wave; F.NGW = F.G * 8;
    volatile LAS unsigned* MISC = (volatile LAS unsigned*)((LAS unsigned char*)lds + MISC_OFF);
    if (F.tid < 32) MISC[F.tid] = 0u;
    __syncthreads();
    unsigned char* ws = args.ws;
    const int lo = args.ph_lo, hi = args.ph_hi;
    XcdBarrier bar; bar.bar = (unsigned*)(ws + WS_CTL); bar.x = 0; bar.st = nullptr;
    if (hi - lo > 1) bar = xcd_barrier_post((unsigned*)(ws + WS_CTL), MISC + 8);
    if (F.tid == 0) { const unsigned x = xb_xcc_id(); MISC[16] = x; MISC[17] = xb_add((unsigned*)(ws + WS_CTL) + 3520 + 64 * x, 1u); }
    __syncthreads();
#define IN(k) (lo <= (k) && (k) < hi)
#define SEAM(k) do { if (IN(k) && IN((k) + 1)) xcd_barrier(bar); } while (0)
    PG8_LAS unsigned char* lds3 = (PG8_LAS unsigned char*)lds;

#ifndef PROBE_REPEAT
#define PROBE_REPEAT -1
#endif
#ifndef PROBE_TIME
#define PROBE_TIME -1
#endif
#ifndef PROBE_TSEL
#define PROBE_TSEL 0
#endif
    unsigned long long pt_ticks = 0ull;
#define PHASE(k) do { unsigned long long pt0_ = 0ull; if (PROBE_TIME == (k)) pt0_ = __builtin_amdgcn_s_memrealtime(); \
        if (IN(k)) { run_phase<k>(F, args, lds3); if (PROBE_REPEAT == (k)) { xcd_barrier(bar); run_phase<(PROBE_VAR && (k) == 2) ? 102 : (k)>(F, args, lds3); } } \
        if (PROBE_TIME == (k) && PROBE_TSEL == 1) pt_ticks = __builtin_amdgcn_s_memrealtime() - pt0_;     \
        if (PROBE_TIME == (k) && PROBE_TSEL == 2) pt0_ = __builtin_amdgcn_s_memrealtime();                \
        SEAM(k); \
        if (PROBE_TIME == (k) && PROBE_TSEL != 1) pt_ticks = __builtin_amdgcn_s_memrealtime() - pt0_; } while (0)
    PHASE(0); PHASE(1); PHASE(2); PHASE(3); PHASE(4); PHASE(5); PHASE(6); PHASE(7); PHASE(8); PHASE(9); PHASE(10); PHASE(11); PHASE(12); PHASE(13); PHASE(14); PHASE(15);
#undef PHASE
    if (PROBE_STAGE >= 0) { __syncthreads(); pt_ticks = *(volatile unsigned long long*)(lds + 143360 + 96); }
    if (PROBE_TIME >= 0 || PROBE_STAGE >= 0) { const unsigned long long t0_ = __builtin_amdgcn_s_memrealtime(); while (__builtin_amdgcn_s_memrealtime() - t0_ < 4ull * pt_ticks) __builtin_amdgcn_s_sleep(32); }
#undef IN
#undef SEAM
}

#ifndef N_LAUNCHES
#define N_LAUNCHES 1
#endif
extern "C" void kernel_launch(void* const* d_in, const int* in_sizes, int n_in, void* d_out, int out_size, void* d_ws, size_t ws_size, hipStream_t stream) {
    static int grid = 0;
    if (grid == 0) {
        if (n_in != 20 || out_size != MU * DM || ws_size < WS_END) { fprintf(stderr, "kernel_launch: unexpected shapes (n_in %d out %d ws %zu)\n", n_in, out_size, ws_size); grid = -1; return; }
        int dev = 0, cus = 0, per_cu = 0;
        if (hipGetDevice(&dev) != hipSuccess || hipDeviceGetAttribute(&cus, hipDeviceAttributeMultiprocessorCount, dev) != hipSuccess) { grid = -1; return; }
        if (hipFuncSetAttribute((const void*)fwd_kernel, hipFuncAttributeMaxDynamicSharedMemorySize, LDS_BYTES) != hipSuccess) { fprintf(stderr, "kernel_launch: hipFuncSetAttribute failed\n"); grid = -1; return; }
        if (hipOccupancyMaxActiveBlocksPerMultiprocessor(&per_cu, (const void*)fwd_kernel, 512, LDS_BYTES) != hipSuccess || per_cu < 1) { fprintf(stderr, "kernel_launch: occupancy query says %d\n", per_cu); (void)hipGetLastError(); per_cu = 1; }
        grid = cus;
    }
    if (grid < 0) return;
    (void)hipMemsetAsync((char*)d_ws + WS_CTL, 0, CTL_ZERO_BYTES, stream);
    Args a{};
    for (int i = 0; i < 20; ++i) a.in[i] = (const float*)d_in[i];
    a.out = (float*)d_out; a.ws = (unsigned char*)d_ws;
    for (int li = 0; li < N_LAUNCHES; ++li) {
        a.ph_lo = li * NPHASE / N_LAUNCHES; a.ph_hi = (li + 1) * NPHASE / N_LAUNCHES;
        if (N_LAUNCHES == 1) {
            void* kargs[] = {&a};
            hipError_t e = hipLaunchCooperativeKernel((const void*)fwd_kernel, dim3(grid), dim3(512), kargs, LDS_BYTES, stream);
            if (e != hipSuccess) fprintf(stderr, "cooperative launch failed: %s (grid %d)\n", hipGetErrorString(e), grid);
        } else {
            hipLaunchKernelGGL(fwd_kernel, dim3(grid), dim3(512), LDS_BYTES, stream, a);
        }
    }
}
```

```cpp
#include <hip/hip_runtime.h>
#include <hip/hip_bf16.h>
#include <cstdio>
#include <cstdint>

#define DI __device__ __forceinline__
#define LAS __attribute__((address_space(3)))
#define GAS __attribute__((address_space(1)))

typedef unsigned short bf16_t;
typedef short bf16x8 __attribute__((ext_vector_type(8)));
typedef short s16x4 __attribute__((ext_vector_type(4)));
typedef float f32x4 __attribute__((ext_vector_type(4)));
typedef float f32x16 __attribute__((ext_vector_type(16)));
typedef unsigned u32x4 __attribute__((ext_vector_type(4)));
typedef unsigned u32x2 __attribute__((ext_vector_type(2)));

namespace pg8 {
#define PG8_LAS __attribute__((address_space(3)))
constexpr int BM = 256, BK = 64, HALF = 128, HTB = HALF * BK * 2  , STAGE_BYTES = 8 * HTB, NXCD = 8, WGM = 8;

__host__ __device__ __forceinline__ int lds_byte(int r, int c) { const int st = (r >> 4) * 2 + (c >> 5), rr = r & 15, cc = c & 31, ob = rr * 64 + cc * 2; return st * 1024 + (ob ^ (((ob >> 9) & 1) << 5)); }
__host__ __device__ __forceinline__ void stage_rc(int b, int& R, int& C) { const int st = b / 1024, sb = b % 1024, swz = sb ^ (((sb >> 9) & 1) << 5); R = (st >> 1) * 16 + swz / 64; C = (st & 1) * 32 + (swz % 64) / 2; }
__host__ __device__ __forceinline__ int perm32(int rho) { const int n = rho >> 4, i = rho & 15; return 8 * (i >> 2) + 4 * n + (i & 3); }

struct Unit { int pm, pn; };
struct Gemm { const bf16_t* A; const bf16_t* Bt; int M, N, K, lda, ldb, a_pn_off; };

struct StaticOrder {
    int nM, nN, nwg, G, c;
    __host__ __device__ void init(int M, int N, int G_, int c_) { nM = M / BM; nN = N / BM; nwg = nM * nN; G = G_; c = c_; }
    __host__ __device__ bool next(int i, Unit& u) const {
        const long L = (long)i * G + c; if (L >= nwg) return false;
        int wgid = (int)L; { const int q = nwg / NXCD, r = nwg % NXCD, xcd = wgid % NXCD, off = wgid / NXCD; wgid = (xcd < r ? xcd * (q + 1) : r * (q + 1) + (xcd - r) * q) + off; }
        const int nig = WGM * nN, gid = wgid / nig, fm = gid * WGM, gsz = (nM - fm) < WGM ? (nM - fm) : WGM;
        u.pm = fm + ((wgid % nig) % gsz); u.pn = (wgid % nig) / gsz; return true;
    }
    __device__ __forceinline__ void a_ready(const Unit&) const {}
    __device__ __forceinline__ void done(const Unit&) const {}
};

__device__ __forceinline__ unsigned cvt_pk_bf16(float lo, float hi) { unsigned r; asm volatile("v_cvt_pk_bf16_f32 %0, %1, %2" : "=v"(r) : "v"(lo), "v"(hi)); return r; }

template <class Epi, class Sched, bool ALIGN_EPI = false, bool SP2 = false>
__device__ __forceinline__ void gemm_phase(PG8_LAS unsigned char* lds, const Gemm g, const Sched& S, const Epi& E) {
    const int tid = threadIdx.x, wid = __builtin_amdgcn_readfirstlane(tid >> 6), lane = tid & 63, wr = wid >> 2, wc = wid & 3, fr = lane & 15, fq = lane >> 4;
    const int K = g.K, nt = K / BK;
    unsigned voffA[2], voffB[2];
#pragma unroll
    for (int i = 0; i < 2; ++i) { int R, C; stage_rc(tid * 16 + i * 8192, R, C); const int Rb = Epi::PERM ? ((R & ~31) + perm32(R & 31)) : R;
        voffA[i] = (unsigned)(R * g.lda + C) * 2u; voffB[i] = (unsigned)(Rb * g.ldb + C) * 2u; }
    const size_t kstep = (size_t)(BK * 2);
    const size_t hstepA = (size_t)HALF * g.lda * 2, hstepB = (size_t)HALF * g.ldb * 2;
    const size_t tstepA = 2 * hstepA, tstepB = 2 * hstepB;
    const size_t pnoffA = (size_t)g.a_pn_off * 2;
    const unsigned ldsw = (unsigned)wid * 1024u;
    const int aoff = lds_byte(wr * 64 + fr, fq * 8), boff = lds_byte(wc * 32 + fr, fq * 8);
#define PG8_SA(b, h) (((b) * 2 + (h)) * HTB)
#define PG8_SB(b, h) ((4 + (b) * 2 + (h)) * HTB)
#define PG8_STAGE(bufoff, gbase, voff) do { _Pragma("unroll") for (int _i = 0; _i < 2; ++_i) \
        __builtin_amdgcn_global_load_lds((const unsigned*)((const char*)(gbase) + (voff)[_i]), (PG8_LAS unsigned*)(lds + (bufoff) + ldsw + _i * 8192), 16, 0, 0); } while (0)
#define PG8_LDA(dst, b, h) do { _Pragma("unroll") for (int m = 0; m < 4; ++m) _Pragma("unroll") for (int k = 0; k < 2; ++k) dst[m][k] = *(const PG8_LAS bf16x8*)(lds + PG8_SA(b, h) + aoff + m * 2048 + k * 1024); } while (0)
#define PG8_LDB(dst, b, h) do { _Pragma("unroll") for (int n = 0; n < 2; ++n) _Pragma("unroll") for (int k = 0; k < 2; ++k) dst[n][k] = *(const PG8_LAS bf16x8*)(lds + PG8_SB(b, h) + boff + n * 2048 + k * 1024); } while (0)
#define PG8_MMA(ai, bj, At, Bt) do { __builtin_amdgcn_s_setprio(1); _Pragma("unroll") for (int m = 0; m < 4; ++m) _Pragma("unroll") for (int n = 0; n < 2; ++n) _Pragma("unroll") for (int k = 0; k < 2; ++k) \
        acc[ai][bj][m][n] = __builtin_amdgcn_mfma_f32_16x16x32_bf16(Bt[n][k], At[m][k], acc[ai][bj][m][n], 0, 0, 0); __builtin_amdgcn_s_setprio(0); } while (0)
#define PG8_WAIT_V(n) asm volatile("s_waitcnt vmcnt(" #n ")" ::: "memory")
#define PG8_WAIT_L(n) asm volatile("s_waitcnt lgkmcnt(" #n ")" ::: "memory")
#define PG8_BAR __builtin_amdgcn_s_barrier()
#define PG8_SCHED __builtin_amdgcn_sched_barrier(0)
    Unit cur, nxt; int ui = 0;
    if (!S.next(0, cur)) return;
    f32x4 acc[2][2][4][2];
#pragma unroll
    for (int a = 0; a < 2; ++a)
#pragma unroll
        for (int b = 0; b < 2; ++b)
#pragma unroll
            for (int m = 0; m < 4; ++m)
#pragma unroll
                for (int n = 0; n < 2; ++n) acc[a][b][m][n] = (f32x4){0.f, 0.f, 0.f, 0.f};
    bf16x8 At[4][2], B0[2][2], B1[2][2];
    const char* cA = (const char*)g.A + (size_t)cur.pm * tstepA + (size_t)cur.pn * pnoffA; const char* cB = (const char*)g.Bt + (size_t)cur.pn * tstepB;
    S.a_ready(cur);
    if constexpr (SP2) {
        PG8_STAGE(PG8_SB(0, 0), cB, voffB); PG8_STAGE(PG8_SB(0, 1), cB + hstepB, voffB); PG8_STAGE(PG8_SA(0, 0), cA, voffA); PG8_STAGE(PG8_SA(0, 1), cA + hstepA, voffA);
        if (wr == 1) PG8_BAR;
        PG8_WAIT_V(2); PG8_BAR;
        PG8_STAGE(PG8_SB(1, 0), cB + kstep, voffB); PG8_STAGE(PG8_SA(1, 0), cA + kstep, voffA); PG8_STAGE(PG8_SB(1, 1), cB + hstepB + kstep, voffB);
        PG8_WAIT_V(6); PG8_BAR;
    } else {
        PG8_STAGE(PG8_SB(0, 0), cB, voffB); PG8_STAGE(PG8_SA(0, 0), cA, voffA); PG8_STAGE(PG8_SB(0, 1), cB + hstepB, voffB); PG8_STAGE(PG8_SA(0, 1), cA + hstepA, voffA);
        if (wr == 1) PG8_BAR;
        PG8_WAIT_V(4); PG8_BAR;
        PG8_STAGE(PG8_SB(1, 0), cB + kstep, voffB); PG8_STAGE(PG8_SA(1, 0), cA + kstep, voffA); PG8_STAGE(PG8_SB(1, 1), cB + hstepB + kstep, voffB);
        PG8_WAIT_V(6); PG8_BAR;
    }
    for (;;) {
        const bool has_next = S.next(ui + 1, nxt);
        const char* nA = has_next ? (const char*)g.A + (size_t)nxt.pm * tstepA + (size_t)nxt.pn * pnoffA : cA; const char* nB = has_next ? (const char*)g.Bt + (size_t)nxt.pn * tstepB : cB;
        for (int t = 0; t < nt; t += 2) {
            const bool last = (t == nt - 2);
            const char* a1 = cA + (size_t)(t + 1) * kstep;
            const char* a2 = last ? nA : cA + (size_t)(t + 2) * kstep; const char* b2 = last ? nB : cB + (size_t)(t + 2) * kstep;
            const char* a3 = a2 + kstep; const char* b3 = b2 + kstep;
            if (last && has_next) S.a_ready(nxt);
            if constexpr (SP2) {
            PG8_LDB(B0, 0, 0); PG8_LDB(B1, 0, 1); PG8_SCHED; PG8_LDA(At, 0, 0); PG8_STAGE(PG8_SA(1, 1), a1 + hstepA, voffA);
            PG8_WAIT_V(8); PG8_WAIT_L(0); PG8_BAR; PG8_MMA(0, 0, At, B0); PG8_MMA(0, 1, At, B1); PG8_BAR; PG8_SCHED;
            PG8_LDA(At, 0, 1); PG8_STAGE(PG8_SB(0, 0), b2, voffB); PG8_STAGE(PG8_SB(0, 1), b2 + hstepB, voffB); PG8_STAGE(PG8_SA(0, 0), a2, voffA);
            PG8_WAIT_V(8); PG8_WAIT_L(0); PG8_BAR; PG8_MMA(1, 0, At, B0); PG8_MMA(1, 1, At, B1); PG8_BAR; PG8_SCHED;
            PG8_LDB(B0, 1, 0); PG8_LDB(B1, 1, 1); PG8_SCHED; PG8_LDA(At, 1, 0); PG8_STAGE(PG8_SA(0, 1), a2 + hstepA, voffA);
            PG8_WAIT_V(8); PG8_WAIT_L(0); PG8_BAR; PG8_MMA(0, 0, At, B0); PG8_MMA(0, 1, At, B1); PG8_BAR; PG8_SCHED;
            PG8_LDA(At, 1, 1); PG8_STAGE(PG8_SB(1, 0), b3, voffB); PG8_STAGE(PG8_SB(1, 1), b3 + hstepB, voffB); PG8_STAGE(PG8_SA(1, 0), a3, voffA);
            PG8_WAIT_V(8); PG8_WAIT_L(0); PG8_BAR; PG8_MMA(1, 0, At, B0); PG8_MMA(1, 1, At, B1); PG8_BAR; PG8_SCHED;
            } else {
            PG8_LDB(B0, 0, 0); PG8_SCHED; PG8_LDA(At, 0, 0); PG8_STAGE(PG8_SA(1, 1), a1 + hstepA, voffA);
            PG8_WAIT_L(8); PG8_BAR; PG8_WAIT_L(0); PG8_MMA(0, 0, At, B0); PG8_BAR; PG8_SCHED;
            PG8_LDB(B1, 0, 1); PG8_STAGE(PG8_SB(0, 0), b2, voffB);
            PG8_BAR; PG8_WAIT_L(0); PG8_MMA(0, 1, At, B1); PG8_BAR;
            PG8_LDA(At, 0, 1); PG8_STAGE(PG8_SA(0, 0), a2, voffA);
            PG8_BAR; PG8_WAIT_L(0); PG8_MMA(1, 0, At, B0); PG8_BAR; PG8_SCHED;
            PG8_STAGE(PG8_SB(0, 1), b2 + hstepB, voffB);
            PG8_WAIT_V(6); PG8_BAR; PG8_MMA(1, 1, At, B1); PG8_BAR;
            PG8_LDB(B0, 1, 0); PG8_SCHED; PG8_LDA(At, 1, 0); PG8_STAGE(PG8_SA(0, 1), a2 + hstepA, voffA);
            PG8_WAIT_L(8); PG8_BAR; PG8_WAIT_L(0); PG8_MMA(0, 0, At, B0); PG8_BAR; PG8_SCHED;
            PG8_LDB(B1, 1, 1); PG8_STAGE(PG8_SB(1, 0), b3, voffB);
            PG8_BAR; PG8_WAIT_L(0); PG8_MMA(0, 1, At, B1); PG8_BAR;
            PG8_LDA(At, 1, 1); PG8_STAGE(PG8_SA(1, 0), a3, voffA);
            PG8_BAR; PG8_WAIT_L(0); PG8_MMA(1, 0, At, B0); PG8_BAR; PG8_SCHED;
            PG8_STAGE(PG8_SB(1, 1), b3 + hstepB, voffB);
            PG8_WAIT_V(6); PG8_BAR; PG8_MMA(1, 1, At, B1); PG8_BAR;
            }
        }
        if constexpr (ALIGN_EPI) { if (wr == 0) PG8_BAR; }
        E(acc, cur, wr, wc, fr, fq); S.done(cur);
        if (!has_next) break;
#pragma unroll
        for (int a = 0; a < 2; ++a)
#pragma unroll
            for (int b = 0; b < 2; ++b)
#pragma unroll
                for (int m = 0; m < 4; ++m)
#pragma unroll
                    for (int n = 0; n < 2; ++n) acc[a][b][m][n] = (f32x4){0.f, 0.f, 0.f, 0.f};
        cur = nxt; cA = nA; cB = nB; ++ui;
        if constexpr (ALIGN_EPI) { if (wr == 1) PG8_BAR; }
    }
    PG8_WAIT_V(0);
    if constexpr (!ALIGN_EPI) { if (wr == 0) PG8_BAR; }
    PG8_BAR;
#undef PG8_SA
#undef PG8_SB
#undef PG8_STAGE
#undef PG8_LDA
#undef PG8_LDB
#undef PG8_MMA
#undef PG8_WAIT_V
#undef PG8_WAIT_L
#undef PG8_BAR
#undef PG8_SCHED
}
}

constexpr int DM = 1024;
constexpr int NTOK = 16400;
constexpr int PADL = 48;
constexpr int LPV = 16448;
constexpr int MP = 16640;
constexpr int MU = 16384;
constexpr int NCHUNK = 257;
constexpr int NHEAD = 8;
constexpr int NPROJ = 2560;
constexpr int KVROWS = 16512;
constexpr float EPS = 1e-6f;

constexpr size_t MiB = 1u << 20;
constexpr size_t WS_CTL = 0, CTL_ZERO_BYTES = 64 * 1024;
constexpr size_t WS_WIN = 1 * MiB;
constexpr size_t WS_WUQ = 6 * MiB;
constexpr size_t WS_WUKV = 6 * MiB + 512 * 1024;
constexpr size_t WS_WOUT = 7 * MiB;
constexpr size_t WS_WPQ = 9 * MiB;
constexpr size_t WS_SKB = 13 * MiB;
constexpr size_t WS_IDX = 16 * MiB;
constexpr size_t WS_GATE = 24 * MiB;
constexpr size_t WS_HN = 32 * MiB;
constexpr size_t WS_QKVR = 96 * MiB;
constexpr size_t WS_Z = 96 * MiB + 49 * MiB;
constexpr size_t WS_P32 = 162 * MiB;
constexpr size_t WS_GA = 195 * MiB;
constexpr size_t WS_GQ = 212 * MiB;
constexpr size_t WS_GS = 229 * MiB;
constexpr size_t WS_GB = 32 * MiB;
constexpr size_t WS_GO = 65 * MiB;
constexpr size_t WS_MIX = 96 * MiB;
constexpr size_t WS_CQN = 128 * MiB;
constexpr size_t WS_CKVN = 136 * MiB + 512 * 1024;
constexpr size_t WS_QH = 32 * MiB;
constexpr size_t WS_KVB = 57 * MiB;
constexpr size_t WS_Q = 195 * MiB;
constexpr size_t WS_K = 220 * MiB;
constexpr size_t WS_VT = 145 * MiB;
constexpr size_t WS_XN = 32 * MiB;
constexpr size_t WS_PQ = 64 * MiB;
constexpr size_t WS_SC = 128 * MiB;
constexpr size_t WS_EU = 96 * MiB;
constexpr size_t WS_EV = 112 * MiB;
constexpr size_t WS_CW = 64 * MiB;
constexpr size_t WS_HP = 128 * MiB;
constexpr size_t WS_END = 256 * MiB;

constexpr int LDS_BYTES = 147456;
constexpr int MISC_OFF = 131072 + 12288;

DI unsigned f2bf(float f) { unsigned u = __builtin_bit_cast(unsigned, f); return (u + 0x7fffu + ((u >> 16) & 1u)) >> 16; }
DI unsigned pk2(float lo, float hi) { return f2bf(lo) | (f2bf(hi) << 16); }
DI float bf2f(unsigned b) { return __builtin_bit_cast(float, b << 16); }
DI float bflo(unsigned w) { return __builtin_bit_cast(float, w << 16); }
DI float bfhi(unsigned w) { return __builtin_bit_cast(float, w & 0xffff0000u); }
DI float wave_sum(float v) {
#pragma unroll
    for (int o = 1; o < 64; o <<= 1) v += __shfl_xor(v, o);
    return v;
}
DI float sigmoidf_(float x) { return 1.f / (1.f + __expf(-x)); }
DI float siluf_(float x) { return x / (1.f + __expf(-x)); }

#define XB_TMO      128
#define XB_XCNT(j)  (256  + 64 * (j))
#define XB_XSUB(j)  (1280 + 64 * (j))
#define XB_XGEN(j)  (2304 + 64 * (j))
#define XB_TOP      3328
#define XB_TOPGEN   3392
#define XCD_BAR_WORDS 3456
#define XB_SPIN_CAP (1u << 22)
DI unsigned xb_ld(unsigned* p)              { return __hip_atomic_load(p, __ATOMIC_RELAXED, __HIP_MEMORY_SCOPE_AGENT); }
DI unsigned xb_add(unsigned* p, unsigned v) { return __hip_atomic_fetch_add(p, v, __ATOMIC_RELAXED, __HIP_MEMORY_SCOPE_AGENT); }
DI unsigned xb_xcc_id() { return (unsigned)__builtin_amdgcn_s_getreg((3 << 11) | 20) & 0xFu; }
#define XB_SPIN(cond, bar) do { unsigned _sp = 0; while (cond) { __builtin_amdgcn_s_sleep(1); \
    if ((++_sp & 255u) == 0u) { if (xb_ld(&(bar)[XB_TMO])) break; if (_sp > XB_SPIN_CAP) { atomicAdd(&(bar)[XB_TMO], 1u); break; } } } } while (0)
struct XcdBarrier { unsigned* bar; unsigned x; volatile LAS unsigned* st; };
DI XcdBarrier xcd_barrier_post(unsigned* bar, volatile LAS unsigned* st) {
    XcdBarrier b; b.bar = bar; b.x = xb_xcc_id(); b.st = st;
    if (threadIdx.x == 0) (void)xb_add(&bar[XB_XCNT(b.x)], 1u);
    return b;
}
DI void xcd_barrier_complete(unsigned* bar, unsigned x, unsigned& nloc, unsigned& nx) {
    const unsigned G = gridDim.x * gridDim.y * gridDim.z;
    unsigned sum, cnt, mine, sp = 0u;
    for (;;) {
        sum = 0u; cnt = 0u; mine = 0u;
#pragma unroll
        for (unsigned j = 0; j < 16; ++j) { const unsigned c = xb_ld(&bar[XB_XCNT(j)]); sum += c; cnt += (c > 0u) ? 1u : 0u; mine = (j == x) ? c : mine; }
        if (sum == G) break;
        __builtin_amdgcn_s_sleep(1);
        if ((++sp & 255u) == 0u) { if (xb_ld(&bar[XB_TMO])) break; if (sp > XB_SPIN_CAP) { atomicAdd(&bar[XB_TMO], 1u); break; } }
    }
    nloc = mine > 0u ? mine : 1u; nx = cnt > 0u ? cnt : 1u;
}
DI void xcd_barrier(const XcdBarrier& b) {
    asm volatile("s_waitcnt vmcnt(0)" ::: "memory");
    __syncthreads();
    if (threadIdx.x == 0) {
        unsigned* bar = b.bar;
        __builtin_amdgcn_s_waitcnt(0);
        unsigned nloc = b.st[0], nx = b.st[1];
        if (nloc == 0u) { xcd_barrier_complete(bar, b.x, nloc, nx); b.st[0] = nloc; b.st[1] = nx; }
        const unsigned old = xb_add(&bar[XB_XSUB(b.x)], 1u);
        const unsigned gen = old / nloc;
        if (old + 1u == (gen + 1u) * nloc) {
            __builtin_amdgcn_fence(__ATOMIC_RELEASE, "agent");
            asm volatile("s_waitcnt vmcnt(0)" ::: "memory");
            const unsigned og = xb_add(&bar[XB_TOP], 1u);
            const unsigned tg = og / nx;
            if (og + 1u == (tg + 1u) * nx) xb_add(&bar[XB_TOPGEN], 1u);
            else XB_SPIN(xb_ld(&bar[XB_TOPGEN]) == tg, bar);
            __builtin_amdgcn_fence(__ATOMIC_ACQUIRE, "agent");
            xb_add(&bar[XB_XGEN(b.x)], 1u);
            asm volatile("s_waitcnt vmcnt(0)" ::: "memory");
        } else {
            XB_SPIN(xb_ld(&bar[XB_XGEN(b.x)]) == gen, bar);
            __builtin_amdgcn_fence(__ATOMIC_ACQUIRE, "agent");
            asm volatile("s_waitcnt vmcnt(0)" ::: "memory");
        }
    }
    __syncthreads();
}

struct Args {
    const float* in[20];
    float* out; unsigned char* ws;
    int ph_lo, ph_hi;
};
struct Frame {
    unsigned char* lds;
    int tid, lane, wave, G, gw, NGW;
};

template <class Map>
DI void transpose_item(const float* __restrict__ W, int Nsrc, bf16_t* __restrict__ WT, int ldk, float* scr, int item, int nblk, int lane, Map srcmap) {
    const int kb = item / nblk, nb = item % nblk, k0 = 64 * kb, n0 = 32 * nb;
    const int ns = srcmap(n0 + (lane & 31));
#pragma unroll 8
    for (int i = 0; i < 32; ++i) { const int kk = 2 * i + (lane >> 5); scr[kk * 33 + (lane & 31)] = (ns >= 0) ? W[(size_t)(k0 + kk) * Nsrc + ns] : 0.f; }
    __builtin_amdgcn_s_waitcnt(0); __builtin_amdgcn_wave_barrier();
    const int c = lane & 7;
#pragma unroll
    for (int j = 0; j < 4; ++j) { const int n = (lane >> 3) + 8 * j; const float* s = scr + (8 * c) * 33 + n;
        u32x4 o; o.x = pk2(s[0 * 33], s[1 * 33]); o.y = pk2(s[2 * 33], s[3 * 33]); o.z = pk2(s[4 * 33], s[5 * 33]); o.w = pk2(s[6 * 33], s[7 * 33]);
        *(u32x4*)(WT + (size_t)(n0 + n) * ldk + k0 + 8 * c) = o; }
    __builtin_amdgcn_s_waitcnt(0); __builtin_amdgcn_wave_barrier();
}
struct MapId { DI int operator()(int n) const { return n; } };
struct MapWin {
    DI int operator()(int n) const {
        if (n < 2048) return n;
        if (n < 2304) return n + 16;
        if (n < 2432) return n + 16;
        if (n < 2464) return n + 16;
        if (n < 2472) return n - 416;
        if (n < 2480) return n - 416;
        return -1;
    }
};

DI void p0_late_weights(const Frame& F, const Args& A, int wi, int nwv, int ti, int nth) {
    unsigned char* ws = A.ws;
    float* scr = (float*)(F.lds + F.wave * 16384);
    const float* w_uq = A.in[10]; const float* w_ukv = A.in[11]; const float* w_out = A.in[14]; const float* w_pq = A.in[16]; const float* sub_keys = A.in[17];
    constexpr int I_UQ = 4 * 24, I_UKV = 2 * 32, I_OUT = 16 * 32, I_PQ = 16 * 64;
    constexpr int NITEMS = I_UQ + I_UKV + I_OUT + I_PQ;
    for (int it = wi; it < NITEMS; it += nwv) {
        int r = it;
        if (r < I_UQ) { transpose_item(w_uq, 768, (bf16_t*)(ws + WS_WUQ), 256, scr, r, 24, F.lane, MapId()); continue; } r -= I_UQ;
        if (r < I_UKV) { transpose_item(w_ukv, 1024, (bf16_t*)(ws + WS_WUKV), 256, scr, r, 32, F.lane, MapId()); continue; } r -= I_UKV;
        if (r < I_OUT) { transpose_item(w_out, 1024, (bf16_t*)(ws + WS_WOUT), 1024, scr, r, 32, F.lane, MapId()); continue; } r -= I_OUT;
        transpose_item(w_pq, 2048, (bf16_t*)(ws + WS_WPQ), 1024, scr, r, 64, F.lane, MapId());
    }
    const int gt = ti, NGT = nth;
    for (int i = gt; i < 1024 * 16; i += NGT) { const int n = i >> 4, c = i & 15; *(u32x4*)((bf16_t*)(ws + WS_WUKV) + (size_t)n * 256 + 128 + c * 8) = (u32x4){0u, 0u, 0u, 0u}; }
    for (int i = gt; i < 2048 * 32; i += NGT) {
        const int n = i >> 5, c8 = (i & 31) * 8; const int p = (n >> 7) & 1;
        u32x4 o = (u32x4){0u, 0u, 0u, 0u};
        if ((c8 >> 7) == p) { const float* s = sub_keys + (size_t)n * 128 + (c8 & 127); const f32x4 a = *(const f32x4*)s, b = *(const f32x4*)(s + 4);
            o.x = pk2(a.x, a.y); o.y = pk2(a.z, a.w); o.z = pk2(b.x, b.y); o.w = pk2(b.z, b.w); }
        *(u32x4*)((bf16_t*)(ws + WS_SKB) + (size_t)n * 256 + c8) = o;
    }
}

DI void p0_prologue(const Frame& F, const Args& A) {
    unsigned char* ws = A.ws;
    float* scr = (float*)(F.lds + F.wave * 16384);
    const float* w_in = A.in[3]; const float* w_uq = A.in[10]; const float* w_ukv = A.in[11]; const float* w_out = A.in[14]; const float* w_pq = A.in[16]; const float* sub_keys = A.in[17];
    constexpr int I_IN = 16 * 80;
    for (int it = F.gw; it < I_IN; it += F.NGW) transpose_item(w_in, 2480, (bf16_t*)(ws + WS_WIN), 1024, scr, it, 80, F.lane, MapWin());
    if (F.G <= 32) p0_late_weights(F, A, F.gw, F.NGW, blockIdx.x * 512 + F.tid, F.G * 512);
    const float* x = A.in[0]; const float* meta = A.in[1]; const float* anorm = A.in[2];
    bf16_t* HN = (bf16_t*)(ws + WS_HN);
    for (int p0 = F.gw; p0 < MP; p0 += 3 * F.NGW) {
        f32x4 v[3][4]; bool ok[3];
#pragma unroll
        for (int r = 0; r < 3; ++r) {
            const int p = p0 + r * F.NGW, t = p - PADL; ok[r] = (p < MP) && t >= 0 && t < NTOK;
            if (ok[r]) { const float* src = (t < 16) ? meta + (size_t)t * DM : x + (size_t)(t - 16) * DM; const f32x4* xr = (const f32x4*)src + F.lane;
#pragma unroll
                for (int j = 0; j < 4; ++j) v[r][j] = xr[64 * j]; }
            else {
#pragma unroll
                for (int j = 0; j < 4; ++j) v[r][j] = (f32x4){0.f, 0.f, 0.f, 0.f}; }
        }
#pragma unroll
        for (int r = 0; r < 3; ++r) {
            const int p = p0 + r * F.NGW; if (p >= MP) continue;
            unsigned long long* o8 = (unsigned long long*)(HN + (size_t)p * DM) + F.lane;
            float s = 0.f;
#pragma unroll
            for (int j = 0; j < 4; ++j) s += (v[r][j].x * v[r][j].x + v[r][j].y * v[r][j].y) + (v[r][j].z * v[r][j].z + v[r][j].w * v[r][j].w);
            const float rstd = ok[r] ? 1.f / sqrtf(wave_sum(s) * (1.f / DM) + EPS) : 0.f;
#pragma unroll
            for (int j = 0; j < 4; ++j) { const f32x4 w = ((const f32x4*)anorm)[64 * j + F.lane];
                o8[64 * j] = (unsigned long long)pk2(v[r][j].x * rstd * w.x, v[r][j].y * rstd * w.y) | ((unsigned long long)pk2(v[r][j].z * rstd * w.z, v[r][j].w * rstd * w.w) << 32); }
        }
    }
}

struct EpiProj {
    static constexpr bool PERM = true;
    bf16_t* QKVR; bf16_t* Z; float* P32;
    DI void operator()(const f32x4 (&acc)[2][2][4][2], const pg8::Unit& u, int wr, int wc, int fr, int fq) const {
        const int row0 = u.pm * 256 + wr * 64 + fr;
        if (u.pn < 8) {
            bf16_t* base; int ld, colt;
            if (u.pn < 6) { base = QKVR; ld = 1536; colt = u.pn * 256; } else { base = Z; ld = 512; colt = (u.pn - 6) * 256; }
            const int col0 = colt + wc * 32 + 8 * fq;
#pragma unroll
            for (int ai = 0; ai < 2; ++ai)
#pragma unroll
                for (int m = 0; m < 4; ++m) { bf16_t* rowp = base + (size_t)(row0 + ai * 128 + m * 16) * ld + col0;
#pragma unroll
                    for (int bj = 0; bj < 2; ++bj) { const f32x4 v0 = acc[ai][bj][m][0], v1 = acc[ai][bj][m][1];
                        u32x4 w; w.x = pg8::cvt_pk_bf16(v0[0], v0[1]); w.y = pg8::cvt_pk_bf16(v0[2], v0[3]); w.z = pg8::cvt_pk_bf16(v1[0], v1[1]); w.w = pg8::cvt_pk_bf16(v1[2], v1[3]);
                        *(u32x4*)(rowp + bj * 128) = w; } }
        } else {
            const int col0 = (u.pn - 8) * 256 + wc * 32 + 8 * fq;
#pragma unroll
            for (int ai = 0; ai < 2; ++ai)
#pragma unroll
                for (int m = 0; m < 4; ++m) { float* rowp = P32 + (size_t)(row0 + ai * 128 + m * 16) * 512 + col0;
#pragma unroll
                    for (int bj = 0; bj < 2; ++bj) { *(f32x4*)(rowp + bj * 128) = acc[ai][bj][m][0]; *(f32x4*)(rowp + bj * 128 + 4) = acc[ai][bj][m][1]; } }
        }
    }
};
struct EpiB16 {
    static constexpr bool PERM = true;
    bf16_t* O; int ldc;
    DI void operator()(const f32x4 (&acc)[2][2][4][2], const pg8::Unit& u, int wr, int wc, int fr, int fq) const {
        const int row0 = u.pm * 256 + wr * 64 + fr, col0 = u.pn * 256 + wc * 32 + 8 * fq;
#pragma unroll
        for (int ai = 0; ai < 2; ++ai)
#pragma unroll
            for (int m = 0; m < 4; ++m) { bf16_t* rowp = O + (size_t)(row0 + ai * 128 + m * 16) * ldc + col0;
#pragma unroll
                for (int bj = 0; bj < 2; ++bj) { const f32x4 v0 = acc[ai][bj][m][0], v1 = acc[ai][bj][m][1];
                    u32x4 w; w.x = pg8::cvt_pk_bf16(v0[0], v0[1]); w.y = pg8::cvt_pk_bf16(v0[2], v0[3]); w.z = pg8::cvt_pk_bf16(v1[0], v1[1]); w.w = pg8::cvt_pk_bf16(v1[2], v1[3]);
                    *(u32x4*)(rowp + bj * 128) = w; } }
    }
};
struct EpiF32 {
    static constexpr bool PERM = true;
    float* C; int ldc; const float* res;
    DI void operator()(const f32x4 (&acc)[2][2][4][2], const pg8::Unit& u, int wr, int wc, int fr, int fq) const {
        const int row0 = u.pm * 256 + wr * 64 + fr, col0 = u.pn * 256 + wc * 32 + 8 * fq;
#pragma unroll
        for (int ai = 0; ai < 2; ++ai)
#pragma unroll
            for (int m = 0; m < 4; ++m) { const size_t off = (size_t)(row0 + ai * 128 + m * 16) * ldc + col0;
#pragma unroll
                for (int bj = 0; bj < 2; ++bj) { f32x4 v0 = acc[ai][bj][m][0], v1 = acc[ai][bj][m][1];
                    if (res) { v0 += *(const f32x4*)(res + off + bj * 128); v1 += *(const f32x4*)(res + off + bj * 128 + 4); }
                    *(f32x4*)(C + off + bj * 128) = v0; *(f32x4*)(C + off + bj * 128 + 4) = v1; } }
    }
};

DI f32x16 mfma32(bf16x8 a, bf16x8 b, f32x16 c) { return __builtin_amdgcn_mfma_f32_32x32x16_bf16(a, b, c, 0, 0, 0); }
DI f32x4 mfma16(bf16x8 a, bf16x8 b, f32x4 c) { return __builtin_amdgcn_mfma_f32_16x16x32_bf16(a, b, c, 0, 0, 0); }
DI int crow(int r, int hi) { return (r & 3) + 8 * (r >> 2) + 4 * hi; }
DI f32x16 zero16() { f32x16 z;
#pragma unroll
    for (int i = 0; i < 16; ++i) z[i] = 0.f; return z; }

constexpr int G_KF = 0, G_VF = 16384, G_MF = 32768;
constexpr int G_QB = 50176, G_KB = 59392, G_KBB = 68608;
constexpr int G_QKB = 77824, G_UT = 87040, G_WT = 96256, G_KDT = 105472;
constexpr int G_VEC = 114688;
constexpr int G_RAW = G_QKB;
constexpr int GST = 72;

DI f32x16 mm_quad(const unsigned char* A, const unsigned char* Bt, int qr, int qc, int lane) {
    const int r32 = lane & 31, hh = lane >> 5;
    const unsigned char* ap = A + (32 * qr + r32) * (GST * 2) + hh * 16;
    const unsigned char* bp = Bt + (32 * qc + r32) * (GST * 2) + hh * 16;
    f32x16 acc = zero16();
#pragma unroll
    for (int s = 0; s < 4; ++s) acc = mfma32(*(const bf16x8*)(ap + s * 32), *(const bf16x8*)(bp + s * 32), acc);
    return acc;
}

constexpr int G_RAW2 = 115712;
static_assert(G_RAW2 + 67 * 400 <= 143360, "GDN prep LDS map");
constexpr int G_CONVW = 143360 + 512;

#ifndef PROBE_STAGE
#define PROBE_STAGE -1
#endif
template <int VAR> DI void gdn_prep_phase(const Frame& F, const Args& A) {
    unsigned long long stg_t = 0ull, stg_acc = 0ull;
#define STG(n) do { if (PROBE_STAGE >= 0) { const unsigned long long now_ = __builtin_amdgcn_s_memrealtime(); if (PROBE_STAGE == (n)) stg_acc += now_ - stg_t; stg_t = now_; } } while (0)
    unsigned char* ws = A.ws; unsigned char* lds = F.lds;
    const int tid = F.tid, lane = F.lane, wave = F.wave;
    const bf16_t* QKVR = (const bf16_t*)(ws + WS_QKVR); const float* P32 = (const float*)(ws + WS_P32);
    float* KF = (float*)(lds + G_KF); float* VF = (float*)(lds + G_VF); float* MF = (float*)(lds + G_MF);
    float* VEC = (float*)(lds + G_VEC);
    if (VAR == 6) return;
    const int NIT = NCHUNK * 8;
#define LBAR() do { asm volatile("s_waitcnt lgkmcnt(0)" ::: "memory"); __builtin_amdgcn_s_barrier(); asm volatile("" ::: "memory"); } while (0)
#define LAUNDER(dst, src) int dst = (src); asm volatile("" : "+v"(dst))
    int item = blockIdx.x;
    if (item >= NIT) return;
    u32x4 pr[4]; float nb = 0.f, na = 0.f;
    auto raw_fetch = [&](int it) {
        const int c = it >> 3, h = it & 7; LAUNDER(tl, tid);
#pragma unroll
        for (int i = 0; i < 4; ++i) { const int q = tl + 512 * i; pr[i] = (u32x4){0u, 0u, 0u, 0u};
            if (q < 67 * 24) { const int r = q / 24, cc = q % 24, seg = cc >> 3, c8 = cc & 7; const int p = 64 * c - 3 + r;
                if (p >= 0) pr[i] = *(const u32x4*)(QKVR + (size_t)p * 1536 + seg * 512 + h * 64 + c8 * 8); } }
        if (wave == 0) { const int p = 64 * c + lane; nb = P32[(size_t)p * 512 + 416 + h]; na = P32[(size_t)p * 512 + 424 + h]; }
    };
    auto raw_park = [&]() {
        LAUNDER(tl, tid);
#pragma unroll
        for (int i = 0; i < 4; ++i) { const int q = tl + 512 * i;
            if (q < 67 * 24) { const int r = q / 24, cc = q % 24, seg = cc >> 3, c8 = cc & 7; *(u32x4*)(lds + G_RAW2 + r * 400 + (seg * 64 + c8 * 8) * 2) = pr[i]; } }
    };
    raw_fetch(item); raw_park();
    float cb = nb, ca = na;
    float* CWL = (float*)(lds + G_CONVW);
    int cw_h = -1;
#pragma unroll 1
    for (; item < NIT; item += F.G) {
        if (PROBE_STAGE >= 0 && stg_t == 0ull) stg_t = __builtin_amdgcn_s_memrealtime();
        const int c = item >> 3, h = item & 7;
        if (h != cw_h) { cw_h = h;
            if (tid < 192) { LAUNDER(t0, tid); const int sg = t0 >> 6, jt = (t0 >> 4) & 3, c4 = t0 & 15; *(f32x4*)(CWL + (sg * 4 + jt) * 64 + 4 * c4) = *(const f32x4*)(A.in[4] + jt * 1536 + sg * 512 + h * 64 + 4 * c4); } }
        const int nxt = item + F.G;
        if (VAR != 5 && nxt < NIT) raw_fetch(nxt);
        if (wave == 0) {
            const int p = 64 * c + lane;
            const float alog = A.in[5][h], dtb = A.in[6][h];
            float beta = sigmoidf_(cb);
            const float xx = ca + dtb; const float sp = xx > 20.f ? xx : log1pf(__expf(xx));
            float g = -__expf(alog) * sp;
            if (p < PADL) { beta = 0.f; g = 0.f; }
            float gc = g;
#pragma unroll
            for (int o = 1; o < 64; o <<= 1) { const float t = __shfl_up(gc, o); if (lane >= o) gc += t; }
            const float glast = __shfl(gc, 63);
            VEC[lane] = gc; VEC[64 + lane] = beta; VEC[128 + lane] = __expf(gc); VEC[192 + lane] = __expf(glast - gc);
        }
        LBAR(); STG(0);
        LAUNDER(t1, tid); const int sub = t1 & 15, grp = t1 >> 4;
#pragma unroll
        for (int sg = 0; sg < ((VAR == 2 || VAR >= 4) ? 0 : 3); ++sg) {
#pragma unroll 1
            for (int ps = 0; ps < 2; ++ps) {
                const int i = grp + 32 * ps;
                float acc[4] = {0.f, 0.f, 0.f, 0.f};
#pragma unroll
                for (int jt = 0; jt < 4; ++jt) {
                    const f32x4 w = *(const f32x4*)(CWL + (sg * 4 + jt) * 64 + 4 * sub);
                    const u32x2 rv = *(const u32x2*)(lds + G_RAW2 + (i + jt) * 400 + (sg * 64 + 4 * sub) * 2);
                    acc[0] += w.x * bflo(rv.x); acc[1] += w.y * bfhi(rv.x); acc[2] += w.z * bflo(rv.y); acc[3] += w.w * bfhi(rv.y);
                }
                float y[4];
#pragma unroll
                for (int k = 0; k < 4; ++k) y[k] = siluf_(acc[k]);
                if (sg < 2) {
                    float ss = (y[0] * y[0] + y[1] * y[1]) + (y[2] * y[2] + y[3] * y[3]);
                    ss += __shfl_xor(ss, 1); ss += __shfl_xor(ss, 2); ss += __shfl_xor(ss, 4); ss += __shfl_xor(ss, 8);
                    const float rn = 1.f / sqrtf(ss + EPS);
#pragma unroll
                    for (int k = 0; k < 4; ++k) y[k] *= rn;
                }
                if (sg == 0) {
                    u32x2 o; o.x = pk2(y[0] * 0.125f, y[1] * 0.125f); o.y = pk2(y[2] * 0.125f, y[3] * 0.125f);
                    *(u32x2*)(lds + G_QB + i * (GST * 2) + 8 * sub) = o;
                } else if (sg == 1) {
                    const float beta = VEC[64 + i], ekd = VEC[192 + i];
                    *(f32x4*)(KF + i * 64 + 4 * sub) = (f32x4){y[0], y[1], y[2], y[3]};
                    u32x2 o; o.x = pk2(y[0], y[1]); o.y = pk2(y[2], y[3]);
                    *(u32x2*)(lds + G_KB + i * (GST * 2) + 8 * sub) = o;
                    o.x = pk2(y[0] * beta, y[1] * beta); o.y = pk2(y[2] * beta, y[3] * beta);
                    *(u32x2*)(lds + G_KBB + i * (GST * 2) + 8 * sub) = o;
#pragma unroll
                    for (int k = 0; k < 4; ++k) *(bf16_t*)(lds + G_KDT + (4 * sub + k) * (GST * 2) + i * 2) = (bf16_t)f2bf(y[k] * ekd);
                } else {
                    *(f32x4*)(VF + i * 64 + 4 * sub) = (f32x4){y[0], y[1], y[2], y[3]};
                }
            }
        }
        LBAR(); STG(1);
        if (VAR != 3 && VAR < 4) {
            LAUNDER(l3, lane);
            const int prod = wave >> 2, quad = wave & 3, qr = quad >> 1, qc = quad & 1, r32 = l3 & 31, hh = l3 >> 5;
            const f32x16 acc = mm_quad(lds + (prod ? G_QB : G_KBB), lds + G_KB, qr, qc, l3);
            const int j = 32 * qc + r32; const float gcj = VEC[j];
#pragma unroll
            for (int r = 0; r < 16; ++r) {
                const int i = 32 * qr + crow(r, hh);
                if (prod == 0) { MF[i * 68 + j] = (j < i) ? acc[r] * __expf(VEC[i] - gcj) : 0.f; }
                else { *(bf16_t*)(lds + G_QKB + i * (GST * 2) + j * 2) = (bf16_t)f2bf((j <= i) ? acc[r] * __expf(VEC[i] - gcj) : 0.f); }
            }
        }
        LBAR(); STG(2);
        float* DB = (float*)(lds + G_KBB);
        if (VAR != 1 && VAR < 4 && wave == 0) {
            LAUNDER(l4, lane); const int b = l4 >> 4, jc = l4 & 15;
            float d[16];
#pragma unroll
            for (int i = 0; i < 16; ++i) {
                float acc = (i == jc) ? 1.f : 0.f;
                const float* mrow = MF + (16 * b + i) * 68 + 16 * b;
#pragma unroll
                for (int k = 0; k < i; ++k) acc -= mrow[k] * d[k];
                d[i] = acc;
            }
#pragma unroll
            for (int i = 0; i < 16; ++i) DB[(b * 16 + i) * 20 + jc] = d[i];
        }
        LBAR();
        if (VAR != 1 && VAR < 4) {
            LAUNDER(l4, lane); const int cc = l4 & 15, g = l4 >> 4;
            const bool isU = wave < 4; const int col = 16 * (wave & 3) + cc;
            const float* src = (isU ? VF : KF) + col;
            f32x4 X[4];
#pragma unroll
            for (int b = 0; b < 4; ++b) {
                f32x4 acc;
#pragma unroll
                for (int r = 0; r < 4; ++r) { const int i = 16 * b + 4 * g + r; float rv = src[i * 64] * VEC[64 + i]; if (!isU) rv *= VEC[128 + i]; acc[r] = -rv; }
#pragma unroll
                for (int a = 0; a < b; ++a) {
                    const f32x4 lv = *(const f32x4*)(MF + (16 * b + cc) * 68 + 16 * a + 4 * g);
#pragma unroll
                    for (int sp = 0; sp < 4; ++sp) acc = __builtin_amdgcn_mfma_f32_16x16x4f32(lv[sp], X[a][sp], acc, 0, 0, 0);
                }
                const f32x4 dv = *(const f32x4*)(DB + (b * 16 + cc) * 20 + 4 * g);
                f32x4 xb = (f32x4){0.f, 0.f, 0.f, 0.f};
#pragma unroll
                for (int sp = 0; sp < 4; ++sp) xb = __builtin_amdgcn_mfma_f32_16x16x4f32(dv[sp], acc[sp], xb, 0, 0, 0);
                X[b] = -xb;
                unsigned char* dst = lds + (isU ? G_UT : G_WT) + col * (GST * 2) + (16 * b + 4 * g) * 2;
                *(u32x2*)dst = (u32x2){pk2(X[b][0], X[b][1]), pk2(X[b][2], X[b][3])};
            }
        }
        LBAR(); STG(3);
        if (VAR != 3 && VAR < 4) {
            const float gl = VEC[128 + 63];
            float* GB = VAR ? (float*)(ws + WS_GS + (size_t)item * 8192) : (float*)(ws + WS_GB) + (size_t)item * 4096;
            bf16_t* GQ = (bf16_t*)(ws + (VAR ? WS_GS : WS_GQ)) + (size_t)item * 4096; bf16_t* GO = (bf16_t*)(ws + (VAR ? WS_GS : WS_GO)) + (size_t)item * 4096;
            bf16_t* GAL = (bf16_t*)(lds + G_MF);
            LAUNDER(l5, lane); const int r32 = l5 & 31, hh = l5 >> 5;
#pragma unroll 1
            for (int it = 0; it < 2; ++it) {
                const int task = wave + 8 * it, prod = task >> 2, quad = task & 3, qr = quad >> 1, qc = quad & 1;
                const f32x16 acc = mm_quad(lds + (prod < 2 ? G_KDT : G_QKB), lds + ((prod & 1) ? G_UT : G_WT), qr, qc, l5);
                const int Cc = 32 * qc + r32;
                if (prod == 0) {
#pragma unroll
                    for (int r = 0; r < 16; ++r) {
                        const int R = 32 * qr + crow(r, hh);
                        const float val = ((R == Cc) ? gl : 0.f) - acc[r];
                        const int rb = R >> 4, m = R & 15, q4 = Cc >> 4, g = (Cc >> 2) & 3, rr = Cc & 3, ks = q4 >> 1, jj = 4 * (q4 & 1) + rr, ls = 16 * g + m;
                        GAL[((rb * 2 + ks) * 64 + ls) * 8 + jj] = (bf16_t)f2bf(val);
                    }
                } else if (prod == 1) {
                    const int eslab = Cc >> 4, n = Cc & 15;
#pragma unroll
                    for (int a = 0; a < 4; ++a) {
                        const int R0 = 32 * qr + 8 * a + 4 * hh; const int rb = R0 >> 4, g = (R0 >> 2) & 3, ls = 16 * g + n;
                        *(f32x4*)(GB + ((eslab * 4 + rb) * 64 + ls) * 4) = (f32x4){acc[4 * a], acc[4 * a + 1], acc[4 * a + 2], acc[4 * a + 3]};
                    }
                } else if (prod == 2) {
#pragma unroll
                    for (int r = 0; r < 16; ++r) {
                        const int R = 32 * qr + crow(r, hh);
                        const float qv = bf2f(*(const bf16_t*)(lds + G_QB + R * (GST * 2) + Cc * 2));
                        GQ[R * 64 + Cc] = (bf16_t)f2bf(qv * VEC[128 + R] - acc[r]);
                    }
                } else {
#pragma unroll
                    for (int r = 0; r < 16; ++r) GO[(quad * 16 + r) * 64 + l5] = (bf16_t)f2bf(acc[r]);
                }
            }
        }
        if (VAR != 5 && nxt < NIT) { raw_park(); cb = nb; ca = na; }
        LBAR(); STG(4);
        if (VAR != 5) { LAUNDER(t6, tid); *(u32x4*)((bf16_t*)(ws + (VAR ? WS_GS : WS_GA)) + (size_t)item * 4096 + t6 * 8) = *(const u32x4*)(lds + G_MF + t6 * 16); }
        STG(5);
    }
    if (PROBE_STAGE >= 0 && tid == 0) { *(unsigned long long*)(lds + 143360 + 96) = stg_acc; }
}

constexpr int SC_D = 8, SC_PD = 6, SC_SLOT = 12288;
DI void gdn_scan(const Frame& F, const Args& A) {
    if (blockIdx.x >= 32) return;
    unsigned char* ws = A.ws;
    const int h = blockIdx.x & 7, eslab = blockIdx.x >> 3, lane = F.lane, wave = F.wave, n = lane & 15, g = lane >> 4;
    const unsigned char* GA = ws + WS_GA; const unsigned char* GB = ws + WS_GB; bf16_t* GS = (bf16_t*)(ws + WS_GS);
    LAS unsigned char* ring = (LAS unsigned char*)F.lds;
    const int np = (wave == 0) ? 0 : ((wave - 1 < 5) ? 2 : 1);
    auto issue = [&](int c) {
        const int cc = c < NCHUNK ? c : NCHUNK - 1;
        const size_t item = (size_t)cc * 8 + h;
        LAS unsigned char* slot = ring + (c % SC_D) * SC_SLOT;
#pragma unroll
        for (int i = 0; i < 2; ++i) if (i < np) {
            const int q = (wave - 1) + 7 * i;
            const unsigned char* src = (q < 8) ? GA + item * 8192 + q * 1024 : GB + item * 16384 + eslab * 4096 + (q - 8) * 1024;
            LAS unsigned char* dst = slot + ((q < 8) ? q * 1024 : 8192 + (q - 8) * 1024);
            __builtin_amdgcn_global_load_lds((const unsigned*)(src + lane * 16), (LAS unsigned*)dst, 16, 0, 0);
        }
    };
    for (int c = 0; c < SC_PD; ++c) issue(c);
    f32x4 S[4];
#pragma unroll
    for (int rb = 0; rb < 4; ++rb) S[rb] = (f32x4){0.f, 0.f, 0.f, 0.f};
#pragma unroll 1
    for (int c = 0; c < NCHUNK; ++c) {
        issue(c + SC_PD);
        if (np == 2) asm volatile("s_waitcnt vmcnt(12)" ::: "memory");
        else if (np == 1) asm volatile("s_waitcnt vmcnt(6)" ::: "memory");
        asm volatile("s_waitcnt lgkmcnt(0)" ::: "memory");
        __builtin_amdgcn_s_barrier();
        asm volatile("" ::: "memory");
        if (wave == 0) {
            const LAS unsigned char* slot = ring + (c % SC_D) * SC_SLOT;
            bf16x8 ac[8]; f32x4 bc[4];
#pragma unroll
            for (int q = 0; q < 8; ++q) ac[q] = *(const LAS bf16x8*)(slot + q * 1024 + lane * 16);
#pragma unroll
            for (int rb = 0; rb < 4; ++rb) bc[rb] = *(const LAS f32x4*)(slot + 8192 + rb * 1024 + lane * 16);
            const size_t item = (size_t)c * 8 + h;
            u32x4 p0, p1;
            p0.x = pk2(S[0][0], S[0][1]); p0.y = pk2(S[0][2], S[0][3]); p0.z = pk2(S[1][0], S[1][1]); p0.w = pk2(S[1][2], S[1][3]);
            p1.x = pk2(S[2][0], S[2][1]); p1.y = pk2(S[2][2], S[2][3]); p1.z = pk2(S[3][0], S[3][1]); p1.w = pk2(S[3][2], S[3][3]);
            {
                bf16_t* st = GS + item * 4096 + (16 * eslab + n) * 64 + 4 * g;
                *(u32x2*)(st + 0) = (u32x2){p0.x, p0.y}; *(u32x2*)(st + 16) = (u32x2){p0.z, p0.w};
                *(u32x2*)(st + 32) = (u32x2){p1.x, p1.y}; *(u32x2*)(st + 48) = (u32x2){p1.z, p1.w};
            }
            const bf16x8 b0 = __builtin_bit_cast(bf16x8, p0), b1 = __builtin_bit_cast(bf16x8, p1);
#pragma unroll
            for (int rb = 0; rb < 4; ++rb) {
                f32x4 acc = bc[rb];
                acc = mfma16(ac[rb * 2 + 0], b0, acc);
                acc = mfma16(ac[rb * 2 + 1], b1, acc);
                S[rb] = acc;
            }
        }
    }
    asm volatile("s_waitcnt vmcnt(0) lgkmcnt(0)" ::: "memory");
    __builtin_amdgcn_s_barrier();
}

DI void gdn_out_task(const Frame& F, const Args& A, int task) {
    unsigned char* ws = A.ws;
    const int ihalf = task & 1, item = (task >> 1) + 8, c = item >> 3, h = item & 7, lane = F.lane, r32 = lane & 31, hh = lane >> 5;
    const bf16_t* GQ = (const bf16_t*)(ws + WS_GQ) + (size_t)item * 4096; const bf16_t* GS = (const bf16_t*)(ws + WS_GS) + (size_t)item * 4096;
    const bf16_t* GO = (const bf16_t*)(ws + WS_GO) + (size_t)item * 4096;
    const bf16_t* Z = (const bf16_t*)(ws + WS_Z); bf16_t* MIX = (bf16_t*)(ws + WS_MIX);
    f32x16 acc[2];
#pragma unroll
    for (int eh = 0; eh < 2; ++eh)
#pragma unroll
        for (int r = 0; r < 16; ++r) acc[eh][r] = bf2f(GO[((ihalf * 2 + eh) * 16 + r) * 64 + lane]);
#pragma unroll
    for (int s = 0; s < 4; ++s) {
        const bf16x8 a = *(const bf16x8*)(GQ + (32 * ihalf + r32) * 64 + 16 * s + 8 * hh);
#pragma unroll
        for (int eh = 0; eh < 2; ++eh) {
            const bf16x8 b = *(const bf16x8*)(GS + (32 * eh + r32) * 64 + 16 * s + 8 * hh);
            acc[eh] = mfma32(a, b, acc[eh]);
        }
    }
    const float* gnorm = A.in[7];
    const float w0 = gnorm[r32], w1 = gnorm[32 + r32];
#pragma unroll
    for (int r = 0; r < 16; ++r) {
        float ss = acc[0][r] * acc[0][r] + acc[1][r] * acc[1][r];
        ss += __shfl_xor(ss, 1); ss += __shfl_xor(ss, 2); ss += __shfl_xor(ss, 4); ss += __shfl_xor(ss, 8); ss += __shfl_xor(ss, 16);
        const float rstd = 1.f / sqrtf(ss * (1.f / 64.f) + EPS);
        const int i = 32 * ihalf + crow(r, hh); const int p = 64 * c + i;
        const float z0 = bf2f(Z[(size_t)p * 512 + h * 64 + r32]), z1 = bf2f(Z[(size_t)p * 512 + h * 64 + 32 + r32]);
        bf16_t* o = MIX + (size_t)(p - 64) * 1024 + h * 64;
        o[r32] = (bf16_t)f2bf(acc[0][r] * rstd * w0 * siluf_(z0));
        o[32 + r32] = (bf16_t)f2bf(acc[1][r] * rstd * w1 * siluf_(z1));
    }
}

DI void mla_prep1_row(const Frame& F, const Args& A, int p) {
    unsigned char* ws = A.ws; const int lane = F.lane;
    const float* P32 = (const float*)(ws + WS_P32) + (size_t)p * 512;
    bf16_t* CQN = (bf16_t*)(ws + WS_CQN) + (size_t)p * 256; bf16_t* CKVN = (bf16_t*)(ws + WS_CKVN) + (size_t)p * 256;
    const f32x4 q = *(const f32x4*)(P32 + 4 * lane);
    const float sq = wave_sum((q.x * q.x + q.y * q.y) + (q.z * q.z + q.w * q.w));
    const float rq = 1.f / sqrtf(sq * (1.f / 256.f) + EPS);
    const f32x4 wq = *(const f32x4*)(A.in[8] + 4 * lane);
    *(u32x2*)(CQN + 4 * lane) = (u32x2){pk2(q.x * rq * wq.x, q.y * rq * wq.y), pk2(q.z * rq * wq.z, q.w * rq * wq.w)};
    const float k0 = P32[256 + 2 * lane], k1 = P32[256 + 2 * lane + 1];
    const float sk = wave_sum(k0 * k0 + k1 * k1);
    const float rk = 1.f / sqrtf(sk * (1.f / 128.f) + EPS);
    const float wk0 = A.in[9][2 * lane], wk1 = A.in[9][2 * lane + 1];
    *(unsigned*)(CKVN + 2 * lane) = pk2(k0 * rk * wk0, k1 * rk * wk1);
    *(unsigned*)(CKVN + 128 + 2 * lane) = 0u;
}

constexpr float QSCALE = 0.10206207261596577f * 1.4426950408889634f;
DI double rope_inv_rev(int i) {
    const double t8[8] = {0.15915494309189535, 0.08949940160889101, 0.050329212104487035, 0.0283021958306234, 0.015915494309189534, 0.008949940160889102, 0.005032921210448704, 0.00283021958306234};
    double v = t8[0];
#pragma unroll
    for (int k = 1; k < 8; ++k) v = ((i & 7) == k) ? t8[k] : v;
    return (i & 8) ? v * 0.01 : v;
}
constexpr int P2_TS = 136;
DI void mla_prep2_task(const Frame& F, const Args& A, int task) {
    unsigned char* ws = A.ws; const int lane = F.lane, h = task & 7, blk = task >> 3;
    const int p = 64 * blk + lane;
    const bool valid = (p >= PADL) && (p < LPV);
    const float* qn = A.in[12]; const float* kn = A.in[13];
    float sn[16], cs[16];
    { const double pos = (double)(p - PADL);
#pragma unroll
      for (int i = 0; i < 16; ++i) { const double rev = pos * rope_inv_rev(i); const float fr = (float)(rev - floor(rev)); sn[i] = __builtin_amdgcn_sinf(fr); cs[i] = __builtin_amdgcn_cosf(fr); } }
    {
        const bf16_t* src = (const bf16_t*)(ws + WS_QH) + (size_t)p * 768 + h * 96;
        u32x4 w[12];
#pragma unroll
        for (int c = 0; c < 12; ++c) w[c] = *(const u32x4*)(src + 8 * c);
        float ss = 0.f;
#pragma unroll
        for (int c = 0; c < 12; ++c) { const float a0 = bflo(w[c].x), a1 = bfhi(w[c].x), a2 = bflo(w[c].y), a3 = bfhi(w[c].y), a4 = bflo(w[c].z), a5 = bfhi(w[c].z), a6 = bflo(w[c].w), a7 = bfhi(w[c].w);
            ss += (a0 * a0 + a1 * a1) + (a2 * a2 + a3 * a3) + (a4 * a4 + a5 * a5) + (a6 * a6 + a7 * a7); }
        const float rs = valid ? QSCALE / sqrtf(ss * (1.f / 96.f) + EPS) : 0.f;
        bf16_t* dst = (bf16_t*)(ws + WS_Q) + ((size_t)h * KVROWS + p) * 96;
#pragma unroll
        for (int c = 0; c < 8; ++c) {
            const f32x4 g0 = *(const f32x4*)(qn + 8 * c), g1 = *(const f32x4*)(qn + 8 * c + 4);
            *(u32x4*)(dst + 8 * c) = (u32x4){pk2(bflo(w[c].x) * rs * g0.x, bfhi(w[c].x) * rs * g0.y), pk2(bflo(w[c].y) * rs * g0.z, bfhi(w[c].y) * rs * g0.w),
                                             pk2(bflo(w[c].z) * rs * g1.x, bfhi(w[c].z) * rs * g1.y), pk2(bflo(w[c].w) * rs * g1.z, bfhi(w[c].w) * rs * g1.w)};
        }
#pragma unroll
        for (int c = 0; c < 2; ++c) {
            float x1[8], x2[8];
            const u32x4 wa = w[8 + c], wb = w[10 + c];
            x1[0] = bflo(wa.x); x1[1] = bfhi(wa.x); x1[2] = bflo(wa.y); x1[3] = bfhi(wa.y); x1[4] = bflo(wa.z); x1[5] = bfhi(wa.z); x1[6] = bflo(wa.w); x1[7] = bfhi(wa.w);
            x2[0] = bflo(wb.x); x2[1] = bfhi(wb.x); x2[2] = bflo(wb.y); x2[3] = bfhi(wb.y); x2[4] = bflo(wb.z); x2[5] = bfhi(wb.z); x2[6] = bflo(wb.w); x2[7] = bfhi(wb.w);
            float o1[8], o2[8];
#pragma unroll
            for (int t = 0; t < 8; ++t) { const float a = x1[t] * rs * qn[64 + 8 * c + t], b = x2[t] * rs * qn[80 + 8 * c + t]; o1[t] = a * cs[8 * c + t] - b * sn[8 * c + t]; o2[t] = b * cs[8 * c + t] + a * sn[8 * c + t]; }
            *(u32x4*)(dst + 64 + 8 * c) = (u32x4){pk2(o1[0], o1[1]), pk2(o1[2], o1[3]), pk2(o1[4], o1[5]), pk2(o1[6], o1[7])};
            *(u32x4*)(dst + 80 + 8 * c) = (u32x4){pk2(o2[0], o2[1]), pk2(o2[2], o2[3]), pk2(o2[4], o2[5]), pk2(o2[6], o2[7])};
        }
    }
    {
        const bf16_t* src = (const bf16_t*)(ws + WS_KVB) + (size_t)p * 1024 + h * 128;
        const float* kpe = (const float*)(ws + WS_P32) + (size_t)p * 512 + 384;
        u32x4 w[8]; f32x4 e[8];
#pragma unroll
        for (int c = 0; c < 8; ++c) { w[c] = *(const u32x4*)(src + 8 * c); e[c] = *(const f32x4*)(kpe + 4 * c); }
        float ss = 0.f;
#pragma unroll
        for (int c = 0; c < 8; ++c) { const float a0 = bflo(w[c].x), a1 = bfhi(w[c].x), a2 = bflo(w[c].y), a3 = bfhi(w[c].y), a4 = bflo(w[c].z), a5 = bfhi(w[c].z), a6 = bflo(w[c].w), a7 = bfhi(w[c].w);
            ss += (a0 * a0 + a1 * a1) + (a2 * a2 + a3 * a3) + (a4 * a4 + a5 * a5) + (a6 * a6 + a7 * a7);
            ss += (e[c].x * e[c].x + e[c].y * e[c].y) + (e[c].z * e[c].z + e[c].w * e[c].w); }
        const float rs = valid ? 1.f / sqrtf(ss * (1.f / 96.f) + EPS) : 0.f;
        bf16_t* dst = (bf16_t*)(ws + WS_K) + ((size_t)h * KVROWS + p) * 96;
#pragma unroll
        for (int c = 0; c < 8; ++c) {
            const f32x4 g0 = *(const f32x4*)(kn + 8 * c), g1 = *(const f32x4*)(kn + 8 * c + 4);
            *(u32x4*)(dst + 8 * c) = (u32x4){pk2(bflo(w[c].x) * rs * g0.x, bfhi(w[c].x) * rs * g0.y), pk2(bflo(w[c].y) * rs * g0.z, bfhi(w[c].y) * rs * g0.w),
                                             pk2(bflo(w[c].z) * rs * g1.x, bfhi(w[c].z) * rs * g1.y), pk2(bflo(w[c].w) * rs * g1.z, bfhi(w[c].w) * rs * g1.w)};
        }
#pragma unroll
        for (int c = 0; c < 2; ++c) {
            const float x1[8] = {e[2 * c].x, e[2 * c].y, e[2 * c].z, e[2 * c].w, e[2 * c + 1].x, e[2 * c + 1].y, e[2 * c + 1].z, e[2 * c + 1].w};
            const float x2[8] = {e[4 + 2 * c].x, e[4 + 2 * c].y, e[4 + 2 * c].z, e[4 + 2 * c].w, e[5 + 2 * c].x, e[5 + 2 * c].y, e[5 + 2 * c].z, e[5 + 2 * c].w};
            float o1[8], o2[8];
#pragma unroll
            for (int t = 0; t < 8; ++t) { const float a = x1[t] * rs * kn[64 + 8 * c + t], b = x2[t] * rs * kn[80 + 8 * c + t]; o1[t] = a * cs[8 * c + t] - b * sn[8 * c + t]; o2[t] = b * cs[8 * c + t] + a * sn[8 * c + t]; }
            *(u32x4*)(dst + 64 + 8 * c) = (u32x4){pk2(o1[0], o1[1]), pk2(o1[2], o1[3]), pk2(o1[4], o1[5]), pk2(o1[6], o1[7])};
            *(u32x4*)(dst + 80 + 8 * c) = (u32x4){pk2(o2[0], o2[1]), pk2(o2[2], o2[3]), pk2(o2[4], o2[5]), pk2(o2[6], o2[7])};
        }
    }
    {
        unsigned char* T = F.lds + F.wave * (64 * P2_TS);
        const bf16_t* src = (const bf16_t*)(ws + WS_KVB) + h * 128 + 64;
#pragma unroll
        for (int it = 0; it < 8; ++it) {
            const int pr = 8 * it + (lane >> 3), ch = lane & 7; const int pp = 64 * blk + pr;
            u32x4 v = (u32x4){0u, 0u, 0u, 0u};
            if (pp >= PADL && pp < LPV) v = *(const u32x4*)(src + (size_t)pp * 1024 + 8 * ch);
            unsigned char* tp = T + (8 * ch) * P2_TS + pr * 2;
            *(bf16_t*)(tp + 0 * P2_TS) = (bf16_t)(v.x & 0xffffu); *(bf16_t*)(tp + 1 * P2_TS) = (bf16_t)(v.x >> 16);
            *(bf16_t*)(tp + 2 * P2_TS) = (bf16_t)(v.y & 0xffffu); *(bf16_t*)(tp + 3 * P2_TS) = (bf16_t)(v.y >> 16);
            *(bf16_t*)(tp + 4 * P2_TS) = (bf16_t)(v.z & 0xffffu); *(bf16_t*)(tp + 5 * P2_TS) = (bf16_t)(v.z >> 16);
            *(bf16_t*)(tp + 6 * P2_TS) = (bf16_t)(v.w & 0xffffu); *(bf16_t*)(tp + 7 * P2_TS) = (bf16_t)(v.w >> 16);
        }
        __builtin_amdgcn_s_waitcnt(0); __builtin_amdgcn_wave_barrier();
        bf16_t* VT = (bf16_t*)(ws + WS_VT) + (size_t)h * 64 * KVROWS + 64 * blk;
#pragma unroll
        for (int it = 0; it < 8; ++it) {
            const int e = 8 * it + (lane >> 3), ch = lane & 7;
            const u32x2 lo = *(const u32x2*)(T + e * P2_TS + 16 * ch), hi = *(const u32x2*)(T + e * P2_TS + 16 * ch + 8);
            *(u32x4*)(VT + (size_t)e * KVROWS + 8 * ch) = (u32x4){lo.x, lo.y, hi.x, hi.y};
        }
        __builtin_amdgcn_s_waitcnt(0); __builtin_amdgcn_wave_barrier();
    }
}

constexpr int A_KSTR = 208;
constexpr int A_VSTR = 136;
constexpr int A_KBYTES = 64 * A_KSTR;
constexpr int A_VBYTES = 64 * A_VSTR;
constexpr int A_BUF = A_KBYTES + A_VBYTES;
DI unsigned cvtpk_s(float lo, float hi) { typedef float f2 __attribute__((ext_vector_type(2))); typedef __bf16 b2 __attribute__((ext_vector_type(2))); f2 v = {lo, hi}; b2 b = __builtin_convertvector(v, b2); return __builtin_bit_cast(unsigned, b); }

DI void attn_item(const Frame& F, const Args& A, int h, int qb) {
    unsigned char* ws = A.ws; unsigned char* lds = F.lds;
    const int tid = F.tid, lane = F.lane, wave = F.wave, r32 = lane & 31, hh = lane >> 5;
    const bf16_t* Qg = (const bf16_t*)(ws + WS_Q) + (size_t)h * KVROWS * 96;
    const bf16_t* Kg = (const bf16_t*)(ws + WS_K) + (size_t)h * KVROWS * 96;
    const bf16_t* Vg = (const bf16_t*)(ws + WS_VT) + (size_t)h * 64 * KVROWS;
    const int p0w = 64 + 256 * qb + 32 * wave;
    const int qp = p0w + r32;
    const int ntile = 4 * qb + 5;
    const int mylast = 1 + 4 * qb + (wave >> 1);
    bf16x8 qf[6];
#pragma unroll
    for (int s = 0; s < 6; ++s) qf[s] = *(const bf16x8*)(Qg + (size_t)qp * 96 + 16 * s + 8 * hh);
    f32x16 ot[2]; ot[0] = zero16(); ot[1] = zero16();
    float mrun = -1e30f, lrun = 0.f;
    const int kr0 = tid / 12, kc0 = tid % 12, kr1 = (tid + 512) / 12, kc1 = (tid + 512) % 12; const bool k1ok = tid < 256;
    const int vr = tid >> 3, vc = tid & 7;
    u32x4 sk0, sk1, sv;
    auto gload = [&](int j) {
        const int kv0 = 64 * j;
        sk0 = *(const u32x4*)(Kg + (size_t)(kv0 + kr0) * 96 + kc0 * 8);
        if (k1ok) sk1 = *(const u32x4*)(Kg + (size_t)(kv0 + kr1) * 96 + kc1 * 8);
        sv = *(const u32x4*)(Vg + (size_t)vr * KVROWS + kv0 + vc * 8);
    };
    auto lstore = [&](int b) {
        unsigned char* kb = lds + b * A_BUF; unsigned char* vb = kb + A_KBYTES;
        *(u32x4*)(kb + kr0 * A_KSTR + kc0 * 16) = sk0;
        if (k1ok) *(u32x4*)(kb + kr1 * A_KSTR + kc1 * 16) = sk1;
        *(u32x2*)(vb + vr * A_VSTR + vc * 16) = (u32x2){sv.x, sv.y};
        *(u32x2*)(vb + vr * A_VSTR + vc * 16 + 8) = (u32x2){sv.z, sv.w};
    };
    gload(0); lstore(0);
    __syncthreads();
#pragma unroll 1
    for (int j = 0; j < ntile; ++j) {
        const int b = j & 1;
        if (j + 1 < ntile) gload(j + 1);
        if (j <= mylast) {
            const unsigned char* kb = lds + b * A_BUF; const unsigned char* vb = kb + A_KBYTES;
            f32x16 sc[2];
#pragma unroll
            for (int kh = 0; kh < 2; ++kh) {
                f32x16 acc = zero16();
                const unsigned char* kp = kb + (32 * kh + r32) * A_KSTR + hh * 16;
#pragma unroll
                for (int s = 0; s < 6; ++s) acc = mfma32(*(const bf16x8*)(kp + s * 32), qf[s], acc);
                sc[kh] = acc;
            }
            if (j == 0) {
#pragma unroll
                for (int kh = 0; kh < 2; ++kh)
#pragma unroll
                    for (int r = 0; r < 16; ++r) { const int kv = 32 * kh + crow(r, hh); if (kv < PADL) sc[kh][r] = -INFINITY; }
            }
            if (j == mylast) {
#pragma unroll
                for (int kh = 0; kh < 2; ++kh)
#pragma unroll
                    for (int r = 0; r < 16; ++r) { const int kv = 64 * j + 32 * kh + crow(r, hh); if (kv > qp) sc[kh][r] = -INFINITY; }
            }
            float mx = sc[0][0];
#pragma unroll
            for (int r = 1; r < 16; ++r) mx = fmaxf(mx, sc[0][r]);
#pragma unroll
            for (int r = 0; r < 16; ++r) mx = fmaxf(mx, sc[1][r]);
            mx = fmaxf(mx, __shfl_xor(mx, 32));
            const float mnew = fmaxf(mrun, mx);
            const float alpha = __builtin_amdgcn_exp2f(mrun - mnew);
            mrun = mnew;
            float ps = 0.f;
#pragma unroll
            for (int kh = 0; kh < 2; ++kh)
#pragma unroll
                for (int r = 0; r < 16; ++r) { const float e = __builtin_amdgcn_exp2f(sc[kh][r] - mnew); sc[kh][r] = e; ps += e; }
            lrun = lrun * alpha + ps;
#pragma unroll
            for (int eh = 0; eh < 2; ++eh)
#pragma unroll
                for (int r = 0; r < 16; ++r) ot[eh][r] *= alpha;
#pragma unroll
            for (int kh = 0; kh < 2; ++kh)
#pragma unroll
                for (int s2 = 0; s2 < 2; ++s2) {
                    u32x4 pw; pw.x = cvtpk_s(sc[kh][8 * s2 + 0], sc[kh][8 * s2 + 1]); pw.y = cvtpk_s(sc[kh][8 * s2 + 2], sc[kh][8 * s2 + 3]);
                    pw.z = cvtpk_s(sc[kh][8 * s2 + 4], sc[kh][8 * s2 + 5]); pw.w = cvtpk_s(sc[kh][8 * s2 + 6], sc[kh][8 * s2 + 7]);
                    const bf16x8 pf = __builtin_bit_cast(bf16x8, pw);
#pragma unroll
                    for (int eh = 0; eh < 2; ++eh) {
                        const unsigned char* vp = vb + (32 * eh + r32) * A_VSTR + (32 * kh + 16 * s2 + 4 * hh) * 2;
                        const u32x2 lo = *(const u32x2*)vp, hi2 = *(const u32x2*)(vp + 16);
                        const bf16x8 vf = __builtin_bit_cast(bf16x8, (u32x4){lo.x, lo.y, hi2.x, hi2.y});
                        ot[eh] = mfma32(vf, pf, ot[eh]);
                    }
                }
        }
        if (j + 1 < ntile) lstore(b ^ 1);
        __syncthreads();
    }
    const float ltot = lrun + __shfl_xor(lrun, 32);
    const float rl = 1.f / ltot;
    bf16_t* o = (bf16_t*)(ws + WS_MIX) + (size_t)(qp - 64) * 1024 + 512 + h * 64;
#pragma unroll
    for (int eh = 0; eh < 2; ++eh)
#pragma unroll
        for (int a = 0; a < 4; ++a) {
            const int e = 32 * eh + 8 * a + 4 * hh;
            *(u32x2*)(o + e) = (u32x2){pk2(ot[eh][4 * a] * rl, ot[eh][4 * a + 1] * rl), pk2(ot[eh][4 * a + 2] * rl, ot[eh][4 * a + 3] * rl)};
        }
}

DI void xn_rows(const Frame& F, const Args& A, int u0, int stride) {
    f32x4 v[2][4];
#pragma unroll
    for (int r = 0; r < 2; ++r) { const int u = u0 + r * stride; if (u < MU) { const f32x4* xr = (const f32x4*)(A.out + (size_t)u * DM) + F.lane;
#pragma unroll
        for (int j = 0; j < 4; ++j) v[r][j] = xr[64 * j]; } }
#pragma unroll
    for (int r = 0; r < 2; ++r) {
        const int u = u0 + r * stride; if (u >= MU) continue;
        float s = 0.f;
#pragma unroll
        for (int j = 0; j < 4; ++j) s += (v[r][j].x * v[r][j].x + v[r][j].y * v[r][j].y) + (v[r][j].z * v[r][j].z + v[r][j].w * v[r][j].w);
        const float rstd = 1.f / sqrtf(wave_sum(s) * (1.f / DM) + EPS);
        unsigned long long* o8 = (unsigned long long*)((bf16_t*)(A.ws + WS_XN) + (size_t)u * DM) + F.lane;
#pragma unroll
        for (int j = 0; j < 4; ++j) { const f32x4 w = ((const f32x4*)A.in[15])[64 * j + F.lane];
            o8[64 * j] = (unsigned long long)pk2(v[r][j].x * rstd * w.x, v[r][j].y * rstd * w.y) | ((unsigned long long)pk2(v[r][j].z * rstd * w.z, v[r][j].w * rstd * w.w) << 32); }
    }
}

DI unsigned fkey(float v, int idx) { unsigned u = __builtin_bit_cast(unsigned, v); u = (u & 0x80000000u) ? ~u : (u | 0x80000000u); return (u & ~127u) | (unsigned)(127 - idx); }
DI float keyval(unsigned k) { unsigned u = k & ~127u; u = (u & 0x80000000u) ? (u & 0x7fffffffu) : ~u; return __builtin_bit_cast(float, u); }

__device__ const unsigned char PAIR_A[50] = {0,0,0,0,0,0,0,0,0,0,0,0,0,0,0,0, 1,1,1,1,1,1,1,1, 2,2,2,2,2, 3,3,3,3, 4,4,4, 5,5, 6,6, 7,7, 8,9,10,11,12,13,14,15};
__device__ const unsigned char PAIR_B[50] = {0,1,2,3,4,5,6,7,8,9,10,11,12,13,14,15, 0,1,2,3,4,5,6,7, 0,1,2,3,4, 0,1,2,3, 0,1,2, 0,1, 0,1, 0,1, 0,0,0,0,0,0,0,0};

DI void ce_desc(unsigned& a, unsigned& b) { const unsigned mx = a > b ? a : b, mn = a > b ? b : a; a = mx; b = mn; }
template <int BASE, int NK> DI void bitonic_sort16_desc(unsigned (&x)[NK]) {
#pragma unroll
    for (int k = 2; k <= 16; k <<= 1)
#pragma unroll
        for (int j = k >> 1; j > 0; j >>= 1)
#pragma unroll
            for (int i = 0; i < 16; ++i) { const int l = i ^ j; if (l > i) { if ((i & k) == 0) ce_desc(x[BASE + i], x[BASE + l]); else ce_desc(x[BASE + l], x[BASE + i]); } }
}
template <int A0, int B0, int NK> DI void merge_top16(unsigned (&x)[NK]) {
#pragma unroll
    for (int i = 0; i < 16; ++i) { const unsigned p = x[A0 + i], q = x[B0 + 15 - i]; x[A0 + i] = p > q ? p : q; }
#pragma unroll
    for (int j = 8; j > 0; j >>= 1)
#pragma unroll
        for (int i = 0; i < 16; ++i) { const int l = i ^ j; if (l > i) ce_desc(x[A0 + i], x[A0 + l]); }
}
template <int NK> DI void top16_of_128(unsigned (&key)[NK]) {
    bitonic_sort16_desc<0, NK>(key); bitonic_sort16_desc<16, NK>(key); bitonic_sort16_desc<32, NK>(key); bitonic_sort16_desc<48, NK>(key);
    bitonic_sort16_desc<64, NK>(key); bitonic_sort16_desc<80, NK>(key); bitonic_sort16_desc<96, NK>(key); bitonic_sort16_desc<112, NK>(key);
    merge_top16<0, 16, NK>(key); merge_top16<32, 48, NK>(key); merge_top16<64, 80, NK>(key); merge_top16<96, 112, NK>(key);
    merge_top16<0, 32, NK>(key); merge_top16<64, 96, NK>(key);
    merge_top16<0, 64, NK>(key);
}

DI void topk_task(const Frame& F, const Args& A, int task) {
    unsigned char* ws = A.ws; const int tid = F.tid;
    const int u = task >> 3, h = task & 7;
    LAS unsigned* sk = (LAS unsigned*)(LAS unsigned char*)F.lds;
    LAS unsigned* pkk = sk + 16384;
    LAS float* stg = (LAS float*)(sk + 16384);
    const float* SCb = (const float*)(ws + WS_SC) + (size_t)(task & ~511) * 256;
#pragma unroll 1
    for (int half = 0; half < 2; ++half) {
        unsigned key[128];
#pragma unroll
        for (int qb = 0; qb < 4; ++qb) {
            u32x4 pf[8];
#pragma unroll
            for (int k = 0; k < 8; ++k) { const int c = tid + 512 * k; pf[k] = *(const u32x4*)(SCb + (size_t)(c >> 3) * 256 + half * 128 + qb * 32 + (c & 7) * 4); }
#pragma unroll
            for (int k = 0; k < 8; ++k) { const int c = tid + 512 * k; *(LAS u32x4*)(stg + (c >> 3) * 36 + (c & 7) * 4) = pf[k]; }
            __syncthreads();
#pragma unroll
            for (int i = 0; i < 8; ++i) { const f32x4 v = *(const LAS f32x4*)(stg + tid * 36 + 4 * i);
                key[32 * qb + 4 * i] = fkey(v.x, 32 * qb + 4 * i); key[32 * qb + 4 * i + 1] = fkey(v.y, 32 * qb + 4 * i + 1);
                key[32 * qb + 4 * i + 2] = fkey(v.z, 32 * qb + 4 * i + 2); key[32 * qb + 4 * i + 3] = fkey(v.w, 32 * qb + 4 * i + 3); }
            __syncthreads();
        }
        top16_of_128(key);
#pragma unroll
        for (int r = 0; r < 16; ++r) sk[(half * 16 + r) * 512 + tid] = key[r];
    }
    float v1[16], v2[16];
#pragma unroll
    for (int r = 0; r < 16; ++r) { v1[r] = keyval(sk[r * 512 + tid]); v2[r] = keyval(sk[(16 + r) * 512 + tid]); }
    unsigned ck[64];
#pragma unroll
    for (int c = 50; c < 64; ++c) ck[c] = 0u;
#pragma unroll
    for (int a = 0; a < 16; ++a) {
        const int off = a == 0 ? 0 : a == 1 ? 16 : a == 2 ? 24 : a == 3 ? 29 : a == 4 ? 33 : a == 5 ? 36 : a == 6 ? 38 : a == 7 ? 40 : 42 + (a - 8);
#pragma unroll
        for (int b = 0; b < 16; ++b) if ((a + 1) * (b + 1) <= 16) ck[off + b] = fkey(v1[a] + v2[b], off + b);
    }
    bitonic_sort16_desc<0, 64>(ck); bitonic_sort16_desc<16, 64>(ck); bitonic_sort16_desc<32, 64>(ck); bitonic_sort16_desc<48, 64>(ck);
    merge_top16<0, 16, 64>(ck); merge_top16<32, 48, 64>(ck); merge_top16<0, 32, 64>(ck);
#pragma unroll
    for (int r = 0; r < 16; ++r) pkk[r * 512 + tid] = ck[r];
    const float cmax = keyval(pkk[tid]);
    float ev[16]; float esum = 0.f; int ex[16];
#pragma unroll
    for (int r = 0; r < 16; ++r) {
        const unsigned k = pkk[r * 512 + tid]; const int c = 127 - (int)(k & 127u);
        ev[r] = __expf(keyval(k) - cmax); esum += ev[r];
        const int a = PAIR_A[c], b = PAIR_B[c];
        const int i1 = 127 - (int)(sk[a * 512 + tid] & 127u), i2 = 127 - (int)(sk[(16 + b) * 512 + tid] & 127u);
        ex[r] = i1 * 128 + i2;
    }
    const float rs = 1.f / esum;
    int* IDX = (int*)(ws + WS_IDX) + (size_t)u * 128 + h * 16; float* GATE = (float*)(ws + WS_GATE) + (size_t)u * 128 + h * 16;
#pragma unroll
    for (int r = 0; r < 16; r += 4) {
        *(int4*)(IDX + r) = make_int4(ex[r], ex[r + 1], ex[r + 2], ex[r + 3]);
        *(f32x4*)(GATE + r) = (f32x4){ev[r] * rs, ev[r + 1] * rs, ev[r + 2] * rs, ev[r + 3] * rs};
    }
}

constexpr float EU_SCALE = 64.f, EV_SCALE = 16.f;
DI unsigned pk4_fp8(float a, float b, float c, float d) { int w = 0; w = __builtin_amdgcn_cvt_pk_fp8_f32(a, b, w, false); w = __builtin_amdgcn_cvt_pk_fp8_f32(c, d, w, true); return (unsigned)w; }
DI void convert_tables(const Frame& F, const Args& A) {
    const size_t n16 = (size_t)16384 * 1024 / 16;
    const size_t gt = (size_t)blockIdx.x * 512 + F.tid, NGT = (size_t)F.G * 512;
#pragma unroll 1
    for (int t = 0; t < 2; ++t) {
        const float* src = A.in[18 + t]; unsigned char* dst = A.ws + (t ? WS_EV : WS_EU); const float sc = t ? EV_SCALE : EU_SCALE;
        for (size_t i = gt; i < n16; i += NGT) {
            const f32x4 a = *(const f32x4*)(src + i * 16) * sc, b = *(const f32x4*)(src + i * 16 + 4) * sc, c = *(const f32x4*)(src + i * 16 + 8) * sc, d = *(const f32x4*)(src + i * 16 + 12) * sc;
            const size_t e_ = i >> 6, c16_ = i & 63;
            *(u32x4*)(dst + (c16_ >> 3) * ((size_t)16384 * 128) + e_ * 128 + (c16_ & 7) * 16) = (u32x4){pk4_fp8(a.x, a.y, a.z, a.w), pk4_fp8(b.x, b.y, b.z, b.w), pk4_fp8(c.x, c.y, c.z, c.w), pk4_fp8(d.x, d.y, d.z, d.w)};
        }
    }
}

DI float gelu_exact(float x) { return 0.5f * x * (1.f + erff(x * 0.70710678118654752f)); }
typedef float f32x2 __attribute__((ext_vector_type(2)));
#define UNPK16(dst, W_) do { f32x2 _t; \
    _t = __builtin_amdgcn_cvt_pk_f32_fp8((int)(W_).x, false); dst[0] = _t.x; dst[1] = _t.y; _t = __builtin_amdgcn_cvt_pk_f32_fp8((int)(W_).x, true); dst[2] = _t.x; dst[3] = _t.y; \
    _t = __builtin_amdgcn_cvt_pk_f32_fp8((int)(W_).y, false); dst[4] = _t.x; dst[5] = _t.y; _t = __builtin_amdgcn_cvt_pk_f32_fp8((int)(W_).y, true); dst[6] = _t.x; dst[7] = _t.y; \
    _t = __builtin_amdgcn_cvt_pk_f32_fp8((int)(W_).z, false); dst[8] = _t.x; dst[9] = _t.y; _t = __builtin_amdgcn_cvt_pk_f32_fp8((int)(W_).z, true); dst[10] = _t.x; dst[11] = _t.y; \
    _t = __builtin_amdgcn_cvt_pk_f32_fp8((int)(W_).w, false); dst[12] = _t.x; dst[13] = _t.y; _t = __builtin_amdgcn_cvt_pk_f32_fp8((int)(W_).w, true); dst[14] = _t.x; dst[15] = _t.y; } while (0)

template <bool UPH>
DI void expert_phase(const Frame& F, const Args& A, int xv, int wq, int nw) {
    unsigned char* ws = A.ws; const int lane = F.lane, grp = lane >> 3, j = lane & 7;
    const unsigned char* TBL = ws + (UPH ? WS_EU : WS_EV) + (size_t)xv * ((size_t)16384 * 128) + 16 * j;
    const int* IDX = (const int*)(ws + WS_IDX); const float* CW = (const float*)(ws + WS_CW);
    const bf16_t* XN = (const bf16_t*)(ws + WS_XN) + 128 * xv + 16 * j;
    float* HP = (float*)(ws + WS_HP);
    LAS unsigned* ring = (LAS unsigned*)((LAS unsigned char*)F.lds + F.wave * 4096);
    const int nt = (MU - wq + nw - 1) / nw;
    if (nt <= 0) return;
    auto tok = [&](int k) { return __builtin_amdgcn_readfirstlane(wq + (k < nt ? k : nt - 1) * nw); };
    int mi0, mi1; u32x4 mx0, mx1; float mh0, mh1;
    auto meta_load = [&](int k) {
        const int u = tok(k);
        mi0 = IDX[(size_t)u * 128 + lane]; mi1 = IDX[(size_t)u * 128 + 64 + lane];
        if constexpr (UPH) { mx0 = *(const u32x4*)(XN + (size_t)u * DM); mx1 = *(const u32x4*)(XN + (size_t)u * DM + 8); }
        else { mh0 = CW[(size_t)u * 128 + lane]; mh1 = CW[(size_t)u * 128 + 64 + lane]; }
    };
    auto meta_store = [&](int k) {
        LAS unsigned* sl = ring + (k & 3) * 256;
        sl[lane] = (unsigned)mi0; sl[64 + lane] = (unsigned)mi1;
        if constexpr (UPH) { if (grp == 0) { *(LAS u32x4*)(sl + 128 + 8 * j) = mx0; *(LAS u32x4*)(sl + 128 + 8 * j + 4) = mx1; } }
        else { sl[128 + lane] = __builtin_bit_cast(unsigned, mh0); sl[192 + lane] = __builtin_bit_cast(unsigned, mh1); }
    };
    auto gather = [&](u32x4 (&buf)[8], int n) {
        const LAS unsigned* sl = ring + ((n >> 1) & 3) * 256 + 64 * (n & 1) + grp;
#pragma unroll
        for (int i = 0; i < 8; ++i) { const int e = (int)sl[8 * i]; buf[i] = *(const u32x4*)(TBL + (size_t)e * 128); }
    };
    const int ocol = 128 * xv + 16 * j + ((lane & 32) ? 8 : 0) + ((lane & 16) ? 4 : 0) + ((lane & 8) ? 2 : 0);
    f32x2 ocur = (f32x2){0.f, 0.f};
    float acc[16];
    float xn[16];
    auto compute = [&](u32x4 (&buf)[8], int n) {
        const int k = n >> 1, hf = n & 1;
        const LAS unsigned* sl = ring + (k & 3) * 256;
        if (hf == 0) {
            if constexpr (UPH) {
                const u32x4 x0 = *(const LAS u32x4*)(sl + 128 + 8 * j), x1 = *(const LAS u32x4*)(sl + 128 + 8 * j + 4);
                xn[0] = bflo(x0.x); xn[1] = bfhi(x0.x); xn[2] = bflo(x0.y); xn[3] = bfhi(x0.y); xn[4] = bflo(x0.z); xn[5] = bfhi(x0.z); xn[6] = bflo(x0.w); xn[7] = bfhi(x0.w);
                xn[8] = bflo(x1.x); xn[9] = bfhi(x1.x); xn[10] = bflo(x1.y); xn[11] = bfhi(x1.y); xn[12] = bflo(x1.z); xn[13] = bfhi(x1.z); xn[14] = bflo(x1.w); xn[15] = bfhi(x1.w);
            } else {
#pragma unroll
                for (int c = 0; c < 16; ++c) acc[c] = 0.f;
                ocur = *(const f32x2*)(A.out + (size_t)tok(k) * DM + ocol);
            }
        }
#pragma unroll
        for (int i = 0; i < 8; ++i) {
            float f[16]; UNPK16(f, buf[i]);
            if constexpr (UPH) {
                float a0 = 0.f, a1 = 0.f;
#pragma unroll
                for (int c = 0; c < 16; c += 2) { a0 += f[c] * xn[c]; a1 += f[c + 1] * xn[c + 1]; }
                if (hf == 0) acc[i] = a0 + a1; else acc[8 + i] = a0 + a1;
                if (i < 7) { if (hf == 0) asm volatile("" : "+v"(buf[i + 1].x), "+v"(buf[i + 1].y), "+v"(buf[i + 1].z), "+v"(buf[i + 1].w), "+v"(acc[i]));
                             else asm volatile("" : "+v"(buf[i + 1].x), "+v"(buf[i + 1].y), "+v"(buf[i + 1].z), "+v"(buf[i + 1].w), "+v"(acc[8 + i])); }
            } else {
                const float cw = __builtin_bit_cast(float, sl[128 + 64 * hf + 8 * i + grp]);
#pragma unroll
                for (int c = 0; c < 16; ++c) acc[c] += cw * f[c];
                if (i < 7) asm volatile("" : "+v"(buf[i + 1].x), "+v"(buf[i + 1].y), "+v"(buf[i + 1].z), "+v"(buf[i + 1].w),
                                             "+v"(acc[0]), "+v"(acc[1]), "+v"(acc[2]), "+v"(acc[3]), "+v"(acc[4]), "+v"(acc[5]), "+v"(acc[6]), "+v"(acc[7]),
                                             "+v"(acc[8]), "+v"(acc[9]), "+v"(acc[10]), "+v"(acc[11]), "+v"(acc[12]), "+v"(acc[13]), "+v"(acc[14]), "+v"(acc[15]));
            }
            __builtin_amdgcn_sched_barrier(0);
        }
        if (hf == 1 && k < nt) {
            const int u = tok(k);
            float r8[8], r4[4], r2[2];
            if constexpr (UPH) {
                { const bool up = lane & 4;
#pragma unroll
                  for (int i = 0; i < 8; ++i) { const float send = up ? acc[i] : acc[i + 8], keep = up ? acc[i + 8] : acc[i]; r8[i] = keep + __shfl_xor(send, 4); } }
                { const bool up = lane & 2;
#pragma unroll
                  for (int i = 0; i < 4; ++i) { const float send = up ? r8[i] : r8[i + 4], keep = up ? r8[i + 4] : r8[i]; r4[i] = keep + __shfl_xor(send, 2); } }
                { const bool up = lane & 1;
#pragma unroll
                  for (int i = 0; i < 2; ++i) { const float send = up ? r4[i] : r4[i + 2], keep = up ? r4[i + 2] : r4[i]; r2[i] = keep + __shfl_xor(send, 1); } }
                const int st = ((lane & 4) ? 8 : 0) + ((lane & 2) ? 4 : 0) + ((lane & 1) ? 2 : 0);
                float* hp = HP + ((size_t)xv * MU + u) * 128 + grp;
                hp[8 * st] = r2[0]; hp[8 * (st + 1)] = r2[1];
            } else {
                { const bool up = lane & 32;
#pragma unroll
                  for (int c = 0; c < 8; ++c) { const float send = up ? acc[c] : acc[c + 8], keep = up ? acc[c + 8] : acc[c]; r8[c] = keep + __shfl_xor(send, 32); } }
                { const bool up = lane & 16;
#pragma unroll
                  for (int c = 0; c < 4; ++c) { const float send = up ? r8[c] : r8[c + 4], keep = up ? r8[c + 4] : r8[c]; r4[c] = keep + __shfl_xor(send, 16); } }
                { const bool up = lane & 8;
#pragma unroll
                  for (int c = 0; c < 2; ++c) { const float send = up ? r4[c] : r4[c + 2], keep = up ? r4[c + 2] : r4[c]; r2[c] = keep + __shfl_xor(send, 8); } }
                f32x2* o = (f32x2*)(A.out + (size_t)u * DM + ocol);
                f32x2 cur = ocur; cur.x += r2[0]; cur.y += r2[1]; *o = cur;
            }
        }
    };
    meta_load(0); meta_store(0); meta_load(1); meta_store(1); meta_load(2); meta_store(2);
    u32x4 b0[8], b1[8], b2[8];
    gather(b0, 0); gather(b1, 1); gather(b2, 2);
#pragma unroll 1
    for (int k0 = 0; k0 < nt; k0 += 3) {
        const int n0 = 2 * k0;
        meta_load(k0 + 3);
        compute(b0, n0);     gather(b0, n0 + 3);
        compute(b1, n0 + 1); meta_store(k0 + 3); gather(b1, n0 + 4);
        meta_load(k0 + 4);
        compute(b2, n0 + 2); gather(b2, n0 + 5);
        compute(b0, n0 + 3); meta_store(k0 + 4); gather(b0, n0 + 6);
        meta_load(k0 + 5);
        compute(b1, n0 + 4); gather(b1, n0 + 7);
        compute(b2, n0 + 5); meta_store(k0 + 5); gather(b2, n0 + 8);
    }
}


DI void expert_c_pass(const Frame& F, const Args& A) {
    unsigned char* ws = A.ws;
    const float* HP = (const float*)(ws + WS_HP); const float* GATE = (const float*)(ws + WS_GATE); float* CW = (float*)(ws + WS_CW);
    const size_t n4 = (size_t)MU * 128 / 4;
    for (size_t i = (size_t)blockIdx.x * 512 + F.tid; i < n4; i += (size_t)F.G * 512) {
        f32x4 h = *(const f32x4*)(HP + i * 4);
#pragma unroll
        for (int x = 1; x < 8; ++x) h += *(const f32x4*)(HP + (size_t)x * MU * 128 + i * 4);
        const f32x4 g = *(const f32x4*)(GATE + i * 4);
        f32x4 c;
        c.x = gelu_exact(h.x * (1.f / EU_SCALE)) * g.x * (1.f / EV_SCALE); c.y = gelu_exact(h.y * (1.f / EU_SCALE)) * g.y * (1.f / EV_SCALE);
        c.z = gelu_exact(h.z * (1.f / EU_SCALE)) * g.z * (1.f / EV_SCALE); c.w = gelu_exact(h.w * (1.f / EU_SCALE)) * g.w * (1.f / EV_SCALE);
        *(f32x4*)(CW + i * 4) = c;
    }
}
#ifndef PROBE_VAR
#define PROBE_VAR 0
#endif
template <int PH> DI void run_phase(const Frame& F, const Args& args, PG8_LAS unsigned char* lds3) {
    unsigned char* ws = args.ws;
    if constexpr (PH == 0) { p0_prologue(F, args); }
    if constexpr (PH == 1) {
        pg8::Gemm g{(const bf16_t*)(ws + WS_HN), (const bf16_t*)(ws + WS_WIN), MP, NPROJ, 1024, 1024, 1024, 0};
        pg8::StaticOrder S; S.init(MP, NPROJ, F.G, (int)blockIdx.x);
        EpiProj E{(bf16_t*)(ws + WS_QKVR), (bf16_t*)(ws + WS_Z), (float*)(ws + WS_P32)};
        pg8::gemm_phase<EpiProj, pg8::StaticOrder, true, true>(lds3, g, S, E);
    }
    if constexpr (PH == 2) { gdn_prep_phase<0>(F, args); }
    if constexpr (PH == 102) { gdn_prep_phase<PROBE_VAR>(F, args); }
    if constexpr (PH == 3) {
        gdn_scan(F, args);
        if (F.G > 32 && blockIdx.x >= 32) {
            const int wi = (blockIdx.x - 32) * 8 + F.wave, nwv = (F.G - 32) * 8;
            p0_late_weights(F, args, wi, nwv, (blockIdx.x - 32) * 512 + F.tid, (F.G - 32) * 512);
            for (int p = wi; p < MP; p += nwv) mla_prep1_row(F, args, p);
        }
    }
    if constexpr (PH == 4) {
        for (int t = F.gw; t < 2048 * 2; t += F.NGW) gdn_out_task(F, args, t);
        if (F.G <= 32) for (int p = F.gw; p < MP; p += F.NGW) mla_prep1_row(F, args, p);
    }
    if constexpr (PH == 5) {
        { pg8::Gemm g{(const bf16_t*)(ws + WS_CQN), (const bf16_t*)(ws + WS_WUQ), MP, 768, 256, 256, 256, 0};
          pg8::StaticOrder S; S.init(MP, 768, F.G, (int)blockIdx.x); EpiB16 E{(bf16_t*)(ws + WS_QH), 768};
          pg8::gemm_phase<EpiB16, pg8::StaticOrder, true, true>(lds3, g, S, E); }
        { pg8::Gemm g{(const bf16_t*)(ws + WS_CKVN), (const bf16_t*)(ws + WS_WUKV), MP, 1024, 256, 256, 256, 0};
          pg8::StaticOrder S; S.init(MP, 1024, F.G, (int)blockIdx.x); EpiB16 E{(bf16_t*)(ws + WS_KVB), 1024};
          pg8::gemm_phase<EpiB16, pg8::StaticOrder, true, true>(lds3, g, S, E); }
    }
    if constexpr (PH == 6) { for (int t = F.gw; t < (KVROWS / 64) * 8; t += F.NGW) mla_prep2_task(F, args, t); }
    if constexpr (PH == 7) {
        for (int rep = 0; rep < 2; ++rep) {
            for (int k0 = blockIdx.x; k0 < 256; k0 += F.G) {
                const int k = rep == 0 ? k0 : 511 - k0;
                attn_item(F, args, k & 7, 63 - (k >> 3));
            }
        }
    }
    if constexpr (PH == 8) {
        pg8::Gemm g{(const bf16_t*)(ws + WS_MIX), (const bf16_t*)(ws + WS_WOUT), MU, 1024, 1024, 1024, 1024, 0};
        pg8::StaticOrder S; S.init(MU, 1024, F.G, (int)blockIdx.x); EpiF32 E{args.out, 1024, args.in[0]};
        pg8::gemm_phase<EpiF32, pg8::StaticOrder, true, true>(lds3, g, S, E);
    }
    if constexpr (PH == 9) { for (int u = F.gw; u < MU; u += 2 * F.NGW) xn_rows(F, args, u, F.NGW); }
    if constexpr (PH == 10) {
        pg8::Gemm g{(const bf16_t*)(ws + WS_XN), (const bf16_t*)(ws + WS_WPQ), MU, 2048, 1024, 1024, 1024, 0};
        pg8::StaticOrder S; S.init(MU, 2048, F.G, (int)blockIdx.x); EpiB16 E{(bf16_t*)(ws + WS_PQ), 2048};
        pg8::gemm_phase<EpiB16, pg8::StaticOrder, true, true>(lds3, g, S, E);
    }
    if constexpr (PH == 11) {
        pg8::Gemm g{(const bf16_t*)(ws + WS_PQ), (const bf16_t*)(ws + WS_SKB), MU, 2048, 256, 2048, 256, 256};
        pg8::StaticOrder S; S.init(MU, 2048, F.G, (int)blockIdx.x); EpiF32 E{(float*)(ws + WS_SC), 2048, nullptr};
        pg8::gemm_phase<EpiF32, pg8::StaticOrder, true, true>(lds3, g, S, E);
    }
    if constexpr (PH == 12) {
        convert_tables(F, args);
        for (int t = blockIdx.x * 512 + F.tid; t < MU * 8; t += F.G * 512) topk_task(F, args, t);
    }
    if constexpr (PH == 14) { expert_c_pass(F, args); }
    if constexpr (PH == 13 || PH == 15) {
        volatile LAS unsigned* MISC = (volatile LAS unsigned*)(lds3 + MISC_OFF);
        const unsigned x = MISC[16], rank = MISC[17];
        unsigned* bar = (unsigned*)(ws + WS_CTL);
        unsigned nloc = 0, nx = 0, myidx = 0;
#pragma unroll
        for (unsigned j = 0; j < 16; ++j) { const unsigned c = xb_ld(&bar[XB_XCNT(j)]); nx += (c > 0u) ? 1u : 0u; myidx += (c > 0u && j < x) ? 1u : 0u; nloc = (j == x) ? c : nloc; }
        const int wq = __builtin_amdgcn_readfirstlane((int)rank * 8 + F.wave), nw = __builtin_amdgcn_readfirstlane((int)nloc * 8);
        const int xstep = __builtin_amdgcn_readfirstlane((int)nx);
        for (int xv = __builtin_amdgcn_readfirstlane((int)myidx); xv < 8; xv += xstep)
            { if constexpr (PH == 13) expert_phase<true>(F, args, xv, wq, nw); else expert_phase<false>(F, args, xv, wq, nw); }
    }
}
constexpr int NPHASE = 16;
__global__ void __launch_bounds__(512, 2) fwd_kernel(Args args) {
    extern __shared__ __attribute__((aligned(16))) unsigned char lds[];
    Frame F;
    F.lds = lds; F.tid = threadIdx.x; F.lane = F.tid & 63; F.wave = __builtin_amdgcn_readfirstlane(F.tid >> 6);
    F.G = gridDim.x; F.gw = blockIdx.x * 8 + F.wave; F.NGW = F.G * 8;
    volatile LAS unsigned* MISC = (volatile LAS unsigned*)((LAS unsigned char*)lds + MISC_OFF);
    if (F.tid < 32) MISC[F.tid] = 0u;
    __syncthreads();
    unsigned char* ws = args.ws;
    const int lo = args.ph_lo, hi = args.ph_hi;
    XcdBarrier bar; bar.bar = (unsigned*)(ws + WS_CTL); bar.x = 0; bar.st = nullptr;
    if (hi - lo > 1) bar = xcd_barrier_post((unsigned*)(ws + WS_CTL), MISC + 8);
    if (F.tid == 0) { const unsigned x = xb_xcc_id(); MISC[16] = x; MISC[17] = xb_add((unsigned*)(ws + WS_CTL) + 3520 + 64 * x, 1u); }
    __syncthreads();
#define IN(k) (lo <= (k) && (k) < hi)
#define SEAM(k) do { if (IN(k) && IN((k) + 1)) xcd_barrier(bar); } while (0)
    PG8_LAS unsigned char* lds3 = (PG8_LAS unsigned char*)lds;

#ifndef PROBE_REPEAT
#define PROBE_REPEAT -1
#endif
#ifndef PROBE_TIME
#define PROBE_TIME -1
#endif
#ifndef PROBE_TSEL
#define PROBE_TSEL 0
#endif
    unsigned long long pt_ticks = 0ull;
#define PHASE(k) do { unsigned long long pt0_ = 0ull; if (PROBE_TIME == (k)) pt0_ = __builtin_amdgcn_s_memrealtime(); \
        if (IN(k)) { run_phase<k>(F, args, lds3); if (PROBE_REPEAT == (k)) { xcd_barrier(bar); run_phase<(PROBE_VAR && (k) == 2) ? 102 : (k)>(F, args, lds3); } } \
        if (PROBE_TIME == (k) && PROBE_TSEL == 1) pt_ticks = __builtin_amdgcn_s_memrealtime() - pt0_;     \
        if (PROBE_TIME == (k) && PROBE_TSEL == 2) pt0_ = __builtin_amdgcn_s_memrealtime();                \
        SEAM(k); \
        if (PROBE_TIME == (k) && PROBE_TSEL != 1) pt_ticks = __builtin_amdgcn_s_memrealtime() - pt0_; } while (0)
    PHASE(0); PHASE(1); PHASE(2); PHASE(3); PHASE(4); PHASE(5); PHASE(6); PHASE(7); PHASE(8); PHASE(9); PHASE(10); PHASE(11); PHASE(12); PHASE(13); PHASE(14); PHASE(15);
#undef PHASE
    if (PROBE_STAGE >= 0) { __syncthreads(); pt_ticks = *(volatile unsigned long long*)(lds + 143360 + 96); }
    if (PROBE_TIME >= 0 || PROBE_STAGE >= 0) { const unsigned long long t0_ = __builtin_amdgcn_s_memrealtime(); while (__builtin_amdgcn_s_memrealtime() - t0_ < 4ull * pt_ticks) __builtin_amdgcn_s_sleep(32); }
#undef IN
#undef SEAM
}

#ifndef N_LAUNCHES
#define N_LAUNCHES 1
#endif
extern "C" void kernel_launch(void* const* d_in, const int* in_sizes, int n_in, void* d_out, int out_size, void* d_ws, size_t ws_size, hipStream_t stream) {
    static int grid = 0;
    if (grid == 0) {
        if (n_in != 20 || out_size != MU * DM || ws_size < WS_END) { fprintf(stderr, "kernel_launch: unexpected shapes (n_in %d out %d ws %zu)\n", n_in, out_size, ws_size); grid = -1; return; }
        int dev = 0, cus = 0, per_cu = 0;
        if (hipGetDevice(&dev) != hipSuccess || hipDeviceGetAttribute(&cus, hipDeviceAttributeMultiprocessorCount, dev) != hipSuccess) { grid = -1; return; }
        if (hipFuncSetAttribute((const void*)fwd_kernel, hipFuncAttributeMaxDynamicSharedMemorySize, LDS_BYTES) != hipSuccess) { fprintf(stderr, "kernel_launch: hipFuncSetAttribute failed\n"); grid = -1; return; }
        if (hipOccupancyMaxActiveBlocksPerMultiprocessor(&per_cu, (const void*)fwd_kernel, 512, LDS_BYTES) != hipSuccess || per_cu < 1) { fprintf(stderr, "kernel_launch: occupancy query says %d\n", per_cu); (void)hipGetLastError(); per_cu = 1; }
        grid = cus;
    }
    if (grid < 0) return;
    (void)hipMemsetAsync((char*)d_ws + WS_CTL, 0, CTL_ZERO_BYTES, stream);
    Args a{};
    for (int i = 0; i < 20; ++i) a.in[i] = (const float*)d_in[i];
    a.out = (float*)d_out; a.ws = (unsigned char*)d_ws;
    for (int li = 0; li < N_LAUNCHES; ++li) {
        a.ph_lo = li * NPHASE / N_LAUNCHES; a.ph_hi = (li + 1) * NPHASE / N_LAUNCHES;
        if (N_LAUNCHES == 1) {
            void* kargs[] = {&a};
            hipError_t e = hipLaunchCooperativeKernel((const void*)fwd_kernel, dim3(grid), dim3(512), kargs, LDS_BYTES, stream);
            if (e != hipSuccess) fprintf(stderr, "cooperative launch failed: %s (grid %d)\n", hipGetErrorString(e), grid);
        } else {
            hipLaunchKernelGGL(fwd_kernel, dim3(grid), dim3(512), LDS_BYTES, stream, a);
        }
    }
}
```

```cpp
#include <hip/hip_runtime.h>
#include <hip/hip_bf16.h>
#include <cstdio>
#include <cstdint>

#define DI __device__ __forceinline__
#define LAS __attribute__((address_space(3)))
#define GAS __attribute__((address_space(1)))

typedef unsigned short bf16_t;
typedef short bf16x8 __attribute__((ext_vector_type(8)));
typedef short s16x4 __attribute__((ext_vector_type(4)));
typedef float f32x4 __attribute__((ext_vector_type(4)));
typedef float f32x16 __attribute__((ext_vector_type(16)));
typedef unsigned u32x4 __attribute__((ext_vector_type(4)));
typedef unsigned u32x2 __attribute__((ext_vector_type(2)));

namespace pg8 {
#define PG8_LAS __attribute__((address_space(3)))
constexpr int BM = 256, BK = 64, HALF = 128, HTB = HALF * BK * 2  , STAGE_BYTES = 8 * HTB, NXCD = 8, WGM = 8;

__host__ __device__ __forceinline__ int lds_byte(int r, int c) { const int st = (r >> 4) * 2 + (c >> 5), rr = r & 15, cc = c & 31, ob = rr * 64 + cc * 2; return st * 1024 + (ob ^ (((ob >> 9) & 1) << 5)); }
__host__ __device__ __forceinline__ void stage_rc(int b, int& R, int& C) { const int st = b / 1024, sb = b % 1024, swz = sb ^ (((sb >> 9) & 1) << 5); R = (st >> 1) * 16 + swz / 64; C = (st & 1) * 32 + (swz % 64) / 2; }
__host__ __device__ __forceinline__ int perm32(int rho) { const int n = rho >> 4, i = rho & 15; return 8 * (i >> 2) + 4 * n + (i & 3); }

struct Unit { int pm, pn; };
struct Gemm { const bf16_t* A; const bf16_t* Bt; int M, N, K, lda, ldb, a_pn_off; };

struct StaticOrder {
    int nM, nN, nwg, G, c;
    __host__ __device__ void init(int M, int N, int G_, int c_) { nM = M / BM; nN = N / BM; nwg = nM * nN; G = G_; c = c_; }
    __host__ __device__ bool next(int i, Unit& u) const {
        const long L = (long)i * G + c; if (L >= nwg) return false;
        int wgid = (int)L; { const int q = nwg / NXCD, r = nwg % NXCD, xcd = wgid % NXCD, off = wgid / NXCD; wgid = (xcd < r ? xcd * (q + 1) : r * (q + 1) + (xcd - r) * q) + off; }
        const int nig = WGM * nN, gid = wgid / nig, fm = gid * WGM, gsz = (nM - fm) < WGM ? (nM - fm) : WGM;
        u.pm = fm + ((wgid % nig) % gsz); u.pn = (wgid % nig) / gsz; return true;
    }
    __device__ __forceinline__ void a_ready(const Unit&) const {}
    __device__ __forceinline__ void done(const Unit&) const {}
};

__device__ __forceinline__ unsigned cvt_pk_bf16(float lo, float hi) { unsigned r; asm volatile("v_cvt_pk_bf16_f32 %0, %1, %2" : "=v"(r) : "v"(lo), "v"(hi)); return r; }

template <class Epi, class Sched, bool ALIGN_EPI = false, bool SP2 = false>
__device__ __forceinline__ void gemm_phase(PG8_LAS unsigned char* lds, const Gemm g, const Sched& S, const Epi& E) {
    const int tid = threadIdx.x, wid = __builtin_amdgcn_readfirstlane(tid >> 6), lane = tid & 63, wr = wid >> 2, wc = wid & 3, fr = lane & 15, fq = lane >> 4;
    const int K = g.K, nt = K / BK;
    unsigned voffA[2], voffB[2];
#pragma unroll
    for (int i = 0; i < 2; ++i) { int R, C; stage_rc(tid * 16 + i * 8192, R, C); const int Rb = Epi::PERM ? ((R & ~31) + perm32(R & 31)) : R;
        voffA[i] = (unsigned)(R * g.lda + C) * 2u; voffB[i] = (unsigned)(Rb * g.ldb + C) * 2u; }
    const size_t kstep = (size_t)(BK * 2);
    const size_t hstepA = (size_t)HALF * g.lda * 2, hstepB = (size_t)HALF * g.ldb * 2;
    const size_t tstepA = 2 * hstepA, tstepB = 2 * hstepB;
    const size_t pnoffA = (size_t)g.a_pn_off * 2;
    const unsigned ldsw = (unsigned)wid * 1024u;
    const int aoff = lds_byte(wr * 64 + fr, fq * 8), boff = lds_byte(wc * 32 + fr, fq * 8);
#define PG8_SA(b, h) (((b) * 2 + (h)) * HTB)
#define PG8_SB(b, h) ((4 + (b) * 2 + (h)) * HTB)
#define PG8_STAGE(bufoff, gbase, voff) do { _Pragma("unroll") for (int _i = 0; _i < 2; ++_i) \
        __builtin_amdgcn_global_load_lds((const unsigned*)((const char*)(gbase) + (voff)[_i]), (PG8_LAS unsigned*)(lds + (bufoff) + ldsw + _i * 8192), 16, 0, 0); } while (0)
#define PG8_LDA(dst, b, h) do { _Pragma("unroll") for (int m = 0; m < 4; ++m) _Pragma("unroll") for (int k = 0; k < 2; ++k) dst[m][k] = *(const PG8_LAS bf16x8*)(lds + PG8_SA(b, h) + aoff + m * 2048 + k * 1024); } while (0)
#define PG8_LDB(dst, b, h) do { _Pragma("unroll") for (int n = 0; n < 2; ++n) _Pragma("unroll") for (int k = 0; k < 2; ++k) dst[n][k] = *(const PG8_LAS bf16x8*)(lds + PG8_SB(b, h) + boff + n * 2048 + k * 1024); } while (0)
#define PG8_MMA(ai, bj, At, Bt) do { __builtin_amdgcn_s_setprio(1); _Pragma("unroll") for (int m = 0; m < 4; ++m) _Pragma("unroll") for (int n = 0; n < 2; ++n) _Pragma("unroll") for (int k = 0; k < 2; ++k) \
        acc[ai][bj][m][n] = __builtin_amdgcn_mfma_f32_16x16x32_bf16(Bt[n][k], At[m][k], acc[ai][bj][m][n], 0, 0, 0); __builtin_amdgcn_s_setprio(0); } while (0)
#define PG8_WAIT_V(n) asm volatile("s_waitcnt vmcnt(" #n ")" ::: "memory")
#define PG8_WAIT_L(n) asm volatile("s_waitcnt lgkmcnt(" #n ")" ::: "memory")
#define PG8_BAR __builtin_amdgcn_s_barrier()
#define PG8_SCHED __builtin_amdgcn_sched_barrier(0)
    Unit cur, nxt; int ui = 0;
    if (!S.next(0, cur)) return;
    f32x4 acc[2][2][4][2];
#pragma unroll
    for (int a = 0; a < 2; ++a)
#pragma unroll
        for (int b = 0; b < 2; ++b)
#pragma unroll
            for (int m = 0; m < 4; ++m)
#pragma unroll
                for (int n = 0; n < 2; ++n) acc[a][b][m][n] = (f32x4){0.f, 0.f, 0.f, 0.f};
    bf16x8 At[4][2], B0[2][2], B1[2][2];
    const char* cA = (const char*)g.A + (size_t)cur.pm * tstepA + (size_t)cur.pn * pnoffA; const char* cB = (const char*)g.Bt + (size_t)cur.pn * tstepB;
    S.a_ready(cur);
    if constexpr (SP2) {
        PG8_STAGE(PG8_SB(0, 0), cB, voffB); PG8_STAGE(PG8_SB(0, 1), cB + hstepB, voffB); PG8_STAGE(PG8_SA(0, 0), cA, voffA); PG8_STAGE(PG8_SA(0, 1), cA + hstepA, voffA);
        if (wr == 1) PG8_BAR;
        PG8_WAIT_V(2); PG8_BAR;
        PG8_STAGE(PG8_SB(1, 0), cB + kstep, voffB); PG8_STAGE(PG8_SA(1, 0), cA + kstep, voffA); PG8_STAGE(PG8_SB(1, 1), cB + hstepB + kstep, voffB);
        PG8_WAIT_V(6); PG8_BAR;
    } else {
        PG8_STAGE(PG8_SB(0, 0), cB, voffB); PG8_STAGE(PG8_SA(0, 0), cA, voffA); PG8_STAGE(PG8_SB(0, 1), cB + hstepB, voffB); PG8_STAGE(PG8_SA(0, 1), cA + hstepA, voffA);
        if (wr == 1) PG8_BAR;
        PG8_WAIT_V(4); PG8_BAR;
        PG8_STAGE(PG8_SB(1, 0), cB + kstep, voffB); PG8_STAGE(PG8_SA(1, 0), cA + kstep, voffA); PG8_STAGE(PG8_SB(1, 1), cB + hstepB + kstep, voffB);
        PG8_WAIT_V(6); PG8_BAR;
    }
    for (;;) {
        const bool has_next = S.next(ui + 1, nxt);
        const char* nA = has_next ? (const char*)g.A + (size_t)nxt.pm * tstepA + (size_t)nxt.pn * pnoffA : cA; const char* nB = has_next ? (const char*)g.Bt + (size_t)nxt.pn * tstepB : cB;
        for (int t = 0; t < nt; t += 2) {
            const bool last = (t == nt - 2);
            const char* a1 = cA + (size_t)(t + 1) * kstep;
            const char* a2 = last ? nA : cA + (size_t)(t + 2) * kstep; const char* b2 = last ? nB : cB + (size_t)(t + 2) * kstep;
            const char* a3 = a2 + kstep; const char* b3 = b2 + kstep;
            if (last && has_next) S.a_ready(nxt);
            if constexpr (SP2) {
            PG8_LDB(B0, 0, 0); PG8_LDB(B1, 0, 1); PG8_SCHED; PG8_LDA(At, 0, 0); PG8_STAGE(PG8_SA(1, 1), a1 + hstepA, voffA);
            PG8_WAIT_V(8); PG8_WAIT_L(0); PG8_BAR; PG8_MMA(0, 0, At, B0); PG8_MMA(0, 1, At, B1); PG8_BAR; PG8_SCHED;
            PG8_LDA(At, 0, 1); PG8_STAGE(PG8_SB(0, 0), b2, voffB); PG8_STAGE(PG8_SB(0, 1), b2 + hstepB, voffB); PG8_STAGE(PG8_SA(0, 0), a2, voffA);
            PG8_WAIT_V(8); PG8_WAIT_L(0); PG8_BAR; PG8_MMA(1, 0, At, B0); PG8_MMA(1, 1, At, B1); PG8_BAR; PG8_SCHED;
            PG8_LDB(B0, 1, 0); PG8_LDB(B1, 1, 1); PG8_SCHED; PG8_LDA(At, 1, 0); PG8_STAGE(PG8_SA(0, 1), a2 + hstepA, voffA);
            PG8_WAIT_V(8); PG8_WAIT_L(0); PG8_BAR; PG8_MMA(0, 0, At, B0); PG8_MMA(0, 1, At, B1); PG8_BAR; PG8_SCHED;
            PG8_LDA(At, 1, 1); PG8_STAGE(PG8_SB(1, 0), b3, voffB); PG8_STAGE(PG8_SB(1, 1), b3 + hstepB, voffB); PG8_STAGE(PG8_SA(1, 0), a3, voffA);
            PG8_WAIT_V(8); PG8_WAIT_L(0); PG8_BAR; PG8_MMA(1, 0, At, B0); PG8_MMA(1, 1, At, B1); PG8_BAR; PG8_SCHED;
            } else {
            PG8_LDB(B0, 0, 0); PG8_SCHED; PG8_LDA(At, 0, 0); PG8_STAGE(PG8_SA(1, 1), a1 + hstepA, voffA);
            PG8_WAIT_L(8); PG8_BAR; PG8_WAIT_L(0); PG8_MMA(0, 0, At, B0); PG8_BAR; PG8_SCHED;
            PG8_LDB(B1, 0, 1); PG8_STAGE(PG8_SB(0, 0), b2, voffB);
            PG8_BAR; PG8_WAIT_L(0); PG8_MMA(0, 1, At, B1); PG8_BAR;
            PG8_LDA(At, 0, 1); PG8_STAGE(PG8_SA(0, 0), a2, voffA);
            PG8_BAR; PG8_WAIT_L(0); PG8_MMA(1, 0, At, B0); PG8_BAR; PG8_SCHED;
            PG8_STAGE(PG8_SB(0, 1), b2 + hstepB, voffB);
            PG8_WAIT_V(6); PG8_BAR; PG8_MMA(1, 1, At, B1); PG8_BAR;
            PG8_LDB(B0, 1, 0); PG8_SCHED; PG8_LDA(At, 1, 0); PG8_STAGE(PG8_SA(0, 1), a2 + hstepA, voffA);
            PG8_WAIT_L(8); PG8_BAR; PG8_WAIT_L(0); PG8_MMA(0, 0, At, B0); PG8_BAR; PG8_SCHED;
            PG8_LDB(B1, 1, 1); PG8_STAGE(PG8_SB(1, 0), b3, voffB);
            PG8_BAR; PG8_WAIT_L(0); PG8_MMA(0, 1, At, B1); PG8_BAR;
            PG8_LDA(At, 1, 1); PG8_STAGE(PG8_SA(1, 0), a3, voffA);
            PG8_BAR; PG8_WAIT_L(0); PG8_MMA(1, 0, At, B0); PG8_BAR; PG8_SCHED;
            PG8_STAGE(PG8_SB(1, 1), b3 + hstepB, voffB);
            PG8_WAIT_V(6); PG8_BAR; PG8_MMA(1, 1, At, B1); PG8_BAR;
            }
        }
        if constexpr (ALIGN_EPI) { if (wr == 0) PG8_BAR; }
        E(acc, cur, wr, wc, fr, fq); S.done(cur);
        if (!has_next) break;
#pragma unroll
        for (int a = 0; a < 2; ++a)
#pragma unroll
            for (int b = 0; b < 2; ++b)
#pragma unroll
                for (int m = 0; m < 4; ++m)
#pragma unroll
                    for (int n = 0; n < 2; ++n) acc[a][b][m][n] = (f32x4){0.f, 0.f, 0.f, 0.f};
        cur = nxt; cA = nA; cB = nB; ++ui;
        if constexpr (ALIGN_EPI) { if (wr == 1) PG8_BAR; }
    }
    PG8_WAIT_V(0);
    if constexpr (!ALIGN_EPI) { if (wr == 0) PG8_BAR; }
    PG8_BAR;
#undef PG8_SA
#undef PG8_SB
#undef PG8_STAGE
#undef PG8_LDA
#undef PG8_LDB
#undef PG8_MMA
#undef PG8_WAIT_V
#undef PG8_WAIT_L
#undef PG8_BAR
#undef PG8_SCHED
}
}

constexpr int DM = 1024;
constexpr int NTOK = 16400;
constexpr int PADL = 48;
constexpr int LPV = 16448;
constexpr int MP = 16640;
constexpr int MU = 16384;
constexpr int NCHUNK = 257;
constexpr int NHEAD = 8;
constexpr int NPROJ = 2560;
constexpr int KVROWS = 16512;
constexpr float EPS = 1e-6f;

constexpr size_t MiB = 1u << 20;
constexpr size_t WS_CTL = 0, CTL_ZERO_BYTES = 64 * 1024;
constexpr size_t WS_WIN = 1 * MiB;
constexpr size_t WS_WUQ = 6 * MiB;
constexpr size_t WS_WUKV = 6 * MiB + 512 * 1024;
constexpr size_t WS_WOUT = 7 * MiB;
constexpr size_t WS_WPQ = 9 * MiB;
constexpr size_t WS_SKB = 13 * MiB;
constexpr size_t WS_IDX = 16 * MiB;
constexpr size_t WS_GATE = 24 * MiB;
constexpr size_t WS_HN = 32 * MiB;
constexpr size_t WS_QKVR = 96 * MiB;
constexpr size_t WS_Z = 96 * MiB + 49 * MiB;
constexpr size_t WS_P32 = 162 * MiB;
constexpr size_t WS_GA = 195 * MiB;
constexpr size_t WS_GQ = 212 * MiB;
constexpr size_t WS_GS = 229 * MiB;
constexpr size_t WS_GB = 32 * MiB;
constexpr size_t WS_GO = 65 * MiB;
constexpr size_t WS_MIX = 96 * MiB;
constexpr size_t WS_CQN = 128 * MiB;
constexpr size_t WS_CKVN = 136 * MiB + 512 * 1024;
constexpr size_t WS_QH = 32 * MiB;
constexpr size_t WS_KVB = 57 * MiB;
constexpr size_t WS_Q = 195 * MiB;
constexpr size_t WS_K = 220 * MiB;
constexpr size_t WS_VT = 145 * MiB;
constexpr size_t WS_XN = 32 * MiB;
constexpr size_t WS_PQ = 64 * MiB;
constexpr size_t WS_SC = 128 * MiB;
constexpr size_t WS_EU = 96 * MiB;
constexpr size_t WS_EV = 112 * MiB;
constexpr size_t WS_CW = 64 * MiB;
constexpr size_t WS_HP = 128 * MiB;
constexpr size_t WS_END = 256 * MiB;

constexpr int LDS_BYTES = 147456;
constexpr int MISC_OFF = 131072 + 12288;

DI unsigned f2bf(float f) { unsigned u = __builtin_bit_cast(unsigned, f); return (u + 0x7fffu + ((u >> 16) & 1u)) >> 16; }
DI unsigned pk2(float lo, float hi) { return f2bf(lo) | (f2bf(hi) << 16); }
DI float bf2f(unsigned b) { return __builtin_bit_cast(float, b << 16); }
DI float bflo(unsigned w) { return __builtin_bit_cast(float, w << 16); }
DI float bfhi(unsigned w) { return __builtin_bit_cast(float, w & 0xffff0000u); }
DI float wave_sum(float v) {
#pragma unroll
    for (int o = 1; o < 64; o <<= 1) v += __shfl_xor(v, o);
    return v;
}
DI float sigmoidf_(float x) { return 1.f / (1.f + __expf(-x)); }
DI float siluf_(float x) { return x / (1.f + __expf(-x)); }

#define XB_TMO      128
#define XB_XCNT(j)  (256  + 64 * (j))
#define XB_XSUB(j)  (1280 + 64 * (j))
#define XB_XGEN(j)  (2304 + 64 * (j))
#define XB_TOP      3328
#define XB_TOPGEN   3392
#define XCD_BAR_WORDS 3456
#define XB_SPIN_CAP (1u << 22)
DI unsigned xb_ld(unsigned* p)              { return __hip_atomic_load(p, __ATOMIC_RELAXED, __HIP_MEMORY_SCOPE_AGENT); }
DI unsigned xb_add(unsigned* p, unsigned v) { return __hip_atomic_fetch_add(p, v, __ATOMIC_RELAXED, __HIP_MEMORY_SCOPE_AGENT); }
DI unsigned xb_xcc_id() { return (unsigned)__builtin_amdgcn_s_getreg((3 << 11) | 20) & 0xFu; }
#define XB_SPIN(cond, bar) do { unsigned _sp = 0; while (cond) { __builtin_amdgcn_s_sleep(1); \
    if ((++_sp & 255u) == 0u) { if (xb_ld(&(bar)[XB_TMO])) break; if (_sp > XB_SPIN_CAP) { atomicAdd(&(bar)[XB_TMO], 1u); break; } } } } while (0)
struct XcdBarrier { unsigned* bar; unsigned x; volatile LAS unsigned* st; };
DI XcdBarrier xcd_barrier_post(unsigned* bar, volatile LAS unsigned* st) {
    XcdBarrier b; b.bar = bar; b.x = xb_xcc_id(); b.st = st;
    if (threadIdx.x == 0) (void)xb_add(&bar[XB_XCNT(b.x)], 1u);
    return b;
}
DI void xcd_barrier_complete(unsigned* bar, unsigned x, unsigned& nloc, unsigned& nx) {
    const unsigned G = gridDim.x * gridDim.y * gridDim.z;
    unsigned sum, cnt, mine, sp = 0u;
    for (;;) {
        sum = 0u; cnt = 0u; mine = 0u;
#pragma unroll
        for (unsigned j = 0; j < 16; ++j) { const unsigned c = xb_ld(&bar[XB_XCNT(j)]); sum += c; cnt += (c > 0u) ? 1u : 0u; mine = (j == x) ? c : mine; }
        if (sum == G) break;
        __builtin_amdgcn_s_sleep(1);
        if ((++sp & 255u) == 0u) { if (xb_ld(&bar[XB_TMO])) break; if (sp > XB_SPIN_CAP) { atomicAdd(&bar[XB_TMO], 1u); break; } }
    }
    nloc = mine > 0u ? mine : 1u; nx = cnt > 0u ? cnt : 1u;
}
DI void xcd_barrier(const XcdBarrier& b) {
    asm volatile("s_waitcnt vmcnt(0)" ::: "memory");
    __syncthreads();
    if (threadIdx.x == 0) {
        unsigned* bar = b.bar;
        __builtin_amdgcn_s_waitcnt(0);
        unsigned nloc = b.st[0], nx = b.st[1];
        if (nloc == 0u) { xcd_barrier_complete(bar, b.x, nloc, nx); b.st[0] = nloc; b.st[1] = nx; }
        const unsigned old = xb_add(&bar[XB_XSUB(b.x)], 1u);
        const unsigned gen = old / nloc;
        if (old + 1u == (gen + 1u) * nloc) {
            __builtin_amdgcn_fence(__ATOMIC_RELEASE, "agent");
            asm volatile("s_waitcnt vmcnt(0)" ::: "memory");
            const unsigned og = xb_add(&bar[XB_TOP], 1u);
            const unsigned tg = og / nx;
            if (og + 1u == (tg + 1u) * nx) xb_add(&bar[XB_TOPGEN], 1u);
            else XB_SPIN(xb_ld(&bar[XB_TOPGEN]) == tg, bar);
            __builtin_amdgcn_fence(__ATOMIC_ACQUIRE, "agent");
            xb_add(&bar[XB_XGEN(b.x)], 1u);
            asm volatile("s_waitcnt vmcnt(0)" ::: "memory");
        } else {
            XB_SPIN(xb_ld(&bar[XB_XGEN(b.x)]) == gen, bar);
            __builtin_amdgcn_fence(__ATOMIC_ACQUIRE, "agent");
            asm volatile("s_waitcnt vmcnt(0)" ::: "memory");
        }
    }
    __syncthreads();
}

struct Args {
    const float* in[20];
    float* out; unsigned char* ws;
    int ph_lo, ph_hi;
};
struct Frame {
    unsigned char* lds;
    int tid, lane, wave, G, gw, NGW;
};

template <class Map>
DI void transpose_item(const float* __restrict__ W, int Nsrc, bf16_t* __restrict__ WT, int ldk, float* scr, int item, int nblk, int lane, Map srcmap) {
    const int kb = item / nblk, nb = item % nblk, k0 = 64 * kb, n0 = 32 * nb;
    const int ns = srcmap(n0 + (lane & 31));
#pragma unroll 8
    for (int i = 0; i < 32; ++i) { const int kk = 2 * i + (lane >> 5); scr[kk * 33 + (lane & 31)] = (ns >= 0) ? W[(size_t)(k0 + kk) * Nsrc + ns] : 0.f; }
    __builtin_amdgcn_s_waitcnt(0); __builtin_amdgcn_wave_barrier();
    const int c = lane & 7;
#pragma unroll
    for (int j = 0; j < 4; ++j) { const int n = (lane >> 3) + 8 * j; const float* s = scr + (8 * c) * 33 + n;
        u32x4 o; o.x = pk2(s[0 * 33], s[1 * 33]); o.y = pk2(s[2 * 33], s[3 * 33]); o.z = pk2(s[4 * 33], s[5 * 33]); o.w = pk2(s[6 * 33], s[7 * 33]);
        *(u32x4*)(WT + (size_t)(n0 + n) * ldk + k0 + 8 * c) = o; }
    __builtin_amdgcn_s_waitcnt(0); __builtin_amdgcn_wave_barrier();
}
struct MapId { DI int operator()(int n) const { return n; } };
struct MapWin {
    DI int operator()(int n) const {
        if (n < 2048) return n;
        if (n < 2304) return n + 16;
        if (n < 2432) return n + 16;
        if (n < 2464) return n + 16;
        if (n < 2472) return n - 416;
        if (n < 2480) return n - 416;
        return -1;
    }
};

DI void p0_late_weights(const Frame& F, const Args& A, int wi, int nwv, int ti, int nth) {
    unsigned char* ws = A.ws;
    float* scr = (float*)(F.lds + F.wave * 16384);
    const float* w_uq = A.in[10]; const float* w_ukv = A.in[11]; const float* w_out = A.in[14]; const float* w_pq = A.in[16]; const float* sub_keys = A.in[17];
    constexpr int I_UQ = 4 * 24, I_UKV = 2 * 32, I_OUT = 16 * 32, I_PQ = 16 * 64;
    constexpr int NITEMS = I_UQ + I_UKV + I_OUT + I_PQ;
    for (int it = wi; it < NITEMS; it += nwv) {
        int r = it;
        if (r < I_UQ) { transpose_item(w_uq, 768, (bf16_t*)(ws + WS_WUQ), 256, scr, r, 24, F.lane, MapId()); continue; } r -= I_UQ;
        if (r < I_UKV) { transpose_item(w_ukv, 1024, (bf16_t*)(ws + WS_WUKV), 256, scr, r, 32, F.lane, MapId()); continue; } r -= I_UKV;
        if (r < I_OUT) { transpose_item(w_out, 1024, (bf16_t*)(ws + WS_WOUT), 1024, scr, r, 32, F.lane, MapId()); continue; } r -= I_OUT;
        transpose_item(w_pq, 2048, (bf16_t*)(ws + WS_WPQ), 1024, scr, r, 64, F.lane, MapId());
    }
    const int gt = ti, NGT = nth;
    for (int i = gt; i < 1024 * 16; i += NGT) { const int n = i >> 4, c = i & 15; *(u32x4*)((bf16_t*)(ws + WS_WUKV) + (size_t)n * 256 + 128 + c * 8) = (u32x4){0u, 0u, 0u, 0u}; }
    for (int i = gt; i < 2048 * 32; i += NGT) {
        const int n = i >> 5, c8 = (i & 31) * 8; const int p = (n >> 7) & 1;
        u32x4 o = (u32x4){0u, 0u, 0u, 0u};
        if ((c8 >> 7) == p) { const float* s = sub_keys + (size_t)n * 128 + (c8 & 127); const f32x4 a = *(const f32x4*)s, b = *(const f32x4*)(s + 4);
            o.x = pk2(a.x, a.y); o.y = pk2(a.z, a.w); o.z = pk2(b.x, b.y); o.w = pk2(b.z, b.w); }
        *(u32x4*)((bf16_t*)(ws + WS_SKB) + (size_t)n * 256 + c8) = o;
    }
}

DI void p0_prologue(const Frame& F, const Args& A) {
    unsigned char* ws = A.ws;
    float* scr = (float*)(F.lds + F.wave * 16384);
    const float* w_in = A.in[3]; const float* w_uq = A.in[10]; const float* w_ukv = A.in[11]; const float* w_out = A.in[14]; const float* w_pq = A.in[16]; const float* sub_keys = A.in[17];
    constexpr int I_IN = 16 * 80;
    for (int it = F.gw; it < I_IN; it += F.NGW) transpose_item(w_in, 2480, (bf16_t*)(ws + WS_WIN), 1024, scr, it, 80, F.lane, MapWin());
    if (F.G <= 32) p0_late_weights(F, A, F.gw, F.NGW, blockIdx.x * 512 + F.tid, F.G * 512);
    const float* x = A.in[0]; const float* meta = A.in[1]; const float* anorm = A.in[2];
    bf16_t* HN = (bf16_t*)(ws + WS_HN);
    for (int p0 = F.gw; p0 < MP; p0 += 3 * F.NGW) {
        f32x4 v[3][4]; bool ok[3];
#pragma unroll
        for (int r = 0; r < 3; ++r) {
            const int p = p0 + r * F.NGW, t = p - PADL; ok[r] = (p < MP) && t >= 0 && t < NTOK;
            if (ok[r]) { const float* src = (t < 16) ? meta + (size_t)t * DM : x + (size_t)(t - 16) * DM; const f32x4* xr = (const f32x4*)src + F.lane;
#pragma unroll
                for (int j = 0; j < 4; ++j) v[r][j] = xr[64 * j]; }
            else {
#pragma unroll
                for (int j = 0; j < 4; ++j) v[r][j] = (f32x4){0.f, 0.f, 0.f, 0.f}; }
        }
#pragma unroll
        for (int r = 0; r < 3; ++r) {
            const int p = p0 + r * F.NGW; if (p >= MP) continue;
            unsigned long long* o8 = (unsigned long long*)(HN + (size_t)p * DM) + F.lane;
            float s = 0.f;
#pragma unroll
            for (int j = 0; j < 4; ++j) s += (v[r][j].x * v[r][j].x + v[r][j].y * v[r][j].y) + (v[r][j].z * v[r][j].z + v[r][j].w * v[r][j].w);
            const float rstd = ok[r] ? 1.f / sqrtf(wave_sum(s) * (1.f / DM) + EPS) : 0.f;
#pragma unroll
            for (int j = 0; j < 4; ++j) { const f32x4 w = ((const f32x4*)anorm)[64 * j + F.lane];
                o8[64 * j] = (unsigned long long)pk2(v[r][j].x * rstd * w.x, v[r][j].y * rstd * w.y) | ((unsigned long long)pk2(v[r][j].z * rstd * w.z, v[r][j].w * rstd * w.w) << 32); }
        }
    }
}

struct EpiProj {
    static constexpr bool PERM = true;
    bf16_t* QKVR; bf16_t* Z; float* P32;
    DI void operator()(const f32x4 (&acc)[2][2][4][2], const pg8::Unit& u, int wr, int wc, int fr, int fq) const {
        const int row0 = u.pm * 256 + wr * 64 + fr;
        if (u.pn < 8) {
            bf16_t* base; int ld, colt;
            if (u.pn < 6) { base = QKVR; ld = 1536; colt = u.pn * 256; } else { base = Z; ld = 512; colt = (u.pn - 6) * 256; }
            const int col0 = colt + wc * 32 + 8 * fq;
#pragma unroll
            for (int ai = 0; ai < 2; ++ai)
#pragma unroll
                for (int m = 0; m < 4; ++m) { bf16_t* rowp = base + (size_t)(row0 + ai * 128 + m * 16) * ld + col0;
#pragma unroll
                    for (int bj = 0; bj < 2; ++bj) { const f32x4 v0 = acc[ai][bj][m][0], v1 = acc[ai][bj][m][1];
                        u32x4 w; w.x = pg8::cvt_pk_bf16(v0[0], v0[1]); w.y = pg8::cvt_pk_bf16(v0[2], v0[3]); w.z = pg8::cvt_pk_bf16(v1[0], v1[1]); w.w = pg8::cvt_pk_bf16(v1[2], v1[3]);
                        *(u32x4*)(rowp + bj * 128) = w; } }
        } else {
            const int col0 = (u.pn - 8) * 256 + wc * 32 + 8 * fq;
#pragma unroll
            for (int ai = 0; ai < 2; ++ai)
#pragma unroll
                for (int m = 0; m < 4; ++m) { float* rowp = P32 + (size_t)(row0 + ai * 128 + m * 16) * 512 + col0;
#pragma unroll
                    for (int bj = 0; bj < 2; ++bj) { *(f32x4*)(rowp + bj * 128) = acc[ai][bj][m][0]; *(f32x4*)(rowp + bj * 128 + 4) = acc[ai][bj][m][1]; } }
        }
    }
};
struct EpiB16 {
    static constexpr bool PERM = true;
    bf16_t* O; int ldc;
    DI void operator()(const f32x4 (&acc)[2][2][4][2], const pg8::Unit& u, int wr, int wc, int fr, int fq) const {
        const int row0 = u.pm * 256 + wr * 64 + fr, col0 = u.pn * 256 + wc * 32 + 8 * fq;
#pragma unroll
        for (int ai = 0; ai < 2; ++ai)
#pragma unroll
            for (int m = 0; m < 4; ++m) { bf16_t* rowp = O + (size_t)(row0 + ai * 128 + m * 16) * ldc + col0;
#pragma unroll
                for (int bj = 0; bj < 2; ++bj) { const f32x4 v0 = acc[ai][bj][m][0], v1 = acc[ai][bj][m][1];
                    u32x4 w; w.x = pg8::cvt_pk_bf16(v0[0], v0[1]); w.y = pg8::cvt_pk_bf16(v0[2], v0[3]); w.z = pg8::cvt_pk_bf16(v1[0], v1[1]); w.w = pg8::cvt_pk_bf16(v1[2], v1[3]);
                    *(u32x4*)(rowp + bj * 128) = w; } }
    }
};
struct EpiF32 {
    static constexpr bool PERM = true;
    float* C; int ldc; const float* res;
    DI void operator()(const f32x4 (&acc)[2][2][4][2], const pg8::Unit& u, int wr, int wc, int fr, int fq) const {
        const int row0 = u.pm * 256 + wr * 64 + fr, col0 = u.pn * 256 + wc * 32 + 8 * fq;
#pragma unroll
        for (int ai = 0; ai < 2; ++ai)
#pragma unroll
            for (int m = 0; m < 4; ++m) { const size_t off = (size_t)(row0 + ai * 128 + m * 16) * ldc + col0;
#pragma unroll
                for (int bj = 0; bj < 2; ++bj) { f32x4 v0 = acc[ai][bj][m][0], v1 = acc[ai][bj][m][1];
                    if (res) { v0 += *(const f32x4*)(res + off + bj * 128); v1 += *(const f32x4*)(res + off + bj * 128 + 4); }
                    *(f32x4*)(C + off + bj * 128) = v0; *(f32x4*)(C + off + bj * 128 + 4) = v1; } }
    }
};

DI f32x16 mfma32(bf16x8 a, bf16x8 b, f32x16 c) { return __builtin_amdgcn_mfma_f32_32x32x16_bf16(a, b, c, 0, 0, 0); }
DI f32x4 mfma16(bf16x8 a, bf16x8 b, f32x4 c) { return __builtin_amdgcn_mfma_f32_16x16x32_bf16(a, b, c, 0, 0, 0); }
DI int crow(int r, int hi) { return (r & 3) + 8 * (r >> 2) + 4 * hi; }
DI f32x16 zero16() { f32x16 z;
#pragma unroll
    for (int i = 0; i < 16; ++i) z[i] = 0.f; return z; }

constexpr int G_KF = 0, G_VF = 16384, G_MF = 32768;
constexpr int G_QB = 50176, G_KB = 59392, G_KBB = 68608;
constexpr int G_QKB = 77824, G_UT = 87040, G_WT = 96256, G_KDT = 105472;
constexpr int G_VEC = 114688;
constexpr int G_RAW = G_QKB;
constexpr int GST = 72;

DI f32x16 mm_quad(const unsigned char* A, const unsigned char* Bt, int qr, int qc, int lane) {
    const int r32 = lane & 31, hh = lane >> 5;
    const unsigned char* ap = A + (32 * qr + r32) * (GST * 2) + hh * 16;
    const unsigned char* bp = Bt + (32 * qc + r32) * (GST * 2) + hh * 16;
    f32x16 acc = zero16();
#pragma unroll
    for (int s = 0; s < 4; ++s) acc = mfma32(*(const bf16x8*)(ap + s * 32), *(const bf16x8*)(bp + s * 32), acc);
    return acc;
}

constexpr int G_RAW2 = 115712;
static_assert(G_RAW2 + 67 * 400 <= 143360, "GDN prep LDS map");
constexpr int G_CONVW = 143360 + 512;

#ifndef PROBE_STAGE
#define PROBE_STAGE -1
#endif
template <int VAR> DI void gdn_prep_phase(const Frame& F, const Args& A) {
    unsigned long long stg_t = 0ull, stg_acc = 0ull;
#define STG(n) do { if (PROBE_STAGE >= 0) { const unsigned long long now_ = __builtin_amdgcn_s_memrealtime(); if (PROBE_STAGE == (n)) stg_acc += now_ - stg_t; stg_t = now_; } } while (0)
    unsigned char* ws = A.ws; unsigned char* lds = F.lds;
    const int tid = F.tid, lane = F.lane, wave = F.wave;
    const bf16_t* QKVR = (const bf16_t*)(ws + WS_QKVR); const float* P32 = (const float*)(ws + WS_P32);
    float* KF = (float*)(lds + G_KF); float* VF = (float*)(lds + G_VF); float* MF = (float*)(lds + G_MF);
    float* VEC = (float*)(lds + G_VEC);
    if (VAR == 6) return;
    const int NIT = NCHUNK * 8;
#define LBAR() do { asm volatile("s_waitcnt lgkmcnt(0)" ::: "memory"); __builtin_amdgcn_s_barrier(); asm volatile("" ::: "memory"); } while (0)
#define LAUNDER(dst, src) int dst = (src); asm volatile("" : "+v"(dst))
    int item = blockIdx.x;
    if (item >= NIT) return;
    u32x4 pr[4]; float nb = 0.f, na = 0.f;
    auto raw_fetch = [&](int it) {
        const int c = it >> 3, h = it & 7; LAUNDER(tl, tid);
#pragma unroll
        for (int i = 0; i < 4; ++i) { const int q = tl + 512 * i; pr[i] = (u32x4){0u, 0u, 0u, 0u};
            if (q < 67 * 24) { const int r = q / 24, cc = q % 24, seg = cc >> 3, c8 = cc & 7; const int p = 64 * c - 3 + r;
                if (p >= 0) pr[i] = *(const u32x4*)(QKVR + (size_t)p * 1536 + seg * 512 + h * 64 + c8 * 8); } }
        if (wave == 0) { const int p = 64 * c + lane; nb = P32[(size_t)p * 512 + 416 + h]; na = P32[(size_t)p * 512 + 424 + h]; }
    };
    auto raw_park = [&]() {
        LAUNDER(tl, tid);
#pragma unroll
        for (int i = 0; i < 4; ++i) { const int q = tl + 512 * i;
            if (q < 67 * 24) { const int r = q / 24, cc = q % 24, seg = cc >> 3, c8 = cc & 7; *(u32x4*)(lds + G_RAW2 + r * 400 + (seg * 64 + c8 * 8) * 2) = pr[i]; } }
    };
    raw_fetch(item); raw_park();
    float cb = nb, ca = na;
    float* CWL = (float*)(lds + G_CONVW);
    int cw_h = -1;
#pragma unroll 1
    for (; item < NIT; item += F.G) {
        if (PROBE_STAGE >= 0 && stg_t == 0ull) stg_t = __builtin_amdgcn_s_memrealtime();
        const int c = item >> 3, h = item & 7;
        if (h != cw_h) { cw_h = h;
            if (tid < 192) { LAUNDER(t0, tid); const int sg = t0 >> 6, jt = (t0 >> 4) & 3, c4 = t0 & 15; *(f32x4*)(CWL + (sg * 4 + jt) * 64 + 4 * c4) = *(const f32x4*)(A.in[4] + jt * 1536 + sg * 512 + h * 64 + 4 * c4); } }
        const int nxt = item + F.G;
        if (VAR != 5 && nxt < NIT) raw_fetch(nxt);
        if (wave == 0) {
            const int p = 64 * c + lane;
            const float alog = A.in[5][h], dtb = A.in[6][h];
            float beta = sigmoidf_(cb);
            const float xx = ca + dtb; const float sp = xx > 20.f ? xx : log1pf(__expf(xx));
            float g = -__expf(alog) * sp;
            if (p < PADL) { beta = 0.f; g = 0.f; }
            float gc = g;
#pragma unroll
            for (int o = 1; o < 64; o <<= 1) { const float t = __shfl_up(gc, o); if (lane >= o) gc += t; }
            const float glast = __shfl(gc, 63);
            VEC[lane] = gc; VEC[64 + lane] = beta; VEC[128 + lane] = __expf(gc); VEC[192 + lane] = __expf(glast - gc);
        }
        LBAR(); STG(0);
        LAUNDER(t1, tid); const int sub = t1 & 15, grp = t1 >> 4;
#pragma unroll
        for (int sg = 0; sg < ((VAR == 2 || VAR >= 4) ? 0 : 3); ++sg) {
#pragma unroll 1
            for (int ps = 0; ps < 2; ++ps) {
                const int i = grp + 32 * ps;
                float acc[4] = {0.f, 0.f, 0.f, 0.f};
#pragma unroll
                for (int jt = 0; jt < 4; ++jt) {
                    const f32x4 w = *(const f32x4*)(CWL + (sg * 4 + jt) * 64 + 4 * sub);
                    const u32x2 rv = *(const u32x2*)(lds + G_RAW2 + (i + jt) * 400 + (sg * 64 + 4 * sub) * 2);
                    acc[0] += w.x * bflo(rv.x); acc[1] += w.y * bfhi(rv.x); acc[2] += w.z * bflo(rv.y); acc[3] += w.w * bfhi(rv.y);
                }
                float y[4];
#pragma unroll
                for (int k = 0; k < 4; ++k) y[k] = siluf_(acc[k]);
                if (sg < 2) {
                    float ss = (y[0] * y[0] + y[1] * y[1]) + (y[2] * y[2] + y[3] * y[3]);
                    ss += __shfl_xor(ss, 1); ss += __shfl_xor(ss, 2); ss += __shfl_xor(ss, 4); ss += __shfl_xor(ss, 8);
                    const float rn = 1.f / sqrtf(ss + EPS);
#pragma unroll
                    for (int k = 0; k < 4; ++k) y[k] *= rn;
                }
                if (sg == 0) {
                    u32x2 o; o.x = pk2(y[0] * 0.125f, y[1] * 0.125f); o.y = pk2(y[2] * 0.125f, y[3] * 0.125f);
                    *(u32x2*)(lds + G_QB + i * (GST * 2) + 8 * sub) = o;
                } else if (sg == 1) {
                    const float beta = VEC[64 + i], ekd = VEC[192 + i];
                    *(f32x4*)(KF + i * 64 + 4 * sub) = (f32x4){y[0], y[1], y[2], y[3]};
                    u32x2 o; o.x = pk2(y[0], y[1]); o.y = pk2(y[2], y[3]);
                    *(u32x2*)(lds + G_KB + i * (GST * 2) + 8 * sub) = o;
                    o.x = pk2(y[0] * beta, y[1] * beta); o.y = pk2(y[2] * beta, y[3] * beta);
                    *(u32x2*)(lds + G_KBB + i * (GST * 2) + 8 * sub) = o;
#pragma unroll
                    for (int k = 0; k < 4; ++k) *(bf16_t*)(lds + G_KDT + (4 * sub + k) * (GST * 2) + i * 2) = (bf16_t)f2bf(y[k] * ekd);
                } else {
                    *(f32x4*)(VF + i * 64 + 4 * sub) = (f32x4){y[0], y[1], y[2], y[3]};
                }
            }
        }
        LBAR(); STG(1);
        if (VAR != 3 && VAR < 4) {
            LAUNDER(l3, lane);
            const int prod = wave >> 2, quad = wave & 3, qr = quad >> 1, qc = quad & 1, r32 = l3 & 31, hh = l3 >> 5;
            const f32x16 acc = mm_quad(lds + (prod ? G_QB : G_KBB), lds + G_KB, qr, qc, l3);
            const int j = 32 * qc + r32; const float gcj = VEC[j];
#pragma unroll
            for (int r = 0; r < 16; ++r) {
                const int i = 32 * qr + crow(r, hh);
                if (prod == 0) { MF[i * 68 + j] = (j < i) ? acc[r] * __expf(VEC[i] - gcj) : 0.f; }
                else { *(bf16_t*)(lds + G_QKB + i * (GST * 2) + j * 2) = (bf16_t)f2bf((j <= i) ? acc[r] * __expf(VEC[i] - gcj) : 0.f); }
            }
        }
        LBAR(); STG(2);
        float* DB = (float*)(lds + G_KBB);
        if (VAR != 1 && VAR < 4 && wave == 0) {
            LAUNDER(l4, lane); const int b = l4 >> 4, jc = l4 & 15;
            float d[16];
#pragma unroll
            for (int i = 0; i < 16; ++i) {
                float acc = (i == jc) ? 1.f : 0.f;
                const float* mrow = MF + (16 * b + i) * 68 + 16 * b;
#pragma unroll
                for (int k = 0; k < i; ++k) acc -= mrow[k] * d[k];
                d[i] = acc;
            }
#pragma unroll
            for (int i = 0; i < 16; ++i) DB[(b * 16 + i) * 20 + jc] = d[i];
        }
        LBAR();
        if (VAR != 1 && VAR < 4) {
            LAUNDER(l4, lane); const int cc = l4 & 15, g = l4 >> 4;
            const bool isU = wave < 4; const int col = 16 * (wave & 3) + cc;
            const float* src = (isU ? VF : KF) + col;
            f32x4 X[4];
#pragma unroll
            for (int b = 0; b < 4; ++b) {
                f32x4 acc;
#pragma unroll
                for (int r = 0; r < 4; ++r) { const int i = 16 * b + 4 * g + r; float rv = src[i * 64] * VEC[64 + i]; if (!isU) rv *= VEC[128 + i]; acc[r] = -rv; }
#pragma unroll
                for (int a = 0; a < b; ++a) {
                    const f32x4 lv = *(const f32x4*)(MF + (16 * b + cc) * 68 + 16 * a + 4 * g);
#pragma unroll
                    for (int sp = 0; sp < 4; ++sp) acc = __builtin_amdgcn_mfma_f32_16x16x4f32(lv[sp], X[a][sp], acc, 0, 0, 0);
                }
                const f32x4 dv = *(const f32x4*)(DB + (b * 16 + cc) * 20 + 4 * g);
                f32x4 xb = (f32x4){0.f, 0.f, 0.f, 0.f};
#pragma unroll
                for (int sp = 0; sp < 4; ++sp) xb = __builtin_amdgcn_mfma_f32_16x16x4f32(dv[sp], acc[sp], xb, 0, 0, 0);
                X[b] = -xb;
                unsigned char* dst = lds + (isU ? G_UT : G_WT) + col * (GST * 2) + (16 * b + 4 * g) * 2;
                *(u32x2*)dst = (u32x2){pk2(X[b][0], X[b][1]), pk2(X[b][2], X[b][3])};
            }
        }
        LBAR(); STG(3);
        if (VAR != 3 && VAR < 4) {
            const float gl = VEC[128 + 63];
            float* GB = VAR ? (float*)(ws + WS_GS + (size_t)item * 8192) : (float*)(ws + WS_GB) + (size_t)item * 4096;
            bf16_t* GQ = (bf16_t*)(ws + (VAR ? WS_GS : WS_GQ)) + (size_t)item * 4096; bf16_t* GO = (bf16_t*)(ws + (VAR ? WS_GS : WS_GO)) + (size_t)item * 4096;
            bf16_t* GAL = (bf16_t*)(lds + G_MF);
            LAUNDER(l5, lane); const int r32 = l5 & 31, hh = l5 >> 5;
#pragma unroll 1
            for (int it = 0; it < 2; ++it) {
                const int task = wave + 8 * it, prod = task >> 2, quad = task & 3, qr = quad >> 1, qc = quad & 1;
                const f32x16 acc = mm_quad(lds + (prod < 2 ? G_KDT : G_QKB), lds + ((prod & 1) ? G_UT : G_WT), qr, qc, l5);
                const int Cc = 32 * qc + r32;
                if (prod == 0) {
#pragma unroll
                    for (int r = 0; r < 16; ++r) {
                        const int R = 32 * qr + crow(r, hh);
                        const float val = ((R == Cc) ? gl : 0.f) - acc[r];
                        const int rb = R >> 4, m = R & 15, q4 = Cc >> 4, g = (Cc >> 2) & 3, rr = Cc & 3, ks = q4 >> 1, jj = 4 * (q4 & 1) + rr, ls = 16 * g + m;
                        GAL[((rb * 2 + ks) * 64 + ls) * 8 + jj] = (bf16_t)f2bf(val);
                    }
                } else if (prod == 1) {
                    const int eslab = Cc >> 4, n = Cc & 15;
#pragma unroll
                    for (int a = 0; a < 4; ++a) {
                        const int R0 = 32 * qr + 8 * a + 4 * hh; const int rb = R0 >> 4, g = (R0 >> 2) & 3, ls = 16 * g + n;
                        *(f32x4*)(GB + ((eslab * 4 + rb) * 64 + ls) * 4) = (f32x4){acc[4 * a], acc[4 * a + 1], acc[4 * a + 2], acc[4 * a + 3]};
                    }
                } else if (prod == 2) {
#pragma unroll
                    for (int r = 0; r < 16; ++r) {
                        const int R = 32 * qr + crow(r, hh);
                        const float qv = bf2f(*(const bf16_t*)(lds + G_QB + R * (GST * 2) + Cc * 2));
                        GQ[R * 64 + Cc] = (bf16_t)f2bf(qv * VEC[128 + R] - acc[r]);
                    }
                } else {
#pragma unroll
                    for (int r = 0; r < 16; ++r) GO[(quad * 16 + r) * 64 + l5] = (bf16_t)f2bf(acc[r]);
                }
            }
        }
        if (VAR != 5 && nxt < NIT) { raw_park(); cb = nb; ca = na; }
        LBAR(); STG(4);
        if (VAR != 5) { LAUNDER(t6, tid); *(u32x4*)((bf16_t*)(ws + (VAR ? WS_GS : WS_GA)) + (size_t)item * 4096 + t6 * 8) = *(const u32x4*)(lds + G_MF + t6 * 16); }
        STG(5);
    }
    if (PROBE_STAGE >= 0 && tid == 0) { *(unsigned long long*)(lds + 143360 + 96) = stg_acc; }
}

constexpr int SC_D = 8, SC_PD = 6, SC_SLOT = 12288;
DI void gdn_scan(const Frame& F, const Args& A) {
    if (blockIdx.x >= 32) return;
    unsigned char* ws = A.ws;
    const int h = blockIdx.x & 7, eslab = blockIdx.x >> 3, lane = F.lane, wave = F.wave, n = lane & 15, g = lane >> 4;
    const unsigned char* GA = ws + WS_GA; const unsigned char* GB = ws + WS_GB; bf16_t* GS = (bf16_t*)(ws + WS_GS);
    LAS unsigned char* ring = (LAS unsigned char*)F.lds;
    const int np = (wave == 0) ? 0 : ((wave - 1 < 5) ? 2 : 1);
    auto issue = [&](int c) {
        const int cc = c < NCHUNK ? c : NCHUNK - 1;
        const size_t item = (size_t)cc * 8 + h;
        LAS unsigned char* slot = ring + (c % SC_D) * SC_SLOT;
#pragma unroll
        for (int i = 0; i < 2; ++i) if (i < np) {
            const int q = (wave - 1) + 7 * i;
            const unsigned char* src = (q < 8) ? GA + item * 8192 + q * 1024 : GB + item * 16384 + eslab * 4096 + (q - 8) * 1024;
            LAS unsigned char* dst = slot + ((q < 8) ? q * 1024 : 8192 + (q - 8) * 1024);
            __builtin_amdgcn_global_load_lds((const unsigned*)(src + lane * 16), (LAS unsigned*)dst, 16, 0, 0);
        }
    };
    for (int c = 0; c < SC_PD; ++c) issue(c);
    f32x4 S[4];
#pragma unroll
    for (int rb = 0; rb < 4; ++rb) S[rb] = (f32x4){0.f, 0.f, 0.f, 0.f};
#pragma unroll 1
    for (int c = 0; c < NCHUNK; ++c) {
        issue(c + SC_PD);
        if (np == 2) asm volatile("s_waitcnt vmcnt(12)" ::: "memory");
        else if (np == 1) asm volatile("s_waitcnt vmcnt(6)" ::: "memory");
        asm volatile("s_waitcnt lgkmcnt(0)" ::: "memory");
        __builtin_amdgcn_s_barrier();
        asm volatile("" ::: "memory");
        if (wave == 0) {
            const LAS unsigned char* slot = ring + (c % SC_D) * SC_SLOT;
            bf16x8 ac[8]; f32x4 bc[4];
#pragma unroll
            for (int q = 0; q < 8; ++q) ac[q] = *(const LAS bf16x8*)(slot + q * 1024 + lane * 16);
#pragma unroll
            for (int rb = 0; rb < 4; ++rb) bc[rb] = *(const LAS f32x4*)(slot + 8192 + rb * 1024 + lane * 16);
            const size_t item = (size_t)c * 8 + h;
            u32x4 p0, p1;
            p0.x = pk2(S[0][0], S[0][1]); p0.y = pk2(S[0][2], S[0][3]); p0.z = pk2(S[1][0], S[1][1]); p0.w = pk2(S[1][2], S[1][3]);
            p1.x = pk2(S[2][0], S[2][1]); p1.y = pk2(S[2][2], S[2][3]); p1.z = pk2(S[3][0], S[3][1]); p1.w = pk2(S[3][2], S[3][3]);
            {
                bf16_t* st = GS + item * 4096 + (16 * eslab + n) * 64 + 4 * g;
                *(u32x2*)(st + 0) = (u32x2){p0.x, p0.y}; *(u32x2*)(st + 16) = (u32x2){p0.z, p0.w};
                *(u32x2*)(st + 32) = (u32x2){p1.x, p1.y}; *(u32x2*)(st + 48) = (u32x2){p1.z, p1.w};
            }
            const bf16x8 b0 = __builtin_bit_cast(bf16x8, p0), b1 = __builtin_bit_cast(bf16x8, p1);
#pragma unroll
            for (int rb = 0; rb < 4; ++rb) {
                f32x4 acc = bc[rb];
                acc = mfma16(ac[rb * 2 + 0], b0, acc);
                acc = mfma16(ac[rb * 2 + 1], b1, acc);
                S[rb] = acc;
            }
        }
    }
    asm volatile("s_waitcnt vmcnt(0) lgkmcnt(0)" ::: "memory");
    __builtin_amdgcn_s_barrier();
}

DI void gdn_out_task(const Frame& F, const Args& A, int task) {
    unsigned char* ws = A.ws;
    const int ihalf = task & 1, item = (task >> 1) + 8, c = item >> 3, h = item & 7, lane = F.lane, r32 = lane & 31, hh = lane >> 5;
    const bf16_t* GQ = (const bf16_t*)(ws + WS_GQ) + (size_t)item * 4096; const bf16_t* GS = (const bf16_t*)(ws + WS_GS) + (size_t)item * 4096;
    const bf16_t* GO = (const bf16_t*)(ws + WS_GO) + (size_t)item * 4096;
    const bf16_t* Z = (const bf16_t*)(ws + WS_Z); bf16_t* MIX = (bf16_t*)(ws + WS_MIX);
    f32x16 acc[2];
#pragma unroll
    for (int eh = 0; eh < 2; ++eh)
#pragma unroll
        for (int r = 0; r < 16; ++r) acc[eh][r] = bf2f(GO[((ihalf * 2 + eh) * 16 + r) * 64 + lane]);
#pragma unroll
    for (int s = 0; s < 4; ++s) {
        const bf16x8 a = *(const bf16x8*)(GQ + (32 * ihalf + r32) * 64 + 16 * s + 8 * hh);
#pragma unroll
        for (int eh = 0; eh < 2; ++eh) {
            const bf16x8 b = *(const bf16x8*)(GS + (32 * eh + r32) * 64 + 16 * s + 8 * hh);
            acc[eh] = mfma32(a, b, acc[eh]);
        }
    }
    const float* gnorm = A.in[7];
    const float w0 = gnorm[r32], w1 = gnorm[32 + r32];
#pragma unroll
    for (int r = 0; r < 16; ++r) {
        float ss = acc[0][r] * acc[0][r] + acc[1][r] * acc[1][r];
        ss += __shfl_xor(ss, 1); ss += __shfl_xor(ss, 2); ss += __shfl_xor(ss, 4); ss += __shfl_xor(ss, 8); ss += __shfl_xor(ss, 16);
        const float rstd = 1.f / sqrtf(ss * (1.f / 64.f) + EPS);
        const int i = 32 * ihalf + crow(r, hh); const int p = 64 * c + i;
        const float z0 = bf2f(Z[(size_t)p * 512 + h * 64 + r32]), z1 = bf2f(Z[(size_t)p * 512 + h * 64 + 32 + r32]);
        bf16_t* o = MIX + (size_t)(p - 64) * 1024 + h * 64;
        o[r32] = (bf16_t)f2bf(acc[0][r] * rstd * w0 * siluf_(z0));
        o[32 + r32] = (bf16_t)f2bf(acc[1][r] * rstd * w1 * siluf_(z1));
    }
}

DI void mla_prep1_row(const Frame& F, const Args& A, int p) {
    unsigned char* ws = A.ws; const int lane = F.lane;
    const float* P32 = (const float*)(ws + WS_P32) + (size_t)p * 512;
    bf16_t* CQN = (bf16_t*)(ws + WS_CQN) + (size_t)p * 256; bf16_t* CKVN = (bf16_t*)(ws + WS_CKVN) + (size_t)p * 256;
    const f32x4 q = *(const f32x4*)(P32 + 4 * lane);
    const float sq = wave_sum((q.x * q.x + q.y * q.y) + (q.z * q.z + q.w * q.w));
    const float rq = 1.f / sqrtf(sq * (1.f / 256.f) + EPS);
    const f32x4 wq = *(const f32x4*)(A.in[8] + 4 * lane);
    *(u32x2*)(CQN + 4 * lane) = (u32x2){pk2(q.x * rq * wq.x, q.y * rq * wq.y), pk2(q.z * rq * wq.z, q.w * rq * wq.w)};
    const float k0 = P32[256 + 2 * lane], k1 = P32[256 + 2 * lane + 1];
    const float sk = wave_sum(k0 * k0 + k1 * k1);
    const float rk = 1.f / sqrtf(sk * (1.f / 128.f) + EPS);
    const float wk0 = A.in[9][2 * lane], wk1 = A.in[9][2 * lane + 1];
    *(unsigned*)(CKVN + 2 * lane) = pk2(k0 * rk * wk0, k1 * rk * wk1);
    *(unsigned*)(CKVN + 128 + 2 * lane) = 0u;
}

constexpr float QSCALE = 0.10206207261596577f * 1.4426950408889634f;
DI double rope_inv_rev(int i) {
    const double t8[8] = {0.15915494309189535, 0.08949940160889101, 0.050329212104487035, 0.0283021958306234, 0.015915494309189534, 0.008949940160889102, 0.005032921210448704, 0.00283021958306234};
    double v = t8[0];
#pragma unroll
    for (int k = 1; k < 8; ++k) v = ((i & 7) == k) ? t8[k] : v;
    return (i & 8) ? v * 0.01 : v;
}
constexpr int P2_TS = 136;
DI void mla_prep2_task(const Frame& F, const Args& A, int task) {
    unsigned char* ws = A.ws; const int lane = F.lane, h = task & 7, blk = task >> 3;
    const int p = 64 * blk + lane;
    const bool valid = (p >= PADL) && (p < LPV);
    const float* qn = A.in[12]; const float* kn = A.in[13];
    float sn[16], cs[16];
    { const double pos = (double)(p - PADL);
#pragma unroll
      for (int i = 0; i < 16; ++i) { const double rev = pos * rope_inv_rev(i); const float fr = (float)(rev - floor(rev)); sn[i] = __builtin_amdgcn_sinf(fr); cs[i] = __builtin_amdgcn_cosf(fr); } }
    {
        const bf16_t* src = (const bf16_t*)(ws + WS_QH) + (size_t)p * 768 + h * 96;
        u32x4 w[12];
#pragma unroll
        for (int c = 0; c < 12; ++c) w[c] = *(const u32x4*)(src + 8 * c);
        float ss = 0.f;
#pragma unroll
        for (int c = 0; c < 12; ++c) { const float a0 = bflo(w[c].x), a1 = bfhi(w[c].x), a2 = bflo(w[c].y), a3 = bfhi(w[c].y), a4 = bflo(w[c].z), a5 = bfhi(w[c].z), a6 = bflo(w[c].w), a7 = bfhi(w[c].w);
            ss += (a0 * a0 + a1 * a1) + (a2 * a2 + a3 * a3) + (a4 * a4 + a5 * a5) + (a6 * a6 + a7 * a7); }
        const float rs = valid ? QSCALE / sqrtf(ss * (1.f / 96.f) + EPS) : 0.f;
        bf16_t* dst = (bf16_t*)(ws + WS_Q) + ((size_t)h * KVROWS + p) * 96;
#pragma unroll
        for (int c = 0; c < 8; ++c) {
            const f32x4 g0 = *(const f32x4*)(qn + 8 * c), g1 = *(const f32x4*)(qn + 8 * c + 4);
            *(u32x4*)(dst + 8 * c) = (u32x4){pk2(bflo(w[c].x) * rs * g0.x, bfhi(w[c].x) * rs * g0.y), pk2(bflo(w[c].y) * rs * g0.z, bfhi(w[c].y) * rs * g0.w),
                                             pk2(bflo(w[c].z) * rs * g1.x, bfhi(w[c].z) * rs * g1.y), pk2(bflo(w[c].w) * rs * g1.z, bfhi(w[c].w) * rs * g1.w)};
        }
#pragma unroll
        for (int c = 0; c < 2; ++c) {
            float x1[8], x2[8];
            const u32x4 wa = w[8 + c], wb = w[10 + c];
            x1[0] = bflo(wa.x); x1[1] = bfhi(wa.x); x1[2] = bflo(wa.y); x1[3] = bfhi(wa.y); x1[4] = bflo(wa.z); x1[5] = bfhi(wa.z); x1[6] = bflo(wa.w); x1[7] = bfhi(wa.w);
            x2[0] = bflo(wb.x); x2[1] = bfhi(wb.x); x2[2] = bflo(wb.y); x2[3] = bfhi(wb.y); x2[4] = bflo(wb.z); x2[5] = bfhi(wb.z); x2[6] = bflo(wb.w); x2[7] = bfhi(wb.w);
            float o1[8], o2[8];
#pragma unroll
            for (int t = 0; t < 8; ++t) { const float a = x1[t] * rs * qn[64 + 8 * c + t], b = x2[t] * rs * qn[80 + 8 * c + t]; o1[t] = a * cs[8 * c + t] - b * sn[8 * c + t]; o2[t] = b * cs[8 * c + t] + a * sn[8 * c + t]; }
            *(u32x4*)(dst + 64 + 8 * c) = (u32x4){pk2(o1[0], o1[1]), pk2(o1[2], o1[3]), pk2(o1[4], o1[5]), pk2(o1[6], o1[7])};
            *(u32x4*)(dst + 80 + 8 * c) = (u32x4){pk2(o2[0], o2[1]), pk2(o2[2], o2[3]), pk2(o2[4], o2[5]), pk2(o2[6], o2[7])};
        }
    }
    {
        const bf16_t* src = (const bf16_t*)(ws + WS_KVB) + (size_t)p * 1024 + h * 128;
        const float* kpe = (const float*)(ws + WS_P32) + (size_t)p * 512 + 384;
        u32x4 w[8]; f32x4 e[8];
#pragma unroll
        for (int c = 0; c < 8; ++c) { w[c] = *(const u32x4*)(src + 8 * c); e[c] = *(const f32x4*)(kpe + 4 * c); }
        float ss = 0.f;
#pragma unroll
        for (int c = 0; c < 8; ++c) { const float a0 = bflo(w[c].x), a1 = bfhi(w[c].x), a2 = bflo(w[c].y), a3 = bfhi(w[c].y), a4 = bflo(w[c].z), a5 = bfhi(w[c].z), a6 = bflo(w[c].w), a7 = bfhi(w[c].w);
            ss += (a0 * a0 + a1 * a1) + (a2 * a2 + a3 * a3) + (a4 * a4 + a5 * a5) + (a6 * a6 + a7 * a7);
            ss += (e[c].x * e[c].x + e[c].y * e[c].y) + (e[c].z * e[c].z + e[c].w * e[c].w); }
        const float rs = valid ? 1.f / sqrtf(ss * (1.f / 96.f) + EPS) : 0.f;
        bf16_t* dst = (bf16_t*)(ws + WS_K) + ((size_t)h * KVROWS + p) * 96;
#pragma unroll
        for (int c = 0; c < 8; ++c) {
            const f32x4 g0 = *(const f32x4*)(kn + 8 * c), g1 = *(const f32x4*)(kn + 8 * c + 4);
            *(u32x4*)(dst + 8 * c) = (u32x4){pk2(bflo(w[c].x) * rs * g0.x, bfhi(w[c].x) * rs * g0.y), pk2(bflo(w[c].y) * rs * g0.z, bfhi(w[c].y) * rs * g0.w),
                                             pk2(bflo(w[c].z) * rs * g1.x, bfhi(w[c].z) * rs * g1.y), pk2(bflo(w[c].w) * rs * g1.z, bfhi(w[c].w) * rs * g1.w)};
        }
#pragma unroll
        for (int c = 0; c < 2; ++c) {
            const float x1[8] = {e[2 * c].x, e[2 * c].y, e[2 * c].z, e[2 * c].w, e[2 * c + 1].x, e[2 * c + 1].y, e[2 * c + 1].z, e[2 * c + 1].w};
            const float x2[8] = {e[4 + 2 * c].x, e[4 + 2 * c].y, e[4 + 2 * c].z, e[4 + 2 * c].w, e[5 + 2 * c].x, e[5 + 2 * c].y, e[5 + 2 * c].z, e[5 + 2 * c].w};
            float o1[8], o2[8];
#pragma unroll
            for (int t = 0; t < 8; ++t) { const float a = x1[t] * rs * kn[64 + 8 * c + t], b = x2[t] * rs * kn[80 + 8 * c + t]; o1[t] = a * cs[8 * c + t] - b * sn[8 * c + t]; o2[t] = b * cs[8 * c + t] + a * sn[8 * c + t]; }
            *(u32x4*)(dst + 64 + 8 * c) = (u32x4){pk2(o1[0], o1[1]), pk2(o1[2], o1[3]), pk2(o1[4], o1[5]), pk2(o1[6], o1[7])};
            *(u32x4*)(dst + 80 + 8 * c) = (u32x4){pk2(o2[0], o2[1]), pk2(o2[2], o2[3]), pk2(o2[4], o2[5]), pk2(o2[6], o2[7])};
        }
    }
    {
        unsigned char* T = F.lds + F.wave * (64 * P2_TS);
        const bf16_t* src = (const bf16_t*)(ws + WS_KVB) + h * 128 + 64;
#pragma unroll
        for (int it = 0; it < 8; ++it) {
            const int pr = 8 * it + (lane >> 3), ch = lane & 7; const int pp = 64 * blk + pr;
            u32x4 v = (u32x4){0u, 0u, 0u, 0u};
            if (pp >= PADL && pp < LPV) v = *(const u32x4*)(src + (size_t)pp * 1024 + 8 * ch);
            unsigned char* tp = T + (8 * ch) * P2_TS + pr * 2;
            *(bf16_t*)(tp + 0 * P2_TS) = (bf16_t)(v.x & 0xffffu); *(bf16_t*)(tp + 1 * P2_TS) = (bf16_t)(v.x >> 16);
            *(bf16_t*)(tp + 2 * P2_TS) = (bf16_t)(v.y & 0xffffu); *(bf16_t*)(tp + 3 * P2_TS) = (bf16_t)(v.y >> 16);
            *(bf16_t*)(tp + 4 * P2_TS) = (bf16_t)(v.z & 0xffffu); *(bf16_t*)(tp + 5 * P2_TS) = (bf16_t)(v.z >> 16);
            *(bf16_t*)(tp + 6 * P2_TS) = (bf16_t)(v.w & 0xffffu); *(bf16_t*)(tp + 7 * P2_TS) = (bf16_t)(v.w >> 16);
        }
        __builtin_amdgcn_s_waitcnt(0); __builtin_amdgcn_wave_barrier();
        bf16_t* VT = (bf16_t*)(ws + WS_VT) + (size_t)h * 64 * KVROWS + 64 * blk;
#pragma unroll
        for (int it = 0; it < 8; ++it) {
            const int e = 8 * it + (lane >> 3), ch = lane & 7;
            const u32x2 lo = *(const u32x2*)(T + e * P2_TS + 16 * ch), hi = *(const u32x2*)(T + e * P2_TS + 16 * ch + 8);
            *(u32x4*)(VT + (size_t)e * KVROWS + 8 * ch) = (u32x4){lo.x, lo.y, hi.x, hi.y};
        }
        __builtin_amdgcn_s_waitcnt(0); __builtin_amdgcn_wave_barrier();
    }
}

constexpr int A_KSTR = 208;
constexpr int A_VSTR = 136;
constexpr int A_KBYTES = 64 * A_KSTR;
constexpr int A_VBYTES = 64 * A_VSTR;
constexpr int A_BUF = A_KBYTES + A_VBYTES;
DI unsigned cvtpk_s(float lo, float hi) { typedef float f2 __attribute__((ext_vector_type(2))); typedef __bf16 b2 __attribute__((ext_vector_type(2))); f2 v = {lo, hi}; b2 b = __builtin_convertvector(v, b2); return __builtin_bit_cast(unsigned, b); }

DI void attn_item(const Frame& F, const Args& A, int h, int qb) {
    unsigned char* ws = A.ws; unsigned char* lds = F.lds;
    const int tid = F.tid, lane = F.lane, wave = F.wave, r32 = lane & 31, hh = lane >> 5;
    const bf16_t* Qg = (const bf16_t*)(ws + WS_Q) + (size_t)h * KVROWS * 96;
    const bf16_t* Kg = (const bf16_t*)(ws + WS_K) + (size_t)h * KVROWS * 96;
    const bf16_t* Vg = (const bf16_t*)(ws + WS_VT) + (size_t)h * 64 * KVROWS;
    const int p0w = 64 + 256 * qb + 32 * wave;
    const int qp = p0w + r32;
    const int ntile = 4 * qb + 5;
    const int mylast = 1 + 4 * qb + (wave >> 1);
    bf16x8 qf[6];
#pragma unroll
    for (int s = 0; s < 6; ++s) qf[s] = *(const bf16x8*)(Qg + (size_t)qp * 96 + 16 * s + 8 * hh);
    f32x16 ot[2]; ot[0] = zero16(); ot[1] = zero16();
    float mrun = -1e30f, lrun = 0.f;
    const int kr0 = tid / 12, kc0 = tid % 12, kr1 = (tid + 512) / 12, kc1 = (tid + 512) % 12; const bool k1ok = tid < 256;
    const int vr = tid >> 3, vc = tid & 7;
    struct Stg { u32x4 k0, k1, v; };
    Stg sA, sB;
    auto gload = [&](Stg& st, int j) {
        const int kv0 = 64 * j;
        st.k0 = *(const u32x4*)(Kg + (size_t)(kv0 + kr0) * 96 + kc0 * 8);
        if (k1ok) st.k1 = *(const u32x4*)(Kg + (size_t)(kv0 + kr1) * 96 + kc1 * 8);
        st.v = *(const u32x4*)(Vg + (size_t)vr * KVROWS + kv0 + vc * 8);
    };
    auto lstore = [&](const Stg& st, int b) {
        unsigned char* kb = lds + b * A_BUF; unsigned char* vb = kb + A_KBYTES;
        *(u32x4*)(kb + kr0 * A_KSTR + kc0 * 16) = st.k0;
        if (k1ok) *(u32x4*)(kb + kr1 * A_KSTR + kc1 * 16) = st.k1;
        *(u32x2*)(vb + vr * A_VSTR + vc * 16) = (u32x2){st.v.x, st.v.y};
        *(u32x2*)(vb + vr * A_VSTR + vc * 16 + 8) = (u32x2){st.v.z, st.v.w};
    };
    gload(sA, 0); lstore(sA, 0); gload(sB, 1);
    __syncthreads();
    auto step = [&](int j, Stg& sNext  , Stg& sFree  ) {
        const int b = j & 1;
        if (j + 2 < ntile) gload(sFree, j + 2);
        if (j <= mylast) {
            const unsigned char* kb = lds + b * A_BUF; const unsigned char* vb = kb + A_KBYTES;
            f32x16 sc[2];
#pragma unroll
            for (int kh = 0; kh < 2; ++kh) {
                f32x16 acc = zero16();
                const unsigned char* kp = kb + (32 * kh + r32) * A_KSTR + hh * 16;
#pragma unroll
                for (int s = 0; s < 6; ++s) acc = mfma32(*(const bf16x8*)(kp + s * 32), qf[s], acc);
                sc[kh] = acc;
            }
            if (j == 0) {
#pragma unroll
                for (int kh = 0; kh < 2; ++kh)
#pragma unroll
                    for (int r = 0; r < 16; ++r) { const int kv = 32 * kh + crow(r, hh); if (kv < PADL) sc[kh][r] = -INFINITY; }
            }
            if (j == mylast) {
#pragma unroll
                for (int kh = 0; kh < 2; ++kh)
#pragma unroll
                    for (int r = 0; r < 16; ++r) { const int kv = 64 * j + 32 * kh + crow(r, hh); if (kv > qp) sc[kh][r] = -INFINITY; }
            }
            float mx = sc[0][0];
#pragma unroll
            for (int r = 1; r < 16; ++r) mx = fmaxf(mx, sc[0][r]);
#pragma unroll
            for (int r = 0; r < 16; ++r) mx = fmaxf(mx, sc[1][r]);
            mx = fmaxf(mx, __shfl_xor(mx, 32));
            const float mnew = fmaxf(mrun, mx);
            const float alpha = __builtin_amdgcn_exp2f(mrun - mnew);
            mrun = mnew;
            float ps = 0.f;
#pragma unroll
            for (int kh = 0; kh < 2; ++kh)
#pragma unroll
                for (int r = 0; r < 16; ++r) { const float e = __builtin_amdgcn_exp2f(sc[kh][r] - mnew); sc[kh][r] = e; ps += e; }
            lrun = lrun * alpha + ps;
#pragma unroll
            for (int eh = 0; eh < 2; ++eh)
#pragma unroll
                for (int r = 0; r < 16; ++r) ot[eh][r] *= alpha;
#pragma unroll
            for (int kh = 0; kh < 2; ++kh)
#pragma unroll
                for (int s2 = 0; s2 < 2; ++s2) {
                    u32x4 pw; pw.x = cvtpk_s(sc[kh][8 * s2 + 0], sc[kh][8 * s2 + 1]); pw.y = cvtpk_s(sc[kh][8 * s2 + 2], sc[kh][8 * s2 + 3]);
                    pw.z = cvtpk_s(sc[kh][8 * s2 + 4], sc[kh][8 * s2 + 5]); pw.w = cvtpk_s(sc[kh][8 * s2 + 6], sc[kh][8 * s2 + 7]);
                    const bf16x8 pf = __builtin_bit_cast(bf16x8, pw);
#pragma unroll
                    for (int eh = 0; eh < 2; ++eh) {
                        const unsigned char* vp = vb + (32 * eh + r32) * A_VSTR + (32 * kh + 16 * s2 + 4 * hh) * 2;
                        const u32x2 lo = *(const u32x2*)vp, hi2 = *(const u32x2*)(vp + 16);
                        const bf16x8 vf = __builtin_bit_cast(bf16x8, (u32x4){lo.x, lo.y, hi2.x, hi2.y});
                        ot[eh] = mfma32(vf, pf, ot[eh]);
                    }
                }
        }
        if (j + 1 < ntile) lstore(sNext, b ^ 1);
        __syncthreads();
    };
#pragma unroll 1
    for (int j = 0; j < ntile; j += 2) {
        step(j, sB, sA);
        if (j + 1 < ntile) step(j + 1, sA, sB);
    }
    const float ltot = lrun + __shfl_xor(lrun, 32);
    const float rl = 1.f / ltot;
    bf16_t* o = (bf16_t*)(ws + WS_MIX) + (size_t)(qp - 64) * 1024 + 512 + h * 64;
#pragma unroll
    for (int eh = 0; eh < 2; ++eh)
#pragma unroll
        for (int a = 0; a < 4; ++a) {
            const int e = 32 * eh + 8 * a + 4 * hh;
            *(u32x2*)(o + e) = (u32x2){pk2(ot[eh][4 * a] * rl, ot[eh][4 * a + 1] * rl), pk2(ot[eh][4 * a + 2] * rl, ot[eh][4 * a + 3] * rl)};
        }
}

DI void xn_rows(const Frame& F, const Args& A, int u0, int stride) {
    f32x4 v[2][4];
#pragma unroll
    for (int r = 0; r < 2; ++r) { const int u = u0 + r * stride; if (u < MU) { const f32x4* xr = (const f32x4*)(A.out + (size_t)u * DM) + F.lane;
#pragma unroll
        for (int j = 0; j < 4; ++j) v[r][j] = xr[64 * j]; } }
#pragma unroll
    for (int r = 0; r < 2; ++r) {
        const int u = u0 + r * stride; if (u >= MU) continue;
        float s = 0.f;
#pragma unroll
        for (int j = 0; j < 4; ++j) s += (v[r][j].x * v[r][j].x + v[r][j].y * v[r][j].y) + (v[r][j].z * v[r][j].z + v[r][j].w * v[r][j].w);
        const float rstd = 1.f / sqrtf(wave_sum(s) * (1.f / DM) + EPS);
        unsigned long long* o8 = (unsigned long long*)((bf16_t*)(A.ws + WS_XN) + (size_t)u * DM) + F.lane;
#pragma unroll
        for (int j = 0; j < 4; ++j) { const f32x4 w = ((const f32x4*)A.in[15])[64 * j + F.lane];
            o8[64 * j] = (unsigned long long)pk2(v[r][j].x * rstd * w.x, v[r][j].y * rstd * w.y) | ((unsigned long long)pk2(v[r][j].z * rstd * w.z, v[r][j].w * rstd * w.w) << 32); }
    }
}

DI unsigned fkey(float v, int idx) { unsigned u = __builtin_bit_cast(unsigned, v); u = (u & 0x80000000u) ? ~u : (u | 0x80000000u); return (u & ~127u) | (unsigned)(127 - idx); }
DI float keyval(unsigned k) { unsigned u = k & ~127u; u = (u & 0x80000000u) ? (u & 0x7fffffffu) : ~u; return __builtin_bit_cast(float, u); }

__device__ const unsigned char PAIR_A[50] = {0,0,0,0,0,0,0,0,0,0,0,0,0,0,0,0, 1,1,1,1,1,1,1,1, 2,2,2,2,2, 3,3,3,3, 4,4,4, 5,5, 6,6, 7,7, 8,9,10,11,12,13,14,15};
__device__ const unsigned char PAIR_B[50] = {0,1,2,3,4,5,6,7,8,9,10,11,12,13,14,15, 0,1,2,3,4,5,6,7, 0,1,2,3,4, 0,1,2,3, 0,1,2, 0,1, 0,1, 0,1, 0,0,0,0,0,0,0,0};

DI void ce_desc(unsigned& a, unsigned& b) { const unsigned mx = a > b ? a : b, mn = a > b ? b : a; a = mx; b = mn; }
template <int BASE, int NK> DI void bitonic_sort16_desc(unsigned (&x)[NK]) {
#pragma unroll
    for (int k = 2; k <= 16; k <<= 1)
#pragma unroll
        for (int j = k >> 1; j > 0; j >>= 1)
#pragma unroll
            for (int i = 0; i < 16; ++i) { const int l = i ^ j; if (l > i) { if ((i & k) == 0) ce_desc(x[BASE + i], x[BASE + l]); else ce_desc(x[BASE + l], x[BASE + i]); } }
}
template <int A0, int B0, int NK> DI void merge_top16(unsigned (&x)[NK]) {
#pragma unroll
    for (int i = 0; i < 16; ++i) { const unsigned p = x[A0 + i], q = x[B0 + 15 - i]; x[A0 + i] = p > q ? p : q; }
#pragma unroll
    for (int j = 8; j > 0; j >>= 1)
#pragma unroll
        for (int i = 0; i < 16; ++i) { const int l = i ^ j; if (l > i) ce_desc(x[A0 + i], x[A0 + l]); }
}
template <int NK> DI void top16_of_128(unsigned (&key)[NK]) {
    bitonic_sort16_desc<0, NK>(key); bitonic_sort16_desc<16, NK>(key); bitonic_sort16_desc<32, NK>(key); bitonic_sort16_desc<48, NK>(key);
    bitonic_sort16_desc<64, NK>(key); bitonic_sort16_desc<80, NK>(key); bitonic_sort16_desc<96, NK>(key); bitonic_sort16_desc<112, NK>(key);
    merge_top16<0, 16, NK>(key); merge_top16<32, 48, NK>(key); merge_top16<64, 80, NK>(key); merge_top16<96, 112, NK>(key);
    merge_top16<0, 32, NK>(key); merge_top16<64, 96, NK>(key);
    merge_top16<0, 64, NK>(key);
}

DI void topk_task(const Frame& F, const Args& A, int task) {
    unsigned char* ws = A.ws; const int tid = F.tid;
    const int u = task >> 3, h = task & 7;
    LAS unsigned* sk = (LAS unsigned*)(LAS unsigned char*)F.lds;
    LAS unsigned* pkk = sk + 16384;
    LAS float* stg = (LAS float*)(sk + 16384);
    const float* SCb = (const float*)(ws + WS_SC) + (size_t)(task & ~511) * 256;
#pragma unroll 1
    for (int half = 0; half < 2; ++half) {
        unsigned key[128];
#pragma unroll
        for (int qb = 0; qb < 4; ++qb) {
            u32x4 pf[8];
#pragma unroll
            for (int k = 0; k < 8; ++k) { const int c = tid + 512 * k; pf[k] = *(const u32x4*)(SCb + (size_t)(c >> 3) * 256 + half * 128 + qb * 32 + (c & 7) * 4); }
#pragma unroll
            for (int k = 0; k < 8; ++k) { const int c = tid + 512 * k; *(LAS u32x4*)(stg + (c >> 3) * 36 + (c & 7) * 4) = pf[k]; }
            __syncthreads();
#pragma unroll
            for (int i = 0; i < 8; ++i) { const f32x4 v = *(const LAS f32x4*)(stg + tid * 36 + 4 * i);
                key[32 * qb + 4 * i] = fkey(v.x, 32 * qb + 4 * i); key[32 * qb + 4 * i + 1] = fkey(v.y, 32 * qb + 4 * i + 1);
                key[32 * qb + 4 * i + 2] = fkey(v.z, 32 * qb + 4 * i + 2); key[32 * qb + 4 * i + 3] = fkey(v.w, 32 * qb + 4 * i + 3); }
            __syncthreads();
        }
        top16_of_128(key);
#pragma unroll
        for (int r = 0; r < 16; ++r) sk[(half * 16 + r) * 512 + tid] = key[r];
    }
    float v1[16], v2[16];
#pragma unroll
    for (int r = 0; r < 16; ++r) { v1[r] = keyval(sk[r * 512 + tid]); v2[r] = keyval(sk[(16 + r) * 512 + tid]); }
    unsigned ck[64];
#pragma unroll
    for (int c = 50; c < 64; ++c) ck[c] = 0u;
#pragma unroll
    for (int a = 0; a < 16; ++a) {
        const int off = a == 0 ? 0 : a == 1 ? 16 : a == 2 ? 24 : a == 3 ? 29 : a == 4 ? 33 : a == 5 ? 36 : a == 6 ? 38 : a == 7 ? 40 : 42 + (a - 8);
#pragma unroll
        for (int b = 0; b < 16; ++b) if ((a + 1) * (b + 1) <= 16) ck[off + b] = fkey(v1[a] + v2[b], off + b);
    }
    bitonic_sort16_desc<0, 64>(ck); bitonic_sort16_desc<16, 64>(ck); bitonic_sort16_desc<32, 64>(ck); bitonic_sort16_desc<48, 64>(ck);
    merge_top16<0, 16, 64>(ck); merge_top16<32, 48, 64>(ck); merge_top16<0, 32, 64>(ck);
#pragma unroll
    for (int r = 0; r < 16; ++r) pkk[r * 512 + tid] = ck[r];
    const float cmax = keyval(pkk[tid]);
    float ev[16]; float esum = 0.f; int ex[16];
#pragma unroll
    for (int r = 0; r < 16; ++r) {
        const unsigned k = pkk[r * 512 + tid]; const int c = 127 - (int)(k & 127u);
        ev[r] = __expf(keyval(k) - cmax); esum += ev[r];
        const int a = PAIR_A[c], b = PAIR_B[c];
        const int i1 = 127 - (int)(sk[a * 512 + tid] & 127u), i2 = 127 - (int)(sk[(16 + b) * 512 + tid] & 127u);
        ex[r] = i1 * 128 + i2;
    }
    const float rs = 1.f / esum;
    int* IDX = (int*)(ws + WS_IDX) + (size_t)u * 128 + h * 16; float* GATE = (float*)(ws + WS_GATE) + (size_t)u * 128 + h * 16;
#pragma unroll
    for (int r = 0; r < 16; r += 4) {
        *(int4*)(IDX + r) = make_int4(ex[r], ex[r + 1], ex[r + 2], ex[r + 3]);
        *(f32x4*)(GATE + r) = (f32x4){ev[r] * rs, ev[r + 1] * rs, ev[r + 2] * rs, ev[r + 3] * rs};
    }
}

constexpr float EU_SCALE = 64.f, EV_SCALE = 16.f;
DI unsigned pk4_fp8(float a, float b, float c, float d) { int w = 0; w = __builtin_amdgcn_cvt_pk_fp8_f32(a, b, w, false); w = __builtin_amdgcn_cvt_pk_fp8_f32(c, d, w, true); return (unsigned)w; }
DI void convert_tables(const Frame& F, const Args& A) {
    const size_t n16 = (size_t)16384 * 1024 / 16;
    const size_t gt = (size_t)blockIdx.x * 512 + F.tid, NGT = (size_t)F.G * 512;
#pragma unroll 1
    for (int t = 0; t < 2; ++t) {
        const float* src = A.in[18 + t]; unsigned char* dst = A.ws + (t ? WS_EV : WS_EU); const float sc = t ? EV_SCALE : EU_SCALE;
        for (size_t i = gt; i < n16; i += NGT) {
            const f32x4 a = *(const f32x4*)(src + i * 16) * sc, b = *(const f32x4*)(src + i * 16 + 4) * sc, c = *(const f32x4*)(src + i * 16 + 8) * sc, d = *(const f32x4*)(src + i * 16 + 12) * sc;
            const size_t e_ = i >> 6, c16_ = i & 63;
            *(u32x4*)(dst + (c16_ >> 3) * ((size_t)16384 * 128) + e_ * 128 + (c16_ & 7) * 16) = (u32x4){pk4_fp8(a.x, a.y, a.z, a.w), pk4_fp8(b.x, b.y, b.z, b.w), pk4_fp8(c.x, c.y, c.z, c.w), pk4_fp8(d.x, d.y, d.z, d.w)};
        }
    }
}

DI float gelu_exact(float x) { return 0.5f * x * (1.f + erff(x * 0.70710678118654752f)); }
typedef float f32x2 __attribute__((ext_vector_type(2)));
#define UNPK16(dst, W_) do { f32x2 _t; \
    _t = __builtin_amdgcn_cvt_pk_f32_fp8((int)(W_).x, false); dst[0] = _t.x; dst[1] = _t.y; _t = __builtin_amdgcn_cvt_pk_f32_fp8((int)(W_).x, true); dst[2] = _t.x; dst[3] = _t.y; \
    _t = __builtin_amdgcn_cvt_pk_f32_fp8((int)(W_).y, false); dst[4] = _t.x; dst[5] = _t.y; _t = __builtin_amdgcn_cvt_pk_f32_fp8((int)(W_).y, true); dst[6] = _t.x; dst[7] = _t.y; \
    _t = __builtin_amdgcn_cvt_pk_f32_fp8((int)(W_).z, false); dst[8] = _t.x; dst[9] = _t.y; _t = __builtin_amdgcn_cvt_pk_f32_fp8((int)(W_).z, true); dst[10] = _t.x; dst[11] = _t.y; \
    _t = __builtin_amdgcn_cvt_pk_f32_fp8((int)(W_).w, false); dst[12] = _t.x; dst[13] = _t.y; _t = __builtin_amdgcn_cvt_pk_f32_fp8((int)(W_).w, true); dst[14] = _t.x; dst[15] = _t.y; } while (0)

template <bool UPH>
DI void expert_phase(const Frame& F, const Args& A, int xv, int wq, int nw) {
    unsigned char* ws = A.ws; const int lane = F.lane, grp = lane >> 3, j = lane & 7;
    const unsigned char* TBL = ws + (UPH ? WS_EU : WS_EV) + (size_t)xv * ((size_t)16384 * 128) + 16 * j;
    const int* IDX = (const int*)(ws + WS_IDX); const float* CW = (const float*)(ws + WS_CW);
    const bf16_t* XN = (const bf16_t*)(ws + WS_XN) + 128 * xv + 16 * j;
    float* HP = (float*)(ws + WS_HP);
    LAS unsigned* ring = (LAS unsigned*)((LAS unsigned char*)F.lds + F.wave * 4096);
    const int nt = (MU - wq + nw - 1) / nw;
    if (nt <= 0) return;
    auto tok = [&](int k) { return __builtin_amdgcn_readfirstlane(wq + (k < nt ? k : nt - 1) * nw); };
    int mi0, mi1; u32x4 mx0, mx1; float mh0, mh1;
    auto meta_load = [&](int k) {
        const int u = tok(k);
        mi0 = IDX[(size_t)u * 128 + lane]; mi1 = IDX[(size_t)u * 128 + 64 + lane];
        if constexpr (UPH) { mx0 = *(const u32x4*)(XN + (size_t)u * DM); mx1 = *(const u32x4*)(XN + (size_t)u * DM + 8); }
        else { mh0 = CW[(size_t)u * 128 + lane]; mh1 = CW[(size_t)u * 128 + 64 + lane]; }
    };
    auto meta_store = [&](int k) {
        LAS unsigned* sl = ring + (k & 3) * 256;
        sl[lane] = (unsigned)mi0; sl[64 + lane] = (unsigned)mi1;
        if constexpr (UPH) { if (grp == 0) { *(LAS u32x4*)(sl + 128 + 8 * j) = mx0; *(LAS u32x4*)(sl + 128 + 8 * j + 4) = mx1; } }
        else { sl[128 + lane] = __builtin_bit_cast(unsigned, mh0); sl[192 + lane] = __builtin_bit_cast(unsigned, mh1); }
    };
    auto gather = [&](u32x4 (&buf)[8], int n) {
        const LAS unsigned* sl = ring + ((n >> 1) & 3) * 256 + 64 * (n & 1) + grp;
#pragma unroll
        for (int i = 0; i < 8; ++i) { const int e = (int)sl[8 * i]; buf[i] = *(const u32x4*)(TBL + (size_t)e * 128); }
    };
    const int ocol = 128 * xv + 16 * j + ((lane & 32) ? 8 : 0) + ((lane & 16) ? 4 : 0) + ((lane & 8) ? 2 : 0);
    f32x2 ocur = (f32x2){0.f, 0.f};
    float acc[16];
    float xn[16];
    auto compute = [&](u32x4 (&buf)[8], int n) {
        const int k = n >> 1, hf = n & 1;
        const LAS unsigned* sl = ring + (k & 3) * 256;
        if (hf == 0) {
            if constexpr (UPH) {
                const u32x4 x0 = *(const LAS u32x4*)(sl + 128 + 8 * j), x1 = *(const LAS u32x4*)(sl + 128 + 8 * j + 4);
                xn[0] = bflo(x0.x); xn[1] = bfhi(x0.x); xn[2] = bflo(x0.y); xn[3] = bfhi(x0.y); xn[4] = bflo(x0.z); xn[5] = bfhi(x0.z); xn[6] = bflo(x0.w); xn[7] = bfhi(x0.w);
                xn[8] = bflo(x1.x); xn[9] = bfhi(x1.x); xn[10] = bflo(x1.y); xn[11] = bfhi(x1.y); xn[12] = bflo(x1.z); xn[13] = bfhi(x1.z); xn[14] = bflo(x1.w); xn[15] = bfhi(x1.w);
            } else {
#pragma unroll
                for (int c = 0; c < 16; ++c) acc[c] = 0.f;
                ocur = *(const f32x2*)(A.out + (size_t)tok(k) * DM + ocol);
            }
        }
#pragma unroll
        for (int i = 0; i < 8; ++i) {
            float f[16]; UNPK16(f, buf[i]);
            if constexpr (UPH) {
                float a0 = 0.f, a1 = 0.f;
#pragma unroll
                for (int c = 0; c < 16; c += 2) { a0 += f[c] * xn[c]; a1 += f[c + 1] * xn[c + 1]; }
                if (hf == 0) acc[i] = a0 + a1; else acc[8 + i] = a0 + a1;
                if (i < 7) { if (hf == 0) asm volatile("" : "+v"(buf[i + 1].x), "+v"(buf[i + 1].y), "+v"(buf[i + 1].z), "+v"(buf[i + 1].w), "+v"(acc[i]));
                             else asm volatile("" : "+v"(buf[i + 1].x), "+v"(buf[i + 1].y), "+v"(buf[i + 1].z), "+v"(buf[i + 1].w), "+v"(acc[8 + i])); }
            } else {
                const float cw = __builtin_bit_cast(float, sl[128 + 64 * hf + 8 * i + grp]);
#pragma unroll
                for (int c = 0; c < 16; ++c) acc[c] += cw * f[c];
                if (i < 7) asm volatile("" : "+v"(buf[i + 1].x), "+v"(buf[i + 1].y), "+v"(buf[i + 1].z), "+v"(buf[i + 1].w),
                                             "+v"(acc[0]), "+v"(acc[1]), "+v"(acc[2]), "+v"(acc[3]), "+v"(acc[4]), "+v"(acc[5]), "+v"(acc[6]), "+v"(acc[7]),
                                             "+v"(acc[8]), "+v"(acc[9]), "+v"(acc[10]), "+v"(acc[11]), "+v"(acc[12]), "+v"(acc[13]), "+v"(acc[14]), "+v"(acc[15]));
            }
            __builtin_amdgcn_sched_barrier(0);
        }
        if (hf == 1 && k < nt) {
            const int u = tok(k);
            float r8[8], r4[4], r2[2];
            if constexpr (UPH) {
                { const bool up = lane & 4;
#pragma unroll
                  for (int i = 0; i < 8; ++i) { const float send = up ? acc[i] : acc[i + 8], keep = up ? acc[i + 8] : acc[i]; r8[i] = keep + __shfl_xor(send, 4); } }
                { const bool up = lane & 2;
#pragma unroll
                  for (int i = 0; i < 4; ++i) { const float send = up ? r8[i] : r8[i + 4], keep = up ? r8[i + 4] : r8[i]; r4[i] = keep + __shfl_xor(send, 2); } }
                { const bool up = lane & 1;
#pragma unroll
                  for (int i = 0; i < 2; ++i) { const float send = up ? r4[i] : r4[i + 2], keep = up ? r4[i + 2] : r4[i]; r2[i] = keep + __shfl_xor(send, 1); } }
                const int st = ((lane & 4) ? 8 : 0) + ((lane & 2) ? 4 : 0) + ((lane & 1) ? 2 : 0);
                float* hp = HP + ((size_t)xv * MU + u) * 128 + grp;
                hp[8 * st] = r2[0]; hp[8 * (st + 1)] = r2[1];
            } else {
                { const bool up = lane & 32;
#pragma unroll
                  for (int c = 0; c < 8; ++c) { const float send = up ? acc[c] : acc[c + 8], keep = up ? acc[c + 8] : acc[c]; r8[c] = keep + __shfl_xor(send, 32); } }
                { const bool up = lane & 16;
#pragma unroll
                  for (int c = 0; c < 4; ++c) { const float send = up ? r8[c] : r8[c + 4], keep = up ? r8[c + 4] : r8[c]; r4[c] = keep + __shfl_xor(send, 16); } }
                { const bool up = lane & 8;
#pragma unroll
                  for (int c = 0; c < 2; ++c) { const float send = up ? r4[c] : r4[c + 2], keep = up ? r4[c + 2] : r4[c]; r2[c] = keep + __shfl_xor(send, 8); } }
                f32x2* o = (f32x2*)(A.out + (size_t)u * DM + ocol);
                f32x2 cur = ocur; cur.x += r2[0]; cur.y += r2[1]; *o = cur;
            }
        }
    };
    meta_load(0); meta_store(0); meta_load(1); meta_store(1); meta_load(2); meta_store(2);
    u32x4 b0[8], b1[8], b2[8];
    gather(b0, 0); gather(b1, 1); gather(b2, 2);
#pragma unroll 1
    for (int k0 = 0; k0 < nt; k0 += 3) {
        const int n0 = 2 * k0;
        meta_load(k0 + 3);
        compute(b0, n0);     gather(b0, n0 + 3);
        compute(b1, n0 + 1); meta_store(k0 + 3); gather(b1, n0 + 4);
        meta_load(k0 + 4);
        compute(b2, n0 + 2); gather(b2, n0 + 5);
        compute(b0, n0 + 3); meta_store(k0 + 4); gather(b0, n0 + 6);
        meta_load(k0 + 5);
        compute(b1, n0 + 4); gather(b1, n0 + 7);
        compute(b2, n0 + 5); meta_store(k0 + 5); gather(b2, n0 + 8);
    }
}


DI void expert_c_pass(const Frame& F, const Args& A) {
    unsigned char* ws = A.ws;
    const float* HP = (const float*)(ws + WS_HP); const float* GATE = (const float*)(ws + WS_GATE); float* CW = (float*)(ws + WS_CW);
    const size_t n4 = (size_t)MU * 128 / 4;
    for (size_t i = (size_t)blockIdx.x * 512 + F.tid; i < n4; i += (size_t)F.G * 512) {
        f32x4 h = *(const f32x4*)(HP + i * 4);
#pragma unroll
        for (int x = 1; x < 8; ++x) h += *(const f32x4*)(HP + (size_t)x * MU * 128 + i * 4);
        const f32x4 g = *(const f32x4*)(GATE + i * 4);
        f32x4 c;
        c.x = gelu_exact(h.x * (1.f / EU_SCALE)) * g.x * (1.f / EV_SCALE); c.y = gelu_exact(h.y * (1.f / EU_SCALE)) * g.y * (1.f / EV_SCALE);
        c.z = gelu_exact(h.z * (1.f / EU_SCALE)) * g.z * (1.f / EV_SCALE); c.w = gelu_exact(h.w * (1.f / EU_SCALE)) * g.w * (1.f / EV_SCALE);
        *(f32x4*)(CW + i * 4) = c;
    }
}
#ifndef PROBE_VAR
#define PROBE_VAR 0
#endif
template <int PH> DI void run_phase(const Frame& F, const Args& args, PG8_LAS unsigned char* lds3) {
    unsigned char* ws = args.ws;
    if constexpr (PH == 0) { p0_prologue(F, args); }
    if constexpr (PH == 1) {
        pg8::Gemm g{(const bf16_t*)(ws + WS_HN), (const bf16_t*)(ws + WS_WIN), MP, NPROJ, 1024, 1024, 1024, 0};
        pg8::StaticOrder S; S.init(MP, NPROJ, F.G, (int)blockIdx.x);
        EpiProj E{(bf16_t*)(ws + WS_QKVR), (bf16_t*)(ws + WS_Z), (float*)(ws + WS_P32)};
        pg8::gemm_phase<EpiProj, pg8::StaticOrder, true, true>(lds3, g, S, E);
    }
    if constexpr (PH == 2) { gdn_prep_phase<0>(F, args); }
    if constexpr (PH == 102) { gdn_prep_phase<PROBE_VAR>(F, args); }
    if constexpr (PH == 3) {
        gdn_scan(F, args);
        if (F.G > 32 && blockIdx.x >= 32) {
            const int wi = (blockIdx.x - 32) * 8 + F.wave, nwv = (F.G - 32) * 8;
            p0_late_weights(F, args, wi, nwv, (blockIdx.x - 32) * 512 + F.tid, (F.G - 32) * 512);
            for (int p = wi; p < MP; p += nwv) mla_prep1_row(F, args, p);
        }
    }
    if constexpr (PH == 4) {
        for (int t = F.gw; t < 2048 * 2; t += F.NGW) gdn_out_task(F, args, t);
        if (F.G <= 32) for (int p = F.gw; p < MP; p += F.NGW) mla_prep1_row(F, args, p);
    }
    if constexpr (PH == 5) {
        { pg8::Gemm g{(const bf16_t*)(ws + WS_CQN), (const bf16_t*)(ws + WS_WUQ), MP, 768, 256, 256, 256, 0};
          pg8::StaticOrder S; S.init(MP, 768, F.G, (int)blockIdx.x); EpiB16 E{(bf16_t*)(ws + WS_QH), 768};
          pg8::gemm_phase<EpiB16, pg8::StaticOrder, true, true>(lds3, g, S, E); }
        { pg8::Gemm g{(const bf16_t*)(ws + WS_CKVN), (const bf16_t*)(ws + WS_WUKV), MP, 1024, 256, 256, 256, 0};
          pg8::StaticOrder S; S.init(MP, 1024, F.G, (int)blockIdx.x); EpiB16 E{(bf16_t*)(ws + WS_KVB), 1024};
          pg8::gemm_phase<EpiB16, pg8::StaticOrder, true, true>(lds3, g, S, E); }
    }
    if constexpr (PH == 6) { for (int t = F.gw; t < (KVROWS / 64) * 8; t += F.NGW) mla_prep2_task(F, args, t); }
    if constexpr (PH == 7) {
        for (int rep = 0; rep < 2; ++rep) {
            for (int k0 = blockIdx.x; k0 < 256; k0 += F.G) {
                const int k = rep == 0 ? k0 : 511 - k0;
                attn_item(F, args, k & 7, 63 - (k >> 3));
            }
        }
    }
    if constexpr (PH == 8) {
        pg8::Gemm g{(const bf16_t*)(ws + WS_MIX), (const bf16_t*)(ws + WS_WOUT), MU, 1024, 1024, 1024, 1024, 0};
        pg8::StaticOrder S; S.init(MU, 1024, F.G, (int)blockIdx.x); EpiF32 E{args.out, 1024, args.in[0]};
        pg8::gemm_phase<EpiF32, pg8::StaticOrder, true, true>(lds3, g, S, E);
    }
    if constexpr (PH == 9) { for (int u = F.gw; u < MU; u += 2 * F.NGW) xn_rows(F, args, u, F.NGW); }
    if constexpr (PH == 10) {
        pg8::Gemm g{(const bf16_t*)(ws + WS_XN), (const bf16_t*)(ws + WS_WPQ), MU, 2048, 1024, 1024, 1024, 0};
        pg8::StaticOrder S; S.init(MU, 2048, F.G, (int)blockIdx.x); EpiB16 E{(bf16_t*)(ws + WS_PQ), 2048};
        pg8::gemm_phase<EpiB16, pg8::StaticOrder, true, true>(lds3, g, S, E);
    }
    if constexpr (PH == 11) {
        pg8::Gemm g{(const bf16_t*)(ws + WS_PQ), (const bf16_t*)(ws + WS_SKB), MU, 2048, 256, 2048, 256, 256};
        pg8::StaticOrder S; S.init(MU, 2048, F.G, (int)blockIdx.x); EpiF32 E{(float*)(ws + WS_SC), 2048, nullptr};
        pg8::gemm_phase<EpiF32, pg8::StaticOrder, true, true>(lds3, g, S, E);
    }
    if constexpr (PH == 12) {
        convert_tables(F, args);
        for (int t = blockIdx.x * 512 + F.tid; t < MU * 8; t += F.G * 512) topk_task(F, args, t);
    }
    if constexpr (PH == 14) { expert_c_pass(F, args); }
    if constexpr (PH == 13 || PH == 15) {
        volatile LAS unsigned* MISC = (volatile LAS unsigned*)(lds3 + MISC_OFF);
        const unsigned x = MISC[16], rank = MISC[17];
        unsigned* bar = (unsigned*)(ws + WS_CTL);
        unsigned nloc = 0, nx = 0, myidx = 0;
#pragma unroll
        for (unsigned j = 0; j < 16; ++j) { const unsigned c = xb_ld(&bar[XB_XCNT(j)]); nx += (c > 0u) ? 1u : 0u; myidx += (c > 0u && j < x) ? 1u : 0u; nloc = (j == x) ? c : nloc; }
        const int wq = __builtin_amdgcn_readfirstlane((int)rank * 8 + F.wave), nw = __builtin_amdgcn_readfirstlane((int)nloc * 8);
        const int xstep = __builtin_amdgcn_readfirstlane((int)nx);
        for (int xv = __builtin_amdgcn_readfirstlane((int)myidx); xv < 8; xv += xstep)
            { if constexpr (PH == 13) expert_phase<true>(F, args, xv, wq, nw); else expert_phase<false>(F, args, xv, wq, nw); }
    }
}
constexpr int NPHASE = 16;
__global__ void __launch_bounds__(512, 2) fwd_kernel(Args args) {
    extern __shared__ __attribute__((aligned(16))) unsigned char lds[];
    Frame F;
    F.lds = lds; F.tid = threadIdx.x; F.lane = F.tid & 63; F.wave = __builtin_amdgcn_readfirstlane(F.tid >> 6);
    F.G = gridDim.x; F.gw = blockIdx.x * 8 + F.wave; F.NGW = F.G * 8;
    volatile LAS unsigned* MISC = (volatile LAS unsigned*)((LAS unsigned char*)lds + MISC_OFF);
    if (F.tid < 32) MISC[F.tid] = 0u;
    __syncthreads();
    unsigned char* ws = args.ws;
    const int lo = args.ph_lo, hi = args.ph_hi;
    XcdBarrier bar; bar.bar = (unsigned*)(ws + WS_CTL); bar.x = 0; bar.st = nullptr;
    if (hi - lo > 1) bar = xcd_barrier_post((unsigned*)(ws + WS_CTL), MISC + 8);
    if (F.tid == 0) { const unsigned x = xb_xcc_id(); MISC[16] = x; MISC[17] = xb_add((unsigned*)(ws + WS_CTL) + 3520 + 64 * x, 1u); }
    __syncthreads();
#define IN(k) (lo <= (k) && (k) < hi)
#define SEAM(k) do { if (IN(k) && IN((k) + 1)) xcd_barrier(bar); } while (0)
    PG8_LAS unsigned char* lds3 = (PG8_LAS unsigned char*)lds;

#ifndef PROBE_REPEAT
#define PROBE_REPEAT -1
#endif
#ifndef PROBE_TIME
#define PROBE_TIME -1
#endif
#ifndef PROBE_TSEL
#define PROBE_TSEL 0
#endif
    unsigned long long pt_ticks = 0ull;
#define PHASE(k) do { unsigned long long pt0_ = 0ull; if (PROBE_TIME == (k)) pt0_ = __builtin_amdgcn_s_memrealtime(); \
        if (IN(k)) { run_phase<k>(F, args, lds3); if (PROBE_REPEAT == (k)) { xcd_barrier(bar); run_phase<(PROBE_VAR && (k) == 2) ? 102 : (k)>(F, args, lds3); } } \
        if (PROBE_TIME == (k) && PROBE_TSEL == 1) pt_ticks = __builtin_amdgcn_s_memrealtime() - pt0_;     \
        if (PROBE_TIME == (k) && PROBE_TSEL == 2) pt0_ = __builtin_amdgcn_s_memrealtime();                \
        SEAM(k); \
        if (PROBE_TIME == (k) && PROBE_TSEL != 1) pt_ticks = __builtin_amdgcn_s_memrealtime() - pt0_; } while (0)
    PHASE(0); PHASE(1); PHASE(2); PHASE(3); PHASE(4); PHASE(5); PHASE(6); PHASE(7); PHASE(8); PHASE(9); PHASE(10); PHASE(11); PHASE(12); PHASE(13); PHASE(14); PHASE(15);
#undef PHASE
    if (PROBE_STAGE >= 0) { __syncthreads(); pt_ticks = *(volatile unsigned long long*)(lds + 143360 + 96); }
    if (PROBE_TIME >= 0 || PROBE_STAGE >= 0) { const unsigned long long t0_ = __builtin_amdgcn_s_memrealtime(); while (__builtin_amdgcn_s_memrealtime() - t0_ < 4ull * pt_ticks) __builtin_amdgcn_s_sleep(32); }
#undef IN
#undef SEAM
}

#ifndef N_LAUNCHES
#define N_LAUNCHES 1
#endif
extern "C" void kernel_launch(void* const* d_in, const int* in_sizes, int n_in, void* d_out, int out_size, void* d_ws, size_t ws_size, hipStream_t stream) {
    static int grid = 0;
    if (grid == 0) {
        if (n_in != 20 || out_size != MU * DM || ws_size < WS_END) { fprintf(stderr, "kernel_launch: unexpected shapes (n_in %d out %d ws %zu)\n", n_in, out_size, ws_size); grid = -1; return; }
        int dev = 0, cus = 0, per_cu = 0;
        if (hipGetDevice(&dev) != hipSuccess || hipDeviceGetAttribute(&cus, hipDeviceAttributeMultiprocessorCount, dev) != hipSuccess) { grid = -1; return; }
        if (hipFuncSetAttribute((const void*)fwd_kernel, hipFuncAttributeMaxDynamicSharedMemorySize, LDS_BYTES) != hipSuccess) { fprintf(stderr, "kernel_launch: hipFuncSetAttribute failed\n"); grid = -1; return; }
        if (hipOccupancyMaxActiveBlocksPerMultiprocessor(&per_cu, (const void*)fwd_kernel, 512, LDS_BYTES) != hipSuccess || per_cu < 1) { fprintf(stderr, "kernel_launch: occupancy query says %d\n", per_cu); (void)hipGetLastError(); per_cu = 1; }
        grid = cus;
    }
    if (grid < 0) return;
    (void)hipMemsetAsync((char*)d_ws + WS_CTL, 0, CTL_ZERO_BYTES, stream);
    Args a{};
    for (int i = 0; i < 20; ++i) a.in[i] = (const float*)d_in[i];
    a.out = (float*)d_out; a.ws = (unsigned char*)d_ws;
    for (int li = 0; li < N_LAUNCHES; ++li) {
        a.ph_lo = li * NPHASE / N_LAUNCHES; a.ph_hi = (li + 1) * NPHASE / N_LAUNCHES;
        if (N_LAUNCHES == 1) {
            void* kargs[] = {&a};
            hipError_t e = hipLaunchCooperativeKernel((const void*)fwd_kernel, dim3(grid), dim3(512), kargs, LDS_BYTES, stream);
            if (e != hipSuccess) fprintf(stderr, "cooperative launch failed: %s (grid %d)\n", hipGetErrorString(e), grid);
        } else {
            hipLaunchKernelGGL(fwd_kernel, dim3(grid), dim3(512), LDS_BYTES, stream, a);
        }
    }
}
```

```cpp
#include <hip/hip_runtime.h>
#include <hip/hip_bf16.h>
#include <cstdio>
#include <cstdint>

#define DI __device__ __forceinline__
#define LAS __attribute__((address_space(3)))
#define GAS __attribute__((address_space(1)))

typedef unsigned short bf16_t;
typedef short bf16x8 __attribute__((ext_vector_type(8)));
typedef short s16x4 __attribute__((ext_vector_type(4)));
typedef float f32x4 __attribute__((ext_vector_type(4)));
typedef float f32x16 __attribute__((ext_vector_type(16)));
typedef unsigned u32x4 __attribute__((ext_vector_type(4)));
typedef unsigned u32x2 __attribute__((ext_vector_type(2)));

namespace pg8 {
#define PG8_LAS __attribute__((address_space(3)))
constexpr int BM = 256, BK = 64, HALF = 128, HTB = HALF * BK * 2  , STAGE_BYTES = 8 * HTB, NXCD = 8, WGM = 8;

__host__ __device__ __forceinline__ int lds_byte(int r, int c) { const int st = (r >> 4) * 2 + (c >> 5), rr = r & 15, cc = c & 31, ob = rr * 64 + cc * 2; return st * 1024 + (ob ^ (((ob >> 9) & 1) << 5)); }
__host__ __device__ __forceinline__ void stage_rc(int b, int& R, int& C) { const int st = b / 1024, sb = b % 1024, swz = sb ^ (((sb >> 9) & 1) << 5); R = (st >> 1) * 16 + swz / 64; C = (st & 1) * 32 + (swz % 64) / 2; }
__host__ __device__ __forceinline__ int perm32(int rho) { const int n = rho >> 4, i = rho & 15; return 8 * (i >> 2) + 4 * n + (i & 3); }

struct Unit { int pm, pn; };
struct Gemm { const bf16_t* A; const bf16_t* Bt; int M, N, K, lda, ldb, a_pn_off; };

struct StaticOrder {
    int nM, nN, nwg, G, c;
    __host__ __device__ void init(int M, int N, int G_, int c_) { nM = M / BM; nN = N / BM; nwg = nM * nN; G = G_; c = c_; }
    __host__ __device__ bool next(int i, Unit& u) const {
        const long L = (long)i * G + c; if (L >= nwg) return false;
        int wgid = (int)L; { const int q = nwg / NXCD, r = nwg % NXCD, xcd = wgid % NXCD, off = wgid / NXCD; wgid = (xcd < r ? xcd * (q + 1) : r * (q + 1) + (xcd - r) * q) + off; }
        const int nig = WGM * nN, gid = wgid / nig, fm = gid * WGM, gsz = (nM - fm) < WGM ? (nM - fm) : WGM;
        u.pm = fm + ((wgid % nig) % gsz); u.pn = (wgid % nig) / gsz; return true;
    }
    __device__ __forceinline__ void a_ready(const Unit&) const {}
    __device__ __forceinline__ void done(const Unit&) const {}
};

__device__ __forceinline__ unsigned cvt_pk_bf16(float lo, float hi) { unsigned r; asm volatile("v_cvt_pk_bf16_f32 %0, %1, %2" : "=v"(r) : "v"(lo), "v"(hi)); return r; }

template <class Epi, class Sched, bool ALIGN_EPI = false, bool SP2 = false>
__device__ __forceinline__ void gemm_phase(PG8_LAS unsigned char* lds, const Gemm g, const Sched& S, const Epi& E) {
    const int tid = threadIdx.x, wid = __builtin_amdgcn_readfirstlane(tid >> 6), lane = tid & 63, wr = wid >> 2, wc = wid & 3, fr = lane & 15, fq = lane >> 4;
    const int K = g.K, nt = K / BK;
    unsigned voffA[2], voffB[2];
#pragma unroll
    for (int i = 0; i < 2; ++i) { int R, C; stage_rc(tid * 16 + i * 8192, R, C); const int Rb = Epi::PERM ? ((R & ~31) + perm32(R & 31)) : R;
        voffA[i] = (unsigned)(R * g.lda + C) * 2u; voffB[i] = (unsigned)(Rb * g.ldb + C) * 2u; }
    const size_t kstep = (size_t)(BK * 2);
    const size_t hstepA = (size_t)HALF * g.lda * 2, hstepB = (size_t)HALF * g.ldb * 2;
    const size_t tstepA = 2 * hstepA, tstepB = 2 * hstepB;
    const size_t pnoffA = (size_t)g.a_pn_off * 2;
    const unsigned ldsw = (unsigned)wid * 1024u;
    const int aoff = lds_byte(wr * 64 + fr, fq * 8), boff = lds_byte(wc * 32 + fr, fq * 8);
#define PG8_SA(b, h) (((b) * 2 + (h)) * HTB)
#define PG8_SB(b, h) ((4 + (b) * 2 + (h)) * HTB)
#define PG8_STAGE(bufoff, gbase, voff) do { _Pragma("unroll") for (int _i = 0; _i < 2; ++_i) \
        __builtin_amdgcn_global_load_lds((const unsigned*)((const char*)(gbase) + (voff)[_i]), (PG8_LAS unsigned*)(lds + (bufoff) + ldsw + _i * 8192), 16, 0, 0); } while (0)
#define PG8_LDA(dst, b, h) do { _Pragma("unroll") for (int m = 0; m < 4; ++m) _Pragma("unroll") for (int k = 0; k < 2; ++k) dst[m][k] = *(const PG8_LAS bf16x8*)(lds + PG8_SA(b, h) + aoff + m * 2048 + k * 1024); } while (0)
#define PG8_LDB(dst, b, h) do { _Pragma("unroll") for (int n = 0; n < 2; ++n) _Pragma("unroll") for (int k = 0; k < 2; ++k) dst[n][k] = *(const PG8_LAS bf16x8*)(lds + PG8_SB(b, h) + boff + n * 2048 + k * 1024); } while (0)
#define PG8_MMA(ai, bj, At, Bt) do { __builtin_amdgcn_s_setprio(1); _Pragma("unroll") for (int m = 0; m < 4; ++m) _Pragma("unroll") for (int n = 0; n < 2; ++n) _Pragma("unroll") for (int k = 0; k < 2; ++k) \
        acc[ai][bj][m][n] = __builtin_amdgcn_mfma_f32_16x16x32_bf16(Bt[n][k], At[m][k], acc[ai][bj][m][n], 0, 0, 0); __builtin_amdgcn_s_setprio(0); } while (0)
#define PG8_WAIT_V(n) asm volatile("s_waitcnt vmcnt(" #n ")" ::: "memory")
#define PG8_WAIT_L(n) asm volatile("s_waitcnt lgkmcnt(" #n ")" ::: "memory")
#define PG8_BAR __builtin_amdgcn_s_barrier()
#define PG8_SCHED __builtin_amdgcn_sched_barrier(0)
    Unit cur, nxt; int ui = 0;
    if (!S.next(0, cur)) return;
    f32x4 acc[2][2][4][2];
#pragma unroll
    for (int a = 0; a < 2; ++a)
#pragma unroll
        for (int b = 0; b < 2; ++b)
#pragma unroll
            for (int m = 0; m < 4; ++m)
#pragma unroll
                for (int n = 0; n < 2; ++n) acc[a][b][m][n] = (f32x4){0.f, 0.f, 0.f, 0.f};
    bf16x8 At[4][2], B0[2][2], B1[2][2];
    const char* cA = (const char*)g.A + (size_t)cur.pm * tstepA + (size_t)cur.pn * pnoffA; const char* cB = (const char*)g.Bt + (size_t)cur.pn * tstepB;
    S.a_ready(cur);
    if constexpr (SP2) {
        PG8_STAGE(PG8_SB(0, 0), cB, voffB); PG8_STAGE(PG8_SB(0, 1), cB + hstepB, voffB); PG8_STAGE(PG8_SA(0, 0), cA, voffA); PG8_STAGE(PG8_SA(0, 1), cA + hstepA, voffA);
        if (wr == 1) PG8_BAR;
        PG8_WAIT_V(2); PG8_BAR;
        PG8_STAGE(PG8_SB(1, 0), cB + kstep, voffB); PG8_STAGE(PG8_SA(1, 0), cA + kstep, voffA); PG8_STAGE(PG8_SB(1, 1), cB + hstepB + kstep, voffB);
        PG8_WAIT_V(6); PG8_BAR;
    } else {
        PG8_STAGE(PG8_SB(0, 0), cB, voffB); PG8_STAGE(PG8_SA(0, 0), cA, voffA); PG8_STAGE(PG8_SB(0, 1), cB + hstepB, voffB); PG8_STAGE(PG8_SA(0, 1), cA + hstepA, voffA);
        if (wr == 1) PG8_BAR;
        PG8_WAIT_V(4); PG8_BAR;
        PG8_STAGE(PG8_SB(1, 0), cB + kstep, voffB); PG8_STAGE(PG8_SA(1, 0), cA + kstep, voffA); PG8_STAGE(PG8_SB(1, 1), cB + hstepB + kstep, voffB);
        PG8_WAIT_V(6); PG8_BAR;
    }
    for (;;) {
        const bool has_next = S.next(ui + 1, nxt);
        const char* nA = has_next ? (const char*)g.A + (size_t)nxt.pm * tstepA + (size_t)nxt.pn * pnoffA : cA; const char* nB = has_next ? (const char*)g.Bt + (size_t)nxt.pn * tstepB : cB;
        for (int t = 0; t < nt; t += 2) {
            const bool last = (t == nt - 2);
            const char* a1 = cA + (size_t)(t + 1) * kstep;
            const char* a2 = last ? nA : cA + (size_t)(t + 2) * kstep; const char* b2 = last ? nB : cB + (size_t)(t + 2) * kstep;
            const char* a3 = a2 + kstep; const char* b3 = b2 + kstep;
            if (last && has_next) S.a_ready(nxt);
            if constexpr (SP2) {
            PG8_LDB(B0, 0, 0); PG8_LDB(B1, 0, 1); PG8_SCHED; PG8_LDA(At, 0, 0); PG8_STAGE(PG8_SA(1, 1), a1 + hstepA, voffA);
            PG8_WAIT_V(8); PG8_WAIT_L(0); PG8_BAR; PG8_MMA(0, 0, At, B0); PG8_MMA(0, 1, At, B1); PG8_BAR; PG8_SCHED;
            PG8_LDA(At, 0, 1); PG8_STAGE(PG8_SB(0, 0), b2, voffB); PG8_STAGE(PG8_SB(0, 1), b2 + hstepB, voffB); PG8_STAGE(PG8_SA(0, 0), a2, voffA);
            PG8_WAIT_V(8); PG8_WAIT_L(0); PG8_BAR; PG8_MMA(1, 0, At, B0); PG8_MMA(1, 1, At, B1); PG8_BAR; PG8_SCHED;
            PG8_LDB(B0, 1, 0); PG8_LDB(B1, 1, 1); PG8_SCHED; PG8_LDA(At, 1, 0); PG8_STAGE(PG8_SA(0, 1), a2 + hstepA, voffA);
            PG8_WAIT_V(8); PG8_WAIT_L(0); PG8_BAR; PG8_MMA(0, 0, At, B0); PG8_MMA(0, 1, At, B1); PG8_BAR; PG8_SCHED;
            PG8_LDA(At, 1, 1); PG8_STAGE(PG8_SB(1, 0), b3, voffB); PG8_STAGE(PG8_SB(1, 1), b3 + hstepB, voffB); PG8_STAGE(PG8_SA(1, 0), a3, voffA);
            PG8_WAIT_V(8); PG8_WAIT_L(0); PG8_BAR; PG8_MMA(1, 0, At, B0); PG8_MMA(1, 1, At, B1); PG8_BAR; PG8_SCHED;
            } else {
            PG8_LDB(B0, 0, 0); PG8_SCHED; PG8_LDA(At, 0, 0); PG8_STAGE(PG8_SA(1, 1), a1 + hstepA, voffA);
            PG8_WAIT_L(8); PG8_BAR; PG8_WAIT_L(0); PG8_MMA(0, 0, At, B0); PG8_BAR; PG8_SCHED;
            PG8_LDB(B1, 0, 1); PG8_STAGE(PG8_SB(0, 0), b2, voffB);
            PG8_BAR; PG8_WAIT_L(0); PG8_MMA(0, 1, At, B1); PG8_BAR;
            PG8_LDA(At, 0, 1); PG8_STAGE(PG8_SA(0, 0), a2, voffA);
            PG8_BAR; PG8_WAIT_L(0); PG8_MMA(1, 0, At, B0); PG8_BAR; PG8_SCHED;
            PG8_STAGE(PG8_SB(0, 1), b2 + hstepB, voffB);
            PG8_WAIT_V(6); PG8_BAR; PG8_MMA(1, 1, At, B1); PG8_BAR;
            PG8_LDB(B0, 1, 0); PG8_SCHED; PG8_LDA(At, 1, 0); PG8_STAGE(PG8_SA(0, 1), a2 + hstepA, voffA);
            PG8_WAIT_L(8); PG8_BAR; PG8_WAIT_L(0); PG8_MMA(0, 0, At, B0); PG8_BAR; PG8_SCHED;
            PG8_LDB(B1, 1, 1); PG8_STAGE(PG8_SB(1, 0), b3, voffB);
            PG8_BAR; PG8_WAIT_L(0); PG8_MMA(0, 1, At, B1); PG8_BAR;
            PG8_LDA(At, 1, 1); PG8_STAGE(PG8_SA(1, 0), a3, voffA);
            PG8_BAR; PG8_WAIT_L(0); PG8_MMA(1, 0, At, B0); PG8_BAR; PG8_SCHED;
            PG8_STAGE(PG8_SB(1, 1), b3 + hstepB, voffB);
            PG8_WAIT_V(6); PG8_BAR; PG8_MMA(1, 1, At, B1); PG8_BAR;
            }
        }
        if constexpr (ALIGN_EPI) { if (wr == 0) PG8_BAR; }
        E(acc, cur, wr, wc, fr, fq); S.done(cur);
        if (!has_next) break;
#pragma unroll
        for (int a = 0; a < 2; ++a)
#pragma unroll
            for (int b = 0; b < 2; ++b)
#pragma unroll
                for (int m = 0; m < 4; ++m)
#pragma unroll
                    for (int n = 0; n < 2; ++n) acc[a][b][m][n] = (f32x4){0.f, 0.f, 0.f, 0.f};
        cur = nxt; cA = nA; cB = nB; ++ui;
        if constexpr (ALIGN_EPI) { if (wr == 1) PG8_BAR; }
    }
    PG8_WAIT_V(0);
    if constexpr (!ALIGN_EPI) { if (wr == 0) PG8_BAR; }
    PG8_BAR;
#undef PG8_SA
#undef PG8_SB
#undef PG8_STAGE
#undef PG8_LDA
#undef PG8_LDB
#undef PG8_MMA
#undef PG8_WAIT_V
#undef PG8_WAIT_L
#undef PG8_BAR
#undef PG8_SCHED
}
}

constexpr int DM = 1024;
constexpr int NTOK = 16400;
constexpr int PADL = 48;
constexpr int LPV = 16448;
constexpr int MP = 16640;
constexpr int MU = 16384;
constexpr int NCHUNK = 257;
constexpr int NHEAD = 8;
constexpr int NPROJ = 2560;
constexpr int KVROWS = 16512;
constexpr float EPS = 1e-6f;

constexpr size_t MiB = 1u << 20;
constexpr size_t WS_CTL = 0, CTL_ZERO_BYTES = 64 * 1024;
constexpr size_t WS_WIN = 1 * MiB;
constexpr size_t WS_WUQ = 6 * MiB;
constexpr size_t WS_WUKV = 6 * MiB + 512 * 1024;
constexpr size_t WS_WOUT = 7 * MiB;
constexpr size_t WS_WPQ = 9 * MiB;
constexpr size_t WS_SKB = 13 * MiB;
constexpr size_t WS_IDX = 16 * MiB;
constexpr size_t WS_GATE = 24 * MiB;
constexpr size_t WS_HN = 16 * MiB;
constexpr size_t WS_QKVR = 101 * MiB;
constexpr size_t WS_Z = 150 * MiB;
constexpr size_t WS_P32 = 167 * MiB;
constexpr size_t WS_GA = 16 * MiB;
constexpr size_t WS_GQ = 33 * MiB;
constexpr size_t WS_GS = 67 * MiB;
constexpr size_t WS_GB = 84 * MiB;
constexpr size_t WS_GO = 50 * MiB;
constexpr size_t WS_MIX = 167 * MiB;
constexpr size_t WS_CQN = 200 * MiB;
constexpr size_t WS_CKVN = 208 * MiB + 512 * 1024;
constexpr size_t WS_QH = 101 * MiB;
constexpr size_t WS_KVB = 167 * MiB;
constexpr size_t WS_Q = 125 * MiB + 512 * 1024;
constexpr size_t WS_K = 220 * MiB;
constexpr size_t WS_VT = 200 * MiB;
constexpr size_t WS_XN = 32 * MiB;
constexpr size_t WS_PQ = 64 * MiB;
constexpr size_t WS_SC = 128 * MiB;
constexpr size_t WS_EU = 96 * MiB;
constexpr size_t WS_EV = 112 * MiB;
constexpr size_t WS_CW = 64 * MiB;
constexpr size_t WS_HP = 128 * MiB;
constexpr size_t WS_KPE = 217 * MiB;
constexpr size_t WS_END = 256 * MiB;
constexpr int CW_ATTQ = 8192;

constexpr int LDS_BYTES = 147456;
constexpr int MISC_OFF = 131072 + 12288;

DI unsigned f2bf(float f) { unsigned u = __builtin_bit_cast(unsigned, f); return (u + 0x7fffu + ((u >> 16) & 1u)) >> 16; }
DI unsigned pk2(float lo, float hi) { return f2bf(lo) | (f2bf(hi) << 16); }
DI float bf2f(unsigned b) { return __builtin_bit_cast(float, b << 16); }
DI float bflo(unsigned w) { return __builtin_bit_cast(float, w << 16); }
DI float bfhi(unsigned w) { return __builtin_bit_cast(float, w & 0xffff0000u); }
DI float wave_sum(float v) {
#pragma unroll
    for (int o = 1; o < 64; o <<= 1) v += __shfl_xor(v, o);
    return v;
}
DI float sigmoidf_(float x) { return 1.f / (1.f + __expf(-x)); }
DI float siluf_(float x) { return x / (1.f + __expf(-x)); }

#define XB_TMO      128
#define XB_XCNT(j)  (256  + 64 * (j))
#define XB_XSUB(j)  (1280 + 64 * (j))
#define XB_XGEN(j)  (2304 + 64 * (j))
#define XB_TOP      3328
#define XB_TOPGEN   3392
#define XCD_BAR_WORDS 3456
#define XB_SPIN_CAP (1u << 22)
DI unsigned xb_ld(unsigned* p)              { return __hip_atomic_load(p, __ATOMIC_RELAXED, __HIP_MEMORY_SCOPE_AGENT); }
DI unsigned xb_add(unsigned* p, unsigned v) { return __hip_atomic_fetch_add(p, v, __ATOMIC_RELAXED, __HIP_MEMORY_SCOPE_AGENT); }
DI unsigned xb_xcc_id() { return (unsigned)__builtin_amdgcn_s_getreg((3 << 11) | 20) & 0xFu; }
#define XB_SPIN(cond, bar) do { unsigned _sp = 0; while (cond) { __builtin_amdgcn_s_sleep(1); \
    if ((++_sp & 255u) == 0u) { if (xb_ld(&(bar)[XB_TMO])) break; if (_sp > XB_SPIN_CAP) { atomicAdd(&(bar)[XB_TMO], 1u); break; } } } } while (0)
struct XcdBarrier { unsigned* bar; unsigned x; volatile LAS unsigned* st; };
DI XcdBarrier xcd_barrier_post(unsigned* bar, volatile LAS unsigned* st) {
    XcdBarrier b; b.bar = bar; b.x = xb_xcc_id(); b.st = st;
    if (threadIdx.x == 0) (void)xb_add(&bar[XB_XCNT(b.x)], 1u);
    return b;
}
DI void xcd_barrier_complete(unsigned* bar, unsigned x, unsigned& nloc, unsigned& nx) {
    const unsigned G = gridDim.x * gridDim.y * gridDim.z;
    unsigned sum, cnt, mine, sp = 0u;
    for (;;) {
        sum = 0u; cnt = 0u; mine = 0u;
#pragma unroll
        for (unsigned j = 0; j < 16; ++j) { const unsigned c = xb_ld(&bar[XB_XCNT(j)]); sum += c; cnt += (c > 0u) ? 1u : 0u; mine = (j == x) ? c : mine; }
        if (sum == G) break;
        __builtin_amdgcn_s_sleep(1);
        if ((++sp & 255u) == 0u) { if (xb_ld(&bar[XB_TMO])) break; if (sp > XB_SPIN_CAP) { atomicAdd(&bar[XB_TMO], 1u); break; } }
    }
    nloc = mine > 0u ? mine : 1u; nx = cnt > 0u ? cnt : 1u;
}
DI void xcd_barrier(const XcdBarrier& b) {
    asm volatile("s_waitcnt vmcnt(0)" ::: "memory");
    __syncthreads();
    if (threadIdx.x == 0) {
        unsigned* bar = b.bar;
        __builtin_amdgcn_s_waitcnt(0);
        unsigned nloc = b.st[0], nx = b.st[1];
        if (nloc == 0u) { xcd_barrier_complete(bar, b.x, nloc, nx); b.st[0] = nloc; b.st[1] = nx; }
        const unsigned old = xb_add(&bar[XB_XSUB(b.x)], 1u);
        const unsigned gen = old / nloc;
        if (old + 1u == (gen + 1u) * nloc) {
            __builtin_amdgcn_fence(__ATOMIC_RELEASE, "agent");
            asm volatile("s_waitcnt vmcnt(0)" ::: "memory");
            const unsigned og = xb_add(&bar[XB_TOP], 1u);
            const unsigned tg = og / nx;
            if (og + 1u == (tg + 1u) * nx) xb_add(&bar[XB_TOPGEN], 1u);
            else XB_SPIN(xb_ld(&bar[XB_TOPGEN]) == tg, bar);
            __builtin_amdgcn_fence(__ATOMIC_ACQUIRE, "agent");
            xb_add(&bar[XB_XGEN(b.x)], 1u);
            asm volatile("s_waitcnt vmcnt(0)" ::: "memory");
        } else {
            XB_SPIN(xb_ld(&bar[XB_XGEN(b.x)]) == gen, bar);
            __builtin_amdgcn_fence(__ATOMIC_ACQUIRE, "agent");
            asm volatile("s_waitcnt vmcnt(0)" ::: "memory");
        }
    }
    __syncthreads();
}

struct Args {
    const float* in[20];
    float* out; unsigned char* ws;
    int ph_lo, ph_hi;
};
struct Frame {
    unsigned char* lds;
    int tid, lane, wave, G, gw, NGW;
};

template <class Map>
DI void transpose_item(const float* __restrict__ W, int Nsrc, bf16_t* __restrict__ WT, int ldk, float* scr, int item, int nblk, int lane, Map srcmap) {
    const int kb = item / nblk, nb = item % nblk, k0 = 64 * kb, n0 = 32 * nb;
    const int ns = srcmap(n0 + (lane & 31));
#pragma unroll 8
    for (int i = 0; i < 32; ++i) { const int kk = 2 * i + (lane >> 5); scr[kk * 33 + (lane & 31)] = (ns >= 0) ? W[(size_t)(k0 + kk) * Nsrc + ns] : 0.f; }
    __builtin_amdgcn_s_waitcnt(0); __builtin_amdgcn_wave_barrier();
    const int c = lane & 7;
#pragma unroll
    for (int j = 0; j < 4; ++j) { const int n = (lane >> 3) + 8 * j; const float* s = scr + (8 * c) * 33 + n;
        u32x4 o; o.x = pk2(s[0 * 33], s[1 * 33]); o.y = pk2(s[2 * 33], s[3 * 33]); o.z = pk2(s[4 * 33], s[5 * 33]); o.w = pk2(s[6 * 33], s[7 * 33]);
        *(u32x4*)(WT + (size_t)(n0 + n) * ldk + k0 + 8 * c) = o; }
    __builtin_amdgcn_s_waitcnt(0); __builtin_amdgcn_wave_barrier();
}
struct MapId { DI int operator()(int n) const { return n; } };
struct MapWin {
    DI int operator()(int n) const {
        if (n < 2048) return n;
        if (n < 2304) return n + 16;
        if (n < 2432) return n + 16;
        if (n < 2464) return n + 16;
        if (n < 2472) return n - 416;
        if (n < 2480) return n - 416;
        return -1;
    }
};

template <int PART> DI void p0_late_weights(const Frame& F, const Args& A, int wi, int nwv, int ti, int nth) {
    unsigned char* ws = A.ws;
    float* scr = (float*)(F.lds + F.wave * 16384);
    const float* w_uq = A.in[10]; const float* w_ukv = A.in[11]; const float* w_out = A.in[14]; const float* w_pq = A.in[16]; const float* sub_keys = A.in[17];
    constexpr int I_UQ = 4 * 24, I_UKV = 2 * 32, I_OUT = 16 * 32, I_PQ = 16 * 64;
    constexpr int NITEMS = I_UQ + I_UKV + I_OUT + I_PQ;
    const int lo_ = PART == 0 ? 0 : I_UQ + I_UKV, hi_ = PART == 0 ? I_UQ + I_UKV : NITEMS;
    for (int it = lo_ + wi; it < hi_; it += nwv) {
        int r = it;
        if (r < I_UQ) { transpose_item(w_uq, 768, (bf16_t*)(ws + WS_WUQ), 256, scr, r, 24, F.lane, MapId()); continue; } r -= I_UQ;
        if (r < I_UKV) { transpose_item(w_ukv, 1024, (bf16_t*)(ws + WS_WUKV), 256, scr, r, 32, F.lane, MapId()); continue; } r -= I_UKV;
        if (r < I_OUT) { transpose_item(w_out, 1024, (bf16_t*)(ws + WS_WOUT), 1024, scr, r, 32, F.lane, MapId()); continue; } r -= I_OUT;
        transpose_item(w_pq, 2048, (bf16_t*)(ws + WS_WPQ), 1024, scr, r, 64, F.lane, MapId());
    }
    const int gt = ti, NGT = nth;
    if (PART == 0) for (int i = gt; i < 1024 * 16; i += NGT) { const int n = i >> 4, c = i & 15; *(u32x4*)((bf16_t*)(ws + WS_WUKV) + (size_t)n * 256 + 128 + c * 8) = (u32x4){0u, 0u, 0u, 0u}; }
    if (PART == 1) for (int i = gt; i < 2048 * 32; i += NGT) {
        const int n = i >> 5, c8 = (i & 31) * 8; const int p = (n >> 7) & 1;
        u32x4 o = (u32x4){0u, 0u, 0u, 0u};
        if ((c8 >> 7) == p) { const float* s = sub_keys + (size_t)n * 128 + (c8 & 127); const f32x4 a = *(const f32x4*)s, b = *(const f32x4*)(s + 4);
            o.x = pk2(a.x, a.y); o.y = pk2(a.z, a.w); o.z = pk2(b.x, b.y); o.w = pk2(b.z, b.w); }
        *(u32x4*)((bf16_t*)(ws + WS_SKB) + (size_t)n * 256 + c8) = o;
    }
}

DI void p0_prologue(const Frame& F, const Args& A) {
    unsigned char* ws = A.ws;
    float* scr = (float*)(F.lds + F.wave * 16384);
    const float* w_in = A.in[3]; const float* w_uq = A.in[10]; const float* w_ukv = A.in[11]; const float* w_out = A.in[14]; const float* w_pq = A.in[16]; const float* sub_keys = A.in[17];
    constexpr int I_IN = 16 * 80;
    for (int it = F.gw; it < I_IN; it += F.NGW) transpose_item(w_in, 2480, (bf16_t*)(ws + WS_WIN), 1024, scr, it, 80, F.lane, MapWin());
    const float* x = A.in[0]; const float* meta = A.in[1]; const float* anorm = A.in[2];
    bf16_t* HN = (bf16_t*)(ws + WS_HN);
    for (int p0 = F.gw; p0 < MP; p0 += 3 * F.NGW) {
        f32x4 v[3][4]; bool ok[3];
#pragma unroll
        for (int r = 0; r < 3; ++r) {
            const int p = p0 + r * F.NGW, t = p - PADL; ok[r] = (p < MP) && t >= 0 && t < NTOK;
            if (ok[r]) { const float* src = (t < 16) ? meta + (size_t)t * DM : x + (size_t)(t - 16) * DM; const f32x4* xr = (const f32x4*)src + F.lane;
#pragma unroll
                for (int j = 0; j < 4; ++j) v[r][j] = xr[64 * j]; }
            else {
#pragma unroll
                for (int j = 0; j < 4; ++j) v[r][j] = (f32x4){0.f, 0.f, 0.f, 0.f}; }
        }
#pragma unroll
        for (int r = 0; r < 3; ++r) {
            const int p = p0 + r * F.NGW; if (p >= MP) continue;
            unsigned long long* o8 = (unsigned long long*)(HN + (size_t)p * DM) + F.lane;
            float s = 0.f;
#pragma unroll
            for (int j = 0; j < 4; ++j) s += (v[r][j].x * v[r][j].x + v[r][j].y * v[r][j].y) + (v[r][j].z * v[r][j].z + v[r][j].w * v[r][j].w);
            const float rstd = ok[r] ? 1.f / sqrtf(wave_sum(s) * (1.f / DM) + EPS) : 0.f;
#pragma unroll
            for (int j = 0; j < 4; ++j) { const f32x4 w = ((const f32x4*)anorm)[64 * j + F.lane];
                o8[64 * j] = (unsigned long long)pk2(v[r][j].x * rstd * w.x, v[r][j].y * rstd * w.y) | ((unsigned long long)pk2(v[r][j].z * rstd * w.z, v[r][j].w * rstd * w.w) << 32); }
        }
    }
}

struct EpiProj {
    static constexpr bool PERM = true;
    bf16_t* QKVR; bf16_t* Z; float* P32;
    DI void operator()(const f32x4 (&acc)[2][2][4][2], const pg8::Unit& u, int wr, int wc, int fr, int fq) const {
        const int row0 = u.pm * 256 + wr * 64 + fr;
        if (u.pn < 8) {
            bf16_t* base; int ld, colt;
            if (u.pn < 6) { base = QKVR; ld = 1536; colt = u.pn * 256; } else { base = Z; ld = 512; colt = (u.pn - 6) * 256; }
            const int col0 = colt + wc * 32 + 8 * fq;
#pragma unroll
            for (int ai = 0; ai < 2; ++ai)
#pragma unroll
                for (int m = 0; m < 4; ++m) { bf16_t* rowp = base + (size_t)(row0 + ai * 128 + m * 16) * ld + col0;
#pragma unroll
                    for (int bj = 0; bj < 2; ++bj) { const f32x4 v0 = acc[ai][bj][m][0], v1 = acc[ai][bj][m][1];
                        u32x4 w; w.x = pg8::cvt_pk_bf16(v0[0], v0[1]); w.y = pg8::cvt_pk_bf16(v0[2], v0[3]); w.z = pg8::cvt_pk_bf16(v1[0], v1[1]); w.w = pg8::cvt_pk_bf16(v1[2], v1[3]);
                        *(u32x4*)(rowp + bj * 128) = w; } }
        } else {
            const int col0 = (u.pn - 8) * 256 + wc * 32 + 8 * fq;
#pragma unroll
            for (int ai = 0; ai < 2; ++ai)
#pragma unroll
                for (int m = 0; m < 4; ++m) { float* rowp = P32 + (size_t)(row0 + ai * 128 + m * 16) * 512 + col0;
#pragma unroll
                    for (int bj = 0; bj < 2; ++bj) { *(f32x4*)(rowp + bj * 128) = acc[ai][bj][m][0]; *(f32x4*)(rowp + bj * 128 + 4) = acc[ai][bj][m][1]; } }
        }
    }
};
struct EpiB16 {
    static constexpr bool PERM = true;
    bf16_t* O; int ldc;
    DI void operator()(const f32x4 (&acc)[2][2][4][2], const pg8::Unit& u, int wr, int wc, int fr, int fq) const {
        const int row0 = u.pm * 256 + wr * 64 + fr, col0 = u.pn * 256 + wc * 32 + 8 * fq;
#pragma unroll
        for (int ai = 0; ai < 2; ++ai)
#pragma unroll
            for (int m = 0; m < 4; ++m) { bf16_t* rowp = O + (size_t)(row0 + ai * 128 + m * 16) * ldc + col0;
#pragma unroll
                for (int bj = 0; bj < 2; ++bj) { const f32x4 v0 = acc[ai][bj][m][0], v1 = acc[ai][bj][m][1];
                    u32x4 w; w.x = pg8::cvt_pk_bf16(v0[0], v0[1]); w.y = pg8::cvt_pk_bf16(v0[2], v0[3]); w.z = pg8::cvt_pk_bf16(v1[0], v1[1]); w.w = pg8::cvt_pk_bf16(v1[2], v1[3]);
                    *(u32x4*)(rowp + bj * 128) = w; } }
    }
};
struct EpiF32 {
    static constexpr bool PERM = true;
    float* C; int ldc; const float* res;
    DI void operator()(const f32x4 (&acc)[2][2][4][2], const pg8::Unit& u, int wr, int wc, int fr, int fq) const {
        const int row0 = u.pm * 256 + wr * 64 + fr, col0 = u.pn * 256 + wc * 32 + 8 * fq;
#pragma unroll
        for (int ai = 0; ai < 2; ++ai)
#pragma unroll
            for (int m = 0; m < 4; ++m) { const size_t off = (size_t)(row0 + ai * 128 + m * 16) * ldc + col0;
#pragma unroll
                for (int bj = 0; bj < 2; ++bj) { f32x4 v0 = acc[ai][bj][m][0], v1 = acc[ai][bj][m][1];
                    if (res) { v0 += *(const f32x4*)(res + off + bj * 128); v1 += *(const f32x4*)(res + off + bj * 128 + 4); }
                    *(f32x4*)(C + off + bj * 128) = v0; *(f32x4*)(C + off + bj * 128 + 4) = v1; } }
    }
};

DI f32x16 mfma32(bf16x8 a, bf16x8 b, f32x16 c) { return __builtin_amdgcn_mfma_f32_32x32x16_bf16(a, b, c, 0, 0, 0); }
DI f32x4 mfma16(bf16x8 a, bf16x8 b, f32x4 c) { return __builtin_amdgcn_mfma_f32_16x16x32_bf16(a, b, c, 0, 0, 0); }
DI int crow(int r, int hi) { return (r & 3) + 8 * (r >> 2) + 4 * hi; }
DI f32x16 zero16() { f32x16 z;
#pragma unroll
    for (int i = 0; i < 16; ++i) z[i] = 0.f; return z; }

constexpr int G_KF = 0, G_VF = 16384, G_MF = 32768;
constexpr int G_QB = 50176, G_KB = 59392, G_KBB = 68608;
constexpr int G_QKB = 77824, G_UT = 87040, G_WT = 96256, G_KDT = 105472;
constexpr int G_VEC = 114688;
constexpr int G_RAW = G_QKB;
constexpr int GST = 72;

DI f32x16 mm_quad(const unsigned char* A, const unsigned char* Bt, int qr, int qc, int lane) {
    const int r32 = lane & 31, hh = lane >> 5;
    const unsigned char* ap = A + (32 * qr + r32) * (GST * 2) + hh * 16;
    const unsigned char* bp = Bt + (32 * qc + r32) * (GST * 2) + hh * 16;
    f32x16 acc = zero16();
#pragma unroll
    for (int s = 0; s < 4; ++s) acc = mfma32(*(const bf16x8*)(ap + s * 32), *(const bf16x8*)(bp + s * 32), acc);
    return acc;
}

constexpr int G_RAW2 = 115712;
static_assert(G_RAW2 + 67 * 400 <= 143360, "GDN prep LDS map");
constexpr int G_CONVW = 143360 + 512;

#ifndef PROBE_STAGE
#define PROBE_STAGE -1
#endif
template <int VAR> DI void gdn_prep_phase(const Frame& F, const Args& A) {
    unsigned long long stg_t = 0ull, stg_acc = 0ull;
#define STG(n) do { if (PROBE_STAGE >= 0) { const unsigned long long now_ = __builtin_amdgcn_s_memrealtime(); if (PROBE_STAGE == (n)) stg_acc += now_ - stg_t; stg_t = now_; } } while (0)
    unsigned char* ws = A.ws; unsigned char* lds = F.lds;
    const int tid = F.tid, lane = F.lane, wave = F.wave;
    const bf16_t* QKVR = (const bf16_t*)(ws + WS_QKVR); const float* P32 = (const float*)(ws + WS_P32);
    float* KF = (float*)(lds + G_KF); float* VF = (float*)(lds + G_VF); float* MF = (float*)(lds + G_MF);
    float* VEC = (float*)(lds + G_VEC);
    if (VAR == 6) return;
    const int NIT = NCHUNK * 8;
#define LBAR() do { asm volatile("s_waitcnt lgkmcnt(0)" ::: "memory"); __builtin_amdgcn_s_barrier(); asm volatile("" ::: "memory"); } while (0)
#define LAUNDER(dst, src) int dst = (src); asm volatile("" : "+v"(dst))
    int item = blockIdx.x;
    if (item >= NIT) return;
    u32x4 pr[4]; float nb = 0.f, na = 0.f;
    auto raw_fetch = [&](int it) {
        const int c = it >> 3, h = it & 7; LAUNDER(tl, tid);
#pragma unroll
        for (int i = 0; i < 4; ++i) { const int q = tl + 512 * i; pr[i] = (u32x4){0u, 0u, 0u, 0u};
            if (q < 67 * 24) { const int r = q / 24, cc = q % 24, seg = cc >> 3, c8 = cc & 7; const int p = 64 * c - 3 + r;
                if (p >= 0) pr[i] = *(const u32x4*)(QKVR + (size_t)p * 1536 + seg * 512 + h * 64 + c8 * 8); } }
        if (wave == 0) { const int p = 64 * c + lane; nb = P32[(size_t)p * 512 + 416 + h]; na = P32[(size_t)p * 512 + 424 + h]; }
    };
    auto raw_park = [&]() {
        LAUNDER(tl, tid);
#pragma unroll
        for (int i = 0; i < 4; ++i) { const int q = tl + 512 * i;
            if (q < 67 * 24) { const int r = q / 24, cc = q % 24, seg = cc >> 3, c8 = cc & 7; *(u32x4*)(lds + G_RAW2 + r * 400 + (seg * 64 + c8 * 8) * 2) = pr[i]; } }
    };
    raw_fetch(item); raw_park();
    float cb = nb, ca = na;
    float* CWL = (float*)(lds + G_CONVW);
    int cw_h = -1;
#pragma unroll 1
    for (; item < NIT; item += F.G) {
        if (PROBE_STAGE >= 0 && stg_t == 0ull) stg_t = __builtin_amdgcn_s_memrealtime();
        const int c = item >> 3, h = item & 7;
        if (h != cw_h) { cw_h = h;
            if (tid < 192) { LAUNDER(t0, tid); const int sg = t0 >> 6, jt = (t0 >> 4) & 3, c4 = t0 & 15; *(f32x4*)(CWL + (sg * 4 + jt) * 64 + 4 * c4) = *(const f32x4*)(A.in[4] + jt * 1536 + sg * 512 + h * 64 + 4 * c4); } }
        const int nxt = item + F.G;
        if (VAR != 5 && nxt < NIT) raw_fetch(nxt);
        if (wave == 0) {
            const int p = 64 * c + lane;
            const float alog = A.in[5][h], dtb = A.in[6][h];
            float beta = sigmoidf_(cb);
            const float xx = ca + dtb; const float sp = xx > 20.f ? xx : log1pf(__expf(xx));
            float g = -__expf(alog) * sp;
            if (p < PADL) { beta = 0.f; g = 0.f; }
            float gc = g;
#pragma unroll
            for (int o = 1; o < 64; o <<= 1) { const float t = __shfl_up(gc, o); if (lane >= o) gc += t; }
            const float glast = __shfl(gc, 63);
            VEC[lane] = gc; VEC[64 + lane] = beta; VEC[128 + lane] = __expf(gc); VEC[192 + lane] = __expf(glast - gc);
        }
        LBAR(); STG(0);
        LAUNDER(t1, tid); const int sub = t1 & 15, grp = t1 >> 4;
#pragma unroll
        for (int sg = 0; sg < ((VAR == 2 || VAR >= 4) ? 0 : 3); ++sg) {
#pragma unroll 1
            for (int ps = 0; ps < 2; ++ps) {
                const int i = grp + 32 * ps;
                float acc[4] = {0.f, 0.f, 0.f, 0.f};
#pragma unroll
                for (int jt = 0; jt < 4; ++jt) {
                    const f32x4 w = *(const f32x4*)(CWL + (sg * 4 + jt) * 64 + 4 * sub);
                    const u32x2 rv = *(const u32x2*)(lds + G_RAW2 + (i + jt) * 400 + (sg * 64 + 4 * sub) * 2);
                    acc[0] += w.x * bflo(rv.x); acc[1] += w.y * bfhi(rv.x); acc[2] += w.z * bflo(rv.y); acc[3] += w.w * bfhi(rv.y);
                }
                float y[4];
#pragma unroll
                for (int k = 0; k < 4; ++k) y[k] = siluf_(acc[k]);
                if (sg < 2) {
                    float ss = (y[0] * y[0] + y[1] * y[1]) + (y[2] * y[2] + y[3] * y[3]);
                    ss += __shfl_xor(ss, 1); ss += __shfl_xor(ss, 2); ss += __shfl_xor(ss, 4); ss += __shfl_xor(ss, 8);
                    const float rn = 1.f / sqrtf(ss + EPS);
#pragma unroll
                    for (int k = 0; k < 4; ++k) y[k] *= rn;
                }
                if (sg == 0) {
                    u32x2 o; o.x = pk2(y[0] * 0.125f, y[1] * 0.125f); o.y = pk2(y[2] * 0.125f, y[3] * 0.125f);
                    *(u32x2*)(lds + G_QB + i * (GST * 2) + 8 * sub) = o;
                } else if (sg == 1) {
                    const float beta = VEC[64 + i], ekd = VEC[192 + i];
                    *(f32x4*)(KF + i * 64 + 4 * sub) = (f32x4){y[0], y[1], y[2], y[3]};
                    u32x2 o; o.x = pk2(y[0], y[1]); o.y = pk2(y[2], y[3]);
                    *(u32x2*)(lds + G_KB + i * (GST * 2) + 8 * sub) = o;
                    o.x = pk2(y[0] * beta, y[1] * beta); o.y = pk2(y[2] * beta, y[3] * beta);
                    *(u32x2*)(lds + G_KBB + i * (GST * 2) + 8 * sub) = o;
#pragma unroll
                    for (int k = 0; k < 4; ++k) *(bf16_t*)(lds + G_KDT + (4 * sub + k) * (GST * 2) + i * 2) = (bf16_t)f2bf(y[k] * ekd);
                } else {
                    *(f32x4*)(VF + i * 64 + 4 * sub) = (f32x4){y[0], y[1], y[2], y[3]};
                }
            }
        }
        LBAR(); STG(1);
        if (VAR != 3 && VAR < 4) {
            LAUNDER(l3, lane);
            const int prod = wave >> 2, quad = wave & 3, qr = quad >> 1, qc = quad & 1, r32 = l3 & 31, hh = l3 >> 5;
            const f32x16 acc = mm_quad(lds + (prod ? G_QB : G_KBB), lds + G_KB, qr, qc, l3);
            const int j = 32 * qc + r32; const float gcj = VEC[j];
#pragma unroll
            for (int r = 0; r < 16; ++r) {
                const int i = 32 * qr + crow(r, hh);
                if (prod == 0) { MF[i * 68 + j] = (j < i) ? acc[r] * __expf(VEC[i] - gcj) : 0.f; }
                else { *(bf16_t*)(lds + G_QKB + i * (GST * 2) + j * 2) = (bf16_t)f2bf((j <= i) ? acc[r] * __expf(VEC[i] - gcj) : 0.f); }
            }
        }
        LBAR(); STG(2);
        float* DB = (float*)(lds + G_KBB);
        if (VAR != 1 && VAR < 4 && wave == 0) {
            LAUNDER(l4, lane); const int b = l4 >> 4, jc = l4 & 15;
            float d[16];
#pragma unroll
            for (int i = 0; i < 16; ++i) {
                float acc = (i == jc) ? 1.f : 0.f;
                const float* mrow = MF + (16 * b + i) * 68 + 16 * b;
#pragma unroll
                for (int k = 0; k < i; ++k) acc -= mrow[k] * d[k];
                d[i] = acc;
            }
#pragma unroll
            for (int i = 0; i < 16; ++i) DB[(b * 16 + i) * 20 + jc] = d[i];
        }
        LBAR();
        if (VAR != 1 && VAR < 4) {
            LAUNDER(l4, lane); const int cc = l4 & 15, g = l4 >> 4;
            const bool isU = wave < 4; const int col = 16 * (wave & 3) + cc;
            const float* src = (isU ? VF : KF) + col;
            f32x4 X[4];
#pragma unroll
            for (int b = 0; b < 4; ++b) {
                f32x4 acc;
#pragma unroll
                for (int r = 0; r < 4; ++r) { const int i = 16 * b + 4 * g + r; float rv = src[i * 64] * VEC[64 + i]; if (!isU) rv *= VEC[128 + i]; acc[r] = -rv; }
#pragma unroll
                for (int a = 0; a < b; ++a) {
                    const f32x4 lv = *(const f32x4*)(MF + (16 * b + cc) * 68 + 16 * a + 4 * g);
#pragma unroll
                    for (int sp = 0; sp < 4; ++sp) acc = __builtin_amdgcn_mfma_f32_16x16x4f32(lv[sp], X[a][sp], acc, 0, 0, 0);
                }
                const f32x4 dv = *(const f32x4*)(DB + (b * 16 + cc) * 20 + 4 * g);
                f32x4 xb = (f32x4){0.f, 0.f, 0.f, 0.f};
#pragma unroll
                for (int sp = 0; sp < 4; ++sp) xb = __builtin_amdgcn_mfma_f32_16x16x4f32(dv[sp], acc[sp], xb, 0, 0, 0);
                X[b] = -xb;
                unsigned char* dst = lds + (isU ? G_UT : G_WT) + col * (GST * 2) + (16 * b + 4 * g) * 2;
                *(u32x2*)dst = (u32x2){pk2(X[b][0], X[b][1]), pk2(X[b][2], X[b][3])};
            }
        }
        LBAR(); STG(3);
        if (VAR != 3 && VAR < 4) {
            const float gl = VEC[128 + 63];
            bf16_t* GB = (bf16_t*)(ws + WS_GB) + (size_t)item * 4096;
            bf16_t* GQ = (bf16_t*)(ws + (VAR ? WS_GS : WS_GQ)) + (size_t)item * 4096; bf16_t* GO = (bf16_t*)(ws + (VAR ? WS_GS : WS_GO)) + (size_t)item * 4096;
            bf16_t* GAL = (bf16_t*)(lds + G_MF);
            LAUNDER(l5, lane); const int r32 = l5 & 31, hh = l5 >> 5;
#pragma unroll 1
            for (int it = 0; it < 2; ++it) {
                const int task = wave + 8 * it, prod = task >> 2, quad = task & 3, qr = quad >> 1, qc = quad & 1;
                const f32x16 acc = mm_quad(lds + (prod < 2 ? G_KDT : G_QKB), lds + ((prod & 1) ? G_UT : G_WT), qr, qc, l5);
                const int Cc = 32 * qc + r32;
                if (prod == 0) {
#pragma unroll
                    for (int r = 0; r < 16; ++r) {
                        const int R = 32 * qr + crow(r, hh);
                        const float val = ((R == Cc) ? gl : 0.f) - acc[r];
                        const int rb = R >> 4, m = R & 15, q4 = Cc >> 4, g = (Cc >> 2) & 3, rr = Cc & 3, ks = q4 >> 1, jj = 4 * (q4 & 1) + rr, ls = 16 * g + m;
                        GAL[((rb * 2 + ks) * 64 + ls) * 8 + jj] = (bf16_t)f2bf(val);
                    }
                } else if (prod == 1) {
                    const int eslab = Cc >> 4, n = Cc & 15;
#pragma unroll
                    for (int a = 0; a < 4; ++a) {
                        const int R0 = 32 * qr + 8 * a + 4 * hh; const int rb = R0 >> 4, g = (R0 >> 2) & 3, ls = 16 * g + n;
                        *(u32x2*)(GB + ((eslab * 4 + rb) * 64 + ls) * 4) = (u32x2){pk2(acc[4 * a], acc[4 * a + 1]), pk2(acc[4 * a + 2], acc[4 * a + 3])};
                    }
                } else if (prod == 2) {
#pragma unroll
                    for (int r = 0; r < 16; ++r) {
                        const int R = 32 * qr + crow(r, hh);
                        const float qv = bf2f(*(const bf16_t*)(lds + G_QB + R * (GST * 2) + Cc * 2));
                        GQ[R * 64 + Cc] = (bf16_t)f2bf(qv * VEC[128 + R] - acc[r]);
                    }
                } else {
#pragma unroll
                    for (int r = 0; r < 16; ++r) GO[(quad * 16 + r) * 64 + l5] = (bf16_t)f2bf(acc[r]);
                }
            }
        }
        if (VAR != 5 && nxt < NIT) { raw_park(); cb = nb; ca = na; }
        LBAR(); STG(4);
        if (VAR != 5) { LAUNDER(t6, tid); *(u32x4*)((bf16_t*)(ws + (VAR ? WS_GS : WS_GA)) + (size_t)item * 4096 + t6 * 8) = *(const u32x4*)(lds + G_MF + t6 * 16); }
        STG(5);
    }
    if (PROBE_STAGE >= 0 && tid == 0) { *(unsigned long long*)(lds + 143360 + 96) = stg_acc; }
}

constexpr int SC_D = 8, SC_PD = 6, SC_SLOT = 10240;
DI void gdn_scan(const Frame& F, const Args& A) {
    if (blockIdx.x >= 32) return;
    unsigned char* ws = A.ws;
    const int h = blockIdx.x & 7, eslab = blockIdx.x >> 3, lane = F.lane, wave = F.wave, n = lane & 15, g = lane >> 4;
    const unsigned char* GA = ws + WS_GA; const unsigned char* GB = ws + WS_GB; bf16_t* GS = (bf16_t*)(ws + WS_GS);
    LAS unsigned char* ring = (LAS unsigned char*)F.lds;
    const int np = (wave == 0) ? 0 : ((wave - 1 < 3) ? 2 : 1);
    auto issue = [&](int c) {
        const int cc = c < NCHUNK ? c : NCHUNK - 1;
        const size_t item = (size_t)cc * 8 + h;
        LAS unsigned char* slot = ring + (c % SC_D) * SC_SLOT;
#pragma unroll
        for (int i = 0; i < 2; ++i) if (i < np) {
            const int q = (wave - 1) + 7 * i;
            const unsigned char* src = (q < 8) ? GA + item * 8192 + q * 1024 : GB + item * 8192 + eslab * 2048 + (q - 8) * 1024;
            LAS unsigned char* dst = slot + ((q < 8) ? q * 1024 : 8192 + (q - 8) * 1024);
            __builtin_amdgcn_global_load_lds((const unsigned*)(src + lane * 16), (LAS unsigned*)dst, 16, 0, 0);
        }
    };
    for (int c = 0; c < SC_PD; ++c) issue(c);
    f32x4 S[4];
#pragma unroll
    for (int rb = 0; rb < 4; ++rb) S[rb] = (f32x4){0.f, 0.f, 0.f, 0.f};
#pragma unroll 1
    for (int c = 0; c < NCHUNK; ++c) {
        issue(c + SC_PD);
        if (np == 2) asm volatile("s_waitcnt vmcnt(12)" ::: "memory");
        else if (np == 1) asm volatile("s_waitcnt vmcnt(6)" ::: "memory");
        asm volatile("s_waitcnt lgkmcnt(0)" ::: "memory");
        __builtin_amdgcn_s_barrier();
        asm volatile("" ::: "memory");
        if (wave == 0) {
            const LAS unsigned char* slot = ring + (c % SC_D) * SC_SLOT;
            bf16x8 ac[8]; f32x4 bc[4];
#pragma unroll
            for (int q = 0; q < 8; ++q) ac[q] = *(const LAS bf16x8*)(slot + q * 1024 + lane * 16);
#pragma unroll
            for (int rb = 0; rb < 4; ++rb) { const u32x2 w = *(const LAS u32x2*)(slot + 8192 + rb * 512 + lane * 8); bc[rb] = (f32x4){bflo(w.x), bfhi(w.x), bflo(w.y), bfhi(w.y)}; }
            const size_t item = (size_t)c * 8 + h;
            u32x4 p0, p1;
            p0.x = pk2(S[0][0], S[0][1]); p0.y = pk2(S[0][2], S[0][3]); p0.z = pk2(S[1][0], S[1][1]); p0.w = pk2(S[1][2], S[1][3]);
            p1.x = pk2(S[2][0], S[2][1]); p1.y = pk2(S[2][2], S[2][3]); p1.z = pk2(S[3][0], S[3][1]); p1.w = pk2(S[3][2], S[3][3]);
            {
                bf16_t* st = GS + item * 4096 + (16 * eslab + n) * 64 + 4 * g;
                *(u32x2*)(st + 0) = (u32x2){p0.x, p0.y}; *(u32x2*)(st + 16) = (u32x2){p0.z, p0.w};
                *(u32x2*)(st + 32) = (u32x2){p1.x, p1.y}; *(u32x2*)(st + 48) = (u32x2){p1.z, p1.w};
            }
            const bf16x8 b0 = __builtin_bit_cast(bf16x8, p0), b1 = __builtin_bit_cast(bf16x8, p1);
#pragma unroll
            for (int rb = 0; rb < 4; ++rb) {
                f32x4 acc = bc[rb];
                acc = mfma16(ac[rb * 2 + 0], b0, acc);
                acc = mfma16(ac[rb * 2 + 1], b1, acc);
                S[rb] = acc;
            }
        }
    }
    asm volatile("s_waitcnt vmcnt(0) lgkmcnt(0)" ::: "memory");
    __builtin_amdgcn_s_barrier();
}

DI void gdn_out_task(const Frame& F, const Args& A, int task) {
    unsigned char* ws = A.ws;
    const int ihalf = task & 1, item = (task >> 1) + 8, c = item >> 3, h = item & 7, lane = F.lane, r32 = lane & 31, hh = lane >> 5;
    const bf16_t* GQ = (const bf16_t*)(ws + WS_GQ) + (size_t)item * 4096; const bf16_t* GS = (const bf16_t*)(ws + WS_GS) + (size_t)item * 4096;
    const bf16_t* GO = (const bf16_t*)(ws + WS_GO) + (size_t)item * 4096;
    const bf16_t* Z = (const bf16_t*)(ws + WS_Z); bf16_t* MIX = (bf16_t*)(ws + WS_MIX);
    f32x16 acc[2];
#pragma unroll
    for (int eh = 0; eh < 2; ++eh)
#pragma unroll
        for (int r = 0; r < 16; ++r) acc[eh][r] = bf2f(GO[((ihalf * 2 + eh) * 16 + r) * 64 + lane]);
#pragma unroll
    for (int s = 0; s < 4; ++s) {
        const bf16x8 a = *(const bf16x8*)(GQ + (32 * ihalf + r32) * 64 + 16 * s + 8 * hh);
#pragma unroll
        for (int eh = 0; eh < 2; ++eh) {
            const bf16x8 b = *(const bf16x8*)(GS + (32 * eh + r32) * 64 + 16 * s + 8 * hh);
            acc[eh] = mfma32(a, b, acc[eh]);
        }
    }
    const float* gnorm = A.in[7];
    const float w0 = gnorm[r32], w1 = gnorm[32 + r32];
#pragma unroll
    for (int r = 0; r < 16; ++r) {
        float ss = acc[0][r] * acc[0][r] + acc[1][r] * acc[1][r];
        ss += __shfl_xor(ss, 1); ss += __shfl_xor(ss, 2); ss += __shfl_xor(ss, 4); ss += __shfl_xor(ss, 8); ss += __shfl_xor(ss, 16);
        const float rstd = 1.f / sqrtf(ss * (1.f / 64.f) + EPS);
        const int i = 32 * ihalf + crow(r, hh); const int p = 64 * c + i;
        const float z0 = bf2f(Z[(size_t)p * 512 + h * 64 + r32]), z1 = bf2f(Z[(size_t)p * 512 + h * 64 + 32 + r32]);
        bf16_t* o = MIX + (size_t)(p - 64) * 1024 + h * 64;
        o[r32] = (bf16_t)f2bf(acc[0][r] * rstd * w0 * siluf_(z0));
        o[32 + r32] = (bf16_t)f2bf(acc[1][r] * rstd * w1 * siluf_(z1));
    }
}

DI void mla_prep1_rows(const Frame& F, const Args& A, int p0, int stride) {
    unsigned char* ws = A.ws; const int lane = F.lane;
    f32x4 q[4]; float k0[4], k1[4], pe[4];
#pragma unroll
    for (int r = 0; r < 4; ++r) { const int p = p0 + r * stride; const int pc = p < MP ? p : MP - 1;
        const float* P32 = (const float*)(ws + WS_P32) + (size_t)pc * 512;
        q[r] = *(const f32x4*)(P32 + 4 * lane); k0[r] = P32[256 + 2 * lane]; k1[r] = P32[256 + 2 * lane + 1]; pe[r] = P32[384 + (lane & 31)]; }
    const f32x4 wq = *(const f32x4*)(A.in[8] + 4 * lane);
    const float wk0 = A.in[9][2 * lane], wk1 = A.in[9][2 * lane + 1];
#pragma unroll
    for (int r = 0; r < 4; ++r) {
        const int p = p0 + r * stride; if (p >= MP) continue;
        bf16_t* CQN = (bf16_t*)(ws + WS_CQN) + (size_t)p * 256; bf16_t* CKVN = (bf16_t*)(ws + WS_CKVN) + (size_t)p * 256;
        const float sq = wave_sum((q[r].x * q[r].x + q[r].y * q[r].y) + (q[r].z * q[r].z + q[r].w * q[r].w));
        const float rq = 1.f / sqrtf(sq * (1.f / 256.f) + EPS);
        *(u32x2*)(CQN + 4 * lane) = (u32x2){pk2(q[r].x * rq * wq.x, q[r].y * rq * wq.y), pk2(q[r].z * rq * wq.z, q[r].w * rq * wq.w)};
        const float sk = wave_sum(k0[r] * k0[r] + k1[r] * k1[r]);
        const float rk = 1.f / sqrtf(sk * (1.f / 128.f) + EPS);
        *(unsigned*)(CKVN + 2 * lane) = pk2(k0[r] * rk * wk0, k1[r] * rk * wk1);
        *(unsigned*)(CKVN + 128 + 2 * lane) = 0u;
        if (lane < 32) ((float*)(ws + WS_KPE))[(size_t)p * 32 + lane] = pe[r];
    }
}

constexpr float QSCALE = 0.10206207261596577f * 1.4426950408889634f;
DI double rope_inv_rev(int i) {
    const double t8[8] = {0.15915494309189535, 0.08949940160889101, 0.050329212104487035, 0.0283021958306234, 0.015915494309189534, 0.008949940160889102, 0.005032921210448704, 0.00283021958306234};
    double v = t8[0];
#pragma unroll
    for (int k = 1; k < 8; ++k) v = ((i & 7) == k) ? t8[k] : v;
    return (i & 8) ? v * 0.01 : v;
}
constexpr int P2_TS = 136;
DI void mla_prep2_task(const Frame& F, const Args& A, int task) {
    unsigned char* ws = A.ws; const int lane = F.lane, h = task & 7, blk = task >> 3;
    const int p = 64 * blk + lane;
    const bool valid = (p >= PADL) && (p < LPV);
    const float* qn = A.in[12]; const float* kn = A.in[13];
    float sn[16], cs[16];
    { const double pos = (double)(p - PADL);
#pragma unroll
      for (int i = 0; i < 16; ++i) { const double rev = pos * rope_inv_rev(i); const float fr = (float)(rev - floor(rev)); sn[i] = __builtin_amdgcn_sinf(fr); cs[i] = __builtin_amdgcn_cosf(fr); } }
    {
        const bf16_t* src = (const bf16_t*)(ws + WS_QH) + (size_t)p * 768 + h * 96;
        u32x4 w[12];
#pragma unroll
        for (int c = 0; c < 12; ++c) w[c] = *(const u32x4*)(src + 8 * c);
        float ss = 0.f;
#pragma unroll
        for (int c = 0; c < 12; ++c) { const float a0 = bflo(w[c].x), a1 = bfhi(w[c].x), a2 = bflo(w[c].y), a3 = bfhi(w[c].y), a4 = bflo(w[c].z), a5 = bfhi(w[c].z), a6 = bflo(w[c].w), a7 = bfhi(w[c].w);
            ss += (a0 * a0 + a1 * a1) + (a2 * a2 + a3 * a3) + (a4 * a4 + a5 * a5) + (a6 * a6 + a7 * a7); }
        const float rs = valid ? QSCALE / sqrtf(ss * (1.f / 96.f) + EPS) : 0.f;
        bf16_t* dst = (bf16_t*)(ws + WS_Q) + ((size_t)h * KVROWS + p) * 96;
#pragma unroll
        for (int c = 0; c < 8; ++c) {
            const f32x4 g0 = *(const f32x4*)(qn + 8 * c), g1 = *(const f32x4*)(qn + 8 * c + 4);
            *(u32x4*)(dst + 8 * c) = (u32x4){pk2(bflo(w[c].x) * rs * g0.x, bfhi(w[c].x) * rs * g0.y), pk2(bflo(w[c].y) * rs * g0.z, bfhi(w[c].y) * rs * g0.w),
                                             pk2(bflo(w[c].z) * rs * g1.x, bfhi(w[c].z) * rs * g1.y), pk2(bflo(w[c].w) * rs * g1.z, bfhi(w[c].w) * rs * g1.w)};
        }
#pragma unroll
        for (int c = 0; c < 2; ++c) {
            float x1[8], x2[8];
            const u32x4 wa = w[8 + c], wb = w[10 + c];
            x1[0] = bflo(wa.x); x1[1] = bfhi(wa.x); x1[2] = bflo(wa.y); x1[3] = bfhi(wa.y); x1[4] = bflo(wa.z); x1[5] = bfhi(wa.z); x1[6] = bflo(wa.w); x1[7] = bfhi(wa.w);
            x2[0] = bflo(wb.x); x2[1] = bfhi(wb.x); x2[2] = bflo(wb.y); x2[3] = bfhi(wb.y); x2[4] = bflo(wb.z); x2[5] = bfhi(wb.z); x2[6] = bflo(wb.w); x2[7] = bfhi(wb.w);
            float o1[8], o2[8];
#pragma unroll
            for (int t = 0; t < 8; ++t) { const float a = x1[t] * rs * qn[64 + 8 * c + t], b = x2[t] * rs * qn[80 + 8 * c + t]; o1[t] = a * cs[8 * c + t] - b * sn[8 * c + t]; o2[t] = b * cs[8 * c + t] + a * sn[8 * c + t]; }
            *(u32x4*)(dst + 64 + 8 * c) = (u32x4){pk2(o1[0], o1[1]), pk2(o1[2], o1[3]), pk2(o1[4], o1[5]), pk2(o1[6], o1[7])};
            *(u32x4*)(dst + 80 + 8 * c) = (u32x4){pk2(o2[0], o2[1]), pk2(o2[2], o2[3]), pk2(o2[4], o2[5]), pk2(o2[6], o2[7])};
        }
    }
    {
        const bf16_t* src = (const bf16_t*)(ws + WS_KVB) + (size_t)p * 1024 + h * 128;
        const float* kpe = (const float*)(ws + WS_KPE) + (size_t)p * 32;
        u32x4 w[8]; f32x4 e[8];
#pragma unroll
        for (int c = 0; c < 8; ++c) { w[c] = *(const u32x4*)(src + 8 * c); e[c] = *(const f32x4*)(kpe + 4 * c); }
        float ss = 0.f;
#pragma unroll
        for (int c = 0; c < 8; ++c) { const float a0 = bflo(w[c].x), a1 = bfhi(w[c].x), a2 = bflo(w[c].y), a3 = bfhi(w[c].y), a4 = bflo(w[c].z), a5 = bfhi(w[c].z), a6 = bflo(w[c].w), a7 = bfhi(w[c].w);
            ss += (a0 * a0 + a1 * a1) + (a2 * a2 + a3 * a3) + (a4 * a4 + a5 * a5) + (a6 * a6 + a7 * a7);
            ss += (e[c].x * e[c].x + e[c].y * e[c].y) + (e[c].z * e[c].z + e[c].w * e[c].w); }
        const float rs = valid ? 1.f / sqrtf(ss * (1.f / 96.f) + EPS) : 0.f;
        bf16_t* dst = (bf16_t*)(ws + WS_K) + ((size_t)h * KVROWS + p) * 96;
#pragma unroll
        for (int c = 0; c < 8; ++c) {
            const f32x4 g0 = *(const f32x4*)(kn + 8 * c), g1 = *(const f32x4*)(kn + 8 * c + 4);
            *(u32x4*)(dst + 8 * c) = (u32x4){pk2(bflo(w[c].x) * rs * g0.x, bfhi(w[c].x) * rs * g0.y), pk2(bflo(w[c].y) * rs * g0.z, bfhi(w[c].y) * rs * g0.w),
                                             pk2(bflo(w[c].z) * rs * g1.x, bfhi(w[c].z) * rs * g1.y), pk2(bflo(w[c].w) * rs * g1.z, bfhi(w[c].w) * rs * g1.w)};
        }
#pragma unroll
        for (int c = 0; c < 2; ++c) {
            const float x1[8] = {e[2 * c].x, e[2 * c].y, e[2 * c].z, e[2 * c].w, e[2 * c + 1].x, e[2 * c + 1].y, e[2 * c + 1].z, e[2 * c + 1].w};
            const float x2[8] = {e[4 + 2 * c].x, e[4 + 2 * c].y, e[4 + 2 * c].z, e[4 + 2 * c].w, e[5 + 2 * c].x, e[5 + 2 * c].y, e[5 + 2 * c].z, e[5 + 2 * c].w};
            float o1[8], o2[8];
#pragma unroll
            for (int t = 0; t < 8; ++t) { const float a = x1[t] * rs * kn[64 + 8 * c + t], b = x2[t] * rs * kn[80 + 8 * c + t]; o1[t] = a * cs[8 * c + t] - b * sn[8 * c + t]; o2[t] = b * cs[8 * c + t] + a * sn[8 * c + t]; }
            *(u32x4*)(dst + 64 + 8 * c) = (u32x4){pk2(o1[0], o1[1]), pk2(o1[2], o1[3]), pk2(o1[4], o1[5]), pk2(o1[6], o1[7])};
            *(u32x4*)(dst + 80 + 8 * c) = (u32x4){pk2(o2[0], o2[1]), pk2(o2[2], o2[3]), pk2(o2[4], o2[5]), pk2(o2[6], o2[7])};
        }
    }
    {
        unsigned char* T = F.lds + F.wave * (64 * P2_TS);
        const bf16_t* src = (const bf16_t*)(ws + WS_KVB) + h * 128 + 64;
#pragma unroll
        for (int it = 0; it < 8; ++it) {
            const int pr = 8 * it + (lane >> 3), ch = lane & 7; const int pp = 64 * blk + pr;
            u32x4 v = (u32x4){0u, 0u, 0u, 0u};
            if (pp >= PADL && pp < LPV) v = *(const u32x4*)(src + (size_t)pp * 1024 + 8 * ch);
            unsigned char* tp = T + (8 * ch) * P2_TS + pr * 2;
            *(bf16_t*)(tp + 0 * P2_TS) = (bf16_t)(v.x & 0xffffu); *(bf16_t*)(tp + 1 * P2_TS) = (bf16_t)(v.x >> 16);
            *(bf16_t*)(tp + 2 * P2_TS) = (bf16_t)(v.y & 0xffffu); *(bf16_t*)(tp + 3 * P2_TS) = (bf16_t)(v.y >> 16);
            *(bf16_t*)(tp + 4 * P2_TS) = (bf16_t)(v.z & 0xffffu); *(bf16_t*)(tp + 5 * P2_TS) = (bf16_t)(v.z >> 16);
            *(bf16_t*)(tp + 6 * P2_TS) = (bf16_t)(v.w & 0xffffu); *(bf16_t*)(tp + 7 * P2_TS) = (bf16_t)(v.w >> 16);
        }
        __builtin_amdgcn_s_waitcnt(0); __builtin_amdgcn_wave_barrier();
        bf16_t* VT = (bf16_t*)(ws + WS_VT) + (size_t)h * 64 * KVROWS + 64 * blk;
#pragma unroll
        for (int it = 0; it < 8; ++it) {
            const int e = 8 * it + (lane >> 3), ch = lane & 7;
            const u32x2 lo = *(const u32x2*)(T + e * P2_TS + 16 * ch), hi = *(const u32x2*)(T + e * P2_TS + 16 * ch + 8);
            *(u32x4*)(VT + (size_t)e * KVROWS + 8 * ch) = (u32x4){lo.x, lo.y, hi.x, hi.y};
        }
        __builtin_amdgcn_s_waitcnt(0); __builtin_amdgcn_wave_barrier();
    }
}

constexpr int A_KSTR = 208;
constexpr int A_VSTR = 136;
constexpr int A_KBYTES = 64 * A_KSTR;
constexpr int A_VBYTES = 64 * A_VSTR;
constexpr int A_BUF = A_KBYTES + A_VBYTES;
DI unsigned cvtpk_s(float lo, float hi) { typedef float f2 __attribute__((ext_vector_type(2))); typedef __bf16 b2 __attribute__((ext_vector_type(2))); f2 v = {lo, hi}; b2 b = __builtin_convertvector(v, b2); return __builtin_bit_cast(unsigned, b); }

DI void attn_item(const Frame& F, const Args& A, int h, int qb) {
    unsigned char* ws = A.ws; unsigned char* lds = F.lds;
    const int tid = F.tid, lane = F.lane, wave = F.wave, r32 = lane & 31, hh = lane >> 5;
    const bf16_t* Qg = (const bf16_t*)(ws + WS_Q) + (size_t)h * KVROWS * 96;
    const bf16_t* Kg = (const bf16_t*)(ws + WS_K) + (size_t)h * KVROWS * 96;
    const bf16_t* Vg = (const bf16_t*)(ws + WS_VT) + (size_t)h * 64 * KVROWS;
    const int p0w = 64 + 256 * qb + 32 * wave;
    const int qp = p0w + r32;
    const int ntile = 4 * qb + 5;
    const int mylast = 1 + 4 * qb + (wave >> 1);
    bf16x8 qf[6];
#pragma unroll
    for (int s = 0; s < 6; ++s) qf[s] = *(const bf16x8*)(Qg + (size_t)qp * 96 + 16 * s + 8 * hh);
    f32x16 ot[2]; ot[0] = zero16(); ot[1] = zero16();
    float mrun = -1e30f, lrun = 0.f;
    const int kr0 = tid / 12, kc0 = tid % 12, kr1 = (tid + 512) / 12, kc1 = (tid + 512) % 12; const bool k1ok = tid < 256;
    const int vr = tid >> 3, vc = tid & 7;
    struct Stg { u32x4 k0, k1, v; };
    Stg sA, sB;
    auto gload = [&](Stg& st, int j) {
        const int kv0 = 64 * j;
        st.k0 = *(const u32x4*)(Kg + (size_t)(kv0 + kr0) * 96 + kc0 * 8);
        if (k1ok) st.k1 = *(const u32x4*)(Kg + (size_t)(kv0 + kr1) * 96 + kc1 * 8);
        st.v = *(const u32x4*)(Vg + (size_t)vr * KVROWS + kv0 + vc * 8);
    };
    auto lstore = [&](const Stg& st, int b) {
        unsigned char* kb = lds + b * A_BUF; unsigned char* vb = kb + A_KBYTES;
        *(u32x4*)(kb + kr0 * A_KSTR + kc0 * 16) = st.k0;
        if (k1ok) *(u32x4*)(kb + kr1 * A_KSTR + kc1 * 16) = st.k1;
        *(u32x2*)(vb + vr * A_VSTR + vc * 16) = (u32x2){st.v.x, st.v.y};
        *(u32x2*)(vb + vr * A_VSTR + vc * 16 + 8) = (u32x2){st.v.z, st.v.w};
    };
    gload(sA, 0); lstore(sA, 0); gload(sB, 1);
    __syncthreads();
    auto step = [&](int j, Stg& sNext  , Stg& sFree  ) {
        const int b = j & 1;
        if (j + 2 < ntile) gload(sFree, j + 2);
        if (j <= mylast) {
            const unsigned char* kb = lds + b * A_BUF; const unsigned char* vb = kb + A_KBYTES;
            f32x16 sc[2];
#pragma unroll
            for (int kh = 0; kh < 2; ++kh) {
                f32x16 acc = zero16();
                const unsigned char* kp = kb + (32 * kh + r32) * A_KSTR + hh * 16;
#pragma unroll
                for (int s = 0; s < 6; ++s) acc = mfma32(*(const bf16x8*)(kp + s * 32), qf[s], acc);
                sc[kh] = acc;
            }
            if (j == 0) {
#pragma unroll
                for (int kh = 0; kh < 2; ++kh)
#pragma unroll
                    for (int r = 0; r < 16; ++r) { const int kv = 32 * kh + crow(r, hh); if (kv < PADL) sc[kh][r] = -INFINITY; }
            }
            if (j == mylast) {
#pragma unroll
                for (int kh = 0; kh < 2; ++kh)
#pragma unroll
                    for (int r = 0; r < 16; ++r) { const int kv = 64 * j + 32 * kh + crow(r, hh); if (kv > qp) sc[kh][r] = -INFINITY; }
            }
            float mx = sc[0][0];
#pragma unroll
            for (int r = 1; r < 16; ++r) mx = fmaxf(mx, sc[0][r]);
#pragma unroll
            for (int r = 0; r < 16; ++r) mx = fmaxf(mx, sc[1][r]);
            mx = fmaxf(mx, __shfl_xor(mx, 32));
            const float mnew = fmaxf(mrun, mx);
            const float alpha = __builtin_amdgcn_exp2f(mrun - mnew);
            mrun = mnew;
            float ps = 0.f;
#pragma unroll
            for (int kh = 0; kh < 2; ++kh)
#pragma unroll
                for (int r = 0; r < 16; ++r) { const float e = __builtin_amdgcn_exp2f(sc[kh][r] - mnew); sc[kh][r] = e; ps += e; }
            lrun = lrun * alpha + ps;
#pragma unroll
            for (int eh = 0; eh < 2; ++eh)
#pragma unroll
                for (int r = 0; r < 16; ++r) ot[eh][r] *= alpha;
#pragma unroll
            for (int kh = 0; kh < 2; ++kh)
#pragma unroll
                for (int s2 = 0; s2 < 2; ++s2) {
                    u32x4 pw; pw.x = cvtpk_s(sc[kh][8 * s2 + 0], sc[kh][8 * s2 + 1]); pw.y = cvtpk_s(sc[kh][8 * s2 + 2], sc[kh][8 * s2 + 3]);
                    pw.z = cvtpk_s(sc[kh][8 * s2 + 4], sc[kh][8 * s2 + 5]); pw.w = cvtpk_s(sc[kh][8 * s2 + 6], sc[kh][8 * s2 + 7]);
                    const bf16x8 pf = __builtin_bit_cast(bf16x8, pw);
#pragma unroll
                    for (int eh = 0; eh < 2; ++eh) {
                        const unsigned char* vp = vb + (32 * eh + r32) * A_VSTR + (32 * kh + 16 * s2 + 4 * hh) * 2;
                        const u32x2 lo = *(const u32x2*)vp, hi2 = *(const u32x2*)(vp + 16);
                        const bf16x8 vf = __builtin_bit_cast(bf16x8, (u32x4){lo.x, lo.y, hi2.x, hi2.y});
                        ot[eh] = mfma32(vf, pf, ot[eh]);
                    }
                }
        }
        if (j + 1 < ntile) lstore(sNext, b ^ 1);
        __syncthreads();
    };
#pragma unroll 1
    for (int j = 0; j < ntile; j += 2) {
        step(j, sB, sA);
        if (j + 1 < ntile) step(j + 1, sA, sB);
    }
    const float ltot = lrun + __shfl_xor(lrun, 32);
    const float rl = 1.f / ltot;
    bf16_t* o = (bf16_t*)(ws + WS_MIX) + (size_t)(qp - 64) * 1024 + 512 + h * 64;
#pragma unroll
    for (int eh = 0; eh < 2; ++eh)
#pragma unroll
        for (int a = 0; a < 4; ++a) {
            const int e = 32 * eh + 8 * a + 4 * hh;
            *(u32x2*)(o + e) = (u32x2){pk2(ot[eh][4 * a] * rl, ot[eh][4 * a + 1] * rl), pk2(ot[eh][4 * a + 2] * rl, ot[eh][4 * a + 3] * rl)};
        }
}

DI void xn_rows(const Frame& F, const Args& A, int u0, int stride) {
    f32x4 v[2][4];
#pragma unroll
    for (int r = 0; r < 2; ++r) { const int u = u0 + r * stride; if (u < MU) { const f32x4* xr = (const f32x4*)(A.out + (size_t)u * DM) + F.lane;
#pragma unroll
        for (int j = 0; j < 4; ++j) v[r][j] = xr[64 * j]; } }
#pragma unroll
    for (int r = 0; r < 2; ++r) {
        const int u = u0 + r * stride; if (u >= MU) continue;
        float s = 0.f;
#pragma unroll
        for (int j = 0; j < 4; ++j) s += (v[r][j].x * v[r][j].x + v[r][j].y * v[r][j].y) + (v[r][j].z * v[r][j].z + v[r][j].w * v[r][j].w);
        const float rstd = 1.f / sqrtf(wave_sum(s) * (1.f / DM) + EPS);
        unsigned long long* o8 = (unsigned long long*)((bf16_t*)(A.ws + WS_XN) + (size_t)u * DM) + F.lane;
#pragma unroll
        for (int j = 0; j < 4; ++j) { const f32x4 w = ((const f32x4*)A.in[15])[64 * j + F.lane];
            o8[64 * j] = (unsigned long long)pk2(v[r][j].x * rstd * w.x, v[r][j].y * rstd * w.y) | ((unsigned long long)pk2(v[r][j].z * rstd * w.z, v[r][j].w * rstd * w.w) << 32); }
    }
}

DI unsigned fkey(float v, int idx) { unsigned u = __builtin_bit_cast(unsigned, v); u = (u & 0x80000000u) ? ~u : (u | 0x80000000u); return (u & ~127u) | (unsigned)(127 - idx); }
DI float keyval(unsigned k) { unsigned u = k & ~127u; u = (u & 0x80000000u) ? (u & 0x7fffffffu) : ~u; return __builtin_bit_cast(float, u); }

__device__ const unsigned char PAIR_A[50] = {0,0,0,0,0,0,0,0,0,0,0,0,0,0,0,0, 1,1,1,1,1,1,1,1, 2,2,2,2,2, 3,3,3,3, 4,4,4, 5,5, 6,6, 7,7, 8,9,10,11,12,13,14,15};
__device__ const unsigned char PAIR_B[50] = {0,1,2,3,4,5,6,7,8,9,10,11,12,13,14,15, 0,1,2,3,4,5,6,7, 0,1,2,3,4, 0,1,2,3, 0,1,2, 0,1, 0,1, 0,1, 0,0,0,0,0,0,0,0};

DI void ce_desc(unsigned& a, unsigned& b) { const unsigned mx = a > b ? a : b, mn = a > b ? b : a; a = mx; b = mn; }
template <int BASE, int NK> DI void bitonic_sort16_desc(unsigned (&x)[NK]) {
#pragma unroll
    for (int k = 2; k <= 16; k <<= 1)
#pragma unroll
        for (int j = k >> 1; j > 0; j >>= 1)
#pragma unroll
            for (int i = 0; i < 16; ++i) { const int l = i ^ j; if (l > i) { if ((i & k) == 0) ce_desc(x[BASE + i], x[BASE + l]); else ce_desc(x[BASE + l], x[BASE + i]); } }
}
template <int A0, int B0, int NK> DI void merge_top16(unsigned (&x)[NK]) {
#pragma unroll
    for (int i = 0; i < 16; ++i) { const unsigned p = x[A0 + i], q = x[B0 + 15 - i]; x[A0 + i] = p > q ? p : q; }
#pragma unroll
    for (int j = 8; j > 0; j >>= 1)
#pragma unroll
        for (int i = 0; i < 16; ++i) { const int l = i ^ j; if (l > i) ce_desc(x[A0 + i], x[A0 + l]); }
}
template <int NK> DI void top16_of_128(unsigned (&key)[NK]) {
    bitonic_sort16_desc<0, NK>(key); bitonic_sort16_desc<16, NK>(key); bitonic_sort16_desc<32, NK>(key); bitonic_sort16_desc<48, NK>(key);
    bitonic_sort16_desc<64, NK>(key); bitonic_sort16_desc<80, NK>(key); bitonic_sort16_desc<96, NK>(key); bitonic_sort16_desc<112, NK>(key);
    merge_top16<0, 16, NK>(key); merge_top16<32, 48, NK>(key); merge_top16<64, 80, NK>(key); merge_top16<96, 112, NK>(key);
    merge_top16<0, 32, NK>(key); merge_top16<64, 96, NK>(key);
    merge_top16<0, 64, NK>(key);
}

DI void topk_task(const Frame& F, const Args& A, int task) {
    unsigned char* ws = A.ws; const int tid = F.tid;
    const int u = task >> 3, h = task & 7;
    LAS unsigned* sk = (LAS unsigned*)(LAS unsigned char*)F.lds;
    LAS unsigned* pkk = sk + 16384;
    LAS float* stg = (LAS float*)(sk + 16384);
    const float* SCb = (const float*)(ws + WS_SC) + (size_t)(task & ~511) * 256;
#pragma unroll 1
    for (int half = 0; half < 2; ++half) {
        unsigned key[128];
#pragma unroll
        for (int qb = 0; qb < 4; ++qb) {
            u32x4 pf[8];
#pragma unroll
            for (int k = 0; k < 8; ++k) { const int c = tid + 512 * k; pf[k] = *(const u32x4*)(SCb + (size_t)(c >> 3) * 256 + half * 128 + qb * 32 + (c & 7) * 4); }
#pragma unroll
            for (int k = 0; k < 8; ++k) { const int c = tid + 512 * k; *(LAS u32x4*)(stg + (c >> 3) * 36 + (c & 7) * 4) = pf[k]; }
            __syncthreads();
#pragma unroll
            for (int i = 0; i < 8; ++i) { const f32x4 v = *(const LAS f32x4*)(stg + tid * 36 + 4 * i);
                key[32 * qb + 4 * i] = fkey(v.x, 32 * qb + 4 * i); key[32 * qb + 4 * i + 1] = fkey(v.y, 32 * qb + 4 * i + 1);
                key[32 * qb + 4 * i + 2] = fkey(v.z, 32 * qb + 4 * i + 2); key[32 * qb + 4 * i + 3] = fkey(v.w, 32 * qb + 4 * i + 3); }
            __syncthreads();
        }
        top16_of_128(key);
#pragma unroll
        for (int r = 0; r < 16; ++r) sk[(half * 16 + r) * 512 + tid] = key[r];
    }
    float v1[16], v2[16];
#pragma unroll
    for (int r = 0; r < 16; ++r) { v1[r] = keyval(sk[r * 512 + tid]); v2[r] = keyval(sk[(16 + r) * 512 + tid]); }
    unsigned ck[64];
#pragma unroll
    for (int c = 50; c < 64; ++c) ck[c] = 0u;
#pragma unroll
    for (int a = 0; a < 16; ++a) {
        const int off = a == 0 ? 0 : a == 1 ? 16 : a == 2 ? 24 : a == 3 ? 29 : a == 4 ? 33 : a == 5 ? 36 : a == 6 ? 38 : a == 7 ? 40 : 42 + (a - 8);
#pragma unroll
        for (int b = 0; b < 16; ++b) if ((a + 1) * (b + 1) <= 16) ck[off + b] = fkey(v1[a] + v2[b], off + b);
    }
    bitonic_sort16_desc<0, 64>(ck); bitonic_sort16_desc<16, 64>(ck); bitonic_sort16_desc<32, 64>(ck); bitonic_sort16_desc<48, 64>(ck);
    merge_top16<0, 16, 64>(ck); merge_top16<32, 48, 64>(ck); merge_top16<0, 32, 64>(ck);
#pragma unroll
    for (int r = 0; r < 16; ++r) pkk[r * 512 + tid] = ck[r];
    const float cmax = keyval(pkk[tid]);
    float ev[16]; float esum = 0.f; int ex[16];
#pragma unroll
    for (int r = 0; r < 16; ++r) {
        const unsigned k = pkk[r * 512 + tid]; const int c = 127 - (int)(k & 127u);
        ev[r] = __expf(keyval(k) - cmax); esum += ev[r];
        const int a = PAIR_A[c], b = PAIR_B[c];
        const int i1 = 127 - (int)(sk[a * 512 + tid] & 127u), i2 = 127 - (int)(sk[(16 + b) * 512 + tid] & 127u);
        ex[r] = i1 * 128 + i2;
    }
    const float rs = 1.f / esum;
    int* IDX = (int*)(ws + WS_IDX) + (size_t)u * 128 + h * 16; float* GATE = (float*)(ws + WS_GATE) + (size_t)u * 128 + h * 16;
#pragma unroll
    for (int r = 0; r < 16; r += 4) {
        *(int4*)(IDX + r) = make_int4(ex[r], ex[r + 1], ex[r + 2], ex[r + 3]);
        *(f32x4*)(GATE + r) = (f32x4){ev[r] * rs, ev[r + 1] * rs, ev[r + 2] * rs, ev[r + 3] * rs};
    }
}

constexpr float EU_SCALE = 64.f, EV_SCALE = 16.f;
DI unsigned pk4_fp8(float a, float b, float c, float d) { int w = 0; w = __builtin_amdgcn_cvt_pk_fp8_f32(a, b, w, false); w = __builtin_amdgcn_cvt_pk_fp8_f32(c, d, w, true); return (unsigned)w; }
DI void convert_tables(const Frame& F, const Args& A) {
    const size_t n16 = (size_t)16384 * 1024 / 16;
    const size_t gt = (size_t)blockIdx.x * 512 + F.tid, NGT = (size_t)F.G * 512;
#pragma unroll 1
    for (int t = 0; t < 2; ++t) {
        const float* src = A.in[18 + t]; unsigned char* dst = A.ws + (t ? WS_EV : WS_EU); const float sc = t ? EV_SCALE : EU_SCALE;
        for (size_t i = gt; i < n16; i += NGT) {
            const f32x4 a = *(const f32x4*)(src + i * 16) * sc, b = *(const f32x4*)(src + i * 16 + 4) * sc, c = *(const f32x4*)(src + i * 16 + 8) * sc, d = *(const f32x4*)(src + i * 16 + 12) * sc;
            const size_t e_ = i >> 6, c16_ = i & 63;
            *(u32x4*)(dst + (c16_ >> 3) * ((size_t)16384 * 128) + e_ * 128 + (c16_ & 7) * 16) = (u32x4){pk4_fp8(a.x, a.y, a.z, a.w), pk4_fp8(b.x, b.y, b.z, b.w), pk4_fp8(c.x, c.y, c.z, c.w), pk4_fp8(d.x, d.y, d.z, d.w)};
        }
    }
}

DI float gelu_exact(float x) { return 0.5f * x * (1.f + erff(x * 0.70710678118654752f)); }
typedef float f32x2 __attribute__((ext_vector_type(2)));
#define UNPK16(dst, W_) do { f32x2 _t; \
    _t = __builtin_amdgcn_cvt_pk_f32_fp8((int)(W_).x, false); dst[0] = _t.x; dst[1] = _t.y; _t = __builtin_amdgcn_cvt_pk_f32_fp8((int)(W_).x, true); dst[2] = _t.x; dst[3] = _t.y; \
    _t = __builtin_amdgcn_cvt_pk_f32_fp8((int)(W_).y, false); dst[4] = _t.x; dst[5] = _t.y; _t = __builtin_amdgcn_cvt_pk_f32_fp8((int)(W_).y, true); dst[6] = _t.x; dst[7] = _t.y; \
    _t = __builtin_amdgcn_cvt_pk_f32_fp8((int)(W_).z, false); dst[8] = _t.x; dst[9] = _t.y; _t = __builtin_amdgcn_cvt_pk_f32_fp8((int)(W_).z, true); dst[10] = _t.x; dst[11] = _t.y; \
    _t = __builtin_amdgcn_cvt_pk_f32_fp8((int)(W_).w, false); dst[12] = _t.x; dst[13] = _t.y; _t = __builtin_amdgcn_cvt_pk_f32_fp8((int)(W_).w, true); dst[14] = _t.x; dst[15] = _t.y; } while (0)

template <bool UPH>
DI void expert_phase(const Frame& F, const Args& A, int xv, int wq, int nw) {
    unsigned char* ws = A.ws; const int lane = F.lane, grp = lane >> 3, j = lane & 7;
    const unsigned char* TBL = ws + (UPH ? WS_EU : WS_EV) + (size_t)xv * ((size_t)16384 * 128) + 16 * j;
    const int* IDX = (const int*)(ws + WS_IDX); const float* CW = (const float*)(ws + WS_CW);
    const bf16_t* XN = (const bf16_t*)(ws + WS_XN) + 128 * xv + 16 * j;
    float* HP = (float*)(ws + WS_HP);
    LAS unsigned* ring = (LAS unsigned*)((LAS unsigned char*)F.lds + F.wave * 4096);
    const int nt = (MU - wq + nw - 1) / nw;
    if (nt <= 0) return;
    auto tok = [&](int k) { return __builtin_amdgcn_readfirstlane(wq + (k < nt ? k : nt - 1) * nw); };
    int mi0, mi1; u32x4 mx0, mx1; float mh0, mh1;
    auto meta_load = [&](int k) {
        const int u = tok(k);
        mi0 = IDX[(size_t)u * 128 + lane]; mi1 = IDX[(size_t)u * 128 + 64 + lane];
        if constexpr (UPH) { mx0 = *(const u32x4*)(XN + (size_t)u * DM); mx1 = *(const u32x4*)(XN + (size_t)u * DM + 8); }
        else { mh0 = CW[(size_t)u * 128 + lane]; mh1 = CW[(size_t)u * 128 + 64 + lane]; }
    };
    auto meta_store = [&](int k) {
        LAS unsigned* sl = ring + (k & 3) * 256;
        sl[lane] = (unsigned)mi0; sl[64 + lane] = (unsigned)mi1;
        if constexpr (UPH) { if (grp == 0) { *(LAS u32x4*)(sl + 128 + 8 * j) = mx0; *(LAS u32x4*)(sl + 128 + 8 * j + 4) = mx1; } }
        else { sl[128 + lane] = __builtin_bit_cast(unsigned, mh0); sl[192 + lane] = __builtin_bit_cast(unsigned, mh1); }
    };
    auto gather = [&](u32x4 (&buf)[8], int n) {
        const LAS unsigned* sl = ring + ((n >> 1) & 3) * 256 + 64 * (n & 1) + grp;
#pragma unroll
        for (int i = 0; i < 8; ++i) { const int e = (int)sl[8 * i]; buf[i] = *(const u32x4*)(TBL + (size_t)e * 128); }
    };
    const int ocol = 128 * xv + 16 * j + ((lane & 32) ? 8 : 0) + ((lane & 16) ? 4 : 0) + ((lane & 8) ? 2 : 0);
    f32x2 ocur = (f32x2){0.f, 0.f};
    float acc[16];
    float xn[16];
    auto compute = [&](u32x4 (&buf)[8], int n) {
        const int k = n >> 1, hf = n & 1;
        const LAS unsigned* sl = ring + (k & 3) * 256;
        if (hf == 0) {
            if constexpr (UPH) {
                const u32x4 x0 = *(const LAS u32x4*)(sl + 128 + 8 * j), x1 = *(const LAS u32x4*)(sl + 128 + 8 * j + 4);
                xn[0] = bflo(x0.x); xn[1] = bfhi(x0.x); xn[2] = bflo(x0.y); xn[3] = bfhi(x0.y); xn[4] = bflo(x0.z); xn[5] = bfhi(x0.z); xn[6] = bflo(x0.w); xn[7] = bfhi(x0.w);
                xn[8] = bflo(x1.x); xn[9] = bfhi(x1.x); xn[10] = bflo(x1.y); xn[11] = bfhi(x1.y); xn[12] = bflo(x1.z); xn[13] = bfhi(x1.z); xn[14] = bflo(x1.w); xn[15] = bfhi(x1.w);
            } else {
#pragma unroll
                for (int c = 0; c < 16; ++c) acc[c] = 0.f;
                ocur = *(const f32x2*)(A.out + (size_t)tok(k) * DM + ocol);
            }
        }
#pragma unroll
        for (int i = 0; i < 8; ++i) {
            float f[16]; UNPK16(f, buf[i]);
            if constexpr (UPH) {
                float a0 = 0.f, a1 = 0.f;
#pragma unroll
                for (int c = 0; c < 16; c += 2) { a0 += f[c] * xn[c]; a1 += f[c + 1] * xn[c + 1]; }
                if (hf == 0) acc[i] = a0 + a1; else acc[8 + i] = a0 + a1;
                if (i < 7) { if (hf == 0) asm volatile("" : "+v"(buf[i + 1].x), "+v"(buf[i + 1].y), "+v"(buf[i + 1].z), "+v"(buf[i + 1].w), "+v"(acc[i]));
                             else asm volatile("" : "+v"(buf[i + 1].x), "+v"(buf[i + 1].y), "+v"(buf[i + 1].z), "+v"(buf[i + 1].w), "+v"(acc[8 + i])); }
            } else {
                const float cw = __builtin_bit_cast(float, sl[128 + 64 * hf + 8 * i + grp]);
#pragma unroll
                for (int c = 0; c < 16; ++c) acc[c] += cw * f[c];
                if (i < 7) asm volatile("" : "+v"(buf[i + 1].x), "+v"(buf[i + 1].y), "+v"(buf[i + 1].z), "+v"(buf[i + 1].w),
                                             "+v"(acc[0]), "+v"(acc[1]), "+v"(acc[2]), "+v"(acc[3]), "+v"(acc[4]), "+v"(acc[5]), "+v"(acc[6]), "+v"(acc[7]),
                                             "+v"(acc[8]), "+v"(acc[9]), "+v"(acc[10]), "+v"(acc[11]), "+v"(acc[12]), "+v"(acc[13]), "+v"(acc[14]), "+v"(acc[15]));
            }
            __builtin_amdgcn_sched_barrier(0);
        }
        if (hf == 1 && k < nt) {
            const int u = tok(k);
            float r8[8], r4[4], r2[2];
            if constexpr (UPH) {
                { const bool up = lane & 4;
#pragma unroll
                  for (int i = 0; i < 8; ++i) { const float send = up ? acc[i] : acc[i + 8], keep = up ? acc[i + 8] : acc[i]; r8[i] = keep + __shfl_xor(send, 4); } }
                { const bool up = lane & 2;
#pragma unroll
                  for (int i = 0; i < 4; ++i) { const float send = up ? r8[i] : r8[i + 4], keep = up ? r8[i + 4] : r8[i]; r4[i] = keep + __shfl_xor(send, 2); } }
                { const bool up = lane & 1;
#pragma unroll
                  for (int i = 0; i < 2; ++i) { const float send = up ? r4[i] : r4[i + 2], keep = up ? r4[i + 2] : r4[i]; r2[i] = keep + __shfl_xor(send, 1); } }
                const int st = ((lane & 4) ? 8 : 0) + ((lane & 2) ? 4 : 0) + ((lane & 1) ? 2 : 0);
                float* hp = HP + ((size_t)xv * MU + u) * 128 + grp;
                hp[8 * st] = r2[0]; hp[8 * (st + 1)] = r2[1];
            } else {
                { const bool up = lane & 32;
#pragma unroll
                  for (int c = 0; c < 8; ++c) { const float send = up ? acc[c] : acc[c + 8], keep = up ? acc[c + 8] : acc[c]; r8[c] = keep + __shfl_xor(send, 32); } }
                { const bool up = lane & 16;
#pragma unroll
                  for (int c = 0; c < 4; ++c) { const float send = up ? r8[c] : r8[c + 4], keep = up ? r8[c + 4] : r8[c]; r4[c] = keep + __shfl_xor(send, 16); } }
                { const bool up = lane & 8;
#pragma unroll
                  for (int c = 0; c < 2; ++c) { const float send = up ? r4[c] : r4[c + 2], keep = up ? r4[c + 2] : r4[c]; r2[c] = keep + __shfl_xor(send, 8); } }
                f32x2* o = (f32x2*)(A.out + (size_t)u * DM + ocol);
                f32x2 cur = ocur; cur.x += r2[0]; cur.y += r2[1]; *o = cur;
            }
        }
    };
    meta_load(0); meta_store(0); meta_load(1); meta_store(1); meta_load(2); meta_store(2);
    u32x4 b0[8], b1[8], b2[8];
    gather(b0, 0); gather(b1, 1); gather(b2, 2);
#pragma unroll 1
    for (int k0 = 0; k0 < nt; k0 += 3) {
        const int n0 = 2 * k0;
        meta_load(k0 + 3);
        compute(b0, n0);     gather(b0, n0 + 3);
        compute(b1, n0 + 1); meta_store(k0 + 3); gather(b1, n0 + 4);
        meta_load(k0 + 4);
        compute(b2, n0 + 2); gather(b2, n0 + 5);
        compute(b0, n0 + 3); meta_store(k0 + 4); gather(b0, n0 + 6);
        meta_load(k0 + 5);
        compute(b1, n0 + 4); gather(b1, n0 + 7);
        compute(b2, n0 + 5); meta_store(k0 + 5); gather(b2, n0 + 8);
    }
}


DI void expert_c_pass(const Frame& F, const Args& A) {
    unsigned char* ws = A.ws;
    const float* HP = (const float*)(ws + WS_HP); const float* GATE = (const float*)(ws + WS_GATE); float* CW = (float*)(ws + WS_CW);
    const size_t n4 = (size_t)MU * 128 / 4;
    for (size_t i = (size_t)blockIdx.x * 512 + F.tid; i < n4; i += (size_t)F.G * 512) {
        f32x4 h = *(const f32x4*)(HP + i * 4);
#pragma unroll
        for (int x = 1; x < 8; ++x) h += *(const f32x4*)(HP + (size_t)x * MU * 128 + i * 4);
        const f32x4 g = *(const f32x4*)(GATE + i * 4);
        f32x4 c;
        c.x = gelu_exact(h.x * (1.f / EU_SCALE)) * g.x * (1.f / EV_SCALE); c.y = gelu_exact(h.y * (1.f / EU_SCALE)) * g.y * (1.f / EV_SCALE);
        c.z = gelu_exact(h.z * (1.f / EU_SCALE)) * g.z * (1.f / EV_SCALE); c.w = gelu_exact(h.w * (1.f / EU_SCALE)) * g.w * (1.f / EV_SCALE);
        *(f32x4*)(CW + i * 4) = c;
    }
}
#ifndef PROBE_VAR
#define PROBE_VAR 0
#endif
template <int PH> DI void run_phase(const Frame& F, const Args& args, PG8_LAS unsigned char* lds3) {
    unsigned char* ws = args.ws;
    if constexpr (PH == 0) { p0_prologue(F, args); }
    if constexpr (PH == 1) {
        pg8::Gemm g{(const bf16_t*)(ws + WS_HN), (const bf16_t*)(ws + WS_WIN), MP, NPROJ, 1024, 1024, 1024, 0};
        pg8::StaticOrder S; S.init(MP, NPROJ, F.G, (int)blockIdx.x);
        EpiProj E{(bf16_t*)(ws + WS_QKVR), (bf16_t*)(ws + WS_Z), (float*)(ws + WS_P32)};
        pg8::gemm_phase<EpiProj, pg8::StaticOrder, true, true>(lds3, g, S, E);
    }
    if constexpr (PH == 2) { gdn_prep_phase<0>(F, args); }
    if constexpr (PH == 102) { gdn_prep_phase<PROBE_VAR>(F, args); }
    if constexpr (PH == 3) {
        p0_late_weights<0>(F, args, F.gw, F.NGW, blockIdx.x * 512 + F.tid, F.G * 512);
        for (int p = F.gw; p < MP; p += 4 * F.NGW) mla_prep1_rows(F, args, p, F.NGW);
    }
    if constexpr (PH == 4) {
        { pg8::Gemm g{(const bf16_t*)(ws + WS_CQN), (const bf16_t*)(ws + WS_WUQ), MP, 768, 256, 256, 256, 0};
          pg8::StaticOrder S; S.init(MP, 768, F.G, (int)blockIdx.x); EpiB16 E{(bf16_t*)(ws + WS_QH), 768};
          pg8::gemm_phase<EpiB16, pg8::StaticOrder, true, true>(lds3, g, S, E); }
        { pg8::Gemm g{(const bf16_t*)(ws + WS_CKVN), (const bf16_t*)(ws + WS_WUKV), MP, 1024, 256, 256, 256, 0};
          pg8::StaticOrder S; S.init(MP, 1024, F.G, (int)blockIdx.x); EpiB16 E{(bf16_t*)(ws + WS_KVB), 1024};
          pg8::gemm_phase<EpiB16, pg8::StaticOrder, true, true>(lds3, g, S, E); }
    }
    if constexpr (PH == 5) { for (int t = F.gw; t < (KVROWS / 64) * 8; t += F.NGW) mla_prep2_task(F, args, t); }
    if constexpr (PH == 6) {
        gdn_scan(F, args);
        volatile LAS unsigned* MISC = (volatile LAS unsigned*)(lds3 + MISC_OFF);
        unsigned* qhead = (unsigned*)(ws + WS_CTL) + CW_ATTQ;
        for (;;) {
            __syncthreads();
            if (F.tid == 0) MISC[24] = xb_add(qhead, 1u);
            __syncthreads();
            const int k = (int)MISC[24];
            if (k >= 512) break;
            attn_item(F, args, k & 7, 63 - (k >> 3));
        }
        p0_late_weights<1>(F, args, F.gw, F.NGW, blockIdx.x * 512 + F.tid, F.G * 512);
    }
    if constexpr (PH == 7) { for (int t = F.gw; t < 2048 * 2; t += F.NGW) gdn_out_task(F, args, t); }
    if constexpr (PH == 8) {
        pg8::Gemm g{(const bf16_t*)(ws + WS_MIX), (const bf16_t*)(ws + WS_WOUT), MU, 1024, 1024, 1024, 1024, 0};
        pg8::StaticOrder S; S.init(MU, 1024, F.G, (int)blockIdx.x); EpiF32 E{args.out, 1024, args.in[0]};
        pg8::gemm_phase<EpiF32, pg8::StaticOrder, true, true>(lds3, g, S, E);
    }
    if constexpr (PH == 9) { for (int u = F.gw; u < MU; u += 2 * F.NGW) xn_rows(F, args, u, F.NGW); }
    if constexpr (PH == 10) {
        pg8::Gemm g{(const bf16_t*)(ws + WS_XN), (const bf16_t*)(ws + WS_WPQ), MU, 2048, 1024, 1024, 1024, 0};
        pg8::StaticOrder S; S.init(MU, 2048, F.G, (int)blockIdx.x); EpiB16 E{(bf16_t*)(ws + WS_PQ), 2048};
        pg8::gemm_phase<EpiB16, pg8::StaticOrder, true, true>(lds3, g, S, E);
    }
    if constexpr (PH == 11) {
        pg8::Gemm g{(const bf16_t*)(ws + WS_PQ), (const bf16_t*)(ws + WS_SKB), MU, 2048, 256, 2048, 256, 256};
        pg8::StaticOrder S; S.init(MU, 2048, F.G, (int)blockIdx.x); EpiF32 E{(float*)(ws + WS_SC), 2048, nullptr};
        pg8::gemm_phase<EpiF32, pg8::StaticOrder, true, true>(lds3, g, S, E);
    }
    if constexpr (PH == 12) {
        convert_tables(F, args);
        for (int t = blockIdx.x * 512 + F.tid; t < MU * 8; t += F.G * 512) topk_task(F, args, t);
    }
    if constexpr (PH == 14) { expert_c_pass(F, args); }
    if constexpr (PH == 13 || PH == 15) {
        volatile LAS unsigned* MISC = (volatile LAS unsigned*)(lds3 + MISC_OFF);
        const unsigned x = MISC[16], rank = MISC[17];
        unsigned* bar = (unsigned*)(ws + WS_CTL);
        unsigned nloc = 0, nx = 0, myidx = 0;
#pragma unroll
        for (unsigned j = 0; j < 16; ++j) { const unsigned c = xb_ld(&bar[XB_XCNT(j)]); nx += (c > 0u) ? 1u : 0u; myidx += (c > 0u && j < x) ? 1u : 0u; nloc = (j == x) ? c : nloc; }
        const int wq = __builtin_amdgcn_readfirstlane((int)rank * 8 + F.wave), nw = __builtin_amdgcn_readfirstlane((int)nloc * 8);
        const int xstep = __builtin_amdgcn_readfirstlane((int)nx);
        for (int xv = __builtin_amdgcn_readfirstlane((int)myidx); xv < 8; xv += xstep)
            { if constexpr (PH == 13) expert_phase<true>(F, args, xv, wq, nw); else expert_phase<false>(F, args, xv, wq, nw); }
    }
}
constexpr int NPHASE = 16;
__global__ void __launch_bounds__(512, 2) fwd_kernel(Args args) {
    extern __shared__ __attribute__((aligned(16))) unsigned char lds[];
    Frame F;
    F.lds = lds; F.tid = threadIdx.x; F.lane = F.tid & 63; F.wave = __builtin_amdgcn_readfirstlane(F.tid >> 6);
    F.G = gridDim.x; F.gw = blockIdx.x * 8 + F.wave; F.NGW = F.G * 8;
    volatile LAS unsigned* MISC = (volatile LAS unsigned*)((LAS unsigned char*)lds + MISC_OFF);
    if (F.tid < 32) MISC[F.tid] = 0u;
    __syncthreads();
    unsigned char* ws = args.ws;
    const int lo = args.ph_lo, hi = args.ph_hi;
    XcdBarrier bar; bar.bar = (unsigned*)(ws + WS_CTL); bar.x = 0; bar.st = nullptr;
    if (hi - lo > 1) bar = xcd_barrier_post((unsigned*)(ws + WS_CTL), MISC + 8);
    if (F.tid == 0) { const unsigned x = xb_xcc_id(); MISC[16] = x; MISC[17] = xb_add((unsigned*)(ws + WS_CTL) + 3520 + 64 * x, 1u); }
    __syncthreads();
#define IN(k) (lo <= (k) && (k) < hi)
#define SEAM(k) do { if (IN(k) && IN((k) + 1)) xcd_barrier(bar); } while (0)
    PG8_LAS unsigned char* lds3 = (PG8_LAS unsigned char*)lds;

#ifndef PROBE_REPEAT
#define PROBE_REPEAT -1
#endif
#ifndef PROBE_TIME
#define PROBE_TIME -1
#endif
#ifndef PROBE_TSEL
#define PROBE_TSEL 0
#endif
    unsigned long long pt_ticks = 0ull;
#define PHASE(k) do { unsigned long long pt0_ = 0ull; if (PROBE_TIME == (k)) pt0_ = __builtin_amdgcn_s_memrealtime(); \
        if (IN(k)) { run_phase<k>(F, args, lds3); if (PROBE_REPEAT == (k)) { xcd_barrier(bar); run_phase<(PROBE_VAR && (k) == 2) ? 102 : (k)>(F, args, lds3); } } \
        if (PROBE_TIME == (k) && PROBE_TSEL == 1) pt_ticks = __builtin_amdgcn_s_memrealtime() - pt0_;     \
        if (PROBE_TIME == (k) && PROBE_TSEL == 2) pt0_ = __builtin_amdgcn_s_memrealtime();                \
        SEAM(k); \
        if (PROBE_TIME == (k) && PROBE_TSEL != 1) pt_ticks = __builtin_amdgcn_s_memrealtime() - pt0_; } while (0)
    PHASE(0); PHASE(1); PHASE(2); PHASE(3); PHASE(4); PHASE(5); PHASE(6); PHASE(7); PHASE(8); PHASE(9); PHASE(10); PHASE(11); PHASE(12); PHASE(13); PHASE(14); PHASE(15);
#undef PHASE
    if (PROBE_STAGE >= 0) { __syncthreads(); pt_ticks = *(volatile unsigned long long*)(lds + 143360 + 96); }
    if (PROBE_TIME >= 0 || PROBE_STAGE >= 0) { const unsigned long long t0_ = __builtin_amdgcn_s_memrealtime(); while (__builtin_amdgcn_s_memrealtime() - t0_ < 4ull * pt_ticks) __builtin_amdgcn_s_sleep(32); }
#undef IN
#undef SEAM
}

#ifndef N_LAUNCHES
#define N_LAUNCHES 1
#endif
extern "C" void kernel_launch(void* const* d_in, const int* in_sizes, int n_in, void* d_out, int out_size, void* d_ws, size_t ws_size, hipStream_t stream) {
    static int grid = 0;
    if (grid == 0) {
        if (n_in != 20 || out_size != MU * DM || ws_size < WS_END) { fprintf(stderr, "kernel_launch: unexpected shapes (n_in %d out %d ws %zu)\n", n_in, out_size, ws_size); grid = -1; return; }
        int dev = 0, cus = 0, per_cu = 0;
        if (hipGetDevice(&dev) != hipSuccess || hipDeviceGetAttribute(&cus, hipDeviceAttributeMultiprocessorCount, dev) != hipSuccess) { grid = -1; return; }
        if (hipFuncSetAttribute((const void*)fwd_kernel, hipFuncAttributeMaxDynamicSharedMemorySize, LDS_BYTES) != hipSuccess) { fprintf(stderr, "kernel_launch: hipFuncSetAttribute failed\n"); grid = -1; return; }
        if (hipOccupancyMaxActiveBlocksPerMultiprocessor(&per_cu, (const void*)fwd_kernel, 512, LDS_BYTES) != hipSuccess || per_cu < 1) { fprintf(stderr, "kernel_launch: occupancy query says %d\n", per_cu); (void)hipGetLastError(); per_cu = 1; }
        grid = cus;
    }
    if (grid < 0) return;
    (void)hipMemsetAsync((char*)d_ws + WS_CTL, 0, CTL_ZERO_BYTES, stream);
    Args a{};
    for (int i = 0; i < 20; ++i) a.in[i] = (const float*)d_in[i];
    a.out = (float*)d_out; a.ws = (unsigned char*)d_ws;
    for (int li = 0; li < N_LAUNCHES; ++li) {
        a.ph_lo = li * NPHASE / N_LAUNCHES; a.ph_hi = (li + 1) * NPHASE / N_LAUNCHES;
        if (N_LAUNCHES == 1) {
            void* kargs[] = {&a};
            hipError_t e = hipLaunchCooperativeKernel((const void*)fwd_kernel, dim3(grid), dim3(512), kargs, LDS_BYTES, stream);
            if (e != hipSuccess) fprintf(stderr, "cooperative launch failed: %s (grid %d)\n", hipGetErrorString(e), grid);
        } else {
            hipLaunchKernelGGL(fwd_kernel, dim3(grid), dim3(512), LDS_BYTES, stream, a);
        }
    }
}
```

```cpp
#include <hip/hip_runtime.h>
#include <hip/hip_bf16.h>
#include <cstdio>
#include <cstdint>

#define DI __device__ __forceinline__
#define LAS __attribute__((address_space(3)))
#define GAS __attribute__((address_space(1)))

typedef unsigned short bf16_t;
typedef short bf16x8 __attribute__((ext_vector_type(8)));
typedef short s16x4 __attribute__((ext_vector_type(4)));
typedef float f32x4 __attribute__((ext_vector_type(4)));
typedef float f32x16 __attribute__((ext_vector_type(16)));
typedef unsigned u32x4 __attribute__((ext_vector_type(4)));
typedef unsigned u32x2 __attribute__((ext_vector_type(2)));

namespace pg8 {
#define PG8_LAS __attribute__((address_space(3)))
constexpr int BM = 256, BK = 64, HALF = 128, HTB = HALF * BK * 2  , STAGE_BYTES = 8 * HTB, NXCD = 8, WGM = 8;

__host__ __device__ __forceinline__ int lds_byte(int r, int c) { const int st = (r >> 4) * 2 + (c >> 5), rr = r & 15, cc = c & 31, ob = rr * 64 + cc * 2; return st * 1024 + (ob ^ (((ob >> 9) & 1) << 5)); }
__host__ __device__ __forceinline__ void stage_rc(int b, int& R, int& C) { const int st = b / 1024, sb = b % 1024, swz = sb ^ (((sb >> 9) & 1) << 5); R = (st >> 1) * 16 + swz / 64; C = (st & 1) * 32 + (swz % 64) / 2; }
__host__ __device__ __forceinline__ int perm32(int rho) { const int n = rho >> 4, i = rho & 15; return 8 * (i >> 2) + 4 * n + (i & 3); }

struct Unit { int pm, pn; };
struct Gemm { const bf16_t* A; const bf16_t* Bt; int M, N, K, lda, ldb, a_pn_off; };

struct StaticOrder {
    int nM, nN, nwg, G, c;
    __host__ __device__ void init(int M, int N, int G_, int c_) { nM = M / BM; nN = N / BM; nwg = nM * nN; G = G_; c = c_; }
    __host__ __device__ bool next(int i, Unit& u) const {
        const long L = (long)i * G + c; if (L >= nwg) return false;
        int wgid = (int)L; { const int q = nwg / NXCD, r = nwg % NXCD, xcd = wgid % NXCD, off = wgid / NXCD; wgid = (xcd < r ? xcd * (q + 1) : r * (q + 1) + (xcd - r) * q) + off; }
        const int nig = WGM * nN, gid = wgid / nig, fm = gid * WGM, gsz = (nM - fm) < WGM ? (nM - fm) : WGM;
        u.pm = fm + ((wgid % nig) % gsz); u.pn = (wgid % nig) / gsz; return true;
    }
    __device__ __forceinline__ void a_ready(const Unit&) const {}
    __device__ __forceinline__ void done(const Unit&) const {}
};

__device__ __forceinline__ unsigned cvt_pk_bf16(float lo, float hi) { unsigned r; asm volatile("v_cvt_pk_bf16_f32 %0, %1, %2" : "=v"(r) : "v"(lo), "v"(hi)); return r; }

template <class Epi, class Sched, bool ALIGN_EPI = false, bool SP2 = false>
__device__ __forceinline__ void gemm_phase(PG8_LAS unsigned char* lds, const Gemm g, const Sched& S, const Epi& E) {
    const int tid = threadIdx.x, wid = __builtin_amdgcn_readfirstlane(tid >> 6), lane = tid & 63, wr = wid >> 2, wc = wid & 3, fr = lane & 15, fq = lane >> 4;
    const int K = g.K, nt = K / BK;
    unsigned voffA[2], voffB[2];
#pragma unroll
    for (int i = 0; i < 2; ++i) { int R, C; stage_rc(tid * 16 + i * 8192, R, C); const int Rb = Epi::PERM ? ((R & ~31) + perm32(R & 31)) : R;
        voffA[i] = (unsigned)(R * g.lda + C) * 2u; voffB[i] = (unsigned)(Rb * g.ldb + C) * 2u; }
    const size_t kstep = (size_t)(BK * 2);
    const size_t hstepA = (size_t)HALF * g.lda * 2, hstepB = (size_t)HALF * g.ldb * 2;
    const size_t tstepA = 2 * hstepA, tstepB = 2 * hstepB;
    const size_t pnoffA = (size_t)g.a_pn_off * 2;
    const unsigned ldsw = (unsigned)wid * 1024u;
    const int aoff = lds_byte(wr * 64 + fr, fq * 8), boff = lds_byte(wc * 32 + fr, fq * 8);
#define PG8_SA(b, h) (((b) * 2 + (h)) * HTB)
#define PG8_SB(b, h) ((4 + (b) * 2 + (h)) * HTB)
#define PG8_STAGE(bufoff, gbase, voff) do { _Pragma("unroll") for (int _i = 0; _i < 2; ++_i) \
        __builtin_amdgcn_global_load_lds((const unsigned*)((const char*)(gbase) + (voff)[_i]), (PG8_LAS unsigned*)(lds + (bufoff) + ldsw + _i * 8192), 16, 0, 0); } while (0)
#define PG8_LDA(dst, b, h) do { _Pragma("unroll") for (int m = 0; m < 4; ++m) _Pragma("unroll") for (int k = 0; k < 2; ++k) dst[m][k] = *(const PG8_LAS bf16x8*)(lds + PG8_SA(b, h) + aoff + m * 2048 + k * 1024); } while (0)
#define PG8_LDB(dst, b, h) do { _Pragma("unroll") for (int n = 0; n < 2; ++n) _Pragma("unroll") for (int k = 0; k < 2; ++k) dst[n][k] = *(const PG8_LAS bf16x8*)(lds + PG8_SB(b, h) + boff + n * 2048 + k * 1024); } while (0)
#define PG8_MMA(ai, bj, At, Bt) do { __builtin_amdgcn_s_setprio(1); _Pragma("unroll") for (int m = 0; m < 4; ++m) _Pragma("unroll") for (int n = 0; n < 2; ++n) _Pragma("unroll") for (int k = 0; k < 2; ++k) \
        acc[ai][bj][m][n] = __builtin_amdgcn_mfma_f32_16x16x32_bf16(Bt[n][k], At[m][k], acc[ai][bj][m][n], 0, 0, 0); __builtin_amdgcn_s_setprio(0); } while (0)
#define PG8_WAIT_V(n) asm volatile("s_waitcnt vmcnt(" #n ")" ::: "memory")
#define PG8_WAIT_L(n) asm volatile("s_waitcnt lgkmcnt(" #n ")" ::: "memory")
#define PG8_BAR __builtin_amdgcn_s_barrier()
#define PG8_SCHED __builtin_amdgcn_sched_barrier(0)
    Unit cur, nxt; int ui = 0;
    if (!S.next(0, cur)) return;
    f32x4 acc[2][2][4][2];
#pragma unroll
    for (int a = 0; a < 2; ++a)
#pragma unroll
        for (int b = 0; b < 2; ++b)
#pragma unroll
            for (int m = 0; m < 4; ++m)
#pragma unroll
                for (int n = 0; n < 2; ++n) acc[a][b][m][n] = (f32x4){0.f, 0.f, 0.f, 0.f};
    bf16x8 At[4][2], B0[2][2], B1[2][2];
    const char* cA = (const char*)g.A + (size_t)cur.pm * tstepA + (size_t)cur.pn * pnoffA; const char* cB = (const char*)g.Bt + (size_t)cur.pn * tstepB;
    S.a_ready(cur);
    if constexpr (SP2) {
        PG8_STAGE(PG8_SB(0, 0), cB, voffB); PG8_STAGE(PG8_SB(0, 1), cB + hstepB, voffB); PG8_STAGE(PG8_SA(0, 0), cA, voffA); PG8_STAGE(PG8_SA(0, 1), cA + hstepA, voffA);
        if (wr == 1) PG8_BAR;
        PG8_WAIT_V(2); PG8_BAR;
        PG8_STAGE(PG8_SB(1, 0), cB + kstep, voffB); PG8_STAGE(PG8_SA(1, 0), cA + kstep, voffA); PG8_STAGE(PG8_SB(1, 1), cB + hstepB + kstep, voffB);
        PG8_WAIT_V(6); PG8_BAR;
    } else {
        PG8_STAGE(PG8_SB(0, 0), cB, voffB); PG8_STAGE(PG8_SA(0, 0), cA, voffA); PG8_STAGE(PG8_SB(0, 1), cB + hstepB, voffB); PG8_STAGE(PG8_SA(0, 1), cA + hstepA, voffA);
        if (wr == 1) PG8_BAR;
        PG8_WAIT_V(4); PG8_BAR;
        PG8_STAGE(PG8_SB(1, 0), cB + kstep, voffB); PG8_STAGE(PG8_SA(1, 0), cA + kstep, voffA); PG8_STAGE(PG8_SB(1, 1), cB + hstepB + kstep, voffB);
        PG8_WAIT_V(6); PG8_BAR;
    }
    for (;;) {
        const bool has_next = S.next(ui + 1, nxt);
        const char* nA = has_next ? (const char*)g.A + (size_t)nxt.pm * tstepA + (size_t)nxt.pn * pnoffA : cA; const char* nB = has_next ? (const char*)g.Bt + (size_t)nxt.pn * tstepB : cB;
        for (int t = 0; t < nt; t += 2) {
            const bool last = (t == nt - 2);
            const char* a1 = cA + (size_t)(t + 1) * kstep;
            const char* a2 = last ? nA : cA + (size_t)(t + 2) * kstep; const char* b2 = last ? nB : cB + (size_t)(t + 2) * kstep;
            const char* a3 = a2 + kstep; const char* b3 = b2 + kstep;
            if (last && has_next) S.a_ready(nxt);
            if constexpr (SP2) {
            PG8_LDB(B0, 0, 0); PG8_LDB(B1, 0, 1); PG8_SCHED; PG8_LDA(At, 0, 0); PG8_STAGE(PG8_SA(1, 1), a1 + hstepA, voffA);
            PG8_WAIT_V(8); PG8_WAIT_L(0); PG8_BAR; PG8_MMA(0, 0, At, B0); PG8_MMA(0, 1, At, B1); PG8_BAR; PG8_SCHED;
            PG8_LDA(At, 0, 1); PG8_STAGE(PG8_SB(0, 0), b2, voffB); PG8_STAGE(PG8_SB(0, 1), b2 + hstepB, voffB); PG8_STAGE(PG8_SA(0, 0), a2, voffA);
            PG8_WAIT_V(8); PG8_WAIT_L(0); PG8_BAR; PG8_MMA(1, 0, At, B0); PG8_MMA(1, 1, At, B1); PG8_BAR; PG8_SCHED;
            PG8_LDB(B0, 1, 0); PG8_LDB(B1, 1, 1); PG8_SCHED; PG8_LDA(At, 1, 0); PG8_STAGE(PG8_SA(0, 1), a2 + hstepA, voffA);
            PG8_WAIT_V(8); PG8_WAIT_L(0); PG8_BAR; PG8_MMA(0, 0, At, B0); PG8_MMA(0, 1, At, B1); PG8_BAR; PG8_SCHED;
            PG8_LDA(At, 1, 1); PG8_STAGE(PG8_SB(1, 0), b3, voffB); PG8_STAGE(PG8_SB(1, 1), b3 + hstepB, voffB); PG8_STAGE(PG8_SA(1, 0), a3, voffA);
            PG8_WAIT_V(8); PG8_WAIT_L(0); PG8_BAR; PG8_MMA(1, 0, At, B0); PG8_MMA(1, 1, At, B1); PG8_BAR; PG8_SCHED;
            } else {
            PG8_LDB(B0, 0, 0); PG8_SCHED; PG8_LDA(At, 0, 0); PG8_STAGE(PG8_SA(1, 1), a1 + hstepA, voffA);
            PG8_WAIT_L(8); PG8_BAR; PG8_WAIT_L(0); PG8_MMA(0, 0, At, B0); PG8_BAR; PG8_SCHED;
            PG8_LDB(B1, 0, 1); PG8_STAGE(PG8_SB(0, 0), b2, voffB);
            PG8_BAR; PG8_WAIT_L(0); PG8_MMA(0, 1, At, B1); PG8_BAR;
            PG8_LDA(At, 0, 1); PG8_STAGE(PG8_SA(0, 0), a2, voffA);
            PG8_BAR; PG8_WAIT_L(0); PG8_MMA(1, 0, At, B0); PG8_BAR; PG8_SCHED;
            PG8_STAGE(PG8_SB(0, 1), b2 + hstepB, voffB);
            PG8_WAIT_V(6); PG8_BAR; PG8_MMA(1, 1, At, B1); PG8_BAR;
            PG8_LDB(B0, 1, 0); PG8_SCHED; PG8_LDA(At, 1, 0); PG8_STAGE(PG8_SA(0, 1), a2 + hstepA, voffA);
            PG8_WAIT_L(8); PG8_BAR; PG8_WAIT_L(0); PG8_MMA(0, 0, At, B0); PG8_BAR; PG8_SCHED;
            PG8_LDB(B1, 1, 1); PG8_STAGE(PG8_SB(1, 0), b3, voffB);
            PG8_BAR; PG8_WAIT_L(0); PG8_MMA(0, 1, At, B1); PG8_BAR;
            PG8_LDA(At, 1, 1); PG8_STAGE(PG8_SA(1, 0), a3, voffA);
            PG8_BAR; PG8_WAIT_L(0); PG8_MMA(1, 0, At, B0); PG8_BAR; PG8_SCHED;
            PG8_STAGE(PG8_SB(1, 1), b3 + hstepB, voffB);
            PG8_WAIT_V(6); PG8_BAR; PG8_MMA(1, 1, At, B1); PG8_BAR;
            }
        }
        if constexpr (ALIGN_EPI) { if (wr == 0) PG8_BAR; }
        E(acc, cur, wr, wc, fr, fq); S.done(cur);
        if (!has_next) break;
#pragma unroll
        for (int a = 0; a < 2; ++a)
#pragma unroll
            for (int b = 0; b < 2; ++b)
#pragma unroll
                for (int m = 0; m < 4; ++m)
#pragma unroll
                    for (int n = 0; n < 2; ++n) acc[a][b][m][n] = (f32x4){0.f, 0.f, 0.f, 0.f};
        cur = nxt; cA = nA; cB = nB; ++ui;
        if constexpr (ALIGN_EPI) { if (wr == 1) PG8_BAR; }
    }
    PG8_WAIT_V(0);
    if constexpr (!ALIGN_EPI) { if (wr == 0) PG8_BAR; }
    PG8_BAR;
#undef PG8_SA
#undef PG8_SB
#undef PG8_STAGE
#undef PG8_LDA
#undef PG8_LDB
#undef PG8_MMA
#undef PG8_WAIT_V
#undef PG8_WAIT_L
#undef PG8_BAR
#undef PG8_SCHED
}
}

constexpr int DM = 1024;
constexpr int NTOK = 16400;
constexpr int PADL = 48;
constexpr int LPV = 16448;
constexpr int MP = 16640;
constexpr int MU = 16384;
constexpr int NCHUNK = 257;
constexpr int NHEAD = 8;
constexpr int NPROJ = 2560;
constexpr int KVROWS = 16512;
constexpr float EPS = 1e-6f;

constexpr size_t MiB = 1u << 20;
constexpr size_t WS_CTL = 0, CTL_ZERO_BYTES = 512 * 1024;
constexpr size_t WS_SSQ = 128 * 1024;
constexpr size_t WS_SSK = 256 * 1024;
constexpr size_t WS_SS4 = 384 * 1024;
constexpr size_t WS_WIN = 1 * MiB;
constexpr size_t WS_WUQ = 6 * MiB;
constexpr size_t WS_WUKV = 6 * MiB + 512 * 1024;
constexpr size_t WS_WOUT = 7 * MiB;
constexpr size_t WS_WPQ = 9 * MiB;
constexpr size_t WS_SKB = 13 * MiB;
constexpr size_t WS_IDX = 16 * MiB;
constexpr size_t WS_GATE = 24 * MiB;
constexpr size_t WS_HN = 16 * MiB;
constexpr size_t WS_QKVR = 101 * MiB;
constexpr size_t WS_Z = 150 * MiB;
constexpr size_t WS_P32 = 167 * MiB;
constexpr size_t WS_GA = 16 * MiB;
constexpr size_t WS_GQ = 33 * MiB;
constexpr size_t WS_GS = 67 * MiB;
constexpr size_t WS_GB = 84 * MiB;
constexpr size_t WS_GO = 50 * MiB;
constexpr size_t WS_MIX = 167 * MiB;
constexpr size_t WS_CQN = 200 * MiB;
constexpr size_t WS_CKVN = 208 * MiB + 512 * 1024;
constexpr size_t WS_QH = 101 * MiB;
constexpr size_t WS_KVB = 167 * MiB;
constexpr size_t WS_Q = 125 * MiB + 512 * 1024;
constexpr size_t WS_K = 220 * MiB;
constexpr size_t WS_VT = 200 * MiB;
constexpr size_t WS_XN = 32 * MiB;
constexpr size_t WS_PQ = 64 * MiB;
constexpr size_t WS_SC = 128 * MiB;
constexpr size_t WS_EU = 96 * MiB;
constexpr size_t WS_EV = 112 * MiB;
constexpr size_t WS_CW = 64 * MiB;
constexpr size_t WS_HP = 128 * MiB;
constexpr size_t WS_KPE = 217 * MiB;
constexpr size_t WS_END = 256 * MiB;
constexpr int CW_ATTQ = 8192;

constexpr int LDS_BYTES = 147456;
constexpr int MISC_OFF = 131072 + 12288;

DI unsigned f2bf(float f) { unsigned u = __builtin_bit_cast(unsigned, f); return (u + 0x7fffu + ((u >> 16) & 1u)) >> 16; }
DI unsigned pk2(float lo, float hi) { return f2bf(lo) | (f2bf(hi) << 16); }
DI float bf2f(unsigned b) { return __builtin_bit_cast(float, b << 16); }
DI float bflo(unsigned w) { return __builtin_bit_cast(float, w << 16); }
DI float bfhi(unsigned w) { return __builtin_bit_cast(float, w & 0xffff0000u); }
DI float wave_sum(float v) {
#pragma unroll
    for (int o = 1; o < 64; o <<= 1) v += __shfl_xor(v, o);
    return v;
}
DI float sigmoidf_(float x) { return 1.f / (1.f + __expf(-x)); }
DI float siluf_(float x) { return x / (1.f + __expf(-x)); }

#define XB_TMO      128
#define XB_XCNT(j)  (256  + 64 * (j))
#define XB_XSUB(j)  (1280 + 64 * (j))
#define XB_XGEN(j)  (2304 + 64 * (j))
#define XB_TOP      3328
#define XB_TOPGEN   3392
#define XCD_BAR_WORDS 3456
#define XB_SPIN_CAP (1u << 22)
DI unsigned xb_ld(unsigned* p)              { return __hip_atomic_load(p, __ATOMIC_RELAXED, __HIP_MEMORY_SCOPE_AGENT); }
DI unsigned xb_add(unsigned* p, unsigned v) { return __hip_atomic_fetch_add(p, v, __ATOMIC_RELAXED, __HIP_MEMORY_SCOPE_AGENT); }
DI unsigned xb_xcc_id() { return (unsigned)__builtin_amdgcn_s_getreg((3 << 11) | 20) & 0xFu; }
#define XB_SPIN(cond, bar) do { unsigned _sp = 0; while (cond) { __builtin_amdgcn_s_sleep(1); \
    if ((++_sp & 255u) == 0u) { if (xb_ld(&(bar)[XB_TMO])) break; if (_sp > XB_SPIN_CAP) { atomicAdd(&(bar)[XB_TMO], 1u); break; } } } } while (0)
struct XcdBarrier { unsigned* bar; unsigned x; volatile LAS unsigned* st; };
DI XcdBarrier xcd_barrier_post(unsigned* bar, volatile LAS unsigned* st) {
    XcdBarrier b; b.bar = bar; b.x = xb_xcc_id(); b.st = st;
    if (threadIdx.x == 0) (void)xb_add(&bar[XB_XCNT(b.x)], 1u);
    return b;
}
DI void xcd_barrier_complete(unsigned* bar, unsigned x, unsigned& nloc, unsigned& nx) {
    const unsigned G = gridDim.x * gridDim.y * gridDim.z;
    unsigned sum, cnt, mine, sp = 0u;
    for (;;) {
        sum = 0u; cnt = 0u; mine = 0u;
#pragma unroll
        for (unsigned j = 0; j < 16; ++j) { const unsigned c = xb_ld(&bar[XB_XCNT(j)]); sum += c; cnt += (c > 0u) ? 1u : 0u; mine = (j == x) ? c : mine; }
        if (sum == G) break;
        __builtin_amdgcn_s_sleep(1);
        if ((++sp & 255u) == 0u) { if (xb_ld(&bar[XB_TMO])) break; if (sp > XB_SPIN_CAP) { atomicAdd(&bar[XB_TMO], 1u); break; } }
    }
    nloc = mine > 0u ? mine : 1u; nx = cnt > 0u ? cnt : 1u;
}
DI void xcd_barrier(const XcdBarrier& b) {
    asm volatile("s_waitcnt vmcnt(0)" ::: "memory");
    __syncthreads();
    if (threadIdx.x == 0) {
        unsigned* bar = b.bar;
        __builtin_amdgcn_s_waitcnt(0);
        unsigned nloc = b.st[0], nx = b.st[1];
        if (nloc == 0u) { xcd_barrier_complete(bar, b.x, nloc, nx); b.st[0] = nloc; b.st[1] = nx; }
        const unsigned old = xb_add(&bar[XB_XSUB(b.x)], 1u);
        const unsigned gen = old / nloc;
        if (old + 1u == (gen + 1u) * nloc) {
            __builtin_amdgcn_fence(__ATOMIC_RELEASE, "agent");
            asm volatile("s_waitcnt vmcnt(0)" ::: "memory");
            const unsigned og = xb_add(&bar[XB_TOP], 1u);
            const unsigned tg = og / nx;
            if (og + 1u == (tg + 1u) * nx) xb_add(&bar[XB_TOPGEN], 1u);
            else XB_SPIN(xb_ld(&bar[XB_TOPGEN]) == tg, bar);
            __builtin_amdgcn_fence(__ATOMIC_ACQUIRE, "agent");
            xb_add(&bar[XB_XGEN(b.x)], 1u);
            asm volatile("s_waitcnt vmcnt(0)" ::: "memory");
        } else {
            XB_SPIN(xb_ld(&bar[XB_XGEN(b.x)]) == gen, bar);
            __builtin_amdgcn_fence(__ATOMIC_ACQUIRE, "agent");
            asm volatile("s_waitcnt vmcnt(0)" ::: "memory");
        }
    }
    __syncthreads();
}

struct Args {
    const float* in[20];
    float* out; unsigned char* ws;
    int ph_lo, ph_hi;
};
struct Frame {
    unsigned char* lds;
    int tid, lane, wave, G, gw, NGW;
};

template <class Map>
DI void transpose_item(const float* __restrict__ W, int Nsrc, bf16_t* __restrict__ WT, int ldk, float* scr, int item, int nblk, int lane, Map srcmap, const float* __restrict__ rowscale = nullptr) {
    const int kb = item / nblk, nb = item % nblk, k0 = 64 * kb, n0 = 32 * nb;
    const int ns = srcmap(n0 + (lane & 31));
#pragma unroll 8
    for (int i = 0; i < 32; ++i) { const int kk = 2 * i + (lane >> 5); float v = (ns >= 0) ? W[(size_t)(k0 + kk) * Nsrc + ns] : 0.f; if (rowscale) v *= rowscale[k0 + kk]; scr[kk * 33 + (lane & 31)] = v; }
    __builtin_amdgcn_s_waitcnt(0); __builtin_amdgcn_wave_barrier();
    const int c = lane & 7;
#pragma unroll
    for (int j = 0; j < 4; ++j) { const int n = (lane >> 3) + 8 * j; const float* s = scr + (8 * c) * 33 + n;
        u32x4 o; o.x = pk2(s[0 * 33], s[1 * 33]); o.y = pk2(s[2 * 33], s[3 * 33]); o.z = pk2(s[4 * 33], s[5 * 33]); o.w = pk2(s[6 * 33], s[7 * 33]);
        *(u32x4*)(WT + (size_t)(n0 + n) * ldk + k0 + 8 * c) = o; }
    __builtin_amdgcn_s_waitcnt(0); __builtin_amdgcn_wave_barrier();
}
struct MapId { DI int operator()(int n) const { return n; } };
struct MapWin {
    DI int operator()(int n) const {
        if (n < 2048) return n;
        if (n < 2304) return n + 16;
        if (n < 2432) return n + 16;
        if (n < 2464) return n + 16;
        if (n < 2472) return n - 416;
        if (n < 2480) return n - 416;
        return -1;
    }
};

template <int PART> DI void p0_late_weights(const Frame& F, const Args& A, int wi, int nwv, int ti, int nth) {
    unsigned char* ws = A.ws;
    float* scr = (float*)(F.lds + F.wave * 16384);
    const float* w_uq = A.in[10]; const float* w_ukv = A.in[11]; const float* w_out = A.in[14]; const float* w_pq = A.in[16]; const float* sub_keys = A.in[17];
    constexpr int I_UQ = 4 * 24, I_UKV = 2 * 32, I_OUT = 16 * 32, I_PQ = 16 * 64;
    constexpr int NITEMS = I_UQ + I_UKV + I_OUT + I_PQ;
    const int lo_ = PART == 0 ? 0 : I_UQ + I_UKV, hi_ = PART == 0 ? I_UQ + I_UKV : NITEMS;
    for (int it = lo_ + wi; it < hi_; it += nwv) {
        int r = it;
        if (r < I_UQ) { transpose_item(w_uq, 768, (bf16_t*)(ws + WS_WUQ), 256, scr, r, 24, F.lane, MapId(), A.in[8]); continue; } r -= I_UQ;
        if (r < I_UKV) { transpose_item(w_ukv, 1024, (bf16_t*)(ws + WS_WUKV), 256, scr, r, 32, F.lane, MapId(), A.in[9]); continue; } r -= I_UKV;
        if (r < I_OUT) { transpose_item(w_out, 1024, (bf16_t*)(ws + WS_WOUT), 1024, scr, r, 32, F.lane, MapId()); continue; } r -= I_OUT;
        transpose_item(w_pq, 2048, (bf16_t*)(ws + WS_WPQ), 1024, scr, r, 64, F.lane, MapId(), A.in[15]);
    }
    const int gt = ti, NGT = nth;
    if (PART == 0) for (int i = gt; i < 1024 * 16; i += NGT) { const int n = i >> 4, c = i & 15; *(u32x4*)((bf16_t*)(ws + WS_WUKV) + (size_t)n * 256 + 128 + c * 8) = (u32x4){0u, 0u, 0u, 0u}; }
    if (PART == 1) for (int i = gt; i < 2048 * 32; i += NGT) {
        const int n = i >> 5, c8 = (i & 31) * 8; const int p = (n >> 7) & 1;
        u32x4 o = (u32x4){0u, 0u, 0u, 0u};
        if ((c8 >> 7) == p) { const float* s = sub_keys + (size_t)n * 128 + (c8 & 127); const f32x4 a = *(const f32x4*)s, b = *(const f32x4*)(s + 4);
            o.x = pk2(a.x, a.y); o.y = pk2(a.z, a.w); o.z = pk2(b.x, b.y); o.w = pk2(b.z, b.w); }
        *(u32x4*)((bf16_t*)(ws + WS_SKB) + (size_t)n * 256 + c8) = o;
    }
}

DI void p0_prologue(const Frame& F, const Args& A) {
    unsigned char* ws = A.ws;
    float* scr = (float*)(F.lds + F.wave * 16384);
    const float* w_in = A.in[3]; const float* w_uq = A.in[10]; const float* w_ukv = A.in[11]; const float* w_out = A.in[14]; const float* w_pq = A.in[16]; const float* sub_keys = A.in[17];
    constexpr int I_IN = 16 * 80;
    for (int it = F.gw; it < I_IN; it += F.NGW) transpose_item(w_in, 2480, (bf16_t*)(ws + WS_WIN), 1024, scr, it, 80, F.lane, MapWin());
    const float* x = A.in[0]; const float* meta = A.in[1]; const float* anorm = A.in[2];
    bf16_t* HN = (bf16_t*)(ws + WS_HN);
    for (int p0 = F.gw; p0 < MP; p0 += 3 * F.NGW) {
        f32x4 v[3][4]; bool ok[3];
#pragma unroll
        for (int r = 0; r < 3; ++r) {
            const int p = p0 + r * F.NGW, t = p - PADL; ok[r] = (p < MP) && t >= 0 && t < NTOK;
            if (ok[r]) { const float* src = (t < 16) ? meta + (size_t)t * DM : x + (size_t)(t - 16) * DM; const f32x4* xr = (const f32x4*)src + F.lane;
#pragma unroll
                for (int j = 0; j < 4; ++j) v[r][j] = xr[64 * j]; }
            else {
#pragma unroll
                for (int j = 0; j < 4; ++j) v[r][j] = (f32x4){0.f, 0.f, 0.f, 0.f}; }
        }
#pragma unroll
        for (int r = 0; r < 3; ++r) {
            const int p = p0 + r * F.NGW; if (p >= MP) continue;
            unsigned long long* o8 = (unsigned long long*)(HN + (size_t)p * DM) + F.lane;
            float s = 0.f;
#pragma unroll
            for (int j = 0; j < 4; ++j) s += (v[r][j].x * v[r][j].x + v[r][j].y * v[r][j].y) + (v[r][j].z * v[r][j].z + v[r][j].w * v[r][j].w);
            const float rstd = ok[r] ? 1.f / sqrtf(wave_sum(s) * (1.f / DM) + EPS) : 0.f;
#pragma unroll
            for (int j = 0; j < 4; ++j) { const f32x4 w = ((const f32x4*)anorm)[64 * j + F.lane];
                o8[64 * j] = (unsigned long long)pk2(v[r][j].x * rstd * w.x, v[r][j].y * rstd * w.y) | ((unsigned long long)pk2(v[r][j].z * rstd * w.z, v[r][j].w * rstd * w.w) << 32); }
        }
    }
}

DI void row_ss_atomic(const f32x4 (&v)[2][2][4][2], float* SS, int row0, int fq, bool bj0_only) {
#pragma unroll
    for (int ai = 0; ai < 2; ++ai)
#pragma unroll
        for (int m = 0; m < 4; ++m) {
            float s = 0.f;
#pragma unroll
            for (int bj = 0; bj < 2; ++bj) if (bj == 0 || !bj0_only)
#pragma unroll
                for (int n = 0; n < 2; ++n) { const f32x4 x = v[ai][bj][m][n]; s += (x[0] * x[0] + x[1] * x[1]) + (x[2] * x[2] + x[3] * x[3]); }
            s += __shfl_xor(s, 16); s += __shfl_xor(s, 32);
            if (fq == 0) atomicAdd(SS + row0 + ai * 128 + m * 16, s);
        }
}
struct EpiProj {
    static constexpr bool PERM = true;
    bf16_t* QKVR; bf16_t* Z; float* P32; bf16_t* CQ16; bf16_t* CKV16; float* KPE; float* SSQ; float* SSK;
    DI void operator()(const f32x4 (&acc)[2][2][4][2], const pg8::Unit& u, int wr, int wc, int fr, int fq) const {
        const int row0 = u.pm * 256 + wr * 64 + fr;
        if (u.pn < 8) {
            bf16_t* base; int ld, colt;
            if (u.pn < 6) { base = QKVR; ld = 1536; colt = u.pn * 256; } else { base = Z; ld = 512; colt = (u.pn - 6) * 256; }
            const int col0 = colt + wc * 32 + 8 * fq;
#pragma unroll
            for (int ai = 0; ai < 2; ++ai)
#pragma unroll
                for (int m = 0; m < 4; ++m) { bf16_t* rowp = base + (size_t)(row0 + ai * 128 + m * 16) * ld + col0;
#pragma unroll
                    for (int bj = 0; bj < 2; ++bj) { const f32x4 v0 = acc[ai][bj][m][0], v1 = acc[ai][bj][m][1];
                        u32x4 w; w.x = pg8::cvt_pk_bf16(v0[0], v0[1]); w.y = pg8::cvt_pk_bf16(v0[2], v0[3]); w.z = pg8::cvt_pk_bf16(v1[0], v1[1]); w.w = pg8::cvt_pk_bf16(v1[2], v1[3]);
                        *(u32x4*)(rowp + bj * 128) = w; } }
        } else {
            const int lcol0 = wc * 32 + 8 * fq;
            bf16_t* b16 = (u.pn == 8) ? CQ16 : CKV16;
#pragma unroll
            for (int ai = 0; ai < 2; ++ai)
#pragma unroll
                for (int m = 0; m < 4; ++m) { const size_t row = (size_t)(row0 + ai * 128 + m * 16);
                    float* rowp = P32 + row * 512 + (u.pn - 8) * 256 + lcol0;
#pragma unroll
                    for (int bj = 0; bj < 2; ++bj) { const f32x4 v0 = acc[ai][bj][m][0], v1 = acc[ai][bj][m][1];
                        *(f32x4*)(rowp + bj * 128) = v0; *(f32x4*)(rowp + bj * 128 + 4) = v1;
                        u32x4 w; w.x = pg8::cvt_pk_bf16(v0[0], v0[1]); w.y = pg8::cvt_pk_bf16(v0[2], v0[3]); w.z = pg8::cvt_pk_bf16(v1[0], v1[1]); w.w = pg8::cvt_pk_bf16(v1[2], v1[3]);
                        *(u32x4*)(b16 + row * 256 + lcol0 + bj * 128) = w;
                        if (u.pn == 9 && bj == 1 && wc == 0) { *(f32x4*)(KPE + row * 32 + 8 * fq) = v0; *(f32x4*)(KPE + row * 32 + 8 * fq + 4) = v1; }
                    } }
            row_ss_atomic(acc, (u.pn == 8) ? SSQ : SSK, row0, fq, u.pn == 9);
        }
    }
};
struct EpiB16 {
    static constexpr bool PERM = true;
    bf16_t* O; int ldc; const float* SS; float invn;
    DI void operator()(const f32x4 (&acc)[2][2][4][2], const pg8::Unit& u, int wr, int wc, int fr, int fq) const {
        const int row0 = u.pm * 256 + wr * 64 + fr, col0 = u.pn * 256 + wc * 32 + 8 * fq;
#pragma unroll
        for (int ai = 0; ai < 2; ++ai)
#pragma unroll
            for (int m = 0; m < 4; ++m) { const int row = row0 + ai * 128 + m * 16; bf16_t* rowp = O + (size_t)row * ldc + col0;
                const float rs = SS ? 1.f / sqrtf(SS[row] * invn + EPS) : 1.f;
#pragma unroll
                for (int bj = 0; bj < 2; ++bj) { const f32x4 v0 = acc[ai][bj][m][0] * rs, v1 = acc[ai][bj][m][1] * rs;
                    u32x4 w; w.x = pg8::cvt_pk_bf16(v0[0], v0[1]); w.y = pg8::cvt_pk_bf16(v0[2], v0[3]); w.z = pg8::cvt_pk_bf16(v1[0], v1[1]); w.w = pg8::cvt_pk_bf16(v1[2], v1[3]);
                    *(u32x4*)(rowp + bj * 128) = w; } }
    }
};
struct EpiH1 {
    static constexpr bool PERM = true;
    float* C; const float* res; bf16_t* H16; float* SS;
    DI void operator()(const f32x4 (&acc)[2][2][4][2], const pg8::Unit& u, int wr, int wc, int fr, int fq) const {
        const int row0 = u.pm * 256 + wr * 64 + fr, col0 = u.pn * 256 + wc * 32 + 8 * fq;
        f32x4 v[2][2][4][2];
#pragma unroll
        for (int ai = 0; ai < 2; ++ai)
#pragma unroll
            for (int m = 0; m < 4; ++m) { const size_t off = (size_t)(row0 + ai * 128 + m * 16) * 1024 + col0;
#pragma unroll
                for (int bj = 0; bj < 2; ++bj) { const f32x4 v0 = acc[ai][bj][m][0] + *(const f32x4*)(res + off + bj * 128), v1 = acc[ai][bj][m][1] + *(const f32x4*)(res + off + bj * 128 + 4);
                    v[ai][bj][m][0] = v0; v[ai][bj][m][1] = v1;
                    *(f32x4*)(C + off + bj * 128) = v0; *(f32x4*)(C + off + bj * 128 + 4) = v1;
                    u32x4 w; w.x = pg8::cvt_pk_bf16(v0[0], v0[1]); w.y = pg8::cvt_pk_bf16(v0[2], v0[3]); w.z = pg8::cvt_pk_bf16(v1[0], v1[1]); w.w = pg8::cvt_pk_bf16(v1[2], v1[3]);
                    *(u32x4*)(H16 + off + bj * 128) = w; } }
        row_ss_atomic(v, SS, row0, fq, false);
    }
};
struct EpiF32 {
    static constexpr bool PERM = true;
    float* C; int ldc; const float* res;
    DI void operator()(const f32x4 (&acc)[2][2][4][2], const pg8::Unit& u, int wr, int wc, int fr, int fq) const {
        const int row0 = u.pm * 256 + wr * 64 + fr, col0 = u.pn * 256 + wc * 32 + 8 * fq;
#pragma unroll
        for (int ai = 0; ai < 2; ++ai)
#pragma unroll
            for (int m = 0; m < 4; ++m) { const size_t off = (size_t)(row0 + ai * 128 + m * 16) * ldc + col0;
#pragma unroll
                for (int bj = 0; bj < 2; ++bj) { f32x4 v0 = acc[ai][bj][m][0], v1 = acc[ai][bj][m][1];
                    if (res) { v0 += *(const f32x4*)(res + off + bj * 128); v1 += *(const f32x4*)(res + off + bj * 128 + 4); }
                    *(f32x4*)(C + off + bj * 128) = v0; *(f32x4*)(C + off + bj * 128 + 4) = v1; } }
    }
};

DI f32x16 mfma32(bf16x8 a, bf16x8 b, f32x16 c) { return __builtin_amdgcn_mfma_f32_32x32x16_bf16(a, b, c, 0, 0, 0); }
DI f32x4 mfma16(bf16x8 a, bf16x8 b, f32x4 c) { return __builtin_amdgcn_mfma_f32_16x16x32_bf16(a, b, c, 0, 0, 0); }
DI int crow(int r, int hi) { return (r & 3) + 8 * (r >> 2) + 4 * hi; }
DI f32x16 zero16() { f32x16 z;
#pragma unroll
    for (int i = 0; i < 16; ++i) z[i] = 0.f; return z; }

constexpr int G_KF = 0, G_VF = 16384, G_MF = 32768;
constexpr int G_QB = 50176, G_KB = 59392, G_KBB = 68608;
constexpr int G_QKB = 77824, G_UT = 87040, G_WT = 96256, G_KDT = 105472;
constexpr int G_VEC = 114688;
constexpr int G_RAW = G_QKB;
constexpr int GST = 72;

DI f32x16 mm_quad(const unsigned char* A, const unsigned char* Bt, int qr, int qc, int lane) {
    const int r32 = lane & 31, hh = lane >> 5;
    const unsigned char* ap = A + (32 * qr + r32) * (GST * 2) + hh * 16;
    const unsigned char* bp = Bt + (32 * qc + r32) * (GST * 2) + hh * 16;
    f32x16 acc = zero16();
#pragma unroll
    for (int s = 0; s < 4; ++s) acc = mfma32(*(const bf16x8*)(ap + s * 32), *(const bf16x8*)(bp + s * 32), acc);
    return acc;
}

constexpr int G_RAW2 = 115712;
static_assert(G_RAW2 + 67 * 400 <= 143360, "GDN prep LDS map");
constexpr int G_CONVW = 143360 + 512;

#ifndef PROBE_STAGE
#define PROBE_STAGE -1
#endif
template <int VAR> DI void gdn_prep_phase(const Frame& F, const Args& A) {
    unsigned long long stg_t = 0ull, stg_acc = 0ull;
#define STG(n) do { if (PROBE_STAGE >= 0) { const unsigned long long now_ = __builtin_amdgcn_s_memrealtime(); if (PROBE_STAGE == (n)) stg_acc += now_ - stg_t; stg_t = now_; } } while (0)
    unsigned char* ws = A.ws; unsigned char* lds = F.lds;
    const int tid = F.tid, lane = F.lane, wave = F.wave;
    const bf16_t* QKVR = (const bf16_t*)(ws + WS_QKVR); const float* P32 = (const float*)(ws + WS_P32);
    float* KF = (float*)(lds + G_KF); float* VF = (float*)(lds + G_VF); float* MF = (float*)(lds + G_MF);
    float* VEC = (float*)(lds + G_VEC);
    if (VAR == 6) return;
    const int NIT = NCHUNK * 8;
#define LBAR() do { asm volatile("s_waitcnt lgkmcnt(0)" ::: "memory"); __builtin_amdgcn_s_barrier(); asm volatile("" ::: "memory"); } while (0)
#define LAUNDER(dst, src) int dst = (src); asm volatile("" : "+v"(dst))
    int item = blockIdx.x;
    if (item >= NIT) return;
    u32x4 pr[4]; float nb = 0.f, na = 0.f;
    auto raw_fetch = [&](int it) {
        const int c = it >> 3, h = it & 7; LAUNDER(tl, tid);
#pragma unroll
        for (int i = 0; i < 4; ++i) { const int q = tl + 512 * i; pr[i] = (u32x4){0u, 0u, 0u, 0u};
            if (q < 67 * 24) { const int r = q / 24, cc = q % 24, seg = cc >> 3, c8 = cc & 7; const int p = 64 * c - 3 + r;
                if (p >= 0) pr[i] = *(const u32x4*)(QKVR + (size_t)p * 1536 + seg * 512 + h * 64 + c8 * 8); } }
        if (wave == 0) { const int p = 64 * c + lane; nb = P32[(size_t)p * 512 + 416 + h]; na = P32[(size_t)p * 512 + 424 + h]; }
    };
    auto raw_park = [&]() {
        LAUNDER(tl, tid);
#pragma unroll
        for (int i = 0; i < 4; ++i) { const int q = tl + 512 * i;
            if (q < 67 * 24) { const int r = q / 24, cc = q % 24, seg = cc >> 3, c8 = cc & 7; *(u32x4*)(lds + G_RAW2 + r * 400 + (seg * 64 + c8 * 8) * 2) = pr[i]; } }
    };
    raw_fetch(item); raw_park();
    float cb = nb, ca = na;
    float* CWL = (float*)(lds + G_CONVW);
    int cw_h = -1;
#pragma unroll 1
    for (; item < NIT; item += F.G) {
        if (PROBE_STAGE >= 0 && stg_t == 0ull) stg_t = __builtin_amdgcn_s_memrealtime();
        const int c = item >> 3, h = item & 7;
        if (h != cw_h) { cw_h = h;
            if (tid < 192) { LAUNDER(t0, tid); const int sg = t0 >> 6, jt = (t0 >> 4) & 3, c4 = t0 & 15; *(f32x4*)(CWL + (sg * 4 + jt) * 64 + 4 * c4) = *(const f32x4*)(A.in[4] + jt * 1536 + sg * 512 + h * 64 + 4 * c4); } }
        const int nxt = item + F.G;
        if (VAR != 5 && nxt < NIT) raw_fetch(nxt);
        if (wave == 0) {
            const int p = 64 * c + lane;
            const float alog = A.in[5][h], dtb = A.in[6][h];
            float beta = sigmoidf_(cb);
            const float xx = ca + dtb; const float sp = xx > 20.f ? xx : log1pf(__expf(xx));
            float g = -__expf(alog) * sp;
            if (p < PADL) { beta = 0.f; g = 0.f; }
            float gc = g;
#pragma unroll
            for (int o = 1; o < 64; o <<= 1) { const float t = __shfl_up(gc, o); if (lane >= o) gc += t; }
            const float glast = __shfl(gc, 63);
            VEC[lane] = gc; VEC[64 + lane] = beta; VEC[128 + lane] = __expf(gc); VEC[192 + lane] = __expf(glast - gc);
        }
        LBAR(); STG(0);
        LAUNDER(t1, tid); const int sub = t1 & 15, grp = t1 >> 4;
#pragma unroll
        for (int sg = 0; sg < ((VAR == 2 || VAR >= 4) ? 0 : 3); ++sg) {
#pragma unroll 1
            for (int ps = 0; ps < 2; ++ps) {
                const int i = grp + 32 * ps;
                float acc[4] = {0.f, 0.f, 0.f, 0.f};
#pragma unroll
                for (int jt = 0; jt < 4; ++jt) {
                    const f32x4 w = *(const f32x4*)(CWL + (sg * 4 + jt) * 64 + 4 * sub);
                    const u32x2 rv = *(const u32x2*)(lds + G_RAW2 + (i + jt) * 400 + (sg * 64 + 4 * sub) * 2);
                    acc[0] += w.x * bflo(rv.x); acc[1] += w.y * bfhi(rv.x); acc[2] += w.z * bflo(rv.y); acc[3] += w.w * bfhi(rv.y);
                }
                float y[4];
#pragma unroll
                for (int k = 0; k < 4; ++k) y[k] = siluf_(acc[k]);
                if (sg < 2) {
                    float ss = (y[0] * y[0] + y[1] * y[1]) + (y[2] * y[2] + y[3] * y[3]);
                    ss += __shfl_xor(ss, 1); ss += __shfl_xor(ss, 2); ss += __shfl_xor(ss, 4); ss += __shfl_xor(ss, 8);
                    const float rn = 1.f / sqrtf(ss + EPS);
#pragma unroll
                    for (int k = 0; k < 4; ++k) y[k] *= rn;
                }
                if (sg == 0) {
                    u32x2 o; o.x = pk2(y[0] * 0.125f, y[1] * 0.125f); o.y = pk2(y[2] * 0.125f, y[3] * 0.125f);
                    *(u32x2*)(lds + G_QB + i * (GST * 2) + 8 * sub) = o;
                } else if (sg == 1) {
                    const float beta = VEC[64 + i], ekd = VEC[192 + i];
                    *(f32x4*)(KF + i * 64 + 4 * sub) = (f32x4){y[0], y[1], y[2], y[3]};
                    u32x2 o; o.x = pk2(y[0], y[1]); o.y = pk2(y[2], y[3]);
                    *(u32x2*)(lds + G_KB + i * (GST * 2) + 8 * sub) = o;
                    o.x = pk2(y[0] * beta, y[1] * beta); o.y = pk2(y[2] * beta, y[3] * beta);
                    *(u32x2*)(lds + G_KBB + i * (GST * 2) + 8 * sub) = o;
#pragma unroll
                    for (int k = 0; k < 4; ++k) *(bf16_t*)(lds + G_KDT + (4 * sub + k) * (GST * 2) + i * 2) = (bf16_t)f2bf(y[k] * ekd);
                } else {
                    *(f32x4*)(VF + i * 64 + 4 * sub) = (f32x4){y[0], y[1], y[2], y[3]};
                }
            }
        }
        LBAR(); STG(1);
        if (VAR != 3 && VAR < 4) {
            LAUNDER(l3, lane);
            const int prod = wave >> 2, quad = wave & 3, qr = quad >> 1, qc = quad & 1, r32 = l3 & 31, hh = l3 >> 5;
            const f32x16 acc = mm_quad(lds + (prod ? G_QB : G_KBB), lds + G_KB, qr, qc, l3);
            const int j = 32 * qc + r32; const float gcj = VEC[j];
#pragma unroll
            for (int r = 0; r < 16; ++r) {
                const int i = 32 * qr + crow(r, hh);
                if (prod == 0) { MF[i * 68 + j] = (j < i) ? acc[r] * __expf(VEC[i] - gcj) : 0.f; }
                else { *(bf16_t*)(lds + G_QKB + i * (GST * 2) + j * 2) = (bf16_t)f2bf((j <= i) ? acc[r] * __expf(VEC[i] - gcj) : 0.f); }
            }
        }
        LBAR(); STG(2);
        float* DB = (float*)(lds + G_KBB);
        if (VAR != 1 && VAR < 4 && wave == 0) {
            LAUNDER(l4, lane); const int b = l4 >> 4, jc = l4 & 15;
            float d[16];
#pragma unroll
            for (int i = 0; i < 16; ++i) {
                float acc = (i == jc) ? 1.f : 0.f;
                const float* mrow = MF + (16 * b + i) * 68 + 16 * b;
#pragma unroll
                for (int k = 0; k < i; ++k) acc -= mrow[k] * d[k];
                d[i] = acc;
            }
#pragma unroll
            for (int i = 0; i < 16; ++i) DB[(b * 16 + i) * 20 + jc] = d[i];
        }
        LBAR();
        if (VAR != 1 && VAR < 4) {
            LAUNDER(l4, lane); const int cc = l4 & 15, g = l4 >> 4;
            const bool isU = wave < 4; const int col = 16 * (wave & 3) + cc;
            const float* src = (isU ? VF : KF) + col;
            f32x4 X[4];
#pragma unroll
            for (int b = 0; b < 4; ++b) {
                f32x4 acc;
#pragma unroll
                for (int r = 0; r < 4; ++r) { const int i = 16 * b + 4 * g + r; float rv = src[i * 64] * VEC[64 + i]; if (!isU) rv *= VEC[128 + i]; acc[r] = -rv; }
#pragma unroll
                for (int a = 0; a < b; ++a) {
                    const f32x4 lv = *(const f32x4*)(MF + (16 * b + cc) * 68 + 16 * a + 4 * g);
#pragma unroll
                    for (int sp = 0; sp < 4; ++sp) acc = __builtin_amdgcn_mfma_f32_16x16x4f32(lv[sp], X[a][sp], acc, 0, 0, 0);
                }
                const f32x4 dv = *(const f32x4*)(DB + (b * 16 + cc) * 20 + 4 * g);
                f32x4 xb = (f32x4){0.f, 0.f, 0.f, 0.f};
#pragma unroll
                for (int sp = 0; sp < 4; ++sp) xb = __builtin_amdgcn_mfma_f32_16x16x4f32(dv[sp], acc[sp], xb, 0, 0, 0);
                X[b] = -xb;
                unsigned char* dst = lds + (isU ? G_UT : G_WT) + col * (GST * 2) + (16 * b + 4 * g) * 2;
                *(u32x2*)dst = (u32x2){pk2(X[b][0], X[b][1]), pk2(X[b][2], X[b][3])};
            }
        }
        LBAR(); STG(3);
        if (VAR != 3 && VAR < 4) {
            const float gl = VEC[128 + 63];
            bf16_t* GB = (bf16_t*)(ws + WS_GB) + (size_t)item * 4096;
            bf16_t* GQ = (bf16_t*)(ws + (VAR ? WS_GS : WS_GQ)) + (size_t)item * 4096; bf16_t* GO = (bf16_t*)(ws + (VAR ? WS_GS : WS_GO)) + (size_t)item * 4096;
            bf16_t* GAL = (bf16_t*)(lds + G_MF);
            LAUNDER(l5, lane); const int r32 = l5 & 31, hh = l5 >> 5;
#pragma unroll 1
            for (int it = 0; it < 2; ++it) {
                const int task = wave + 8 * it, prod = task >> 2, quad = task & 3, qr = quad >> 1, qc = quad & 1;
                const f32x16 acc = mm_quad(lds + (prod < 2 ? G_KDT : G_QKB), lds + ((prod & 1) ? G_UT : G_WT), qr, qc, l5);
                const int Cc = 32 * qc + r32;
                if (prod == 0) {
#pragma unroll
                    for (int r = 0; r < 16; ++r) {
                        const int R = 32 * qr + crow(r, hh);
                        const float val = ((R == Cc) ? gl : 0.f) - acc[r];
                        const int rb = R >> 4, m = R & 15, q4 = Cc >> 4, g = (Cc >> 2) & 3, rr = Cc & 3, ks = q4 >> 1, jj = 4 * (q4 & 1) + rr, ls = 16 * g + m;
                        GAL[((rb * 2 + ks) * 64 + ls) * 8 + jj] = (bf16_t)f2bf(val);
                    }
                } else if (prod == 1) {
                    const int eslab = Cc >> 4, n = Cc & 15;
#pragma unroll
                    for (int a = 0; a < 4; ++a) {
                        const int R0 = 32 * qr + 8 * a + 4 * hh; const int rb = R0 >> 4, g = (R0 >> 2) & 3, ls = 16 * g + n;
                        *(u32x2*)(GB + ((eslab * 4 + rb) * 64 + ls) * 4) = (u32x2){pk2(acc[4 * a], acc[4 * a + 1]), pk2(acc[4 * a + 2], acc[4 * a + 3])};
                    }
                } else if (prod == 2) {
#pragma unroll
                    for (int r = 0; r < 16; ++r) {
                        const int R = 32 * qr + crow(r, hh);
                        const float qv = bf2f(*(const bf16_t*)(lds + G_QB + R * (GST * 2) + Cc * 2));
                        GQ[R * 64 + Cc] = (bf16_t)f2bf(qv * VEC[128 + R] - acc[r]);
                    }
                } else {
#pragma unroll
                    for (int r = 0; r < 16; ++r) GO[(quad * 16 + r) * 64 + l5] = (bf16_t)f2bf(acc[r]);
                }
            }
        }
        if (VAR != 5 && nxt < NIT) { raw_park(); cb = nb; ca = na; }
        LBAR(); STG(4);
        if (VAR != 5) { LAUNDER(t6, tid); *(u32x4*)((bf16_t*)(ws + (VAR ? WS_GS : WS_GA)) + (size_t)item * 4096 + t6 * 8) = *(const u32x4*)(lds + G_MF + t6 * 16); }
        STG(5);
    }
    if (PROBE_STAGE >= 0 && tid == 0) { *(unsigned long long*)(lds + 143360 + 96) = stg_acc; }
}

constexpr int SC_D = 8, SC_PD = 6, SC_SLOT = 10240;
DI void gdn_scan(const Frame& F, const Args& A) {
    if (blockIdx.x >= 32) return;
    unsigned char* ws = A.ws;
    const int h = blockIdx.x & 7, eslab = blockIdx.x >> 3, lane = F.lane, wave = F.wave, n = lane & 15, g = lane >> 4;
    const unsigned char* GA = ws + WS_GA; const unsigned char* GB = ws + WS_GB; bf16_t* GS = (bf16_t*)(ws + WS_GS);
    LAS unsigned char* ring = (LAS unsigned char*)F.lds;
    const int np = (wave == 0) ? 0 : ((wave - 1 < 3) ? 2 : 1);
    auto issue = [&](int c) {
        const int cc = c < NCHUNK ? c : NCHUNK - 1;
        const size_t item = (size_t)cc * 8 + h;
        LAS unsigned char* slot = ring + (c % SC_D) * SC_SLOT;
#pragma unroll
        for (int i = 0; i < 2; ++i) if (i < np) {
            const int q = (wave - 1) + 7 * i;
            const unsigned char* src = (q < 8) ? GA + item * 8192 + q * 1024 : GB + item * 8192 + eslab * 2048 + (q - 8) * 1024;
            LAS unsigned char* dst = slot + ((q < 8) ? q * 1024 : 8192 + (q - 8) * 1024);
            __builtin_amdgcn_global_load_lds((const unsigned*)(src + lane * 16), (LAS unsigned*)dst, 16, 0, 0);
        }
    };
    for (int c = 0; c < SC_PD; ++c) issue(c);
    f32x4 S[4];
#pragma unroll
    for (int rb = 0; rb < 4; ++rb) S[rb] = (f32x4){0.f, 0.f, 0.f, 0.f};
#pragma unroll 1
    for (int c = 0; c < NCHUNK; ++c) {
        issue(c + SC_PD);
        if (np == 2) asm volatile("s_waitcnt vmcnt(12)" ::: "memory");
        else if (np == 1) asm volatile("s_waitcnt vmcnt(6)" ::: "memory");
        asm volatile("s_waitcnt lgkmcnt(0)" ::: "memory");
        __builtin_amdgcn_s_barrier();
        asm volatile("" ::: "memory");
        if (wave == 0) {
            const LAS unsigned char* slot = ring + (c % SC_D) * SC_SLOT;
            bf16x8 ac[8]; f32x4 bc[4];
#pragma unroll
            for (int q = 0; q < 8; ++q) ac[q] = *(const LAS bf16x8*)(slot + q * 1024 + lane * 16);
#pragma unroll
            for (int rb = 0; rb < 4; ++rb) { const u32x2 w = *(const LAS u32x2*)(slot + 8192 + rb * 512 + lane * 8); bc[rb] = (f32x4){bflo(w.x), bfhi(w.x), bflo(w.y), bfhi(w.y)}; }
            const size_t item = (size_t)c * 8 + h;
            u32x4 p0, p1;
            p0.x = pk2(S[0][0], S[0][1]); p0.y = pk2(S[0][2], S[0][3]); p0.z = pk2(S[1][0], S[1][1]); p0.w = pk2(S[1][2], S[1][3]);
            p1.x = pk2(S[2][0], S[2][1]); p1.y = pk2(S[2][2], S[2][3]); p1.z = pk2(S[3][0], S[3][1]); p1.w = pk2(S[3][2], S[3][3]);
            {
                bf16_t* st = GS + item * 4096 + (16 * eslab + n) * 64 + 4 * g;
                *(u32x2*)(st + 0) = (u32x2){p0.x, p0.y}; *(u32x2*)(st + 16) = (u32x2){p0.z, p0.w};
                *(u32x2*)(st + 32) = (u32x2){p1.x, p1.y}; *(u32x2*)(st + 48) = (u32x2){p1.z, p1.w};
            }
            const bf16x8 b0 = __builtin_bit_cast(bf16x8, p0), b1 = __builtin_bit_cast(bf16x8, p1);
#pragma unroll
            for (int rb = 0; rb < 4; ++rb) {
                f32x4 acc = bc[rb];
                acc = mfma16(ac[rb * 2 + 0], b0, acc);
                acc = mfma16(ac[rb * 2 + 1], b1, acc);
                S[rb] = acc;
            }
        }
    }
    asm volatile("s_waitcnt vmcnt(0) lgkmcnt(0)" ::: "memory");
    __builtin_amdgcn_s_barrier();
}

DI void gdn_out_task(const Frame& F, const Args& A, int task) {
    unsigned char* ws = A.ws;
    const int ihalf = task & 1, item = (task >> 1) + 8, c = item >> 3, h = item & 7, lane = F.lane, r32 = lane & 31, hh = lane >> 5;
    const bf16_t* GQ = (const bf16_t*)(ws + WS_GQ) + (size_t)item * 4096; const bf16_t* GS = (const bf16_t*)(ws + WS_GS) + (size_t)item * 4096;
    const bf16_t* GO = (const bf16_t*)(ws + WS_GO) + (size_t)item * 4096;
    const bf16_t* Z = (const bf16_t*)(ws + WS_Z); bf16_t* MIX = (bf16_t*)(ws + WS_MIX);
    f32x16 acc[2];
#pragma unroll
    for (int eh = 0; eh < 2; ++eh)
#pragma unroll
        for (int r = 0; r < 16; ++r) acc[eh][r] = bf2f(GO[((ihalf * 2 + eh) * 16 + r) * 64 + lane]);
#pragma unroll
    for (int s = 0; s < 4; ++s) {
        const bf16x8 a = *(const bf16x8*)(GQ + (32 * ihalf + r32) * 64 + 16 * s + 8 * hh);
#pragma unroll
        for (int eh = 0; eh < 2; ++eh) {
            const bf16x8 b = *(const bf16x8*)(GS + (32 * eh + r32) * 64 + 16 * s + 8 * hh);
            acc[eh] = mfma32(a, b, acc[eh]);
        }
    }
    const float* gnorm = A.in[7];
    const float w0 = gnorm[r32], w1 = gnorm[32 + r32];
#pragma unroll
    for (int r = 0; r < 16; ++r) {
        float ss = acc[0][r] * acc[0][r] + acc[1][r] * acc[1][r];
        ss += __shfl_xor(ss, 1); ss += __shfl_xor(ss, 2); ss += __shfl_xor(ss, 4); ss += __shfl_xor(ss, 8); ss += __shfl_xor(ss, 16);
        const float rstd = 1.f / sqrtf(ss * (1.f / 64.f) + EPS);
        const int i = 32 * ihalf + crow(r, hh); const int p = 64 * c + i;
        const float z0 = bf2f(Z[(size_t)p * 512 + h * 64 + r32]), z1 = bf2f(Z[(size_t)p * 512 + h * 64 + 32 + r32]);
        bf16_t* o = MIX + (size_t)(p - 64) * 1024 + h * 64;
        o[r32] = (bf16_t)f2bf(acc[0][r] * rstd * w0 * siluf_(z0));
        o[32 + r32] = (bf16_t)f2bf(acc[1][r] * rstd * w1 * siluf_(z1));
    }
}

DI void mla_prep1_rows(const Frame& F, const Args& A, int p0, int stride) {
    unsigned char* ws = A.ws; const int lane = F.lane;
    f32x4 q[4]; float k0[4], k1[4], pe[4];
#pragma unroll
    for (int r = 0; r < 4; ++r) { const int p = p0 + r * stride; const int pc = p < MP ? p : MP - 1;
        const float* P32 = (const float*)(ws + WS_P32) + (size_t)pc * 512;
        q[r] = *(const f32x4*)(P32 + 4 * lane); k0[r] = P32[256 + 2 * lane]; k1[r] = P32[256 + 2 * lane + 1]; pe[r] = P32[384 + (lane & 31)]; }
    const f32x4 wq = *(const f32x4*)(A.in[8] + 4 * lane);
    const float wk0 = A.in[9][2 * lane], wk1 = A.in[9][2 * lane + 1];
#pragma unroll
    for (int r = 0; r < 4; ++r) {
        const int p = p0 + r * stride; if (p >= MP) continue;
        bf16_t* CQN = (bf16_t*)(ws + WS_CQN) + (size_t)p * 256; bf16_t* CKVN = (bf16_t*)(ws + WS_CKVN) + (size_t)p * 256;
        const float sq = wave_sum((q[r].x * q[r].x + q[r].y * q[r].y) + (q[r].z * q[r].z + q[r].w * q[r].w));
        const float rq = 1.f / sqrtf(sq * (1.f / 256.f) + EPS);
        *(u32x2*)(CQN + 4 * lane) = (u32x2){pk2(q[r].x * rq * wq.x, q[r].y * rq * wq.y), pk2(q[r].z * rq * wq.z, q[r].w * rq * wq.w)};
        const float sk = wave_sum(k0[r] * k0[r] + k1[r] * k1[r]);
        const float rk = 1.f / sqrtf(sk * (1.f / 128.f) + EPS);
        *(unsigned*)(CKVN + 2 * lane) = pk2(k0[r] * rk * wk0, k1[r] * rk * wk1);
        *(unsigned*)(CKVN + 128 + 2 * lane) = 0u;
        if (lane < 32) ((float*)(ws + WS_KPE))[(size_t)p * 32 + lane] = pe[r];
    }
}

constexpr float QSCALE = 0.10206207261596577f * 1.4426950408889634f;
DI double rope_inv_rev(int i) {
    const double t8[8] = {0.15915494309189535, 0.08949940160889101, 0.050329212104487035, 0.0283021958306234, 0.015915494309189534, 0.008949940160889102, 0.005032921210448704, 0.00283021958306234};
    double v = t8[0];
#pragma unroll
    for (int k = 1; k < 8; ++k) v = ((i & 7) == k) ? t8[k] : v;
    return (i & 8) ? v * 0.01 : v;
}
constexpr int P2_TS = 136;
DI void mla_prep2_task(const Frame& F, const Args& A, int task) {
    unsigned char* ws = A.ws; const int lane = F.lane, h = task & 7, blk = task >> 3;
    const int p = 64 * blk + lane;
    const bool valid = (p >= PADL) && (p < LPV);
    const float* qn = A.in[12]; const float* kn = A.in[13];
    float sn[16], cs[16];
    { const double pos = (double)(p - PADL);
#pragma unroll
      for (int i = 0; i < 16; ++i) { const double rev = pos * rope_inv_rev(i); const float fr = (float)(rev - floor(rev)); sn[i] = __builtin_amdgcn_sinf(fr); cs[i] = __builtin_amdgcn_cosf(fr); } }
    {
        const bf16_t* src = (const bf16_t*)(ws + WS_QH) + (size_t)p * 768 + h * 96;
        u32x4 w[12];
#pragma unroll
        for (int c = 0; c < 12; ++c) w[c] = *(const u32x4*)(src + 8 * c);
        float ss = 0.f;
#pragma unroll
        for (int c = 0; c < 12; ++c) { const float a0 = bflo(w[c].x), a1 = bfhi(w[c].x), a2 = bflo(w[c].y), a3 = bfhi(w[c].y), a4 = bflo(w[c].z), a5 = bfhi(w[c].z), a6 = bflo(w[c].w), a7 = bfhi(w[c].w);
            ss += (a0 * a0 + a1 * a1) + (a2 * a2 + a3 * a3) + (a4 * a4 + a5 * a5) + (a6 * a6 + a7 * a7); }
        const float rs = valid ? QSCALE / sqrtf(ss * (1.f / 96.f) + EPS) : 0.f;
        bf16_t* dst = (bf16_t*)(ws + WS_Q) + ((size_t)h * KVROWS + p) * 96;
#pragma unroll
        for (int c = 0; c < 8; ++c) {
            const f32x4 g0 = *(const f32x4*)(qn + 8 * c), g1 = *(const f32x4*)(qn + 8 * c + 4);
            *(u32x4*)(dst + 8 * c) = (u32x4){pk2(bflo(w[c].x) * rs * g0.x, bfhi(w[c].x) * rs * g0.y), pk2(bflo(w[c].y) * rs * g0.z, bfhi(w[c].y) * rs * g0.w),
                                             pk2(bflo(w[c].z) * rs * g1.x, bfhi(w[c].z) * rs * g1.y), pk2(bflo(w[c].w) * rs * g1.z, bfhi(w[c].w) * rs * g1.w)};
        }
#pragma unroll
        for (int c = 0; c < 2; ++c) {
            float x1[8], x2[8];
            const u32x4 wa = w[8 + c], wb = w[10 + c];
            x1[0] = bflo(wa.x); x1[1] = bfhi(wa.x); x1[2] = bflo(wa.y); x1[3] = bfhi(wa.y); x1[4] = bflo(wa.z); x1[5] = bfhi(wa.z); x1[6] = bflo(wa.w); x1[7] = bfhi(wa.w);
            x2[0] = bflo(wb.x); x2[1] = bfhi(wb.x); x2[2] = bflo(wb.y); x2[3] = bfhi(wb.y); x2[4] = bflo(wb.z); x2[5] = bfhi(wb.z); x2[6] = bflo(wb.w); x2[7] = bfhi(wb.w);
            float o1[8], o2[8];
#pragma unroll
            for (int t = 0; t < 8; ++t) { const float a = x1[t] * rs * qn[64 + 8 * c + t], b = x2[t] * rs * qn[80 + 8 * c + t]; o1[t] = a * cs[8 * c + t] - b * sn[8 * c + t]; o2[t] = b * cs[8 * c + t] + a * sn[8 * c + t]; }
            *(u32x4*)(dst + 64 + 8 * c) = (u32x4){pk2(o1[0], o1[1]), pk2(o1[2], o1[3]), pk2(o1[4], o1[5]), pk2(o1[6], o1[7])};
            *(u32x4*)(dst + 80 + 8 * c) = (u32x4){pk2(o2[0], o2[1]), pk2(o2[2], o2[3]), pk2(o2[4], o2[5]), pk2(o2[6], o2[7])};
        }
    }
    {
        const bf16_t* src = (const bf16_t*)(ws + WS_KVB) + (size_t)p * 1024 + h * 128;
        const float* kpe = (const float*)(ws + WS_KPE) + (size_t)p * 32;
        u32x4 w[8]; f32x4 e[8];
#pragma unroll
        for (int c = 0; c < 8; ++c) { w[c] = *(const u32x4*)(src + 8 * c); e[c] = *(const f32x4*)(kpe + 4 * c); }
        float ss = 0.f;
#pragma unroll
        for (int c = 0; c < 8; ++c) { const float a0 = bflo(w[c].x), a1 = bfhi(w[c].x), a2 = bflo(w[c].y), a3 = bfhi(w[c].y), a4 = bflo(w[c].z), a5 = bfhi(w[c].z), a6 = bflo(w[c].w), a7 = bfhi(w[c].w);
            ss += (a0 * a0 + a1 * a1) + (a2 * a2 + a3 * a3) + (a4 * a4 + a5 * a5) + (a6 * a6 + a7 * a7);
            ss += (e[c].x * e[c].x + e[c].y * e[c].y) + (e[c].z * e[c].z + e[c].w * e[c].w); }
        const float rs = valid ? 1.f / sqrtf(ss * (1.f / 96.f) + EPS) : 0.f;
        bf16_t* dst = (bf16_t*)(ws + WS_K) + ((size_t)h * KVROWS + p) * 96;
#pragma unroll
        for (int c = 0; c < 8; ++c) {
            const f32x4 g0 = *(const f32x4*)(kn + 8 * c), g1 = *(const f32x4*)(kn + 8 * c + 4);
            *(u32x4*)(dst + 8 * c) = (u32x4){pk2(bflo(w[c].x) * rs * g0.x, bfhi(w[c].x) * rs * g0.y), pk2(bflo(w[c].y) * rs * g0.z, bfhi(w[c].y) * rs * g0.w),
                                             pk2(bflo(w[c].z) * rs * g1.x, bfhi(w[c].z) * rs * g1.y), pk2(bflo(w[c].w) * rs * g1.z, bfhi(w[c].w) * rs * g1.w)};
        }
#pragma unroll
        for (int c = 0; c < 2; ++c) {
            const float x1[8] = {e[2 * c].x, e[2 * c].y, e[2 * c].z, e[2 * c].w, e[2 * c + 1].x, e[2 * c + 1].y, e[2 * c + 1].z, e[2 * c + 1].w};
            const float x2[8] = {e[4 + 2 * c].x, e[4 + 2 * c].y, e[4 + 2 * c].z, e[4 + 2 * c].w, e[5 + 2 * c].x, e[5 + 2 * c].y, e[5 + 2 * c].z, e[5 + 2 * c].w};
            float o1[8], o2[8];
#pragma unroll
            for (int t = 0; t < 8; ++t) { const float a = x1[t] * rs * kn[64 + 8 * c + t], b = x2[t] * rs * kn[80 + 8 * c + t]; o1[t] = a * cs[8 * c + t] - b * sn[8 * c + t]; o2[t] = b * cs[8 * c + t] + a * sn[8 * c + t]; }
            *(u32x4*)(dst + 64 + 8 * c) = (u32x4){pk2(o1[0], o1[1]), pk2(o1[2], o1[3]), pk2(o1[4], o1[5]), pk2(o1[6], o1[7])};
            *(u32x4*)(dst + 80 + 8 * c) = (u32x4){pk2(o2[0], o2[1]), pk2(o2[2], o2[3]), pk2(o2[4], o2[5]), pk2(o2[6], o2[7])};
        }
    }
    {
        unsigned char* T = F.lds + F.wave * (64 * P2_TS);
        const bf16_t* src = (const bf16_t*)(ws + WS_KVB) + h * 128 + 64;
#pragma unroll
        for (int it = 0; it < 8; ++it) {
            const int pr = 8 * it + (lane >> 3), ch = lane & 7; const int pp = 64 * blk + pr;
            u32x4 v = (u32x4){0u, 0u, 0u, 0u};
            if (pp >= PADL && pp < LPV) v = *(const u32x4*)(src + (size_t)pp * 1024 + 8 * ch);
            unsigned char* tp = T + (8 * ch) * P2_TS + pr * 2;
            *(bf16_t*)(tp + 0 * P2_TS) = (bf16_t)(v.x & 0xffffu); *(bf16_t*)(tp + 1 * P2_TS) = (bf16_t)(v.x >> 16);
            *(bf16_t*)(tp + 2 * P2_TS) = (bf16_t)(v.y & 0xffffu); *(bf16_t*)(tp + 3 * P2_TS) = (bf16_t)(v.y >> 16);
            *(bf16_t*)(tp + 4 * P2_TS) = (bf16_t)(v.z & 0xffffu); *(bf16_t*)(tp + 5 * P2_TS) = (bf16_t)(v.z >> 16);
            *(bf16_t*)(tp + 6 * P2_TS) = (bf16_t)(v.w & 0xffffu); *(bf16_t*)(tp + 7 * P2_TS) = (bf16_t)(v.w >> 16);
        }
        __builtin_amdgcn_s_waitcnt(0); __builtin_amdgcn_wave_barrier();
        bf16_t* VT = (bf16_t*)(ws + WS_VT) + (size_t)h * 64 * KVROWS + 64 * blk;
#pragma unroll
        for (int it = 0; it < 8; ++it) {
            const int e = 8 * it + (lane >> 3), ch = lane & 7;
            const u32x2 lo = *(const u32x2*)(T + e * P2_TS + 16 * ch), hi = *(const u32x2*)(T + e * P2_TS + 16 * ch + 8);
            *(u32x4*)(VT + (size_t)e * KVROWS + 8 * ch) = (u32x4){lo.x, lo.y, hi.x, hi.y};
        }
        __builtin_amdgcn_s_waitcnt(0); __builtin_amdgcn_wave_barrier();
    }
}

constexpr int A_KSTR = 208;
constexpr int A_VSTR = 136;
constexpr int A_KBYTES = 64 * A_KSTR;
constexpr int A_VBYTES = 64 * A_VSTR;
constexpr int A_BUF = A_KBYTES + A_VBYTES;
DI unsigned cvtpk_s(float lo, float hi) { typedef float f2 __attribute__((ext_vector_type(2))); typedef __bf16 b2 __attribute__((ext_vector_type(2))); f2 v = {lo, hi}; b2 b = __builtin_convertvector(v, b2); return __builtin_bit_cast(unsigned, b); }

DI void attn_item(const Frame& F, const Args& A, int h, int qb) {
    unsigned char* ws = A.ws; unsigned char* lds = F.lds;
    const int tid = F.tid, lane = F.lane, wave = F.wave, r32 = lane & 31, hh = lane >> 5;
    const bf16_t* Qg = (const bf16_t*)(ws + WS_Q) + (size_t)h * KVROWS * 96;
    const bf16_t* Kg = (const bf16_t*)(ws + WS_K) + (size_t)h * KVROWS * 96;
    const bf16_t* Vg = (const bf16_t*)(ws + WS_VT) + (size_t)h * 64 * KVROWS;
    const int p0w = 64 + 256 * qb + 32 * wave;
    const int qp = p0w + r32;
    const int ntile = 4 * qb + 5;
    const int mylast = 1 + 4 * qb + (wave >> 1);
    bf16x8 qf[6];
#pragma unroll
    for (int s = 0; s < 6; ++s) qf[s] = *(const bf16x8*)(Qg + (size_t)qp * 96 + 16 * s + 8 * hh);
    f32x16 ot[2]; ot[0] = zero16(); ot[1] = zero16();
    float mrun = -1e30f, lrun = 0.f;
    const int kr0 = tid / 12, kc0 = tid % 12, kr1 = (tid + 512) / 12, kc1 = (tid + 512) % 12; const bool k1ok = tid < 256;
    const int vr = tid >> 3, vc = tid & 7;
    struct Stg { u32x4 k0, k1, v; };
    Stg sA, sB;
    auto gload = [&](Stg& st, int j) {
        const int kv0 = 64 * j;
        st.k0 = *(const u32x4*)(Kg + (size_t)(kv0 + kr0) * 96 + kc0 * 8);
        if (k1ok) st.k1 = *(const u32x4*)(Kg + (size_t)(kv0 + kr1) * 96 + kc1 * 8);
        st.v = *(const u32x4*)(Vg + (size_t)vr * KVROWS + kv0 + vc * 8);
    };
    auto lstore = [&](const Stg& st, int b) {
        unsigned char* kb = lds + b * A_BUF; unsigned char* vb = kb + A_KBYTES;
        *(u32x4*)(kb + kr0 * A_KSTR + kc0 * 16) = st.k0;
        if (k1ok) *(u32x4*)(kb + kr1 * A_KSTR + kc1 * 16) = st.k1;
        *(u32x2*)(vb + vr * A_VSTR + vc * 16) = (u32x2){st.v.x, st.v.y};
        *(u32x2*)(vb + vr * A_VSTR + vc * 16 + 8) = (u32x2){st.v.z, st.v.w};
    };
    gload(sA, 0); lstore(sA, 0); gload(sB, 1);
    __syncthreads();
    auto step = [&](int j, Stg& sNext  , Stg& sFree  ) {
        const int b = j & 1;
        if (j + 2 < ntile) gload(sFree, j + 2);
        if (j <= mylast) {
            const unsigned char* kb = lds + b * A_BUF; const unsigned char* vb = kb + A_KBYTES;
            f32x16 sc[2];
#pragma unroll
            for (int kh = 0; kh < 2; ++kh) {
                f32x16 acc = zero16();
                const unsigned char* kp = kb + (32 * kh + r32) * A_KSTR + hh * 16;
#pragma unroll
                for (int s = 0; s < 6; ++s) acc = mfma32(*(const bf16x8*)(kp + s * 32), qf[s], acc);
                sc[kh] = acc;
            }
            if (j == 0) {
#pragma unroll
                for (int kh = 0; kh < 2; ++kh)
#pragma unroll
                    for (int r = 0; r < 16; ++r) { const int kv = 32 * kh + crow(r, hh); if (kv < PADL) sc[kh][r] = -INFINITY; }
            }
            if (j == mylast) {
#pragma unroll
                for (int kh = 0; kh < 2; ++kh)
#pragma unroll
                    for (int r = 0; r < 16; ++r) { const int kv = 64 * j + 32 * kh + crow(r, hh); if (kv > qp) sc[kh][r] = -INFINITY; }
            }
            float mx = sc[0][0];
#pragma unroll
            for (int r = 1; r < 16; ++r) mx = fmaxf(mx, sc[0][r]);
#pragma unroll
            for (int r = 0; r < 16; ++r) mx = fmaxf(mx, sc[1][r]);
            mx = fmaxf(mx, __shfl_xor(mx, 32));
            const float mnew = fmaxf(mrun, mx);
            const float alpha = __builtin_amdgcn_exp2f(mrun - mnew);
            mrun = mnew;
            float ps = 0.f;
#pragma unroll
            for (int kh = 0; kh < 2; ++kh)
#pragma unroll
                for (int r = 0; r < 16; ++r) { const float e = __builtin_amdgcn_exp2f(sc[kh][r] - mnew); sc[kh][r] = e; ps += e; }
            lrun = lrun * alpha + ps;
#pragma unroll
            for (int eh = 0; eh < 2; ++eh)
#pragma unroll
                for (int r = 0; r < 16; ++r) ot[eh][r] *= alpha;
#pragma unroll
            for (int kh = 0; kh < 2; ++kh)
#pragma unroll
                for (int s2 = 0; s2 < 2; ++s2) {
                    u32x4 pw; pw.x = cvtpk_s(sc[kh][8 * s2 + 0], sc[kh][8 * s2 + 1]); pw.y = cvtpk_s(sc[kh][8 * s2 + 2], sc[kh][8 * s2 + 3]);
                    pw.z = cvtpk_s(sc[kh][8 * s2 + 4], sc[kh][8 * s2 + 5]); pw.w = cvtpk_s(sc[kh][8 * s2 + 6], sc[kh][8 * s2 + 7]);
                    const bf16x8 pf = __builtin_bit_cast(bf16x8, pw);
#pragma unroll
                    for (int eh = 0; eh < 2; ++eh) {
                        const unsigned char* vp = vb + (32 * eh + r32) * A_VSTR + (32 * kh + 16 * s2 + 4 * hh) * 2;
                        const u32x2 lo = *(const u32x2*)vp, hi2 = *(const u32x2*)(vp + 16);
                        const bf16x8 vf = __builtin_bit_cast(bf16x8, (u32x4){lo.x, lo.y, hi2.x, hi2.y});
                        ot[eh] = mfma32(vf, pf, ot[eh]);
                    }
                }
        }
        if (j + 1 < ntile) lstore(sNext, b ^ 1);
        __syncthreads();
    };
#pragma unroll 1
    for (int j = 0; j < ntile; j += 2) {
        step(j, sB, sA);
        if (j + 1 < ntile) step(j + 1, sA, sB);
    }
    const float ltot = lrun + __shfl_xor(lrun, 32);
    const float rl = 1.f / ltot;
    bf16_t* o = (bf16_t*)(ws + WS_MIX) + (size_t)(qp - 64) * 1024 + 512 + h * 64;
#pragma unroll
    for (int eh = 0; eh < 2; ++eh)
#pragma unroll
        for (int a = 0; a < 4; ++a) {
            const int e = 32 * eh + 8 * a + 4 * hh;
            *(u32x2*)(o + e) = (u32x2){pk2(ot[eh][4 * a] * rl, ot[eh][4 * a + 1] * rl), pk2(ot[eh][4 * a + 2] * rl, ot[eh][4 * a + 3] * rl)};
        }
}

DI void xn_rows(const Frame& F, const Args& A, int u0, int stride) {
    f32x4 v[2][4];
#pragma unroll
    for (int r = 0; r < 2; ++r) { const int u = u0 + r * stride; if (u < MU) { const f32x4* xr = (const f32x4*)(A.out + (size_t)u * DM) + F.lane;
#pragma unroll
        for (int j = 0; j < 4; ++j) v[r][j] = xr[64 * j]; } }
#pragma unroll
    for (int r = 0; r < 2; ++r) {
        const int u = u0 + r * stride; if (u >= MU) continue;
        float s = 0.f;
#pragma unroll
        for (int j = 0; j < 4; ++j) s += (v[r][j].x * v[r][j].x + v[r][j].y * v[r][j].y) + (v[r][j].z * v[r][j].z + v[r][j].w * v[r][j].w);
        const float rstd = 1.f / sqrtf(wave_sum(s) * (1.f / DM) + EPS);
        unsigned long long* o8 = (unsigned long long*)((bf16_t*)(A.ws + WS_XN) + (size_t)u * DM) + F.lane;
#pragma unroll
        for (int j = 0; j < 4; ++j) { const f32x4 w = ((const f32x4*)A.in[15])[64 * j + F.lane];
            o8[64 * j] = (unsigned long long)pk2(v[r][j].x * rstd * w.x, v[r][j].y * rstd * w.y) | ((unsigned long long)pk2(v[r][j].z * rstd * w.z, v[r][j].w * rstd * w.w) << 32); }
    }
}

DI unsigned fkey(float v, int idx) { unsigned u = __builtin_bit_cast(unsigned, v); u = (u & 0x80000000u) ? ~u : (u | 0x80000000u); return (u & ~127u) | (unsigned)(127 - idx); }
DI float keyval(unsigned k) { unsigned u = k & ~127u; u = (u & 0x80000000u) ? (u & 0x7fffffffu) : ~u; return __builtin_bit_cast(float, u); }

__device__ const unsigned char PAIR_A[50] = {0,0,0,0,0,0,0,0,0,0,0,0,0,0,0,0, 1,1,1,1,1,1,1,1, 2,2,2,2,2, 3,3,3,3, 4,4,4, 5,5, 6,6, 7,7, 8,9,10,11,12,13,14,15};
__device__ const unsigned char PAIR_B[50] = {0,1,2,3,4,5,6,7,8,9,10,11,12,13,14,15, 0,1,2,3,4,5,6,7, 0,1,2,3,4, 0,1,2,3, 0,1,2, 0,1, 0,1, 0,1, 0,0,0,0,0,0,0,0};

DI void ce_desc(unsigned& a, unsigned& b) { const unsigned mx = a > b ? a : b, mn = a > b ? b : a; a = mx; b = mn; }
template <int BASE, int NK> DI void bitonic_sort16_desc(unsigned (&x)[NK]) {
#pragma unroll
    for (int k = 2; k <= 16; k <<= 1)
#pragma unroll
        for (int j = k >> 1; j > 0; j >>= 1)
#pragma unroll
            for (int i = 0; i < 16; ++i) { const int l = i ^ j; if (l > i) { if ((i & k) == 0) ce_desc(x[BASE + i], x[BASE + l]); else ce_desc(x[BASE + l], x[BASE + i]); } }
}
template <int A0, int B0, int NK> DI void merge_top16(unsigned (&x)[NK]) {
#pragma unroll
    for (int i = 0; i < 16; ++i) { const unsigned p = x[A0 + i], q = x[B0 + 15 - i]; x[A0 + i] = p > q ? p : q; }
#pragma unroll
    for (int j = 8; j > 0; j >>= 1)
#pragma unroll
        for (int i = 0; i < 16; ++i) { const int l = i ^ j; if (l > i) ce_desc(x[A0 + i], x[A0 + l]); }
}
template <int NK> DI void top16_of_128(unsigned (&key)[NK]) {
    bitonic_sort16_desc<0, NK>(key); bitonic_sort16_desc<16, NK>(key); bitonic_sort16_desc<32, NK>(key); bitonic_sort16_desc<48, NK>(key);
    bitonic_sort16_desc<64, NK>(key); bitonic_sort16_desc<80, NK>(key); bitonic_sort16_desc<96, NK>(key); bitonic_sort16_desc<112, NK>(key);
    merge_top16<0, 16, NK>(key); merge_top16<32, 48, NK>(key); merge_top16<64, 80, NK>(key); merge_top16<96, 112, NK>(key);
    merge_top16<0, 32, NK>(key); merge_top16<64, 96, NK>(key);
    merge_top16<0, 64, NK>(key);
}

DI void topk_task(const Frame& F, const Args& A, int task) {
    unsigned char* ws = A.ws; const int tid = F.tid;
    const int u = task >> 3, h = task & 7;
    LAS unsigned* sk = (LAS unsigned*)(LAS unsigned char*)F.lds;
    LAS unsigned* pkk = sk + 16384;
    LAS float* stg = (LAS float*)(sk + 16384);
    const float* SCb = (const float*)(ws + WS_SC) + (size_t)(task & ~511) * 256;
#pragma unroll 1
    for (int half = 0; half < 2; ++half) {
        unsigned key[128];
#pragma unroll
        for (int qb = 0; qb < 4; ++qb) {
            u32x4 pf[8];
#pragma unroll
            for (int k = 0; k < 8; ++k) { const int c = tid + 512 * k; pf[k] = *(const u32x4*)(SCb + (size_t)(c >> 3) * 256 + half * 128 + qb * 32 + (c & 7) * 4); }
#pragma unroll
            for (int k = 0; k < 8; ++k) { const int c = tid + 512 * k; *(LAS u32x4*)(stg + (c >> 3) * 36 + (c & 7) * 4) = pf[k]; }
            __syncthreads();
#pragma unroll
            for (int i = 0; i < 8; ++i) { const f32x4 v = *(const LAS f32x4*)(stg + tid * 36 + 4 * i);
                key[32 * qb + 4 * i] = fkey(v.x, 32 * qb + 4 * i); key[32 * qb + 4 * i + 1] = fkey(v.y, 32 * qb + 4 * i + 1);
                key[32 * qb + 4 * i + 2] = fkey(v.z, 32 * qb + 4 * i + 2); key[32 * qb + 4 * i + 3] = fkey(v.w, 32 * qb + 4 * i + 3); }
            __syncthreads();
        }
        top16_of_128(key);
#pragma unroll
        for (int r = 0; r < 16; ++r) sk[(half * 16 + r) * 512 + tid] = key[r];
    }
    float v1[16], v2[16];
#pragma unroll
    for (int r = 0; r < 16; ++r) { v1[r] = keyval(sk[r * 512 + tid]); v2[r] = keyval(sk[(16 + r) * 512 + tid]); }
    unsigned ck[64];
#pragma unroll
    for (int c = 50; c < 64; ++c) ck[c] = 0u;
#pragma unroll
    for (int a = 0; a < 16; ++a) {
        const int off = a == 0 ? 0 : a == 1 ? 16 : a == 2 ? 24 : a == 3 ? 29 : a == 4 ? 33 : a == 5 ? 36 : a == 6 ? 38 : a == 7 ? 40 : 42 + (a - 8);
#pragma unroll
        for (int b = 0; b < 16; ++b) if ((a + 1) * (b + 1) <= 16) ck[off + b] = fkey(v1[a] + v2[b], off + b);
    }
    bitonic_sort16_desc<0, 64>(ck); bitonic_sort16_desc<16, 64>(ck); bitonic_sort16_desc<32, 64>(ck); bitonic_sort16_desc<48, 64>(ck);
    merge_top16<0, 16, 64>(ck); merge_top16<32, 48, 64>(ck); merge_top16<0, 32, 64>(ck);
#pragma unroll
    for (int r = 0; r < 16; ++r) pkk[r * 512 + tid] = ck[r];
    const float cmax = keyval(pkk[tid]);
    float ev[16]; float esum = 0.f; int ex[16];
#pragma unroll
    for (int r = 0; r < 16; ++r) {
        const unsigned k = pkk[r * 512 + tid]; const int c = 127 - (int)(k & 127u);
        ev[r] = __expf(keyval(k) - cmax); esum += ev[r];
        const int a = PAIR_A[c], b = PAIR_B[c];
        const int i1 = 127 - (int)(sk[a * 512 + tid] & 127u), i2 = 127 - (int)(sk[(16 + b) * 512 + tid] & 127u);
        ex[r] = i1 * 128 + i2;
    }
    const float rs = 1.f / esum;
    int* IDX = (int*)(ws + WS_IDX) + (size_t)u * 128 + h * 16; float* GATE = (float*)(ws + WS_GATE) + (size_t)u * 128 + h * 16;
#pragma unroll
    for (int r = 0; r < 16; r += 4) {
        *(int4*)(IDX + r) = make_int4(ex[r], ex[r + 1], ex[r + 2], ex[r + 3]);
        *(f32x4*)(GATE + r) = (f32x4){ev[r] * rs, ev[r + 1] * rs, ev[r + 2] * rs, ev[r + 3] * rs};
    }
}

constexpr float EU_SCALE = 64.f, EV_SCALE = 16.f;
DI unsigned pk4_fp8(float a, float b, float c, float d) { int w = 0; w = __builtin_amdgcn_cvt_pk_fp8_f32(a, b, w, false); w = __builtin_amdgcn_cvt_pk_fp8_f32(c, d, w, true); return (unsigned)w; }
DI void convert_tables(const Frame& F, const Args& A) {
    const size_t n16 = (size_t)16384 * 1024 / 16;
    const size_t gt = (size_t)blockIdx.x * 512 + F.tid, NGT = (size_t)F.G * 512;
#pragma unroll 1
    for (int t = 0; t < 2; ++t) {
        const float* src = A.in[18 + t]; unsigned char* dst = A.ws + (t ? WS_EV : WS_EU); const float sc = t ? EV_SCALE : EU_SCALE;
        const float* fn = A.in[15];
        for (size_t i = gt; i < n16; i += NGT) {
            f32x4 a = *(const f32x4*)(src + i * 16) * sc, b = *(const f32x4*)(src + i * 16 + 4) * sc, c = *(const f32x4*)(src + i * 16 + 8) * sc, d = *(const f32x4*)(src + i * 16 + 12) * sc;
            if (t == 0) { const float* g = fn + (i & 63) * 16; a *= *(const f32x4*)g; b *= *(const f32x4*)(g + 4); c *= *(const f32x4*)(g + 8); d *= *(const f32x4*)(g + 12); }
            const size_t e_ = i >> 6, c16_ = i & 63;
            *(u32x4*)(dst + (c16_ >> 3) * ((size_t)16384 * 128) + e_ * 128 + (c16_ & 7) * 16) = (u32x4){pk4_fp8(a.x, a.y, a.z, a.w), pk4_fp8(b.x, b.y, b.z, b.w), pk4_fp8(c.x, c.y, c.z, c.w), pk4_fp8(d.x, d.y, d.z, d.w)};
        }
    }
}

DI float gelu_exact(float x) { return 0.5f * x * (1.f + erff(x * 0.70710678118654752f)); }
typedef float f32x2 __attribute__((ext_vector_type(2)));
#define UNPK16(dst, W_) do { f32x2 _t; \
    _t = __builtin_amdgcn_cvt_pk_f32_fp8((int)(W_).x, false); dst[0] = _t.x; dst[1] = _t.y; _t = __builtin_amdgcn_cvt_pk_f32_fp8((int)(W_).x, true); dst[2] = _t.x; dst[3] = _t.y; \
    _t = __builtin_amdgcn_cvt_pk_f32_fp8((int)(W_).y, false); dst[4] = _t.x; dst[5] = _t.y; _t = __builtin_amdgcn_cvt_pk_f32_fp8((int)(W_).y, true); dst[6] = _t.x; dst[7] = _t.y; \
    _t = __builtin_amdgcn_cvt_pk_f32_fp8((int)(W_).z, false); dst[8] = _t.x; dst[9] = _t.y; _t = __builtin_amdgcn_cvt_pk_f32_fp8((int)(W_).z, true); dst[10] = _t.x; dst[11] = _t.y; \
    _t = __builtin_amdgcn_cvt_pk_f32_fp8((int)(W_).w, false); dst[12] = _t.x; dst[13] = _t.y; _t = __builtin_amdgcn_cvt_pk_f32_fp8((int)(W_).w, true); dst[14] = _t.x; dst[15] = _t.y; } while (0)

template <bool UPH>
DI void expert_phase(const Frame& F, const Args& A, int xv, int wq, int nw) {
    unsigned char* ws = A.ws; const int lane = F.lane, grp = lane >> 3, j = lane & 7;
    const unsigned char* TBL = ws + (UPH ? WS_EU : WS_EV) + (size_t)xv * ((size_t)16384 * 128) + 16 * j;
    const int* IDX = (const int*)(ws + WS_IDX); const float* CW = (const float*)(ws + WS_CW);
    const bf16_t* XN = (const bf16_t*)(ws + WS_XN) + 128 * xv + 16 * j;
    float* HP = (float*)(ws + WS_HP);
    LAS unsigned* ring = (LAS unsigned*)((LAS unsigned char*)F.lds + F.wave * 4096);
    const int nt = (MU - wq + nw - 1) / nw;
    if (nt <= 0) return;
    auto tok = [&](int k) { return __builtin_amdgcn_readfirstlane(wq + (k < nt ? k : nt - 1) * nw); };
    int mi0, mi1; u32x4 mx0, mx1; float mh0, mh1;
    auto meta_load = [&](int k) {
        const int u = tok(k);
        mi0 = IDX[(size_t)u * 128 + lane]; mi1 = IDX[(size_t)u * 128 + 64 + lane];
        if constexpr (UPH) { mx0 = *(const u32x4*)(XN + (size_t)u * DM); mx1 = *(const u32x4*)(XN + (size_t)u * DM + 8); }
        else { mh0 = CW[(size_t)u * 128 + lane]; mh1 = CW[(size_t)u * 128 + 64 + lane]; }
    };
    auto meta_store = [&](int k) {
        LAS unsigned* sl = ring + (k & 3) * 256;
        sl[lane] = (unsigned)mi0; sl[64 + lane] = (unsigned)mi1;
        if constexpr (UPH) { if (grp == 0) { *(LAS u32x4*)(sl + 128 + 8 * j) = mx0; *(LAS u32x4*)(sl + 128 + 8 * j + 4) = mx1; } }
        else { sl[128 + lane] = __builtin_bit_cast(unsigned, mh0); sl[192 + lane] = __builtin_bit_cast(unsigned, mh1); }
    };
    auto gather = [&](u32x4 (&buf)[8], int n) {
        const LAS unsigned* sl = ring + ((n >> 1) & 3) * 256 + 64 * (n & 1) + grp;
#pragma unroll
        for (int i = 0; i < 8; ++i) { const int e = (int)sl[8 * i]; buf[i] = *(const u32x4*)(TBL + (size_t)e * 128); }
    };
    const int ocol = 128 * xv + 16 * j + ((lane & 32) ? 8 : 0) + ((lane & 16) ? 4 : 0) + ((lane & 8) ? 2 : 0);
    f32x2 ocur = (f32x2){0.f, 0.f};
    float acc[16];
    float xn[16];
    auto compute = [&](u32x4 (&buf)[8], int n) {
        const int k = n >> 1, hf = n & 1;
        const LAS unsigned* sl = ring + (k & 3) * 256;
        if (hf == 0) {
            if constexpr (UPH) {
                const u32x4 x0 = *(const LAS u32x4*)(sl + 128 + 8 * j), x1 = *(const LAS u32x4*)(sl + 128 + 8 * j + 4);
                xn[0] = bflo(x0.x); xn[1] = bfhi(x0.x); xn[2] = bflo(x0.y); xn[3] = bfhi(x0.y); xn[4] = bflo(x0.z); xn[5] = bfhi(x0.z); xn[6] = bflo(x0.w); xn[7] = bfhi(x0.w);
                xn[8] = bflo(x1.x); xn[9] = bfhi(x1.x); xn[10] = bflo(x1.y); xn[11] = bfhi(x1.y); xn[12] = bflo(x1.z); xn[13] = bfhi(x1.z); xn[14] = bflo(x1.w); xn[15] = bfhi(x1.w);
            } else {
#pragma unroll
                for (int c = 0; c < 16; ++c) acc[c] = 0.f;
                ocur = *(const f32x2*)(A.out + (size_t)tok(k) * DM + ocol);
            }
        }
#pragma unroll
        for (int i = 0; i < 8; ++i) {
            float f[16]; UNPK16(f, buf[i]);
            if constexpr (UPH) {
                float a0 = 0.f, a1 = 0.f;
#pragma unroll
                for (int c = 0; c < 16; c += 2) { a0 += f[c] * xn[c]; a1 += f[c + 1] * xn[c + 1]; }
                if (hf == 0) acc[i] = a0 + a1; else acc[8 + i] = a0 + a1;
                if (i < 7) { if (hf == 0) asm volatile("" : "+v"(buf[i + 1].x), "+v"(buf[i + 1].y), "+v"(buf[i + 1].z), "+v"(buf[i + 1].w), "+v"(acc[i]));
                             else asm volatile("" : "+v"(buf[i + 1].x), "+v"(buf[i + 1].y), "+v"(buf[i + 1].z), "+v"(buf[i + 1].w), "+v"(acc[8 + i])); }
            } else {
                const float cw = __builtin_bit_cast(float, sl[128 + 64 * hf + 8 * i + grp]);
#pragma unroll
                for (int c = 0; c < 16; ++c) acc[c] += cw * f[c];
                if (i < 7) asm volatile("" : "+v"(buf[i + 1].x), "+v"(buf[i + 1].y), "+v"(buf[i + 1].z), "+v"(buf[i + 1].w),
                                             "+v"(acc[0]), "+v"(acc[1]), "+v"(acc[2]), "+v"(acc[3]), "+v"(acc[4]), "+v"(acc[5]), "+v"(acc[6]), "+v"(acc[7]),
                                             "+v"(acc[8]), "+v"(acc[9]), "+v"(acc[10]), "+v"(acc[11]), "+v"(acc[12]), "+v"(acc[13]), "+v"(acc[14]), "+v"(acc[15]));
            }
            __builtin_amdgcn_sched_barrier(0);
        }
        if (hf == 1 && k < nt) {
            const int u = tok(k);
            float r8[8], r4[4], r2[2];
            if constexpr (UPH) {
                { const bool up = lane & 4;
#pragma unroll
                  for (int i = 0; i < 8; ++i) { const float send = up ? acc[i] : acc[i + 8], keep = up ? acc[i + 8] : acc[i]; r8[i] = keep + __shfl_xor(send, 4); } }
                { const bool up = lane & 2;
#pragma unroll
                  for (int i = 0; i < 4; ++i) { const float send = up ? r8[i] : r8[i + 4], keep = up ? r8[i + 4] : r8[i]; r4[i] = keep + __shfl_xor(send, 2); } }
                { const bool up = lane & 1;
#pragma unroll
                  for (int i = 0; i < 2; ++i) { const float send = up ? r4[i] : r4[i + 2], keep = up ? r4[i + 2] : r4[i]; r2[i] = keep + __shfl_xor(send, 1); } }
                const int st = ((lane & 4) ? 8 : 0) + ((lane & 2) ? 4 : 0) + ((lane & 1) ? 2 : 0);
                float* hp = HP + ((size_t)xv * MU + u) * 128 + grp;
                hp[8 * st] = r2[0]; hp[8 * (st + 1)] = r2[1];
            } else {
                { const bool up = lane & 32;
#pragma unroll
                  for (int c = 0; c < 8; ++c) { const float send = up ? acc[c] : acc[c + 8], keep = up ? acc[c + 8] : acc[c]; r8[c] = keep + __shfl_xor(send, 32); } }
                { const bool up = lane & 16;
#pragma unroll
                  for (int c = 0; c < 4; ++c) { const float send = up ? r8[c] : r8[c + 4], keep = up ? r8[c + 4] : r8[c]; r4[c] = keep + __shfl_xor(send, 16); } }
                { const bool up = lane & 8;
#pragma unroll
                  for (int c = 0; c < 2; ++c) { const float send = up ? r4[c] : r4[c + 2], keep = up ? r4[c + 2] : r4[c]; r2[c] = keep + __shfl_xor(send, 8); } }
                f32x2* o = (f32x2*)(A.out + (size_t)u * DM + ocol);
                f32x2 cur = ocur; cur.x += r2[0]; cur.y += r2[1]; *o = cur;
            }
        }
    };
    meta_load(0); meta_store(0); meta_load(1); meta_store(1); meta_load(2); meta_store(2);
    u32x4 b0[8], b1[8], b2[8];
    gather(b0, 0); gather(b1, 1); gather(b2, 2);
#pragma unroll 1
    for (int k0 = 0; k0 < nt; k0 += 3) {
        const int n0 = 2 * k0;
        meta_load(k0 + 3);
        compute(b0, n0);     gather(b0, n0 + 3);
        compute(b1, n0 + 1); meta_store(k0 + 3); gather(b1, n0 + 4);
        meta_load(k0 + 4);
        compute(b2, n0 + 2); gather(b2, n0 + 5);
        compute(b0, n0 + 3); meta_store(k0 + 4); gather(b0, n0 + 6);
        meta_load(k0 + 5);
        compute(b1, n0 + 4); gather(b1, n0 + 7);
        compute(b2, n0 + 5); meta_store(k0 + 5); gather(b2, n0 + 8);
    }
}


DI void expert_c_pass(const Frame& F, const Args& A) {
    unsigned char* ws = A.ws;
    const float* HP = (const float*)(ws + WS_HP); const float* GATE = (const float*)(ws + WS_GATE); float* CW = (float*)(ws + WS_CW);
    const size_t n4 = (size_t)MU * 128 / 4;
    for (size_t i = (size_t)blockIdx.x * 512 + F.tid; i < n4; i += (size_t)F.G * 512) {
        f32x4 h = *(const f32x4*)(HP + i * 4);
#pragma unroll
        for (int x = 1; x < 8; ++x) h += *(const f32x4*)(HP + (size_t)x * MU * 128 + i * 4);
        const f32x4 g = *(const f32x4*)(GATE + i * 4);
        const float rs = (1.f / EU_SCALE) / sqrtf(((const float*)(ws + WS_SS4))[i >> 5] * (1.f / DM) + EPS);
        f32x4 c;
        c.x = gelu_exact(h.x * rs) * g.x * (1.f / EV_SCALE); c.y = gelu_exact(h.y * rs) * g.y * (1.f / EV_SCALE);
        c.z = gelu_exact(h.z * rs) * g.z * (1.f / EV_SCALE); c.w = gelu_exact(h.w * rs) * g.w * (1.f / EV_SCALE);
        *(f32x4*)(CW + i * 4) = c;
    }
}
template <int PH> DI void run_phase(const Frame& F, const Args& args, PG8_LAS unsigned char* lds3) {
    unsigned char* ws = args.ws;
    if constexpr (PH == 0) { p0_prologue(F, args); p0_late_weights<0>(F, args, F.gw, F.NGW, blockIdx.x * 512 + F.tid, F.G * 512); }
    if constexpr (PH == 1) {
        pg8::Gemm g{(const bf16_t*)(ws + WS_HN), (const bf16_t*)(ws + WS_WIN), MP, NPROJ, 1024, 1024, 1024, 0};
        pg8::StaticOrder S; S.init(MP, NPROJ, F.G, (int)blockIdx.x);
        EpiProj E{(bf16_t*)(ws + WS_QKVR), (bf16_t*)(ws + WS_Z), (float*)(ws + WS_P32), (bf16_t*)(ws + WS_CQN), (bf16_t*)(ws + WS_CKVN), (float*)(ws + WS_KPE), (float*)(ws + WS_SSQ), (float*)(ws + WS_SSK)};
        pg8::gemm_phase<EpiProj, pg8::StaticOrder, true, true>(lds3, g, S, E);
    }
    if constexpr (PH == 2) { gdn_prep_phase<0>(F, args); }
    if constexpr (PH == 3) {
        { pg8::Gemm g{(const bf16_t*)(ws + WS_CQN), (const bf16_t*)(ws + WS_WUQ), MP, 768, 256, 256, 256, 0};
          pg8::StaticOrder S; S.init(MP, 768, F.G, (int)blockIdx.x); EpiB16 E{(bf16_t*)(ws + WS_QH), 768, (const float*)(ws + WS_SSQ), 1.f / 256.f};
          pg8::gemm_phase<EpiB16, pg8::StaticOrder, true, true>(lds3, g, S, E); }
        { pg8::Gemm g{(const bf16_t*)(ws + WS_CKVN), (const bf16_t*)(ws + WS_WUKV), MP, 1024, 256, 256, 256, 0};
          pg8::StaticOrder S; S.init(MP, 1024, F.G, (int)blockIdx.x); EpiB16 E{(bf16_t*)(ws + WS_KVB), 1024, (const float*)(ws + WS_SSK), 1.f / 128.f};
          pg8::gemm_phase<EpiB16, pg8::StaticOrder, true, true>(lds3, g, S, E); }
    }
    if constexpr (PH == 4) { for (int t = F.gw; t < (KVROWS / 64) * 8; t += F.NGW) mla_prep2_task(F, args, t); }
    if constexpr (PH == 5) {
        gdn_scan(F, args);
        volatile LAS unsigned* MISC = (volatile LAS unsigned*)(lds3 + MISC_OFF);
        unsigned* qhead = (unsigned*)(ws + WS_CTL) + CW_ATTQ;
        for (;;) {
            __syncthreads();
            if (F.tid == 0) MISC[24] = xb_add(qhead, 1u);
            __syncthreads();
            const int k = (int)MISC[24];
            if (k >= 512) break;
            attn_item(F, args, k & 7, 63 - (k >> 3));
        }
        p0_late_weights<1>(F, args, F.gw, F.NGW, blockIdx.x * 512 + F.tid, F.G * 512);
    }
    if constexpr (PH == 6) { for (int t = F.gw; t < 2048 * 2; t += F.NGW) gdn_out_task(F, args, t); }
    if constexpr (PH == 7) {
        pg8::Gemm g{(const bf16_t*)(ws + WS_MIX), (const bf16_t*)(ws + WS_WOUT), MU, 1024, 1024, 1024, 1024, 0};
        pg8::StaticOrder S; S.init(MU, 1024, F.G, (int)blockIdx.x); EpiH1 E{args.out, args.in[0], (bf16_t*)(ws + WS_XN), (float*)(ws + WS_SS4)};
        pg8::gemm_phase<EpiH1, pg8::StaticOrder, true, true>(lds3, g, S, E);
    }
    if constexpr (PH == 8) {
        pg8::Gemm g{(const bf16_t*)(ws + WS_XN), (const bf16_t*)(ws + WS_WPQ), MU, 2048, 1024, 1024, 1024, 0};
        pg8::StaticOrder S; S.init(MU, 2048, F.G, (int)blockIdx.x); EpiB16 E{(bf16_t*)(ws + WS_PQ), 2048, (const float*)(ws + WS_SS4), 1.f / 1024.f};
        pg8::gemm_phase<EpiB16, pg8::StaticOrder, true, true>(lds3, g, S, E);
    }
    if constexpr (PH == 9) {
        pg8::Gemm g{(const bf16_t*)(ws + WS_PQ), (const bf16_t*)(ws + WS_SKB), MU, 2048, 256, 2048, 256, 256};
        pg8::StaticOrder S; S.init(MU, 2048, F.G, (int)blockIdx.x); EpiF32 E{(float*)(ws + WS_SC), 2048, nullptr};
        pg8::gemm_phase<EpiF32, pg8::StaticOrder, true, true>(lds3, g, S, E);
    }
    if constexpr (PH == 10) {
        convert_tables(F, args);
        for (int t = blockIdx.x * 512 + F.tid; t < MU * 8; t += F.G * 512) topk_task(F, args, t);
    }
    if constexpr (PH == 12) { expert_c_pass(F, args); }
    if constexpr (PH == 11 || PH == 13) {
        volatile LAS unsigned* MISC = (volatile LAS unsigned*)(lds3 + MISC_OFF);
        const unsigned x = MISC[16], rank = MISC[17];
        unsigned* bar = (unsigned*)(ws + WS_CTL);
        unsigned nloc = 0, nx = 0, myidx = 0;
#pragma unroll
        for (unsigned j = 0; j < 16; ++j) { const unsigned c = xb_ld(&bar[XB_XCNT(j)]); nx += (c > 0u) ? 1u : 0u; myidx += (c > 0u && j < x) ? 1u : 0u; nloc = (j == x) ? c : nloc; }
        const int wq = __builtin_amdgcn_readfirstlane((int)rank * 8 + F.wave), nw = __builtin_amdgcn_readfirstlane((int)nloc * 8);
        const int xstep = __builtin_amdgcn_readfirstlane((int)nx);
        for (int xv = __builtin_amdgcn_readfirstlane((int)myidx); xv < 8; xv += xstep)
            { if constexpr (PH == 11) expert_phase<true>(F, args, xv, wq, nw); else expert_phase<false>(F, args, xv, wq, nw); }
    }
}
constexpr int NPHASE = 14;
__global__ void __launch_bounds__(512, 2) fwd_kernel(Args args) {
    extern __shared__ __attribute__((aligned(16))) unsigned char lds[];
    Frame F;
    F.lds = lds; F.tid = threadIdx.x; F.lane = F.tid & 63; F.wave = __builtin_amdgcn_readfirstlane(F.tid >> 6);
    F.G = gridDim.x; F.gw = blockIdx.x * 8 + F.wave; F.NGW = F.G * 8;
    volatile LAS unsigned* MISC = (volatile LAS unsigned*)((LAS unsigned char*)lds + MISC_OFF);
    if (F.tid < 32) MISC[F.tid] = 0u;
    __syncthreads();
    unsigned char* ws = args.ws;
    const int lo = args.ph_lo, hi = args.ph_hi;
    XcdBarrier bar; bar.bar = (unsigned*)(ws + WS_CTL); bar.x = 0; bar.st = nullptr;
    if (hi - lo > 1) bar = xcd_barrier_post((unsigned*)(ws + WS_CTL), MISC + 8);
    if (F.tid == 0) { const unsigned x = xb_xcc_id(); MISC[16] = x; MISC[17] = xb_add((unsigned*)(ws + WS_CTL) + 3520 + 64 * x, 1u); }
    __syncthreads();
#define IN(k) (lo <= (k) && (k) < hi)
#define SEAM(k) do { if (IN(k) && IN((k) + 1)) xcd_barrier(bar); } while (0)
    PG8_LAS unsigned char* lds3 = (PG8_LAS unsigned char*)lds;

#ifndef PROBE_REPEAT
#define PROBE_REPEAT -1
#endif
#ifndef PROBE_TIME
#define PROBE_TIME -1
#endif
#ifndef PROBE_TSEL
#define PROBE_TSEL 0
#endif
    unsigned long long pt_ticks = 0ull;
#define PHASE(k) do { unsigned long long pt0_ = 0ull; if (PROBE_TIME == (k)) pt0_ = __builtin_amdgcn_s_memrealtime(); \
        if (IN(k)) { run_phase<k>(F, args, lds3); if (PROBE_REPEAT == (k)) { xcd_barrier(bar); run_phase<(k)>(F, args, lds3); } } \
        if (PROBE_TIME == (k) && PROBE_TSEL == 1) pt_ticks = __builtin_amdgcn_s_memrealtime() - pt0_;     \
        if (PROBE_TIME == (k) && PROBE_TSEL == 2) pt0_ = __builtin_amdgcn_s_memrealtime();                \
        SEAM(k); \
        if (PROBE_TIME == (k) && PROBE_TSEL != 1) pt_ticks = __builtin_amdgcn_s_memrealtime() - pt0_; } while (0)
    PHASE(0); PHASE(1); PHASE(2); PHASE(3); PHASE(4); PHASE(5); PHASE(6); PHASE(7); PHASE(8); PHASE(9); PHASE(10); PHASE(11); PHASE(12); PHASE(13);
#undef PHASE
    if (PROBE_STAGE >= 0) { __syncthreads(); pt_ticks = *(volatile unsigned long long*)(lds + 143360 + 96); }
    if (PROBE_TIME >= 0 || PROBE_STAGE >= 0) { const unsigned long long t0_ = __builtin_amdgcn_s_memrealtime(); while (__builtin_amdgcn_s_memrealtime() - t0_ < 4ull * pt_ticks) __builtin_amdgcn_s_sleep(32); }
#undef IN
#undef SEAM
}

#ifndef N_LAUNCHES
#define N_LAUNCHES 1
#endif
extern "C" void kernel_launch(void* const* d_in, const int* in_sizes, int n_in, void* d_out, int out_size, void* d_ws, size_t ws_size, hipStream_t stream) {
    static int grid = 0;
    if (grid == 0) {
        if (n_in != 20 || out_size != MU * DM || ws_size < WS_END) { fprintf(stderr, "kernel_launch: unexpected shapes (n_in %d out %d ws %zu)\n", n_in, out_size, ws_size); grid = -1; return; }
        int dev = 0, cus = 0, per_cu = 0;
        if (hipGetDevice(&dev) != hipSuccess || hipDeviceGetAttribute(&cus, hipDeviceAttributeMultiprocessorCount, dev) != hipSuccess) { grid = -1; return; }
        if (hipFuncSetAttribute((const void*)fwd_kernel, hipFuncAttributeMaxDynamicSharedMemorySize, LDS_BYTES) != hipSuccess) { fprintf(stderr, "kernel_launch: hipFuncSetAttribute failed\n"); grid = -1; return; }
        if (hipOccupancyMaxActiveBlocksPerMultiprocessor(&per_cu, (const void*)fwd_kernel, 512, LDS_BYTES) != hipSuccess || per_cu < 1) { fprintf(stderr, "kernel_launch: occupancy query says %d\n", per_cu); (void)hipGetLastError(); per_cu = 1; }
        grid = cus;
    }
    if (grid < 0) return;
    (void)hipMemsetAsync((char*)d_ws + WS_CTL, 0, CTL_ZERO_BYTES, stream);
    Args a{};
    for (int i = 0; i < 20; ++i) a.in[i] = (const float*)d_in[i];
    a.out = (float*)d_out; a.ws = (unsigned char*)d_ws;
    for (int li = 0; li < N_LAUNCHES; ++li) {
        a.ph_lo = li * NPHASE / N_LAUNCHES; a.ph_hi = (li + 1) * NPHASE / N_LAUNCHES;
        if (N_LAUNCHES == 1) {
            void* kargs[] = {&a};
            hipError_t e = hipLaunchCooperativeKernel((const void*)fwd_kernel, dim3(grid), dim3(512), kargs, LDS_BYTES, stream);
            if (e != hipSuccess) fprintf(stderr, "cooperative launch failed: %s (grid %d)\n", hipGetErrorString(e), grid);
        } else {
            hipLaunchKernelGGL(fwd_kernel, dim3(grid), dim3(512), LDS_BYTES, stream, a);
        }
    }
}
```

```cpp
#include <hip/hip_runtime.h>
#include <hip/hip_bf16.h>
#include <cstdio>
#include <cstdint>

#define DI __device__ __forceinline__
#define LAS __attribute__((address_space(3)))
#define GAS __attribute__((address_space(1)))

typedef unsigned short bf16_t;
typedef short bf16x8 __attribute__((ext_vector_type(8)));
typedef short s16x4 __attribute__((ext_vector_type(4)));
typedef float f32x4 __attribute__((ext_vector_type(4)));
typedef float f32x16 __attribute__((ext_vector_type(16)));
typedef unsigned u32x4 __attribute__((ext_vector_type(4)));
typedef unsigned u32x2 __attribute__((ext_vector_type(2)));

namespace pg8 {
#define PG8_LAS __attribute__((address_space(3)))
constexpr int BM = 256, BK = 64, HALF = 128, HTB = HALF * BK * 2  , STAGE_BYTES = 8 * HTB, NXCD = 8, WGM = 8;

__host__ __device__ __forceinline__ int lds_byte(int r, int c) { const int st = (r >> 4) * 2 + (c >> 5), rr = r & 15, cc = c & 31, ob = rr * 64 + cc * 2; return st * 1024 + (ob ^ (((ob >> 9) & 1) << 5)); }
__host__ __device__ __forceinline__ void stage_rc(int b, int& R, int& C) { const int st = b / 1024, sb = b % 1024, swz = sb ^ (((sb >> 9) & 1) << 5); R = (st >> 1) * 16 + swz / 64; C = (st & 1) * 32 + (swz % 64) / 2; }
__host__ __device__ __forceinline__ int perm32(int rho) { const int n = rho >> 4, i = rho & 15; return 8 * (i >> 2) + 4 * n + (i & 3); }

struct Unit { int pm, pn; };
struct Gemm { const bf16_t* A; const bf16_t* Bt; int M, N, K, lda, ldb, a_pn_off; };

struct StaticOrder {
    int nM, nN, nwg, G, c;
    __host__ __device__ void init(int M, int N, int G_, int c_) { nM = M / BM; nN = N / BM; nwg = nM * nN; G = G_; c = c_; }
    __host__ __device__ bool next(int i, Unit& u) const {
        const long L = (long)i * G + c; if (L >= nwg) return false;
        int wgid = (int)L; { const int q = nwg / NXCD, r = nwg % NXCD, xcd = wgid % NXCD, off = wgid / NXCD; wgid = (xcd < r ? xcd * (q + 1) : r * (q + 1) + (xcd - r) * q) + off; }
        const int nig = WGM * nN, gid = wgid / nig, fm = gid * WGM, gsz = (nM - fm) < WGM ? (nM - fm) : WGM;
        u.pm = fm + ((wgid % nig) % gsz); u.pn = (wgid % nig) / gsz; return true;
    }
    __device__ __forceinline__ void a_ready(const Unit&) const {}
    __device__ __forceinline__ void done(const Unit&) const {}
};

__device__ __forceinline__ unsigned cvt_pk_bf16(float lo, float hi) { unsigned r; asm volatile("v_cvt_pk_bf16_f32 %0, %1, %2" : "=v"(r) : "v"(lo), "v"(hi)); return r; }

template <class Epi, class Sched, bool ALIGN_EPI = false, bool SP2 = false>
__device__ __forceinline__ void gemm_phase(PG8_LAS unsigned char* lds, const Gemm g, const Sched& S, const Epi& E) {
    const int tid = threadIdx.x, wid = __builtin_amdgcn_readfirstlane(tid >> 6), lane = tid & 63, wr = wid >> 2, wc = wid & 3, fr = lane & 15, fq = lane >> 4;
    const int K = g.K, nt = K / BK;
    unsigned voffA[2], voffB[2];
#pragma unroll
    for (int i = 0; i < 2; ++i) { int R, C; stage_rc(tid * 16 + i * 8192, R, C); const int Rb = Epi::PERM ? ((R & ~31) + perm32(R & 31)) : R;
        voffA[i] = (unsigned)(R * g.lda + C) * 2u; voffB[i] = (unsigned)(Rb * g.ldb + C) * 2u; }
    const size_t kstep = (size_t)(BK * 2);
    const size_t hstepA = (size_t)HALF * g.lda * 2, hstepB = (size_t)HALF * g.ldb * 2;
    const size_t tstepA = 2 * hstepA, tstepB = 2 * hstepB;
    const size_t pnoffA = (size_t)g.a_pn_off * 2;
    const unsigned ldsw = (unsigned)wid * 1024u;
    const int aoff = lds_byte(wr * 64 + fr, fq * 8), boff = lds_byte(wc * 32 + fr, fq * 8);
#define PG8_SA(b, h) (((b) * 2 + (h)) * HTB)
#define PG8_SB(b, h) ((4 + (b) * 2 + (h)) * HTB)
#define PG8_STAGE(bufoff, gbase, voff) do { _Pragma("unroll") for (int _i = 0; _i < 2; ++_i) \
        __builtin_amdgcn_global_load_lds((const unsigned*)((const char*)(gbase) + (voff)[_i]), (PG8_LAS unsigned*)(lds + (bufoff) + ldsw + _i * 8192), 16, 0, 0); } while (0)
#define PG8_LDA(dst, b, h) do { _Pragma("unroll") for (int m = 0; m < 4; ++m) _Pragma("unroll") for (int k = 0; k < 2; ++k) dst[m][k] = *(const PG8_LAS bf16x8*)(lds + PG8_SA(b, h) + aoff + m * 2048 + k * 1024); } while (0)
#define PG8_LDB(dst, b, h) do { _Pragma("unroll") for (int n = 0; n < 2; ++n) _Pragma("unroll") for (int k = 0; k < 2; ++k) dst[n][k] = *(const PG8_LAS bf16x8*)(lds + PG8_SB(b, h) + boff + n * 2048 + k * 1024); } while (0)
#define PG8_MMA(ai, bj, At, Bt) do { __builtin_amdgcn_s_setprio(1); _Pragma("unroll") for (int m = 0; m < 4; ++m) _Pragma("unroll") for (int n = 0; n < 2; ++n) _Pragma("unroll") for (int k = 0; k < 2; ++k) \
        acc[ai][bj][m][n] = __builtin_amdgcn_mfma_f32_16x16x32_bf16(Bt[n][k], At[m][k], acc[ai][bj][m][n], 0, 0, 0); __builtin_amdgcn_s_setprio(0); } while (0)
#define PG8_WAIT_V(n) asm volatile("s_waitcnt vmcnt(" #n ")" ::: "memory")
#define PG8_WAIT_L(n) asm volatile("s_waitcnt lgkmcnt(" #n ")" ::: "memory")
#define PG8_BAR __builtin_amdgcn_s_barrier()
#define PG8_SCHED __builtin_amdgcn_sched_barrier(0)
    Unit cur, nxt; int ui = 0;
    if (!S.next(0, cur)) return;
    f32x4 acc[2][2][4][2];
#pragma unroll
    for (int a = 0; a < 2; ++a)
#pragma unroll
        for (int b = 0; b < 2; ++b)
#pragma unroll
            for (int m = 0; m < 4; ++m)
#pragma unroll
                for (int n = 0; n < 2; ++n) acc[a][b][m][n] = (f32x4){0.f, 0.f, 0.f, 0.f};
    bf16x8 At[4][2], B0[2][2], B1[2][2];
    const char* cA = (const char*)g.A + (size_t)cur.pm * tstepA + (size_t)cur.pn * pnoffA; const char* cB = (const char*)g.Bt + (size_t)cur.pn * tstepB;
    S.a_ready(cur);
    if constexpr (SP2) {
        PG8_STAGE(PG8_SB(0, 0), cB, voffB); PG8_STAGE(PG8_SB(0, 1), cB + hstepB, voffB); PG8_STAGE(PG8_SA(0, 0), cA, voffA); PG8_STAGE(PG8_SA(0, 1), cA + hstepA, voffA);
        if (wr == 1) PG8_BAR;
        PG8_WAIT_V(2); PG8_BAR;
        PG8_STAGE(PG8_SB(1, 0), cB + kstep, voffB); PG8_STAGE(PG8_SA(1, 0), cA + kstep, voffA); PG8_STAGE(PG8_SB(1, 1), cB + hstepB + kstep, voffB);
        PG8_WAIT_V(6); PG8_BAR;
    } else {
        PG8_STAGE(PG8_SB(0, 0), cB, voffB); PG8_STAGE(PG8_SA(0, 0), cA, voffA); PG8_STAGE(PG8_SB(0, 1), cB + hstepB, voffB); PG8_STAGE(PG8_SA(0, 1), cA + hstepA, voffA);
        if (wr == 1) PG8_BAR;
        PG8_WAIT_V(4); PG8_BAR;
        PG8_STAGE(PG8_SB(1, 0), cB + kstep, voffB); PG8_STAGE(PG8_SA(1, 0), cA + kstep, voffA); PG8_STAGE(PG8_SB(1, 1), cB + hstepB + kstep, voffB);
        PG8_WAIT_V(6); PG8_BAR;
    }
    for (;;) {
        const bool has_next = S.next(ui + 1, nxt);
        const char* nA = has_next ? (const char*)g.A + (size_t)nxt.pm * tstepA + (size_t)nxt.pn * pnoffA : cA; const char* nB = has_next ? (const char*)g.Bt + (size_t)nxt.pn * tstepB : cB;
        for (int t = 0; t < nt; t += 2) {
            const bool last = (t == nt - 2);
            const char* a1 = cA + (size_t)(t + 1) * kstep;
            const char* a2 = last ? nA : cA + (size_t)(t + 2) * kstep; const char* b2 = last ? nB : cB + (size_t)(t + 2) * kstep;
            const char* a3 = a2 + kstep; const char* b3 = b2 + kstep;
            if (last && has_next) S.a_ready(nxt);
            if constexpr (SP2) {
            PG8_LDB(B0, 0, 0); PG8_LDB(B1, 0, 1); PG8_SCHED; PG8_LDA(At, 0, 0); PG8_STAGE(PG8_SA(1, 1), a1 + hstepA, voffA);
            PG8_WAIT_V(8); PG8_WAIT_L(0); PG8_BAR; PG8_MMA(0, 0, At, B0); PG8_MMA(0, 1, At, B1); PG8_BAR; PG8_SCHED;
            PG8_LDA(At, 0, 1); PG8_STAGE(PG8_SB(0, 0), b2, voffB); PG8_STAGE(PG8_SB(0, 1), b2 + hstepB, voffB); PG8_STAGE(PG8_SA(0, 0), a2, voffA);
            PG8_WAIT_V(8); PG8_WAIT_L(0); PG8_BAR; PG8_MMA(1, 0, At, B0); PG8_MMA(1, 1, At, B1); PG8_BAR; PG8_SCHED;
            PG8_LDB(B0, 1, 0); PG8_LDB(B1, 1, 1); PG8_SCHED; PG8_LDA(At, 1, 0); PG8_STAGE(PG8_SA(0, 1), a2 + hstepA, voffA);
            PG8_WAIT_V(8); PG8_WAIT_L(0); PG8_BAR; PG8_MMA(0, 0, At, B0); PG8_MMA(0, 1, At, B1); PG8_BAR; PG8_SCHED;
            PG8_LDA(At, 1, 1); PG8_STAGE(PG8_SB(1, 0), b3, voffB); PG8_STAGE(PG8_SB(1, 1), b3 + hstepB, voffB); PG8_STAGE(PG8_SA(1, 0), a3, voffA);
            PG8_WAIT_V(8); PG8_WAIT_L(0); PG8_BAR; PG8_MMA(1, 0, At, B0); PG8_MMA(1, 1, At, B1); PG8_BAR; PG8_SCHED;
            } else {
            PG8_LDB(B0, 0, 0); PG8_SCHED; PG8_LDA(At, 0, 0); PG8_STAGE(PG8_SA(1, 1), a1 + hstepA, voffA);
            PG8_WAIT_L(8); PG8_BAR; PG8_WAIT_L(0); PG8_MMA(0, 0, At, B0); PG8_BAR; PG8_SCHED;
            PG8_LDB(B1, 0, 1); PG8_STAGE(PG8_SB(0, 0), b2, voffB);
            PG8_BAR; PG8_WAIT_L(0); PG8_MMA(0, 1, At, B1); PG8_BAR;
            PG8_LDA(At, 0, 1); PG8_STAGE(PG8_SA(0, 0), a2, voffA);
            PG8_BAR; PG8_WAIT_L(0); PG8_MMA(1, 0, At, B0); PG8_BAR; PG8_SCHED;
            PG8_STAGE(PG8_SB(0, 1), b2 + hstepB, voffB);
            PG8_WAIT_V(6); PG8_BAR; PG8_MMA(1, 1, At, B1); PG8_BAR;
            PG8_LDB(B0, 1, 0); PG8_SCHED; PG8_LDA(At, 1, 0); PG8_STAGE(PG8_SA(0, 1), a2 + hstepA, voffA);
            PG8_WAIT_L(8); PG8_BAR; PG8_WAIT_L(0); PG8_MMA(0, 0, At, B0); PG8_BAR; PG8_SCHED;
            PG8_LDB(B1, 1, 1); PG8_STAGE(PG8_SB(1, 0), b3, voffB);
            PG8_BAR; PG8_WAIT_L(0); PG8_MMA(0, 1, At, B1); PG8_BAR;
            PG8_LDA(At, 1, 1); PG8_STAGE(PG8_SA(1, 0), a3, voffA);
            PG8_BAR; PG8_WAIT_L(0); PG8_MMA(1, 0, At, B0); PG8_BAR; PG8_SCHED;
            PG8_STAGE(PG8_SB(1, 1), b3 + hstepB, voffB);
            PG8_WAIT_V(6); PG8_BAR; PG8_MMA(1, 1, At, B1); PG8_BAR;
            }
        }
        if constexpr (ALIGN_EPI) { if (wr == 0) PG8_BAR; }
        E(acc, cur, wr, wc, fr, fq); S.done(cur);
        if (!has_next) break;
#pragma unroll
        for (int a = 0; a < 2; ++a)
#pragma unroll
            for (int b = 0; b < 2; ++b)
#pragma unroll
                for (int m = 0; m < 4; ++m)
#pragma unroll
                    for (int n = 0; n < 2; ++n) acc[a][b][m][n] = (f32x4){0.f, 0.f, 0.f, 0.f};
        cur = nxt; cA = nA; cB = nB; ++ui;
        if constexpr (ALIGN_EPI) { if (wr == 1) PG8_BAR; }
    }
    PG8_WAIT_V(0);
    if constexpr (!ALIGN_EPI) { if (wr == 0) PG8_BAR; }
    PG8_BAR;
#undef PG8_SA
#undef PG8_SB
#undef PG8_STAGE
#undef PG8_LDA
#undef PG8_LDB
#undef PG8_MMA
#undef PG8_WAIT_V
#undef PG8_WAIT_L
#undef PG8_BAR
#undef PG8_SCHED
}
}

constexpr int DM = 1024;
constexpr int NTOK = 16400;
constexpr int PADL = 48;
constexpr int LPV = 16448;
constexpr int MP = 16640;
constexpr int MU = 16384;
constexpr int NCHUNK = 257;
constexpr int NHEAD = 8;
constexpr int NPROJ = 2560;
constexpr int KVROWS = 16512;
constexpr float EPS = 1e-6f;

constexpr size_t MiB = 1u << 20;
constexpr size_t WS_CTL = 0, CTL_ZERO_BYTES = 512 * 1024;
constexpr size_t WS_SSQ = 128 * 1024;
constexpr size_t WS_SSK = 256 * 1024;
constexpr size_t WS_SS4 = 384 * 1024;
constexpr size_t WS_WIN = 1 * MiB;
constexpr size_t WS_WUQ = 6 * MiB;
constexpr size_t WS_WUKV = 6 * MiB + 512 * 1024;
constexpr size_t WS_WOUT = 7 * MiB;
constexpr size_t WS_WPQ = 9 * MiB;
constexpr size_t WS_SKB = 13 * MiB;
constexpr size_t WS_IDX = 16 * MiB;
constexpr size_t WS_GATE = 24 * MiB;
constexpr size_t WS_HN = 16 * MiB;
constexpr size_t WS_QKVR = 101 * MiB;
constexpr size_t WS_Z = 150 * MiB;
constexpr size_t WS_P32 = 167 * MiB;
constexpr size_t WS_GA = 16 * MiB;
constexpr size_t WS_GQ = 33 * MiB;
constexpr size_t WS_GS = 67 * MiB;
constexpr size_t WS_GB = 84 * MiB;
constexpr size_t WS_GO = 50 * MiB;
constexpr size_t WS_MIX = 167 * MiB;
constexpr size_t WS_CQN = 200 * MiB;
constexpr size_t WS_CKVN = 208 * MiB + 512 * 1024;
constexpr size_t WS_QH = 101 * MiB;
constexpr size_t WS_KVB = 167 * MiB;
constexpr size_t WS_Q = 125 * MiB + 512 * 1024;
constexpr size_t WS_K = 220 * MiB;
constexpr size_t WS_VT = 200 * MiB;
constexpr size_t WS_XN = 32 * MiB;
constexpr size_t WS_PQ = 64 * MiB;
constexpr size_t WS_SC = 128 * MiB;
constexpr size_t WS_EU = 96 * MiB;
constexpr size_t WS_EV = 112 * MiB;
constexpr size_t WS_CW = 64 * MiB;
constexpr size_t WS_HP = 128 * MiB;
constexpr size_t WS_KPE = 217 * MiB;
constexpr size_t WS_END = 256 * MiB;
constexpr int CW_ATTQ = 8192;

constexpr int LDS_BYTES = 147456;
constexpr int MISC_OFF = 131072 + 12288;

DI unsigned f2bf(float f) { unsigned u = __builtin_bit_cast(unsigned, f); return (u + 0x7fffu + ((u >> 16) & 1u)) >> 16; }
DI unsigned pk2(float lo, float hi) { return f2bf(lo) | (f2bf(hi) << 16); }
DI float bf2f(unsigned b) { return __builtin_bit_cast(float, b << 16); }
DI float bflo(unsigned w) { return __builtin_bit_cast(float, w << 16); }
DI float bfhi(unsigned w) { return __builtin_bit_cast(float, w & 0xffff0000u); }
DI float wave_sum(float v) {
#pragma unroll
    for (int o = 1; o < 64; o <<= 1) v += __shfl_xor(v, o);
    return v;
}
DI float sigmoidf_(float x) { return 1.f / (1.f + __expf(-x)); }
DI float siluf_(float x) { return x / (1.f + __expf(-x)); }

#define XB_TMO      128
#define XB_XCNT(j)  (256  + 64 * (j))
#define XB_XSUB(j)  (1280 + 64 * (j))
#define XB_XGEN(j)  (2304 + 64 * (j))
#define XB_TOP      3328
#define XB_TOPGEN   3392
#define XCD_BAR_WORDS 3456
#define XB_SPIN_CAP (1u << 22)
DI unsigned xb_ld(unsigned* p)              { return __hip_atomic_load(p, __ATOMIC_RELAXED, __HIP_MEMORY_SCOPE_AGENT); }
DI unsigned xb_add(unsigned* p, unsigned v) { return __hip_atomic_fetch_add(p, v, __ATOMIC_RELAXED, __HIP_MEMORY_SCOPE_AGENT); }
DI unsigned xb_xcc_id() { return (unsigned)__builtin_amdgcn_s_getreg((3 << 11) | 20) & 0xFu; }
#define XB_SPIN(cond, bar) do { unsigned _sp = 0; while (cond) { __builtin_amdgcn_s_sleep(1); \
    if ((++_sp & 255u) == 0u) { if (xb_ld(&(bar)[XB_TMO])) break; if (_sp > XB_SPIN_CAP) { atomicAdd(&(bar)[XB_TMO], 1u); break; } } } } while (0)
struct XcdBarrier { unsigned* bar; unsigned x; volatile LAS unsigned* st; };
DI XcdBarrier xcd_barrier_post(unsigned* bar, volatile LAS unsigned* st) {
    XcdBarrier b; b.bar = bar; b.x = xb_xcc_id(); b.st = st;
    if (threadIdx.x == 0) (void)xb_add(&bar[XB_XCNT(b.x)], 1u);
    return b;
}
DI void xcd_barrier_complete(unsigned* bar, unsigned x, unsigned& nloc, unsigned& nx) {
    const unsigned G = gridDim.x * gridDim.y * gridDim.z;
    unsigned sum, cnt, mine, sp = 0u;
    for (;;) {
        sum = 0u; cnt = 0u; mine = 0u;
#pragma unroll
        for (unsigned j = 0; j < 16; ++j) { const unsigned c = xb_ld(&bar[XB_XCNT(j)]); sum += c; cnt += (c > 0u) ? 1u : 0u; mine = (j == x) ? c : mine; }
        if (sum == G) break;
        __builtin_amdgcn_s_sleep(1);
        if ((++sp & 255u) == 0u) { if (xb_ld(&bar[XB_TMO])) break; if (sp > XB_SPIN_CAP) { atomicAdd(&bar[XB_TMO], 1u); break; } }
    }
    nloc = mine > 0u ? mine : 1u; nx = cnt > 0u ? cnt : 1u;
}
DI void xcd_barrier(const XcdBarrier& b) {
    asm volatile("s_waitcnt vmcnt(0)" ::: "memory");
    __syncthreads();
    if (threadIdx.x == 0) {
        unsigned* bar = b.bar;
        __builtin_amdgcn_s_waitcnt(0);
        unsigned nloc = b.st[0], nx = b.st[1];
        if (nloc == 0u) { xcd_barrier_complete(bar, b.x, nloc, nx); b.st[0] = nloc; b.st[1] = nx; }
        const unsigned old = xb_add(&bar[XB_XSUB(b.x)], 1u);
        const unsigned gen = old / nloc;
        if (old + 1u == (gen + 1u) * nloc) {
            __builtin_amdgcn_fence(__ATOMIC_RELEASE, "agent");
            asm volatile("s_waitcnt vmcnt(0)" ::: "memory");
            const unsigned og = xb_add(&bar[XB_TOP], 1u);
            const unsigned tg = og / nx;
            if (og + 1u == (tg + 1u) * nx) xb_add(&bar[XB_TOPGEN], 1u);
            else XB_SPIN(xb_ld(&bar[XB_TOPGEN]) == tg, bar);
            __builtin_amdgcn_fence(__ATOMIC_ACQUIRE, "agent");
            xb_add(&bar[XB_XGEN(b.x)], 1u);
            asm volatile("s_waitcnt vmcnt(0)" ::: "memory");
        } else {
            XB_SPIN(xb_ld(&bar[XB_XGEN(b.x)]) == gen, bar);
            __builtin_amdgcn_fence(__ATOMIC_ACQUIRE, "agent");
            asm volatile("s_waitcnt vmcnt(0)" ::: "memory");
        }
    }
    __syncthreads();
}

struct Args {
    const float* in[20];
    float* out; unsigned char* ws;
    int ph_lo, ph_hi;
};
struct Frame {
    unsigned char* lds;
    int tid, lane, wave, G, gw, NGW;
};

template <class Map>
DI void transpose_item(const float* __restrict__ W, int Nsrc, bf16_t* __restrict__ WT, int ldk, float* scr, int item, int nblk, int lane, Map srcmap, const float* __restrict__ rowscale = nullptr) {
    const int kb = item / nblk, nb = item % nblk, k0 = 64 * kb, n0 = 32 * nb;
    const int ns = srcmap(n0 + (lane & 31));
    float vv[32];
#pragma unroll
    for (int i = 0; i < 32; ++i) { const int kk = 2 * i + (lane >> 5); vv[i] = (ns >= 0) ? W[(size_t)(k0 + kk) * Nsrc + ns] : 0.f; }
    if (rowscale) {
#pragma unroll
        for (int i = 0; i < 32; ++i) vv[i] *= rowscale[k0 + 2 * i + (lane >> 5)];
    }
#pragma unroll
    for (int i = 0; i < 32; ++i) { const int kk = 2 * i + (lane >> 5); scr[kk * 33 + (lane & 31)] = vv[i]; }
    __builtin_amdgcn_s_waitcnt(0); __builtin_amdgcn_wave_barrier();
    const int c = lane & 7;
#pragma unroll
    for (int j = 0; j < 4; ++j) { const int n = (lane >> 3) + 8 * j; const float* s = scr + (8 * c) * 33 + n;
        u32x4 o; o.x = pk2(s[0 * 33], s[1 * 33]); o.y = pk2(s[2 * 33], s[3 * 33]); o.z = pk2(s[4 * 33], s[5 * 33]); o.w = pk2(s[6 * 33], s[7 * 33]);
        *(u32x4*)(WT + (size_t)(n0 + n) * ldk + k0 + 8 * c) = o; }
    __builtin_amdgcn_s_waitcnt(0); __builtin_amdgcn_wave_barrier();
}
struct MapId { DI int operator()(int n) const { return n; } };
struct MapWin {
    DI int operator()(int n) const {
        if (n < 2048) return n;
        if (n < 2304) return n + 16;
        if (n < 2432) return n + 16;
        if (n < 2464) return n + 16;
        if (n < 2472) return n - 416;
        if (n < 2480) return n - 416;
        return -1;
    }
};

template <int PART> DI void p0_late_weights(const Frame& F, const Args& A, int wi, int nwv, int ti, int nth) {
    unsigned char* ws = A.ws;
    float* scr = (float*)(F.lds + F.wave * 16384);
    const float* w_uq = A.in[10]; const float* w_ukv = A.in[11]; const float* w_out = A.in[14]; const float* w_pq = A.in[16]; const float* sub_keys = A.in[17];
    constexpr int I_UQ = 4 * 24, I_UKV = 2 * 32, I_OUT = 16 * 32, I_PQ = 16 * 64;
    constexpr int NITEMS = I_UQ + I_UKV + I_OUT + I_PQ;
    const int lo_ = PART == 0 ? 0 : I_UQ + I_UKV, hi_ = PART == 0 ? I_UQ + I_UKV : NITEMS;
    for (int it = lo_ + wi; it < hi_; it += nwv) {
        int r = it;
        if (r < I_UQ) { transpose_item(w_uq, 768, (bf16_t*)(ws + WS_WUQ), 256, scr, r, 24, F.lane, MapId(), A.in[8]); continue; } r -= I_UQ;
        if (r < I_UKV) { transpose_item(w_ukv, 1024, (bf16_t*)(ws + WS_WUKV), 256, scr, r, 32, F.lane, MapId(), A.in[9]); continue; } r -= I_UKV;
        if (r < I_OUT) { transpose_item(w_out, 1024, (bf16_t*)(ws + WS_WOUT), 1024, scr, r, 32, F.lane, MapId()); continue; } r -= I_OUT;
        transpose_item(w_pq, 2048, (bf16_t*)(ws + WS_WPQ), 1024, scr, r, 64, F.lane, MapId(), A.in[15]);
    }
    const int gt = ti, NGT = nth;
    if (PART == 0) for (int i = gt; i < 1024 * 16; i += NGT) { const int n = i >> 4, c = i & 15; *(u32x4*)((bf16_t*)(ws + WS_WUKV) + (size_t)n * 256 + 128 + c * 8) = (u32x4){0u, 0u, 0u, 0u}; }
    if (PART == 1) for (int i = gt; i < 2048 * 32; i += NGT) {
        const int n = i >> 5, c8 = (i & 31) * 8; const int p = (n >> 7) & 1;
        u32x4 o = (u32x4){0u, 0u, 0u, 0u};
        if ((c8 >> 7) == p) { const float* s = sub_keys + (size_t)n * 128 + (c8 & 127); const f32x4 a = *(const f32x4*)s, b = *(const f32x4*)(s + 4);
            o.x = pk2(a.x, a.y); o.y = pk2(a.z, a.w); o.z = pk2(b.x, b.y); o.w = pk2(b.z, b.w); }
        *(u32x4*)((bf16_t*)(ws + WS_SKB) + (size_t)n * 256 + c8) = o;
    }
}

DI void p0_prologue(const Frame& F, const Args& A) {
    unsigned char* ws = A.ws;
    float* scr = (float*)(F.lds + F.wave * 16384);
    const float* w_in = A.in[3]; const float* w_uq = A.in[10]; const float* w_ukv = A.in[11]; const float* w_out = A.in[14]; const float* w_pq = A.in[16]; const float* sub_keys = A.in[17];
    constexpr int I_IN = 16 * 80;
    for (int it = F.wave * F.G + blockIdx.x; it < I_IN; it += F.NGW) transpose_item(w_in, 2480, (bf16_t*)(ws + WS_WIN), 1024, scr, it, 80, F.lane, MapWin());
    const float* x = A.in[0]; const float* meta = A.in[1]; const float* anorm = A.in[2];
    bf16_t* HN = (bf16_t*)(ws + WS_HN);
    for (int p0 = F.gw; p0 < MP; p0 += 3 * F.NGW) {
        f32x4 v[3][4]; bool ok[3];
#pragma unroll
        for (int r = 0; r < 3; ++r) {
            const int p = p0 + r * F.NGW, t = p - PADL; ok[r] = (p < MP) && t >= 0 && t < NTOK;
            if (ok[r]) { const float* src = (t < 16) ? meta + (size_t)t * DM : x + (size_t)(t - 16) * DM; const f32x4* xr = (const f32x4*)src + F.lane;
#pragma unroll
                for (int j = 0; j < 4; ++j) v[r][j] = xr[64 * j]; }
            else {
#pragma unroll
                for (int j = 0; j < 4; ++j) v[r][j] = (f32x4){0.f, 0.f, 0.f, 0.f}; }
        }
#pragma unroll
        for (int r = 0; r < 3; ++r) {
            const int p = p0 + r * F.NGW; if (p >= MP) continue;
            unsigned long long* o8 = (unsigned long long*)(HN + (size_t)p * DM) + F.lane;
            float s = 0.f;
#pragma unroll
            for (int j = 0; j < 4; ++j) s += (v[r][j].x * v[r][j].x + v[r][j].y * v[r][j].y) + (v[r][j].z * v[r][j].z + v[r][j].w * v[r][j].w);
            const float rstd = ok[r] ? 1.f / sqrtf(wave_sum(s) * (1.f / DM) + EPS) : 0.f;
#pragma unroll
            for (int j = 0; j < 4; ++j) { const f32x4 w = ((const f32x4*)anorm)[64 * j + F.lane];
                o8[64 * j] = (unsigned long long)pk2(v[r][j].x * rstd * w.x, v[r][j].y * rstd * w.y) | ((unsigned long long)pk2(v[r][j].z * rstd * w.z, v[r][j].w * rstd * w.w) << 32); }
        }
    }
}

DI void row_ss_atomic(const f32x4 (&v)[2][2][4][2], float* SS, int row0, int fq, bool bj0_only) {
#pragma unroll
    for (int ai = 0; ai < 2; ++ai)
#pragma unroll
        for (int m = 0; m < 4; ++m) {
            float s = 0.f;
#pragma unroll
            for (int bj = 0; bj < 2; ++bj) if (bj == 0 || !bj0_only)
#pragma unroll
                for (int n = 0; n < 2; ++n) { const f32x4 x = v[ai][bj][m][n]; s += (x[0] * x[0] + x[1] * x[1]) + (x[2] * x[2] + x[3] * x[3]); }
            s += __shfl_xor(s, 16); s += __shfl_xor(s, 32);
            if (fq == 0) atomicAdd(SS + row0 + ai * 128 + m * 16, s);
        }
}
struct EpiProj {
    static constexpr bool PERM = true;
    bf16_t* QKVR; bf16_t* Z; float* P32; bf16_t* CQ16; bf16_t* CKV16; float* KPE; float* SSQ; float* SSK;
    DI void operator()(const f32x4 (&acc)[2][2][4][2], const pg8::Unit& u, int wr, int wc, int fr, int fq) const {
        const int row0 = u.pm * 256 + wr * 64 + fr;
        if (u.pn < 8) {
            bf16_t* base; int ld, colt;
            if (u.pn < 6) { base = QKVR; ld = 1536; colt = u.pn * 256; } else { base = Z; ld = 512; colt = (u.pn - 6) * 256; }
            const int col0 = colt + wc * 32 + 8 * fq;
#pragma unroll
            for (int ai = 0; ai < 2; ++ai)
#pragma unroll
                for (int m = 0; m < 4; ++m) { bf16_t* rowp = base + (size_t)(row0 + ai * 128 + m * 16) * ld + col0;
#pragma unroll
                    for (int bj = 0; bj < 2; ++bj) { const f32x4 v0 = acc[ai][bj][m][0], v1 = acc[ai][bj][m][1];
                        u32x4 w; w.x = pg8::cvt_pk_bf16(v0[0], v0[1]); w.y = pg8::cvt_pk_bf16(v0[2], v0[3]); w.z = pg8::cvt_pk_bf16(v1[0], v1[1]); w.w = pg8::cvt_pk_bf16(v1[2], v1[3]);
                        *(u32x4*)(rowp + bj * 128) = w; } }
        } else {
            const int lcol0 = wc * 32 + 8 * fq;
            bf16_t* b16 = (u.pn == 8) ? CQ16 : CKV16;
#pragma unroll
            for (int ai = 0; ai < 2; ++ai)
#pragma unroll
                for (int m = 0; m < 4; ++m) { const size_t row = (size_t)(row0 + ai * 128 + m * 16);
                    float* rowp = P32 + row * 512 + (u.pn - 8) * 256 + lcol0;
#pragma unroll
                    for (int bj = 0; bj < 2; ++bj) { const f32x4 v0 = acc[ai][bj][m][0], v1 = acc[ai][bj][m][1];
                        *(f32x4*)(rowp + bj * 128) = v0; *(f32x4*)(rowp + bj * 128 + 4) = v1;
                        u32x4 w; w.x = pg8::cvt_pk_bf16(v0[0], v0[1]); w.y = pg8::cvt_pk_bf16(v0[2], v0[3]); w.z = pg8::cvt_pk_bf16(v1[0], v1[1]); w.w = pg8::cvt_pk_bf16(v1[2], v1[3]);
                        *(u32x4*)(b16 + row * 256 + lcol0 + bj * 128) = w;
                        if (u.pn == 9 && bj == 1 && wc == 0) { *(f32x4*)(KPE + row * 32 + 8 * fq) = v0; *(f32x4*)(KPE + row * 32 + 8 * fq + 4) = v1; }
                    } }
            row_ss_atomic(acc, (u.pn == 8) ? SSQ : SSK, row0, fq, u.pn == 9);
        }
    }
};
struct EpiB16 {
    static constexpr bool PERM = true;
    bf16_t* O; int ldc; const float* SS; float invn;
    DI void operator()(const f32x4 (&acc)[2][2][4][2], const pg8::Unit& u, int wr, int wc, int fr, int fq) const {
        const int row0 = u.pm * 256 + wr * 64 + fr, col0 = u.pn * 256 + wc * 32 + 8 * fq;
#pragma unroll
        for (int ai = 0; ai < 2; ++ai)
#pragma unroll
            for (int m = 0; m < 4; ++m) { const int row = row0 + ai * 128 + m * 16; bf16_t* rowp = O + (size_t)row * ldc + col0;
                const float rs = SS ? 1.f / sqrtf(SS[row] * invn + EPS) : 1.f;
#pragma unroll
                for (int bj = 0; bj < 2; ++bj) { const f32x4 v0 = acc[ai][bj][m][0] * rs, v1 = acc[ai][bj][m][1] * rs;
                    u32x4 w; w.x = pg8::cvt_pk_bf16(v0[0], v0[1]); w.y = pg8::cvt_pk_bf16(v0[2], v0[3]); w.z = pg8::cvt_pk_bf16(v1[0], v1[1]); w.w = pg8::cvt_pk_bf16(v1[2], v1[3]);
                    *(u32x4*)(rowp + bj * 128) = w; } }
    }
};
struct EpiH1 {
    static constexpr bool PERM = true;
    float* C; const float* res; bf16_t* H16; float* SS;
    DI void operator()(const f32x4 (&acc)[2][2][4][2], const pg8::Unit& u, int wr, int wc, int fr, int fq) const {
        const int row0 = u.pm * 256 + wr * 64 + fr, col0 = u.pn * 256 + wc * 32 + 8 * fq;
        f32x4 v[2][2][4][2];
#pragma unroll
        for (int ai = 0; ai < 2; ++ai)
#pragma unroll
            for (int m = 0; m < 4; ++m) { const size_t off = (size_t)(row0 + ai * 128 + m * 16) * 1024 + col0;
#pragma unroll
                for (int bj = 0; bj < 2; ++bj) { const f32x4 v0 = acc[ai][bj][m][0] + *(const f32x4*)(res + off + bj * 128), v1 = acc[ai][bj][m][1] + *(const f32x4*)(res + off + bj * 128 + 4);
                    v[ai][bj][m][0] = v0; v[ai][bj][m][1] = v1;
                    *(f32x4*)(C + off + bj * 128) = v0; *(f32x4*)(C + off + bj * 128 + 4) = v1;
                    u32x4 w; w.x = pg8::cvt_pk_bf16(v0[0], v0[1]); w.y = pg8::cvt_pk_bf16(v0[2], v0[3]); w.z = pg8::cvt_pk_bf16(v1[0], v1[1]); w.w = pg8::cvt_pk_bf16(v1[2], v1[3]);
                    *(u32x4*)(H16 + off + bj * 128) = w; } }
        row_ss_atomic(v, SS, row0, fq, false);
    }
};
struct EpiF32 {
    static constexpr bool PERM = true;
    float* C; int ldc; const float* res;
    DI void operator()(const f32x4 (&acc)[2][2][4][2], const pg8::Unit& u, int wr, int wc, int fr, int fq) const {
        const int row0 = u.pm * 256 + wr * 64 + fr, col0 = u.pn * 256 + wc * 32 + 8 * fq;
#pragma unroll
        for (int ai = 0; ai < 2; ++ai)
#pragma unroll
            for (int m = 0; m < 4; ++m) { const size_t off = (size_t)(row0 + ai * 128 + m * 16) * ldc + col0;
#pragma unroll
                for (int bj = 0; bj < 2; ++bj) { f32x4 v0 = acc[ai][bj][m][0], v1 = acc[ai][bj][m][1];
                    if (res) { v0 += *(const f32x4*)(res + off + bj * 128); v1 += *(const f32x4*)(res + off + bj * 128 + 4); }
                    *(f32x4*)(C + off + bj * 128) = v0; *(f32x4*)(C + off + bj * 128 + 4) = v1; } }
    }
};

DI f32x16 mfma32(bf16x8 a, bf16x8 b, f32x16 c) { return __builtin_amdgcn_mfma_f32_32x32x16_bf16(a, b, c, 0, 0, 0); }
DI f32x4 mfma16(bf16x8 a, bf16x8 b, f32x4 c) { return __builtin_amdgcn_mfma_f32_16x16x32_bf16(a, b, c, 0, 0, 0); }
DI int crow(int r, int hi) { return (r & 3) + 8 * (r >> 2) + 4 * hi; }
DI f32x16 zero16() { f32x16 z;
#pragma unroll
    for (int i = 0; i < 16; ++i) z[i] = 0.f; return z; }

constexpr int G_KF = 0, G_VF = 16384, G_MF = 32768;
constexpr int G_QB = 50176, G_KB = 59392, G_KBB = 68608;
constexpr int G_QKB = 77824, G_UT = 87040, G_WT = 96256, G_KDT = 105472;
constexpr int G_VEC = 114688;
constexpr int G_RAW = G_QKB;
constexpr int GST = 72;

DI f32x16 mm_quad(const unsigned char* A, const unsigned char* Bt, int qr, int qc, int lane) {
    const int r32 = lane & 31, hh = lane >> 5;
    const unsigned char* ap = A + (32 * qr + r32) * (GST * 2) + hh * 16;
    const unsigned char* bp = Bt + (32 * qc + r32) * (GST * 2) + hh * 16;
    f32x16 acc = zero16();
#pragma unroll
    for (int s = 0; s < 4; ++s) acc = mfma32(*(const bf16x8*)(ap + s * 32), *(const bf16x8*)(bp + s * 32), acc);
    return acc;
}

constexpr int G_RAW2 = 115712;
static_assert(G_RAW2 + 67 * 400 <= 143360, "GDN prep LDS map");
constexpr int G_CONVW = 143360 + 512;

#ifndef PROBE_STAGE
#define PROBE_STAGE -1
#endif
template <int VAR> DI void gdn_prep_phase(const Frame& F, const Args& A) {
    unsigned long long stg_t = 0ull, stg_acc = 0ull;
#define STG(n) do { if (PROBE_STAGE >= 0) { const unsigned long long now_ = __builtin_amdgcn_s_memrealtime(); if (PROBE_STAGE == (n)) stg_acc += now_ - stg_t; stg_t = now_; } } while (0)
    unsigned char* ws = A.ws; unsigned char* lds = F.lds;
    const int tid = F.tid, lane = F.lane, wave = F.wave;
    const bf16_t* QKVR = (const bf16_t*)(ws + WS_QKVR); const float* P32 = (const float*)(ws + WS_P32);
    float* KF = (float*)(lds + G_KF); float* VF = (float*)(lds + G_VF); float* MF = (float*)(lds + G_MF);
    float* VEC = (float*)(lds + G_VEC);
    if (VAR == 6) return;
    const int NIT = NCHUNK * 8;
#define LBAR() do { asm volatile("s_waitcnt lgkmcnt(0)" ::: "memory"); __builtin_amdgcn_s_barrier(); asm volatile("" ::: "memory"); } while (0)
#define LAUNDER(dst, src) int dst = (src); asm volatile("" : "+v"(dst))
    int item = blockIdx.x;
    if (item >= NIT) return;
    u32x4 pr[4]; float nb = 0.f, na = 0.f;
    auto raw_fetch = [&](int it) {
        const int c = it >> 3, h = it & 7; LAUNDER(tl, tid);
#pragma unroll
        for (int i = 0; i < 4; ++i) { const int q = tl + 512 * i; pr[i] = (u32x4){0u, 0u, 0u, 0u};
            if (q < 67 * 24) { const int r = q / 24, cc = q % 24, seg = cc >> 3, c8 = cc & 7; const int p = 64 * c - 3 + r;
                if (p >= 0) pr[i] = *(const u32x4*)(QKVR + (size_t)p * 1536 + seg * 512 + h * 64 + c8 * 8); } }
        if (wave == 0) { const int p = 64 * c + lane; nb = P32[(size_t)p * 512 + 416 + h]; na = P32[(size_t)p * 512 + 424 + h]; }
    };
    auto raw_park = [&]() {
        LAUNDER(tl, tid);
#pragma unroll
        for (int i = 0; i < 4; ++i) { const int q = tl + 512 * i;
            if (q < 67 * 24) { const int r = q / 24, cc = q % 24, seg = cc >> 3, c8 = cc & 7; *(u32x4*)(lds + G_RAW2 + r * 400 + (seg * 64 + c8 * 8) * 2) = pr[i]; } }
    };
    raw_fetch(item); raw_park();
    float cb = nb, ca = na;
    float* CWL = (float*)(lds + G_CONVW);
    int cw_h = -1;
#pragma unroll 1
    for (; item < NIT; item += F.G) {
        if (PROBE_STAGE >= 0 && stg_t == 0ull) stg_t = __builtin_amdgcn_s_memrealtime();
        const int c = item >> 3, h = item & 7;
        if (h != cw_h) { cw_h = h;
            if (tid < 192) { LAUNDER(t0, tid); const int sg = t0 >> 6, jt = (t0 >> 4) & 3, c4 = t0 & 15; *(f32x4*)(CWL + (sg * 4 + jt) * 64 + 4 * c4) = *(const f32x4*)(A.in[4] + jt * 1536 + sg * 512 + h * 64 + 4 * c4); } }
        const int nxt = item + F.G;
        if (VAR != 5 && nxt < NIT) raw_fetch(nxt);
        if (wave == 0) {
            const int p = 64 * c + lane;
            const float alog = A.in[5][h], dtb = A.in[6][h];
            float beta = sigmoidf_(cb);
            const float xx = ca + dtb; const float sp = xx > 20.f ? xx : log1pf(__expf(xx));
            float g = -__expf(alog) * sp;
            if (p < PADL) { beta = 0.f; g = 0.f; }
            float gc = g;
#pragma unroll
            for (int o = 1; o < 64; o <<= 1) { const float t = __shfl_up(gc, o); if (lane >= o) gc += t; }
            const float glast = __shfl(gc, 63);
            VEC[lane] = gc; VEC[64 + lane] = beta; VEC[128 + lane] = __expf(gc); VEC[192 + lane] = __expf(glast - gc);
        }
        LBAR(); STG(0);
        LAUNDER(t1, tid); const int sub = t1 & 15, grp = t1 >> 4;
#pragma unroll
        for (int sg = 0; sg < ((VAR == 2 || VAR >= 4) ? 0 : 3); ++sg) {
#pragma unroll 1
            for (int ps = 0; ps < 2; ++ps) {
                const int i = grp + 32 * ps;
                float acc[4] = {0.f, 0.f, 0.f, 0.f};
#pragma unroll
                for (int jt = 0; jt < 4; ++jt) {
                    const f32x4 w = *(const f32x4*)(CWL + (sg * 4 + jt) * 64 + 4 * sub);
                    const u32x2 rv = *(const u32x2*)(lds + G_RAW2 + (i + jt) * 400 + (sg * 64 + 4 * sub) * 2);
                    acc[0] += w.x * bflo(rv.x); acc[1] += w.y * bfhi(rv.x); acc[2] += w.z * bflo(rv.y); acc[3] += w.w * bfhi(rv.y);
                }
                float y[4];
#pragma unroll
                for (int k = 0; k < 4; ++k) y[k] = siluf_(acc[k]);
                if (sg < 2) {
                    float ss = (y[0] * y[0] + y[1] * y[1]) + (y[2] * y[2] + y[3] * y[3]);
                    ss += __shfl_xor(ss, 1); ss += __shfl_xor(ss, 2); ss += __shfl_xor(ss, 4); ss += __shfl_xor(ss, 8);
                    const float rn = 1.f / sqrtf(ss + EPS);
#pragma unroll
                    for (int k = 0; k < 4; ++k) y[k] *= rn;
                }
                if (sg == 0) {
                    u32x2 o; o.x = pk2(y[0] * 0.125f, y[1] * 0.125f); o.y = pk2(y[2] * 0.125f, y[3] * 0.125f);
                    *(u32x2*)(lds + G_QB + i * (GST * 2) + 8 * sub) = o;
                } else if (sg == 1) {
                    const float beta = VEC[64 + i], ekd = VEC[192 + i];
                    *(f32x4*)(KF + i * 64 + 4 * sub) = (f32x4){y[0], y[1], y[2], y[3]};
                    u32x2 o; o.x = pk2(y[0], y[1]); o.y = pk2(y[2], y[3]);
                    *(u32x2*)(lds + G_KB + i * (GST * 2) + 8 * sub) = o;
                    o.x = pk2(y[0] * beta, y[1] * beta); o.y = pk2(y[2] * beta, y[3] * beta);
                    *(u32x2*)(lds + G_KBB + i * (GST * 2) + 8 * sub) = o;
#pragma unroll
                    for (int k = 0; k < 4; ++k) *(bf16_t*)(lds + G_KDT + (4 * sub + k) * (GST * 2) + i * 2) = (bf16_t)f2bf(y[k] * ekd);
                } else {
                    *(f32x4*)(VF + i * 64 + 4 * sub) = (f32x4){y[0], y[1], y[2], y[3]};
                }
            }
        }
        LBAR(); STG(1);
        if (VAR != 3 && VAR < 4) {
            LAUNDER(l3, lane);
            const int prod = wave >> 2, quad = wave & 3, qr = quad >> 1, qc = quad & 1, r32 = l3 & 31, hh = l3 >> 5;
            const f32x16 acc = mm_quad(lds + (prod ? G_QB : G_KBB), lds + G_KB, qr, qc, l3);
            const int j = 32 * qc + r32; const float gcj = VEC[j];
#pragma unroll
            for (int r = 0; r < 16; ++r) {
                const int i = 32 * qr + crow(r, hh);
                if (prod == 0) { MF[i * 68 + j] = (j < i) ? acc[r] * __expf(VEC[i] - gcj) : 0.f; }
                else { *(bf16_t*)(lds + G_QKB + i * (GST * 2) + j * 2) = (bf16_t)f2bf((j <= i) ? acc[r] * __expf(VEC[i] - gcj) : 0.f); }
            }
        }
        LBAR(); STG(2);
        float* DB = (float*)(lds + G_KBB);
        if (VAR != 1 && VAR < 4 && wave == 0) {
            LAUNDER(l4, lane); const int b = l4 >> 4, jc = l4 & 15;
            float d[16];
#pragma unroll
            for (int i = 0; i < 16; ++i) {
                float acc = (i == jc) ? 1.f : 0.f;
                const float* mrow = MF + (16 * b + i) * 68 + 16 * b;
#pragma unroll
                for (int k = 0; k < i; ++k) acc -= mrow[k] * d[k];
                d[i] = acc;
            }
#pragma unroll
            for (int i = 0; i < 16; ++i) DB[(b * 16 + i) * 20 + jc] = d[i];
        }
        LBAR();
        if (VAR != 1 && VAR < 4) {
            LAUNDER(l4, lane); const int cc = l4 & 15, g = l4 >> 4;
            const bool isU = wave < 4; const int col = 16 * (wave & 3) + cc;
            const float* src = (isU ? VF : KF) + col;
            f32x4 X[4];
#pragma unroll
            for (int b = 0; b < 4; ++b) {
                f32x4 acc;
#pragma unroll
                for (int r = 0; r < 4; ++r) { const int i = 16 * b + 4 * g + r; float rv = src[i * 64] * VEC[64 + i]; if (!isU) rv *= VEC[128 + i]; acc[r] = -rv; }
#pragma unroll
                for (int a = 0; a < b; ++a) {
                    const f32x4 lv = *(const f32x4*)(MF + (16 * b + cc) * 68 + 16 * a + 4 * g);
#pragma unroll
                    for (int sp = 0; sp < 4; ++sp) acc = __builtin_amdgcn_mfma_f32_16x16x4f32(lv[sp], X[a][sp], acc, 0, 0, 0);
                }
                const f32x4 dv = *(const f32x4*)(DB + (b * 16 + cc) * 20 + 4 * g);
                f32x4 xb = (f32x4){0.f, 0.f, 0.f, 0.f};
#pragma unroll
                for (int sp = 0; sp < 4; ++sp) xb = __builtin_amdgcn_mfma_f32_16x16x4f32(dv[sp], acc[sp], xb, 0, 0, 0);
                X[b] = -xb;
                unsigned char* dst = lds + (isU ? G_UT : G_WT) + col * (GST * 2) + (16 * b + 4 * g) * 2;
                *(u32x2*)dst = (u32x2){pk2(X[b][0], X[b][1]), pk2(X[b][2], X[b][3])};
            }
        }
        LBAR(); STG(3);
        if (VAR != 3 && VAR < 4) {
            const float gl = VEC[128 + 63];
            bf16_t* GB = (bf16_t*)(ws + WS_GB) + (size_t)item * 4096;
            bf16_t* GQ = (bf16_t*)(ws + (VAR ? WS_GS : WS_GQ)) + (size_t)item * 4096; bf16_t* GO = (bf16_t*)(ws + (VAR ? WS_GS : WS_GO)) + (size_t)item * 4096;
            bf16_t* GAL = (bf16_t*)(lds + G_MF);
            LAUNDER(l5, lane); const int r32 = l5 & 31, hh = l5 >> 5;
#pragma unroll 1
            for (int it = 0; it < 2; ++it) {
                const int task = wave + 8 * it, prod = task >> 2, quad = task & 3, qr = quad >> 1, qc = quad & 1;
                const f32x16 acc = mm_quad(lds + (prod < 2 ? G_KDT : G_QKB), lds + ((prod & 1) ? G_UT : G_WT), qr, qc, l5);
                const int Cc = 32 * qc + r32;
                if (prod == 0) {
#pragma unroll
                    for (int r = 0; r < 16; ++r) {
                        const int R = 32 * qr + crow(r, hh);
                        const float val = ((R == Cc) ? gl : 0.f) - acc[r];
                        const int rb = R >> 4, m = R & 15, q4 = Cc >> 4, g = (Cc >> 2) & 3, rr = Cc & 3, ks = q4 >> 1, jj = 4 * (q4 & 1) + rr, ls = 16 * g + m;
                        GAL[((rb * 2 + ks) * 64 + ls) * 8 + jj] = (bf16_t)f2bf(val);
                    }
                } else if (prod == 1) {
                    const int eslab = Cc >> 4, n = Cc & 15;
#pragma unroll
                    for (int a = 0; a < 4; ++a) {
                        const int R0 = 32 * qr + 8 * a + 4 * hh; const int rb = R0 >> 4, g = (R0 >> 2) & 3, ls = 16 * g + n;
                        *(u32x2*)(GB + ((eslab * 4 + rb) * 64 + ls) * 4) = (u32x2){pk2(acc[4 * a], acc[4 * a + 1]), pk2(acc[4 * a + 2], acc[4 * a + 3])};
                    }
                } else if (prod == 2) {
#pragma unroll
                    for (int r = 0; r < 16; ++r) {
                        const int R = 32 * qr + crow(r, hh);
                        const float qv = bf2f(*(const bf16_t*)(lds + G_QB + R * (GST * 2) + Cc * 2));
                        GQ[R * 64 + Cc] = (bf16_t)f2bf(qv * VEC[128 + R] - acc[r]);
                    }
                } else {
#pragma unroll
                    for (int r = 0; r < 16; ++r) GO[(quad * 16 + r) * 64 + l5] = (bf16_t)f2bf(acc[r]);
                }
            }
        }
        if (VAR != 5 && nxt < NIT) { raw_park(); cb = nb; ca = na; }
        LBAR(); STG(4);
        if (VAR != 5) { LAUNDER(t6, tid); *(u32x4*)((bf16_t*)(ws + (VAR ? WS_GS : WS_GA)) + (size_t)item * 4096 + t6 * 8) = *(const u32x4*)(lds + G_MF + t6 * 16); }
        STG(5);
    }
    if (PROBE_STAGE >= 0 && tid == 0) { *(unsigned long long*)(lds + 143360 + 96) = stg_acc; }
}

constexpr int SC_D = 8, SC_PD = 6, SC_SLOT = 10240;
DI void gdn_scan(const Frame& F, const Args& A) {
    if (blockIdx.x >= 32) return;
    unsigned char* ws = A.ws;
    const int h = blockIdx.x & 7, eslab = blockIdx.x >> 3, lane = F.lane, wave = F.wave, n = lane & 15, g = lane >> 4;
    const unsigned char* GA = ws + WS_GA; const unsigned char* GB = ws + WS_GB; bf16_t* GS = (bf16_t*)(ws + WS_GS);
    LAS unsigned char* ring = (LAS unsigned char*)F.lds;
    const int np = (wave == 0) ? 0 : ((wave - 1 < 3) ? 2 : 1);
    auto issue = [&](int c) {
        const int cc = c < NCHUNK ? c : NCHUNK - 1;
        const size_t item = (size_t)cc * 8 + h;
        LAS unsigned char* slot = ring + (c % SC_D) * SC_SLOT;
#pragma unroll
        for (int i = 0; i < 2; ++i) if (i < np) {
            const int q = (wave - 1) + 7 * i;
            const unsigned char* src = (q < 8) ? GA + item * 8192 + q * 1024 : GB + item * 8192 + eslab * 2048 + (q - 8) * 1024;
            LAS unsigned char* dst = slot + ((q < 8) ? q * 1024 : 8192 + (q - 8) * 1024);
            __builtin_amdgcn_global_load_lds((const unsigned*)(src + lane * 16), (LAS unsigned*)dst, 16, 0, 0);
        }
    };
    for (int c = 0; c < SC_PD; ++c) issue(c);
    f32x4 S[4];
#pragma unroll
    for (int rb = 0; rb < 4; ++rb) S[rb] = (f32x4){0.f, 0.f, 0.f, 0.f};
#pragma unroll 1
    for (int c = 0; c < NCHUNK; ++c) {
        issue(c + SC_PD);
        if (np == 2) asm volatile("s_waitcnt vmcnt(12)" ::: "memory");
        else if (np == 1) asm volatile("s_waitcnt vmcnt(6)" ::: "memory");
        asm volatile("s_waitcnt lgkmcnt(0)" ::: "memory");
        __builtin_amdgcn_s_barrier();
        asm volatile("" ::: "memory");
        if (wave == 0) {
            const LAS unsigned char* slot = ring + (c % SC_D) * SC_SLOT;
            bf16x8 ac[8]; f32x4 bc[4];
#pragma unroll
            for (int q = 0; q < 8; ++q) ac[q] = *(const LAS bf16x8*)(slot + q * 1024 + lane * 16);
#pragma unroll
            for (int rb = 0; rb < 4; ++rb) { const u32x2 w = *(const LAS u32x2*)(slot + 8192 + rb * 512 + lane * 8); bc[rb] = (f32x4){bflo(w.x), bfhi(w.x), bflo(w.y), bfhi(w.y)}; }
            const size_t item = (size_t)c * 8 + h;
            u32x4 p0, p1;
            p0.x = pk2(S[0][0], S[0][1]); p0.y = pk2(S[0][2], S[0][3]); p0.z = pk2(S[1][0], S[1][1]); p0.w = pk2(S[1][2], S[1][3]);
            p1.x = pk2(S[2][0], S[2][1]); p1.y = pk2(S[2][2], S[2][3]); p1.z = pk2(S[3][0], S[3][1]); p1.w = pk2(S[3][2], S[3][3]);
            {
                bf16_t* st = GS + item * 4096 + (16 * eslab + n) * 64 + 4 * g;
                *(u32x2*)(st + 0) = (u32x2){p0.x, p0.y}; *(u32x2*)(st + 16) = (u32x2){p0.z, p0.w};
                *(u32x2*)(st + 32) = (u32x2){p1.x, p1.y}; *(u32x2*)(st + 48) = (u32x2){p1.z, p1.w};
            }
            const bf16x8 b0 = __builtin_bit_cast(bf16x8, p0), b1 = __builtin_bit_cast(bf16x8, p1);
#pragma unroll
            for (int rb = 0; rb < 4; ++rb) {
                f32x4 acc = bc[rb];
                acc = mfma16(ac[rb * 2 + 0], b0, acc);
                acc = mfma16(ac[rb * 2 + 1], b1, acc);
                S[rb] = acc;
            }
        }
    }
    asm volatile("s_waitcnt vmcnt(0) lgkmcnt(0)" ::: "memory");
    __builtin_amdgcn_s_barrier();
}

DI void gdn_out_task(const Frame& F, const Args& A, int task) {
    unsigned char* ws = A.ws;
    const int ihalf = task & 1, item = (task >> 1) + 8, c = item >> 3, h = item & 7, lane = F.lane, r32 = lane & 31, hh = lane >> 5;
    const bf16_t* GQ = (const bf16_t*)(ws + WS_GQ) + (size_t)item * 4096; const bf16_t* GS = (const bf16_t*)(ws + WS_GS) + (size_t)item * 4096;
    const bf16_t* GO = (const bf16_t*)(ws + WS_GO) + (size_t)item * 4096;
    const bf16_t* Z = (const bf16_t*)(ws + WS_Z); bf16_t* MIX = (bf16_t*)(ws + WS_MIX);
    f32x16 acc[2];
#pragma unroll
    for (int eh = 0; eh < 2; ++eh)
#pragma unroll
        for (int r = 0; r < 16; ++r) acc[eh][r] = bf2f(GO[((ihalf * 2 + eh) * 16 + r) * 64 + lane]);
#pragma unroll
    for (int s = 0; s < 4; ++s) {
        const bf16x8 a = *(const bf16x8*)(GQ + (32 * ihalf + r32) * 64 + 16 * s + 8 * hh);
#pragma unroll
        for (int eh = 0; eh < 2; ++eh) {
            const bf16x8 b = *(const bf16x8*)(GS + (32 * eh + r32) * 64 + 16 * s + 8 * hh);
            acc[eh] = mfma32(a, b, acc[eh]);
        }
    }
    const float* gnorm = A.in[7];
    const float w0 = gnorm[r32], w1 = gnorm[32 + r32];
#pragma unroll
    for (int r = 0; r < 16; ++r) {
        float ss = acc[0][r] * acc[0][r] + acc[1][r] * acc[1][r];
        ss += __shfl_xor(ss, 1); ss += __shfl_xor(ss, 2); ss += __shfl_xor(ss, 4); ss += __shfl_xor(ss, 8); ss += __shfl_xor(ss, 16);
        const float rstd = 1.f / sqrtf(ss * (1.f / 64.f) + EPS);
        const int i = 32 * ihalf + crow(r, hh); const int p = 64 * c + i;
        const float z0 = bf2f(Z[(size_t)p * 512 + h * 64 + r32]), z1 = bf2f(Z[(size_t)p * 512 + h * 64 + 32 + r32]);
        bf16_t* o = MIX + (size_t)(p - 64) * 1024 + h * 64;
        o[r32] = (bf16_t)f2bf(acc[0][r] * rstd * w0 * siluf_(z0));
        o[32 + r32] = (bf16_t)f2bf(acc[1][r] * rstd * w1 * siluf_(z1));
    }
}

DI void mla_prep1_rows(const Frame& F, const Args& A, int p0, int stride) {
    unsigned char* ws = A.ws; const int lane = F.lane;
    f32x4 q[4]; float k0[4], k1[4], pe[4];
#pragma unroll
    for (int r = 0; r < 4; ++r) { const int p = p0 + r * stride; const int pc = p < MP ? p : MP - 1;
        const float* P32 = (const float*)(ws + WS_P32) + (size_t)pc * 512;
        q[r] = *(const f32x4*)(P32 + 4 * lane); k0[r] = P32[256 + 2 * lane]; k1[r] = P32[256 + 2 * lane + 1]; pe[r] = P32[384 + (lane & 31)]; }
    const f32x4 wq = *(const f32x4*)(A.in[8] + 4 * lane);
    const float wk0 = A.in[9][2 * lane], wk1 = A.in[9][2 * lane + 1];
#pragma unroll
    for (int r = 0; r < 4; ++r) {
        const int p = p0 + r * stride; if (p >= MP) continue;
        bf16_t* CQN = (bf16_t*)(ws + WS_CQN) + (size_t)p * 256; bf16_t* CKVN = (bf16_t*)(ws + WS_CKVN) + (size_t)p * 256;
        const float sq = wave_sum((q[r].x * q[r].x + q[r].y * q[r].y) + (q[r].z * q[r].z + q[r].w * q[r].w));
        const float rq = 1.f / sqrtf(sq * (1.f / 256.f) + EPS);
        *(u32x2*)(CQN + 4 * lane) = (u32x2){pk2(q[r].x * rq * wq.x, q[r].y * rq * wq.y), pk2(q[r].z * rq * wq.z, q[r].w * rq * wq.w)};
        const float sk = wave_sum(k0[r] * k0[r] + k1[r] * k1[r]);
        const float rk = 1.f / sqrtf(sk * (1.f / 128.f) + EPS);
        *(unsigned*)(CKVN + 2 * lane) = pk2(k0[r] * rk * wk0, k1[r] * rk * wk1);
        *(unsigned*)(CKVN + 128 + 2 * lane) = 0u;
        if (lane < 32) ((float*)(ws + WS_KPE))[(size_t)p * 32 + lane] = pe[r];
    }
}

constexpr float QSCALE = 0.10206207261596577f * 1.4426950408889634f;
DI double rope_inv_rev(int i) {
    const double t8[8] = {0.15915494309189535, 0.08949940160889101, 0.050329212104487035, 0.0283021958306234, 0.015915494309189534, 0.008949940160889102, 0.005032921210448704, 0.00283021958306234};
    double v = t8[0];
#pragma unroll
    for (int k = 1; k < 8; ++k) v = ((i & 7) == k) ? t8[k] : v;
    return (i & 8) ? v * 0.01 : v;
}
constexpr int P2_TS = 136;
DI void mla_prep2_task(const Frame& F, const Args& A, int task) {
    unsigned char* ws = A.ws; const int lane = F.lane, h = task & 7, blk = task >> 3;
    const int p = 64 * blk + lane;
    const bool valid = (p >= PADL) && (p < LPV);
    const float* qn = A.in[12]; const float* kn = A.in[13];
    float sn[16], cs[16];
    { const double pos = (double)(p - PADL);
#pragma unroll
      for (int i = 0; i < 16; ++i) { const double rev = pos * rope_inv_rev(i); const float fr = (float)(rev - floor(rev)); sn[i] = __builtin_amdgcn_sinf(fr); cs[i] = __builtin_amdgcn_cosf(fr); } }
    {
        const bf16_t* src = (const bf16_t*)(ws + WS_QH) + (size_t)p * 768 + h * 96;
        u32x4 w[12];
#pragma unroll
        for (int c = 0; c < 12; ++c) w[c] = *(const u32x4*)(src + 8 * c);
        float ss = 0.f;
#pragma unroll
        for (int c = 0; c < 12; ++c) { const float a0 = bflo(w[c].x), a1 = bfhi(w[c].x), a2 = bflo(w[c].y), a3 = bfhi(w[c].y), a4 = bflo(w[c].z), a5 = bfhi(w[c].z), a6 = bflo(w[c].w), a7 = bfhi(w[c].w);
            ss += (a0 * a0 + a1 * a1) + (a2 * a2 + a3 * a3) + (a4 * a4 + a5 * a5) + (a6 * a6 + a7 * a7); }
        const float rs = valid ? QSCALE / sqrtf(ss * (1.f / 96.f) + EPS) : 0.f;
        bf16_t* dst = (bf16_t*)(ws + WS_Q) + ((size_t)h * KVROWS + p) * 96;
#pragma unroll
        for (int c = 0; c < 8; ++c) {
            const f32x4 g0 = *(const f32x4*)(qn + 8 * c), g1 = *(const f32x4*)(qn + 8 * c + 4);
            *(u32x4*)(dst + 8 * c) = (u32x4){pk2(bflo(w[c].x) * rs * g0.x, bfhi(w[c].x) * rs * g0.y), pk2(bflo(w[c].y) * rs * g0.z, bfhi(w[c].y) * rs * g0.w),
                                             pk2(bflo(w[c].z) * rs * g1.x, bfhi(w[c].z) * rs * g1.y), pk2(bflo(w[c].w) * rs * g1.z, bfhi(w[c].w) * rs * g1.w)};
        }
#pragma unroll
        for (int c = 0; c < 2; ++c) {
            float x1[8], x2[8];
            const u32x4 wa = w[8 + c], wb = w[10 + c];
            x1[0] = bflo(wa.x); x1[1] = bfhi(wa.x); x1[2] = bflo(wa.y); x1[3] = bfhi(wa.y); x1[4] = bflo(wa.z); x1[5] = bfhi(wa.z); x1[6] = bflo(wa.w); x1[7] = bfhi(wa.w);
            x2[0] = bflo(wb.x); x2[1] = bfhi(wb.x); x2[2] = bflo(wb.y); x2[3] = bfhi(wb.y); x2[4] = bflo(wb.z); x2[5] = bfhi(wb.z); x2[6] = bflo(wb.w); x2[7] = bfhi(wb.w);
            float o1[8], o2[8];
#pragma unroll
            for (int t = 0; t < 8; ++t) { const float a = x1[t] * rs * qn[64 + 8 * c + t], b = x2[t] * rs * qn[80 + 8 * c + t]; o1[t] = a * cs[8 * c + t] - b * sn[8 * c + t]; o2[t] = b * cs[8 * c + t] + a * sn[8 * c + t]; }
            *(u32x4*)(dst + 64 + 8 * c) = (u32x4){pk2(o1[0], o1[1]), pk2(o1[2], o1[3]), pk2(o1[4], o1[5]), pk2(o1[6], o1[7])};
            *(u32x4*)(dst + 80 + 8 * c) = (u32x4){pk2(o2[0], o2[1]), pk2(o2[2], o2[3]), pk2(o2[4], o2[5]), pk2(o2[6], o2[7])};
        }
    }
    {
        const bf16_t* src = (const bf16_t*)(ws + WS_KVB) + (size_t)p * 1024 + h * 128;
        const float* kpe = (const float*)(ws + WS_KPE) + (size_t)p * 32;
        u32x4 w[8]; f32x4 e[8];
#pragma unroll
        for (int c = 0; c < 8; ++c) { w[c] = *(const u32x4*)(src + 8 * c); e[c] = *(const f32x4*)(kpe + 4 * c); }
        float ss = 0.f;
#pragma unroll
        for (int c = 0; c < 8; ++c) { const float a0 = bflo(w[c].x), a1 = bfhi(w[c].x), a2 = bflo(w[c].y), a3 = bfhi(w[c].y), a4 = bflo(w[c].z), a5 = bfhi(w[c].z), a6 = bflo(w[c].w), a7 = bfhi(w[c].w);
            ss += (a0 * a0 + a1 * a1) + (a2 * a2 + a3 * a3) + (a4 * a4 + a5 * a5) + (a6 * a6 + a7 * a7);
            ss += (e[c].x * e[c].x + e[c].y * e[c].y) + (e[c].z * e[c].z + e[c].w * e[c].w); }
        const float rs = valid ? 1.f / sqrtf(ss * (1.f / 96.f) + EPS) : 0.f;
        bf16_t* dst = (bf16_t*)(ws + WS_K) + ((size_t)h * KVROWS + p) * 96;
#pragma unroll
        for (int c = 0; c < 8; ++c) {
            const f32x4 g0 = *(const f32x4*)(kn + 8 * c), g1 = *(const f32x4*)(kn + 8 * c + 4);
            *(u32x4*)(dst + 8 * c) = (u32x4){pk2(bflo(w[c].x) * rs * g0.x, bfhi(w[c].x) * rs * g0.y), pk2(bflo(w[c].y) * rs * g0.z, bfhi(w[c].y) * rs * g0.w),
                                             pk2(bflo(w[c].z) * rs * g1.x, bfhi(w[c].z) * rs * g1.y), pk2(bflo(w[c].w) * rs * g1.z, bfhi(w[c].w) * rs * g1.w)};
        }
#pragma unroll
        for (int c = 0; c < 2; ++c) {
            const float x1[8] = {e[2 * c].x, e[2 * c].y, e[2 * c].z, e[2 * c].w, e[2 * c + 1].x, e[2 * c + 1].y, e[2 * c + 1].z, e[2 * c + 1].w};
            const float x2[8] = {e[4 + 2 * c].x, e[4 + 2 * c].y, e[4 + 2 * c].z, e[4 + 2 * c].w, e[5 + 2 * c].x, e[5 + 2 * c].y, e[5 + 2 * c].z, e[5 + 2 * c].w};
            float o1[8], o2[8];
#pragma unroll
            for (int t = 0; t < 8; ++t) { const float a = x1[t] * rs * kn[64 + 8 * c + t], b = x2[t] * rs * kn[80 + 8 * c + t]; o1[t] = a * cs[8 * c + t] - b * sn[8 * c + t]; o2[t] = b * cs[8 * c + t] + a * sn[8 * c + t]; }
            *(u32x4*)(dst + 64 + 8 * c) = (u32x4){pk2(o1[0], o1[1]), pk2(o1[2], o1[3]), pk2(o1[4], o1[5]), pk2(o1[6], o1[7])};
            *(u32x4*)(dst + 80 + 8 * c) = (u32x4){pk2(o2[0], o2[1]), pk2(o2[2], o2[3]), pk2(o2[4], o2[5]), pk2(o2[6], o2[7])};
        }
    }
    {
        unsigned char* T = F.lds + F.wave * (64 * P2_TS);
        const bf16_t* src = (const bf16_t*)(ws + WS_KVB) + h * 128 + 64;
#pragma unroll
        for (int it = 0; it < 8; ++it) {
            const int pr = 8 * it + (lane >> 3), ch = lane & 7; const int pp = 64 * blk + pr;
            u32x4 v = (u32x4){0u, 0u, 0u, 0u};
            if (pp >= PADL && pp < LPV) v = *(const u32x4*)(src + (size_t)pp * 1024 + 8 * ch);
            unsigned char* tp = T + (8 * ch) * P2_TS + pr * 2;
            *(bf16_t*)(tp + 0 * P2_TS) = (bf16_t)(v.x & 0xffffu); *(bf16_t*)(tp + 1 * P2_TS) = (bf16_t)(v.x >> 16);
            *(bf16_t*)(tp + 2 * P2_TS) = (bf16_t)(v.y & 0xffffu); *(bf16_t*)(tp + 3 * P2_TS) = (bf16_t)(v.y >> 16);
            *(bf16_t*)(tp + 4 * P2_TS) = (bf16_t)(v.z & 0xffffu); *(bf16_t*)(tp + 5 * P2_TS) = (bf16_t)(v.z >> 16);
            *(bf16_t*)(tp + 6 * P2_TS) = (bf16_t)(v.w & 0xffffu); *(bf16_t*)(tp + 7 * P2_TS) = (bf16_t)(v.w >> 16);
        }
        __builtin_amdgcn_s_waitcnt(0); __builtin_amdgcn_wave_barrier();
        bf16_t* VT = (bf16_t*)(ws + WS_VT) + (size_t)h * 64 * KVROWS + 64 * blk;
#pragma unroll
        for (int it = 0; it < 8; ++it) {
            const int e = 8 * it + (lane >> 3), ch = lane & 7;
            const u32x2 lo = *(const u32x2*)(T + e * P2_TS + 16 * ch), hi = *(const u32x2*)(T + e * P2_TS + 16 * ch + 8);
            *(u32x4*)(VT + (size_t)e * KVROWS + 8 * ch) = (u32x4){lo.x, lo.y, hi.x, hi.y};
        }
        __builtin_amdgcn_s_waitcnt(0); __builtin_amdgcn_wave_barrier();
    }
}

constexpr int A_KSTR = 208;
constexpr int A_VSTR = 136;
constexpr int A_KBYTES = 64 * A_KSTR;
constexpr int A_VBYTES = 64 * A_VSTR;
constexpr int A_BUF = A_KBYTES + A_VBYTES;
DI unsigned cvtpk_s(float lo, float hi) { typedef float f2 __attribute__((ext_vector_type(2))); typedef __bf16 b2 __attribute__((ext_vector_type(2))); f2 v = {lo, hi}; b2 b = __builtin_convertvector(v, b2); return __builtin_bit_cast(unsigned, b); }

DI void attn_item(const Frame& F, const Args& A, int h, int qb) {
    unsigned char* ws = A.ws; unsigned char* lds = F.lds;
    const int tid = F.tid, lane = F.lane, wave = F.wave, r32 = lane & 31, hh = lane >> 5;
    const bf16_t* Qg = (const bf16_t*)(ws + WS_Q) + (size_t)h * KVROWS * 96;
    const bf16_t* Kg = (const bf16_t*)(ws + WS_K) + (size_t)h * KVROWS * 96;
    const bf16_t* Vg = (const bf16_t*)(ws + WS_VT) + (size_t)h * 64 * KVROWS;
    const int p0w = 64 + 256 * qb + 32 * wave;
    const int qp = p0w + r32;
    const int ntile = 4 * qb + 5;
    const int mylast = 1 + 4 * qb + (wave >> 1);
    bf16x8 qf[6];
#pragma unroll
    for (int s = 0; s < 6; ++s) qf[s] = *(const bf16x8*)(Qg + (size_t)qp * 96 + 16 * s + 8 * hh);
    f32x16 ot[2]; ot[0] = zero16(); ot[1] = zero16();
    float mrun = -1e30f, lrun = 0.f;
    const int kr0 = tid / 12, kc0 = tid % 12, kr1 = (tid + 512) / 12, kc1 = (tid + 512) % 12; const bool k1ok = tid < 256;
    const int vr = tid >> 3, vc = tid & 7;
    struct Stg { u32x4 k0, k1, v; };
    Stg sA, sB;
    auto gload = [&](Stg& st, int j) {
        const int kv0 = 64 * j;
        st.k0 = *(const u32x4*)(Kg + (size_t)(kv0 + kr0) * 96 + kc0 * 8);
        if (k1ok) st.k1 = *(const u32x4*)(Kg + (size_t)(kv0 + kr1) * 96 + kc1 * 8);
        st.v = *(const u32x4*)(Vg + (size_t)vr * KVROWS + kv0 + vc * 8);
    };
    auto lstore = [&](const Stg& st, int b) {
        unsigned char* kb = lds + b * A_BUF; unsigned char* vb = kb + A_KBYTES;
        *(u32x4*)(kb + kr0 * A_KSTR + kc0 * 16) = st.k0;
        if (k1ok) *(u32x4*)(kb + kr1 * A_KSTR + kc1 * 16) = st.k1;
        *(u32x2*)(vb + vr * A_VSTR + vc * 16) = (u32x2){st.v.x, st.v.y};
        *(u32x2*)(vb + vr * A_VSTR + vc * 16 + 8) = (u32x2){st.v.z, st.v.w};
    };
    gload(sA, 0); lstore(sA, 0); gload(sB, 1);
    __syncthreads();
    auto step = [&](int j, Stg& sNext  , Stg& sFree  ) {
        const int b = j & 1;
        if (j + 2 < ntile) gload(sFree, j + 2);
        if (j <= mylast) {
            const unsigned char* kb = lds + b * A_BUF; const unsigned char* vb = kb + A_KBYTES;
            f32x16 sc[2];
#pragma unroll
            for (int kh = 0; kh < 2; ++kh) {
                f32x16 acc = zero16();
                const unsigned char* kp = kb + (32 * kh + r32) * A_KSTR + hh * 16;
#pragma unroll
                for (int s = 0; s < 6; ++s) acc = mfma32(*(const bf16x8*)(kp + s * 32), qf[s], acc);
                sc[kh] = acc;
            }
            if (j == 0) {
#pragma unroll
                for (int kh = 0; kh < 2; ++kh)
#pragma unroll
                    for (int r = 0; r < 16; ++r) { const int kv = 32 * kh + crow(r, hh); if (kv < PADL) sc[kh][r] = -INFINITY; }
            }
            if (j == mylast) {
#pragma unroll
                for (int kh = 0; kh < 2; ++kh)
#pragma unroll
                    for (int r = 0; r < 16; ++r) { const int kv = 64 * j + 32 * kh + crow(r, hh); if (kv > qp) sc[kh][r] = -INFINITY; }
            }
            float mx = sc[0][0];
#pragma unroll
            for (int r = 1; r < 16; ++r) mx = fmaxf(mx, sc[0][r]);
#pragma unroll
            for (int r = 0; r < 16; ++r) mx = fmaxf(mx, sc[1][r]);
            mx = fmaxf(mx, __shfl_xor(mx, 32));
            const float mnew = fmaxf(mrun, mx);
            const float alpha = __builtin_amdgcn_exp2f(mrun - mnew);
            mrun = mnew;
            float ps = 0.f;
#pragma unroll
            for (int kh = 0; kh < 2; ++kh)
#pragma unroll
                for (int r = 0; r < 16; ++r) { const float e = __builtin_amdgcn_exp2f(sc[kh][r] - mnew); sc[kh][r] = e; ps += e; }
            lrun = lrun * alpha + ps;
#pragma unroll
            for (int eh = 0; eh < 2; ++eh)
#pragma unroll
                for (int r = 0; r < 16; ++r) ot[eh][r] *= alpha;
#pragma unroll
            for (int kh = 0; kh < 2; ++kh)
#pragma unroll
                for (int s2 = 0; s2 < 2; ++s2) {
                    u32x4 pw; pw.x = cvtpk_s(sc[kh][8 * s2 + 0], sc[kh][8 * s2 + 1]); pw.y = cvtpk_s(sc[kh][8 * s2 + 2], sc[kh][8 * s2 + 3]);
                    pw.z = cvtpk_s(sc[kh][8 * s2 + 4], sc[kh][8 * s2 + 5]); pw.w = cvtpk_s(sc[kh][8 * s2 + 6], sc[kh][8 * s2 + 7]);
                    const bf16x8 pf = __builtin_bit_cast(bf16x8, pw);
#pragma unroll
                    for (int eh = 0; eh < 2; ++eh) {
                        const unsigned char* vp = vb + (32 * eh + r32) * A_VSTR + (32 * kh + 16 * s2 + 4 * hh) * 2;
                        const u32x2 lo = *(const u32x2*)vp, hi2 = *(const u32x2*)(vp + 16);
                        const bf16x8 vf = __builtin_bit_cast(bf16x8, (u32x4){lo.x, lo.y, hi2.x, hi2.y});
                        ot[eh] = mfma32(vf, pf, ot[eh]);
                    }
                }
        }
        if (j + 1 < ntile) lstore(sNext, b ^ 1);
        __syncthreads();
    };
#pragma unroll 1
    for (int j = 0; j < ntile; j += 2) {
        step(j, sB, sA);
        if (j + 1 < ntile) step(j + 1, sA, sB);
    }
    const float ltot = lrun + __shfl_xor(lrun, 32);
    const float rl = 1.f / ltot;
    bf16_t* o = (bf16_t*)(ws + WS_MIX) + (size_t)(qp - 64) * 1024 + 512 + h * 64;
#pragma unroll
    for (int eh = 0; eh < 2; ++eh)
#pragma unroll
        for (int a = 0; a < 4; ++a) {
            const int e = 32 * eh + 8 * a + 4 * hh;
            *(u32x2*)(o + e) = (u32x2){pk2(ot[eh][4 * a] * rl, ot[eh][4 * a + 1] * rl), pk2(ot[eh][4 * a + 2] * rl, ot[eh][4 * a + 3] * rl)};
        }
}

DI void xn_rows(const Frame& F, const Args& A, int u0, int stride) {
    f32x4 v[2][4];
#pragma unroll
    for (int r = 0; r < 2; ++r) { const int u = u0 + r * stride; if (u < MU) { const f32x4* xr = (const f32x4*)(A.out + (size_t)u * DM) + F.lane;
#pragma unroll
        for (int j = 0; j < 4; ++j) v[r][j] = xr[64 * j]; } }
#pragma unroll
    for (int r = 0; r < 2; ++r) {
        const int u = u0 + r * stride; if (u >= MU) continue;
        float s = 0.f;
#pragma unroll
        for (int j = 0; j < 4; ++j) s += (v[r][j].x * v[r][j].x + v[r][j].y * v[r][j].y) + (v[r][j].z * v[r][j].z + v[r][j].w * v[r][j].w);
        const float rstd = 1.f / sqrtf(wave_sum(s) * (1.f / DM) + EPS);
        unsigned long long* o8 = (unsigned long long*)((bf16_t*)(A.ws + WS_XN) + (size_t)u * DM) + F.lane;
#pragma unroll
        for (int j = 0; j < 4; ++j) { const f32x4 w = ((const f32x4*)A.in[15])[64 * j + F.lane];
            o8[64 * j] = (unsigned long long)pk2(v[r][j].x * rstd * w.x, v[r][j].y * rstd * w.y) | ((unsigned long long)pk2(v[r][j].z * rstd * w.z, v[r][j].w * rstd * w.w) << 32); }
    }
}

DI unsigned fkey(float v, int idx) { unsigned u = __builtin_bit_cast(unsigned, v); u = (u & 0x80000000u) ? ~u : (u | 0x80000000u); return (u & ~127u) | (unsigned)(127 - idx); }
DI float keyval(unsigned k) { unsigned u = k & ~127u; u = (u & 0x80000000u) ? (u & 0x7fffffffu) : ~u; return __builtin_bit_cast(float, u); }

__device__ const unsigned char PAIR_A[50] = {0,0,0,0,0,0,0,0,0,0,0,0,0,0,0,0, 1,1,1,1,1,1,1,1, 2,2,2,2,2, 3,3,3,3, 4,4,4, 5,5, 6,6, 7,7, 8,9,10,11,12,13,14,15};
__device__ const unsigned char PAIR_B[50] = {0,1,2,3,4,5,6,7,8,9,10,11,12,13,14,15, 0,1,2,3,4,5,6,7, 0,1,2,3,4, 0,1,2,3, 0,1,2, 0,1, 0,1, 0,1, 0,0,0,0,0,0,0,0};

DI void ce_desc(unsigned& a, unsigned& b) { const unsigned mx = a > b ? a : b, mn = a > b ? b : a; a = mx; b = mn; }
template <int BASE, int NK> DI void bitonic_sort16_desc(unsigned (&x)[NK]) {
#pragma unroll
    for (int k = 2; k <= 16; k <<= 1)
#pragma unroll
        for (int j = k >> 1; j > 0; j >>= 1)
#pragma unroll
            for (int i = 0; i < 16; ++i) { const int l = i ^ j; if (l > i) { if ((i & k) == 0) ce_desc(x[BASE + i], x[BASE + l]); else ce_desc(x[BASE + l], x[BASE + i]); } }
}
template <int A0, int B0, int NK> DI void merge_top16(unsigned (&x)[NK]) {
#pragma unroll
    for (int i = 0; i < 16; ++i) { const unsigned p = x[A0 + i], q = x[B0 + 15 - i]; x[A0 + i] = p > q ? p : q; }
#pragma unroll
    for (int j = 8; j > 0; j >>= 1)
#pragma unroll
        for (int i = 0; i < 16; ++i) { const int l = i ^ j; if (l > i) ce_desc(x[A0 + i], x[A0 + l]); }
}
template <int NK> DI void top16_of_128(unsigned (&key)[NK]) {
    bitonic_sort16_desc<0, NK>(key); bitonic_sort16_desc<16, NK>(key); bitonic_sort16_desc<32, NK>(key); bitonic_sort16_desc<48, NK>(key);
    bitonic_sort16_desc<64, NK>(key); bitonic_sort16_desc<80, NK>(key); bitonic_sort16_desc<96, NK>(key); bitonic_sort16_desc<112, NK>(key);
    merge_top16<0, 16, NK>(key); merge_top16<32, 48, NK>(key); merge_top16<64, 80, NK>(key); merge_top16<96, 112, NK>(key);
    merge_top16<0, 32, NK>(key); merge_top16<64, 96, NK>(key);
    merge_top16<0, 64, NK>(key);
}

DI void topk_task(const Frame& F, const Args& A, int task) {
    unsigned char* ws = A.ws; const int tid = F.tid;
    const int u = task >> 3, h = task & 7;
    LAS unsigned* sk = (LAS unsigned*)(LAS unsigned char*)F.lds;
    LAS unsigned* pkk = sk + 16384;
    LAS float* stg = (LAS float*)(sk + 16384);
    const float* SCb = (const float*)(ws + WS_SC) + (size_t)(task & ~511) * 256;
#pragma unroll 1
    for (int half = 0; half < 2; ++half) {
        unsigned key[128];
#pragma unroll
        for (int qb = 0; qb < 4; ++qb) {
            u32x4 pf[8];
#pragma unroll
            for (int k = 0; k < 8; ++k) { const int c = tid + 512 * k; pf[k] = *(const u32x4*)(SCb + (size_t)(c >> 3) * 256 + half * 128 + qb * 32 + (c & 7) * 4); }
#pragma unroll
            for (int k = 0; k < 8; ++k) { const int c = tid + 512 * k; *(LAS u32x4*)(stg + (c >> 3) * 36 + (c & 7) * 4) = pf[k]; }
            __syncthreads();
#pragma unroll
            for (int i = 0; i < 8; ++i) { const f32x4 v = *(const LAS f32x4*)(stg + tid * 36 + 4 * i);
                key[32 * qb + 4 * i] = fkey(v.x, 32 * qb + 4 * i); key[32 * qb + 4 * i + 1] = fkey(v.y, 32 * qb + 4 * i + 1);
                key[32 * qb + 4 * i + 2] = fkey(v.z, 32 * qb + 4 * i + 2); key[32 * qb + 4 * i + 3] = fkey(v.w, 32 * qb + 4 * i + 3); }
            __syncthreads();
        }
        top16_of_128(key);
#pragma unroll
        for (int r = 0; r < 16; ++r) sk[(half * 16 + r) * 512 + tid] = key[r];
    }
    float v1[16], v2[16];
#pragma unroll
    for (int r = 0; r < 16; ++r) { v1[r] = keyval(sk[r * 512 + tid]); v2[r] = keyval(sk[(16 + r) * 512 + tid]); }
    unsigned ck[64];
#pragma unroll
    for (int c = 50; c < 64; ++c) ck[c] = 0u;
#pragma unroll
    for (int a = 0; a < 16; ++a) {
        const int off = a == 0 ? 0 : a == 1 ? 16 : a == 2 ? 24 : a == 3 ? 29 : a == 4 ? 33 : a == 5 ? 36 : a == 6 ? 38 : a == 7 ? 40 : 42 + (a - 8);
#pragma unroll
        for (int b = 0; b < 16; ++b) if ((a + 1) * (b + 1) <= 16) ck[off + b] = fkey(v1[a] + v2[b], off + b);
    }
    bitonic_sort16_desc<0, 64>(ck); bitonic_sort16_desc<16, 64>(ck); bitonic_sort16_desc<32, 64>(ck); bitonic_sort16_desc<48, 64>(ck);
    merge_top16<0, 16, 64>(ck); merge_top16<32, 48, 64>(ck); merge_top16<0, 32, 64>(ck);
#pragma unroll
    for (int r = 0; r < 16; ++r) pkk[r * 512 + tid] = ck[r];
    const float cmax = keyval(pkk[tid]);
    float ev[16]; float esum = 0.f; int ex[16];
#pragma unroll
    for (int r = 0; r < 16; ++r) {
        const unsigned k = pkk[r * 512 + tid]; const int c = 127 - (int)(k & 127u);
        ev[r] = __expf(keyval(k) - cmax); esum += ev[r];
        const int a = PAIR_A[c], b = PAIR_B[c];
        const int i1 = 127 - (int)(sk[a * 512 + tid] & 127u), i2 = 127 - (int)(sk[(16 + b) * 512 + tid] & 127u);
        ex[r] = i1 * 128 + i2;
    }
    const float rs = 1.f / esum;
    int* IDX = (int*)(ws + WS_IDX) + (size_t)u * 128 + h * 16; float* GATE = (float*)(ws + WS_GATE) + (size_t)u * 128 + h * 16;
#pragma unroll
    for (int r = 0; r < 16; r += 4) {
        *(int4*)(IDX + r) = make_int4(ex[r], ex[r + 1], ex[r + 2], ex[r + 3]);
        *(f32x4*)(GATE + r) = (f32x4){ev[r] * rs, ev[r + 1] * rs, ev[r + 2] * rs, ev[r + 3] * rs};
    }
}

constexpr float EU_SCALE = 64.f, EV_SCALE = 16.f;
DI unsigned pk4_fp8(float a, float b, float c, float d) { int w = 0; w = __builtin_amdgcn_cvt_pk_fp8_f32(a, b, w, false); w = __builtin_amdgcn_cvt_pk_fp8_f32(c, d, w, true); return (unsigned)w; }
DI void convert_tables(const Frame& F, const Args& A) {
    const size_t n16 = (size_t)16384 * 1024 / 16;
    const size_t gt = (size_t)blockIdx.x * 512 + F.tid, NGT = (size_t)F.G * 512;
#pragma unroll 1
    for (int t = 0; t < 2; ++t) {
        const float* src = A.in[18 + t]; unsigned char* dst = A.ws + (t ? WS_EV : WS_EU); const float sc = t ? EV_SCALE : EU_SCALE;
        const float* fn = A.in[15];
        for (size_t i = gt; i < n16; i += NGT) {
            f32x4 a = *(const f32x4*)(src + i * 16) * sc, b = *(const f32x4*)(src + i * 16 + 4) * sc, c = *(const f32x4*)(src + i * 16 + 8) * sc, d = *(const f32x4*)(src + i * 16 + 12) * sc;
            if (t == 0) { const float* g = fn + (i & 63) * 16; a *= *(const f32x4*)g; b *= *(const f32x4*)(g + 4); c *= *(const f32x4*)(g + 8); d *= *(const f32x4*)(g + 12); }
            const size_t e_ = i >> 6, c16_ = i & 63;
            *(u32x4*)(dst + (c16_ >> 3) * ((size_t)16384 * 128) + e_ * 128 + (c16_ & 7) * 16) = (u32x4){pk4_fp8(a.x, a.y, a.z, a.w), pk4_fp8(b.x, b.y, b.z, b.w), pk4_fp8(c.x, c.y, c.z, c.w), pk4_fp8(d.x, d.y, d.z, d.w)};
        }
    }
}

DI float gelu_exact(float x) { return 0.5f * x * (1.f + erff(x * 0.70710678118654752f)); }
typedef float f32x2 __attribute__((ext_vector_type(2)));
#define UNPK16(dst, W_) do { f32x2 _t; \
    _t = __builtin_amdgcn_cvt_pk_f32_fp8((int)(W_).x, false); dst[0] = _t.x; dst[1] = _t.y; _t = __builtin_amdgcn_cvt_pk_f32_fp8((int)(W_).x, true); dst[2] = _t.x; dst[3] = _t.y; \
    _t = __builtin_amdgcn_cvt_pk_f32_fp8((int)(W_).y, false); dst[4] = _t.x; dst[5] = _t.y; _t = __builtin_amdgcn_cvt_pk_f32_fp8((int)(W_).y, true); dst[6] = _t.x; dst[7] = _t.y; \
    _t = __builtin_amdgcn_cvt_pk_f32_fp8((int)(W_).z, false); dst[8] = _t.x; dst[9] = _t.y; _t = __builtin_amdgcn_cvt_pk_f32_fp8((int)(W_).z, true); dst[10] = _t.x; dst[11] = _t.y; \
    _t = __builtin_amdgcn_cvt_pk_f32_fp8((int)(W_).w, false); dst[12] = _t.x; dst[13] = _t.y; _t = __builtin_amdgcn_cvt_pk_f32_fp8((int)(W_).w, true); dst[14] = _t.x; dst[15] = _t.y; } while (0)

template <bool UPH>
DI void expert_phase(const Frame& F, const Args& A, int xv, int wq, int nw) {
    unsigned char* ws = A.ws; const int lane = F.lane, grp = lane >> 3, j = lane & 7;
    const unsigned char* TBL = ws + (UPH ? WS_EU : WS_EV) + (size_t)xv * ((size_t)16384 * 128) + 16 * j;
    const int* IDX = (const int*)(ws + WS_IDX); const float* CW = (const float*)(ws + WS_CW);
    const bf16_t* XN = (const bf16_t*)(ws + WS_XN) + 128 * xv + 16 * j;
    float* HP = (float*)(ws + WS_HP);
    LAS unsigned* ring = (LAS unsigned*)((LAS unsigned char*)F.lds + F.wave * 4096);
    const int nt = (MU - wq + nw - 1) / nw;
    if (nt <= 0) return;
    auto tok = [&](int k) { return __builtin_amdgcn_readfirstlane(wq + (k < nt ? k : nt - 1) * nw); };
    int mi0, mi1; u32x4 mx0, mx1; float mh0, mh1;
    auto meta_load = [&](int k) {
        const int u = tok(k);
        mi0 = IDX[(size_t)u * 128 + lane]; mi1 = IDX[(size_t)u * 128 + 64 + lane];
        if constexpr (UPH) { mx0 = *(const u32x4*)(XN + (size_t)u * DM); mx1 = *(const u32x4*)(XN + (size_t)u * DM + 8); }
        else { mh0 = CW[(size_t)u * 128 + lane]; mh1 = CW[(size_t)u * 128 + 64 + lane]; }
    };
    auto meta_store = [&](int k) {
        LAS unsigned* sl = ring + (k & 3) * 256;
        sl[lane] = (unsigned)mi0; sl[64 + lane] = (unsigned)mi1;
        if constexpr (UPH) { if (grp == 0) { *(LAS u32x4*)(sl + 128 + 8 * j) = mx0; *(LAS u32x4*)(sl + 128 + 8 * j + 4) = mx1; } }
        else { sl[128 + lane] = __builtin_bit_cast(unsigned, mh0); sl[192 + lane] = __builtin_bit_cast(unsigned, mh1); }
    };
    auto gather = [&](u32x4 (&buf)[8], int n) {
        const LAS unsigned* sl = ring + ((n >> 1) & 3) * 256 + 64 * (n & 1) + grp;
#pragma unroll
        for (int i = 0; i < 8; ++i) { const int e = (int)sl[8 * i]; buf[i] = *(const u32x4*)(TBL + (size_t)e * 128); }
    };
    const int ocol = 128 * xv + 16 * j + ((lane & 32) ? 8 : 0) + ((lane & 16) ? 4 : 0) + ((lane & 8) ? 2 : 0);
    f32x2 ocur = (f32x2){0.f, 0.f};
    float acc[16];
    float xn[16];
    auto compute = [&](u32x4 (&buf)[8], int n) {
        const int k = n >> 1, hf = n & 1;
        const LAS unsigned* sl = ring + (k & 3) * 256;
        if (hf == 0) {
            if constexpr (UPH) {
                const u32x4 x0 = *(const LAS u32x4*)(sl + 128 + 8 * j), x1 = *(const LAS u32x4*)(sl + 128 + 8 * j + 4);
                xn[0] = bflo(x0.x); xn[1] = bfhi(x0.x); xn[2] = bflo(x0.y); xn[3] = bfhi(x0.y); xn[4] = bflo(x0.z); xn[5] = bfhi(x0.z); xn[6] = bflo(x0.w); xn[7] = bfhi(x0.w);
                xn[8] = bflo(x1.x); xn[9] = bfhi(x1.x); xn[10] = bflo(x1.y); xn[11] = bfhi(x1.y); xn[12] = bflo(x1.z); xn[13] = bfhi(x1.z); xn[14] = bflo(x1.w); xn[15] = bfhi(x1.w);
            } else {
#pragma unroll
                for (int c = 0; c < 16; ++c) acc[c] = 0.f;
                ocur = *(const f32x2*)(A.out + (size_t)tok(k) * DM + ocol);
            }
        }
#pragma unroll
        for (int i = 0; i < 8; ++i) {
            float f[16]; UNPK16(f, buf[i]);
            if constexpr (UPH) {
                float a0 = 0.f, a1 = 0.f;
#pragma unroll
                for (int c = 0; c < 16; c += 2) { a0 += f[c] * xn[c]; a1 += f[c + 1] * xn[c + 1]; }
                if (hf == 0) acc[i] = a0 + a1; else acc[8 + i] = a0 + a1;
                if (i < 7) { if (hf == 0) asm volatile("" : "+v"(buf[i + 1].x), "+v"(buf[i + 1].y), "+v"(buf[i + 1].z), "+v"(buf[i + 1].w), "+v"(acc[i]));
                             else asm volatile("" : "+v"(buf[i + 1].x), "+v"(buf[i + 1].y), "+v"(buf[i + 1].z), "+v"(buf[i + 1].w), "+v"(acc[8 + i])); }
            } else {
                const float cw = __builtin_bit_cast(float, sl[128 + 64 * hf + 8 * i + grp]);
#pragma unroll
                for (int c = 0; c < 16; ++c) acc[c] += cw * f[c];
                if (i < 7) asm volatile("" : "+v"(buf[i + 1].x), "+v"(buf[i + 1].y), "+v"(buf[i + 1].z), "+v"(buf[i + 1].w),
                                             "+v"(acc[0]), "+v"(acc[1]), "+v"(acc[2]), "+v"(acc[3]), "+v"(acc[4]), "+v"(acc[5]), "+v"(acc[6]), "+v"(acc[7]),
                                             "+v"(acc[8]), "+v"(acc[9]), "+v"(acc[10]), "+v"(acc[11]), "+v"(acc[12]), "+v"(acc[13]), "+v"(acc[14]), "+v"(acc[15]));
            }
            __builtin_amdgcn_sched_barrier(0);
        }
        if (hf == 1 && k < nt) {
            const int u = tok(k);
            float r8[8], r4[4], r2[2];
            if constexpr (UPH) {
                { const bool up = lane & 4;
#pragma unroll
                  for (int i = 0; i < 8; ++i) { const float send = up ? acc[i] : acc[i + 8], keep = up ? acc[i + 8] : acc[i]; r8[i] = keep + __shfl_xor(send, 4); } }
                { const bool up = lane & 2;
#pragma unroll
                  for (int i = 0; i < 4; ++i) { const float send = up ? r8[i] : r8[i + 4], keep = up ? r8[i + 4] : r8[i]; r4[i] = keep + __shfl_xor(send, 2); } }
                { const bool up = lane & 1;
#pragma unroll
                  for (int i = 0; i < 2; ++i) { const float send = up ? r4[i] : r4[i + 2], keep = up ? r4[i + 2] : r4[i]; r2[i] = keep + __shfl_xor(send, 1); } }
                const int st = ((lane & 4) ? 8 : 0) + ((lane & 2) ? 4 : 0) + ((lane & 1) ? 2 : 0);
                float* hp = HP + ((size_t)xv * MU + u) * 128 + grp;
                hp[8 * st] = r2[0]; hp[8 * (st + 1)] = r2[1];
            } else {
                { const bool up = lane & 32;
#pragma unroll
                  for (int c = 0; c < 8; ++c) { const float send = up ? acc[c] : acc[c + 8], keep = up ? acc[c + 8] : acc[c]; r8[c] = keep + __shfl_xor(send, 32); } }
                { const bool up = lane & 16;
#pragma unroll
                  for (int c = 0; c < 4; ++c) { const float send = up ? r8[c] : r8[c + 4], keep = up ? r8[c + 4] : r8[c]; r4[c] = keep + __shfl_xor(send, 16); } }
                { const bool up = lane & 8;
#pragma unroll
                  for (int c = 0; c < 2; ++c) { const float send = up ? r4[c] : r4[c + 2], keep = up ? r4[c + 2] : r4[c]; r2[c] = keep + __shfl_xor(send, 8); } }
                f32x2* o = (f32x2*)(A.out + (size_t)u * DM + ocol);
                f32x2 cur = ocur; cur.x += r2[0]; cur.y += r2[1]; *o = cur;
            }
        }
    };
    meta_load(0); meta_store(0); meta_load(1); meta_store(1); meta_load(2); meta_store(2);
    u32x4 b0[8], b1[8], b2[8];
    gather(b0, 0); gather(b1, 1); gather(b2, 2);
#pragma unroll 1
    for (int k0 = 0; k0 < nt; k0 += 3) {
        const int n0 = 2 * k0;
        meta_load(k0 + 3);
        compute(b0, n0);     gather(b0, n0 + 3);
        compute(b1, n0 + 1); meta_store(k0 + 3); gather(b1, n0 + 4);
        meta_load(k0 + 4);
        compute(b2, n0 + 2); gather(b2, n0 + 5);
        compute(b0, n0 + 3); meta_store(k0 + 4); gather(b0, n0 + 6);
        meta_load(k0 + 5);
        compute(b1, n0 + 4); gather(b1, n0 + 7);
        compute(b2, n0 + 5); meta_store(k0 + 5); gather(b2, n0 + 8);
    }
}


DI void expert_c_pass(const Frame& F, const Args& A) {
    unsigned char* ws = A.ws;
    const float* HP = (const float*)(ws + WS_HP); const float* GATE = (const float*)(ws + WS_GATE); float* CW = (float*)(ws + WS_CW);
    const size_t n4 = (size_t)MU * 128 / 4;
    for (size_t i = (size_t)blockIdx.x * 512 + F.tid; i < n4; i += (size_t)F.G * 512) {
        f32x4 h = *(const f32x4*)(HP + i * 4);
#pragma unroll
        for (int x = 1; x < 8; ++x) h += *(const f32x4*)(HP + (size_t)x * MU * 128 + i * 4);
        const f32x4 g = *(const f32x4*)(GATE + i * 4);
        const float rs = (1.f / EU_SCALE) / sqrtf(((const float*)(ws + WS_SS4))[i >> 5] * (1.f / DM) + EPS);
        f32x4 c;
        c.x = gelu_exact(h.x * rs) * g.x * (1.f / EV_SCALE); c.y = gelu_exact(h.y * rs) * g.y * (1.f / EV_SCALE);
        c.z = gelu_exact(h.z * rs) * g.z * (1.f / EV_SCALE); c.w = gelu_exact(h.w * rs) * g.w * (1.f / EV_SCALE);
        *(f32x4*)(CW + i * 4) = c;
    }
}
template <int PH> DI void run_phase(const Frame& F, const Args& args, PG8_LAS unsigned char* lds3) {
    unsigned char* ws = args.ws;
    if constexpr (PH == 0) { p0_prologue(F, args); p0_late_weights<0>(F, args, (7 - F.wave) * F.G + blockIdx.x, F.NGW, blockIdx.x * 512 + F.tid, F.G * 512); }
    if constexpr (PH == 1) {
        pg8::Gemm g{(const bf16_t*)(ws + WS_HN), (const bf16_t*)(ws + WS_WIN), MP, NPROJ, 1024, 1024, 1024, 0};
        pg8::StaticOrder S; S.init(MP, NPROJ, F.G, (int)blockIdx.x);
        EpiProj E{(bf16_t*)(ws + WS_QKVR), (bf16_t*)(ws + WS_Z), (float*)(ws + WS_P32), (bf16_t*)(ws + WS_CQN), (bf16_t*)(ws + WS_CKVN), (float*)(ws + WS_KPE), (float*)(ws + WS_SSQ), (float*)(ws + WS_SSK)};
        pg8::gemm_phase<EpiProj, pg8::StaticOrder, true, true>(lds3, g, S, E);
    }
    if constexpr (PH == 2) { gdn_prep_phase<0>(F, args); }
    if constexpr (PH == 3) {
        { pg8::Gemm g{(const bf16_t*)(ws + WS_CQN), (const bf16_t*)(ws + WS_WUQ), MP, 768, 256, 256, 256, 0};
          pg8::StaticOrder S; S.init(MP, 768, F.G, (int)blockIdx.x); EpiB16 E{(bf16_t*)(ws + WS_QH), 768, (const float*)(ws + WS_SSQ), 1.f / 256.f};
          pg8::gemm_phase<EpiB16, pg8::StaticOrder, true, true>(lds3, g, S, E); }
        { pg8::Gemm g{(const bf16_t*)(ws + WS_CKVN), (const bf16_t*)(ws + WS_WUKV), MP, 1024, 256, 256, 256, 0};
          pg8::StaticOrder S; S.init(MP, 1024, F.G, (int)blockIdx.x); EpiB16 E{(bf16_t*)(ws + WS_KVB), 1024, (const float*)(ws + WS_SSK), 1.f / 128.f};
          pg8::gemm_phase<EpiB16, pg8::StaticOrder, true, true>(lds3, g, S, E); }
    }
    if constexpr (PH == 4) { for (int t = F.gw; t < (KVROWS / 64) * 8; t += F.NGW) mla_prep2_task(F, args, t); }
    if constexpr (PH == 5) {
        gdn_scan(F, args);
        volatile LAS unsigned* MISC = (volatile LAS unsigned*)(lds3 + MISC_OFF);
        unsigned* qhead = (unsigned*)(ws + WS_CTL) + CW_ATTQ;
        for (;;) {
            __syncthreads();
            if (F.tid == 0) MISC[24] = xb_add(qhead, 1u);
            __syncthreads();
            const int k = (int)MISC[24];
            if (k >= 512) break;
            attn_item(F, args, k & 7, 63 - (k >> 3));
        }
        p0_late_weights<1>(F, args, F.gw, F.NGW, blockIdx.x * 512 + F.tid, F.G * 512);
    }
    if constexpr (PH == 6) { for (int t = F.gw; t < 2048 * 2; t += F.NGW) gdn_out_task(F, args, t); }
    if constexpr (PH == 7) {
        pg8::Gemm g{(const bf16_t*)(ws + WS_MIX), (const bf16_t*)(ws + WS_WOUT), MU, 1024, 1024, 1024, 1024, 0};
        pg8::StaticOrder S; S.init(MU, 1024, F.G, (int)blockIdx.x); EpiH1 E{args.out, args.in[0], (bf16_t*)(ws + WS_XN), (float*)(ws + WS_SS4)};
        pg8::gemm_phase<EpiH1, pg8::StaticOrder, true, true>(lds3, g, S, E);
    }
    if constexpr (PH == 8) {
        pg8::Gemm g{(const bf16_t*)(ws + WS_XN), (const bf16_t*)(ws + WS_WPQ), MU, 2048, 1024, 1024, 1024, 0};
        pg8::StaticOrder S; S.init(MU, 2048, F.G, (int)blockIdx.x); EpiB16 E{(bf16_t*)(ws + WS_PQ), 2048, (const float*)(ws + WS_SS4), 1.f / 1024.f};
        pg8::gemm_phase<EpiB16, pg8::StaticOrder, true, true>(lds3, g, S, E);
    }
    if constexpr (PH == 9) {
        pg8::Gemm g{(const bf16_t*)(ws + WS_PQ), (const bf16_t*)(ws + WS_SKB), MU, 2048, 256, 2048, 256, 256};
        pg8::StaticOrder S; S.init(MU, 2048, F.G, (int)blockIdx.x); EpiF32 E{(float*)(ws + WS_SC), 2048, nullptr};
        pg8::gemm_phase<EpiF32, pg8::StaticOrder, true, true>(lds3, g, S, E);
    }
    if constexpr (PH == 10) {
        convert_tables(F, args);
        for (int t = blockIdx.x * 512 + F.tid; t < MU * 8; t += F.G * 512) topk_task(F, args, t);
    }
    if constexpr (PH == 12) { expert_c_pass(F, args); }
    if constexpr (PH == 11 || PH == 13) {
        volatile LAS unsigned* MISC = (volatile LAS unsigned*)(lds3 + MISC_OFF);
        const unsigned x = MISC[16], rank = MISC[17];
        unsigned* bar = (unsigned*)(ws + WS_CTL);
        unsigned nloc = 0, nx = 0, myidx = 0;
#pragma unroll
        for (unsigned j = 0; j < 16; ++j) { const unsigned c = xb_ld(&bar[XB_XCNT(j)]); nx += (c > 0u) ? 1u : 0u; myidx += (c > 0u && j < x) ? 1u : 0u; nloc = (j == x) ? c : nloc; }
        const int wq = __builtin_amdgcn_readfirstlane((int)rank * 8 + F.wave), nw = __builtin_amdgcn_readfirstlane((int)nloc * 8);
        const int xstep = __builtin_amdgcn_readfirstlane((int)nx);
        for (int xv = __builtin_amdgcn_readfirstlane((int)myidx); xv < 8; xv += xstep)
            { if constexpr (PH == 11) expert_phase<true>(F, args, xv, wq, nw); else expert_phase<false>(F, args, xv, wq, nw); }
    }
}
constexpr int NPHASE = 14;
__global__ void __launch_bounds__(512, 2) fwd_kernel(Args args) {
    extern __shared__ __attribute__((aligned(16))) unsigned char lds[];
    Frame F;
    F.lds = lds; F.tid = threadIdx.x; F.lane = F.tid & 63; F.wave = __builtin_amdgcn_readfirstlane(F.tid >> 6);
    F.G = gridDim.x; F.gw = blockIdx.x * 8 + F.wave; F.NGW = F.G * 8;
    volatile LAS unsigned* MISC = (volatile LAS unsigned*)((LAS unsigned char*)lds + MISC_OFF);
    if (F.tid < 32) MISC[F.tid] = 0u;
    __syncthreads();
    unsigned char* ws = args.ws;
    const int lo = args.ph_lo, hi = args.ph_hi;
    XcdBarrier bar; bar.bar = (unsigned*)(ws + WS_CTL); bar.x = 0; bar.st = nullptr;
    if (hi - lo > 1) bar = xcd_barrier_post((unsigned*)(ws + WS_CTL), MISC + 8);
    if (F.tid == 0) { const unsigned x = xb_xcc_id(); MISC[16] = x; MISC[17] = xb_add((unsigned*)(ws + WS_CTL) + 3520 + 64 * x, 1u); }
    __syncthreads();
#define IN(k) (lo <= (k) && (k) < hi)
#define SEAM(k) do { if (IN(k) && IN((k) + 1)) xcd_barrier(bar); } while (0)
    PG8_LAS unsigned char* lds3 = (PG8_LAS unsigned char*)lds;

#ifndef PROBE_REPEAT
#define PROBE_REPEAT -1
#endif
#ifndef PROBE_TIME
#define PROBE_TIME -1
#endif
#ifndef PROBE_TSEL
#define PROBE_TSEL 0
#endif
    unsigned long long pt_ticks = 0ull;
#define PHASE(k) do { unsigned long long pt0_ = 0ull; if (PROBE_TIME == (k)) pt0_ = __builtin_amdgcn_s_memrealtime(); \
        if (IN(k)) { run_phase<k>(F, args, lds3); if (PROBE_REPEAT == (k)) { xcd_barrier(bar); run_phase<(k)>(F, args, lds3); } } \
        if (PROBE_TIME == (k) && PROBE_TSEL == 1) pt_ticks = __builtin_amdgcn_s_memrealtime() - pt0_;     \
        if (PROBE_TIME == (k) && PROBE_TSEL == 2) pt0_ = __builtin_amdgcn_s_memrealtime();                \
        SEAM(k); \
        if (PROBE_TIME == (k) && PROBE_TSEL != 1) pt_ticks = __builtin_amdgcn_s_memrealtime() - pt0_; } while (0)
    PHASE(0); PHASE(1); PHASE(2); PHASE(3); PHASE(4); PHASE(5); PHASE(6); PHASE(7); PHASE(8); PHASE(9); PHASE(10); PHASE(11); PHASE(12); PHASE(13);
#undef PHASE
    if (PROBE_STAGE >= 0) { __syncthreads(); pt_ticks = *(volatile unsigned long long*)(lds + 143360 + 96); }
    if (PROBE_TIME >= 0 || PROBE_STAGE >= 0) { const unsigned long long t0_ = __builtin_amdgcn_s_memrealtime(); while (__builtin_amdgcn_s_memrealtime() - t0_ < 4ull * pt_ticks) __builtin_amdgcn_s_sleep(32); }
#undef IN
#undef SEAM
}

#ifndef N_LAUNCHES
#define N_LAUNCHES 1
#endif
extern "C" void kernel_launch(void* const* d_in, const int* in_sizes, int n_in, void* d_out, int out_size, void* d_ws, size_t ws_size, hipStream_t stream) {
    static int grid = 0;
    if (grid == 0) {
        if (n_in != 20 || out_size != MU * DM || ws_size < WS_END) { fprintf(stderr, "kernel_launch: unexpected shapes (n_in %d out %d ws %zu)\n", n_in, out_size, ws_size); grid = -1; return; }
        int dev = 0, cus = 0, per_cu = 0;
        if (hipGetDevice(&dev) != hipSuccess || hipDeviceGetAttribute(&cus, hipDeviceAttributeMultiprocessorCount, dev) != hipSuccess) { grid = -1; return; }
        if (hipFuncSetAttribute((const void*)fwd_kernel, hipFuncAttributeMaxDynamicSharedMemorySize, LDS_BYTES) != hipSuccess) { fprintf(stderr, "kernel_launch: hipFuncSetAttribute failed\n"); grid = -1; return; }
        if (hipOccupancyMaxActiveBlocksPerMultiprocessor(&per_cu, (const void*)fwd_kernel, 512, LDS_BYTES) != hipSuccess || per_cu < 1) { fprintf(stderr, "kernel_launch: occupancy query says %d\n", per_cu); (void)hipGetLastError(); per_cu = 1; }
        grid = cus;
    }
    if (grid < 0) return;
    (void)hipMemsetAsync((char*)d_ws + WS_CTL, 0, CTL_ZERO_BYTES, stream);
    Args a{};
    for (int i = 0; i < 20; ++i) a.in[i] = (const float*)d_in[i];
    a.out = (float*)d_out; a.ws = (unsigned char*)d_ws;
    for (int li = 0; li < N_LAUNCHES; ++li) {
        a.ph_lo = li * NPHASE / N_LAUNCHES; a.ph_hi = (li + 1) * NPHASE / N_LAUNCHES;
        if (N_LAUNCHES == 1) {
            void* kargs[] = {&a};
            hipError_t e = hipLaunchCooperativeKernel((const void*)fwd_kernel, dim3(grid), dim3(512), kargs, LDS_BYTES, stream);
            if (e != hipSuccess) fprintf(stderr, "cooperative launch failed: %s (grid %d)\n", hipGetErrorString(e), grid);
        } else {
            hipLaunchKernelGGL(fwd_kernel, dim3(grid), dim3(512), LDS_BYTES, stream, a);
        }
    }
}
```

```cpp
#include <hip/hip_runtime.h>
#include <hip/hip_bf16.h>
#include <cstdio>
#include <cstdint>

#define DI __device__ __forceinline__
#define LAS __attribute__((address_space(3)))
#define GAS __attribute__((address_space(1)))

typedef unsigned short bf16_t;
typedef short bf16x8 __attribute__((ext_vector_type(8)));
typedef short s16x4 __attribute__((ext_vector_type(4)));
typedef float f32x4 __attribute__((ext_vector_type(4)));
typedef float f32x16 __attribute__((ext_vector_type(16)));
typedef unsigned u32x4 __attribute__((ext_vector_type(4)));
typedef unsigned u32x2 __attribute__((ext_vector_type(2)));

namespace pg8 {
#define PG8_LAS __attribute__((address_space(3)))
constexpr int BM = 256, BK = 64, HALF = 128, HTB = HALF * BK * 2  , STAGE_BYTES = 8 * HTB, NXCD = 8, WGM = 8;

__host__ __device__ __forceinline__ int lds_byte(int r, int c) { const int st = (r >> 4) * 2 + (c >> 5), rr = r & 15, cc = c & 31, ob = rr * 64 + cc * 2; return st * 1024 + (ob ^ (((ob >> 9) & 1) << 5)); }
__host__ __device__ __forceinline__ void stage_rc(int b, int& R, int& C) { const int st = b / 1024, sb = b % 1024, swz = sb ^ (((sb >> 9) & 1) << 5); R = (st >> 1) * 16 + swz / 64; C = (st & 1) * 32 + (swz % 64) / 2; }
__host__ __device__ __forceinline__ int perm32(int rho) { const int n = rho >> 4, i = rho & 15; return 8 * (i >> 2) + 4 * n + (i & 3); }

struct Unit { int pm, pn; };
struct Gemm { const bf16_t* A; const bf16_t* Bt; int M, N, K, lda, ldb, a_pn_off; };

struct StaticOrder {
    int nM, nN, nwg, G, c;
    __host__ __device__ void init(int M, int N, int G_, int c_) { nM = M / BM; nN = N / BM; nwg = nM * nN; G = G_; c = c_; }
    __host__ __device__ bool next(int i, Unit& u) const {
        const long L = (long)i * G + c; if (L >= nwg) return false;
        int wgid = (int)L; { const int q = nwg / NXCD, r = nwg % NXCD, xcd = wgid % NXCD, off = wgid / NXCD; wgid = (xcd < r ? xcd * (q + 1) : r * (q + 1) + (xcd - r) * q) + off; }
        const int nig = WGM * nN, gid = wgid / nig, fm = gid * WGM, gsz = (nM - fm) < WGM ? (nM - fm) : WGM;
        u.pm = fm + ((wgid % nig) % gsz); u.pn = (wgid % nig) / gsz; return true;
    }
    __device__ __forceinline__ void a_ready(const Unit&) const {}
    __device__ __forceinline__ void done(const Unit&) const {}
};

__device__ __forceinline__ unsigned cvt_pk_bf16(float lo, float hi) { unsigned r; asm volatile("v_cvt_pk_bf16_f32 %0, %1, %2" : "=v"(r) : "v"(lo), "v"(hi)); return r; }

template <class Epi, class Sched, bool ALIGN_EPI = false, bool SP2 = false>
__device__ __forceinline__ void gemm_phase(PG8_LAS unsigned char* lds, const Gemm g, const Sched& S, const Epi& E) {
    const int tid = threadIdx.x, wid = __builtin_amdgcn_readfirstlane(tid >> 6), lane = tid & 63, wr = wid >> 2, wc = wid & 3, fr = lane & 15, fq = lane >> 4;
    const int K = g.K, nt = K / BK;
    unsigned voffA[2], voffB[2];
#pragma unroll
    for (int i = 0; i < 2; ++i) { int R, C; stage_rc(tid * 16 + i * 8192, R, C); const int Rb = Epi::PERM ? ((R & ~31) + perm32(R & 31)) : R;
        voffA[i] = (unsigned)(R * g.lda + C) * 2u; voffB[i] = (unsigned)(Rb * g.ldb + C) * 2u; }
    const size_t kstep = (size_t)(BK * 2);
    const size_t hstepA = (size_t)HALF * g.lda * 2, hstepB = (size_t)HALF * g.ldb * 2;
    const size_t tstepA = 2 * hstepA, tstepB = 2 * hstepB;
    const size_t pnoffA = (size_t)g.a_pn_off * 2;
    const unsigned ldsw = (unsigned)wid * 1024u;
    const int aoff = lds_byte(wr * 64 + fr, fq * 8), boff = lds_byte(wc * 32 + fr, fq * 8);
#define PG8_SA(b, h) (((b) * 2 + (h)) * HTB)
#define PG8_SB(b, h) ((4 + (b) * 2 + (h)) * HTB)
#define PG8_STAGE(bufoff, gbase, voff) do { _Pragma("unroll") for (int _i = 0; _i < 2; ++_i) \
        __builtin_amdgcn_global_load_lds((const unsigned*)((const char*)(gbase) + (voff)[_i]), (PG8_LAS unsigned*)(lds + (bufoff) + ldsw + _i * 8192), 16, 0, 0); } while (0)
#define PG8_LDA(dst, b, h) do { _Pragma("unroll") for (int m = 0; m < 4; ++m) _Pragma("unroll") for (int k = 0; k < 2; ++k) dst[m][k] = *(const PG8_LAS bf16x8*)(lds + PG8_SA(b, h) + aoff + m * 2048 + k * 1024); } while (0)
#define PG8_LDB(dst, b, h) do { _Pragma("unroll") for (int n = 0; n < 2; ++n) _Pragma("unroll") for (int k = 0; k < 2; ++k) dst[n][k] = *(const PG8_LAS bf16x8*)(lds + PG8_SB(b, h) + boff + n * 2048 + k * 1024); } while (0)
#define PG8_MMA(ai, bj, At, Bt) do { __builtin_amdgcn_s_setprio(1); _Pragma("unroll") for (int m = 0; m < 4; ++m) _Pragma("unroll") for (int n = 0; n < 2; ++n) _Pragma("unroll") for (int k = 0; k < 2; ++k) \
        acc[ai][bj][m][n] = __builtin_amdgcn_mfma_f32_16x16x32_bf16(Bt[n][k], At[m][k], acc[ai][bj][m][n], 0, 0, 0); __builtin_amdgcn_s_setprio(0); } while (0)
#define PG8_WAIT_V(n) asm volatile("s_waitcnt vmcnt(" #n ")" ::: "memory")
#define PG8_WAIT_L(n) asm volatile("s_waitcnt lgkmcnt(" #n ")" ::: "memory")
#define PG8_BAR __builtin_amdgcn_s_barrier()
#define PG8_SCHED __builtin_amdgcn_sched_barrier(0)
    Unit cur, nxt; int ui = 0;
    if (!S.next(0, cur)) return;
    f32x4 acc[2][2][4][2];
#pragma unroll
    for (int a = 0; a < 2; ++a)
#pragma unroll
        for (int b = 0; b < 2; ++b)
#pragma unroll
            for (int m = 0; m < 4; ++m)
#pragma unroll
                for (int n = 0; n < 2; ++n) acc[a][b][m][n] = (f32x4){0.f, 0.f, 0.f, 0.f};
    bf16x8 At[4][2], B0[2][2], B1[2][2];
    const char* cA = (const char*)g.A + (size_t)cur.pm * tstepA + (size_t)cur.pn * pnoffA; const char* cB = (const char*)g.Bt + (size_t)cur.pn * tstepB;
    S.a_ready(cur);
    if constexpr (SP2) {
        PG8_STAGE(PG8_SB(0, 0), cB, voffB); PG8_STAGE(PG8_SB(0, 1), cB + hstepB, voffB); PG8_STAGE(PG8_SA(0, 0), cA, voffA); PG8_STAGE(PG8_SA(0, 1), cA + hstepA, voffA);
        if (wr == 1) PG8_BAR;
        PG8_WAIT_V(2); PG8_BAR;
        PG8_STAGE(PG8_SB(1, 0), cB + kstep, voffB); PG8_STAGE(PG8_SA(1, 0), cA + kstep, voffA); PG8_STAGE(PG8_SB(1, 1), cB + hstepB + kstep, voffB);
        PG8_WAIT_V(6); PG8_BAR;
    } else {
        PG8_STAGE(PG8_SB(0, 0), cB, voffB); PG8_STAGE(PG8_SA(0, 0), cA, voffA); PG8_STAGE(PG8_SB(0, 1), cB + hstepB, voffB); PG8_STAGE(PG8_SA(0, 1), cA + hstepA, voffA);
        if (wr == 1) PG8_BAR;
        PG8_WAIT_V(4); PG8_BAR;
        PG8_STAGE(PG8_SB(1, 0), cB + kstep, voffB); PG8_STAGE(PG8_SA(1, 0), cA + kstep, voffA); PG8_STAGE(PG8_SB(1, 1), cB + hstepB + kstep, voffB);
        PG8_WAIT_V(6); PG8_BAR;
    }
    for (;;) {
        const bool has_next = S.next(ui + 1, nxt);
        const char* nA = has_next ? (const char*)g.A + (size_t)nxt.pm * tstepA + (size_t)nxt.pn * pnoffA : cA; const char* nB = has_next ? (const char*)g.Bt + (size_t)nxt.pn * tstepB : cB;
        for (int t = 0; t < nt; t += 2) {
            const bool last = (t == nt - 2);
            const char* a1 = cA + (size_t)(t + 1) * kstep;
            const char* a2 = last ? nA : cA + (size_t)(t + 2) * kstep; const char* b2 = last ? nB : cB + (size_t)(t + 2) * kstep;
            const char* a3 = a2 + kstep; const char* b3 = b2 + kstep;
            if (last && has_next) S.a_ready(nxt);
            if constexpr (SP2) {
            PG8_LDB(B0, 0, 0); PG8_LDB(B1, 0, 1); PG8_SCHED; PG8_LDA(At, 0, 0); PG8_STAGE(PG8_SA(1, 1), a1 + hstepA, voffA);
            PG8_WAIT_V(8); PG8_WAIT_L(0); PG8_BAR; PG8_MMA(0, 0, At, B0); PG8_MMA(0, 1, At, B1); PG8_BAR; PG8_SCHED;
            PG8_LDA(At, 0, 1); PG8_STAGE(PG8_SB(0, 0), b2, voffB); PG8_STAGE(PG8_SB(0, 1), b2 + hstepB, voffB); PG8_STAGE(PG8_SA(0, 0), a2, voffA);
            PG8_WAIT_V(8); PG8_WAIT_L(0); PG8_BAR; PG8_MMA(1, 0, At, B0); PG8_MMA(1, 1, At, B1); PG8_BAR; PG8_SCHED;
            PG8_LDB(B0, 1, 0); PG8_LDB(B1, 1, 1); PG8_SCHED; PG8_LDA(At, 1, 0); PG8_STAGE(PG8_SA(0, 1), a2 + hstepA, voffA);
            PG8_WAIT_V(8); PG8_WAIT_L(0); PG8_BAR; PG8_MMA(0, 0, At, B0); PG8_MMA(0, 1, At, B1); PG8_BAR; PG8_SCHED;
            PG8_LDA(At, 1, 1); PG8_STAGE(PG8_SB(1, 0), b3, voffB); PG8_STAGE(PG8_SB(1, 1), b3 + hstepB, voffB); PG8_STAGE(PG8_SA(1, 0), a3, voffA);
            PG8_WAIT_V(8); PG8_WAIT_L(0); PG8_BAR; PG8_MMA(1, 0, At, B0); PG8_MMA(1, 1, At, B1); PG8_BAR; PG8_SCHED;
            } else {
            PG8_LDB(B0, 0, 0); PG8_SCHED; PG8_LDA(At, 0, 0); PG8_STAGE(PG8_SA(1, 1), a1 + hstepA, voffA);
            PG8_WAIT_L(8); PG8_BAR; PG8_WAIT_L(0); PG8_MMA(0, 0, At, B0); PG8_BAR; PG8_SCHED;
            PG8_LDB(B1, 0, 1); PG8_STAGE(PG8_SB(0, 0), b2, voffB);
            PG8_BAR; PG8_WAIT_L(0); PG8_MMA(0, 1, At, B1); PG8_BAR;
            PG8_LDA(At, 0, 1); PG8_STAGE(PG8_SA(0, 0), a2, voffA);
            PG8_BAR; PG8_WAIT_L(0); PG8_MMA(1, 0, At, B0); PG8_BAR; PG8_SCHED;
            PG8_STAGE(PG8_SB(0, 1), b2 + hstepB, voffB);
            PG8_WAIT_V(6); PG8_BAR; PG8_MMA(1, 1, At, B1); PG8_BAR;
            PG8_LDB(B0, 1, 0); PG8_SCHED; PG8_LDA(At, 1, 0); PG8_STAGE(PG8_SA(0, 1), a2 + hstepA, voffA);
            PG8_WAIT_L(8); PG8_BAR; PG8_WAIT_L(0); PG8_MMA(0, 0, At, B0); PG8_BAR; PG8_SCHED;
            PG8_LDB(B1, 1, 1); PG8_STAGE(PG8_SB(1, 0), b3, voffB);
            PG8_BAR; PG8_WAIT_L(0); PG8_MMA(0, 1, At, B1); PG8_BAR;
            PG8_LDA(At, 1, 1); PG8_STAGE(PG8_SA(1, 0), a3, voffA);
            PG8_BAR; PG8_WAIT_L(0); PG8_MMA(1, 0, At, B0); PG8_BAR; PG8_SCHED;
            PG8_STAGE(PG8_SB(1, 1), b3 + hstepB, voffB);
            PG8_WAIT_V(6); PG8_BAR; PG8_MMA(1, 1, At, B1); PG8_BAR;
            }
        }
        if constexpr (ALIGN_EPI) { if (wr == 0) PG8_BAR; }
        E(acc, cur, wr, wc, fr, fq); S.done(cur);
        if (!has_next) break;
#pragma unroll
        for (int a = 0; a < 2; ++a)
#pragma unroll
            for (int b = 0; b < 2; ++b)
#pragma unroll
                for (int m = 0; m < 4; ++m)
#pragma unroll
                    for (int n = 0; n < 2; ++n) acc[a][b][m][n] = (f32x4){0.f, 0.f, 0.f, 0.f};
        cur = nxt; cA = nA; cB = nB; ++ui;
        if constexpr (ALIGN_EPI) { if (wr == 1) PG8_BAR; }
    }
    PG8_WAIT_V(0);
    if constexpr (!ALIGN_EPI) { if (wr == 0) PG8_BAR; }
    PG8_BAR;
#undef PG8_SA
#undef PG8_SB
#undef PG8_STAGE
#undef PG8_LDA
#undef PG8_LDB
#undef PG8_MMA
#undef PG8_WAIT_V
#undef PG8_WAIT_L
#undef PG8_BAR
#undef PG8_SCHED
}
}

constexpr int DM = 1024;
constexpr int NTOK = 16400;
constexpr int PADL = 48;
constexpr int LPV = 16448;
constexpr int MP = 16640;
constexpr int MU = 16384;
constexpr int NCHUNK = 257;
constexpr int NHEAD = 8;
constexpr int NPROJ = 2560;
constexpr int KVROWS = 16512;
constexpr float EPS = 1e-6f;

constexpr size_t MiB = 1u << 20;
constexpr size_t WS_CTL = 0, CTL_ZERO_BYTES = 512 * 1024;
constexpr size_t WS_SSQ = 128 * 1024;
constexpr size_t WS_SSK = 256 * 1024;
constexpr size_t WS_SS4 = 384 * 1024;
constexpr size_t WS_WIN = 1 * MiB;
constexpr size_t WS_WUQ = 6 * MiB;
constexpr size_t WS_WUKV = 6 * MiB + 512 * 1024;
constexpr size_t WS_WOUT = 7 * MiB;
constexpr size_t WS_WPQ = 9 * MiB;
constexpr size_t WS_SKB = 13 * MiB;
constexpr size_t WS_IDX = 16 * MiB;
constexpr size_t WS_GATE = 24 * MiB;
constexpr size_t WS_HN = 16 * MiB;
constexpr size_t WS_QKVR = 101 * MiB;
constexpr size_t WS_Z = 150 * MiB;
constexpr size_t WS_P32 = 167 * MiB;
constexpr size_t WS_GA = 16 * MiB;
constexpr size_t WS_GQ = 33 * MiB;
constexpr size_t WS_GS = 67 * MiB;
constexpr size_t WS_GB = 84 * MiB;
constexpr size_t WS_GO = 50 * MiB;
constexpr size_t WS_MIX = 167 * MiB;
constexpr size_t WS_CQN = 200 * MiB;
constexpr size_t WS_CKVN = 208 * MiB + 512 * 1024;
constexpr size_t WS_QH = 101 * MiB;
constexpr size_t WS_KVB = 167 * MiB;
constexpr size_t WS_Q = 125 * MiB + 512 * 1024;
constexpr size_t WS_K = 220 * MiB;
constexpr size_t WS_VT = 200 * MiB;
constexpr size_t WS_XN = 32 * MiB;
constexpr size_t WS_PQ = 64 * MiB;
constexpr size_t WS_SC = 128 * MiB;
constexpr size_t WS_EU = 96 * MiB;
constexpr size_t WS_EV = 112 * MiB;
constexpr size_t WS_CW = 64 * MiB;
constexpr size_t WS_HP = 128 * MiB;
constexpr size_t WS_KPE = 217 * MiB;
constexpr size_t WS_END = 256 * MiB;
constexpr int CW_ATTQ = 8192;

constexpr int LDS_BYTES = 147456;
constexpr int MISC_OFF = 131072 + 12288;

DI unsigned f2bf(float f) { unsigned u = __builtin_bit_cast(unsigned, f); return (u + 0x7fffu + ((u >> 16) & 1u)) >> 16; }
DI unsigned pk2(float lo, float hi) { return f2bf(lo) | (f2bf(hi) << 16); }
DI float bf2f(unsigned b) { return __builtin_bit_cast(float, b << 16); }
DI float bflo(unsigned w) { return __builtin_bit_cast(float, w << 16); }
DI float bfhi(unsigned w) { return __builtin_bit_cast(float, w & 0xffff0000u); }
DI float wave_sum(float v) {
#pragma unroll
    for (int o = 1; o < 64; o <<= 1) v += __shfl_xor(v, o);
    return v;
}
DI float sigmoidf_(float x) { return 1.f / (1.f + __expf(-x)); }
DI float siluf_(float x) { return x / (1.f + __expf(-x)); }

#define XB_TMO      128
#define XB_XCNT(j)  (256  + 64 * (j))
#define XB_XSUB(j)  (1280 + 64 * (j))
#define XB_XGEN(j)  (2304 + 64 * (j))
#define XB_TOP      3328
#define XB_TOPGEN   3392
#define XCD_BAR_WORDS 3456
#define XB_SPIN_CAP (1u << 22)
DI unsigned xb_ld(unsigned* p)              { return __hip_atomic_load(p, __ATOMIC_RELAXED, __HIP_MEMORY_SCOPE_AGENT); }
DI unsigned xb_add(unsigned* p, unsigned v) { return __hip_atomic_fetch_add(p, v, __ATOMIC_RELAXED, __HIP_MEMORY_SCOPE_AGENT); }
DI unsigned xb_xcc_id() { return (unsigned)__builtin_amdgcn_s_getreg((3 << 11) | 20) & 0xFu; }
#define XB_SPIN(cond, bar) do { unsigned _sp = 0; while (cond) { __builtin_amdgcn_s_sleep(1); \
    if ((++_sp & 255u) == 0u) { if (xb_ld(&(bar)[XB_TMO])) break; if (_sp > XB_SPIN_CAP) { atomicAdd(&(bar)[XB_TMO], 1u); break; } } } } while (0)
struct XcdBarrier { unsigned* bar; unsigned x; volatile LAS unsigned* st; };
DI XcdBarrier xcd_barrier_post(unsigned* bar, volatile LAS unsigned* st) {
    XcdBarrier b; b.bar = bar; b.x = xb_xcc_id(); b.st = st;
    if (threadIdx.x == 0) (void)xb_add(&bar[XB_XCNT(b.x)], 1u);
    return b;
}
DI void xcd_barrier_complete(unsigned* bar, unsigned x, unsigned& nloc, unsigned& nx) {
    const unsigned G = gridDim.x * gridDim.y * gridDim.z;
    unsigned sum, cnt, mine, sp = 0u;
    for (;;) {
        sum = 0u; cnt = 0u; mine = 0u;
#pragma unroll
        for (unsigned j = 0; j < 16; ++j) { const unsigned c = xb_ld(&bar[XB_XCNT(j)]); sum += c; cnt += (c > 0u) ? 1u : 0u; mine = (j == x) ? c : mine; }
        if (sum == G) break;
        __builtin_amdgcn_s_sleep(1);
        if ((++sp & 255u) == 0u) { if (xb_ld(&bar[XB_TMO])) break; if (sp > XB_SPIN_CAP) { atomicAdd(&bar[XB_TMO], 1u); break; } }
    }
    nloc = mine > 0u ? mine : 1u; nx = cnt > 0u ? cnt : 1u;
}
DI void xcd_barrier(const XcdBarrier& b) {
    asm volatile("s_waitcnt vmcnt(0)" ::: "memory");
    __syncthreads();
    if (threadIdx.x == 0) {
        unsigned* bar = b.bar;
        __builtin_amdgcn_s_waitcnt(0);
        unsigned nloc = b.st[0], nx = b.st[1];
        if (nloc == 0u) { xcd_barrier_complete(bar, b.x, nloc, nx); b.st[0] = nloc; b.st[1] = nx; }
        const unsigned old = xb_add(&bar[XB_XSUB(b.x)], 1u);
        const unsigned gen = old / nloc;
        if (old + 1u == (gen + 1u) * nloc) {
            __builtin_amdgcn_fence(__ATOMIC_RELEASE, "agent");
            asm volatile("s_waitcnt vmcnt(0)" ::: "memory");
            const unsigned og = xb_add(&bar[XB_TOP], 1u);
            const unsigned tg = og / nx;
            if (og + 1u == (tg + 1u) * nx) xb_add(&bar[XB_TOPGEN], 1u);
            else XB_SPIN(xb_ld(&bar[XB_TOPGEN]) == tg, bar);
            __builtin_amdgcn_fence(__ATOMIC_ACQUIRE, "agent");
            xb_add(&bar[XB_XGEN(b.x)], 1u);
            asm volatile("s_waitcnt vmcnt(0)" ::: "memory");
        } else {
            XB_SPIN(xb_ld(&bar[XB_XGEN(b.x)]) == gen, bar);
            __builtin_amdgcn_fence(__ATOMIC_ACQUIRE, "agent");
            asm volatile("s_waitcnt vmcnt(0)" ::: "memory");
        }
    }
    __syncthreads();
}

struct Args {
    const float* in[20];
    float* out; unsigned char* ws;
    int ph_lo, ph_hi;
};
struct Frame {
    unsigned char* lds;
    int tid, lane, wave, G, gw, NGW;
};

template <class Map>
DI void transpose_item(const float* __restrict__ W, int Nsrc, bf16_t* __restrict__ WT, int ldk, float* scr, int item, int nblk, int lane, Map srcmap, const float* __restrict__ rowscale = nullptr) {
    const int kb = item / nblk, nb = item % nblk, k0 = 64 * kb, n0 = 32 * nb;
    const int ns = srcmap(n0 + (lane & 31));
    float vv[32];
#pragma unroll
    for (int i = 0; i < 32; ++i) { const int kk = 2 * i + (lane >> 5); vv[i] = (ns >= 0) ? W[(size_t)(k0 + kk) * Nsrc + ns] : 0.f; }
    if (rowscale) {
#pragma unroll
        for (int i = 0; i < 32; ++i) vv[i] *= rowscale[k0 + 2 * i + (lane >> 5)];
    }
#pragma unroll
    for (int i = 0; i < 32; ++i) { const int kk = 2 * i + (lane >> 5); scr[kk * 33 + (lane & 31)] = vv[i]; }
    __builtin_amdgcn_s_waitcnt(0); __builtin_amdgcn_wave_barrier();
    const int c = lane & 7;
#pragma unroll
    for (int j = 0; j < 4; ++j) { const int n = (lane >> 3) + 8 * j; const float* s = scr + (8 * c) * 33 + n;
        u32x4 o; o.x = pk2(s[0 * 33], s[1 * 33]); o.y = pk2(s[2 * 33], s[3 * 33]); o.z = pk2(s[4 * 33], s[5 * 33]); o.w = pk2(s[6 * 33], s[7 * 33]);
        *(u32x4*)(WT + (size_t)(n0 + n) * ldk + k0 + 8 * c) = o; }
    __builtin_amdgcn_s_waitcnt(0); __builtin_amdgcn_wave_barrier();
}
struct MapId { DI int operator()(int n) const { return n; } };
struct MapWin {
    DI int operator()(int n) const {
        if (n < 2048) return n;
        if (n < 2304) return n + 16;
        if (n < 2432) return n + 16;
        if (n < 2464) return n + 16;
        if (n < 2472) return n - 416;
        if (n < 2480) return n - 416;
        return -1;
    }
};

template <int PART> DI void p0_late_weights(const Frame& F, const Args& A, int wi, int nwv, int ti, int nth) {
    unsigned char* ws = A.ws;
    float* scr = (float*)(F.lds + F.wave * 16384);
    const float* w_uq = A.in[10]; const float* w_ukv = A.in[11]; const float* w_out = A.in[14]; const float* w_pq = A.in[16]; const float* sub_keys = A.in[17];
    constexpr int I_UQ = 4 * 24, I_UKV = 2 * 32, I_OUT = 16 * 32, I_PQ = 16 * 64;
    constexpr int NITEMS = I_UQ + I_UKV + I_OUT + I_PQ;
    const int lo_ = PART == 0 ? 0 : I_UQ + I_UKV, hi_ = PART == 0 ? I_UQ + I_UKV : NITEMS;
    for (int it = lo_ + wi; it < hi_; it += nwv) {
        int r = it;
        if (r < I_UQ) { transpose_item(w_uq, 768, (bf16_t*)(ws + WS_WUQ), 256, scr, r, 24, F.lane, MapId(), A.in[8]); continue; } r -= I_UQ;
        if (r < I_UKV) { transpose_item(w_ukv, 1024, (bf16_t*)(ws + WS_WUKV), 256, scr, r, 32, F.lane, MapId(), A.in[9]); continue; } r -= I_UKV;
        if (r < I_OUT) { transpose_item(w_out, 1024, (bf16_t*)(ws + WS_WOUT), 1024, scr, r, 32, F.lane, MapId()); continue; } r -= I_OUT;
        transpose_item(w_pq, 2048, (bf16_t*)(ws + WS_WPQ), 1024, scr, r, 64, F.lane, MapId(), A.in[15]);
    }
    const int gt = ti, NGT = nth;
    if (PART == 0) for (int i = gt; i < 1024 * 16; i += NGT) { const int n = i >> 4, c = i & 15; *(u32x4*)((bf16_t*)(ws + WS_WUKV) + (size_t)n * 256 + 128 + c * 8) = (u32x4){0u, 0u, 0u, 0u}; }
    if (PART == 1) for (int i = gt; i < 2048 * 32; i += NGT) {
        const int n = i >> 5, c8 = (i & 31) * 8; const int p = (n >> 7) & 1;
        u32x4 o = (u32x4){0u, 0u, 0u, 0u};
        if ((c8 >> 7) == p) { const float* s = sub_keys + (size_t)n * 128 + (c8 & 127); const f32x4 a = *(const f32x4*)s, b = *(const f32x4*)(s + 4);
            o.x = pk2(a.x, a.y); o.y = pk2(a.z, a.w); o.z = pk2(b.x, b.y); o.w = pk2(b.z, b.w); }
        *(u32x4*)((bf16_t*)(ws + WS_SKB) + (size_t)n * 256 + c8) = o;
    }
}

DI void p0_prologue(const Frame& F, const Args& A) {
    unsigned char* ws = A.ws;
    float* scr = (float*)(F.lds + F.wave * 16384);
    const float* w_in = A.in[3]; const float* w_uq = A.in[10]; const float* w_ukv = A.in[11]; const float* w_out = A.in[14]; const float* w_pq = A.in[16]; const float* sub_keys = A.in[17];
    constexpr int I_IN = 16 * 80;
    for (int it = F.wave * F.G + blockIdx.x; it < I_IN; it += F.NGW) transpose_item(w_in, 2480, (bf16_t*)(ws + WS_WIN), 1024, scr, it, 80, F.lane, MapWin());
    const float* x = A.in[0]; const float* meta = A.in[1]; const float* anorm = A.in[2];
    bf16_t* HN = (bf16_t*)(ws + WS_HN);
    for (int p0 = F.gw; p0 < MP; p0 += 3 * F.NGW) {
        f32x4 v[3][4]; bool ok[3];
#pragma unroll
        for (int r = 0; r < 3; ++r) {
            const int p = p0 + r * F.NGW, t = p - PADL; ok[r] = (p < MP) && t >= 0 && t < NTOK;
            if (ok[r]) { const float* src = (t < 16) ? meta + (size_t)t * DM : x + (size_t)(t - 16) * DM; const f32x4* xr = (const f32x4*)src + F.lane;
#pragma unroll
                for (int j = 0; j < 4; ++j) v[r][j] = xr[64 * j]; }
            else {
#pragma unroll
                for (int j = 0; j < 4; ++j) v[r][j] = (f32x4){0.f, 0.f, 0.f, 0.f}; }
        }
#pragma unroll
        for (int r = 0; r < 3; ++r) {
            const int p = p0 + r * F.NGW; if (p >= MP) continue;
            unsigned long long* o8 = (unsigned long long*)(HN + (size_t)p * DM) + F.lane;
            float s = 0.f;
#pragma unroll
            for (int j = 0; j < 4; ++j) s += (v[r][j].x * v[r][j].x + v[r][j].y * v[r][j].y) + (v[r][j].z * v[r][j].z + v[r][j].w * v[r][j].w);
            const float rstd = ok[r] ? 1.f / sqrtf(wave_sum(s) * (1.f / DM) + EPS) : 0.f;
#pragma unroll
            for (int j = 0; j < 4; ++j) { const f32x4 w = ((const f32x4*)anorm)[64 * j + F.lane];
                o8[64 * j] = (unsigned long long)pk2(v[r][j].x * rstd * w.x, v[r][j].y * rstd * w.y) | ((unsigned long long)pk2(v[r][j].z * rstd * w.z, v[r][j].w * rstd * w.w) << 32); }
        }
    }
}

DI void row_ss_atomic(const f32x4 (&v)[2][2][4][2], float* SS, int row0, int fq, bool bj0_only) {
#pragma unroll
    for (int ai = 0; ai < 2; ++ai)
#pragma unroll
        for (int m = 0; m < 4; ++m) {
            float s = 0.f;
#pragma unroll
            for (int bj = 0; bj < 2; ++bj) if (bj == 0 || !bj0_only)
#pragma unroll
                for (int n = 0; n < 2; ++n) { const f32x4 x = v[ai][bj][m][n]; s += (x[0] * x[0] + x[1] * x[1]) + (x[2] * x[2] + x[3] * x[3]); }
            s += __shfl_xor(s, 16); s += __shfl_xor(s, 32);
            if (fq == 0) atomicAdd(SS + row0 + ai * 128 + m * 16, s);
        }
}
struct EpiProj {
    static constexpr bool PERM = true;
    bf16_t* QKVR; bf16_t* Z; float* P32; bf16_t* CQ16; bf16_t* CKV16; float* KPE; float* SSQ; float* SSK;
    DI void operator()(const f32x4 (&acc)[2][2][4][2], const pg8::Unit& u, int wr, int wc, int fr, int fq) const {
        const int row0 = u.pm * 256 + wr * 64 + fr;
        if (u.pn < 8) {
            bf16_t* base; int ld, colt;
            if (u.pn < 6) { base = QKVR; ld = 1536; colt = u.pn * 256; } else { base = Z; ld = 512; colt = (u.pn - 6) * 256; }
            const int col0 = colt + wc * 32 + 8 * fq;
#pragma unroll
            for (int ai = 0; ai < 2; ++ai)
#pragma unroll
                for (int m = 0; m < 4; ++m) { bf16_t* rowp = base + (size_t)(row0 + ai * 128 + m * 16) * ld + col0;
#pragma unroll
                    for (int bj = 0; bj < 2; ++bj) { const f32x4 v0 = acc[ai][bj][m][0], v1 = acc[ai][bj][m][1];
                        u32x4 w; w.x = pg8::cvt_pk_bf16(v0[0], v0[1]); w.y = pg8::cvt_pk_bf16(v0[2], v0[3]); w.z = pg8::cvt_pk_bf16(v1[0], v1[1]); w.w = pg8::cvt_pk_bf16(v1[2], v1[3]);
                        *(u32x4*)(rowp + bj * 128) = w; } }
        } else {
            const int lcol0 = wc * 32 + 8 * fq;
            bf16_t* b16 = (u.pn == 8) ? CQ16 : CKV16;
#pragma unroll
            for (int ai = 0; ai < 2; ++ai)
#pragma unroll
                for (int m = 0; m < 4; ++m) { const size_t row = (size_t)(row0 + ai * 128 + m * 16);
                    float* rowp = P32 + row * 512 + (u.pn - 8) * 256 + lcol0;
#pragma unroll
                    for (int bj = 0; bj < 2; ++bj) { const f32x4 v0 = acc[ai][bj][m][0], v1 = acc[ai][bj][m][1];
                        *(f32x4*)(rowp + bj * 128) = v0; *(f32x4*)(rowp + bj * 128 + 4) = v1;
                        u32x4 w; w.x = pg8::cvt_pk_bf16(v0[0], v0[1]); w.y = pg8::cvt_pk_bf16(v0[2], v0[3]); w.z = pg8::cvt_pk_bf16(v1[0], v1[1]); w.w = pg8::cvt_pk_bf16(v1[2], v1[3]);
                        *(u32x4*)(b16 + row * 256 + lcol0 + bj * 128) = w;
                        if (u.pn == 9 && bj == 1 && wc == 0) { *(f32x4*)(KPE + row * 32 + 8 * fq) = v0; *(f32x4*)(KPE + row * 32 + 8 * fq + 4) = v1; }
                    } }
            row_ss_atomic(acc, (u.pn == 8) ? SSQ : SSK, row0, fq, u.pn == 9);
        }
    }
};
struct EpiB16 {
    static constexpr bool PERM = true;
    bf16_t* O; int ldc; const float* SS; float invn;
    DI void operator()(const f32x4 (&acc)[2][2][4][2], const pg8::Unit& u, int wr, int wc, int fr, int fq) const {
        const int row0 = u.pm * 256 + wr * 64 + fr, col0 = u.pn * 256 + wc * 32 + 8 * fq;
#pragma unroll
        for (int ai = 0; ai < 2; ++ai)
#pragma unroll
            for (int m = 0; m < 4; ++m) { const int row = row0 + ai * 128 + m * 16; bf16_t* rowp = O + (size_t)row * ldc + col0;
                const float rs = SS ? 1.f / sqrtf(SS[row] * invn + EPS) : 1.f;
#pragma unroll
                for (int bj = 0; bj < 2; ++bj) { const f32x4 v0 = acc[ai][bj][m][0] * rs, v1 = acc[ai][bj][m][1] * rs;
                    u32x4 w; w.x = pg8::cvt_pk_bf16(v0[0], v0[1]); w.y = pg8::cvt_pk_bf16(v0[2], v0[3]); w.z = pg8::cvt_pk_bf16(v1[0], v1[1]); w.w = pg8::cvt_pk_bf16(v1[2], v1[3]);
                    *(u32x4*)(rowp + bj * 128) = w; } }
    }
};
struct EpiH1 {
    static constexpr bool PERM = true;
    float* C; const float* res; bf16_t* H16; float* SS;
    DI void operator()(const f32x4 (&acc)[2][2][4][2], const pg8::Unit& u, int wr, int wc, int fr, int fq) const {
        const int row0 = u.pm * 256 + wr * 64 + fr, col0 = u.pn * 256 + wc * 32 + 8 * fq;
        f32x4 v[2][2][4][2];
#pragma unroll
        for (int ai = 0; ai < 2; ++ai)
#pragma unroll
            for (int m = 0; m < 4; ++m) { const size_t off = (size_t)(row0 + ai * 128 + m * 16) * 1024 + col0;
#pragma unroll
                for (int bj = 0; bj < 2; ++bj) { const f32x4 v0 = acc[ai][bj][m][0] + *(const f32x4*)(res + off + bj * 128), v1 = acc[ai][bj][m][1] + *(const f32x4*)(res + off + bj * 128 + 4);
                    v[ai][bj][m][0] = v0; v[ai][bj][m][1] = v1;
                    *(f32x4*)(C + off + bj * 128) = v0; *(f32x4*)(C + off + bj * 128 + 4) = v1;
                    u32x4 w; w.x = pg8::cvt_pk_bf16(v0[0], v0[1]); w.y = pg8::cvt_pk_bf16(v0[2], v0[3]); w.z = pg8::cvt_pk_bf16(v1[0], v1[1]); w.w = pg8::cvt_pk_bf16(v1[2], v1[3]);
                    *(u32x4*)(H16 + off + bj * 128) = w; } }
        row_ss_atomic(v, SS, row0, fq, false);
    }
};
struct EpiF32 {
    static constexpr bool PERM = true;
    float* C; int ldc; const float* res;
    DI void operator()(const f32x4 (&acc)[2][2][4][2], const pg8::Unit& u, int wr, int wc, int fr, int fq) const {
        const int row0 = u.pm * 256 + wr * 64 + fr, col0 = u.pn * 256 + wc * 32 + 8 * fq;
#pragma unroll
        for (int ai = 0; ai < 2; ++ai)
#pragma unroll
            for (int m = 0; m < 4; ++m) { const size_t off = (size_t)(row0 + ai * 128 + m * 16) * ldc + col0;
#pragma unroll
                for (int bj = 0; bj < 2; ++bj) { f32x4 v0 = acc[ai][bj][m][0], v1 = acc[ai][bj][m][1];
                    if (res) { v0 += *(const f32x4*)(res + off + bj * 128); v1 += *(const f32x4*)(res + off + bj * 128 + 4); }
                    *(f32x4*)(C + off + bj * 128) = v0; *(f32x4*)(C + off + bj * 128 + 4) = v1; } }
    }
};

DI f32x16 mfma32(bf16x8 a, bf16x8 b, f32x16 c) { return __builtin_amdgcn_mfma_f32_32x32x16_bf16(a, b, c, 0, 0, 0); }
DI f32x4 mfma16(bf16x8 a, bf16x8 b, f32x4 c) { return __builtin_amdgcn_mfma_f32_16x16x32_bf16(a, b, c, 0, 0, 0); }
DI int crow(int r, int hi) { return (r & 3) + 8 * (r >> 2) + 4 * hi; }
DI f32x16 zero16() { f32x16 z;
#pragma unroll
    for (int i = 0; i < 16; ++i) z[i] = 0.f; return z; }

constexpr int G_KF = 0, G_VF = 16384, G_MF = 32768;
constexpr int G_QB = 50176, G_KB = 59392, G_KBB = 68608;
constexpr int G_QKB = 77824, G_UT = 87040, G_WT = 96256, G_KDT = 105472;
constexpr int G_VEC = 114688;
constexpr int G_RAW = G_QKB;
constexpr int GST = 72;

DI f32x16 mm_quad(const unsigned char* A, const unsigned char* Bt, int qr, int qc, int lane) {
    const int r32 = lane & 31, hh = lane >> 5;
    const unsigned char* ap = A + (32 * qr + r32) * (GST * 2) + hh * 16;
    const unsigned char* bp = Bt + (32 * qc + r32) * (GST * 2) + hh * 16;
    f32x16 acc = zero16();
#pragma unroll
    for (int s = 0; s < 4; ++s) acc = mfma32(*(const bf16x8*)(ap + s * 32), *(const bf16x8*)(bp + s * 32), acc);
    return acc;
}

constexpr int G_RAW2 = 115712;
static_assert(G_RAW2 + 67 * 400 <= 143360, "GDN prep LDS map");
constexpr int G_CONVW = 143360 + 512;

#ifndef PROBE_STAGE
#define PROBE_STAGE -1
#endif
template <int VAR> DI void gdn_prep_phase(const Frame& F, const Args& A) {
    unsigned long long stg_t = 0ull, stg_acc = 0ull;
#define STG(n) do { if (PROBE_STAGE >= 0) { const unsigned long long now_ = __builtin_amdgcn_s_memrealtime(); if (PROBE_STAGE == (n)) stg_acc += now_ - stg_t; stg_t = now_; } } while (0)
    unsigned char* ws = A.ws; unsigned char* lds = F.lds;
    const int tid = F.tid, lane = F.lane, wave = F.wave;
    const bf16_t* QKVR = (const bf16_t*)(ws + WS_QKVR); const float* P32 = (const float*)(ws + WS_P32);
    float* KF = (float*)(lds + G_KF); float* VF = (float*)(lds + G_VF); float* MF = (float*)(lds + G_MF);
    float* VEC = (float*)(lds + G_VEC);
    if (VAR == 6) return;
    const int NIT = NCHUNK * 8;
#define LBAR() do { asm volatile("s_waitcnt lgkmcnt(0)" ::: "memory"); __builtin_amdgcn_s_barrier(); asm volatile("" ::: "memory"); } while (0)
#define LAUNDER(dst, src) int dst = (src); asm volatile("" : "+v"(dst))
    int item = blockIdx.x;
    if (item >= NIT) return;
    u32x4 pr[4]; float nb = 0.f, na = 0.f;
    auto raw_fetch = [&](int it) {
        const int c = it >> 3, h = it & 7; LAUNDER(tl, tid);
#pragma unroll
        for (int i = 0; i < 4; ++i) { const int q = tl + 512 * i; pr[i] = (u32x4){0u, 0u, 0u, 0u};
            if (q < 67 * 24) { const int r = q / 24, cc = q % 24, seg = cc >> 3, c8 = cc & 7; const int p = 64 * c - 3 + r;
                if (p >= 0) pr[i] = *(const u32x4*)(QKVR + (size_t)p * 1536 + seg * 512 + h * 64 + c8 * 8); } }
        if (wave == 0) { const int p = 64 * c + lane; nb = P32[(size_t)p * 512 + 416 + h]; na = P32[(size_t)p * 512 + 424 + h]; }
    };
    auto raw_park = [&]() {
        LAUNDER(tl, tid);
#pragma unroll
        for (int i = 0; i < 4; ++i) { const int q = tl + 512 * i;
            if (q < 67 * 24) { const int r = q / 24, cc = q % 24, seg = cc >> 3, c8 = cc & 7; *(u32x4*)(lds + G_RAW2 + r * 400 + (seg * 64 + c8 * 8) * 2) = pr[i]; } }
    };
    raw_fetch(item); raw_park();
    float cb = nb, ca = na;
    float* CWL = (float*)(lds + G_CONVW);
    int cw_h = -1;
#pragma unroll 1
    for (; item < NIT; item += F.G) {
        if (PROBE_STAGE >= 0 && stg_t == 0ull) stg_t = __builtin_amdgcn_s_memrealtime();
        const int c = item >> 3, h = item & 7;
        if (h != cw_h) { cw_h = h;
            if (tid < 192) { LAUNDER(t0, tid); const int sg = t0 >> 6, jt = (t0 >> 4) & 3, c4 = t0 & 15; *(f32x4*)(CWL + (sg * 4 + jt) * 64 + 4 * c4) = *(const f32x4*)(A.in[4] + jt * 1536 + sg * 512 + h * 64 + 4 * c4); } }
        const int nxt = item + F.G;
        if (VAR != 5 && nxt < NIT) raw_fetch(nxt);
        if (wave == 0) {
            const int p = 64 * c + lane;
            const float alog = A.in[5][h], dtb = A.in[6][h];
            float beta = sigmoidf_(cb);
            const float xx = ca + dtb; const float sp = xx > 20.f ? xx : log1pf(__expf(xx));
            float g = -__expf(alog) * sp;
            if (p < PADL) { beta = 0.f; g = 0.f; }
            float gc = g;
#pragma unroll
            for (int o = 1; o < 64; o <<= 1) { const float t = __shfl_up(gc, o); if (lane >= o) gc += t; }
            const float glast = __shfl(gc, 63);
            VEC[lane] = gc; VEC[64 + lane] = beta; VEC[128 + lane] = __expf(gc); VEC[192 + lane] = __expf(glast - gc);
        }
        LBAR(); STG(0);
        LAUNDER(t1, tid); const int sub = t1 & 15, grp = t1 >> 4;
#pragma unroll
        for (int sg = 0; sg < ((VAR == 2 || VAR >= 4) ? 0 : 3); ++sg) {
#pragma unroll 1
            for (int ps = 0; ps < 2; ++ps) {
                const int i = grp + 32 * ps;
                float acc[4] = {0.f, 0.f, 0.f, 0.f};
#pragma unroll
                for (int jt = 0; jt < 4; ++jt) {
                    const f32x4 w = *(const f32x4*)(CWL + (sg * 4 + jt) * 64 + 4 * sub);
                    const u32x2 rv = *(const u32x2*)(lds + G_RAW2 + (i + jt) * 400 + (sg * 64 + 4 * sub) * 2);
                    acc[0] += w.x * bflo(rv.x); acc[1] += w.y * bfhi(rv.x); acc[2] += w.z * bflo(rv.y); acc[3] += w.w * bfhi(rv.y);
                }
                float y[4];
#pragma unroll
                for (int k = 0; k < 4; ++k) y[k] = siluf_(acc[k]);
                if (sg < 2) {
                    float ss = (y[0] * y[0] + y[1] * y[1]) + (y[2] * y[2] + y[3] * y[3]);
                    ss += __shfl_xor(ss, 1); ss += __shfl_xor(ss, 2); ss += __shfl_xor(ss, 4); ss += __shfl_xor(ss, 8);
                    const float rn = 1.f / sqrtf(ss + EPS);
#pragma unroll
                    for (int k = 0; k < 4; ++k) y[k] *= rn;
                }
                if (sg == 0) {
                    u32x2 o; o.x = pk2(y[0] * 0.125f, y[1] * 0.125f); o.y = pk2(y[2] * 0.125f, y[3] * 0.125f);
                    *(u32x2*)(lds + G_QB + i * (GST * 2) + 8 * sub) = o;
                } else if (sg == 1) {
                    const float beta = VEC[64 + i], ekd = VEC[192 + i];
                    *(f32x4*)(KF + i * 64 + 4 * sub) = (f32x4){y[0], y[1], y[2], y[3]};
                    u32x2 o; o.x = pk2(y[0], y[1]); o.y = pk2(y[2], y[3]);
                    *(u32x2*)(lds + G_KB + i * (GST * 2) + 8 * sub) = o;
                    o.x = pk2(y[0] * beta, y[1] * beta); o.y = pk2(y[2] * beta, y[3] * beta);
                    *(u32x2*)(lds + G_KBB + i * (GST * 2) + 8 * sub) = o;
#pragma unroll
                    for (int k = 0; k < 4; ++k) *(bf16_t*)(lds + G_KDT + (4 * sub + k) * (GST * 2) + i * 2) = (bf16_t)f2bf(y[k] * ekd);
                } else {
                    *(f32x4*)(VF + i * 64 + 4 * sub) = (f32x4){y[0], y[1], y[2], y[3]};
                }
            }
        }
        LBAR(); STG(1);
        if (VAR != 3 && VAR < 4) {
            LAUNDER(l3, lane);
            const int prod = wave >> 2, quad = wave & 3, qr = quad >> 1, qc = quad & 1, r32 = l3 & 31, hh = l3 >> 5;
            const f32x16 acc = mm_quad(lds + (prod ? G_QB : G_KBB), lds + G_KB, qr, qc, l3);
            const int j = 32 * qc + r32; const float gcj = VEC[j];
#pragma unroll
            for (int r = 0; r < 16; ++r) {
                const int i = 32 * qr + crow(r, hh);
                if (prod == 0) { MF[i * 68 + j] = (j < i) ? acc[r] * __expf(VEC[i] - gcj) : 0.f; }
                else { *(bf16_t*)(lds + G_QKB + i * (GST * 2) + j * 2) = (bf16_t)f2bf((j <= i) ? acc[r] * __expf(VEC[i] - gcj) : 0.f); }
            }
        }
        LBAR(); STG(2);
        float* DB = (float*)(lds + G_KBB);
        if (VAR != 1 && VAR < 4 && wave == 0) {
            LAUNDER(l4, lane); const int b = l4 >> 4, jc = l4 & 15;
            float d[16];
#pragma unroll
            for (int i = 0; i < 16; ++i) {
                float acc = (i == jc) ? 1.f : 0.f;
                const float* mrow = MF + (16 * b + i) * 68 + 16 * b;
#pragma unroll
                for (int k = 0; k < i; ++k) acc -= mrow[k] * d[k];
                d[i] = acc;
            }
#pragma unroll
            for (int i = 0; i < 16; ++i) DB[(b * 16 + i) * 20 + jc] = d[i];
        }
        LBAR();
        if (VAR != 1 && VAR < 4) {
            LAUNDER(l4, lane); const int cc = l4 & 15, g = l4 >> 4;
            const bool isU = wave < 4; const int col = 16 * (wave & 3) + cc;
            const float* src = (isU ? VF : KF) + col;
            f32x4 X[4];
#pragma unroll
            for (int b = 0; b < 4; ++b) {
                f32x4 acc;
#pragma unroll
                for (int r = 0; r < 4; ++r) { const int i = 16 * b + 4 * g + r; float rv = src[i * 64] * VEC[64 + i]; if (!isU) rv *= VEC[128 + i]; acc[r] = -rv; }
#pragma unroll
                for (int a = 0; a < b; ++a) {
                    const f32x4 lv = *(const f32x4*)(MF + (16 * b + cc) * 68 + 16 * a + 4 * g);
#pragma unroll
                    for (int sp = 0; sp < 4; ++sp) acc = __builtin_amdgcn_mfma_f32_16x16x4f32(lv[sp], X[a][sp], acc, 0, 0, 0);
                }
                const f32x4 dv = *(const f32x4*)(DB + (b * 16 + cc) * 20 + 4 * g);
                f32x4 xb = (f32x4){0.f, 0.f, 0.f, 0.f};
#pragma unroll
                for (int sp = 0; sp < 4; ++sp) xb = __builtin_amdgcn_mfma_f32_16x16x4f32(dv[sp], acc[sp], xb, 0, 0, 0);
                X[b] = -xb;
                unsigned char* dst = lds + (isU ? G_UT : G_WT) + col * (GST * 2) + (16 * b + 4 * g) * 2;
                *(u32x2*)dst = (u32x2){pk2(X[b][0], X[b][1]), pk2(X[b][2], X[b][3])};
            }
        }
        LBAR(); STG(3);
        if (VAR != 3 && VAR < 4) {
            const float gl = VEC[128 + 63];
            bf16_t* GB = (bf16_t*)(ws + WS_GB) + (size_t)item * 4096;
            bf16_t* GQ = (bf16_t*)(ws + (VAR ? WS_GS : WS_GQ)) + (size_t)item * 4096; bf16_t* GO = (bf16_t*)(ws + (VAR ? WS_GS : WS_GO)) + (size_t)item * 4096;
            bf16_t* GAL = (bf16_t*)(lds + G_MF);
            LAUNDER(l5, lane); const int r32 = l5 & 31, hh = l5 >> 5;
#pragma unroll 1
            for (int it = 0; it < 2; ++it) {
                const int task = wave + 8 * it, prod = task >> 2, quad = task & 3, qr = quad >> 1, qc = quad & 1;
                const f32x16 acc = mm_quad(lds + (prod < 2 ? G_KDT : G_QKB), lds + ((prod & 1) ? G_UT : G_WT), qr, qc, l5);
                const int Cc = 32 * qc + r32;
                if (prod == 0) {
#pragma unroll
                    for (int r = 0; r < 16; ++r) {
                        const int R = 32 * qr + crow(r, hh);
                        const float val = ((R == Cc) ? gl : 0.f) - acc[r];
                        const int rb = R >> 4, m = R & 15, q4 = Cc >> 4, g = (Cc >> 2) & 3, rr = Cc & 3, ks = q4 >> 1, jj = 4 * (q4 & 1) + rr, ls = 16 * g + m;
                        GAL[((rb * 2 + ks) * 64 + ls) * 8 + jj] = (bf16_t)f2bf(val);
                    }
                } else if (prod == 1) {
                    const int eslab = Cc >> 4, n = Cc & 15;
#pragma unroll
                    for (int a = 0; a < 4; ++a) {
                        const int R0 = 32 * qr + 8 * a + 4 * hh; const int rb = R0 >> 4, g = (R0 >> 2) & 3, ls = 16 * g + n;
                        *(u32x2*)(GB + ((eslab * 4 + rb) * 64 + ls) * 4) = (u32x2){pk2(acc[4 * a], acc[4 * a + 1]), pk2(acc[4 * a + 2], acc[4 * a + 3])};
                    }
                } else if (prod == 2) {
#pragma unroll
                    for (int r = 0; r < 16; ++r) {
                        const int R = 32 * qr + crow(r, hh);
                        const float qv = bf2f(*(const bf16_t*)(lds + G_QB + R * (GST * 2) + Cc * 2));
                        GQ[R * 64 + Cc] = (bf16_t)f2bf(qv * VEC[128 + R] - acc[r]);
                    }
                } else {
#pragma unroll
                    for (int r = 0; r < 16; ++r) GO[(quad * 16 + r) * 64 + l5] = (bf16_t)f2bf(acc[r]);
                }
            }
        }
        if (VAR != 5 && nxt < NIT) { raw_park(); cb = nb; ca = na; }
        LBAR(); STG(4);
        if (VAR != 5) { LAUNDER(t6, tid); *(u32x4*)((bf16_t*)(ws + (VAR ? WS_GS : WS_GA)) + (size_t)item * 4096 + t6 * 8) = *(const u32x4*)(lds + G_MF + t6 * 16); }
        STG(5);
    }
    if (PROBE_STAGE >= 0 && tid == 0) { *(unsigned long long*)(lds + 143360 + 96) = stg_acc; }
}

constexpr int SC_D = 8, SC_PD = 6, SC_SLOT = 10240;
DI void gdn_scan(const Frame& F, const Args& A) {
    if (blockIdx.x >= 32) return;
    unsigned char* ws = A.ws;
    const int h = blockIdx.x & 7, eslab = blockIdx.x >> 3, lane = F.lane, wave = F.wave, n = lane & 15, g = lane >> 4;
    const unsigned char* GA = ws + WS_GA; const unsigned char* GB = ws + WS_GB; bf16_t* GS = (bf16_t*)(ws + WS_GS);
    LAS unsigned char* ring = (LAS unsigned char*)F.lds;
    const int np = (wave == 0) ? 0 : ((wave - 1 < 3) ? 2 : 1);
    auto issue = [&](int c) {
        const int cc = c < NCHUNK ? c : NCHUNK - 1;
        const size_t item = (size_t)cc * 8 + h;
        LAS unsigned char* slot = ring + (c % SC_D) * SC_SLOT;
#pragma unroll
        for (int i = 0; i < 2; ++i) if (i < np) {
            const int q = (wave - 1) + 7 * i;
            const unsigned char* src = (q < 8) ? GA + item * 8192 + q * 1024 : GB + item * 8192 + eslab * 2048 + (q - 8) * 1024;
            LAS unsigned char* dst = slot + ((q < 8) ? q * 1024 : 8192 + (q - 8) * 1024);
            __builtin_amdgcn_global_load_lds((const unsigned*)(src + lane * 16), (LAS unsigned*)dst, 16, 0, 0);
        }
    };
    for (int c = 0; c < SC_PD; ++c) issue(c);
    f32x4 S[4];
#pragma unroll
    for (int rb = 0; rb < 4; ++rb) S[rb] = (f32x4){0.f, 0.f, 0.f, 0.f};
#pragma unroll 1
    for (int c = 0; c < NCHUNK; ++c) {
        issue(c + SC_PD);
        if (np == 2) asm volatile("s_waitcnt vmcnt(12)" ::: "memory");
        else if (np == 1) asm volatile("s_waitcnt vmcnt(6)" ::: "memory");
        asm volatile("s_waitcnt lgkmcnt(0)" ::: "memory");
        __builtin_amdgcn_s_barrier();
        asm volatile("" ::: "memory");
        if (wave == 0) {
            const LAS unsigned char* slot = ring + (c % SC_D) * SC_SLOT;
            bf16x8 ac[8]; f32x4 bc[4];
#pragma unroll
            for (int q = 0; q < 8; ++q) ac[q] = *(const LAS bf16x8*)(slot + q * 1024 + lane * 16);
#pragma unroll
            for (int rb = 0; rb < 4; ++rb) { const u32x2 w = *(const LAS u32x2*)(slot + 8192 + rb * 512 + lane * 8); bc[rb] = (f32x4){bflo(w.x), bfhi(w.x), bflo(w.y), bfhi(w.y)}; }
            const size_t item = (size_t)c * 8 + h;
            u32x4 p0, p1;
            p0.x = pk2(S[0][0], S[0][1]); p0.y = pk2(S[0][2], S[0][3]); p0.z = pk2(S[1][0], S[1][1]); p0.w = pk2(S[1][2], S[1][3]);
            p1.x = pk2(S[2][0], S[2][1]); p1.y = pk2(S[2][2], S[2][3]); p1.z = pk2(S[3][0], S[3][1]); p1.w = pk2(S[3][2], S[3][3]);
            {
                bf16_t* st = GS + item * 4096 + (16 * eslab + n) * 64 + 4 * g;
                *(u32x2*)(st + 0) = (u32x2){p0.x, p0.y}; *(u32x2*)(st + 16) = (u32x2){p0.z, p0.w};
                *(u32x2*)(st + 32) = (u32x2){p1.x, p1.y}; *(u32x2*)(st + 48) = (u32x2){p1.z, p1.w};
            }
            const bf16x8 b0 = __builtin_bit_cast(bf16x8, p0), b1 = __builtin_bit_cast(bf16x8, p1);
#pragma unroll
            for (int rb = 0; rb < 4; ++rb) {
                f32x4 acc = bc[rb];
                acc = mfma16(ac[rb * 2 + 0], b0, acc);
                acc = mfma16(ac[rb * 2 + 1], b1, acc);
                S[rb] = acc;
            }
        }
    }
    asm volatile("s_waitcnt vmcnt(0) lgkmcnt(0)" ::: "memory");
    __builtin_amdgcn_s_barrier();
}

DI void gdn_out_task(const Frame& F, const Args& A, int task) {
    unsigned char* ws = A.ws;
    const int ihalf = task & 1, item = (task >> 1) + 8, c = item >> 3, h = item & 7, lane = F.lane, r32 = lane & 31, hh = lane >> 5;
    const bf16_t* GQ = (const bf16_t*)(ws + WS_GQ) + (size_t)item * 4096; const bf16_t* GS = (const bf16_t*)(ws + WS_GS) + (size_t)item * 4096;
    const bf16_t* GO = (const bf16_t*)(ws + WS_GO) + (size_t)item * 4096;
    const bf16_t* Z = (const bf16_t*)(ws + WS_Z); bf16_t* MIX = (bf16_t*)(ws + WS_MIX);
    f32x16 acc[2];
#pragma unroll
    for (int eh = 0; eh < 2; ++eh)
#pragma unroll
        for (int r = 0; r < 16; ++r) acc[eh][r] = bf2f(GO[((ihalf * 2 + eh) * 16 + r) * 64 + lane]);
#pragma unroll
    for (int s = 0; s < 4; ++s) {
        const bf16x8 a = *(const bf16x8*)(GQ + (32 * ihalf + r32) * 64 + 16 * s + 8 * hh);
#pragma unroll
        for (int eh = 0; eh < 2; ++eh) {
            const bf16x8 b = *(const bf16x8*)(GS + (32 * eh + r32) * 64 + 16 * s + 8 * hh);
            acc[eh] = mfma32(a, b, acc[eh]);
        }
    }
    const float* gnorm = A.in[7];
    const float w0 = gnorm[r32], w1 = gnorm[32 + r32];
#pragma unroll
    for (int r = 0; r < 16; ++r) {
        float ss = acc[0][r] * acc[0][r] + acc[1][r] * acc[1][r];
        ss += __shfl_xor(ss, 1); ss += __shfl_xor(ss, 2); ss += __shfl_xor(ss, 4); ss += __shfl_xor(ss, 8); ss += __shfl_xor(ss, 16);
        const float rstd = 1.f / sqrtf(ss * (1.f / 64.f) + EPS);
        const int i = 32 * ihalf + crow(r, hh); const int p = 64 * c + i;
        const float z0 = bf2f(Z[(size_t)p * 512 + h * 64 + r32]), z1 = bf2f(Z[(size_t)p * 512 + h * 64 + 32 + r32]);
        bf16_t* o = MIX + (size_t)(p - 64) * 1024 + h * 64;
        o[r32] = (bf16_t)f2bf(acc[0][r] * rstd * w0 * siluf_(z0));
        o[32 + r32] = (bf16_t)f2bf(acc[1][r] * rstd * w1 * siluf_(z1));
    }
}

DI void mla_prep1_rows(const Frame& F, const Args& A, int p0, int stride) {
    unsigned char* ws = A.ws; const int lane = F.lane;
    f32x4 q[4]; float k0[4], k1[4], pe[4];
#pragma unroll
    for (int r = 0; r < 4; ++r) { const int p = p0 + r * stride; const int pc = p < MP ? p : MP - 1;
        const float* P32 = (const float*)(ws + WS_P32) + (size_t)pc * 512;
        q[r] = *(const f32x4*)(P32 + 4 * lane); k0[r] = P32[256 + 2 * lane]; k1[r] = P32[256 + 2 * lane + 1]; pe[r] = P32[384 + (lane & 31)]; }
    const f32x4 wq = *(const f32x4*)(A.in[8] + 4 * lane);
    const float wk0 = A.in[9][2 * lane], wk1 = A.in[9][2 * lane + 1];
#pragma unroll
    for (int r = 0; r < 4; ++r) {
        const int p = p0 + r * stride; if (p >= MP) continue;
        bf16_t* CQN = (bf16_t*)(ws + WS_CQN) + (size_t)p * 256; bf16_t* CKVN = (bf16_t*)(ws + WS_CKVN) + (size_t)p * 256;
        const float sq = wave_sum((q[r].x * q[r].x + q[r].y * q[r].y) + (q[r].z * q[r].z + q[r].w * q[r].w));
        const float rq = 1.f / sqrtf(sq * (1.f / 256.f) + EPS);
        *(u32x2*)(CQN + 4 * lane) = (u32x2){pk2(q[r].x * rq * wq.x, q[r].y * rq * wq.y), pk2(q[r].z * rq * wq.z, q[r].w * rq * wq.w)};
        const float sk = wave_sum(k0[r] * k0[r] + k1[r] * k1[r]);
        const float rk = 1.f / sqrtf(sk * (1.f / 128.f) + EPS);
        *(unsigned*)(CKVN + 2 * lane) = pk2(k0[r] * rk * wk0, k1[r] * rk * wk1);
        *(unsigned*)(CKVN + 128 + 2 * lane) = 0u;
        if (lane < 32) ((float*)(ws + WS_KPE))[(size_t)p * 32 + lane] = pe[r];
    }
}

constexpr float QSCALE = 0.10206207261596577f * 1.4426950408889634f;
DI double rope_inv_rev(int i) {
    const double t8[8] = {0.15915494309189535, 0.08949940160889101, 0.050329212104487035, 0.0283021958306234, 0.015915494309189534, 0.008949940160889102, 0.005032921210448704, 0.00283021958306234};
    double v = t8[0];
#pragma unroll
    for (int k = 1; k < 8; ++k) v = ((i & 7) == k) ? t8[k] : v;
    return (i & 8) ? v * 0.01 : v;
}
constexpr int P2_TS = 136;
constexpr int P2_RS = 272;
#define P2_WSYNC() do { __builtin_amdgcn_s_waitcnt(0); __builtin_amdgcn_wave_barrier(); } while (0)
DI void mla_prep2_task(const Frame& F, const Args& A, int task) {
    unsigned char* ws = A.ws; int lane = F.lane; asm volatile("" : "+v"(lane));
    const int h = task & 7, blk = task >> 3;
    const int p = 64 * blk + lane;
    const bool valid = (p >= PADL) && (p < LPV);
    const float* qn = A.in[12]; const float* kn = A.in[13];
    unsigned char* TS = F.lds + F.wave * (64 * P2_RS);
    unsigned char* trow = TS + lane * P2_RS;
    const double pos = (double)(p - PADL);
    auto rot = [&](int i, float& sn_, float& cs_) { const double rev = pos * rope_inv_rev(i); const float fr = (float)(rev - floor(rev)); sn_ = __builtin_amdgcn_sinf(fr); cs_ = __builtin_amdgcn_cosf(fr); };
    {
        {
            const bf16_t* srcb = (const bf16_t*)(ws + WS_QH) + (size_t)(64 * blk) * 768 + h * 96;
            u32x4 t[12];
#pragma unroll
            for (int i = 0; i < 12; ++i) { const int c = 64 * i + lane, r = c / 12, pc = c % 12; t[i] = *(const u32x4*)(srcb + (size_t)r * 768 + 8 * pc); }
#pragma unroll
            for (int i = 0; i < 12; ++i) { const int c = 64 * i + lane, r = c / 12, pc = c % 12; *(u32x4*)(TS + r * P2_RS + 16 * pc) = t[i]; }
            P2_WSYNC();
        }
        u32x4 w[12];
#pragma unroll
        for (int c = 0; c < 12; ++c) w[c] = *(const u32x4*)(trow + 16 * c);
        float ss = 0.f;
#pragma unroll
        for (int c = 0; c < 12; ++c) { const float a0 = bflo(w[c].x), a1 = bfhi(w[c].x), a2 = bflo(w[c].y), a3 = bfhi(w[c].y), a4 = bflo(w[c].z), a5 = bfhi(w[c].z), a6 = bflo(w[c].w), a7 = bfhi(w[c].w);
            ss += (a0 * a0 + a1 * a1) + (a2 * a2 + a3 * a3) + (a4 * a4 + a5 * a5) + (a6 * a6 + a7 * a7); }
        const float rs = valid ? QSCALE / sqrtf(ss * (1.f / 96.f) + EPS) : 0.f;
        unsigned char* dst = trow;
#pragma unroll
        for (int c = 0; c < 8; ++c) {
            const f32x4 g0 = *(const f32x4*)(qn + 8 * c), g1 = *(const f32x4*)(qn + 8 * c + 4);
            *(u32x4*)(dst + 16 * c) = (u32x4){pk2(bflo(w[c].x) * rs * g0.x, bfhi(w[c].x) * rs * g0.y), pk2(bflo(w[c].y) * rs * g0.z, bfhi(w[c].y) * rs * g0.w),
                                              pk2(bflo(w[c].z) * rs * g1.x, bfhi(w[c].z) * rs * g1.y), pk2(bflo(w[c].w) * rs * g1.z, bfhi(w[c].w) * rs * g1.w)};
        }
#pragma unroll
        for (int c = 0; c < 2; ++c) {
            float x1[8], x2[8];
            const u32x4 wa = w[8 + c], wb = w[10 + c];
            x1[0] = bflo(wa.x); x1[1] = bfhi(wa.x); x1[2] = bflo(wa.y); x1[3] = bfhi(wa.y); x1[4] = bflo(wa.z); x1[5] = bfhi(wa.z); x1[6] = bflo(wa.w); x1[7] = bfhi(wa.w);
            x2[0] = bflo(wb.x); x2[1] = bfhi(wb.x); x2[2] = bflo(wb.y); x2[3] = bfhi(wb.y); x2[4] = bflo(wb.z); x2[5] = bfhi(wb.z); x2[6] = bflo(wb.w); x2[7] = bfhi(wb.w);
            float o1[8], o2[8];
#pragma unroll
            for (int t = 0; t < 8; ++t) { float sn_, cs_; rot(8 * c + t, sn_, cs_); const float a = x1[t] * rs * qn[64 + 8 * c + t], b = x2[t] * rs * qn[80 + 8 * c + t]; o1[t] = a * cs_ - b * sn_; o2[t] = b * cs_ + a * sn_; }
            *(u32x4*)(dst + 2 * (64 + 8 * c)) = (u32x4){pk2(o1[0], o1[1]), pk2(o1[2], o1[3]), pk2(o1[4], o1[5]), pk2(o1[6], o1[7])};
            *(u32x4*)(dst + 2 * (80 + 8 * c)) = (u32x4){pk2(o2[0], o2[1]), pk2(o2[2], o2[3]), pk2(o2[4], o2[5]), pk2(o2[6], o2[7])};
        }
        P2_WSYNC();
        {
            unsigned char* outb = (unsigned char*)((bf16_t*)(ws + WS_Q) + ((size_t)h * KVROWS + 64 * blk) * 96);
            u32x4 t[12];
#pragma unroll
            for (int i = 0; i < 12; ++i) { const int c = 64 * i + lane, r = c / 12, pc = c % 12; t[i] = *(const u32x4*)(TS + r * P2_RS + 16 * pc); }
#pragma unroll
            for (int i = 0; i < 12; ++i) *(u32x4*)(outb + (size_t)(64 * i + lane) * 16) = t[i];
            P2_WSYNC();
        }
    }
    {
        {
            const bf16_t* srcb = (const bf16_t*)(ws + WS_KVB) + (size_t)(64 * blk) * 1024 + h * 128;
            const unsigned char* kpb = (const unsigned char*)((const float*)(ws + WS_KPE) + (size_t)(64 * blk) * 32);
            u32x4 t[8], e8[8];
#pragma unroll
            for (int i = 0; i < 8; ++i) { const int c = 64 * i + lane, r = c >> 3, pc = c & 7; t[i] = *(const u32x4*)(srcb + (size_t)r * 1024 + 8 * pc); e8[i] = *(const u32x4*)(kpb + (size_t)c * 16); }
#pragma unroll
            for (int i = 0; i < 8; ++i) { const int c = 64 * i + lane, r = c >> 3, pc = c & 7; *(u32x4*)(TS + r * P2_RS + 16 * pc) = t[i]; *(u32x4*)(TS + r * P2_RS + 128 + 16 * pc) = e8[i]; }
            P2_WSYNC();
        }
        u32x4 w[8]; f32x4 e[8];
#pragma unroll
        for (int c = 0; c < 8; ++c) { w[c] = *(const u32x4*)(trow + 16 * c); e[c] = *(const f32x4*)(trow + 128 + 16 * c); }
        float ss = 0.f;
#pragma unroll
        for (int c = 0; c < 8; ++c) { const float a0 = bflo(w[c].x), a1 = bfhi(w[c].x), a2 = bflo(w[c].y), a3 = bfhi(w[c].y), a4 = bflo(w[c].z), a5 = bfhi(w[c].z), a6 = bflo(w[c].w), a7 = bfhi(w[c].w);
            ss += (a0 * a0 + a1 * a1) + (a2 * a2 + a3 * a3) + (a4 * a4 + a5 * a5) + (a6 * a6 + a7 * a7);
            ss += (e[c].x * e[c].x + e[c].y * e[c].y) + (e[c].z * e[c].z + e[c].w * e[c].w); }
        const float rs = valid ? 1.f / sqrtf(ss * (1.f / 96.f) + EPS) : 0.f;
        unsigned char* dst = trow;
#pragma unroll
        for (int c = 0; c < 8; ++c) {
            const f32x4 g0 = *(const f32x4*)(kn + 8 * c), g1 = *(const f32x4*)(kn + 8 * c + 4);
            *(u32x4*)(dst + 16 * c) = (u32x4){pk2(bflo(w[c].x) * rs * g0.x, bfhi(w[c].x) * rs * g0.y), pk2(bflo(w[c].y) * rs * g0.z, bfhi(w[c].y) * rs * g0.w),
                                              pk2(bflo(w[c].z) * rs * g1.x, bfhi(w[c].z) * rs * g1.y), pk2(bflo(w[c].w) * rs * g1.z, bfhi(w[c].w) * rs * g1.w)};
        }
#pragma unroll
        for (int c = 0; c < 2; ++c) {
            const float x1[8] = {e[2 * c].x, e[2 * c].y, e[2 * c].z, e[2 * c].w, e[2 * c + 1].x, e[2 * c + 1].y, e[2 * c + 1].z, e[2 * c + 1].w};
            const float x2[8] = {e[4 + 2 * c].x, e[4 + 2 * c].y, e[4 + 2 * c].z, e[4 + 2 * c].w, e[5 + 2 * c].x, e[5 + 2 * c].y, e[5 + 2 * c].z, e[5 + 2 * c].w};
            float o1[8], o2[8];
#pragma unroll
            for (int t = 0; t < 8; ++t) { float sn_, cs_; rot(8 * c + t, sn_, cs_); const float a = x1[t] * rs * kn[64 + 8 * c + t], b = x2[t] * rs * kn[80 + 8 * c + t]; o1[t] = a * cs_ - b * sn_; o2[t] = b * cs_ + a * sn_; }
            *(u32x4*)(dst + 2 * (64 + 8 * c)) = (u32x4){pk2(o1[0], o1[1]), pk2(o1[2], o1[3]), pk2(o1[4], o1[5]), pk2(o1[6], o1[7])};
            *(u32x4*)(dst + 2 * (80 + 8 * c)) = (u32x4){pk2(o2[0], o2[1]), pk2(o2[2], o2[3]), pk2(o2[4], o2[5]), pk2(o2[6], o2[7])};
        }
        P2_WSYNC();
        {
            unsigned char* outb = (unsigned char*)((bf16_t*)(ws + WS_K) + ((size_t)h * KVROWS + 64 * blk) * 96);
            u32x4 t[12];
#pragma unroll
            for (int i = 0; i < 12; ++i) { const int c = 64 * i + lane, r = c / 12, pc = c % 12; t[i] = *(const u32x4*)(TS + r * P2_RS + 16 * pc); }
#pragma unroll
            for (int i = 0; i < 12; ++i) *(u32x4*)(outb + (size_t)(64 * i + lane) * 16) = t[i];
            P2_WSYNC();
        }
    }
    {
        unsigned char* T = TS;
        const bf16_t* src = (const bf16_t*)(ws + WS_KVB) + h * 128 + 64;
#pragma unroll
        for (int it = 0; it < 8; ++it) {
            const int pr = 8 * it + (lane >> 3), ch = lane & 7; const int pp = 64 * blk + pr;
            u32x4 v = (u32x4){0u, 0u, 0u, 0u};
            if (pp >= PADL && pp < LPV) v = *(const u32x4*)(src + (size_t)pp * 1024 + 8 * ch);
            unsigned char* tp = T + (8 * ch) * P2_TS + pr * 2;
            *(bf16_t*)(tp + 0 * P2_TS) = (bf16_t)(v.x & 0xffffu); *(bf16_t*)(tp + 1 * P2_TS) = (bf16_t)(v.x >> 16);
            *(bf16_t*)(tp + 2 * P2_TS) = (bf16_t)(v.y & 0xffffu); *(bf16_t*)(tp + 3 * P2_TS) = (bf16_t)(v.y >> 16);
            *(bf16_t*)(tp + 4 * P2_TS) = (bf16_t)(v.z & 0xffffu); *(bf16_t*)(tp + 5 * P2_TS) = (bf16_t)(v.z >> 16);
            *(bf16_t*)(tp + 6 * P2_TS) = (bf16_t)(v.w & 0xffffu); *(bf16_t*)(tp + 7 * P2_TS) = (bf16_t)(v.w >> 16);
        }
        __builtin_amdgcn_s_waitcnt(0); __builtin_amdgcn_wave_barrier();
        bf16_t* VT = (bf16_t*)(ws + WS_VT) + (size_t)h * 64 * KVROWS + 64 * blk;
#pragma unroll
        for (int it = 0; it < 8; ++it) {
            const int e = 8 * it + (lane >> 3), ch = lane & 7;
            const u32x2 lo = *(const u32x2*)(T + e * P2_TS + 16 * ch), hi = *(const u32x2*)(T + e * P2_TS + 16 * ch + 8);
            *(u32x4*)(VT + (size_t)e * KVROWS + 8 * ch) = (u32x4){lo.x, lo.y, hi.x, hi.y};
        }
        __builtin_amdgcn_s_waitcnt(0); __builtin_amdgcn_wave_barrier();
    }
}

constexpr int A_KSTR = 208;
constexpr int A_VSTR = 136;
constexpr int A_KBYTES = 64 * A_KSTR;
constexpr int A_VBYTES = 64 * A_VSTR;
constexpr int A_BUF = A_KBYTES + A_VBYTES;
DI unsigned cvtpk_s(float lo, float hi) { typedef float f2 __attribute__((ext_vector_type(2))); typedef __bf16 b2 __attribute__((ext_vector_type(2))); f2 v = {lo, hi}; b2 b = __builtin_convertvector(v, b2); return __builtin_bit_cast(unsigned, b); }

DI void attn_item(const Frame& F, const Args& A, int h, int qb) {
    unsigned char* ws = A.ws; unsigned char* lds = F.lds;
    const int tid = F.tid, lane = F.lane, wave = F.wave, r32 = lane & 31, hh = lane >> 5;
    const bf16_t* Qg = (const bf16_t*)(ws + WS_Q) + (size_t)h * KVROWS * 96;
    const bf16_t* Kg = (const bf16_t*)(ws + WS_K) + (size_t)h * KVROWS * 96;
    const bf16_t* Vg = (const bf16_t*)(ws + WS_VT) + (size_t)h * 64 * KVROWS;
    const int p0w = 64 + 256 * qb + 32 * wave;
    const int qp = p0w + r32;
    const int ntile = 4 * qb + 5;
    const int mylast = 1 + 4 * qb + (wave >> 1);
    bf16x8 qf[6];
#pragma unroll
    for (int s = 0; s < 6; ++s) qf[s] = *(const bf16x8*)(Qg + (size_t)qp * 96 + 16 * s + 8 * hh);
    f32x16 ot[2]; ot[0] = zero16(); ot[1] = zero16();
    float mrun = -1e30f, lrun = 0.f;
    const int kr0 = tid / 12, kc0 = tid % 12, kr1 = (tid + 512) / 12, kc1 = (tid + 512) % 12; const bool k1ok = tid < 256;
    const int vr = tid >> 3, vc = tid & 7;
    struct Stg { u32x4 k0, k1, v; };
    Stg sA, sB;
    auto gload = [&](Stg& st, int j) {
        const int kv0 = 64 * j;
        st.k0 = *(const u32x4*)(Kg + (size_t)(kv0 + kr0) * 96 + kc0 * 8);
        if (k1ok) st.k1 = *(const u32x4*)(Kg + (size_t)(kv0 + kr1) * 96 + kc1 * 8);
        st.v = *(const u32x4*)(Vg + (size_t)vr * KVROWS + kv0 + vc * 8);
    };
    auto lstore = [&](const Stg& st, int b) {
        unsigned char* kb = lds + b * A_BUF; unsigned char* vb = kb + A_KBYTES;
        *(u32x4*)(kb + kr0 * A_KSTR + kc0 * 16) = st.k0;
        if (k1ok) *(u32x4*)(kb + kr1 * A_KSTR + kc1 * 16) = st.k1;
        *(u32x2*)(vb + vr * A_VSTR + vc * 16) = (u32x2){st.v.x, st.v.y};
        *(u32x2*)(vb + vr * A_VSTR + vc * 16 + 8) = (u32x2){st.v.z, st.v.w};
    };
    gload(sA, 0); lstore(sA, 0); gload(sB, 1);
    __syncthreads();
    auto step = [&](int j, Stg& sNext  , Stg& sFree  ) {
        const int b = j & 1;
        if (j + 2 < ntile) gload(sFree, j + 2);
        if (j <= mylast) {
            const unsigned char* kb = lds + b * A_BUF; const unsigned char* vb = kb + A_KBYTES;
            f32x16 sc[2];
#pragma unroll
            for (int kh = 0; kh < 2; ++kh) {
                f32x16 acc = zero16();
                const unsigned char* kp = kb + (32 * kh + r32) * A_KSTR + hh * 16;
#pragma unroll
                for (int s = 0; s < 6; ++s) acc = mfma32(*(const bf16x8*)(kp + s * 32), qf[s], acc);
                sc[kh] = acc;
            }
            if (j == 0) {
#pragma unroll
                for (int kh = 0; kh < 2; ++kh)
#pragma unroll
                    for (int r = 0; r < 16; ++r) { const int kv = 32 * kh + crow(r, hh); if (kv < PADL) sc[kh][r] = -INFINITY; }
            }
            if (j == mylast) {
#pragma unroll
                for (int kh = 0; kh < 2; ++kh)
#pragma unroll
                    for (int r = 0; r < 16; ++r) { const int kv = 64 * j + 32 * kh + crow(r, hh); if (kv > qp) sc[kh][r] = -INFINITY; }
            }
            float mx = sc[0][0];
#pragma unroll
            for (int r = 1; r < 16; ++r) mx = fmaxf(mx, sc[0][r]);
#pragma unroll
            for (int r = 0; r < 16; ++r) mx = fmaxf(mx, sc[1][r]);
            mx = fmaxf(mx, __shfl_xor(mx, 32));
            const float mnew = fmaxf(mrun, mx);
            const float alpha = __builtin_amdgcn_exp2f(mrun - mnew);
            mrun = mnew;
            float ps = 0.f;
#pragma unroll
            for (int kh = 0; kh < 2; ++kh)
#pragma unroll
                for (int r = 0; r < 16; ++r) { const float e = __builtin_amdgcn_exp2f(sc[kh][r] - mnew); sc[kh][r] = e; ps += e; }
            lrun = lrun * alpha + ps;
#pragma unroll
            for (int eh = 0; eh < 2; ++eh)
#pragma unroll
                for (int r = 0; r < 16; ++r) ot[eh][r] *= alpha;
#pragma unroll
            for (int kh = 0; kh < 2; ++kh)
#pragma unroll
                for (int s2 = 0; s2 < 2; ++s2) {
                    u32x4 pw; pw.x = cvtpk_s(sc[kh][8 * s2 + 0], sc[kh][8 * s2 + 1]); pw.y = cvtpk_s(sc[kh][8 * s2 + 2], sc[kh][8 * s2 + 3]);
                    pw.z = cvtpk_s(sc[kh][8 * s2 + 4], sc[kh][8 * s2 + 5]); pw.w = cvtpk_s(sc[kh][8 * s2 + 6], sc[kh][8 * s2 + 7]);
                    const bf16x8 pf = __builtin_bit_cast(bf16x8, pw);
#pragma unroll
                    for (int eh = 0; eh < 2; ++eh) {
                        const unsigned char* vp = vb + (32 * eh + r32) * A_VSTR + (32 * kh + 16 * s2 + 4 * hh) * 2;
                        const u32x2 lo = *(const u32x2*)vp, hi2 = *(const u32x2*)(vp + 16);
                        const bf16x8 vf = __builtin_bit_cast(bf16x8, (u32x4){lo.x, lo.y, hi2.x, hi2.y});
                        ot[eh] = mfma32(vf, pf, ot[eh]);
                    }
                }
        }
        if (j + 1 < ntile) lstore(sNext, b ^ 1);
        __syncthreads();
    };
#pragma unroll 1
    for (int j = 0; j < ntile; j += 2) {
        step(j, sB, sA);
        if (j + 1 < ntile) step(j + 1, sA, sB);
    }
    const float ltot = lrun + __shfl_xor(lrun, 32);
    const float rl = 1.f / ltot;
    bf16_t* o = (bf16_t*)(ws + WS_MIX) + (size_t)(qp - 64) * 1024 + 512 + h * 64;
#pragma unroll
    for (int eh = 0; eh < 2; ++eh)
#pragma unroll
        for (int a = 0; a < 4; ++a) {
            const int e = 32 * eh + 8 * a + 4 * hh;
            *(u32x2*)(o + e) = (u32x2){pk2(ot[eh][4 * a] * rl, ot[eh][4 * a + 1] * rl), pk2(ot[eh][4 * a + 2] * rl, ot[eh][4 * a + 3] * rl)};
        }
}

DI void xn_rows(const Frame& F, const Args& A, int u0, int stride) {
    f32x4 v[2][4];
#pragma unroll
    for (int r = 0; r < 2; ++r) { const int u = u0 + r * stride; if (u < MU) { const f32x4* xr = (const f32x4*)(A.out + (size_t)u * DM) + F.lane;
#pragma unroll
        for (int j = 0; j < 4; ++j) v[r][j] = xr[64 * j]; } }
#pragma unroll
    for (int r = 0; r < 2; ++r) {
        const int u = u0 + r * stride; if (u >= MU) continue;
        float s = 0.f;
#pragma unroll
        for (int j = 0; j < 4; ++j) s += (v[r][j].x * v[r][j].x + v[r][j].y * v[r][j].y) + (v[r][j].z * v[r][j].z + v[r][j].w * v[r][j].w);
        const float rstd = 1.f / sqrtf(wave_sum(s) * (1.f / DM) + EPS);
        unsigned long long* o8 = (unsigned long long*)((bf16_t*)(A.ws + WS_XN) + (size_t)u * DM) + F.lane;
#pragma unroll
        for (int j = 0; j < 4; ++j) { const f32x4 w = ((const f32x4*)A.in[15])[64 * j + F.lane];
            o8[64 * j] = (unsigned long long)pk2(v[r][j].x * rstd * w.x, v[r][j].y * rstd * w.y) | ((unsigned long long)pk2(v[r][j].z * rstd * w.z, v[r][j].w * rstd * w.w) << 32); }
    }
}

DI unsigned fkey(float v, int idx) { unsigned u = __builtin_bit_cast(unsigned, v); u = (u & 0x80000000u) ? ~u : (u | 0x80000000u); return (u & ~127u) | (unsigned)(127 - idx); }
DI float keyval(unsigned k) { unsigned u = k & ~127u; u = (u & 0x80000000u) ? (u & 0x7fffffffu) : ~u; return __builtin_bit_cast(float, u); }

__device__ const unsigned char PAIR_A[50] = {0,0,0,0,0,0,0,0,0,0,0,0,0,0,0,0, 1,1,1,1,1,1,1,1, 2,2,2,2,2, 3,3,3,3, 4,4,4, 5,5, 6,6, 7,7, 8,9,10,11,12,13,14,15};
__device__ const unsigned char PAIR_B[50] = {0,1,2,3,4,5,6,7,8,9,10,11,12,13,14,15, 0,1,2,3,4,5,6,7, 0,1,2,3,4, 0,1,2,3, 0,1,2, 0,1, 0,1, 0,1, 0,0,0,0,0,0,0,0};

DI void ce_desc(unsigned& a, unsigned& b) { const unsigned mx = a > b ? a : b, mn = a > b ? b : a; a = mx; b = mn; }
template <int BASE, int NK> DI void bitonic_sort16_desc(unsigned (&x)[NK]) {
#pragma unroll
    for (int k = 2; k <= 16; k <<= 1)
#pragma unroll
        for (int j = k >> 1; j > 0; j >>= 1)
#pragma unroll
            for (int i = 0; i < 16; ++i) { const int l = i ^ j; if (l > i) { if ((i & k) == 0) ce_desc(x[BASE + i], x[BASE + l]); else ce_desc(x[BASE + l], x[BASE + i]); } }
}
template <int A0, int B0, int NK> DI void merge_top16(unsigned (&x)[NK]) {
#pragma unroll
    for (int i = 0; i < 16; ++i) { const unsigned p = x[A0 + i], q = x[B0 + 15 - i]; x[A0 + i] = p > q ? p : q; }
#pragma unroll
    for (int j = 8; j > 0; j >>= 1)
#pragma unroll
        for (int i = 0; i < 16; ++i) { const int l = i ^ j; if (l > i) ce_desc(x[A0 + i], x[A0 + l]); }
}
template <int NK> DI void top16_of_128(unsigned (&key)[NK]) {
    bitonic_sort16_desc<0, NK>(key); bitonic_sort16_desc<16, NK>(key); bitonic_sort16_desc<32, NK>(key); bitonic_sort16_desc<48, NK>(key);
    bitonic_sort16_desc<64, NK>(key); bitonic_sort16_desc<80, NK>(key); bitonic_sort16_desc<96, NK>(key); bitonic_sort16_desc<112, NK>(key);
    merge_top16<0, 16, NK>(key); merge_top16<32, 48, NK>(key); merge_top16<64, 80, NK>(key); merge_top16<96, 112, NK>(key);
    merge_top16<0, 32, NK>(key); merge_top16<64, 96, NK>(key);
    merge_top16<0, 64, NK>(key);
}

DI void topk_task(const Frame& F, const Args& A, int task) {
    unsigned char* ws = A.ws; const int tid = F.tid;
    const int u = task >> 3, h = task & 7;
    LAS unsigned* sk = (LAS unsigned*)(LAS unsigned char*)F.lds;
    LAS unsigned* pkk = sk + 16384;
    LAS float* stg = (LAS float*)(sk + 16384);
    const float* SCb = (const float*)(ws + WS_SC) + (size_t)(task & ~511) * 256;
#pragma unroll 1
    for (int half = 0; half < 2; ++half) {
        unsigned key[128];
#pragma unroll
        for (int qb = 0; qb < 4; ++qb) {
            u32x4 pf[8];
#pragma unroll
            for (int k = 0; k < 8; ++k) { const int c = tid + 512 * k; pf[k] = *(const u32x4*)(SCb + (size_t)(c >> 3) * 256 + half * 128 + qb * 32 + (c & 7) * 4); }
#pragma unroll
            for (int k = 0; k < 8; ++k) { const int c = tid + 512 * k; *(LAS u32x4*)(stg + (c >> 3) * 36 + (c & 7) * 4) = pf[k]; }
            __syncthreads();
#pragma unroll
            for (int i = 0; i < 8; ++i) { const f32x4 v = *(const LAS f32x4*)(stg + tid * 36 + 4 * i);
                key[32 * qb + 4 * i] = fkey(v.x, 32 * qb + 4 * i); key[32 * qb + 4 * i + 1] = fkey(v.y, 32 * qb + 4 * i + 1);
                key[32 * qb + 4 * i + 2] = fkey(v.z, 32 * qb + 4 * i + 2); key[32 * qb + 4 * i + 3] = fkey(v.w, 32 * qb + 4 * i + 3); }
            __syncthreads();
        }
        top16_of_128(key);
#pragma unroll
        for (int r = 0; r < 16; ++r) sk[(half * 16 + r) * 512 + tid] = key[r];
    }
    float v1[16], v2[16];
#pragma unroll
    for (int r = 0; r < 16; ++r) { v1[r] = keyval(sk[r * 512 + tid]); v2[r] = keyval(sk[(16 + r) * 512 + tid]); }
    unsigned ck[64];
#pragma unroll
    for (int c = 50; c < 64; ++c) ck[c] = 0u;
#pragma unroll
    for (int a = 0; a < 16; ++a) {
        const int off = a == 0 ? 0 : a == 1 ? 16 : a == 2 ? 24 : a == 3 ? 29 : a == 4 ? 33 : a == 5 ? 36 : a == 6 ? 38 : a == 7 ? 40 : 42 + (a - 8);
#pragma unroll
        for (int b = 0; b < 16; ++b) if ((a + 1) * (b + 1) <= 16) ck[off + b] = fkey(v1[a] + v2[b], off + b);
    }
    bitonic_sort16_desc<0, 64>(ck); bitonic_sort16_desc<16, 64>(ck); bitonic_sort16_desc<32, 64>(ck); bitonic_sort16_desc<48, 64>(ck);
    merge_top16<0, 16, 64>(ck); merge_top16<32, 48, 64>(ck); merge_top16<0, 32, 64>(ck);
#pragma unroll
    for (int r = 0; r < 16; ++r) pkk[r * 512 + tid] = ck[r];
    const float cmax = keyval(pkk[tid]);
    float ev[16]; float esum = 0.f; int ex[16];
#pragma unroll
    for (int r = 0; r < 16; ++r) {
        const unsigned k = pkk[r * 512 + tid]; const int c = 127 - (int)(k & 127u);
        ev[r] = __expf(keyval(k) - cmax); esum += ev[r];
        const int a = PAIR_A[c], b = PAIR_B[c];
        const int i1 = 127 - (int)(sk[a * 512 + tid] & 127u), i2 = 127 - (int)(sk[(16 + b) * 512 + tid] & 127u);
        ex[r] = i1 * 128 + i2;
    }
    const float rs = 1.f / esum;
    int* IDX = (int*)(ws + WS_IDX) + (size_t)u * 128 + h * 16; float* GATE = (float*)(ws + WS_GATE) + (size_t)u * 128 + h * 16;
#pragma unroll
    for (int r = 0; r < 16; r += 4) {
        *(int4*)(IDX + r) = make_int4(ex[r], ex[r + 1], ex[r + 2], ex[r + 3]);
        *(f32x4*)(GATE + r) = (f32x4){ev[r] * rs, ev[r + 1] * rs, ev[r + 2] * rs, ev[r + 3] * rs};
    }
}

constexpr float EU_SCALE = 64.f, EV_SCALE = 16.f;
DI unsigned pk4_fp8(float a, float b, float c, float d) { int w = 0; w = __builtin_amdgcn_cvt_pk_fp8_f32(a, b, w, false); w = __builtin_amdgcn_cvt_pk_fp8_f32(c, d, w, true); return (unsigned)w; }
DI void convert_tables(const Frame& F, const Args& A) {
    const size_t n16 = (size_t)16384 * 1024 / 16;
    const size_t gt = (size_t)blockIdx.x * 512 + F.tid, NGT = (size_t)F.G * 512;
#pragma unroll 1
    for (int t = 0; t < 2; ++t) {
        const float* src = A.in[18 + t]; unsigned char* dst = A.ws + (t ? WS_EV : WS_EU); const float sc = t ? EV_SCALE : EU_SCALE;
        const float* fn = A.in[15];
        for (size_t i = gt; i < n16; i += NGT) {
            f32x4 a = *(const f32x4*)(src + i * 16) * sc, b = *(const f32x4*)(src + i * 16 + 4) * sc, c = *(const f32x4*)(src + i * 16 + 8) * sc, d = *(const f32x4*)(src + i * 16 + 12) * sc;
            if (t == 0) { const float* g = fn + (i & 63) * 16; a *= *(const f32x4*)g; b *= *(const f32x4*)(g + 4); c *= *(const f32x4*)(g + 8); d *= *(const f32x4*)(g + 12); }
            const size_t e_ = i >> 6, c16_ = i & 63;
            *(u32x4*)(dst + (c16_ >> 3) * ((size_t)16384 * 128) + e_ * 128 + (c16_ & 7) * 16) = (u32x4){pk4_fp8(a.x, a.y, a.z, a.w), pk4_fp8(b.x, b.y, b.z, b.w), pk4_fp8(c.x, c.y, c.z, c.w), pk4_fp8(d.x, d.y, d.z, d.w)};
        }
    }
}

DI float gelu_exact(float x) { return 0.5f * x * (1.f + erff(x * 0.70710678118654752f)); }
typedef float f32x2 __attribute__((ext_vector_type(2)));
#define UNPK16(dst, W_) do { f32x2 _t; \
    _t = __builtin_amdgcn_cvt_pk_f32_fp8((int)(W_).x, false); dst[0] = _t.x; dst[1] = _t.y; _t = __builtin_amdgcn_cvt_pk_f32_fp8((int)(W_).x, true); dst[2] = _t.x; dst[3] = _t.y; \
    _t = __builtin_amdgcn_cvt_pk_f32_fp8((int)(W_).y, false); dst[4] = _t.x; dst[5] = _t.y; _t = __builtin_amdgcn_cvt_pk_f32_fp8((int)(W_).y, true); dst[6] = _t.x; dst[7] = _t.y; \
    _t = __builtin_amdgcn_cvt_pk_f32_fp8((int)(W_).z, false); dst[8] = _t.x; dst[9] = _t.y; _t = __builtin_amdgcn_cvt_pk_f32_fp8((int)(W_).z, true); dst[10] = _t.x; dst[11] = _t.y; \
    _t = __builtin_amdgcn_cvt_pk_f32_fp8((int)(W_).w, false); dst[12] = _t.x; dst[13] = _t.y; _t = __builtin_amdgcn_cvt_pk_f32_fp8((int)(W_).w, true); dst[14] = _t.x; dst[15] = _t.y; } while (0)

template <bool UPH>
DI void expert_phase(const Frame& F, const Args& A, int xv, int wq, int nw) {
    unsigned char* ws = A.ws; const int lane = F.lane, grp = lane >> 3, j = lane & 7;
    const unsigned char* TBL = ws + (UPH ? WS_EU : WS_EV) + (size_t)xv * ((size_t)16384 * 128) + 16 * j;
    const int* IDX = (const int*)(ws + WS_IDX); const float* CW = (const float*)(ws + WS_CW);
    const bf16_t* XN = (const bf16_t*)(ws + WS_XN) + 128 * xv + 16 * j;
    float* HP = (float*)(ws + WS_HP);
    LAS unsigned* ring = (LAS unsigned*)((LAS unsigned char*)F.lds + F.wave * 4096);
    const int nt = (MU - wq + nw - 1) / nw;
    if (nt <= 0) return;
    auto tok = [&](int k) { return __builtin_amdgcn_readfirstlane(wq + (k < nt ? k : nt - 1) * nw); };
    int mi0, mi1; u32x4 mx0, mx1; float mh0, mh1;
    auto meta_load = [&](int k) {
        const int u = tok(k);
        mi0 = IDX[(size_t)u * 128 + lane]; mi1 = IDX[(size_t)u * 128 + 64 + lane];
        if constexpr (UPH) { mx0 = *(const u32x4*)(XN + (size_t)u * DM); mx1 = *(const u32x4*)(XN + (size_t)u * DM + 8); }
        else { mh0 = CW[(size_t)u * 128 + lane]; mh1 = CW[(size_t)u * 128 + 64 + lane]; }
    };
    auto meta_store = [&](int k) {
        LAS unsigned* sl = ring + (k & 3) * 256;
        sl[lane] = (unsigned)mi0; sl[64 + lane] = (unsigned)mi1;
        if constexpr (UPH) { if (grp == 0) { *(LAS u32x4*)(sl + 128 + 8 * j) = mx0; *(LAS u32x4*)(sl + 128 + 8 * j + 4) = mx1; } }
        else { sl[128 + lane] = __builtin_bit_cast(unsigned, mh0); sl[192 + lane] = __builtin_bit_cast(unsigned, mh1); }
    };
    auto gather = [&](u32x4 (&buf)[8], int n) {
        const LAS unsigned* sl = ring + ((n >> 1) & 3) * 256 + 64 * (n & 1) + grp;
#pragma unroll
        for (int i = 0; i < 8; ++i) { const int e = (int)sl[8 * i]; buf[i] = *(const u32x4*)(TBL + (size_t)e * 128); }
    };
    const int ocol = 128 * xv + 16 * j + ((lane & 32) ? 8 : 0) + ((lane & 16) ? 4 : 0) + ((lane & 8) ? 2 : 0);
    f32x2 ocur = (f32x2){0.f, 0.f};
    float acc[16];
    float xn[16];
    auto compute = [&](u32x4 (&buf)[8], int n) {
        const int k = n >> 1, hf = n & 1;
        const LAS unsigned* sl = ring + (k & 3) * 256;
        if (hf == 0) {
            if constexpr (UPH) {
                const u32x4 x0 = *(const LAS u32x4*)(sl + 128 + 8 * j), x1 = *(const LAS u32x4*)(sl + 128 + 8 * j + 4);
                xn[0] = bflo(x0.x); xn[1] = bfhi(x0.x); xn[2] = bflo(x0.y); xn[3] = bfhi(x0.y); xn[4] = bflo(x0.z); xn[5] = bfhi(x0.z); xn[6] = bflo(x0.w); xn[7] = bfhi(x0.w);
                xn[8] = bflo(x1.x); xn[9] = bfhi(x1.x); xn[10] = bflo(x1.y); xn[11] = bfhi(x1.y); xn[12] = bflo(x1.z); xn[13] = bfhi(x1.z); xn[14] = bflo(x1.w); xn[15] = bfhi(x1.w);
            } else {
#pragma unroll
                for (int c = 0; c < 16; ++c) acc[c] = 0.f;
                ocur = *(const f32x2*)(A.out + (size_t)tok(k) * DM + ocol);
            }
        }
#pragma unroll
        for (int i = 0; i < 8; ++i) {
            float f[16]; UNPK16(f, buf[i]);
            if constexpr (UPH) {
                float a0 = 0.f, a1 = 0.f;
#pragma unroll
                for (int c = 0; c < 16; c += 2) { a0 += f[c] * xn[c]; a1 += f[c + 1] * xn[c + 1]; }
                if (hf == 0) acc[i] = a0 + a1; else acc[8 + i] = a0 + a1;
                if (i < 7) { if (hf == 0) asm volatile("" : "+v"(buf[i + 1].x), "+v"(buf[i + 1].y), "+v"(buf[i + 1].z), "+v"(buf[i + 1].w), "+v"(acc[i]));
                             else asm volatile("" : "+v"(buf[i + 1].x), "+v"(buf[i + 1].y), "+v"(buf[i + 1].z), "+v"(buf[i + 1].w), "+v"(acc[8 + i])); }
            } else {
                const float cw = __builtin_bit_cast(float, sl[128 + 64 * hf + 8 * i + grp]);
#pragma unroll
                for (int c = 0; c < 16; ++c) acc[c] += cw * f[c];
                if (i < 7) asm volatile("" : "+v"(buf[i + 1].x), "+v"(buf[i + 1].y), "+v"(buf[i + 1].z), "+v"(buf[i + 1].w),
                                             "+v"(acc[0]), "+v"(acc[1]), "+v"(acc[2]), "+v"(acc[3]), "+v"(acc[4]), "+v"(acc[5]), "+v"(acc[6]), "+v"(acc[7]),
                                             "+v"(acc[8]), "+v"(acc[9]), "+v"(acc[10]), "+v"(acc[11]), "+v"(acc[12]), "+v"(acc[13]), "+v"(acc[14]), "+v"(acc[15]));
            }
            __builtin_amdgcn_sched_barrier(0);
        }
        if (hf == 1 && k < nt) {
            const int u = tok(k);
            float r8[8], r4[4], r2[2];
            if constexpr (UPH) {
                { const bool up = lane & 4;
#pragma unroll
                  for (int i = 0; i < 8; ++i) { const float send = up ? acc[i] : acc[i + 8], keep = up ? acc[i + 8] : acc[i]; r8[i] = keep + __shfl_xor(send, 4); } }
                { const bool up = lane & 2;
#pragma unroll
                  for (int i = 0; i < 4; ++i) { const float send = up ? r8[i] : r8[i + 4], keep = up ? r8[i + 4] : r8[i]; r4[i] = keep + __shfl_xor(send, 2); } }
                { const bool up = lane & 1;
#pragma unroll
                  for (int i = 0; i < 2; ++i) { const float send = up ? r4[i] : r4[i + 2], keep = up ? r4[i + 2] : r4[i]; r2[i] = keep + __shfl_xor(send, 1); } }
                const int st = ((lane & 4) ? 8 : 0) + ((lane & 2) ? 4 : 0) + ((lane & 1) ? 2 : 0);
                float* hp = HP + ((size_t)xv * MU + u) * 128 + grp;
                hp[8 * st] = r2[0]; hp[8 * (st + 1)] = r2[1];
            } else {
                { const bool up = lane & 32;
#pragma unroll
                  for (int c = 0; c < 8; ++c) { const float send = up ? acc[c] : acc[c + 8], keep = up ? acc[c + 8] : acc[c]; r8[c] = keep + __shfl_xor(send, 32); } }
                { const bool up = lane & 16;
#pragma unroll
                  for (int c = 0; c < 4; ++c) { const float send = up ? r8[c] : r8[c + 4], keep = up ? r8[c + 4] : r8[c]; r4[c] = keep + __shfl_xor(send, 16); } }
                { const bool up = lane & 8;
#pragma unroll
                  for (int c = 0; c < 2; ++c) { const float send = up ? r4[c] : r4[c + 2], keep = up ? r4[c + 2] : r4[c]; r2[c] = keep + __shfl_xor(send, 8); } }
                f32x2* o = (f32x2*)(A.out + (size_t)u * DM + ocol);
                f32x2 cur = ocur; cur.x += r2[0]; cur.y += r2[1]; *o = cur;
            }
        }
    };
    meta_load(0); meta_store(0); meta_load(1); meta_store(1); meta_load(2); meta_store(2);
    u32x4 b0[8], b1[8], b2[8];
    gather(b0, 0); gather(b1, 1); gather(b2, 2);
#pragma unroll 1
    for (int k0 = 0; k0 < nt; k0 += 3) {
        const int n0 = 2 * k0;
        meta_load(k0 + 3);
        compute(b0, n0);     gather(b0, n0 + 3);
        compute(b1, n0 + 1); meta_store(k0 + 3); gather(b1, n0 + 4);
        meta_load(k0 + 4);
        compute(b2, n0 + 2); gather(b2, n0 + 5);
        compute(b0, n0 + 3); meta_store(k0 + 4); gather(b0, n0 + 6);
        meta_load(k0 + 5);
        compute(b1, n0 + 4); gather(b1, n0 + 7);
        compute(b2, n0 + 5); meta_store(k0 + 5); gather(b2, n0 + 8);
    }
}


DI void expert_c_pass(const Frame& F, const Args& A) {
    unsigned char* ws = A.ws;
    const float* HP = (const float*)(ws + WS_HP); const float* GATE = (const float*)(ws + WS_GATE); float* CW = (float*)(ws + WS_CW);
    const size_t n4 = (size_t)MU * 128 / 4;
    for (size_t i = (size_t)blockIdx.x * 512 + F.tid; i < n4; i += (size_t)F.G * 512) {
        f32x4 h = *(const f32x4*)(HP + i * 4);
#pragma unroll
        for (int x = 1; x < 8; ++x) h += *(const f32x4*)(HP + (size_t)x * MU * 128 + i * 4);
        const f32x4 g = *(const f32x4*)(GATE + i * 4);
        const float rs = (1.f / EU_SCALE) / sqrtf(((const float*)(ws + WS_SS4))[i >> 5] * (1.f / DM) + EPS);
        f32x4 c;
        c.x = gelu_exact(h.x * rs) * g.x * (1.f / EV_SCALE); c.y = gelu_exact(h.y * rs) * g.y * (1.f / EV_SCALE);
        c.z = gelu_exact(h.z * rs) * g.z * (1.f / EV_SCALE); c.w = gelu_exact(h.w * rs) * g.w * (1.f / EV_SCALE);
        *(f32x4*)(CW + i * 4) = c;
    }
}
template <int PH> DI void run_phase(const Frame& F, const Args& args, PG8_LAS unsigned char* lds3) {
    unsigned char* ws = args.ws;
    if constexpr (PH == 0) { p0_prologue(F, args); p0_late_weights<0>(F, args, (7 - F.wave) * F.G + blockIdx.x, F.NGW, blockIdx.x * 512 + F.tid, F.G * 512); }
    if constexpr (PH == 1) {
        pg8::Gemm g{(const bf16_t*)(ws + WS_HN), (const bf16_t*)(ws + WS_WIN), MP, NPROJ, 1024, 1024, 1024, 0};
        pg8::StaticOrder S; S.init(MP, NPROJ, F.G, (int)blockIdx.x);
        EpiProj E{(bf16_t*)(ws + WS_QKVR), (bf16_t*)(ws + WS_Z), (float*)(ws + WS_P32), (bf16_t*)(ws + WS_CQN), (bf16_t*)(ws + WS_CKVN), (float*)(ws + WS_KPE), (float*)(ws + WS_SSQ), (float*)(ws + WS_SSK)};
        pg8::gemm_phase<EpiProj, pg8::StaticOrder, true, true>(lds3, g, S, E);
    }
    if constexpr (PH == 2) { gdn_prep_phase<0>(F, args); }
    if constexpr (PH == 3) {
        { pg8::Gemm g{(const bf16_t*)(ws + WS_CQN), (const bf16_t*)(ws + WS_WUQ), MP, 768, 256, 256, 256, 0};
          pg8::StaticOrder S; S.init(MP, 768, F.G, (int)blockIdx.x); EpiB16 E{(bf16_t*)(ws + WS_QH), 768, (const float*)(ws + WS_SSQ), 1.f / 256.f};
          pg8::gemm_phase<EpiB16, pg8::StaticOrder, true, true>(lds3, g, S, E); }
        { pg8::Gemm g{(const bf16_t*)(ws + WS_CKVN), (const bf16_t*)(ws + WS_WUKV), MP, 1024, 256, 256, 256, 0};
          pg8::StaticOrder S; S.init(MP, 1024, F.G, (int)blockIdx.x); EpiB16 E{(bf16_t*)(ws + WS_KVB), 1024, (const float*)(ws + WS_SSK), 1.f / 128.f};
          pg8::gemm_phase<EpiB16, pg8::StaticOrder, true, true>(lds3, g, S, E); }
    }
    if constexpr (PH == 4) { for (int t = F.gw; t < (KVROWS / 64) * 8; t += F.NGW) mla_prep2_task(F, args, t); }
    if constexpr (PH == 5) {
        gdn_scan(F, args);
        volatile LAS unsigned* MISC = (volatile LAS unsigned*)(lds3 + MISC_OFF);
        unsigned* qhead = (unsigned*)(ws + WS_CTL) + CW_ATTQ;
        for (;;) {
            __syncthreads();
            if (F.tid == 0) MISC[24] = xb_add(qhead, 1u);
            __syncthreads();
            const int k = (int)MISC[24];
            if (k >= 512) break;
            attn_item(F, args, k & 7, 63 - (k >> 3));
        }
        p0_late_weights<1>(F, args, F.gw, F.NGW, blockIdx.x * 512 + F.tid, F.G * 512);
    }
    if constexpr (PH == 6) { for (int t = F.gw; t < 2048 * 2; t += F.NGW) gdn_out_task(F, args, t); }
    if constexpr (PH == 7) {
        pg8::Gemm g{(const bf16_t*)(ws + WS_MIX), (const bf16_t*)(ws + WS_WOUT), MU, 1024, 1024, 1024, 1024, 0};
        pg8::StaticOrder S; S.init(MU, 1024, F.G, (int)blockIdx.x); EpiH1 E{args.out, args.in[0], (bf16_t*)(ws + WS_XN), (float*)(ws + WS_SS4)};
        pg8::gemm_phase<EpiH1, pg8::StaticOrder, true, true>(lds3, g, S, E);
    }
    if constexpr (PH == 8) {
        pg8::Gemm g{(const bf16_t*)(ws + WS_XN), (const bf16_t*)(ws + WS_WPQ), MU, 2048, 1024, 1024, 1024, 0};
        pg8::StaticOrder S; S.init(MU, 2048, F.G, (int)blockIdx.x); EpiB16 E{(bf16_t*)(ws + WS_PQ), 2048, (const float*)(ws + WS_SS4), 1.f / 1024.f};
        pg8::gemm_phase<EpiB16, pg8::StaticOrder, true, true>(lds3, g, S, E);
    }
    if constexpr (PH == 9) {
        pg8::Gemm g{(const bf16_t*)(ws + WS_PQ), (const bf16_t*)(ws + WS_SKB), MU, 2048, 256, 2048, 256, 256};
        pg8::StaticOrder S; S.init(MU, 2048, F.G, (int)blockIdx.x); EpiF32 E{(float*)(ws + WS_SC), 2048, nullptr};
        pg8::gemm_phase<EpiF32, pg8::StaticOrder, true, true>(lds3, g, S, E);
    }
    if constexpr (PH == 10) {
        convert_tables(F, args);
        for (int t = blockIdx.x * 512 + F.tid; t < MU * 8; t += F.G * 512) topk_task(F, args, t);
    }
    if constexpr (PH == 12) { expert_c_pass(F, args); }
    if constexpr (PH == 11 || PH == 13) {
        volatile LAS unsigned* MISC = (volatile LAS unsigned*)(lds3 + MISC_OFF);
        const unsigned x = MISC[16], rank = MISC[17];
        unsigned* bar = (unsigned*)(ws + WS_CTL);
        unsigned nloc = 0, nx = 0, myidx = 0;
#pragma unroll
        for (unsigned j = 0; j < 16; ++j) { const unsigned c = xb_ld(&bar[XB_XCNT(j)]); nx += (c > 0u) ? 1u : 0u; myidx += (c > 0u && j < x) ? 1u : 0u; nloc = (j == x) ? c : nloc; }
        const int wq = __builtin_amdgcn_readfirstlane((int)rank * 8 + F.wave), nw = __builtin_amdgcn_readfirstlane((int)nloc * 8);
        const int xstep = __builtin_amdgcn_readfirstlane((int)nx);
        for (int xv = __builtin_amdgcn_readfirstlane((int)myidx); xv < 8; xv += xstep)
            { if constexpr (PH == 11) expert_phase<true>(F, args, xv, wq, nw); else expert_phase<false>(F, args, xv, wq, nw); }
    }
}
constexpr int NPHASE = 14;
__global__ void __launch_bounds__(512, 2) fwd_kernel(Args args) {
    extern __shared__ __attribute__((aligned(16))) unsigned char lds[];
    Frame F;
    F.lds = lds; F.tid = threadIdx.x; F.lane = F.tid & 63; F.wave = __builtin_amdgcn_readfirstlane(F.tid >> 6);
    F.G = gridDim.x; F.gw = blockIdx.x * 8 + F.wave; F.NGW = F.G * 8;
    volatile LAS unsigned* MISC = (volatile LAS unsigned*)((LAS unsigned char*)lds + MISC_OFF);
    if (F.tid < 32) MISC[F.tid] = 0u;
    __syncthreads();
    unsigned char* ws = args.ws;
    const int lo = args.ph_lo, hi = args.ph_hi;
    XcdBarrier bar; bar.bar = (unsigned*)(ws + WS_CTL); bar.x = 0; bar.st = nullptr;
    if (hi - lo > 1) bar = xcd_barrier_post((unsigned*)(ws + WS_CTL), MISC + 8);
    if (F.tid == 0) { const unsigned x = xb_xcc_id(); MISC[16] = x; MISC[17] = xb_add((unsigned*)(ws + WS_CTL) + 3520 + 64 * x, 1u); }
    __syncthreads();
#define IN(k) (lo <= (k) && (k) < hi)
#define SEAM(k) do { if (IN(k) && IN((k) + 1)) xcd_barrier(bar); } while (0)
    PG8_LAS unsigned char* lds3 = (PG8_LAS unsigned char*)lds;

#ifndef PROBE_REPEAT
#define PROBE_REPEAT -1
#endif
#ifndef PROBE_TIME
#define PROBE_TIME -1
#endif
#ifndef PROBE_TSEL
#define PROBE_TSEL 0
#endif
    unsigned long long pt_ticks = 0ull;
#define PHASE(k) do { unsigned long long pt0_ = 0ull; if (PROBE_TIME == (k)) pt0_ = __builtin_amdgcn_s_memrealtime(); \
        if (IN(k)) { run_phase<k>(F, args, lds3); if (PROBE_REPEAT == (k)) { xcd_barrier(bar); run_phase<(k)>(F, args, lds3); } } \
        if (PROBE_TIME == (k) && PROBE_TSEL == 1) pt_ticks = __builtin_amdgcn_s_memrealtime() - pt0_;     \
        if (PROBE_TIME == (k) && PROBE_TSEL == 2) pt0_ = __builtin_amdgcn_s_memrealtime();                \
        SEAM(k); \
        if (PROBE_TIME == (k) && PROBE_TSEL != 1) pt_ticks = __builtin_amdgcn_s_memrealtime() - pt0_; } while (0)
    PHASE(0); PHASE(1); PHASE(2); PHASE(3); PHASE(4); PHASE(5); PHASE(6); PHASE(7); PHASE(8); PHASE(9); PHASE(10); PHASE(11); PHASE(12); PHASE(13);
#undef PHASE
    if (PROBE_STAGE >= 0) { __syncthreads(); pt_ticks = *(volatile unsigned long long*)(lds + 143360 + 96); }
    if (PROBE_TIME >= 0 || PROBE_STAGE >= 0) { const unsigned long long t0_ = __builtin_amdgcn_s_memrealtime(); while (__builtin_amdgcn_s_memrealtime() - t0_ < 4ull * pt_ticks) __builtin_amdgcn_s_sleep(32); }
#undef IN
#undef SEAM
}

#ifndef N_LAUNCHES
#define N_LAUNCHES 1
#endif
extern "C" void kernel_launch(void* const* d_in, const int* in_sizes, int n_in, void* d_out, int out_size, void* d_ws, size_t ws_size, hipStream_t stream) {
    static int grid = 0;
    if (grid == 0) {
        if (n_in != 20 || out_size != MU * DM || ws_size < WS_END) { fprintf(stderr, "kernel_launch: unexpected shapes (n_in %d out %d ws %zu)\n", n_in, out_size, ws_size); grid = -1; return; }
        int dev = 0, cus = 0, per_cu = 0;
        if (hipGetDevice(&dev) != hipSuccess || hipDeviceGetAttribute(&cus, hipDeviceAttributeMultiprocessorCount, dev) != hipSuccess) { grid = -1; return; }
        if (hipFuncSetAttribute((const void*)fwd_kernel, hipFuncAttributeMaxDynamicSharedMemorySize, LDS_BYTES) != hipSuccess) { fprintf(stderr, "kernel_launch: hipFuncSetAttribute failed\n"); grid = -1; return; }
        if (hipOccupancyMaxActiveBlocksPerMultiprocessor(&per_cu, (const void*)fwd_kernel, 512, LDS_BYTES) != hipSuccess || per_cu < 1) { fprintf(stderr, "kernel_launch: occupancy query says %d\n", per_cu); (void)hipGetLastError(); per_cu = 1; }
        grid = cus;
    }
    if (grid < 0) return;
    (void)hipMemsetAsync((char*)d_ws + WS_CTL, 0, CTL_ZERO_BYTES, stream);
    Args a{};
    for (int i = 0; i < 20; ++i) a.in[i] = (const float*)d_in[i];
    a.out = (float*)d_out; a.ws = (unsigned char*)d_ws;
    for (int li = 0; li < N_LAUNCHES; ++li) {
        a.ph_lo = li * NPHASE / N_LAUNCHES; a.ph_hi = (li + 1) * NPHASE / N_LAUNCHES;
        if (N_LAUNCHES == 1) {
            void* kargs[] = {&a};
            hipError_t e = hipLaunchCooperativeKernel((const void*)fwd_kernel, dim3(grid), dim3(512), kargs, LDS_BYTES, stream);
            if (e != hipSuccess) fprintf(stderr, "cooperative launch failed: %s (grid %d)\n", hipGetErrorString(e), grid);
        } else {
            hipLaunchKernelGGL(fwd_kernel, dim3(grid), dim3(512), LDS_BYTES, stream, a);
        }
    }
}
```

```cpp
#include <hip/hip_runtime.h>
#include <hip/hip_bf16.h>
#include <cstdio>
#include <cstdint>

#define DI __device__ __forceinline__
#define LAS __attribute__((address_space(3)))
#define GAS __attribute__((address_space(1)))

typedef unsigned short bf16_t;
typedef short bf16x8 __attribute__((ext_vector_type(8)));
typedef short s16x4 __attribute__((ext_vector_type(4)));
typedef float f32x4 __attribute__((ext_vector_type(4)));
typedef float f32x16 __attribute__((ext_vector_type(16)));
typedef unsigned u32x4 __attribute__((ext_vector_type(4)));
typedef unsigned u32x2 __attribute__((ext_vector_type(2)));

namespace pg8 {
#define PG8_LAS __attribute__((address_space(3)))
constexpr int BM = 256, BK = 64, HALF = 128, HTB = HALF * BK * 2  , STAGE_BYTES = 8 * HTB, NXCD = 8, WGM = 8;

__host__ __device__ __forceinline__ int lds_byte(int r, int c) { const int st = (r >> 4) * 2 + (c >> 5), rr = r & 15, cc = c & 31, ob = rr * 64 + cc * 2; return st * 1024 + (ob ^ (((ob >> 9) & 1) << 5)); }
__host__ __device__ __forceinline__ void stage_rc(int b, int& R, int& C) { const int st = b / 1024, sb = b % 1024, swz = sb ^ (((sb >> 9) & 1) << 5); R = (st >> 1) * 16 + swz / 64; C = (st & 1) * 32 + (swz % 64) / 2; }
__host__ __device__ __forceinline__ int perm32(int rho) { const int n = rho >> 4, i = rho & 15; return 8 * (i >> 2) + 4 * n + (i & 3); }

struct Unit { int pm, pn; };
struct Gemm { const bf16_t* A; const bf16_t* Bt; int M, N, K, lda, ldb, a_pn_off; };

struct StaticOrder {
    int nM, nN, nwg, G, c;
    __host__ __device__ void init(int M, int N, int G_, int c_) { nM = M / BM; nN = N / BM; nwg = nM * nN; G = G_; c = c_; }
    __host__ __device__ bool next(int i, Unit& u) const {
        const long L = (long)i * G + c; if (L >= nwg) return false;
        int wgid = (int)L; { const int q = nwg / NXCD, r = nwg % NXCD, xcd = wgid % NXCD, off = wgid / NXCD; wgid = (xcd < r ? xcd * (q + 1) : r * (q + 1) + (xcd - r) * q) + off; }
        const int nig = WGM * nN, gid = wgid / nig, fm = gid * WGM, gsz = (nM - fm) < WGM ? (nM - fm) : WGM;
        u.pm = fm + ((wgid % nig) % gsz); u.pn = (wgid % nig) / gsz; return true;
    }
    __device__ __forceinline__ void a_ready(const Unit&) const {}
    __device__ __forceinline__ void done(const Unit&) const {}
};

__device__ __forceinline__ unsigned cvt_pk_bf16(float lo, float hi) { unsigned r; asm volatile("v_cvt_pk_bf16_f32 %0, %1, %2" : "=v"(r) : "v"(lo), "v"(hi)); return r; }

template <class Epi, class Sched, bool ALIGN_EPI = false, bool SP2 = false>
__device__ __forceinline__ void gemm_phase(PG8_LAS unsigned char* lds, const Gemm g, const Sched& S, const Epi& E) {
    const int tid = threadIdx.x, wid = __builtin_amdgcn_readfirstlane(tid >> 6), lane = tid & 63, wr = wid >> 2, wc = wid & 3, fr = lane & 15, fq = lane >> 4;
    const int K = g.K, nt = K / BK;
    unsigned voffA[2], voffB[2];
#pragma unroll
    for (int i = 0; i < 2; ++i) { int R, C; stage_rc(tid * 16 + i * 8192, R, C); const int Rb = Epi::PERM ? ((R & ~31) + perm32(R & 31)) : R;
        voffA[i] = (unsigned)(R * g.lda + C) * 2u; voffB[i] = (unsigned)(Rb * g.ldb + C) * 2u; }
    const size_t kstep = (size_t)(BK * 2);
    const size_t hstepA = (size_t)HALF * g.lda * 2, hstepB = (size_t)HALF * g.ldb * 2;
    const size_t tstepA = 2 * hstepA, tstepB = 2 * hstepB;
    const size_t pnoffA = (size_t)g.a_pn_off * 2;
    const unsigned ldsw = (unsigned)wid * 1024u;
    const int aoff = lds_byte(wr * 64 + fr, fq * 8), boff = lds_byte(wc * 32 + fr, fq * 8);
#define PG8_SA(b, h) (((b) * 2 + (h)) * HTB)
#define PG8_SB(b, h) ((4 + (b) * 2 + (h)) * HTB)
#define PG8_STAGE(bufoff, gbase, voff) do { _Pragma("unroll") for (int _i = 0; _i < 2; ++_i) \
        __builtin_amdgcn_global_load_lds((const unsigned*)((const char*)(gbase) + (voff)[_i]), (PG8_LAS unsigned*)(lds + (bufoff) + ldsw + _i * 8192), 16, 0, 0); } while (0)
#define PG8_LDA(dst, b, h) do { _Pragma("unroll") for (int m = 0; m < 4; ++m) _Pragma("unroll") for (int k = 0; k < 2; ++k) dst[m][k] = *(const PG8_LAS bf16x8*)(lds + PG8_SA(b, h) + aoff + m * 2048 + k * 1024); } while (0)
#define PG8_LDB(dst, b, h) do { _Pragma("unroll") for (int n = 0; n < 2; ++n) _Pragma("unroll") for (int k = 0; k < 2; ++k) dst[n][k] = *(const PG8_LAS bf16x8*)(lds + PG8_SB(b, h) + boff + n * 2048 + k * 1024); } while (0)
#define PG8_MMA(ai, bj, At, Bt) do { __builtin_amdgcn_s_setprio(1); _Pragma("unroll") for (int m = 0; m < 4; ++m) _Pragma("unroll") for (int n = 0; n < 2; ++n) _Pragma("unroll") for (int k = 0; k < 2; ++k) \
        acc[ai][bj][m][n] = __builtin_amdgcn_mfma_f32_16x16x32_bf16(Bt[n][k], At[m][k], acc[ai][bj][m][n], 0, 0, 0); __builtin_amdgcn_s_setprio(0); } while (0)
#define PG8_WAIT_V(n) asm volatile("s_waitcnt vmcnt(" #n ")" ::: "memory")
#define PG8_WAIT_L(n) asm volatile("s_waitcnt lgkmcnt(" #n ")" ::: "memory")
#define PG8_BAR __builtin_amdgcn_s_barrier()
#define PG8_SCHED __builtin_amdgcn_sched_barrier(0)
    Unit cur, nxt; int ui = 0;
    if (!S.next(0, cur)) return;
    f32x4 acc[2][2][4][2];
#pragma unroll
    for (int a = 0; a < 2; ++a)
#pragma unroll
        for (int b = 0; b < 2; ++b)
#pragma unroll
            for (int m = 0; m < 4; ++m)
#pragma unroll
                for (int n = 0; n < 2; ++n) acc[a][b][m][n] = (f32x4){0.f, 0.f, 0.f, 0.f};
    bf16x8 At[4][2], B0[2][2], B1[2][2];
    const char* cA = (const char*)g.A + (size_t)cur.pm * tstepA + (size_t)cur.pn * pnoffA; const char* cB = (const char*)g.Bt + (size_t)cur.pn * tstepB;
    S.a_ready(cur);
    if constexpr (SP2) {
        PG8_STAGE(PG8_SB(0, 0), cB, voffB); PG8_STAGE(PG8_SB(0, 1), cB + hstepB, voffB); PG8_STAGE(PG8_SA(0, 0), cA, voffA); PG8_STAGE(PG8_SA(0, 1), cA + hstepA, voffA);
        if (wr == 1) PG8_BAR;
        PG8_WAIT_V(2); PG8_BAR;
        PG8_STAGE(PG8_SB(1, 0), cB + kstep, voffB); PG8_STAGE(PG8_SA(1, 0), cA + kstep, voffA); PG8_STAGE(PG8_SB(1, 1), cB + hstepB + kstep, voffB);
        PG8_WAIT_V(6); PG8_BAR;
    } else {
        PG8_STAGE(PG8_SB(0, 0), cB, voffB); PG8_STAGE(PG8_SA(0, 0), cA, voffA); PG8_STAGE(PG8_SB(0, 1), cB + hstepB, voffB); PG8_STAGE(PG8_SA(0, 1), cA + hstepA, voffA);
        if (wr == 1) PG8_BAR;
        PG8_WAIT_V(4); PG8_BAR;
        PG8_STAGE(PG8_SB(1, 0), cB + kstep, voffB); PG8_STAGE(PG8_SA(1, 0), cA + kstep, voffA); PG8_STAGE(PG8_SB(1, 1), cB + hstepB + kstep, voffB);
        PG8_WAIT_V(6); PG8_BAR;
    }
    for (;;) {
        const bool has_next = S.next(ui + 1, nxt);
        const char* nA = has_next ? (const char*)g.A + (size_t)nxt.pm * tstepA + (size_t)nxt.pn * pnoffA : cA; const char* nB = has_next ? (const char*)g.Bt + (size_t)nxt.pn * tstepB : cB;
        for (int t = 0; t < nt; t += 2) {
            const bool last = (t == nt - 2);
            const char* a1 = cA + (size_t)(t + 1) * kstep;
            const char* a2 = last ? nA : cA + (size_t)(t + 2) * kstep; const char* b2 = last ? nB : cB + (size_t)(t + 2) * kstep;
            const char* a3 = a2 + kstep; const char* b3 = b2 + kstep;
            if (last && has_next) S.a_ready(nxt);
            if constexpr (SP2) {
            PG8_LDB(B0, 0, 0); PG8_LDB(B1, 0, 1); PG8_SCHED; PG8_LDA(At, 0, 0); PG8_STAGE(PG8_SA(1, 1), a1 + hstepA, voffA);
            PG8_WAIT_V(8); PG8_WAIT_L(0); PG8_BAR; PG8_MMA(0, 0, At, B0); PG8_MMA(0, 1, At, B1); PG8_BAR; PG8_SCHED;
            PG8_LDA(At, 0, 1); PG8_STAGE(PG8_SB(0, 0), b2, voffB); PG8_STAGE(PG8_SB(0, 1), b2 + hstepB, voffB); PG8_STAGE(PG8_SA(0, 0), a2, voffA);
            PG8_WAIT_V(8); PG8_WAIT_L(0); PG8_BAR; PG8_MMA(1, 0, At, B0); PG8_MMA(1, 1, At, B1); PG8_BAR; PG8_SCHED;
            PG8_LDB(B0, 1, 0); PG8_LDB(B1, 1, 1); PG8_SCHED; PG8_LDA(At, 1, 0); PG8_STAGE(PG8_SA(0, 1), a2 + hstepA, voffA);
            PG8_WAIT_V(8); PG8_WAIT_L(0); PG8_BAR; PG8_MMA(0, 0, At, B0); PG8_MMA(0, 1, At, B1); PG8_BAR; PG8_SCHED;
            PG8_LDA(At, 1, 1); PG8_STAGE(PG8_SB(1, 0), b3, voffB); PG8_STAGE(PG8_SB(1, 1), b3 + hstepB, voffB); PG8_STAGE(PG8_SA(1, 0), a3, voffA);
            PG8_WAIT_V(8); PG8_WAIT_L(0); PG8_BAR; PG8_MMA(1, 0, At, B0); PG8_MMA(1, 1, At, B1); PG8_BAR; PG8_SCHED;
            } else {
            PG8_LDB(B0, 0, 0); PG8_SCHED; PG8_LDA(At, 0, 0); PG8_STAGE(PG8_SA(1, 1), a1 + hstepA, voffA);
            PG8_WAIT_L(8); PG8_BAR; PG8_WAIT_L(0); PG8_MMA(0, 0, At, B0); PG8_BAR; PG8_SCHED;
            PG8_LDB(B1, 0, 1); PG8_STAGE(PG8_SB(0, 0), b2, voffB);
            PG8_BAR; PG8_WAIT_L(0); PG8_MMA(0, 1, At, B1); PG8_BAR;
            PG8_LDA(At, 0, 1); PG8_STAGE(PG8_SA(0, 0), a2, voffA);
            PG8_BAR; PG8_WAIT_L(0); PG8_MMA(1, 0, At, B0); PG8_BAR; PG8_SCHED;
            PG8_STAGE(PG8_SB(0, 1), b2 + hstepB, voffB);
            PG8_WAIT_V(6); PG8_BAR; PG8_MMA(1, 1, At, B1); PG8_BAR;
            PG8_LDB(B0, 1, 0); PG8_SCHED; PG8_LDA(At, 1, 0); PG8_STAGE(PG8_SA(0, 1), a2 + hstepA, voffA);
            PG8_WAIT_L(8); PG8_BAR; PG8_WAIT_L(0); PG8_MMA(0, 0, At, B0); PG8_BAR; PG8_SCHED;
            PG8_LDB(B1, 1, 1); PG8_STAGE(PG8_SB(1, 0), b3, voffB);
            PG8_BAR; PG8_WAIT_L(0); PG8_MMA(0, 1, At, B1); PG8_BAR;
            PG8_LDA(At, 1, 1); PG8_STAGE(PG8_SA(1, 0), a3, voffA);
            PG8_BAR; PG8_WAIT_L(0); PG8_MMA(1, 0, At, B0); PG8_BAR; PG8_SCHED;
            PG8_STAGE(PG8_SB(1, 1), b3 + hstepB, voffB);
            PG8_WAIT_V(6); PG8_BAR; PG8_MMA(1, 1, At, B1); PG8_BAR;
            }
        }
        if constexpr (ALIGN_EPI) { if (wr == 0) PG8_BAR; }
        E(acc, cur, wr, wc, fr, fq); S.done(cur);
        if (!has_next) break;
#pragma unroll
        for (int a = 0; a < 2; ++a)
#pragma unroll
            for (int b = 0; b < 2; ++b)
#pragma unroll
                for (int m = 0; m < 4; ++m)
#pragma unroll
                    for (int n = 0; n < 2; ++n) acc[a][b][m][n] = (f32x4){0.f, 0.f, 0.f, 0.f};
        cur = nxt; cA = nA; cB = nB; ++ui;
        if constexpr (ALIGN_EPI) { if (wr == 1) PG8_BAR; }
    }
    PG8_WAIT_V(0);
    if constexpr (!ALIGN_EPI) { if (wr == 0) PG8_BAR; }
    PG8_BAR;
#undef PG8_SA
#undef PG8_SB
#undef PG8_STAGE
#undef PG8_LDA
#undef PG8_LDB
#undef PG8_MMA
#undef PG8_WAIT_V
#undef PG8_WAIT_L
#undef PG8_BAR
#undef PG8_SCHED
}
}

constexpr int DM = 1024;
constexpr int NTOK = 16400;
constexpr int PADL = 48;
constexpr int LPV = 16448;
constexpr int MP = 16640;
constexpr int MU = 16384;
constexpr int NCHUNK = 257;
constexpr int NHEAD = 8;
constexpr int NPROJ = 2560;
constexpr int KVROWS = 16512;
constexpr float EPS = 1e-6f;

constexpr size_t MiB = 1u << 20;
constexpr size_t WS_CTL = 0, CTL_ZERO_BYTES = 64 * 1024;
constexpr size_t WS_SSQ = 128 * 1024;
constexpr size_t WS_SSK = 512 * 1024;
constexpr size_t WS_SS4 = 14 * MiB;
constexpr size_t WS_WIN = 1 * MiB;
constexpr size_t WS_WUQ = 6 * MiB;
constexpr size_t WS_WUKV = 6 * MiB + 512 * 1024;
constexpr size_t WS_WOUT = 7 * MiB;
constexpr size_t WS_WPQ = 9 * MiB;
constexpr size_t WS_SKB = 13 * MiB;
constexpr size_t WS_IDX = 16 * MiB;
constexpr size_t WS_GATE = 24 * MiB;
constexpr size_t WS_HN = 16 * MiB;
constexpr size_t WS_QKVR = 101 * MiB;
constexpr size_t WS_Z = 150 * MiB;
constexpr size_t WS_P32 = 167 * MiB;
constexpr size_t WS_GA = 16 * MiB;
constexpr size_t WS_GQ = 33 * MiB;
constexpr size_t WS_GS = 67 * MiB;
constexpr size_t WS_GB = 84 * MiB;
constexpr size_t WS_GO = 50 * MiB;
constexpr size_t WS_MIX = 167 * MiB;
constexpr size_t WS_CQN = 200 * MiB;
constexpr size_t WS_CKVN = 208 * MiB + 512 * 1024;
constexpr size_t WS_QH = 101 * MiB;
constexpr size_t WS_KVB = 167 * MiB;
constexpr size_t WS_Q = 125 * MiB + 512 * 1024;
constexpr size_t WS_K = 220 * MiB;
constexpr size_t WS_VT = 200 * MiB;
constexpr size_t WS_XN = 32 * MiB;
constexpr size_t WS_PQ = 64 * MiB;
constexpr size_t WS_SC = 128 * MiB;
constexpr size_t WS_EU = 96 * MiB;
constexpr size_t WS_EV = 112 * MiB;
constexpr size_t WS_CW = 64 * MiB;
constexpr size_t WS_HP = 128 * MiB;
constexpr size_t WS_KPE = 217 * MiB;
constexpr size_t WS_END = 256 * MiB;
constexpr int CW_ATTQ = 8192;

constexpr int LDS_BYTES = 147456;
constexpr int MISC_OFF = 131072 + 12288;

DI unsigned f2bf(float f) { unsigned u = __builtin_bit_cast(unsigned, f); return (u + 0x7fffu + ((u >> 16) & 1u)) >> 16; }
DI unsigned pk2(float lo, float hi) { return f2bf(lo) | (f2bf(hi) << 16); }
DI float bf2f(unsigned b) { return __builtin_bit_cast(float, b << 16); }
DI float bflo(unsigned w) { return __builtin_bit_cast(float, w << 16); }
DI float bfhi(unsigned w) { return __builtin_bit_cast(float, w & 0xffff0000u); }
DI float wave_sum(float v) {
#pragma unroll
    for (int o = 1; o < 64; o <<= 1) v += __shfl_xor(v, o);
    return v;
}
DI float sigmoidf_(float x) { return 1.f / (1.f + __expf(-x)); }
DI float siluf_(float x) { return x / (1.f + __expf(-x)); }

#define XB_TMO      128
#define XB_XCNT(j)  (256  + 64 * (j))
#define XB_XSUB(j)  (1280 + 64 * (j))
#define XB_XGEN(j)  (2304 + 64 * (j))
#define XB_TOP      3328
#define XB_TOPGEN   3392
#define XCD_BAR_WORDS 3456
#define XB_SPIN_CAP (1u << 22)
DI unsigned xb_ld(unsigned* p)              { return __hip_atomic_load(p, __ATOMIC_RELAXED, __HIP_MEMORY_SCOPE_AGENT); }
DI unsigned xb_add(unsigned* p, unsigned v) { return __hip_atomic_fetch_add(p, v, __ATOMIC_RELAXED, __HIP_MEMORY_SCOPE_AGENT); }
DI unsigned xb_xcc_id() { return (unsigned)__builtin_amdgcn_s_getreg((3 << 11) | 20) & 0xFu; }
#define XB_SPIN(cond, bar) do { unsigned _sp = 0; while (cond) { __builtin_amdgcn_s_sleep(1); \
    if ((++_sp & 255u) == 0u) { if (xb_ld(&(bar)[XB_TMO])) break; if (_sp > XB_SPIN_CAP) { atomicAdd(&(bar)[XB_TMO], 1u); break; } } } } while (0)
struct XcdBarrier { unsigned* bar; unsigned x; volatile LAS unsigned* st; };
DI XcdBarrier xcd_barrier_post(unsigned* bar, volatile LAS unsigned* st) {
    XcdBarrier b; b.bar = bar; b.x = xb_xcc_id(); b.st = st;
    if (threadIdx.x == 0) (void)xb_add(&bar[XB_XCNT(b.x)], 1u);
    return b;
}
DI void xcd_barrier_complete(unsigned* bar, unsigned x, unsigned& nloc, unsigned& nx) {
    const unsigned G = gridDim.x * gridDim.y * gridDim.z;
    unsigned sum, cnt, mine, sp = 0u;
    for (;;) {
        sum = 0u; cnt = 0u; mine = 0u;
#pragma unroll
        for (unsigned j = 0; j < 16; ++j) { const unsigned c = xb_ld(&bar[XB_XCNT(j)]); sum += c; cnt += (c > 0u) ? 1u : 0u; mine = (j == x) ? c : mine; }
        if (sum == G) break;
        __builtin_amdgcn_s_sleep(1);
        if ((++sp & 255u) == 0u) { if (xb_ld(&bar[XB_TMO])) break; if (sp > XB_SPIN_CAP) { atomicAdd(&bar[XB_TMO], 1u); break; } }
    }
    nloc = mine > 0u ? mine : 1u; nx = cnt > 0u ? cnt : 1u;
}
DI void xcd_barrier(const XcdBarrier& b) {
    asm volatile("s_waitcnt vmcnt(0)" ::: "memory");
    __syncthreads();
    if (threadIdx.x == 0) {
        unsigned* bar = b.bar;
        __builtin_amdgcn_s_waitcnt(0);
        unsigned nloc = b.st[0], nx = b.st[1];
        if (nloc == 0u) { xcd_barrier_complete(bar, b.x, nloc, nx); b.st[0] = nloc; b.st[1] = nx; }
        const unsigned old = xb_add(&bar[XB_XSUB(b.x)], 1u);
        const unsigned gen = old / nloc;
        if (old + 1u == (gen + 1u) * nloc) {
            __builtin_amdgcn_fence(__ATOMIC_RELEASE, "agent");
            asm volatile("s_waitcnt vmcnt(0)" ::: "memory");
            const unsigned og = xb_add(&bar[XB_TOP], 1u);
            const unsigned tg = og / nx;
            if (og + 1u == (tg + 1u) * nx) xb_add(&bar[XB_TOPGEN], 1u);
            else XB_SPIN(xb_ld(&bar[XB_TOPGEN]) == tg, bar);
            __builtin_amdgcn_fence(__ATOMIC_ACQUIRE, "agent");
            xb_add(&bar[XB_XGEN(b.x)], 1u);
            asm volatile("s_waitcnt vmcnt(0)" ::: "memory");
        } else {
            XB_SPIN(xb_ld(&bar[XB_XGEN(b.x)]) == gen, bar);
            __builtin_amdgcn_fence(__ATOMIC_ACQUIRE, "agent");
            asm volatile("s_waitcnt vmcnt(0)" ::: "memory");
        }
    }
    __syncthreads();
}

struct Args {
    const float* in[20];
    float* out; unsigned char* ws;
    int ph_lo, ph_hi;
};
struct Frame {
    unsigned char* lds;
    int tid, lane, wave, G, gw, NGW;
};

template <class Map>
DI void transpose_item(const float* __restrict__ W, int Nsrc, bf16_t* __restrict__ WT, int ldk, float* scr, int item, int nblk, int lane, Map srcmap, const float* __restrict__ rowscale = nullptr) {
    const int kb = item / nblk, nb = item % nblk, k0 = 64 * kb, n0 = 32 * nb;
    const int ns = srcmap(n0 + (lane & 31));
    float vv[32];
#pragma unroll
    for (int i = 0; i < 32; ++i) { const int kk = 2 * i + (lane >> 5); vv[i] = (ns >= 0) ? W[(size_t)(k0 + kk) * Nsrc + ns] : 0.f; }
    if (rowscale) {
#pragma unroll
        for (int i = 0; i < 32; ++i) vv[i] *= rowscale[k0 + 2 * i + (lane >> 5)];
    }
#pragma unroll
    for (int i = 0; i < 32; ++i) { const int kk = 2 * i + (lane >> 5); scr[kk * 33 + (lane & 31)] = vv[i]; }
    __builtin_amdgcn_s_waitcnt(0); __builtin_amdgcn_wave_barrier();
    const int c = lane & 7;
#pragma unroll
    for (int j = 0; j < 4; ++j) { const int n = (lane >> 3) + 8 * j; const float* s = scr + (8 * c) * 33 + n;
        u32x4 o; o.x = pk2(s[0 * 33], s[1 * 33]); o.y = pk2(s[2 * 33], s[3 * 33]); o.z = pk2(s[4 * 33], s[5 * 33]); o.w = pk2(s[6 * 33], s[7 * 33]);
        *(u32x4*)(WT + (size_t)(n0 + n) * ldk + k0 + 8 * c) = o; }
    __builtin_amdgcn_s_waitcnt(0); __builtin_amdgcn_wave_barrier();
}
struct MapId { DI int operator()(int n) const { return n; } };
struct MapWin {
    DI int operator()(int n) const {
        if (n < 2048) return n;
        if (n < 2304) return n + 16;
        if (n < 2432) return n + 16;
        if (n < 2464) return n + 16;
        if (n < 2472) return n - 416;
        if (n < 2480) return n - 416;
        return -1;
    }
};

template <int PART> DI void p0_late_weights(const Frame& F, const Args& A, int wi, int nwv, int ti, int nth) {
    unsigned char* ws = A.ws;
    float* scr = (float*)(F.lds + F.wave * 16384);
    const float* w_uq = A.in[10]; const float* w_ukv = A.in[11]; const float* w_out = A.in[14]; const float* w_pq = A.in[16]; const float* sub_keys = A.in[17];
    constexpr int I_UQ = 4 * 24, I_UKV = 2 * 32, I_OUT = 16 * 32, I_PQ = 16 * 64;
    constexpr int NITEMS = I_UQ + I_UKV + I_OUT + I_PQ;
    const int lo_ = PART == 0 ? 0 : I_UQ + I_UKV, hi_ = PART == 0 ? I_UQ + I_UKV : NITEMS;
    for (int it = lo_ + wi; it < hi_; it += nwv) {
        int r = it;
        if (r < I_UQ) { transpose_item(w_uq, 768, (bf16_t*)(ws + WS_WUQ), 256, scr, r, 24, F.lane, MapId(), A.in[8]); continue; } r -= I_UQ;
        if (r < I_UKV) { transpose_item(w_ukv, 1024, (bf16_t*)(ws + WS_WUKV), 256, scr, r, 32, F.lane, MapId(), A.in[9]); continue; } r -= I_UKV;
        if (r < I_OUT) { transpose_item(w_out, 1024, (bf16_t*)(ws + WS_WOUT), 1024, scr, r, 32, F.lane, MapId()); continue; } r -= I_OUT;
        transpose_item(w_pq, 2048, (bf16_t*)(ws + WS_WPQ), 1024, scr, r, 64, F.lane, MapId(), A.in[15]);
    }
    const int gt = ti, NGT = nth;
    if (PART == 0) for (int i = gt; i < 1024 * 16; i += NGT) { const int n = i >> 4, c = i & 15; *(u32x4*)((bf16_t*)(ws + WS_WUKV) + (size_t)n * 256 + 128 + c * 8) = (u32x4){0u, 0u, 0u, 0u}; }
    if (PART == 1) for (int i = gt; i < 2048 * 32; i += NGT) {
        const int n = i >> 5, c8 = (i & 31) * 8; const int p = (n >> 7) & 1;
        u32x4 o = (u32x4){0u, 0u, 0u, 0u};
        if ((c8 >> 7) == p) { const float* s = sub_keys + (size_t)n * 128 + (c8 & 127); const f32x4 a = *(const f32x4*)s, b = *(const f32x4*)(s + 4);
            o.x = pk2(a.x, a.y); o.y = pk2(a.z, a.w); o.z = pk2(b.x, b.y); o.w = pk2(b.z, b.w); }
        *(u32x4*)((bf16_t*)(ws + WS_SKB) + (size_t)n * 256 + c8) = o;
    }
}

DI void p0_prologue(const Frame& F, const Args& A) {
    unsigned char* ws = A.ws;
    float* scr = (float*)(F.lds + F.wave * 16384);
    const float* w_in = A.in[3]; const float* w_uq = A.in[10]; const float* w_ukv = A.in[11]; const float* w_out = A.in[14]; const float* w_pq = A.in[16]; const float* sub_keys = A.in[17];
    constexpr int I_IN = 16 * 80;
    for (int it = F.wave * F.G + blockIdx.x; it < I_IN; it += F.NGW) transpose_item(w_in, 2480, (bf16_t*)(ws + WS_WIN), 1024, scr, it, 80, F.lane, MapWin());
    const float* x = A.in[0]; const float* meta = A.in[1]; const float* anorm = A.in[2];
    bf16_t* HN = (bf16_t*)(ws + WS_HN);
    for (int p0 = F.gw; p0 < MP; p0 += 3 * F.NGW) {
        f32x4 v[3][4]; bool ok[3];
#pragma unroll
        for (int r = 0; r < 3; ++r) {
            const int p = p0 + r * F.NGW, t = p - PADL; ok[r] = (p < MP) && t >= 0 && t < NTOK;
            if (ok[r]) { const float* src = (t < 16) ? meta + (size_t)t * DM : x + (size_t)(t - 16) * DM; const f32x4* xr = (const f32x4*)src + F.lane;
#pragma unroll
                for (int j = 0; j < 4; ++j) v[r][j] = xr[64 * j]; }
            else {
#pragma unroll
                for (int j = 0; j < 4; ++j) v[r][j] = (f32x4){0.f, 0.f, 0.f, 0.f}; }
        }
#pragma unroll
        for (int r = 0; r < 3; ++r) {
            const int p = p0 + r * F.NGW; if (p >= MP) continue;
            unsigned long long* o8 = (unsigned long long*)(HN + (size_t)p * DM) + F.lane;
            float s = 0.f;
#pragma unroll
            for (int j = 0; j < 4; ++j) s += (v[r][j].x * v[r][j].x + v[r][j].y * v[r][j].y) + (v[r][j].z * v[r][j].z + v[r][j].w * v[r][j].w);
            const float rstd = ok[r] ? 1.f / sqrtf(wave_sum(s) * (1.f / DM) + EPS) : 0.f;
#pragma unroll
            for (int j = 0; j < 4; ++j) { const f32x4 w = ((const f32x4*)anorm)[64 * j + F.lane];
                o8[64 * j] = (unsigned long long)pk2(v[r][j].x * rstd * w.x, v[r][j].y * rstd * w.y) | ((unsigned long long)pk2(v[r][j].z * rstd * w.z, v[r][j].w * rstd * w.w) << 32); }
        }
    }
}

DI void row_ss_store(const f32x4 (&v)[2][2][4][2], float* SSP, int nslot, int slot, int row0, int fq, bool bj0_only) {
#pragma unroll
    for (int ai = 0; ai < 2; ++ai)
#pragma unroll
        for (int m = 0; m < 4; ++m) {
            float s = 0.f;
#pragma unroll
            for (int bj = 0; bj < 2; ++bj) if (bj == 0 || !bj0_only)
#pragma unroll
                for (int n = 0; n < 2; ++n) { const f32x4 x = v[ai][bj][m][n]; s += (x[0] * x[0] + x[1] * x[1]) + (x[2] * x[2] + x[3] * x[3]); }
            s += __shfl_xor(s, 16); s += __shfl_xor(s, 32);
            if (fq == 0) SSP[(size_t)(row0 + ai * 128 + m * 16) * nslot + slot] = s;
        }
}
DI float ss_sum4(const float* SSP, int row) { const f32x4 a = *(const f32x4*)(SSP + (size_t)row * 4); return (a.x + a.y) + (a.z + a.w); }
DI float ss_sum16(const float* SSP, int row) { const f32x4 a = *(const f32x4*)(SSP + (size_t)row * 16), b = *(const f32x4*)(SSP + (size_t)row * 16 + 4), c = *(const f32x4*)(SSP + (size_t)row * 16 + 8), d = *(const f32x4*)(SSP + (size_t)row * 16 + 12);
    return (((a.x + a.y) + (a.z + a.w)) + ((b.x + b.y) + (b.z + b.w))) + (((c.x + c.y) + (c.z + c.w)) + ((d.x + d.y) + (d.z + d.w))); }
struct EpiProj {
    static constexpr bool PERM = true;
    bf16_t* QKVR; bf16_t* Z; float* P32; bf16_t* CQ16; bf16_t* CKV16; float* KPE; float* SSQ; float* SSK;
    DI void operator()(const f32x4 (&acc)[2][2][4][2], const pg8::Unit& u, int wr, int wc, int fr, int fq) const {
        const int row0 = u.pm * 256 + wr * 64 + fr;
        if (u.pn < 8) {
            bf16_t* base; int ld, colt;
            if (u.pn < 6) { base = QKVR; ld = 1536; colt = u.pn * 256; } else { base = Z; ld = 512; colt = (u.pn - 6) * 256; }
            const int col0 = colt + wc * 32 + 8 * fq;
#pragma unroll
            for (int ai = 0; ai < 2; ++ai)
#pragma unroll
                for (int m = 0; m < 4; ++m) { bf16_t* rowp = base + (size_t)(row0 + ai * 128 + m * 16) * ld + col0;
#pragma unroll
                    for (int bj = 0; bj < 2; ++bj) { const f32x4 v0 = acc[ai][bj][m][0], v1 = acc[ai][bj][m][1];
                        u32x4 w; w.x = pg8::cvt_pk_bf16(v0[0], v0[1]); w.y = pg8::cvt_pk_bf16(v0[2], v0[3]); w.z = pg8::cvt_pk_bf16(v1[0], v1[1]); w.w = pg8::cvt_pk_bf16(v1[2], v1[3]);
                        *(u32x4*)(rowp + bj * 128) = w; } }
        } else {
            const int lcol0 = wc * 32 + 8 * fq;
            bf16_t* b16 = (u.pn == 8) ? CQ16 : CKV16;
#pragma unroll
            for (int ai = 0; ai < 2; ++ai)
#pragma unroll
                for (int m = 0; m < 4; ++m) { const size_t row = (size_t)(row0 + ai * 128 + m * 16);
                    float* rowp = P32 + row * 512 + (u.pn - 8) * 256 + lcol0;
#pragma unroll
                    for (int bj = 0; bj < 2; ++bj) { const f32x4 v0 = acc[ai][bj][m][0], v1 = acc[ai][bj][m][1];
                        *(f32x4*)(rowp + bj * 128) = v0; *(f32x4*)(rowp + bj * 128 + 4) = v1;
                        u32x4 w; w.x = pg8::cvt_pk_bf16(v0[0], v0[1]); w.y = pg8::cvt_pk_bf16(v0[2], v0[3]); w.z = pg8::cvt_pk_bf16(v1[0], v1[1]); w.w = pg8::cvt_pk_bf16(v1[2], v1[3]);
                        *(u32x4*)(b16 + row * 256 + lcol0 + bj * 128) = w;
                        if (u.pn == 9 && bj == 1 && wc == 0) { *(f32x4*)(KPE + row * 32 + 8 * fq) = v0; *(f32x4*)(KPE + row * 32 + 8 * fq + 4) = v1; }
                    } }
            row_ss_store(acc, (u.pn == 8) ? SSQ : SSK, 4, wc, row0, fq, u.pn == 9);
        }
    }
};
struct EpiB16 {
    static constexpr bool PERM = true;
    bf16_t* O; int ldc; const float* SS; float invn; int nslot;
    DI void operator()(const f32x4 (&acc)[2][2][4][2], const pg8::Unit& u, int wr, int wc, int fr, int fq) const {
        const int row0 = u.pm * 256 + wr * 64 + fr, col0 = u.pn * 256 + wc * 32 + 8 * fq;
#pragma unroll
        for (int ai = 0; ai < 2; ++ai)
#pragma unroll
            for (int m = 0; m < 4; ++m) { const int row = row0 + ai * 128 + m * 16; bf16_t* rowp = O + (size_t)row * ldc + col0;
                const float rs = SS ? 1.f / sqrtf((nslot == 16 ? ss_sum16(SS, row) : ss_sum4(SS, row)) * invn + EPS) : 1.f;
#pragma unroll
                for (int bj = 0; bj < 2; ++bj) { const f32x4 v0 = acc[ai][bj][m][0] * rs, v1 = acc[ai][bj][m][1] * rs;
                    u32x4 w; w.x = pg8::cvt_pk_bf16(v0[0], v0[1]); w.y = pg8::cvt_pk_bf16(v0[2], v0[3]); w.z = pg8::cvt_pk_bf16(v1[0], v1[1]); w.w = pg8::cvt_pk_bf16(v1[2], v1[3]);
                    *(u32x4*)(rowp + bj * 128) = w; } }
    }
};
struct EpiH1 {
    static constexpr bool PERM = true;
    float* C; const float* res; bf16_t* H16; float* SS;
    DI void operator()(const f32x4 (&acc)[2][2][4][2], const pg8::Unit& u, int wr, int wc, int fr, int fq) const {
        const int row0 = u.pm * 256 + wr * 64 + fr, col0 = u.pn * 256 + wc * 32 + 8 * fq;
        f32x4 v[2][2][4][2];
#pragma unroll
        for (int ai = 0; ai < 2; ++ai)
#pragma unroll
            for (int m = 0; m < 4; ++m) { const size_t off = (size_t)(row0 + ai * 128 + m * 16) * 1024 + col0;
#pragma unroll
                for (int bj = 0; bj < 2; ++bj) { const f32x4 v0 = acc[ai][bj][m][0] + *(const f32x4*)(res + off + bj * 128), v1 = acc[ai][bj][m][1] + *(const f32x4*)(res + off + bj * 128 + 4);
                    v[ai][bj][m][0] = v0; v[ai][bj][m][1] = v1;
                    *(f32x4*)(C + off + bj * 128) = v0; *(f32x4*)(C + off + bj * 128 + 4) = v1;
                    u32x4 w; w.x = pg8::cvt_pk_bf16(v0[0], v0[1]); w.y = pg8::cvt_pk_bf16(v0[2], v0[3]); w.z = pg8::cvt_pk_bf16(v1[0], v1[1]); w.w = pg8::cvt_pk_bf16(v1[2], v1[3]);
                    *(u32x4*)(H16 + off + bj * 128) = w; } }
        row_ss_store(v, SS, 16, u.pn * 4 + wc, row0, fq, false);
    }
};
struct EpiF32 {
    static constexpr bool PERM = true;
    float* C; int ldc; const float* res;
    DI void operator()(const f32x4 (&acc)[2][2][4][2], const pg8::Unit& u, int wr, int wc, int fr, int fq) const {
        const int row0 = u.pm * 256 + wr * 64 + fr, col0 = u.pn * 256 + wc * 32 + 8 * fq;
#pragma unroll
        for (int ai = 0; ai < 2; ++ai)
#pragma unroll
            for (int m = 0; m < 4; ++m) { const size_t off = (size_t)(row0 + ai * 128 + m * 16) * ldc + col0;
#pragma unroll
                for (int bj = 0; bj < 2; ++bj) { f32x4 v0 = acc[ai][bj][m][0], v1 = acc[ai][bj][m][1];
                    if (res) { v0 += *(const f32x4*)(res + off + bj * 128); v1 += *(const f32x4*)(res + off + bj * 128 + 4); }
                    *(f32x4*)(C + off + bj * 128) = v0; *(f32x4*)(C + off + bj * 128 + 4) = v1; } }
    }
};

DI f32x16 mfma32(bf16x8 a, bf16x8 b, f32x16 c) { return __builtin_amdgcn_mfma_f32_32x32x16_bf16(a, b, c, 0, 0, 0); }
DI f32x4 mfma16(bf16x8 a, bf16x8 b, f32x4 c) { return __builtin_amdgcn_mfma_f32_16x16x32_bf16(a, b, c, 0, 0, 0); }
DI int crow(int r, int hi) { return (r & 3) + 8 * (r >> 2) + 4 * hi; }
DI f32x16 zero16() { f32x16 z;
#pragma unroll
    for (int i = 0; i < 16; ++i) z[i] = 0.f; return z; }

constexpr int G_KF = 0, G_VF = 16384, G_MF = 32768;
constexpr int G_QB = 50176, G_KB = 59392, G_KBB = 68608;
constexpr int G_QKB = 77824, G_UT = 87040, G_WT = 96256, G_KDT = 105472;
constexpr int G_VEC = 114688;
constexpr int G_RAW = G_QKB;
constexpr int GST = 72;

DI f32x16 mm_quad(const unsigned char* A, const unsigned char* Bt, int qr, int qc, int lane) {
    const int r32 = lane & 31, hh = lane >> 5;
    const unsigned char* ap = A + (32 * qr + r32) * (GST * 2) + hh * 16;
    const unsigned char* bp = Bt + (32 * qc + r32) * (GST * 2) + hh * 16;
    f32x16 acc = zero16();
#pragma unroll
    for (int s = 0; s < 4; ++s) acc = mfma32(*(const bf16x8*)(ap + s * 32), *(const bf16x8*)(bp + s * 32), acc);
    return acc;
}

constexpr int G_RAW2 = 115712;
static_assert(G_RAW2 + 67 * 400 <= 143360, "GDN prep LDS map");
constexpr int G_CONVW = 143360 + 512;

#ifndef PROBE_STAGE
#define PROBE_STAGE -1
#endif
template <int VAR> DI void gdn_prep_phase(const Frame& F, const Args& A) {
    unsigned long long stg_t = 0ull, stg_acc = 0ull;
#define STG(n) do { if (PROBE_STAGE >= 0) { const unsigned long long now_ = __builtin_amdgcn_s_memrealtime(); if (PROBE_STAGE == (n)) stg_acc += now_ - stg_t; stg_t = now_; } } while (0)
    unsigned char* ws = A.ws; unsigned char* lds = F.lds;
    const int tid = F.tid, lane = F.lane, wave = F.wave;
    const bf16_t* QKVR = (const bf16_t*)(ws + WS_QKVR); const float* P32 = (const float*)(ws + WS_P32);
    float* KF = (float*)(lds + G_KF); float* VF = (float*)(lds + G_VF); float* MF = (float*)(lds + G_MF);
    float* VEC = (float*)(lds + G_VEC);
    if (VAR == 6) return;
    const int NIT = NCHUNK * 8;
#define LBAR() do { asm volatile("s_waitcnt lgkmcnt(0)" ::: "memory"); __builtin_amdgcn_s_barrier(); asm volatile("" ::: "memory"); } while (0)
#define LAUNDER(dst, src) int dst = (src); asm volatile("" : "+v"(dst))
    int item = blockIdx.x;
    if (item >= NIT) return;
    u32x4 pr[4]; float nb = 0.f, na = 0.f;
    auto raw_fetch = [&](int it) {
        const int c = it >> 3, h = it & 7; LAUNDER(tl, tid);
#pragma unroll
        for (int i = 0; i < 4; ++i) { const int q = tl + 512 * i; pr[i] = (u32x4){0u, 0u, 0u, 0u};
            if (q < 67 * 24) { const int r = q / 24, cc = q % 24, seg = cc >> 3, c8 = cc & 7; const int p = 64 * c - 3 + r;
                if (p >= 0) pr[i] = *(const u32x4*)(QKVR + (size_t)p * 1536 + seg * 512 + h * 64 + c8 * 8); } }
        if (wave == 0) { const int p = 64 * c + lane; nb = P32[(size_t)p * 512 + 416 + h]; na = P32[(size_t)p * 512 + 424 + h]; }
    };
    auto raw_park = [&]() {
        LAUNDER(tl, tid);
#pragma unroll
        for (int i = 0; i < 4; ++i) { const int q = tl + 512 * i;
            if (q < 67 * 24) { const int r = q / 24, cc = q % 24, seg = cc >> 3, c8 = cc & 7; *(u32x4*)(lds + G_RAW2 + r * 400 + (seg * 64 + c8 * 8) * 2) = pr[i]; } }
    };
    raw_fetch(item); raw_park();
    float cb = nb, ca = na;
    float* CWL = (float*)(lds + G_CONVW);
    int cw_h = -1;
#pragma unroll 1
    for (; item < NIT; item += F.G) {
        if (PROBE_STAGE >= 0 && stg_t == 0ull) stg_t = __builtin_amdgcn_s_memrealtime();
        const int c = item >> 3, h = item & 7;
        if (h != cw_h) { cw_h = h;
            if (tid < 192) { LAUNDER(t0, tid); const int sg = t0 >> 6, jt = (t0 >> 4) & 3, c4 = t0 & 15; *(f32x4*)(CWL + (sg * 4 + jt) * 64 + 4 * c4) = *(const f32x4*)(A.in[4] + jt * 1536 + sg * 512 + h * 64 + 4 * c4); } }
        const int nxt = item + F.G;
        if (VAR != 5 && nxt < NIT) raw_fetch(nxt);
        if (wave == 0) {
            const int p = 64 * c + lane;
            const float alog = A.in[5][h], dtb = A.in[6][h];
            float beta = sigmoidf_(cb);
            const float xx = ca + dtb; const float sp = xx > 20.f ? xx : log1pf(__expf(xx));
            float g = -__expf(alog) * sp;
            if (p < PADL) { beta = 0.f; g = 0.f; }
            float gc = g;
#pragma unroll
            for (int o = 1; o < 64; o <<= 1) { const float t = __shfl_up(gc, o); if (lane >= o) gc += t; }
            const float glast = __shfl(gc, 63);
            VEC[lane] = gc; VEC[64 + lane] = beta; VEC[128 + lane] = __expf(gc); VEC[192 + lane] = __expf(glast - gc);
        }
        LBAR(); STG(0);
        LAUNDER(t1, tid); const int sub = t1 & 15, grp = t1 >> 4;
#pragma unroll
        for (int sg = 0; sg < ((VAR == 2 || VAR >= 4) ? 0 : 3); ++sg) {
#pragma unroll 1
            for (int ps = 0; ps < 2; ++ps) {
                const int i = grp + 32 * ps;
                float acc[4] = {0.f, 0.f, 0.f, 0.f};
#pragma unroll
                for (int jt = 0; jt < 4; ++jt) {
                    const f32x4 w = *(const f32x4*)(CWL + (sg * 4 + jt) * 64 + 4 * sub);
                    const u32x2 rv = *(const u32x2*)(lds + G_RAW2 + (i + jt) * 400 + (sg * 64 + 4 * sub) * 2);
                    acc[0] += w.x * bflo(rv.x); acc[1] += w.y * bfhi(rv.x); acc[2] += w.z * bflo(rv.y); acc[3] += w.w * bfhi(rv.y);
                }
                float y[4];
#pragma unroll
                for (int k = 0; k < 4; ++k) y[k] = siluf_(acc[k]);
                if (sg < 2) {
                    float ss = (y[0] * y[0] + y[1] * y[1]) + (y[2] * y[2] + y[3] * y[3]);
                    ss += __shfl_xor(ss, 1); ss += __shfl_xor(ss, 2); ss += __shfl_xor(ss, 4); ss += __shfl_xor(ss, 8);
                    const float rn = 1.f / sqrtf(ss + EPS);
#pragma unroll
                    for (int k = 0; k < 4; ++k) y[k] *= rn;
                }
                if (sg == 0) {
                    u32x2 o; o.x = pk2(y[0] * 0.125f, y[1] * 0.125f); o.y = pk2(y[2] * 0.125f, y[3] * 0.125f);
                    *(u32x2*)(lds + G_QB + i * (GST * 2) + 8 * sub) = o;
                } else if (sg == 1) {
                    const float beta = VEC[64 + i], ekd = VEC[192 + i];
                    *(f32x4*)(KF + i * 64 + 4 * sub) = (f32x4){y[0], y[1], y[2], y[3]};
                    u32x2 o; o.x = pk2(y[0], y[1]); o.y = pk2(y[2], y[3]);
                    *(u32x2*)(lds + G_KB + i * (GST * 2) + 8 * sub) = o;
                    o.x = pk2(y[0] * beta, y[1] * beta); o.y = pk2(y[2] * beta, y[3] * beta);
                    *(u32x2*)(lds + G_KBB + i * (GST * 2) + 8 * sub) = o;
#pragma unroll
                    for (int k = 0; k < 4; ++k) *(bf16_t*)(lds + G_KDT + (4 * sub + k) * (GST * 2) + i * 2) = (bf16_t)f2bf(y[k] * ekd);
                } else {
                    *(f32x4*)(VF + i * 64 + 4 * sub) = (f32x4){y[0], y[1], y[2], y[3]};
                }
            }
        }
        LBAR(); STG(1);
        if (VAR != 3 && VAR < 4) {
            LAUNDER(l3, lane);
            const int prod = wave >> 2, quad = wave & 3, qr = quad >> 1, qc = quad & 1, r32 = l3 & 31, hh = l3 >> 5;
            const f32x16 acc = mm_quad(lds + (prod ? G_QB : G_KBB), lds + G_KB, qr, qc, l3);
            const int j = 32 * qc + r32; const float gcj = VEC[j];
#pragma unroll
            for (int r = 0; r < 16; ++r) {
                const int i = 32 * qr + crow(r, hh);
                if (prod == 0) { MF[i * 68 + j] = (j < i) ? acc[r] * __expf(VEC[i] - gcj) : 0.f; }
                else { *(bf16_t*)(lds + G_QKB + i * (GST * 2) + j * 2) = (bf16_t)f2bf((j <= i) ? acc[r] * __expf(VEC[i] - gcj) : 0.f); }
            }
        }
        LBAR(); STG(2);
        float* DB = (float*)(lds + G_KBB);
        if (VAR != 1 && VAR < 4 && wave == 0) {
            LAUNDER(l4, lane); const int b = l4 >> 4, jc = l4 & 15;
            float d[16];
#pragma unroll
            for (int i = 0; i < 16; ++i) {
                float acc = (i == jc) ? 1.f : 0.f;
                const float* mrow = MF + (16 * b + i) * 68 + 16 * b;
#pragma unroll
                for (int k = 0; k < i; ++k) acc -= mrow[k] * d[k];
                d[i] = acc;
            }
#pragma unroll
            for (int i = 0; i < 16; ++i) DB[(b * 16 + i) * 20 + jc] = d[i];
        }
        LBAR();
        if (VAR != 1 && VAR < 4) {
            LAUNDER(l4, lane); const int cc = l4 & 15, g = l4 >> 4;
            const bool isU = wave < 4; const int col = 16 * (wave & 3) + cc;
            const float* src = (isU ? VF : KF) + col;
            f32x4 X[4];
#pragma unroll
            for (int b = 0; b < 4; ++b) {
                f32x4 acc;
#pragma unroll
                for (int r = 0; r < 4; ++r) { const int i = 16 * b + 4 * g + r; float rv = src[i * 64] * VEC[64 + i]; if (!isU) rv *= VEC[128 + i]; acc[r] = -rv; }
#pragma unroll
                for (int a = 0; a < b; ++a) {
                    const f32x4 lv = *(const f32x4*)(MF + (16 * b + cc) * 68 + 16 * a + 4 * g);
#pragma unroll
                    for (int sp = 0; sp < 4; ++sp) acc = __builtin_amdgcn_mfma_f32_16x16x4f32(lv[sp], X[a][sp], acc, 0, 0, 0);
                }
                const f32x4 dv = *(const f32x4*)(DB + (b * 16 + cc) * 20 + 4 * g);
                f32x4 xb = (f32x4){0.f, 0.f, 0.f, 0.f};
#pragma unroll
                for (int sp = 0; sp < 4; ++sp) xb = __builtin_amdgcn_mfma_f32_16x16x4f32(dv[sp], acc[sp], xb, 0, 0, 0);
                X[b] = -xb;
                unsigned char* dst = lds + (isU ? G_UT : G_WT) + col * (GST * 2) + (16 * b + 4 * g) * 2;
                *(u32x2*)dst = (u32x2){pk2(X[b][0], X[b][1]), pk2(X[b][2], X[b][3])};
            }
        }
        LBAR(); STG(3);
        if (VAR != 3 && VAR < 4) {
            const float gl = VEC[128 + 63];
            bf16_t* GB = (bf16_t*)(ws + WS_GB) + (size_t)item * 4096;
            bf16_t* GQ = (bf16_t*)(ws + (VAR ? WS_GS : WS_GQ)) + (size_t)item * 4096; bf16_t* GO = (bf16_t*)(ws + (VAR ? WS_GS : WS_GO)) + (size_t)item * 4096;
            bf16_t* GAL = (bf16_t*)(lds + G_MF);
            LAUNDER(l5, lane); const int r32 = l5 & 31, hh = l5 >> 5;
#pragma unroll 1
            for (int it = 0; it < 2; ++it) {
                const int task = wave + 8 * it, prod = task >> 2, quad = task & 3, qr = quad >> 1, qc = quad & 1;
                const f32x16 acc = mm_quad(lds + (prod < 2 ? G_KDT : G_QKB), lds + ((prod & 1) ? G_UT : G_WT), qr, qc, l5);
                const int Cc = 32 * qc + r32;
                if (prod == 0) {
#pragma unroll
                    for (int r = 0; r < 16; ++r) {
                        const int R = 32 * qr + crow(r, hh);
                        const float val = ((R == Cc) ? gl : 0.f) - acc[r];
                        const int rb = R >> 4, m = R & 15, q4 = Cc >> 4, g = (Cc >> 2) & 3, rr = Cc & 3, ks = q4 >> 1, jj = 4 * (q4 & 1) + rr, ls = 16 * g + m;
                        GAL[((rb * 2 + ks) * 64 + ls) * 8 + jj] = (bf16_t)f2bf(val);
                    }
                } else if (prod == 1) {
                    const int eslab = Cc >> 4, n = Cc & 15;
#pragma unroll
                    for (int a = 0; a < 4; ++a) {
                        const int R0 = 32 * qr + 8 * a + 4 * hh; const int rb = R0 >> 4, g = (R0 >> 2) & 3, ls = 16 * g + n;
                        *(u32x2*)(GB + ((eslab * 4 + rb) * 64 + ls) * 4) = (u32x2){pk2(acc[4 * a], acc[4 * a + 1]), pk2(acc[4 * a + 2], acc[4 * a + 3])};
                    }
                } else if (prod == 2) {
#pragma unroll
                    for (int r = 0; r < 16; ++r) {
                        const int R = 32 * qr + crow(r, hh);
                        const float qv = bf2f(*(const bf16_t*)(lds + G_QB + R * (GST * 2) + Cc * 2));
                        GQ[R * 64 + Cc] = (bf16_t)f2bf(qv * VEC[128 + R] - acc[r]);
                    }
                } else {
#pragma unroll
                    for (int r = 0; r < 16; ++r) GO[(quad * 16 + r) * 64 + l5] = (bf16_t)f2bf(acc[r]);
                }
            }
        }
        if (VAR != 5 && nxt < NIT) { raw_park(); cb = nb; ca = na; }
        LBAR(); STG(4);
        if (VAR != 5) { LAUNDER(t6, tid); *(u32x4*)((bf16_t*)(ws + (VAR ? WS_GS : WS_GA)) + (size_t)item * 4096 + t6 * 8) = *(const u32x4*)(lds + G_MF + t6 * 16); }
        STG(5);
    }
    if (PROBE_STAGE >= 0 && tid == 0) { *(unsigned long long*)(lds + 143360 + 96) = stg_acc; }
}

constexpr int SC_D = 8, SC_PD = 6, SC_SLOT = 10240;
DI void gdn_scan(const Frame& F, const Args& A) {
    if (blockIdx.x >= 32) return;
    unsigned char* ws = A.ws;
    const int h = blockIdx.x & 7, eslab = blockIdx.x >> 3, lane = F.lane, wave = F.wave, n = lane & 15, g = lane >> 4;
    const unsigned char* GA = ws + WS_GA; const unsigned char* GB = ws + WS_GB; bf16_t* GS = (bf16_t*)(ws + WS_GS);
    LAS unsigned char* ring = (LAS unsigned char*)F.lds;
    const int np = (wave == 0) ? 0 : ((wave - 1 < 3) ? 2 : 1);
    auto issue = [&](int c) {
        const int cc = c < NCHUNK ? c : NCHUNK - 1;
        const size_t item = (size_t)cc * 8 + h;
        LAS unsigned char* slot = ring + (c % SC_D) * SC_SLOT;
#pragma unroll
        for (int i = 0; i < 2; ++i) if (i < np) {
            const int q = (wave - 1) + 7 * i;
            const unsigned char* src = (q < 8) ? GA + item * 8192 + q * 1024 : GB + item * 8192 + eslab * 2048 + (q - 8) * 1024;
            LAS unsigned char* dst = slot + ((q < 8) ? q * 1024 : 8192 + (q - 8) * 1024);
            __builtin_amdgcn_global_load_lds((const unsigned*)(src + lane * 16), (LAS unsigned*)dst, 16, 0, 0);
        }
    };
    for (int c = 0; c < SC_PD; ++c) issue(c);
    f32x4 S[4];
#pragma unroll
    for (int rb = 0; rb < 4; ++rb) S[rb] = (f32x4){0.f, 0.f, 0.f, 0.f};
#pragma unroll 1
    for (int c = 0; c < NCHUNK; ++c) {
        issue(c + SC_PD);
        if (np == 2) asm volatile("s_waitcnt vmcnt(12)" ::: "memory");
        else if (np == 1) asm volatile("s_waitcnt vmcnt(6)" ::: "memory");
        asm volatile("s_waitcnt lgkmcnt(0)" ::: "memory");
        __builtin_amdgcn_s_barrier();
        asm volatile("" ::: "memory");
        if (wave == 0) {
            const LAS unsigned char* slot = ring + (c % SC_D) * SC_SLOT;
            bf16x8 ac[8]; f32x4 bc[4];
#pragma unroll
            for (int q = 0; q < 8; ++q) ac[q] = *(const LAS bf16x8*)(slot + q * 1024 + lane * 16);
#pragma unroll
            for (int rb = 0; rb < 4; ++rb) { const u32x2 w = *(const LAS u32x2*)(slot + 8192 + rb * 512 + lane * 8); bc[rb] = (f32x4){bflo(w.x), bfhi(w.x), bflo(w.y), bfhi(w.y)}; }
            const size_t item = (size_t)c * 8 + h;
            u32x4 p0, p1;
            p0.x = pk2(S[0][0], S[0][1]); p0.y = pk2(S[0][2], S[0][3]); p0.z = pk2(S[1][0], S[1][1]); p0.w = pk2(S[1][2], S[1][3]);
            p1.x = pk2(S[2][0], S[2][1]); p1.y = pk2(S[2][2], S[2][3]); p1.z = pk2(S[3][0], S[3][1]); p1.w = pk2(S[3][2], S[3][3]);
            {
                bf16_t* st = GS + item * 4096 + (16 * eslab + n) * 64 + 4 * g;
                *(u32x2*)(st + 0) = (u32x2){p0.x, p0.y}; *(u32x2*)(st + 16) = (u32x2){p0.z, p0.w};
                *(u32x2*)(st + 32) = (u32x2){p1.x, p1.y}; *(u32x2*)(st + 48) = (u32x2){p1.z, p1.w};
            }
            const bf16x8 b0 = __builtin_bit_cast(bf16x8, p0), b1 = __builtin_bit_cast(bf16x8, p1);
#pragma unroll
            for (int rb = 0; rb < 4; ++rb) {
                f32x4 acc = bc[rb];
                acc = mfma16(ac[rb * 2 + 0], b0, acc);
                acc = mfma16(ac[rb * 2 + 1], b1, acc);
                S[rb] = acc;
            }
        }
    }
    asm volatile("s_waitcnt vmcnt(0) lgkmcnt(0)" ::: "memory");
    __builtin_amdgcn_s_barrier();
}

DI void gdn_out_task(const Frame& F, const Args& A, int task) {
    unsigned char* ws = A.ws;
    const int ihalf = task & 1, item = (task >> 1) + 8, c = item >> 3, h = item & 7, lane = F.lane, r32 = lane & 31, hh = lane >> 5;
    const bf16_t* GQ = (const bf16_t*)(ws + WS_GQ) + (size_t)item * 4096; const bf16_t* GS = (const bf16_t*)(ws + WS_GS) + (size_t)item * 4096;
    const bf16_t* GO = (const bf16_t*)(ws + WS_GO) + (size_t)item * 4096;
    const bf16_t* Z = (const bf16_t*)(ws + WS_Z); bf16_t* MIX = (bf16_t*)(ws + WS_MIX);
    f32x16 acc[2];
#pragma unroll
    for (int eh = 0; eh < 2; ++eh)
#pragma unroll
        for (int r = 0; r < 16; ++r) acc[eh][r] = bf2f(GO[((ihalf * 2 + eh) * 16 + r) * 64 + lane]);
#pragma unroll
    for (int s = 0; s < 4; ++s) {
        const bf16x8 a = *(const bf16x8*)(GQ + (32 * ihalf + r32) * 64 + 16 * s + 8 * hh);
#pragma unroll
        for (int eh = 0; eh < 2; ++eh) {
            const bf16x8 b = *(const bf16x8*)(GS + (32 * eh + r32) * 64 + 16 * s + 8 * hh);
            acc[eh] = mfma32(a, b, acc[eh]);
        }
    }
    const float* gnorm = A.in[7];
    const float w0 = gnorm[r32], w1 = gnorm[32 + r32];
#pragma unroll
    for (int r = 0; r < 16; ++r) {
        float ss = acc[0][r] * acc[0][r] + acc[1][r] * acc[1][r];
        ss += __shfl_xor(ss, 1); ss += __shfl_xor(ss, 2); ss += __shfl_xor(ss, 4); ss += __shfl_xor(ss, 8); ss += __shfl_xor(ss, 16);
        const float rstd = 1.f / sqrtf(ss * (1.f / 64.f) + EPS);
        const int i = 32 * ihalf + crow(r, hh); const int p = 64 * c + i;
        const float z0 = bf2f(Z[(size_t)p * 512 + h * 64 + r32]), z1 = bf2f(Z[(size_t)p * 512 + h * 64 + 32 + r32]);
        bf16_t* o = MIX + (size_t)(p - 64) * 1024 + h * 64;
        o[r32] = (bf16_t)f2bf(acc[0][r] * rstd * w0 * siluf_(z0));
        o[32 + r32] = (bf16_t)f2bf(acc[1][r] * rstd * w1 * siluf_(z1));
    }
}

DI void mla_prep1_rows(const Frame& F, const Args& A, int p0, int stride) {
    unsigned char* ws = A.ws; const int lane = F.lane;
    f32x4 q[4]; float k0[4], k1[4], pe[4];
#pragma unroll
    for (int r = 0; r < 4; ++r) { const int p = p0 + r * stride; const int pc = p < MP ? p : MP - 1;
        const float* P32 = (const float*)(ws + WS_P32) + (size_t)pc * 512;
        q[r] = *(const f32x4*)(P32 + 4 * lane); k0[r] = P32[256 + 2 * lane]; k1[r] = P32[256 + 2 * lane + 1]; pe[r] = P32[384 + (lane & 31)]; }
    const f32x4 wq = *(const f32x4*)(A.in[8] + 4 * lane);
    const float wk0 = A.in[9][2 * lane], wk1 = A.in[9][2 * lane + 1];
#pragma unroll
    for (int r = 0; r < 4; ++r) {
        const int p = p0 + r * stride; if (p >= MP) continue;
        bf16_t* CQN = (bf16_t*)(ws + WS_CQN) + (size_t)p * 256; bf16_t* CKVN = (bf16_t*)(ws + WS_CKVN) + (size_t)p * 256;
        const float sq = wave_sum((q[r].x * q[r].x + q[r].y * q[r].y) + (q[r].z * q[r].z + q[r].w * q[r].w));
        const float rq = 1.f / sqrtf(sq * (1.f / 256.f) + EPS);
        *(u32x2*)(CQN + 4 * lane) = (u32x2){pk2(q[r].x * rq * wq.x, q[r].y * rq * wq.y), pk2(q[r].z * rq * wq.z, q[r].w * rq * wq.w)};
        const float sk = wave_sum(k0[r] * k0[r] + k1[r] * k1[r]);
        const float rk = 1.f / sqrtf(sk * (1.f / 128.f) + EPS);
        *(unsigned*)(CKVN + 2 * lane) = pk2(k0[r] * rk * wk0, k1[r] * rk * wk1);
        *(unsigned*)(CKVN + 128 + 2 * lane) = 0u;
        if (lane < 32) ((float*)(ws + WS_KPE))[(size_t)p * 32 + lane] = pe[r];
    }
}

constexpr float QSCALE = 0.10206207261596577f * 1.4426950408889634f;
DI double rope_inv_rev(int i) {
    const double t8[8] = {0.15915494309189535, 0.08949940160889101, 0.050329212104487035, 0.0283021958306234, 0.015915494309189534, 0.008949940160889102, 0.005032921210448704, 0.00283021958306234};
    double v = t8[0];
#pragma unroll
    for (int k = 1; k < 8; ++k) v = ((i & 7) == k) ? t8[k] : v;
    return (i & 8) ? v * 0.01 : v;
}
constexpr int P2_TS = 136;
constexpr int P2_RS = 272;
#define P2_WSYNC() do { __builtin_amdgcn_s_waitcnt(0); __builtin_amdgcn_wave_barrier(); } while (0)
DI void mla_prep2_task(const Frame& F, const Args& A, int task) {
    unsigned char* ws = A.ws; int lane = F.lane; asm volatile("" : "+v"(lane));
    const int h = task & 7, blk = task >> 3;
    const int p = 64 * blk + lane;
    const bool valid = (p >= PADL) && (p < LPV);
    const float* qn = A.in[12]; const float* kn = A.in[13];
    unsigned char* TS = F.lds + F.wave * (64 * P2_RS);
    unsigned char* trow = TS + lane * P2_RS;
    const double pos = (double)(p - PADL);
    auto rot = [&](int i, float& sn_, float& cs_) { const double rev = pos * rope_inv_rev(i); const float fr = (float)(rev - floor(rev)); sn_ = __builtin_amdgcn_sinf(fr); cs_ = __builtin_amdgcn_cosf(fr); };
    {
        {
            const bf16_t* srcb = (const bf16_t*)(ws + WS_QH) + (size_t)(64 * blk) * 768 + h * 96;
            u32x4 t[12];
#pragma unroll
            for (int i = 0; i < 12; ++i) { const int c = 64 * i + lane, r = c / 12, pc = c % 12; t[i] = *(const u32x4*)(srcb + (size_t)r * 768 + 8 * pc); }
#pragma unroll
            for (int i = 0; i < 12; ++i) { const int c = 64 * i + lane, r = c / 12, pc = c % 12; *(u32x4*)(TS + r * P2_RS + 16 * pc) = t[i]; }
            P2_WSYNC();
        }
        u32x4 w[12];
#pragma unroll
        for (int c = 0; c < 12; ++c) w[c] = *(const u32x4*)(trow + 16 * c);
        float ss = 0.f;
#pragma unroll
        for (int c = 0; c < 12; ++c) { const float a0 = bflo(w[c].x), a1 = bfhi(w[c].x), a2 = bflo(w[c].y), a3 = bfhi(w[c].y), a4 = bflo(w[c].z), a5 = bfhi(w[c].z), a6 = bflo(w[c].w), a7 = bfhi(w[c].w);
            ss += (a0 * a0 + a1 * a1) + (a2 * a2 + a3 * a3) + (a4 * a4 + a5 * a5) + (a6 * a6 + a7 * a7); }
        const float rs = valid ? QSCALE / sqrtf(ss * (1.f / 96.f) + EPS) : 0.f;
        unsigned char* dst = trow;
#pragma unroll
        for (int c = 0; c < 8; ++c) {
            const f32x4 g0 = *(const f32x4*)(qn + 8 * c), g1 = *(const f32x4*)(qn + 8 * c + 4);
            *(u32x4*)(dst + 16 * c) = (u32x4){pk2(bflo(w[c].x) * rs * g0.x, bfhi(w[c].x) * rs * g0.y), pk2(bflo(w[c].y) * rs * g0.z, bfhi(w[c].y) * rs * g0.w),
                                              pk2(bflo(w[c].z) * rs * g1.x, bfhi(w[c].z) * rs * g1.y), pk2(bflo(w[c].w) * rs * g1.z, bfhi(w[c].w) * rs * g1.w)};
        }
#pragma unroll
        for (int c = 0; c < 2; ++c) {
            float x1[8], x2[8];
            const u32x4 wa = w[8 + c], wb = w[10 + c];
            x1[0] = bflo(wa.x); x1[1] = bfhi(wa.x); x1[2] = bflo(wa.y); x1[3] = bfhi(wa.y); x1[4] = bflo(wa.z); x1[5] = bfhi(wa.z); x1[6] = bflo(wa.w); x1[7] = bfhi(wa.w);
            x2[0] = bflo(wb.x); x2[1] = bfhi(wb.x); x2[2] = bflo(wb.y); x2[3] = bfhi(wb.y); x2[4] = bflo(wb.z); x2[5] = bfhi(wb.z); x2[6] = bflo(wb.w); x2[7] = bfhi(wb.w);
            float o1[8], o2[8];
#pragma unroll
            for (int t = 0; t < 8; ++t) { float sn_, cs_; rot(8 * c + t, sn_, cs_); const float a = x1[t] * rs * qn[64 + 8 * c + t], b = x2[t] * rs * qn[80 + 8 * c + t]; o1[t] = a * cs_ - b * sn_; o2[t] = b * cs_ + a * sn_; }
            *(u32x4*)(dst + 2 * (64 + 8 * c)) = (u32x4){pk2(o1[0], o1[1]), pk2(o1[2], o1[3]), pk2(o1[4], o1[5]), pk2(o1[6], o1[7])};
            *(u32x4*)(dst + 2 * (80 + 8 * c)) = (u32x4){pk2(o2[0], o2[1]), pk2(o2[2], o2[3]), pk2(o2[4], o2[5]), pk2(o2[6], o2[7])};
        }
        P2_WSYNC();
        {
            unsigned char* outb = (unsigned char*)((bf16_t*)(ws + WS_Q) + ((size_t)h * KVROWS + 64 * blk) * 96);
            u32x4 t[12];
#pragma unroll
            for (int i = 0; i < 12; ++i) { const int c = 64 * i + lane, r = c / 12, pc = c % 12; t[i] = *(const u32x4*)(TS + r * P2_RS + 16 * pc); }
#pragma unroll
            for (int i = 0; i < 12; ++i) *(u32x4*)(outb + (size_t)(64 * i + lane) * 16) = t[i];
            P2_WSYNC();
        }
    }
    {
        {
            const bf16_t* srcb = (const bf16_t*)(ws + WS_KVB) + (size_t)(64 * blk) * 1024 + h * 128;
            const unsigned char* kpb = (const unsigned char*)((const float*)(ws + WS_KPE) + (size_t)(64 * blk) * 32);
            u32x4 t[8], e8[8];
#pragma unroll
            for (int i = 0; i < 8; ++i) { const int c = 64 * i + lane, r = c >> 3, pc = c & 7; t[i] = *(const u32x4*)(srcb + (size_t)r * 1024 + 8 * pc); e8[i] = *(const u32x4*)(kpb + (size_t)c * 16); }
#pragma unroll
            for (int i = 0; i < 8; ++i) { const int c = 64 * i + lane, r = c >> 3, pc = c & 7; *(u32x4*)(TS + r * P2_RS + 16 * pc) = t[i]; *(u32x4*)(TS + r * P2_RS + 128 + 16 * pc) = e8[i]; }
            P2_WSYNC();
        }
        u32x4 w[8]; f32x4 e[8];
#pragma unroll
        for (int c = 0; c < 8; ++c) { w[c] = *(const u32x4*)(trow + 16 * c); e[c] = *(const f32x4*)(trow + 128 + 16 * c); }
        float ss = 0.f;
#pragma unroll
        for (int c = 0; c < 8; ++c) { const float a0 = bflo(w[c].x), a1 = bfhi(w[c].x), a2 = bflo(w[c].y), a3 = bfhi(w[c].y), a4 = bflo(w[c].z), a5 = bfhi(w[c].z), a6 = bflo(w[c].w), a7 = bfhi(w[c].w);
            ss += (a0 * a0 + a1 * a1) + (a2 * a2 + a3 * a3) + (a4 * a4 + a5 * a5) + (a6 * a6 + a7 * a7);
            ss += (e[c].x * e[c].x + e[c].y * e[c].y) + (e[c].z * e[c].z + e[c].w * e[c].w); }
        const float rs = valid ? 1.f / sqrtf(ss * (1.f / 96.f) + EPS) : 0.f;
        unsigned char* dst = trow;
#pragma unroll
        for (int c = 0; c < 8; ++c) {
            const f32x4 g0 = *(const f32x4*)(kn + 8 * c), g1 = *(const f32x4*)(kn + 8 * c + 4);
            *(u32x4*)(dst + 16 * c) = (u32x4){pk2(bflo(w[c].x) * rs * g0.x, bfhi(w[c].x) * rs * g0.y), pk2(bflo(w[c].y) * rs * g0.z, bfhi(w[c].y) * rs * g0.w),
                                              pk2(bflo(w[c].z) * rs * g1.x, bfhi(w[c].z) * rs * g1.y), pk2(bflo(w[c].w) * rs * g1.z, bfhi(w[c].w) * rs * g1.w)};
        }
#pragma unroll
        for (int c = 0; c < 2; ++c) {
            const float x1[8] = {e[2 * c].x, e[2 * c].y, e[2 * c].z, e[2 * c].w, e[2 * c + 1].x, e[2 * c + 1].y, e[2 * c + 1].z, e[2 * c + 1].w};
            const float x2[8] = {e[4 + 2 * c].x, e[4 + 2 * c].y, e[4 + 2 * c].z, e[4 + 2 * c].w, e[5 + 2 * c].x, e[5 + 2 * c].y, e[5 + 2 * c].z, e[5 + 2 * c].w};
            float o1[8], o2[8];
#pragma unroll
            for (int t = 0; t < 8; ++t) { float sn_, cs_; rot(8 * c + t, sn_, cs_); const float a = x1[t] * rs * kn[64 + 8 * c + t], b = x2[t] * rs * kn[80 + 8 * c + t]; o1[t] = a * cs_ - b * sn_; o2[t] = b * cs_ + a * sn_; }
            *(u32x4*)(dst + 2 * (64 + 8 * c)) = (u32x4){pk2(o1[0], o1[1]), pk2(o1[2], o1[3]), pk2(o1[4], o1[5]), pk2(o1[6], o1[7])};
            *(u32x4*)(dst + 2 * (80 + 8 * c)) = (u32x4){pk2(o2[0], o2[1]), pk2(o2[2], o2[3]), pk2(o2[4], o2[5]), pk2(o2[6], o2[7])};
        }
        P2_WSYNC();
        {
            unsigned char* outb = (unsigned char*)((bf16_t*)(ws + WS_K) + ((size_t)h * KVROWS + 64 * blk) * 96);
            u32x4 t[12];
#pragma unroll
            for (int i = 0; i < 12; ++i) { const int c = 64 * i + lane, r = c / 12, pc = c % 12; t[i] = *(const u32x4*)(TS + r * P2_RS + 16 * pc); }
#pragma unroll
            for (int i = 0; i < 12; ++i) *(u32x4*)(outb + (size_t)(64 * i + lane) * 16) = t[i];
            P2_WSYNC();
        }
    }
    {
        unsigned char* T = TS;
        const bf16_t* src = (const bf16_t*)(ws + WS_KVB) + h * 128 + 64;
#pragma unroll
        for (int it = 0; it < 8; ++it) {
            const int pr = 8 * it + (lane >> 3), ch = lane & 7; const int pp = 64 * blk + pr;
            u32x4 v = (u32x4){0u, 0u, 0u, 0u};
            if (pp >= PADL && pp < LPV) v = *(const u32x4*)(src + (size_t)pp * 1024 + 8 * ch);
            unsigned char* tp = T + (8 * ch) * P2_TS + pr * 2;
            *(bf16_t*)(tp + 0 * P2_TS) = (bf16_t)(v.x & 0xffffu); *(bf16_t*)(tp + 1 * P2_TS) = (bf16_t)(v.x >> 16);
            *(bf16_t*)(tp + 2 * P2_TS) = (bf16_t)(v.y & 0xffffu); *(bf16_t*)(tp + 3 * P2_TS) = (bf16_t)(v.y >> 16);
            *(bf16_t*)(tp + 4 * P2_TS) = (bf16_t)(v.z & 0xffffu); *(bf16_t*)(tp + 5 * P2_TS) = (bf16_t)(v.z >> 16);
            *(bf16_t*)(tp + 6 * P2_TS) = (bf16_t)(v.w & 0xffffu); *(bf16_t*)(tp + 7 * P2_TS) = (bf16_t)(v.w >> 16);
        }
        __builtin_amdgcn_s_waitcnt(0); __builtin_amdgcn_wave_barrier();
        bf16_t* VT = (bf16_t*)(ws + WS_VT) + (size_t)h * 64 * KVROWS + 64 * blk;
#pragma unroll
        for (int it = 0; it < 8; ++it) {
            const int e = 8 * it + (lane >> 3), ch = lane & 7;
            const u32x2 lo = *(const u32x2*)(T + e * P2_TS + 16 * ch), hi = *(const u32x2*)(T + e * P2_TS + 16 * ch + 8);
            *(u32x4*)(VT + (size_t)e * KVROWS + 8 * ch) = (u32x4){lo.x, lo.y, hi.x, hi.y};
        }
        __builtin_amdgcn_s_waitcnt(0); __builtin_amdgcn_wave_barrier();
    }
}

constexpr int A_KSTR = 208;
constexpr int A_VSTR = 136;
constexpr int A_KBYTES = 64 * A_KSTR;
constexpr int A_VBYTES = 64 * A_VSTR;
constexpr int A_BUF = A_KBYTES + A_VBYTES;
DI unsigned cvtpk_s(float lo, float hi) { typedef float f2 __attribute__((ext_vector_type(2))); typedef __bf16 b2 __attribute__((ext_vector_type(2))); f2 v = {lo, hi}; b2 b = __builtin_convertvector(v, b2); return __builtin_bit_cast(unsigned, b); }

DI void attn_item(const Frame& F, const Args& A, int h, int qb) {
    unsigned char* ws = A.ws; unsigned char* lds = F.lds;
    const int tid = F.tid, lane = F.lane, wave = F.wave, r32 = lane & 31, hh = lane >> 5;
    const bf16_t* Qg = (const bf16_t*)(ws + WS_Q) + (size_t)h * KVROWS * 96;
    const bf16_t* Kg = (const bf16_t*)(ws + WS_K) + (size_t)h * KVROWS * 96;
    const bf16_t* Vg = (const bf16_t*)(ws + WS_VT) + (size_t)h * 64 * KVROWS;
    const int p0w = 64 + 256 * qb + 32 * wave;
    const int qp = p0w + r32;
    const int ntile = 4 * qb + 5;
    const int mylast = 1 + 4 * qb + (wave >> 1);
    bf16x8 qf[6];
#pragma unroll
    for (int s = 0; s < 6; ++s) qf[s] = *(const bf16x8*)(Qg + (size_t)qp * 96 + 16 * s + 8 * hh);
    f32x16 ot[2]; ot[0] = zero16(); ot[1] = zero16();
    float mrun = -1e30f, lrun = 0.f;
    const int kr0 = tid / 12, kc0 = tid % 12, kr1 = (tid + 512) / 12, kc1 = (tid + 512) % 12; const bool k1ok = tid < 256;
    const int vr = tid >> 3, vc = tid & 7;
    struct Stg { u32x4 k0, k1, v; };
    Stg sA, sB;
    auto gload = [&](Stg& st, int j) {
        const int kv0 = 64 * j;
        st.k0 = *(const u32x4*)(Kg + (size_t)(kv0 + kr0) * 96 + kc0 * 8);
        if (k1ok) st.k1 = *(const u32x4*)(Kg + (size_t)(kv0 + kr1) * 96 + kc1 * 8);
        st.v = *(const u32x4*)(Vg + (size_t)vr * KVROWS + kv0 + vc * 8);
    };
    auto lstore = [&](const Stg& st, int b) {
        unsigned char* kb = lds + b * A_BUF; unsigned char* vb = kb + A_KBYTES;
        *(u32x4*)(kb + kr0 * A_KSTR + kc0 * 16) = st.k0;
        if (k1ok) *(u32x4*)(kb + kr1 * A_KSTR + kc1 * 16) = st.k1;
        *(u32x2*)(vb + vr * A_VSTR + vc * 16) = (u32x2){st.v.x, st.v.y};
        *(u32x2*)(vb + vr * A_VSTR + vc * 16 + 8) = (u32x2){st.v.z, st.v.w};
    };
    gload(sA, 0); lstore(sA, 0); gload(sB, 1);
    __syncthreads();
    auto step = [&](int j, Stg& sNext  , Stg& sFree  ) {
        const int b = j & 1;
        if (j + 2 < ntile) gload(sFree, j + 2);
        if (j <= mylast) {
            const unsigned char* kb = lds + b * A_BUF; const unsigned char* vb = kb + A_KBYTES;
            f32x16 sc[2];
#pragma unroll
            for (int kh = 0; kh < 2; ++kh) {
                f32x16 acc = zero16();
                const unsigned char* kp = kb + (32 * kh + r32) * A_KSTR + hh * 16;
#pragma unroll
                for (int s = 0; s < 6; ++s) acc = mfma32(*(const bf16x8*)(kp + s * 32), qf[s], acc);
                sc[kh] = acc;
            }
            if (j == 0) {
#pragma unroll
                for (int kh = 0; kh < 2; ++kh)
#pragma unroll
                    for (int r = 0; r < 16; ++r) { const int kv = 32 * kh + crow(r, hh); if (kv < PADL) sc[kh][r] = -INFINITY; }
            }
            if (j == mylast) {
#pragma unroll
                for (int kh = 0; kh < 2; ++kh)
#pragma unroll
                    for (int r = 0; r < 16; ++r) { const int kv = 64 * j + 32 * kh + crow(r, hh); if (kv > qp) sc[kh][r] = -INFINITY; }
            }
            float mx = sc[0][0];
#pragma unroll
            for (int r = 1; r < 16; ++r) mx = fmaxf(mx, sc[0][r]);
#pragma unroll
            for (int r = 0; r < 16; ++r) mx = fmaxf(mx, sc[1][r]);
            mx = fmaxf(mx, __shfl_xor(mx, 32));
            const float mnew = fmaxf(mrun, mx);
            const float alpha = __builtin_amdgcn_exp2f(mrun - mnew);
            mrun = mnew;
            float ps = 0.f;
#pragma unroll
            for (int kh = 0; kh < 2; ++kh)
#pragma unroll
                for (int r = 0; r < 16; ++r) { const float e = __builtin_amdgcn_exp2f(sc[kh][r] - mnew); sc[kh][r] = e; ps += e; }
            lrun = lrun * alpha + ps;
#pragma unroll
            for (int eh = 0; eh < 2; ++eh)
#pragma unroll
                for (int r = 0; r < 16; ++r) ot[eh][r] *= alpha;
#pragma unroll
            for (int kh = 0; kh < 2; ++kh)
#pragma unroll
                for (int s2 = 0; s2 < 2; ++s2) {
                    u32x4 pw; pw.x = cvtpk_s(sc[kh][8 * s2 + 0], sc[kh][8 * s2 + 1]); pw.y = cvtpk_s(sc[kh][8 * s2 + 2], sc[kh][8 * s2 + 3]);
                    pw.z = cvtpk_s(sc[kh][8 * s2 + 4], sc[kh][8 * s2 + 5]); pw.w = cvtpk_s(sc[kh][8 * s2 + 6], sc[kh][8 * s2 + 7]);
                    const bf16x8 pf = __builtin_bit_cast(bf16x8, pw);
#pragma unroll
                    for (int eh = 0; eh < 2; ++eh) {
                        const unsigned char* vp = vb + (32 * eh + r32) * A_VSTR + (32 * kh + 16 * s2 + 4 * hh) * 2;
                        const u32x2 lo = *(const u32x2*)vp, hi2 = *(const u32x2*)(vp + 16);
                        const bf16x8 vf = __builtin_bit_cast(bf16x8, (u32x4){lo.x, lo.y, hi2.x, hi2.y});
                        ot[eh] = mfma32(vf, pf, ot[eh]);
                    }
                }
        }
        if (j + 1 < ntile) lstore(sNext, b ^ 1);
        __syncthreads();
    };
#pragma unroll 1
    for (int j = 0; j < ntile; j += 2) {
        step(j, sB, sA);
        if (j + 1 < ntile) step(j + 1, sA, sB);
    }
    const float ltot = lrun + __shfl_xor(lrun, 32);
    const float rl = 1.f / ltot;
    bf16_t* o = (bf16_t*)(ws + WS_MIX) + (size_t)(qp - 64) * 1024 + 512 + h * 64;
#pragma unroll
    for (int eh = 0; eh < 2; ++eh)
#pragma unroll
        for (int a = 0; a < 4; ++a) {
            const int e = 32 * eh + 8 * a + 4 * hh;
            *(u32x2*)(o + e) = (u32x2){pk2(ot[eh][4 * a] * rl, ot[eh][4 * a + 1] * rl), pk2(ot[eh][4 * a + 2] * rl, ot[eh][4 * a + 3] * rl)};
        }
}

DI void xn_rows(const Frame& F, const Args& A, int u0, int stride) {
    f32x4 v[2][4];
#pragma unroll
    for (int r = 0; r < 2; ++r) { const int u = u0 + r * stride; if (u < MU) { const f32x4* xr = (const f32x4*)(A.out + (size_t)u * DM) + F.lane;
#pragma unroll
        for (int j = 0; j < 4; ++j) v[r][j] = xr[64 * j]; } }
#pragma unroll
    for (int r = 0; r < 2; ++r) {
        const int u = u0 + r * stride; if (u >= MU) continue;
        float s = 0.f;
#pragma unroll
        for (int j = 0; j < 4; ++j) s += (v[r][j].x * v[r][j].x + v[r][j].y * v[r][j].y) + (v[r][j].z * v[r][j].z + v[r][j].w * v[r][j].w);
        const float rstd = 1.f / sqrtf(wave_sum(s) * (1.f / DM) + EPS);
        unsigned long long* o8 = (unsigned long long*)((bf16_t*)(A.ws + WS_XN) + (size_t)u * DM) + F.lane;
#pragma unroll
        for (int j = 0; j < 4; ++j) { const f32x4 w = ((const f32x4*)A.in[15])[64 * j + F.lane];
            o8[64 * j] = (unsigned long long)pk2(v[r][j].x * rstd * w.x, v[r][j].y * rstd * w.y) | ((unsigned long long)pk2(v[r][j].z * rstd * w.z, v[r][j].w * rstd * w.w) << 32); }
    }
}

DI unsigned fkey(float v, int idx) { unsigned u = __builtin_bit_cast(unsigned, v); u = (u & 0x80000000u) ? ~u : (u | 0x80000000u); return (u & ~127u) | (unsigned)(127 - idx); }
DI float keyval(unsigned k) { unsigned u = k & ~127u; u = (u & 0x80000000u) ? (u & 0x7fffffffu) : ~u; return __builtin_bit_cast(float, u); }

__device__ const unsigned char PAIR_A[50] = {0,0,0,0,0,0,0,0,0,0,0,0,0,0,0,0, 1,1,1,1,1,1,1,1, 2,2,2,2,2, 3,3,3,3, 4,4,4, 5,5, 6,6, 7,7, 8,9,10,11,12,13,14,15};
__device__ const unsigned char PAIR_B[50] = {0,1,2,3,4,5,6,7,8,9,10,11,12,13,14,15, 0,1,2,3,4,5,6,7, 0,1,2,3,4, 0,1,2,3, 0,1,2, 0,1, 0,1, 0,1, 0,0,0,0,0,0,0,0};

DI void ce_desc(unsigned& a, unsigned& b) { const unsigned mx = a > b ? a : b, mn = a > b ? b : a; a = mx; b = mn; }
template <int BASE, int NK> DI void bitonic_sort16_desc(unsigned (&x)[NK]) {
#pragma unroll
    for (int k = 2; k <= 16; k <<= 1)
#pragma unroll
        for (int j = k >> 1; j > 0; j >>= 1)
#pragma unroll
            for (int i = 0; i < 16; ++i) { const int l = i ^ j; if (l > i) { if ((i & k) == 0) ce_desc(x[BASE + i], x[BASE + l]); else ce_desc(x[BASE + l], x[BASE + i]); } }
}
template <int A0, int B0, int NK> DI void merge_top16(unsigned (&x)[NK]) {
#pragma unroll
    for (int i = 0; i < 16; ++i) { const unsigned p = x[A0 + i], q = x[B0 + 15 - i]; x[A0 + i] = p > q ? p : q; }
#pragma unroll
    for (int j = 8; j > 0; j >>= 1)
#pragma unroll
        for (int i = 0; i < 16; ++i) { const int l = i ^ j; if (l > i) ce_desc(x[A0 + i], x[A0 + l]); }
}
template <int NK> DI void top16_of_128(unsigned (&key)[NK]) {
    bitonic_sort16_desc<0, NK>(key); bitonic_sort16_desc<16, NK>(key); bitonic_sort16_desc<32, NK>(key); bitonic_sort16_desc<48, NK>(key);
    bitonic_sort16_desc<64, NK>(key); bitonic_sort16_desc<80, NK>(key); bitonic_sort16_desc<96, NK>(key); bitonic_sort16_desc<112, NK>(key);
    merge_top16<0, 16, NK>(key); merge_top16<32, 48, NK>(key); merge_top16<64, 80, NK>(key); merge_top16<96, 112, NK>(key);
    merge_top16<0, 32, NK>(key); merge_top16<64, 96, NK>(key);
    merge_top16<0, 64, NK>(key);
}

DI void topk_task(const Frame& F, const Args& A, int task) {
    unsigned char* ws = A.ws; const int tid = F.tid;
    const int u = task >> 3, h = task & 7;
    LAS unsigned* sk = (LAS unsigned*)(LAS unsigned char*)F.lds;
    LAS unsigned* pkk = sk + 16384;
    LAS unsigned* stg = sk + 16384;
    const bf16_t* SCb = (const bf16_t*)(ws + WS_SC) + (size_t)(task & ~511) * 256;
#pragma unroll 1
    for (int half = 0; half < 2; ++half) {
        unsigned key[128];
#pragma unroll
        for (int qb = 0; qb < 2; ++qb) {
            u32x4 pf[8];
#pragma unroll
            for (int k = 0; k < 8; ++k) { const int c = tid + 512 * k; pf[k] = *(const u32x4*)(SCb + (size_t)(c >> 3) * 256 + half * 128 + qb * 64 + (c & 7) * 8); }
#pragma unroll
            for (int k = 0; k < 8; ++k) { const int c = tid + 512 * k; *(LAS u32x4*)(stg + (c >> 3) * 36 + (c & 7) * 4) = pf[k]; }
            __syncthreads();
#pragma unroll
            for (int i = 0; i < 8; ++i) { const u32x4 v = *(const LAS u32x4*)(stg + tid * 36 + 4 * i); const int b0 = 64 * qb + 8 * i;
                key[b0] = fkey(bflo(v.x), b0); key[b0 + 1] = fkey(bfhi(v.x), b0 + 1); key[b0 + 2] = fkey(bflo(v.y), b0 + 2); key[b0 + 3] = fkey(bfhi(v.y), b0 + 3);
                key[b0 + 4] = fkey(bflo(v.z), b0 + 4); key[b0 + 5] = fkey(bfhi(v.z), b0 + 5); key[b0 + 6] = fkey(bflo(v.w), b0 + 6); key[b0 + 7] = fkey(bfhi(v.w), b0 + 7); }
            __syncthreads();
        }
        top16_of_128(key);
#pragma unroll
        for (int r = 0; r < 16; ++r) sk[(half * 16 + r) * 512 + tid] = key[r];
    }
    float v1[16], v2[16];
#pragma unroll
    for (int r = 0; r < 16; ++r) { v1[r] = keyval(sk[r * 512 + tid]); v2[r] = keyval(sk[(16 + r) * 512 + tid]); }
    unsigned ck[64];
#pragma unroll
    for (int c = 50; c < 64; ++c) ck[c] = 0u;
#pragma unroll
    for (int a = 0; a < 16; ++a) {
        const int off = a == 0 ? 0 : a == 1 ? 16 : a == 2 ? 24 : a == 3 ? 29 : a == 4 ? 33 : a == 5 ? 36 : a == 6 ? 38 : a == 7 ? 40 : 42 + (a - 8);
#pragma unroll
        for (int b = 0; b < 16; ++b) if ((a + 1) * (b + 1) <= 16) ck[off + b] = fkey(v1[a] + v2[b], off + b);
    }
    bitonic_sort16_desc<0, 64>(ck); bitonic_sort16_desc<16, 64>(ck); bitonic_sort16_desc<32, 64>(ck); bitonic_sort16_desc<48, 64>(ck);
    merge_top16<0, 16, 64>(ck); merge_top16<32, 48, 64>(ck); merge_top16<0, 32, 64>(ck);
#pragma unroll
    for (int r = 0; r < 16; ++r) pkk[r * 512 + tid] = ck[r];
    const float cmax = keyval(pkk[tid]);
    float ev[16]; float esum = 0.f; int ex[16];
#pragma unroll
    for (int r = 0; r < 16; ++r) {
        const unsigned k = pkk[r * 512 + tid]; const int c = 127 - (int)(k & 127u);
        ev[r] = __expf(keyval(k) - cmax); esum += ev[r];
        const int a = PAIR_A[c], b = PAIR_B[c];
        const int i1 = 127 - (int)(sk[a * 512 + tid] & 127u), i2 = 127 - (int)(sk[(16 + b) * 512 + tid] & 127u);
        ex[r] = i1 * 128 + i2;
    }
    const float rs = 1.f / esum;
    int* IDX = (int*)(ws + WS_IDX) + (size_t)u * 128 + h * 16; float* GATE = (float*)(ws + WS_GATE) + (size_t)u * 128 + h * 16;
#pragma unroll
    for (int r = 0; r < 16; r += 4) {
        *(int4*)(IDX + r) = make_int4(ex[r], ex[r + 1], ex[r + 2], ex[r + 3]);
        *(f32x4*)(GATE + r) = (f32x4){ev[r] * rs, ev[r + 1] * rs, ev[r + 2] * rs, ev[r + 3] * rs};
    }
}

constexpr float EU_SCALE = 64.f, EV_SCALE = 16.f;
DI unsigned pk4_fp8(float a, float b, float c, float d) { int w = 0; w = __builtin_amdgcn_cvt_pk_fp8_f32(a, b, w, false); w = __builtin_amdgcn_cvt_pk_fp8_f32(c, d, w, true); return (unsigned)w; }
DI void convert_tables(const Frame& F, const Args& A) {
    const size_t n16 = (size_t)16384 * 1024 / 16;
    const size_t gt = (size_t)blockIdx.x * 512 + F.tid, NGT = (size_t)F.G * 512;
#pragma unroll 1
    for (int t = 0; t < 2; ++t) {
        const float* src = A.in[18 + t]; unsigned char* dst = A.ws + (t ? WS_EV : WS_EU); const float sc = t ? EV_SCALE : EU_SCALE;
        const float* fn = A.in[15];
        for (size_t i = gt; i < n16; i += NGT) {
            f32x4 a = *(const f32x4*)(src + i * 16) * sc, b = *(const f32x4*)(src + i * 16 + 4) * sc, c = *(const f32x4*)(src + i * 16 + 8) * sc, d = *(const f32x4*)(src + i * 16 + 12) * sc;
            if (t == 0) { const float* g = fn + (i & 63) * 16; a *= *(const f32x4*)g; b *= *(const f32x4*)(g + 4); c *= *(const f32x4*)(g + 8); d *= *(const f32x4*)(g + 12); }
            const size_t e_ = i >> 6, c16_ = i & 63;
            *(u32x4*)(dst + (c16_ >> 3) * ((size_t)16384 * 128) + e_ * 128 + (c16_ & 7) * 16) = (u32x4){pk4_fp8(a.x, a.y, a.z, a.w), pk4_fp8(b.x, b.y, b.z, b.w), pk4_fp8(c.x, c.y, c.z, c.w), pk4_fp8(d.x, d.y, d.z, d.w)};
        }
    }
}

DI float gelu_exact(float x) { return 0.5f * x * (1.f + erff(x * 0.70710678118654752f)); }
typedef float f32x2 __attribute__((ext_vector_type(2)));
#define UNPK16(dst, W_) do { f32x2 _t; \
    _t = __builtin_amdgcn_cvt_pk_f32_fp8((int)(W_).x, false); dst[0] = _t.x; dst[1] = _t.y; _t = __builtin_amdgcn_cvt_pk_f32_fp8((int)(W_).x, true); dst[2] = _t.x; dst[3] = _t.y; \
    _t = __builtin_amdgcn_cvt_pk_f32_fp8((int)(W_).y, false); dst[4] = _t.x; dst[5] = _t.y; _t = __builtin_amdgcn_cvt_pk_f32_fp8((int)(W_).y, true); dst[6] = _t.x; dst[7] = _t.y; \
    _t = __builtin_amdgcn_cvt_pk_f32_fp8((int)(W_).z, false); dst[8] = _t.x; dst[9] = _t.y; _t = __builtin_amdgcn_cvt_pk_f32_fp8((int)(W_).z, true); dst[10] = _t.x; dst[11] = _t.y; \
    _t = __builtin_amdgcn_cvt_pk_f32_fp8((int)(W_).w, false); dst[12] = _t.x; dst[13] = _t.y; _t = __builtin_amdgcn_cvt_pk_f32_fp8((int)(W_).w, true); dst[14] = _t.x; dst[15] = _t.y; } while (0)

template <bool UPH>
DI void expert_phase(const Frame& F, const Args& A, int xv, int wq, int nw) {
    unsigned char* ws = A.ws; const int lane = F.lane, grp = lane >> 3, j = lane & 7;
    const unsigned char* TBL = ws + (UPH ? WS_EU : WS_EV) + (size_t)xv * ((size_t)16384 * 128) + 16 * j;
    const int* IDX = (const int*)(ws + WS_IDX); const float* CW = (const float*)(ws + WS_CW);
    const bf16_t* XN = (const bf16_t*)(ws + WS_XN) + 128 * xv + 16 * j;
    float* HP = (float*)(ws + WS_HP);
    LAS unsigned* ring = (LAS unsigned*)((LAS unsigned char*)F.lds + F.wave * 4096);
    const int nt = (MU - wq + nw - 1) / nw;
    if (nt <= 0) return;
    auto tok = [&](int k) { return __builtin_amdgcn_readfirstlane(wq + (k < nt ? k : nt - 1) * nw); };
    int mi0, mi1; u32x4 mx0, mx1; float mh0, mh1;
    auto meta_load = [&](int k) {
        const int u = tok(k);
        mi0 = IDX[(size_t)u * 128 + lane]; mi1 = IDX[(size_t)u * 128 + 64 + lane];
        if constexpr (UPH) { mx0 = *(const u32x4*)(XN + (size_t)u * DM); mx1 = *(const u32x4*)(XN + (size_t)u * DM + 8); }
        else { mh0 = CW[(size_t)u * 128 + lane]; mh1 = CW[(size_t)u * 128 + 64 + lane]; }
    };
    auto meta_store = [&](int k) {
        LAS unsigned* sl = ring + (k & 3) * 256;
        sl[lane] = (unsigned)mi0; sl[64 + lane] = (unsigned)mi1;
        if constexpr (UPH) { if (grp == 0) { *(LAS u32x4*)(sl + 128 + 8 * j) = mx0; *(LAS u32x4*)(sl + 128 + 8 * j + 4) = mx1; } }
        else { sl[128 + lane] = __builtin_bit_cast(unsigned, mh0); sl[192 + lane] = __builtin_bit_cast(unsigned, mh1); }
    };
    auto gather = [&](u32x4 (&buf)[8], int n) {
        const LAS unsigned* sl = ring + ((n >> 1) & 3) * 256 + 64 * (n & 1) + grp;
#pragma unroll
        for (int i = 0; i < 8; ++i) { const int e = (int)sl[8 * i]; buf[i] = *(const u32x4*)(TBL + (size_t)e * 128); }
    };
    const int ocol = 128 * xv + 16 * j + ((lane & 32) ? 8 : 0) + ((lane & 16) ? 4 : 0) + ((lane & 8) ? 2 : 0);
    f32x2 ocur = (f32x2){0.f, 0.f};
    float acc[16];
    float xn[16];
    auto compute = [&](u32x4 (&buf)[8], int n) {
        const int k = n >> 1, hf = n & 1;
        const LAS unsigned* sl = ring + (k & 3) * 256;
        if (hf == 0) {
            if constexpr (UPH) {
                const u32x4 x0 = *(const LAS u32x4*)(sl + 128 + 8 * j), x1 = *(const LAS u32x4*)(sl + 128 + 8 * j + 4);
                xn[0] = bflo(x0.x); xn[1] = bfhi(x0.x); xn[2] = bflo(x0.y); xn[3] = bfhi(x0.y); xn[4] = bflo(x0.z); xn[5] = bfhi(x0.z); xn[6] = bflo(x0.w); xn[7] = bfhi(x0.w);
                xn[8] = bflo(x1.x); xn[9] = bfhi(x1.x); xn[10] = bflo(x1.y); xn[11] = bfhi(x1.y); xn[12] = bflo(x1.z); xn[13] = bfhi(x1.z); xn[14] = bflo(x1.w); xn[15] = bfhi(x1.w);
            } else {
#pragma unroll
                for (int c = 0; c < 16; ++c) acc[c] = 0.f;
                ocur = *(const f32x2*)(A.out + (size_t)tok(k) * DM + ocol);
            }
        }
#pragma unroll
        for (int i = 0; i < 8; ++i) {
            float f[16]; UNPK16(f, buf[i]);
            if constexpr (UPH) {
                float a0 = 0.f, a1 = 0.f;
#pragma unroll
                for (int c = 0; c < 16; c += 2) { a0 += f[c] * xn[c]; a1 += f[c + 1] * xn[c + 1]; }
                if (hf == 0) acc[i] = a0 + a1; else acc[8 + i] = a0 + a1;
                if (i < 7) { if (hf == 0) asm volatile("" : "+v"(buf[i + 1].x), "+v"(buf[i + 1].y), "+v"(buf[i + 1].z), "+v"(buf[i + 1].w), "+v"(acc[i]));
                             else asm volatile("" : "+v"(buf[i + 1].x), "+v"(buf[i + 1].y), "+v"(buf[i + 1].z), "+v"(buf[i + 1].w), "+v"(acc[8 + i])); }
            } else {
                const float cw = __builtin_bit_cast(float, sl[128 + 64 * hf + 8 * i + grp]);
#pragma unroll
                for (int c = 0; c < 16; ++c) acc[c] += cw * f[c];
                if (i < 7) asm volatile("" : "+v"(buf[i + 1].x), "+v"(buf[i + 1].y), "+v"(buf[i + 1].z), "+v"(buf[i + 1].w),
                                             "+v"(acc[0]), "+v"(acc[1]), "+v"(acc[2]), "+v"(acc[3]), "+v"(acc[4]), "+v"(acc[5]), "+v"(acc[6]), "+v"(acc[7]),
                                             "+v"(acc[8]), "+v"(acc[9]), "+v"(acc[10]), "+v"(acc[11]), "+v"(acc[12]), "+v"(acc[13]), "+v"(acc[14]), "+v"(acc[15]));
            }
            __builtin_amdgcn_sched_barrier(0);
        }
        if (hf == 1 && k < nt) {
            const int u = tok(k);
            float r8[8], r4[4], r2[2];
            if constexpr (UPH) {
                { const bool up = lane & 4;
#pragma unroll
                  for (int i = 0; i < 8; ++i) { const float send = up ? acc[i] : acc[i + 8], keep = up ? acc[i + 8] : acc[i]; r8[i] = keep + __shfl_xor(send, 4); } }
                { const bool up = lane & 2;
#pragma unroll
                  for (int i = 0; i < 4; ++i) { const float send = up ? r8[i] : r8[i + 4], keep = up ? r8[i + 4] : r8[i]; r4[i] = keep + __shfl_xor(send, 2); } }
                { const bool up = lane & 1;
#pragma unroll
                  for (int i = 0; i < 2; ++i) { const float send = up ? r4[i] : r4[i + 2], keep = up ? r4[i + 2] : r4[i]; r2[i] = keep + __shfl_xor(send, 1); } }
                const int st = ((lane & 4) ? 8 : 0) + ((lane & 2) ? 4 : 0) + ((lane & 1) ? 2 : 0);
                float* hp = HP + ((size_t)xv * MU + u) * 128 + grp;
                hp[8 * st] = r2[0]; hp[8 * (st + 1)] = r2[1];
            } else {
                { const bool up = lane & 32;
#pragma unroll
                  for (int c = 0; c < 8; ++c) { const float send = up ? acc[c] : acc[c + 8], keep = up ? acc[c + 8] : acc[c]; r8[c] = keep + __shfl_xor(send, 32); } }
                { const bool up = lane & 16;
#pragma unroll
                  for (int c = 0; c < 4; ++c) { const float send = up ? r8[c] : r8[c + 4], keep = up ? r8[c + 4] : r8[c]; r4[c] = keep + __shfl_xor(send, 16); } }
                { const bool up = lane & 8;
#pragma unroll
                  for (int c = 0; c < 2; ++c) { const float send = up ? r4[c] : r4[c + 2], keep = up ? r4[c + 2] : r4[c]; r2[c] = keep + __shfl_xor(send, 8); } }
                f32x2* o = (f32x2*)(A.out + (size_t)u * DM + ocol);
                f32x2 cur = ocur; cur.x += r2[0]; cur.y += r2[1]; *o = cur;
            }
        }
    };
    meta_load(0); meta_store(0); meta_load(1); meta_store(1); meta_load(2); meta_store(2);
    u32x4 b0[8], b1[8], b2[8];
    gather(b0, 0); gather(b1, 1); gather(b2, 2);
#pragma unroll 1
    for (int k0 = 0; k0 < nt; k0 += 3) {
        const int n0 = 2 * k0;
        meta_load(k0 + 3);
        compute(b0, n0);     gather(b0, n0 + 3);
        compute(b1, n0 + 1); meta_store(k0 + 3); gather(b1, n0 + 4);
        meta_load(k0 + 4);
        compute(b2, n0 + 2); gather(b2, n0 + 5);
        compute(b0, n0 + 3); meta_store(k0 + 4); gather(b0, n0 + 6);
        meta_load(k0 + 5);
        compute(b1, n0 + 4); gather(b1, n0 + 7);
        compute(b2, n0 + 5); meta_store(k0 + 5); gather(b2, n0 + 8);
    }
}


DI void expert_c_pass(const Frame& F, const Args& A) {
    unsigned char* ws = A.ws;
    const float* HP = (const float*)(ws + WS_HP); const float* GATE = (const float*)(ws + WS_GATE); float* CW = (float*)(ws + WS_CW);
    const size_t n4 = (size_t)MU * 128 / 4;
    for (size_t i = (size_t)blockIdx.x * 512 + F.tid; i < n4; i += (size_t)F.G * 512) {
        f32x4 h = *(const f32x4*)(HP + i * 4);
#pragma unroll
        for (int x = 1; x < 8; ++x) h += *(const f32x4*)(HP + (size_t)x * MU * 128 + i * 4);
        const f32x4 g = *(const f32x4*)(GATE + i * 4);
        const float rs = (1.f / EU_SCALE) / sqrtf(ss_sum16((const float*)(ws + WS_SS4), (int)(i >> 5)) * (1.f / DM) + EPS);
        f32x4 c;
        c.x = gelu_exact(h.x * rs) * g.x * (1.f / EV_SCALE); c.y = gelu_exact(h.y * rs) * g.y * (1.f / EV_SCALE);
        c.z = gelu_exact(h.z * rs) * g.z * (1.f / EV_SCALE); c.w = gelu_exact(h.w * rs) * g.w * (1.f / EV_SCALE);
        *(f32x4*)(CW + i * 4) = c;
    }
}
template <int PH> DI void run_phase(const Frame& F, const Args& args, PG8_LAS unsigned char* lds3) {
    unsigned char* ws = args.ws;
    if constexpr (PH == 0) { p0_prologue(F, args); p0_late_weights<0>(F, args, (7 - F.wave) * F.G + blockIdx.x, F.NGW, blockIdx.x * 512 + F.tid, F.G * 512); }
    if constexpr (PH == 1) {
        pg8::Gemm g{(const bf16_t*)(ws + WS_HN), (const bf16_t*)(ws + WS_WIN), MP, NPROJ, 1024, 1024, 1024, 0};
        pg8::StaticOrder S; S.init(MP, NPROJ, F.G, (int)blockIdx.x);
        EpiProj E{(bf16_t*)(ws + WS_QKVR), (bf16_t*)(ws + WS_Z), (float*)(ws + WS_P32), (bf16_t*)(ws + WS_CQN), (bf16_t*)(ws + WS_CKVN), (float*)(ws + WS_KPE), (float*)(ws + WS_SSQ), (float*)(ws + WS_SSK)};
        pg8::gemm_phase<EpiProj, pg8::StaticOrder, true, true>(lds3, g, S, E);
    }
    if constexpr (PH == 2) { gdn_prep_phase<0>(F, args); }
    if constexpr (PH == 3) {
        { pg8::Gemm g{(const bf16_t*)(ws + WS_CQN), (const bf16_t*)(ws + WS_WUQ), MP, 768, 256, 256, 256, 0};
          pg8::StaticOrder S; S.init(MP, 768, F.G, (int)blockIdx.x); EpiB16 E{(bf16_t*)(ws + WS_QH), 768, (const float*)(ws + WS_SSQ), 1.f / 256.f, 4};
          pg8::gemm_phase<EpiB16, pg8::StaticOrder, true, true>(lds3, g, S, E); }
        { pg8::Gemm g{(const bf16_t*)(ws + WS_CKVN), (const bf16_t*)(ws + WS_WUKV), MP, 1024, 256, 256, 256, 0};
          pg8::StaticOrder S; S.init(MP, 1024, F.G, (int)blockIdx.x); EpiB16 E{(bf16_t*)(ws + WS_KVB), 1024, (const float*)(ws + WS_SSK), 1.f / 128.f, 4};
          pg8::gemm_phase<EpiB16, pg8::StaticOrder, true, true>(lds3, g, S, E); }
    }
    if constexpr (PH == 4) { for (int t = F.gw; t < (KVROWS / 64) * 8; t += F.NGW) mla_prep2_task(F, args, t); }
    if constexpr (PH == 5) {
        gdn_scan(F, args);
        volatile LAS unsigned* MISC = (volatile LAS unsigned*)(lds3 + MISC_OFF);
        unsigned* qhead = (unsigned*)(ws + WS_CTL) + CW_ATTQ;
        for (;;) {
            __syncthreads();
            if (F.tid == 0) MISC[24] = xb_add(qhead, 1u);
            __syncthreads();
            const int k = (int)MISC[24];
            if (k >= 512) break;
            attn_item(F, args, k & 7, 63 - (k >> 3));
        }
        p0_late_weights<1>(F, args, F.gw, F.NGW, blockIdx.x * 512 + F.tid, F.G * 512);
    }
    if constexpr (PH == 6) { for (int t = F.gw; t < 2048 * 2; t += F.NGW) gdn_out_task(F, args, t); }
    if constexpr (PH == 7) {
        pg8::Gemm g{(const bf16_t*)(ws + WS_MIX), (const bf16_t*)(ws + WS_WOUT), MU, 1024, 1024, 1024, 1024, 0};
        pg8::StaticOrder S; S.init(MU, 1024, F.G, (int)blockIdx.x); EpiH1 E{args.out, args.in[0], (bf16_t*)(ws + WS_XN), (float*)(ws + WS_SS4)};
        pg8::gemm_phase<EpiH1, pg8::StaticOrder, true, true>(lds3, g, S, E);
    }
    if constexpr (PH == 8) {
        pg8::Gemm g{(const bf16_t*)(ws + WS_XN), (const bf16_t*)(ws + WS_WPQ), MU, 2048, 1024, 1024, 1024, 0};
        pg8::StaticOrder S; S.init(MU, 2048, F.G, (int)blockIdx.x); EpiB16 E{(bf16_t*)(ws + WS_PQ), 2048, (const float*)(ws + WS_SS4), 1.f / 1024.f, 16};
        pg8::gemm_phase<EpiB16, pg8::StaticOrder, true, true>(lds3, g, S, E);
    }
    if constexpr (PH == 9) {
        pg8::Gemm g{(const bf16_t*)(ws + WS_PQ), (const bf16_t*)(ws + WS_SKB), MU, 2048, 256, 2048, 256, 256};
        pg8::StaticOrder S; S.init(MU, 2048, F.G, (int)blockIdx.x); EpiB16 E{(bf16_t*)(ws + WS_SC), 2048, nullptr, 0.f, 0};
        pg8::gemm_phase<EpiB16, pg8::StaticOrder, true, true>(lds3, g, S, E);
    }
    if constexpr (PH == 10) {
        convert_tables(F, args);
        for (int t = blockIdx.x * 512 + F.tid; t < MU * 8; t += F.G * 512) topk_task(F, args, t);
    }
    if constexpr (PH == 12) { expert_c_pass(F, args); }
    if constexpr (PH == 11 || PH == 13) {
        volatile LAS unsigned* MISC = (volatile LAS unsigned*)(lds3 + MISC_OFF);
        const unsigned x = MISC[16], rank = MISC[17];
        unsigned* bar = (unsigned*)(ws + WS_CTL);
        unsigned nloc = 0, nx = 0, myidx = 0;
#pragma unroll
        for (unsigned j = 0; j < 16; ++j) { const unsigned c = xb_ld(&bar[XB_XCNT(j)]); nx += (c > 0u) ? 1u : 0u; myidx += (c > 0u && j < x) ? 1u : 0u; nloc = (j == x) ? c : nloc; }
        const int wq = __builtin_amdgcn_readfirstlane((int)rank * 8 + F.wave), nw = __builtin_amdgcn_readfirstlane((int)nloc * 8);
        const int xstep = __builtin_amdgcn_readfirstlane((int)nx);
        for (int xv = __builtin_amdgcn_readfirstlane((int)myidx); xv < 8; xv += xstep)
            { if constexpr (PH == 11) expert_phase<true>(F, args, xv, wq, nw); else expert_phase<false>(F, args, xv, wq, nw); }
    }
}
constexpr int NPHASE = 14;
__global__ void __launch_bounds__(512, 2) fwd_kernel(Args args) {
    extern __shared__ __attribute__((aligned(16))) unsigned char lds[];
    Frame F;
    F.lds = lds; F.tid = threadIdx.x; F.lane = F.tid & 63; F.wave = __builtin_amdgcn_readfirstlane(F.tid >> 6);
    F.G = gridDim.x; F.gw = blockIdx.x * 8 + F.wave; F.NGW = F.G * 8;
    volatile LAS unsigned* MISC = (volatile LAS unsigned*)((LAS unsigned char*)lds + MISC_OFF);
    if (F.tid < 32) MISC[F.tid] = 0u;
    __syncthreads();
    unsigned char* ws = args.ws;
    const int lo = args.ph_lo, hi = args.ph_hi;
    XcdBarrier bar; bar.bar = (unsigned*)(ws + WS_CTL); bar.x = 0; bar.st = nullptr;
    if (hi - lo > 1) bar = xcd_barrier_post((unsigned*)(ws + WS_CTL), MISC + 8);
    if (F.tid == 0) { const unsigned x = xb_xcc_id(); MISC[16] = x; MISC[17] = xb_add((unsigned*)(ws + WS_CTL) + 3520 + 64 * x, 1u); }
    __syncthreads();
#define IN(k) (lo <= (k) && (k) < hi)
#define SEAM(k) do { if (IN(k) && IN((k) + 1)) xcd_barrier(bar); } while (0)
    PG8_LAS unsigned char* lds3 = (PG8_LAS unsigned char*)lds;

#ifndef PROBE_REPEAT
#define PROBE_REPEAT -1
#endif
#ifndef PROBE_TIME
#define PROBE_TIME -1
#endif
#ifndef PROBE_TSEL
#define PROBE_TSEL 0
#endif
    unsigned long long pt_ticks = 0ull;
#define PHASE(k) do { unsigned long long pt0_ = 0ull; if (PROBE_TIME == (k)) pt0_ = __builtin_amdgcn_s_memrealtime(); \
        if (IN(k)) { run_phase<k>(F, args, lds3); if (PROBE_REPEAT == (k)) { xcd_barrier(bar); run_phase<(k)>(F, args, lds3); } } \
        if (PROBE_TIME == (k) && PROBE_TSEL == 1) pt_ticks = __builtin_amdgcn_s_memrealtime() - pt0_;     \
        if (PROBE_TIME == (k) && PROBE_TSEL == 2) pt0_ = __builtin_amdgcn_s_memrealtime();                \
        SEAM(k); \
        if (PROBE_TIME == (k) && PROBE_TSEL != 1) pt_ticks = __builtin_amdgcn_s_memrealtime() - pt0_; } while (0)
    PHASE(0); PHASE(1); PHASE(2); PHASE(3); PHASE(4); PHASE(5); PHASE(6); PHASE(7); PHASE(8); PHASE(9); PHASE(10); PHASE(11); PHASE(12); PHASE(13);
#undef PHASE
    if (PROBE_STAGE >= 0) { __syncthreads(); pt_ticks = *(volatile unsigned long long*)(lds + 143360 + 96); }
    if (PROBE_TIME >= 0 || PROBE_STAGE >= 0) { const unsigned long long t0_ = __builtin_amdgcn_s_memrealtime(); while (__builtin_amdgcn_s_memrealtime() - t0_ < 4ull * pt_ticks) __builtin_amdgcn_s_sleep(32); }
#undef IN
#undef SEAM
}

#ifndef N_LAUNCHES
#define N_LAUNCHES 1
#endif
extern "C" void kernel_launch(void* const* d_in, const int* in_sizes, int n_in, void* d_out, int out_size, void* d_ws, size_t ws_size, hipStream_t stream) {
    static int grid = 0;
    if (grid == 0) {
        if (n_in != 20 || out_size != MU * DM || ws_size < WS_END) { fprintf(stderr, "kernel_launch: unexpected shapes (n_in %d out %d ws %zu)\n", n_in, out_size, ws_size); grid = -1; return; }
        int dev = 0, cus = 0, per_cu = 0;
        if (hipGetDevice(&dev) != hipSuccess || hipDeviceGetAttribute(&cus, hipDeviceAttributeMultiprocessorCount, dev) != hipSuccess) { grid = -1; return; }
        if (hipFuncSetAttribute((const void*)fwd_kernel, hipFuncAttributeMaxDynamicSharedMemorySize, LDS_BYTES) != hipSuccess) { fprintf(stderr, "kernel_launch: hipFuncSetAttribute failed\n"); grid = -1; return; }
        if (hipOccupancyMaxActiveBlocksPerMultiprocessor(&per_cu, (const void*)fwd_kernel, 512, LDS_BYTES) != hipSuccess || per_cu < 1) { fprintf(stderr, "kernel_launch: occupancy query says %d\n", per_cu); (void)hipGetLastError(); per_cu = 1; }
        grid = cus;
    }
    if (grid < 0) return;
    (void)hipMemsetAsync((char*)d_ws + WS_CTL, 0, CTL_ZERO_BYTES, stream);
    Args a{};
    for (int i = 0; i < 20; ++i) a.in[i] = (const float*)d_in[i];
    a.out = (float*)d_out; a.ws = (unsigned char*)d_ws;
    for (int li = 0; li < N_LAUNCHES; ++li) {
        a.ph_lo = li * NPHASE / N_LAUNCHES; a.ph_hi = (li + 1) * NPHASE / N_LAUNCHES;
        if (N_LAUNCHES == 1) {
            void* kargs[] = {&a};
            hipError_t e = hipLaunchCooperativeKernel((const void*)fwd_kernel, dim3(grid), dim3(512), kargs, LDS_BYTES, stream);
            if (e != hipSuccess) fprintf(stderr, "cooperative launch failed: %s (grid %d)\n", hipGetErrorString(e), grid);
        } else {
            hipLaunchKernelGGL(fwd_kernel, dim3(grid), dim3(512), LDS_BYTES, stream, a);
        }
    }
}
```

```cpp
#include <hip/hip_runtime.h>
#include <hip/hip_bf16.h>
#include <cstdio>
#include <cstdint>

#define DI __device__ __forceinline__
#define LAS __attribute__((address_space(3)))
#define GAS __attribute__((address_space(1)))

typedef unsigned short bf16_t;
typedef short bf16x8 __attribute__((ext_vector_type(8)));
typedef short s16x4 __attribute__((ext_vector_type(4)));
typedef float f32x4 __attribute__((ext_vector_type(4)));
typedef float f32x16 __attribute__((ext_vector_type(16)));
typedef unsigned u32x4 __attribute__((ext_vector_type(4)));
typedef unsigned u32x2 __attribute__((ext_vector_type(2)));

namespace pg8 {
#define PG8_LAS __attribute__((address_space(3)))
constexpr int BM = 256, BK = 64, HALF = 128, HTB = HALF * BK * 2  , STAGE_BYTES = 8 * HTB, NXCD = 8, WGM = 8;

__host__ __device__ __forceinline__ int lds_byte(int r, int c) { const int st = (r >> 4) * 2 + (c >> 5), rr = r & 15, cc = c & 31, ob = rr * 64 + cc * 2; return st * 1024 + (ob ^ (((ob >> 9) & 1) << 5)); }
__host__ __device__ __forceinline__ void stage_rc(int b, int& R, int& C) { const int st = b / 1024, sb = b % 1024, swz = sb ^ (((sb >> 9) & 1) << 5); R = (st >> 1) * 16 + swz / 64; C = (st & 1) * 32 + (swz % 64) / 2; }
__host__ __device__ __forceinline__ int perm32(int rho) { const int n = rho >> 4, i = rho & 15; return 8 * (i >> 2) + 4 * n + (i & 3); }

struct Unit { int pm, pn; };
struct Gemm { const bf16_t* A; const bf16_t* Bt; int M, N, K, lda, ldb, a_pn_off; };

struct StaticOrder {
    int nM, nN, nwg, G, c;
    __host__ __device__ void init(int M, int N, int G_, int c_) { nM = M / BM; nN = N / BM; nwg = nM * nN; G = G_; c = c_; }
    __host__ __device__ bool next(int i, Unit& u) const {
        const long L = (long)i * G + c; if (L >= nwg) return false;
        int wgid = (int)L; { const int q = nwg / NXCD, r = nwg % NXCD, xcd = wgid % NXCD, off = wgid / NXCD; wgid = (xcd < r ? xcd * (q + 1) : r * (q + 1) + (xcd - r) * q) + off; }
        const int nig = WGM * nN, gid = wgid / nig, fm = gid * WGM, gsz = (nM - fm) < WGM ? (nM - fm) : WGM;
        u.pm = fm + ((wgid % nig) % gsz); u.pn = (wgid % nig) / gsz; return true;
    }
    __device__ __forceinline__ void a_ready(const Unit&) const {}
    __device__ __forceinline__ void done(const Unit&) const {}
};

__device__ __forceinline__ unsigned cvt_pk_bf16(float lo, float hi) { unsigned r; asm volatile("v_cvt_pk_bf16_f32 %0, %1, %2" : "=v"(r) : "v"(lo), "v"(hi)); return r; }

template <class Epi, class Sched, bool ALIGN_EPI = false, bool SP2 = false>
__device__ __forceinline__ void gemm_phase(PG8_LAS unsigned char* lds, const Gemm g, const Sched& S, const Epi& E) {
    const int tid = threadIdx.x, wid = __builtin_amdgcn_readfirstlane(tid >> 6), lane = tid & 63, wr = wid >> 2, wc = wid & 3, fr = lane & 15, fq = lane >> 4;
    const int K = g.K, nt = K / BK;
    unsigned voffA[2], voffB[2];
#pragma unroll
    for (int i = 0; i < 2; ++i) { int R, C; stage_rc(tid * 16 + i * 8192, R, C); const int Rb = Epi::PERM ? ((R & ~31) + perm32(R & 31)) : R;
        voffA[i] = (unsigned)(R * g.lda + C) * 2u; voffB[i] = (unsigned)(Rb * g.ldb + C) * 2u; }
    const size_t kstep = (size_t)(BK * 2);
    const size_t hstepA = (size_t)HALF * g.lda * 2, hstepB = (size_t)HALF * g.ldb * 2;
    const size_t tstepA = 2 * hstepA, tstepB = 2 * hstepB;
    const size_t pnoffA = (size_t)g.a_pn_off * 2;
    const unsigned ldsw = (unsigned)wid * 1024u;
    const int aoff = lds_byte(wr * 64 + fr, fq * 8), boff = lds_byte(wc * 32 + fr, fq * 8);
#define PG8_SA(b, h) (((b) * 2 + (h)) * HTB)
#define PG8_SB(b, h) ((4 + (b) * 2 + (h)) * HTB)
#define PG8_STAGE(bufoff, gbase, voff) do { _Pragma("unroll") for (int _i = 0; _i < 2; ++_i) \
        __builtin_amdgcn_global_load_lds((const unsigned*)((const char*)(gbase) + (voff)[_i]), (PG8_LAS unsigned*)(lds + (bufoff) + ldsw + _i * 8192), 16, 0, 0); } while (0)
#define PG8_LDA(dst, b, h) do { _Pragma("unroll") for (int m = 0; m < 4; ++m) _Pragma("unroll") for (int k = 0; k < 2; ++k) dst[m][k] = *(const PG8_LAS bf16x8*)(lds + PG8_SA(b, h) + aoff + m * 2048 + k * 1024); } while (0)
#define PG8_LDB(dst, b, h) do { _Pragma("unroll") for (int n = 0; n < 2; ++n) _Pragma("unroll") for (int k = 0; k < 2; ++k) dst[n][k] = *(const PG8_LAS bf16x8*)(lds + PG8_SB(b, h) + boff + n * 2048 + k * 1024); } while (0)
#define PG8_MMA(ai, bj, At, Bt) do { __builtin_amdgcn_s_setprio(1); _Pragma("unroll") for (int m = 0; m < 4; ++m) _Pragma("unroll") for (int n = 0; n < 2; ++n) _Pragma("unroll") for (int k = 0; k < 2; ++k) \
        acc[ai][bj][m][n] = __builtin_amdgcn_mfma_f32_16x16x32_bf16(Bt[n][k], At[m][k], acc[ai][bj][m][n], 0, 0, 0); __builtin_amdgcn_s_setprio(0); } while (0)
#define PG8_WAIT_V(n) asm volatile("s_waitcnt vmcnt(" #n ")" ::: "memory")
#define PG8_WAIT_L(n) asm volatile("s_waitcnt lgkmcnt(" #n ")" ::: "memory")
#define PG8_BAR __builtin_amdgcn_s_barrier()
#define PG8_SCHED __builtin_amdgcn_sched_barrier(0)
    Unit cur, nxt; int ui = 0;
    if (!S.next(0, cur)) return;
    f32x4 acc[2][2][4][2];
#pragma unroll
    for (int a = 0; a < 2; ++a)
#pragma unroll
        for (int b = 0; b < 2; ++b)
#pragma unroll
            for (int m = 0; m < 4; ++m)
#pragma unroll
                for (int n = 0; n < 2; ++n) acc[a][b][m][n] = (f32x4){0.f, 0.f, 0.f, 0.f};
    bf16x8 At[4][2], B0[2][2], B1[2][2];
    const char* cA = (const char*)g.A + (size_t)cur.pm * tstepA + (size_t)cur.pn * pnoffA; const char* cB = (const char*)g.Bt + (size_t)cur.pn * tstepB;
    S.a_ready(cur);
    if constexpr (SP2) {
        PG8_STAGE(PG8_SB(0, 0), cB, voffB); PG8_STAGE(PG8_SB(0, 1), cB + hstepB, voffB); PG8_STAGE(PG8_SA(0, 0), cA, voffA); PG8_STAGE(PG8_SA(0, 1), cA + hstepA, voffA);
        if (wr == 1) PG8_BAR;
        PG8_WAIT_V(2); PG8_BAR;
        PG8_STAGE(PG8_SB(1, 0), cB + kstep, voffB); PG8_STAGE(PG8_SA(1, 0), cA + kstep, voffA); PG8_STAGE(PG8_SB(1, 1), cB + hstepB + kstep, voffB);
        PG8_WAIT_V(6); PG8_BAR;
    } else {
        PG8_STAGE(PG8_SB(0, 0), cB, voffB); PG8_STAGE(PG8_SA(0, 0), cA, voffA); PG8_STAGE(PG8_SB(0, 1), cB + hstepB, voffB); PG8_STAGE(PG8_SA(0, 1), cA + hstepA, voffA);
        if (wr == 1) PG8_BAR;
        PG8_WAIT_V(4); PG8_BAR;
        PG8_STAGE(PG8_SB(1, 0), cB + kstep, voffB); PG8_STAGE(PG8_SA(1, 0), cA + kstep, voffA); PG8_STAGE(PG8_SB(1, 1), cB + hstepB + kstep, voffB);
        PG8_WAIT_V(6); PG8_BAR;
    }
    for (;;) {
        const bool has_next = S.next(ui + 1, nxt);
        const char* nA = has_next ? (const char*)g.A + (size_t)nxt.pm * tstepA + (size_t)nxt.pn * pnoffA : cA; const char* nB = has_next ? (const char*)g.Bt + (size_t)nxt.pn * tstepB : cB;
        for (int t = 0; t < nt; t += 2) {
            const bool last = (t == nt - 2);
            const char* a1 = cA + (size_t)(t + 1) * kstep;
            const char* a2 = last ? nA : cA + (size_t)(t + 2) * kstep; const char* b2 = last ? nB : cB + (size_t)(t + 2) * kstep;
            const char* a3 = a2 + kstep; const char* b3 = b2 + kstep;
            if (last && has_next) S.a_ready(nxt);
            if constexpr (SP2) {
            PG8_LDB(B0, 0, 0); PG8_LDB(B1, 0, 1); PG8_SCHED; PG8_LDA(At, 0, 0); PG8_STAGE(PG8_SA(1, 1), a1 + hstepA, voffA);
            PG8_WAIT_V(8); PG8_WAIT_L(0); PG8_BAR; PG8_MMA(0, 0, At, B0); PG8_MMA(0, 1, At, B1); PG8_BAR; PG8_SCHED;
            PG8_LDA(At, 0, 1); PG8_STAGE(PG8_SB(0, 0), b2, voffB); PG8_STAGE(PG8_SB(0, 1), b2 + hstepB, voffB); PG8_STAGE(PG8_SA(0, 0), a2, voffA);
            PG8_WAIT_V(8); PG8_WAIT_L(0); PG8_BAR; PG8_MMA(1, 0, At, B0); PG8_MMA(1, 1, At, B1); PG8_BAR; PG8_SCHED;
            PG8_LDB(B0, 1, 0); PG8_LDB(B1, 1, 1); PG8_SCHED; PG8_LDA(At, 1, 0); PG8_STAGE(PG8_SA(0, 1), a2 + hstepA, voffA);
            PG8_WAIT_V(8); PG8_WAIT_L(0); PG8_BAR; PG8_MMA(0, 0, At, B0); PG8_MMA(0, 1, At, B1); PG8_BAR; PG8_SCHED;
            PG8_LDA(At, 1, 1); PG8_STAGE(PG8_SB(1, 0), b3, voffB); PG8_STAGE(PG8_SB(1, 1), b3 + hstepB, voffB); PG8_STAGE(PG8_SA(1, 0), a3, voffA);
            PG8_WAIT_V(8); PG8_WAIT_L(0); PG8_BAR; PG8_MMA(1, 0, At, B0); PG8_MMA(1, 1, At, B1); PG8_BAR; PG8_SCHED;
            } else {
            PG8_LDB(B0, 0, 0); PG8_SCHED; PG8_LDA(At, 0, 0); PG8_STAGE(PG8_SA(1, 1), a1 + hstepA, voffA);
            PG8_WAIT_L(8); PG8_BAR; PG8_WAIT_L(0); PG8_MMA(0, 0, At, B0); PG8_BAR; PG8_SCHED;
            PG8_LDB(B1, 0, 1); PG8_STAGE(PG8_SB(0, 0), b2, voffB);
            PG8_BAR; PG8_WAIT_L(0); PG8_MMA(0, 1, At, B1); PG8_BAR;
            PG8_LDA(At, 0, 1); PG8_STAGE(PG8_SA(0, 0), a2, voffA);
            PG8_BAR; PG8_WAIT_L(0); PG8_MMA(1, 0, At, B0); PG8_BAR; PG8_SCHED;
            PG8_STAGE(PG8_SB(0, 1), b2 + hstepB, voffB);
            PG8_WAIT_V(6); PG8_BAR; PG8_MMA(1, 1, At, B1); PG8_BAR;
            PG8_LDB(B0, 1, 0); PG8_SCHED; PG8_LDA(At, 1, 0); PG8_STAGE(PG8_SA(0, 1), a2 + hstepA, voffA);
            PG8_WAIT_L(8); PG8_BAR; PG8_WAIT_L(0); PG8_MMA(0, 0, At, B0); PG8_BAR; PG8_SCHED;
            PG8_LDB(B1, 1, 1); PG8_STAGE(PG8_SB(1, 0), b3, voffB);
            PG8_BAR; PG8_WAIT_L(0); PG8_MMA(0, 1, At, B1); PG8_BAR;
            PG8_LDA(At, 1, 1); PG8_STAGE(PG8_SA(1, 0), a3, voffA);
            PG8_BAR; PG8_WAIT_L(0); PG8_MMA(1, 0, At, B0); PG8_BAR; PG8_SCHED;
            PG8_STAGE(PG8_SB(1, 1), b3 + hstepB, voffB);
            PG8_WAIT_V(6); PG8_BAR; PG8_MMA(1, 1, At, B1); PG8_BAR;
            }
        }
        if constexpr (ALIGN_EPI) { if (wr == 0) PG8_BAR; }
        E(acc, cur, wr, wc, fr, fq); S.done(cur);
        if (!has_next) break;
#pragma unroll
        for (int a = 0; a < 2; ++a)
#pragma unroll
            for (int b = 0; b < 2; ++b)
#pragma unroll
                for (int m = 0; m < 4; ++m)
#pragma unroll
                    for (int n = 0; n < 2; ++n) acc[a][b][m][n] = (f32x4){0.f, 0.f, 0.f, 0.f};
        cur = nxt; cA = nA; cB = nB; ++ui;
        if constexpr (ALIGN_EPI) { if (wr == 1) PG8_BAR; }
    }
    PG8_WAIT_V(0);
    if constexpr (!ALIGN_EPI) { if (wr == 0) PG8_BAR; }
    PG8_BAR;
#undef PG8_SA
#undef PG8_SB
#undef PG8_STAGE
#undef PG8_LDA
#undef PG8_LDB
#undef PG8_MMA
#undef PG8_WAIT_V
#undef PG8_WAIT_L
#undef PG8_BAR
#undef PG8_SCHED
}
}

constexpr int DM = 1024;
constexpr int NTOK = 16400;
constexpr int PADL = 48;
constexpr int LPV = 16448;
constexpr int MP = 16640;
constexpr int MU = 16384;
constexpr int NCHUNK = 257;
constexpr int NHEAD = 8;
constexpr int NPROJ = 2560;
constexpr int KVROWS = 16512;
constexpr float EPS = 1e-6f;

constexpr size_t MiB = 1u << 20;
constexpr size_t WS_CTL = 0, CTL_ZERO_BYTES = 64 * 1024;
constexpr size_t WS_SSQ = 128 * 1024;
constexpr size_t WS_SSK = 512 * 1024;
constexpr size_t WS_SS4 = 14 * MiB;
constexpr size_t WS_WIN = 1 * MiB;
constexpr size_t WS_WUQ = 6 * MiB;
constexpr size_t WS_WUKV = 6 * MiB + 512 * 1024;
constexpr size_t WS_WOUT = 7 * MiB;
constexpr size_t WS_WPQ = 9 * MiB;
constexpr size_t WS_SKB = 13 * MiB;
constexpr size_t WS_IDX = 16 * MiB;
constexpr size_t WS_GATE = 24 * MiB;
constexpr size_t WS_HN = 16 * MiB;
constexpr size_t WS_QKVR = 101 * MiB;
constexpr size_t WS_Z = 150 * MiB;
constexpr size_t WS_P32 = 167 * MiB;
constexpr size_t WS_GA = 16 * MiB;
constexpr size_t WS_GQ = 33 * MiB;
constexpr size_t WS_GS = 67 * MiB;
constexpr size_t WS_GB = 84 * MiB;
constexpr size_t WS_GO = 50 * MiB;
constexpr size_t WS_MIX = 167 * MiB;
constexpr size_t WS_CQN = 200 * MiB;
constexpr size_t WS_CKVN = 208 * MiB + 512 * 1024;
constexpr size_t WS_QH = 101 * MiB;
constexpr size_t WS_KVB = 167 * MiB;
constexpr size_t WS_Q = 125 * MiB + 512 * 1024;
constexpr size_t WS_K = 220 * MiB;
constexpr size_t WS_VT = 200 * MiB;
constexpr size_t WS_XN = 32 * MiB;
constexpr size_t WS_PQ = 64 * MiB;
constexpr size_t WS_SC = 128 * MiB;
constexpr size_t WS_EU = 96 * MiB;
constexpr size_t WS_EV = 112 * MiB;
constexpr size_t WS_CW = 64 * MiB;
constexpr size_t WS_HP = 128 * MiB;
constexpr size_t WS_KPE = 217 * MiB;
constexpr size_t WS_END = 256 * MiB;
constexpr int CW_ATTQ = 8192;

constexpr int LDS_BYTES = 147456;
constexpr int MISC_OFF = 131072 + 12288;

DI unsigned f2bf(float f) { unsigned u = __builtin_bit_cast(unsigned, f); return (u + 0x7fffu + ((u >> 16) & 1u)) >> 16; }
DI unsigned pk2(float lo, float hi) { return f2bf(lo) | (f2bf(hi) << 16); }
DI float bf2f(unsigned b) { return __builtin_bit_cast(float, b << 16); }
DI float bflo(unsigned w) { return __builtin_bit_cast(float, w << 16); }
DI float bfhi(unsigned w) { return __builtin_bit_cast(float, w & 0xffff0000u); }
DI float wave_sum(float v) {
#pragma unroll
    for (int o = 1; o < 64; o <<= 1) v += __shfl_xor(v, o);
    return v;
}
DI float sigmoidf_(float x) { return 1.f / (1.f + __expf(-x)); }
DI float siluf_(float x) { return x / (1.f + __expf(-x)); }

#define XB_TMO      128
#define XB_XCNT(j)  (256  + 64 * (j))
#define XB_XSUB(j)  (1280 + 64 * (j))
#define XB_XGEN(j)  (2304 + 64 * (j))
#define XB_TOP      3328
#define XB_TOPGEN   3392
#define XCD_BAR_WORDS 3456
#define XB_SPIN_CAP (1u << 22)
DI unsigned xb_ld(unsigned* p)              { return __hip_atomic_load(p, __ATOMIC_RELAXED, __HIP_MEMORY_SCOPE_AGENT); }
DI unsigned xb_add(unsigned* p, unsigned v) { return __hip_atomic_fetch_add(p, v, __ATOMIC_RELAXED, __HIP_MEMORY_SCOPE_AGENT); }
DI unsigned xb_xcc_id() { return (unsigned)__builtin_amdgcn_s_getreg((3 << 11) | 20) & 0xFu; }
#define XB_SPIN(cond, bar) do { unsigned _sp = 0; while (cond) { __builtin_amdgcn_s_sleep(1); \
    if ((++_sp & 255u) == 0u) { if (xb_ld(&(bar)[XB_TMO])) break; if (_sp > XB_SPIN_CAP) { atomicAdd(&(bar)[XB_TMO], 1u); break; } } } } while (0)
struct XcdBarrier { unsigned* bar; unsigned x; volatile LAS unsigned* st; };
DI XcdBarrier xcd_barrier_post(unsigned* bar, volatile LAS unsigned* st) {
    XcdBarrier b; b.bar = bar; b.x = xb_xcc_id(); b.st = st;
    if (threadIdx.x == 0) (void)xb_add(&bar[XB_XCNT(b.x)], 1u);
    return b;
}
DI void xcd_barrier_complete(unsigned* bar, unsigned x, unsigned& nloc, unsigned& nx) {
    const unsigned G = gridDim.x * gridDim.y * gridDim.z;
    unsigned sum, cnt, mine, sp = 0u;
    for (;;) {
        sum = 0u; cnt = 0u; mine = 0u;
#pragma unroll
        for (unsigned j = 0; j < 16; ++j) { const unsigned c = xb_ld(&bar[XB_XCNT(j)]); sum += c; cnt += (c > 0u) ? 1u : 0u; mine = (j == x) ? c : mine; }
        if (sum == G) break;
        __builtin_amdgcn_s_sleep(1);
        if ((++sp & 255u) == 0u) { if (xb_ld(&bar[XB_TMO])) break; if (sp > XB_SPIN_CAP) { atomicAdd(&bar[XB_TMO], 1u); break; } }
    }
    nloc = mine > 0u ? mine : 1u; nx = cnt > 0u ? cnt : 1u;
}
DI void xcd_barrier(const XcdBarrier& b) {
    asm volatile("s_waitcnt vmcnt(0)" ::: "memory");
    __syncthreads();
    if (threadIdx.x == 0) {
        unsigned* bar = b.bar;
        __builtin_amdgcn_s_waitcnt(0);
        unsigned nloc = b.st[0], nx = b.st[1];
        if (nloc == 0u) { xcd_barrier_complete(bar, b.x, nloc, nx); b.st[0] = nloc; b.st[1] = nx; }
        const unsigned old = xb_add(&bar[XB_XSUB(b.x)], 1u);
        const unsigned gen = old / nloc;
        if (old + 1u == (gen + 1u) * nloc) {
            __builtin_amdgcn_fence(__ATOMIC_RELEASE, "agent");
            asm volatile("s_waitcnt vmcnt(0)" ::: "memory");
            const unsigned og = xb_add(&bar[XB_TOP], 1u);
            const unsigned tg = og / nx;
            if (og + 1u == (tg + 1u) * nx) xb_add(&bar[XB_TOPGEN], 1u);
            else XB_SPIN(xb_ld(&bar[XB_TOPGEN]) == tg, bar);
            __builtin_amdgcn_fence(__ATOMIC_ACQUIRE, "agent");
            xb_add(&bar[XB_XGEN(b.x)], 1u);
            asm volatile("s_waitcnt vmcnt(0)" ::: "memory");
        } else {
            XB_SPIN(xb_ld(&bar[XB_XGEN(b.x)]) == gen, bar);
            __builtin_amdgcn_fence(__ATOMIC_ACQUIRE, "agent");
            asm volatile("s_waitcnt vmcnt(0)" ::: "memory");
        }
    }
    __syncthreads();
}

struct Args {
    const float* in[20];
    float* out; unsigned char* ws;
    int ph_lo, ph_hi;
};
struct Frame {
    unsigned char* lds;
    int tid, lane, wave, G, gw, NGW;
};

template <class Map>
DI void transpose_item(const float* __restrict__ W, int Nsrc, bf16_t* __restrict__ WT, int ldk, float* scr, int item, int nblk, int lane, Map srcmap, const float* __restrict__ rowscale = nullptr) {
    const int kb = item / nblk, nb = item % nblk, k0 = 64 * kb, n0 = 32 * nb;
    const int ns = srcmap(n0 + (lane & 31));
    float vv[32];
#pragma unroll
    for (int i = 0; i < 32; ++i) { const int kk = 2 * i + (lane >> 5); vv[i] = (ns >= 0) ? W[(size_t)(k0 + kk) * Nsrc + ns] : 0.f; }
    if (rowscale) {
#pragma unroll
        for (int i = 0; i < 32; ++i) vv[i] *= rowscale[k0 + 2 * i + (lane >> 5)];
    }
#pragma unroll
    for (int i = 0; i < 32; ++i) { const int kk = 2 * i + (lane >> 5); scr[kk * 33 + (lane & 31)] = vv[i]; }
    __builtin_amdgcn_s_waitcnt(0); __builtin_amdgcn_wave_barrier();
    const int c = lane & 7;
#pragma unroll
    for (int j = 0; j < 4; ++j) { const int n = (lane >> 3) + 8 * j; const float* s = scr + (8 * c) * 33 + n;
        u32x4 o; o.x = pk2(s[0 * 33], s[1 * 33]); o.y = pk2(s[2 * 33], s[3 * 33]); o.z = pk2(s[4 * 33], s[5 * 33]); o.w = pk2(s[6 * 33], s[7 * 33]);
        *(u32x4*)(WT + (size_t)(n0 + n) * ldk + k0 + 8 * c) = o; }
    __builtin_amdgcn_s_waitcnt(0); __builtin_amdgcn_wave_barrier();
}
struct MapId { DI int operator()(int n) const { return n; } };
struct MapWin {
    DI int operator()(int n) const {
        if (n < 2048) return n;
        if (n < 2304) return n + 16;
        if (n < 2432) return n + 16;
        if (n < 2464) return n + 16;
        if (n < 2472) return n - 416;
        if (n < 2480) return n - 416;
        return -1;
    }
};

template <int PART> DI void p0_late_weights(const Frame& F, const Args& A, int wi, int nwv, int ti, int nth) {
    unsigned char* ws = A.ws;
    float* scr = (float*)(F.lds + F.wave * 16384);
    const float* w_uq = A.in[10]; const float* w_ukv = A.in[11]; const float* w_out = A.in[14]; const float* w_pq = A.in[16]; const float* sub_keys = A.in[17];
    constexpr int I_UQ = 4 * 24, I_UKV = 2 * 32, I_OUT = 16 * 32, I_PQ = 16 * 64;
    constexpr int NITEMS = I_UQ + I_UKV + I_OUT + I_PQ;
    const int lo_ = PART == 0 ? 0 : I_UQ + I_UKV, hi_ = PART == 0 ? I_UQ + I_UKV : NITEMS;
    for (int it = lo_ + wi; it < hi_; it += nwv) {
        int r = it;
        if (r < I_UQ) { transpose_item(w_uq, 768, (bf16_t*)(ws + WS_WUQ), 256, scr, r, 24, F.lane, MapId(), A.in[8]); continue; } r -= I_UQ;
        if (r < I_UKV) { transpose_item(w_ukv, 1024, (bf16_t*)(ws + WS_WUKV), 256, scr, r, 32, F.lane, MapId(), A.in[9]); continue; } r -= I_UKV;
        if (r < I_OUT) { transpose_item(w_out, 1024, (bf16_t*)(ws + WS_WOUT), 1024, scr, r, 32, F.lane, MapId()); continue; } r -= I_OUT;
        transpose_item(w_pq, 2048, (bf16_t*)(ws + WS_WPQ), 1024, scr, r, 64, F.lane, MapId(), A.in[15]);
    }
    const int gt = ti, NGT = nth;
    if (PART == 0) for (int i = gt; i < 1024 * 16; i += NGT) { const int n = i >> 4, c = i & 15; *(u32x4*)((bf16_t*)(ws + WS_WUKV) + (size_t)n * 256 + 128 + c * 8) = (u32x4){0u, 0u, 0u, 0u}; }
    if (PART == 1) for (int i = gt; i < 2048 * 32; i += NGT) {
        const int n = i >> 5, c8 = (i & 31) * 8; const int p = (n >> 7) & 1;
        u32x4 o = (u32x4){0u, 0u, 0u, 0u};
        if ((c8 >> 7) == p) { const float* s = sub_keys + (size_t)n * 128 + (c8 & 127); const f32x4 a = *(const f32x4*)s, b = *(const f32x4*)(s + 4);
            o.x = pk2(a.x, a.y); o.y = pk2(a.z, a.w); o.z = pk2(b.x, b.y); o.w = pk2(b.z, b.w); }
        *(u32x4*)((bf16_t*)(ws + WS_SKB) + (size_t)n * 256 + c8) = o;
    }
}

DI void p0_prologue(const Frame& F, const Args& A) {
    unsigned char* ws = A.ws;
    float* scr = (float*)(F.lds + F.wave * 16384);
    const float* w_in = A.in[3]; const float* w_uq = A.in[10]; const float* w_ukv = A.in[11]; const float* w_out = A.in[14]; const float* w_pq = A.in[16]; const float* sub_keys = A.in[17];
    constexpr int I_IN = 16 * 80;
    for (int it = F.wave * F.G + blockIdx.x; it < I_IN; it += F.NGW) transpose_item(w_in, 2480, (bf16_t*)(ws + WS_WIN), 1024, scr, it, 80, F.lane, MapWin());
    const float* x = A.in[0]; const float* meta = A.in[1]; const float* anorm = A.in[2];
    bf16_t* HN = (bf16_t*)(ws + WS_HN);
    for (int p0 = F.gw; p0 < MP; p0 += 3 * F.NGW) {
        f32x4 v[3][4]; bool ok[3];
#pragma unroll
        for (int r = 0; r < 3; ++r) {
            const int p = p0 + r * F.NGW, t = p - PADL; ok[r] = (p < MP) && t >= 0 && t < NTOK;
            if (ok[r]) { const float* src = (t < 16) ? meta + (size_t)t * DM : x + (size_t)(t - 16) * DM; const f32x4* xr = (const f32x4*)src + F.lane;
#pragma unroll
                for (int j = 0; j < 4; ++j) v[r][j] = xr[64 * j]; }
            else {
#pragma unroll
                for (int j = 0; j < 4; ++j) v[r][j] = (f32x4){0.f, 0.f, 0.f, 0.f}; }
        }
#pragma unroll
        for (int r = 0; r < 3; ++r) {
            const int p = p0 + r * F.NGW; if (p >= MP) continue;
            unsigned long long* o8 = (unsigned long long*)(HN + (size_t)p * DM) + F.lane;
            float s = 0.f;
#pragma unroll
            for (int j = 0; j < 4; ++j) s += (v[r][j].x * v[r][j].x + v[r][j].y * v[r][j].y) + (v[r][j].z * v[r][j].z + v[r][j].w * v[r][j].w);
            const float rstd = ok[r] ? 1.f / sqrtf(wave_sum(s) * (1.f / DM) + EPS) : 0.f;
#pragma unroll
            for (int j = 0; j < 4; ++j) { const f32x4 w = ((const f32x4*)anorm)[64 * j + F.lane];
                o8[64 * j] = (unsigned long long)pk2(v[r][j].x * rstd * w.x, v[r][j].y * rstd * w.y) | ((unsigned long long)pk2(v[r][j].z * rstd * w.z, v[r][j].w * rstd * w.w) << 32); }
        }
    }
}

DI void row_ss_store(const f32x4 (&v)[2][2][4][2], float* SSP, int nslot, int slot, int row0, int fq, bool bj0_only) {
#pragma unroll
    for (int ai = 0; ai < 2; ++ai)
#pragma unroll
        for (int m = 0; m < 4; ++m) {
            float s = 0.f;
#pragma unroll
            for (int bj = 0; bj < 2; ++bj) if (bj == 0 || !bj0_only)
#pragma unroll
                for (int n = 0; n < 2; ++n) { const f32x4 x = v[ai][bj][m][n]; s += (x[0] * x[0] + x[1] * x[1]) + (x[2] * x[2] + x[3] * x[3]); }
            s += __shfl_xor(s, 16); s += __shfl_xor(s, 32);
            if (fq == 0) SSP[(size_t)(row0 + ai * 128 + m * 16) * nslot + slot] = s;
        }
}
DI float ss_sum4(const float* SSP, int row) { const f32x4 a = *(const f32x4*)(SSP + (size_t)row * 4); return (a.x + a.y) + (a.z + a.w); }
DI float ss_sum16(const float* SSP, int row) { const f32x4 a = *(const f32x4*)(SSP + (size_t)row * 16), b = *(const f32x4*)(SSP + (size_t)row * 16 + 4), c = *(const f32x4*)(SSP + (size_t)row * 16 + 8), d = *(const f32x4*)(SSP + (size_t)row * 16 + 12);
    return (((a.x + a.y) + (a.z + a.w)) + ((b.x + b.y) + (b.z + b.w))) + (((c.x + c.y) + (c.z + c.w)) + ((d.x + d.y) + (d.z + d.w))); }
struct EpiProj {
    static constexpr bool PERM = true;
    bf16_t* QKVR; bf16_t* Z; float* P32; bf16_t* CQ16; bf16_t* CKV16; float* KPE; float* SSQ; float* SSK;
    DI void operator()(const f32x4 (&acc)[2][2][4][2], const pg8::Unit& u, int wr, int wc, int fr, int fq) const {
        const int row0 = u.pm * 256 + wr * 64 + fr;
        if (u.pn < 8) {
            bf16_t* base; int ld, colt;
            if (u.pn < 6) { base = QKVR; ld = 1536; colt = u.pn * 256; } else { base = Z; ld = 512; colt = (u.pn - 6) * 256; }
            const int col0 = colt + wc * 32 + 8 * fq;
#pragma unroll
            for (int ai = 0; ai < 2; ++ai)
#pragma unroll
                for (int m = 0; m < 4; ++m) { bf16_t* rowp = base + (size_t)(row0 + ai * 128 + m * 16) * ld + col0;
#pragma unroll
                    for (int bj = 0; bj < 2; ++bj) { const f32x4 v0 = acc[ai][bj][m][0], v1 = acc[ai][bj][m][1];
                        u32x4 w; w.x = pg8::cvt_pk_bf16(v0[0], v0[1]); w.y = pg8::cvt_pk_bf16(v0[2], v0[3]); w.z = pg8::cvt_pk_bf16(v1[0], v1[1]); w.w = pg8::cvt_pk_bf16(v1[2], v1[3]);
                        *(u32x4*)(rowp + bj * 128) = w; } }
        } else {
            const int lcol0 = wc * 32 + 8 * fq;
            bf16_t* b16 = (u.pn == 8) ? CQ16 : CKV16;
#pragma unroll
            for (int ai = 0; ai < 2; ++ai)
#pragma unroll
                for (int m = 0; m < 4; ++m) { const size_t row = (size_t)(row0 + ai * 128 + m * 16);
                    float* rowp = P32 + row * 512 + (u.pn - 8) * 256 + lcol0;
#pragma unroll
                    for (int bj = 0; bj < 2; ++bj) { const f32x4 v0 = acc[ai][bj][m][0], v1 = acc[ai][bj][m][1];
                        *(f32x4*)(rowp + bj * 128) = v0; *(f32x4*)(rowp + bj * 128 + 4) = v1;
                        u32x4 w; w.x = pg8::cvt_pk_bf16(v0[0], v0[1]); w.y = pg8::cvt_pk_bf16(v0[2], v0[3]); w.z = pg8::cvt_pk_bf16(v1[0], v1[1]); w.w = pg8::cvt_pk_bf16(v1[2], v1[3]);
                        *(u32x4*)(b16 + row * 256 + lcol0 + bj * 128) = w;
                        if (u.pn == 9 && bj == 1 && wc == 0) { *(f32x4*)(KPE + row * 32 + 8 * fq) = v0; *(f32x4*)(KPE + row * 32 + 8 * fq + 4) = v1; }
                    } }
            row_ss_store(acc, (u.pn == 8) ? SSQ : SSK, 4, wc, row0, fq, u.pn == 9);
        }
    }
};
struct EpiB16 {
    static constexpr bool PERM = true;
    bf16_t* O; int ldc; const float* SS; float invn; int nslot;
    DI void operator()(const f32x4 (&acc)[2][2][4][2], const pg8::Unit& u, int wr, int wc, int fr, int fq) const {
        const int row0 = u.pm * 256 + wr * 64 + fr, col0 = u.pn * 256 + wc * 32 + 8 * fq;
#pragma unroll
        for (int ai = 0; ai < 2; ++ai)
#pragma unroll
            for (int m = 0; m < 4; ++m) { const int row = row0 + ai * 128 + m * 16; bf16_t* rowp = O + (size_t)row * ldc + col0;
                const float rs = SS ? 1.f / sqrtf((nslot == 16 ? ss_sum16(SS, row) : ss_sum4(SS, row)) * invn + EPS) : 1.f;
#pragma unroll
                for (int bj = 0; bj < 2; ++bj) { const f32x4 v0 = acc[ai][bj][m][0] * rs, v1 = acc[ai][bj][m][1] * rs;
                    u32x4 w; w.x = pg8::cvt_pk_bf16(v0[0], v0[1]); w.y = pg8::cvt_pk_bf16(v0[2], v0[3]); w.z = pg8::cvt_pk_bf16(v1[0], v1[1]); w.w = pg8::cvt_pk_bf16(v1[2], v1[3]);
                    *(u32x4*)(rowp + bj * 128) = w; } }
    }
};
struct EpiH1 {
    static constexpr bool PERM = true;
    float* C; const float* res; bf16_t* H16; float* SS;
    DI void operator()(const f32x4 (&acc)[2][2][4][2], const pg8::Unit& u, int wr, int wc, int fr, int fq) const {
        const int row0 = u.pm * 256 + wr * 64 + fr, col0 = u.pn * 256 + wc * 32 + 8 * fq;
        f32x4 v[2][2][4][2];
#pragma unroll
        for (int ai = 0; ai < 2; ++ai)
#pragma unroll
            for (int m = 0; m < 4; ++m) { const size_t off = (size_t)(row0 + ai * 128 + m * 16) * 1024 + col0;
#pragma unroll
                for (int bj = 0; bj < 2; ++bj) { const f32x4 v0 = acc[ai][bj][m][0] + *(const f32x4*)(res + off + bj * 128), v1 = acc[ai][bj][m][1] + *(const f32x4*)(res + off + bj * 128 + 4);
                    v[ai][bj][m][0] = v0; v[ai][bj][m][1] = v1;
                    *(f32x4*)(C + off + bj * 128) = v0; *(f32x4*)(C + off + bj * 128 + 4) = v1;
                    u32x4 w; w.x = pg8::cvt_pk_bf16(v0[0], v0[1]); w.y = pg8::cvt_pk_bf16(v0[2], v0[3]); w.z = pg8::cvt_pk_bf16(v1[0], v1[1]); w.w = pg8::cvt_pk_bf16(v1[2], v1[3]);
                    *(u32x4*)(H16 + off + bj * 128) = w; } }
        row_ss_store(v, SS, 16, u.pn * 4 + wc, row0, fq, false);
    }
};
struct EpiF32 {
    static constexpr bool PERM = true;
    float* C; int ldc; const float* res;
    DI void operator()(const f32x4 (&acc)[2][2][4][2], const pg8::Unit& u, int wr, int wc, int fr, int fq) const {
        const int row0 = u.pm * 256 + wr * 64 + fr, col0 = u.pn * 256 + wc * 32 + 8 * fq;
#pragma unroll
        for (int ai = 0; ai < 2; ++ai)
#pragma unroll
            for (int m = 0; m < 4; ++m) { const size_t off = (size_t)(row0 + ai * 128 + m * 16) * ldc + col0;
#pragma unroll
                for (int bj = 0; bj < 2; ++bj) { f32x4 v0 = acc[ai][bj][m][0], v1 = acc[ai][bj][m][1];
                    if (res) { v0 += *(const f32x4*)(res + off + bj * 128); v1 += *(const f32x4*)(res + off + bj * 128 + 4); }
                    *(f32x4*)(C + off + bj * 128) = v0; *(f32x4*)(C + off + bj * 128 + 4) = v1; } }
    }
};

DI f32x16 mfma32(bf16x8 a, bf16x8 b, f32x16 c) { return __builtin_amdgcn_mfma_f32_32x32x16_bf16(a, b, c, 0, 0, 0); }
DI f32x4 mfma16(bf16x8 a, bf16x8 b, f32x4 c) { return __builtin_amdgcn_mfma_f32_16x16x32_bf16(a, b, c, 0, 0, 0); }
DI int crow(int r, int hi) { return (r & 3) + 8 * (r >> 2) + 4 * hi; }
DI f32x16 zero16() { f32x16 z;
#pragma unroll
    for (int i = 0; i < 16; ++i) z[i] = 0.f; return z; }

constexpr int G_KF = 0, G_VF = 16384, G_MF = 32768;
constexpr int G_QB = 50176, G_KB = 59392, G_KBB = 68608;
constexpr int G_QKB = 77824, G_UT = 87040, G_WT = 96256, G_KDT = 105472;
constexpr int G_VEC = 114688;
constexpr int G_RAW = G_QKB;
constexpr int GST = 72;

DI f32x16 mm_quad(const unsigned char* A, const unsigned char* Bt, int qr, int qc, int lane) {
    const int r32 = lane & 31, hh = lane >> 5;
    const unsigned char* ap = A + (32 * qr + r32) * (GST * 2) + hh * 16;
    const unsigned char* bp = Bt + (32 * qc + r32) * (GST * 2) + hh * 16;
    f32x16 acc = zero16();
#pragma unroll
    for (int s = 0; s < 4; ++s) acc = mfma32(*(const bf16x8*)(ap + s * 32), *(const bf16x8*)(bp + s * 32), acc);
    return acc;
}

constexpr int G_RAW2 = 115712;
static_assert(G_RAW2 + 67 * 400 <= 143360, "GDN prep LDS map");
constexpr int G_CONVW = 143360 + 512;

#ifndef PROBE_STAGE
#define PROBE_STAGE -1
#endif
template <int VAR> DI void gdn_prep_phase(const Frame& F, const Args& A) {
    unsigned long long stg_t = 0ull, stg_acc = 0ull;
#define STG(n) do { if (PROBE_STAGE >= 0) { const unsigned long long now_ = __builtin_amdgcn_s_memrealtime(); if (PROBE_STAGE == (n)) stg_acc += now_ - stg_t; stg_t = now_; } } while (0)
    unsigned char* ws = A.ws; unsigned char* lds = F.lds;
    const int tid = F.tid, lane = F.lane, wave = F.wave;
    const bf16_t* QKVR = (const bf16_t*)(ws + WS_QKVR); const float* P32 = (const float*)(ws + WS_P32);
    float* KF = (float*)(lds + G_KF); float* VF = (float*)(lds + G_VF); float* MF = (float*)(lds + G_MF);
    float* VEC = (float*)(lds + G_VEC);
    if (VAR == 6) return;
    const int NIT = NCHUNK * 8;
#define LBAR() do { asm volatile("s_waitcnt lgkmcnt(0)" ::: "memory"); __builtin_amdgcn_s_barrier(); asm volatile("" ::: "memory"); } while (0)
#define LAUNDER(dst, src) int dst = (src); asm volatile("" : "+v"(dst))
    int item = blockIdx.x;
    if (item >= NIT) return;
    u32x4 pr[4]; float nb = 0.f, na = 0.f;
    auto raw_fetch = [&](int it) {
        const int c = it >> 3, h = it & 7; LAUNDER(tl, tid);
#pragma unroll
        for (int i = 0; i < 4; ++i) { const int q = tl + 512 * i; pr[i] = (u32x4){0u, 0u, 0u, 0u};
            if (q < 67 * 24) { const int r = q / 24, cc = q % 24, seg = cc >> 3, c8 = cc & 7; const int p = 64 * c - 3 + r;
                if (p >= 0) pr[i] = *(const u32x4*)(QKVR + (size_t)p * 1536 + seg * 512 + h * 64 + c8 * 8); } }
        if (wave == 0) { const int p = 64 * c + lane; nb = P32[(size_t)p * 512 + 416 + h]; na = P32[(size_t)p * 512 + 424 + h]; }
    };
    auto raw_park = [&]() {
        LAUNDER(tl, tid);
#pragma unroll
        for (int i = 0; i < 4; ++i) { const int q = tl + 512 * i;
            if (q < 67 * 24) { const int r = q / 24, cc = q % 24, seg = cc >> 3, c8 = cc & 7; *(u32x4*)(lds + G_RAW2 + r * 400 + (seg * 64 + c8 * 8) * 2) = pr[i]; } }
    };
    raw_fetch(item); raw_park();
    float cb = nb, ca = na;
    float* CWL = (float*)(lds + G_CONVW);
    int cw_h = -1;
#pragma unroll 1
    for (; item < NIT; item += F.G) {
        if (PROBE_STAGE >= 0 && stg_t == 0ull) stg_t = __builtin_amdgcn_s_memrealtime();
        const int c = item >> 3, h = item & 7;
        if (h != cw_h) { cw_h = h;
            if (tid < 192) { LAUNDER(t0, tid); const int sg = t0 >> 6, jt = (t0 >> 4) & 3, c4 = t0 & 15; *(f32x4*)(CWL + (sg * 4 + jt) * 64 + 4 * c4) = *(const f32x4*)(A.in[4] + jt * 1536 + sg * 512 + h * 64 + 4 * c4); } }
        const int nxt = item + F.G;
        if (VAR != 5 && nxt < NIT) raw_fetch(nxt);
        if (wave == 0) {
            const int p = 64 * c + lane;
            const float alog = A.in[5][h], dtb = A.in[6][h];
            float beta = sigmoidf_(cb);
            const float xx = ca + dtb; const float sp = xx > 20.f ? xx : log1pf(__expf(xx));
            float g = -__expf(alog) * sp;
            if (p < PADL) { beta = 0.f; g = 0.f; }
            float gc = g;
#pragma unroll
            for (int o = 1; o < 64; o <<= 1) { const float t = __shfl_up(gc, o); if (lane >= o) gc += t; }
            const float glast = __shfl(gc, 63);
            VEC[lane] = gc; VEC[64 + lane] = beta; VEC[128 + lane] = __expf(gc); VEC[192 + lane] = __expf(glast - gc);
        }
        LBAR(); STG(0);
        LAUNDER(t1, tid); const int sub = t1 & 15, grp = t1 >> 4;
#pragma unroll
        for (int sg = 0; sg < ((VAR == 2 || VAR >= 4) ? 0 : 3); ++sg) {
#pragma unroll
            for (int ps = 0; ps < 2; ++ps) {
                const int i = grp + 32 * ps;
                float acc[4] = {0.f, 0.f, 0.f, 0.f};
#pragma unroll
                for (int jt = 0; jt < 4; ++jt) {
                    const f32x4 w = *(const f32x4*)(CWL + (sg * 4 + jt) * 64 + 4 * sub);
                    const u32x2 rv = *(const u32x2*)(lds + G_RAW2 + (i + jt) * 400 + (sg * 64 + 4 * sub) * 2);
                    acc[0] += w.x * bflo(rv.x); acc[1] += w.y * bfhi(rv.x); acc[2] += w.z * bflo(rv.y); acc[3] += w.w * bfhi(rv.y);
                }
                float y[4];
#pragma unroll
                for (int k = 0; k < 4; ++k) y[k] = siluf_(acc[k]);
                if (sg < 2) {
                    float ss = (y[0] * y[0] + y[1] * y[1]) + (y[2] * y[2] + y[3] * y[3]);
                    ss += __shfl_xor(ss, 1); ss += __shfl_xor(ss, 2); ss += __shfl_xor(ss, 4); ss += __shfl_xor(ss, 8);
                    const float rn = 1.f / sqrtf(ss + EPS);
#pragma unroll
                    for (int k = 0; k < 4; ++k) y[k] *= rn;
                }
                if (sg == 0) {
                    u32x2 o; o.x = pk2(y[0] * 0.125f, y[1] * 0.125f); o.y = pk2(y[2] * 0.125f, y[3] * 0.125f);
                    *(u32x2*)(lds + G_QB + i * (GST * 2) + 8 * sub) = o;
                } else if (sg == 1) {
                    const float beta = VEC[64 + i], ekd = VEC[192 + i];
                    *(f32x4*)(KF + i * 64 + 4 * sub) = (f32x4){y[0], y[1], y[2], y[3]};
                    u32x2 o; o.x = pk2(y[0], y[1]); o.y = pk2(y[2], y[3]);
                    *(u32x2*)(lds + G_KB + i * (GST * 2) + 8 * sub) = o;
                    o.x = pk2(y[0] * beta, y[1] * beta); o.y = pk2(y[2] * beta, y[3] * beta);
                    *(u32x2*)(lds + G_KBB + i * (GST * 2) + 8 * sub) = o;
#pragma unroll
                    for (int k = 0; k < 4; ++k) *(bf16_t*)(lds + G_KDT + (4 * sub + k) * (GST * 2) + i * 2) = (bf16_t)f2bf(y[k] * ekd);
                } else {
                    *(f32x4*)(VF + i * 64 + 4 * sub) = (f32x4){y[0], y[1], y[2], y[3]};
                }
            }
        }
        LBAR(); STG(1);
        if (VAR != 3 && VAR < 4) {
            LAUNDER(l3, lane);
            const int prod = wave >> 2, quad = wave & 3, qr = quad >> 1, qc = quad & 1, r32 = l3 & 31, hh = l3 >> 5;
            const f32x16 acc = mm_quad(lds + (prod ? G_QB : G_KBB), lds + G_KB, qr, qc, l3);
            const int j = 32 * qc + r32; const float gcj = VEC[j];
#pragma unroll
            for (int r = 0; r < 16; ++r) {
                const int i = 32 * qr + crow(r, hh);
                if (prod == 0) { MF[i * 68 + j] = (j < i) ? acc[r] * __expf(VEC[i] - gcj) : 0.f; }
                else { *(bf16_t*)(lds + G_QKB + i * (GST * 2) + j * 2) = (bf16_t)f2bf((j <= i) ? acc[r] * __expf(VEC[i] - gcj) : 0.f); }
            }
        }
        LBAR(); STG(2);
        float* DB = (float*)(lds + G_KBB);
        if (VAR != 1 && VAR < 4 && wave == 0) {
            LAUNDER(l4, lane); const int b = l4 >> 4, jc = l4 & 15;
            float d[16];
#pragma unroll
            for (int i = 0; i < 16; ++i) {
                float acc = (i == jc) ? 1.f : 0.f;
                const float* mrow = MF + (16 * b + i) * 68 + 16 * b;
#pragma unroll
                for (int k = 0; k < i; ++k) acc -= mrow[k] * d[k];
                d[i] = acc;
            }
#pragma unroll
            for (int i = 0; i < 16; ++i) DB[(b * 16 + i) * 20 + jc] = d[i];
        }
        LBAR();
        if (VAR != 1 && VAR < 4) {
            LAUNDER(l4, lane); const int cc = l4 & 15, g = l4 >> 4;
            const bool isU = wave < 4; const int col = 16 * (wave & 3) + cc;
            const float* src = (isU ? VF : KF) + col;
            f32x4 X[4];
#pragma unroll
            for (int b = 0; b < 4; ++b) {
                f32x4 acc;
#pragma unroll
                for (int r = 0; r < 4; ++r) { const int i = 16 * b + 4 * g + r; float rv = src[i * 64] * VEC[64 + i]; if (!isU) rv *= VEC[128 + i]; acc[r] = -rv; }
#pragma unroll
                for (int a = 0; a < b; ++a) {
                    const f32x4 lv = *(const f32x4*)(MF + (16 * b + cc) * 68 + 16 * a + 4 * g);
#pragma unroll
                    for (int sp = 0; sp < 4; ++sp) acc = __builtin_amdgcn_mfma_f32_16x16x4f32(lv[sp], X[a][sp], acc, 0, 0, 0);
                }
                const f32x4 dv = *(const f32x4*)(DB + (b * 16 + cc) * 20 + 4 * g);
                f32x4 xb = (f32x4){0.f, 0.f, 0.f, 0.f};
#pragma unroll
                for (int sp = 0; sp < 4; ++sp) xb = __builtin_amdgcn_mfma_f32_16x16x4f32(dv[sp], acc[sp], xb, 0, 0, 0);
                X[b] = -xb;
                unsigned char* dst = lds + (isU ? G_UT : G_WT) + col * (GST * 2) + (16 * b + 4 * g) * 2;
                *(u32x2*)dst = (u32x2){pk2(X[b][0], X[b][1]), pk2(X[b][2], X[b][3])};
            }
        }
        LBAR(); STG(3);
        if (VAR != 3 && VAR < 4) {
            const float gl = VEC[128 + 63];
            bf16_t* GB = (bf16_t*)(ws + WS_GB) + (size_t)item * 4096;
            bf16_t* GQ = (bf16_t*)(ws + (VAR ? WS_GS : WS_GQ)) + (size_t)item * 4096; bf16_t* GO = (bf16_t*)(ws + (VAR ? WS_GS : WS_GO)) + (size_t)item * 4096;
            bf16_t* GAL = (bf16_t*)(lds + G_MF);
            LAUNDER(l5, lane); const int r32 = l5 & 31, hh = l5 >> 5;
#pragma unroll 1
            for (int it = 0; it < 2; ++it) {
                const int task = wave + 8 * it, prod = task >> 2, quad = task & 3, qr = quad >> 1, qc = quad & 1;
                const f32x16 acc = mm_quad(lds + (prod < 2 ? G_KDT : G_QKB), lds + ((prod & 1) ? G_UT : G_WT), qr, qc, l5);
                const int Cc = 32 * qc + r32;
                if (prod == 0) {
#pragma unroll
                    for (int r = 0; r < 16; ++r) {
                        const int R = 32 * qr + crow(r, hh);
                        const float val = ((R == Cc) ? gl : 0.f) - acc[r];
                        const int rb = R >> 4, m = R & 15, q4 = Cc >> 4, g = (Cc >> 2) & 3, rr = Cc & 3, ks = q4 >> 1, jj = 4 * (q4 & 1) + rr, ls = 16 * g + m;
                        GAL[((rb * 2 + ks) * 64 + ls) * 8 + jj] = (bf16_t)f2bf(val);
                    }
                } else if (prod == 1) {
                    const int eslab = Cc >> 4, n = Cc & 15;
#pragma unroll
                    for (int a = 0; a < 4; ++a) {
                        const int R0 = 32 * qr + 8 * a + 4 * hh; const int rb = R0 >> 4, g = (R0 >> 2) & 3, ls = 16 * g + n;
                        *(u32x2*)(GB + ((eslab * 4 + rb) * 64 + ls) * 4) = (u32x2){pk2(acc[4 * a], acc[4 * a + 1]), pk2(acc[4 * a + 2], acc[4 * a + 3])};
                    }
                } else if (prod == 2) {
#pragma unroll
                    for (int r = 0; r < 16; ++r) {
                        const int R = 32 * qr + crow(r, hh);
                        const float qv = bf2f(*(const bf16_t*)(lds + G_QB + R * (GST * 2) + Cc * 2));
                        GQ[R * 64 + Cc] = (bf16_t)f2bf(qv * VEC[128 + R] - acc[r]);
                    }
                } else {
#pragma unroll
                    for (int r = 0; r < 16; ++r) GO[(quad * 16 + r) * 64 + l5] = (bf16_t)f2bf(acc[r]);
                }
            }
        }
        if (VAR != 5 && nxt < NIT) { raw_park(); cb = nb; ca = na; }
        LBAR(); STG(4);
        if (VAR != 5) { LAUNDER(t6, tid); *(u32x4*)((bf16_t*)(ws + (VAR ? WS_GS : WS_GA)) + (size_t)item * 4096 + t6 * 8) = *(const u32x4*)(lds + G_MF + t6 * 16); }
        STG(5);
    }
    if (PROBE_STAGE >= 0 && tid == 0) { *(unsigned long long*)(lds + 143360 + 96) = stg_acc; }
}

constexpr int SC_D = 8, SC_PD = 6, SC_SLOT = 10240;
DI void gdn_scan(const Frame& F, const Args& A) {
    if (blockIdx.x >= 32) return;
    unsigned char* ws = A.ws;
    const int h = blockIdx.x & 7, eslab = blockIdx.x >> 3, lane = F.lane, wave = F.wave, n = lane & 15, g = lane >> 4;
    const unsigned char* GA = ws + WS_GA; const unsigned char* GB = ws + WS_GB; bf16_t* GS = (bf16_t*)(ws + WS_GS);
    LAS unsigned char* ring = (LAS unsigned char*)F.lds;
    const int np = (wave == 0) ? 0 : ((wave - 1 < 3) ? 2 : 1);
    auto issue = [&](int c) {
        const int cc = c < NCHUNK ? c : NCHUNK - 1;
        const size_t item = (size_t)cc * 8 + h;
        LAS unsigned char* slot = ring + (c % SC_D) * SC_SLOT;
#pragma unroll
        for (int i = 0; i < 2; ++i) if (i < np) {
            const int q = (wave - 1) + 7 * i;
            const unsigned char* src = (q < 8) ? GA + item * 8192 + q * 1024 : GB + item * 8192 + eslab * 2048 + (q - 8) * 1024;
            LAS unsigned char* dst = slot + ((q < 8) ? q * 1024 : 8192 + (q - 8) * 1024);
            __builtin_amdgcn_global_load_lds((const unsigned*)(src + lane * 16), (LAS unsigned*)dst, 16, 0, 0);
        }
    };
    for (int c = 0; c < SC_PD; ++c) issue(c);
    f32x4 S[4];
#pragma unroll
    for (int rb = 0; rb < 4; ++rb) S[rb] = (f32x4){0.f, 0.f, 0.f, 0.f};
#pragma unroll 1
    for (int c = 0; c < NCHUNK; ++c) {
        issue(c + SC_PD);
        if (np == 2) asm volatile("s_waitcnt vmcnt(12)" ::: "memory");
        else if (np == 1) asm volatile("s_waitcnt vmcnt(6)" ::: "memory");
        asm volatile("s_waitcnt lgkmcnt(0)" ::: "memory");
        __builtin_amdgcn_s_barrier();
        asm volatile("" ::: "memory");
        if (wave == 0) {
            const LAS unsigned char* slot = ring + (c % SC_D) * SC_SLOT;
            bf16x8 ac[8]; f32x4 bc[4];
#pragma unroll
            for (int q = 0; q < 8; ++q) ac[q] = *(const LAS bf16x8*)(slot + q * 1024 + lane * 16);
#pragma unroll
            for (int rb = 0; rb < 4; ++rb) { const u32x2 w = *(const LAS u32x2*)(slot + 8192 + rb * 512 + lane * 8); bc[rb] = (f32x4){bflo(w.x), bfhi(w.x), bflo(w.y), bfhi(w.y)}; }
            const size_t item = (size_t)c * 8 + h;
            u32x4 p0, p1;
            p0.x = pk2(S[0][0], S[0][1]); p0.y = pk2(S[0][2], S[0][3]); p0.z = pk2(S[1][0], S[1][1]); p0.w = pk2(S[1][2], S[1][3]);
            p1.x = pk2(S[2][0], S[2][1]); p1.y = pk2(S[2][2], S[2][3]); p1.z = pk2(S[3][0], S[3][1]); p1.w = pk2(S[3][2], S[3][3]);
            {
                bf16_t* st = GS + item * 4096 + (16 * eslab + n) * 64 + 4 * g;
                *(u32x2*)(st + 0) = (u32x2){p0.x, p0.y}; *(u32x2*)(st + 16) = (u32x2){p0.z, p0.w};
                *(u32x2*)(st + 32) = (u32x2){p1.x, p1.y}; *(u32x2*)(st + 48) = (u32x2){p1.z, p1.w};
            }
            const bf16x8 b0 = __builtin_bit_cast(bf16x8, p0), b1 = __builtin_bit_cast(bf16x8, p1);
#pragma unroll
            for (int rb = 0; rb < 4; ++rb) {
                f32x4 acc = bc[rb];
                acc = mfma16(ac[rb * 2 + 0], b0, acc);
                acc = mfma16(ac[rb * 2 + 1], b1, acc);
                S[rb] = acc;
            }
        }
    }
    asm volatile("s_waitcnt vmcnt(0) lgkmcnt(0)" ::: "memory");
    __builtin_amdgcn_s_barrier();
}

DI void gdn_out_task(const Frame& F, const Args& A, int task) {
    unsigned char* ws = A.ws;
    const int ihalf = task & 1, item = (task >> 1) + 8, c = item >> 3, h = item & 7, lane = F.lane, r32 = lane & 31, hh = lane >> 5;
    const bf16_t* GQ = (const bf16_t*)(ws + WS_GQ) + (size_t)item * 4096; const bf16_t* GS = (const bf16_t*)(ws + WS_GS) + (size_t)item * 4096;
    const bf16_t* GO = (const bf16_t*)(ws + WS_GO) + (size_t)item * 4096;
    const bf16_t* Z = (const bf16_t*)(ws + WS_Z); bf16_t* MIX = (bf16_t*)(ws + WS_MIX);
    f32x16 acc[2];
#pragma unroll
    for (int eh = 0; eh < 2; ++eh)
#pragma unroll
        for (int r = 0; r < 16; ++r) acc[eh][r] = bf2f(GO[((ihalf * 2 + eh) * 16 + r) * 64 + lane]);
#pragma unroll
    for (int s = 0; s < 4; ++s) {
        const bf16x8 a = *(const bf16x8*)(GQ + (32 * ihalf + r32) * 64 + 16 * s + 8 * hh);
#pragma unroll
        for (int eh = 0; eh < 2; ++eh) {
            const bf16x8 b = *(const bf16x8*)(GS + (32 * eh + r32) * 64 + 16 * s + 8 * hh);
            acc[eh] = mfma32(a, b, acc[eh]);
        }
    }
    const float* gnorm = A.in[7];
    const float w0 = gnorm[r32], w1 = gnorm[32 + r32];
#pragma unroll
    for (int r = 0; r < 16; ++r) {
        float ss = acc[0][r] * acc[0][r] + acc[1][r] * acc[1][r];
        ss += __shfl_xor(ss, 1); ss += __shfl_xor(ss, 2); ss += __shfl_xor(ss, 4); ss += __shfl_xor(ss, 8); ss += __shfl_xor(ss, 16);
        const float rstd = 1.f / sqrtf(ss * (1.f / 64.f) + EPS);
        const int i = 32 * ihalf + crow(r, hh); const int p = 64 * c + i;
        const float z0 = bf2f(Z[(size_t)p * 512 + h * 64 + r32]), z1 = bf2f(Z[(size_t)p * 512 + h * 64 + 32 + r32]);
        bf16_t* o = MIX + (size_t)(p - 64) * 1024 + h * 64;
        o[r32] = (bf16_t)f2bf(acc[0][r] * rstd * w0 * siluf_(z0));
        o[32 + r32] = (bf16_t)f2bf(acc[1][r] * rstd * w1 * siluf_(z1));
    }
}

DI void mla_prep1_rows(const Frame& F, const Args& A, int p0, int stride) {
    unsigned char* ws = A.ws; const int lane = F.lane;
    f32x4 q[4]; float k0[4], k1[4], pe[4];
#pragma unroll
    for (int r = 0; r < 4; ++r) { const int p = p0 + r * stride; const int pc = p < MP ? p : MP - 1;
        const float* P32 = (const float*)(ws + WS_P32) + (size_t)pc * 512;
        q[r] = *(const f32x4*)(P32 + 4 * lane); k0[r] = P32[256 + 2 * lane]; k1[r] = P32[256 + 2 * lane + 1]; pe[r] = P32[384 + (lane & 31)]; }
    const f32x4 wq = *(const f32x4*)(A.in[8] + 4 * lane);
    const float wk0 = A.in[9][2 * lane], wk1 = A.in[9][2 * lane + 1];
#pragma unroll
    for (int r = 0; r < 4; ++r) {
        const int p = p0 + r * stride; if (p >= MP) continue;
        bf16_t* CQN = (bf16_t*)(ws + WS_CQN) + (size_t)p * 256; bf16_t* CKVN = (bf16_t*)(ws + WS_CKVN) + (size_t)p * 256;
        const float sq = wave_sum((q[r].x * q[r].x + q[r].y * q[r].y) + (q[r].z * q[r].z + q[r].w * q[r].w));
        const float rq = 1.f / sqrtf(sq * (1.f / 256.f) + EPS);
        *(u32x2*)(CQN + 4 * lane) = (u32x2){pk2(q[r].x * rq * wq.x, q[r].y * rq * wq.y), pk2(q[r].z * rq * wq.z, q[r].w * rq * wq.w)};
        const float sk = wave_sum(k0[r] * k0[r] + k1[r] * k1[r]);
        const float rk = 1.f / sqrtf(sk * (1.f / 128.f) + EPS);
        *(unsigned*)(CKVN + 2 * lane) = pk2(k0[r] * rk * wk0, k1[r] * rk * wk1);
        *(unsigned*)(CKVN + 128 + 2 * lane) = 0u;
        if (lane < 32) ((float*)(ws + WS_KPE))[(size_t)p * 32 + lane] = pe[r];
    }
}

constexpr float QSCALE = 0.10206207261596577f * 1.4426950408889634f;
DI double rope_inv_rev(int i) {
    const double t8[8] = {0.15915494309189535, 0.08949940160889101, 0.050329212104487035, 0.0283021958306234, 0.015915494309189534, 0.008949940160889102, 0.005032921210448704, 0.00283021958306234};
    double v = t8[0];
#pragma unroll
    for (int k = 1; k < 8; ++k) v = ((i & 7) == k) ? t8[k] : v;
    return (i & 8) ? v * 0.01 : v;
}
constexpr int P2_TS = 136;
constexpr int P2_RS = 272;
#define P2_WSYNC() do { __builtin_amdgcn_s_waitcnt(0); __builtin_amdgcn_wave_barrier(); } while (0)
DI void mla_prep2_task(const Frame& F, const Args& A, int task) {
    unsigned char* ws = A.ws; int lane = F.lane; asm volatile("" : "+v"(lane));
    const int h = task & 7, blk = task >> 3;
    const int p = 64 * blk + lane;
    const bool valid = (p >= PADL) && (p < LPV);
    const float* qn = A.in[12]; const float* kn = A.in[13];
    unsigned char* TS = F.lds + F.wave * (64 * P2_RS);
    unsigned char* trow = TS + lane * P2_RS;
    const double pos = (double)(p - PADL);
    auto rot = [&](int i, float& sn_, float& cs_) { const double rev = pos * rope_inv_rev(i); const float fr = (float)(rev - floor(rev)); sn_ = __builtin_amdgcn_sinf(fr); cs_ = __builtin_amdgcn_cosf(fr); };
    {
        {
            const bf16_t* srcb = (const bf16_t*)(ws + WS_QH) + (size_t)(64 * blk) * 768 + h * 96;
            u32x4 t[12];
#pragma unroll
            for (int i = 0; i < 12; ++i) { const int c = 64 * i + lane, r = c / 12, pc = c % 12; t[i] = *(const u32x4*)(srcb + (size_t)r * 768 + 8 * pc); }
#pragma unroll
            for (int i = 0; i < 12; ++i) { const int c = 64 * i + lane, r = c / 12, pc = c % 12; *(u32x4*)(TS + r * P2_RS + 16 * pc) = t[i]; }
            P2_WSYNC();
        }
        u32x4 w[12];
#pragma unroll
        for (int c = 0; c < 12; ++c) w[c] = *(const u32x4*)(trow + 16 * c);
        float ss = 0.f;
#pragma unroll
        for (int c = 0; c < 12; ++c) { const float a0 = bflo(w[c].x), a1 = bfhi(w[c].x), a2 = bflo(w[c].y), a3 = bfhi(w[c].y), a4 = bflo(w[c].z), a5 = bfhi(w[c].z), a6 = bflo(w[c].w), a7 = bfhi(w[c].w);
            ss += (a0 * a0 + a1 * a1) + (a2 * a2 + a3 * a3) + (a4 * a4 + a5 * a5) + (a6 * a6 + a7 * a7); }
        const float rs = valid ? QSCALE / sqrtf(ss * (1.f / 96.f) + EPS) : 0.f;
        unsigned char* dst = trow;
#pragma unroll
        for (int c = 0; c < 8; ++c) {
            const f32x4 g0 = *(const f32x4*)(qn + 8 * c), g1 = *(const f32x4*)(qn + 8 * c + 4);
            *(u32x4*)(dst + 16 * c) = (u32x4){pk2(bflo(w[c].x) * rs * g0.x, bfhi(w[c].x) * rs * g0.y), pk2(bflo(w[c].y) * rs * g0.z, bfhi(w[c].y) * rs * g0.w),
                                              pk2(bflo(w[c].z) * rs * g1.x, bfhi(w[c].z) * rs * g1.y), pk2(bflo(w[c].w) * rs * g1.z, bfhi(w[c].w) * rs * g1.w)};
        }
#pragma unroll
        for (int c = 0; c < 2; ++c) {
            float x1[8], x2[8];
            const u32x4 wa = w[8 + c], wb = w[10 + c];
            x1[0] = bflo(wa.x); x1[1] = bfhi(wa.x); x1[2] = bflo(wa.y); x1[3] = bfhi(wa.y); x1[4] = bflo(wa.z); x1[5] = bfhi(wa.z); x1[6] = bflo(wa.w); x1[7] = bfhi(wa.w);
            x2[0] = bflo(wb.x); x2[1] = bfhi(wb.x); x2[2] = bflo(wb.y); x2[3] = bfhi(wb.y); x2[4] = bflo(wb.z); x2[5] = bfhi(wb.z); x2[6] = bflo(wb.w); x2[7] = bfhi(wb.w);
            float o1[8], o2[8];
#pragma unroll
            for (int t = 0; t < 8; ++t) { float sn_, cs_; rot(8 * c + t, sn_, cs_); const float a = x1[t] * rs * qn[64 + 8 * c + t], b = x2[t] * rs * qn[80 + 8 * c + t]; o1[t] = a * cs_ - b * sn_; o2[t] = b * cs_ + a * sn_; }
            *(u32x4*)(dst + 2 * (64 + 8 * c)) = (u32x4){pk2(o1[0], o1[1]), pk2(o1[2], o1[3]), pk2(o1[4], o1[5]), pk2(o1[6], o1[7])};
            *(u32x4*)(dst + 2 * (80 + 8 * c)) = (u32x4){pk2(o2[0], o2[1]), pk2(o2[2], o2[3]), pk2(o2[4], o2[5]), pk2(o2[6], o2[7])};
        }
        P2_WSYNC();
        {
            unsigned char* outb = (unsigned char*)((bf16_t*)(ws + WS_Q) + ((size_t)h * KVROWS + 64 * blk) * 96);
            u32x4 t[12];
#pragma unroll
            for (int i = 0; i < 12; ++i) { const int c = 64 * i + lane, r = c / 12, pc = c % 12; t[i] = *(const u32x4*)(TS + r * P2_RS + 16 * pc); }
#pragma unroll
            for (int i = 0; i < 12; ++i) *(u32x4*)(outb + (size_t)(64 * i + lane) * 16) = t[i];
            P2_WSYNC();
        }
    }
    {
        {
            const bf16_t* srcb = (const bf16_t*)(ws + WS_KVB) + (size_t)(64 * blk) * 1024 + h * 128;
            const unsigned char* kpb = (const unsigned char*)((const float*)(ws + WS_KPE) + (size_t)(64 * blk) * 32);
            u32x4 t[8], e8[8];
#pragma unroll
            for (int i = 0; i < 8; ++i) { const int c = 64 * i + lane, r = c >> 3, pc = c & 7; t[i] = *(const u32x4*)(srcb + (size_t)r * 1024 + 8 * pc); e8[i] = *(const u32x4*)(kpb + (size_t)c * 16); }
#pragma unroll
            for (int i = 0; i < 8; ++i) { const int c = 64 * i + lane, r = c >> 3, pc = c & 7; *(u32x4*)(TS + r * P2_RS + 16 * pc) = t[i]; *(u32x4*)(TS + r * P2_RS + 128 + 16 * pc) = e8[i]; }
            P2_WSYNC();
        }
        u32x4 w[8]; f32x4 e[8];
#pragma unroll
        for (int c = 0; c < 8; ++c) { w[c] = *(const u32x4*)(trow + 16 * c); e[c] = *(const f32x4*)(trow + 128 + 16 * c); }
        float ss = 0.f;
#pragma unroll
        for (int c = 0; c < 8; ++c) { const float a0 = bflo(w[c].x), a1 = bfhi(w[c].x), a2 = bflo(w[c].y), a3 = bfhi(w[c].y), a4 = bflo(w[c].z), a5 = bfhi(w[c].z), a6 = bflo(w[c].w), a7 = bfhi(w[c].w);
            ss += (a0 * a0 + a1 * a1) + (a2 * a2 + a3 * a3) + (a4 * a4 + a5 * a5) + (a6 * a6 + a7 * a7);
            ss += (e[c].x * e[c].x + e[c].y * e[c].y) + (e[c].z * e[c].z + e[c].w * e[c].w); }
        const float rs = valid ? 1.f / sqrtf(ss * (1.f / 96.f) + EPS) : 0.f;
        unsigned char* dst = trow;
#pragma unroll
        for (int c = 0; c < 8; ++c) {
            const f32x4 g0 = *(const f32x4*)(kn + 8 * c), g1 = *(const f32x4*)(kn + 8 * c + 4);
            *(u32x4*)(dst + 16 * c) = (u32x4){pk2(bflo(w[c].x) * rs * g0.x, bfhi(w[c].x) * rs * g0.y), pk2(bflo(w[c].y) * rs * g0.z, bfhi(w[c].y) * rs * g0.w),
                                              pk2(bflo(w[c].z) * rs * g1.x, bfhi(w[c].z) * rs * g1.y), pk2(bflo(w[c].w) * rs * g1.z, bfhi(w[c].w) * rs * g1.w)};
        }
#pragma unroll
        for (int c = 0; c < 2; ++c) {
            const float x1[8] = {e[2 * c].x, e[2 * c].y, e[2 * c].z, e[2 * c].w, e[2 * c + 1].x, e[2 * c + 1].y, e[2 * c + 1].z, e[2 * c + 1].w};
            const float x2[8] = {e[4 + 2 * c].x, e[4 + 2 * c].y, e[4 + 2 * c].z, e[4 + 2 * c].w, e[5 + 2 * c].x, e[5 + 2 * c].y, e[5 + 2 * c].z, e[5 + 2 * c].w};
            float o1[8], o2[8];
#pragma unroll
            for (int t = 0; t < 8; ++t) { float sn_, cs_; rot(8 * c + t, sn_, cs_); const float a = x1[t] * rs * kn[64 + 8 * c + t], b = x2[t] * rs * kn[80 + 8 * c + t]; o1[t] = a * cs_ - b * sn_; o2[t] = b * cs_ + a * sn_; }
            *(u32x4*)(dst + 2 * (64 + 8 * c)) = (u32x4){pk2(o1[0], o1[1]), pk2(o1[2], o1[3]), pk2(o1[4], o1[5]), pk2(o1[6], o1[7])};
            *(u32x4*)(dst + 2 * (80 + 8 * c)) = (u32x4){pk2(o2[0], o2[1]), pk2(o2[2], o2[3]), pk2(o2[4], o2[5]), pk2(o2[6], o2[7])};
        }
        P2_WSYNC();
        {
            unsigned char* outb = (unsigned char*)((bf16_t*)(ws + WS_K) + ((size_t)h * KVROWS + 64 * blk) * 96);
            u32x4 t[12];
#pragma unroll
            for (int i = 0; i < 12; ++i) { const int c = 64 * i + lane, r = c / 12, pc = c % 12; t[i] = *(const u32x4*)(TS + r * P2_RS + 16 * pc); }
#pragma unroll
            for (int i = 0; i < 12; ++i) *(u32x4*)(outb + (size_t)(64 * i + lane) * 16) = t[i];
            P2_WSYNC();
        }
    }
    {
        unsigned char* T = TS;
        const bf16_t* src = (const bf16_t*)(ws + WS_KVB) + h * 128 + 64;
#pragma unroll
        for (int it = 0; it < 8; ++it) {
            const int pr = 8 * it + (lane >> 3), ch = lane & 7; const int pp = 64 * blk + pr;
            u32x4 v = (u32x4){0u, 0u, 0u, 0u};
            if (pp >= PADL && pp < LPV) v = *(const u32x4*)(src + (size_t)pp * 1024 + 8 * ch);
            unsigned char* tp = T + (8 * ch) * P2_TS + pr * 2;
            *(bf16_t*)(tp + 0 * P2_TS) = (bf16_t)(v.x & 0xffffu); *(bf16_t*)(tp + 1 * P2_TS) = (bf16_t)(v.x >> 16);
            *(bf16_t*)(tp + 2 * P2_TS) = (bf16_t)(v.y & 0xffffu); *(bf16_t*)(tp + 3 * P2_TS) = (bf16_t)(v.y >> 16);
            *(bf16_t*)(tp + 4 * P2_TS) = (bf16_t)(v.z & 0xffffu); *(bf16_t*)(tp + 5 * P2_TS) = (bf16_t)(v.z >> 16);
            *(bf16_t*)(tp + 6 * P2_TS) = (bf16_t)(v.w & 0xffffu); *(bf16_t*)(tp + 7 * P2_TS) = (bf16_t)(v.w >> 16);
        }
        __builtin_amdgcn_s_waitcnt(0); __builtin_amdgcn_wave_barrier();
        bf16_t* VT = (bf16_t*)(ws + WS_VT) + (size_t)h * 64 * KVROWS + 64 * blk;
#pragma unroll
        for (int it = 0; it < 8; ++it) {
            const int e = 8 * it + (lane >> 3), ch = lane & 7;
            const u32x2 lo = *(const u32x2*)(T + e * P2_TS + 16 * ch), hi = *(const u32x2*)(T + e * P2_TS + 16 * ch + 8);
            *(u32x4*)(VT + (size_t)e * KVROWS + 8 * ch) = (u32x4){lo.x, lo.y, hi.x, hi.y};
        }
        __builtin_amdgcn_s_waitcnt(0); __builtin_amdgcn_wave_barrier();
    }
}

constexpr int A_KSTR = 208;
constexpr int A_VSTR = 136;
constexpr int A_KBYTES = 64 * A_KSTR;
constexpr int A_VBYTES = 64 * A_VSTR;
constexpr int A_BUF = A_KBYTES + A_VBYTES;
DI unsigned cvtpk_s(float lo, float hi) { typedef float f2 __attribute__((ext_vector_type(2))); typedef __bf16 b2 __attribute__((ext_vector_type(2))); f2 v = {lo, hi}; b2 b = __builtin_convertvector(v, b2); return __builtin_bit_cast(unsigned, b); }

DI void attn_item(const Frame& F, const Args& A, int h, int qb) {
    unsigned char* ws = A.ws; unsigned char* lds = F.lds;
    const int tid = F.tid, lane = F.lane, wave = F.wave, r32 = lane & 31, hh = lane >> 5;
    const bf16_t* Qg = (const bf16_t*)(ws + WS_Q) + (size_t)h * KVROWS * 96;
    const bf16_t* Kg = (const bf16_t*)(ws + WS_K) + (size_t)h * KVROWS * 96;
    const bf16_t* Vg = (const bf16_t*)(ws + WS_VT) + (size_t)h * 64 * KVROWS;
    const int p0w = 64 + 256 * qb + 32 * wave;
    const int qp = p0w + r32;
    const int ntile = 4 * qb + 5;
    const int mylast = 1 + 4 * qb + (wave >> 1);
    bf16x8 qf[6];
#pragma unroll
    for (int s = 0; s < 6; ++s) qf[s] = *(const bf16x8*)(Qg + (size_t)qp * 96 + 16 * s + 8 * hh);
    f32x16 ot[2]; ot[0] = zero16(); ot[1] = zero16();
    float mrun = -1e30f, lrun = 0.f;
    const int kr0 = tid / 12, kc0 = tid % 12, kr1 = (tid + 512) / 12, kc1 = (tid + 512) % 12; const bool k1ok = tid < 256;
    const int vr = tid >> 3, vc = tid & 7;
    struct Stg { u32x4 k0, k1, v; };
    Stg sA, sB;
    auto gload = [&](Stg& st, int j) {
        const int kv0 = 64 * j;
        st.k0 = *(const u32x4*)(Kg + (size_t)(kv0 + kr0) * 96 + kc0 * 8);
        if (k1ok) st.k1 = *(const u32x4*)(Kg + (size_t)(kv0 + kr1) * 96 + kc1 * 8);
        st.v = *(const u32x4*)(Vg + (size_t)vr * KVROWS + kv0 + vc * 8);
    };
    auto lstore = [&](const Stg& st, int b) {
        unsigned char* kb = lds + b * A_BUF; unsigned char* vb = kb + A_KBYTES;
        *(u32x4*)(kb + kr0 * A_KSTR + kc0 * 16) = st.k0;
        if (k1ok) *(u32x4*)(kb + kr1 * A_KSTR + kc1 * 16) = st.k1;
        *(u32x2*)(vb + vr * A_VSTR + vc * 16) = (u32x2){st.v.x, st.v.y};
        *(u32x2*)(vb + vr * A_VSTR + vc * 16 + 8) = (u32x2){st.v.z, st.v.w};
    };
    gload(sA, 0); lstore(sA, 0); gload(sB, 1);
    __syncthreads();
    auto step = [&](int j, Stg& sNext  , Stg& sFree  ) {
        const int b = j & 1;
        if (j + 2 < ntile) gload(sFree, j + 2);
        if (j <= mylast) {
            const unsigned char* kb = lds + b * A_BUF; const unsigned char* vb = kb + A_KBYTES;
            f32x16 sc[2];
#pragma unroll
            for (int kh = 0; kh < 2; ++kh) {
                f32x16 acc = zero16();
                const unsigned char* kp = kb + (32 * kh + r32) * A_KSTR + hh * 16;
#pragma unroll
                for (int s = 0; s < 6; ++s) acc = mfma32(*(const bf16x8*)(kp + s * 32), qf[s], acc);
                sc[kh] = acc;
            }
            if (j == 0) {
#pragma unroll
                for (int kh = 0; kh < 2; ++kh)
#pragma unroll
                    for (int r = 0; r < 16; ++r) { const int kv = 32 * kh + crow(r, hh); if (kv < PADL) sc[kh][r] = -INFINITY; }
            }
            if (j == mylast) {
#pragma unroll
                for (int kh = 0; kh < 2; ++kh)
#pragma unroll
                    for (int r = 0; r < 16; ++r) { const int kv = 64 * j + 32 * kh + crow(r, hh); if (kv > qp) sc[kh][r] = -INFINITY; }
            }
            float mx = sc[0][0];
#pragma unroll
            for (int r = 1; r < 16; ++r) mx = fmaxf(mx, sc[0][r]);
#pragma unroll
            for (int r = 0; r < 16; ++r) mx = fmaxf(mx, sc[1][r]);
            mx = fmaxf(mx, __shfl_xor(mx, 32));
            const float mnew = fmaxf(mrun, mx);
            const float alpha = __builtin_amdgcn_exp2f(mrun - mnew);
            mrun = mnew;
            float ps = 0.f;
#pragma unroll
            for (int kh = 0; kh < 2; ++kh)
#pragma unroll
                for (int r = 0; r < 16; ++r) { const float e = __builtin_amdgcn_exp2f(sc[kh][r] - mnew); sc[kh][r] = e; ps += e; }
            lrun = lrun * alpha + ps;
#pragma unroll
            for (int eh = 0; eh < 2; ++eh)
#pragma unroll
                for (int r = 0; r < 16; ++r) ot[eh][r] *= alpha;
#pragma unroll
            for (int kh = 0; kh < 2; ++kh)
#pragma unroll
                for (int s2 = 0; s2 < 2; ++s2) {
                    u32x4 pw; pw.x = cvtpk_s(sc[kh][8 * s2 + 0], sc[kh][8 * s2 + 1]); pw.y = cvtpk_s(sc[kh][8 * s2 + 2], sc[kh][8 * s2 + 3]);
                    pw.z = cvtpk_s(sc[kh][8 * s2 + 4], sc[kh][8 * s2 + 5]); pw.w = cvtpk_s(sc[kh][8 * s2 + 6], sc[kh][8 * s2 + 7]);
                    const bf16x8 pf = __builtin_bit_cast(bf16x8, pw);
#pragma unroll
                    for (int eh = 0; eh < 2; ++eh) {
                        const unsigned char* vp = vb + (32 * eh + r32) * A_VSTR + (32 * kh + 16 * s2 + 4 * hh) * 2;
                        const u32x2 lo = *(const u32x2*)vp, hi2 = *(const u32x2*)(vp + 16);
                        const bf16x8 vf = __builtin_bit_cast(bf16x8, (u32x4){lo.x, lo.y, hi2.x, hi2.y});
                        ot[eh] = mfma32(vf, pf, ot[eh]);
                    }
                }
        }
        if (j + 1 < ntile) lstore(sNext, b ^ 1);
        __syncthreads();
    };
#pragma unroll 1
    for (int j = 0; j < ntile; j += 2) {
        step(j, sB, sA);
        if (j + 1 < ntile) step(j + 1, sA, sB);
    }
    const float ltot = lrun + __shfl_xor(lrun, 32);
    const float rl = 1.f / ltot;
    bf16_t* o = (bf16_t*)(ws + WS_MIX) + (size_t)(qp - 64) * 1024 + 512 + h * 64;
#pragma unroll
    for (int eh = 0; eh < 2; ++eh)
#pragma unroll
        for (int a = 0; a < 4; ++a) {
            const int e = 32 * eh + 8 * a + 4 * hh;
            *(u32x2*)(o + e) = (u32x2){pk2(ot[eh][4 * a] * rl, ot[eh][4 * a + 1] * rl), pk2(ot[eh][4 * a + 2] * rl, ot[eh][4 * a + 3] * rl)};
        }
}

DI void xn_rows(const Frame& F, const Args& A, int u0, int stride) {
    f32x4 v[2][4];
#pragma unroll
    for (int r = 0; r < 2; ++r) { const int u = u0 + r * stride; if (u < MU) { const f32x4* xr = (const f32x4*)(A.out + (size_t)u * DM) + F.lane;
#pragma unroll
        for (int j = 0; j < 4; ++j) v[r][j] = xr[64 * j]; } }
#pragma unroll
    for (int r = 0; r < 2; ++r) {
        const int u = u0 + r * stride; if (u >= MU) continue;
        float s = 0.f;
#pragma unroll
        for (int j = 0; j < 4; ++j) s += (v[r][j].x * v[r][j].x + v[r][j].y * v[r][j].y) + (v[r][j].z * v[r][j].z + v[r][j].w * v[r][j].w);
        const float rstd = 1.f / sqrtf(wave_sum(s) * (1.f / DM) + EPS);
        unsigned long long* o8 = (unsigned long long*)((bf16_t*)(A.ws + WS_XN) + (size_t)u * DM) + F.lane;
#pragma unroll
        for (int j = 0; j < 4; ++j) { const f32x4 w = ((const f32x4*)A.in[15])[64 * j + F.lane];
            o8[64 * j] = (unsigned long long)pk2(v[r][j].x * rstd * w.x, v[r][j].y * rstd * w.y) | ((unsigned long long)pk2(v[r][j].z * rstd * w.z, v[r][j].w * rstd * w.w) << 32); }
    }
}

DI unsigned fkey(float v, int idx) { unsigned u = __builtin_bit_cast(unsigned, v); u = (u & 0x80000000u) ? ~u : (u | 0x80000000u); return (u & ~127u) | (unsigned)(127 - idx); }
DI float keyval(unsigned k) { unsigned u = k & ~127u; u = (u & 0x80000000u) ? (u & 0x7fffffffu) : ~u; return __builtin_bit_cast(float, u); }

__device__ const unsigned char PAIR_A[50] = {0,0,0,0,0,0,0,0,0,0,0,0,0,0,0,0, 1,1,1,1,1,1,1,1, 2,2,2,2,2, 3,3,3,3, 4,4,4, 5,5, 6,6, 7,7, 8,9,10,11,12,13,14,15};
__device__ const unsigned char PAIR_B[50] = {0,1,2,3,4,5,6,7,8,9,10,11,12,13,14,15, 0,1,2,3,4,5,6,7, 0,1,2,3,4, 0,1,2,3, 0,1,2, 0,1, 0,1, 0,1, 0,0,0,0,0,0,0,0};

DI void ce_desc(unsigned& a, unsigned& b) { const unsigned mx = a > b ? a : b, mn = a > b ? b : a; a = mx; b = mn; }
template <int BASE, int NK> DI void bitonic_sort16_desc(unsigned (&x)[NK]) {
#pragma unroll
    for (int k = 2; k <= 16; k <<= 1)
#pragma unroll
        for (int j = k >> 1; j > 0; j >>= 1)
#pragma unroll
            for (int i = 0; i < 16; ++i) { const int l = i ^ j; if (l > i) { if ((i & k) == 0) ce_desc(x[BASE + i], x[BASE + l]); else ce_desc(x[BASE + l], x[BASE + i]); } }
}
template <int A0, int B0, int NK> DI void merge_top16(unsigned (&x)[NK]) {
#pragma unroll
    for (int i = 0; i < 16; ++i) { const unsigned p = x[A0 + i], q = x[B0 + 15 - i]; x[A0 + i] = p > q ? p : q; }
#pragma unroll
    for (int j = 8; j > 0; j >>= 1)
#pragma unroll
        for (int i = 0; i < 16; ++i) { const int l = i ^ j; if (l > i) ce_desc(x[A0 + i], x[A0 + l]); }
}
template <int NK> DI void top16_of_128(unsigned (&key)[NK]) {
    bitonic_sort16_desc<0, NK>(key); bitonic_sort16_desc<16, NK>(key); bitonic_sort16_desc<32, NK>(key); bitonic_sort16_desc<48, NK>(key);
    bitonic_sort16_desc<64, NK>(key); bitonic_sort16_desc<80, NK>(key); bitonic_sort16_desc<96, NK>(key); bitonic_sort16_desc<112, NK>(key);
    merge_top16<0, 16, NK>(key); merge_top16<32, 48, NK>(key); merge_top16<64, 80, NK>(key); merge_top16<96, 112, NK>(key);
    merge_top16<0, 32, NK>(key); merge_top16<64, 96, NK>(key);
    merge_top16<0, 64, NK>(key);
}

DI void topk_task(const Frame& F, const Args& A, int task) {
    unsigned char* ws = A.ws; const int tid = F.tid;
    const int u = task >> 3, h = task & 7;
    LAS unsigned* sk = (LAS unsigned*)(LAS unsigned char*)F.lds;
    LAS unsigned* pkk = sk + 16384;
    LAS unsigned* stg = sk + 16384;
    const bf16_t* SCb = (const bf16_t*)(ws + WS_SC) + (size_t)(task & ~511) * 256;
#pragma unroll 1
    for (int half = 0; half < 2; ++half) {
        unsigned key[128];
#pragma unroll
        for (int qb = 0; qb < 2; ++qb) {
            u32x4 pf[8];
#pragma unroll
            for (int k = 0; k < 8; ++k) { const int c = tid + 512 * k; pf[k] = *(const u32x4*)(SCb + (size_t)(c >> 3) * 256 + half * 128 + qb * 64 + (c & 7) * 8); }
#pragma unroll
            for (int k = 0; k < 8; ++k) { const int c = tid + 512 * k; *(LAS u32x4*)(stg + (c >> 3) * 36 + (c & 7) * 4) = pf[k]; }
            __syncthreads();
#pragma unroll
            for (int i = 0; i < 8; ++i) { const u32x4 v = *(const LAS u32x4*)(stg + tid * 36 + 4 * i); const int b0 = 64 * qb + 8 * i;
                key[b0] = fkey(bflo(v.x), b0); key[b0 + 1] = fkey(bfhi(v.x), b0 + 1); key[b0 + 2] = fkey(bflo(v.y), b0 + 2); key[b0 + 3] = fkey(bfhi(v.y), b0 + 3);
                key[b0 + 4] = fkey(bflo(v.z), b0 + 4); key[b0 + 5] = fkey(bfhi(v.z), b0 + 5); key[b0 + 6] = fkey(bflo(v.w), b0 + 6); key[b0 + 7] = fkey(bfhi(v.w), b0 + 7); }
            __syncthreads();
        }
        top16_of_128(key);
#pragma unroll
        for (int r = 0; r < 16; ++r) sk[(half * 16 + r) * 512 + tid] = key[r];
    }
    float v1[16], v2[16];
#pragma unroll
    for (int r = 0; r < 16; ++r) { v1[r] = keyval(sk[r * 512 + tid]); v2[r] = keyval(sk[(16 + r) * 512 + tid]); }
    unsigned ck[64];
#pragma unroll
    for (int c = 50; c < 64; ++c) ck[c] = 0u;
#pragma unroll
    for (int a = 0; a < 16; ++a) {
        const int off = a == 0 ? 0 : a == 1 ? 16 : a == 2 ? 24 : a == 3 ? 29 : a == 4 ? 33 : a == 5 ? 36 : a == 6 ? 38 : a == 7 ? 40 : 42 + (a - 8);
#pragma unroll
        for (int b = 0; b < 16; ++b) if ((a + 1) * (b + 1) <= 16) ck[off + b] = fkey(v1[a] + v2[b], off + b);
    }
    bitonic_sort16_desc<0, 64>(ck); bitonic_sort16_desc<16, 64>(ck); bitonic_sort16_desc<32, 64>(ck); bitonic_sort16_desc<48, 64>(ck);
    merge_top16<0, 16, 64>(ck); merge_top16<32, 48, 64>(ck); merge_top16<0, 32, 64>(ck);
#pragma unroll
    for (int r = 0; r < 16; ++r) pkk[r * 512 + tid] = ck[r];
    const float cmax = keyval(pkk[tid]);
    float ev[16]; float esum = 0.f; int ex[16];
#pragma unroll
    for (int r = 0; r < 16; ++r) {
        const unsigned k = pkk[r * 512 + tid]; const int c = 127 - (int)(k & 127u);
        ev[r] = __expf(keyval(k) - cmax); esum += ev[r];
        const int a = PAIR_A[c], b = PAIR_B[c];
        const int i1 = 127 - (int)(sk[a * 512 + tid] & 127u), i2 = 127 - (int)(sk[(16 + b) * 512 + tid] & 127u);
        ex[r] = i1 * 128 + i2;
    }
    const float rs = 1.f / esum;
    int* IDX = (int*)(ws + WS_IDX) + (size_t)u * 128 + h * 16; float* GATE = (float*)(ws + WS_GATE) + (size_t)u * 128 + h * 16;
#pragma unroll
    for (int r = 0; r < 16; r += 4) {
        *(int4*)(IDX + r) = make_int4(ex[r], ex[r + 1], ex[r + 2], ex[r + 3]);
        *(f32x4*)(GATE + r) = (f32x4){ev[r] * rs, ev[r + 1] * rs, ev[r + 2] * rs, ev[r + 3] * rs};
    }
}

constexpr float EU_SCALE = 64.f, EV_SCALE = 16.f;
DI unsigned pk4_fp8(float a, float b, float c, float d) { int w = 0; w = __builtin_amdgcn_cvt_pk_fp8_f32(a, b, w, false); w = __builtin_amdgcn_cvt_pk_fp8_f32(c, d, w, true); return (unsigned)w; }
DI void convert_tables(const Frame& F, const Args& A) {
    const size_t n16 = (size_t)16384 * 1024 / 16;
    const size_t gt = (size_t)blockIdx.x * 512 + F.tid, NGT = (size_t)F.G * 512;
#pragma unroll 1
    for (int t = 0; t < 2; ++t) {
        const float* src = A.in[18 + t]; unsigned char* dst = A.ws + (t ? WS_EV : WS_EU); const float sc = t ? EV_SCALE : EU_SCALE;
        const float* fn = A.in[15];
        for (size_t i = gt; i < n16; i += NGT) {
            f32x4 a = *(const f32x4*)(src + i * 16) * sc, b = *(const f32x4*)(src + i * 16 + 4) * sc, c = *(const f32x4*)(src + i * 16 + 8) * sc, d = *(const f32x4*)(src + i * 16 + 12) * sc;
            if (t == 0) { const float* g = fn + (i & 63) * 16; a *= *(const f32x4*)g; b *= *(const f32x4*)(g + 4); c *= *(const f32x4*)(g + 8); d *= *(const f32x4*)(g + 12); }
            const size_t e_ = i >> 6, c16_ = i & 63;
            *(u32x4*)(dst + (c16_ >> 3) * ((size_t)16384 * 128) + e_ * 128 + (c16_ & 7) * 16) = (u32x4){pk4_fp8(a.x, a.y, a.z, a.w), pk4_fp8(b.x, b.y, b.z, b.w), pk4_fp8(c.x, c.y, c.z, c.w), pk4_fp8(d.x, d.y, d.z, d.w)};
        }
    }
}

DI float gelu_exact(float x) { return 0.5f * x * (1.f + erff(x * 0.70710678118654752f)); }
typedef float f32x2 __attribute__((ext_vector_type(2)));
#define UNPK16(dst, W_) do { f32x2 _t; \
    _t = __builtin_amdgcn_cvt_pk_f32_fp8((int)(W_).x, false); dst[0] = _t.x; dst[1] = _t.y; _t = __builtin_amdgcn_cvt_pk_f32_fp8((int)(W_).x, true); dst[2] = _t.x; dst[3] = _t.y; \
    _t = __builtin_amdgcn_cvt_pk_f32_fp8((int)(W_).y, false); dst[4] = _t.x; dst[5] = _t.y; _t = __builtin_amdgcn_cvt_pk_f32_fp8((int)(W_).y, true); dst[6] = _t.x; dst[7] = _t.y; \
    _t = __builtin_amdgcn_cvt_pk_f32_fp8((int)(W_).z, false); dst[8] = _t.x; dst[9] = _t.y; _t = __builtin_amdgcn_cvt_pk_f32_fp8((int)(W_).z, true); dst[10] = _t.x; dst[11] = _t.y; \
    _t = __builtin_amdgcn_cvt_pk_f32_fp8((int)(W_).w, false); dst[12] = _t.x; dst[13] = _t.y; _t = __builtin_amdgcn_cvt_pk_f32_fp8((int)(W_).w, true); dst[14] = _t.x; dst[15] = _t.y; } while (0)

template <bool UPH>
DI void expert_phase(const Frame& F, const Args& A, int xv, int wq, int nw) {
    unsigned char* ws = A.ws; const int lane = F.lane, grp = lane >> 3, j = lane & 7;
    const unsigned char* TBL = ws + (UPH ? WS_EU : WS_EV) + (size_t)xv * ((size_t)16384 * 128) + 16 * j;
    const int* IDX = (const int*)(ws + WS_IDX); const float* CW = (const float*)(ws + WS_CW);
    const bf16_t* XN = (const bf16_t*)(ws + WS_XN) + 128 * xv + 16 * j;
    float* HP = (float*)(ws + WS_HP);
    LAS unsigned* ring = (LAS unsigned*)((LAS unsigned char*)F.lds + F.wave * 4096);
    const int nt = (MU - wq + nw - 1) / nw;
    if (nt <= 0) return;
    auto tok = [&](int k) { return __builtin_amdgcn_readfirstlane(wq + (k < nt ? k : nt - 1) * nw); };
    int mi0, mi1; u32x4 mx0, mx1; float mh0, mh1;
    auto meta_load = [&](int k) {
        const int u = tok(k);
        mi0 = IDX[(size_t)u * 128 + lane]; mi1 = IDX[(size_t)u * 128 + 64 + lane];
        if constexpr (UPH) { mx0 = *(const u32x4*)(XN + (size_t)u * DM); mx1 = *(const u32x4*)(XN + (size_t)u * DM + 8); }
        else { mh0 = CW[(size_t)u * 128 + lane]; mh1 = CW[(size_t)u * 128 + 64 + lane]; }
    };
    auto meta_store = [&](int k) {
        LAS unsigned* sl = ring + (k & 3) * 256;
        sl[lane] = (unsigned)mi0; sl[64 + lane] = (unsigned)mi1;
        if constexpr (UPH) { if (grp == 0) { *(LAS u32x4*)(sl + 128 + 8 * j) = mx0; *(LAS u32x4*)(sl + 128 + 8 * j + 4) = mx1; } }
        else { sl[128 + lane] = __builtin_bit_cast(unsigned, mh0); sl[192 + lane] = __builtin_bit_cast(unsigned, mh1); }
    };
    auto gather = [&](u32x4 (&buf)[8], int n) {
        const LAS unsigned* sl = ring + ((n >> 1) & 3) * 256 + 64 * (n & 1) + grp;
#pragma unroll
        for (int i = 0; i < 8; ++i) { const int e = (int)sl[8 * i]; buf[i] = *(const u32x4*)(TBL + (size_t)e * 128); }
    };
    const int ocol = 128 * xv + 16 * j + ((lane & 32) ? 8 : 0) + ((lane & 16) ? 4 : 0) + ((lane & 8) ? 2 : 0);
    f32x2 ocur = (f32x2){0.f, 0.f};
    float acc[16];
    float xn[16];
    auto compute = [&](u32x4 (&buf)[8], int n) {
        const int k = n >> 1, hf = n & 1;
        const LAS unsigned* sl = ring + (k & 3) * 256;
        if (hf == 0) {
            if constexpr (UPH) {
                const u32x4 x0 = *(const LAS u32x4*)(sl + 128 + 8 * j), x1 = *(const LAS u32x4*)(sl + 128 + 8 * j + 4);
                xn[0] = bflo(x0.x); xn[1] = bfhi(x0.x); xn[2] = bflo(x0.y); xn[3] = bfhi(x0.y); xn[4] = bflo(x0.z); xn[5] = bfhi(x0.z); xn[6] = bflo(x0.w); xn[7] = bfhi(x0.w);
                xn[8] = bflo(x1.x); xn[9] = bfhi(x1.x); xn[10] = bflo(x1.y); xn[11] = bfhi(x1.y); xn[12] = bflo(x1.z); xn[13] = bfhi(x1.z); xn[14] = bflo(x1.w); xn[15] = bfhi(x1.w);
            } else {
#pragma unroll
                for (int c = 0; c < 16; ++c) acc[c] = 0.f;
                ocur = *(const f32x2*)(A.out + (size_t)tok(k) * DM + ocol);
            }
        }
#pragma unroll
        for (int i = 0; i < 8; ++i) {
            float f[16]; UNPK16(f, buf[i]);
            if constexpr (UPH) {
                float a0 = 0.f, a1 = 0.f;
#pragma unroll
                for (int c = 0; c < 16; c += 2) { a0 += f[c] * xn[c]; a1 += f[c + 1] * xn[c + 1]; }
                if (hf == 0) acc[i] = a0 + a1; else acc[8 + i] = a0 + a1;
                if (i < 7) { if (hf == 0) asm volatile("" : "+v"(buf[i + 1].x), "+v"(buf[i + 1].y), "+v"(buf[i + 1].z), "+v"(buf[i + 1].w), "+v"(acc[i]));
                             else asm volatile("" : "+v"(buf[i + 1].x), "+v"(buf[i + 1].y), "+v"(buf[i + 1].z), "+v"(buf[i + 1].w), "+v"(acc[8 + i])); }
            } else {
                const float cw = __builtin_bit_cast(float, sl[128 + 64 * hf + 8 * i + grp]);
#pragma unroll
                for (int c = 0; c < 16; ++c) acc[c] += cw * f[c];
                if (i < 7) asm volatile("" : "+v"(buf[i + 1].x), "+v"(buf[i + 1].y), "+v"(buf[i + 1].z), "+v"(buf[i + 1].w),
                                             "+v"(acc[0]), "+v"(acc[1]), "+v"(acc[2]), "+v"(acc[3]), "+v"(acc[4]), "+v"(acc[5]), "+v"(acc[6]), "+v"(acc[7]),
                                             "+v"(acc[8]), "+v"(acc[9]), "+v"(acc[10]), "+v"(acc[11]), "+v"(acc[12]), "+v"(acc[13]), "+v"(acc[14]), "+v"(acc[15]));
            }
            __builtin_amdgcn_sched_barrier(0);
        }
        if (hf == 1 && k < nt) {
            const int u = tok(k);
            float r8[8], r4[4], r2[2];
            if constexpr (UPH) {
                { const bool up = lane & 4;
#pragma unroll
                  for (int i = 0; i < 8; ++i) { const float send = up ? acc[i] : acc[i + 8], keep = up ? acc[i + 8] : acc[i]; r8[i] = keep + __shfl_xor(send, 4); } }
                { const bool up = lane & 2;
#pragma unroll
                  for (int i = 0; i < 4; ++i) { const float send = up ? r8[i] : r8[i + 4], keep = up ? r8[i + 4] : r8[i]; r4[i] = keep + __shfl_xor(send, 2); } }
                { const bool up = lane & 1;
#pragma unroll
                  for (int i = 0; i < 2; ++i) { const float send = up ? r4[i] : r4[i + 2], keep = up ? r4[i + 2] : r4[i]; r2[i] = keep + __shfl_xor(send, 1); } }
                const int st = ((lane & 4) ? 8 : 0) + ((lane & 2) ? 4 : 0) + ((lane & 1) ? 2 : 0);
                float* hp = HP + ((size_t)xv * MU + u) * 128 + grp;
                hp[8 * st] = r2[0]; hp[8 * (st + 1)] = r2[1];
            } else {
                { const bool up = lane & 32;
#pragma unroll
                  for (int c = 0; c < 8; ++c) { const float send = up ? acc[c] : acc[c + 8], keep = up ? acc[c + 8] : acc[c]; r8[c] = keep + __shfl_xor(send, 32); } }
                { const bool up = lane & 16;
#pragma unroll
                  for (int c = 0; c < 4; ++c) { const float send = up ? r8[c] : r8[c + 4], keep = up ? r8[c + 4] : r8[c]; r4[c] = keep + __shfl_xor(send, 16); } }
                { const bool up = lane & 8;
#pragma unroll
                  for (int c = 0; c < 2; ++c) { const float send = up ? r4[c] : r4[c + 2], keep = up ? r4[c + 2] : r4[c]; r2[c] = keep + __shfl_xor(send, 8); } }
                f32x2* o = (f32x2*)(A.out + (size_t)u * DM + ocol);
                f32x2 cur = ocur; cur.x += r2[0]; cur.y += r2[1]; *o = cur;
            }
        }
    };
    meta_load(0); meta_store(0); meta_load(1); meta_store(1); meta_load(2); meta_store(2);
    u32x4 b0[8], b1[8], b2[8];
    gather(b0, 0); gather(b1, 1); gather(b2, 2);
#pragma unroll 1
    for (int k0 = 0; k0 < nt; k0 += 3) {
        const int n0 = 2 * k0;
        meta_load(k0 + 3);
        compute(b0, n0);     gather(b0, n0 + 3);
        compute(b1, n0 + 1); meta_store(k0 + 3); gather(b1, n0 + 4);
        meta_load(k0 + 4);
        compute(b2, n0 + 2); gather(b2, n0 + 5);
        compute(b0, n0 + 3); meta_store(k0 + 4); gather(b0, n0 + 6);
        meta_load(k0 + 5);
        compute(b1, n0 + 4); gather(b1, n0 + 7);
        compute(b2, n0 + 5); meta_store(k0 + 5); gather(b2, n0 + 8);
    }
}


DI void expert_c_pass(const Frame& F, const Args& A) {
    unsigned char* ws = A.ws;
    const float* HP = (const float*)(ws + WS_HP); const float* GATE = (const float*)(ws + WS_GATE); float* CW = (float*)(ws + WS_CW);
    const size_t n4 = (size_t)MU * 128 / 4;
    for (size_t i = (size_t)blockIdx.x * 512 + F.tid; i < n4; i += (size_t)F.G * 512) {
        f32x4 h = *(const f32x4*)(HP + i * 4);
#pragma unroll
        for (int x = 1; x < 8; ++x) h += *(const f32x4*)(HP + (size_t)x * MU * 128 + i * 4);
        const f32x4 g = *(const f32x4*)(GATE + i * 4);
        const float rs = (1.f / EU_SCALE) / sqrtf(ss_sum16((const float*)(ws + WS_SS4), (int)(i >> 5)) * (1.f / DM) + EPS);
        f32x4 c;
        c.x = gelu_exact(h.x * rs) * g.x * (1.f / EV_SCALE); c.y = gelu_exact(h.y * rs) * g.y * (1.f / EV_SCALE);
        c.z = gelu_exact(h.z * rs) * g.z * (1.f / EV_SCALE); c.w = gelu_exact(h.w * rs) * g.w * (1.f / EV_SCALE);
        *(f32x4*)(CW + i * 4) = c;
    }
}
template <int PH> DI void run_phase(const Frame& F, const Args& args, PG8_LAS unsigned char* lds3) {
    unsigned char* ws = args.ws;
    if constexpr (PH == 0) { p0_prologue(F, args); p0_late_weights<0>(F, args, (7 - F.wave) * F.G + blockIdx.x, F.NGW, blockIdx.x * 512 + F.tid, F.G * 512); }
    if constexpr (PH == 1) {
        pg8::Gemm g{(const bf16_t*)(ws + WS_HN), (const bf16_t*)(ws + WS_WIN), MP, NPROJ, 1024, 1024, 1024, 0};
        pg8::StaticOrder S; S.init(MP, NPROJ, F.G, (int)blockIdx.x);
        EpiProj E{(bf16_t*)(ws + WS_QKVR), (bf16_t*)(ws + WS_Z), (float*)(ws + WS_P32), (bf16_t*)(ws + WS_CQN), (bf16_t*)(ws + WS_CKVN), (float*)(ws + WS_KPE), (float*)(ws + WS_SSQ), (float*)(ws + WS_SSK)};
        pg8::gemm_phase<EpiProj, pg8::StaticOrder, true, true>(lds3, g, S, E);
    }
    if constexpr (PH == 2) { gdn_prep_phase<0>(F, args); }
    if constexpr (PH == 3) {
        { pg8::Gemm g{(const bf16_t*)(ws + WS_CQN), (const bf16_t*)(ws + WS_WUQ), MP, 768, 256, 256, 256, 0};
          pg8::StaticOrder S; S.init(MP, 768, F.G, (int)blockIdx.x); EpiB16 E{(bf16_t*)(ws + WS_QH), 768, (const float*)(ws + WS_SSQ), 1.f / 256.f, 4};
          pg8::gemm_phase<EpiB16, pg8::StaticOrder, true, true>(lds3, g, S, E); }
        { pg8::Gemm g{(const bf16_t*)(ws + WS_CKVN), (const bf16_t*)(ws + WS_WUKV), MP, 1024, 256, 256, 256, 0};
          pg8::StaticOrder S; S.init(MP, 1024, F.G, (int)blockIdx.x); EpiB16 E{(bf16_t*)(ws + WS_KVB), 1024, (const float*)(ws + WS_SSK), 1.f / 128.f, 4};
          pg8::gemm_phase<EpiB16, pg8::StaticOrder, true, true>(lds3, g, S, E); }
    }
    if constexpr (PH == 4) { for (int t = F.gw; t < (KVROWS / 64) * 8; t += F.NGW) mla_prep2_task(F, args, t); }
    if constexpr (PH == 5) {
        gdn_scan(F, args);
        volatile LAS unsigned* MISC = (volatile LAS unsigned*)(lds3 + MISC_OFF);
        unsigned* qhead = (unsigned*)(ws + WS_CTL) + CW_ATTQ;
        for (;;) {
            __syncthreads();
            if (F.tid == 0) MISC[24] = xb_add(qhead, 1u);
            __syncthreads();
            const int k = (int)MISC[24];
            if (k >= 512) break;
            attn_item(F, args, k & 7, 63 - (k >> 3));
        }
        p0_late_weights<1>(F, args, F.gw, F.NGW, blockIdx.x * 512 + F.tid, F.G * 512);
    }
    if constexpr (PH == 6) { for (int t = F.gw; t < 2048 * 2; t += F.NGW) gdn_out_task(F, args, t); }
    if constexpr (PH == 7) {
        pg8::Gemm g{(const bf16_t*)(ws + WS_MIX), (const bf16_t*)(ws + WS_WOUT), MU, 1024, 1024, 1024, 1024, 0};
        pg8::StaticOrder S; S.init(MU, 1024, F.G, (int)blockIdx.x); EpiH1 E{args.out, args.in[0], (bf16_t*)(ws + WS_XN), (float*)(ws + WS_SS4)};
        pg8::gemm_phase<EpiH1, pg8::StaticOrder, true, true>(lds3, g, S, E);
    }
    if constexpr (PH == 8) {
        pg8::Gemm g{(const bf16_t*)(ws + WS_XN), (const bf16_t*)(ws + WS_WPQ), MU, 2048, 1024, 1024, 1024, 0};
        pg8::StaticOrder S; S.init(MU, 2048, F.G, (int)blockIdx.x); EpiB16 E{(bf16_t*)(ws + WS_PQ), 2048, (const float*)(ws + WS_SS4), 1.f / 1024.f, 16};
        pg8::gemm_phase<EpiB16, pg8::StaticOrder, true, true>(lds3, g, S, E);
    }
    if constexpr (PH == 9) {
        pg8::Gemm g{(const bf16_t*)(ws + WS_PQ), (const bf16_t*)(ws + WS_SKB), MU, 2048, 256, 2048, 256, 256};
        pg8::StaticOrder S; S.init(MU, 2048, F.G, (int)blockIdx.x); EpiB16 E{(bf16_t*)(ws + WS_SC), 2048, nullptr, 0.f, 0};
        pg8::gemm_phase<EpiB16, pg8::StaticOrder, true, true>(lds3, g, S, E);
    }
    if constexpr (PH == 10) {
        convert_tables(F, args);
        for (int t = blockIdx.x * 512 + F.tid; t < MU * 8; t += F.G * 512) topk_task(F, args, t);
    }
    if constexpr (PH == 12) { expert_c_pass(F, args); }
    if constexpr (PH == 11 || PH == 13) {
        volatile LAS unsigned* MISC = (volatile LAS unsigned*)(lds3 + MISC_OFF);
        const unsigned x = MISC[16], rank = MISC[17];
        unsigned* bar = (unsigned*)(ws + WS_CTL);
        unsigned nloc = 0, nx = 0, myidx = 0;
#pragma unroll
        for (unsigned j = 0; j < 16; ++j) { const unsigned c = xb_ld(&bar[XB_XCNT(j)]); nx += (c > 0u) ? 1u : 0u; myidx += (c > 0u && j < x) ? 1u : 0u; nloc = (j == x) ? c : nloc; }
        const int wq = __builtin_amdgcn_readfirstlane((int)rank * 8 + F.wave), nw = __builtin_amdgcn_readfirstlane((int)nloc * 8);
        const int xstep = __builtin_amdgcn_readfirstlane((int)nx);
        for (int xv = __builtin_amdgcn_readfirstlane((int)myidx); xv < 8; xv += xstep)
            { if constexpr (PH == 11) expert_phase<true>(F, args, xv, wq, nw); else expert_phase<false>(F, args, xv, wq, nw); }
    }
}
constexpr int NPHASE = 14;
__global__ void __launch_bounds__(512, 2) fwd_kernel(Args args) {
    extern __shared__ __attribute__((aligned(16))) unsigned char lds[];
    Frame F;
    F.lds = lds; F.tid = threadIdx.x; F.lane = F.tid & 63; F.wave = __builtin_amdgcn_readfirstlane(F.tid >> 6);
    F.G = gridDim.x; F.gw = blockIdx.x * 8 + F.wave; F.NGW = F.G * 8;
    volatile LAS unsigned* MISC = (volatile LAS unsigned*)((LAS unsigned char*)lds + MISC_OFF);
    if (F.tid < 32) MISC[F.tid] = 0u;
    __syncthreads();
    unsigned char* ws = args.ws;
    const int lo = args.ph_lo, hi = args.ph_hi;
    XcdBarrier bar; bar.bar = (unsigned*)(ws + WS_CTL); bar.x = 0; bar.st = nullptr;
    if (hi - lo > 1) bar = xcd_barrier_post((unsigned*)(ws + WS_CTL), MISC + 8);
    if (F.tid == 0) { const unsigned x = xb_xcc_id(); MISC[16] = x; MISC[17] = xb_add((unsigned*)(ws + WS_CTL) + 3520 + 64 * x, 1u); }
    __syncthreads();
#define IN(k) (lo <= (k) && (k) < hi)
#define SEAM(k) do { if (IN(k) && IN((k) + 1)) xcd_barrier(bar); } while (0)
    PG8_LAS unsigned char* lds3 = (PG8_LAS unsigned char*)lds;

#ifndef PROBE_REPEAT
#define PROBE_REPEAT -1
#endif
#ifndef PROBE_TIME
#define PROBE_TIME -1
#endif
#ifndef PROBE_TSEL
#define PROBE_TSEL 0
#endif
    unsigned long long pt_ticks = 0ull;
#define PHASE(k) do { unsigned long long pt0_ = 0ull; if (PROBE_TIME == (k)) pt0_ = __builtin_amdgcn_s_memrealtime(); \
        if (IN(k)) { run_phase<k>(F, args, lds3); if (PROBE_REPEAT == (k)) { xcd_barrier(bar); run_phase<(k)>(F, args, lds3); } } \
        if (PROBE_TIME == (k) && PROBE_TSEL == 1) pt_ticks = __builtin_amdgcn_s_memrealtime() - pt0_;     \
        if (PROBE_TIME == (k) && PROBE_TSEL == 2) pt0_ = __builtin_amdgcn_s_memrealtime();                \
        SEAM(k); \
        if (PROBE_TIME == (k) && PROBE_TSEL != 1) pt_ticks = __builtin_amdgcn_s_memrealtime() - pt0_; } while (0)
    PHASE(0); PHASE(1); PHASE(2); PHASE(3); PHASE(4); PHASE(5); PHASE(6); PHASE(7); PHASE(8); PHASE(9); PHASE(10); PHASE(11); PHASE(12); PHASE(13);
#undef PHASE
    if (PROBE_STAGE >= 0) { __syncthreads(); pt_ticks = *(volatile unsigned long long*)(lds + 143360 + 96); }
    if (PROBE_TIME >= 0 || PROBE_STAGE >= 0) { const unsigned long long t0_ = __builtin_amdgcn_s_memrealtime(); while (__builtin_amdgcn_s_memrealtime() - t0_ < 4ull * pt_ticks) __builtin_amdgcn_s_sleep(32); }
#undef IN
#undef SEAM
}

#ifndef N_LAUNCHES
#define N_LAUNCHES 1
#endif
extern "C" void kernel_launch(void* const* d_in, const int* in_sizes, int n_in, void* d_out, int out_size, void* d_ws, size_t ws_size, hipStream_t stream) {
    static int grid = 0;
    if (grid == 0) {
        if (n_in != 20 || out_size != MU * DM || ws_size < WS_END) { fprintf(stderr, "kernel_launch: unexpected shapes (n_in %d out %d ws %zu)\n", n_in, out_size, ws_size); grid = -1; return; }
        int dev = 0, cus = 0, per_cu = 0;
        if (hipGetDevice(&dev) != hipSuccess || hipDeviceGetAttribute(&cus, hipDeviceAttributeMultiprocessorCount, dev) != hipSuccess) { grid = -1; return; }
        if (hipFuncSetAttribute((const void*)fwd_kernel, hipFuncAttributeMaxDynamicSharedMemorySize, LDS_BYTES) != hipSuccess) { fprintf(stderr, "kernel_launch: hipFuncSetAttribute failed\n"); grid = -1; return; }
        if (hipOccupancyMaxActiveBlocksPerMultiprocessor(&per_cu, (const void*)fwd_kernel, 512, LDS_BYTES) != hipSuccess || per_cu < 1) { fprintf(stderr, "kernel_launch: occupancy query says %d\n", per_cu); (void)hipGetLastError(); per_cu = 1; }
        grid = cus;
    }
    if (grid < 0) return;
    (void)hipMemsetAsync((char*)d_ws + WS_CTL, 0, CTL_ZERO_BYTES, stream);
    Args a{};
    for (int i = 0; i < 20; ++i) a.in[i] = (const float*)d_in[i];
    a.out = (float*)d_out; a.ws = (unsigned char*)d_ws;
    for (int li = 0; li < N_LAUNCHES; ++li) {
        a.ph_lo = li * NPHASE / N_LAUNCHES; a.ph_hi = (li + 1) * NPHASE / N_LAUNCHES;
        if (N_LAUNCHES == 1) {
            void* kargs[] = {&a};
            hipError_t e = hipLaunchCooperativeKernel((const void*)fwd_kernel, dim3(grid), dim3(512), kargs, LDS_BYTES, stream);
            if (e != hipSuccess) fprintf(stderr, "cooperative launch failed: %s (grid %d)\n", hipGetErrorString(e), grid);
        } else {
            hipLaunchKernelGGL(fwd_kernel, dim3(grid), dim3(512), LDS_BYTES, stream, a);
        }
    }
}
```

```cpp
#include <hip/hip_runtime.h>
#include <hip/hip_bf16.h>
#include <cstdio>
#include <cstdint>
#include <type_traits>

#define DI __device__ __forceinline__
#define LAS __attribute__((address_space(3)))
#define GAS __attribute__((address_space(1)))

typedef unsigned short bf16_t;
typedef short bf16x8 __attribute__((ext_vector_type(8)));
typedef short s16x4 __attribute__((ext_vector_type(4)));
typedef float f32x4 __attribute__((ext_vector_type(4)));
typedef float f32x16 __attribute__((ext_vector_type(16)));
typedef unsigned u32x4 __attribute__((ext_vector_type(4)));
typedef unsigned u32x2 __attribute__((ext_vector_type(2)));

namespace pg8 {
#define PG8_LAS __attribute__((address_space(3)))
constexpr int BM = 256, BK = 64, HALF = 128, HTB = HALF * BK * 2  , STAGE_BYTES = 8 * HTB, NXCD = 8, WGM = 8;

__host__ __device__ __forceinline__ int lds_byte(int r, int c) { const int st = (r >> 4) * 2 + (c >> 5), rr = r & 15, cc = c & 31, ob = rr * 64 + cc * 2; return st * 1024 + (ob ^ (((ob >> 9) & 1) << 5)); }
__host__ __device__ __forceinline__ void stage_rc(int b, int& R, int& C) { const int st = b / 1024, sb = b % 1024, swz = sb ^ (((sb >> 9) & 1) << 5); R = (st >> 1) * 16 + swz / 64; C = (st & 1) * 32 + (swz % 64) / 2; }
__host__ __device__ __forceinline__ int perm32(int rho) { const int n = rho >> 4, i = rho & 15; return 8 * (i >> 2) + 4 * n + (i & 3); }

struct Unit { int pm, pn; };
struct Gemm { const bf16_t* A; const bf16_t* Bt; int M, N, K, lda, ldb, a_pn_off; };

struct StaticOrder {
    int nM, nN, nwg, G, c;
    __host__ __device__ void init(int M, int N, int G_, int c_) { nM = M / BM; nN = N / BM; nwg = nM * nN; G = G_; c = c_; }
    __host__ __device__ bool next(int i, Unit& u) const {
        const long L = (long)i * G + c; if (L >= nwg) return false;
        int wgid = (int)L; { const int q = nwg / NXCD, r = nwg % NXCD, xcd = wgid % NXCD, off = wgid / NXCD; wgid = (xcd < r ? xcd * (q + 1) : r * (q + 1) + (xcd - r) * q) + off; }
        const int nig = WGM * nN, gid = wgid / nig, fm = gid * WGM, gsz = (nM - fm) < WGM ? (nM - fm) : WGM;
        u.pm = fm + ((wgid % nig) % gsz); u.pn = (wgid % nig) / gsz; return true;
    }
    __device__ __forceinline__ void a_ready(const Unit&) const {}
    __device__ __forceinline__ void done(const Unit&) const {}
};

__device__ __forceinline__ unsigned cvt_pk_bf16(float lo, float hi) { unsigned r; asm volatile("v_cvt_pk_bf16_f32 %0, %1, %2" : "=v"(r) : "v"(lo), "v"(hi)); return r; }

template <class Epi, class Sched, bool ALIGN_EPI = false, bool SP2 = false>
__device__ __forceinline__ void gemm_phase(PG8_LAS unsigned char* lds, const Gemm g, const Sched& S, const Epi& E) {
    const int tid = threadIdx.x, wid = __builtin_amdgcn_readfirstlane(tid >> 6), lane = tid & 63, wr = wid >> 2, wc = wid & 3, fr = lane & 15, fq = lane >> 4;
    const int K = g.K, nt = K / BK;
    unsigned voffA[2], voffB[2];
#pragma unroll
    for (int i = 0; i < 2; ++i) { int R, C; stage_rc(tid * 16 + i * 8192, R, C); const int Rb = Epi::PERM ? ((R & ~31) + perm32(R & 31)) : R;
        voffA[i] = (unsigned)(R * g.lda + C) * 2u; voffB[i] = (unsigned)(Rb * g.ldb + C) * 2u; }
    const size_t kstep = (size_t)(BK * 2);
    const size_t hstepA = (size_t)HALF * g.lda * 2, hstepB = (size_t)HALF * g.ldb * 2;
    const size_t tstepA = 2 * hstepA, tstepB = 2 * hstepB;
    const size_t pnoffA = (size_t)g.a_pn_off * 2;
    const unsigned ldsw = (unsigned)wid * 1024u;
    const int aoff = lds_byte(wr * 64 + fr, fq * 8), boff = lds_byte(wc * 32 + fr, fq * 8);
#define PG8_SA(b, h) (((b) * 2 + (h)) * HTB)
#define PG8_SB(b, h) ((4 + (b) * 2 + (h)) * HTB)
#define PG8_STAGE(bufoff, gbase, voff) do { _Pragma("unroll") for (int _i = 0; _i < 2; ++_i) \
        __builtin_amdgcn_global_load_lds((const unsigned*)((const char*)(gbase) + (voff)[_i]), (PG8_LAS unsigned*)(lds + (bufoff) + ldsw + _i * 8192), 16, 0, 0); } while (0)
#define PG8_LDA(dst, b, h) do { _Pragma("unroll") for (int m = 0; m < 4; ++m) _Pragma("unroll") for (int k = 0; k < 2; ++k) dst[m][k] = *(const PG8_LAS bf16x8*)(lds + PG8_SA(b, h) + aoff + m * 2048 + k * 1024); } while (0)
#define PG8_LDB(dst, b, h) do { _Pragma("unroll") for (int n = 0; n < 2; ++n) _Pragma("unroll") for (int k = 0; k < 2; ++k) dst[n][k] = *(const PG8_LAS bf16x8*)(lds + PG8_SB(b, h) + boff + n * 2048 + k * 1024); } while (0)
#define PG8_MMA(ai, bj, At, Bt) do { __builtin_amdgcn_s_setprio(1); _Pragma("unroll") for (int m = 0; m < 4; ++m) _Pragma("unroll") for (int n = 0; n < 2; ++n) _Pragma("unroll") for (int k = 0; k < 2; ++k) \
        acc[ai][bj][m][n] = __builtin_amdgcn_mfma_f32_16x16x32_bf16(Bt[n][k], At[m][k], acc[ai][bj][m][n], 0, 0, 0); __builtin_amdgcn_s_setprio(0); } while (0)
#define PG8_WAIT_V(n) asm volatile("s_waitcnt vmcnt(" #n ")" ::: "memory")
#define PG8_WAIT_L(n) asm volatile("s_waitcnt lgkmcnt(" #n ")" ::: "memory")
#define PG8_BAR __builtin_amdgcn_s_barrier()
#define PG8_SCHED __builtin_amdgcn_sched_barrier(0)
    Unit cur, nxt; int ui = 0;
    if (!S.next(0, cur)) return;
    f32x4 acc[2][2][4][2];
#pragma unroll
    for (int a = 0; a < 2; ++a)
#pragma unroll
        for (int b = 0; b < 2; ++b)
#pragma unroll
            for (int m = 0; m < 4; ++m)
#pragma unroll
                for (int n = 0; n < 2; ++n) acc[a][b][m][n] = (f32x4){0.f, 0.f, 0.f, 0.f};
    bf16x8 At[4][2], B0[2][2], B1[2][2];
    const char* cA = (const char*)g.A + (size_t)cur.pm * tstepA + (size_t)cur.pn * pnoffA; const char* cB = (const char*)g.Bt + (size_t)cur.pn * tstepB;
    S.a_ready(cur);
    if constexpr (SP2) {
        PG8_STAGE(PG8_SB(0, 0), cB, voffB); PG8_STAGE(PG8_SB(0, 1), cB + hstepB, voffB); PG8_STAGE(PG8_SA(0, 0), cA, voffA); PG8_STAGE(PG8_SA(0, 1), cA + hstepA, voffA);
        if (wr == 1) PG8_BAR;
        PG8_WAIT_V(2); PG8_BAR;
        PG8_STAGE(PG8_SB(1, 0), cB + kstep, voffB); PG8_STAGE(PG8_SA(1, 0), cA + kstep, voffA); PG8_STAGE(PG8_SB(1, 1), cB + hstepB + kstep, voffB);
        PG8_WAIT_V(6); PG8_BAR;
    } else {
        PG8_STAGE(PG8_SB(0, 0), cB, voffB); PG8_STAGE(PG8_SA(0, 0), cA, voffA); PG8_STAGE(PG8_SB(0, 1), cB + hstepB, voffB); PG8_STAGE(PG8_SA(0, 1), cA + hstepA, voffA);
        if (wr == 1) PG8_BAR;
        PG8_WAIT_V(4); PG8_BAR;
        PG8_STAGE(PG8_SB(1, 0), cB + kstep, voffB); PG8_STAGE(PG8_SA(1, 0), cA + kstep, voffA); PG8_STAGE(PG8_SB(1, 1), cB + hstepB + kstep, voffB);
        PG8_WAIT_V(6); PG8_BAR;
    }
    for (;;) {
        const bool has_next = S.next(ui + 1, nxt);
        const char* nA = has_next ? (const char*)g.A + (size_t)nxt.pm * tstepA + (size_t)nxt.pn * pnoffA : cA; const char* nB = has_next ? (const char*)g.Bt + (size_t)nxt.pn * tstepB : cB;
        for (int t = 0; t < nt; t += 2) {
            const bool last = (t == nt - 2);
            const char* a1 = cA + (size_t)(t + 1) * kstep;
            const char* a2 = last ? nA : cA + (size_t)(t + 2) * kstep; const char* b2 = last ? nB : cB + (size_t)(t + 2) * kstep;
            const char* a3 = a2 + kstep; const char* b3 = b2 + kstep;
            if (last && has_next) S.a_ready(nxt);
            if constexpr (SP2) {
            PG8_LDB(B0, 0, 0); PG8_LDB(B1, 0, 1); PG8_SCHED; PG8_LDA(At, 0, 0); PG8_STAGE(PG8_SA(1, 1), a1 + hstepA, voffA);
            PG8_WAIT_V(8); PG8_WAIT_L(0); PG8_BAR; PG8_MMA(0, 0, At, B0); PG8_MMA(0, 1, At, B1); PG8_BAR; PG8_SCHED;
            PG8_LDA(At, 0, 1); PG8_STAGE(PG8_SB(0, 0), b2, voffB); PG8_STAGE(PG8_SB(0, 1), b2 + hstepB, voffB); PG8_STAGE(PG8_SA(0, 0), a2, voffA);
            PG8_WAIT_V(8); PG8_WAIT_L(0); PG8_BAR; PG8_MMA(1, 0, At, B0); PG8_MMA(1, 1, At, B1); PG8_BAR; PG8_SCHED;
            PG8_LDB(B0, 1, 0); PG8_LDB(B1, 1, 1); PG8_SCHED; PG8_LDA(At, 1, 0); PG8_STAGE(PG8_SA(0, 1), a2 + hstepA, voffA);
            PG8_WAIT_V(8); PG8_WAIT_L(0); PG8_BAR; PG8_MMA(0, 0, At, B0); PG8_MMA(0, 1, At, B1); PG8_BAR; PG8_SCHED;
            PG8_LDA(At, 1, 1); PG8_STAGE(PG8_SB(1, 0), b3, voffB); PG8_STAGE(PG8_SB(1, 1), b3 + hstepB, voffB); PG8_STAGE(PG8_SA(1, 0), a3, voffA);
            PG8_WAIT_V(8); PG8_WAIT_L(0); PG8_BAR; PG8_MMA(1, 0, At, B0); PG8_MMA(1, 1, At, B1); PG8_BAR; PG8_SCHED;
            } else {
            PG8_LDB(B0, 0, 0); PG8_SCHED; PG8_LDA(At, 0, 0); PG8_STAGE(PG8_SA(1, 1), a1 + hstepA, voffA);
            PG8_WAIT_L(8); PG8_BAR; PG8_WAIT_L(0); PG8_MMA(0, 0, At, B0); PG8_BAR; PG8_SCHED;
            PG8_LDB(B1, 0, 1); PG8_STAGE(PG8_SB(0, 0), b2, voffB);
            PG8_BAR; PG8_WAIT_L(0); PG8_MMA(0, 1, At, B1); PG8_BAR;
            PG8_LDA(At, 0, 1); PG8_STAGE(PG8_SA(0, 0), a2, voffA);
            PG8_BAR; PG8_WAIT_L(0); PG8_MMA(1, 0, At, B0); PG8_BAR; PG8_SCHED;
            PG8_STAGE(PG8_SB(0, 1), b2 + hstepB, voffB);
            PG8_WAIT_V(6); PG8_BAR; PG8_MMA(1, 1, At, B1); PG8_BAR;
            PG8_LDB(B0, 1, 0); PG8_SCHED; PG8_LDA(At, 1, 0); PG8_STAGE(PG8_SA(0, 1), a2 + hstepA, voffA);
            PG8_WAIT_L(8); PG8_BAR; PG8_WAIT_L(0); PG8_MMA(0, 0, At, B0); PG8_BAR; PG8_SCHED;
            PG8_LDB(B1, 1, 1); PG8_STAGE(PG8_SB(1, 0), b3, voffB);
            PG8_BAR; PG8_WAIT_L(0); PG8_MMA(0, 1, At, B1); PG8_BAR;
            PG8_LDA(At, 1, 1); PG8_STAGE(PG8_SA(1, 0), a3, voffA);
            PG8_BAR; PG8_WAIT_L(0); PG8_MMA(1, 0, At, B0); PG8_BAR; PG8_SCHED;
            PG8_STAGE(PG8_SB(1, 1), b3 + hstepB, voffB);
            PG8_WAIT_V(6); PG8_BAR; PG8_MMA(1, 1, At, B1); PG8_BAR;
            }
        }
        if constexpr (ALIGN_EPI) { if (wr == 0) PG8_BAR; }
        E(acc, cur, wr, wc, fr, fq); S.done(cur);
        if (!has_next) break;
#pragma unroll
        for (int a = 0; a < 2; ++a)
#pragma unroll
            for (int b = 0; b < 2; ++b)
#pragma unroll
                for (int m = 0; m < 4; ++m)
#pragma unroll
                    for (int n = 0; n < 2; ++n) acc[a][b][m][n] = (f32x4){0.f, 0.f, 0.f, 0.f};
        cur = nxt; cA = nA; cB = nB; ++ui;
        if constexpr (ALIGN_EPI) { if (wr == 1) PG8_BAR; }
    }
    PG8_WAIT_V(0);
    if constexpr (!ALIGN_EPI) { if (wr == 0) PG8_BAR; }
    PG8_BAR;
#undef PG8_SA
#undef PG8_SB
#undef PG8_STAGE
#undef PG8_LDA
#undef PG8_LDB
#undef PG8_MMA
#undef PG8_WAIT_V
#undef PG8_WAIT_L
#undef PG8_BAR
#undef PG8_SCHED
}
}

constexpr int DM = 1024;
constexpr int NTOK = 16400;
constexpr int PADL = 48;
constexpr int LPV = 16448;
constexpr int MP = 16640;
constexpr int MU = 16384;
constexpr int NCHUNK = 257;
constexpr int NHEAD = 8;
constexpr int NPROJ = 2560;
constexpr int KVROWS = 16512;
constexpr float EPS = 1e-6f;

constexpr size_t MiB = 1u << 20;
constexpr size_t WS_CTL = 0, CTL_ZERO_BYTES = 64 * 1024;
constexpr size_t WS_SSQ = 128 * 1024;
constexpr size_t WS_SSK = 512 * 1024;
constexpr size_t WS_SS4 = 14 * MiB;
constexpr size_t WS_WIN = 1 * MiB;
constexpr size_t WS_WUQ = 6 * MiB;
constexpr size_t WS_WUKV = 6 * MiB + 512 * 1024;
constexpr size_t WS_WOUT = 7 * MiB;
constexpr size_t WS_WPQ = 9 * MiB;
constexpr size_t WS_SKB = 13 * MiB;
constexpr size_t WS_IDX = 16 * MiB;
constexpr size_t WS_GATE = 24 * MiB;
constexpr size_t WS_HN = 16 * MiB;
constexpr size_t WS_QKVR = 101 * MiB;
constexpr size_t WS_Z = 150 * MiB;
constexpr size_t WS_P32 = 167 * MiB;
constexpr size_t WS_GA = 16 * MiB;
constexpr size_t WS_GQ = 33 * MiB;
constexpr size_t WS_GS = 67 * MiB;
constexpr size_t WS_GB = 84 * MiB;
constexpr size_t WS_GO = 50 * MiB;
constexpr size_t WS_MIX = 167 * MiB;
constexpr size_t WS_CQN = 200 * MiB;
constexpr size_t WS_CKVN = 208 * MiB + 512 * 1024;
constexpr size_t WS_QH = 101 * MiB;
constexpr size_t WS_KVB = 167 * MiB;
constexpr size_t WS_Q = 125 * MiB + 512 * 1024;
constexpr size_t WS_K = 220 * MiB;
constexpr size_t WS_VT = 200 * MiB;
constexpr size_t WS_XN = 32 * MiB;
constexpr size_t WS_PQ = 64 * MiB;
constexpr size_t WS_SC = 128 * MiB;
constexpr size_t WS_EU = 96 * MiB;
constexpr size_t WS_EV = 112 * MiB;
constexpr size_t WS_CW = 64 * MiB;
constexpr size_t WS_HP = 128 * MiB;
constexpr size_t WS_KPE = 217 * MiB;
constexpr size_t WS_END = 256 * MiB;
constexpr int CW_ATTQ = 8192;

constexpr int LDS_BYTES = 147456;
constexpr int MISC_OFF = 131072 + 12288;

DI unsigned f2bf(float f) { unsigned u = __builtin_bit_cast(unsigned, f); return (u + 0x7fffu + ((u >> 16) & 1u)) >> 16; }
DI unsigned pk2(float lo, float hi) { return f2bf(lo) | (f2bf(hi) << 16); }
DI float bf2f(unsigned b) { return __builtin_bit_cast(float, b << 16); }
DI float bflo(unsigned w) { return __builtin_bit_cast(float, w << 16); }
DI float bfhi(unsigned w) { return __builtin_bit_cast(float, w & 0xffff0000u); }
DI float wave_sum(float v) {
#pragma unroll
    for (int o = 1; o < 64; o <<= 1) v += __shfl_xor(v, o);
    return v;
}
DI float sigmoidf_(float x) { return 1.f / (1.f + __expf(-x)); }
DI float siluf_(float x) { return x / (1.f + __expf(-x)); }

#define XB_TMO      128
#define XB_XCNT(j)  (256  + 64 * (j))
#define XB_XSUB(j)  (1280 + 64 * (j))
#define XB_XGEN(j)  (2304 + 64 * (j))
#define XB_TOP      3328
#define XB_TOPGEN   3392
#define XCD_BAR_WORDS 3456
#define XB_SPIN_CAP (1u << 22)
DI unsigned xb_ld(unsigned* p)              { return __hip_atomic_load(p, __ATOMIC_RELAXED, __HIP_MEMORY_SCOPE_AGENT); }
DI unsigned xb_add(unsigned* p, unsigned v) { return __hip_atomic_fetch_add(p, v, __ATOMIC_RELAXED, __HIP_MEMORY_SCOPE_AGENT); }
DI unsigned xb_xcc_id() { return (unsigned)__builtin_amdgcn_s_getreg((3 << 11) | 20) & 0xFu; }
#define XB_SPIN(cond, bar) do { unsigned _sp = 0; while (cond) { __builtin_amdgcn_s_sleep(1); \
    if ((++_sp & 255u) == 0u) { if (xb_ld(&(bar)[XB_TMO])) break; if (_sp > XB_SPIN_CAP) { atomicAdd(&(bar)[XB_TMO], 1u); break; } } } } while (0)
struct XcdBarrier { unsigned* bar; unsigned x; volatile LAS unsigned* st; };
DI XcdBarrier xcd_barrier_post(unsigned* bar, volatile LAS unsigned* st) {
    XcdBarrier b; b.bar = bar; b.x = xb_xcc_id(); b.st = st;
    if (threadIdx.x == 0) (void)xb_add(&bar[XB_XCNT(b.x)], 1u);
    return b;
}
DI void xcd_barrier_complete(unsigned* bar, unsigned x, unsigned& nloc, unsigned& nx) {
    const unsigned G = gridDim.x * gridDim.y * gridDim.z;
    unsigned sum, cnt, mine, sp = 0u;
    for (;;) {
        sum = 0u; cnt = 0u; mine = 0u;
#pragma unroll
        for (unsigned j = 0; j < 16; ++j) { const unsigned c = xb_ld(&bar[XB_XCNT(j)]); sum += c; cnt += (c > 0u) ? 1u : 0u; mine = (j == x) ? c : mine; }
        if (sum == G) break;
        __builtin_amdgcn_s_sleep(1);
        if ((++sp & 255u) == 0u) { if (xb_ld(&bar[XB_TMO])) break; if (sp > XB_SPIN_CAP) { atomicAdd(&bar[XB_TMO], 1u); break; } }
    }
    nloc = mine > 0u ? mine : 1u; nx = cnt > 0u ? cnt : 1u;
}
DI void xcd_barrier(const XcdBarrier& b) {
    asm volatile("s_waitcnt vmcnt(0)" ::: "memory");
    __syncthreads();
    if (threadIdx.x == 0) {
        unsigned* bar = b.bar;
        __builtin_amdgcn_s_waitcnt(0);
        unsigned nloc = b.st[0], nx = b.st[1];
        if (nloc == 0u) { xcd_barrier_complete(bar, b.x, nloc, nx); b.st[0] = nloc; b.st[1] = nx; }
        const unsigned old = xb_add(&bar[XB_XSUB(b.x)], 1u);
        const unsigned gen = old / nloc;
        if (old + 1u == (gen + 1u) * nloc) {
            __builtin_amdgcn_fence(__ATOMIC_RELEASE, "agent");
            asm volatile("s_waitcnt vmcnt(0)" ::: "memory");
            const unsigned og = xb_add(&bar[XB_TOP], 1u);
            const unsigned tg = og / nx;
            if (og + 1u == (tg + 1u) * nx) xb_add(&bar[XB_TOPGEN], 1u);
            else XB_SPIN(xb_ld(&bar[XB_TOPGEN]) == tg, bar);
            __builtin_amdgcn_fence(__ATOMIC_ACQUIRE, "agent");
            xb_add(&bar[XB_XGEN(b.x)], 1u);
            asm volatile("s_waitcnt vmcnt(0)" ::: "memory");
        } else {
            XB_SPIN(xb_ld(&bar[XB_XGEN(b.x)]) == gen, bar);
            __builtin_amdgcn_fence(__ATOMIC_ACQUIRE, "agent");
            asm volatile("s_waitcnt vmcnt(0)" ::: "memory");
        }
    }
    __syncthreads();
}

struct Args {
    const float* in[20];
    float* out; unsigned char* ws;
    int ph_lo, ph_hi;
};
struct Frame {
    unsigned char* lds;
    int tid, lane, wave, G, gw, NGW;
};

template <class Map>
DI void transpose_item(const float* __restrict__ W, int Nsrc, bf16_t* __restrict__ WT, int ldk, float* scr, int item, int nblk, int lane, Map srcmap, const float* __restrict__ rowscale = nullptr) {
    const int kb = item / nblk, nb = item % nblk, k0 = 64 * kb, n0 = 32 * nb;
    const int ns = srcmap(n0 + (lane & 31));
    float vv[32];
#pragma unroll
    for (int i = 0; i < 32; ++i) { const int kk = 2 * i + (lane >> 5); vv[i] = (ns >= 0) ? W[(size_t)(k0 + kk) * Nsrc + ns] : 0.f; }
    if (rowscale) {
#pragma unroll
        for (int i = 0; i < 32; ++i) vv[i] *= rowscale[k0 + 2 * i + (lane >> 5)];
    }
#pragma unroll
    for (int i = 0; i < 32; ++i) { const int kk = 2 * i + (lane >> 5); scr[kk * 33 + (lane & 31)] = vv[i]; }
    __builtin_amdgcn_s_waitcnt(0); __builtin_amdgcn_wave_barrier();
    const int c = lane & 7;
#pragma unroll
    for (int j = 0; j < 4; ++j) { const int n = (lane >> 3) + 8 * j; const float* s = scr + (8 * c) * 33 + n;
        u32x4 o; o.x = pk2(s[0 * 33], s[1 * 33]); o.y = pk2(s[2 * 33], s[3 * 33]); o.z = pk2(s[4 * 33], s[5 * 33]); o.w = pk2(s[6 * 33], s[7 * 33]);
        *(u32x4*)(WT + (size_t)(n0 + n) * ldk + k0 + 8 * c) = o; }
    __builtin_amdgcn_s_waitcnt(0); __builtin_amdgcn_wave_barrier();
}
struct MapId { DI int operator()(int n) const { return n; } };
struct MapWin {
    DI int operator()(int n) const {
        if (n < 2048) return n;
        if (n < 2304) return n + 16;
        if (n < 2432) return n + 16;
        if (n < 2464) return n + 16;
        if (n < 2472) return n - 416;
        if (n < 2480) return n - 416;
        return -1;
    }
};

template <int PART> DI void p0_late_weights(const Frame& F, const Args& A, int wi, int nwv, int ti, int nth) {
    unsigned char* ws = A.ws;
    float* scr = (float*)(F.lds + F.wave * 16384);
    const float* w_uq = A.in[10]; const float* w_ukv = A.in[11]; const float* w_out = A.in[14]; const float* w_pq = A.in[16]; const float* sub_keys = A.in[17];
    constexpr int I_UQ = 4 * 24, I_UKV = 2 * 32, I_OUT = 16 * 32, I_PQ = 16 * 64;
    constexpr int NITEMS = I_UQ + I_UKV + I_OUT + I_PQ;
    const int lo_ = PART == 0 ? 0 : I_UQ + I_UKV, hi_ = PART == 0 ? I_UQ + I_UKV : NITEMS;
    for (int it = lo_ + wi; it < hi_; it += nwv) {
        int r = it;
        if (r < I_UQ) { transpose_item(w_uq, 768, (bf16_t*)(ws + WS_WUQ), 256, scr, r, 24, F.lane, MapId(), A.in[8]); continue; } r -= I_UQ;
        if (r < I_UKV) { transpose_item(w_ukv, 1024, (bf16_t*)(ws + WS_WUKV), 256, scr, r, 32, F.lane, MapId(), A.in[9]); continue; } r -= I_UKV;
        if (r < I_OUT) { transpose_item(w_out, 1024, (bf16_t*)(ws + WS_WOUT), 1024, scr, r, 32, F.lane, MapId()); continue; } r -= I_OUT;
        transpose_item(w_pq, 2048, (bf16_t*)(ws + WS_WPQ), 1024, scr, r, 64, F.lane, MapId(), A.in[15]);
    }
    const int gt = ti, NGT = nth;
    if (PART == 0) for (int i = gt; i < 1024 * 16; i += NGT) { const int n = i >> 4, c = i & 15; *(u32x4*)((bf16_t*)(ws + WS_WUKV) + (size_t)n * 256 + 128 + c * 8) = (u32x4){0u, 0u, 0u, 0u}; }
    if (PART == 1) for (int i = gt; i < 2048 * 32; i += NGT) {
        const int n = i >> 5, c8 = (i & 31) * 8; const int p = (n >> 7) & 1;
        u32x4 o = (u32x4){0u, 0u, 0u, 0u};
        if ((c8 >> 7) == p) { const float* s = sub_keys + (size_t)n * 128 + (c8 & 127); const f32x4 a = *(const f32x4*)s, b = *(const f32x4*)(s + 4);
            o.x = pk2(a.x, a.y); o.y = pk2(a.z, a.w); o.z = pk2(b.x, b.y); o.w = pk2(b.z, b.w); }
        *(u32x4*)((bf16_t*)(ws + WS_SKB) + (size_t)n * 256 + c8) = o;
    }
}

DI void p0_prologue(const Frame& F, const Args& A) {
    unsigned char* ws = A.ws;
    float* scr = (float*)(F.lds + F.wave * 16384);
    const float* w_in = A.in[3]; const float* w_uq = A.in[10]; const float* w_ukv = A.in[11]; const float* w_out = A.in[14]; const float* w_pq = A.in[16]; const float* sub_keys = A.in[17];
    constexpr int I_IN = 16 * 80;
    for (int it = F.wave * F.G + blockIdx.x; it < I_IN; it += F.NGW) transpose_item(w_in, 2480, (bf16_t*)(ws + WS_WIN), 1024, scr, it, 80, F.lane, MapWin());
    const float* x = A.in[0]; const float* meta = A.in[1]; const float* anorm = A.in[2];
    bf16_t* HN = (bf16_t*)(ws + WS_HN);
    for (int p0 = F.gw; p0 < MP; p0 += 3 * F.NGW) {
        f32x4 v[3][4]; bool ok[3];
#pragma unroll
        for (int r = 0; r < 3; ++r) {
            const int p = p0 + r * F.NGW, t = p - PADL; ok[r] = (p < MP) && t >= 0 && t < NTOK;
            if (ok[r]) { const float* src = (t < 16) ? meta + (size_t)t * DM : x + (size_t)(t - 16) * DM; const f32x4* xr = (const f32x4*)src + F.lane;
#pragma unroll
                for (int j = 0; j < 4; ++j) v[r][j] = xr[64 * j]; }
            else {
#pragma unroll
                for (int j = 0; j < 4; ++j) v[r][j] = (f32x4){0.f, 0.f, 0.f, 0.f}; }
        }
#pragma unroll
        for (int r = 0; r < 3; ++r) {
            const int p = p0 + r * F.NGW; if (p >= MP) continue;
            unsigned long long* o8 = (unsigned long long*)(HN + (size_t)p * DM) + F.lane;
            float s = 0.f;
#pragma unroll
            for (int j = 0; j < 4; ++j) s += (v[r][j].x * v[r][j].x + v[r][j].y * v[r][j].y) + (v[r][j].z * v[r][j].z + v[r][j].w * v[r][j].w);
            const float rstd = ok[r] ? 1.f / sqrtf(wave_sum(s) * (1.f / DM) + EPS) : 0.f;
#pragma unroll
            for (int j = 0; j < 4; ++j) { const f32x4 w = ((const f32x4*)anorm)[64 * j + F.lane];
                o8[64 * j] = (unsigned long long)pk2(v[r][j].x * rstd * w.x, v[r][j].y * rstd * w.y) | ((unsigned long long)pk2(v[r][j].z * rstd * w.z, v[r][j].w * rstd * w.w) << 32); }
        }
    }
}

DI void row_ss_store(const f32x4 (&v)[2][2][4][2], float* SSP, int nslot, int slot, int row0, int fq, bool bj0_only) {
#pragma unroll
    for (int ai = 0; ai < 2; ++ai)
#pragma unroll
        for (int m = 0; m < 4; ++m) {
            float s = 0.f;
#pragma unroll
            for (int bj = 0; bj < 2; ++bj) if (bj == 0 || !bj0_only)
#pragma unroll
                for (int n = 0; n < 2; ++n) { const f32x4 x = v[ai][bj][m][n]; s += (x[0] * x[0] + x[1] * x[1]) + (x[2] * x[2] + x[3] * x[3]); }
            s += __shfl_xor(s, 16); s += __shfl_xor(s, 32);
            if (fq == 0) SSP[(size_t)(row0 + ai * 128 + m * 16) * nslot + slot] = s;
        }
}
DI float ss_sum4(const float* SSP, int row) { const f32x4 a = *(const f32x4*)(SSP + (size_t)row * 4); return (a.x + a.y) + (a.z + a.w); }
DI float ss_sum16(const float* SSP, int row) { const f32x4 a = *(const f32x4*)(SSP + (size_t)row * 16), b = *(const f32x4*)(SSP + (size_t)row * 16 + 4), c = *(const f32x4*)(SSP + (size_t)row * 16 + 8), d = *(const f32x4*)(SSP + (size_t)row * 16 + 12);
    return (((a.x + a.y) + (a.z + a.w)) + ((b.x + b.y) + (b.z + b.w))) + (((c.x + c.y) + (c.z + c.w)) + ((d.x + d.y) + (d.z + d.w))); }
struct EpiProj {
    static constexpr bool PERM = true;
    bf16_t* QKVR; bf16_t* Z; float* P32; bf16_t* CQ16; bf16_t* CKV16; float* KPE; float* SSQ; float* SSK;
    DI void operator()(const f32x4 (&acc)[2][2][4][2], const pg8::Unit& u, int wr, int wc, int fr, int fq) const {
        const int row0 = u.pm * 256 + wr * 64 + fr;
        if (u.pn < 8) {
            bf16_t* base; int ld, colt;
            if (u.pn < 6) { base = QKVR; ld = 1536; colt = u.pn * 256; } else { base = Z; ld = 512; colt = (u.pn - 6) * 256; }
            const int col0 = colt + wc * 32 + 8 * fq;
#pragma unroll
            for (int ai = 0; ai < 2; ++ai)
#pragma unroll
                for (int m = 0; m < 4; ++m) { bf16_t* rowp = base + (size_t)(row0 + ai * 128 + m * 16) * ld + col0;
#pragma unroll
                    for (int bj = 0; bj < 2; ++bj) { const f32x4 v0 = acc[ai][bj][m][0], v1 = acc[ai][bj][m][1];
                        u32x4 w; w.x = pg8::cvt_pk_bf16(v0[0], v0[1]); w.y = pg8::cvt_pk_bf16(v0[2], v0[3]); w.z = pg8::cvt_pk_bf16(v1[0], v1[1]); w.w = pg8::cvt_pk_bf16(v1[2], v1[3]);
                        *(u32x4*)(rowp + bj * 128) = w; } }
        } else {
            const int lcol0 = wc * 32 + 8 * fq;
            bf16_t* b16 = (u.pn == 8) ? CQ16 : CKV16;
#pragma unroll
            for (int ai = 0; ai < 2; ++ai)
#pragma unroll
                for (int m = 0; m < 4; ++m) { const size_t row = (size_t)(row0 + ai * 128 + m * 16);
                    float* rowp = P32 + row * 512 + (u.pn - 8) * 256 + lcol0;
#pragma unroll
                    for (int bj = 0; bj < 2; ++bj) { const f32x4 v0 = acc[ai][bj][m][0], v1 = acc[ai][bj][m][1];
                        *(f32x4*)(rowp + bj * 128) = v0; *(f32x4*)(rowp + bj * 128 + 4) = v1;
                        u32x4 w; w.x = pg8::cvt_pk_bf16(v0[0], v0[1]); w.y = pg8::cvt_pk_bf16(v0[2], v0[3]); w.z = pg8::cvt_pk_bf16(v1[0], v1[1]); w.w = pg8::cvt_pk_bf16(v1[2], v1[3]);
                        *(u32x4*)(b16 + row * 256 + lcol0 + bj * 128) = w;
                        if (u.pn == 9 && bj == 1 && wc == 0) { *(f32x4*)(KPE + row * 32 + 8 * fq) = v0; *(f32x4*)(KPE + row * 32 + 8 * fq + 4) = v1; }
                    } }
            row_ss_store(acc, (u.pn == 8) ? SSQ : SSK, 4, wc, row0, fq, u.pn == 9);
        }
    }
};
struct EpiB16 {
    static constexpr bool PERM = true;
    bf16_t* O; int ldc; const float* SS; float invn; int nslot;
    DI void operator()(const f32x4 (&acc)[2][2][4][2], const pg8::Unit& u, int wr, int wc, int fr, int fq) const {
        const int row0 = u.pm * 256 + wr * 64 + fr, col0 = u.pn * 256 + wc * 32 + 8 * fq;
#pragma unroll
        for (int ai = 0; ai < 2; ++ai)
#pragma unroll
            for (int m = 0; m < 4; ++m) { const int row = row0 + ai * 128 + m * 16; bf16_t* rowp = O + (size_t)row * ldc + col0;
                const float rs = SS ? 1.f / sqrtf((nslot == 16 ? ss_sum16(SS, row) : ss_sum4(SS, row)) * invn + EPS) : 1.f;
#pragma unroll
                for (int bj = 0; bj < 2; ++bj) { const f32x4 v0 = acc[ai][bj][m][0] * rs, v1 = acc[ai][bj][m][1] * rs;
                    u32x4 w; w.x = pg8::cvt_pk_bf16(v0[0], v0[1]); w.y = pg8::cvt_pk_bf16(v0[2], v0[3]); w.z = pg8::cvt_pk_bf16(v1[0], v1[1]); w.w = pg8::cvt_pk_bf16(v1[2], v1[3]);
                    *(u32x4*)(rowp + bj * 128) = w; } }
    }
};
struct EpiH1 {
    static constexpr bool PERM = true;
    float* C; const float* res; bf16_t* H16; float* SS;
    DI void operator()(const f32x4 (&acc)[2][2][4][2], const pg8::Unit& u, int wr, int wc, int fr, int fq) const {
        const int row0 = u.pm * 256 + wr * 64 + fr, col0 = u.pn * 256 + wc * 32 + 8 * fq;
        f32x4 v[2][2][4][2];
#pragma unroll
        for (int ai = 0; ai < 2; ++ai)
#pragma unroll
            for (int m = 0; m < 4; ++m) { const size_t off = (size_t)(row0 + ai * 128 + m * 16) * 1024 + col0;
#pragma unroll
                for (int bj = 0; bj < 2; ++bj) { const f32x4 v0 = acc[ai][bj][m][0] + *(const f32x4*)(res + off + bj * 128), v1 = acc[ai][bj][m][1] + *(const f32x4*)(res + off + bj * 128 + 4);
                    v[ai][bj][m][0] = v0; v[ai][bj][m][1] = v1;
                    *(f32x4*)(C + off + bj * 128) = v0; *(f32x4*)(C + off + bj * 128 + 4) = v1;
                    u32x4 w; w.x = pg8::cvt_pk_bf16(v0[0], v0[1]); w.y = pg8::cvt_pk_bf16(v0[2], v0[3]); w.z = pg8::cvt_pk_bf16(v1[0], v1[1]); w.w = pg8::cvt_pk_bf16(v1[2], v1[3]);
                    *(u32x4*)(H16 + off + bj * 128) = w; } }
        row_ss_store(v, SS, 16, u.pn * 4 + wc, row0, fq, false);
    }
};
struct EpiF32 {
    static constexpr bool PERM = true;
    float* C; int ldc; const float* res;
    DI void operator()(const f32x4 (&acc)[2][2][4][2], const pg8::Unit& u, int wr, int wc, int fr, int fq) const {
        const int row0 = u.pm * 256 + wr * 64 + fr, col0 = u.pn * 256 + wc * 32 + 8 * fq;
#pragma unroll
        for (int ai = 0; ai < 2; ++ai)
#pragma unroll
            for (int m = 0; m < 4; ++m) { const size_t off = (size_t)(row0 + ai * 128 + m * 16) * ldc + col0;
#pragma unroll
                for (int bj = 0; bj < 2; ++bj) { f32x4 v0 = acc[ai][bj][m][0], v1 = acc[ai][bj][m][1];
                    if (res) { v0 += *(const f32x4*)(res + off + bj * 128); v1 += *(const f32x4*)(res + off + bj * 128 + 4); }
                    *(f32x4*)(C + off + bj * 128) = v0; *(f32x4*)(C + off + bj * 128 + 4) = v1; } }
    }
};

DI f32x16 mfma32(bf16x8 a, bf16x8 b, f32x16 c) { return __builtin_amdgcn_mfma_f32_32x32x16_bf16(a, b, c, 0, 0, 0); }
DI f32x4 mfma16(bf16x8 a, bf16x8 b, f32x4 c) { return __builtin_amdgcn_mfma_f32_16x16x32_bf16(a, b, c, 0, 0, 0); }
DI int crow(int r, int hi) { return (r & 3) + 8 * (r >> 2) + 4 * hi; }
DI f32x16 zero16() { f32x16 z;
#pragma unroll
    for (int i = 0; i < 16; ++i) z[i] = 0.f; return z; }

constexpr int G_KF = 0, G_VF = 16384, G_MF = 32768;
constexpr int G_QB = 50176, G_KB = 59392, G_KBB = 68608;
constexpr int G_QKB = 77824, G_UT = 87040, G_WT = 96256, G_KDT = 105472;
constexpr int G_VEC = 114688;
constexpr int G_RAW = G_QKB;
constexpr int GST = 72;

DI f32x16 mm_quad(const unsigned char* A, const unsigned char* Bt, int qr, int qc, int lane) {
    const int r32 = lane & 31, hh = lane >> 5;
    const unsigned char* ap = A + (32 * qr + r32) * (GST * 2) + hh * 16;
    const unsigned char* bp = Bt + (32 * qc + r32) * (GST * 2) + hh * 16;
    f32x16 acc = zero16();
#pragma unroll
    for (int s = 0; s < 4; ++s) acc = mfma32(*(const bf16x8*)(ap + s * 32), *(const bf16x8*)(bp + s * 32), acc);
    return acc;
}

constexpr int G_RAW2 = 115712;
static_assert(G_RAW2 + 67 * 400 <= 143360, "GDN prep LDS map");
constexpr int G_CONVW = 143360 + 512;

#ifndef PROBE_STAGE
#define PROBE_STAGE -1
#endif
template <int VAR> DI void gdn_prep_phase(const Frame& F, const Args& A) {
    unsigned long long stg_t = 0ull, stg_acc = 0ull;
#define STG(n) do { if (PROBE_STAGE >= 0) { const unsigned long long now_ = __builtin_amdgcn_s_memrealtime(); if (PROBE_STAGE == (n)) stg_acc += now_ - stg_t; stg_t = now_; } } while (0)
    unsigned char* ws = A.ws; unsigned char* lds = F.lds;
    const int tid = F.tid, lane = F.lane, wave = F.wave;
    const bf16_t* QKVR = (const bf16_t*)(ws + WS_QKVR); const float* P32 = (const float*)(ws + WS_P32);
    float* KF = (float*)(lds + G_KF); float* VF = (float*)(lds + G_VF); float* MF = (float*)(lds + G_MF);
    float* VEC = (float*)(lds + G_VEC);
    if (VAR == 6) return;
    const int NIT = NCHUNK * 8;
#define LBAR() do { asm volatile("s_waitcnt lgkmcnt(0)" ::: "memory"); __builtin_amdgcn_s_barrier(); asm volatile("" ::: "memory"); } while (0)
#define LAUNDER(dst, src) int dst = (src); asm volatile("" : "+v"(dst))
    int item = blockIdx.x;
    if (item >= NIT) return;
    u32x4 pr[4]; float nb = 0.f, na = 0.f;
    auto raw_fetch = [&](int it) {
        const int c = it >> 3, h = it & 7; LAUNDER(tl, tid);
#pragma unroll
        for (int i = 0; i < 4; ++i) { const int q = tl + 512 * i; pr[i] = (u32x4){0u, 0u, 0u, 0u};
            if (q < 67 * 24) { const int r = q / 24, cc = q % 24, seg = cc >> 3, c8 = cc & 7; const int p = 64 * c - 3 + r;
                if (p >= 0) pr[i] = *(const u32x4*)(QKVR + (size_t)p * 1536 + seg * 512 + h * 64 + c8 * 8); } }
        if (wave == 0) { const int p = 64 * c + lane; nb = P32[(size_t)p * 512 + 416 + h]; na = P32[(size_t)p * 512 + 424 + h]; }
    };
    auto raw_park = [&]() {
        LAUNDER(tl, tid);
#pragma unroll
        for (int i = 0; i < 4; ++i) { const int q = tl + 512 * i;
            if (q < 67 * 24) { const int r = q / 24, cc = q % 24, seg = cc >> 3, c8 = cc & 7; *(u32x4*)(lds + G_RAW2 + r * 400 + (seg * 64 + c8 * 8) * 2) = pr[i]; } }
    };
    raw_fetch(item); raw_park();
    float cb = nb, ca = na;
    float* CWL = (float*)(lds + G_CONVW);
    int cw_h = -1;
#pragma unroll 1
    for (; item < NIT; item += F.G) {
        if (PROBE_STAGE >= 0 && stg_t == 0ull) stg_t = __builtin_amdgcn_s_memrealtime();
        const int c = item >> 3, h = item & 7;
        if (h != cw_h) { cw_h = h;
            if (tid < 192) { LAUNDER(t0, tid); const int sg = t0 >> 6, jt = (t0 >> 4) & 3, c4 = t0 & 15; *(f32x4*)(CWL + (sg * 4 + jt) * 64 + 4 * c4) = *(const f32x4*)(A.in[4] + jt * 1536 + sg * 512 + h * 64 + 4 * c4); } }
        const int nxt = item + F.G;
        if (VAR != 5 && nxt < NIT) raw_fetch(nxt);
        if (wave == 0) {
            const int p = 64 * c + lane;
            const float alog = A.in[5][h], dtb = A.in[6][h];
            float beta = sigmoidf_(cb);
            const float xx = ca + dtb; const float sp = xx > 20.f ? xx : log1pf(__expf(xx));
            float g = -__expf(alog) * sp;
            if (p < PADL) { beta = 0.f; g = 0.f; }
            float gc = g;
#pragma unroll
            for (int o = 1; o < 64; o <<= 1) { const float t = __shfl_up(gc, o); if (lane >= o) gc += t; }
            const float glast = __shfl(gc, 63);
            VEC[lane] = gc; VEC[64 + lane] = beta; VEC[128 + lane] = __expf(gc); VEC[192 + lane] = __expf(glast - gc);
        }
        LBAR(); STG(0);
        LAUNDER(t1, tid); const int sub = t1 & 15, grp = t1 >> 4;
#pragma unroll
        for (int sg = 0; sg < ((VAR == 2 || VAR >= 4) ? 0 : 3); ++sg) {
#pragma unroll
            for (int ps = 0; ps < 2; ++ps) {
                const int i = grp + 32 * ps;
                float acc[4] = {0.f, 0.f, 0.f, 0.f};
#pragma unroll
                for (int jt = 0; jt < 4; ++jt) {
                    const f32x4 w = *(const f32x4*)(CWL + (sg * 4 + jt) * 64 + 4 * sub);
                    const u32x2 rv = *(const u32x2*)(lds + G_RAW2 + (i + jt) * 400 + (sg * 64 + 4 * sub) * 2);
                    acc[0] += w.x * bflo(rv.x); acc[1] += w.y * bfhi(rv.x); acc[2] += w.z * bflo(rv.y); acc[3] += w.w * bfhi(rv.y);
                }
                float y[4];
#pragma unroll
                for (int k = 0; k < 4; ++k) y[k] = siluf_(acc[k]);
                if (sg < 2) {
                    float ss = (y[0] * y[0] + y[1] * y[1]) + (y[2] * y[2] + y[3] * y[3]);
                    ss += __shfl_xor(ss, 1); ss += __shfl_xor(ss, 2); ss += __shfl_xor(ss, 4); ss += __shfl_xor(ss, 8);
                    const float rn = 1.f / sqrtf(ss + EPS);
#pragma unroll
                    for (int k = 0; k < 4; ++k) y[k] *= rn;
                }
                if (sg == 0) {
                    u32x2 o; o.x = pk2(y[0] * 0.125f, y[1] * 0.125f); o.y = pk2(y[2] * 0.125f, y[3] * 0.125f);
                    *(u32x2*)(lds + G_QB + i * (GST * 2) + 8 * sub) = o;
                } else if (sg == 1) {
                    const float beta = VEC[64 + i], ekd = VEC[192 + i];
                    *(f32x4*)(KF + i * 64 + 4 * sub) = (f32x4){y[0], y[1], y[2], y[3]};
                    u32x2 o; o.x = pk2(y[0], y[1]); o.y = pk2(y[2], y[3]);
                    *(u32x2*)(lds + G_KB + i * (GST * 2) + 8 * sub) = o;
                    o.x = pk2(y[0] * beta, y[1] * beta); o.y = pk2(y[2] * beta, y[3] * beta);
                    *(u32x2*)(lds + G_KBB + i * (GST * 2) + 8 * sub) = o;
#pragma unroll
                    for (int k = 0; k < 4; ++k) *(bf16_t*)(lds + G_KDT + (4 * sub + k) * (GST * 2) + i * 2) = (bf16_t)f2bf(y[k] * ekd);
                } else {
                    *(f32x4*)(VF + i * 64 + 4 * sub) = (f32x4){y[0], y[1], y[2], y[3]};
                }
            }
        }
        LBAR(); STG(1);
        if (VAR != 3 && VAR < 4) {
            LAUNDER(l3, lane);
            const int prod = wave >> 2, quad = wave & 3, qr = quad >> 1, qc = quad & 1, r32 = l3 & 31, hh = l3 >> 5;
            const f32x16 acc = mm_quad(lds + (prod ? G_QB : G_KBB), lds + G_KB, qr, qc, l3);
            const int j = 32 * qc + r32; const float gcj = VEC[j];
#pragma unroll
            for (int r = 0; r < 16; ++r) {
                const int i = 32 * qr + crow(r, hh);
                if (prod == 0) { MF[i * 68 + j] = (j < i) ? acc[r] * __expf(VEC[i] - gcj) : 0.f; }
                else { *(bf16_t*)(lds + G_QKB + i * (GST * 2) + j * 2) = (bf16_t)f2bf((j <= i) ? acc[r] * __expf(VEC[i] - gcj) : 0.f); }
            }
        }
        LBAR(); STG(2);
        float* DB = (float*)(lds + G_KBB);
        if (VAR != 1 && VAR < 4 && wave == 0) {
            LAUNDER(l4, lane); const int b = l4 >> 4, jc = l4 & 15;
            float d[16];
#pragma unroll
            for (int i = 0; i < 16; ++i) {
                float acc = (i == jc) ? 1.f : 0.f;
                const float* mrow = MF + (16 * b + i) * 68 + 16 * b;
#pragma unroll
                for (int k = 0; k < i; ++k) acc -= mrow[k] * d[k];
                d[i] = acc;
            }
#pragma unroll
            for (int i = 0; i < 16; ++i) DB[(b * 16 + i) * 20 + jc] = d[i];
        }
        LBAR();
        if (VAR != 1 && VAR < 4) {
            LAUNDER(l4, lane); const int cc = l4 & 15, g = l4 >> 4;
            const bool isU = wave < 4; const int col = 16 * (wave & 3) + cc;
            const float* src = (isU ? VF : KF) + col;
            f32x4 X[4];
#pragma unroll
            for (int b = 0; b < 4; ++b) {
                f32x4 acc;
#pragma unroll
                for (int r = 0; r < 4; ++r) { const int i = 16 * b + 4 * g + r; float rv = src[i * 64] * VEC[64 + i]; if (!isU) rv *= VEC[128 + i]; acc[r] = -rv; }
#pragma unroll
                for (int a = 0; a < b; ++a) {
                    const f32x4 lv = *(const f32x4*)(MF + (16 * b + cc) * 68 + 16 * a + 4 * g);
#pragma unroll
                    for (int sp = 0; sp < 4; ++sp) acc = __builtin_amdgcn_mfma_f32_16x16x4f32(lv[sp], X[a][sp], acc, 0, 0, 0);
                }
                const f32x4 dv = *(const f32x4*)(DB + (b * 16 + cc) * 20 + 4 * g);
                f32x4 xb = (f32x4){0.f, 0.f, 0.f, 0.f};
#pragma unroll
                for (int sp = 0; sp < 4; ++sp) xb = __builtin_amdgcn_mfma_f32_16x16x4f32(dv[sp], acc[sp], xb, 0, 0, 0);
                X[b] = -xb;
                unsigned char* dst = lds + (isU ? G_UT : G_WT) + col * (GST * 2) + (16 * b + 4 * g) * 2;
                *(u32x2*)dst = (u32x2){pk2(X[b][0], X[b][1]), pk2(X[b][2], X[b][3])};
            }
        }
        LBAR(); STG(3);
        if (VAR != 3 && VAR < 4) {
            const float gl = VEC[128 + 63];
            bf16_t* GB = (bf16_t*)(ws + WS_GB) + (size_t)item * 4096;
            bf16_t* GQ = (bf16_t*)(ws + (VAR ? WS_GS : WS_GQ)) + (size_t)item * 4096; bf16_t* GO = (bf16_t*)(ws + (VAR ? WS_GS : WS_GO)) + (size_t)item * 4096;
            bf16_t* GAL = (bf16_t*)(lds + G_MF);
            LAUNDER(l5, lane); const int r32 = l5 & 31, hh = l5 >> 5;
#pragma unroll 1
            for (int it = 0; it < 2; ++it) {
                const int task = wave + 8 * it, prod = task >> 2, quad = task & 3, qr = quad >> 1, qc = quad & 1;
                const f32x16 acc = mm_quad(lds + (prod < 2 ? G_KDT : G_QKB), lds + ((prod & 1) ? G_UT : G_WT), qr, qc, l5);
                const int Cc = 32 * qc + r32;
                if (prod == 0) {
#pragma unroll
                    for (int r = 0; r < 16; ++r) {
                        const int R = 32 * qr + crow(r, hh);
                        const float val = ((R == Cc) ? gl : 0.f) - acc[r];
                        const int rb = R >> 4, m = R & 15, q4 = Cc >> 4, g = (Cc >> 2) & 3, rr = Cc & 3, ks = q4 >> 1, jj = 4 * (q4 & 1) + rr, ls = 16 * g + m;
                        GAL[((rb * 2 + ks) * 64 + ls) * 8 + jj] = (bf16_t)f2bf(val);
                    }
                } else if (prod == 1) {
                    const int eslab = Cc >> 4, n = Cc & 15;
#pragma unroll
                    for (int a = 0; a < 4; ++a) {
                        const int R0 = 32 * qr + 8 * a + 4 * hh; const int rb = R0 >> 4, g = (R0 >> 2) & 3, ls = 16 * g + n;
                        *(u32x2*)(GB + ((eslab * 4 + rb) * 64 + ls) * 4) = (u32x2){pk2(acc[4 * a], acc[4 * a + 1]), pk2(acc[4 * a + 2], acc[4 * a + 3])};
                    }
                } else if (prod == 2) {
#pragma unroll
                    for (int r = 0; r < 16; ++r) {
                        const int R = 32 * qr + crow(r, hh);
                        const float qv = bf2f(*(const bf16_t*)(lds + G_QB + R * (GST * 2) + Cc * 2));
                        GQ[R * 64 + Cc] = (bf16_t)f2bf(qv * VEC[128 + R] - acc[r]);
                    }
                } else {
#pragma unroll
                    for (int r = 0; r < 16; ++r) GO[(quad * 16 + r) * 64 + l5] = (bf16_t)f2bf(acc[r]);
                }
            }
        }
        if (VAR != 5 && nxt < NIT) { raw_park(); cb = nb; ca = na; }
        LBAR(); STG(4);
        if (VAR != 5) { LAUNDER(t6, tid); *(u32x4*)((bf16_t*)(ws + (VAR ? WS_GS : WS_GA)) + (size_t)item * 4096 + t6 * 8) = *(const u32x4*)(lds + G_MF + t6 * 16); }
        STG(5);
    }
    if (PROBE_STAGE >= 0 && tid == 0) { *(unsigned long long*)(lds + 143360 + 96) = stg_acc; }
}

constexpr int SC_D = 8, SC_PD = 6, SC_SLOT = 10240;
DI void gdn_scan(const Frame& F, const Args& A) {
    if (blockIdx.x >= 32) return;
    unsigned char* ws = A.ws;
    const int h = blockIdx.x & 7, eslab = blockIdx.x >> 3, lane = F.lane, wave = F.wave, n = lane & 15, g = lane >> 4;
    const unsigned char* GA = ws + WS_GA; const unsigned char* GB = ws + WS_GB; bf16_t* GS = (bf16_t*)(ws + WS_GS);
    LAS unsigned char* ring = (LAS unsigned char*)F.lds;
    const int np = (wave == 0) ? 0 : ((wave - 1 < 3) ? 2 : 1);
    auto issue = [&](int c) {
        const int cc = c < NCHUNK ? c : NCHUNK - 1;
        const size_t item = (size_t)cc * 8 + h;
        LAS unsigned char* slot = ring + (c % SC_D) * SC_SLOT;
#pragma unroll
        for (int i = 0; i < 2; ++i) if (i < np) {
            const int q = (wave - 1) + 7 * i;
            const unsigned char* src = (q < 8) ? GA + item * 8192 + q * 1024 : GB + item * 8192 + eslab * 2048 + (q - 8) * 1024;
            LAS unsigned char* dst = slot + ((q < 8) ? q * 1024 : 8192 + (q - 8) * 1024);
            __builtin_amdgcn_global_load_lds((const unsigned*)(src + lane * 16), (LAS unsigned*)dst, 16, 0, 0);
        }
    };
    for (int c = 0; c < SC_PD; ++c) issue(c);
    f32x4 S[4];
#pragma unroll
    for (int rb = 0; rb < 4; ++rb) S[rb] = (f32x4){0.f, 0.f, 0.f, 0.f};
#pragma unroll 1
    for (int c = 0; c < NCHUNK; ++c) {
        issue(c + SC_PD);
        if (np == 2) asm volatile("s_waitcnt vmcnt(12)" ::: "memory");
        else if (np == 1) asm volatile("s_waitcnt vmcnt(6)" ::: "memory");
        asm volatile("s_waitcnt lgkmcnt(0)" ::: "memory");
        __builtin_amdgcn_s_barrier();
        asm volatile("" ::: "memory");
        if (wave == 0) {
            const LAS unsigned char* slot = ring + (c % SC_D) * SC_SLOT;
            bf16x8 ac[8]; f32x4 bc[4];
#pragma unroll
            for (int q = 0; q < 8; ++q) ac[q] = *(const LAS bf16x8*)(slot + q * 1024 + lane * 16);
#pragma unroll
            for (int rb = 0; rb < 4; ++rb) { const u32x2 w = *(const LAS u32x2*)(slot + 8192 + rb * 512 + lane * 8); bc[rb] = (f32x4){bflo(w.x), bfhi(w.x), bflo(w.y), bfhi(w.y)}; }
            const size_t item = (size_t)c * 8 + h;
            u32x4 p0, p1;
            p0.x = pk2(S[0][0], S[0][1]); p0.y = pk2(S[0][2], S[0][3]); p0.z = pk2(S[1][0], S[1][1]); p0.w = pk2(S[1][2], S[1][3]);
            p1.x = pk2(S[2][0], S[2][1]); p1.y = pk2(S[2][2], S[2][3]); p1.z = pk2(S[3][0], S[3][1]); p1.w = pk2(S[3][2], S[3][3]);
            {
                bf16_t* st = GS + item * 4096 + (16 * eslab + n) * 64 + 4 * g;
                *(u32x2*)(st + 0) = (u32x2){p0.x, p0.y}; *(u32x2*)(st + 16) = (u32x2){p0.z, p0.w};
                *(u32x2*)(st + 32) = (u32x2){p1.x, p1.y}; *(u32x2*)(st + 48) = (u32x2){p1.z, p1.w};
            }
            const bf16x8 b0 = __builtin_bit_cast(bf16x8, p0), b1 = __builtin_bit_cast(bf16x8, p1);
#pragma unroll
            for (int rb = 0; rb < 4; ++rb) {
                f32x4 acc = bc[rb];
                acc = mfma16(ac[rb * 2 + 0], b0, acc);
                acc = mfma16(ac[rb * 2 + 1], b1, acc);
                S[rb] = acc;
            }
        }
    }
    asm volatile("s_waitcnt vmcnt(0) lgkmcnt(0)" ::: "memory");
    __builtin_amdgcn_s_barrier();
}

DI void gdn_out_task(const Frame& F, const Args& A, int task) {
    unsigned char* ws = A.ws;
    const int ihalf = task & 1, item = (task >> 1) + 8, c = item >> 3, h = item & 7, lane = F.lane, r32 = lane & 31, hh = lane >> 5;
    const bf16_t* GQ = (const bf16_t*)(ws + WS_GQ) + (size_t)item * 4096; const bf16_t* GS = (const bf16_t*)(ws + WS_GS) + (size_t)item * 4096;
    const bf16_t* GO = (const bf16_t*)(ws + WS_GO) + (size_t)item * 4096;
    const bf16_t* Z = (const bf16_t*)(ws + WS_Z); bf16_t* MIX = (bf16_t*)(ws + WS_MIX);
    f32x16 acc[2];
#pragma unroll
    for (int eh = 0; eh < 2; ++eh)
#pragma unroll
        for (int r = 0; r < 16; ++r) acc[eh][r] = bf2f(GO[((ihalf * 2 + eh) * 16 + r) * 64 + lane]);
#pragma unroll
    for (int s = 0; s < 4; ++s) {
        const bf16x8 a = *(const bf16x8*)(GQ + (32 * ihalf + r32) * 64 + 16 * s + 8 * hh);
#pragma unroll
        for (int eh = 0; eh < 2; ++eh) {
            const bf16x8 b = *(const bf16x8*)(GS + (32 * eh + r32) * 64 + 16 * s + 8 * hh);
            acc[eh] = mfma32(a, b, acc[eh]);
        }
    }
    const float* gnorm = A.in[7];
    const float w0 = gnorm[r32], w1 = gnorm[32 + r32];
#pragma unroll
    for (int r = 0; r < 16; ++r) {
        float ss = acc[0][r] * acc[0][r] + acc[1][r] * acc[1][r];
        ss += __shfl_xor(ss, 1); ss += __shfl_xor(ss, 2); ss += __shfl_xor(ss, 4); ss += __shfl_xor(ss, 8); ss += __shfl_xor(ss, 16);
        const float rstd = 1.f / sqrtf(ss * (1.f / 64.f) + EPS);
        const int i = 32 * ihalf + crow(r, hh); const int p = 64 * c + i;
        const float z0 = bf2f(Z[(size_t)p * 512 + h * 64 + r32]), z1 = bf2f(Z[(size_t)p * 512 + h * 64 + 32 + r32]);
        bf16_t* o = MIX + (size_t)(p - 64) * 1024 + h * 64;
        o[r32] = (bf16_t)f2bf(acc[0][r] * rstd * w0 * siluf_(z0));
        o[32 + r32] = (bf16_t)f2bf(acc[1][r] * rstd * w1 * siluf_(z1));
    }
}

DI void mla_prep1_rows(const Frame& F, const Args& A, int p0, int stride) {
    unsigned char* ws = A.ws; const int lane = F.lane;
    f32x4 q[4]; float k0[4], k1[4], pe[4];
#pragma unroll
    for (int r = 0; r < 4; ++r) { const int p = p0 + r * stride; const int pc = p < MP ? p : MP - 1;
        const float* P32 = (const float*)(ws + WS_P32) + (size_t)pc * 512;
        q[r] = *(const f32x4*)(P32 + 4 * lane); k0[r] = P32[256 + 2 * lane]; k1[r] = P32[256 + 2 * lane + 1]; pe[r] = P32[384 + (lane & 31)]; }
    const f32x4 wq = *(const f32x4*)(A.in[8] + 4 * lane);
    const float wk0 = A.in[9][2 * lane], wk1 = A.in[9][2 * lane + 1];
#pragma unroll
    for (int r = 0; r < 4; ++r) {
        const int p = p0 + r * stride; if (p >= MP) continue;
        bf16_t* CQN = (bf16_t*)(ws + WS_CQN) + (size_t)p * 256; bf16_t* CKVN = (bf16_t*)(ws + WS_CKVN) + (size_t)p * 256;
        const float sq = wave_sum((q[r].x * q[r].x + q[r].y * q[r].y) + (q[r].z * q[r].z + q[r].w * q[r].w));
        const float rq = 1.f / sqrtf(sq * (1.f / 256.f) + EPS);
        *(u32x2*)(CQN + 4 * lane) = (u32x2){pk2(q[r].x * rq * wq.x, q[r].y * rq * wq.y), pk2(q[r].z * rq * wq.z, q[r].w * rq * wq.w)};
        const float sk = wave_sum(k0[r] * k0[r] + k1[r] * k1[r]);
        const float rk = 1.f / sqrtf(sk * (1.f / 128.f) + EPS);
        *(unsigned*)(CKVN + 2 * lane) = pk2(k0[r] * rk * wk0, k1[r] * rk * wk1);
        *(unsigned*)(CKVN + 128 + 2 * lane) = 0u;
        if (lane < 32) ((float*)(ws + WS_KPE))[(size_t)p * 32 + lane] = pe[r];
    }
}

constexpr float QSCALE = 0.10206207261596577f * 1.4426950408889634f;
DI double rope_inv_rev(int i) {
    const double t8[8] = {0.15915494309189535, 0.08949940160889101, 0.050329212104487035, 0.0283021958306234, 0.015915494309189534, 0.008949940160889102, 0.005032921210448704, 0.00283021958306234};
    double v = t8[0];
#pragma unroll
    for (int k = 1; k < 8; ++k) v = ((i & 7) == k) ? t8[k] : v;
    return (i & 8) ? v * 0.01 : v;
}
constexpr int P2_TS = 136;
constexpr int P2_RS = 272;
#define P2_WSYNC() do { __builtin_amdgcn_s_waitcnt(0); __builtin_amdgcn_wave_barrier(); } while (0)
DI void mla_prep2_task(const Frame& F, const Args& A, int task) {
    unsigned char* ws = A.ws; int lane = F.lane; asm volatile("" : "+v"(lane));
    const int h = task & 7, blk = task >> 3;
    const int p = 64 * blk + lane;
    const bool valid = (p >= PADL) && (p < LPV);
    const float* qn = A.in[12]; const float* kn = A.in[13];
    unsigned char* TS = F.lds + F.wave * (64 * P2_RS);
    unsigned char* trow = TS + lane * P2_RS;
    const double pos = (double)(p - PADL);
    auto rot = [&](int i, float& sn_, float& cs_) { const double rev = pos * rope_inv_rev(i); const float fr = (float)(rev - floor(rev)); sn_ = __builtin_amdgcn_sinf(fr); cs_ = __builtin_amdgcn_cosf(fr); };
    {
        {
            const bf16_t* srcb = (const bf16_t*)(ws + WS_QH) + (size_t)(64 * blk) * 768 + h * 96;
            u32x4 t[12];
#pragma unroll
            for (int i = 0; i < 12; ++i) { const int c = 64 * i + lane, r = c / 12, pc = c % 12; t[i] = *(const u32x4*)(srcb + (size_t)r * 768 + 8 * pc); }
#pragma unroll
            for (int i = 0; i < 12; ++i) { const int c = 64 * i + lane, r = c / 12, pc = c % 12; *(u32x4*)(TS + r * P2_RS + 16 * pc) = t[i]; }
            P2_WSYNC();
        }
        u32x4 w[12];
#pragma unroll
        for (int c = 0; c < 12; ++c) w[c] = *(const u32x4*)(trow + 16 * c);
        float ss = 0.f;
#pragma unroll
        for (int c = 0; c < 12; ++c) { const float a0 = bflo(w[c].x), a1 = bfhi(w[c].x), a2 = bflo(w[c].y), a3 = bfhi(w[c].y), a4 = bflo(w[c].z), a5 = bfhi(w[c].z), a6 = bflo(w[c].w), a7 = bfhi(w[c].w);
            ss += (a0 * a0 + a1 * a1) + (a2 * a2 + a3 * a3) + (a4 * a4 + a5 * a5) + (a6 * a6 + a7 * a7); }
        const float rs = valid ? QSCALE / sqrtf(ss * (1.f / 96.f) + EPS) : 0.f;
        unsigned char* dst = trow;
#pragma unroll
        for (int c = 0; c < 8; ++c) {
            const f32x4 g0 = *(const f32x4*)(qn + 8 * c), g1 = *(const f32x4*)(qn + 8 * c + 4);
            *(u32x4*)(dst + 16 * c) = (u32x4){pk2(bflo(w[c].x) * rs * g0.x, bfhi(w[c].x) * rs * g0.y), pk2(bflo(w[c].y) * rs * g0.z, bfhi(w[c].y) * rs * g0.w),
                                              pk2(bflo(w[c].z) * rs * g1.x, bfhi(w[c].z) * rs * g1.y), pk2(bflo(w[c].w) * rs * g1.z, bfhi(w[c].w) * rs * g1.w)};
        }
#pragma unroll
        for (int c = 0; c < 2; ++c) {
            float x1[8], x2[8];
            const u32x4 wa = w[8 + c], wb = w[10 + c];
            x1[0] = bflo(wa.x); x1[1] = bfhi(wa.x); x1[2] = bflo(wa.y); x1[3] = bfhi(wa.y); x1[4] = bflo(wa.z); x1[5] = bfhi(wa.z); x1[6] = bflo(wa.w); x1[7] = bfhi(wa.w);
            x2[0] = bflo(wb.x); x2[1] = bfhi(wb.x); x2[2] = bflo(wb.y); x2[3] = bfhi(wb.y); x2[4] = bflo(wb.z); x2[5] = bfhi(wb.z); x2[6] = bflo(wb.w); x2[7] = bfhi(wb.w);
            float o1[8], o2[8];
#pragma unroll
            for (int t = 0; t < 8; ++t) { float sn_, cs_; rot(8 * c + t, sn_, cs_); const float a = x1[t] * rs * qn[64 + 8 * c + t], b = x2[t] * rs * qn[80 + 8 * c + t]; o1[t] = a * cs_ - b * sn_; o2[t] = b * cs_ + a * sn_; }
            *(u32x4*)(dst + 2 * (64 + 8 * c)) = (u32x4){pk2(o1[0], o1[1]), pk2(o1[2], o1[3]), pk2(o1[4], o1[5]), pk2(o1[6], o1[7])};
            *(u32x4*)(dst + 2 * (80 + 8 * c)) = (u32x4){pk2(o2[0], o2[1]), pk2(o2[2], o2[3]), pk2(o2[4], o2[5]), pk2(o2[6], o2[7])};
        }
        P2_WSYNC();
        {
            unsigned char* outb = (unsigned char*)((bf16_t*)(ws + WS_Q) + ((size_t)h * KVROWS + 64 * blk) * 96);
            u32x4 t[12];
#pragma unroll
            for (int i = 0; i < 12; ++i) { const int c = 64 * i + lane, r = c / 12, pc = c % 12; t[i] = *(const u32x4*)(TS + r * P2_RS + 16 * pc); }
#pragma unroll
            for (int i = 0; i < 12; ++i) *(u32x4*)(outb + (size_t)(64 * i + lane) * 16) = t[i];
            P2_WSYNC();
        }
    }
    {
        {
            const bf16_t* srcb = (const bf16_t*)(ws + WS_KVB) + (size_t)(64 * blk) * 1024 + h * 128;
            const unsigned char* kpb = (const unsigned char*)((const float*)(ws + WS_KPE) + (size_t)(64 * blk) * 32);
            u32x4 t[8], e8[8];
#pragma unroll
            for (int i = 0; i < 8; ++i) { const int c = 64 * i + lane, r = c >> 3, pc = c & 7; t[i] = *(const u32x4*)(srcb + (size_t)r * 1024 + 8 * pc); e8[i] = *(const u32x4*)(kpb + (size_t)c * 16); }
#pragma unroll
            for (int i = 0; i < 8; ++i) { const int c = 64 * i + lane, r = c >> 3, pc = c & 7; *(u32x4*)(TS + r * P2_RS + 16 * pc) = t[i]; *(u32x4*)(TS + r * P2_RS + 128 + 16 * pc) = e8[i]; }
            P2_WSYNC();
        }
        u32x4 w[8]; f32x4 e[8];
#pragma unroll
        for (int c = 0; c < 8; ++c) { w[c] = *(const u32x4*)(trow + 16 * c); e[c] = *(const f32x4*)(trow + 128 + 16 * c); }
        float ss = 0.f;
#pragma unroll
        for (int c = 0; c < 8; ++c) { const float a0 = bflo(w[c].x), a1 = bfhi(w[c].x), a2 = bflo(w[c].y), a3 = bfhi(w[c].y), a4 = bflo(w[c].z), a5 = bfhi(w[c].z), a6 = bflo(w[c].w), a7 = bfhi(w[c].w);
            ss += (a0 * a0 + a1 * a1) + (a2 * a2 + a3 * a3) + (a4 * a4 + a5 * a5) + (a6 * a6 + a7 * a7);
            ss += (e[c].x * e[c].x + e[c].y * e[c].y) + (e[c].z * e[c].z + e[c].w * e[c].w); }
        const float rs = valid ? 1.f / sqrtf(ss * (1.f / 96.f) + EPS) : 0.f;
        unsigned char* dst = trow;
#pragma unroll
        for (int c = 0; c < 8; ++c) {
            const f32x4 g0 = *(const f32x4*)(kn + 8 * c), g1 = *(const f32x4*)(kn + 8 * c + 4);
            *(u32x4*)(dst + 16 * c) = (u32x4){pk2(bflo(w[c].x) * rs * g0.x, bfhi(w[c].x) * rs * g0.y), pk2(bflo(w[c].y) * rs * g0.z, bfhi(w[c].y) * rs * g0.w),
                                              pk2(bflo(w[c].z) * rs * g1.x, bfhi(w[c].z) * rs * g1.y), pk2(bflo(w[c].w) * rs * g1.z, bfhi(w[c].w) * rs * g1.w)};
        }
#pragma unroll
        for (int c = 0; c < 2; ++c) {
            const float x1[8] = {e[2 * c].x, e[2 * c].y, e[2 * c].z, e[2 * c].w, e[2 * c + 1].x, e[2 * c + 1].y, e[2 * c + 1].z, e[2 * c + 1].w};
            const float x2[8] = {e[4 + 2 * c].x, e[4 + 2 * c].y, e[4 + 2 * c].z, e[4 + 2 * c].w, e[5 + 2 * c].x, e[5 + 2 * c].y, e[5 + 2 * c].z, e[5 + 2 * c].w};
            float o1[8], o2[8];
#pragma unroll
            for (int t = 0; t < 8; ++t) { float sn_, cs_; rot(8 * c + t, sn_, cs_); const float a = x1[t] * rs * kn[64 + 8 * c + t], b = x2[t] * rs * kn[80 + 8 * c + t]; o1[t] = a * cs_ - b * sn_; o2[t] = b * cs_ + a * sn_; }
            *(u32x4*)(dst + 2 * (64 + 8 * c)) = (u32x4){pk2(o1[0], o1[1]), pk2(o1[2], o1[3]), pk2(o1[4], o1[5]), pk2(o1[6], o1[7])};
            *(u32x4*)(dst + 2 * (80 + 8 * c)) = (u32x4){pk2(o2[0], o2[1]), pk2(o2[2], o2[3]), pk2(o2[4], o2[5]), pk2(o2[6], o2[7])};
        }
        P2_WSYNC();
        {
            unsigned char* outb = (unsigned char*)((bf16_t*)(ws + WS_K) + ((size_t)h * KVROWS + 64 * blk) * 96);
            u32x4 t[12];
#pragma unroll
            for (int i = 0; i < 12; ++i) { const int c = 64 * i + lane, r = c / 12, pc = c % 12; t[i] = *(const u32x4*)(TS + r * P2_RS + 16 * pc); }
#pragma unroll
            for (int i = 0; i < 12; ++i) *(u32x4*)(outb + (size_t)(64 * i + lane) * 16) = t[i];
            P2_WSYNC();
        }
    }
    {
        unsigned char* T = TS;
        const bf16_t* src = (const bf16_t*)(ws + WS_KVB) + h * 128 + 64;
#pragma unroll
        for (int it = 0; it < 8; ++it) {
            const int pr = 8 * it + (lane >> 3), ch = lane & 7; const int pp = 64 * blk + pr;
            u32x4 v = (u32x4){0u, 0u, 0u, 0u};
            if (pp >= PADL && pp < LPV) v = *(const u32x4*)(src + (size_t)pp * 1024 + 8 * ch);
            unsigned char* tp = T + (8 * ch) * P2_TS + pr * 2;
            *(bf16_t*)(tp + 0 * P2_TS) = (bf16_t)(v.x & 0xffffu); *(bf16_t*)(tp + 1 * P2_TS) = (bf16_t)(v.x >> 16);
            *(bf16_t*)(tp + 2 * P2_TS) = (bf16_t)(v.y & 0xffffu); *(bf16_t*)(tp + 3 * P2_TS) = (bf16_t)(v.y >> 16);
            *(bf16_t*)(tp + 4 * P2_TS) = (bf16_t)(v.z & 0xffffu); *(bf16_t*)(tp + 5 * P2_TS) = (bf16_t)(v.z >> 16);
            *(bf16_t*)(tp + 6 * P2_TS) = (bf16_t)(v.w & 0xffffu); *(bf16_t*)(tp + 7 * P2_TS) = (bf16_t)(v.w >> 16);
        }
        __builtin_amdgcn_s_waitcnt(0); __builtin_amdgcn_wave_barrier();
        bf16_t* VT = (bf16_t*)(ws + WS_VT) + (size_t)h * 64 * KVROWS + 64 * blk;
#pragma unroll
        for (int it = 0; it < 8; ++it) {
            const int e = 8 * it + (lane >> 3), ch = lane & 7;
            const u32x2 lo = *(const u32x2*)(T + e * P2_TS + 16 * ch), hi = *(const u32x2*)(T + e * P2_TS + 16 * ch + 8);
            *(u32x4*)(VT + (size_t)e * KVROWS + 8 * ch) = (u32x4){lo.x, lo.y, hi.x, hi.y};
        }
        __builtin_amdgcn_s_waitcnt(0); __builtin_amdgcn_wave_barrier();
    }
}

constexpr int A_KSTR = 208;
constexpr int A_VSTR = 136;
constexpr int A_KBYTES = 64 * A_KSTR;
constexpr int A_VBYTES = 64 * A_VSTR;
constexpr int A_BUF = A_KBYTES + A_VBYTES;
DI unsigned cvtpk_s(float lo, float hi) { typedef float f2 __attribute__((ext_vector_type(2))); typedef __bf16 b2 __attribute__((ext_vector_type(2))); f2 v = {lo, hi}; b2 b = __builtin_convertvector(v, b2); return __builtin_bit_cast(unsigned, b); }

DI void attn_item(const Frame& F, const Args& A, int h, int qb) {
    unsigned char* ws = A.ws; unsigned char* lds = F.lds;
    const int tid = F.tid, lane = F.lane, wave = F.wave, r32 = lane & 31, hh = lane >> 5;
    const bf16_t* Qg = (const bf16_t*)(ws + WS_Q) + (size_t)h * KVROWS * 96;
    const bf16_t* Kg = (const bf16_t*)(ws + WS_K) + (size_t)h * KVROWS * 96;
    const bf16_t* Vg = (const bf16_t*)(ws + WS_VT) + (size_t)h * 64 * KVROWS;
    const int p0w = 64 + 256 * qb + 32 * wave;
    const int qp = p0w + r32;
    const int ntile = 4 * qb + 5;
    const int mylast = 1 + 4 * qb + (wave >> 1);
    bf16x8 qf[6];
#pragma unroll
    for (int s = 0; s < 6; ++s) qf[s] = *(const bf16x8*)(Qg + (size_t)qp * 96 + 16 * s + 8 * hh);
    f32x16 ot[2]; ot[0] = zero16(); ot[1] = zero16();
    float mrun = -1e30f, lrun = 0.f;
    const int kr0 = tid / 12, kc0 = tid % 12, kr1 = (tid + 512) / 12, kc1 = (tid + 512) % 12; const bool k1ok = tid < 256;
    const int vr = tid >> 3, vc = tid & 7;
    struct Stg { u32x4 k0, k1, v; };
    Stg sA;
    auto gload = [&](Stg& st, int j) {
        const int kv0 = 64 * j;
        st.k0 = *(const u32x4*)(Kg + (size_t)(kv0 + kr0) * 96 + kc0 * 8);
        if (k1ok) st.k1 = *(const u32x4*)(Kg + (size_t)(kv0 + kr1) * 96 + kc1 * 8);
        st.v = *(const u32x4*)(Vg + (size_t)vr * KVROWS + kv0 + vc * 8);
    };
    auto lstore = [&](const Stg& st, int t) {
        unsigned char* kb = lds + (t % 3) * A_BUF; unsigned char* vb = kb + A_KBYTES;
        *(u32x4*)(kb + kr0 * A_KSTR + kc0 * 16) = st.k0;
        if (k1ok) *(u32x4*)(kb + kr1 * A_KSTR + kc1 * 16) = st.k1;
        *(u32x2*)(vb + vr * A_VSTR + vc * 16) = (u32x2){st.v.x, st.v.y};
        *(u32x2*)(vb + vr * A_VSTR + vc * 16 + 8) = (u32x2){st.v.z, st.v.w};
    };
    auto step = [&](auto FIRSTc, auto LASTc, int t, f32x16 (&C)[2], f32x16 (&P)[2]) {
        if (t + 1 < ntile) gload(sA, t + 1);
        constexpr bool has_cur = !decltype(LASTc)::value, has_prev = !decltype(FIRSTc)::value;
        const unsigned char* kb = lds + (t % 3) * A_BUF;
        const unsigned char* vb = lds + ((t + 2) % 3) * A_BUF + A_KBYTES;
        bf16x8 kf[2][6];
        if constexpr (has_cur) {
            const unsigned char* kp = kb + r32 * A_KSTR + hh * 16;
#pragma unroll
            for (int s = 0; s < 6; ++s) kf[0][s] = *(const bf16x8*)(kp + s * 32);
        }
        float ps0 = 0.f, ps1 = 0.f; u32x4 pw[4]; bf16x8 vfr[4][2];
        auto vload = [&](int g) -> bf16x8 {
            const int f = g >> 1, eh = g & 1, kh2 = f >> 1, s2 = f & 1;
            const unsigned char* vp = vb + (32 * eh + r32) * A_VSTR + (32 * kh2 + 16 * s2 + 4 * hh) * 2;
            const u32x2 lo = *(const u32x2*)vp, hi2 = *(const u32x2*)(vp + 16);
            return __builtin_bit_cast(bf16x8, (u32x4){lo.x, lo.y, hi2.x, hi2.y}); };
        __builtin_amdgcn_sched_barrier(0);
#pragma unroll
        for (int i = 0; i < 12; ++i) {
            const int kh = i / 6, sx = i % 6;
            if constexpr (has_cur) { C[kh] = mfma32(kf[kh][sx], qf[sx], sx == 0 ? zero16() : C[kh]); if (i < 6) kf[1][i] = *(const bf16x8*)(kb + (32 + r32) * A_KSTR + hh * 16 + i * 32); }
            if (has_prev && i < 8) {
                const int f = i >> 1, kh2 = f >> 1, b0 = 8 * (f & 1) + 4 * (i & 1);
                const float v0 = P[kh2][b0], v1 = P[kh2][b0 + 1], v2 = P[kh2][b0 + 2], v3 = P[kh2][b0 + 3];
                ps0 += v0 + v1; ps1 += v2 + v3;
                if (i & 1) { pw[f].z = cvtpk_s(v0, v1); pw[f].w = cvtpk_s(v2, v3); asm volatile("" : "+v"(ps0), "+v"(ps1), "+v"(pw[f].z), "+v"(pw[f].w)); }
                else { pw[f].x = cvtpk_s(v0, v1); pw[f].y = cvtpk_s(v2, v3); asm volatile("" : "+v"(ps0), "+v"(ps1), "+v"(pw[f].x), "+v"(pw[f].y)); }
            }
            if (has_prev && i >= 10) {
                const int g0 = i - 10; vfr[g0 >> 1][g0 & 1] = vload(g0);
            }
            __builtin_amdgcn_sched_barrier(0);
        }
        if (has_prev) lrun += ps0 + ps1;
        float mnew = mrun, alpha = 1.f; bool resc = false;
        if constexpr (has_cur) {
            if (t == 0) {
#pragma unroll
                for (int kh = 0; kh < 2; ++kh)
#pragma unroll
                    for (int r = 0; r < 16; ++r) { const int kv = 32 * kh + crow(r, hh); if (kv < PADL) C[kh][r] = -INFINITY; }
            }
            if (t >= mylast) {
#pragma unroll
                for (int kh = 0; kh < 2; ++kh)
#pragma unroll
                    for (int r = 0; r < 16; ++r) { const int kv = 64 * t + 32 * kh + crow(r, hh); if (kv > qp) C[kh][r] = -INFINITY; }
            }
            float mx = C[0][0];
#pragma unroll
            for (int r = 1; r < 16; ++r) mx = fmaxf(mx, C[0][r]);
#pragma unroll
            for (int r = 0; r < 16; ++r) mx = fmaxf(mx, C[1][r]);
            mx = fmaxf(mx, __shfl_xor(mx, 32));
            mnew = fmaxf(mrun, mx);
            alpha = __builtin_amdgcn_exp2f(mrun - mnew);
            resc = __any(mnew > mrun);
        }
        __builtin_amdgcn_sched_barrier(0);
#pragma unroll
        for (int g = 0; g < 8; ++g) {
            const int f = g >> 1, eh = g & 1;
            if constexpr (has_prev) { ot[eh] = mfma32(vfr[f][eh], __builtin_bit_cast(bf16x8, pw[f]), ot[eh]); if (g + 2 < 8) vfr[(g + 2) >> 1][(g + 2) & 1] = vload(g + 2); }
            if constexpr (has_cur) { const int kh = g >> 2, r0 = 4 * (g & 3);
#pragma unroll
                for (int q = 0; q < 4; ++q) C[kh][r0 + q] = __builtin_amdgcn_exp2f(C[kh][r0 + q] - mnew);
                asm volatile("" : "+v"(C[kh][r0]), "+v"(C[kh][r0 + 1]), "+v"(C[kh][r0 + 2]), "+v"(C[kh][r0 + 3])); }
            __builtin_amdgcn_sched_barrier(0);
        }
        if constexpr (has_cur) {
            if (resc) {
#pragma unroll
                for (int eh = 0; eh < 2; ++eh)
#pragma unroll
                    for (int r = 0; r < 16; ++r) ot[eh][r] *= alpha;
            }
            lrun *= alpha; mrun = mnew;
        }
        if (t + 1 < ntile) lstore(sA, t + 1);
        __syncthreads();
    };
    gload(sA, 0); lstore(sA, 0);
    __syncthreads();
    f32x16 scA[2], scB[2];
    scB[0] = zero16(); scB[1] = zero16();
    {
        using TT = std::integral_constant<bool, true>; using FF = std::integral_constant<bool, false>;
        step(TT{}, FF{}, 0, scA, scB);
#pragma unroll 1
        for (int t = 1; t + 1 < ntile; t += 2) {
            step(FF{}, FF{}, t, scB, scA);
            step(FF{}, FF{}, t + 1, scA, scB);
        }
        step(FF{}, TT{}, ntile, scB, scA);
    }
    const float ltot = lrun + __shfl_xor(lrun, 32);
    const float rl = 1.f / ltot;
    bf16_t* o = (bf16_t*)(ws + WS_MIX) + (size_t)(qp - 64) * 1024 + 512 + h * 64;
#pragma unroll
    for (int eh = 0; eh < 2; ++eh)
#pragma unroll
        for (int a = 0; a < 4; ++a) {
            const int e = 32 * eh + 8 * a + 4 * hh;
            *(u32x2*)(o + e) = (u32x2){pk2(ot[eh][4 * a] * rl, ot[eh][4 * a + 1] * rl), pk2(ot[eh][4 * a + 2] * rl, ot[eh][4 * a + 3] * rl)};
        }
}

DI void xn_rows(const Frame& F, const Args& A, int u0, int stride) {
    f32x4 v[2][4];
#pragma unroll
    for (int r = 0; r < 2; ++r) { const int u = u0 + r * stride; if (u < MU) { const f32x4* xr = (const f32x4*)(A.out + (size_t)u * DM) + F.lane;
#pragma unroll
        for (int j = 0; j < 4; ++j) v[r][j] = xr[64 * j]; } }
#pragma unroll
    for (int r = 0; r < 2; ++r) {
        const int u = u0 + r * stride; if (u >= MU) continue;
        float s = 0.f;
#pragma unroll
        for (int j = 0; j < 4; ++j) s += (v[r][j].x * v[r][j].x + v[r][j].y * v[r][j].y) + (v[r][j].z * v[r][j].z + v[r][j].w * v[r][j].w);
        const float rstd = 1.f / sqrtf(wave_sum(s) * (1.f / DM) + EPS);
        unsigned long long* o8 = (unsigned long long*)((bf16_t*)(A.ws + WS_XN) + (size_t)u * DM) + F.lane;
#pragma unroll
        for (int j = 0; j < 4; ++j) { const f32x4 w = ((const f32x4*)A.in[15])[64 * j + F.lane];
            o8[64 * j] = (unsigned long long)pk2(v[r][j].x * rstd * w.x, v[r][j].y * rstd * w.y) | ((unsigned long long)pk2(v[r][j].z * rstd * w.z, v[r][j].w * rstd * w.w) << 32); }
    }
}

DI unsigned fkey(float v, int idx) { unsigned u = __builtin_bit_cast(unsigned, v); u = (u & 0x80000000u) ? ~u : (u | 0x80000000u); return (u & ~127u) | (unsigned)(127 - idx); }
DI float keyval(unsigned k) { unsigned u = k & ~127u; u = (u & 0x80000000u) ? (u & 0x7fffffffu) : ~u; return __builtin_bit_cast(float, u); }

__device__ const unsigned char PAIR_A[50] = {0,0,0,0,0,0,0,0,0,0,0,0,0,0,0,0, 1,1,1,1,1,1,1,1, 2,2,2,2,2, 3,3,3,3, 4,4,4, 5,5, 6,6, 7,7, 8,9,10,11,12,13,14,15};
__device__ const unsigned char PAIR_B[50] = {0,1,2,3,4,5,6,7,8,9,10,11,12,13,14,15, 0,1,2,3,4,5,6,7, 0,1,2,3,4, 0,1,2,3, 0,1,2, 0,1, 0,1, 0,1, 0,0,0,0,0,0,0,0};

DI void ce_desc(unsigned& a, unsigned& b) { const unsigned mx = a > b ? a : b, mn = a > b ? b : a; a = mx; b = mn; }
template <int BASE, int NK> DI void bitonic_sort16_desc(unsigned (&x)[NK]) {
#pragma unroll
    for (int k = 2; k <= 16; k <<= 1)
#pragma unroll
        for (int j = k >> 1; j > 0; j >>= 1)
#pragma unroll
            for (int i = 0; i < 16; ++i) { const int l = i ^ j; if (l > i) { if ((i & k) == 0) ce_desc(x[BASE + i], x[BASE + l]); else ce_desc(x[BASE + l], x[BASE + i]); } }
}
template <int A0, int B0, int NK> DI void merge_top16(unsigned (&x)[NK]) {
#pragma unroll
    for (int i = 0; i < 16; ++i) { const unsigned p = x[A0 + i], q = x[B0 + 15 - i]; x[A0 + i] = p > q ? p : q; }
#pragma unroll
    for (int j = 8; j > 0; j >>= 1)
#pragma unroll
        for (int i = 0; i < 16; ++i) { const int l = i ^ j; if (l > i) ce_desc(x[A0 + i], x[A0 + l]); }
}
template <int NK> DI void top16_of_128(unsigned (&key)[NK]) {
    bitonic_sort16_desc<0, NK>(key); bitonic_sort16_desc<16, NK>(key); bitonic_sort16_desc<32, NK>(key); bitonic_sort16_desc<48, NK>(key);
    bitonic_sort16_desc<64, NK>(key); bitonic_sort16_desc<80, NK>(key); bitonic_sort16_desc<96, NK>(key); bitonic_sort16_desc<112, NK>(key);
    merge_top16<0, 16, NK>(key); merge_top16<32, 48, NK>(key); merge_top16<64, 80, NK>(key); merge_top16<96, 112, NK>(key);
    merge_top16<0, 32, NK>(key); merge_top16<64, 96, NK>(key);
    merge_top16<0, 64, NK>(key);
}

DI void topk_task(const Frame& F, const Args& A, int task) {
    unsigned char* ws = A.ws; const int tid = F.tid;
    const int u = task >> 3, h = task & 7;
    LAS unsigned* sk = (LAS unsigned*)(LAS unsigned char*)F.lds;
    LAS unsigned* pkk = sk + 16384;
    LAS unsigned* stg = sk + 16384;
    const bf16_t* SCb = (const bf16_t*)(ws + WS_SC) + (size_t)(task & ~511) * 256;
#pragma unroll 1
    for (int half = 0; half < 2; ++half) {
        unsigned key[128];
#pragma unroll
        for (int qb = 0; qb < 2; ++qb) {
            u32x4 pf[8];
#pragma unroll
            for (int k = 0; k < 8; ++k) { const int c = tid + 512 * k; pf[k] = *(const u32x4*)(SCb + (size_t)(c >> 3) * 256 + half * 128 + qb * 64 + (c & 7) * 8); }
#pragma unroll
            for (int k = 0; k < 8; ++k) { const int c = tid + 512 * k; *(LAS u32x4*)(stg + (c >> 3) * 36 + (c & 7) * 4) = pf[k]; }
            __syncthreads();
#pragma unroll
            for (int i = 0; i < 8; ++i) { const u32x4 v = *(const LAS u32x4*)(stg + tid * 36 + 4 * i); const int b0 = 64 * qb + 8 * i;
                key[b0] = fkey(bflo(v.x), b0); key[b0 + 1] = fkey(bfhi(v.x), b0 + 1); key[b0 + 2] = fkey(bflo(v.y), b0 + 2); key[b0 + 3] = fkey(bfhi(v.y), b0 + 3);
                key[b0 + 4] = fkey(bflo(v.z), b0 + 4); key[b0 + 5] = fkey(bfhi(v.z), b0 + 5); key[b0 + 6] = fkey(bflo(v.w), b0 + 6); key[b0 + 7] = fkey(bfhi(v.w), b0 + 7); }
            __syncthreads();
        }
        top16_of_128(key);
#pragma unroll
        for (int r = 0; r < 16; ++r) sk[(half * 16 + r) * 512 + tid] = key[r];
    }
    float v1[16], v2[16];
#pragma unroll
    for (int r = 0; r < 16; ++r) { v1[r] = keyval(sk[r * 512 + tid]); v2[r] = keyval(sk[(16 + r) * 512 + tid]); }
    unsigned ck[64];
#pragma unroll
    for (int c = 50; c < 64; ++c) ck[c] = 0u;
#pragma unroll
    for (int a = 0; a < 16; ++a) {
        const int off = a == 0 ? 0 : a == 1 ? 16 : a == 2 ? 24 : a == 3 ? 29 : a == 4 ? 33 : a == 5 ? 36 : a == 6 ? 38 : a == 7 ? 40 : 42 + (a - 8);
#pragma unroll
        for (int b = 0; b < 16; ++b) if ((a + 1) * (b + 1) <= 16) ck[off + b] = fkey(v1[a] + v2[b], off + b);
    }
    bitonic_sort16_desc<0, 64>(ck); bitonic_sort16_desc<16, 64>(ck); bitonic_sort16_desc<32, 64>(ck); bitonic_sort16_desc<48, 64>(ck);
    merge_top16<0, 16, 64>(ck); merge_top16<32, 48, 64>(ck); merge_top16<0, 32, 64>(ck);
#pragma unroll
    for (int r = 0; r < 16; ++r) pkk[r * 512 + tid] = ck[r];
    const float cmax = keyval(pkk[tid]);
    float ev[16]; float esum = 0.f; int ex[16];
#pragma unroll
    for (int r = 0; r < 16; ++r) {
        const unsigned k = pkk[r * 512 + tid]; const int c = 127 - (int)(k & 127u);
        ev[r] = __expf(keyval(k) - cmax); esum += ev[r];
        const int a = PAIR_A[c], b = PAIR_B[c];
        const int i1 = 127 - (int)(sk[a * 512 + tid] & 127u), i2 = 127 - (int)(sk[(16 + b) * 512 + tid] & 127u);
        ex[r] = i1 * 128 + i2;
    }
    const float rs = 1.f / esum;
    int* IDX = (int*)(ws + WS_IDX) + (size_t)u * 128 + h * 16; float* GATE = (float*)(ws + WS_GATE) + (size_t)u * 128 + h * 16;
#pragma unroll
    for (int r = 0; r < 16; r += 4) {
        *(int4*)(IDX + r) = make_int4(ex[r], ex[r + 1], ex[r + 2], ex[r + 3]);
        *(f32x4*)(GATE + r) = (f32x4){ev[r] * rs, ev[r + 1] * rs, ev[r + 2] * rs, ev[r + 3] * rs};
    }
}

constexpr float EU_SCALE = 64.f, EV_SCALE = 16.f;
DI unsigned pk4_fp8(float a, float b, float c, float d) { int w = 0; w = __builtin_amdgcn_cvt_pk_fp8_f32(a, b, w, false); w = __builtin_amdgcn_cvt_pk_fp8_f32(c, d, w, true); return (unsigned)w; }
DI void convert_tables(const Frame& F, const Args& A) {
    const size_t n16 = (size_t)16384 * 1024 / 16;
    const size_t gt = (size_t)blockIdx.x * 512 + F.tid, NGT = (size_t)F.G * 512;
#pragma unroll 1
    for (int t = 0; t < 2; ++t) {
        const float* src = A.in[18 + t]; unsigned char* dst = A.ws + (t ? WS_EV : WS_EU); const float sc = t ? EV_SCALE : EU_SCALE;
        const float* fn = A.in[15];
        for (size_t i = gt; i < n16; i += NGT) {
            f32x4 a = *(const f32x4*)(src + i * 16) * sc, b = *(const f32x4*)(src + i * 16 + 4) * sc, c = *(const f32x4*)(src + i * 16 + 8) * sc, d = *(const f32x4*)(src + i * 16 + 12) * sc;
            if (t == 0) { const float* g = fn + (i & 63) * 16; a *= *(const f32x4*)g; b *= *(const f32x4*)(g + 4); c *= *(const f32x4*)(g + 8); d *= *(const f32x4*)(g + 12); }
            const size_t e_ = i >> 6, c16_ = i & 63;
            *(u32x4*)(dst + (c16_ >> 3) * ((size_t)16384 * 128) + e_ * 128 + (c16_ & 7) * 16) = (u32x4){pk4_fp8(a.x, a.y, a.z, a.w), pk4_fp8(b.x, b.y, b.z, b.w), pk4_fp8(c.x, c.y, c.z, c.w), pk4_fp8(d.x, d.y, d.z, d.w)};
        }
    }
}

DI float gelu_exact(float x) { return 0.5f * x * (1.f + erff(x * 0.70710678118654752f)); }
typedef float f32x2 __attribute__((ext_vector_type(2)));
#define UNPK16(dst, W_) do { f32x2 _t; \
    _t = __builtin_amdgcn_cvt_pk_f32_fp8((int)(W_).x, false); dst[0] = _t.x; dst[1] = _t.y; _t = __builtin_amdgcn_cvt_pk_f32_fp8((int)(W_).x, true); dst[2] = _t.x; dst[3] = _t.y; \
    _t = __builtin_amdgcn_cvt_pk_f32_fp8((int)(W_).y, false); dst[4] = _t.x; dst[5] = _t.y; _t = __builtin_amdgcn_cvt_pk_f32_fp8((int)(W_).y, true); dst[6] = _t.x; dst[7] = _t.y; \
    _t = __builtin_amdgcn_cvt_pk_f32_fp8((int)(W_).z, false); dst[8] = _t.x; dst[9] = _t.y; _t = __builtin_amdgcn_cvt_pk_f32_fp8((int)(W_).z, true); dst[10] = _t.x; dst[11] = _t.y; \
    _t = __builtin_amdgcn_cvt_pk_f32_fp8((int)(W_).w, false); dst[12] = _t.x; dst[13] = _t.y; _t = __builtin_amdgcn_cvt_pk_f32_fp8((int)(W_).w, true); dst[14] = _t.x; dst[15] = _t.y; } while (0)

template <bool UPH>
DI void expert_phase(const Frame& F, const Args& A, int xv, int wq, int nw) {
    unsigned char* ws = A.ws; const int lane = F.lane, grp = lane >> 3, j = lane & 7;
    const unsigned char* TBL = ws + (UPH ? WS_EU : WS_EV) + (size_t)xv * ((size_t)16384 * 128) + 16 * j;
    const int* IDX = (const int*)(ws + WS_IDX); const float* CW = (const float*)(ws + WS_CW);
    const bf16_t* XN = (const bf16_t*)(ws + WS_XN) + 128 * xv + 16 * j;
    float* HP = (float*)(ws + WS_HP);
    LAS unsigned* ring = (LAS unsigned*)((LAS unsigned char*)F.lds + F.wave * 4096);
    const int nt = (MU - wq + nw - 1) / nw;
    if (nt <= 0) return;
    auto tok = [&](int k) { return __builtin_amdgcn_readfirstlane(wq + (k < nt ? k : nt - 1) * nw); };
    int mi0, mi1; u32x4 mx0, mx1; float mh0, mh1;
    auto meta_load = [&](int k) {
        const int u = tok(k);
        mi0 = IDX[(size_t)u * 128 + lane]; mi1 = IDX[(size_t)u * 128 + 64 + lane];
        if constexpr (UPH) { mx0 = *(const u32x4*)(XN + (size_t)u * DM); mx1 = *(const u32x4*)(XN + (size_t)u * DM + 8); }
        else { mh0 = CW[(size_t)u * 128 + lane]; mh1 = CW[(size_t)u * 128 + 64 + lane]; }
    };
    auto meta_store = [&](int k) {
        LAS unsigned* sl = ring + (k & 3) * 256;
        sl[lane] = (unsigned)mi0; sl[64 + lane] = (unsigned)mi1;
        if constexpr (UPH) { if (grp == 0) { *(LAS u32x4*)(sl + 128 + 8 * j) = mx0; *(LAS u32x4*)(sl + 128 + 8 * j + 4) = mx1; } }
        else { sl[128 + lane] = __builtin_bit_cast(unsigned, mh0); sl[192 + lane] = __builtin_bit_cast(unsigned, mh1); }
    };
    auto gather = [&](u32x4 (&buf)[8], int n) {
        const LAS unsigned* sl = ring + ((n >> 1) & 3) * 256 + 64 * (n & 1) + grp;
#pragma unroll
        for (int i = 0; i < 8; ++i) { const int e = (int)sl[8 * i]; buf[i] = *(const u32x4*)(TBL + (size_t)e * 128); }
    };
    const int ocol = 128 * xv + 16 * j + ((lane & 32) ? 8 : 0) + ((lane & 16) ? 4 : 0) + ((lane & 8) ? 2 : 0);
    f32x2 ocur = (f32x2){0.f, 0.f};
    float acc[16];
    float xn[16];
    auto compute = [&](u32x4 (&buf)[8], int n) {
        const int k = n >> 1, hf = n & 1;
        const LAS unsigned* sl = ring + (k & 3) * 256;
        if (hf == 0) {
            if constexpr (UPH) {
                const u32x4 x0 = *(const LAS u32x4*)(sl + 128 + 8 * j), x1 = *(const LAS u32x4*)(sl + 128 + 8 * j + 4);
                xn[0] = bflo(x0.x); xn[1] = bfhi(x0.x); xn[2] = bflo(x0.y); xn[3] = bfhi(x0.y); xn[4] = bflo(x0.z); xn[5] = bfhi(x0.z); xn[6] = bflo(x0.w); xn[7] = bfhi(x0.w);
                xn[8] = bflo(x1.x); xn[9] = bfhi(x1.x); xn[10] = bflo(x1.y); xn[11] = bfhi(x1.y); xn[12] = bflo(x1.z); xn[13] = bfhi(x1.z); xn[14] = bflo(x1.w); xn[15] = bfhi(x1.w);
            } else {
#pragma unroll
                for (int c = 0; c < 16; ++c) acc[c] = 0.f;
                ocur = *(const f32x2*)(A.out + (size_t)tok(k) * DM + ocol);
            }
        }
#pragma unroll
        for (int i = 0; i < 8; ++i) {
            float f[16]; UNPK16(f, buf[i]);
            if constexpr (UPH) {
                float a0 = 0.f, a1 = 0.f;
#pragma unroll
                for (int c = 0; c < 16; c += 2) { a0 += f[c] * xn[c]; a1 += f[c + 1] * xn[c + 1]; }
                if (hf == 0) acc[i] = a0 + a1; else acc[8 + i] = a0 + a1;
                if (i < 7) { if (hf == 0) asm volatile("" : "+v"(buf[i + 1].x), "+v"(buf[i + 1].y), "+v"(buf[i + 1].z), "+v"(buf[i + 1].w), "+v"(acc[i]));
                             else asm volatile("" : "+v"(buf[i + 1].x), "+v"(buf[i + 1].y), "+v"(buf[i + 1].z), "+v"(buf[i + 1].w), "+v"(acc[8 + i])); }
            } else {
                const float cw = __builtin_bit_cast(float, sl[128 + 64 * hf + 8 * i + grp]);
#pragma unroll
                for (int c = 0; c < 16; ++c) acc[c] += cw * f[c];
                if (i < 7) asm volatile("" : "+v"(buf[i + 1].x), "+v"(buf[i + 1].y), "+v"(buf[i + 1].z), "+v"(buf[i + 1].w),
                                             "+v"(acc[0]), "+v"(acc[1]), "+v"(acc[2]), "+v"(acc[3]), "+v"(acc[4]), "+v"(acc[5]), "+v"(acc[6]), "+v"(acc[7]),
                                             "+v"(acc[8]), "+v"(acc[9]), "+v"(acc[10]), "+v"(acc[11]), "+v"(acc[12]), "+v"(acc[13]), "+v"(acc[14]), "+v"(acc[15]));
            }
            __builtin_amdgcn_sched_barrier(0);
        }
        if (hf == 1 && k < nt) {
            const int u = tok(k);
            float r8[8], r4[4], r2[2];
            if constexpr (UPH) {
                { const bool up = lane & 4;
#pragma unroll
                  for (int i = 0; i < 8; ++i) { const float send = up ? acc[i] : acc[i + 8], keep = up ? acc[i + 8] : acc[i]; r8[i] = keep + __shfl_xor(send, 4); } }
                { const bool up = lane & 2;
#pragma unroll
                  for (int i = 0; i < 4; ++i) { const float send = up ? r8[i] : r8[i + 4], keep = up ? r8[i + 4] : r8[i]; r4[i] = keep + __shfl_xor(send, 2); } }
                { const bool up = lane & 1;
#pragma unroll
                  for (int i = 0; i < 2; ++i) { const float send = up ? r4[i] : r4[i + 2], keep = up ? r4[i + 2] : r4[i]; r2[i] = keep + __shfl_xor(send, 1); } }
                const int st = ((lane & 4) ? 8 : 0) + ((lane & 2) ? 4 : 0) + ((lane & 1) ? 2 : 0);
                float* hp = HP + ((size_t)xv * MU + u) * 128 + grp;
                hp[8 * st] = r2[0]; hp[8 * (st + 1)] = r2[1];
            } else {
                { const bool up = lane & 32;
#pragma unroll
                  for (int c = 0; c < 8; ++c) { const float send = up ? acc[c] : acc[c + 8], keep = up ? acc[c + 8] : acc[c]; r8[c] = keep + __shfl_xor(send, 32); } }
                { const bool up = lane & 16;
#pragma unroll
                  for (int c = 0; c < 4; ++c) { const float send = up ? r8[c] : r8[c + 4], keep = up ? r8[c + 4] : r8[c]; r4[c] = keep + __shfl_xor(send, 16); } }
                { const bool up = lane & 8;
#pragma unroll
                  for (int c = 0; c < 2; ++c) { const float send = up ? r4[c] : r4[c + 2], keep = up ? r4[c + 2] : r4[c]; r2[c] = keep + __shfl_xor(send, 8); } }
                f32x2* o = (f32x2*)(A.out + (size_t)u * DM + ocol);
                f32x2 cur = ocur; cur.x += r2[0]; cur.y += r2[1]; *o = cur;
            }
        }
    };
    meta_load(0); meta_store(0); meta_load(1); meta_store(1); meta_load(2); meta_store(2);
    u32x4 b0[8], b1[8], b2[8];
    gather(b0, 0); gather(b1, 1); gather(b2, 2);
#pragma unroll 1
    for (int k0 = 0; k0 < nt; k0 += 3) {
        const int n0 = 2 * k0;
        meta_load(k0 + 3);
        compute(b0, n0);     gather(b0, n0 + 3);
        compute(b1, n0 + 1); meta_store(k0 + 3); gather(b1, n0 + 4);
        meta_load(k0 + 4);
        compute(b2, n0 + 2); gather(b2, n0 + 5);
        compute(b0, n0 + 3); meta_store(k0 + 4); gather(b0, n0 + 6);
        meta_load(k0 + 5);
        compute(b1, n0 + 4); gather(b1, n0 + 7);
        compute(b2, n0 + 5); meta_store(k0 + 5); gather(b2, n0 + 8);
    }
}


DI void expert_c_pass(const Frame& F, const Args& A) {
    unsigned char* ws = A.ws;
    const float* HP = (const float*)(ws + WS_HP); const float* GATE = (const float*)(ws + WS_GATE); float* CW = (float*)(ws + WS_CW);
    const size_t n4 = (size_t)MU * 128 / 4;
    for (size_t i = (size_t)blockIdx.x * 512 + F.tid; i < n4; i += (size_t)F.G * 512) {
        f32x4 h = *(const f32x4*)(HP + i * 4);
#pragma unroll
        for (int x = 1; x < 8; ++x) h += *(const f32x4*)(HP + (size_t)x * MU * 128 + i * 4);
        const f32x4 g = *(const f32x4*)(GATE + i * 4);
        const float rs = (1.f / EU_SCALE) / sqrtf(ss_sum16((const float*)(ws + WS_SS4), (int)(i >> 5)) * (1.f / DM) + EPS);
        f32x4 c;
        c.x = gelu_exact(h.x * rs) * g.x * (1.f / EV_SCALE); c.y = gelu_exact(h.y * rs) * g.y * (1.f / EV_SCALE);
        c.z = gelu_exact(h.z * rs) * g.z * (1.f / EV_SCALE); c.w = gelu_exact(h.w * rs) * g.w * (1.f / EV_SCALE);
        *(f32x4*)(CW + i * 4) = c;
    }
}
template <int PH> DI void run_phase(const Frame& F, const Args& args, PG8_LAS unsigned char* lds3) {
    unsigned char* ws = args.ws;
    if constexpr (PH == 0) { p0_prologue(F, args); p0_late_weights<0>(F, args, (7 - F.wave) * F.G + blockIdx.x, F.NGW, blockIdx.x * 512 + F.tid, F.G * 512); }
    if constexpr (PH == 1) {
        pg8::Gemm g{(const bf16_t*)(ws + WS_HN), (const bf16_t*)(ws + WS_WIN), MP, NPROJ, 1024, 1024, 1024, 0};
        pg8::StaticOrder S; S.init(MP, NPROJ, F.G, (int)blockIdx.x);
        EpiProj E{(bf16_t*)(ws + WS_QKVR), (bf16_t*)(ws + WS_Z), (float*)(ws + WS_P32), (bf16_t*)(ws + WS_CQN), (bf16_t*)(ws + WS_CKVN), (float*)(ws + WS_KPE), (float*)(ws + WS_SSQ), (float*)(ws + WS_SSK)};
        pg8::gemm_phase<EpiProj, pg8::StaticOrder, true, true>(lds3, g, S, E);
    }
    if constexpr (PH == 2) { gdn_prep_phase<0>(F, args); }
    if constexpr (PH == 3) {
        { pg8::Gemm g{(const bf16_t*)(ws + WS_CQN), (const bf16_t*)(ws + WS_WUQ), MP, 768, 256, 256, 256, 0};
          pg8::StaticOrder S; S.init(MP, 768, F.G, (int)blockIdx.x); EpiB16 E{(bf16_t*)(ws + WS_QH), 768, (const float*)(ws + WS_SSQ), 1.f / 256.f, 4};
          pg8::gemm_phase<EpiB16, pg8::StaticOrder, true, true>(lds3, g, S, E); }
        { pg8::Gemm g{(const bf16_t*)(ws + WS_CKVN), (const bf16_t*)(ws + WS_WUKV), MP, 1024, 256, 256, 256, 0};
          pg8::StaticOrder S; S.init(MP, 1024, F.G, (int)blockIdx.x); EpiB16 E{(bf16_t*)(ws + WS_KVB), 1024, (const float*)(ws + WS_SSK), 1.f / 128.f, 4};
          pg8::gemm_phase<EpiB16, pg8::StaticOrder, true, true>(lds3, g, S, E); }
    }
    if constexpr (PH == 4) { for (int t = F.gw; t < (KVROWS / 64) * 8; t += F.NGW) mla_prep2_task(F, args, t); }
    if constexpr (PH == 5) {
        gdn_scan(F, args);
        volatile LAS unsigned* MISC = (volatile LAS unsigned*)(lds3 + MISC_OFF);
        unsigned* qhead = (unsigned*)(ws + WS_CTL) + CW_ATTQ;
        for (;;) {
            __syncthreads();
            if (F.tid == 0) MISC[24] = xb_add(qhead, 1u);
            __syncthreads();
            const int k = (int)MISC[24];
            if (k >= 512) break;
            attn_item(F, args, k & 7, 63 - (k >> 3));
        }
        p0_late_weights<1>(F, args, F.gw, F.NGW, blockIdx.x * 512 + F.tid, F.G * 512);
    }
    if constexpr (PH == 6) { for (int t = F.gw; t < 2048 * 2; t += F.NGW) gdn_out_task(F, args, t); }
    if constexpr (PH == 7) {
        pg8::Gemm g{(const bf16_t*)(ws + WS_MIX), (const bf16_t*)(ws + WS_WOUT), MU, 1024, 1024, 1024, 1024, 0};
        pg8::StaticOrder S; S.init(MU, 1024, F.G, (int)blockIdx.x); EpiH1 E{args.out, args.in[0], (bf16_t*)(ws + WS_XN), (float*)(ws + WS_SS4)};
        pg8::gemm_phase<EpiH1, pg8::StaticOrder, true, true>(lds3, g, S, E);
    }
    if constexpr (PH == 8) {
        pg8::Gemm g{(const bf16_t*)(ws + WS_XN), (const bf16_t*)(ws + WS_WPQ), MU, 2048, 1024, 1024, 1024, 0};
        pg8::StaticOrder S; S.init(MU, 2048, F.G, (int)blockIdx.x); EpiB16 E{(bf16_t*)(ws + WS_PQ), 2048, (const float*)(ws + WS_SS4), 1.f / 1024.f, 16};
        pg8::gemm_phase<EpiB16, pg8::StaticOrder, true, true>(lds3, g, S, E);
    }
    if constexpr (PH == 9) {
        pg8::Gemm g{(const bf16_t*)(ws + WS_PQ), (const bf16_t*)(ws + WS_SKB), MU, 2048, 256, 2048, 256, 256};
        pg8::StaticOrder S; S.init(MU, 2048, F.G, (int)blockIdx.x); EpiB16 E{(bf16_t*)(ws + WS_SC), 2048, nullptr, 0.f, 0};
        pg8::gemm_phase<EpiB16, pg8::StaticOrder, true, true>(lds3, g, S, E);
    }
    if constexpr (PH == 10) {
        convert_tables(F, args);
        for (int t = blockIdx.x * 512 + F.tid; t < MU * 8; t += F.G * 512) topk_task(F, args, t);
    }
    if constexpr (PH == 12) { expert_c_pass(F, args); }
    if constexpr (PH == 11 || PH == 13) {
        volatile LAS unsigned* MISC = (volatile LAS unsigned*)(lds3 + MISC_OFF);
        const unsigned x = MISC[16], rank = MISC[17];
        unsigned* bar = (unsigned*)(ws + WS_CTL);
        unsigned nloc = 0, nx = 0, myidx = 0;
#pragma unroll
        for (unsigned j = 0; j < 16; ++j) { const unsigned c = xb_ld(&bar[XB_XCNT(j)]); nx += (c > 0u) ? 1u : 0u; myidx += (c > 0u && j < x) ? 1u : 0u; nloc = (j == x) ? c : nloc; }
        const int wq = __builtin_amdgcn_readfirstlane((int)rank * 8 + F.wave), nw = __builtin_amdgcn_readfirstlane((int)nloc * 8);
        const int xstep = __builtin_amdgcn_readfirstlane((int)nx);
        for (int xv = __builtin_amdgcn_readfirstlane((int)myidx); xv < 8; xv += xstep)
            { if constexpr (PH == 11) expert_phase<true>(F, args, xv, wq, nw); else expert_phase<false>(F, args, xv, wq, nw); }
    }
}
constexpr int NPHASE = 14;
__global__ void __launch_bounds__(512, 2) fwd_kernel(Args args) {
    extern __shared__ __attribute__((aligned(16))) unsigned char lds[];
    Frame F;
    F.lds = lds; F.tid = threadIdx.x; F.lane = F.tid & 63; F.wave = __builtin_amdgcn_readfirstlane(F.tid >> 6);
    F.G = gridDim.x; F.gw = blockIdx.x * 8 + F.wave; F.NGW = F.G * 8;
    volatile LAS unsigned* MISC = (volatile LAS unsigned*)((LAS unsigned char*)lds + MISC_OFF);
    if (F.tid < 32) MISC[F.tid] = 0u;
    __syncthreads();
    unsigned char* ws = args.ws;
    const int lo = args.ph_lo, hi = args.ph_hi;
    XcdBarrier bar; bar.bar = (unsigned*)(ws + WS_CTL); bar.x = 0; bar.st = nullptr;
    if (hi - lo > 1) bar = xcd_barrier_post((unsigned*)(ws + WS_CTL), MISC + 8);
    if (F.tid == 0) { const unsigned x = xb_xcc_id(); MISC[16] = x; MISC[17] = xb_add((unsigned*)(ws + WS_CTL) + 3520 + 64 * x, 1u); }
    __syncthreads();
#define IN(k) (lo <= (k) && (k) < hi)
#define SEAM(k) do { if (IN(k) && IN((k) + 1)) xcd_barrier(bar); } while (0)
    PG8_LAS unsigned char* lds3 = (PG8_LAS unsigned char*)lds;

#ifndef PROBE_REPEAT
#define PROBE_REPEAT -1
#endif
#ifndef PROBE_TIME
#define PROBE_TIME -1
#endif
#ifndef PROBE_TSEL
#define PROBE_TSEL 0
#endif
    unsigned long long pt_ticks = 0ull;
#define PHASE(k) do { unsigned long long pt0_ = 0ull; if (PROBE_TIME == (k)) pt0_ = __builtin_amdgcn_s_memrealtime(); \
        if (IN(k)) { run_phase<k>(F, args, lds3); if (PROBE_REPEAT == (k)) { xcd_barrier(bar); run_phase<(k)>(F, args, lds3); } } \
        if (PROBE_TIME == (k) && PROBE_TSEL == 1) pt_ticks = __builtin_amdgcn_s_memrealtime() - pt0_;     \
        if (PROBE_TIME == (k) && PROBE_TSEL == 2) pt0_ = __builtin_amdgcn_s_memrealtime();                \
        SEAM(k); \
        if (PROBE_TIME == (k) && PROBE_TSEL != 1) pt_ticks = __builtin_amdgcn_s_memrealtime() - pt0_; } while (0)
    PHASE(0); PHASE(1); PHASE(2); PHASE(3); PHASE(4); PHASE(5); PHASE(6); PHASE(7); PHASE(8); PHASE(9); PHASE(10); PHASE(11); PHASE(12); PHASE(13);
#undef PHASE
    if (PROBE_STAGE >= 0) { __syncthreads(); pt_ticks = *(volatile unsigned long long*)(lds + 143360 + 96); }
    if (PROBE_TIME >= 0 || PROBE_STAGE >= 0) { const unsigned long long t0_ = __builtin_amdgcn_s_memrealtime(); while (__builtin_amdgcn_s_memrealtime() - t0_ < 4ull * pt_ticks) __builtin_amdgcn_s_sleep(32); }
#undef IN
#undef SEAM
}

#ifndef N_LAUNCHES
#define N_LAUNCHES 1
#endif
extern "C" void kernel_launch(void* const* d_in, const int* in_sizes, int n_in, void* d_out, int out_size, void* d_ws, size_t ws_size, hipStream_t stream) {
    static int grid = 0;
    if (grid == 0) {
        if (n_in != 20 || out_size != MU * DM || ws_size < WS_END) { fprintf(stderr, "kernel_launch: unexpected shapes (n_in %d out %d ws %zu)\n", n_in, out_size, ws_size); grid = -1; return; }
        int dev = 0, cus = 0, per_cu = 0;
        if (hipGetDevice(&dev) != hipSuccess || hipDeviceGetAttribute(&cus, hipDeviceAttributeMultiprocessorCount, dev) != hipSuccess) { grid = -1; return; }
        if (hipFuncSetAttribute((const void*)fwd_kernel, hipFuncAttributeMaxDynamicSharedMemorySize, LDS_BYTES) != hipSuccess) { fprintf(stderr, "kernel_launch: hipFuncSetAttribute failed\n"); grid = -1; return; }
        if (hipOccupancyMaxActiveBlocksPerMultiprocessor(&per_cu, (const void*)fwd_kernel, 512, LDS_BYTES) != hipSuccess || per_cu < 1) { fprintf(stderr, "kernel_launch: occupancy query says %d\n", per_cu); (void)hipGetLastError(); per_cu = 1; }
        grid = cus;
    }
    if (grid < 0) return;
    (void)hipMemsetAsync((char*)d_ws + WS_CTL, 0, CTL_ZERO_BYTES, stream);
    Args a{};
    for (int i = 0; i < 20; ++i) a.in[i] = (const float*)d_in[i];
    a.out = (float*)d_out; a.ws = (unsigned char*)d_ws;
    for (int li = 0; li < N_LAUNCHES; ++li) {
        a.ph_lo = li * NPHASE / N_LAUNCHES; a.ph_hi = (li + 1) * NPHASE / N_LAUNCHES;
        if (N_LAUNCHES == 1) {
            void* kargs[] = {&a};
            hipError_t e = hipLaunchCooperativeKernel((const void*)fwd_kernel, dim3(grid), dim3(512), kargs, LDS_BYTES, stream);
            if (e != hipSuccess) fprintf(stderr, "cooperative launch failed: %s (grid %d)\n", hipGetErrorString(e), grid);
        } else {
            hipLaunchKernelGGL(fwd_kernel, dim3(grid), dim3(512), LDS_BYTES, stream, a);
        }
    }
}
```

```cpp
#include <hip/hip_runtime.h>
#include <hip/hip_bf16.h>
#include <cstdio>
#include <cstdint>
#include <type_traits>

#define DI __device__ __forceinline__
#define LAS __attribute__((address_space(3)))
#define GAS __attribute__((address_space(1)))

typedef unsigned short bf16_t;
typedef short bf16x8 __attribute__((ext_vector_type(8)));
typedef short s16x4 __attribute__((ext_vector_type(4)));
typedef float f32x4 __attribute__((ext_vector_type(4)));
typedef float f32x16 __attribute__((ext_vector_type(16)));
typedef unsigned u32x4 __attribute__((ext_vector_type(4)));
typedef unsigned u32x2 __attribute__((ext_vector_type(2)));

namespace pg8 {
#define PG8_LAS __attribute__((address_space(3)))
constexpr int BM = 256, BK = 64, HALF = 128, HTB = HALF * BK * 2  , STAGE_BYTES = 8 * HTB, NXCD = 8, WGM = 8;

__host__ __device__ __forceinline__ int lds_byte(int r, int c) { const int st = (r >> 4) * 2 + (c >> 5), rr = r & 15, cc = c & 31, ob = rr * 64 + cc * 2; return st * 1024 + (ob ^ (((ob >> 9) & 1) << 5)); }
__host__ __device__ __forceinline__ void stage_rc(int b, int& R, int& C) { const int st = b / 1024, sb = b % 1024, swz = sb ^ (((sb >> 9) & 1) << 5); R = (st >> 1) * 16 + swz / 64; C = (st & 1) * 32 + (swz % 64) / 2; }
__host__ __device__ __forceinline__ int perm32(int rho) { const int n = rho >> 4, i = rho & 15; return 8 * (i >> 2) + 4 * n + (i & 3); }

struct Unit { int pm, pn; };
struct Gemm { const bf16_t* A; const bf16_t* Bt; int M, N, K, lda, ldb, a_pn_off; };

struct StaticOrder {
    int nM, nN, nwg, G, c;
    __host__ __device__ void init(int M, int N, int G_, int c_) { nM = M / BM; nN = N / BM; nwg = nM * nN; G = G_; c = c_; }
    __host__ __device__ bool next(int i, Unit& u) const {
        const long L = (long)i * G + c; if (L >= nwg) return false;
        int wgid = (int)L; { const int q = nwg / NXCD, r = nwg % NXCD, xcd = wgid % NXCD, off = wgid / NXCD; wgid = (xcd < r ? xcd * (q + 1) : r * (q + 1) + (xcd - r) * q) + off; }
        const int nig = WGM * nN, gid = wgid / nig, fm = gid * WGM, gsz = (nM - fm) < WGM ? (nM - fm) : WGM;
        u.pm = fm + ((wgid % nig) % gsz); u.pn = (wgid % nig) / gsz; return true;
    }
    __device__ __forceinline__ void a_ready(const Unit&) const {}
    __device__ __forceinline__ void done(const Unit&) const {}
};

__device__ __forceinline__ unsigned cvt_pk_bf16(float lo, float hi) { unsigned r; asm volatile("v_cvt_pk_bf16_f32 %0, %1, %2" : "=v"(r) : "v"(lo), "v"(hi)); return r; }

template <class Epi, class Sched, bool ALIGN_EPI = false, bool SP2 = false>
__device__ __forceinline__ void gemm_phase(PG8_LAS unsigned char* lds, const Gemm g, const Sched& S, const Epi& E) {
    const int tid = threadIdx.x, wid = __builtin_amdgcn_readfirstlane(tid >> 6), lane = tid & 63, wr = wid >> 2, wc = wid & 3, fr = lane & 15, fq = lane >> 4;
    const int K = g.K, nt = K / BK;
    unsigned voffA[2], voffB[2];
#pragma unroll
    for (int i = 0; i < 2; ++i) { int R, C; stage_rc(tid * 16 + i * 8192, R, C); const int Rb = Epi::PERM ? ((R & ~31) + perm32(R & 31)) : R;
        voffA[i] = (unsigned)(R * g.lda + C) * 2u; voffB[i] = (unsigned)(Rb * g.ldb + C) * 2u; }
    const size_t kstep = (size_t)(BK * 2);
    const size_t hstepA = (size_t)HALF * g.lda * 2, hstepB = (size_t)HALF * g.ldb * 2;
    const size_t tstepA = 2 * hstepA, tstepB = 2 * hstepB;
    const size_t pnoffA = (size_t)g.a_pn_off * 2;
    const unsigned ldsw = (unsigned)wid * 1024u;
    const int aoff = lds_byte(wr * 64 + fr, fq * 8), boff = lds_byte(wc * 32 + fr, fq * 8);
#define PG8_SA(b, h) (((b) * 2 + (h)) * HTB)
#define PG8_SB(b, h) ((4 + (b) * 2 + (h)) * HTB)
#define PG8_STAGE(bufoff, gbase, voff) do { _Pragma("unroll") for (int _i = 0; _i < 2; ++_i) \
        __builtin_amdgcn_global_load_lds((const unsigned*)((const char*)(gbase) + (voff)[_i]), (PG8_LAS unsigned*)(lds + (bufoff) + ldsw + _i * 8192), 16, 0, 0); } while (0)
#define PG8_LDA(dst, b, h) do { _Pragma("unroll") for (int m = 0; m < 4; ++m) _Pragma("unroll") for (int k = 0; k < 2; ++k) dst[m][k] = *(const PG8_LAS bf16x8*)(lds + PG8_SA(b, h) + aoff + m * 2048 + k * 1024); } while (0)
#define PG8_LDB(dst, b, h) do { _Pragma("unroll") for (int n = 0; n < 2; ++n) _Pragma("unroll") for (int k = 0; k < 2; ++k) dst[n][k] = *(const PG8_LAS bf16x8*)(lds + PG8_SB(b, h) + boff + n * 2048 + k * 1024); } while (0)
#define PG8_MMA(ai, bj, At, Bt) do { __builtin_amdgcn_s_setprio(1); _Pragma("unroll") for (int m = 0; m < 4; ++m) _Pragma("unroll") for (int n = 0; n < 2; ++n) _Pragma("unroll") for (int k = 0; k < 2; ++k) \
        acc[ai][bj][m][n] = __builtin_amdgcn_mfma_f32_16x16x32_bf16(Bt[n][k], At[m][k], acc[ai][bj][m][n], 0, 0, 0); __builtin_amdgcn_s_setprio(0); } while (0)
#define PG8_WAIT_V(n) asm volatile("s_waitcnt vmcnt(" #n ")" ::: "memory")
#define PG8_WAIT_L(n) asm volatile("s_waitcnt lgkmcnt(" #n ")" ::: "memory")
#define PG8_BAR __builtin_amdgcn_s_barrier()
#define PG8_SCHED __builtin_amdgcn_sched_barrier(0)
    Unit cur, nxt; int ui = 0;
    if (!S.next(0, cur)) return;
    f32x4 acc[2][2][4][2];
#pragma unroll
    for (int a = 0; a < 2; ++a)
#pragma unroll
        for (int b = 0; b < 2; ++b)
#pragma unroll
            for (int m = 0; m < 4; ++m)
#pragma unroll
                for (int n = 0; n < 2; ++n) acc[a][b][m][n] = (f32x4){0.f, 0.f, 0.f, 0.f};
    bf16x8 At[4][2], B0[2][2], B1[2][2];
    const char* cA = (const char*)g.A + (size_t)cur.pm * tstepA + (size_t)cur.pn * pnoffA; const char* cB = (const char*)g.Bt + (size_t)cur.pn * tstepB;
    S.a_ready(cur);
    if constexpr (SP2) {
        PG8_STAGE(PG8_SB(0, 0), cB, voffB); PG8_STAGE(PG8_SB(0, 1), cB + hstepB, voffB); PG8_STAGE(PG8_SA(0, 0), cA, voffA); PG8_STAGE(PG8_SA(0, 1), cA + hstepA, voffA);
        if (wr == 1) PG8_BAR;
        PG8_WAIT_V(2); PG8_BAR;
        PG8_STAGE(PG8_SB(1, 0), cB + kstep, voffB); PG8_STAGE(PG8_SA(1, 0), cA + kstep, voffA); PG8_STAGE(PG8_SB(1, 1), cB + hstepB + kstep, voffB);
        PG8_WAIT_V(6); PG8_BAR;
    } else {
        PG8_STAGE(PG8_SB(0, 0), cB, voffB); PG8_STAGE(PG8_SA(0, 0), cA, voffA); PG8_STAGE(PG8_SB(0, 1), cB + hstepB, voffB); PG8_STAGE(PG8_SA(0, 1), cA + hstepA, voffA);
        if (wr == 1) PG8_BAR;
        PG8_WAIT_V(4); PG8_BAR;
        PG8_STAGE(PG8_SB(1, 0), cB + kstep, voffB); PG8_STAGE(PG8_SA(1, 0), cA + kstep, voffA); PG8_STAGE(PG8_SB(1, 1), cB + hstepB + kstep, voffB);
        PG8_WAIT_V(6); PG8_BAR;
    }
    for (;;) {
        const bool has_next = S.next(ui + 1, nxt);
        const char* nA = has_next ? (const char*)g.A + (size_t)nxt.pm * tstepA + (size_t)nxt.pn * pnoffA : cA; const char* nB = has_next ? (const char*)g.Bt + (size_t)nxt.pn * tstepB : cB;
        for (int t = 0; t < nt; t += 2) {
            const bool last = (t == nt - 2);
            const char* a1 = cA + (size_t)(t + 1) * kstep;
            const char* a2 = last ? nA : cA + (size_t)(t + 2) * kstep; const char* b2 = last ? nB : cB + (size_t)(t + 2) * kstep;
            const char* a3 = a2 + kstep; const char* b3 = b2 + kstep;
            if (last && has_next) S.a_ready(nxt);
            if constexpr (SP2) {
            PG8_LDB(B0, 0, 0); PG8_LDB(B1, 0, 1); PG8_SCHED; PG8_LDA(At, 0, 0); PG8_STAGE(PG8_SA(1, 1), a1 + hstepA, voffA);
            PG8_WAIT_V(8); PG8_WAIT_L(0); PG8_BAR; PG8_MMA(0, 0, At, B0); PG8_MMA(0, 1, At, B1); PG8_BAR; PG8_SCHED;
            PG8_LDA(At, 0, 1); PG8_STAGE(PG8_SB(0, 0), b2, voffB); PG8_STAGE(PG8_SB(0, 1), b2 + hstepB, voffB); PG8_STAGE(PG8_SA(0, 0), a2, voffA);
            PG8_WAIT_V(8); PG8_WAIT_L(0); PG8_BAR; PG8_MMA(1, 0, At, B0); PG8_MMA(1, 1, At, B1); PG8_BAR; PG8_SCHED;
            PG8_LDB(B0, 1, 0); PG8_LDB(B1, 1, 1); PG8_SCHED; PG8_LDA(At, 1, 0); PG8_STAGE(PG8_SA(0, 1), a2 + hstepA, voffA);
            PG8_WAIT_V(8); PG8_WAIT_L(0); PG8_BAR; PG8_MMA(0, 0, At, B0); PG8_MMA(0, 1, At, B1); PG8_BAR; PG8_SCHED;
            PG8_LDA(At, 1, 1); PG8_STAGE(PG8_SB(1, 0), b3, voffB); PG8_STAGE(PG8_SB(1, 1), b3 + hstepB, voffB); PG8_STAGE(PG8_SA(1, 0), a3, voffA);
            PG8_WAIT_V(8); PG8_WAIT_L(0); PG8_BAR; PG8_MMA(1, 0, At, B0); PG8_MMA(1, 1, At, B1); PG8_BAR; PG8_SCHED;
            } else {
            PG8_LDB(B0, 0, 0); PG8_SCHED; PG8_LDA(At, 0, 0); PG8_STAGE(PG8_SA(1, 1), a1 + hstepA, voffA);
            PG8_WAIT_L(8); PG8_BAR; PG8_WAIT_L(0); PG8_MMA(0, 0, At, B0); PG8_BAR; PG8_SCHED;
            PG8_LDB(B1, 0, 1); PG8_STAGE(PG8_SB(0, 0), b2, voffB);
            PG8_BAR; PG8_WAIT_L(0); PG8_MMA(0, 1, At, B1); PG8_BAR;
            PG8_LDA(At, 0, 1); PG8_STAGE(PG8_SA(0, 0), a2, voffA);
            PG8_BAR; PG8_WAIT_L(0); PG8_MMA(1, 0, At, B0); PG8_BAR; PG8_SCHED;
            PG8_STAGE(PG8_SB(0, 1), b2 + hstepB, voffB);
            PG8_WAIT_V(6); PG8_BAR; PG8_MMA(1, 1, At, B1); PG8_BAR;
            PG8_LDB(B0, 1, 0); PG8_SCHED; PG8_LDA(At, 1, 0); PG8_STAGE(PG8_SA(0, 1), a2 + hstepA, voffA);
            PG8_WAIT_L(8); PG8_BAR; PG8_WAIT_L(0); PG8_MMA(0, 0, At, B0); PG8_BAR; PG8_SCHED;
            PG8_LDB(B1, 1, 1); PG8_STAGE(PG8_SB(1, 0), b3, voffB);
            PG8_BAR; PG8_WAIT_L(0); PG8_MMA(0, 1, At, B1); PG8_BAR;
            PG8_LDA(At, 1, 1); PG8_STAGE(PG8_SA(1, 0), a3, voffA);
            PG8_BAR; PG8_WAIT_L(0); PG8_MMA(1, 0, At, B0); PG8_BAR; PG8_SCHED;
            PG8_STAGE(PG8_SB(1, 1), b3 + hstepB, voffB);
            PG8_WAIT_V(6); PG8_BAR; PG8_MMA(1, 1, At, B1); PG8_BAR;
            }
        }
        if constexpr (ALIGN_EPI) { if (wr == 0) PG8_BAR; }
        E(acc, cur, wr, wc, fr, fq); S.done(cur);
        if (!has_next) break;
#pragma unroll
        for (int a = 0; a < 2; ++a)
#pragma unroll
            for (int b = 0; b < 2; ++b)
#pragma unroll
                for (int m = 0; m < 4; ++m)
#pragma unroll
                    for (int n = 0; n < 2; ++n) acc[a][b][m][n] = (f32x4){0.f, 0.f, 0.f, 0.f};
        cur = nxt; cA = nA; cB = nB; ++ui;
        if constexpr (ALIGN_EPI) { if (wr == 1) PG8_BAR; }
    }
    PG8_WAIT_V(0);
    if constexpr (!ALIGN_EPI) { if (wr == 0) PG8_BAR; }
    PG8_BAR;
#undef PG8_SA
#undef PG8_SB
#undef PG8_STAGE
#undef PG8_LDA
#undef PG8_LDB
#undef PG8_MMA
#undef PG8_WAIT_V
#undef PG8_WAIT_L
#undef PG8_BAR
#undef PG8_SCHED
}
}

constexpr int DM = 1024;
constexpr int NTOK = 16400;
constexpr int PADL = 48;
constexpr int LPV = 16448;
constexpr int MP = 16640;
constexpr int MU = 16384;
constexpr int NCHUNK = 257;
constexpr int NHEAD = 8;
constexpr int NPROJ = 2560;
constexpr int KVROWS = 16512;
constexpr float EPS = 1e-6f;

constexpr size_t MiB = 1u << 20;
constexpr size_t WS_CTL = 0, CTL_ZERO_BYTES = 64 * 1024;
constexpr size_t WS_SSQ = 128 * 1024;
constexpr size_t WS_SSK = 512 * 1024;
constexpr size_t WS_SS4 = 14 * MiB;
constexpr size_t WS_WIN = 1 * MiB;
constexpr size_t WS_WUQ = 6 * MiB;
constexpr size_t WS_WUKV = 6 * MiB + 512 * 1024;
constexpr size_t WS_WOUT = 7 * MiB;
constexpr size_t WS_WPQ = 9 * MiB;
constexpr size_t WS_SKB = 13 * MiB;
constexpr size_t WS_IDX = 16 * MiB;
constexpr size_t WS_GATE = 24 * MiB;
constexpr size_t WS_HN = 16 * MiB;
constexpr size_t WS_QKVR = 101 * MiB;
constexpr size_t WS_Z = 150 * MiB;
constexpr size_t WS_P32 = 167 * MiB;
constexpr size_t WS_GA = 16 * MiB;
constexpr size_t WS_GQ = 33 * MiB;
constexpr size_t WS_GS = 67 * MiB;
constexpr size_t WS_GB = 84 * MiB;
constexpr size_t WS_GO = 50 * MiB;
constexpr size_t WS_MIX = 167 * MiB;
constexpr size_t WS_CQN = 200 * MiB;
constexpr size_t WS_CKVN = 208 * MiB + 512 * 1024;
constexpr size_t WS_QH = 101 * MiB;
constexpr size_t WS_KVB = 167 * MiB;
constexpr size_t WS_Q = 125 * MiB + 512 * 1024;
constexpr size_t WS_K = 220 * MiB;
constexpr size_t WS_VT = 200 * MiB;
constexpr size_t WS_XN = 32 * MiB;
constexpr size_t WS_PQ = 64 * MiB;
constexpr size_t WS_SC = 128 * MiB;
constexpr size_t WS_EU = 96 * MiB;
constexpr size_t WS_EV = 112 * MiB;
constexpr size_t WS_CW = 64 * MiB;
constexpr size_t WS_HP = 128 * MiB;
constexpr size_t WS_KPE = 217 * MiB;
constexpr size_t WS_END = 256 * MiB;
constexpr int CW_ATTQ = 8192;

constexpr int LDS_BYTES = 147456;
constexpr int MISC_OFF = 131072 + 12288;

DI unsigned f2bf(float f) { unsigned u = __builtin_bit_cast(unsigned, f); return (u + 0x7fffu + ((u >> 16) & 1u)) >> 16; }
DI unsigned pk2(float lo, float hi) { return f2bf(lo) | (f2bf(hi) << 16); }
DI float bf2f(unsigned b) { return __builtin_bit_cast(float, b << 16); }
DI float bflo(unsigned w) { return __builtin_bit_cast(float, w << 16); }
DI float bfhi(unsigned w) { return __builtin_bit_cast(float, w & 0xffff0000u); }
DI float wave_sum(float v) {
#pragma unroll
    for (int o = 1; o < 64; o <<= 1) v += __shfl_xor(v, o);
    return v;
}
DI float sigmoidf_(float x) { return 1.f / (1.f + __expf(-x)); }
DI float siluf_(float x) { return x / (1.f + __expf(-x)); }

#define XB_TMO      128
#define XB_XCNT(j)  (256  + 64 * (j))
#define XB_XSUB(j)  (1280 + 64 * (j))
#define XB_XGEN(j)  (2304 + 64 * (j))
#define XB_TOP      3328
#define XB_TOPGEN   3392
#define XCD_BAR_WORDS 3456
#define XB_SPIN_CAP (1u << 22)
DI unsigned xb_ld(unsigned* p)              { return __hip_atomic_load(p, __ATOMIC_RELAXED, __HIP_MEMORY_SCOPE_AGENT); }
DI unsigned xb_add(unsigned* p, unsigned v) { return __hip_atomic_fetch_add(p, v, __ATOMIC_RELAXED, __HIP_MEMORY_SCOPE_AGENT); }
DI unsigned xb_xcc_id() { return (unsigned)__builtin_amdgcn_s_getreg((3 << 11) | 20) & 0xFu; }
#define XB_SPIN(cond, bar) do { unsigned _sp = 0; while (cond) { __builtin_amdgcn_s_sleep(1); \
    if ((++_sp & 255u) == 0u) { if (xb_ld(&(bar)[XB_TMO])) break; if (_sp > XB_SPIN_CAP) { atomicAdd(&(bar)[XB_TMO], 1u); break; } } } } while (0)
struct XcdBarrier { unsigned* bar; unsigned x; volatile LAS unsigned* st; };
DI XcdBarrier xcd_barrier_post(unsigned* bar, volatile LAS unsigned* st) {
    XcdBarrier b; b.bar = bar; b.x = xb_xcc_id(); b.st = st;
    if (threadIdx.x == 0) (void)xb_add(&bar[XB_XCNT(b.x)], 1u);
    return b;
}
DI void xcd_barrier_complete(unsigned* bar, unsigned x, unsigned& nloc, unsigned& nx) {
    const unsigned G = gridDim.x * gridDim.y * gridDim.z;
    unsigned sum, cnt, mine, sp = 0u;
    for (;;) {
        sum = 0u; cnt = 0u; mine = 0u;
#pragma unroll
        for (unsigned j = 0; j < 16; ++j) { const unsigned c = xb_ld(&bar[XB_XCNT(j)]); sum += c; cnt += (c > 0u) ? 1u : 0u; mine = (j == x) ? c : mine; }
        if (sum == G) break;
        __builtin_amdgcn_s_sleep(1);
        if ((++sp & 255u) == 0u) { if (xb_ld(&bar[XB_TMO])) break; if (sp > XB_SPIN_CAP) { atomicAdd(&bar[XB_TMO], 1u); break; } }
    }
    nloc = mine > 0u ? mine : 1u; nx = cnt > 0u ? cnt : 1u;
}
DI void xcd_barrier(const XcdBarrier& b) {
    asm volatile("s_waitcnt vmcnt(0)" ::: "memory");
    __syncthreads();
    if (threadIdx.x == 0) {
        unsigned* bar = b.bar;
        __builtin_amdgcn_s_waitcnt(0);
        unsigned nloc = b.st[0], nx = b.st[1];
        if (nloc == 0u) { xcd_barrier_complete(bar, b.x, nloc, nx); b.st[0] = nloc; b.st[1] = nx; }
        const unsigned old = xb_add(&bar[XB_XSUB(b.x)], 1u);
        const unsigned gen = old / nloc;
        if (old + 1u == (gen + 1u) * nloc) {
            __builtin_amdgcn_fence(__ATOMIC_RELEASE, "agent");
            asm volatile("s_waitcnt vmcnt(0)" ::: "memory");
            const unsigned og = xb_add(&bar[XB_TOP], 1u);
            const unsigned tg = og / nx;
            if (og + 1u == (tg + 1u) * nx) xb_add(&bar[XB_TOPGEN], 1u);
            else XB_SPIN(xb_ld(&bar[XB_TOPGEN]) == tg, bar);
            __builtin_amdgcn_fence(__ATOMIC_ACQUIRE, "agent");
            xb_add(&bar[XB_XGEN(b.x)], 1u);
            asm volatile("s_waitcnt vmcnt(0)" ::: "memory");
        } else {
            XB_SPIN(xb_ld(&bar[XB_XGEN(b.x)]) == gen, bar);
            __builtin_amdgcn_fence(__ATOMIC_ACQUIRE, "agent");
            asm volatile("s_waitcnt vmcnt(0)" ::: "memory");
        }
    }
    __syncthreads();
}

struct Args {
    const float* in[20];
    float* out; unsigned char* ws;
    int ph_lo, ph_hi;
};
struct Frame {
    unsigned char* lds;
    int tid, lane, wave, G, gw, NGW;
};

template <class Map>
DI void transpose_item(const float* __restrict__ W, int Nsrc, bf16_t* __restrict__ WT, int ldk, float* scr, int item, int nblk, int lane, Map srcmap, const float* __restrict__ rowscale = nullptr) {
    const int kb = item / nblk, nb = item % nblk, k0 = 64 * kb, n0 = 32 * nb;
    const int ns = srcmap(n0 + (lane & 31));
    float vv[32];
#pragma unroll
    for (int i = 0; i < 32; ++i) { const int kk = 2 * i + (lane >> 5); vv[i] = (ns >= 0) ? W[(size_t)(k0 + kk) * Nsrc + ns] : 0.f; }
    if (rowscale) {
#pragma unroll
        for (int i = 0; i < 32; ++i) vv[i] *= rowscale[k0 + 2 * i + (lane >> 5)];
    }
#pragma unroll
    for (int i = 0; i < 32; ++i) { const int kk = 2 * i + (lane >> 5); scr[kk * 33 + (lane & 31)] = vv[i]; }
    __builtin_amdgcn_s_waitcnt(0); __builtin_amdgcn_wave_barrier();
    const int c = lane & 7;
#pragma unroll
    for (int j = 0; j < 4; ++j) { const int n = (lane >> 3) + 8 * j; const float* s = scr + (8 * c) * 33 + n;
        u32x4 o; o.x = pk2(s[0 * 33], s[1 * 33]); o.y = pk2(s[2 * 33], s[3 * 33]); o.z = pk2(s[4 * 33], s[5 * 33]); o.w = pk2(s[6 * 33], s[7 * 33]);
        *(u32x4*)(WT + (size_t)(n0 + n) * ldk + k0 + 8 * c) = o; }
    __builtin_amdgcn_s_waitcnt(0); __builtin_amdgcn_wave_barrier();
}
struct MapId { DI int operator()(int n) const { return n; } };
struct MapWin {
    DI int operator()(int n) const {
        if (n < 2048) return n;
        if (n < 2304) return n + 16;
        if (n < 2432) return n + 16;
        if (n < 2464) return n + 16;
        if (n < 2472) return n - 416;
        if (n < 2480) return n - 416;
        return -1;
    }
};

template <int PART> DI void p0_late_weights(const Frame& F, const Args& A, int wi, int nwv, int ti, int nth) {
    unsigned char* ws = A.ws;
    float* scr = (float*)(F.lds + F.wave * 16384);
    const float* w_uq = A.in[10]; const float* w_ukv = A.in[11]; const float* w_out = A.in[14]; const float* w_pq = A.in[16]; const float* sub_keys = A.in[17];
    constexpr int I_UQ = 4 * 24, I_UKV = 2 * 32, I_OUT = 16 * 32, I_PQ = 16 * 64;
    constexpr int NITEMS = I_UQ + I_UKV + I_OUT + I_PQ;
    const int lo_ = PART == 0 ? 0 : I_UQ + I_UKV, hi_ = PART == 0 ? I_UQ + I_UKV : NITEMS;
    for (int it = lo_ + wi; it < hi_; it += nwv) {
        int r = it;
        if (r < I_UQ) { transpose_item(w_uq, 768, (bf16_t*)(ws + WS_WUQ), 256, scr, r, 24, F.lane, MapId(), A.in[8]); continue; } r -= I_UQ;
        if (r < I_UKV) { transpose_item(w_ukv, 1024, (bf16_t*)(ws + WS_WUKV), 256, scr, r, 32, F.lane, MapId(), A.in[9]); continue; } r -= I_UKV;
        if (r < I_OUT) { transpose_item(w_out, 1024, (bf16_t*)(ws + WS_WOUT), 1024, scr, r, 32, F.lane, MapId()); continue; } r -= I_OUT;
        transpose_item(w_pq, 2048, (bf16_t*)(ws + WS_WPQ), 1024, scr, r, 64, F.lane, MapId(), A.in[15]);
    }
    const int gt = ti, NGT = nth;
    if (PART == 0) for (int i = gt; i < 1024 * 16; i += NGT) { const int n = i >> 4, c = i & 15; *(u32x4*)((bf16_t*)(ws + WS_WUKV) + (size_t)n * 256 + 128 + c * 8) = (u32x4){0u, 0u, 0u, 0u}; }
    if (PART == 1) for (int i = gt; i < 2048 * 32; i += NGT) {
        const int n = i >> 5, c8 = (i & 31) * 8; const int p = (n >> 7) & 1;
        u32x4 o = (u32x4){0u, 0u, 0u, 0u};
        if ((c8 >> 7) == p) { const float* s = sub_keys + (size_t)n * 128 + (c8 & 127); const f32x4 a = *(const f32x4*)s, b = *(const f32x4*)(s + 4);
            o.x = pk2(a.x, a.y); o.y = pk2(a.z, a.w); o.z = pk2(b.x, b.y); o.w = pk2(b.z, b.w); }
        *(u32x4*)((bf16_t*)(ws + WS_SKB) + (size_t)n * 256 + c8) = o;
    }
}

DI void p0_prologue(const Frame& F, const Args& A) {
    unsigned char* ws = A.ws;
    float* scr = (float*)(F.lds + F.wave * 16384);
    const float* w_in = A.in[3]; const float* w_uq = A.in[10]; const float* w_ukv = A.in[11]; const float* w_out = A.in[14]; const float* w_pq = A.in[16]; const float* sub_keys = A.in[17];
    constexpr int I_IN = 16 * 80;
    for (int it = F.wave * F.G + blockIdx.x; it < I_IN; it += F.NGW) transpose_item(w_in, 2480, (bf16_t*)(ws + WS_WIN), 1024, scr, it, 80, F.lane, MapWin());
    const float* x = A.in[0]; const float* meta = A.in[1]; const float* anorm = A.in[2];
    bf16_t* HN = (bf16_t*)(ws + WS_HN);
    for (int p0 = F.gw; p0 < MP; p0 += 3 * F.NGW) {
        f32x4 v[3][4]; bool ok[3];
#pragma unroll
        for (int r = 0; r < 3; ++r) {
            const int p = p0 + r * F.NGW, t = p - PADL; ok[r] = (p < MP) && t >= 0 && t < NTOK;
            if (ok[r]) { const float* src = (t < 16) ? meta + (size_t)t * DM : x + (size_t)(t - 16) * DM; const f32x4* xr = (const f32x4*)src + F.lane;
#pragma unroll
                for (int j = 0; j < 4; ++j) v[r][j] = xr[64 * j]; }
            else {
#pragma unroll
                for (int j = 0; j < 4; ++j) v[r][j] = (f32x4){0.f, 0.f, 0.f, 0.f}; }
        }
#pragma unroll
        for (int r = 0; r < 3; ++r) {
            const int p = p0 + r * F.NGW; if (p >= MP) continue;
            unsigned long long* o8 = (unsigned long long*)(HN + (size_t)p * DM) + F.lane;
            float s = 0.f;
#pragma unroll
            for (int j = 0; j < 4; ++j) s += (v[r][j].x * v[r][j].x + v[r][j].y * v[r][j].y) + (v[r][j].z * v[r][j].z + v[r][j].w * v[r][j].w);
            const float rstd = ok[r] ? 1.f / sqrtf(wave_sum(s) * (1.f / DM) + EPS) : 0.f;
#pragma unroll
            for (int j = 0; j < 4; ++j) { const f32x4 w = ((const f32x4*)anorm)[64 * j + F.lane];
                o8[64 * j] = (unsigned long long)pk2(v[r][j].x * rstd * w.x, v[r][j].y * rstd * w.y) | ((unsigned long long)pk2(v[r][j].z * rstd * w.z, v[r][j].w * rstd * w.w) << 32); }
        }
    }
}

DI void row_ss_store(const f32x4 (&v)[2][2][4][2], float* SSP, int nslot, int slot, int row0, int fq, bool bj0_only) {
#pragma unroll
    for (int ai = 0; ai < 2; ++ai)
#pragma unroll
        for (int m = 0; m < 4; ++m) {
            float s = 0.f;
#pragma unroll
            for (int bj = 0; bj < 2; ++bj) if (bj == 0 || !bj0_only)
#pragma unroll
                for (int n = 0; n < 2; ++n) { const f32x4 x = v[ai][bj][m][n]; s += (x[0] * x[0] + x[1] * x[1]) + (x[2] * x[2] + x[3] * x[3]); }
            s += __shfl_xor(s, 16); s += __shfl_xor(s, 32);
            if (fq == 0) SSP[(size_t)(row0 + ai * 128 + m * 16) * nslot + slot] = s;
        }
}
DI float ss_sum4(const float* SSP, int row) { const f32x4 a = *(const f32x4*)(SSP + (size_t)row * 4); return (a.x + a.y) + (a.z + a.w); }
DI float ss_sum16(const float* SSP, int row) { const f32x4 a = *(const f32x4*)(SSP + (size_t)row * 16), b = *(const f32x4*)(SSP + (size_t)row * 16 + 4), c = *(const f32x4*)(SSP + (size_t)row * 16 + 8), d = *(const f32x4*)(SSP + (size_t)row * 16 + 12);
    return (((a.x + a.y) + (a.z + a.w)) + ((b.x + b.y) + (b.z + b.w))) + (((c.x + c.y) + (c.z + c.w)) + ((d.x + d.y) + (d.z + d.w))); }
struct EpiProj {
    static constexpr bool PERM = true;
    bf16_t* QKVR; bf16_t* Z; float* P32; bf16_t* CQ16; bf16_t* CKV16; float* KPE; float* SSQ; float* SSK;
    DI void operator()(const f32x4 (&acc)[2][2][4][2], const pg8::Unit& u, int wr, int wc, int fr, int fq) const {
        const int row0 = u.pm * 256 + wr * 64 + fr;
        if (u.pn < 8) {
            bf16_t* base; int ld, colt;
            if (u.pn < 6) { base = QKVR; ld = 1536; colt = u.pn * 256; } else { base = Z; ld = 512; colt = (u.pn - 6) * 256; }
            const int col0 = colt + wc * 32 + 8 * fq;
#pragma unroll
            for (int ai = 0; ai < 2; ++ai)
#pragma unroll
                for (int m = 0; m < 4; ++m) { bf16_t* rowp = base + (size_t)(row0 + ai * 128 + m * 16) * ld + col0;
#pragma unroll
                    for (int bj = 0; bj < 2; ++bj) { const f32x4 v0 = acc[ai][bj][m][0], v1 = acc[ai][bj][m][1];
                        u32x4 w; w.x = pg8::cvt_pk_bf16(v0[0], v0[1]); w.y = pg8::cvt_pk_bf16(v0[2], v0[3]); w.z = pg8::cvt_pk_bf16(v1[0], v1[1]); w.w = pg8::cvt_pk_bf16(v1[2], v1[3]);
                        *(u32x4*)(rowp + bj * 128) = w; } }
        } else {
            const int lcol0 = wc * 32 + 8 * fq;
            bf16_t* b16 = (u.pn == 8) ? CQ16 : CKV16;
#pragma unroll
            for (int ai = 0; ai < 2; ++ai)
#pragma unroll
                for (int m = 0; m < 4; ++m) { const size_t row = (size_t)(row0 + ai * 128 + m * 16);
                    float* rowp = P32 + row * 512 + (u.pn - 8) * 256 + lcol0;
#pragma unroll
                    for (int bj = 0; bj < 2; ++bj) { const f32x4 v0 = acc[ai][bj][m][0], v1 = acc[ai][bj][m][1];
                        *(f32x4*)(rowp + bj * 128) = v0; *(f32x4*)(rowp + bj * 128 + 4) = v1;
                        u32x4 w; w.x = pg8::cvt_pk_bf16(v0[0], v0[1]); w.y = pg8::cvt_pk_bf16(v0[2], v0[3]); w.z = pg8::cvt_pk_bf16(v1[0], v1[1]); w.w = pg8::cvt_pk_bf16(v1[2], v1[3]);
                        *(u32x4*)(b16 + row * 256 + lcol0 + bj * 128) = w;
                        if (u.pn == 9 && bj == 1 && wc == 0) { *(f32x4*)(KPE + row * 32 + 8 * fq) = v0; *(f32x4*)(KPE + row * 32 + 8 * fq + 4) = v1; }
                    } }
            row_ss_store(acc, (u.pn == 8) ? SSQ : SSK, 4, wc, row0, fq, u.pn == 9);
        }
    }
};
struct EpiB16 {
    static constexpr bool PERM = true;
    bf16_t* O; int ldc; const float* SS; float invn; int nslot;
    DI void operator()(const f32x4 (&acc)[2][2][4][2], const pg8::Unit& u, int wr, int wc, int fr, int fq) const {
        const int row0 = u.pm * 256 + wr * 64 + fr, col0 = u.pn * 256 + wc * 32 + 8 * fq;
#pragma unroll
        for (int ai = 0; ai < 2; ++ai)
#pragma unroll
            for (int m = 0; m < 4; ++m) { const int row = row0 + ai * 128 + m * 16; bf16_t* rowp = O + (size_t)row * ldc + col0;
                const float rs = SS ? 1.f / sqrtf((nslot == 16 ? ss_sum16(SS, row) : ss_sum4(SS, row)) * invn + EPS) : 1.f;
#pragma unroll
                for (int bj = 0; bj < 2; ++bj) { const f32x4 v0 = acc[ai][bj][m][0] * rs, v1 = acc[ai][bj][m][1] * rs;
                    u32x4 w; w.x = pg8::cvt_pk_bf16(v0[0], v0[1]); w.y = pg8::cvt_pk_bf16(v0[2], v0[3]); w.z = pg8::cvt_pk_bf16(v1[0], v1[1]); w.w = pg8::cvt_pk_bf16(v1[2], v1[3]);
                    *(u32x4*)(rowp + bj * 128) = w; } }
    }
};
struct EpiH1 {
    static constexpr bool PERM = true;
    float* C; const float* res; bf16_t* H16; float* SS;
    DI void operator()(const f32x4 (&acc)[2][2][4][2], const pg8::Unit& u, int wr, int wc, int fr, int fq) const {
        const int row0 = u.pm * 256 + wr * 64 + fr, col0 = u.pn * 256 + wc * 32 + 8 * fq;
        f32x4 v[2][2][4][2];
#pragma unroll
        for (int ai = 0; ai < 2; ++ai)
#pragma unroll
            for (int m = 0; m < 4; ++m) { const size_t off = (size_t)(row0 + ai * 128 + m * 16) * 1024 + col0;
#pragma unroll
                for (int bj = 0; bj < 2; ++bj) { const f32x4 v0 = acc[ai][bj][m][0] + *(const f32x4*)(res + off + bj * 128), v1 = acc[ai][bj][m][1] + *(const f32x4*)(res + off + bj * 128 + 4);
                    v[ai][bj][m][0] = v0; v[ai][bj][m][1] = v1;
                    *(f32x4*)(C + off + bj * 128) = v0; *(f32x4*)(C + off + bj * 128 + 4) = v1;
                    u32x4 w; w.x = pg8::cvt_pk_bf16(v0[0], v0[1]); w.y = pg8::cvt_pk_bf16(v0[2], v0[3]); w.z = pg8::cvt_pk_bf16(v1[0], v1[1]); w.w = pg8::cvt_pk_bf16(v1[2], v1[3]);
                    *(u32x4*)(H16 + off + bj * 128) = w; } }
        row_ss_store(v, SS, 16, u.pn * 4 + wc, row0, fq, false);
    }
};
struct EpiF32 {
    static constexpr bool PERM = true;
    float* C; int ldc; const float* res;
    DI void operator()(const f32x4 (&acc)[2][2][4][2], const pg8::Unit& u, int wr, int wc, int fr, int fq) const {
        const int row0 = u.pm * 256 + wr * 64 + fr, col0 = u.pn * 256 + wc * 32 + 8 * fq;
#pragma unroll
        for (int ai = 0; ai < 2; ++ai)
#pragma unroll
            for (int m = 0; m < 4; ++m) { const size_t off = (size_t)(row0 + ai * 128 + m * 16) * ldc + col0;
#pragma unroll
                for (int bj = 0; bj < 2; ++bj) { f32x4 v0 = acc[ai][bj][m][0], v1 = acc[ai][bj][m][1];
                    if (res) { v0 += *(const f32x4*)(res + off + bj * 128); v1 += *(const f32x4*)(res + off + bj * 128 + 4); }
                    *(f32x4*)(C + off + bj * 128) = v0; *(f32x4*)(C + off + bj * 128 + 4) = v1; } }
    }
};

DI f32x16 mfma32(bf16x8 a, bf16x8 b, f32x16 c) { return __builtin_amdgcn_mfma_f32_32x32x16_bf16(a, b, c, 0, 0, 0); }
DI f32x4 mfma16(bf16x8 a, bf16x8 b, f32x4 c) { return __builtin_amdgcn_mfma_f32_16x16x32_bf16(a, b, c, 0, 0, 0); }
DI int crow(int r, int hi) { return (r & 3) + 8 * (r >> 2) + 4 * hi; }
DI f32x16 zero16() { f32x16 z;
#pragma unroll
    for (int i = 0; i < 16; ++i) z[i] = 0.f; return z; }

constexpr int G_KF = 0, G_VF = 16384, G_MF = 32768;
constexpr int G_QB = 50176, G_KB = 59392, G_KBB = 68608;
constexpr int G_QKB = 77824, G_UT = 87040, G_WT = 96256, G_KDT = 105472;
constexpr int G_VEC = 114688;
constexpr int G_RAW = G_QKB;
constexpr int GST = 72;

DI f32x16 mm_quad(const unsigned char* A, const unsigned char* Bt, int qr, int qc, int lane) {
    const int r32 = lane & 31, hh = lane >> 5;
    const unsigned char* ap = A + (32 * qr + r32) * (GST * 2) + hh * 16;
    const unsigned char* bp = Bt + (32 * qc + r32) * (GST * 2) + hh * 16;
    f32x16 acc = zero16();
#pragma unroll
    for (int s = 0; s < 4; ++s) acc = mfma32(*(const bf16x8*)(ap + s * 32), *(const bf16x8*)(bp + s * 32), acc);
    return acc;
}

constexpr int G_RAW2 = 115712;
static_assert(G_RAW2 + 67 * 400 <= 143360, "GDN prep LDS map");
constexpr int G_CONVW = 143360 + 512;

#ifndef PROBE_STAGE
#define PROBE_STAGE -1
#endif
template <int VAR> DI void gdn_prep_phase(const Frame& F, const Args& A) {
    unsigned long long stg_t = 0ull, stg_acc = 0ull;
#define STG(n) do { if (PROBE_STAGE >= 0) { const unsigned long long now_ = __builtin_amdgcn_s_memrealtime(); if (PROBE_STAGE == (n)) stg_acc += now_ - stg_t; stg_t = now_; } } while (0)
    unsigned char* ws = A.ws; unsigned char* lds = F.lds;
    const int tid = F.tid, lane = F.lane, wave = F.wave;
    const bf16_t* QKVR = (const bf16_t*)(ws + WS_QKVR); const float* P32 = (const float*)(ws + WS_P32);
    float* KF = (float*)(lds + G_KF); float* VF = (float*)(lds + G_VF); float* MF = (float*)(lds + G_MF);
    float* VEC = (float*)(lds + G_VEC);
    if (VAR == 6) return;
    const int NIT = NCHUNK * 8;
#define LBAR() do { asm volatile("s_waitcnt lgkmcnt(0)" ::: "memory"); __builtin_amdgcn_s_barrier(); asm volatile("" ::: "memory"); } while (0)
#define LAUNDER(dst, src) int dst = (src); asm volatile("" : "+v"(dst))
    int item = blockIdx.x;
    if (item >= NIT) return;
    u32x4 pr[4]; float nb = 0.f, na = 0.f;
    auto raw_fetch = [&](int it) {
        const int c = it >> 3, h = it & 7; LAUNDER(tl, tid);
#pragma unroll
        for (int i = 0; i < 4; ++i) { const int q = tl + 512 * i; pr[i] = (u32x4){0u, 0u, 0u, 0u};
            if (q < 67 * 24) { const int r = q / 24, cc = q % 24, seg = cc >> 3, c8 = cc & 7; const int p = 64 * c - 3 + r;
                if (p >= 0) pr[i] = *(const u32x4*)(QKVR + (size_t)p * 1536 + seg * 512 + h * 64 + c8 * 8); } }
        if (wave == 0) { const int p = 64 * c + lane; nb = P32[(size_t)p * 512 + 416 + h]; na = P32[(size_t)p * 512 + 424 + h]; }
    };
    auto raw_park = [&]() {
        LAUNDER(tl, tid);
#pragma unroll
        for (int i = 0; i < 4; ++i) { const int q = tl + 512 * i;
            if (q < 67 * 24) { const int r = q / 24, cc = q % 24, seg = cc >> 3, c8 = cc & 7; *(u32x4*)(lds + G_RAW2 + r * 400 + (seg * 64 + c8 * 8) * 2) = pr[i]; } }
    };
    raw_fetch(item); raw_park();
    float cb = nb, ca = na;
    float* CWL = (float*)(lds + G_CONVW);
    int cw_h = -1;
#pragma unroll 1
    for (; item < NIT; item += F.G) {
        if (PROBE_STAGE >= 0 && stg_t == 0ull) stg_t = __builtin_amdgcn_s_memrealtime();
        const int c = item >> 3, h = item & 7;
        if (h != cw_h) { cw_h = h;
            if (tid < 192) { LAUNDER(t0, tid); const int sg = t0 >> 6, jt = (t0 >> 4) & 3, c4 = t0 & 15; *(f32x4*)(CWL + (sg * 4 + jt) * 64 + 4 * c4) = *(const f32x4*)(A.in[4] + jt * 1536 + sg * 512 + h * 64 + 4 * c4); } }
        const int nxt = item + F.G;
        if (VAR != 5 && nxt < NIT) raw_fetch(nxt);
        if (wave == 0) {
            const int p = 64 * c + lane;
            const float alog = A.in[5][h], dtb = A.in[6][h];
            float beta = sigmoidf_(cb);
            const float xx = ca + dtb; const float sp = xx > 20.f ? xx : log1pf(__expf(xx));
            float g = -__expf(alog) * sp;
            if (p < PADL) { beta = 0.f; g = 0.f; }
            float gc = g;
#pragma unroll
            for (int o = 1; o < 64; o <<= 1) { const float t = __shfl_up(gc, o); if (lane >= o) gc += t; }
            const float glast = __shfl(gc, 63);
            VEC[lane] = gc; VEC[64 + lane] = beta; VEC[128 + lane] = __expf(gc); VEC[192 + lane] = __expf(glast - gc);
        }
        LBAR(); STG(0);
        LAUNDER(t1, tid); const int sub = t1 & 15, grp = t1 >> 4;
#pragma unroll
        for (int sg = 0; sg < ((VAR == 2 || VAR >= 4) ? 0 : 3); ++sg) {
#pragma unroll
            for (int ps = 0; ps < 2; ++ps) {
                const int i = grp + 32 * ps;
                float acc[4] = {0.f, 0.f, 0.f, 0.f};
#pragma unroll
                for (int jt = 0; jt < 4; ++jt) {
                    const f32x4 w = *(const f32x4*)(CWL + (sg * 4 + jt) * 64 + 4 * sub);
                    const u32x2 rv = *(const u32x2*)(lds + G_RAW2 + (i + jt) * 400 + (sg * 64 + 4 * sub) * 2);
                    acc[0] += w.x * bflo(rv.x); acc[1] += w.y * bfhi(rv.x); acc[2] += w.z * bflo(rv.y); acc[3] += w.w * bfhi(rv.y);
                }
                float y[4];
#pragma unroll
                for (int k = 0; k < 4; ++k) y[k] = siluf_(acc[k]);
                if (sg < 2) {
                    float ss = (y[0] * y[0] + y[1] * y[1]) + (y[2] * y[2] + y[3] * y[3]);
                    ss += __shfl_xor(ss, 1); ss += __shfl_xor(ss, 2); ss += __shfl_xor(ss, 4); ss += __shfl_xor(ss, 8);
                    const float rn = 1.f / sqrtf(ss + EPS);
#pragma unroll
                    for (int k = 0; k < 4; ++k) y[k] *= rn;
                }
                if (sg == 0) {
                    u32x2 o; o.x = pk2(y[0] * 0.125f, y[1] * 0.125f); o.y = pk2(y[2] * 0.125f, y[3] * 0.125f);
                    *(u32x2*)(lds + G_QB + i * (GST * 2) + 8 * sub) = o;
                } else if (sg == 1) {
                    const float beta = VEC[64 + i], ekd = VEC[192 + i];
                    *(f32x4*)(KF + i * 64 + 4 * sub) = (f32x4){y[0], y[1], y[2], y[3]};
                    u32x2 o; o.x = pk2(y[0], y[1]); o.y = pk2(y[2], y[3]);
                    *(u32x2*)(lds + G_KB + i * (GST * 2) + 8 * sub) = o;
                    o.x = pk2(y[0] * beta, y[1] * beta); o.y = pk2(y[2] * beta, y[3] * beta);
                    *(u32x2*)(lds + G_KBB + i * (GST * 2) + 8 * sub) = o;
#pragma unroll
                    for (int k = 0; k < 4; ++k) *(bf16_t*)(lds + G_KDT + (4 * sub + k) * (GST * 2) + i * 2) = (bf16_t)f2bf(y[k] * ekd);
                } else {
                    *(f32x4*)(VF + i * 64 + 4 * sub) = (f32x4){y[0], y[1], y[2], y[3]};
                }
            }
        }
        LBAR(); STG(1);
        if (VAR != 3 && VAR < 4) {
            LAUNDER(l3, lane);
            const int prod = wave >> 2, quad = wave & 3, qr = quad >> 1, qc = quad & 1, r32 = l3 & 31, hh = l3 >> 5;
            const f32x16 acc = mm_quad(lds + (prod ? G_QB : G_KBB), lds + G_KB, qr, qc, l3);
            const int j = 32 * qc + r32; const float gcj = VEC[j];
#pragma unroll
            for (int r = 0; r < 16; ++r) {
                const int i = 32 * qr + crow(r, hh);
                if (prod == 0) { MF[i * 68 + j] = (j < i) ? acc[r] * __expf(VEC[i] - gcj) : 0.f; }
                else { *(bf16_t*)(lds + G_QKB + i * (GST * 2) + j * 2) = (bf16_t)f2bf((j <= i) ? acc[r] * __expf(VEC[i] - gcj) : 0.f); }
            }
        }
        LBAR(); STG(2);
        float* DB = (float*)(lds + G_KBB);
        if (VAR != 1 && VAR < 4 && wave == 0) {
            LAUNDER(l4, lane); const int b = l4 >> 4, jc = l4 & 15;
            float d[16];
#pragma unroll
            for (int i = 0; i < 16; ++i) {
                float acc = (i == jc) ? 1.f : 0.f;
                const float* mrow = MF + (16 * b + i) * 68 + 16 * b;
#pragma unroll
                for (int k = 0; k < i; ++k) acc -= mrow[k] * d[k];
                d[i] = acc;
            }
#pragma unroll
            for (int i = 0; i < 16; ++i) DB[(b * 16 + i) * 20 + jc] = d[i];
        }
        LBAR();
        if (VAR != 1 && VAR < 4) {
            LAUNDER(l4, lane); const int cc = l4 & 15, g = l4 >> 4;
            const bool isU = wave < 4; const int col = 16 * (wave & 3) + cc;
            const float* src = (isU ? VF : KF) + col;
            f32x4 X[4];
#pragma unroll
            for (int b = 0; b < 4; ++b) {
                f32x4 acc;
#pragma unroll
                for (int r = 0; r < 4; ++r) { const int i = 16 * b + 4 * g + r; float rv = src[i * 64] * VEC[64 + i]; if (!isU) rv *= VEC[128 + i]; acc[r] = -rv; }
#pragma unroll
                for (int a = 0; a < b; ++a) {
                    const f32x4 lv = *(const f32x4*)(MF + (16 * b + cc) * 68 + 16 * a + 4 * g);
#pragma unroll
                    for (int sp = 0; sp < 4; ++sp) acc = __builtin_amdgcn_mfma_f32_16x16x4f32(lv[sp], X[a][sp], acc, 0, 0, 0);
                }
                const f32x4 dv = *(const f32x4*)(DB + (b * 16 + cc) * 20 + 4 * g);
                f32x4 xb = (f32x4){0.f, 0.f, 0.f, 0.f};
#pragma unroll
                for (int sp = 0; sp < 4; ++sp) xb = __builtin_amdgcn_mfma_f32_16x16x4f32(dv[sp], acc[sp], xb, 0, 0, 0);
                X[b] = -xb;
                unsigned char* dst = lds + (isU ? G_UT : G_WT) + col * (GST * 2) + (16 * b + 4 * g) * 2;
                *(u32x2*)dst = (u32x2){pk2(X[b][0], X[b][1]), pk2(X[b][2], X[b][3])};
            }
        }
        LBAR(); STG(3);
        if (VAR != 3 && VAR < 4) {
            const float gl = VEC[128 + 63];
            bf16_t* GB = (bf16_t*)(ws + WS_GB) + (size_t)item * 4096;
            bf16_t* GQ = (bf16_t*)(ws + (VAR ? WS_GS : WS_GQ)) + (size_t)item * 4096; bf16_t* GO = (bf16_t*)(ws + (VAR ? WS_GS : WS_GO)) + (size_t)item * 4096;
            bf16_t* GAL = (bf16_t*)(lds + G_MF);
            LAUNDER(l5, lane); const int r32 = l5 & 31, hh = l5 >> 5;
#pragma unroll 1
            for (int it = 0; it < 2; ++it) {
                const int task = wave + 8 * it, prod = task >> 2, quad = task & 3, qr = quad >> 1, qc = quad & 1;
                const f32x16 acc = mm_quad(lds + (prod < 2 ? G_KDT : G_QKB), lds + ((prod & 1) ? G_UT : G_WT), qr, qc, l5);
                const int Cc = 32 * qc + r32;
                if (prod == 0) {
#pragma unroll
                    for (int r = 0; r < 16; ++r) {
                        const int R = 32 * qr + crow(r, hh);
                        const float val = ((R == Cc) ? gl : 0.f) - acc[r];
                        const int rb = R >> 4, m = R & 15, q4 = Cc >> 4, g = (Cc >> 2) & 3, rr = Cc & 3, ks = q4 >> 1, jj = 4 * (q4 & 1) + rr, ls = 16 * g + m;
                        GAL[((rb * 2 + ks) * 64 + ls) * 8 + jj] = (bf16_t)f2bf(val);
                    }
                } else if (prod == 1) {
                    const int eslab = Cc >> 4, n = Cc & 15;
#pragma unroll
                    for (int a = 0; a < 4; ++a) {
                        const int R0 = 32 * qr + 8 * a + 4 * hh; const int rb = R0 >> 4, g = (R0 >> 2) & 3, ls = 16 * g + n;
                        *(u32x2*)(GB + ((eslab * 4 + rb) * 64 + ls) * 4) = (u32x2){pk2(acc[4 * a], acc[4 * a + 1]), pk2(acc[4 * a + 2], acc[4 * a + 3])};
                    }
                } else if (prod == 2) {
#pragma unroll
                    for (int r = 0; r < 16; ++r) {
                        const int R = 32 * qr + crow(r, hh);
                        const float qv = bf2f(*(const bf16_t*)(lds + G_QB + R * (GST * 2) + Cc * 2));
                        GQ[R * 64 + Cc] = (bf16_t)f2bf(qv * VEC[128 + R] - acc[r]);
                    }
                } else {
#pragma unroll
                    for (int r = 0; r < 16; ++r) GO[(quad * 16 + r) * 64 + l5] = (bf16_t)f2bf(acc[r]);
                }
            }
        }
        if (VAR != 5 && nxt < NIT) { raw_park(); cb = nb; ca = na; }
        LBAR(); STG(4);
        if (VAR != 5) { LAUNDER(t6, tid); *(u32x4*)((bf16_t*)(ws + (VAR ? WS_GS : WS_GA)) + (size_t)item * 4096 + t6 * 8) = *(const u32x4*)(lds + G_MF + t6 * 16); }
        STG(5);
    }
    if (PROBE_STAGE >= 0 && tid == 0) { *(unsigned long long*)(lds + 143360 + 96) = stg_acc; }
}

constexpr int SC_D = 8, SC_PD = 6, SC_SLOT = 10240;
DI void gdn_scan(const Frame& F, const Args& A) {
    if (blockIdx.x >= 32) return;
    unsigned char* ws = A.ws;
    const int h = blockIdx.x & 7, eslab = blockIdx.x >> 3, lane = F.lane, wave = F.wave, n = lane & 15, g = lane >> 4;
    const unsigned char* GA = ws + WS_GA; const unsigned char* GB = ws + WS_GB; bf16_t* GS = (bf16_t*)(ws + WS_GS);
    LAS unsigned char* ring = (LAS unsigned char*)F.lds;
    const int np = (wave == 0) ? 0 : ((wave - 1 < 3) ? 2 : 1);
    auto issue = [&](int c) {
        const int cc = c < NCHUNK ? c : NCHUNK - 1;
        const size_t item = (size_t)cc * 8 + h;
        LAS unsigned char* slot = ring + (c % SC_D) * SC_SLOT;
#pragma unroll
        for (int i = 0; i < 2; ++i) if (i < np) {
            const int q = (wave - 1) + 7 * i;
            const unsigned char* src = (q < 8) ? GA + item * 8192 + q * 1024 : GB + item * 8192 + eslab * 2048 + (q - 8) * 1024;
            LAS unsigned char* dst = slot + ((q < 8) ? q * 1024 : 8192 + (q - 8) * 1024);
            __builtin_amdgcn_global_load_lds((const unsigned*)(src + lane * 16), (LAS unsigned*)dst, 16, 0, 0);
        }
    };
    for (int c = 0; c < SC_PD; ++c) issue(c);
    f32x4 S[4];
#pragma unroll
    for (int rb = 0; rb < 4; ++rb) S[rb] = (f32x4){0.f, 0.f, 0.f, 0.f};
#pragma unroll 1
    for (int c = 0; c < NCHUNK; ++c) {
        issue(c + SC_PD);
        if (np == 2) asm volatile("s_waitcnt vmcnt(12)" ::: "memory");
        else if (np == 1) asm volatile("s_waitcnt vmcnt(6)" ::: "memory");
        asm volatile("s_waitcnt lgkmcnt(0)" ::: "memory");
        __builtin_amdgcn_s_barrier();
        asm volatile("" ::: "memory");
        if (wave == 0) {
            const LAS unsigned char* slot = ring + (c % SC_D) * SC_SLOT;
            bf16x8 ac[8]; f32x4 bc[4];
#pragma unroll
            for (int q = 0; q < 8; ++q) ac[q] = *(const LAS bf16x8*)(slot + q * 1024 + lane * 16);
#pragma unroll
            for (int rb = 0; rb < 4; ++rb) { const u32x2 w = *(const LAS u32x2*)(slot + 8192 + rb * 512 + lane * 8); bc[rb] = (f32x4){bflo(w.x), bfhi(w.x), bflo(w.y), bfhi(w.y)}; }
            const size_t item = (size_t)c * 8 + h;
            u32x4 p0, p1;
            p0.x = pk2(S[0][0], S[0][1]); p0.y = pk2(S[0][2], S[0][3]); p0.z = pk2(S[1][0], S[1][1]); p0.w = pk2(S[1][2], S[1][3]);
            p1.x = pk2(S[2][0], S[2][1]); p1.y = pk2(S[2][2], S[2][3]); p1.z = pk2(S[3][0], S[3][1]); p1.w = pk2(S[3][2], S[3][3]);
            {
                bf16_t* st = GS + item * 4096 + (16 * eslab + n) * 64 + 4 * g;
                *(u32x2*)(st + 0) = (u32x2){p0.x, p0.y}; *(u32x2*)(st + 16) = (u32x2){p0.z, p0.w};
                *(u32x2*)(st + 32) = (u32x2){p1.x, p1.y}; *(u32x2*)(st + 48) = (u32x2){p1.z, p1.w};
            }
            const bf16x8 b0 = __builtin_bit_cast(bf16x8, p0), b1 = __builtin_bit_cast(bf16x8, p1);
#pragma unroll
            for (int rb = 0; rb < 4; ++rb) {
                f32x4 acc = bc[rb];
                acc = mfma16(ac[rb * 2 + 0], b0, acc);
                acc = mfma16(ac[rb * 2 + 1], b1, acc);
                S[rb] = acc;
            }
        }
    }
    asm volatile("s_waitcnt vmcnt(0) lgkmcnt(0)" ::: "memory");
    __builtin_amdgcn_s_barrier();
}

DI void gdn_out_task(const Frame& F, const Args& A, int task) {
    unsigned char* ws = A.ws;
    const int ihalf = task & 1, item = (task >> 1) + 8, c = item >> 3, h = item & 7, lane = F.lane, r32 = lane & 31, hh = lane >> 5;
    const bf16_t* GQ = (const bf16_t*)(ws + WS_GQ) + (size_t)item * 4096; const bf16_t* GS = (const bf16_t*)(ws + WS_GS) + (size_t)item * 4096;
    const bf16_t* GO = (const bf16_t*)(ws + WS_GO) + (size_t)item * 4096;
    const bf16_t* Z = (const bf16_t*)(ws + WS_Z); bf16_t* MIX = (bf16_t*)(ws + WS_MIX);
    f32x16 acc[2];
#pragma unroll
    for (int eh = 0; eh < 2; ++eh)
#pragma unroll
        for (int r = 0; r < 16; ++r) acc[eh][r] = bf2f(GO[((ihalf * 2 + eh) * 16 + r) * 64 + lane]);
#pragma unroll
    for (int s = 0; s < 4; ++s) {
        const bf16x8 a = *(const bf16x8*)(GQ + (32 * ihalf + r32) * 64 + 16 * s + 8 * hh);
#pragma unroll
        for (int eh = 0; eh < 2; ++eh) {
            const bf16x8 b = *(const bf16x8*)(GS + (32 * eh + r32) * 64 + 16 * s + 8 * hh);
            acc[eh] = mfma32(a, b, acc[eh]);
        }
    }
    const float* gnorm = A.in[7];
    const float w0 = gnorm[r32], w1 = gnorm[32 + r32];
#pragma unroll
    for (int r = 0; r < 16; ++r) {
        float ss = acc[0][r] * acc[0][r] + acc[1][r] * acc[1][r];
        ss += __shfl_xor(ss, 1); ss += __shfl_xor(ss, 2); ss += __shfl_xor(ss, 4); ss += __shfl_xor(ss, 8); ss += __shfl_xor(ss, 16);
        const float rstd = 1.f / sqrtf(ss * (1.f / 64.f) + EPS);
        const int i = 32 * ihalf + crow(r, hh); const int p = 64 * c + i;
        const float z0 = bf2f(Z[(size_t)p * 512 + h * 64 + r32]), z1 = bf2f(Z[(size_t)p * 512 + h * 64 + 32 + r32]);
        bf16_t* o = MIX + (size_t)(p - 64) * 1024 + h * 64;
        o[r32] = (bf16_t)f2bf(acc[0][r] * rstd * w0 * siluf_(z0));
        o[32 + r32] = (bf16_t)f2bf(acc[1][r] * rstd * w1 * siluf_(z1));
    }
}

DI void mla_prep1_rows(const Frame& F, const Args& A, int p0, int stride) {
    unsigned char* ws = A.ws; const int lane = F.lane;
    f32x4 q[4]; float k0[4], k1[4], pe[4];
#pragma unroll
    for (int r = 0; r < 4; ++r) { const int p = p0 + r * stride; const int pc = p < MP ? p : MP - 1;
        const float* P32 = (const float*)(ws + WS_P32) + (size_t)pc * 512;
        q[r] = *(const f32x4*)(P32 + 4 * lane); k0[r] = P32[256 + 2 * lane]; k1[r] = P32[256 + 2 * lane + 1]; pe[r] = P32[384 + (lane & 31)]; }
    const f32x4 wq = *(const f32x4*)(A.in[8] + 4 * lane);
    const float wk0 = A.in[9][2 * lane], wk1 = A.in[9][2 * lane + 1];
#pragma unroll
    for (int r = 0; r < 4; ++r) {
        const int p = p0 + r * stride; if (p >= MP) continue;
        bf16_t* CQN = (bf16_t*)(ws + WS_CQN) + (size_t)p * 256; bf16_t* CKVN = (bf16_t*)(ws + WS_CKVN) + (size_t)p * 256;
        const float sq = wave_sum((q[r].x * q[r].x + q[r].y * q[r].y) + (q[r].z * q[r].z + q[r].w * q[r].w));
        const float rq = 1.f / sqrtf(sq * (1.f / 256.f) + EPS);
        *(u32x2*)(CQN + 4 * lane) = (u32x2){pk2(q[r].x * rq * wq.x, q[r].y * rq * wq.y), pk2(q[r].z * rq * wq.z, q[r].w * rq * wq.w)};
        const float sk = wave_sum(k0[r] * k0[r] + k1[r] * k1[r]);
        const float rk = 1.f / sqrtf(sk * (1.f / 128.f) + EPS);
        *(unsigned*)(CKVN + 2 * lane) = pk2(k0[r] * rk * wk0, k1[r] * rk * wk1);
        *(unsigned*)(CKVN + 128 + 2 * lane) = 0u;
        if (lane < 32) ((float*)(ws + WS_KPE))[(size_t)p * 32 + lane] = pe[r];
    }
}

constexpr float QSCALE = 0.10206207261596577f * 1.4426950408889634f;
DI double rope_inv_rev(int i) {
    const double t8[8] = {0.15915494309189535, 0.08949940160889101, 0.050329212104487035, 0.0283021958306234, 0.015915494309189534, 0.008949940160889102, 0.005032921210448704, 0.00283021958306234};
    double v = t8[0];
#pragma unroll
    for (int k = 1; k < 8; ++k) v = ((i & 7) == k) ? t8[k] : v;
    return (i & 8) ? v * 0.01 : v;
}
constexpr int P2_TS = 136;
constexpr int P2_RS = 272;
#define P2_WSYNC() do { __builtin_amdgcn_s_waitcnt(0); __builtin_amdgcn_wave_barrier(); } while (0)
DI void mla_prep2_task(const Frame& F, const Args& A, int task) {
    unsigned char* ws = A.ws; int lane = F.lane; asm volatile("" : "+v"(lane));
    const int h = task & 7, blk = task >> 3;
    const int p = 64 * blk + lane;
    const bool valid = (p >= PADL) && (p < LPV);
    const float* qn = A.in[12]; const float* kn = A.in[13];
    unsigned char* TS = F.lds + F.wave * (64 * P2_RS);
    unsigned char* trow = TS + lane * P2_RS;
    const double pos = (double)(p - PADL);
    auto rot = [&](int i, float& sn_, float& cs_) { const double rev = pos * rope_inv_rev(i); const float fr = (float)(rev - floor(rev)); sn_ = __builtin_amdgcn_sinf(fr); cs_ = __builtin_amdgcn_cosf(fr); };
    {
        {
            const bf16_t* srcb = (const bf16_t*)(ws + WS_QH) + (size_t)(64 * blk) * 768 + h * 96;
            u32x4 t[12];
#pragma unroll
            for (int i = 0; i < 12; ++i) { const int c = 64 * i + lane, r = c / 12, pc = c % 12; t[i] = *(const u32x4*)(srcb + (size_t)r * 768 + 8 * pc); }
#pragma unroll
            for (int i = 0; i < 12; ++i) { const int c = 64 * i + lane, r = c / 12, pc = c % 12; *(u32x4*)(TS + r * P2_RS + 16 * pc) = t[i]; }
            P2_WSYNC();
        }
        u32x4 w[12];
#pragma unroll
        for (int c = 0; c < 12; ++c) w[c] = *(const u32x4*)(trow + 16 * c);
        float ss = 0.f;
#pragma unroll
        for (int c = 0; c < 12; ++c) { const float a0 = bflo(w[c].x), a1 = bfhi(w[c].x), a2 = bflo(w[c].y), a3 = bfhi(w[c].y), a4 = bflo(w[c].z), a5 = bfhi(w[c].z), a6 = bflo(w[c].w), a7 = bfhi(w[c].w);
            ss += (a0 * a0 + a1 * a1) + (a2 * a2 + a3 * a3) + (a4 * a4 + a5 * a5) + (a6 * a6 + a7 * a7); }
        const float rs = valid ? QSCALE / sqrtf(ss * (1.f / 96.f) + EPS) : 0.f;
        unsigned char* dst = trow;
#pragma unroll
        for (int c = 0; c < 8; ++c) {
            const f32x4 g0 = *(const f32x4*)(qn + 8 * c), g1 = *(const f32x4*)(qn + 8 * c + 4);
            *(u32x4*)(dst + 16 * c) = (u32x4){pk2(bflo(w[c].x) * rs * g0.x, bfhi(w[c].x) * rs * g0.y), pk2(bflo(w[c].y) * rs * g0.z, bfhi(w[c].y) * rs * g0.w),
                                              pk2(bflo(w[c].z) * rs * g1.x, bfhi(w[c].z) * rs * g1.y), pk2(bflo(w[c].w) * rs * g1.z, bfhi(w[c].w) * rs * g1.w)};
        }
#pragma unroll
        for (int c = 0; c < 2; ++c) {
            float x1[8], x2[8];
            const u32x4 wa = w[8 + c], wb = w[10 + c];
            x1[0] = bflo(wa.x); x1[1] = bfhi(wa.x); x1[2] = bflo(wa.y); x1[3] = bfhi(wa.y); x1[4] = bflo(wa.z); x1[5] = bfhi(wa.z); x1[6] = bflo(wa.w); x1[7] = bfhi(wa.w);
            x2[0] = bflo(wb.x); x2[1] = bfhi(wb.x); x2[2] = bflo(wb.y); x2[3] = bfhi(wb.y); x2[4] = bflo(wb.z); x2[5] = bfhi(wb.z); x2[6] = bflo(wb.w); x2[7] = bfhi(wb.w);
            float o1[8], o2[8];
#pragma unroll
            for (int t = 0; t < 8; ++t) { float sn_, cs_; rot(8 * c + t, sn_, cs_); const float a = x1[t] * rs * qn[64 + 8 * c + t], b = x2[t] * rs * qn[80 + 8 * c + t]; o1[t] = a * cs_ - b * sn_; o2[t] = b * cs_ + a * sn_; }
            *(u32x4*)(dst + 2 * (64 + 8 * c)) = (u32x4){pk2(o1[0], o1[1]), pk2(o1[2], o1[3]), pk2(o1[4], o1[5]), pk2(o1[6], o1[7])};
            *(u32x4*)(dst + 2 * (80 + 8 * c)) = (u32x4){pk2(o2[0], o2[1]), pk2(o2[2], o2[3]), pk2(o2[4], o2[5]), pk2(o2[6], o2[7])};
        }
        P2_WSYNC();
        {
            unsigned char* outb = (unsigned char*)((bf16_t*)(ws + WS_Q) + ((size_t)h * KVROWS + 64 * blk) * 96);
            u32x4 t[12];
#pragma unroll
            for (int i = 0; i < 12; ++i) { const int c = 64 * i + lane, r = c / 12, pc = c % 12; t[i] = *(const u32x4*)(TS + r * P2_RS + 16 * pc); }
#pragma unroll
            for (int i = 0; i < 12; ++i) *(u32x4*)(outb + (size_t)(64 * i + lane) * 16) = t[i];
            P2_WSYNC();
        }
    }
    {
        {
            const bf16_t* srcb = (const bf16_t*)(ws + WS_KVB) + (size_t)(64 * blk) * 1024 + h * 128;
            const unsigned char* kpb = (const unsigned char*)((const float*)(ws + WS_KPE) + (size_t)(64 * blk) * 32);
            u32x4 t[8], e8[8];
#pragma unroll
            for (int i = 0; i < 8; ++i) { const int c = 64 * i + lane, r = c >> 3, pc = c & 7; t[i] = *(const u32x4*)(srcb + (size_t)r * 1024 + 8 * pc); e8[i] = *(const u32x4*)(kpb + (size_t)c * 16); }
#pragma unroll
            for (int i = 0; i < 8; ++i) { const int c = 64 * i + lane, r = c >> 3, pc = c & 7; *(u32x4*)(TS + r * P2_RS + 16 * pc) = t[i]; *(u32x4*)(TS + r * P2_RS + 128 + 16 * pc) = e8[i]; }
            P2_WSYNC();
        }
        u32x4 w[8]; f32x4 e[8];
#pragma unroll
        for (int c = 0; c < 8; ++c) { w[c] = *(const u32x4*)(trow + 16 * c); e[c] = *(const f32x4*)(trow + 128 + 16 * c); }
        float ss = 0.f;
#pragma unroll
        for (int c = 0; c < 8; ++c) { const float a0 = bflo(w[c].x), a1 = bfhi(w[c].x), a2 = bflo(w[c].y), a3 = bfhi(w[c].y), a4 = bflo(w[c].z), a5 = bfhi(w[c].z), a6 = bflo(w[c].w), a7 = bfhi(w[c].w);
            ss += (a0 * a0 + a1 * a1) + (a2 * a2 + a3 * a3) + (a4 * a4 + a5 * a5) + (a6 * a6 + a7 * a7);
            ss += (e[c].x * e[c].x + e[c].y * e[c].y) + (e[c].z * e[c].z + e[c].w * e[c].w); }
        const float rs = valid ? 1.f / sqrtf(ss * (1.f / 96.f) + EPS) : 0.f;
        unsigned char* dst = trow;
#pragma unroll
        for (int c = 0; c < 8; ++c) {
            const f32x4 g0 = *(const f32x4*)(kn + 8 * c), g1 = *(const f32x4*)(kn + 8 * c + 4);
            *(u32x4*)(dst + 16 * c) = (u32x4){pk2(bflo(w[c].x) * rs * g0.x, bfhi(w[c].x) * rs * g0.y), pk2(bflo(w[c].y) * rs * g0.z, bfhi(w[c].y) * rs * g0.w),
                                              pk2(bflo(w[c].z) * rs * g1.x, bfhi(w[c].z) * rs * g1.y), pk2(bflo(w[c].w) * rs * g1.z, bfhi(w[c].w) * rs * g1.w)};
        }
#pragma unroll
        for (int c = 0; c < 2; ++c) {
            const float x1[8] = {e[2 * c].x, e[2 * c].y, e[2 * c].z, e[2 * c].w, e[2 * c + 1].x, e[2 * c + 1].y, e[2 * c + 1].z, e[2 * c + 1].w};
            const float x2[8] = {e[4 + 2 * c].x, e[4 + 2 * c].y, e[4 + 2 * c].z, e[4 + 2 * c].w, e[5 + 2 * c].x, e[5 + 2 * c].y, e[5 + 2 * c].z, e[5 + 2 * c].w};
            float o1[8], o2[8];
#pragma unroll
            for (int t = 0; t < 8; ++t) { float sn_, cs_; rot(8 * c + t, sn_, cs_); const float a = x1[t] * rs * kn[64 + 8 * c + t], b = x2[t] * rs * kn[80 + 8 * c + t]; o1[t] = a * cs_ - b * sn_; o2[t] = b * cs_ + a * sn_; }
            *(u32x4*)(dst + 2 * (64 + 8 * c)) = (u32x4){pk2(o1[0], o1[1]), pk2(o1[2], o1[3]), pk2(o1[4], o1[5]), pk2(o1[6], o1[7])};
            *(u32x4*)(dst + 2 * (80 + 8 * c)) = (u32x4){pk2(o2[0], o2[1]), pk2(o2[2], o2[3]), pk2(o2[4], o2[5]), pk2(o2[6], o2[7])};
        }
        P2_WSYNC();
        {
            unsigned char* outb = (unsigned char*)((bf16_t*)(ws + WS_K) + ((size_t)h * KVROWS + 64 * blk) * 96);
            u32x4 t[12];
#pragma unroll
            for (int i = 0; i < 12; ++i) { const int c = 64 * i + lane, r = c / 12, pc = c % 12; t[i] = *(const u32x4*)(TS + r * P2_RS + 16 * pc); }
#pragma unroll
            for (int i = 0; i < 12; ++i) *(u32x4*)(outb + (size_t)(64 * i + lane) * 16) = t[i];
            P2_WSYNC();
        }
    }
    {
        unsigned char* T = TS;
        const bf16_t* src = (const bf16_t*)(ws + WS_KVB) + h * 128 + 64;
#pragma unroll
        for (int it = 0; it < 8; ++it) {
            const int pr = 8 * it + (lane >> 3), ch = lane & 7; const int pp = 64 * blk + pr;
            u32x4 v = (u32x4){0u, 0u, 0u, 0u};
            if (pp >= PADL && pp < LPV) v = *(const u32x4*)(src + (size_t)pp * 1024 + 8 * ch);
            unsigned char* tp = T + (8 * ch) * P2_TS + pr * 2;
            *(bf16_t*)(tp + 0 * P2_TS) = (bf16_t)(v.x & 0xffffu); *(bf16_t*)(tp + 1 * P2_TS) = (bf16_t)(v.x >> 16);
            *(bf16_t*)(tp + 2 * P2_TS) = (bf16_t)(v.y & 0xffffu); *(bf16_t*)(tp + 3 * P2_TS) = (bf16_t)(v.y >> 16);
            *(bf16_t*)(tp + 4 * P2_TS) = (bf16_t)(v.z & 0xffffu); *(bf16_t*)(tp + 5 * P2_TS) = (bf16_t)(v.z >> 16);
            *(bf16_t*)(tp + 6 * P2_TS) = (bf16_t)(v.w & 0xffffu); *(bf16_t*)(tp + 7 * P2_TS) = (bf16_t)(v.w >> 16);
        }
        __builtin_amdgcn_s_waitcnt(0); __builtin_amdgcn_wave_barrier();
        bf16_t* VT = (bf16_t*)(ws + WS_VT) + (size_t)h * 64 * KVROWS + 64 * blk;
#pragma unroll
        for (int it = 0; it < 8; ++it) {
            const int e = 8 * it + (lane >> 3), ch = lane & 7;
            const u32x2 lo = *(const u32x2*)(T + e * P2_TS + 16 * ch), hi = *(const u32x2*)(T + e * P2_TS + 16 * ch + 8);
            *(u32x4*)(VT + (size_t)e * KVROWS + 8 * ch) = (u32x4){lo.x, lo.y, hi.x, hi.y};
        }
        __builtin_amdgcn_s_waitcnt(0); __builtin_amdgcn_wave_barrier();
    }
}

constexpr int A_KSTR = 208;
constexpr int A_VSTR = 136;
constexpr int A_KBYTES = 64 * A_KSTR;
constexpr int A_VBYTES = 64 * A_VSTR;
constexpr int A_BUF = A_KBYTES + A_VBYTES;
DI unsigned cvtpk_s(float lo, float hi) { typedef float f2 __attribute__((ext_vector_type(2))); typedef __bf16 b2 __attribute__((ext_vector_type(2))); f2 v = {lo, hi}; b2 b = __builtin_convertvector(v, b2); return __builtin_bit_cast(unsigned, b); }

DI void attn_item(const Frame& F, const Args& A, int h, int qb) {
    unsigned char* ws = A.ws; unsigned char* lds = F.lds;
    const int tid = F.tid, lane = F.lane, wave = F.wave, r32 = lane & 31, hh = lane >> 5;
    const bf16_t* Qg = (const bf16_t*)(ws + WS_Q) + (size_t)h * KVROWS * 96;
    const bf16_t* Kg = (const bf16_t*)(ws + WS_K) + (size_t)h * KVROWS * 96;
    const bf16_t* Vg = (const bf16_t*)(ws + WS_VT) + (size_t)h * 64 * KVROWS;
    const int p0w = 64 + 256 * qb + 32 * wave;
    const int qp = p0w + r32;
    const int ntile = 4 * qb + 5;
    const int mylast = 1 + 4 * qb + (wave >> 1);
    bf16x8 qf[6];
#pragma unroll
    for (int s = 0; s < 6; ++s) qf[s] = *(const bf16x8*)(Qg + (size_t)qp * 96 + 16 * s + 8 * hh);
    f32x16 ot[2]; ot[0] = zero16(); ot[1] = zero16();
    float mrun = -1e30f, lrun = 0.f;
    const int kr0 = tid / 12, kc0 = tid % 12, kr1 = (tid + 512) / 12, kc1 = (tid + 512) % 12; const bool k1ok = tid < 256;
    const int vr = tid >> 3, vc = tid & 7;
    struct Stg { u32x4 k0, k1, v; };
    Stg sA;
    auto gload = [&](Stg& st, int j) {
        const int kv0 = 64 * j;
        st.k0 = *(const u32x4*)(Kg + (size_t)(kv0 + kr0) * 96 + kc0 * 8);
        if (k1ok) st.k1 = *(const u32x4*)(Kg + (size_t)(kv0 + kr1) * 96 + kc1 * 8);
        st.v = *(const u32x4*)(Vg + (size_t)vr * KVROWS + kv0 + vc * 8);
    };
    auto lstore = [&](const Stg& st, int t) {
        unsigned char* kb = lds + (t % 3) * A_BUF; unsigned char* vb = kb + A_KBYTES;
        *(u32x4*)(kb + kr0 * A_KSTR + kc0 * 16) = st.k0;
        if (k1ok) *(u32x4*)(kb + kr1 * A_KSTR + kc1 * 16) = st.k1;
        *(u32x2*)(vb + vr * A_VSTR + vc * 16) = (u32x2){st.v.x, st.v.y};
        *(u32x2*)(vb + vr * A_VSTR + vc * 16 + 8) = (u32x2){st.v.z, st.v.w};
    };
    auto step = [&](auto FIRSTc, auto LASTc, int t, f32x16 (&C)[2], f32x16 (&P)[2]) {
        if (t + 1 < ntile) gload(sA, t + 1);
        constexpr bool has_cur = !decltype(LASTc)::value, has_prev = !decltype(FIRSTc)::value;
        const unsigned char* kb = lds + (t % 3) * A_BUF;
        const unsigned char* vb = lds + ((t + 2) % 3) * A_BUF + A_KBYTES;
        bf16x8 kf[2][6];
        if constexpr (has_cur) {
            const unsigned char* kp = kb + r32 * A_KSTR + hh * 16;
#pragma unroll
            for (int s = 0; s < 6; ++s) kf[0][s] = *(const bf16x8*)(kp + s * 32);
        }
        float ps0 = 0.f, ps1 = 0.f; u32x4 pw[4]; bf16x8 vfr[4][2];
        auto vload = [&](int g) -> bf16x8 {
            const int f = g >> 1, eh = g & 1, kh2 = f >> 1, s2 = f & 1;
            const unsigned char* vp = vb + (32 * eh + r32) * A_VSTR + (32 * kh2 + 16 * s2 + 4 * hh) * 2;
            const u32x2 lo = *(const u32x2*)vp, hi2 = *(const u32x2*)(vp + 16);
            return __builtin_bit_cast(bf16x8, (u32x4){lo.x, lo.y, hi2.x, hi2.y}); };
        __builtin_amdgcn_sched_barrier(0);
#pragma unroll
        for (int i = 0; i < 12; ++i) {
            const int kh = i / 6, sx = i % 6;
            if constexpr (has_cur) { C[kh] = mfma32(kf[kh][sx], qf[sx], sx == 0 ? zero16() : C[kh]); if (i < 6) kf[1][i] = *(const bf16x8*)(kb + (32 + r32) * A_KSTR + hh * 16 + i * 32); }
            if (has_prev && i < 8) {
                const int f = i >> 1, kh2 = f >> 1, b0 = 8 * (f & 1) + 4 * (i & 1);
                const float v0 = P[kh2][b0], v1 = P[kh2][b0 + 1], v2 = P[kh2][b0 + 2], v3 = P[kh2][b0 + 3];
                ps0 += v0 + v1; ps1 += v2 + v3;
                if (i & 1) { pw[f].z = cvtpk_s(v0, v1); pw[f].w = cvtpk_s(v2, v3); asm volatile("" : "+v"(ps0), "+v"(ps1), "+v"(pw[f].z), "+v"(pw[f].w)); }
                else { pw[f].x = cvtpk_s(v0, v1); pw[f].y = cvtpk_s(v2, v3); asm volatile("" : "+v"(ps0), "+v"(ps1), "+v"(pw[f].x), "+v"(pw[f].y)); }
            }
            if (has_prev && i >= 10) {
                const int g0 = i - 10; vfr[g0 >> 1][g0 & 1] = vload(g0);
            }
            __builtin_amdgcn_sched_barrier(0);
        }
        if (has_prev) lrun += ps0 + ps1;
        float mnew = mrun, alpha = 1.f; bool resc = false;
        if constexpr (has_cur) {
            if (t == 0) {
#pragma unroll
                for (int kh = 0; kh < 2; ++kh)
#pragma unroll
                    for (int r = 0; r < 16; ++r) { const int kv = 32 * kh + crow(r, hh); if (kv < PADL) C[kh][r] = -INFINITY; }
            }
            if (t >= mylast) {
#pragma unroll
                for (int kh = 0; kh < 2; ++kh)
#pragma unroll
                    for (int r = 0; r < 16; ++r) { const int kv = 64 * t + 32 * kh + crow(r, hh); if (kv > qp) C[kh][r] = -INFINITY; }
            }
            float mx = C[0][0];
#pragma unroll
            for (int r = 1; r < 16; ++r) mx = fmaxf(mx, C[0][r]);
#pragma unroll
            for (int r = 0; r < 16; ++r) mx = fmaxf(mx, C[1][r]);
            mx = fmaxf(mx, __shfl_xor(mx, 32));
            mnew = fmaxf(mrun, mx);
            alpha = __builtin_amdgcn_exp2f(mrun - mnew);
            resc = __any(mnew > mrun);
        }
        __builtin_amdgcn_sched_barrier(0);
#pragma unroll
        for (int g = 0; g < 8; ++g) {
            const int f = g >> 1, eh = g & 1;
            if constexpr (has_prev) { ot[eh] = mfma32(vfr[f][eh], __builtin_bit_cast(bf16x8, pw[f]), ot[eh]); if (g + 2 < 8) vfr[(g + 2) >> 1][(g + 2) & 1] = vload(g + 2); }
            if constexpr (has_cur) { const int kh = g >> 2, r0 = 4 * (g & 3);
#pragma unroll
                for (int q = 0; q < 4; ++q) C[kh][r0 + q] = __builtin_amdgcn_exp2f(C[kh][r0 + q] - mnew);
                asm volatile("" : "+v"(C[kh][r0]), "+v"(C[kh][r0 + 1]), "+v"(C[kh][r0 + 2]), "+v"(C[kh][r0 + 3])); }
            __builtin_amdgcn_sched_barrier(0);
        }
        if constexpr (has_cur) {
            if (resc) {
#pragma unroll
                for (int eh = 0; eh < 2; ++eh)
#pragma unroll
                    for (int r = 0; r < 16; ++r) ot[eh][r] *= alpha;
            }
            lrun *= alpha; mrun = mnew;
        }
        if (t + 1 < ntile) lstore(sA, t + 1);
        __syncthreads();
    };
    gload(sA, 0); lstore(sA, 0);
    __syncthreads();
    f32x16 scA[2], scB[2];
    scB[0] = zero16(); scB[1] = zero16();
    {
        using TT = std::integral_constant<bool, true>; using FF = std::integral_constant<bool, false>;
        step(TT{}, FF{}, 0, scA, scB);
#pragma unroll 1
        for (int t = 1; t + 1 < ntile; t += 2) {
            step(FF{}, FF{}, t, scB, scA);
            step(FF{}, FF{}, t + 1, scA, scB);
        }
        step(FF{}, TT{}, ntile, scB, scA);
    }
    const float ltot = lrun + __shfl_xor(lrun, 32);
    const float rl = 1.f / ltot;
    bf16_t* o = (bf16_t*)(ws + WS_MIX) + (size_t)(qp - 64) * 1024 + 512 + h * 64;
#pragma unroll
    for (int eh = 0; eh < 2; ++eh)
#pragma unroll
        for (int a = 0; a < 4; ++a) {
            const int e = 32 * eh + 8 * a + 4 * hh;
            *(u32x2*)(o + e) = (u32x2){pk2(ot[eh][4 * a] * rl, ot[eh][4 * a + 1] * rl), pk2(ot[eh][4 * a + 2] * rl, ot[eh][4 * a + 3] * rl)};
        }
}

DI void xn_rows(const Frame& F, const Args& A, int u0, int stride) {
    f32x4 v[2][4];
#pragma unroll
    for (int r = 0; r < 2; ++r) { const int u = u0 + r * stride; if (u < MU) { const f32x4* xr = (const f32x4*)(A.out + (size_t)u * DM) + F.lane;
#pragma unroll
        for (int j = 0; j < 4; ++j) v[r][j] = xr[64 * j]; } }
#pragma unroll
    for (int r = 0; r < 2; ++r) {
        const int u = u0 + r * stride; if (u >= MU) continue;
        float s = 0.f;
#pragma unroll
        for (int j = 0; j < 4; ++j) s += (v[r][j].x * v[r][j].x + v[r][j].y * v[r][j].y) + (v[r][j].z * v[r][j].z + v[r][j].w * v[r][j].w);
        const float rstd = 1.f / sqrtf(wave_sum(s) * (1.f / DM) + EPS);
        unsigned long long* o8 = (unsigned long long*)((bf16_t*)(A.ws + WS_XN) + (size_t)u * DM) + F.lane;
#pragma unroll
        for (int j = 0; j < 4; ++j) { const f32x4 w = ((const f32x4*)A.in[15])[64 * j + F.lane];
            o8[64 * j] = (unsigned long long)pk2(v[r][j].x * rstd * w.x, v[r][j].y * rstd * w.y) | ((unsigned long long)pk2(v[r][j].z * rstd * w.z, v[r][j].w * rstd * w.w) << 32); }
    }
}

DI unsigned fkey(float v, int idx) { unsigned u = __builtin_bit_cast(unsigned, v); u = (u & 0x80000000u) ? ~u : (u | 0x80000000u); return (u & ~127u) | (unsigned)(127 - idx); }
DI float keyval(unsigned k) { unsigned u = k & ~127u; u = (u & 0x80000000u) ? (u & 0x7fffffffu) : ~u; return __builtin_bit_cast(float, u); }

__device__ const unsigned char PAIR_A[50] = {0,0,0,0,0,0,0,0,0,0,0,0,0,0,0,0, 1,1,1,1,1,1,1,1, 2,2,2,2,2, 3,3,3,3, 4,4,4, 5,5, 6,6, 7,7, 8,9,10,11,12,13,14,15};
__device__ const unsigned char PAIR_B[50] = {0,1,2,3,4,5,6,7,8,9,10,11,12,13,14,15, 0,1,2,3,4,5,6,7, 0,1,2,3,4, 0,1,2,3, 0,1,2, 0,1, 0,1, 0,1, 0,0,0,0,0,0,0,0};

DI void ce_desc(unsigned& a, unsigned& b) { const unsigned mx = a > b ? a : b, mn = a > b ? b : a; a = mx; b = mn; }
template <int BASE, int NK> DI void bitonic_sort16_desc(unsigned (&x)[NK]) {
#pragma unroll
    for (int k = 2; k <= 16; k <<= 1)
#pragma unroll
        for (int j = k >> 1; j > 0; j >>= 1)
#pragma unroll
            for (int i = 0; i < 16; ++i) { const int l = i ^ j; if (l > i) { if ((i & k) == 0) ce_desc(x[BASE + i], x[BASE + l]); else ce_desc(x[BASE + l], x[BASE + i]); } }
}
template <int A0, int B0, int NK> DI void merge_top16(unsigned (&x)[NK]) {
#pragma unroll
    for (int i = 0; i < 16; ++i) { const unsigned p = x[A0 + i], q = x[B0 + 15 - i]; x[A0 + i] = p > q ? p : q; }
#pragma unroll
    for (int j = 8; j > 0; j >>= 1)
#pragma unroll
        for (int i = 0; i < 16; ++i) { const int l = i ^ j; if (l > i) ce_desc(x[A0 + i], x[A0 + l]); }
}
template <int NK> DI void top16_of_128(unsigned (&key)[NK]) {
    bitonic_sort16_desc<0, NK>(key); bitonic_sort16_desc<16, NK>(key); bitonic_sort16_desc<32, NK>(key); bitonic_sort16_desc<48, NK>(key);
    bitonic_sort16_desc<64, NK>(key); bitonic_sort16_desc<80, NK>(key); bitonic_sort16_desc<96, NK>(key); bitonic_sort16_desc<112, NK>(key);
    merge_top16<0, 16, NK>(key); merge_top16<32, 48, NK>(key); merge_top16<64, 80, NK>(key); merge_top16<96, 112, NK>(key);
    merge_top16<0, 32, NK>(key); merge_top16<64, 96, NK>(key);
    merge_top16<0, 64, NK>(key);
}

DI void topk_task(const Frame& F, const Args& A, int task) {
    unsigned char* ws = A.ws; const int tid = F.tid;
    const int u = task >> 3, h = task & 7;
    LAS unsigned* sk = (LAS unsigned*)(LAS unsigned char*)F.lds;
    LAS unsigned* pkk = sk + 16384;
    LAS unsigned* stg = sk + 16384;
    const bf16_t* SCb = (const bf16_t*)(ws + WS_SC) + (size_t)(task & ~511) * 256;
#pragma unroll 1
    for (int half = 0; half < 2; ++half) {
        unsigned key[128];
#pragma unroll
        for (int qb = 0; qb < 2; ++qb) {
            u32x4 pf[8];
#pragma unroll
            for (int k = 0; k < 8; ++k) { const int c = tid + 512 * k; pf[k] = *(const u32x4*)(SCb + (size_t)(c >> 3) * 256 + half * 128 + qb * 64 + (c & 7) * 8); }
#pragma unroll
            for (int k = 0; k < 8; ++k) { const int c = tid + 512 * k; *(LAS u32x4*)(stg + (c >> 3) * 36 + (c & 7) * 4) = pf[k]; }
            __syncthreads();
#pragma unroll
            for (int i = 0; i < 8; ++i) { const u32x4 v = *(const LAS u32x4*)(stg + tid * 36 + 4 * i); const int b0 = 64 * qb + 8 * i;
                key[b0] = fkey(bflo(v.x), b0); key[b0 + 1] = fkey(bfhi(v.x), b0 + 1); key[b0 + 2] = fkey(bflo(v.y), b0 + 2); key[b0 + 3] = fkey(bfhi(v.y), b0 + 3);
                key[b0 + 4] = fkey(bflo(v.z), b0 + 4); key[b0 + 5] = fkey(bfhi(v.z), b0 + 5); key[b0 + 6] = fkey(bflo(v.w), b0 + 6); key[b0 + 7] = fkey(bfhi(v.w), b0 + 7); }
            __syncthreads();
        }
        top16_of_128(key);
#pragma unroll
        for (int r = 0; r < 16; ++r) sk[(half * 16 + r) * 512 + tid] = key[r];
    }
    float v1[16], v2[16];
#pragma unroll
    for (int r = 0; r < 16; ++r) { v1[r] = keyval(sk[r * 512 + tid]); v2[r] = keyval(sk[(16 + r) * 512 + tid]); }
    unsigned ck[64];
#pragma unroll
    for (int c = 50; c < 64; ++c) ck[c] = 0u;
#pragma unroll
    for (int a = 0; a < 16; ++a) {
        const int off = a == 0 ? 0 : a == 1 ? 16 : a == 2 ? 24 : a == 3 ? 29 : a == 4 ? 33 : a == 5 ? 36 : a == 6 ? 38 : a == 7 ? 40 : 42 + (a - 8);
#pragma unroll
        for (int b = 0; b < 16; ++b) if ((a + 1) * (b + 1) <= 16) ck[off + b] = fkey(v1[a] + v2[b], off + b);
    }
    bitonic_sort16_desc<0, 64>(ck); bitonic_sort16_desc<16, 64>(ck); bitonic_sort16_desc<32, 64>(ck); bitonic_sort16_desc<48, 64>(ck);
    merge_top16<0, 16, 64>(ck); merge_top16<32, 48, 64>(ck); merge_top16<0, 32, 64>(ck);
#pragma unroll
    for (int r = 0; r < 16; ++r) pkk[r * 512 + tid] = ck[r];
    const float cmax = keyval(pkk[tid]);
    float ev[16]; float esum = 0.f; int ex[16];
#pragma unroll
    for (int r = 0; r < 16; ++r) {
        const unsigned k = pkk[r * 512 + tid]; const int c = 127 - (int)(k & 127u);
        ev[r] = __expf(keyval(k) - cmax); esum += ev[r];
        const int a = PAIR_A[c], b = PAIR_B[c];
        const int i1 = 127 - (int)(sk[a * 512 + tid] & 127u), i2 = 127 - (int)(sk[(16 + b) * 512 + tid] & 127u);
        ex[r] = i1 * 128 + i2;
    }
    const float rs = 1.f / esum;
    int* IDX = (int*)(ws + WS_IDX) + (size_t)u * 128 + h * 16; float* GATE = (float*)(ws + WS_GATE) + (size_t)u * 128 + h * 16;
#pragma unroll
    for (int r = 0; r < 16; r += 4) {
        *(int4*)(IDX + r) = make_int4(ex[r], ex[r + 1], ex[r + 2], ex[r + 3]);
        *(f32x4*)(GATE + r) = (f32x4){ev[r] * rs, ev[r + 1] * rs, ev[r + 2] * rs, ev[r + 3] * rs};
    }
}

constexpr float EU_SCALE = 64.f, EV_SCALE = 16.f;
DI unsigned pk4_fp8(float a, float b, float c, float d) { int w = 0; w = __builtin_amdgcn_cvt_pk_fp8_f32(a, b, w, false); w = __builtin_amdgcn_cvt_pk_fp8_f32(c, d, w, true); return (unsigned)w; }
DI void convert_tables(const Frame& F, const Args& A) {
    const size_t n16 = (size_t)16384 * 1024 / 16;
    const size_t gt = (size_t)blockIdx.x * 512 + F.tid, NGT = (size_t)F.G * 512;
#pragma unroll 1
    for (int t = 0; t < 2; ++t) {
        const float* src = A.in[18 + t]; unsigned char* dst = A.ws + (t ? WS_EV : WS_EU); const float sc = t ? EV_SCALE : EU_SCALE;
        const float* fn = A.in[15];
        for (size_t i = gt; i < n16; i += NGT) {
            f32x4 a = *(const f32x4*)(src + i * 16) * sc, b = *(const f32x4*)(src + i * 16 + 4) * sc, c = *(const f32x4*)(src + i * 16 + 8) * sc, d = *(const f32x4*)(src + i * 16 + 12) * sc;
            if (t == 0) { const float* g = fn + (i & 63) * 16; a *= *(const f32x4*)g; b *= *(const f32x4*)(g + 4); c *= *(const f32x4*)(g + 8); d *= *(const f32x4*)(g + 12); }
            const size_t e_ = i >> 6, c16_ = i & 63;
            *(u32x4*)(dst + (c16_ >> 3) * ((size_t)16384 * 128) + e_ * 128 + (c16_ & 7) * 16) = (u32x4){pk4_fp8(a.x, a.y, a.z, a.w), pk4_fp8(b.x, b.y, b.z, b.w), pk4_fp8(c.x, c.y, c.z, c.w), pk4_fp8(d.x, d.y, d.z, d.w)};
        }
    }
}

DI float gelu_exact(float x) { return 0.5f * x * (1.f + erff(x * 0.70710678118654752f)); }
typedef float f32x2 __attribute__((ext_vector_type(2)));
#define UNPK16(dst, W_) do { f32x2 _t; \
    _t = __builtin_amdgcn_cvt_pk_f32_fp8((int)(W_).x, false); dst[0] = _t.x; dst[1] = _t.y; _t = __builtin_amdgcn_cvt_pk_f32_fp8((int)(W_).x, true); dst[2] = _t.x; dst[3] = _t.y; \
    _t = __builtin_amdgcn_cvt_pk_f32_fp8((int)(W_).y, false); dst[4] = _t.x; dst[5] = _t.y; _t = __builtin_amdgcn_cvt_pk_f32_fp8((int)(W_).y, true); dst[6] = _t.x; dst[7] = _t.y; \
    _t = __builtin_amdgcn_cvt_pk_f32_fp8((int)(W_).z, false); dst[8] = _t.x; dst[9] = _t.y; _t = __builtin_amdgcn_cvt_pk_f32_fp8((int)(W_).z, true); dst[10] = _t.x; dst[11] = _t.y; \
    _t = __builtin_amdgcn_cvt_pk_f32_fp8((int)(W_).w, false); dst[12] = _t.x; dst[13] = _t.y; _t = __builtin_amdgcn_cvt_pk_f32_fp8((int)(W_).w, true); dst[14] = _t.x; dst[15] = _t.y; } while (0)

template <bool UPH>
DI void expert_phase(const Frame& F, const Args& A, int xv, int wq, int nw) {
    unsigned char* ws = A.ws; const int lane = F.lane, grp = lane >> 3, j = lane & 7;
    const unsigned char* TBL = ws + (UPH ? WS_EU : WS_EV) + (size_t)xv * ((size_t)16384 * 128) + 16 * j;
    const int* IDX = (const int*)(ws + WS_IDX); const float* CW = (const float*)(ws + WS_CW);
    const bf16_t* XN = (const bf16_t*)(ws + WS_XN) + 128 * xv + 16 * j;
    float* HP = (float*)(ws + WS_HP);
    LAS unsigned* ring = (LAS unsigned*)((LAS unsigned char*)F.lds + F.wave * 4096);
    const int nt = (MU - wq + nw - 1) / nw;
    if (nt <= 0) return;
    auto tok = [&](int k) { return __builtin_amdgcn_readfirstlane(wq + (k < nt ? k : nt - 1) * nw); };
    int mi0, mi1; u32x4 mx0, mx1; float mh0, mh1;
    auto meta_load = [&](int k) {
        const int u = tok(k);
        mi0 = IDX[(size_t)u * 128 + lane]; mi1 = IDX[(size_t)u * 128 + 64 + lane];
        if constexpr (UPH) { mx0 = *(const u32x4*)(XN + (size_t)u * DM); mx1 = *(const u32x4*)(XN + (size_t)u * DM + 8); }
        else { mh0 = CW[(size_t)u * 128 + lane]; mh1 = CW[(size_t)u * 128 + 64 + lane]; }
    };
    auto meta_store = [&](int k) {
        LAS unsigned* sl = ring + (k & 3) * 256;
        sl[lane] = (unsigned)mi0; sl[64 + lane] = (unsigned)mi1;
        if constexpr (UPH) { if (grp == 0) { *(LAS u32x4*)(sl + 128 + 8 * j) = mx0; *(LAS u32x4*)(sl + 128 + 8 * j + 4) = mx1; } }
        else { sl[128 + lane] = __builtin_bit_cast(unsigned, mh0); sl[192 + lane] = __builtin_bit_cast(unsigned, mh1); }
    };
    auto gather = [&](u32x4 (&buf)[8], int n) {
        const LAS unsigned* sl = ring + ((n >> 1) & 3) * 256 + 64 * (n & 1) + grp;
#pragma unroll
        for (int i = 0; i < 8; ++i) { const int e = (int)sl[8 * i]; buf[i] = *(const u32x4*)(TBL + (size_t)e * 128); }
    };
    const int ocol = 128 * xv + 16 * j + ((lane & 32) ? 8 : 0) + ((lane & 16) ? 4 : 0) + ((lane & 8) ? 2 : 0);
    f32x2 ocur = (f32x2){0.f, 0.f};
    float acc[16];
    float xn[16];
    auto compute = [&](u32x4 (&buf)[8], int n) {
        const int k = n >> 1, hf = n & 1;
        const LAS unsigned* sl = ring + (k & 3) * 256;
        if (hf == 0) {
            if constexpr (UPH) {
                const u32x4 x0 = *(const LAS u32x4*)(sl + 128 + 8 * j), x1 = *(const LAS u32x4*)(sl + 128 + 8 * j + 4);
                xn[0] = bflo(x0.x); xn[1] = bfhi(x0.x); xn[2] = bflo(x0.y); xn[3] = bfhi(x0.y); xn[4] = bflo(x0.z); xn[5] = bfhi(x0.z); xn[6] = bflo(x0.w); xn[7] = bfhi(x0.w);
                xn[8] = bflo(x1.x); xn[9] = bfhi(x1.x); xn[10] = bflo(x1.y); xn[11] = bfhi(x1.y); xn[12] = bflo(x1.z); xn[13] = bfhi(x1.z); xn[14] = bflo(x1.w); xn[15] = bfhi(x1.w);
            } else {
#pragma unroll
                for (int c = 0; c < 16; ++c) acc[c] = 0.f;
                ocur = *(const f32x2*)(A.out + (size_t)tok(k) * DM + ocol);
            }
        }
#pragma unroll
        for (int i = 0; i < 8; ++i) {
            float f[16]; UNPK16(f, buf[i]);
            if constexpr (UPH) {
                float a0 = 0.f, a1 = 0.f;
#pragma unroll
                for (int c = 0; c < 16; c += 2) { a0 += f[c] * xn[c]; a1 += f[c + 1] * xn[c + 1]; }
                if (hf == 0) acc[i] = a0 + a1; else acc[8 + i] = a0 + a1;
                if (i < 7) { if (hf == 0) asm volatile("" : "+v"(buf[i + 1].x), "+v"(buf[i + 1].y), "+v"(buf[i + 1].z), "+v"(buf[i + 1].w), "+v"(acc[i]));
                             else asm volatile("" : "+v"(buf[i + 1].x), "+v"(buf[i + 1].y), "+v"(buf[i + 1].z), "+v"(buf[i + 1].w), "+v"(acc[8 + i])); }
            } else {
                const float cw = __builtin_bit_cast(float, sl[128 + 64 * hf + 8 * i + grp]);
#pragma unroll
                for (int c = 0; c < 16; ++c) acc[c] += cw * f[c];
                if (i < 7) asm volatile("" : "+v"(buf[i + 1].x), "+v"(buf[i + 1].y), "+v"(buf[i + 1].z), "+v"(buf[i + 1].w),
                                             "+v"(acc[0]), "+v"(acc[1]), "+v"(acc[2]), "+v"(acc[3]), "+v"(acc[4]), "+v"(acc[5]), "+v"(acc[6]), "+v"(acc[7]),
                                             "+v"(acc[8]), "+v"(acc[9]), "+v"(acc[10]), "+v"(acc[11]), "+v"(acc[12]), "+v"(acc[13]), "+v"(acc[14]), "+v"(acc[15]));
            }
            __builtin_amdgcn_sched_barrier(0);
        }
        if (hf == 1 && k < nt) {
            const int u = tok(k);
            float r8[8], r4[4], r2[2];
            if constexpr (UPH) {
                { const bool up = lane & 4;
#pragma unroll
                  for (int i = 0; i < 8; ++i) { const float send = up ? acc[i] : acc[i + 8], keep = up ? acc[i + 8] : acc[i]; r8[i] = keep + __shfl_xor(send, 4); } }
                { const bool up = lane & 2;
#pragma unroll
                  for (int i = 0; i < 4; ++i) { const float send = up ? r8[i] : r8[i + 4], keep = up ? r8[i + 4] : r8[i]; r4[i] = keep + __shfl_xor(send, 2); } }
                { const bool up = lane & 1;
#pragma unroll
                  for (int i = 0; i < 2; ++i) { const float send = up ? r4[i] : r4[i + 2], keep = up ? r4[i + 2] : r4[i]; r2[i] = keep + __shfl_xor(send, 1); } }
                const int st = ((lane & 4) ? 8 : 0) + ((lane & 2) ? 4 : 0) + ((lane & 1) ? 2 : 0);
                float* hp = HP + ((size_t)xv * MU + u) * 128 + grp;
                hp[8 * st] = r2[0]; hp[8 * (st + 1)] = r2[1];
            } else {
                { const bool up = lane & 32;
#pragma unroll
                  for (int c = 0; c < 8; ++c) { const float send = up ? acc[c] : acc[c + 8], keep = up ? acc[c + 8] : acc[c]; r8[c] = keep + __shfl_xor(send, 32); } }
                { const bool up = lane & 16;
#pragma unroll
                  for (int c = 0; c < 4; ++c) { const float send = up ? r8[c] : r8[c + 4], keep = up ? r8[c + 4] : r8[c]; r4[c] = keep + __shfl_xor(send, 16); } }
                { const bool up = lane & 8;
#pragma unroll
                  for (int c = 0; c < 2; ++c) { const float send = up ? r4[c] : r4[c + 2], keep = up ? r4[c + 2] : r4[c]; r2[c] = keep + __shfl_xor(send, 8); } }
                f32x2* o = (f32x2*)(A.out + (size_t)u * DM + ocol);
                f32x2 cur = ocur; cur.x += r2[0]; cur.y += r2[1]; *o = cur;
            }
        }
    };
    meta_load(0); meta_store(0); meta_load(1); meta_store(1); meta_load(2); meta_store(2);
    u32x4 b0[8], b1[8], b2[8];
    gather(b0, 0); gather(b1, 1); gather(b2, 2);
#pragma unroll 1
    for (int k0 = 0; k0 < nt; k0 += 3) {
        const int n0 = 2 * k0;
        meta_load(k0 + 3);
        compute(b0, n0);     gather(b0, n0 + 3);
        compute(b1, n0 + 1); meta_store(k0 + 3); gather(b1, n0 + 4);
        meta_load(k0 + 4);
        compute(b2, n0 + 2); gather(b2, n0 + 5);
        compute(b0, n0 + 3); meta_store(k0 + 4); gather(b0, n0 + 6);
        meta_load(k0 + 5);
        compute(b1, n0 + 4); gather(b1, n0 + 7);
        compute(b2, n0 + 5); meta_store(k0 + 5); gather(b2, n0 + 8);
    }
}


DI void expert_c_pass(const Frame& F, const Args& A) {
    unsigned char* ws = A.ws;
    const float* HP = (const float*)(ws + WS_HP); const float* GATE = (const float*)(ws + WS_GATE); float* CW = (float*)(ws + WS_CW);
    const size_t n4 = (size_t)MU * 128 / 4;
    for (size_t i = (size_t)blockIdx.x * 512 + F.tid; i < n4; i += (size_t)F.G * 512) {
        f32x4 h = *(const f32x4*)(HP + i * 4);
#pragma unroll
        for (int x = 1; x < 8; ++x) h += *(const f32x4*)(HP + (size_t)x * MU * 128 + i * 4);
        const f32x4 g = *(const f32x4*)(GATE + i * 4);
        const float rs = (1.f / EU_SCALE) / sqrtf(ss_sum16((const float*)(ws + WS_SS4), (int)(i >> 5)) * (1.f / DM) + EPS);
        f32x4 c;
        c.x = gelu_exact(h.x * rs) * g.x * (1.f / EV_SCALE); c.y = gelu_exact(h.y * rs) * g.y * (1.f / EV_SCALE);
        c.z = gelu_exact(h.z * rs) * g.z * (1.f / EV_SCALE); c.w = gelu_exact(h.w * rs) * g.w * (1.f / EV_SCALE);
        *(f32x4*)(CW + i * 4) = c;
    }
}
template <int PH> DI void run_phase(const Frame& F, const Args& args, PG8_LAS unsigned char* lds3) {
    unsigned char* ws = args.ws;
    if constexpr (PH == 0) { p0_prologue(F, args); p0_late_weights<0>(F, args, (7 - F.wave) * F.G + blockIdx.x, F.NGW, blockIdx.x * 512 + F.tid, F.G * 512); }
    if constexpr (PH == 1) {
        pg8::Gemm g{(const bf16_t*)(ws + WS_HN), (const bf16_t*)(ws + WS_WIN), MP, NPROJ, 1024, 1024, 1024, 0};
        pg8::StaticOrder S; S.init(MP, NPROJ, F.G, (int)blockIdx.x);
        EpiProj E{(bf16_t*)(ws + WS_QKVR), (bf16_t*)(ws + WS_Z), (float*)(ws + WS_P32), (bf16_t*)(ws + WS_CQN), (bf16_t*)(ws + WS_CKVN), (float*)(ws + WS_KPE), (float*)(ws + WS_SSQ), (float*)(ws + WS_SSK)};
        pg8::gemm_phase<EpiProj, pg8::StaticOrder, true, true>(lds3, g, S, E);
    }
    if constexpr (PH == 2) { gdn_prep_phase<0>(F, args); }
    if constexpr (PH == 3) {
        { pg8::Gemm g{(const bf16_t*)(ws + WS_CQN), (const bf16_t*)(ws + WS_WUQ), MP, 768, 256, 256, 256, 0};
          pg8::StaticOrder S; S.init(MP, 768, F.G, (int)blockIdx.x); EpiB16 E{(bf16_t*)(ws + WS_QH), 768, (const float*)(ws + WS_SSQ), 1.f / 256.f, 4};
          pg8::gemm_phase<EpiB16, pg8::StaticOrder, true, true>(lds3, g, S, E); }
        { pg8::Gemm g{(const bf16_t*)(ws + WS_CKVN), (const bf16_t*)(ws + WS_WUKV), MP, 1024, 256, 256, 256, 0};
          pg8::StaticOrder S; S.init(MP, 1024, F.G, (int)blockIdx.x); EpiB16 E{(bf16_t*)(ws + WS_KVB), 1024, (const float*)(ws + WS_SSK), 1.f / 128.f, 4};
          pg8::gemm_phase<EpiB16, pg8::StaticOrder, true, true>(lds3, g, S, E); }
    }
    if constexpr (PH == 4) { for (int t = F.gw; t < (KVROWS / 64) * 8; t += F.NGW) mla_prep2_task(F, args, t); }
    if constexpr (PH == 5) {
        gdn_scan(F, args);
        volatile LAS unsigned* MISC = (volatile LAS unsigned*)(lds3 + MISC_OFF);
        unsigned* qhead = (unsigned*)(ws + WS_CTL) + CW_ATTQ;
        for (;;) {
            __syncthreads();
            if (F.tid == 0) MISC[24] = xb_add(qhead, 1u);
            __syncthreads();
            const int k = (int)MISC[24];
            if (k >= 512) break;
            attn_item(F, args, k & 7, 63 - (k >> 3));
        }
        p0_late_weights<1>(F, args, F.gw, F.NGW, blockIdx.x * 512 + F.tid, F.G * 512);
    }
    if constexpr (PH == 6) { for (int t = F.gw; t < 2048 * 2; t += F.NGW) gdn_out_task(F, args, t); }
    if constexpr (PH == 7) {
        pg8::Gemm g{(const bf16_t*)(ws + WS_MIX), (const bf16_t*)(ws + WS_WOUT), MU, 1024, 1024, 1024, 1024, 0};
        pg8::StaticOrder S; S.init(MU, 1024, F.G, (int)blockIdx.x); EpiH1 E{args.out, args.in[0], (bf16_t*)(ws + WS_XN), (float*)(ws + WS_SS4)};
        pg8::gemm_phase<EpiH1, pg8::StaticOrder, true, true>(lds3, g, S, E);
    }
    if constexpr (PH == 8) {
        pg8::Gemm g{(const bf16_t*)(ws + WS_XN), (const bf16_t*)(ws + WS_WPQ), MU, 2048, 1024, 1024, 1024, 0};
        pg8::StaticOrder S; S.init(MU, 2048, F.G, (int)blockIdx.x); EpiB16 E{(bf16_t*)(ws + WS_PQ), 2048, (const float*)(ws + WS_SS4), 1.f / 1024.f, 16};
        pg8::gemm_phase<EpiB16, pg8::StaticOrder, true, true>(lds3, g, S, E);
        __threadfence_block(); __syncthreads();
    }
    if constexpr (PH == 8) {
        pg8::Gemm g{(const bf16_t*)(ws + WS_PQ), (const bf16_t*)(ws + WS_SKB), MU, 2048, 256, 2048, 256, 256};
        pg8::StaticOrder S; S.init(MU, 2048, F.G, (int)blockIdx.x); EpiB16 E{(bf16_t*)(ws + WS_SC), 2048, nullptr, 0.f, 0};
        pg8::gemm_phase<EpiB16, pg8::StaticOrder, true, true>(lds3, g, S, E);
    }
    if constexpr (PH == 9) {
        convert_tables(F, args);
        for (int t = blockIdx.x * 512 + F.tid; t < MU * 8; t += F.G * 512) topk_task(F, args, t);
    }
    if constexpr (PH == 11) { expert_c_pass(F, args); }
    if constexpr (PH == 10 || PH == 12) {
        volatile LAS unsigned* MISC = (volatile LAS unsigned*)(lds3 + MISC_OFF);
        const unsigned x = MISC[16], rank = MISC[17];
        unsigned* bar = (unsigned*)(ws + WS_CTL);
        unsigned nloc = 0, nx = 0, myidx = 0;
#pragma unroll
        for (unsigned j = 0; j < 16; ++j) { const unsigned c = xb_ld(&bar[XB_XCNT(j)]); nx += (c > 0u) ? 1u : 0u; myidx += (c > 0u && j < x) ? 1u : 0u; nloc = (j == x) ? c : nloc; }
        const int wq = __builtin_amdgcn_readfirstlane((int)rank * 8 + F.wave), nw = __builtin_amdgcn_readfirstlane((int)nloc * 8);
        const int xstep = __builtin_amdgcn_readfirstlane((int)nx);
        for (int xv = __builtin_amdgcn_readfirstlane((int)myidx); xv < 8; xv += xstep)
            { if constexpr (PH == 10) expert_phase<true>(F, args, xv, wq, nw); else expert_phase<false>(F, args, xv, wq, nw); }
    }
}
constexpr int NPHASE = 13;
__global__ void __launch_bounds__(512, 2) fwd_kernel(Args args) {
    extern __shared__ __attribute__((aligned(16))) unsigned char lds[];
    Frame F;
    F.lds = lds; F.tid = threadIdx.x; F.lane = F.tid & 63; F.wave = __builtin_amdgcn_readfirstlane(F.tid >> 6);
    F.G = gridDim.x; F.gw = blockIdx.x * 8 + F.wave; F.NGW = F.G * 8;
    volatile LAS unsigned* MISC = (volatile LAS unsigned*)((LAS unsigned char*)lds + MISC_OFF);
    if (F.tid < 32) MISC[F.tid] = 0u;
    __syncthreads();
    unsigned char* ws = args.ws;
    const int lo = args.ph_lo, hi = args.ph_hi;
    XcdBarrier bar; bar.bar = (unsigned*)(ws + WS_CTL); bar.x = 0; bar.st = nullptr;
    if (hi - lo > 1) bar = xcd_barrier_post((unsigned*)(ws + WS_CTL), MISC + 8);
    if (F.tid == 0) { const unsigned x = xb_xcc_id(); MISC[16] = x; MISC[17] = xb_add((unsigned*)(ws + WS_CTL) + 3520 + 64 * x, 1u); }
    __syncthreads();
#define IN(k) (lo <= (k) && (k) < hi)
#define SEAM(k) do { if (IN(k) && IN((k) + 1)) xcd_barrier(bar); } while (0)
    PG8_LAS unsigned char* lds3 = (PG8_LAS unsigned char*)lds;

#ifndef PROBE_REPEAT
#define PROBE_REPEAT -1
#endif
#ifndef PROBE_TIME
#define PROBE_TIME -1
#endif
#ifndef PROBE_TSEL
#define PROBE_TSEL 0
#endif
    unsigned long long pt_ticks = 0ull;
#define PHASE(k) do { unsigned long long pt0_ = 0ull; if (PROBE_TIME == (k)) pt0_ = __builtin_amdgcn_s_memrealtime(); \
        if (IN(k)) { run_phase<k>(F, args, lds3); if (PROBE_REPEAT == (k)) { xcd_barrier(bar); run_phase<(k)>(F, args, lds3); } } \
        if (PROBE_TIME == (k) && PROBE_TSEL == 1) pt_ticks = __builtin_amdgcn_s_memrealtime() - pt0_;     \
        if (PROBE_TIME == (k) && PROBE_TSEL == 2) pt0_ = __builtin_amdgcn_s_memrealtime();                \
        SEAM(k); \
        if (PROBE_TIME == (k) && PROBE_TSEL != 1) pt_ticks = __builtin_amdgcn_s_memrealtime() - pt0_; } while (0)
    PHASE(0); PHASE(1); PHASE(2); PHASE(3); PHASE(4); PHASE(5); PHASE(6); PHASE(7); PHASE(8); PHASE(9); PHASE(10); PHASE(11); PHASE(12);
#undef PHASE
    if (PROBE_STAGE >= 0) { __syncthreads(); pt_ticks = *(volatile unsigned long long*)(lds + 143360 + 96); }
    if (PROBE_TIME >= 0 || PROBE_STAGE >= 0) { const unsigned long long t0_ = __builtin_amdgcn_s_memrealtime(); while (__builtin_amdgcn_s_memrealtime() - t0_ < 4ull * pt_ticks) __builtin_amdgcn_s_sleep(32); }
#undef IN
#undef SEAM
}

#ifndef N_LAUNCHES
#define N_LAUNCHES 1
#endif
extern "C" void kernel_launch(void* const* d_in, const int* in_sizes, int n_in, void* d_out, int out_size, void* d_ws, size_t ws_size, hipStream_t stream) {
    static int grid = 0;
    if (grid == 0) {
        if (n_in != 20 || out_size != MU * DM || ws_size < WS_END) { fprintf(stderr, "kernel_launch: unexpected shapes (n_in %d out %d ws %zu)\n", n_in, out_size, ws_size); grid = -1; return; }
        int dev = 0, cus = 0, per_cu = 0;
        if (hipGetDevice(&dev) != hipSuccess || hipDeviceGetAttribute(&cus, hipDeviceAttributeMultiprocessorCount, dev) != hipSuccess) { grid = -1; return; }
        if (hipFuncSetAttribute((const void*)fwd_kernel, hipFuncAttributeMaxDynamicSharedMemorySize, LDS_BYTES) != hipSuccess) { fprintf(stderr, "kernel_launch: hipFuncSetAttribute failed\n"); grid = -1; return; }
        if (hipOccupancyMaxActiveBlocksPerMultiprocessor(&per_cu, (const void*)fwd_kernel, 512, LDS_BYTES) != hipSuccess || per_cu < 1) { fprintf(stderr, "kernel_launch: occupancy query says %d\n", per_cu); (void)hipGetLastError(); per_cu = 1; }
        grid = cus;
    }
    if (grid < 0) return;
    (void)hipMemsetAsync((char*)d_ws + WS_CTL, 0, CTL_ZERO_BYTES, stream);
    Args a{};
    for (int i = 0; i < 20; ++i) a.in[i] = (const float*)d_in[i];
    a.out = (float*)d_out; a.ws = (unsigned char*)d_ws;
    for (int li = 0; li < N_LAUNCHES; ++li) {
        a.ph_lo = li * NPHASE / N_LAUNCHES; a.ph_hi = (li + 1) * NPHASE / N_LAUNCHES;
        if (N_LAUNCHES == 1) {
            void* kargs[] = {&a};
            hipError_t e = hipLaunchCooperativeKernel((const void*)fwd_kernel, dim3(grid), dim3(512), kargs, LDS_BYTES, stream);
            if (e != hipSuccess) fprintf(stderr, "cooperative launch failed: %s (grid %d)\n", hipGetErrorString(e), grid);
        } else {
            hipLaunchKernelGGL(fwd_kernel, dim3(grid), dim3(512), LDS_BYTES, stream, a);
        }
    }
}
```

```cpp
#include <hip/hip_runtime.h>
#include <hip/hip_bf16.h>
#include <cstdio>
#include <cstdint>
#include <type_traits>

#define DI __device__ __forceinline__
#define LAS __attribute__((address_space(3)))
#define GAS __attribute__((address_space(1)))

typedef unsigned short bf16_t;
typedef short bf16x8 __attribute__((ext_vector_type(8)));
typedef short s16x4 __attribute__((ext_vector_type(4)));
typedef float f32x4 __attribute__((ext_vector_type(4)));
typedef float f32x16 __attribute__((ext_vector_type(16)));
typedef unsigned u32x4 __attribute__((ext_vector_type(4)));
typedef unsigned u32x2 __attribute__((ext_vector_type(2)));

namespace pg8 {
#define PG8_LAS __attribute__((address_space(3)))
constexpr int BM = 256, BK = 64, HALF = 128, HTB = HALF * BK * 2  , STAGE_BYTES = 8 * HTB, NXCD = 8, WGM = 8;

__host__ __device__ __forceinline__ int lds_byte(int r, int c) { const int st = (r >> 4) * 2 + (c >> 5), rr = r & 15, cc = c & 31, ob = rr * 64 + cc * 2; return st * 1024 + (ob ^ (((ob >> 9) & 1) << 5)); }
__host__ __device__ __forceinline__ void stage_rc(int b, int& R, int& C) { const int st = b / 1024, sb = b % 1024, swz = sb ^ (((sb >> 9) & 1) << 5); R = (st >> 1) * 16 + swz / 64; C = (st & 1) * 32 + (swz % 64) / 2; }
__host__ __device__ __forceinline__ int perm32(int rho) { const int n = rho >> 4, i = rho & 15; return 8 * (i >> 2) + 4 * n + (i & 3); }

struct Unit { int pm, pn; };
struct Gemm { const bf16_t* A; const bf16_t* Bt; int M, N, K, lda, ldb, a_pn_off; };

struct StaticOrder {
    int nM, nN, nwg, G, c;
    __host__ __device__ void init(int M, int N, int G_, int c_) { nM = M / BM; nN = N / BM; nwg = nM * nN; G = G_; c = c_; }
    __host__ __device__ bool next(int i, Unit& u) const {
        const long L = (long)i * G + c; if (L >= nwg) return false;
        int wgid = (int)L; { const int q = nwg / NXCD, r = nwg % NXCD, xcd = wgid % NXCD, off = wgid / NXCD; wgid = (xcd < r ? xcd * (q + 1) : r * (q + 1) + (xcd - r) * q) + off; }
        const int nig = WGM * nN, gid = wgid / nig, fm = gid * WGM, gsz = (nM - fm) < WGM ? (nM - fm) : WGM;
        u.pm = fm + ((wgid % nig) % gsz); u.pn = (wgid % nig) / gsz; return true;
    }
    __device__ __forceinline__ void a_ready(const Unit&) const {}
    __device__ __forceinline__ void done(const Unit&) const {}
};

__device__ __forceinline__ unsigned cvt_pk_bf16(float lo, float hi) { unsigned r; asm volatile("v_cvt_pk_bf16_f32 %0, %1, %2" : "=v"(r) : "v"(lo), "v"(hi)); return r; }

template <class Epi, class Sched, bool ALIGN_EPI = false, bool SP2 = false>
__device__ __forceinline__ void gemm_phase(PG8_LAS unsigned char* lds, const Gemm g, const Sched& S, const Epi& E) {
    const int tid = threadIdx.x, wid = __builtin_amdgcn_readfirstlane(tid >> 6), lane = tid & 63, wr = wid >> 2, wc = wid & 3, fr = lane & 15, fq = lane >> 4;
    const int K = g.K, nt = K / BK;
    unsigned voffA[2], voffB[2];
#pragma unroll
    for (int i = 0; i < 2; ++i) { int R, C; stage_rc(tid * 16 + i * 8192, R, C); const int Rb = Epi::PERM ? ((R & ~31) + perm32(R & 31)) : R;
        voffA[i] = (unsigned)(R * g.lda + C) * 2u; voffB[i] = (unsigned)(Rb * g.ldb + C) * 2u; }
    const size_t kstep = (size_t)(BK * 2);
    const size_t hstepA = (size_t)HALF * g.lda * 2, hstepB = (size_t)HALF * g.ldb * 2;
    const size_t tstepA = 2 * hstepA, tstepB = 2 * hstepB;
    const size_t pnoffA = (size_t)g.a_pn_off * 2;
    const unsigned ldsw = (unsigned)wid * 1024u;
    const int aoff = lds_byte(wr * 64 + fr, fq * 8), boff = lds_byte(wc * 32 + fr, fq * 8);
#define PG8_SA(b, h) (((b) * 2 + (h)) * HTB)
#define PG8_SB(b, h) ((4 + (b) * 2 + (h)) * HTB)
#define PG8_STAGE(bufoff, gbase, voff) do { _Pragma("unroll") for (int _i = 0; _i < 2; ++_i) \
        __builtin_amdgcn_global_load_lds((const unsigned*)((const char*)(gbase) + (voff)[_i]), (PG8_LAS unsigned*)(lds + (bufoff) + ldsw + _i * 8192), 16, 0, 0); } while (0)
#define PG8_LDA(dst, b, h) do { _Pragma("unroll") for (int m = 0; m < 4; ++m) _Pragma("unroll") for (int k = 0; k < 2; ++k) dst[m][k] = *(const PG8_LAS bf16x8*)(lds + PG8_SA(b, h) + aoff + m * 2048 + k * 1024); } while (0)
#define PG8_LDB(dst, b, h) do { _Pragma("unroll") for (int n = 0; n < 2; ++n) _Pragma("unroll") for (int k = 0; k < 2; ++k) dst[n][k] = *(const PG8_LAS bf16x8*)(lds + PG8_SB(b, h) + boff + n * 2048 + k * 1024); } while (0)
#define PG8_MMA(ai, bj, At, Bt) do { __builtin_amdgcn_s_setprio(1); _Pragma("unroll") for (int m = 0; m < 4; ++m) _Pragma("unroll") for (int n = 0; n < 2; ++n) _Pragma("unroll") for (int k = 0; k < 2; ++k) \
        acc[ai][bj][m][n] = __builtin_amdgcn_mfma_f32_16x16x32_bf16(Bt[n][k], At[m][k], acc[ai][bj][m][n], 0, 0, 0); __builtin_amdgcn_s_setprio(0); } while (0)
#define PG8_WAIT_V(n) asm volatile("s_waitcnt vmcnt(" #n ")" ::: "memory")
#define PG8_WAIT_L(n) asm volatile("s_waitcnt lgkmcnt(" #n ")" ::: "memory")
#define PG8_BAR __builtin_amdgcn_s_barrier()
#define PG8_SCHED __builtin_amdgcn_sched_barrier(0)
    Unit cur, nxt; int ui = 0;
    if (!S.next(0, cur)) return;
    f32x4 acc[2][2][4][2];
#pragma unroll
    for (int a = 0; a < 2; ++a)
#pragma unroll
        for (int b = 0; b < 2; ++b)
#pragma unroll
            for (int m = 0; m < 4; ++m)
#pragma unroll
                for (int n = 0; n < 2; ++n) acc[a][b][m][n] = (f32x4){0.f, 0.f, 0.f, 0.f};
    bf16x8 At[4][2], B0[2][2], B1[2][2];
    const char* cA = (const char*)g.A + (size_t)cur.pm * tstepA + (size_t)cur.pn * pnoffA; const char* cB = (const char*)g.Bt + (size_t)cur.pn * tstepB;
    S.a_ready(cur);
    if constexpr (SP2) {
        PG8_STAGE(PG8_SB(0, 0), cB, voffB); PG8_STAGE(PG8_SB(0, 1), cB + hstepB, voffB); PG8_STAGE(PG8_SA(0, 0), cA, voffA); PG8_STAGE(PG8_SA(0, 1), cA + hstepA, voffA);
        if (wr == 1) PG8_BAR;
        PG8_WAIT_V(2); PG8_BAR;
        PG8_STAGE(PG8_SB(1, 0), cB + kstep, voffB); PG8_STAGE(PG8_SA(1, 0), cA + kstep, voffA); PG8_STAGE(PG8_SB(1, 1), cB + hstepB + kstep, voffB);
        PG8_WAIT_V(6); PG8_BAR;
    } else {
        PG8_STAGE(PG8_SB(0, 0), cB, voffB); PG8_STAGE(PG8_SA(0, 0), cA, voffA); PG8_STAGE(PG8_SB(0, 1), cB + hstepB, voffB); PG8_STAGE(PG8_SA(0, 1), cA + hstepA, voffA);
        if (wr == 1) PG8_BAR;
        PG8_WAIT_V(4); PG8_BAR;
        PG8_STAGE(PG8_SB(1, 0), cB + kstep, voffB); PG8_STAGE(PG8_SA(1, 0), cA + kstep, voffA); PG8_STAGE(PG8_SB(1, 1), cB + hstepB + kstep, voffB);
        PG8_WAIT_V(6); PG8_BAR;
    }
    for (;;) {
        const bool has_next = S.next(ui + 1, nxt);
        const char* nA = has_next ? (const char*)g.A + (size_t)nxt.pm * tstepA + (size_t)nxt.pn * pnoffA : cA; const char* nB = has_next ? (const char*)g.Bt + (size_t)nxt.pn * tstepB : cB;
        for (int t = 0; t < nt; t += 2) {
            const bool last = (t == nt - 2);
            const char* a1 = cA + (size_t)(t + 1) * kstep;
            const char* a2 = last ? nA : cA + (size_t)(t + 2) * kstep; const char* b2 = last ? nB : cB + (size_t)(t + 2) * kstep;
            const char* a3 = a2 + kstep; const char* b3 = b2 + kstep;
            if (last && has_next) S.a_ready(nxt);
            if constexpr (SP2) {
            PG8_LDB(B0, 0, 0); PG8_LDB(B1, 0, 1); PG8_SCHED; PG8_LDA(At, 0, 0); PG8_STAGE(PG8_SA(1, 1), a1 + hstepA, voffA);
            PG8_WAIT_V(8); PG8_WAIT_L(0); PG8_BAR; PG8_MMA(0, 0, At, B0); PG8_MMA(0, 1, At, B1); PG8_BAR; PG8_SCHED;
            PG8_LDA(At, 0, 1); PG8_STAGE(PG8_SB(0, 0), b2, voffB); PG8_STAGE(PG8_SB(0, 1), b2 + hstepB, voffB); PG8_STAGE(PG8_SA(0, 0), a2, voffA);
            PG8_WAIT_V(8); PG8_WAIT_L(0); PG8_BAR; PG8_MMA(1, 0, At, B0); PG8_MMA(1, 1, At, B1); PG8_BAR; PG8_SCHED;
            PG8_LDB(B0, 1, 0); PG8_LDB(B1, 1, 1); PG8_SCHED; PG8_LDA(At, 1, 0); PG8_STAGE(PG8_SA(0, 1), a2 + hstepA, voffA);
            PG8_WAIT_V(8); PG8_WAIT_L(0); PG8_BAR; PG8_MMA(0, 0, At, B0); PG8_MMA(0, 1, At, B1); PG8_BAR; PG8_SCHED;
            PG8_LDA(At, 1, 1); PG8_STAGE(PG8_SB(1, 0), b3, voffB); PG8_STAGE(PG8_SB(1, 1), b3 + hstepB, voffB); PG8_STAGE(PG8_SA(1, 0), a3, voffA);
            PG8_WAIT_V(8); PG8_WAIT_L(0); PG8_BAR; PG8_MMA(1, 0, At, B0); PG8_MMA(1, 1, At, B1); PG8_BAR; PG8_SCHED;
            } else {
            PG8_LDB(B0, 0, 0); PG8_SCHED; PG8_LDA(At, 0, 0); PG8_STAGE(PG8_SA(1, 1), a1 + hstepA, voffA);
            PG8_WAIT_L(8); PG8_BAR; PG8_WAIT_L(0); PG8_MMA(0, 0, At, B0); PG8_BAR; PG8_SCHED;
            PG8_LDB(B1, 0, 1); PG8_STAGE(PG8_SB(0, 0), b2, voffB);
            PG8_BAR; PG8_WAIT_L(0); PG8_MMA(0, 1, At, B1); PG8_BAR;
            PG8_LDA(At, 0, 1); PG8_STAGE(PG8_SA(0, 0), a2, voffA);
            PG8_BAR; PG8_WAIT_L(0); PG8_MMA(1, 0, At, B0); PG8_BAR; PG8_SCHED;
            PG8_STAGE(PG8_SB(0, 1), b2 + hstepB, voffB);
            PG8_WAIT_V(6); PG8_BAR; PG8_MMA(1, 1, At, B1); PG8_BAR;
            PG8_LDB(B0, 1, 0); PG8_SCHED; PG8_LDA(At, 1, 0); PG8_STAGE(PG8_SA(0, 1), a2 + hstepA, voffA);
            PG8_WAIT_L(8); PG8_BAR; PG8_WAIT_L(0); PG8_MMA(0, 0, At, B0); PG8_BAR; PG8_SCHED;
            PG8_LDB(B1, 1, 1); PG8_STAGE(PG8_SB(1, 0), b3, voffB);
            PG8_BAR; PG8_WAIT_L(0); PG8_MMA(0, 1, At, B1); PG8_BAR;
            PG8_LDA(At, 1, 1); PG8_STAGE(PG8_SA(1, 0), a3, voffA);
            PG8_BAR; PG8_WAIT_L(0); PG8_MMA(1, 0, At, B0); PG8_BAR; PG8_SCHED;
            PG8_STAGE(PG8_SB(1, 1), b3 + hstepB, voffB);
            PG8_WAIT_V(6); PG8_BAR; PG8_MMA(1, 1, At, B1); PG8_BAR;
            }
        }
        if constexpr (ALIGN_EPI) { if (wr == 0) PG8_BAR; }
        E(acc, cur, wr, wc, fr, fq); S.done(cur);
        if (!has_next) break;
#pragma unroll
        for (int a = 0; a < 2; ++a)
#pragma unroll
            for (int b = 0; b < 2; ++b)
#pragma unroll
                for (int m = 0; m < 4; ++m)
#pragma unroll
                    for (int n = 0; n < 2; ++n) acc[a][b][m][n] = (f32x4){0.f, 0.f, 0.f, 0.f};
        cur = nxt; cA = nA; cB = nB; ++ui;
        if constexpr (ALIGN_EPI) { if (wr == 1) PG8_BAR; }
    }
    PG8_WAIT_V(0);
    if constexpr (!ALIGN_EPI) { if (wr == 0) PG8_BAR; }
    PG8_BAR;
#undef PG8_SA
#undef PG8_SB
#undef PG8_STAGE
#undef PG8_LDA
#undef PG8_LDB
#undef PG8_MMA
#undef PG8_WAIT_V
#undef PG8_WAIT_L
#undef PG8_BAR
#undef PG8_SCHED
}
}

constexpr int DM = 1024;
constexpr int NTOK = 16400;
constexpr int PADL = 48;
constexpr int LPV = 16448;
constexpr int MP = 16640;
constexpr int MU = 16384;
constexpr int NCHUNK = 257;
constexpr int NHEAD = 8;
constexpr int NPROJ = 2560;
constexpr int KVROWS = 16512;
constexpr float EPS = 1e-6f;

constexpr size_t MiB = 1u << 20;
constexpr size_t WS_CTL = 0, CTL_ZERO_BYTES = 64 * 1024;
constexpr size_t WS_SSQ = 128 * 1024;
constexpr size_t WS_SSK = 512 * 1024;
constexpr size_t WS_SS4 = 14 * MiB;
constexpr size_t WS_WIN = 1 * MiB;
constexpr size_t WS_WUQ = 6 * MiB;
constexpr size_t WS_WUKV = 6 * MiB + 512 * 1024;
constexpr size_t WS_WOUT = 7 * MiB;
constexpr size_t WS_WPQ = 9 * MiB;
constexpr size_t WS_SKB = 13 * MiB;
constexpr size_t WS_IDX = 16 * MiB;
constexpr size_t WS_GATE = 24 * MiB;
constexpr size_t WS_HN = 16 * MiB;
constexpr size_t WS_QKVR = 101 * MiB;
constexpr size_t WS_Z = 150 * MiB;
constexpr size_t WS_BA = 245 * MiB;
constexpr size_t WS_GA = 16 * MiB;
constexpr size_t WS_GQ = 33 * MiB;
constexpr size_t WS_GS = 67 * MiB;
constexpr size_t WS_GB = 84 * MiB;
constexpr size_t WS_GO = 50 * MiB;
constexpr size_t WS_MIX = 167 * MiB;
constexpr size_t WS_CQN = 200 * MiB;
constexpr size_t WS_CKVN = 208 * MiB + 512 * 1024;
constexpr size_t WS_QH = 220 * MiB;
constexpr size_t WS_KVB = 167 * MiB;
constexpr size_t WS_Q = 125 * MiB + 512 * 1024;
constexpr size_t WS_K = 101 * MiB;
constexpr size_t WS_VT = 200 * MiB;
constexpr size_t WS_XN = 32 * MiB;
constexpr size_t WS_PQ = 64 * MiB;
constexpr size_t WS_SC = 128 * MiB;
constexpr size_t WS_EU = 96 * MiB;
constexpr size_t WS_EV = 112 * MiB;
constexpr size_t WS_CW = 64 * MiB;
constexpr size_t WS_HP = 128 * MiB;
constexpr size_t WS_KPE = 217 * MiB;
constexpr size_t WS_END = 256 * MiB;
constexpr int CW_ATTQ = 8192;

constexpr int LDS_BYTES = 147456;
constexpr int MISC_OFF = 131072 + 12288;

DI unsigned f2bf(float f) { unsigned u = __builtin_bit_cast(unsigned, f); return (u + 0x7fffu + ((u >> 16) & 1u)) >> 16; }
DI unsigned pk2(float lo, float hi) { return f2bf(lo) | (f2bf(hi) << 16); }
DI float bf2f(unsigned b) { return __builtin_bit_cast(float, b << 16); }
DI float bflo(unsigned w) { return __builtin_bit_cast(float, w << 16); }
DI float bfhi(unsigned w) { return __builtin_bit_cast(float, w & 0xffff0000u); }
DI float wave_sum(float v) {
#pragma unroll
    for (int o = 1; o < 64; o <<= 1) v += __shfl_xor(v, o);
    return v;
}
DI float sigmoidf_(float x) { return 1.f / (1.f + __expf(-x)); }
DI float siluf_(float x) { return x / (1.f + __expf(-x)); }

#define XB_TMO      128
#define XB_XCNT(j)  (256  + 64 * (j))
#define XB_XSUB(j)  (1280 + 64 * (j))
#define XB_XGEN(j)  (2304 + 64 * (j))
#define XB_TOP      3328
#define XB_TOPGEN   3392
#define XCD_BAR_WORDS 3456
#define XB_SPIN_CAP (1u << 22)
DI unsigned xb_ld(unsigned* p)              { return __hip_atomic_load(p, __ATOMIC_RELAXED, __HIP_MEMORY_SCOPE_AGENT); }
DI unsigned xb_add(unsigned* p, unsigned v) { return __hip_atomic_fetch_add(p, v, __ATOMIC_RELAXED, __HIP_MEMORY_SCOPE_AGENT); }
DI unsigned xb_xcc_id() { return (unsigned)__builtin_amdgcn_s_getreg((3 << 11) | 20) & 0xFu; }
#define XB_SPIN(cond, bar) do { unsigned _sp = 0; while (cond) { __builtin_amdgcn_s_sleep(1); \
    if ((++_sp & 255u) == 0u) { if (xb_ld(&(bar)[XB_TMO])) break; if (_sp > XB_SPIN_CAP) { atomicAdd(&(bar)[XB_TMO], 1u); break; } } } } while (0)
struct XcdBarrier { unsigned* bar; unsigned x; volatile LAS unsigned* st; };
DI XcdBarrier xcd_barrier_post(unsigned* bar, volatile LAS unsigned* st) {
    XcdBarrier b; b.bar = bar; b.x = xb_xcc_id(); b.st = st;
    if (threadIdx.x == 0) (void)xb_add(&bar[XB_XCNT(b.x)], 1u);
    return b;
}
DI void xcd_barrier_complete(unsigned* bar, unsigned x, unsigned& nloc, unsigned& nx) {
    const unsigned G = gridDim.x * gridDim.y * gridDim.z;
    unsigned sum, cnt, mine, sp = 0u;
    for (;;) {
        sum = 0u; cnt = 0u; mine = 0u;
#pragma unroll
        for (unsigned j = 0; j < 16; ++j) { const unsigned c = xb_ld(&bar[XB_XCNT(j)]); sum += c; cnt += (c > 0u) ? 1u : 0u; mine = (j == x) ? c : mine; }
        if (sum == G) break;
        __builtin_amdgcn_s_sleep(1);
        if ((++sp & 255u) == 0u) { if (xb_ld(&bar[XB_TMO])) break; if (sp > XB_SPIN_CAP) { atomicAdd(&bar[XB_TMO], 1u); break; } }
    }
    nloc = mine > 0u ? mine : 1u; nx = cnt > 0u ? cnt : 1u;
}
DI void xcd_barrier(const XcdBarrier& b) {
    asm volatile("s_waitcnt vmcnt(0)" ::: "memory");
    __syncthreads();
    if (threadIdx.x == 0) {
        unsigned* bar = b.bar;
        __builtin_amdgcn_s_waitcnt(0);
        unsigned nloc = b.st[0], nx = b.st[1];
        if (nloc == 0u) { xcd_barrier_complete(bar, b.x, nloc, nx); b.st[0] = nloc; b.st[1] = nx; }
        const unsigned old = xb_add(&bar[XB_XSUB(b.x)], 1u);
        const unsigned gen = old / nloc;
        if (old + 1u == (gen + 1u) * nloc) {
            __builtin_amdgcn_fence(__ATOMIC_RELEASE, "agent");
            asm volatile("s_waitcnt vmcnt(0)" ::: "memory");
            const unsigned og = xb_add(&bar[XB_TOP], 1u);
            const unsigned tg = og / nx;
            if (og + 1u == (tg + 1u) * nx) xb_add(&bar[XB_TOPGEN], 1u);
            else XB_SPIN(xb_ld(&bar[XB_TOPGEN]) == tg, bar);
            __builtin_amdgcn_fence(__ATOMIC_ACQUIRE, "agent");
            xb_add(&bar[XB_XGEN(b.x)], 1u);
            asm volatile("s_waitcnt vmcnt(0)" ::: "memory");
        } else {
            XB_SPIN(xb_ld(&bar[XB_XGEN(b.x)]) == gen, bar);
            __builtin_amdgcn_fence(__ATOMIC_ACQUIRE, "agent");
            asm volatile("s_waitcnt vmcnt(0)" ::: "memory");
        }
    }
    __syncthreads();
}

struct Args {
    const float* in[20];
    float* out; unsigned char* ws;
    int ph_lo, ph_hi;
};
struct Frame {
    unsigned char* lds;
    int tid, lane, wave, G, gw, NGW;
};

template <class Map>
DI void transpose_item(const float* __restrict__ W, int Nsrc, bf16_t* __restrict__ WT, int ldk, float* scr, int item, int nblk, int lane, Map srcmap, const float* __restrict__ rowscale = nullptr) {
    const int kb = item / nblk, nb = item % nblk, k0 = 64 * kb, n0 = 32 * nb;
    const int ns = srcmap(n0 + (lane & 31));
    float vv[32];
#pragma unroll
    for (int i = 0; i < 32; ++i) { const int kk = 2 * i + (lane >> 5); vv[i] = (ns >= 0) ? W[(size_t)(k0 + kk) * Nsrc + ns] : 0.f; }
    if (rowscale) {
#pragma unroll
        for (int i = 0; i < 32; ++i) vv[i] *= rowscale[k0 + 2 * i + (lane >> 5)];
    }
#pragma unroll
    for (int i = 0; i < 32; ++i) { const int kk = 2 * i + (lane >> 5); scr[kk * 33 + (lane & 31)] = vv[i]; }
    __builtin_amdgcn_s_waitcnt(0); __builtin_amdgcn_wave_barrier();
    const int c = lane & 7;
#pragma unroll
    for (int j = 0; j < 4; ++j) { const int n = (lane >> 3) + 8 * j; const float* s = scr + (8 * c) * 33 + n;
        u32x4 o; o.x = pk2(s[0 * 33], s[1 * 33]); o.y = pk2(s[2 * 33], s[3 * 33]); o.z = pk2(s[4 * 33], s[5 * 33]); o.w = pk2(s[6 * 33], s[7 * 33]);
        *(u32x4*)(WT + (size_t)(n0 + n) * ldk + k0 + 8 * c) = o; }
    __builtin_amdgcn_s_waitcnt(0); __builtin_amdgcn_wave_barrier();
}
struct MapId { DI int operator()(int n) const { return n; } };
struct MapWin {
    DI int operator()(int n) const {
        if (n < 2048) return n;
        if (n < 2304) return n + 16;
        if (n < 2432) return n + 16;
        if (n < 2464) return n + 16;
        if (n < 2472) return n - 416;
        if (n < 2480) return n - 416;
        return -1;
    }
};

template <int PART> DI void p0_late_weights(const Frame& F, const Args& A, int wi, int nwv, int ti, int nth) {
    unsigned char* ws = A.ws;
    float* scr = (float*)(F.lds + F.wave * 16384);
    const float* w_uq = A.in[10]; const float* w_ukv = A.in[11]; const float* w_out = A.in[14]; const float* w_pq = A.in[16]; const float* sub_keys = A.in[17];
    constexpr int I_UQ = 4 * 24, I_UKV = 2 * 32, I_OUT = 16 * 32, I_PQ = 16 * 64;
    constexpr int NITEMS = I_UQ + I_UKV + I_OUT + I_PQ;
    const int lo_ = PART == 0 ? 0 : I_UQ + I_UKV, hi_ = PART == 0 ? I_UQ + I_UKV : NITEMS;
    for (int it = lo_ + wi; it < hi_; it += nwv) {
        int r = it;
        if (r < I_UQ) { transpose_item(w_uq, 768, (bf16_t*)(ws + WS_WUQ), 256, scr, r, 24, F.lane, MapId(), A.in[8]); continue; } r -= I_UQ;
        if (r < I_UKV) { transpose_item(w_ukv, 1024, (bf16_t*)(ws + WS_WUKV), 256, scr, r, 32, F.lane, MapId(), A.in[9]); continue; } r -= I_UKV;
        if (r < I_OUT) { transpose_item(w_out, 1024, (bf16_t*)(ws + WS_WOUT), 1024, scr, r, 32, F.lane, MapId()); continue; } r -= I_OUT;
        transpose_item(w_pq, 2048, (bf16_t*)(ws + WS_WPQ), 1024, scr, r, 64, F.lane, MapId(), A.in[15]);
    }
    const int gt = ti, NGT = nth;
    if (PART == 0) for (int i = gt; i < 1024 * 16; i += NGT) { const int n = i >> 4, c = i & 15; *(u32x4*)((bf16_t*)(ws + WS_WUKV) + (size_t)n * 256 + 128 + c * 8) = (u32x4){0u, 0u, 0u, 0u}; }
    if (PART == 1) for (int i = gt; i < 2048 * 32; i += NGT) {
        const int n = i >> 5, c8 = (i & 31) * 8; const int p = (n >> 7) & 1;
        u32x4 o = (u32x4){0u, 0u, 0u, 0u};
        if ((c8 >> 7) == p) { const float* s = sub_keys + (size_t)n * 128 + (c8 & 127); const f32x4 a = *(const f32x4*)s, b = *(const f32x4*)(s + 4);
            o.x = pk2(a.x, a.y); o.y = pk2(a.z, a.w); o.z = pk2(b.x, b.y); o.w = pk2(b.z, b.w); }
        *(u32x4*)((bf16_t*)(ws + WS_SKB) + (size_t)n * 256 + c8) = o;
    }
}

DI void p0_prologue(const Frame& F, const Args& A) {
    unsigned char* ws = A.ws;
    float* scr = (float*)(F.lds + F.wave * 16384);
    const float* w_in = A.in[3]; const float* w_uq = A.in[10]; const float* w_ukv = A.in[11]; const float* w_out = A.in[14]; const float* w_pq = A.in[16]; const float* sub_keys = A.in[17];
    constexpr int I_IN = 16 * 80;
    for (int it = F.wave * F.G + blockIdx.x; it < I_IN; it += F.NGW) transpose_item(w_in, 2480, (bf16_t*)(ws + WS_WIN), 1024, scr, it, 80, F.lane, MapWin());
    const float* x = A.in[0]; const float* meta = A.in[1]; const float* anorm = A.in[2];
    bf16_t* HN = (bf16_t*)(ws + WS_HN);
    for (int p0 = F.gw; p0 < MP; p0 += 3 * F.NGW) {
        f32x4 v[3][4]; bool ok[3];
#pragma unroll
        for (int r = 0; r < 3; ++r) {
            const int p = p0 + r * F.NGW, t = p - PADL; ok[r] = (p < MP) && t >= 0 && t < NTOK;
            if (ok[r]) { const float* src = (t < 16) ? meta + (size_t)t * DM : x + (size_t)(t - 16) * DM; const f32x4* xr = (const f32x4*)src + F.lane;
#pragma unroll
                for (int j = 0; j < 4; ++j) v[r][j] = xr[64 * j]; }
            else {
#pragma unroll
                for (int j = 0; j < 4; ++j) v[r][j] = (f32x4){0.f, 0.f, 0.f, 0.f}; }
        }
#pragma unroll
        for (int r = 0; r < 3; ++r) {
            const int p = p0 + r * F.NGW; if (p >= MP) continue;
            unsigned long long* o8 = (unsigned long long*)(HN + (size_t)p * DM) + F.lane;
            float s = 0.f;
#pragma unroll
            for (int j = 0; j < 4; ++j) s += (v[r][j].x * v[r][j].x + v[r][j].y * v[r][j].y) + (v[r][j].z * v[r][j].z + v[r][j].w * v[r][j].w);
            const float rstd = ok[r] ? 1.f / sqrtf(wave_sum(s) * (1.f / DM) + EPS) : 0.f;
#pragma unroll
            for (int j = 0; j < 4; ++j) { const f32x4 w = ((const f32x4*)anorm)[64 * j + F.lane];
                o8[64 * j] = (unsigned long long)pk2(v[r][j].x * rstd * w.x, v[r][j].y * rstd * w.y) | ((unsigned long long)pk2(v[r][j].z * rstd * w.z, v[r][j].w * rstd * w.w) << 32); }
        }
    }
}

DI void row_ss_store(const f32x4 (&v)[2][2][4][2], float* SSP, int nslot, int slot, int row0, int fq, bool bj0_only) {
#pragma unroll
    for (int ai = 0; ai < 2; ++ai)
#pragma unroll
        for (int m = 0; m < 4; ++m) {
            float s = 0.f;
#pragma unroll
            for (int bj = 0; bj < 2; ++bj) if (bj == 0 || !bj0_only)
#pragma unroll
                for (int n = 0; n < 2; ++n) { const f32x4 x = v[ai][bj][m][n]; s += (x[0] * x[0] + x[1] * x[1]) + (x[2] * x[2] + x[3] * x[3]); }
            s += __shfl_xor(s, 16); s += __shfl_xor(s, 32);
            if (fq == 0) SSP[(size_t)(row0 + ai * 128 + m * 16) * nslot + slot] = s;
        }
}
DI float ss_sum4(const float* SSP, int row) { const f32x4 a = *(const f32x4*)(SSP + (size_t)row * 4); return (a.x + a.y) + (a.z + a.w); }
DI float ss_sum16(const float* SSP, int row) { const f32x4 a = *(const f32x4*)(SSP + (size_t)row * 16), b = *(const f32x4*)(SSP + (size_t)row * 16 + 4), c = *(const f32x4*)(SSP + (size_t)row * 16 + 8), d = *(const f32x4*)(SSP + (size_t)row * 16 + 12);
    return (((a.x + a.y) + (a.z + a.w)) + ((b.x + b.y) + (b.z + b.w))) + (((c.x + c.y) + (c.z + c.w)) + ((d.x + d.y) + (d.z + d.w))); }
struct EpiProj {
    static constexpr bool PERM = true;
    bf16_t* QKVR; bf16_t* Z; float* BA; bf16_t* CQ16; bf16_t* CKV16; float* KPE; float* SSQ; float* SSK;
    DI void operator()(const f32x4 (&acc)[2][2][4][2], const pg8::Unit& u, int wr, int wc, int fr, int fq) const {
        const int row0 = u.pm * 256 + wr * 64 + fr;
        if (u.pn < 8) {
            bf16_t* base; int ld, colt;
            if (u.pn < 6) { base = QKVR; ld = 1536; colt = u.pn * 256; } else { base = Z; ld = 512; colt = (u.pn - 6) * 256; }
            const int col0 = colt + wc * 32 + 8 * fq;
#pragma unroll
            for (int ai = 0; ai < 2; ++ai)
#pragma unroll
                for (int m = 0; m < 4; ++m) { bf16_t* rowp = base + (size_t)(row0 + ai * 128 + m * 16) * ld + col0;
#pragma unroll
                    for (int bj = 0; bj < 2; ++bj) { const f32x4 v0 = acc[ai][bj][m][0], v1 = acc[ai][bj][m][1];
                        u32x4 w; w.x = pg8::cvt_pk_bf16(v0[0], v0[1]); w.y = pg8::cvt_pk_bf16(v0[2], v0[3]); w.z = pg8::cvt_pk_bf16(v1[0], v1[1]); w.w = pg8::cvt_pk_bf16(v1[2], v1[3]);
                        *(u32x4*)(rowp + bj * 128) = w; } }
        } else {
            const int lcol0 = wc * 32 + 8 * fq;
            bf16_t* b16 = (u.pn == 8) ? CQ16 : CKV16;
#pragma unroll
            for (int ai = 0; ai < 2; ++ai)
#pragma unroll
                for (int m = 0; m < 4; ++m) { const size_t row = (size_t)(row0 + ai * 128 + m * 16);
#pragma unroll
                    for (int bj = 0; bj < 2; ++bj) { const f32x4 v0 = acc[ai][bj][m][0], v1 = acc[ai][bj][m][1];
                        u32x4 w; w.x = pg8::cvt_pk_bf16(v0[0], v0[1]); w.y = pg8::cvt_pk_bf16(v0[2], v0[3]); w.z = pg8::cvt_pk_bf16(v1[0], v1[1]); w.w = pg8::cvt_pk_bf16(v1[2], v1[3]);
                        *(u32x4*)(b16 + row * 256 + lcol0 + bj * 128) = w;
                        if (u.pn == 9 && bj == 1 && wc == 0) { *(f32x4*)(KPE + row * 32 + 8 * fq) = v0; *(f32x4*)(KPE + row * 32 + 8 * fq + 4) = v1; }
                        if (u.pn == 9 && bj == 1 && wc == 1 && fq < 2) { *(f32x4*)(BA + row * 16 + 8 * fq) = v0; *(f32x4*)(BA + row * 16 + 8 * fq + 4) = v1; }
                    } }
            row_ss_store(acc, (u.pn == 8) ? SSQ : SSK, 4, wc, row0, fq, u.pn == 9);
        }
    }
};
struct EpiB16 {
    static constexpr bool PERM = true;
    bf16_t* O; int ldc; const float* SS; float invn; int nslot;
    DI void operator()(const f32x4 (&acc)[2][2][4][2], const pg8::Unit& u, int wr, int wc, int fr, int fq) const {
        const int row0 = u.pm * 256 + wr * 64 + fr, col0 = u.pn * 256 + wc * 32 + 8 * fq;
#pragma unroll
        for (int ai = 0; ai < 2; ++ai)
#pragma unroll
            for (int m = 0; m < 4; ++m) { const int row = row0 + ai * 128 + m * 16; bf16_t* rowp = O + (size_t)row * ldc + col0;
                const float rs = SS ? 1.f / sqrtf((nslot == 16 ? ss_sum16(SS, row) : ss_sum4(SS, row)) * invn + EPS) : 1.f;
#pragma unroll
                for (int bj = 0; bj < 2; ++bj) { const f32x4 v0 = acc[ai][bj][m][0] * rs, v1 = acc[ai][bj][m][1] * rs;
                    u32x4 w; w.x = pg8::cvt_pk_bf16(v0[0], v0[1]); w.y = pg8::cvt_pk_bf16(v0[2], v0[3]); w.z = pg8::cvt_pk_bf16(v1[0], v1[1]); w.w = pg8::cvt_pk_bf16(v1[2], v1[3]);
                    *(u32x4*)(rowp + bj * 128) = w; } }
    }
};
struct EpiH1 {
    static constexpr bool PERM = true;
    float* C; const float* res; bf16_t* H16; float* SS;
    DI void operator()(const f32x4 (&acc)[2][2][4][2], const pg8::Unit& u, int wr, int wc, int fr, int fq) const {
        const int row0 = u.pm * 256 + wr * 64 + fr, col0 = u.pn * 256 + wc * 32 + 8 * fq;
        f32x4 v[2][2][4][2];
#pragma unroll
        for (int ai = 0; ai < 2; ++ai)
#pragma unroll
            for (int m = 0; m < 4; ++m) { const size_t off = (size_t)(row0 + ai * 128 + m * 16) * 1024 + col0;
#pragma unroll
                for (int bj = 0; bj < 2; ++bj) { const f32x4 v0 = acc[ai][bj][m][0] + *(const f32x4*)(res + off + bj * 128), v1 = acc[ai][bj][m][1] + *(const f32x4*)(res + off + bj * 128 + 4);
                    v[ai][bj][m][0] = v0; v[ai][bj][m][1] = v1;
                    *(f32x4*)(C + off + bj * 128) = v0; *(f32x4*)(C + off + bj * 128 + 4) = v1;
                    u32x4 w; w.x = pg8::cvt_pk_bf16(v0[0], v0[1]); w.y = pg8::cvt_pk_bf16(v0[2], v0[3]); w.z = pg8::cvt_pk_bf16(v1[0], v1[1]); w.w = pg8::cvt_pk_bf16(v1[2], v1[3]);
                    *(u32x4*)(H16 + off + bj * 128) = w; } }
        row_ss_store(v, SS, 16, u.pn * 4 + wc, row0, fq, false);
    }
};
struct EpiF32 {
    static constexpr bool PERM = true;
    float* C; int ldc; const float* res;
    DI void operator()(const f32x4 (&acc)[2][2][4][2], const pg8::Unit& u, int wr, int wc, int fr, int fq) const {
        const int row0 = u.pm * 256 + wr * 64 + fr, col0 = u.pn * 256 + wc * 32 + 8 * fq;
#pragma unroll
        for (int ai = 0; ai < 2; ++ai)
#pragma unroll
            for (int m = 0; m < 4; ++m) { const size_t off = (size_t)(row0 + ai * 128 + m * 16) * ldc + col0;
#pragma unroll
                for (int bj = 0; bj < 2; ++bj) { f32x4 v0 = acc[ai][bj][m][0], v1 = acc[ai][bj][m][1];
                    if (res) { v0 += *(const f32x4*)(res + off + bj * 128); v1 += *(const f32x4*)(res + off + bj * 128 + 4); }
                    *(f32x4*)(C + off + bj * 128) = v0; *(f32x4*)(C + off + bj * 128 + 4) = v1; } }
    }
};

DI f32x16 mfma32(bf16x8 a, bf16x8 b, f32x16 c) { return __builtin_amdgcn_mfma_f32_32x32x16_bf16(a, b, c, 0, 0, 0); }
DI f32x4 mfma16(bf16x8 a, bf16x8 b, f32x4 c) { return __builtin_amdgcn_mfma_f32_16x16x32_bf16(a, b, c, 0, 0, 0); }
DI int crow(int r, int hi) { return (r & 3) + 8 * (r >> 2) + 4 * hi; }
DI f32x16 zero16() { f32x16 z;
#pragma unroll
    for (int i = 0; i < 16; ++i) z[i] = 0.f; return z; }

constexpr int G_KF = 0, G_VF = 16384, G_MF = 32768;
constexpr int G_QB = 50176, G_KB = 59392, G_KBB = 68608;
constexpr int G_QKB = 77824, G_UT = 87040, G_WT = 96256, G_KDT = 105472;
constexpr int G_VEC = 114688;
constexpr int G_RAW = G_QKB;
constexpr int GST = 72;

DI f32x16 mm_quad(const unsigned char* A, const unsigned char* Bt, int qr, int qc, int lane) {
    const int r32 = lane & 31, hh = lane >> 5;
    const unsigned char* ap = A + (32 * qr + r32) * (GST * 2) + hh * 16;
    const unsigned char* bp = Bt + (32 * qc + r32) * (GST * 2) + hh * 16;
    f32x16 acc = zero16();
#pragma unroll
    for (int s = 0; s < 4; ++s) acc = mfma32(*(const bf16x8*)(ap + s * 32), *(const bf16x8*)(bp + s * 32), acc);
    return acc;
}

constexpr int G_RAW2 = 115712;
static_assert(G_RAW2 + 67 * 400 <= 143360, "GDN prep LDS map");
constexpr int G_CONVW = 143360 + 512;

#ifndef PROBE_STAGE
#define PROBE_STAGE -1
#endif
template <int VAR> DI void gdn_prep_phase(const Frame& F, const Args& A) {
    unsigned long long stg_t = 0ull, stg_acc = 0ull;
#define STG(n) do { if (PROBE_STAGE >= 0) { const unsigned long long now_ = __builtin_amdgcn_s_memrealtime(); if (PROBE_STAGE == (n)) stg_acc += now_ - stg_t; stg_t = now_; } } while (0)
    unsigned char* ws = A.ws; unsigned char* lds = F.lds;
    const int tid = F.tid, lane = F.lane, wave = F.wave;
    const bf16_t* QKVR = (const bf16_t*)(ws + WS_QKVR); const float* BA = (const float*)(ws + WS_BA);
    float* KF = (float*)(lds + G_KF); float* VF = (float*)(lds + G_VF); float* MF = (float*)(lds + G_MF);
    float* VEC = (float*)(lds + G_VEC);
    if (VAR == 6) return;
    const int NIT = NCHUNK * 8;
#define LBAR() do { asm volatile("s_waitcnt lgkmcnt(0)" ::: "memory"); __builtin_amdgcn_s_barrier(); asm volatile("" ::: "memory"); } while (0)
#define LAUNDER(dst, src) int dst = (src); asm volatile("" : "+v"(dst))
    int item = blockIdx.x;
    if (item >= NIT) return;
    u32x4 pr[4]; float nb = 0.f, na = 0.f;
    auto raw_fetch = [&](int it) {
        const int c = it >> 3, h = it & 7; LAUNDER(tl, tid);
#pragma unroll
        for (int i = 0; i < 4; ++i) { const int q = tl + 512 * i; pr[i] = (u32x4){0u, 0u, 0u, 0u};
            if (q < 67 * 24) { const int r = q / 24, cc = q % 24, seg = cc >> 3, c8 = cc & 7; const int p = 64 * c - 3 + r;
                if (p >= 0) pr[i] = *(const u32x4*)(QKVR + (size_t)p * 1536 + seg * 512 + h * 64 + c8 * 8); } }
        if (wave == 0) { const int p = 64 * c + lane; nb = BA[(size_t)p * 16 + h]; na = BA[(size_t)p * 16 + 8 + h]; }
    };
    auto raw_park = [&]() {
        LAUNDER(tl, tid);
#pragma unroll
        for (int i = 0; i < 4; ++i) { const int q = tl + 512 * i;
            if (q < 67 * 24) { const int r = q / 24, cc = q % 24, seg = cc >> 3, c8 = cc & 7; *(u32x4*)(lds + G_RAW2 + r * 400 + (seg * 64 + c8 * 8) * 2) = pr[i]; } }
    };
    raw_fetch(item); raw_park();
    float cb = nb, ca = na;
    float* CWL = (float*)(lds + G_CONVW);
    int cw_h = -1;
#pragma unroll 1
    for (; item < NIT; item += F.G) {
        if (PROBE_STAGE >= 0 && stg_t == 0ull) stg_t = __builtin_amdgcn_s_memrealtime();
        const int c = item >> 3, h = item & 7;
        if (h != cw_h) { cw_h = h;
            if (tid < 192) { LAUNDER(t0, tid); const int sg = t0 >> 6, jt = (t0 >> 4) & 3, c4 = t0 & 15; *(f32x4*)(CWL + (sg * 4 + jt) * 64 + 4 * c4) = *(const f32x4*)(A.in[4] + jt * 1536 + sg * 512 + h * 64 + 4 * c4); } }
        const int nxt = item + F.G;
        if (VAR != 5 && nxt < NIT) raw_fetch(nxt);
        if (wave == 0) {
            const int p = 64 * c + lane;
            const float alog = A.in[5][h], dtb = A.in[6][h];
            float beta = sigmoidf_(cb);
            const float xx = ca + dtb; const float sp = xx > 20.f ? xx : log1pf(__expf(xx));
            float g = -__expf(alog) * sp;
            if (p < PADL) { beta = 0.f; g = 0.f; }
            float gc = g;
#pragma unroll
            for (int o = 1; o < 64; o <<= 1) { const float t = __shfl_up(gc, o); if (lane >= o) gc += t; }
            const float glast = __shfl(gc, 63);
            VEC[lane] = gc; VEC[64 + lane] = beta; VEC[128 + lane] = __expf(gc); VEC[192 + lane] = __expf(glast - gc);
        }
        LBAR(); STG(0);
        LAUNDER(t1, tid); const int sub = t1 & 15, grp = t1 >> 4;
#pragma unroll
        for (int sg = 0; sg < ((VAR == 2 || VAR >= 4) ? 0 : 3); ++sg) {
#pragma unroll
            for (int ps = 0; ps < 2; ++ps) {
                const int i = grp + 32 * ps;
                float acc[4] = {0.f, 0.f, 0.f, 0.f};
#pragma unroll
                for (int jt = 0; jt < 4; ++jt) {
                    const f32x4 w = *(const f32x4*)(CWL + (sg * 4 + jt) * 64 + 4 * sub);
                    const u32x2 rv = *(const u32x2*)(lds + G_RAW2 + (i + jt) * 400 + (sg * 64 + 4 * sub) * 2);
                    acc[0] += w.x * bflo(rv.x); acc[1] += w.y * bfhi(rv.x); acc[2] += w.z * bflo(rv.y); acc[3] += w.w * bfhi(rv.y);
                }
                float y[4];
#pragma unroll
                for (int k = 0; k < 4; ++k) y[k] = siluf_(acc[k]);
                if (sg < 2) {
                    float ss = (y[0] * y[0] + y[1] * y[1]) + (y[2] * y[2] + y[3] * y[3]);
                    ss += __shfl_xor(ss, 1); ss += __shfl_xor(ss, 2); ss += __shfl_xor(ss, 4); ss += __shfl_xor(ss, 8);
                    const float rn = 1.f / sqrtf(ss + EPS);
#pragma unroll
                    for (int k = 0; k < 4; ++k) y[k] *= rn;
                }
                if (sg == 0) {
                    u32x2 o; o.x = pk2(y[0] * 0.125f, y[1] * 0.125f); o.y = pk2(y[2] * 0.125f, y[3] * 0.125f);
                    *(u32x2*)(lds + G_QB + i * (GST * 2) + 8 * sub) = o;
                } else if (sg == 1) {
                    const float beta = VEC[64 + i], ekd = VEC[192 + i];
                    *(f32x4*)(KF + i * 64 + 4 * sub) = (f32x4){y[0], y[1], y[2], y[3]};
                    u32x2 o; o.x = pk2(y[0], y[1]); o.y = pk2(y[2], y[3]);
                    *(u32x2*)(lds + G_KB + i * (GST * 2) + 8 * sub) = o;
                    o.x = pk2(y[0] * beta, y[1] * beta); o.y = pk2(y[2] * beta, y[3] * beta);
                    *(u32x2*)(lds + G_KBB + i * (GST * 2) + 8 * sub) = o;
#pragma unroll
                    for (int k = 0; k < 4; ++k) *(bf16_t*)(lds + G_KDT + (4 * sub + k) * (GST * 2) + i * 2) = (bf16_t)f2bf(y[k] * ekd);
                } else {
                    *(f32x4*)(VF + i * 64 + 4 * sub) = (f32x4){y[0], y[1], y[2], y[3]};
                }
            }
        }
        LBAR(); STG(1);
        if (VAR != 3 && VAR < 4) {
            LAUNDER(l3, lane);
            const int prod = wave >> 2, quad = wave & 3, qr = quad >> 1, qc = quad & 1, r32 = l3 & 31, hh = l3 >> 5;
            const f32x16 acc = mm_quad(lds + (prod ? G_QB : G_KBB), lds + G_KB, qr, qc, l3);
            const int j = 32 * qc + r32; const float gcj = VEC[j];
#pragma unroll
            for (int r = 0; r < 16; ++r) {
                const int i = 32 * qr + crow(r, hh);
                if (prod == 0) { MF[i * 68 + j] = (j < i) ? acc[r] * __expf(VEC[i] - gcj) : 0.f; }
                else { *(bf16_t*)(lds + G_QKB + i * (GST * 2) + j * 2) = (bf16_t)f2bf((j <= i) ? acc[r] * __expf(VEC[i] - gcj) : 0.f); }
            }
        }
        LBAR(); STG(2);
        float* DB = (float*)(lds + G_KBB);
        if (VAR != 1 && VAR < 4 && wave == 0) {
            LAUNDER(l4, lane); const int b = l4 >> 4, jc = l4 & 15;
            float d[16];
#pragma unroll
            for (int i = 0; i < 16; ++i) {
                float acc = (i == jc) ? 1.f : 0.f;
                const float* mrow = MF + (16 * b + i) * 68 + 16 * b;
#pragma unroll
                for (int k = 0; k < i; ++k) acc -= mrow[k] * d[k];
                d[i] = acc;
            }
#pragma unroll
            for (int i = 0; i < 16; ++i) DB[(b * 16 + i) * 20 + jc] = d[i];
        }
        LBAR();
        if (VAR != 1 && VAR < 4) {
            LAUNDER(l4, lane); const int cc = l4 & 15, g = l4 >> 4;
            const bool isU = wave < 4; const int col = 16 * (wave & 3) + cc;
            const float* src = (isU ? VF : KF) + col;
            f32x4 X[4];
#pragma unroll
            for (int b = 0; b < 4; ++b) {
                f32x4 acc;
#pragma unroll
                for (int r = 0; r < 4; ++r) { const int i = 16 * b + 4 * g + r; float rv = src[i * 64] * VEC[64 + i]; if (!isU) rv *= VEC[128 + i]; acc[r] = -rv; }
#pragma unroll
                for (int a = 0; a < b; ++a) {
                    const f32x4 lv = *(const f32x4*)(MF + (16 * b + cc) * 68 + 16 * a + 4 * g);
#pragma unroll
                    for (int sp = 0; sp < 4; ++sp) acc = __builtin_amdgcn_mfma_f32_16x16x4f32(lv[sp], X[a][sp], acc, 0, 0, 0);
                }
                const f32x4 dv = *(const f32x4*)(DB + (b * 16 + cc) * 20 + 4 * g);
                f32x4 xb = (f32x4){0.f, 0.f, 0.f, 0.f};
#pragma unroll
                for (int sp = 0; sp < 4; ++sp) xb = __builtin_amdgcn_mfma_f32_16x16x4f32(dv[sp], acc[sp], xb, 0, 0, 0);
                X[b] = -xb;
                unsigned char* dst = lds + (isU ? G_UT : G_WT) + col * (GST * 2) + (16 * b + 4 * g) * 2;
                *(u32x2*)dst = (u32x2){pk2(X[b][0], X[b][1]), pk2(X[b][2], X[b][3])};
            }
        }
        LBAR(); STG(3);
        if (VAR != 3 && VAR < 4) {
            const float gl = VEC[128 + 63];
            bf16_t* GB = (bf16_t*)(ws + WS_GB) + (size_t)item * 4096;
            bf16_t* GQ = (bf16_t*)(ws + (VAR ? WS_GS : WS_GQ)) + (size_t)item * 4096; bf16_t* GO = (bf16_t*)(ws + (VAR ? WS_GS : WS_GO)) + (size_t)item * 4096;
            bf16_t* GAL = (bf16_t*)(lds + G_MF);
            LAUNDER(l5, lane); const int r32 = l5 & 31, hh = l5 >> 5;
#pragma unroll 1
            for (int it = 0; it < 2; ++it) {
                const int task = wave + 8 * it, prod = task >> 2, quad = task & 3, qr = quad >> 1, qc = quad & 1;
                const f32x16 acc = mm_quad(lds + (prod < 2 ? G_KDT : G_QKB), lds + ((prod & 1) ? G_UT : G_WT), qr, qc, l5);
                const int Cc = 32 * qc + r32;
                if (prod == 0) {
#pragma unroll
                    for (int r = 0; r < 16; ++r) {
                        const int R = 32 * qr + crow(r, hh);
                        const float val = ((R == Cc) ? gl : 0.f) - acc[r];
                        const int rb = R >> 4, m = R & 15, q4 = Cc >> 4, g = (Cc >> 2) & 3, rr = Cc & 3, ks = q4 >> 1, jj = 4 * (q4 & 1) + rr, ls = 16 * g + m;
                        GAL[((rb * 2 + ks) * 64 + ls) * 8 + jj] = (bf16_t)f2bf(val);
                    }
                } else if (prod == 1) {
                    const int eslab = Cc >> 4, n = Cc & 15;
#pragma unroll
                    for (int a = 0; a < 4; ++a) {
                        const int R0 = 32 * qr + 8 * a + 4 * hh; const int rb = R0 >> 4, g = (R0 >> 2) & 3, ls = 16 * g + n;
                        *(u32x2*)(GB + ((eslab * 4 + rb) * 64 + ls) * 4) = (u32x2){pk2(acc[4 * a], acc[4 * a + 1]), pk2(acc[4 * a + 2], acc[4 * a + 3])};
                    }
                } else if (prod == 2) {
#pragma unroll
                    for (int r = 0; r < 16; ++r) {
                        const int R = 32 * qr + crow(r, hh);
                        const float qv = bf2f(*(const bf16_t*)(lds + G_QB + R * (GST * 2) + Cc * 2));
                        GQ[R * 64 + Cc] = (bf16_t)f2bf(qv * VEC[128 + R] - acc[r]);
                    }
                } else {
#pragma unroll
                    for (int r = 0; r < 16; ++r) GO[(quad * 16 + r) * 64 + l5] = (bf16_t)f2bf(acc[r]);
                }
            }
        }
        if (VAR != 5 && nxt < NIT) { raw_park(); cb = nb; ca = na; }
        LBAR(); STG(4);
        if (VAR != 5) { LAUNDER(t6, tid); *(u32x4*)((bf16_t*)(ws + (VAR ? WS_GS : WS_GA)) + (size_t)item * 4096 + t6 * 8) = *(const u32x4*)(lds + G_MF + t6 * 16); }
        STG(5);
    }
    if (PROBE_STAGE >= 0 && tid == 0) { *(unsigned long long*)(lds + 143360 + 96) = stg_acc; }
}

constexpr int SC_D = 8, SC_PD = 6, SC_SLOT = 10240;
DI void gdn_scan(const Frame& F, const Args& A) {
    if (blockIdx.x >= 32) return;
    unsigned char* ws = A.ws;
    const int h = blockIdx.x & 7, eslab = blockIdx.x >> 3, lane = F.lane, wave = F.wave, n = lane & 15, g = lane >> 4;
    const unsigned char* GA = ws + WS_GA; const unsigned char* GB = ws + WS_GB; bf16_t* GS = (bf16_t*)(ws + WS_GS);
    LAS unsigned char* ring = (LAS unsigned char*)F.lds;
    const int np = (wave == 0) ? 0 : ((wave - 1 < 3) ? 2 : 1);
    auto issue = [&](int c) {
        const int cc = c < NCHUNK ? c : NCHUNK - 1;
        const size_t item = (size_t)cc * 8 + h;
        LAS unsigned char* slot = ring + (c % SC_D) * SC_SLOT;
#pragma unroll
        for (int i = 0; i < 2; ++i) if (i < np) {
            const int q = (wave - 1) + 7 * i;
            const unsigned char* src = (q < 8) ? GA + item * 8192 + q * 1024 : GB + item * 8192 + eslab * 2048 + (q - 8) * 1024;
            LAS unsigned char* dst = slot + ((q < 8) ? q * 1024 : 8192 + (q - 8) * 1024);
            __builtin_amdgcn_global_load_lds((const unsigned*)(src + lane * 16), (LAS unsigned*)dst, 16, 0, 0);
        }
    };
    for (int c = 0; c < SC_PD; ++c) issue(c);
    f32x4 S[4];
#pragma unroll
    for (int rb = 0; rb < 4; ++rb) S[rb] = (f32x4){0.f, 0.f, 0.f, 0.f};
#pragma unroll 1
    for (int c = 0; c < NCHUNK; ++c) {
        issue(c + SC_PD);
        if (np == 2) asm volatile("s_waitcnt vmcnt(12)" ::: "memory");
        else if (np == 1) asm volatile("s_waitcnt vmcnt(6)" ::: "memory");
        asm volatile("s_waitcnt lgkmcnt(0)" ::: "memory");
        __builtin_amdgcn_s_barrier();
        asm volatile("" ::: "memory");
        if (wave == 0) {
            const LAS unsigned char* slot = ring + (c % SC_D) * SC_SLOT;
            bf16x8 ac[8]; f32x4 bc[4];
#pragma unroll
            for (int q = 0; q < 8; ++q) ac[q] = *(const LAS bf16x8*)(slot + q * 1024 + lane * 16);
#pragma unroll
            for (int rb = 0; rb < 4; ++rb) { const u32x2 w = *(const LAS u32x2*)(slot + 8192 + rb * 512 + lane * 8); bc[rb] = (f32x4){bflo(w.x), bfhi(w.x), bflo(w.y), bfhi(w.y)}; }
            const size_t item = (size_t)c * 8 + h;
            u32x4 p0, p1;
            p0.x = pk2(S[0][0], S[0][1]); p0.y = pk2(S[0][2], S[0][3]); p0.z = pk2(S[1][0], S[1][1]); p0.w = pk2(S[1][2], S[1][3]);
            p1.x = pk2(S[2][0], S[2][1]); p1.y = pk2(S[2][2], S[2][3]); p1.z = pk2(S[3][0], S[3][1]); p1.w = pk2(S[3][2], S[3][3]);
            {
                bf16_t* st = GS + item * 4096 + (16 * eslab + n) * 64 + 4 * g;
                *(u32x2*)(st + 0) = (u32x2){p0.x, p0.y}; *(u32x2*)(st + 16) = (u32x2){p0.z, p0.w};
                *(u32x2*)(st + 32) = (u32x2){p1.x, p1.y}; *(u32x2*)(st + 48) = (u32x2){p1.z, p1.w};
            }
            const bf16x8 b0 = __builtin_bit_cast(bf16x8, p0), b1 = __builtin_bit_cast(bf16x8, p1);
#pragma unroll
            for (int rb = 0; rb < 4; ++rb) {
                f32x4 acc = bc[rb];
                acc = mfma16(ac[rb * 2 + 0], b0, acc);
                acc = mfma16(ac[rb * 2 + 1], b1, acc);
                S[rb] = acc;
            }
        }
    }
    asm volatile("s_waitcnt vmcnt(0) lgkmcnt(0)" ::: "memory");
    __builtin_amdgcn_s_barrier();
}

DI void gdn_out_task(const Frame& F, const Args& A, int task) {
    unsigned char* ws = A.ws;
    const int ihalf = task & 1, item = (task >> 1) + 8, c = item >> 3, h = item & 7, lane = F.lane, r32 = lane & 31, hh = lane >> 5;
    const bf16_t* GQ = (const bf16_t*)(ws + WS_GQ) + (size_t)item * 4096; const bf16_t* GS = (const bf16_t*)(ws + WS_GS) + (size_t)item * 4096;
    const bf16_t* GO = (const bf16_t*)(ws + WS_GO) + (size_t)item * 4096;
    const bf16_t* Z = (const bf16_t*)(ws + WS_Z); bf16_t* MIX = (bf16_t*)(ws + WS_MIX);
    f32x16 acc[2];
#pragma unroll
    for (int eh = 0; eh < 2; ++eh)
#pragma unroll
        for (int r = 0; r < 16; ++r) acc[eh][r] = bf2f(GO[((ihalf * 2 + eh) * 16 + r) * 64 + lane]);
#pragma unroll
    for (int s = 0; s < 4; ++s) {
        const bf16x8 a = *(const bf16x8*)(GQ + (32 * ihalf + r32) * 64 + 16 * s + 8 * hh);
#pragma unroll
        for (int eh = 0; eh < 2; ++eh) {
            const bf16x8 b = *(const bf16x8*)(GS + (32 * eh + r32) * 64 + 16 * s + 8 * hh);
            acc[eh] = mfma32(a, b, acc[eh]);
        }
    }
    const float* gnorm = A.in[7];
    const float w0 = gnorm[r32], w1 = gnorm[32 + r32];
#pragma unroll
    for (int r = 0; r < 16; ++r) {
        float ss = acc[0][r] * acc[0][r] + acc[1][r] * acc[1][r];
        ss += __shfl_xor(ss, 1); ss += __shfl_xor(ss, 2); ss += __shfl_xor(ss, 4); ss += __shfl_xor(ss, 8); ss += __shfl_xor(ss, 16);
        const float rstd = 1.f / sqrtf(ss * (1.f / 64.f) + EPS);
        const int i = 32 * ihalf + crow(r, hh); const int p = 64 * c + i;
        const float z0 = bf2f(Z[(size_t)p * 512 + h * 64 + r32]), z1 = bf2f(Z[(size_t)p * 512 + h * 64 + 32 + r32]);
        bf16_t* o = MIX + (size_t)(p - 64) * 1024 + h * 64;
        o[r32] = (bf16_t)f2bf(acc[0][r] * rstd * w0 * siluf_(z0));
        o[32 + r32] = (bf16_t)f2bf(acc[1][r] * rstd * w1 * siluf_(z1));
    }
}


constexpr float QSCALE = 0.10206207261596577f * 1.4426950408889634f;
DI double rope_inv_rev(int i) {
    const double t8[8] = {0.15915494309189535, 0.08949940160889101, 0.050329212104487035, 0.0283021958306234, 0.015915494309189534, 0.008949940160889102, 0.005032921210448704, 0.00283021958306234};
    double v = t8[0];
#pragma unroll
    for (int k = 1; k < 8; ++k) v = ((i & 7) == k) ? t8[k] : v;
    return (i & 8) ? v * 0.01 : v;
}
constexpr int P2_TS = 136;
constexpr int P2_RS = 272;
#define P2_WSYNC() do { __builtin_amdgcn_s_waitcnt(0); __builtin_amdgcn_wave_barrier(); } while (0)
DI void mla_prep2_task(const Frame& F, const Args& A, int task) {
    unsigned char* ws = A.ws; int lane = F.lane; asm volatile("" : "+v"(lane));
    const int h = task & 7, blk = task >> 3;
    const int p = 64 * blk + lane;
    const bool valid = (p >= PADL) && (p < LPV);
    const float* qn = A.in[12]; const float* kn = A.in[13];
    unsigned char* TS = F.lds + F.wave * (64 * P2_RS);
    unsigned char* trow = TS + lane * P2_RS;
    const double pos = (double)(p - PADL);
    auto rot = [&](int i, float& sn_, float& cs_) { const double rev = pos * rope_inv_rev(i); const float fr = (float)(rev - floor(rev)); sn_ = __builtin_amdgcn_sinf(fr); cs_ = __builtin_amdgcn_cosf(fr); };
    {
        {
            const bf16_t* srcb = (const bf16_t*)(ws + WS_QH) + (size_t)(64 * blk) * 768 + h * 96;
            u32x4 t[12];
#pragma unroll
            for (int i = 0; i < 12; ++i) { const int c = 64 * i + lane, r = c / 12, pc = c % 12; t[i] = *(const u32x4*)(srcb + (size_t)r * 768 + 8 * pc); }
#pragma unroll
            for (int i = 0; i < 12; ++i) { const int c = 64 * i + lane, r = c / 12, pc = c % 12; *(u32x4*)(TS + r * P2_RS + 16 * pc) = t[i]; }
            P2_WSYNC();
        }
        u32x4 w[12];
#pragma unroll
        for (int c = 0; c < 12; ++c) w[c] = *(const u32x4*)(trow + 16 * c);
        float ss = 0.f;
#pragma unroll
        for (int c = 0; c < 12; ++c) { const float a0 = bflo(w[c].x), a1 = bfhi(w[c].x), a2 = bflo(w[c].y), a3 = bfhi(w[c].y), a4 = bflo(w[c].z), a5 = bfhi(w[c].z), a6 = bflo(w[c].w), a7 = bfhi(w[c].w);
            ss += (a0 * a0 + a1 * a1) + (a2 * a2 + a3 * a3) + (a4 * a4 + a5 * a5) + (a6 * a6 + a7 * a7); }
        const float rs = valid ? QSCALE / sqrtf(ss * (1.f / 96.f) + EPS) : 0.f;
        unsigned char* dst = trow;
#pragma unroll
        for (int c = 0; c < 8; ++c) {
            const f32x4 g0 = *(const f32x4*)(qn + 8 * c), g1 = *(const f32x4*)(qn + 8 * c + 4);
            *(u32x4*)(dst + 16 * c) = (u32x4){pk2(bflo(w[c].x) * rs * g0.x, bfhi(w[c].x) * rs * g0.y), pk2(bflo(w[c].y) * rs * g0.z, bfhi(w[c].y) * rs * g0.w),
                                              pk2(bflo(w[c].z) * rs * g1.x, bfhi(w[c].z) * rs * g1.y), pk2(bflo(w[c].w) * rs * g1.z, bfhi(w[c].w) * rs * g1.w)};
        }
#pragma unroll
        for (int c = 0; c < 2; ++c) {
            float x1[8], x2[8];
            const u32x4 wa = w[8 + c], wb = w[10 + c];
            x1[0] = bflo(wa.x); x1[1] = bfhi(wa.x); x1[2] = bflo(wa.y); x1[3] = bfhi(wa.y); x1[4] = bflo(wa.z); x1[5] = bfhi(wa.z); x1[6] = bflo(wa.w); x1[7] = bfhi(wa.w);
            x2[0] = bflo(wb.x); x2[1] = bfhi(wb.x); x2[2] = bflo(wb.y); x2[3] = bfhi(wb.y); x2[4] = bflo(wb.z); x2[5] = bfhi(wb.z); x2[6] = bflo(wb.w); x2[7] = bfhi(wb.w);
            float o1[8], o2[8];
#pragma unroll
            for (int t = 0; t < 8; ++t) { float sn_, cs_; rot(8 * c + t, sn_, cs_); const float a = x1[t] * rs * qn[64 + 8 * c + t], b = x2[t] * rs * qn[80 + 8 * c + t]; o1[t] = a * cs_ - b * sn_; o2[t] = b * cs_ + a * sn_; }
            *(u32x4*)(dst + 2 * (64 + 8 * c)) = (u32x4){pk2(o1[0], o1[1]), pk2(o1[2], o1[3]), pk2(o1[4], o1[5]), pk2(o1[6], o1[7])};
            *(u32x4*)(dst + 2 * (80 + 8 * c)) = (u32x4){pk2(o2[0], o2[1]), pk2(o2[2], o2[3]), pk2(o2[4], o2[5]), pk2(o2[6], o2[7])};
        }
        P2_WSYNC();
        {
            unsigned char* outb = (unsigned char*)((bf16_t*)(ws + WS_Q) + ((size_t)h * KVROWS + 64 * blk) * 96);
            u32x4 t[12];
#pragma unroll
            for (int i = 0; i < 12; ++i) { const int c = 64 * i + lane, r = c / 12, pc = c % 12; t[i] = *(const u32x4*)(TS + r * P2_RS + 16 * pc); }
#pragma unroll
            for (int i = 0; i < 12; ++i) *(u32x4*)(outb + (size_t)(64 * i + lane) * 16) = t[i];
            P2_WSYNC();
        }
    }
    {
        {
            const bf16_t* srcb = (const bf16_t*)(ws + WS_KVB) + (size_t)(64 * blk) * 1024 + h * 128;
            const unsigned char* kpb = (const unsigned char*)((const float*)(ws + WS_KPE) + (size_t)(64 * blk) * 32);
            u32x4 t[8], e8[8];
#pragma unroll
            for (int i = 0; i < 8; ++i) { const int c = 64 * i + lane, r = c >> 3, pc = c & 7; t[i] = *(const u32x4*)(srcb + (size_t)r * 1024 + 8 * pc); e8[i] = *(const u32x4*)(kpb + (size_t)c * 16); }
#pragma unroll
            for (int i = 0; i < 8; ++i) { const int c = 64 * i + lane, r = c >> 3, pc = c & 7; *(u32x4*)(TS + r * P2_RS + 16 * pc) = t[i]; *(u32x4*)(TS + r * P2_RS + 128 + 16 * pc) = e8[i]; }
            P2_WSYNC();
        }
        u32x4 w[8]; f32x4 e[8];
#pragma unroll
        for (int c = 0; c < 8; ++c) { w[c] = *(const u32x4*)(trow + 16 * c); e[c] = *(const f32x4*)(trow + 128 + 16 * c); }
        float ss = 0.f;
#pragma unroll
        for (int c = 0; c < 8; ++c) { const float a0 = bflo(w[c].x), a1 = bfhi(w[c].x), a2 = bflo(w[c].y), a3 = bfhi(w[c].y), a4 = bflo(w[c].z), a5 = bfhi(w[c].z), a6 = bflo(w[c].w), a7 = bfhi(w[c].w);
            ss += (a0 * a0 + a1 * a1) + (a2 * a2 + a3 * a3) + (a4 * a4 + a5 * a5) + (a6 * a6 + a7 * a7);
            ss += (e[c].x * e[c].x + e[c].y * e[c].y) + (e[c].z * e[c].z + e[c].w * e[c].w); }
        const float rs = valid ? 1.f / sqrtf(ss * (1.f / 96.f) + EPS) : 0.f;
        unsigned char* dst = trow;
#pragma unroll
        for (int c = 0; c < 8; ++c) {
            const f32x4 g0 = *(const f32x4*)(kn + 8 * c), g1 = *(const f32x4*)(kn + 8 * c + 4);
            *(u32x4*)(dst + 16 * c) = (u32x4){pk2(bflo(w[c].x) * rs * g0.x, bfhi(w[c].x) * rs * g0.y), pk2(bflo(w[c].y) * rs * g0.z, bfhi(w[c].y) * rs * g0.w),
                                              pk2(bflo(w[c].z) * rs * g1.x, bfhi(w[c].z) * rs * g1.y), pk2(bflo(w[c].w) * rs * g1.z, bfhi(w[c].w) * rs * g1.w)};
        }
#pragma unroll
        for (int c = 0; c < 2; ++c) {
            const float x1[8] = {e[2 * c].x, e[2 * c].y, e[2 * c].z, e[2 * c].w, e[2 * c + 1].x, e[2 * c + 1].y, e[2 * c + 1].z, e[2 * c + 1].w};
            const float x2[8] = {e[4 + 2 * c].x, e[4 + 2 * c].y, e[4 + 2 * c].z, e[4 + 2 * c].w, e[5 + 2 * c].x, e[5 + 2 * c].y, e[5 + 2 * c].z, e[5 + 2 * c].w};
            float o1[8], o2[8];
#pragma unroll
            for (int t = 0; t < 8; ++t) { float sn_, cs_; rot(8 * c + t, sn_, cs_); const float a = x1[t] * rs * kn[64 + 8 * c + t], b = x2[t] * rs * kn[80 + 8 * c + t]; o1[t] = a * cs_ - b * sn_; o2[t] = b * cs_ + a * sn_; }
            *(u32x4*)(dst + 2 * (64 + 8 * c)) = (u32x4){pk2(o1[0], o1[1]), pk2(o1[2], o1[3]), pk2(o1[4], o1[5]), pk2(o1[6], o1[7])};
            *(u32x4*)(dst + 2 * (80 + 8 * c)) = (u32x4){pk2(o2[0], o2[1]), pk2(o2[2], o2[3]), pk2(o2[4], o2[5]), pk2(o2[6], o2[7])};
        }
        P2_WSYNC();
        {
            unsigned char* outb = (unsigned char*)((bf16_t*)(ws + WS_K) + ((size_t)h * KVROWS + 64 * blk) * 96);
            u32x4 t[12];
#pragma unroll
            for (int i = 0; i < 12; ++i) { const int c = 64 * i + lane, r = c / 12, pc = c % 12; t[i] = *(const u32x4*)(TS + r * P2_RS + 16 * pc); }
#pragma unroll
            for (int i = 0; i < 12; ++i) *(u32x4*)(outb + (size_t)(64 * i + lane) * 16) = t[i];
            P2_WSYNC();
        }
    }
    {
        unsigned char* T = TS;
        const bf16_t* src = (const bf16_t*)(ws + WS_KVB) + h * 128 + 64;
#pragma unroll
        for (int it = 0; it < 8; ++it) {
            const int pr = 8 * it + (lane >> 3), ch = lane & 7; const int pp = 64 * blk + pr;
            u32x4 v = (u32x4){0u, 0u, 0u, 0u};
            if (pp >= PADL && pp < LPV) v = *(const u32x4*)(src + (size_t)pp * 1024 + 8 * ch);
            unsigned char* tp = T + (8 * ch) * P2_TS + pr * 2;
            *(bf16_t*)(tp + 0 * P2_TS) = (bf16_t)(v.x & 0xffffu); *(bf16_t*)(tp + 1 * P2_TS) = (bf16_t)(v.x >> 16);
            *(bf16_t*)(tp + 2 * P2_TS) = (bf16_t)(v.y & 0xffffu); *(bf16_t*)(tp + 3 * P2_TS) = (bf16_t)(v.y >> 16);
            *(bf16_t*)(tp + 4 * P2_TS) = (bf16_t)(v.z & 0xffffu); *(bf16_t*)(tp + 5 * P2_TS) = (bf16_t)(v.z >> 16);
            *(bf16_t*)(tp + 6 * P2_TS) = (bf16_t)(v.w & 0xffffu); *(bf16_t*)(tp + 7 * P2_TS) = (bf16_t)(v.w >> 16);
        }
        __builtin_amdgcn_s_waitcnt(0); __builtin_amdgcn_wave_barrier();
        bf16_t* VT = (bf16_t*)(ws + WS_VT) + (size_t)h * 64 * KVROWS + 64 * blk;
#pragma unroll
        for (int it = 0; it < 8; ++it) {
            const int e = 8 * it + (lane >> 3), ch = lane & 7;
            const u32x2 lo = *(const u32x2*)(T + e * P2_TS + 16 * ch), hi = *(const u32x2*)(T + e * P2_TS + 16 * ch + 8);
            *(u32x4*)(VT + (size_t)e * KVROWS + 8 * ch) = (u32x4){lo.x, lo.y, hi.x, hi.y};
        }
        __builtin_amdgcn_s_waitcnt(0); __builtin_amdgcn_wave_barrier();
    }
}

constexpr int A_KSTR = 208;
constexpr int A_VSTR = 136;
constexpr int A_KBYTES = 64 * A_KSTR;
constexpr int A_VBYTES = 64 * A_VSTR;
constexpr int A_BUF = A_KBYTES + A_VBYTES;
DI unsigned cvtpk_s(float lo, float hi) { typedef float f2 __attribute__((ext_vector_type(2))); typedef __bf16 b2 __attribute__((ext_vector_type(2))); f2 v = {lo, hi}; b2 b = __builtin_convertvector(v, b2); return __builtin_bit_cast(unsigned, b); }

DI void attn_item(const Frame& F, const Args& A, int h, int qb) {
    unsigned char* ws = A.ws; unsigned char* lds = F.lds;
    const int tid = F.tid, lane = F.lane, wave = F.wave, r32 = lane & 31, hh = lane >> 5;
    const bf16_t* Qg = (const bf16_t*)(ws + WS_Q) + (size_t)h * KVROWS * 96;
    const bf16_t* Kg = (const bf16_t*)(ws + WS_K) + (size_t)h * KVROWS * 96;
    const bf16_t* Vg = (const bf16_t*)(ws + WS_VT) + (size_t)h * 64 * KVROWS;
    const int p0w = 64 + 256 * qb + 32 * wave;
    const int qp = p0w + r32;
    const int ntile = 4 * qb + 5;
    const int mylast = 1 + 4 * qb + (wave >> 1);
    bf16x8 qf[6];
#pragma unroll
    for (int s = 0; s < 6; ++s) qf[s] = *(const bf16x8*)(Qg + (size_t)qp * 96 + 16 * s + 8 * hh);
    f32x16 ot[2]; ot[0] = zero16(); ot[1] = zero16();
    float mrun = -1e30f, lrun = 0.f;
    const int kr0 = tid / 12, kc0 = tid % 12, kr1 = (tid + 512) / 12, kc1 = (tid + 512) % 12; const bool k1ok = tid < 256;
    const int vr = tid >> 3, vc = tid & 7;
    struct Stg { u32x4 k0, k1, v; };
    Stg sA;
    auto gload = [&](Stg& st, int j) {
        const int kv0 = 64 * j;
        st.k0 = *(const u32x4*)(Kg + (size_t)(kv0 + kr0) * 96 + kc0 * 8);
        if (k1ok) st.k1 = *(const u32x4*)(Kg + (size_t)(kv0 + kr1) * 96 + kc1 * 8);
        st.v = *(const u32x4*)(Vg + (size_t)vr * KVROWS + kv0 + vc * 8);
    };
    auto lstore = [&](const Stg& st, int t) {
        unsigned char* kb = lds + (t % 3) * A_BUF; unsigned char* vb = kb + A_KBYTES;
        *(u32x4*)(kb + kr0 * A_KSTR + kc0 * 16) = st.k0;
        if (k1ok) *(u32x4*)(kb + kr1 * A_KSTR + kc1 * 16) = st.k1;
        *(u32x2*)(vb + vr * A_VSTR + vc * 16) = (u32x2){st.v.x, st.v.y};
        *(u32x2*)(vb + vr * A_VSTR + vc * 16 + 8) = (u32x2){st.v.z, st.v.w};
    };
    auto step = [&](auto FIRSTc, auto LASTc, int t, f32x16 (&C)[2], f32x16 (&P)[2]) {
        if (t + 1 < ntile) gload(sA, t + 1);
        constexpr bool has_cur = !decltype(LASTc)::value, has_prev = !decltype(FIRSTc)::value;
        const unsigned char* kb = lds + (t % 3) * A_BUF;
        const unsigned char* vb = lds + ((t + 2) % 3) * A_BUF + A_KBYTES;
        bf16x8 kf[2][6];
        if constexpr (has_cur) {
            const unsigned char* kp = kb + r32 * A_KSTR + hh * 16;
#pragma unroll
            for (int s = 0; s < 6; ++s) kf[0][s] = *(const bf16x8*)(kp + s * 32);
        }
        float ps0 = 0.f, ps1 = 0.f; u32x4 pw[4]; bf16x8 vfr[4][2];
        auto vload = [&](int g) -> bf16x8 {
            const int f = g >> 1, eh = g & 1, kh2 = f >> 1, s2 = f & 1;
            const unsigned char* vp = vb + (32 * eh + r32) * A_VSTR + (32 * kh2 + 16 * s2 + 4 * hh) * 2;
            const u32x2 lo = *(const u32x2*)vp, hi2 = *(const u32x2*)(vp + 16);
            return __builtin_bit_cast(bf16x8, (u32x4){lo.x, lo.y, hi2.x, hi2.y}); };
        __builtin_amdgcn_sched_barrier(0);
#pragma unroll
        for (int i = 0; i < 12; ++i) {
            const int kh = i / 6, sx = i % 6;
            if constexpr (has_cur) { C[kh] = mfma32(kf[kh][sx], qf[sx], sx == 0 ? zero16() : C[kh]); if (i < 6) kf[1][i] = *(const bf16x8*)(kb + (32 + r32) * A_KSTR + hh * 16 + i * 32); }
            if (has_prev && i < 8) {
                const int f = i >> 1, kh2 = f >> 1, b0 = 8 * (f & 1) + 4 * (i & 1);
                const float v0 = P[kh2][b0], v1 = P[kh2][b0 + 1], v2 = P[kh2][b0 + 2], v3 = P[kh2][b0 + 3];
                ps0 += v0 + v1; ps1 += v2 + v3;
                if (i & 1) { pw[f].z = cvtpk_s(v0, v1); pw[f].w = cvtpk_s(v2, v3); asm volatile("" : "+v"(ps0), "+v"(ps1), "+v"(pw[f].z), "+v"(pw[f].w)); }
                else { pw[f].x = cvtpk_s(v0, v1); pw[f].y = cvtpk_s(v2, v3); asm volatile("" : "+v"(ps0), "+v"(ps1), "+v"(pw[f].x), "+v"(pw[f].y)); }
            }
            if (has_prev && i >= 10) {
                const int g0 = i - 10; vfr[g0 >> 1][g0 & 1] = vload(g0);
            }
            __builtin_amdgcn_sched_barrier(0);
        }
        if (has_prev) lrun += ps0 + ps1;
        float mnew = mrun, alpha = 1.f; bool resc = false;
        if constexpr (has_cur) {
            if (t == 0) {
#pragma unroll
                for (int kh = 0; kh < 2; ++kh)
#pragma unroll
                    for (int r = 0; r < 16; ++r) { const int kv = 32 * kh + crow(r, hh); if (kv < PADL) C[kh][r] = -INFINITY; }
            }
            if (t >= mylast) {
#pragma unroll
                for (int kh = 0; kh < 2; ++kh)
#pragma unroll
                    for (int r = 0; r < 16; ++r) { const int kv = 64 * t + 32 * kh + crow(r, hh); if (kv > qp) C[kh][r] = -INFINITY; }
            }
            float mx = C[0][0];
#pragma unroll
            for (int r = 1; r < 16; ++r) mx = fmaxf(mx, C[0][r]);
#pragma unroll
            for (int r = 0; r < 16; ++r) mx = fmaxf(mx, C[1][r]);
            mx = fmaxf(mx, __shfl_xor(mx, 32));
            mnew = fmaxf(mrun, mx);
            alpha = __builtin_amdgcn_exp2f(mrun - mnew);
            resc = __any(mnew > mrun);
        }
        __builtin_amdgcn_sched_barrier(0);
#pragma unroll
        for (int g = 0; g < 8; ++g) {
            const int f = g >> 1, eh = g & 1;
            if constexpr (has_prev) { ot[eh] = mfma32(vfr[f][eh], __builtin_bit_cast(bf16x8, pw[f]), ot[eh]); if (g + 2 < 8) vfr[(g + 2) >> 1][(g + 2) & 1] = vload(g + 2); }
            if constexpr (has_cur) { const int kh = g >> 2, r0 = 4 * (g & 3);
#pragma unroll
                for (int q = 0; q < 4; ++q) C[kh][r0 + q] = __builtin_amdgcn_exp2f(C[kh][r0 + q] - mnew);
                asm volatile("" : "+v"(C[kh][r0]), "+v"(C[kh][r0 + 1]), "+v"(C[kh][r0 + 2]), "+v"(C[kh][r0 + 3])); }
            __builtin_amdgcn_sched_barrier(0);
        }
        if constexpr (has_cur) {
            if (resc) {
#pragma unroll
                for (int eh = 0; eh < 2; ++eh)
#pragma unroll
                    for (int r = 0; r < 16; ++r) ot[eh][r] *= alpha;
            }
            lrun *= alpha; mrun = mnew;
        }
        if (t + 1 < ntile) lstore(sA, t + 1);
        __syncthreads();
    };
    gload(sA, 0); lstore(sA, 0);
    __syncthreads();
    f32x16 scA[2], scB[2];
    scB[0] = zero16(); scB[1] = zero16();
    {
        using TT = std::integral_constant<bool, true>; using FF = std::integral_constant<bool, false>;
        step(TT{}, FF{}, 0, scA, scB);
#pragma unroll 1
        for (int t = 1; t + 1 < ntile; t += 2) {
            step(FF{}, FF{}, t, scB, scA);
            step(FF{}, FF{}, t + 1, scA, scB);
        }
        step(FF{}, TT{}, ntile, scB, scA);
    }
    const float ltot = lrun + __shfl_xor(lrun, 32);
    const float rl = 1.f / ltot;
    bf16_t* o = (bf16_t*)(ws + WS_MIX) + (size_t)(qp - 64) * 1024 + 512 + h * 64;
#pragma unroll
    for (int eh = 0; eh < 2; ++eh)
#pragma unroll
        for (int a = 0; a < 4; ++a) {
            const int e = 32 * eh + 8 * a + 4 * hh;
            *(u32x2*)(o + e) = (u32x2){pk2(ot[eh][4 * a] * rl, ot[eh][4 * a + 1] * rl), pk2(ot[eh][4 * a + 2] * rl, ot[eh][4 * a + 3] * rl)};
        }
}

DI void xn_rows(const Frame& F, const Args& A, int u0, int stride) {
    f32x4 v[2][4];
#pragma unroll
    for (int r = 0; r < 2; ++r) { const int u = u0 + r * stride; if (u < MU) { const f32x4* xr = (const f32x4*)(A.out + (size_t)u * DM) + F.lane;
#pragma unroll
        for (int j = 0; j < 4; ++j) v[r][j] = xr[64 * j]; } }
#pragma unroll
    for (int r = 0; r < 2; ++r) {
        const int u = u0 + r * stride; if (u >= MU) continue;
        float s = 0.f;
#pragma unroll
        for (int j = 0; j < 4; ++j) s += (v[r][j].x * v[r][j].x + v[r][j].y * v[r][j].y) + (v[r][j].z * v[r][j].z + v[r][j].w * v[r][j].w);
        const float rstd = 1.f / sqrtf(wave_sum(s) * (1.f / DM) + EPS);
        unsigned long long* o8 = (unsigned long long*)((bf16_t*)(A.ws + WS_XN) + (size_t)u * DM) + F.lane;
#pragma unroll
        for (int j = 0; j < 4; ++j) { const f32x4 w = ((const f32x4*)A.in[15])[64 * j + F.lane];
            o8[64 * j] = (unsigned long long)pk2(v[r][j].x * rstd * w.x, v[r][j].y * rstd * w.y) | ((unsigned long long)pk2(v[r][j].z * rstd * w.z, v[r][j].w * rstd * w.w) << 32); }
    }
}

DI unsigned fkey(float v, int idx) { unsigned u = __builtin_bit_cast(unsigned, v); u = (u & 0x80000000u) ? ~u : (u | 0x80000000u); return (u & ~127u) | (unsigned)(127 - idx); }
DI float keyval(unsigned k) { unsigned u = k & ~127u; u = (u & 0x80000000u) ? (u & 0x7fffffffu) : ~u; return __builtin_bit_cast(float, u); }

__device__ const unsigned char PAIR_A[50] = {0,0,0,0,0,0,0,0,0,0,0,0,0,0,0,0, 1,1,1,1,1,1,1,1, 2,2,2,2,2, 3,3,3,3, 4,4,4, 5,5, 6,6, 7,7, 8,9,10,11,12,13,14,15};
__device__ const unsigned char PAIR_B[50] = {0,1,2,3,4,5,6,7,8,9,10,11,12,13,14,15, 0,1,2,3,4,5,6,7, 0,1,2,3,4, 0,1,2,3, 0,1,2, 0,1, 0,1, 0,1, 0,0,0,0,0,0,0,0};

DI void ce_desc(unsigned& a, unsigned& b) { const unsigned mx = a > b ? a : b, mn = a > b ? b : a; a = mx; b = mn; }
template <int BASE, int NK> DI void bitonic_sort16_desc(unsigned (&x)[NK]) {
#pragma unroll
    for (int k = 2; k <= 16; k <<= 1)
#pragma unroll
        for (int j = k >> 1; j > 0; j >>= 1)
#pragma unroll
            for (int i = 0; i < 16; ++i) { const int l = i ^ j; if (l > i) { if ((i & k) == 0) ce_desc(x[BASE + i], x[BASE + l]); else ce_desc(x[BASE + l], x[BASE + i]); } }
}
template <int A0, int B0, int NK> DI void merge_top16(unsigned (&x)[NK]) {
#pragma unroll
    for (int i = 0; i < 16; ++i) { const unsigned p = x[A0 + i], q = x[B0 + 15 - i]; x[A0 + i] = p > q ? p : q; }
#pragma unroll
    for (int j = 8; j > 0; j >>= 1)
#pragma unroll
        for (int i = 0; i < 16; ++i) { const int l = i ^ j; if (l > i) ce_desc(x[A0 + i], x[A0 + l]); }
}
template <int NK> DI void top16_of_128(unsigned (&key)[NK]) {
    bitonic_sort16_desc<0, NK>(key); bitonic_sort16_desc<16, NK>(key); bitonic_sort16_desc<32, NK>(key); bitonic_sort16_desc<48, NK>(key);
    bitonic_sort16_desc<64, NK>(key); bitonic_sort16_desc<80, NK>(key); bitonic_sort16_desc<96, NK>(key); bitonic_sort16_desc<112, NK>(key);
    merge_top16<0, 16, NK>(key); merge_top16<32, 48, NK>(key); merge_top16<64, 80, NK>(key); merge_top16<96, 112, NK>(key);
    merge_top16<0, 32, NK>(key); merge_top16<64, 96, NK>(key);
    merge_top16<0, 64, NK>(key);
}

DI void topk_task(const Frame& F, const Args& A, int task) {
    unsigned char* ws = A.ws; const int tid = F.tid;
    const int u = task >> 3, h = task & 7;
    LAS unsigned* sk = (LAS unsigned*)(LAS unsigned char*)F.lds;
    LAS unsigned* pkk = sk + 16384;
    LAS unsigned* stg = sk + 16384;
    const bf16_t* SCb = (const bf16_t*)(ws + WS_SC) + (size_t)(task & ~511) * 256;
#pragma unroll 1
    for (int half = 0; half < 2; ++half) {
        unsigned key[128];
#pragma unroll
        for (int qb = 0; qb < 2; ++qb) {
            u32x4 pf[8];
#pragma unroll
            for (int k = 0; k < 8; ++k) { const int c = tid + 512 * k; pf[k] = *(const u32x4*)(SCb + (size_t)(c >> 3) * 256 + half * 128 + qb * 64 + (c & 7) * 8); }
#pragma unroll
            for (int k = 0; k < 8; ++k) { const int c = tid + 512 * k; *(LAS u32x4*)(stg + (c >> 3) * 36 + (c & 7) * 4) = pf[k]; }
            __syncthreads();
#pragma unroll
            for (int i = 0; i < 8; ++i) { const u32x4 v = *(const LAS u32x4*)(stg + tid * 36 + 4 * i); const int b0 = 64 * qb + 8 * i;
                key[b0] = fkey(bflo(v.x), b0); key[b0 + 1] = fkey(bfhi(v.x), b0 + 1); key[b0 + 2] = fkey(bflo(v.y), b0 + 2); key[b0 + 3] = fkey(bfhi(v.y), b0 + 3);
                key[b0 + 4] = fkey(bflo(v.z), b0 + 4); key[b0 + 5] = fkey(bfhi(v.z), b0 + 5); key[b0 + 6] = fkey(bflo(v.w), b0 + 6); key[b0 + 7] = fkey(bfhi(v.w), b0 + 7); }
            __syncthreads();
        }
        top16_of_128(key);
#pragma unroll
        for (int r = 0; r < 16; ++r) sk[(half * 16 + r) * 512 + tid] = key[r];
    }
    float v1[16], v2[16];
#pragma unroll
    for (int r = 0; r < 16; ++r) { v1[r] = keyval(sk[r * 512 + tid]); v2[r] = keyval(sk[(16 + r) * 512 + tid]); }
    unsigned ck[64];
#pragma unroll
    for (int c = 50; c < 64; ++c) ck[c] = 0u;
#pragma unroll
    for (int a = 0; a < 16; ++a) {
        const int off = a == 0 ? 0 : a == 1 ? 16 : a == 2 ? 24 : a == 3 ? 29 : a == 4 ? 33 : a == 5 ? 36 : a == 6 ? 38 : a == 7 ? 40 : 42 + (a - 8);
#pragma unroll
        for (int b = 0; b < 16; ++b) if ((a + 1) * (b + 1) <= 16) ck[off + b] = fkey(v1[a] + v2[b], off + b);
    }
    bitonic_sort16_desc<0, 64>(ck); bitonic_sort16_desc<16, 64>(ck); bitonic_sort16_desc<32, 64>(ck); bitonic_sort16_desc<48, 64>(ck);
    merge_top16<0, 16, 64>(ck); merge_top16<32, 48, 64>(ck); merge_top16<0, 32, 64>(ck);
#pragma unroll
    for (int r = 0; r < 16; ++r) pkk[r * 512 + tid] = ck[r];
    const float cmax = keyval(pkk[tid]);
    float ev[16]; float esum = 0.f; int ex[16];
#pragma unroll
    for (int r = 0; r < 16; ++r) {
        const unsigned k = pkk[r * 512 + tid]; const int c = 127 - (int)(k & 127u);
        ev[r] = __expf(keyval(k) - cmax); esum += ev[r];
        const int a = PAIR_A[c], b = PAIR_B[c];
        const int i1 = 127 - (int)(sk[a * 512 + tid] & 127u), i2 = 127 - (int)(sk[(16 + b) * 512 + tid] & 127u);
        ex[r] = i1 * 128 + i2;
    }
    const float rs = 1.f / esum;
    int* IDX = (int*)(ws + WS_IDX) + (size_t)u * 128 + h * 16; float* GATE = (float*)(ws + WS_GATE) + (size_t)u * 128 + h * 16;
#pragma unroll
    for (int r = 0; r < 16; r += 4) {
        *(int4*)(IDX + r) = make_int4(ex[r], ex[r + 1], ex[r + 2], ex[r + 3]);
        *(f32x4*)(GATE + r) = (f32x4){ev[r] * rs, ev[r + 1] * rs, ev[r + 2] * rs, ev[r + 3] * rs};
    }
}

constexpr float EU_SCALE = 64.f, EV_SCALE = 16.f;
DI unsigned pk4_fp8(float a, float b, float c, float d) { int w = 0; w = __builtin_amdgcn_cvt_pk_fp8_f32(a, b, w, false); w = __builtin_amdgcn_cvt_pk_fp8_f32(c, d, w, true); return (unsigned)w; }
DI void convert_tables(const Frame& F, const Args& A) {
    const size_t n16 = (size_t)16384 * 1024 / 16;
    const size_t gt = (size_t)blockIdx.x * 512 + F.tid, NGT = (size_t)F.G * 512;
#pragma unroll 1
    for (int t = 0; t < 2; ++t) {
        const float* src = A.in[18 + t]; unsigned char* dst = A.ws + (t ? WS_EV : WS_EU); const float sc = t ? EV_SCALE : EU_SCALE;
        const float* fn = A.in[15];
        for (size_t i = gt; i < n16; i += NGT) {
            f32x4 a = *(const f32x4*)(src + i * 16) * sc, b = *(const f32x4*)(src + i * 16 + 4) * sc, c = *(const f32x4*)(src + i * 16 + 8) * sc, d = *(const f32x4*)(src + i * 16 + 12) * sc;
            if (t == 0) { const float* g = fn + (i & 63) * 16; a *= *(const f32x4*)g; b *= *(const f32x4*)(g + 4); c *= *(const f32x4*)(g + 8); d *= *(const f32x4*)(g + 12); }
            const size_t e_ = i >> 6, c16_ = i & 63;
            *(u32x4*)(dst + (c16_ >> 3) * ((size_t)16384 * 128) + e_ * 128 + (c16_ & 7) * 16) = (u32x4){pk4_fp8(a.x, a.y, a.z, a.w), pk4_fp8(b.x, b.y, b.z, b.w), pk4_fp8(c.x, c.y, c.z, c.w), pk4_fp8(d.x, d.y, d.z, d.w)};
        }
    }
}

DI float gelu_exact(float x) { return 0.5f * x * (1.f + erff(x * 0.70710678118654752f)); }
typedef float f32x2 __attribute__((ext_vector_type(2)));
#define UNPK16(dst, W_) do { f32x2 _t; \
    _t = __builtin_amdgcn_cvt_pk_f32_fp8((int)(W_).x, false); dst[0] = _t.x; dst[1] = _t.y; _t = __builtin_amdgcn_cvt_pk_f32_fp8((int)(W_).x, true); dst[2] = _t.x; dst[3] = _t.y; \
    _t = __builtin_amdgcn_cvt_pk_f32_fp8((int)(W_).y, false); dst[4] = _t.x; dst[5] = _t.y; _t = __builtin_amdgcn_cvt_pk_f32_fp8((int)(W_).y, true); dst[6] = _t.x; dst[7] = _t.y; \
    _t = __builtin_amdgcn_cvt_pk_f32_fp8((int)(W_).z, false); dst[8] = _t.x; dst[9] = _t.y; _t = __builtin_amdgcn_cvt_pk_f32_fp8((int)(W_).z, true); dst[10] = _t.x; dst[11] = _t.y; \
    _t = __builtin_amdgcn_cvt_pk_f32_fp8((int)(W_).w, false); dst[12] = _t.x; dst[13] = _t.y; _t = __builtin_amdgcn_cvt_pk_f32_fp8((int)(W_).w, true); dst[14] = _t.x; dst[15] = _t.y; } while (0)

template <bool UPH>
DI void expert_phase(const Frame& F, const Args& A, int xv, int wq, int nw) {
    unsigned char* ws = A.ws; const int lane = F.lane, grp = lane >> 3, j = lane & 7;
    const unsigned char* TBL = ws + (UPH ? WS_EU : WS_EV) + (size_t)xv * ((size_t)16384 * 128) + 16 * j;
    const int* IDX = (const int*)(ws + WS_IDX); const float* CW = (const float*)(ws + WS_CW);
    const bf16_t* XN = (const bf16_t*)(ws + WS_XN) + 128 * xv + 16 * j;
    float* HP = (float*)(ws + WS_HP);
    LAS unsigned* ring = (LAS unsigned*)((LAS unsigned char*)F.lds + F.wave * 4096);
    const int nt = (MU - wq + nw - 1) / nw;
    if (nt <= 0) return;
    auto tok = [&](int k) { return __builtin_amdgcn_readfirstlane(wq + (k < nt ? k : nt - 1) * nw); };
    int mi0, mi1; u32x4 mx0, mx1; float mh0, mh1;
    auto meta_load = [&](int k) {
        const int u = tok(k);
        mi0 = IDX[(size_t)u * 128 + lane]; mi1 = IDX[(size_t)u * 128 + 64 + lane];
        if constexpr (UPH) { mx0 = *(const u32x4*)(XN + (size_t)u * DM); mx1 = *(const u32x4*)(XN + (size_t)u * DM + 8); }
        else { mh0 = CW[(size_t)u * 128 + lane]; mh1 = CW[(size_t)u * 128 + 64 + lane]; }
    };
    auto meta_store = [&](int k) {
        LAS unsigned* sl = ring + (k & 3) * 256;
        sl[lane] = (unsigned)mi0; sl[64 + lane] = (unsigned)mi1;
        if constexpr (UPH) { if (grp == 0) { *(LAS u32x4*)(sl + 128 + 8 * j) = mx0; *(LAS u32x4*)(sl + 128 + 8 * j + 4) = mx1; } }
        else { sl[128 + lane] = __builtin_bit_cast(unsigned, mh0); sl[192 + lane] = __builtin_bit_cast(unsigned, mh1); }
    };
    auto gather = [&](u32x4 (&buf)[8], int n) {
        const LAS unsigned* sl = ring + ((n >> 1) & 3) * 256 + 64 * (n & 1) + grp;
#pragma unroll
        for (int i = 0; i < 8; ++i) { const int e = (int)sl[8 * i]; buf[i] = *(const u32x4*)(TBL + (size_t)e * 128); }
    };
    const int ocol = 128 * xv + 16 * j + ((lane & 32) ? 8 : 0) + ((lane & 16) ? 4 : 0) + ((lane & 8) ? 2 : 0);
    f32x2 ocur = (f32x2){0.f, 0.f};
    float acc[16];
    float xn[16];
    auto compute = [&](u32x4 (&buf)[8], int n) {
        const int k = n >> 1, hf = n & 1;
        const LAS unsigned* sl = ring + (k & 3) * 256;
        if (hf == 0) {
            if constexpr (UPH) {
                const u32x4 x0 = *(const LAS u32x4*)(sl + 128 + 8 * j), x1 = *(const LAS u32x4*)(sl + 128 + 8 * j + 4);
                xn[0] = bflo(x0.x); xn[1] = bfhi(x0.x); xn[2] = bflo(x0.y); xn[3] = bfhi(x0.y); xn[4] = bflo(x0.z); xn[5] = bfhi(x0.z); xn[6] = bflo(x0.w); xn[7] = bfhi(x0.w);
                xn[8] = bflo(x1.x); xn[9] = bfhi(x1.x); xn[10] = bflo(x1.y); xn[11] = bfhi(x1.y); xn[12] = bflo(x1.z); xn[13] = bfhi(x1.z); xn[14] = bflo(x1.w); xn[15] = bfhi(x1.w);
            } else {
#pragma unroll
                for (int c = 0; c < 16; ++c) acc[c] = 0.f;
                ocur = *(const f32x2*)(A.out + (size_t)tok(k) * DM + ocol);
            }
        }
#pragma unroll
        for (int i = 0; i < 8; ++i) {
            float f[16]; UNPK16(f, buf[i]);
            if constexpr (UPH) {
                float a0 = 0.f, a1 = 0.f;
#pragma unroll
                for (int c = 0; c < 16; c += 2) { a0 += f[c] * xn[c]; a1 += f[c + 1] * xn[c + 1]; }
                if (hf == 0) acc[i] = a0 + a1; else acc[8 + i] = a0 + a1;
                if (i < 7) { if (hf == 0) asm volatile("" : "+v"(buf[i + 1].x), "+v"(buf[i + 1].y), "+v"(buf[i + 1].z), "+v"(buf[i + 1].w), "+v"(acc[i]));
                             else asm volatile("" : "+v"(buf[i + 1].x), "+v"(buf[i + 1].y), "+v"(buf[i + 1].z), "+v"(buf[i + 1].w), "+v"(acc[8 + i])); }
            } else {
                const float cw = __builtin_bit_cast(float, sl[128 + 64 * hf + 8 * i + grp]);
#pragma unroll
                for (int c = 0; c < 16; ++c) acc[c] += cw * f[c];
                if (i < 7) asm volatile("" : "+v"(buf[i + 1].x), "+v"(buf[i + 1].y), "+v"(buf[i + 1].z), "+v"(buf[i + 1].w),
                                             "+v"(acc[0]), "+v"(acc[1]), "+v"(acc[2]), "+v"(acc[3]), "+v"(acc[4]), "+v"(acc[5]), "+v"(acc[6]), "+v"(acc[7]),
                                             "+v"(acc[8]), "+v"(acc[9]), "+v"(acc[10]), "+v"(acc[11]), "+v"(acc[12]), "+v"(acc[13]), "+v"(acc[14]), "+v"(acc[15]));
            }
            __builtin_amdgcn_sched_barrier(0);
        }
        if (hf == 1 && k < nt) {
            const int u = tok(k);
            float r8[8], r4[4], r2[2];
            if constexpr (UPH) {
                { const bool up = lane & 4;
#pragma unroll
                  for (int i = 0; i < 8; ++i) { const float send = up ? acc[i] : acc[i + 8], keep = up ? acc[i + 8] : acc[i]; r8[i] = keep + __shfl_xor(send, 4); } }
                { const bool up = lane & 2;
#pragma unroll
                  for (int i = 0; i < 4; ++i) { const float send = up ? r8[i] : r8[i + 4], keep = up ? r8[i + 4] : r8[i]; r4[i] = keep + __shfl_xor(send, 2); } }
                { const bool up = lane & 1;
#pragma unroll
                  for (int i = 0; i < 2; ++i) { const float send = up ? r4[i] : r4[i + 2], keep = up ? r4[i + 2] : r4[i]; r2[i] = keep + __shfl_xor(send, 1); } }
                const int st = ((lane & 4) ? 8 : 0) + ((lane & 2) ? 4 : 0) + ((lane & 1) ? 2 : 0);
                float* hp = HP + ((size_t)xv * MU + u) * 128 + grp;
                hp[8 * st] = r2[0]; hp[8 * (st + 1)] = r2[1];
            } else {
                { const bool up = lane & 32;
#pragma unroll
                  for (int c = 0; c < 8; ++c) { const float send = up ? acc[c] : acc[c + 8], keep = up ? acc[c + 8] : acc[c]; r8[c] = keep + __shfl_xor(send, 32); } }
                { const bool up = lane & 16;
#pragma unroll
                  for (int c = 0; c < 4; ++c) { const float send = up ? r8[c] : r8[c + 4], keep = up ? r8[c + 4] : r8[c]; r4[c] = keep + __shfl_xor(send, 16); } }
                { const bool up = lane & 8;
#pragma unroll
                  for (int c = 0; c < 2; ++c) { const float send = up ? r4[c] : r4[c + 2], keep = up ? r4[c + 2] : r4[c]; r2[c] = keep + __shfl_xor(send, 8); } }
                f32x2* o = (f32x2*)(A.out + (size_t)u * DM + ocol);
                f32x2 cur = ocur; cur.x += r2[0]; cur.y += r2[1]; *o = cur;
            }
        }
    };
    meta_load(0); meta_store(0); meta_load(1); meta_store(1); meta_load(2); meta_store(2);
    u32x4 b0[8], b1[8], b2[8];
    gather(b0, 0); gather(b1, 1); gather(b2, 2);
#pragma unroll 1
    for (int k0 = 0; k0 < nt; k0 += 3) {
        const int n0 = 2 * k0;
        meta_load(k0 + 3);
        compute(b0, n0);     gather(b0, n0 + 3);
        compute(b1, n0 + 1); meta_store(k0 + 3); gather(b1, n0 + 4);
        meta_load(k0 + 4);
        compute(b2, n0 + 2); gather(b2, n0 + 5);
        compute(b0, n0 + 3); meta_store(k0 + 4); gather(b0, n0 + 6);
        meta_load(k0 + 5);
        compute(b1, n0 + 4); gather(b1, n0 + 7);
        compute(b2, n0 + 5); meta_store(k0 + 5); gather(b2, n0 + 8);
    }
}


DI void expert_c_pass(const Frame& F, const Args& A) {
    unsigned char* ws = A.ws;
    const float* HP = (const float*)(ws + WS_HP); const float* GATE = (const float*)(ws + WS_GATE); float* CW = (float*)(ws + WS_CW);
    const size_t n4 = (size_t)MU * 128 / 4;
    for (size_t i = (size_t)blockIdx.x * 512 + F.tid; i < n4; i += (size_t)F.G * 512) {
        f32x4 h = *(const f32x4*)(HP + i * 4);
#pragma unroll
        for (int x = 1; x < 8; ++x) h += *(const f32x4*)(HP + (size_t)x * MU * 128 + i * 4);
        const f32x4 g = *(const f32x4*)(GATE + i * 4);
        const float rs = (1.f / EU_SCALE) / sqrtf(ss_sum16((const float*)(ws + WS_SS4), (int)(i >> 5)) * (1.f / DM) + EPS);
        f32x4 c;
        c.x = gelu_exact(h.x * rs) * g.x * (1.f / EV_SCALE); c.y = gelu_exact(h.y * rs) * g.y * (1.f / EV_SCALE);
        c.z = gelu_exact(h.z * rs) * g.z * (1.f / EV_SCALE); c.w = gelu_exact(h.w * rs) * g.w * (1.f / EV_SCALE);
        *(f32x4*)(CW + i * 4) = c;
    }
}
template <int PH> DI void run_phase(const Frame& F, const Args& args, PG8_LAS unsigned char* lds3) {
    unsigned char* ws = args.ws;
    if constexpr (PH == 0) { p0_prologue(F, args); p0_late_weights<0>(F, args, (7 - F.wave) * F.G + blockIdx.x, F.NGW, blockIdx.x * 512 + F.tid, F.G * 512); }
    if constexpr (PH == 1) {
        pg8::Gemm g{(const bf16_t*)(ws + WS_HN), (const bf16_t*)(ws + WS_WIN), MP, NPROJ, 1024, 1024, 1024, 0};
        pg8::StaticOrder S; S.init(MP, NPROJ, F.G, (int)blockIdx.x);
        EpiProj E{(bf16_t*)(ws + WS_QKVR), (bf16_t*)(ws + WS_Z), (float*)(ws + WS_BA), (bf16_t*)(ws + WS_CQN), (bf16_t*)(ws + WS_CKVN), (float*)(ws + WS_KPE), (float*)(ws + WS_SSQ), (float*)(ws + WS_SSK)};
        pg8::gemm_phase<EpiProj, pg8::StaticOrder, true, true>(lds3, g, S, E);
    }
    if constexpr (PH == 2) {
        gdn_prep_phase<0>(F, args);
        __syncthreads();
        const int G = F.G, c1 = ((int)blockIdx.x + G - 8 % G) % G, c2 = ((int)blockIdx.x + G - 208 % G) % G;
        { pg8::Gemm g{(const bf16_t*)(ws + WS_CQN), (const bf16_t*)(ws + WS_WUQ), MP, 768, 256, 256, 256, 0};
          pg8::StaticOrder S; S.init(MP, 768, G, c1); EpiB16 E{(bf16_t*)(ws + WS_QH), 768, (const float*)(ws + WS_SSQ), 1.f / 256.f, 4};
          pg8::gemm_phase<EpiB16, pg8::StaticOrder, true, true>(lds3, g, S, E); }
        { pg8::Gemm g{(const bf16_t*)(ws + WS_CKVN), (const bf16_t*)(ws + WS_WUKV), MP, 1024, 256, 256, 256, 0};
          pg8::StaticOrder S; S.init(MP, 1024, G, c2); EpiB16 E{(bf16_t*)(ws + WS_KVB), 1024, (const float*)(ws + WS_SSK), 1.f / 128.f, 4};
          pg8::gemm_phase<EpiB16, pg8::StaticOrder, true, true>(lds3, g, S, E); }
    }
    if constexpr (PH == 3) { for (int t = F.gw; t < (KVROWS / 64) * 8; t += F.NGW) mla_prep2_task(F, args, t); }
    if constexpr (PH == 4) {
        gdn_scan(F, args);
        volatile LAS unsigned* MISC = (volatile LAS unsigned*)(lds3 + MISC_OFF);
        unsigned* qhead = (unsigned*)(ws + WS_CTL) + CW_ATTQ;
        for (;;) {
            __syncthreads();
            if (F.tid == 0) MISC[24] = xb_add(qhead, 1u);
            __syncthreads();
            const int k = (int)MISC[24];
            if (k >= 512) break;
            attn_item(F, args, k & 7, 63 - (k >> 3));
        }
        p0_late_weights<1>(F, args, F.gw, F.NGW, blockIdx.x * 512 + F.tid, F.G * 512);
    }
    if constexpr (PH == 5) { for (int t = F.gw; t < 2048 * 2; t += F.NGW) gdn_out_task(F, args, t); }
    if constexpr (PH == 6) {
        pg8::Gemm g{(const bf16_t*)(ws + WS_MIX), (const bf16_t*)(ws + WS_WOUT), MU, 1024, 1024, 1024, 1024, 0};
        pg8::StaticOrder S; S.init(MU, 1024, F.G, (int)blockIdx.x); EpiH1 E{args.out, args.in[0], (bf16_t*)(ws + WS_XN), (float*)(ws + WS_SS4)};
        pg8::gemm_phase<EpiH1, pg8::StaticOrder, true, true>(lds3, g, S, E);
    }
    if constexpr (PH == 7) {
        pg8::Gemm g{(const bf16_t*)(ws + WS_XN), (const bf16_t*)(ws + WS_WPQ), MU, 2048, 1024, 1024, 1024, 0};
        pg8::StaticOrder S; S.init(MU, 2048, F.G, (int)blockIdx.x); EpiB16 E{(bf16_t*)(ws + WS_PQ), 2048, (const float*)(ws + WS_SS4), 1.f / 1024.f, 16};
        pg8::gemm_phase<EpiB16, pg8::StaticOrder, true, true>(lds3, g, S, E);
        __threadfence_block(); __syncthreads();
    }
    if constexpr (PH == 7) {
        pg8::Gemm g{(const bf16_t*)(ws + WS_PQ), (const bf16_t*)(ws + WS_SKB), MU, 2048, 256, 2048, 256, 256};
        pg8::StaticOrder S; S.init(MU, 2048, F.G, (int)blockIdx.x); EpiB16 E{(bf16_t*)(ws + WS_SC), 2048, nullptr, 0.f, 0};
        pg8::gemm_phase<EpiB16, pg8::StaticOrder, true, true>(lds3, g, S, E);
    }
    if constexpr (PH == 8) {
        convert_tables(F, args);
        for (int t = blockIdx.x * 512 + F.tid; t < MU * 8; t += F.G * 512) topk_task(F, args, t);
    }
    if constexpr (PH == 10) { expert_c_pass(F, args); }
    if constexpr (PH == 9 || PH == 11) {
        volatile LAS unsigned* MISC = (volatile LAS unsigned*)(lds3 + MISC_OFF);
        const unsigned x = MISC[16], rank = MISC[17];
        unsigned* bar = (unsigned*)(ws + WS_CTL);
        unsigned nloc = 0, nx = 0, myidx = 0;
#pragma unroll
        for (unsigned j = 0; j < 16; ++j) { const unsigned c = xb_ld(&bar[XB_XCNT(j)]); nx += (c > 0u) ? 1u : 0u; myidx += (c > 0u && j < x) ? 1u : 0u; nloc = (j == x) ? c : nloc; }
        const int wq = __builtin_amdgcn_readfirstlane((int)rank * 8 + F.wave), nw = __builtin_amdgcn_readfirstlane((int)nloc * 8);
        const int xstep = __builtin_amdgcn_readfirstlane((int)nx);
        for (int xv = __builtin_amdgcn_readfirstlane((int)myidx); xv < 8; xv += xstep)
            { if constexpr (PH == 9) expert_phase<true>(F, args, xv, wq, nw); else expert_phase<false>(F, args, xv, wq, nw); }
    }
}
constexpr int NPHASE = 12;
__global__ void __launch_bounds__(512, 2) fwd_kernel(Args args) {
    extern __shared__ __attribute__((aligned(16))) unsigned char lds[];
    Frame F;
    F.lds = lds; F.tid = threadIdx.x; F.lane = F.tid & 63; F.wave = __builtin_amdgcn_readfirstlane(F.tid >> 6);
    F.G = gridDim.x; F.gw = blockIdx.x * 8 + F.wave; F.NGW = F.G * 8;
    volatile LAS unsigned* MISC = (volatile LAS unsigned*)((LAS unsigned char*)lds + MISC_OFF);
    if (F.tid < 32) MISC[F.tid] = 0u;
    __syncthreads();
    unsigned char* ws = args.ws;
    const int lo = args.ph_lo, hi = args.ph_hi;
    XcdBarrier bar; bar.bar = (unsigned*)(ws + WS_CTL); bar.x = 0; bar.st = nullptr;
    if (hi - lo > 1) bar = xcd_barrier_post((unsigned*)(ws + WS_CTL), MISC + 8);
    if (F.tid == 0) { const unsigned x = xb_xcc_id(); MISC[16] = x; MISC[17] = xb_add((unsigned*)(ws + WS_CTL) + 3520 + 64 * x, 1u); }
    __syncthreads();
#define IN(k) (lo <= (k) && (k) < hi)
#define SEAM(k) do { if (IN(k) && IN((k) + 1)) xcd_barrier(bar); } while (0)
    PG8_LAS unsigned char* lds3 = (PG8_LAS unsigned char*)lds;

#ifndef PROBE_REPEAT
#define PROBE_REPEAT -1
#endif
#ifndef PROBE_TIME
#define PROBE_TIME -1
#endif
#ifndef PROBE_TSEL
#define PROBE_TSEL 0
#endif
    unsigned long long pt_ticks = 0ull;
#define PHASE(k) do { unsigned long long pt0_ = 0ull; if (PROBE_TIME == (k)) pt0_ = __builtin_amdgcn_s_memrealtime(); \
        if (IN(k)) { run_phase<k>(F, args, lds3); if (PROBE_REPEAT == (k)) { xcd_barrier(bar); run_phase<(k)>(F, args, lds3); } } \
        if (PROBE_TIME == (k) && PROBE_TSEL == 1) pt_ticks = __builtin_amdgcn_s_memrealtime() - pt0_;     \
        if (PROBE_TIME == (k) && PROBE_TSEL == 2) pt0_ = __builtin_amdgcn_s_memrealtime();                \
        SEAM(k); \
        if (PROBE_TIME == (k) && PROBE_TSEL != 1) pt_ticks = __builtin_amdgcn_s_memrealtime() - pt0_; } while (0)
    PHASE(0); PHASE(1); PHASE(2); PHASE(3); PHASE(4); PHASE(5); PHASE(6); PHASE(7); PHASE(8); PHASE(9); PHASE(10); PHASE(11);
#undef PHASE
    if (PROBE_STAGE >= 0) { __syncthreads(); pt_ticks = *(volatile unsigned long long*)(lds + 143360 + 96); }
    if (PROBE_TIME >= 0 || PROBE_STAGE >= 0) { const unsigned long long t0_ = __builtin_amdgcn_s_memrealtime(); while (__builtin_amdgcn_s_memrealtime() - t0_ < 4ull * pt_ticks) __builtin_amdgcn_s_sleep(32); }
#undef IN
#undef SEAM
}

#ifndef N_LAUNCHES
#define N_LAUNCHES 1
#endif
extern "C" void kernel_launch(void* const* d_in, const int* in_sizes, int n_in, void* d_out, int out_size, void* d_ws, size_t ws_size, hipStream_t stream) {
    static int grid = 0;
    if (grid == 0) {
        if (n_in != 20 || out_size != MU * DM || ws_size < WS_END) { fprintf(stderr, "kernel_launch: unexpected shapes (n_in %d out %d ws %zu)\n", n_in, out_size, ws_size); grid = -1; return; }
        int dev = 0, cus = 0, per_cu = 0;
        if (hipGetDevice(&dev) != hipSuccess || hipDeviceGetAttribute(&cus, hipDeviceAttributeMultiprocessorCount, dev) != hipSuccess) { grid = -1; return; }
        if (hipFuncSetAttribute((const void*)fwd_kernel, hipFuncAttributeMaxDynamicSharedMemorySize, LDS_BYTES) != hipSuccess) { fprintf(stderr, "kernel_launch: hipFuncSetAttribute failed\n"); grid = -1; return; }
        if (hipOccupancyMaxActiveBlocksPerMultiprocessor(&per_cu, (const void*)fwd_kernel, 512, LDS_BYTES) != hipSuccess || per_cu < 1) { fprintf(stderr, "kernel_launch: occupancy query says %d\n", per_cu); (void)hipGetLastError(); per_cu = 1; }
        grid = cus;
    }
    if (grid < 0) return;
    (void)hipMemsetAsync((char*)d_ws + WS_CTL, 0, CTL_ZERO_BYTES, stream);
    Args a{};
    for (int i = 0; i < 20; ++i) a.in[i] = (const float*)d_in[i];
    a.out = (float*)d_out; a.ws = (unsigned char*)d_ws;
    for (int li = 0; li < N_LAUNCHES; ++li) {
        a.ph_lo = li * NPHASE / N_LAUNCHES; a.ph_hi = (li + 1) * NPHASE / N_LAUNCHES;
        if (N_LAUNCHES == 1) {
            void* kargs[] = {&a};
            hipError_t e = hipLaunchCooperativeKernel((const void*)fwd_kernel, dim3(grid), dim3(512), kargs, LDS_BYTES, stream);
            if (e != hipSuccess) fprintf(stderr, "cooperative launch failed: %s (grid %d)\n", hipGetErrorString(e), grid);
        } else {
            hipLaunchKernelGGL(fwd_kernel, dim3(grid), dim3(512), LDS_BYTES, stream, a);
        }
    }
}
```

```cpp
#include <hip/hip_runtime.h>
#include <hip/hip_bf16.h>
#include <cstdio>
#include <cstdint>
#include <type_traits>

#define DI __device__ __forceinline__
#define LAS __attribute__((address_space(3)))
#define GAS __attribute__((address_space(1)))

typedef unsigned short bf16_t;
typedef short bf16x8 __attribute__((ext_vector_type(8)));
typedef short s16x4 __attribute__((ext_vector_type(4)));
typedef float f32x4 __attribute__((ext_vector_type(4)));
typedef float f32x16 __attribute__((ext_vector_type(16)));
typedef unsigned u32x4 __attribute__((ext_vector_type(4)));
typedef unsigned u32x2 __attribute__((ext_vector_type(2)));

namespace pg8 {
#define PG8_LAS __attribute__((address_space(3)))
constexpr int BM = 256, BK = 64, HALF = 128, HTB = HALF * BK * 2  , STAGE_BYTES = 8 * HTB, NXCD = 8, WGM = 8;

__host__ __device__ __forceinline__ int lds_byte(int r, int c) { const int st = (r >> 4) * 2 + (c >> 5), rr = r & 15, cc = c & 31, ob = rr * 64 + cc * 2; return st * 1024 + (ob ^ (((ob >> 9) & 1) << 5)); }
__host__ __device__ __forceinline__ void stage_rc(int b, int& R, int& C) { const int st = b / 1024, sb = b % 1024, swz = sb ^ (((sb >> 9) & 1) << 5); R = (st >> 1) * 16 + swz / 64; C = (st & 1) * 32 + (swz % 64) / 2; }
__host__ __device__ __forceinline__ int perm32(int rho) { const int n = rho >> 4, i = rho & 15; return 8 * (i >> 2) + 4 * n + (i & 3); }

struct Unit { int pm, pn; };
struct Gemm { const bf16_t* A; const bf16_t* Bt; int M, N, K, lda, ldb, a_pn_off; };

struct StaticOrder {
    int nM, nN, nwg, G, c;
    __host__ __device__ void init(int M, int N, int G_, int c_) { nM = M / BM; nN = N / BM; nwg = nM * nN; G = G_; c = c_; }
    __host__ __device__ bool next(int i, Unit& u) const {
        const long L = (long)i * G + c; if (L >= nwg) return false;
        int wgid = (int)L; { const int q = nwg / NXCD, r = nwg % NXCD, xcd = wgid % NXCD, off = wgid / NXCD; wgid = (xcd < r ? xcd * (q + 1) : r * (q + 1) + (xcd - r) * q) + off; }
        const int nig = WGM * nN, gid = wgid / nig, fm = gid * WGM, gsz = (nM - fm) < WGM ? (nM - fm) : WGM;
        u.pm = fm + ((wgid % nig) % gsz); u.pn = (wgid % nig) / gsz; return true;
    }
    __device__ __forceinline__ void a_ready(const Unit&) const {}
    __device__ __forceinline__ void done(const Unit&) const {}
};

__device__ __forceinline__ unsigned cvt_pk_bf16(float lo, float hi) { unsigned r; asm volatile("v_cvt_pk_bf16_f32 %0, %1, %2" : "=v"(r) : "v"(lo), "v"(hi)); return r; }

template <class Epi, class Sched, bool ALIGN_EPI = false, bool SP2 = false>
__device__ __forceinline__ void gemm_phase(PG8_LAS unsigned char* lds, const Gemm g, const Sched& S, const Epi& E) {
    const int tid = threadIdx.x, wid = __builtin_amdgcn_readfirstlane(tid >> 6), lane = tid & 63, wr = wid >> 2, wc = wid & 3, fr = lane & 15, fq = lane >> 4;
    const int K = g.K, nt = K / BK;
    unsigned voffA[2], voffB[2];
#pragma unroll
    for (int i = 0; i < 2; ++i) { int R, C; stage_rc(tid * 16 + i * 8192, R, C); const int Rb = Epi::PERM ? ((R & ~31) + perm32(R & 31)) : R;
        voffA[i] = (unsigned)(R * g.lda + C) * 2u; voffB[i] = (unsigned)(Rb * g.ldb + C) * 2u; }
    const size_t kstep = (size_t)(BK * 2);
    const size_t hstepA = (size_t)HALF * g.lda * 2, hstepB = (size_t)HALF * g.ldb * 2;
    const size_t tstepA = 2 * hstepA, tstepB = 2 * hstepB;
    const size_t pnoffA = (size_t)g.a_pn_off * 2;
    const unsigned ldsw = (unsigned)wid * 1024u;
    const int aoff = lds_byte(wr * 64 + fr, fq * 8), boff = lds_byte(wc * 32 + fr, fq * 8);
#define PG8_SA(b, h) (((b) * 2 + (h)) * HTB)
#define PG8_SB(b, h) ((4 + (b) * 2 + (h)) * HTB)
#define PG8_STAGE(bufoff, gbase, voff) do { _Pragma("unroll") for (int _i = 0; _i < 2; ++_i) \
        __builtin_amdgcn_global_load_lds((const unsigned*)((const char*)(gbase) + (voff)[_i]), (PG8_LAS unsigned*)(lds + (bufoff) + ldsw + _i * 8192), 16, 0, 0); } while (0)
#define PG8_LDA(dst, b, h) do { _Pragma("unroll") for (int m = 0; m < 4; ++m) _Pragma("unroll") for (int k = 0; k < 2; ++k) dst[m][k] = *(const PG8_LAS bf16x8*)(lds + PG8_SA(b, h) + aoff + m * 2048 + k * 1024); } while (0)
#define PG8_LDB(dst, b, h) do { _Pragma("unroll") for (int n = 0; n < 2; ++n) _Pragma("unroll") for (int k = 0; k < 2; ++k) dst[n][k] = *(const PG8_LAS bf16x8*)(lds + PG8_SB(b, h) + boff + n * 2048 + k * 1024); } while (0)
#define PG8_MMA(ai, bj, At, Bt) do { __builtin_amdgcn_s_setprio(1); _Pragma("unroll") for (int m = 0; m < 4; ++m) _Pragma("unroll") for (int n = 0; n < 2; ++n) _Pragma("unroll") for (int k = 0; k < 2; ++k) \
        acc[ai][bj][m][n] = __builtin_amdgcn_mfma_f32_16x16x32_bf16(Bt[n][k], At[m][k], acc[ai][bj][m][n], 0, 0, 0); __builtin_amdgcn_s_setprio(0); } while (0)
#define PG8_WAIT_V(n) asm volatile("s_waitcnt vmcnt(" #n ")" ::: "memory")
#define PG8_WAIT_L(n) asm volatile("s_waitcnt lgkmcnt(" #n ")" ::: "memory")
#define PG8_BAR __builtin_amdgcn_s_barrier()
#define PG8_SCHED __builtin_amdgcn_sched_barrier(0)
    Unit cur, nxt; int ui = 0;
    if (!S.next(0, cur)) return;
    f32x4 acc[2][2][4][2];
#pragma unroll
    for (int a = 0; a < 2; ++a)
#pragma unroll
        for (int b = 0; b < 2; ++b)
#pragma unroll
            for (int m = 0; m < 4; ++m)
#pragma unroll
                for (int n = 0; n < 2; ++n) acc[a][b][m][n] = (f32x4){0.f, 0.f, 0.f, 0.f};
    bf16x8 At[4][2], B0[2][2], B1[2][2];
    const char* cA = (const char*)g.A + (size_t)cur.pm * tstepA + (size_t)cur.pn * pnoffA; const char* cB = (const char*)g.Bt + (size_t)cur.pn * tstepB;
    S.a_ready(cur);
    if constexpr (SP2) {
        PG8_STAGE(PG8_SB(0, 0), cB, voffB); PG8_STAGE(PG8_SB(0, 1), cB + hstepB, voffB); PG8_STAGE(PG8_SA(0, 0), cA, voffA); PG8_STAGE(PG8_SA(0, 1), cA + hstepA, voffA);
        if (wr == 1) PG8_BAR;
        PG8_WAIT_V(2); PG8_BAR;
        PG8_STAGE(PG8_SB(1, 0), cB + kstep, voffB); PG8_STAGE(PG8_SA(1, 0), cA + kstep, voffA); PG8_STAGE(PG8_SB(1, 1), cB + hstepB + kstep, voffB);
        PG8_WAIT_V(6); PG8_BAR;
    } else {
        PG8_STAGE(PG8_SB(0, 0), cB, voffB); PG8_STAGE(PG8_SA(0, 0), cA, voffA); PG8_STAGE(PG8_SB(0, 1), cB + hstepB, voffB); PG8_STAGE(PG8_SA(0, 1), cA + hstepA, voffA);
        if (wr == 1) PG8_BAR;
        PG8_WAIT_V(4); PG8_BAR;
        PG8_STAGE(PG8_SB(1, 0), cB + kstep, voffB); PG8_STAGE(PG8_SA(1, 0), cA + kstep, voffA); PG8_STAGE(PG8_SB(1, 1), cB + hstepB + kstep, voffB);
        PG8_WAIT_V(6); PG8_BAR;
    }
    for (;;) {
        const bool has_next = S.next(ui + 1, nxt);
        const char* nA = has_next ? (const char*)g.A + (size_t)nxt.pm * tstepA + (size_t)nxt.pn * pnoffA : cA; const char* nB = has_next ? (const char*)g.Bt + (size_t)nxt.pn * tstepB : cB;
        for (int t = 0; t < nt; t += 2) {
            const bool last = (t == nt - 2);
            const char* a1 = cA + (size_t)(t + 1) * kstep;
            const char* a2 = last ? nA : cA + (size_t)(t + 2) * kstep; const char* b2 = last ? nB : cB + (size_t)(t + 2) * kstep;
            const char* a3 = a2 + kstep; const char* b3 = b2 + kstep;
            if (last && has_next) S.a_ready(nxt);
            if constexpr (SP2) {
            PG8_LDB(B0, 0, 0); PG8_LDB(B1, 0, 1); PG8_SCHED; PG8_LDA(At, 0, 0); PG8_STAGE(PG8_SA(1, 1), a1 + hstepA, voffA);
            PG8_WAIT_V(8); PG8_WAIT_L(0); PG8_BAR; PG8_MMA(0, 0, At, B0); PG8_MMA(0, 1, At, B1); PG8_BAR; PG8_SCHED;
            PG8_LDA(At, 0, 1); PG8_STAGE(PG8_SB(0, 0), b2, voffB); PG8_STAGE(PG8_SB(0, 1), b2 + hstepB, voffB); PG8_STAGE(PG8_SA(0, 0), a2, voffA);
            PG8_WAIT_V(8); PG8_WAIT_L(0); PG8_BAR; PG8_MMA(1, 0, At, B0); PG8_MMA(1, 1, At, B1); PG8_BAR; PG8_SCHED;
            PG8_LDB(B0, 1, 0); PG8_LDB(B1, 1, 1); PG8_SCHED; PG8_LDA(At, 1, 0); PG8_STAGE(PG8_SA(0, 1), a2 + hstepA, voffA);
            PG8_WAIT_V(8); PG8_WAIT_L(0); PG8_BAR; PG8_MMA(0, 0, At, B0); PG8_MMA(0, 1, At, B1); PG8_BAR; PG8_SCHED;
            PG8_LDA(At, 1, 1); PG8_STAGE(PG8_SB(1, 0), b3, voffB); PG8_STAGE(PG8_SB(1, 1), b3 + hstepB, voffB); PG8_STAGE(PG8_SA(1, 0), a3, voffA);
            PG8_WAIT_V(8); PG8_WAIT_L(0); PG8_BAR; PG8_MMA(1, 0, At, B0); PG8_MMA(1, 1, At, B1); PG8_BAR; PG8_SCHED;
            } else {
            PG8_LDB(B0, 0, 0); PG8_SCHED; PG8_LDA(At, 0, 0); PG8_STAGE(PG8_SA(1, 1), a1 + hstepA, voffA);
            PG8_WAIT_L(8); PG8_BAR; PG8_WAIT_L(0); PG8_MMA(0, 0, At, B0); PG8_BAR; PG8_SCHED;
            PG8_LDB(B1, 0, 1); PG8_STAGE(PG8_SB(0, 0), b2, voffB);
            PG8_BAR; PG8_WAIT_L(0); PG8_MMA(0, 1, At, B1); PG8_BAR;
            PG8_LDA(At, 0, 1); PG8_STAGE(PG8_SA(0, 0), a2, voffA);
            PG8_BAR; PG8_WAIT_L(0); PG8_MMA(1, 0, At, B0); PG8_BAR; PG8_SCHED;
            PG8_STAGE(PG8_SB(0, 1), b2 + hstepB, voffB);
            PG8_WAIT_V(6); PG8_BAR; PG8_MMA(1, 1, At, B1); PG8_BAR;
            PG8_LDB(B0, 1, 0); PG8_SCHED; PG8_LDA(At, 1, 0); PG8_STAGE(PG8_SA(0, 1), a2 + hstepA, voffA);
            PG8_WAIT_L(8); PG8_BAR; PG8_WAIT_L(0); PG8_MMA(0, 0, At, B0); PG8_BAR; PG8_SCHED;
            PG8_LDB(B1, 1, 1); PG8_STAGE(PG8_SB(1, 0), b3, voffB);
            PG8_BAR; PG8_WAIT_L(0); PG8_MMA(0, 1, At, B1); PG8_BAR;
            PG8_LDA(At, 1, 1); PG8_STAGE(PG8_SA(1, 0), a3, voffA);
            PG8_BAR; PG8_WAIT_L(0); PG8_MMA(1, 0, At, B0); PG8_BAR; PG8_SCHED;
            PG8_STAGE(PG8_SB(1, 1), b3 + hstepB, voffB);
            PG8_WAIT_V(6); PG8_BAR; PG8_MMA(1, 1, At, B1); PG8_BAR;
            }
        }
        if constexpr (ALIGN_EPI) { if (wr == 0) PG8_BAR; }
        E(acc, cur, wr, wc, fr, fq); S.done(cur);
        if (!has_next) break;
#pragma unroll
        for (int a = 0; a < 2; ++a)
#pragma unroll
            for (int b = 0; b < 2; ++b)
#pragma unroll
                for (int m = 0; m < 4; ++m)
#pragma unroll
                    for (int n = 0; n < 2; ++n) acc[a][b][m][n] = (f32x4){0.f, 0.f, 0.f, 0.f};
        cur = nxt; cA = nA; cB = nB; ++ui;
        if constexpr (ALIGN_EPI) { if (wr == 1) PG8_BAR; }
    }
    PG8_WAIT_V(0);
    if constexpr (!ALIGN_EPI) { if (wr == 0) PG8_BAR; }
    PG8_BAR;
#undef PG8_SA
#undef PG8_SB
#undef PG8_STAGE
#undef PG8_LDA
#undef PG8_LDB
#undef PG8_MMA
#undef PG8_WAIT_V
#undef PG8_WAIT_L
#undef PG8_BAR
#undef PG8_SCHED
}
}

constexpr int DM = 1024;
constexpr int NTOK = 16400;
constexpr int PADL = 48;
constexpr int LPV = 16448;
constexpr int MP = 16640;
constexpr int MU = 16384;
constexpr int NCHUNK = 257;
constexpr int NHEAD = 8;
constexpr int NPROJ = 2560;
constexpr int KVROWS = 16512;
constexpr float EPS = 1e-6f;

constexpr size_t MiB = 1u << 20;
constexpr size_t WS_CTL = 0, CTL_ZERO_BYTES = 64 * 1024;
constexpr size_t WS_SSQ = 128 * 1024;
constexpr size_t WS_SSK = 512 * 1024;
constexpr size_t WS_SS4 = 14 * MiB;
constexpr size_t WS_WIN = 1 * MiB;
constexpr size_t WS_WUQ = 6 * MiB;
constexpr size_t WS_WUKV = 6 * MiB + 512 * 1024;
constexpr size_t WS_WOUT = 7 * MiB;
constexpr size_t WS_WPQ = 9 * MiB;
constexpr size_t WS_SKB = 13 * MiB;
constexpr size_t WS_IDX = 16 * MiB;
constexpr size_t WS_GATE = 24 * MiB;
constexpr size_t WS_HN = 16 * MiB;
constexpr size_t WS_QKVR = 101 * MiB;
constexpr size_t WS_Z = 150 * MiB;
constexpr size_t WS_BA = 245 * MiB;
constexpr size_t WS_GA = 16 * MiB;
constexpr size_t WS_GQ = 33 * MiB;
constexpr size_t WS_GS = 67 * MiB;
constexpr size_t WS_GB = 84 * MiB;
constexpr size_t WS_GO = 50 * MiB;
constexpr size_t WS_MIX = 167 * MiB;
constexpr size_t WS_CQN = 200 * MiB;
constexpr size_t WS_CKVN = 208 * MiB + 512 * 1024;
constexpr size_t WS_QH = 220 * MiB;
constexpr size_t WS_KVB = 167 * MiB;
constexpr size_t WS_Q = 125 * MiB + 512 * 1024;
constexpr size_t WS_K = 101 * MiB;
constexpr size_t WS_VT = 200 * MiB;
constexpr size_t WS_XN = 32 * MiB;
constexpr size_t WS_PQ = 64 * MiB;
constexpr size_t WS_SC = 128 * MiB;
constexpr size_t WS_EU = 96 * MiB;
constexpr size_t WS_EV = 112 * MiB;
constexpr size_t WS_CW = 64 * MiB;
constexpr size_t WS_HP = 128 * MiB;
constexpr size_t WS_KPE = 217 * MiB;
constexpr size_t WS_END = 256 * MiB;
constexpr int CW_ATTQ = 8192;
constexpr int CW_SCANDONE = 8256;

constexpr int LDS_BYTES = 147456;
constexpr int MISC_OFF = 131072 + 12288;

DI unsigned f2bf(float f) { unsigned u = __builtin_bit_cast(unsigned, f); return (u + 0x7fffu + ((u >> 16) & 1u)) >> 16; }
DI unsigned pk2(float lo, float hi) { return f2bf(lo) | (f2bf(hi) << 16); }
DI float bf2f(unsigned b) { return __builtin_bit_cast(float, b << 16); }
DI float bflo(unsigned w) { return __builtin_bit_cast(float, w << 16); }
DI float bfhi(unsigned w) { return __builtin_bit_cast(float, w & 0xffff0000u); }
DI float wave_sum(float v) {
#pragma unroll
    for (int o = 1; o < 64; o <<= 1) v += __shfl_xor(v, o);
    return v;
}
DI float sigmoidf_(float x) { return 1.f / (1.f + __expf(-x)); }
DI float siluf_(float x) { return x / (1.f + __expf(-x)); }

#define XB_TMO      128
#define XB_XCNT(j)  (256  + 64 * (j))
#define XB_XSUB(j)  (1280 + 64 * (j))
#define XB_XGEN(j)  (2304 + 64 * (j))
#define XB_TOP      3328
#define XB_TOPGEN   3392
#define XCD_BAR_WORDS 3456
#define XB_SPIN_CAP (1u << 22)
DI unsigned xb_ld(unsigned* p)              { return __hip_atomic_load(p, __ATOMIC_RELAXED, __HIP_MEMORY_SCOPE_AGENT); }
DI unsigned xb_add(unsigned* p, unsigned v) { return __hip_atomic_fetch_add(p, v, __ATOMIC_RELAXED, __HIP_MEMORY_SCOPE_AGENT); }
DI unsigned xb_xcc_id() { return (unsigned)__builtin_amdgcn_s_getreg((3 << 11) | 20) & 0xFu; }
#define XB_SPIN(cond, bar) do { unsigned _sp = 0; while (cond) { __builtin_amdgcn_s_sleep(1); \
    if ((++_sp & 255u) == 0u) { if (xb_ld(&(bar)[XB_TMO])) break; if (_sp > XB_SPIN_CAP) { atomicAdd(&(bar)[XB_TMO], 1u); break; } } } } while (0)
struct XcdBarrier { unsigned* bar; unsigned x; volatile LAS unsigned* st; };
DI XcdBarrier xcd_barrier_post(unsigned* bar, volatile LAS unsigned* st) {
    XcdBarrier b; b.bar = bar; b.x = xb_xcc_id(); b.st = st;
    if (threadIdx.x == 0) (void)xb_add(&bar[XB_XCNT(b.x)], 1u);
    return b;
}
DI void xcd_barrier_complete(unsigned* bar, unsigned x, unsigned& nloc, unsigned& nx) {
    const unsigned G = gridDim.x * gridDim.y * gridDim.z;
    unsigned sum, cnt, mine, sp = 0u;
    for (;;) {
        sum = 0u; cnt = 0u; mine = 0u;
#pragma unroll
        for (unsigned j = 0; j < 16; ++j) { const unsigned c = xb_ld(&bar[XB_XCNT(j)]); sum += c; cnt += (c > 0u) ? 1u : 0u; mine = (j == x) ? c : mine; }
        if (sum == G) break;
        __builtin_amdgcn_s_sleep(1);
        if ((++sp & 255u) == 0u) { if (xb_ld(&bar[XB_TMO])) break; if (sp > XB_SPIN_CAP) { atomicAdd(&bar[XB_TMO], 1u); break; } }
    }
    nloc = mine > 0u ? mine : 1u; nx = cnt > 0u ? cnt : 1u;
}
DI void xcd_barrier(const XcdBarrier& b) {
    asm volatile("s_waitcnt vmcnt(0)" ::: "memory");
    __syncthreads();
    if (threadIdx.x == 0) {
        unsigned* bar = b.bar;
        __builtin_amdgcn_s_waitcnt(0);
        unsigned nloc = b.st[0], nx = b.st[1];
        if (nloc == 0u) { xcd_barrier_complete(bar, b.x, nloc, nx); b.st[0] = nloc; b.st[1] = nx; }
        const unsigned old = xb_add(&bar[XB_XSUB(b.x)], 1u);
        const unsigned gen = old / nloc;
        if (old + 1u == (gen + 1u) * nloc) {
            __builtin_amdgcn_fence(__ATOMIC_RELEASE, "agent");
            asm volatile("s_waitcnt vmcnt(0)" ::: "memory");
            const unsigned og = xb_add(&bar[XB_TOP], 1u);
            const unsigned tg = og / nx;
            if (og + 1u == (tg + 1u) * nx) xb_add(&bar[XB_TOPGEN], 1u);
            else XB_SPIN(xb_ld(&bar[XB_TOPGEN]) == tg, bar);
            __builtin_amdgcn_fence(__ATOMIC_ACQUIRE, "agent");
            xb_add(&bar[XB_XGEN(b.x)], 1u);
            asm volatile("s_waitcnt vmcnt(0)" ::: "memory");
        } else {
            XB_SPIN(xb_ld(&bar[XB_XGEN(b.x)]) == gen, bar);
            __builtin_amdgcn_fence(__ATOMIC_ACQUIRE, "agent");
            asm volatile("s_waitcnt vmcnt(0)" ::: "memory");
        }
    }
    __syncthreads();
}

struct Args {
    const float* in[20];
    float* out; unsigned char* ws;
    int ph_lo, ph_hi;
};
struct Frame {
    unsigned char* lds;
    int tid, lane, wave, G, gw, NGW;
};

template <class Map>
DI void transpose_item(const float* __restrict__ W, int Nsrc, bf16_t* __restrict__ WT, int ldk, float* scr, int item, int nblk, int lane, Map srcmap, const float* __restrict__ rowscale = nullptr) {
    const int kb = item / nblk, nb = item % nblk, k0 = 64 * kb, n0 = 32 * nb;
    const int ns = srcmap(n0 + (lane & 31));
    float vv[32];
#pragma unroll
    for (int i = 0; i < 32; ++i) { const int kk = 2 * i + (lane >> 5); vv[i] = (ns >= 0) ? W[(size_t)(k0 + kk) * Nsrc + ns] : 0.f; }
    if (rowscale) {
#pragma unroll
        for (int i = 0; i < 32; ++i) vv[i] *= rowscale[k0 + 2 * i + (lane >> 5)];
    }
#pragma unroll
    for (int i = 0; i < 32; ++i) { const int kk = 2 * i + (lane >> 5); scr[kk * 33 + (lane & 31)] = vv[i]; }
    __builtin_amdgcn_s_waitcnt(0); __builtin_amdgcn_wave_barrier();
    const int c = lane & 7;
#pragma unroll
    for (int j = 0; j < 4; ++j) { const int n = (lane >> 3) + 8 * j; const float* s = scr + (8 * c) * 33 + n;
        u32x4 o; o.x = pk2(s[0 * 33], s[1 * 33]); o.y = pk2(s[2 * 33], s[3 * 33]); o.z = pk2(s[4 * 33], s[5 * 33]); o.w = pk2(s[6 * 33], s[7 * 33]);
        *(u32x4*)(WT + (size_t)(n0 + n) * ldk + k0 + 8 * c) = o; }
    __builtin_amdgcn_s_waitcnt(0); __builtin_amdgcn_wave_barrier();
}
struct MapId { DI int operator()(int n) const { return n; } };
struct MapWin {
    DI int operator()(int n) const {
        if (n < 2048) return n;
        if (n < 2304) return n + 16;
        if (n < 2432) return n + 16;
        if (n < 2464) return n + 16;
        if (n < 2472) return n - 416;
        if (n < 2480) return n - 416;
        return -1;
    }
};

template <int PART> DI void p0_late_weights(const Frame& F, const Args& A, int wi, int nwv, int ti, int nth) {
    unsigned char* ws = A.ws;
    float* scr = (float*)(F.lds + F.wave * 16384);
    const float* w_uq = A.in[10]; const float* w_ukv = A.in[11]; const float* w_out = A.in[14]; const float* w_pq = A.in[16]; const float* sub_keys = A.in[17];
    constexpr int I_UQ = 4 * 24, I_UKV = 2 * 32, I_OUT = 16 * 32, I_PQ = 16 * 64;
    constexpr int NITEMS = I_UQ + I_UKV + I_OUT + I_PQ;
    const int lo_ = PART == 0 ? 0 : I_UQ + I_UKV, hi_ = PART == 0 ? I_UQ + I_UKV : NITEMS;
    for (int it = lo_ + wi; it < hi_; it += nwv) {
        int r = it;
        if (r < I_UQ) { transpose_item(w_uq, 768, (bf16_t*)(ws + WS_WUQ), 256, scr, r, 24, F.lane, MapId(), A.in[8]); continue; } r -= I_UQ;
        if (r < I_UKV) { transpose_item(w_ukv, 1024, (bf16_t*)(ws + WS_WUKV), 256, scr, r, 32, F.lane, MapId(), A.in[9]); continue; } r -= I_UKV;
        if (r < I_OUT) { transpose_item(w_out, 1024, (bf16_t*)(ws + WS_WOUT), 1024, scr, r, 32, F.lane, MapId()); continue; } r -= I_OUT;
        transpose_item(w_pq, 2048, (bf16_t*)(ws + WS_WPQ), 1024, scr, r, 64, F.lane, MapId(), A.in[15]);
    }
    const int gt = ti, NGT = nth;
    if (PART == 0) for (int i = gt; i < 1024 * 16; i += NGT) { const int n = i >> 4, c = i & 15; *(u32x4*)((bf16_t*)(ws + WS_WUKV) + (size_t)n * 256 + 128 + c * 8) = (u32x4){0u, 0u, 0u, 0u}; }
    if (PART == 1) for (int i = gt; i < 2048 * 32; i += NGT) {
        const int n = i >> 5, c8 = (i & 31) * 8; const int p = (n >> 7) & 1;
        u32x4 o = (u32x4){0u, 0u, 0u, 0u};
        if ((c8 >> 7) == p) { const float* s = sub_keys + (size_t)n * 128 + (c8 & 127); const f32x4 a = *(const f32x4*)s, b = *(const f32x4*)(s + 4);
            o.x = pk2(a.x, a.y); o.y = pk2(a.z, a.w); o.z = pk2(b.x, b.y); o.w = pk2(b.z, b.w); }
        *(u32x4*)((bf16_t*)(ws + WS_SKB) + (size_t)n * 256 + c8) = o;
    }
}

DI void p0_prologue(const Frame& F, const Args& A) {
    unsigned char* ws = A.ws;
    float* scr = (float*)(F.lds + F.wave * 16384);
    const float* w_in = A.in[3]; const float* w_uq = A.in[10]; const float* w_ukv = A.in[11]; const float* w_out = A.in[14]; const float* w_pq = A.in[16]; const float* sub_keys = A.in[17];
    constexpr int I_IN = 16 * 80;
    for (int it = F.wave * F.G + blockIdx.x; it < I_IN; it += F.NGW) transpose_item(w_in, 2480, (bf16_t*)(ws + WS_WIN), 1024, scr, it, 80, F.lane, MapWin());
    const float* x = A.in[0]; const float* meta = A.in[1]; const float* anorm = A.in[2];
    bf16_t* HN = (bf16_t*)(ws + WS_HN);
    for (int p0 = F.gw; p0 < MP; p0 += 3 * F.NGW) {
        f32x4 v[3][4]; bool ok[3];
#pragma unroll
        for (int r = 0; r < 3; ++r) {
            const int p = p0 + r * F.NGW, t = p - PADL; ok[r] = (p < MP) && t >= 0 && t < NTOK;
            if (ok[r]) { const float* src = (t < 16) ? meta + (size_t)t * DM : x + (size_t)(t - 16) * DM; const f32x4* xr = (const f32x4*)src + F.lane;
#pragma unroll
                for (int j = 0; j < 4; ++j) v[r][j] = xr[64 * j]; }
            else {
#pragma unroll
                for (int j = 0; j < 4; ++j) v[r][j] = (f32x4){0.f, 0.f, 0.f, 0.f}; }
        }
#pragma unroll
        for (int r = 0; r < 3; ++r) {
            const int p = p0 + r * F.NGW; if (p >= MP) continue;
            unsigned long long* o8 = (unsigned long long*)(HN + (size_t)p * DM) + F.lane;
            float s = 0.f;
#pragma unroll
            for (int j = 0; j < 4; ++j) s += (v[r][j].x * v[r][j].x + v[r][j].y * v[r][j].y) + (v[r][j].z * v[r][j].z + v[r][j].w * v[r][j].w);
            const float rstd = ok[r] ? 1.f / sqrtf(wave_sum(s) * (1.f / DM) + EPS) : 0.f;
#pragma unroll
            for (int j = 0; j < 4; ++j) { const f32x4 w = ((const f32x4*)anorm)[64 * j + F.lane];
                o8[64 * j] = (unsigned long long)pk2(v[r][j].x * rstd * w.x, v[r][j].y * rstd * w.y) | ((unsigned long long)pk2(v[r][j].z * rstd * w.z, v[r][j].w * rstd * w.w) << 32); }
        }
    }
}

DI void row_ss_store(const f32x4 (&v)[2][2][4][2], float* SSP, int nslot, int slot, int row0, int fq, bool bj0_only) {
#pragma unroll
    for (int ai = 0; ai < 2; ++ai)
#pragma unroll
        for (int m = 0; m < 4; ++m) {
            float s = 0.f;
#pragma unroll
            for (int bj = 0; bj < 2; ++bj) if (bj == 0 || !bj0_only)
#pragma unroll
                for (int n = 0; n < 2; ++n) { const f32x4 x = v[ai][bj][m][n]; s += (x[0] * x[0] + x[1] * x[1]) + (x[2] * x[2] + x[3] * x[3]); }
            s += __shfl_xor(s, 16); s += __shfl_xor(s, 32);
            if (fq == 0) SSP[(size_t)(row0 + ai * 128 + m * 16) * nslot + slot] = s;
        }
}
DI float ss_sum4(const float* SSP, int row) { const f32x4 a = *(const f32x4*)(SSP + (size_t)row * 4); return (a.x + a.y) + (a.z + a.w); }
DI float ss_sum16(const float* SSP, int row) { const f32x4 a = *(const f32x4*)(SSP + (size_t)row * 16), b = *(const f32x4*)(SSP + (size_t)row * 16 + 4), c = *(const f32x4*)(SSP + (size_t)row * 16 + 8), d = *(const f32x4*)(SSP + (size_t)row * 16 + 12);
    return (((a.x + a.y) + (a.z + a.w)) + ((b.x + b.y) + (b.z + b.w))) + (((c.x + c.y) + (c.z + c.w)) + ((d.x + d.y) + (d.z + d.w))); }
struct EpiProj {
    static constexpr bool PERM = true;
    bf16_t* QKVR; bf16_t* Z; float* BA; bf16_t* CQ16; bf16_t* CKV16; float* KPE; float* SSQ; float* SSK;
    DI void operator()(const f32x4 (&acc)[2][2][4][2], const pg8::Unit& u, int wr, int wc, int fr, int fq) const {
        const int row0 = u.pm * 256 + wr * 64 + fr;
        if (u.pn < 8) {
            bf16_t* base; int ld, colt;
            if (u.pn < 6) { base = QKVR; ld = 1536; colt = u.pn * 256; } else { base = Z; ld = 512; colt = (u.pn - 6) * 256; }
            const int col0 = colt + wc * 32 + 8 * fq;
#pragma unroll
            for (int ai = 0; ai < 2; ++ai)
#pragma unroll
                for (int m = 0; m < 4; ++m) { bf16_t* rowp = base + (size_t)(row0 + ai * 128 + m * 16) * ld + col0;
#pragma unroll
                    for (int bj = 0; bj < 2; ++bj) { const f32x4 v0 = acc[ai][bj][m][0], v1 = acc[ai][bj][m][1];
                        u32x4 w; w.x = pg8::cvt_pk_bf16(v0[0], v0[1]); w.y = pg8::cvt_pk_bf16(v0[2], v0[3]); w.z = pg8::cvt_pk_bf16(v1[0], v1[1]); w.w = pg8::cvt_pk_bf16(v1[2], v1[3]);
                        *(u32x4*)(rowp + bj * 128) = w; } }
        } else {
            const int lcol0 = wc * 32 + 8 * fq;
            bf16_t* b16 = (u.pn == 8) ? CQ16 : CKV16;
#pragma unroll
            for (int ai = 0; ai < 2; ++ai)
#pragma unroll
                for (int m = 0; m < 4; ++m) { const size_t row = (size_t)(row0 + ai * 128 + m * 16);
#pragma unroll
                    for (int bj = 0; bj < 2; ++bj) { const f32x4 v0 = acc[ai][bj][m][0], v1 = acc[ai][bj][m][1];
                        u32x4 w; w.x = pg8::cvt_pk_bf16(v0[0], v0[1]); w.y = pg8::cvt_pk_bf16(v0[2], v0[3]); w.z = pg8::cvt_pk_bf16(v1[0], v1[1]); w.w = pg8::cvt_pk_bf16(v1[2], v1[3]);
                        *(u32x4*)(b16 + row * 256 + lcol0 + bj * 128) = w;
                        if (u.pn == 9 && bj == 1 && wc == 0) { *(f32x4*)(KPE + row * 32 + 8 * fq) = v0; *(f32x4*)(KPE + row * 32 + 8 * fq + 4) = v1; }
                        if (u.pn == 9 && bj == 1 && wc == 1 && fq < 2) { *(f32x4*)(BA + row * 16 + 8 * fq) = v0; *(f32x4*)(BA + row * 16 + 8 * fq + 4) = v1; }
                    } }
            row_ss_store(acc, (u.pn == 8) ? SSQ : SSK, 4, wc, row0, fq, u.pn == 9);
        }
    }
};
struct EpiB16 {
    static constexpr bool PERM = true;
    bf16_t* O; int ldc; const float* SS; float invn; int nslot;
    DI void operator()(const f32x4 (&acc)[2][2][4][2], const pg8::Unit& u, int wr, int wc, int fr, int fq) const {
        const int row0 = u.pm * 256 + wr * 64 + fr, col0 = u.pn * 256 + wc * 32 + 8 * fq;
#pragma unroll
        for (int ai = 0; ai < 2; ++ai)
#pragma unroll
            for (int m = 0; m < 4; ++m) { const int row = row0 + ai * 128 + m * 16; bf16_t* rowp = O + (size_t)row * ldc + col0;
                const float rs = SS ? 1.f / sqrtf((nslot == 16 ? ss_sum16(SS, row) : ss_sum4(SS, row)) * invn + EPS) : 1.f;
#pragma unroll
                for (int bj = 0; bj < 2; ++bj) { const f32x4 v0 = acc[ai][bj][m][0] * rs, v1 = acc[ai][bj][m][1] * rs;
                    u32x4 w; w.x = pg8::cvt_pk_bf16(v0[0], v0[1]); w.y = pg8::cvt_pk_bf16(v0[2], v0[3]); w.z = pg8::cvt_pk_bf16(v1[0], v1[1]); w.w = pg8::cvt_pk_bf16(v1[2], v1[3]);
                    *(u32x4*)(rowp + bj * 128) = w; } }
    }
};
struct EpiH1 {
    static constexpr bool PERM = true;
    float* C; const float* res; bf16_t* H16; float* SS;
    DI void operator()(const f32x4 (&acc)[2][2][4][2], const pg8::Unit& u, int wr, int wc, int fr, int fq) const {
        const int row0 = u.pm * 256 + wr * 64 + fr, col0 = u.pn * 256 + wc * 32 + 8 * fq;
        f32x4 v[2][2][4][2];
#pragma unroll
        for (int ai = 0; ai < 2; ++ai)
#pragma unroll
            for (int m = 0; m < 4; ++m) { const size_t off = (size_t)(row0 + ai * 128 + m * 16) * 1024 + col0;
#pragma unroll
                for (int bj = 0; bj < 2; ++bj) { const f32x4 v0 = acc[ai][bj][m][0] + *(const f32x4*)(res + off + bj * 128), v1 = acc[ai][bj][m][1] + *(const f32x4*)(res + off + bj * 128 + 4);
                    v[ai][bj][m][0] = v0; v[ai][bj][m][1] = v1;
                    *(f32x4*)(C + off + bj * 128) = v0; *(f32x4*)(C + off + bj * 128 + 4) = v1;
                    u32x4 w; w.x = pg8::cvt_pk_bf16(v0[0], v0[1]); w.y = pg8::cvt_pk_bf16(v0[2], v0[3]); w.z = pg8::cvt_pk_bf16(v1[0], v1[1]); w.w = pg8::cvt_pk_bf16(v1[2], v1[3]);
                    *(u32x4*)(H16 + off + bj * 128) = w; } }
        row_ss_store(v, SS, 16, u.pn * 4 + wc, row0, fq, false);
    }
};
struct EpiF32 {
    static constexpr bool PERM = true;
    float* C; int ldc; const float* res;
    DI void operator()(const f32x4 (&acc)[2][2][4][2], const pg8::Unit& u, int wr, int wc, int fr, int fq) const {
        const int row0 = u.pm * 256 + wr * 64 + fr, col0 = u.pn * 256 + wc * 32 + 8 * fq;
#pragma unroll
        for (int ai = 0; ai < 2; ++ai)
#pragma unroll
            for (int m = 0; m < 4; ++m) { const size_t off = (size_t)(row0 + ai * 128 + m * 16) * ldc + col0;
#pragma unroll
                for (int bj = 0; bj < 2; ++bj) { f32x4 v0 = acc[ai][bj][m][0], v1 = acc[ai][bj][m][1];
                    if (res) { v0 += *(const f32x4*)(res + off + bj * 128); v1 += *(const f32x4*)(res + off + bj * 128 + 4); }
                    *(f32x4*)(C + off + bj * 128) = v0; *(f32x4*)(C + off + bj * 128 + 4) = v1; } }
    }
};

DI f32x16 mfma32(bf16x8 a, bf16x8 b, f32x16 c) { return __builtin_amdgcn_mfma_f32_32x32x16_bf16(a, b, c, 0, 0, 0); }
DI f32x4 mfma16(bf16x8 a, bf16x8 b, f32x4 c) { return __builtin_amdgcn_mfma_f32_16x16x32_bf16(a, b, c, 0, 0, 0); }
DI int crow(int r, int hi) { return (r & 3) + 8 * (r >> 2) + 4 * hi; }
DI f32x16 zero16() { f32x16 z;
#pragma unroll
    for (int i = 0; i < 16; ++i) z[i] = 0.f; return z; }

constexpr int G_KF = 0, G_VF = 16384, G_MF = 32768;
constexpr int G_QB = 50176, G_KB = 59392, G_KBB = 68608;
constexpr int G_QKB = 77824, G_UT = 87040, G_WT = 96256, G_KDT = 105472;
constexpr int G_VEC = 114688;
constexpr int G_RAW = G_QKB;
constexpr int GST = 72;

DI f32x16 mm_quad(const unsigned char* A, const unsigned char* Bt, int qr, int qc, int lane) {
    const int r32 = lane & 31, hh = lane >> 5;
    const unsigned char* ap = A + (32 * qr + r32) * (GST * 2) + hh * 16;
    const unsigned char* bp = Bt + (32 * qc + r32) * (GST * 2) + hh * 16;
    f32x16 acc = zero16();
#pragma unroll
    for (int s = 0; s < 4; ++s) acc = mfma32(*(const bf16x8*)(ap + s * 32), *(const bf16x8*)(bp + s * 32), acc);
    return acc;
}

constexpr int G_RAW2 = 115712;
static_assert(G_RAW2 + 67 * 400 <= 143360, "GDN prep LDS map");
constexpr int G_CONVW = 143360 + 512;

#ifndef PROBE_STAGE
#define PROBE_STAGE -1
#endif
template <int VAR> DI void gdn_prep_phase(const Frame& F, const Args& A) {
    unsigned long long stg_t = 0ull, stg_acc = 0ull;
#define STG(n) do { if (PROBE_STAGE >= 0) { const unsigned long long now_ = __builtin_amdgcn_s_memrealtime(); if (PROBE_STAGE == (n)) stg_acc += now_ - stg_t; stg_t = now_; } } while (0)
    unsigned char* ws = A.ws; unsigned char* lds = F.lds;
    const int tid = F.tid, lane = F.lane, wave = F.wave;
    const bf16_t* QKVR = (const bf16_t*)(ws + WS_QKVR); const float* BA = (const float*)(ws + WS_BA);
    float* KF = (float*)(lds + G_KF); float* VF = (float*)(lds + G_VF); float* MF = (float*)(lds + G_MF);
    float* VEC = (float*)(lds + G_VEC);
    if (VAR == 6) return;
    const int NIT = NCHUNK * 8;
#define LBAR() do { asm volatile("s_waitcnt lgkmcnt(0)" ::: "memory"); __builtin_amdgcn_s_barrier(); asm volatile("" ::: "memory"); } while (0)
#define LAUNDER(dst, src) int dst = (src); asm volatile("" : "+v"(dst))
    int item = blockIdx.x;
    if (item >= NIT) return;
    u32x4 pr[4]; float nb = 0.f, na = 0.f;
    auto raw_fetch = [&](int it) {
        const int c = it >> 3, h = it & 7; LAUNDER(tl, tid);
#pragma unroll
        for (int i = 0; i < 4; ++i) { const int q = tl + 512 * i; pr[i] = (u32x4){0u, 0u, 0u, 0u};
            if (q < 67 * 24) { const int r = q / 24, cc = q % 24, seg = cc >> 3, c8 = cc & 7; const int p = 64 * c - 3 + r;
                if (p >= 0) pr[i] = *(const u32x4*)(QKVR + (size_t)p * 1536 + seg * 512 + h * 64 + c8 * 8); } }
        if (wave == 0) { const int p = 64 * c + lane; nb = BA[(size_t)p * 16 + h]; na = BA[(size_t)p * 16 + 8 + h]; }
    };
    auto raw_park = [&]() {
        LAUNDER(tl, tid);
#pragma unroll
        for (int i = 0; i < 4; ++i) { const int q = tl + 512 * i;
            if (q < 67 * 24) { const int r = q / 24, cc = q % 24, seg = cc >> 3, c8 = cc & 7; *(u32x4*)(lds + G_RAW2 + r * 400 + (seg * 64 + c8 * 8) * 2) = pr[i]; } }
    };
    raw_fetch(item); raw_park();
    float cb = nb, ca = na;
    float* CWL = (float*)(lds + G_CONVW);
    int cw_h = -1;
#pragma unroll 1
    for (; item < NIT; item += F.G) {
        if (PROBE_STAGE >= 0 && stg_t == 0ull) stg_t = __builtin_amdgcn_s_memrealtime();
        const int c = item >> 3, h = item & 7;
        if (h != cw_h) { cw_h = h;
            if (tid < 192) { LAUNDER(t0, tid); const int sg = t0 >> 6, jt = (t0 >> 4) & 3, c4 = t0 & 15; *(f32x4*)(CWL + (sg * 4 + jt) * 64 + 4 * c4) = *(const f32x4*)(A.in[4] + jt * 1536 + sg * 512 + h * 64 + 4 * c4); } }
        const int nxt = item + F.G;
        if (VAR != 5 && nxt < NIT) raw_fetch(nxt);
        if (wave == 0) {
            const int p = 64 * c + lane;
            const float alog = A.in[5][h], dtb = A.in[6][h];
            float beta = sigmoidf_(cb);
            const float xx = ca + dtb; const float sp = xx > 20.f ? xx : log1pf(__expf(xx));
            float g = -__expf(alog) * sp;
            if (p < PADL) { beta = 0.f; g = 0.f; }
            float gc = g;
#pragma unroll
            for (int o = 1; o < 64; o <<= 1) { const float t = __shfl_up(gc, o); if (lane >= o) gc += t; }
            const float glast = __shfl(gc, 63);
            VEC[lane] = gc; VEC[64 + lane] = beta; VEC[128 + lane] = __expf(gc); VEC[192 + lane] = __expf(glast - gc);
        }
        LBAR(); STG(0);
        LAUNDER(t1, tid); const int sub = t1 & 15, grp = t1 >> 4;
#pragma unroll
        for (int sg = 0; sg < ((VAR == 2 || VAR >= 4) ? 0 : 3); ++sg) {
#pragma unroll
            for (int ps = 0; ps < 2; ++ps) {
                const int i = grp + 32 * ps;
                float acc[4] = {0.f, 0.f, 0.f, 0.f};
#pragma unroll
                for (int jt = 0; jt < 4; ++jt) {
                    const f32x4 w = *(const f32x4*)(CWL + (sg * 4 + jt) * 64 + 4 * sub);
                    const u32x2 rv = *(const u32x2*)(lds + G_RAW2 + (i + jt) * 400 + (sg * 64 + 4 * sub) * 2);
                    acc[0] += w.x * bflo(rv.x); acc[1] += w.y * bfhi(rv.x); acc[2] += w.z * bflo(rv.y); acc[3] += w.w * bfhi(rv.y);
                }
                float y[4];
#pragma unroll
                for (int k = 0; k < 4; ++k) y[k] = siluf_(acc[k]);
                if (sg < 2) {
                    float ss = (y[0] * y[0] + y[1] * y[1]) + (y[2] * y[2] + y[3] * y[3]);
                    ss += __shfl_xor(ss, 1); ss += __shfl_xor(ss, 2); ss += __shfl_xor(ss, 4); ss += __shfl_xor(ss, 8);
                    const float rn = 1.f / sqrtf(ss + EPS);
#pragma unroll
                    for (int k = 0; k < 4; ++k) y[k] *= rn;
                }
                if (sg == 0) {
                    u32x2 o; o.x = pk2(y[0] * 0.125f, y[1] * 0.125f); o.y = pk2(y[2] * 0.125f, y[3] * 0.125f);
                    *(u32x2*)(lds + G_QB + i * (GST * 2) + 8 * sub) = o;
                } else if (sg == 1) {
                    const float beta = VEC[64 + i], ekd = VEC[192 + i];
                    *(f32x4*)(KF + i * 64 + 4 * sub) = (f32x4){y[0], y[1], y[2], y[3]};
                    u32x2 o; o.x = pk2(y[0], y[1]); o.y = pk2(y[2], y[3]);
                    *(u32x2*)(lds + G_KB + i * (GST * 2) + 8 * sub) = o;
                    o.x = pk2(y[0] * beta, y[1] * beta); o.y = pk2(y[2] * beta, y[3] * beta);
                    *(u32x2*)(lds + G_KBB + i * (GST * 2) + 8 * sub) = o;
#pragma unroll
                    for (int k = 0; k < 4; ++k) *(bf16_t*)(lds + G_KDT + (4 * sub + k) * (GST * 2) + i * 2) = (bf16_t)f2bf(y[k] * ekd);
                } else {
                    *(f32x4*)(VF + i * 64 + 4 * sub) = (f32x4){y[0], y[1], y[2], y[3]};
                }
            }
        }
        LBAR(); STG(1);
        if (VAR != 3 && VAR < 4) {
            LAUNDER(l3, lane);
            const int prod = wave >> 2, quad = wave & 3, qr = quad >> 1, qc = quad & 1, r32 = l3 & 31, hh = l3 >> 5;
            const f32x16 acc = mm_quad(lds + (prod ? G_QB : G_KBB), lds + G_KB, qr, qc, l3);
            const int j = 32 * qc + r32; const float gcj = VEC[j];
#pragma unroll
            for (int r = 0; r < 16; ++r) {
                const int i = 32 * qr + crow(r, hh);
                if (prod == 0) { MF[i * 68 + j] = (j < i) ? acc[r] * __expf(VEC[i] - gcj) : 0.f; }
                else { *(bf16_t*)(lds + G_QKB + i * (GST * 2) + j * 2) = (bf16_t)f2bf((j <= i) ? acc[r] * __expf(VEC[i] - gcj) : 0.f); }
            }
        }
        LBAR(); STG(2);
        float* DB = (float*)(lds + G_KBB);
        if (VAR != 1 && VAR < 4 && wave == 0) {
            LAUNDER(l4, lane); const int b = l4 >> 4, jc = l4 & 15;
            float d[16];
#pragma unroll
            for (int i = 0; i < 16; ++i) {
                float acc = (i == jc) ? 1.f : 0.f;
                const float* mrow = MF + (16 * b + i) * 68 + 16 * b;
#pragma unroll
                for (int k = 0; k < i; ++k) acc -= mrow[k] * d[k];
                d[i] = acc;
            }
#pragma unroll
            for (int i = 0; i < 16; ++i) DB[(b * 16 + i) * 20 + jc] = d[i];
        }
        LBAR();
        if (VAR != 1 && VAR < 4) {
            LAUNDER(l4, lane); const int cc = l4 & 15, g = l4 >> 4;
            const bool isU = wave < 4; const int col = 16 * (wave & 3) + cc;
            const float* src = (isU ? VF : KF) + col;
            f32x4 X[4];
#pragma unroll
            for (int b = 0; b < 4; ++b) {
                f32x4 acc;
#pragma unroll
                for (int r = 0; r < 4; ++r) { const int i = 16 * b + 4 * g + r; float rv = src[i * 64] * VEC[64 + i]; if (!isU) rv *= VEC[128 + i]; acc[r] = -rv; }
#pragma unroll
                for (int a = 0; a < b; ++a) {
                    const f32x4 lv = *(const f32x4*)(MF + (16 * b + cc) * 68 + 16 * a + 4 * g);
#pragma unroll
                    for (int sp = 0; sp < 4; ++sp) acc = __builtin_amdgcn_mfma_f32_16x16x4f32(lv[sp], X[a][sp], acc, 0, 0, 0);
                }
                const f32x4 dv = *(const f32x4*)(DB + (b * 16 + cc) * 20 + 4 * g);
                f32x4 xb = (f32x4){0.f, 0.f, 0.f, 0.f};
#pragma unroll
                for (int sp = 0; sp < 4; ++sp) xb = __builtin_amdgcn_mfma_f32_16x16x4f32(dv[sp], acc[sp], xb, 0, 0, 0);
                X[b] = -xb;
                unsigned char* dst = lds + (isU ? G_UT : G_WT) + col * (GST * 2) + (16 * b + 4 * g) * 2;
                *(u32x2*)dst = (u32x2){pk2(X[b][0], X[b][1]), pk2(X[b][2], X[b][3])};
            }
        }
        LBAR(); STG(3);
        if (VAR != 3 && VAR < 4) {
            const float gl = VEC[128 + 63];
            bf16_t* GB = (bf16_t*)(ws + WS_GB) + (size_t)item * 4096;
            bf16_t* GQ = (bf16_t*)(ws + (VAR ? WS_GS : WS_GQ)) + (size_t)item * 4096; bf16_t* GO = (bf16_t*)(ws + (VAR ? WS_GS : WS_GO)) + (size_t)item * 4096;
            bf16_t* GAL = (bf16_t*)(lds + G_MF);
            LAUNDER(l5, lane); const int r32 = l5 & 31, hh = l5 >> 5;
#pragma unroll 1
            for (int it = 0; it < 2; ++it) {
                const int task = wave + 8 * it, prod = task >> 2, quad = task & 3, qr = quad >> 1, qc = quad & 1;
                const f32x16 acc = mm_quad(lds + (prod < 2 ? G_KDT : G_QKB), lds + ((prod & 1) ? G_UT : G_WT), qr, qc, l5);
                const int Cc = 32 * qc + r32;
                if (prod == 0) {
#pragma unroll
                    for (int r = 0; r < 16; ++r) {
                        const int R = 32 * qr + crow(r, hh);
                        const float val = ((R == Cc) ? gl : 0.f) - acc[r];
                        const int rb = R >> 4, m = R & 15, q4 = Cc >> 4, g = (Cc >> 2) & 3, rr = Cc & 3, ks = q4 >> 1, jj = 4 * (q4 & 1) + rr, ls = 16 * g + m;
                        GAL[((rb * 2 + ks) * 64 + ls) * 8 + jj] = (bf16_t)f2bf(val);
                    }
                } else if (prod == 1) {
                    const int eslab = Cc >> 4, n = Cc & 15;
#pragma unroll
                    for (int a = 0; a < 4; ++a) {
                        const int R0 = 32 * qr + 8 * a + 4 * hh; const int rb = R0 >> 4, g = (R0 >> 2) & 3, ls = 16 * g + n;
                        *(u32x2*)(GB + ((eslab * 4 + rb) * 64 + ls) * 4) = (u32x2){pk2(acc[4 * a], acc[4 * a + 1]), pk2(acc[4 * a + 2], acc[4 * a + 3])};
                    }
                } else if (prod == 2) {
#pragma unroll
                    for (int r = 0; r < 16; ++r) {
                        const int R = 32 * qr + crow(r, hh);
                        const float qv = bf2f(*(const bf16_t*)(lds + G_QB + R * (GST * 2) + Cc * 2));
                        GQ[R * 64 + Cc] = (bf16_t)f2bf(qv * VEC[128 + R] - acc[r]);
                    }
                } else {
#pragma unroll
                    for (int r = 0; r < 16; ++r) GO[(quad * 16 + r) * 64 + l5] = (bf16_t)f2bf(acc[r]);
                }
            }
        }
        if (VAR != 5 && nxt < NIT) { raw_park(); cb = nb; ca = na; }
        LBAR(); STG(4);
        if (VAR != 5) { LAUNDER(t6, tid); *(u32x4*)((bf16_t*)(ws + (VAR ? WS_GS : WS_GA)) + (size_t)item * 4096 + t6 * 8) = *(const u32x4*)(lds + G_MF + t6 * 16); }
        STG(5);
    }
    if (PROBE_STAGE >= 0 && tid == 0) { *(unsigned long long*)(lds + 143360 + 96) = stg_acc; }
}

constexpr int SC_D = 8, SC_PD = 6, SC_SLOT = 10240;
DI void gdn_scan(const Frame& F, const Args& A) {
    if (blockIdx.x >= 32) return;
    unsigned char* ws = A.ws;
    const int h = blockIdx.x & 7, eslab = blockIdx.x >> 3, lane = F.lane, wave = F.wave, n = lane & 15, g = lane >> 4;
    const unsigned char* GA = ws + WS_GA; const unsigned char* GB = ws + WS_GB; bf16_t* GS = (bf16_t*)(ws + WS_GS);
    LAS unsigned char* ring = (LAS unsigned char*)F.lds;
    const int np = (wave == 0) ? 0 : ((wave - 1 < 3) ? 2 : 1);
    auto issue = [&](int c) {
        const int cc = c < NCHUNK ? c : NCHUNK - 1;
        const size_t item = (size_t)cc * 8 + h;
        LAS unsigned char* slot = ring + (c % SC_D) * SC_SLOT;
#pragma unroll
        for (int i = 0; i < 2; ++i) if (i < np) {
            const int q = (wave - 1) + 7 * i;
            const unsigned char* src = (q < 8) ? GA + item * 8192 + q * 1024 : GB + item * 8192 + eslab * 2048 + (q - 8) * 1024;
            LAS unsigned char* dst = slot + ((q < 8) ? q * 1024 : 8192 + (q - 8) * 1024);
            __builtin_amdgcn_global_load_lds((const unsigned*)(src + lane * 16), (LAS unsigned*)dst, 16, 0, 0);
        }
    };
    for (int c = 0; c < SC_PD; ++c) issue(c);
    f32x4 S[4];
#pragma unroll
    for (int rb = 0; rb < 4; ++rb) S[rb] = (f32x4){0.f, 0.f, 0.f, 0.f};
#pragma unroll 1
    for (int c = 0; c < NCHUNK; ++c) {
        issue(c + SC_PD);
        if (np == 2) asm volatile("s_waitcnt vmcnt(12)" ::: "memory");
        else if (np == 1) asm volatile("s_waitcnt vmcnt(6)" ::: "memory");
        asm volatile("s_waitcnt lgkmcnt(0)" ::: "memory");
        __builtin_amdgcn_s_barrier();
        asm volatile("" ::: "memory");
        if (wave == 0) {
            const LAS unsigned char* slot = ring + (c % SC_D) * SC_SLOT;
            bf16x8 ac[8]; f32x4 bc[4];
#pragma unroll
            for (int q = 0; q < 8; ++q) ac[q] = *(const LAS bf16x8*)(slot + q * 1024 + lane * 16);
#pragma unroll
            for (int rb = 0; rb < 4; ++rb) { const u32x2 w = *(const LAS u32x2*)(slot + 8192 + rb * 512 + lane * 8); bc[rb] = (f32x4){bflo(w.x), bfhi(w.x), bflo(w.y), bfhi(w.y)}; }
            const size_t item = (size_t)c * 8 + h;
            u32x4 p0, p1;
            p0.x = pk2(S[0][0], S[0][1]); p0.y = pk2(S[0][2], S[0][3]); p0.z = pk2(S[1][0], S[1][1]); p0.w = pk2(S[1][2], S[1][3]);
            p1.x = pk2(S[2][0], S[2][1]); p1.y = pk2(S[2][2], S[2][3]); p1.z = pk2(S[3][0], S[3][1]); p1.w = pk2(S[3][2], S[3][3]);
            {
                bf16_t* st = GS + item * 4096 + (16 * eslab + n) * 64 + 4 * g;
                *(u32x2*)(st + 0) = (u32x2){p0.x, p0.y}; *(u32x2*)(st + 16) = (u32x2){p0.z, p0.w};
                *(u32x2*)(st + 32) = (u32x2){p1.x, p1.y}; *(u32x2*)(st + 48) = (u32x2){p1.z, p1.w};
            }
            const bf16x8 b0 = __builtin_bit_cast(bf16x8, p0), b1 = __builtin_bit_cast(bf16x8, p1);
#pragma unroll
            for (int rb = 0; rb < 4; ++rb) {
                f32x4 acc = bc[rb];
                acc = mfma16(ac[rb * 2 + 0], b0, acc);
                acc = mfma16(ac[rb * 2 + 1], b1, acc);
                S[rb] = acc;
            }
        }
    }
    asm volatile("s_waitcnt vmcnt(0) lgkmcnt(0)" ::: "memory");
    __builtin_amdgcn_s_barrier();
    if (F.tid == 0) { __builtin_amdgcn_fence(__ATOMIC_RELEASE, "agent"); (void)xb_add((unsigned*)(ws + WS_CTL) + CW_SCANDONE, 1u); }
}

DI void gdn_out_task(const Frame& F, const Args& A, int task) {
    unsigned char* ws = A.ws;
    const int ihalf = task & 1, item = (task >> 1) + 8, c = item >> 3, h = item & 7, lane = F.lane, r32 = lane & 31, hh = lane >> 5;
    const bf16_t* GQ = (const bf16_t*)(ws + WS_GQ) + (size_t)item * 4096; const bf16_t* GS = (const bf16_t*)(ws + WS_GS) + (size_t)item * 4096;
    const bf16_t* GO = (const bf16_t*)(ws + WS_GO) + (size_t)item * 4096;
    const bf16_t* Z = (const bf16_t*)(ws + WS_Z); bf16_t* MIX = (bf16_t*)(ws + WS_MIX);
    f32x16 acc[2];
#pragma unroll
    for (int eh = 0; eh < 2; ++eh)
#pragma unroll
        for (int r = 0; r < 16; ++r) acc[eh][r] = bf2f(GO[((ihalf * 2 + eh) * 16 + r) * 64 + lane]);
#pragma unroll
    for (int s = 0; s < 4; ++s) {
        const bf16x8 a = *(const bf16x8*)(GQ + (32 * ihalf + r32) * 64 + 16 * s + 8 * hh);
#pragma unroll
        for (int eh = 0; eh < 2; ++eh) {
            const bf16x8 b = *(const bf16x8*)(GS + (32 * eh + r32) * 64 + 16 * s + 8 * hh);
            acc[eh] = mfma32(a, b, acc[eh]);
        }
    }
    const float* gnorm = A.in[7];
    const float w0 = gnorm[r32], w1 = gnorm[32 + r32];
#pragma unroll
    for (int r = 0; r < 16; ++r) {
        float ss = acc[0][r] * acc[0][r] + acc[1][r] * acc[1][r];
        ss += __shfl_xor(ss, 1); ss += __shfl_xor(ss, 2); ss += __shfl_xor(ss, 4); ss += __shfl_xor(ss, 8); ss += __shfl_xor(ss, 16);
        const float rstd = 1.f / sqrtf(ss * (1.f / 64.f) + EPS);
        const int i = 32 * ihalf + crow(r, hh); const int p = 64 * c + i;
        const float z0 = bf2f(Z[(size_t)p * 512 + h * 64 + r32]), z1 = bf2f(Z[(size_t)p * 512 + h * 64 + 32 + r32]);
        bf16_t* o = MIX + (size_t)(p - 64) * 1024 + h * 64;
        o[r32] = (bf16_t)f2bf(acc[0][r] * rstd * w0 * siluf_(z0));
        o[32 + r32] = (bf16_t)f2bf(acc[1][r] * rstd * w1 * siluf_(z1));
    }
}


constexpr float QSCALE = 0.10206207261596577f * 1.4426950408889634f;
DI double rope_inv_rev(int i) {
    const double t8[8] = {0.15915494309189535, 0.08949940160889101, 0.050329212104487035, 0.0283021958306234, 0.015915494309189534, 0.008949940160889102, 0.005032921210448704, 0.00283021958306234};
    double v = t8[0];
#pragma unroll
    for (int k = 1; k < 8; ++k) v = ((i & 7) == k) ? t8[k] : v;
    return (i & 8) ? v * 0.01 : v;
}
constexpr int P2_TS = 136;
constexpr int P2_RS = 272;
#define P2_WSYNC() do { __builtin_amdgcn_s_waitcnt(0); __builtin_amdgcn_wave_barrier(); } while (0)
DI void mla_prep2_task(const Frame& F, const Args& A, int task) {
    unsigned char* ws = A.ws; int lane = F.lane; asm volatile("" : "+v"(lane));
    const int h = task & 7, blk = task >> 3;
    const int p = 64 * blk + lane;
    const bool valid = (p >= PADL) && (p < LPV);
    const float* qn = A.in[12]; const float* kn = A.in[13];
    unsigned char* TS = F.lds + F.wave * (64 * P2_RS);
    unsigned char* trow = TS + lane * P2_RS;
    const double pos = (double)(p - PADL);
    auto rot = [&](int i, float& sn_, float& cs_) { const double rev = pos * rope_inv_rev(i); const float fr = (float)(rev - floor(rev)); sn_ = __builtin_amdgcn_sinf(fr); cs_ = __builtin_amdgcn_cosf(fr); };
    {
        {
            const bf16_t* srcb = (const bf16_t*)(ws + WS_QH) + (size_t)(64 * blk) * 768 + h * 96;
            u32x4 t[12];
#pragma unroll
            for (int i = 0; i < 12; ++i) { const int c = 64 * i + lane, r = c / 12, pc = c % 12; t[i] = *(const u32x4*)(srcb + (size_t)r * 768 + 8 * pc); }
#pragma unroll
            for (int i = 0; i < 12; ++i) { const int c = 64 * i + lane, r = c / 12, pc = c % 12; *(u32x4*)(TS + r * P2_RS + 16 * pc) = t[i]; }
            P2_WSYNC();
        }
        u32x4 w[12];
#pragma unroll
        for (int c = 0; c < 12; ++c) w[c] = *(const u32x4*)(trow + 16 * c);
        float ss = 0.f;
#pragma unroll
        for (int c = 0; c < 12; ++c) { const float a0 = bflo(w[c].x), a1 = bfhi(w[c].x), a2 = bflo(w[c].y), a3 = bfhi(w[c].y), a4 = bflo(w[c].z), a5 = bfhi(w[c].z), a6 = bflo(w[c].w), a7 = bfhi(w[c].w);
            ss += (a0 * a0 + a1 * a1) + (a2 * a2 + a3 * a3) + (a4 * a4 + a5 * a5) + (a6 * a6 + a7 * a7); }
        const float rs = valid ? QSCALE / sqrtf(ss * (1.f / 96.f) + EPS) : 0.f;
        unsigned char* dst = trow;
#pragma unroll
        for (int c = 0; c < 8; ++c) {
            const f32x4 g0 = *(const f32x4*)(qn + 8 * c), g1 = *(const f32x4*)(qn + 8 * c + 4);
            *(u32x4*)(dst + 16 * c) = (u32x4){pk2(bflo(w[c].x) * rs * g0.x, bfhi(w[c].x) * rs * g0.y), pk2(bflo(w[c].y) * rs * g0.z, bfhi(w[c].y) * rs * g0.w),
                                              pk2(bflo(w[c].z) * rs * g1.x, bfhi(w[c].z) * rs * g1.y), pk2(bflo(w[c].w) * rs * g1.z, bfhi(w[c].w) * rs * g1.w)};
        }
#pragma unroll
        for (int c = 0; c < 2; ++c) {
            float x1[8], x2[8];
            const u32x4 wa = w[8 + c], wb = w[10 + c];
            x1[0] = bflo(wa.x); x1[1] = bfhi(wa.x); x1[2] = bflo(wa.y); x1[3] = bfhi(wa.y); x1[4] = bflo(wa.z); x1[5] = bfhi(wa.z); x1[6] = bflo(wa.w); x1[7] = bfhi(wa.w);
            x2[0] = bflo(wb.x); x2[1] = bfhi(wb.x); x2[2] = bflo(wb.y); x2[3] = bfhi(wb.y); x2[4] = bflo(wb.z); x2[5] = bfhi(wb.z); x2[6] = bflo(wb.w); x2[7] = bfhi(wb.w);
            float o1[8], o2[8];
#pragma unroll
            for (int t = 0; t < 8; ++t) { float sn_, cs_; rot(8 * c + t, sn_, cs_); const float a = x1[t] * rs * qn[64 + 8 * c + t], b = x2[t] * rs * qn[80 + 8 * c + t]; o1[t] = a * cs_ - b * sn_; o2[t] = b * cs_ + a * sn_; }
            *(u32x4*)(dst + 2 * (64 + 8 * c)) = (u32x4){pk2(o1[0], o1[1]), pk2(o1[2], o1[3]), pk2(o1[4], o1[5]), pk2(o1[6], o1[7])};
            *(u32x4*)(dst + 2 * (80 + 8 * c)) = (u32x4){pk2(o2[0], o2[1]), pk2(o2[2], o2[3]), pk2(o2[4], o2[5]), pk2(o2[6], o2[7])};
        }
        P2_WSYNC();
        {
            unsigned char* outb = (unsigned char*)((bf16_t*)(ws + WS_Q) + ((size_t)h * KVROWS + 64 * blk) * 96);
            u32x4 t[12];
#pragma unroll
            for (int i = 0; i < 12; ++i) { const int c = 64 * i + lane, r = c / 12, pc = c % 12; t[i] = *(const u32x4*)(TS + r * P2_RS + 16 * pc); }
#pragma unroll
            for (int i = 0; i < 12; ++i) *(u32x4*)(outb + (size_t)(64 * i + lane) * 16) = t[i];
            P2_WSYNC();
        }
    }
    {
        {
            const bf16_t* srcb = (const bf16_t*)(ws + WS_KVB) + (size_t)(64 * blk) * 1024 + h * 128;
            const unsigned char* kpb = (const unsigned char*)((const float*)(ws + WS_KPE) + (size_t)(64 * blk) * 32);
            u32x4 t[8], e8[8];
#pragma unroll
            for (int i = 0; i < 8; ++i) { const int c = 64 * i + lane, r = c >> 3, pc = c & 7; t[i] = *(const u32x4*)(srcb + (size_t)r * 1024 + 8 * pc); e8[i] = *(const u32x4*)(kpb + (size_t)c * 16); }
#pragma unroll
            for (int i = 0; i < 8; ++i) { const int c = 64 * i + lane, r = c >> 3, pc = c & 7; *(u32x4*)(TS + r * P2_RS + 16 * pc) = t[i]; *(u32x4*)(TS + r * P2_RS + 128 + 16 * pc) = e8[i]; }
            P2_WSYNC();
        }
        u32x4 w[8]; f32x4 e[8];
#pragma unroll
        for (int c = 0; c < 8; ++c) { w[c] = *(const u32x4*)(trow + 16 * c); e[c] = *(const f32x4*)(trow + 128 + 16 * c); }
        float ss = 0.f;
#pragma unroll
        for (int c = 0; c < 8; ++c) { const float a0 = bflo(w[c].x), a1 = bfhi(w[c].x), a2 = bflo(w[c].y), a3 = bfhi(w[c].y), a4 = bflo(w[c].z), a5 = bfhi(w[c].z), a6 = bflo(w[c].w), a7 = bfhi(w[c].w);
            ss += (a0 * a0 + a1 * a1) + (a2 * a2 + a3 * a3) + (a4 * a4 + a5 * a5) + (a6 * a6 + a7 * a7);
            ss += (e[c].x * e[c].x + e[c].y * e[c].y) + (e[c].z * e[c].z + e[c].w * e[c].w); }
        const float rs = valid ? 1.f / sqrtf(ss * (1.f / 96.f) + EPS) : 0.f;
        unsigned char* dst = trow;
#pragma unroll
        for (int c = 0; c < 8; ++c) {
            const f32x4 g0 = *(const f32x4*)(kn + 8 * c), g1 = *(const f32x4*)(kn + 8 * c + 4);
            *(u32x4*)(dst + 16 * c) = (u32x4){pk2(bflo(w[c].x) * rs * g0.x, bfhi(w[c].x) * rs * g0.y), pk2(bflo(w[c].y) * rs * g0.z, bfhi(w[c].y) * rs * g0.w),
                                              pk2(bflo(w[c].z) * rs * g1.x, bfhi(w[c].z) * rs * g1.y), pk2(bflo(w[c].w) * rs * g1.z, bfhi(w[c].w) * rs * g1.w)};
        }
#pragma unroll
        for (int c = 0; c < 2; ++c) {
            const float x1[8] = {e[2 * c].x, e[2 * c].y, e[2 * c].z, e[2 * c].w, e[2 * c + 1].x, e[2 * c + 1].y, e[2 * c + 1].z, e[2 * c + 1].w};
            const float x2[8] = {e[4 + 2 * c].x, e[4 + 2 * c].y, e[4 + 2 * c].z, e[4 + 2 * c].w, e[5 + 2 * c].x, e[5 + 2 * c].y, e[5 + 2 * c].z, e[5 + 2 * c].w};
            float o1[8], o2[8];
#pragma unroll
            for (int t = 0; t < 8; ++t) { float sn_, cs_; rot(8 * c + t, sn_, cs_); const float a = x1[t] * rs * kn[64 + 8 * c + t], b = x2[t] * rs * kn[80 + 8 * c + t]; o1[t] = a * cs_ - b * sn_; o2[t] = b * cs_ + a * sn_; }
            *(u32x4*)(dst + 2 * (64 + 8 * c)) = (u32x4){pk2(o1[0], o1[1]), pk2(o1[2], o1[3]), pk2(o1[4], o1[5]), pk2(o1[6], o1[7])};
            *(u32x4*)(dst + 2 * (80 + 8 * c)) = (u32x4){pk2(o2[0], o2[1]), pk2(o2[2], o2[3]), pk2(o2[4], o2[5]), pk2(o2[6], o2[7])};
        }
        P2_WSYNC();
        {
            unsigned char* outb = (unsigned char*)((bf16_t*)(ws + WS_K) + ((size_t)h * KVROWS + 64 * blk) * 96);
            u32x4 t[12];
#pragma unroll
            for (int i = 0; i < 12; ++i) { const int c = 64 * i + lane, r = c / 12, pc = c % 12; t[i] = *(const u32x4*)(TS + r * P2_RS + 16 * pc); }
#pragma unroll
            for (int i = 0; i < 12; ++i) *(u32x4*)(outb + (size_t)(64 * i + lane) * 16) = t[i];
            P2_WSYNC();
        }
    }
    {
        unsigned char* T = TS;
        const bf16_t* src = (const bf16_t*)(ws + WS_KVB) + h * 128 + 64;
#pragma unroll
        for (int it = 0; it < 8; ++it) {
            const int pr = 8 * it + (lane >> 3), ch = lane & 7; const int pp = 64 * blk + pr;
            u32x4 v = (u32x4){0u, 0u, 0u, 0u};
            if (pp >= PADL && pp < LPV) v = *(const u32x4*)(src + (size_t)pp * 1024 + 8 * ch);
            unsigned char* tp = T + (8 * ch) * P2_TS + pr * 2;
            *(bf16_t*)(tp + 0 * P2_TS) = (bf16_t)(v.x & 0xffffu); *(bf16_t*)(tp + 1 * P2_TS) = (bf16_t)(v.x >> 16);
            *(bf16_t*)(tp + 2 * P2_TS) = (bf16_t)(v.y & 0xffffu); *(bf16_t*)(tp + 3 * P2_TS) = (bf16_t)(v.y >> 16);
            *(bf16_t*)(tp + 4 * P2_TS) = (bf16_t)(v.z & 0xffffu); *(bf16_t*)(tp + 5 * P2_TS) = (bf16_t)(v.z >> 16);
            *(bf16_t*)(tp + 6 * P2_TS) = (bf16_t)(v.w & 0xffffu); *(bf16_t*)(tp + 7 * P2_TS) = (bf16_t)(v.w >> 16);
        }
        __builtin_amdgcn_s_waitcnt(0); __builtin_amdgcn_wave_barrier();
        bf16_t* VT = (bf16_t*)(ws + WS_VT) + (size_t)h * 64 * KVROWS + 64 * blk;
#pragma unroll
        for (int it = 0; it < 8; ++it) {
            const int e = 8 * it + (lane >> 3), ch = lane & 7;
            const u32x2 lo = *(const u32x2*)(T + e * P2_TS + 16 * ch), hi = *(const u32x2*)(T + e * P2_TS + 16 * ch + 8);
            *(u32x4*)(VT + (size_t)e * KVROWS + 8 * ch) = (u32x4){lo.x, lo.y, hi.x, hi.y};
        }
        __builtin_amdgcn_s_waitcnt(0); __builtin_amdgcn_wave_barrier();
    }
}

constexpr int A_KSTR = 208;
constexpr int A_VSTR = 136;
constexpr int A_KBYTES = 64 * A_KSTR;
constexpr int A_VBYTES = 64 * A_VSTR;
constexpr int A_BUF = A_KBYTES + A_VBYTES;
DI unsigned cvtpk_s(float lo, float hi) { typedef float f2 __attribute__((ext_vector_type(2))); typedef __bf16 b2 __attribute__((ext_vector_type(2))); f2 v = {lo, hi}; b2 b = __builtin_convertvector(v, b2); return __builtin_bit_cast(unsigned, b); }

DI void attn_item(const Frame& F, const Args& A, int h, int qb) {
    unsigned char* ws = A.ws; unsigned char* lds = F.lds;
    const int tid = F.tid, lane = F.lane, wave = F.wave, r32 = lane & 31, hh = lane >> 5;
    const bf16_t* Qg = (const bf16_t*)(ws + WS_Q) + (size_t)h * KVROWS * 96;
    const bf16_t* Kg = (const bf16_t*)(ws + WS_K) + (size_t)h * KVROWS * 96;
    const bf16_t* Vg = (const bf16_t*)(ws + WS_VT) + (size_t)h * 64 * KVROWS;
    const int p0w = 64 + 256 * qb + 32 * wave;
    const int qp = p0w + r32;
    const int ntile = 4 * qb + 5;
    const int mylast = 1 + 4 * qb + (wave >> 1);
    bf16x8 qf[6];
#pragma unroll
    for (int s = 0; s < 6; ++s) qf[s] = *(const bf16x8*)(Qg + (size_t)qp * 96 + 16 * s + 8 * hh);
    f32x16 ot[2]; ot[0] = zero16(); ot[1] = zero16();
    float mrun = -1e30f, lrun = 0.f;
    const int kr0 = tid / 12, kc0 = tid % 12, kr1 = (tid + 512) / 12, kc1 = (tid + 512) % 12; const bool k1ok = tid < 256;
    const int vr = tid >> 3, vc = tid & 7;
    struct Stg { u32x4 k0, k1, v; };
    Stg sA;
    auto gload = [&](Stg& st, int j) {
        const int kv0 = 64 * j;
        st.k0 = *(const u32x4*)(Kg + (size_t)(kv0 + kr0) * 96 + kc0 * 8);
        if (k1ok) st.k1 = *(const u32x4*)(Kg + (size_t)(kv0 + kr1) * 96 + kc1 * 8);
        st.v = *(const u32x4*)(Vg + (size_t)vr * KVROWS + kv0 + vc * 8);
    };
    auto lstore = [&](const Stg& st, int t) {
        unsigned char* kb = lds + (t % 3) * A_BUF; unsigned char* vb = kb + A_KBYTES;
        *(u32x4*)(kb + kr0 * A_KSTR + kc0 * 16) = st.k0;
        if (k1ok) *(u32x4*)(kb + kr1 * A_KSTR + kc1 * 16) = st.k1;
        *(u32x2*)(vb + vr * A_VSTR + vc * 16) = (u32x2){st.v.x, st.v.y};
        *(u32x2*)(vb + vr * A_VSTR + vc * 16 + 8) = (u32x2){st.v.z, st.v.w};
    };
    auto step = [&](auto FIRSTc, auto LASTc, int t, f32x16 (&C)[2], f32x16 (&P)[2]) {
        if (t + 1 < ntile) gload(sA, t + 1);
        constexpr bool has_cur = !decltype(LASTc)::value, has_prev = !decltype(FIRSTc)::value;
        const unsigned char* kb = lds + (t % 3) * A_BUF;
        const unsigned char* vb = lds + ((t + 2) % 3) * A_BUF + A_KBYTES;
        bf16x8 kf[2][6];
        if constexpr (has_cur) {
            const unsigned char* kp = kb + r32 * A_KSTR + hh * 16;
#pragma unroll
            for (int s = 0; s < 6; ++s) kf[0][s] = *(const bf16x8*)(kp + s * 32);
        }
        float ps0 = 0.f, ps1 = 0.f; u32x4 pw[4]; bf16x8 vfr[4][2];
        auto vload = [&](int g) -> bf16x8 {
            const int f = g >> 1, eh = g & 1, kh2 = f >> 1, s2 = f & 1;
            const unsigned char* vp = vb + (32 * eh + r32) * A_VSTR + (32 * kh2 + 16 * s2 + 4 * hh) * 2;
            const u32x2 lo = *(const u32x2*)vp, hi2 = *(const u32x2*)(vp + 16);
            return __builtin_bit_cast(bf16x8, (u32x4){lo.x, lo.y, hi2.x, hi2.y}); };
        __builtin_amdgcn_sched_barrier(0);
#pragma unroll
        for (int i = 0; i < 12; ++i) {
            const int kh = i / 6, sx = i % 6;
            if constexpr (has_cur) { C[kh] = mfma32(kf[kh][sx], qf[sx], sx == 0 ? zero16() : C[kh]); if (i < 6) kf[1][i] = *(const bf16x8*)(kb + (32 + r32) * A_KSTR + hh * 16 + i * 32); }
            if (has_prev && i < 8) {
                const int f = i >> 1, kh2 = f >> 1, b0 = 8 * (f & 1) + 4 * (i & 1);
                const float v0 = P[kh2][b0], v1 = P[kh2][b0 + 1], v2 = P[kh2][b0 + 2], v3 = P[kh2][b0 + 3];
                ps0 += v0 + v1; ps1 += v2 + v3;
                if (i & 1) { pw[f].z = cvtpk_s(v0, v1); pw[f].w = cvtpk_s(v2, v3); asm volatile("" : "+v"(ps0), "+v"(ps1), "+v"(pw[f].z), "+v"(pw[f].w)); }
                else { pw[f].x = cvtpk_s(v0, v1); pw[f].y = cvtpk_s(v2, v3); asm volatile("" : "+v"(ps0), "+v"(ps1), "+v"(pw[f].x), "+v"(pw[f].y)); }
            }
            if (has_prev && i >= 10) {
                const int g0 = i - 10; vfr[g0 >> 1][g0 & 1] = vload(g0);
            }
            __builtin_amdgcn_sched_barrier(0);
        }
        if (has_prev) lrun += ps0 + ps1;
        float mnew = mrun, alpha = 1.f; bool resc = false;
        if constexpr (has_cur) {
            if (t == 0) {
#pragma unroll
                for (int kh = 0; kh < 2; ++kh)
#pragma unroll
                    for (int r = 0; r < 16; ++r) { const int kv = 32 * kh + crow(r, hh); if (kv < PADL) C[kh][r] = -INFINITY; }
            }
            if (t >= mylast) {
#pragma unroll
                for (int kh = 0; kh < 2; ++kh)
#pragma unroll
                    for (int r = 0; r < 16; ++r) { const int kv = 64 * t + 32 * kh + crow(r, hh); if (kv > qp) C[kh][r] = -INFINITY; }
            }
            float mx = C[0][0];
#pragma unroll
            for (int r = 1; r < 16; ++r) mx = fmaxf(mx, C[0][r]);
#pragma unroll
            for (int r = 0; r < 16; ++r) mx = fmaxf(mx, C[1][r]);
            mx = fmaxf(mx, __shfl_xor(mx, 32));
            mnew = fmaxf(mrun, mx);
            alpha = __builtin_amdgcn_exp2f(mrun - mnew);
            resc = __any(mnew > mrun);
        }
        __builtin_amdgcn_sched_barrier(0);
#pragma unroll
        for (int g = 0; g < 8; ++g) {
            const int f = g >> 1, eh = g & 1;
            if constexpr (has_prev) { ot[eh] = mfma32(vfr[f][eh], __builtin_bit_cast(bf16x8, pw[f]), ot[eh]); if (g + 2 < 8) vfr[(g + 2) >> 1][(g + 2) & 1] = vload(g + 2); }
            if constexpr (has_cur) { const int kh = g >> 2, r0 = 4 * (g & 3);
#pragma unroll
                for (int q = 0; q < 4; ++q) C[kh][r0 + q] = __builtin_amdgcn_exp2f(C[kh][r0 + q] - mnew);
                asm volatile("" : "+v"(C[kh][r0]), "+v"(C[kh][r0 + 1]), "+v"(C[kh][r0 + 2]), "+v"(C[kh][r0 + 3])); }
            __builtin_amdgcn_sched_barrier(0);
        }
        if constexpr (has_cur) {
            if (resc) {
#pragma unroll
                for (int eh = 0; eh < 2; ++eh)
#pragma unroll
                    for (int r = 0; r < 16; ++r) ot[eh][r] *= alpha;
            }
            lrun *= alpha; mrun = mnew;
        }
        if (t + 1 < ntile) lstore(sA, t + 1);
        __syncthreads();
    };
    gload(sA, 0); lstore(sA, 0);
    __syncthreads();
    f32x16 scA[2], scB[2];
    scB[0] = zero16(); scB[1] = zero16();
    {
        using TT = std::integral_constant<bool, true>; using FF = std::integral_constant<bool, false>;
        step(TT{}, FF{}, 0, scA, scB);
#pragma unroll 1
        for (int t = 1; t + 1 < ntile; t += 2) {
            step(FF{}, FF{}, t, scB, scA);
            step(FF{}, FF{}, t + 1, scA, scB);
        }
        step(FF{}, TT{}, ntile, scB, scA);
    }
    const float ltot = lrun + __shfl_xor(lrun, 32);
    const float rl = 1.f / ltot;
    bf16_t* o = (bf16_t*)(ws + WS_MIX) + (size_t)(qp - 64) * 1024 + 512 + h * 64;
#pragma unroll
    for (int eh = 0; eh < 2; ++eh)
#pragma unroll
        for (int a = 0; a < 4; ++a) {
            const int e = 32 * eh + 8 * a + 4 * hh;
            *(u32x2*)(o + e) = (u32x2){pk2(ot[eh][4 * a] * rl, ot[eh][4 * a + 1] * rl), pk2(ot[eh][4 * a + 2] * rl, ot[eh][4 * a + 3] * rl)};
        }
}

DI void xn_rows(const Frame& F, const Args& A, int u0, int stride) {
    f32x4 v[2][4];
#pragma unroll
    for (int r = 0; r < 2; ++r) { const int u = u0 + r * stride; if (u < MU) { const f32x4* xr = (const f32x4*)(A.out + (size_t)u * DM) + F.lane;
#pragma unroll
        for (int j = 0; j < 4; ++j) v[r][j] = xr[64 * j]; } }
#pragma unroll
    for (int r = 0; r < 2; ++r) {
        const int u = u0 + r * stride; if (u >= MU) continue;
        float s = 0.f;
#pragma unroll
        for (int j = 0; j < 4; ++j) s += (v[r][j].x * v[r][j].x + v[r][j].y * v[r][j].y) + (v[r][j].z * v[r][j].z + v[r][j].w * v[r][j].w);
        const float rstd = 1.f / sqrtf(wave_sum(s) * (1.f / DM) + EPS);
        unsigned long long* o8 = (unsigned long long*)((bf16_t*)(A.ws + WS_XN) + (size_t)u * DM) + F.lane;
#pragma unroll
        for (int j = 0; j < 4; ++j) { const f32x4 w = ((const f32x4*)A.in[15])[64 * j + F.lane];
            o8[64 * j] = (unsigned long long)pk2(v[r][j].x * rstd * w.x, v[r][j].y * rstd * w.y) | ((unsigned long long)pk2(v[r][j].z * rstd * w.z, v[r][j].w * rstd * w.w) << 32); }
    }
}

DI unsigned fkey(float v, int idx) { unsigned u = __builtin_bit_cast(unsigned, v); u = (u & 0x80000000u) ? ~u : (u | 0x80000000u); return (u & ~127u) | (unsigned)(127 - idx); }
DI float keyval(unsigned k) { unsigned u = k & ~127u; u = (u & 0x80000000u) ? (u & 0x7fffffffu) : ~u; return __builtin_bit_cast(float, u); }

__device__ const unsigned char PAIR_A[50] = {0,0,0,0,0,0,0,0,0,0,0,0,0,0,0,0, 1,1,1,1,1,1,1,1, 2,2,2,2,2, 3,3,3,3, 4,4,4, 5,5, 6,6, 7,7, 8,9,10,11,12,13,14,15};
__device__ const unsigned char PAIR_B[50] = {0,1,2,3,4,5,6,7,8,9,10,11,12,13,14,15, 0,1,2,3,4,5,6,7, 0,1,2,3,4, 0,1,2,3, 0,1,2, 0,1, 0,1, 0,1, 0,0,0,0,0,0,0,0};

DI void ce_desc(unsigned& a, unsigned& b) { const unsigned mx = a > b ? a : b, mn = a > b ? b : a; a = mx; b = mn; }
template <int BASE, int NK> DI void bitonic_sort16_desc(unsigned (&x)[NK]) {
#pragma unroll
    for (int k = 2; k <= 16; k <<= 1)
#pragma unroll
        for (int j = k >> 1; j > 0; j >>= 1)
#pragma unroll
            for (int i = 0; i < 16; ++i) { const int l = i ^ j; if (l > i) { if ((i & k) == 0) ce_desc(x[BASE + i], x[BASE + l]); else ce_desc(x[BASE + l], x[BASE + i]); } }
}
template <int A0, int B0, int NK> DI void merge_top16(unsigned (&x)[NK]) {
#pragma unroll
    for (int i = 0; i < 16; ++i) { const unsigned p = x[A0 + i], q = x[B0 + 15 - i]; x[A0 + i] = p > q ? p : q; }
#pragma unroll
    for (int j = 8; j > 0; j >>= 1)
#pragma unroll
        for (int i = 0; i < 16; ++i) { const int l = i ^ j; if (l > i) ce_desc(x[A0 + i], x[A0 + l]); }
}
template <int NK> DI void top16_of_128(unsigned (&key)[NK]) {
    bitonic_sort16_desc<0, NK>(key); bitonic_sort16_desc<16, NK>(key); bitonic_sort16_desc<32, NK>(key); bitonic_sort16_desc<48, NK>(key);
    bitonic_sort16_desc<64, NK>(key); bitonic_sort16_desc<80, NK>(key); bitonic_sort16_desc<96, NK>(key); bitonic_sort16_desc<112, NK>(key);
    merge_top16<0, 16, NK>(key); merge_top16<32, 48, NK>(key); merge_top16<64, 80, NK>(key); merge_top16<96, 112, NK>(key);
    merge_top16<0, 32, NK>(key); merge_top16<64, 96, NK>(key);
    merge_top16<0, 64, NK>(key);
}

DI void topk_task(const Frame& F, const Args& A, int task) {
    unsigned char* ws = A.ws; const int tid = F.tid;
    const int u = task >> 3, h = task & 7;
    LAS unsigned* sk = (LAS unsigned*)(LAS unsigned char*)F.lds;
    LAS unsigned* pkk = sk + 16384;
    LAS unsigned* stg = sk + 16384;
    const bf16_t* SCb = (const bf16_t*)(ws + WS_SC) + (size_t)(task & ~511) * 256;
#pragma unroll 1
    for (int half = 0; half < 2; ++half) {
        unsigned key[128];
#pragma unroll
        for (int qb = 0; qb < 2; ++qb) {
            u32x4 pf[8];
#pragma unroll
            for (int k = 0; k < 8; ++k) { const int c = tid + 512 * k; pf[k] = *(const u32x4*)(SCb + (size_t)(c >> 3) * 256 + half * 128 + qb * 64 + (c & 7) * 8); }
#pragma unroll
            for (int k = 0; k < 8; ++k) { const int c = tid + 512 * k; *(LAS u32x4*)(stg + (c >> 3) * 36 + (c & 7) * 4) = pf[k]; }
            __syncthreads();
#pragma unroll
            for (int i = 0; i < 8; ++i) { const u32x4 v = *(const LAS u32x4*)(stg + tid * 36 + 4 * i); const int b0 = 64 * qb + 8 * i;
                key[b0] = fkey(bflo(v.x), b0); key[b0 + 1] = fkey(bfhi(v.x), b0 + 1); key[b0 + 2] = fkey(bflo(v.y), b0 + 2); key[b0 + 3] = fkey(bfhi(v.y), b0 + 3);
                key[b0 + 4] = fkey(bflo(v.z), b0 + 4); key[b0 + 5] = fkey(bfhi(v.z), b0 + 5); key[b0 + 6] = fkey(bflo(v.w), b0 + 6); key[b0 + 7] = fkey(bfhi(v.w), b0 + 7); }
            __syncthreads();
        }
        top16_of_128(key);
#pragma unroll
        for (int r = 0; r < 16; ++r) sk[(half * 16 + r) * 512 + tid] = key[r];
    }
    float v1[16], v2[16];
#pragma unroll
    for (int r = 0; r < 16; ++r) { v1[r] = keyval(sk[r * 512 + tid]); v2[r] = keyval(sk[(16 + r) * 512 + tid]); }
    unsigned ck[64];
#pragma unroll
    for (int c = 50; c < 64; ++c) ck[c] = 0u;
#pragma unroll
    for (int a = 0; a < 16; ++a) {
        const int off = a == 0 ? 0 : a == 1 ? 16 : a == 2 ? 24 : a == 3 ? 29 : a == 4 ? 33 : a == 5 ? 36 : a == 6 ? 38 : a == 7 ? 40 : 42 + (a - 8);
#pragma unroll
        for (int b = 0; b < 16; ++b) if ((a + 1) * (b + 1) <= 16) ck[off + b] = fkey(v1[a] + v2[b], off + b);
    }
    bitonic_sort16_desc<0, 64>(ck); bitonic_sort16_desc<16, 64>(ck); bitonic_sort16_desc<32, 64>(ck); bitonic_sort16_desc<48, 64>(ck);
    merge_top16<0, 16, 64>(ck); merge_top16<32, 48, 64>(ck); merge_top16<0, 32, 64>(ck);
#pragma unroll
    for (int r = 0; r < 16; ++r) pkk[r * 512 + tid] = ck[r];
    const float cmax = keyval(pkk[tid]);
    float ev[16]; float esum = 0.f; int ex[16];
#pragma unroll
    for (int r = 0; r < 16; ++r) {
        const unsigned k = pkk[r * 512 + tid]; const int c = 127 - (int)(k & 127u);
        ev[r] = __expf(keyval(k) - cmax); esum += ev[r];
        const int a = PAIR_A[c], b = PAIR_B[c];
        const int i1 = 127 - (int)(sk[a * 512 + tid] & 127u), i2 = 127 - (int)(sk[(16 + b) * 512 + tid] & 127u);
        ex[r] = i1 * 128 + i2;
    }
    const float rs = 1.f / esum;
    int* IDX = (int*)(ws + WS_IDX) + (size_t)u * 128 + h * 16; float* GATE = (float*)(ws + WS_GATE) + (size_t)u * 128 + h * 16;
#pragma unroll
    for (int r = 0; r < 16; r += 4) {
        *(int4*)(IDX + r) = make_int4(ex[r], ex[r + 1], ex[r + 2], ex[r + 3]);
        *(f32x4*)(GATE + r) = (f32x4){ev[r] * rs, ev[r + 1] * rs, ev[r + 2] * rs, ev[r + 3] * rs};
    }
}

constexpr float EU_SCALE = 64.f, EV_SCALE = 16.f;
DI unsigned pk4_fp8(float a, float b, float c, float d) { int w = 0; w = __builtin_amdgcn_cvt_pk_fp8_f32(a, b, w, false); w = __builtin_amdgcn_cvt_pk_fp8_f32(c, d, w, true); return (unsigned)w; }
DI void convert_tables(const Frame& F, const Args& A) {
    const size_t n16 = (size_t)16384 * 1024 / 16;
    const size_t gt = (size_t)blockIdx.x * 512 + F.tid, NGT = (size_t)F.G * 512;
#pragma unroll 1
    for (int t = 0; t < 2; ++t) {
        const float* src = A.in[18 + t]; unsigned char* dst = A.ws + (t ? WS_EV : WS_EU); const float sc = t ? EV_SCALE : EU_SCALE;
        const float* fn = A.in[15];
        for (size_t i = gt; i < n16; i += NGT) {
            f32x4 a = *(const f32x4*)(src + i * 16) * sc, b = *(const f32x4*)(src + i * 16 + 4) * sc, c = *(const f32x4*)(src + i * 16 + 8) * sc, d = *(const f32x4*)(src + i * 16 + 12) * sc;
            if (t == 0) { const float* g = fn + (i & 63) * 16; a *= *(const f32x4*)g; b *= *(const f32x4*)(g + 4); c *= *(const f32x4*)(g + 8); d *= *(const f32x4*)(g + 12); }
            const size_t e_ = i >> 6, c16_ = i & 63;
            *(u32x4*)(dst + (c16_ >> 3) * ((size_t)16384 * 128) + e_ * 128 + (c16_ & 7) * 16) = (u32x4){pk4_fp8(a.x, a.y, a.z, a.w), pk4_fp8(b.x, b.y, b.z, b.w), pk4_fp8(c.x, c.y, c.z, c.w), pk4_fp8(d.x, d.y, d.z, d.w)};
        }
    }
}

DI float gelu_exact(float x) { return 0.5f * x * (1.f + erff(x * 0.70710678118654752f)); }
typedef float f32x2 __attribute__((ext_vector_type(2)));
#define UNPK16(dst, W_) do { f32x2 _t; \
    _t = __builtin_amdgcn_cvt_pk_f32_fp8((int)(W_).x, false); dst[0] = _t.x; dst[1] = _t.y; _t = __builtin_amdgcn_cvt_pk_f32_fp8((int)(W_).x, true); dst[2] = _t.x; dst[3] = _t.y; \
    _t = __builtin_amdgcn_cvt_pk_f32_fp8((int)(W_).y, false); dst[4] = _t.x; dst[5] = _t.y; _t = __builtin_amdgcn_cvt_pk_f32_fp8((int)(W_).y, true); dst[6] = _t.x; dst[7] = _t.y; \
    _t = __builtin_amdgcn_cvt_pk_f32_fp8((int)(W_).z, false); dst[8] = _t.x; dst[9] = _t.y; _t = __builtin_amdgcn_cvt_pk_f32_fp8((int)(W_).z, true); dst[10] = _t.x; dst[11] = _t.y; \
    _t = __builtin_amdgcn_cvt_pk_f32_fp8((int)(W_).w, false); dst[12] = _t.x; dst[13] = _t.y; _t = __builtin_amdgcn_cvt_pk_f32_fp8((int)(W_).w, true); dst[14] = _t.x; dst[15] = _t.y; } while (0)

template <bool UPH>
DI void expert_phase(const Frame& F, const Args& A, int xv, int wq, int nw) {
    unsigned char* ws = A.ws; const int lane = F.lane, grp = lane >> 3, j = lane & 7;
    const unsigned char* TBL = ws + (UPH ? WS_EU : WS_EV) + (size_t)xv * ((size_t)16384 * 128) + 16 * j;
    const int* IDX = (const int*)(ws + WS_IDX); const float* CW = (const float*)(ws + WS_CW);
    const bf16_t* XN = (const bf16_t*)(ws + WS_XN) + 128 * xv + 16 * j;
    float* HP = (float*)(ws + WS_HP);
    LAS unsigned* ring = (LAS unsigned*)((LAS unsigned char*)F.lds + F.wave * 4096);
    const int nt = (MU - wq + nw - 1) / nw;
    if (nt <= 0) return;
    auto tok = [&](int k) { return __builtin_amdgcn_readfirstlane(wq + (k < nt ? k : nt - 1) * nw); };
    int mi0, mi1; u32x4 mx0, mx1; float mh0, mh1;
    auto meta_load = [&](int k) {
        const int u = tok(k);
        mi0 = IDX[(size_t)u * 128 + lane]; mi1 = IDX[(size_t)u * 128 + 64 + lane];
        if constexpr (UPH) { mx0 = *(const u32x4*)(XN + (size_t)u * DM); mx1 = *(const u32x4*)(XN + (size_t)u * DM + 8); }
        else { mh0 = CW[(size_t)u * 128 + lane]; mh1 = CW[(size_t)u * 128 + 64 + lane]; }
    };
    auto meta_store = [&](int k) {
        LAS unsigned* sl = ring + (k & 3) * 256;
        sl[lane] = (unsigned)mi0; sl[64 + lane] = (unsigned)mi1;
        if constexpr (UPH) { if (grp == 0) { *(LAS u32x4*)(sl + 128 + 8 * j) = mx0; *(LAS u32x4*)(sl + 128 + 8 * j + 4) = mx1; } }
        else { sl[128 + lane] = __builtin_bit_cast(unsigned, mh0); sl[192 + lane] = __builtin_bit_cast(unsigned, mh1); }
    };
    auto gather = [&](u32x4 (&buf)[8], int n) {
        const LAS unsigned* sl = ring + ((n >> 1) & 3) * 256 + 64 * (n & 1) + grp;
#pragma unroll
        for (int i = 0; i < 8; ++i) { const int e = (int)sl[8 * i]; buf[i] = *(const u32x4*)(TBL + (size_t)e * 128); }
    };
    const int ocol = 128 * xv + 16 * j + ((lane & 32) ? 8 : 0) + ((lane & 16) ? 4 : 0) + ((lane & 8) ? 2 : 0);
    f32x2 ocur = (f32x2){0.f, 0.f};
    float acc[16];
    float xn[16];
    auto compute = [&](u32x4 (&buf)[8], int n) {
        const int k = n >> 1, hf = n & 1;
        const LAS unsigned* sl = ring + (k & 3) * 256;
        if (hf == 0) {
            if constexpr (UPH) {
                const u32x4 x0 = *(const LAS u32x4*)(sl + 128 + 8 * j), x1 = *(const LAS u32x4*)(sl + 128 + 8 * j + 4);
                xn[0] = bflo(x0.x); xn[1] = bfhi(x0.x); xn[2] = bflo(x0.y); xn[3] = bfhi(x0.y); xn[4] = bflo(x0.z); xn[5] = bfhi(x0.z); xn[6] = bflo(x0.w); xn[7] = bfhi(x0.w);
                xn[8] = bflo(x1.x); xn[9] = bfhi(x1.x); xn[10] = bflo(x1.y); xn[11] = bfhi(x1.y); xn[12] = bflo(x1.z); xn[13] = bfhi(x1.z); xn[14] = bflo(x1.w); xn[15] = bfhi(x1.w);
            } else {
#pragma unroll
                for (int c = 0; c < 16; ++c) acc[c] = 0.f;
                ocur = *(const f32x2*)(A.out + (size_t)tok(k) * DM + ocol);
            }
        }
#pragma unroll
        for (int i = 0; i < 8; ++i) {
            float f[16]; UNPK16(f, buf[i]);
            if constexpr (UPH) {
                float a0 = 0.f, a1 = 0.f;
#pragma unroll
                for (int c = 0; c < 16; c += 2) { a0 += f[c] * xn[c]; a1 += f[c + 1] * xn[c + 1]; }
                if (hf == 0) acc[i] = a0 + a1; else acc[8 + i] = a0 + a1;
                if (i < 7) { if (hf == 0) asm volatile("" : "+v"(buf[i + 1].x), "+v"(buf[i + 1].y), "+v"(buf[i + 1].z), "+v"(buf[i + 1].w), "+v"(acc[i]));
                             else asm volatile("" : "+v"(buf[i + 1].x), "+v"(buf[i + 1].y), "+v"(buf[i + 1].z), "+v"(buf[i + 1].w), "+v"(acc[8 + i])); }
            } else {
                const float cw = __builtin_bit_cast(float, sl[128 + 64 * hf + 8 * i + grp]);
#pragma unroll
                for (int c = 0; c < 16; ++c) acc[c] += cw * f[c];
                if (i < 7) asm volatile("" : "+v"(buf[i + 1].x), "+v"(buf[i + 1].y), "+v"(buf[i + 1].z), "+v"(buf[i + 1].w),
                                             "+v"(acc[0]), "+v"(acc[1]), "+v"(acc[2]), "+v"(acc[3]), "+v"(acc[4]), "+v"(acc[5]), "+v"(acc[6]), "+v"(acc[7]),
                                             "+v"(acc[8]), "+v"(acc[9]), "+v"(acc[10]), "+v"(acc[11]), "+v"(acc[12]), "+v"(acc[13]), "+v"(acc[14]), "+v"(acc[15]));
            }
            __builtin_amdgcn_sched_barrier(0);
        }
        if (hf == 1 && k < nt) {
            const int u = tok(k);
            float r8[8], r4[4], r2[2];
            if constexpr (UPH) {
                { const bool up = lane & 4;
#pragma unroll
                  for (int i = 0; i < 8; ++i) { const float send = up ? acc[i] : acc[i + 8], keep = up ? acc[i + 8] : acc[i]; r8[i] = keep + __shfl_xor(send, 4); } }
                { const bool up = lane & 2;
#pragma unroll
                  for (int i = 0; i < 4; ++i) { const float send = up ? r8[i] : r8[i + 4], keep = up ? r8[i + 4] : r8[i]; r4[i] = keep + __shfl_xor(send, 2); } }
                { const bool up = lane & 1;
#pragma unroll
                  for (int i = 0; i < 2; ++i) { const float send = up ? r4[i] : r4[i + 2], keep = up ? r4[i + 2] : r4[i]; r2[i] = keep + __shfl_xor(send, 1); } }
                const int st = ((lane & 4) ? 8 : 0) + ((lane & 2) ? 4 : 0) + ((lane & 1) ? 2 : 0);
                float* hp = HP + ((size_t)xv * MU + u) * 128 + grp;
                hp[8 * st] = r2[0]; hp[8 * (st + 1)] = r2[1];
            } else {
                { const bool up = lane & 32;
#pragma unroll
                  for (int c = 0; c < 8; ++c) { const float send = up ? acc[c] : acc[c + 8], keep = up ? acc[c + 8] : acc[c]; r8[c] = keep + __shfl_xor(send, 32); } }
                { const bool up = lane & 16;
#pragma unroll
                  for (int c = 0; c < 4; ++c) { const float send = up ? r8[c] : r8[c + 4], keep = up ? r8[c + 4] : r8[c]; r4[c] = keep + __shfl_xor(send, 16); } }
                { const bool up = lane & 8;
#pragma unroll
                  for (int c = 0; c < 2; ++c) { const float send = up ? r4[c] : r4[c + 2], keep = up ? r4[c + 2] : r4[c]; r2[c] = keep + __shfl_xor(send, 8); } }
                f32x2* o = (f32x2*)(A.out + (size_t)u * DM + ocol);
                f32x2 cur = ocur; cur.x += r2[0]; cur.y += r2[1]; *o = cur;
            }
        }
    };
    meta_load(0); meta_store(0); meta_load(1); meta_store(1); meta_load(2); meta_store(2);
    u32x4 b0[8], b1[8], b2[8];
    gather(b0, 0); gather(b1, 1); gather(b2, 2);
#pragma unroll 1
    for (int k0 = 0; k0 < nt; k0 += 3) {
        const int n0 = 2 * k0;
        meta_load(k0 + 3);
        compute(b0, n0);     gather(b0, n0 + 3);
        compute(b1, n0 + 1); meta_store(k0 + 3); gather(b1, n0 + 4);
        meta_load(k0 + 4);
        compute(b2, n0 + 2); gather(b2, n0 + 5);
        compute(b0, n0 + 3); meta_store(k0 + 4); gather(b0, n0 + 6);
        meta_load(k0 + 5);
        compute(b1, n0 + 4); gather(b1, n0 + 7);
        compute(b2, n0 + 5); meta_store(k0 + 5); gather(b2, n0 + 8);
    }
}


DI void expert_c_pass(const Frame& F, const Args& A) {
    unsigned char* ws = A.ws;
    const float* HP = (const float*)(ws + WS_HP); const float* GATE = (const float*)(ws + WS_GATE); float* CW = (float*)(ws + WS_CW);
    const size_t n4 = (size_t)MU * 128 / 4;
    for (size_t i = (size_t)blockIdx.x * 512 + F.tid; i < n4; i += (size_t)F.G * 512) {
        f32x4 h = *(const f32x4*)(HP + i * 4);
#pragma unroll
        for (int x = 1; x < 8; ++x) h += *(const f32x4*)(HP + (size_t)x * MU * 128 + i * 4);
        const f32x4 g = *(const f32x4*)(GATE + i * 4);
        const float rs = (1.f / EU_SCALE) / sqrtf(ss_sum16((const float*)(ws + WS_SS4), (int)(i >> 5)) * (1.f / DM) + EPS);
        f32x4 c;
        c.x = gelu_exact(h.x * rs) * g.x * (1.f / EV_SCALE); c.y = gelu_exact(h.y * rs) * g.y * (1.f / EV_SCALE);
        c.z = gelu_exact(h.z * rs) * g.z * (1.f / EV_SCALE); c.w = gelu_exact(h.w * rs) * g.w * (1.f / EV_SCALE);
        *(f32x4*)(CW + i * 4) = c;
    }
}
template <int PH> DI void run_phase(const Frame& F, const Args& args, PG8_LAS unsigned char* lds3) {
    unsigned char* ws = args.ws;
    if constexpr (PH == 0) { p0_prologue(F, args); p0_late_weights<0>(F, args, (7 - F.wave) * F.G + blockIdx.x, F.NGW, blockIdx.x * 512 + F.tid, F.G * 512); }
    if constexpr (PH == 1) {
        pg8::Gemm g{(const bf16_t*)(ws + WS_HN), (const bf16_t*)(ws + WS_WIN), MP, NPROJ, 1024, 1024, 1024, 0};
        pg8::StaticOrder S; S.init(MP, NPROJ, F.G, (int)blockIdx.x);
        EpiProj E{(bf16_t*)(ws + WS_QKVR), (bf16_t*)(ws + WS_Z), (float*)(ws + WS_BA), (bf16_t*)(ws + WS_CQN), (bf16_t*)(ws + WS_CKVN), (float*)(ws + WS_KPE), (float*)(ws + WS_SSQ), (float*)(ws + WS_SSK)};
        pg8::gemm_phase<EpiProj, pg8::StaticOrder, true, true>(lds3, g, S, E);
    }
    if constexpr (PH == 2) {
        gdn_prep_phase<0>(F, args);
        __syncthreads();
        const int G = F.G, c1 = ((int)blockIdx.x + G - 8 % G) % G, c2 = ((int)blockIdx.x + G - 208 % G) % G;
        { pg8::Gemm g{(const bf16_t*)(ws + WS_CQN), (const bf16_t*)(ws + WS_WUQ), MP, 768, 256, 256, 256, 0};
          pg8::StaticOrder S; S.init(MP, 768, G, c1); EpiB16 E{(bf16_t*)(ws + WS_QH), 768, (const float*)(ws + WS_SSQ), 1.f / 256.f, 4};
          pg8::gemm_phase<EpiB16, pg8::StaticOrder, true, true>(lds3, g, S, E); }
        { pg8::Gemm g{(const bf16_t*)(ws + WS_CKVN), (const bf16_t*)(ws + WS_WUKV), MP, 1024, 256, 256, 256, 0};
          pg8::StaticOrder S; S.init(MP, 1024, G, c2); EpiB16 E{(bf16_t*)(ws + WS_KVB), 1024, (const float*)(ws + WS_SSK), 1.f / 128.f, 4};
          pg8::gemm_phase<EpiB16, pg8::StaticOrder, true, true>(lds3, g, S, E); }
    }
    if constexpr (PH == 3) { for (int t = F.gw; t < (KVROWS / 64) * 8; t += F.NGW) mla_prep2_task(F, args, t); }
    if constexpr (PH == 4) {
        gdn_scan(F, args);
        volatile LAS unsigned* MISC = (volatile LAS unsigned*)(lds3 + MISC_OFF);
        unsigned* ctl = (unsigned*)(ws + WS_CTL);
        unsigned* qhead = ctl + CW_ATTQ;
        bool scan_seen = false;
        for (;;) {
            __syncthreads();
            if (F.tid == 0) MISC[24] = xb_add(qhead, 1u);
            __syncthreads();
            const int k = (int)MISC[24];
            if (k >= 512 + 512) break;
            if (k < 512) { attn_item(F, args, k & 7, 63 - (k >> 3)); continue; }
            if (!scan_seen) {
                if (F.tid == 0) XB_SPIN(xb_ld(ctl + CW_SCANDONE) < 32u, ctl);
                __syncthreads();
                __builtin_amdgcn_fence(__ATOMIC_ACQUIRE, "agent");
                scan_seen = true;
            }
            gdn_out_task(F, args, (k - 512) * 8 + F.wave);
        }
        p0_late_weights<1>(F, args, F.gw, F.NGW, blockIdx.x * 512 + F.tid, F.G * 512);
    }
    if constexpr (PH == 5) {
        pg8::Gemm g{(const bf16_t*)(ws + WS_MIX), (const bf16_t*)(ws + WS_WOUT), MU, 1024, 1024, 1024, 1024, 0};
        pg8::StaticOrder S; S.init(MU, 1024, F.G, (int)blockIdx.x); EpiH1 E{args.out, args.in[0], (bf16_t*)(ws + WS_XN), (float*)(ws + WS_SS4)};
        pg8::gemm_phase<EpiH1, pg8::StaticOrder, true, true>(lds3, g, S, E);
    }
    if constexpr (PH == 6) {
        pg8::Gemm g{(const bf16_t*)(ws + WS_XN), (const bf16_t*)(ws + WS_WPQ), MU, 2048, 1024, 1024, 1024, 0};
        pg8::StaticOrder S; S.init(MU, 2048, F.G, (int)blockIdx.x); EpiB16 E{(bf16_t*)(ws + WS_PQ), 2048, (const float*)(ws + WS_SS4), 1.f / 1024.f, 16};
        pg8::gemm_phase<EpiB16, pg8::StaticOrder, true, true>(lds3, g, S, E);
        __threadfence_block(); __syncthreads();
    }
    if constexpr (PH == 6) {
        pg8::Gemm g{(const bf16_t*)(ws + WS_PQ), (const bf16_t*)(ws + WS_SKB), MU, 2048, 256, 2048, 256, 256};
        pg8::StaticOrder S; S.init(MU, 2048, F.G, (int)blockIdx.x); EpiB16 E{(bf16_t*)(ws + WS_SC), 2048, nullptr, 0.f, 0};
        pg8::gemm_phase<EpiB16, pg8::StaticOrder, true, true>(lds3, g, S, E);
    }
    if constexpr (PH == 7) {
        convert_tables(F, args);
        for (int t = blockIdx.x * 512 + F.tid; t < MU * 8; t += F.G * 512) topk_task(F, args, t);
    }
    if constexpr (PH == 9) { expert_c_pass(F, args); }
    if constexpr (PH == 8 || PH == 10) {
        volatile LAS unsigned* MISC = (volatile LAS unsigned*)(lds3 + MISC_OFF);
        const unsigned x = MISC[16], rank = MISC[17];
        unsigned* bar = (unsigned*)(ws + WS_CTL);
        unsigned nloc = 0, nx = 0, myidx = 0;
#pragma unroll
        for (unsigned j = 0; j < 16; ++j) { const unsigned c = xb_ld(&bar[XB_XCNT(j)]); nx += (c > 0u) ? 1u : 0u; myidx += (c > 0u && j < x) ? 1u : 0u; nloc = (j == x) ? c : nloc; }
        const int wq = __builtin_amdgcn_readfirstlane((int)rank * 8 + F.wave), nw = __builtin_amdgcn_readfirstlane((int)nloc * 8);
        const int xstep = __builtin_amdgcn_readfirstlane((int)nx);
        for (int xv = __builtin_amdgcn_readfirstlane((int)myidx); xv < 8; xv += xstep)
            { if constexpr (PH == 8) expert_phase<true>(F, args, xv, wq, nw); else expert_phase<false>(F, args, xv, wq, nw); }
    }
}
constexpr int NPHASE = 11;
__global__ void __launch_bounds__(512, 2) fwd_kernel(Args args) {
    extern __shared__ __attribute__((aligned(16))) unsigned char lds[];
    Frame F;
    F.lds = lds; F.tid = threadIdx.x; F.lane = F.tid & 63; F.wave = __builtin_amdgcn_readfirstlane(F.tid >> 6);
    F.G = gridDim.x; F.gw = blockIdx.x * 8 + F.wave; F.NGW = F.G * 8;
    volatile LAS unsigned* MISC = (volatile LAS unsigned*)((LAS unsigned char*)lds + MISC_OFF);
    if (F.tid < 32) MISC[F.tid] = 0u;
    __syncthreads();
    unsigned char* ws = args.ws;
    const int lo = args.ph_lo, hi = args.ph_hi;
    XcdBarrier bar; bar.bar = (unsigned*)(ws + WS_CTL); bar.x = 0; bar.st = nullptr;
    if (hi - lo > 1) bar = xcd_barrier_post((unsigned*)(ws + WS_CTL), MISC + 8);
    if (F.tid == 0) { const unsigned x = xb_xcc_id(); MISC[16] = x; MISC[17] = xb_add((unsigned*)(ws + WS_CTL) + 3520 + 64 * x, 1u); }
    __syncthreads();
#define IN(k) (lo <= (k) && (k) < hi)
#define SEAM(k) do { if (IN(k) && IN((k) + 1)) xcd_barrier(bar); } while (0)
    PG8_LAS unsigned char* lds3 = (PG8_LAS unsigned char*)lds;

#ifndef PROBE_REPEAT
#define PROBE_REPEAT -1
#endif
#ifndef PROBE_TIME
#define PROBE_TIME -1
#endif
#ifndef PROBE_TSEL
#define PROBE_TSEL 0
#endif
    unsigned long long pt_ticks = 0ull;
#define PHASE(k) do { unsigned long long pt0_ = 0ull; if (PROBE_TIME == (k)) pt0_ = __builtin_amdgcn_s_memrealtime(); \
        if (IN(k)) { run_phase<k>(F, args, lds3); if (PROBE_REPEAT == (k)) { xcd_barrier(bar); run_phase<(k)>(F, args, lds3); } } \
        if (PROBE_TIME == (k) && PROBE_TSEL == 1) pt_ticks = __builtin_amdgcn_s_memrealtime() - pt0_;     \
        if (PROBE_TIME == (k) && PROBE_TSEL == 2) pt0_ = __builtin_amdgcn_s_memrealtime();                \
        SEAM(k); \
        if (PROBE_TIME == (k) && PROBE_TSEL != 1) pt_ticks = __builtin_amdgcn_s_memrealtime() - pt0_; } while (0)
    PHASE(0); PHASE(1); PHASE(2); PHASE(3); PHASE(4); PHASE(5); PHASE(6); PHASE(7); PHASE(8); PHASE(9); PHASE(10);
#undef PHASE
    if (PROBE_STAGE >= 0) { __syncthreads(); pt_ticks = *(volatile unsigned long long*)(lds + 143360 + 96); }
    if (PROBE_TIME >= 0 || PROBE_STAGE >= 0) { const unsigned long long t0_ = __builtin_amdgcn_s_memrealtime(); while (__builtin_amdgcn_s_memrealtime() - t0_ < 4ull * pt_ticks) __builtin_amdgcn_s_sleep(32); }
#undef IN
#undef SEAM
}

#ifndef N_LAUNCHES
#define N_LAUNCHES 1
#endif
extern "C" void kernel_launch(void* const* d_in, const int* in_sizes, int n_in, void* d_out, int out_size, void* d_ws, size_t ws_size, hipStream_t stream) {
    static int grid = 0;
    if (grid == 0) {
        if (n_in != 20 || out_size != MU * DM || ws_size < WS_END) { fprintf(stderr, "kernel_launch: unexpected shapes (n_in %d out %d ws %zu)\n", n_in, out_size, ws_size); grid = -1; return; }
        int dev = 0, cus = 0, per_cu = 0;
        if (hipGetDevice(&dev) != hipSuccess || hipDeviceGetAttribute(&cus, hipDeviceAttributeMultiprocessorCount, dev) != hipSuccess) { grid = -1; return; }
        if (hipFuncSetAttribute((const void*)fwd_kernel, hipFuncAttributeMaxDynamicSharedMemorySize, LDS_BYTES) != hipSuccess) { fprintf(stderr, "kernel_launch: hipFuncSetAttribute failed\n"); grid = -1; return; }
        if (hipOccupancyMaxActiveBlocksPerMultiprocessor(&per_cu, (const void*)fwd_kernel, 512, LDS_BYTES) != hipSuccess || per_cu < 1) { fprintf(stderr, "kernel_launch: occupancy query says %d\n", per_cu); (void)hipGetLastError(); per_cu = 1; }
        grid = cus;
    }
    if (grid < 0) return;
    (void)hipMemsetAsync((char*)d_ws + WS_CTL, 0, CTL_ZERO_BYTES, stream);
    Args a{};
    for (int i = 0; i < 20; ++i) a.in[i] = (const float*)d_in[i];
    a.out = (float*)d_out; a.ws = (unsigned char*)d_ws;
    for (int li = 0; li < N_LAUNCHES; ++li) {
        a.ph_lo = li * NPHASE / N_LAUNCHES; a.ph_hi = (li + 1) * NPHASE / N_LAUNCHES;
        if (N_LAUNCHES == 1) {
            void* kargs[] = {&a};
            hipError_t e = hipLaunchCooperativeKernel((const void*)fwd_kernel, dim3(grid), dim3(512), kargs, LDS_BYTES, stream);
            if (e != hipSuccess) fprintf(stderr, "cooperative launch failed: %s (grid %d)\n", hipGetErrorString(e), grid);
        } else {
            hipLaunchKernelGGL(fwd_kernel, dim3(grid), dim3(512), LDS_BYTES, stream, a);
        }
    }
}
```

```cpp
#include <hip/hip_runtime.h>
#include <hip/hip_bf16.h>
#include <cstdio>
#include <cstdint>
#include <type_traits>

#define DI __device__ __forceinline__
#define LAS __attribute__((address_space(3)))
#define GAS __attribute__((address_space(1)))

typedef unsigned short bf16_t;
typedef short bf16x8 __attribute__((ext_vector_type(8)));
typedef short s16x4 __attribute__((ext_vector_type(4)));
typedef float f32x4 __attribute__((ext_vector_type(4)));
typedef float f32x16 __attribute__((ext_vector_type(16)));
typedef unsigned u32x4 __attribute__((ext_vector_type(4)));
typedef unsigned u32x2 __attribute__((ext_vector_type(2)));

namespace pg8 {
#define PG8_LAS __attribute__((address_space(3)))
constexpr int BM = 256, BK = 64, HALF = 128, HTB = HALF * BK * 2  , STAGE_BYTES = 8 * HTB, NXCD = 8, WGM = 8;

__host__ __device__ __forceinline__ int lds_byte(int r, int c) { const int st = (r >> 4) * 2 + (c >> 5), rr = r & 15, cc = c & 31, ob = rr * 64 + cc * 2; return st * 1024 + (ob ^ (((ob >> 9) & 1) << 5)); }
__host__ __device__ __forceinline__ void stage_rc(int b, int& R, int& C) { const int st = b / 1024, sb = b % 1024, swz = sb ^ (((sb >> 9) & 1) << 5); R = (st >> 1) * 16 + swz / 64; C = (st & 1) * 32 + (swz % 64) / 2; }
__host__ __device__ __forceinline__ int perm32(int rho) { const int n = rho >> 4, i = rho & 15; return 8 * (i >> 2) + 4 * n + (i & 3); }

struct Unit { int pm, pn; };
struct Gemm { const bf16_t* A; const bf16_t* Bt; int M, N, K, lda, ldb, a_pn_off; };

struct StaticOrder {
    int nM, nN, nwg, G, c;
    __host__ __device__ void init(int M, int N, int G_, int c_) { nM = M / BM; nN = N / BM; nwg = nM * nN; G = G_; c = c_; }
    __host__ __device__ bool next(int i, Unit& u) const {
        const long L = (long)i * G + c; if (L >= nwg) return false;
        int wgid = (int)L; { const int q = nwg / NXCD, r = nwg % NXCD, xcd = wgid % NXCD, off = wgid / NXCD; wgid = (xcd < r ? xcd * (q + 1) : r * (q + 1) + (xcd - r) * q) + off; }
        const int nig = WGM * nN, gid = wgid / nig, fm = gid * WGM, gsz = (nM - fm) < WGM ? (nM - fm) : WGM;
        u.pm = fm + ((wgid % nig) % gsz); u.pn = (wgid % nig) / gsz; return true;
    }
    __device__ __forceinline__ void a_ready(const Unit&) const {}
    __device__ __forceinline__ void done(const Unit&) const {}
};

__device__ __forceinline__ unsigned cvt_pk_bf16(float lo, float hi) { unsigned r; asm volatile("v_cvt_pk_bf16_f32 %0, %1, %2" : "=v"(r) : "v"(lo), "v"(hi)); return r; }

template <class Epi, class Sched, bool ALIGN_EPI = false, bool SP2 = false>
__device__ __forceinline__ void gemm_phase(PG8_LAS unsigned char* lds, const Gemm g, const Sched& S, const Epi& E) {
    const int tid = threadIdx.x, wid = __builtin_amdgcn_readfirstlane(tid >> 6), lane = tid & 63, wr = wid >> 2, wc = wid & 3, fr = lane & 15, fq = lane >> 4;
    const int K = g.K, nt = K / BK;
    unsigned voffA[2], voffB[2];
#pragma unroll
    for (int i = 0; i < 2; ++i) { int R, C; stage_rc(tid * 16 + i * 8192, R, C); const int Rb = Epi::PERM ? ((R & ~31) + perm32(R & 31)) : R;
        voffA[i] = (unsigned)(R * g.lda + C) * 2u; voffB[i] = (unsigned)(Rb * g.ldb + C) * 2u; }
    const size_t kstep = (size_t)(BK * 2);
    const size_t hstepA = (size_t)HALF * g.lda * 2, hstepB = (size_t)HALF * g.ldb * 2;
    const size_t tstepA = 2 * hstepA, tstepB = 2 * hstepB;
    const size_t pnoffA = (size_t)g.a_pn_off * 2;
    const unsigned ldsw = (unsigned)wid * 1024u;
    const int aoff = lds_byte(wr * 64 + fr, fq * 8), boff = lds_byte(wc * 32 + fr, fq * 8);
#define PG8_SA(b, h) (((b) * 2 + (h)) * HTB)
#define PG8_SB(b, h) ((4 + (b) * 2 + (h)) * HTB)
#define PG8_STAGE(bufoff, gbase, voff) do { _Pragma("unroll") for (int _i = 0; _i < 2; ++_i) \
        __builtin_amdgcn_global_load_lds((const unsigned*)((const char*)(gbase) + (voff)[_i]), (PG8_LAS unsigned*)(lds + (bufoff) + ldsw + _i * 8192), 16, 0, 0); } while (0)
#define PG8_LDA(dst, b, h) do { _Pragma("unroll") for (int m = 0; m < 4; ++m) _Pragma("unroll") for (int k = 0; k < 2; ++k) dst[m][k] = *(const PG8_LAS bf16x8*)(lds + PG8_SA(b, h) + aoff + m * 2048 + k * 1024); } while (0)
#define PG8_LDB(dst, b, h) do { _Pragma("unroll") for (int n = 0; n < 2; ++n) _Pragma("unroll") for (int k = 0; k < 2; ++k) dst[n][k] = *(const PG8_LAS bf16x8*)(lds + PG8_SB(b, h) + boff + n * 2048 + k * 1024); } while (0)
#define PG8_MMA(ai, bj, At, Bt) do { __builtin_amdgcn_s_setprio(1); _Pragma("unroll") for (int m = 0; m < 4; ++m) _Pragma("unroll") for (int n = 0; n < 2; ++n) _Pragma("unroll") for (int k = 0; k < 2; ++k) \
        acc[ai][bj][m][n] = __builtin_amdgcn_mfma_f32_16x16x32_bf16(Bt[n][k], At[m][k], acc[ai][bj][m][n], 0, 0, 0); __builtin_amdgcn_s_setprio(0); } while (0)
#define PG8_WAIT_V(n) asm volatile("s_waitcnt vmcnt(" #n ")" ::: "memory")
#define PG8_WAIT_L(n) asm volatile("s_waitcnt lgkmcnt(" #n ")" ::: "memory")
#define PG8_BAR __builtin_amdgcn_s_barrier()
#define PG8_SCHED __builtin_amdgcn_sched_barrier(0)
    Unit cur, nxt; int ui = 0;
    if (!S.next(0, cur)) return;
    f32x4 acc[2][2][4][2];
#pragma unroll
    for (int a = 0; a < 2; ++a)
#pragma unroll
        for (int b = 0; b < 2; ++b)
#pragma unroll
            for (int m = 0; m < 4; ++m)
#pragma unroll
                for (int n = 0; n < 2; ++n) acc[a][b][m][n] = (f32x4){0.f, 0.f, 0.f, 0.f};
    bf16x8 At[4][2], B0[2][2], B1[2][2];
    const char* cA = (const char*)g.A + (size_t)cur.pm * tstepA + (size_t)cur.pn * pnoffA; const char* cB = (const char*)g.Bt + (size_t)cur.pn * tstepB;
    S.a_ready(cur);
    if constexpr (SP2) {
        PG8_STAGE(PG8_SB(0, 0), cB, voffB); PG8_STAGE(PG8_SB(0, 1), cB + hstepB, voffB); PG8_STAGE(PG8_SA(0, 0), cA, voffA); PG8_STAGE(PG8_SA(0, 1), cA + hstepA, voffA);
        if (wr == 1) PG8_BAR;
        PG8_WAIT_V(2); PG8_BAR;
        PG8_STAGE(PG8_SB(1, 0), cB + kstep, voffB); PG8_STAGE(PG8_SA(1, 0), cA + kstep, voffA); PG8_STAGE(PG8_SB(1, 1), cB + hstepB + kstep, voffB);
        PG8_WAIT_V(6); PG8_BAR;
    } else {
        PG8_STAGE(PG8_SB(0, 0), cB, voffB); PG8_STAGE(PG8_SA(0, 0), cA, voffA); PG8_STAGE(PG8_SB(0, 1), cB + hstepB, voffB); PG8_STAGE(PG8_SA(0, 1), cA + hstepA, voffA);
        if (wr == 1) PG8_BAR;
        PG8_WAIT_V(4); PG8_BAR;
        PG8_STAGE(PG8_SB(1, 0), cB + kstep, voffB); PG8_STAGE(PG8_SA(1, 0), cA + kstep, voffA); PG8_STAGE(PG8_SB(1, 1), cB + hstepB + kstep, voffB);
        PG8_WAIT_V(6); PG8_BAR;
    }
    for (;;) {
        const bool has_next = S.next(ui + 1, nxt);
        const char* nA = has_next ? (const char*)g.A + (size_t)nxt.pm * tstepA + (size_t)nxt.pn * pnoffA : cA; const char* nB = has_next ? (const char*)g.Bt + (size_t)nxt.pn * tstepB : cB;
        for (int t = 0; t < nt; t += 2) {
            const bool last = (t == nt - 2);
            const char* a1 = cA + (size_t)(t + 1) * kstep;
            const char* a2 = last ? nA : cA + (size_t)(t + 2) * kstep; const char* b2 = last ? nB : cB + (size_t)(t + 2) * kstep;
            const char* a3 = a2 + kstep; const char* b3 = b2 + kstep;
            if (last && has_next) S.a_ready(nxt);
            if constexpr (SP2) {
            PG8_LDB(B0, 0, 0); PG8_LDB(B1, 0, 1); PG8_SCHED; PG8_LDA(At, 0, 0); PG8_STAGE(PG8_SA(1, 1), a1 + hstepA, voffA);
            PG8_WAIT_V(8); PG8_WAIT_L(0); PG8_BAR; PG8_MMA(0, 0, At, B0); PG8_MMA(0, 1, At, B1); PG8_BAR; PG8_SCHED;
            PG8_LDA(At, 0, 1); PG8_STAGE(PG8_SB(0, 0), b2, voffB); PG8_STAGE(PG8_SB(0, 1), b2 + hstepB, voffB); PG8_STAGE(PG8_SA(0, 0), a2, voffA);
            PG8_WAIT_V(8); PG8_WAIT_L(0); PG8_BAR; PG8_MMA(1, 0, At, B0); PG8_MMA(1, 1, At, B1); PG8_BAR; PG8_SCHED;
            PG8_LDB(B0, 1, 0); PG8_LDB(B1, 1, 1); PG8_SCHED; PG8_LDA(At, 1, 0); PG8_STAGE(PG8_SA(0, 1), a2 + hstepA, voffA);
            PG8_WAIT_V(8); PG8_WAIT_L(0); PG8_BAR; PG8_MMA(0, 0, At, B0); PG8_MMA(0, 1, At, B1); PG8_BAR; PG8_SCHED;
            PG8_LDA(At, 1, 1); PG8_STAGE(PG8_SB(1, 0), b3, voffB); PG8_STAGE(PG8_SB(1, 1), b3 + hstepB, voffB); PG8_STAGE(PG8_SA(1, 0), a3, voffA);
            PG8_WAIT_V(8); PG8_WAIT_L(0); PG8_BAR; PG8_MMA(1, 0, At, B0); PG8_MMA(1, 1, At, B1); PG8_BAR; PG8_SCHED;
            } else {
            PG8_LDB(B0, 0, 0); PG8_SCHED; PG8_LDA(At, 0, 0); PG8_STAGE(PG8_SA(1, 1), a1 + hstepA, voffA);
            PG8_WAIT_L(8); PG8_BAR; PG8_WAIT_L(0); PG8_MMA(0, 0, At, B0); PG8_BAR; PG8_SCHED;
            PG8_LDB(B1, 0, 1); PG8_STAGE(PG8_SB(0, 0), b2, voffB);
            PG8_BAR; PG8_WAIT_L(0); PG8_MMA(0, 1, At, B1); PG8_BAR;
            PG8_LDA(At, 0, 1); PG8_STAGE(PG8_SA(0, 0), a2, voffA);
            PG8_BAR; PG8_WAIT_L(0); PG8_MMA(1, 0, At, B0); PG8_BAR; PG8_SCHED;
            PG8_STAGE(PG8_SB(0, 1), b2 + hstepB, voffB);
            PG8_WAIT_V(6); PG8_BAR; PG8_MMA(1, 1, At, B1); PG8_BAR;
            PG8_LDB(B0, 1, 0); PG8_SCHED; PG8_LDA(At, 1, 0); PG8_STAGE(PG8_SA(0, 1), a2 + hstepA, voffA);
            PG8_WAIT_L(8); PG8_BAR; PG8_WAIT_L(0); PG8_MMA(0, 0, At, B0); PG8_BAR; PG8_SCHED;
            PG8_LDB(B1, 1, 1); PG8_STAGE(PG8_SB(1, 0), b3, voffB);
            PG8_BAR; PG8_WAIT_L(0); PG8_MMA(0, 1, At, B1); PG8_BAR;
            PG8_LDA(At, 1, 1); PG8_STAGE(PG8_SA(1, 0), a3, voffA);
            PG8_BAR; PG8_WAIT_L(0); PG8_MMA(1, 0, At, B0); PG8_BAR; PG8_SCHED;
            PG8_STAGE(PG8_SB(1, 1), b3 + hstepB, voffB);
            PG8_WAIT_V(6); PG8_BAR; PG8_MMA(1, 1, At, B1); PG8_BAR;
            }
        }
        if constexpr (ALIGN_EPI) { if (wr == 0) PG8_BAR; }
        E(acc, cur, wr, wc, fr, fq); S.done(cur);
        if (!has_next) break;
#pragma unroll
        for (int a = 0; a < 2; ++a)
#pragma unroll
            for (int b = 0; b < 2; ++b)
#pragma unroll
                for (int m = 0; m < 4; ++m)
#pragma unroll
                    for (int n = 0; n < 2; ++n) acc[a][b][m][n] = (f32x4){0.f, 0.f, 0.f, 0.f};
        cur = nxt; cA = nA; cB = nB; ++ui;
        if constexpr (ALIGN_EPI) { if (wr == 1) PG8_BAR; }
    }
    PG8_WAIT_V(0);
    if constexpr (!ALIGN_EPI) { if (wr == 0) PG8_BAR; }
    PG8_BAR;
#undef PG8_SA
#undef PG8_SB
#undef PG8_STAGE
#undef PG8_LDA
#undef PG8_LDB
#undef PG8_MMA
#undef PG8_WAIT_V
#undef PG8_WAIT_L
#undef PG8_BAR
#undef PG8_SCHED
}
}

constexpr int DM = 1024;
constexpr int NTOK = 16400;
constexpr int PADL = 48;
constexpr int LPV = 16448;
constexpr int MP = 16640;
constexpr int MU = 16384;
constexpr int NCHUNK = 257;
constexpr int NHEAD = 8;
constexpr int NPROJ = 2560;
constexpr int KVROWS = 16512;
constexpr float EPS = 1e-6f;

constexpr size_t MiB = 1u << 20;
constexpr size_t WS_CTL = 0, CTL_ZERO_BYTES = 64 * 1024;
constexpr size_t WS_SSQ = 128 * 1024;
constexpr size_t WS_SSK = 512 * 1024;
constexpr size_t WS_SS4 = 14 * MiB;
constexpr size_t WS_WIN = 1 * MiB;
constexpr size_t WS_WUQ = 6 * MiB;
constexpr size_t WS_WUKV = 6 * MiB + 512 * 1024;
constexpr size_t WS_WOUT = 7 * MiB;
constexpr size_t WS_WPQ = 9 * MiB;
constexpr size_t WS_SKB = 13 * MiB;
constexpr size_t WS_IDX = 16 * MiB;
constexpr size_t WS_GATE = 24 * MiB;
constexpr size_t WS_HN = 16 * MiB;
constexpr size_t WS_QKVR = 101 * MiB;
constexpr size_t WS_Z = 150 * MiB;
constexpr size_t WS_BA = 245 * MiB;
constexpr size_t WS_GA = 16 * MiB;
constexpr size_t WS_GQ = 33 * MiB;
constexpr size_t WS_GS = 67 * MiB;
constexpr size_t WS_GB = 84 * MiB;
constexpr size_t WS_GO = 50 * MiB;
constexpr size_t WS_MIX = 167 * MiB;
constexpr size_t WS_CQN = 200 * MiB;
constexpr size_t WS_CKVN = 208 * MiB + 512 * 1024;
constexpr size_t WS_QH = 220 * MiB;
constexpr size_t WS_KVB = 167 * MiB;
constexpr size_t WS_Q = 125 * MiB + 512 * 1024;
constexpr size_t WS_K = 101 * MiB;
constexpr size_t WS_VT = 200 * MiB;
constexpr size_t WS_XN = 32 * MiB;
constexpr size_t WS_PQ = 64 * MiB;
constexpr size_t WS_SC = 128 * MiB;
constexpr size_t WS_EU = 96 * MiB;
constexpr size_t WS_EV = 112 * MiB;
constexpr size_t WS_CW = 64 * MiB;
constexpr size_t WS_HP = 128 * MiB;
constexpr size_t WS_KPE = 217 * MiB;
constexpr size_t WS_END = 256 * MiB;
constexpr int CW_ATTQ = 8192;
constexpr int CW_SCANDONE = 8256;

constexpr int LDS_BYTES = 147456;
constexpr int MISC_OFF = 131072 + 12288;

DI unsigned f2bf(float f) { unsigned u = __builtin_bit_cast(unsigned, f); return (u + 0x7fffu + ((u >> 16) & 1u)) >> 16; }
DI unsigned pk2(float lo, float hi) { return f2bf(lo) | (f2bf(hi) << 16); }
DI float bf2f(unsigned b) { return __builtin_bit_cast(float, b << 16); }
DI float bflo(unsigned w) { return __builtin_bit_cast(float, w << 16); }
DI float bfhi(unsigned w) { return __builtin_bit_cast(float, w & 0xffff0000u); }
DI float wave_sum(float v) {
#pragma unroll
    for (int o = 1; o < 64; o <<= 1) v += __shfl_xor(v, o);
    return v;
}
DI float sigmoidf_(float x) { return 1.f / (1.f + __expf(-x)); }
DI float siluf_(float x) { return x / (1.f + __expf(-x)); }

#define XB_TMO      128
#define XB_XCNT(j)  (256  + 64 * (j))
#define XB_XSUB(j)  (1280 + 64 * (j))
#define XB_XGEN(j)  (2304 + 64 * (j))
#define XB_TOP      3328
#define XB_TOPGEN   3392
#define XCD_BAR_WORDS 3456
#define XB_SPIN_CAP (1u << 22)
DI unsigned xb_ld(unsigned* p)              { return __hip_atomic_load(p, __ATOMIC_RELAXED, __HIP_MEMORY_SCOPE_AGENT); }
DI unsigned xb_add(unsigned* p, unsigned v) { return __hip_atomic_fetch_add(p, v, __ATOMIC_RELAXED, __HIP_MEMORY_SCOPE_AGENT); }
DI unsigned xb_xcc_id() { return (unsigned)__builtin_amdgcn_s_getreg((3 << 11) | 20) & 0xFu; }
#define XB_SPIN(cond, bar) do { unsigned _sp = 0; while (cond) { __builtin_amdgcn_s_sleep(1); \
    if ((++_sp & 255u) == 0u) { if (xb_ld(&(bar)[XB_TMO])) break; if (_sp > XB_SPIN_CAP) { atomicAdd(&(bar)[XB_TMO], 1u); break; } } } } while (0)
struct XcdBarrier { unsigned* bar; unsigned x; volatile LAS unsigned* st; };
DI XcdBarrier xcd_barrier_post(unsigned* bar, volatile LAS unsigned* st) {
    XcdBarrier b; b.bar = bar; b.x = xb_xcc_id(); b.st = st;
    if (threadIdx.x == 0) (void)xb_add(&bar[XB_XCNT(b.x)], 1u);
    return b;
}
DI void xcd_barrier_complete(unsigned* bar, unsigned x, unsigned& nloc, unsigned& nx) {
    const unsigned G = gridDim.x * gridDim.y * gridDim.z;
    unsigned sum, cnt, mine, sp = 0u;
    for (;;) {
        sum = 0u; cnt = 0u; mine = 0u;
#pragma unroll
        for (unsigned j = 0; j < 16; ++j) { const unsigned c = xb_ld(&bar[XB_XCNT(j)]); sum += c; cnt += (c > 0u) ? 1u : 0u; mine = (j == x) ? c : mine; }
        if (sum == G) break;
        __builtin_amdgcn_s_sleep(1);
        if ((++sp & 255u) == 0u) { if (xb_ld(&bar[XB_TMO])) break; if (sp > XB_SPIN_CAP) { atomicAdd(&bar[XB_TMO], 1u); break; } }
    }
    nloc = mine > 0u ? mine : 1u; nx = cnt > 0u ? cnt : 1u;
}
DI void xcd_barrier(const XcdBarrier& b) {
    asm volatile("s_waitcnt vmcnt(0)" ::: "memory");
    __syncthreads();
    if (threadIdx.x == 0) {
        unsigned* bar = b.bar;
        __builtin_amdgcn_s_waitcnt(0);
        unsigned nloc = b.st[0], nx = b.st[1];
        if (nloc == 0u) { xcd_barrier_complete(bar, b.x, nloc, nx); b.st[0] = nloc; b.st[1] = nx; }
        const unsigned old = xb_add(&bar[XB_XSUB(b.x)], 1u);
        const unsigned gen = old / nloc;
        if (old + 1u == (gen + 1u) * nloc) {
            __builtin_amdgcn_fence(__ATOMIC_RELEASE, "agent");
            asm volatile("s_waitcnt vmcnt(0)" ::: "memory");
            const unsigned og = xb_add(&bar[XB_TOP], 1u);
            const unsigned tg = og / nx;
            if (og + 1u == (tg + 1u) * nx) xb_add(&bar[XB_TOPGEN], 1u);
            else XB_SPIN(xb_ld(&bar[XB_TOPGEN]) == tg, bar);
            __builtin_amdgcn_fence(__ATOMIC_ACQUIRE, "agent");
            xb_add(&bar[XB_XGEN(b.x)], 1u);
            asm volatile("s_waitcnt vmcnt(0)" ::: "memory");
        } else {
            XB_SPIN(xb_ld(&bar[XB_XGEN(b.x)]) == gen, bar);
            __builtin_amdgcn_fence(__ATOMIC_ACQUIRE, "agent");
            asm volatile("s_waitcnt vmcnt(0)" ::: "memory");
        }
    }
    __syncthreads();
}

struct Args {
    const float* in[20];
    float* out; unsigned char* ws;
    int ph_lo, ph_hi;
};
struct Frame {
    unsigned char* lds;
    int tid, lane, wave, G, gw, NGW;
};

template <class Map>
DI void transpose_item(const float* __restrict__ W, int Nsrc, bf16_t* __restrict__ WT, int ldk, float* scr, int item, int nblk, int lane, Map srcmap, const float* __restrict__ rowscale = nullptr) {
    const int kb = item / nblk, nb = item % nblk, k0 = 64 * kb, n0 = 32 * nb;
    const int ns = srcmap(n0 + (lane & 31));
    float vv[32];
#pragma unroll
    for (int i = 0; i < 32; ++i) { const int kk = 2 * i + (lane >> 5); vv[i] = (ns >= 0) ? W[(size_t)(k0 + kk) * Nsrc + ns] : 0.f; }
    if (rowscale) {
#pragma unroll
        for (int i = 0; i < 32; ++i) vv[i] *= rowscale[k0 + 2 * i + (lane >> 5)];
    }
#pragma unroll
    for (int i = 0; i < 32; ++i) { const int kk = 2 * i + (lane >> 5); scr[kk * 33 + (lane & 31)] = vv[i]; }
    __builtin_amdgcn_s_waitcnt(0); __builtin_amdgcn_wave_barrier();
    const int c = lane & 7;
#pragma unroll
    for (int j = 0; j < 4; ++j) { const int n = (lane >> 3) + 8 * j; const float* s = scr + (8 * c) * 33 + n;
        u32x4 o; o.x = pk2(s[0 * 33], s[1 * 33]); o.y = pk2(s[2 * 33], s[3 * 33]); o.z = pk2(s[4 * 33], s[5 * 33]); o.w = pk2(s[6 * 33], s[7 * 33]);
        *(u32x4*)(WT + (size_t)(n0 + n) * ldk + k0 + 8 * c) = o; }
    __builtin_amdgcn_s_waitcnt(0); __builtin_amdgcn_wave_barrier();
}
struct MapId { DI int operator()(int n) const { return n; } };
struct MapWin {
    DI int operator()(int n) const {
        if (n < 2048) return n;
        if (n < 2304) return n + 16;
        if (n < 2432) return n + 16;
        if (n < 2464) return n + 16;
        if (n < 2472) return n - 416;
        if (n < 2480) return n - 416;
        return -1;
    }
};

template <int PART> DI void p0_late_weights(const Frame& F, const Args& A, int wi, int nwv, int ti, int nth) {
    unsigned char* ws = A.ws;
    float* scr = (float*)(F.lds + F.wave * 16384);
    const float* w_uq = A.in[10]; const float* w_ukv = A.in[11]; const float* w_out = A.in[14]; const float* w_pq = A.in[16]; const float* sub_keys = A.in[17];
    constexpr int I_UQ = 4 * 24, I_UKV = 2 * 32, I_OUT = 16 * 32, I_PQ = 16 * 64;
    constexpr int NITEMS = I_UQ + I_UKV + I_OUT + I_PQ;
    const int lo_ = PART == 0 ? 0 : I_UQ + I_UKV, hi_ = PART == 0 ? I_UQ + I_UKV : NITEMS;
    for (int it = lo_ + wi; it < hi_; it += nwv) {
        int r = it;
        if (r < I_UQ) { transpose_item(w_uq, 768, (bf16_t*)(ws + WS_WUQ), 256, scr, r, 24, F.lane, MapId(), A.in[8]); continue; } r -= I_UQ;
        if (r < I_UKV) { transpose_item(w_ukv, 1024, (bf16_t*)(ws + WS_WUKV), 256, scr, r, 32, F.lane, MapId(), A.in[9]); continue; } r -= I_UKV;
        if (r < I_OUT) { transpose_item(w_out, 1024, (bf16_t*)(ws + WS_WOUT), 1024, scr, r, 32, F.lane, MapId()); continue; } r -= I_OUT;
        transpose_item(w_pq, 2048, (bf16_t*)(ws + WS_WPQ), 1024, scr, r, 64, F.lane, MapId(), A.in[15]);
    }
    const int gt = ti, NGT = nth;
    if (PART == 0) for (int i = gt; i < 1024 * 16; i += NGT) { const int n = i >> 4, c = i & 15; *(u32x4*)((bf16_t*)(ws + WS_WUKV) + (size_t)n * 256 + 128 + c * 8) = (u32x4){0u, 0u, 0u, 0u}; }
    if (PART == 1) for (int i = gt; i < 2048 * 32; i += NGT) {
        const int n = i >> 5, c8 = (i & 31) * 8; const int p = (n >> 7) & 1;
        u32x4 o = (u32x4){0u, 0u, 0u, 0u};
        if ((c8 >> 7) == p) { const float* s = sub_keys + (size_t)n * 128 + (c8 & 127); const f32x4 a = *(const f32x4*)s, b = *(const f32x4*)(s + 4);
            o.x = pk2(a.x, a.y); o.y = pk2(a.z, a.w); o.z = pk2(b.x, b.y); o.w = pk2(b.z, b.w); }
        *(u32x4*)((bf16_t*)(ws + WS_SKB) + (size_t)n * 256 + c8) = o;
    }
}

DI void p0_prologue(const Frame& F, const Args& A) {
    unsigned char* ws = A.ws;
    float* scr = (float*)(F.lds + F.wave * 16384);
    const float* w_in = A.in[3]; const float* w_uq = A.in[10]; const float* w_ukv = A.in[11]; const float* w_out = A.in[14]; const float* w_pq = A.in[16]; const float* sub_keys = A.in[17];
    constexpr int I_IN = 16 * 80;
    for (int it = F.wave * F.G + blockIdx.x; it < I_IN; it += F.NGW) transpose_item(w_in, 2480, (bf16_t*)(ws + WS_WIN), 1024, scr, it, 80, F.lane, MapWin());
    const float* x = A.in[0]; const float* meta = A.in[1]; const float* anorm = A.in[2];
    bf16_t* HN = (bf16_t*)(ws + WS_HN);
    for (int p0 = F.gw; p0 < MP; p0 += 3 * F.NGW) {
        f32x4 v[3][4]; bool ok[3];
#pragma unroll
        for (int r = 0; r < 3; ++r) {
            const int p = p0 + r * F.NGW, t = p - PADL; ok[r] = (p < MP) && t >= 0 && t < NTOK;
            if (ok[r]) { const float* src = (t < 16) ? meta + (size_t)t * DM : x + (size_t)(t - 16) * DM; const f32x4* xr = (const f32x4*)src + F.lane;
#pragma unroll
                for (int j = 0; j < 4; ++j) v[r][j] = xr[64 * j]; }
            else {
#pragma unroll
                for (int j = 0; j < 4; ++j) v[r][j] = (f32x4){0.f, 0.f, 0.f, 0.f}; }
        }
#pragma unroll
        for (int r = 0; r < 3; ++r) {
            const int p = p0 + r * F.NGW; if (p >= MP) continue;
            unsigned long long* o8 = (unsigned long long*)(HN + (size_t)p * DM) + F.lane;
            float s = 0.f;
#pragma unroll
            for (int j = 0; j < 4; ++j) s += (v[r][j].x * v[r][j].x + v[r][j].y * v[r][j].y) + (v[r][j].z * v[r][j].z + v[r][j].w * v[r][j].w);
            const float rstd = ok[r] ? 1.f / sqrtf(wave_sum(s) * (1.f / DM) + EPS) : 0.f;
#pragma unroll
            for (int j = 0; j < 4; ++j) { const f32x4 w = ((const f32x4*)anorm)[64 * j + F.lane];
                o8[64 * j] = (unsigned long long)pk2(v[r][j].x * rstd * w.x, v[r][j].y * rstd * w.y) | ((unsigned long long)pk2(v[r][j].z * rstd * w.z, v[r][j].w * rstd * w.w) << 32); }
        }
    }
}

DI void row_ss_store(const f32x4 (&v)[2][2][4][2], float* SSP, int nslot, int slot, int row0, int fq, bool bj0_only) {
#pragma unroll
    for (int ai = 0; ai < 2; ++ai)
#pragma unroll
        for (int m = 0; m < 4; ++m) {
            float s = 0.f;
#pragma unroll
            for (int bj = 0; bj < 2; ++bj) if (bj == 0 || !bj0_only)
#pragma unroll
                for (int n = 0; n < 2; ++n) { const f32x4 x = v[ai][bj][m][n]; s += (x[0] * x[0] + x[1] * x[1]) + (x[2] * x[2] + x[3] * x[3]); }
            s += __shfl_xor(s, 16); s += __shfl_xor(s, 32);
            if (fq == 0) SSP[(size_t)(row0 + ai * 128 + m * 16) * nslot + slot] = s;
        }
}
DI float ss_sum4(const float* SSP, int row) { const f32x4 a = *(const f32x4*)(SSP + (size_t)row * 4); return (a.x + a.y) + (a.z + a.w); }
DI float ss_sum16(const float* SSP, int row) { const f32x4 a = *(const f32x4*)(SSP + (size_t)row * 16), b = *(const f32x4*)(SSP + (size_t)row * 16 + 4), c = *(const f32x4*)(SSP + (size_t)row * 16 + 8), d = *(const f32x4*)(SSP + (size_t)row * 16 + 12);
    return (((a.x + a.y) + (a.z + a.w)) + ((b.x + b.y) + (b.z + b.w))) + (((c.x + c.y) + (c.z + c.w)) + ((d.x + d.y) + (d.z + d.w))); }
struct EpiProj {
    static constexpr bool PERM = true;
    bf16_t* QKVR; bf16_t* Z; float* BA; bf16_t* CQ16; bf16_t* CKV16; float* KPE; float* SSQ; float* SSK;
    DI void operator()(const f32x4 (&acc)[2][2][4][2], const pg8::Unit& u, int wr, int wc, int fr, int fq) const {
        const int row0 = u.pm * 256 + wr * 64 + fr;
        if (u.pn < 8) {
            bf16_t* base; int ld, colt;
            if (u.pn < 6) { base = QKVR; ld = 1536; colt = u.pn * 256; } else { base = Z; ld = 512; colt = (u.pn - 6) * 256; }
            const int col0 = colt + wc * 32 + 8 * fq;
#pragma unroll
            for (int ai = 0; ai < 2; ++ai)
#pragma unroll
                for (int m = 0; m < 4; ++m) { bf16_t* rowp = base + (size_t)(row0 + ai * 128 + m * 16) * ld + col0;
#pragma unroll
                    for (int bj = 0; bj < 2; ++bj) { const f32x4 v0 = acc[ai][bj][m][0], v1 = acc[ai][bj][m][1];
                        u32x4 w; w.x = pg8::cvt_pk_bf16(v0[0], v0[1]); w.y = pg8::cvt_pk_bf16(v0[2], v0[3]); w.z = pg8::cvt_pk_bf16(v1[0], v1[1]); w.w = pg8::cvt_pk_bf16(v1[2], v1[3]);
                        *(u32x4*)(rowp + bj * 128) = w; } }
        } else {
            const int lcol0 = wc * 32 + 8 * fq;
            bf16_t* b16 = (u.pn == 8) ? CQ16 : CKV16;
#pragma unroll
            for (int ai = 0; ai < 2; ++ai)
#pragma unroll
                for (int m = 0; m < 4; ++m) { const size_t row = (size_t)(row0 + ai * 128 + m * 16);
#pragma unroll
                    for (int bj = 0; bj < 2; ++bj) { const f32x4 v0 = acc[ai][bj][m][0], v1 = acc[ai][bj][m][1];
                        u32x4 w; w.x = pg8::cvt_pk_bf16(v0[0], v0[1]); w.y = pg8::cvt_pk_bf16(v0[2], v0[3]); w.z = pg8::cvt_pk_bf16(v1[0], v1[1]); w.w = pg8::cvt_pk_bf16(v1[2], v1[3]);
                        *(u32x4*)(b16 + row * 256 + lcol0 + bj * 128) = w;
                        if (u.pn == 9 && bj == 1 && wc == 0) { *(f32x4*)(KPE + row * 32 + 8 * fq) = v0; *(f32x4*)(KPE + row * 32 + 8 * fq + 4) = v1; }
                        if (u.pn == 9 && bj == 1 && wc == 1 && fq < 2) { *(f32x4*)(BA + row * 16 + 8 * fq) = v0; *(f32x4*)(BA + row * 16 + 8 * fq + 4) = v1; }
                    } }
            row_ss_store(acc, (u.pn == 8) ? SSQ : SSK, 4, wc, row0, fq, u.pn == 9);
        }
    }
};
struct EpiB16 {
    static constexpr bool PERM = true;
    bf16_t* O; int ldc; const float* SS; float invn; int nslot;
    DI void operator()(const f32x4 (&acc)[2][2][4][2], const pg8::Unit& u, int wr, int wc, int fr, int fq) const {
        const int row0 = u.pm * 256 + wr * 64 + fr, col0 = u.pn * 256 + wc * 32 + 8 * fq;
#pragma unroll
        for (int ai = 0; ai < 2; ++ai)
#pragma unroll
            for (int m = 0; m < 4; ++m) { const int row = row0 + ai * 128 + m * 16; bf16_t* rowp = O + (size_t)row * ldc + col0;
                const float rs = SS ? 1.f / sqrtf((nslot == 16 ? ss_sum16(SS, row) : ss_sum4(SS, row)) * invn + EPS) : 1.f;
#pragma unroll
                for (int bj = 0; bj < 2; ++bj) { const f32x4 v0 = acc[ai][bj][m][0] * rs, v1 = acc[ai][bj][m][1] * rs;
                    u32x4 w; w.x = pg8::cvt_pk_bf16(v0[0], v0[1]); w.y = pg8::cvt_pk_bf16(v0[2], v0[3]); w.z = pg8::cvt_pk_bf16(v1[0], v1[1]); w.w = pg8::cvt_pk_bf16(v1[2], v1[3]);
                    *(u32x4*)(rowp + bj * 128) = w; } }
    }
};
struct EpiH1 {
    static constexpr bool PERM = true;
    float* C; const float* res; bf16_t* H16; float* SS;
    DI void operator()(const f32x4 (&acc)[2][2][4][2], const pg8::Unit& u, int wr, int wc, int fr, int fq) const {
        const int row0 = u.pm * 256 + wr * 64 + fr, col0 = u.pn * 256 + wc * 32 + 8 * fq;
        f32x4 v[2][2][4][2];
#pragma unroll
        for (int ai = 0; ai < 2; ++ai)
#pragma unroll
            for (int m = 0; m < 4; ++m) { const size_t off = (size_t)(row0 + ai * 128 + m * 16) * 1024 + col0;
#pragma unroll
                for (int bj = 0; bj < 2; ++bj) { const f32x4 v0 = acc[ai][bj][m][0] + *(const f32x4*)(res + off + bj * 128), v1 = acc[ai][bj][m][1] + *(const f32x4*)(res + off + bj * 128 + 4);
                    v[ai][bj][m][0] = v0; v[ai][bj][m][1] = v1;
                    u32x4 w; w.x = pg8::cvt_pk_bf16(v0[0], v0[1]); w.y = pg8::cvt_pk_bf16(v0[2], v0[3]); w.z = pg8::cvt_pk_bf16(v1[0], v1[1]); w.w = pg8::cvt_pk_bf16(v1[2], v1[3]);
                    *(u32x4*)(H16 + off + bj * 128) = w; } }
        row_ss_store(v, SS, 16, u.pn * 4 + wc, row0, fq, false);
    }
};
struct EpiF32 {
    static constexpr bool PERM = true;
    float* C; int ldc; const float* res;
    DI void operator()(const f32x4 (&acc)[2][2][4][2], const pg8::Unit& u, int wr, int wc, int fr, int fq) const {
        const int row0 = u.pm * 256 + wr * 64 + fr, col0 = u.pn * 256 + wc * 32 + 8 * fq;
#pragma unroll
        for (int ai = 0; ai < 2; ++ai)
#pragma unroll
            for (int m = 0; m < 4; ++m) { const size_t off = (size_t)(row0 + ai * 128 + m * 16) * ldc + col0;
#pragma unroll
                for (int bj = 0; bj < 2; ++bj) { f32x4 v0 = acc[ai][bj][m][0], v1 = acc[ai][bj][m][1];
                    if (res) { v0 += *(const f32x4*)(res + off + bj * 128); v1 += *(const f32x4*)(res + off + bj * 128 + 4); }
                    *(f32x4*)(C + off + bj * 128) = v0; *(f32x4*)(C + off + bj * 128 + 4) = v1; } }
    }
};

DI f32x16 mfma32(bf16x8 a, bf16x8 b, f32x16 c) { return __builtin_amdgcn_mfma_f32_32x32x16_bf16(a, b, c, 0, 0, 0); }
DI f32x4 mfma16(bf16x8 a, bf16x8 b, f32x4 c) { return __builtin_amdgcn_mfma_f32_16x16x32_bf16(a, b, c, 0, 0, 0); }
DI int crow(int r, int hi) { return (r & 3) + 8 * (r >> 2) + 4 * hi; }
DI f32x16 zero16() { f32x16 z;
#pragma unroll
    for (int i = 0; i < 16; ++i) z[i] = 0.f; return z; }

constexpr int G_KF = 0, G_VF = 16384, G_MF = 32768;
constexpr int G_QB = 50176, G_KB = 59392, G_KBB = 68608;
constexpr int G_QKB = 77824, G_UT = 87040, G_WT = 96256, G_KDT = 105472;
constexpr int G_VEC = 114688;
constexpr int G_RAW = G_QKB;
constexpr int GST = 72;

DI f32x16 mm_quad(const unsigned char* A, const unsigned char* Bt, int qr, int qc, int lane) {
    const int r32 = lane & 31, hh = lane >> 5;
    const unsigned char* ap = A + (32 * qr + r32) * (GST * 2) + hh * 16;
    const unsigned char* bp = Bt + (32 * qc + r32) * (GST * 2) + hh * 16;
    f32x16 acc = zero16();
#pragma unroll
    for (int s = 0; s < 4; ++s) acc = mfma32(*(const bf16x8*)(ap + s * 32), *(const bf16x8*)(bp + s * 32), acc);
    return acc;
}

constexpr int G_RAW2 = 115712;
static_assert(G_RAW2 + 67 * 400 <= 143360, "GDN prep LDS map");
constexpr int G_CONVW = 143360 + 512;

#ifndef PROBE_STAGE
#define PROBE_STAGE -1
#endif
template <int VAR> DI void gdn_prep_phase(const Frame& F, const Args& A) {
    unsigned long long stg_t = 0ull, stg_acc = 0ull;
#define STG(n) do { if (PROBE_STAGE >= 0) { const unsigned long long now_ = __builtin_amdgcn_s_memrealtime(); if (PROBE_STAGE == (n)) stg_acc += now_ - stg_t; stg_t = now_; } } while (0)
    unsigned char* ws = A.ws; unsigned char* lds = F.lds;
    const int tid = F.tid, lane = F.lane, wave = F.wave;
    const bf16_t* QKVR = (const bf16_t*)(ws + WS_QKVR); const float* BA = (const float*)(ws + WS_BA);
    float* KF = (float*)(lds + G_KF); float* VF = (float*)(lds + G_VF); float* MF = (float*)(lds + G_MF);
    float* VEC = (float*)(lds + G_VEC);
    if (VAR == 6) return;
    const int NIT = NCHUNK * 8;
#define LBAR() do { asm volatile("s_waitcnt lgkmcnt(0)" ::: "memory"); __builtin_amdgcn_s_barrier(); asm volatile("" ::: "memory"); } while (0)
#define LAUNDER(dst, src) int dst = (src); asm volatile("" : "+v"(dst))
    int item = blockIdx.x;
    if (item >= NIT) return;
    u32x4 pr[4]; float nb = 0.f, na = 0.f;
    auto raw_fetch = [&](int it) {
        const int c = it >> 3, h = it & 7; LAUNDER(tl, tid);
#pragma unroll
        for (int i = 0; i < 4; ++i) { const int q = tl + 512 * i; pr[i] = (u32x4){0u, 0u, 0u, 0u};
            if (q < 67 * 24) { const int r = q / 24, cc = q % 24, seg = cc >> 3, c8 = cc & 7; const int p = 64 * c - 3 + r;
                if (p >= 0) pr[i] = *(const u32x4*)(QKVR + (size_t)p * 1536 + seg * 512 + h * 64 + c8 * 8); } }
        if (wave == 0) { const int p = 64 * c + lane; nb = BA[(size_t)p * 16 + h]; na = BA[(size_t)p * 16 + 8 + h]; }
    };
    auto raw_park = [&]() {
        LAUNDER(tl, tid);
#pragma unroll
        for (int i = 0; i < 4; ++i) { const int q = tl + 512 * i;
            if (q < 67 * 24) { const int r = q / 24, cc = q % 24, seg = cc >> 3, c8 = cc & 7; *(u32x4*)(lds + G_RAW2 + r * 400 + (seg * 64 + c8 * 8) * 2) = pr[i]; } }
    };
    raw_fetch(item); raw_park();
    float cb = nb, ca = na;
    float* CWL = (float*)(lds + G_CONVW);
    int cw_h = -1;
#pragma unroll 1
    for (; item < NIT; item += F.G) {
        if (PROBE_STAGE >= 0 && stg_t == 0ull) stg_t = __builtin_amdgcn_s_memrealtime();
        const int c = item >> 3, h = item & 7;
        if (h != cw_h) { cw_h = h;
            if (tid < 192) { LAUNDER(t0, tid); const int sg = t0 >> 6, jt = (t0 >> 4) & 3, c4 = t0 & 15; *(f32x4*)(CWL + (sg * 4 + jt) * 64 + 4 * c4) = *(const f32x4*)(A.in[4] + jt * 1536 + sg * 512 + h * 64 + 4 * c4); } }
        const int nxt = item + F.G;
        if (VAR != 5 && nxt < NIT) raw_fetch(nxt);
        if (wave == 0) {
            const int p = 64 * c + lane;
            const float alog = A.in[5][h], dtb = A.in[6][h];
            float beta = sigmoidf_(cb);
            const float xx = ca + dtb; const float sp = xx > 20.f ? xx : log1pf(__expf(xx));
            float g = -__expf(alog) * sp;
            if (p < PADL) { beta = 0.f; g = 0.f; }
            float gc = g;
#pragma unroll
            for (int o = 1; o < 64; o <<= 1) { const float t = __shfl_up(gc, o); if (lane >= o) gc += t; }
            const float glast = __shfl(gc, 63);
            VEC[lane] = gc; VEC[64 + lane] = beta; VEC[128 + lane] = __expf(gc); VEC[192 + lane] = __expf(glast - gc);
        }
        LBAR(); STG(0);
        LAUNDER(t1, tid); const int sub = t1 & 15, grp = t1 >> 4;
#pragma unroll
        for (int sg = 0; sg < ((VAR == 2 || VAR >= 4) ? 0 : 3); ++sg) {
#pragma unroll
            for (int ps = 0; ps < 2; ++ps) {
                const int i = grp + 32 * ps;
                float acc[4] = {0.f, 0.f, 0.f, 0.f};
#pragma unroll
                for (int jt = 0; jt < 4; ++jt) {
                    const f32x4 w = *(const f32x4*)(CWL + (sg * 4 + jt) * 64 + 4 * sub);
                    const u32x2 rv = *(const u32x2*)(lds + G_RAW2 + (i + jt) * 400 + (sg * 64 + 4 * sub) * 2);
                    acc[0] += w.x * bflo(rv.x); acc[1] += w.y * bfhi(rv.x); acc[2] += w.z * bflo(rv.y); acc[3] += w.w * bfhi(rv.y);
                }
                float y[4];
#pragma unroll
                for (int k = 0; k < 4; ++k) y[k] = siluf_(acc[k]);
                if (sg < 2) {
                    float ss = (y[0] * y[0] + y[1] * y[1]) + (y[2] * y[2] + y[3] * y[3]);
                    ss += __shfl_xor(ss, 1); ss += __shfl_xor(ss, 2); ss += __shfl_xor(ss, 4); ss += __shfl_xor(ss, 8);
                    const float rn = 1.f / sqrtf(ss + EPS);
#pragma unroll
                    for (int k = 0; k < 4; ++k) y[k] *= rn;
                }
                if (sg == 0) {
                    u32x2 o; o.x = pk2(y[0] * 0.125f, y[1] * 0.125f); o.y = pk2(y[2] * 0.125f, y[3] * 0.125f);
                    *(u32x2*)(lds + G_QB + i * (GST * 2) + 8 * sub) = o;
                } else if (sg == 1) {
                    const float beta = VEC[64 + i], ekd = VEC[192 + i];
                    *(f32x4*)(KF + i * 64 + 4 * sub) = (f32x4){y[0], y[1], y[2], y[3]};
                    u32x2 o; o.x = pk2(y[0], y[1]); o.y = pk2(y[2], y[3]);
                    *(u32x2*)(lds + G_KB + i * (GST * 2) + 8 * sub) = o;
                    o.x = pk2(y[0] * beta, y[1] * beta); o.y = pk2(y[2] * beta, y[3] * beta);
                    *(u32x2*)(lds + G_KBB + i * (GST * 2) + 8 * sub) = o;
#pragma unroll
                    for (int k = 0; k < 4; ++k) *(bf16_t*)(lds + G_KDT + (4 * sub + k) * (GST * 2) + i * 2) = (bf16_t)f2bf(y[k] * ekd);
                } else {
                    *(f32x4*)(VF + i * 64 + 4 * sub) = (f32x4){y[0], y[1], y[2], y[3]};
                }
            }
        }
        LBAR(); STG(1);
        if (VAR != 3 && VAR < 4) {
            LAUNDER(l3, lane);
            const int prod = wave >> 2, quad = wave & 3, qr = quad >> 1, qc = quad & 1, r32 = l3 & 31, hh = l3 >> 5;
            const f32x16 acc = mm_quad(lds + (prod ? G_QB : G_KBB), lds + G_KB, qr, qc, l3);
            const int j = 32 * qc + r32; const float gcj = VEC[j];
#pragma unroll
            for (int r = 0; r < 16; ++r) {
                const int i = 32 * qr + crow(r, hh);
                if (prod == 0) { MF[i * 68 + j] = (j < i) ? acc[r] * __expf(VEC[i] - gcj) : 0.f; }
                else { *(bf16_t*)(lds + G_QKB + i * (GST * 2) + j * 2) = (bf16_t)f2bf((j <= i) ? acc[r] * __expf(VEC[i] - gcj) : 0.f); }
            }
        }
        LBAR(); STG(2);
        float* DB = (float*)(lds + G_KBB);
        if (VAR != 1 && VAR < 4 && wave == 0) {
            LAUNDER(l4, lane); const int b = l4 >> 4, jc = l4 & 15;
            float d[16];
#pragma unroll
            for (int i = 0; i < 16; ++i) {
                float acc = (i == jc) ? 1.f : 0.f;
                const float* mrow = MF + (16 * b + i) * 68 + 16 * b;
#pragma unroll
                for (int k = 0; k < i; ++k) acc -= mrow[k] * d[k];
                d[i] = acc;
            }
#pragma unroll
            for (int i = 0; i < 16; ++i) DB[(b * 16 + i) * 20 + jc] = d[i];
        }
        LBAR();
        if (VAR != 1 && VAR < 4) {
            LAUNDER(l4, lane); const int cc = l4 & 15, g = l4 >> 4;
            const bool isU = wave < 4; const int col = 16 * (wave & 3) + cc;
            const float* src = (isU ? VF : KF) + col;
            f32x4 X[4];
#pragma unroll
            for (int b = 0; b < 4; ++b) {
                f32x4 acc;
#pragma unroll
                for (int r = 0; r < 4; ++r) { const int i = 16 * b + 4 * g + r; float rv = src[i * 64] * VEC[64 + i]; if (!isU) rv *= VEC[128 + i]; acc[r] = -rv; }
#pragma unroll
                for (int a = 0; a < b; ++a) {
                    const f32x4 lv = *(const f32x4*)(MF + (16 * b + cc) * 68 + 16 * a + 4 * g);
#pragma unroll
                    for (int sp = 0; sp < 4; ++sp) acc = __builtin_amdgcn_mfma_f32_16x16x4f32(lv[sp], X[a][sp], acc, 0, 0, 0);
                }
                const f32x4 dv = *(const f32x4*)(DB + (b * 16 + cc) * 20 + 4 * g);
                f32x4 xb = (f32x4){0.f, 0.f, 0.f, 0.f};
#pragma unroll
                for (int sp = 0; sp < 4; ++sp) xb = __builtin_amdgcn_mfma_f32_16x16x4f32(dv[sp], acc[sp], xb, 0, 0, 0);
                X[b] = -xb;
                unsigned char* dst = lds + (isU ? G_UT : G_WT) + col * (GST * 2) + (16 * b + 4 * g) * 2;
                *(u32x2*)dst = (u32x2){pk2(X[b][0], X[b][1]), pk2(X[b][2], X[b][3])};
            }
        }
        LBAR(); STG(3);
        if (VAR != 3 && VAR < 4) {
            const float gl = VEC[128 + 63];
            bf16_t* GB = (bf16_t*)(ws + WS_GB) + (size_t)item * 4096;
            bf16_t* GQ = (bf16_t*)(ws + (VAR ? WS_GS : WS_GQ)) + (size_t)item * 4096; bf16_t* GO = (bf16_t*)(ws + (VAR ? WS_GS : WS_GO)) + (size_t)item * 4096;
            bf16_t* GAL = (bf16_t*)(lds + G_MF);
            LAUNDER(l5, lane); const int r32 = l5 & 31, hh = l5 >> 5;
#pragma unroll 1
            for (int it = 0; it < 2; ++it) {
                const int task = wave + 8 * it, prod = task >> 2, quad = task & 3, qr = quad >> 1, qc = quad & 1;
                const f32x16 acc = mm_quad(lds + (prod < 2 ? G_KDT : G_QKB), lds + ((prod & 1) ? G_UT : G_WT), qr, qc, l5);
                const int Cc = 32 * qc + r32;
                if (prod == 0) {
#pragma unroll
                    for (int r = 0; r < 16; ++r) {
                        const int R = 32 * qr + crow(r, hh);
                        const float val = ((R == Cc) ? gl : 0.f) - acc[r];
                        const int rb = R >> 4, m = R & 15, q4 = Cc >> 4, g = (Cc >> 2) & 3, rr = Cc & 3, ks = q4 >> 1, jj = 4 * (q4 & 1) + rr, ls = 16 * g + m;
                        GAL[((rb * 2 + ks) * 64 + ls) * 8 + jj] = (bf16_t)f2bf(val);
                    }
                } else if (prod == 1) {
                    const int eslab = Cc >> 4, n = Cc & 15;
#pragma unroll
                    for (int a = 0; a < 4; ++a) {
                        const int R0 = 32 * qr + 8 * a + 4 * hh; const int rb = R0 >> 4, g = (R0 >> 2) & 3, ls = 16 * g + n;
                        *(u32x2*)(GB + ((eslab * 4 + rb) * 64 + ls) * 4) = (u32x2){pk2(acc[4 * a], acc[4 * a + 1]), pk2(acc[4 * a + 2], acc[4 * a + 3])};
                    }
                } else if (prod == 2) {
#pragma unroll
                    for (int r = 0; r < 16; ++r) {
                        const int R = 32 * qr + crow(r, hh);
                        const float qv = bf2f(*(const bf16_t*)(lds + G_QB + R * (GST * 2) + Cc * 2));
                        GQ[R * 64 + Cc] = (bf16_t)f2bf(qv * VEC[128 + R] - acc[r]);
                    }
                } else {
#pragma unroll
                    for (int r = 0; r < 16; ++r) GO[(quad * 16 + r) * 64 + l5] = (bf16_t)f2bf(acc[r]);
                }
            }
        }
        if (VAR != 5 && nxt < NIT) { raw_park(); cb = nb; ca = na; }
        LBAR(); STG(4);
        if (VAR != 5) { LAUNDER(t6, tid); *(u32x4*)((bf16_t*)(ws + (VAR ? WS_GS : WS_GA)) + (size_t)item * 4096 + t6 * 8) = *(const u32x4*)(lds + G_MF + t6 * 16); }
        STG(5);
    }
    if (PROBE_STAGE >= 0 && tid == 0) { *(unsigned long long*)(lds + 143360 + 96) = stg_acc; }
}

constexpr int SC_D = 8, SC_PD = 6, SC_SLOT = 10240;
DI void gdn_scan(const Frame& F, const Args& A) {
    if (blockIdx.x >= 32) return;
    unsigned char* ws = A.ws;
    const int h = blockIdx.x & 7, eslab = blockIdx.x >> 3, lane = F.lane, wave = F.wave, n = lane & 15, g = lane >> 4;
    const unsigned char* GA = ws + WS_GA; const unsigned char* GB = ws + WS_GB; bf16_t* GS = (bf16_t*)(ws + WS_GS);
    LAS unsigned char* ring = (LAS unsigned char*)F.lds;
    const int np = (wave == 0) ? 0 : ((wave - 1 < 3) ? 2 : 1);
    auto issue = [&](int c) {
        const int cc = c < NCHUNK ? c : NCHUNK - 1;
        const size_t item = (size_t)cc * 8 + h;
        LAS unsigned char* slot = ring + (c % SC_D) * SC_SLOT;
#pragma unroll
        for (int i = 0; i < 2; ++i) if (i < np) {
            const int q = (wave - 1) + 7 * i;
            const unsigned char* src = (q < 8) ? GA + item * 8192 + q * 1024 : GB + item * 8192 + eslab * 2048 + (q - 8) * 1024;
            LAS unsigned char* dst = slot + ((q < 8) ? q * 1024 : 8192 + (q - 8) * 1024);
            __builtin_amdgcn_global_load_lds((const unsigned*)(src + lane * 16), (LAS unsigned*)dst, 16, 0, 0);
        }
    };
    for (int c = 0; c < SC_PD; ++c) issue(c);
    f32x4 S[4];
#pragma unroll
    for (int rb = 0; rb < 4; ++rb) S[rb] = (f32x4){0.f, 0.f, 0.f, 0.f};
#pragma unroll 1
    for (int c = 0; c < NCHUNK; ++c) {
        issue(c + SC_PD);
        if (np == 2) asm volatile("s_waitcnt vmcnt(12)" ::: "memory");
        else if (np == 1) asm volatile("s_waitcnt vmcnt(6)" ::: "memory");
        asm volatile("s_waitcnt lgkmcnt(0)" ::: "memory");
        __builtin_amdgcn_s_barrier();
        asm volatile("" ::: "memory");
        if (wave == 0) {
            const LAS unsigned char* slot = ring + (c % SC_D) * SC_SLOT;
            bf16x8 ac[8]; f32x4 bc[4];
#pragma unroll
            for (int q = 0; q < 8; ++q) ac[q] = *(const LAS bf16x8*)(slot + q * 1024 + lane * 16);
#pragma unroll
            for (int rb = 0; rb < 4; ++rb) { const u32x2 w = *(const LAS u32x2*)(slot + 8192 + rb * 512 + lane * 8); bc[rb] = (f32x4){bflo(w.x), bfhi(w.x), bflo(w.y), bfhi(w.y)}; }
            const size_t item = (size_t)c * 8 + h;
            u32x4 p0, p1;
            p0.x = pk2(S[0][0], S[0][1]); p0.y = pk2(S[0][2], S[0][3]); p0.z = pk2(S[1][0], S[1][1]); p0.w = pk2(S[1][2], S[1][3]);
            p1.x = pk2(S[2][0], S[2][1]); p1.y = pk2(S[2][2], S[2][3]); p1.z = pk2(S[3][0], S[3][1]); p1.w = pk2(S[3][2], S[3][3]);
            {
                bf16_t* st = GS + item * 4096 + (16 * eslab + n) * 64 + 4 * g;
                *(u32x2*)(st + 0) = (u32x2){p0.x, p0.y}; *(u32x2*)(st + 16) = (u32x2){p0.z, p0.w};
                *(u32x2*)(st + 32) = (u32x2){p1.x, p1.y}; *(u32x2*)(st + 48) = (u32x2){p1.z, p1.w};
            }
            const bf16x8 b0 = __builtin_bit_cast(bf16x8, p0), b1 = __builtin_bit_cast(bf16x8, p1);
#pragma unroll
            for (int rb = 0; rb < 4; ++rb) {
                f32x4 acc = bc[rb];
                acc = mfma16(ac[rb * 2 + 0], b0, acc);
                acc = mfma16(ac[rb * 2 + 1], b1, acc);
                S[rb] = acc;
            }
        }
    }
    asm volatile("s_waitcnt vmcnt(0) lgkmcnt(0)" ::: "memory");
    __builtin_amdgcn_s_barrier();
    if (F.tid == 0) { __builtin_amdgcn_fence(__ATOMIC_RELEASE, "agent"); (void)xb_add((unsigned*)(ws + WS_CTL) + CW_SCANDONE, 1u); }
}

DI void gdn_out_task(const Frame& F, const Args& A, int task) {
    unsigned char* ws = A.ws;
    const int ihalf = task & 1, item = (task >> 1) + 8, c = item >> 3, h = item & 7, lane = F.lane, r32 = lane & 31, hh = lane >> 5;
    const bf16_t* GQ = (const bf16_t*)(ws + WS_GQ) + (size_t)item * 4096; const bf16_t* GS = (const bf16_t*)(ws + WS_GS) + (size_t)item * 4096;
    const bf16_t* GO = (const bf16_t*)(ws + WS_GO) + (size_t)item * 4096;
    const bf16_t* Z = (const bf16_t*)(ws + WS_Z); bf16_t* MIX = (bf16_t*)(ws + WS_MIX);
    f32x16 acc[2];
#pragma unroll
    for (int eh = 0; eh < 2; ++eh)
#pragma unroll
        for (int r = 0; r < 16; ++r) acc[eh][r] = bf2f(GO[((ihalf * 2 + eh) * 16 + r) * 64 + lane]);
#pragma unroll
    for (int s = 0; s < 4; ++s) {
        const bf16x8 a = *(const bf16x8*)(GQ + (32 * ihalf + r32) * 64 + 16 * s + 8 * hh);
#pragma unroll
        for (int eh = 0; eh < 2; ++eh) {
            const bf16x8 b = *(const bf16x8*)(GS + (32 * eh + r32) * 64 + 16 * s + 8 * hh);
            acc[eh] = mfma32(a, b, acc[eh]);
        }
    }
    const float* gnorm = A.in[7];
    const float w0 = gnorm[r32], w1 = gnorm[32 + r32];
#pragma unroll
    for (int r = 0; r < 16; ++r) {
        float ss = acc[0][r] * acc[0][r] + acc[1][r] * acc[1][r];
        ss += __shfl_xor(ss, 1); ss += __shfl_xor(ss, 2); ss += __shfl_xor(ss, 4); ss += __shfl_xor(ss, 8); ss += __shfl_xor(ss, 16);
        const float rstd = 1.f / sqrtf(ss * (1.f / 64.f) + EPS);
        const int i = 32 * ihalf + crow(r, hh); const int p = 64 * c + i;
        const float z0 = bf2f(Z[(size_t)p * 512 + h * 64 + r32]), z1 = bf2f(Z[(size_t)p * 512 + h * 64 + 32 + r32]);
        bf16_t* o = MIX + (size_t)(p - 64) * 1024 + h * 64;
        o[r32] = (bf16_t)f2bf(acc[0][r] * rstd * w0 * siluf_(z0));
        o[32 + r32] = (bf16_t)f2bf(acc[1][r] * rstd * w1 * siluf_(z1));
    }
}


constexpr float QSCALE = 0.10206207261596577f * 1.4426950408889634f;
DI double rope_inv_rev(int i) {
    const double t8[8] = {0.15915494309189535, 0.08949940160889101, 0.050329212104487035, 0.0283021958306234, 0.015915494309189534, 0.008949940160889102, 0.005032921210448704, 0.00283021958306234};
    double v = t8[0];
#pragma unroll
    for (int k = 1; k < 8; ++k) v = ((i & 7) == k) ? t8[k] : v;
    return (i & 8) ? v * 0.01 : v;
}
constexpr int P2_TS = 136;
constexpr int P2_RS = 272;
#define P2_WSYNC() do { __builtin_amdgcn_s_waitcnt(0); __builtin_amdgcn_wave_barrier(); } while (0)
DI void mla_prep2_task(const Frame& F, const Args& A, int task) {
    unsigned char* ws = A.ws; int lane = F.lane; asm volatile("" : "+v"(lane));
    const int h = task & 7, blk = task >> 3;
    const int p = 64 * blk + lane;
    const bool valid = (p >= PADL) && (p < LPV);
    const float* qn = A.in[12]; const float* kn = A.in[13];
    unsigned char* TS = F.lds + F.wave * (64 * P2_RS);
    unsigned char* trow = TS + lane * P2_RS;
    const double pos = (double)(p - PADL);
    auto rot = [&](int i, float& sn_, float& cs_) { const double rev = pos * rope_inv_rev(i); const float fr = (float)(rev - floor(rev)); sn_ = __builtin_amdgcn_sinf(fr); cs_ = __builtin_amdgcn_cosf(fr); };
    {
        {
            const bf16_t* srcb = (const bf16_t*)(ws + WS_QH) + (size_t)(64 * blk) * 768 + h * 96;
            u32x4 t[12];
#pragma unroll
            for (int i = 0; i < 12; ++i) { const int c = 64 * i + lane, r = c / 12, pc = c % 12; t[i] = *(const u32x4*)(srcb + (size_t)r * 768 + 8 * pc); }
#pragma unroll
            for (int i = 0; i < 12; ++i) { const int c = 64 * i + lane, r = c / 12, pc = c % 12; *(u32x4*)(TS + r * P2_RS + 16 * pc) = t[i]; }
            P2_WSYNC();
        }
        u32x4 w[12];
#pragma unroll
        for (int c = 0; c < 12; ++c) w[c] = *(const u32x4*)(trow + 16 * c);
        float ss = 0.f;
#pragma unroll
        for (int c = 0; c < 12; ++c) { const float a0 = bflo(w[c].x), a1 = bfhi(w[c].x), a2 = bflo(w[c].y), a3 = bfhi(w[c].y), a4 = bflo(w[c].z), a5 = bfhi(w[c].z), a6 = bflo(w[c].w), a7 = bfhi(w[c].w);
            ss += (a0 * a0 + a1 * a1) + (a2 * a2 + a3 * a3) + (a4 * a4 + a5 * a5) + (a6 * a6 + a7 * a7); }
        const float rs = valid ? QSCALE / sqrtf(ss * (1.f / 96.f) + EPS) : 0.f;
        unsigned char* dst = trow;
#pragma unroll
        for (int c = 0; c < 8; ++c) {
            const f32x4 g0 = *(const f32x4*)(qn + 8 * c), g1 = *(const f32x4*)(qn + 8 * c + 4);
            *(u32x4*)(dst + 16 * c) = (u32x4){pk2(bflo(w[c].x) * rs * g0.x, bfhi(w[c].x) * rs * g0.y), pk2(bflo(w[c].y) * rs * g0.z, bfhi(w[c].y) * rs * g0.w),
                                              pk2(bflo(w[c].z) * rs * g1.x, bfhi(w[c].z) * rs * g1.y), pk2(bflo(w[c].w) * rs * g1.z, bfhi(w[c].w) * rs * g1.w)};
        }
#pragma unroll
        for (int c = 0; c < 2; ++c) {
            float x1[8], x2[8];
            const u32x4 wa = w[8 + c], wb = w[10 + c];
            x1[0] = bflo(wa.x); x1[1] = bfhi(wa.x); x1[2] = bflo(wa.y); x1[3] = bfhi(wa.y); x1[4] = bflo(wa.z); x1[5] = bfhi(wa.z); x1[6] = bflo(wa.w); x1[7] = bfhi(wa.w);
            x2[0] = bflo(wb.x); x2[1] = bfhi(wb.x); x2[2] = bflo(wb.y); x2[3] = bfhi(wb.y); x2[4] = bflo(wb.z); x2[5] = bfhi(wb.z); x2[6] = bflo(wb.w); x2[7] = bfhi(wb.w);
            float o1[8], o2[8];
#pragma unroll
            for (int t = 0; t < 8; ++t) { float sn_, cs_; rot(8 * c + t, sn_, cs_); const float a = x1[t] * rs * qn[64 + 8 * c + t], b = x2[t] * rs * qn[80 + 8 * c + t]; o1[t] = a * cs_ - b * sn_; o2[t] = b * cs_ + a * sn_; }
            *(u32x4*)(dst + 2 * (64 + 8 * c)) = (u32x4){pk2(o1[0], o1[1]), pk2(o1[2], o1[3]), pk2(o1[4], o1[5]), pk2(o1[6], o1[7])};
            *(u32x4*)(dst + 2 * (80 + 8 * c)) = (u32x4){pk2(o2[0], o2[1]), pk2(o2[2], o2[3]), pk2(o2[4], o2[5]), pk2(o2[6], o2[7])};
        }
        P2_WSYNC();
        {
            unsigned char* outb = (unsigned char*)((bf16_t*)(ws + WS_Q) + ((size_t)h * KVROWS + 64 * blk) * 96);
            u32x4 t[12];
#pragma unroll
            for (int i = 0; i < 12; ++i) { const int c = 64 * i + lane, r = c / 12, pc = c % 12; t[i] = *(const u32x4*)(TS + r * P2_RS + 16 * pc); }
#pragma unroll
            for (int i = 0; i < 12; ++i) *(u32x4*)(outb + (size_t)(64 * i + lane) * 16) = t[i];
            P2_WSYNC();
        }
    }
    {
        {
            const bf16_t* srcb = (const bf16_t*)(ws + WS_KVB) + (size_t)(64 * blk) * 1024 + h * 128;
            const unsigned char* kpb = (const unsigned char*)((const float*)(ws + WS_KPE) + (size_t)(64 * blk) * 32);
            u32x4 t[8], e8[8];
#pragma unroll
            for (int i = 0; i < 8; ++i) { const int c = 64 * i + lane, r = c >> 3, pc = c & 7; t[i] = *(const u32x4*)(srcb + (size_t)r * 1024 + 8 * pc); e8[i] = *(const u32x4*)(kpb + (size_t)c * 16); }
#pragma unroll
            for (int i = 0; i < 8; ++i) { const int c = 64 * i + lane, r = c >> 3, pc = c & 7; *(u32x4*)(TS + r * P2_RS + 16 * pc) = t[i]; *(u32x4*)(TS + r * P2_RS + 128 + 16 * pc) = e8[i]; }
            P2_WSYNC();
        }
        u32x4 w[8]; f32x4 e[8];
#pragma unroll
        for (int c = 0; c < 8; ++c) { w[c] = *(const u32x4*)(trow + 16 * c); e[c] = *(const f32x4*)(trow + 128 + 16 * c); }
        float ss = 0.f;
#pragma unroll
        for (int c = 0; c < 8; ++c) { const float a0 = bflo(w[c].x), a1 = bfhi(w[c].x), a2 = bflo(w[c].y), a3 = bfhi(w[c].y), a4 = bflo(w[c].z), a5 = bfhi(w[c].z), a6 = bflo(w[c].w), a7 = bfhi(w[c].w);
            ss += (a0 * a0 + a1 * a1) + (a2 * a2 + a3 * a3) + (a4 * a4 + a5 * a5) + (a6 * a6 + a7 * a7);
            ss += (e[c].x * e[c].x + e[c].y * e[c].y) + (e[c].z * e[c].z + e[c].w * e[c].w); }
        const float rs = valid ? 1.f / sqrtf(ss * (1.f / 96.f) + EPS) : 0.f;
        unsigned char* dst = trow;
#pragma unroll
        for (int c = 0; c < 8; ++c) {
            const f32x4 g0 = *(const f32x4*)(kn + 8 * c), g1 = *(const f32x4*)(kn + 8 * c + 4);
            *(u32x4*)(dst + 16 * c) = (u32x4){pk2(bflo(w[c].x) * rs * g0.x, bfhi(w[c].x) * rs * g0.y), pk2(bflo(w[c].y) * rs * g0.z, bfhi(w[c].y) * rs * g0.w),
                                              pk2(bflo(w[c].z) * rs * g1.x, bfhi(w[c].z) * rs * g1.y), pk2(bflo(w[c].w) * rs * g1.z, bfhi(w[c].w) * rs * g1.w)};
        }
#pragma unroll
        for (int c = 0; c < 2; ++c) {
            const float x1[8] = {e[2 * c].x, e[2 * c].y, e[2 * c].z, e[2 * c].w, e[2 * c + 1].x, e[2 * c + 1].y, e[2 * c + 1].z, e[2 * c + 1].w};
            const float x2[8] = {e[4 + 2 * c].x, e[4 + 2 * c].y, e[4 + 2 * c].z, e[4 + 2 * c].w, e[5 + 2 * c].x, e[5 + 2 * c].y, e[5 + 2 * c].z, e[5 + 2 * c].w};
            float o1[8], o2[8];
#pragma unroll
            for (int t = 0; t < 8; ++t) { float sn_, cs_; rot(8 * c + t, sn_, cs_); const float a = x1[t] * rs * kn[64 + 8 * c + t], b = x2[t] * rs * kn[80 + 8 * c + t]; o1[t] = a * cs_ - b * sn_; o2[t] = b * cs_ + a * sn_; }
            *(u32x4*)(dst + 2 * (64 + 8 * c)) = (u32x4){pk2(o1[0], o1[1]), pk2(o1[2], o1[3]), pk2(o1[4], o1[5]), pk2(o1[6], o1[7])};
            *(u32x4*)(dst + 2 * (80 + 8 * c)) = (u32x4){pk2(o2[0], o2[1]), pk2(o2[2], o2[3]), pk2(o2[4], o2[5]), pk2(o2[6], o2[7])};
        }
        P2_WSYNC();
        {
            unsigned char* outb = (unsigned char*)((bf16_t*)(ws + WS_K) + ((size_t)h * KVROWS + 64 * blk) * 96);
            u32x4 t[12];
#pragma unroll
            for (int i = 0; i < 12; ++i) { const int c = 64 * i + lane, r = c / 12, pc = c % 12; t[i] = *(const u32x4*)(TS + r * P2_RS + 16 * pc); }
#pragma unroll
            for (int i = 0; i < 12; ++i) *(u32x4*)(outb + (size_t)(64 * i + lane) * 16) = t[i];
            P2_WSYNC();
        }
    }
    {
        unsigned char* T = TS;
        const bf16_t* src = (const bf16_t*)(ws + WS_KVB) + h * 128 + 64;
#pragma unroll
        for (int it = 0; it < 8; ++it) {
            const int pr = 8 * it + (lane >> 3), ch = lane & 7; const int pp = 64 * blk + pr;
            u32x4 v = (u32x4){0u, 0u, 0u, 0u};
            if (pp >= PADL && pp < LPV) v = *(const u32x4*)(src + (size_t)pp * 1024 + 8 * ch);
            unsigned char* tp = T + (8 * ch) * P2_TS + pr * 2;
            *(bf16_t*)(tp + 0 * P2_TS) = (bf16_t)(v.x & 0xffffu); *(bf16_t*)(tp + 1 * P2_TS) = (bf16_t)(v.x >> 16);
            *(bf16_t*)(tp + 2 * P2_TS) = (bf16_t)(v.y & 0xffffu); *(bf16_t*)(tp + 3 * P2_TS) = (bf16_t)(v.y >> 16);
            *(bf16_t*)(tp + 4 * P2_TS) = (bf16_t)(v.z & 0xffffu); *(bf16_t*)(tp + 5 * P2_TS) = (bf16_t)(v.z >> 16);
            *(bf16_t*)(tp + 6 * P2_TS) = (bf16_t)(v.w & 0xffffu); *(bf16_t*)(tp + 7 * P2_TS) = (bf16_t)(v.w >> 16);
        }
        __builtin_amdgcn_s_waitcnt(0); __builtin_amdgcn_wave_barrier();
        bf16_t* VT = (bf16_t*)(ws + WS_VT) + (size_t)h * 64 * KVROWS + 64 * blk;
#pragma unroll
        for (int it = 0; it < 8; ++it) {
            const int e = 8 * it + (lane >> 3), ch = lane & 7;
            const u32x2 lo = *(const u32x2*)(T + e * P2_TS + 16 * ch), hi = *(const u32x2*)(T + e * P2_TS + 16 * ch + 8);
            *(u32x4*)(VT + (size_t)e * KVROWS + 8 * ch) = (u32x4){lo.x, lo.y, hi.x, hi.y};
        }
        __builtin_amdgcn_s_waitcnt(0); __builtin_amdgcn_wave_barrier();
    }
}

constexpr int A_KSTR = 208;
constexpr int A_VSTR = 136;
constexpr int A_KBYTES = 64 * A_KSTR;
constexpr int A_VBYTES = 64 * A_VSTR;
constexpr int A_BUF = A_KBYTES + A_VBYTES;
DI unsigned cvtpk_s(float lo, float hi) { typedef float f2 __attribute__((ext_vector_type(2))); typedef __bf16 b2 __attribute__((ext_vector_type(2))); f2 v = {lo, hi}; b2 b = __builtin_convertvector(v, b2); return __builtin_bit_cast(unsigned, b); }

DI void attn_item(const Frame& F, const Args& A, int h, int qb) {
    unsigned char* ws = A.ws; unsigned char* lds = F.lds;
    const int tid = F.tid, lane = F.lane, wave = F.wave, r32 = lane & 31, hh = lane >> 5;
    const bf16_t* Qg = (const bf16_t*)(ws + WS_Q) + (size_t)h * KVROWS * 96;
    const bf16_t* Kg = (const bf16_t*)(ws + WS_K) + (size_t)h * KVROWS * 96;
    const bf16_t* Vg = (const bf16_t*)(ws + WS_VT) + (size_t)h * 64 * KVROWS;
    const int p0w = 64 + 256 * qb + 32 * wave;
    const int qp = p0w + r32;
    const int ntile = 4 * qb + 5;
    const int mylast = 1 + 4 * qb + (wave >> 1);
    bf16x8 qf[6];
#pragma unroll
    for (int s = 0; s < 6; ++s) qf[s] = *(const bf16x8*)(Qg + (size_t)qp * 96 + 16 * s + 8 * hh);
    f32x16 ot[2]; ot[0] = zero16(); ot[1] = zero16();
    float mrun = -1e30f, lrun = 0.f;
    const int kr0 = tid / 12, kc0 = tid % 12, kr1 = (tid + 512) / 12, kc1 = (tid + 512) % 12; const bool k1ok = tid < 256;
    const int vr = tid >> 3, vc = tid & 7;
    struct Stg { u32x4 k0, k1, v; };
    Stg sA;
    auto gload = [&](Stg& st, int j) {
        const int kv0 = 64 * j;
        st.k0 = *(const u32x4*)(Kg + (size_t)(kv0 + kr0) * 96 + kc0 * 8);
        if (k1ok) st.k1 = *(const u32x4*)(Kg + (size_t)(kv0 + kr1) * 96 + kc1 * 8);
        st.v = *(const u32x4*)(Vg + (size_t)vr * KVROWS + kv0 + vc * 8);
    };
    auto lstore = [&](const Stg& st, int t) {
        unsigned char* kb = lds + (t % 3) * A_BUF; unsigned char* vb = kb + A_KBYTES;
        *(u32x4*)(kb + kr0 * A_KSTR + kc0 * 16) = st.k0;
        if (k1ok) *(u32x4*)(kb + kr1 * A_KSTR + kc1 * 16) = st.k1;
        *(u32x2*)(vb + vr * A_VSTR + vc * 16) = (u32x2){st.v.x, st.v.y};
        *(u32x2*)(vb + vr * A_VSTR + vc * 16 + 8) = (u32x2){st.v.z, st.v.w};
    };
    auto step = [&](auto FIRSTc, auto LASTc, int t, f32x16 (&C)[2], f32x16 (&P)[2]) {
        if (t + 1 < ntile) gload(sA, t + 1);
        constexpr bool has_cur = !decltype(LASTc)::value, has_prev = !decltype(FIRSTc)::value;
        const unsigned char* kb = lds + (t % 3) * A_BUF;
        const unsigned char* vb = lds + ((t + 2) % 3) * A_BUF + A_KBYTES;
        bf16x8 kf[2][6];
        if constexpr (has_cur) {
            const unsigned char* kp = kb + r32 * A_KSTR + hh * 16;
#pragma unroll
            for (int s = 0; s < 6; ++s) kf[0][s] = *(const bf16x8*)(kp + s * 32);
        }
        float ps0 = 0.f, ps1 = 0.f; u32x4 pw[4]; bf16x8 vfr[4][2];
        auto vload = [&](int g) -> bf16x8 {
            const int f = g >> 1, eh = g & 1, kh2 = f >> 1, s2 = f & 1;
            const unsigned char* vp = vb + (32 * eh + r32) * A_VSTR + (32 * kh2 + 16 * s2 + 4 * hh) * 2;
            const u32x2 lo = *(const u32x2*)vp, hi2 = *(const u32x2*)(vp + 16);
            return __builtin_bit_cast(bf16x8, (u32x4){lo.x, lo.y, hi2.x, hi2.y}); };
        __builtin_amdgcn_sched_barrier(0);
#pragma unroll
        for (int i = 0; i < 12; ++i) {
            const int kh = i / 6, sx = i % 6;
            if constexpr (has_cur) { C[kh] = mfma32(kf[kh][sx], qf[sx], sx == 0 ? zero16() : C[kh]); if (i < 6) kf[1][i] = *(const bf16x8*)(kb + (32 + r32) * A_KSTR + hh * 16 + i * 32); }
            if (has_prev && i < 8) {
                const int f = i >> 1, kh2 = f >> 1, b0 = 8 * (f & 1) + 4 * (i & 1);
                const float v0 = P[kh2][b0], v1 = P[kh2][b0 + 1], v2 = P[kh2][b0 + 2], v3 = P[kh2][b0 + 3];
                ps0 += v0 + v1; ps1 += v2 + v3;
                if (i & 1) { pw[f].z = cvtpk_s(v0, v1); pw[f].w = cvtpk_s(v2, v3); asm volatile("" : "+v"(ps0), "+v"(ps1), "+v"(pw[f].z), "+v"(pw[f].w)); }
                else { pw[f].x = cvtpk_s(v0, v1); pw[f].y = cvtpk_s(v2, v3); asm volatile("" : "+v"(ps0), "+v"(ps1), "+v"(pw[f].x), "+v"(pw[f].y)); }
            }
            if (has_prev && i >= 10) {
                const int g0 = i - 10; vfr[g0 >> 1][g0 & 1] = vload(g0);
            }
            __builtin_amdgcn_sched_barrier(0);
        }
        if (has_prev) lrun += ps0 + ps1;
        float mnew = mrun, alpha = 1.f; bool resc = false;
        if constexpr (has_cur) {
            if (t == 0) {
#pragma unroll
                for (int kh = 0; kh < 2; ++kh)
#pragma unroll
                    for (int r = 0; r < 16; ++r) { const int kv = 32 * kh + crow(r, hh); if (kv < PADL) C[kh][r] = -INFINITY; }
            }
            if (t >= mylast) {
#pragma unroll
                for (int kh = 0; kh < 2; ++kh)
#pragma unroll
                    for (int r = 0; r < 16; ++r) { const int kv = 64 * t + 32 * kh + crow(r, hh); if (kv > qp) C[kh][r] = -INFINITY; }
            }
            float mx = C[0][0];
#pragma unroll
            for (int r = 1; r < 16; ++r) mx = fmaxf(mx, C[0][r]);
#pragma unroll
            for (int r = 0; r < 16; ++r) mx = fmaxf(mx, C[1][r]);
            mx = fmaxf(mx, __shfl_xor(mx, 32));
            mnew = fmaxf(mrun, mx);
            alpha = __builtin_amdgcn_exp2f(mrun - mnew);
            resc = __any(mnew > mrun);
        }
        __builtin_amdgcn_sched_barrier(0);
#pragma unroll
        for (int g = 0; g < 8; ++g) {
            const int f = g >> 1, eh = g & 1;
            if constexpr (has_prev) { ot[eh] = mfma32(vfr[f][eh], __builtin_bit_cast(bf16x8, pw[f]), ot[eh]); if (g + 2 < 8) vfr[(g + 2) >> 1][(g + 2) & 1] = vload(g + 2); }
            if constexpr (has_cur) { const int kh = g >> 2, r0 = 4 * (g & 3);
#pragma unroll
                for (int q = 0; q < 4; ++q) C[kh][r0 + q] = __builtin_amdgcn_exp2f(C[kh][r0 + q] - mnew);
                asm volatile("" : "+v"(C[kh][r0]), "+v"(C[kh][r0 + 1]), "+v"(C[kh][r0 + 2]), "+v"(C[kh][r0 + 3])); }
            __builtin_amdgcn_sched_barrier(0);
        }
        if constexpr (has_cur) {
            if (resc) {
#pragma unroll
                for (int eh = 0; eh < 2; ++eh)
#pragma unroll
                    for (int r = 0; r < 16; ++r) ot[eh][r] *= alpha;
            }
            lrun *= alpha; mrun = mnew;
        }
        if (t + 1 < ntile) lstore(sA, t + 1);
        __syncthreads();
    };
    gload(sA, 0); lstore(sA, 0);
    __syncthreads();
    f32x16 scA[2], scB[2];
    scB[0] = zero16(); scB[1] = zero16();
    {
        using TT = std::integral_constant<bool, true>; using FF = std::integral_constant<bool, false>;
        step(TT{}, FF{}, 0, scA, scB);
#pragma unroll 1
        for (int t = 1; t + 1 < ntile; t += 2) {
            step(FF{}, FF{}, t, scB, scA);
            step(FF{}, FF{}, t + 1, scA, scB);
        }
        step(FF{}, TT{}, ntile, scB, scA);
    }
    const float ltot = lrun + __shfl_xor(lrun, 32);
    const float rl = 1.f / ltot;
    bf16_t* o = (bf16_t*)(ws + WS_MIX) + (size_t)(qp - 64) * 1024 + 512 + h * 64;
#pragma unroll
    for (int eh = 0; eh < 2; ++eh)
#pragma unroll
        for (int a = 0; a < 4; ++a) {
            const int e = 32 * eh + 8 * a + 4 * hh;
            *(u32x2*)(o + e) = (u32x2){pk2(ot[eh][4 * a] * rl, ot[eh][4 * a + 1] * rl), pk2(ot[eh][4 * a + 2] * rl, ot[eh][4 * a + 3] * rl)};
        }
}

DI void xn_rows(const Frame& F, const Args& A, int u0, int stride) {
    f32x4 v[2][4];
#pragma unroll
    for (int r = 0; r < 2; ++r) { const int u = u0 + r * stride; if (u < MU) { const f32x4* xr = (const f32x4*)(A.out + (size_t)u * DM) + F.lane;
#pragma unroll
        for (int j = 0; j < 4; ++j) v[r][j] = xr[64 * j]; } }
#pragma unroll
    for (int r = 0; r < 2; ++r) {
        const int u = u0 + r * stride; if (u >= MU) continue;
        float s = 0.f;
#pragma unroll
        for (int j = 0; j < 4; ++j) s += (v[r][j].x * v[r][j].x + v[r][j].y * v[r][j].y) + (v[r][j].z * v[r][j].z + v[r][j].w * v[r][j].w);
        const float rstd = 1.f / sqrtf(wave_sum(s) * (1.f / DM) + EPS);
        unsigned long long* o8 = (unsigned long long*)((bf16_t*)(A.ws + WS_XN) + (size_t)u * DM) + F.lane;
#pragma unroll
        for (int j = 0; j < 4; ++j) { const f32x4 w = ((const f32x4*)A.in[15])[64 * j + F.lane];
            o8[64 * j] = (unsigned long long)pk2(v[r][j].x * rstd * w.x, v[r][j].y * rstd * w.y) | ((unsigned long long)pk2(v[r][j].z * rstd * w.z, v[r][j].w * rstd * w.w) << 32); }
    }
}

DI unsigned fkey(float v, int idx) { unsigned u = __builtin_bit_cast(unsigned, v); u = (u & 0x80000000u) ? ~u : (u | 0x80000000u); return (u & ~127u) | (unsigned)(127 - idx); }
DI float keyval(unsigned k) { unsigned u = k & ~127u; u = (u & 0x80000000u) ? (u & 0x7fffffffu) : ~u; return __builtin_bit_cast(float, u); }

__device__ const unsigned char PAIR_A[50] = {0,0,0,0,0,0,0,0,0,0,0,0,0,0,0,0, 1,1,1,1,1,1,1,1, 2,2,2,2,2, 3,3,3,3, 4,4,4, 5,5, 6,6, 7,7, 8,9,10,11,12,13,14,15};
__device__ const unsigned char PAIR_B[50] = {0,1,2,3,4,5,6,7,8,9,10,11,12,13,14,15, 0,1,2,3,4,5,6,7, 0,1,2,3,4, 0,1,2,3, 0,1,2, 0,1, 0,1, 0,1, 0,0,0,0,0,0,0,0};

DI void ce_desc(unsigned& a, unsigned& b) { const unsigned mx = a > b ? a : b, mn = a > b ? b : a; a = mx; b = mn; }
template <int BASE, int NK> DI void bitonic_sort16_desc(unsigned (&x)[NK]) {
#pragma unroll
    for (int k = 2; k <= 16; k <<= 1)
#pragma unroll
        for (int j = k >> 1; j > 0; j >>= 1)
#pragma unroll
            for (int i = 0; i < 16; ++i) { const int l = i ^ j; if (l > i) { if ((i & k) == 0) ce_desc(x[BASE + i], x[BASE + l]); else ce_desc(x[BASE + l], x[BASE + i]); } }
}
template <int A0, int B0, int NK> DI void merge_top16(unsigned (&x)[NK]) {
#pragma unroll
    for (int i = 0; i < 16; ++i) { const unsigned p = x[A0 + i], q = x[B0 + 15 - i]; x[A0 + i] = p > q ? p : q; }
#pragma unroll
    for (int j = 8; j > 0; j >>= 1)
#pragma unroll
        for (int i = 0; i < 16; ++i) { const int l = i ^ j; if (l > i) ce_desc(x[A0 + i], x[A0 + l]); }
}
template <int NK> DI void top16_of_128(unsigned (&key)[NK]) {
    bitonic_sort16_desc<0, NK>(key); bitonic_sort16_desc<16, NK>(key); bitonic_sort16_desc<32, NK>(key); bitonic_sort16_desc<48, NK>(key);
    bitonic_sort16_desc<64, NK>(key); bitonic_sort16_desc<80, NK>(key); bitonic_sort16_desc<96, NK>(key); bitonic_sort16_desc<112, NK>(key);
    merge_top16<0, 16, NK>(key); merge_top16<32, 48, NK>(key); merge_top16<64, 80, NK>(key); merge_top16<96, 112, NK>(key);
    merge_top16<0, 32, NK>(key); merge_top16<64, 96, NK>(key);
    merge_top16<0, 64, NK>(key);
}

DI void topk_task(const Frame& F, const Args& A, int task) {
    unsigned char* ws = A.ws; const int tid = F.tid;
    const int u = task >> 3, h = task & 7;
    LAS unsigned* sk = (LAS unsigned*)(LAS unsigned char*)F.lds;
    LAS unsigned* pkk = sk + 16384;
    LAS unsigned* stg = sk + 16384;
    const bf16_t* SCb = (const bf16_t*)(ws + WS_SC) + (size_t)(task & ~511) * 256;
#pragma unroll 1
    for (int half = 0; half < 2; ++half) {
        unsigned key[128];
#pragma unroll
        for (int qb = 0; qb < 2; ++qb) {
            u32x4 pf[8];
#pragma unroll
            for (int k = 0; k < 8; ++k) { const int c = tid + 512 * k; pf[k] = *(const u32x4*)(SCb + (size_t)(c >> 3) * 256 + half * 128 + qb * 64 + (c & 7) * 8); }
#pragma unroll
            for (int k = 0; k < 8; ++k) { const int c = tid + 512 * k; *(LAS u32x4*)(stg + (c >> 3) * 36 + (c & 7) * 4) = pf[k]; }
            __syncthreads();
#pragma unroll
            for (int i = 0; i < 8; ++i) { const u32x4 v = *(const LAS u32x4*)(stg + tid * 36 + 4 * i); const int b0 = 64 * qb + 8 * i;
                key[b0] = fkey(bflo(v.x), b0); key[b0 + 1] = fkey(bfhi(v.x), b0 + 1); key[b0 + 2] = fkey(bflo(v.y), b0 + 2); key[b0 + 3] = fkey(bfhi(v.y), b0 + 3);
                key[b0 + 4] = fkey(bflo(v.z), b0 + 4); key[b0 + 5] = fkey(bfhi(v.z), b0 + 5); key[b0 + 6] = fkey(bflo(v.w), b0 + 6); key[b0 + 7] = fkey(bfhi(v.w), b0 + 7); }
            __syncthreads();
        }
        top16_of_128(key);
#pragma unroll
        for (int r = 0; r < 16; ++r) sk[(half * 16 + r) * 512 + tid] = key[r];
    }
    float v1[16], v2[16];
#pragma unroll
    for (int r = 0; r < 16; ++r) { v1[r] = keyval(sk[r * 512 + tid]); v2[r] = keyval(sk[(16 + r) * 512 + tid]); }
    unsigned ck[64];
#pragma unroll
    for (int c = 50; c < 64; ++c) ck[c] = 0u;
#pragma unroll
    for (int a = 0; a < 16; ++a) {
        const int off = a == 0 ? 0 : a == 1 ? 16 : a == 2 ? 24 : a == 3 ? 29 : a == 4 ? 33 : a == 5 ? 36 : a == 6 ? 38 : a == 7 ? 40 : 42 + (a - 8);
#pragma unroll
        for (int b = 0; b < 16; ++b) if ((a + 1) * (b + 1) <= 16) ck[off + b] = fkey(v1[a] + v2[b], off + b);
    }
    bitonic_sort16_desc<0, 64>(ck); bitonic_sort16_desc<16, 64>(ck); bitonic_sort16_desc<32, 64>(ck); bitonic_sort16_desc<48, 64>(ck);
    merge_top16<0, 16, 64>(ck); merge_top16<32, 48, 64>(ck); merge_top16<0, 32, 64>(ck);
#pragma unroll
    for (int r = 0; r < 16; ++r) pkk[r * 512 + tid] = ck[r];
    const float cmax = keyval(pkk[tid]);
    float ev[16]; float esum = 0.f; int ex[16];
#pragma unroll
    for (int r = 0; r < 16; ++r) {
        const unsigned k = pkk[r * 512 + tid]; const int c = 127 - (int)(k & 127u);
        ev[r] = __expf(keyval(k) - cmax); esum += ev[r];
        const int a = PAIR_A[c], b = PAIR_B[c];
        const int i1 = 127 - (int)(sk[a * 512 + tid] & 127u), i2 = 127 - (int)(sk[(16 + b) * 512 + tid] & 127u);
        ex[r] = i1 * 128 + i2;
    }
    const float rs = 1.f / esum;
    int* IDX = (int*)(ws + WS_IDX) + (size_t)u * 128 + h * 16; float* GATE = (float*)(ws + WS_GATE) + (size_t)u * 128 + h * 16;
#pragma unroll
    for (int r = 0; r < 16; r += 4) {
        *(int4*)(IDX + r) = make_int4(ex[r], ex[r + 1], ex[r + 2], ex[r + 3]);
        *(f32x4*)(GATE + r) = (f32x4){ev[r] * rs, ev[r + 1] * rs, ev[r + 2] * rs, ev[r + 3] * rs};
    }
}

constexpr float EU_SCALE = 64.f, EV_SCALE = 16.f;
DI unsigned pk4_fp8(float a, float b, float c, float d) { int w = 0; w = __builtin_amdgcn_cvt_pk_fp8_f32(a, b, w, false); w = __builtin_amdgcn_cvt_pk_fp8_f32(c, d, w, true); return (unsigned)w; }
DI void convert_tables(const Frame& F, const Args& A) {
    const size_t n16 = (size_t)16384 * 1024 / 16;
    const size_t gt = (size_t)blockIdx.x * 512 + F.tid, NGT = (size_t)F.G * 512;
#pragma unroll 1
    for (int t = 0; t < 2; ++t) {
        const float* src = A.in[18 + t]; unsigned char* dst = A.ws + (t ? WS_EV : WS_EU); const float sc = t ? EV_SCALE : EU_SCALE;
        const float* fn = A.in[15];
        for (size_t i = gt; i < n16; i += NGT) {
            f32x4 a = *(const f32x4*)(src + i * 16) * sc, b = *(const f32x4*)(src + i * 16 + 4) * sc, c = *(const f32x4*)(src + i * 16 + 8) * sc, d = *(const f32x4*)(src + i * 16 + 12) * sc;
            if (t == 0) { const float* g = fn + (i & 63) * 16; a *= *(const f32x4*)g; b *= *(const f32x4*)(g + 4); c *= *(const f32x4*)(g + 8); d *= *(const f32x4*)(g + 12); }
            const size_t e_ = i >> 6, c16_ = i & 63;
            *(u32x4*)(dst + (c16_ >> 3) * ((size_t)16384 * 128) + e_ * 128 + (c16_ & 7) * 16) = (u32x4){pk4_fp8(a.x, a.y, a.z, a.w), pk4_fp8(b.x, b.y, b.z, b.w), pk4_fp8(c.x, c.y, c.z, c.w), pk4_fp8(d.x, d.y, d.z, d.w)};
        }
    }
}

DI float gelu_exact(float x) { return 0.5f * x * (1.f + erff(x * 0.70710678118654752f)); }
typedef float f32x2 __attribute__((ext_vector_type(2)));
#define UNPK16(dst, W_) do { f32x2 _t; \
    _t = __builtin_amdgcn_cvt_pk_f32_fp8((int)(W_).x, false); dst[0] = _t.x; dst[1] = _t.y; _t = __builtin_amdgcn_cvt_pk_f32_fp8((int)(W_).x, true); dst[2] = _t.x; dst[3] = _t.y; \
    _t = __builtin_amdgcn_cvt_pk_f32_fp8((int)(W_).y, false); dst[4] = _t.x; dst[5] = _t.y; _t = __builtin_amdgcn_cvt_pk_f32_fp8((int)(W_).y, true); dst[6] = _t.x; dst[7] = _t.y; \
    _t = __builtin_amdgcn_cvt_pk_f32_fp8((int)(W_).z, false); dst[8] = _t.x; dst[9] = _t.y; _t = __builtin_amdgcn_cvt_pk_f32_fp8((int)(W_).z, true); dst[10] = _t.x; dst[11] = _t.y; \
    _t = __builtin_amdgcn_cvt_pk_f32_fp8((int)(W_).w, false); dst[12] = _t.x; dst[13] = _t.y; _t = __builtin_amdgcn_cvt_pk_f32_fp8((int)(W_).w, true); dst[14] = _t.x; dst[15] = _t.y; } while (0)

template <bool UPH>
DI void expert_phase(const Frame& F, const Args& A, int xv, int wq, int nw) {
    unsigned char* ws = A.ws; const int lane = F.lane, grp = lane >> 3, j = lane & 7;
    const unsigned char* TBL = ws + (UPH ? WS_EU : WS_EV) + (size_t)xv * ((size_t)16384 * 128) + 16 * j;
    const int* IDX = (const int*)(ws + WS_IDX); const float* CW = (const float*)(ws + WS_CW);
    const bf16_t* XN = (const bf16_t*)(ws + WS_XN) + 128 * xv + 16 * j;
    float* HP = (float*)(ws + WS_HP);
    LAS unsigned* ring = (LAS unsigned*)((LAS unsigned char*)F.lds + F.wave * 4096);
    const int nt = (MU - wq + nw - 1) / nw;
    if (nt <= 0) return;
    auto tok = [&](int k) { return __builtin_amdgcn_readfirstlane(wq + (k < nt ? k : nt - 1) * nw); };
    int mi0, mi1; u32x4 mx0, mx1; float mh0, mh1;
    auto meta_load = [&](int k) {
        const int u = tok(k);
        mi0 = IDX[(size_t)u * 128 + lane]; mi1 = IDX[(size_t)u * 128 + 64 + lane];
        if constexpr (UPH) { mx0 = *(const u32x4*)(XN + (size_t)u * DM); mx1 = *(const u32x4*)(XN + (size_t)u * DM + 8); }
        else { mh0 = CW[(size_t)u * 128 + lane]; mh1 = CW[(size_t)u * 128 + 64 + lane]; }
    };
    auto meta_store = [&](int k) {
        LAS unsigned* sl = ring + (k & 3) * 256;
        sl[lane] = (unsigned)mi0; sl[64 + lane] = (unsigned)mi1;
        if constexpr (UPH) { if (grp == 0) { *(LAS u32x4*)(sl + 128 + 8 * j) = mx0; *(LAS u32x4*)(sl + 128 + 8 * j + 4) = mx1; } }
        else { sl[128 + lane] = __builtin_bit_cast(unsigned, mh0); sl[192 + lane] = __builtin_bit_cast(unsigned, mh1); }
    };
    auto gather = [&](u32x4 (&buf)[8], int n) {
        const LAS unsigned* sl = ring + ((n >> 1) & 3) * 256 + 64 * (n & 1) + grp;
#pragma unroll
        for (int i = 0; i < 8; ++i) { const int e = (int)sl[8 * i]; buf[i] = *(const u32x4*)(TBL + (size_t)e * 128); }
    };
    const int ocol = 128 * xv + 16 * j + ((lane & 32) ? 8 : 0) + ((lane & 16) ? 4 : 0) + ((lane & 8) ? 2 : 0);
    f32x2 ocur = (f32x2){0.f, 0.f};
    float acc[16];
    float xn[16];
    auto compute = [&](u32x4 (&buf)[8], int n) {
        const int k = n >> 1, hf = n & 1;
        const LAS unsigned* sl = ring + (k & 3) * 256;
        if (hf == 0) {
            if constexpr (UPH) {
                const u32x4 x0 = *(const LAS u32x4*)(sl + 128 + 8 * j), x1 = *(const LAS u32x4*)(sl + 128 + 8 * j + 4);
                xn[0] = bflo(x0.x); xn[1] = bfhi(x0.x); xn[2] = bflo(x0.y); xn[3] = bfhi(x0.y); xn[4] = bflo(x0.z); xn[5] = bfhi(x0.z); xn[6] = bflo(x0.w); xn[7] = bfhi(x0.w);
                xn[8] = bflo(x1.x); xn[9] = bfhi(x1.x); xn[10] = bflo(x1.y); xn[11] = bfhi(x1.y); xn[12] = bflo(x1.z); xn[13] = bfhi(x1.z); xn[14] = bflo(x1.w); xn[15] = bfhi(x1.w);
            } else {
#pragma unroll
                for (int c = 0; c < 16; ++c) acc[c] = 0.f;
                { const unsigned hw = *(const unsigned*)((const bf16_t*)(ws + WS_XN) + (size_t)tok(k) * DM + ocol); ocur = (f32x2){bflo(hw), bfhi(hw)}; }
            }
        }
#pragma unroll
        for (int i = 0; i < 8; ++i) {
            float f[16]; UNPK16(f, buf[i]);
            if constexpr (UPH) {
                float a0 = 0.f, a1 = 0.f;
#pragma unroll
                for (int c = 0; c < 16; c += 2) { a0 += f[c] * xn[c]; a1 += f[c + 1] * xn[c + 1]; }
                if (hf == 0) acc[i] = a0 + a1; else acc[8 + i] = a0 + a1;
                if (i < 7) { if (hf == 0) asm volatile("" : "+v"(buf[i + 1].x), "+v"(buf[i + 1].y), "+v"(buf[i + 1].z), "+v"(buf[i + 1].w), "+v"(acc[i]));
                             else asm volatile("" : "+v"(buf[i + 1].x), "+v"(buf[i + 1].y), "+v"(buf[i + 1].z), "+v"(buf[i + 1].w), "+v"(acc[8 + i])); }
            } else {
                const float cw = __builtin_bit_cast(float, sl[128 + 64 * hf + 8 * i + grp]);
#pragma unroll
                for (int c = 0; c < 16; ++c) acc[c] += cw * f[c];
                if (i < 7) asm volatile("" : "+v"(buf[i + 1].x), "+v"(buf[i + 1].y), "+v"(buf[i + 1].z), "+v"(buf[i + 1].w),
                                             "+v"(acc[0]), "+v"(acc[1]), "+v"(acc[2]), "+v"(acc[3]), "+v"(acc[4]), "+v"(acc[5]), "+v"(acc[6]), "+v"(acc[7]),
                                             "+v"(acc[8]), "+v"(acc[9]), "+v"(acc[10]), "+v"(acc[11]), "+v"(acc[12]), "+v"(acc[13]), "+v"(acc[14]), "+v"(acc[15]));
            }
            __builtin_amdgcn_sched_barrier(0);
        }
        if (hf == 1 && k < nt) {
            const int u = tok(k);
            float r8[8], r4[4], r2[2];
            if constexpr (UPH) {
                { const bool up = lane & 4;
#pragma unroll
                  for (int i = 0; i < 8; ++i) { const float send = up ? acc[i] : acc[i + 8], keep = up ? acc[i + 8] : acc[i]; r8[i] = keep + __shfl_xor(send, 4); } }
                { const bool up = lane & 2;
#pragma unroll
                  for (int i = 0; i < 4; ++i) { const float send = up ? r8[i] : r8[i + 4], keep = up ? r8[i + 4] : r8[i]; r4[i] = keep + __shfl_xor(send, 2); } }
                { const bool up = lane & 1;
#pragma unroll
                  for (int i = 0; i < 2; ++i) { const float send = up ? r4[i] : r4[i + 2], keep = up ? r4[i + 2] : r4[i]; r2[i] = keep + __shfl_xor(send, 1); } }
                const int st = ((lane & 4) ? 8 : 0) + ((lane & 2) ? 4 : 0) + ((lane & 1) ? 2 : 0);
                float* hp = HP + ((size_t)xv * MU + u) * 128 + grp;
                hp[8 * st] = r2[0]; hp[8 * (st + 1)] = r2[1];
            } else {
                { const bool up = lane & 32;
#pragma unroll
                  for (int c = 0; c < 8; ++c) { const float send = up ? acc[c] : acc[c + 8], keep = up ? acc[c + 8] : acc[c]; r8[c] = keep + __shfl_xor(send, 32); } }
                { const bool up = lane & 16;
#pragma unroll
                  for (int c = 0; c < 4; ++c) { const float send = up ? r8[c] : r8[c + 4], keep = up ? r8[c + 4] : r8[c]; r4[c] = keep + __shfl_xor(send, 16); } }
                { const bool up = lane & 8;
#pragma unroll
                  for (int c = 0; c < 2; ++c) { const float send = up ? r4[c] : r4[c + 2], keep = up ? r4[c + 2] : r4[c]; r2[c] = keep + __shfl_xor(send, 8); } }
                f32x2* o = (f32x2*)(A.out + (size_t)u * DM + ocol);
                f32x2 cur = ocur; cur.x += r2[0]; cur.y += r2[1]; *o = cur;
            }
        }
    };
    meta_load(0); meta_store(0); meta_load(1); meta_store(1); meta_load(2); meta_store(2);
    u32x4 b0[8], b1[8], b2[8];
    gather(b0, 0); gather(b1, 1); gather(b2, 2);
#pragma unroll 1
    for (int k0 = 0; k0 < nt; k0 += 3) {
        const int n0 = 2 * k0;
        meta_load(k0 + 3);
        compute(b0, n0);     gather(b0, n0 + 3);
        compute(b1, n0 + 1); meta_store(k0 + 3); gather(b1, n0 + 4);
        meta_load(k0 + 4);
        compute(b2, n0 + 2); gather(b2, n0 + 5);
        compute(b0, n0 + 3); meta_store(k0 + 4); gather(b0, n0 + 6);
        meta_load(k0 + 5);
        compute(b1, n0 + 4); gather(b1, n0 + 7);
        compute(b2, n0 + 5); meta_store(k0 + 5); gather(b2, n0 + 8);
    }
}


DI void expert_c_pass(const Frame& F, const Args& A) {
    unsigned char* ws = A.ws;
    const float* HP = (const float*)(ws + WS_HP); const float* GATE = (const float*)(ws + WS_GATE); float* CW = (float*)(ws + WS_CW);
    const size_t n4 = (size_t)MU * 128 / 4;
    for (size_t i = (size_t)blockIdx.x * 512 + F.tid; i < n4; i += (size_t)F.G * 512) {
        f32x4 h = *(const f32x4*)(HP + i * 4);
#pragma unroll
        for (int x = 1; x < 8; ++x) h += *(const f32x4*)(HP + (size_t)x * MU * 128 + i * 4);
        const f32x4 g = *(const f32x4*)(GATE + i * 4);
        const float rs = (1.f / EU_SCALE) / sqrtf(ss_sum16((const float*)(ws + WS_SS4), (int)(i >> 5)) * (1.f / DM) + EPS);
        f32x4 c;
        c.x = gelu_exact(h.x * rs) * g.x * (1.f / EV_SCALE); c.y = gelu_exact(h.y * rs) * g.y * (1.f / EV_SCALE);
        c.z = gelu_exact(h.z * rs) * g.z * (1.f / EV_SCALE); c.w = gelu_exact(h.w * rs) * g.w * (1.f / EV_SCALE);
        *(f32x4*)(CW + i * 4) = c;
    }
}
template <int PH> DI void run_phase(const Frame& F, const Args& args, PG8_LAS unsigned char* lds3) {
    unsigned char* ws = args.ws;
    if constexpr (PH == 0) { p0_prologue(F, args); p0_late_weights<0>(F, args, (7 - F.wave) * F.G + blockIdx.x, F.NGW, blockIdx.x * 512 + F.tid, F.G * 512); }
    if constexpr (PH == 1) {
        pg8::Gemm g{(const bf16_t*)(ws + WS_HN), (const bf16_t*)(ws + WS_WIN), MP, NPROJ, 1024, 1024, 1024, 0};
        pg8::StaticOrder S; S.init(MP, NPROJ, F.G, (int)blockIdx.x);
        EpiProj E{(bf16_t*)(ws + WS_QKVR), (bf16_t*)(ws + WS_Z), (float*)(ws + WS_BA), (bf16_t*)(ws + WS_CQN), (bf16_t*)(ws + WS_CKVN), (float*)(ws + WS_KPE), (float*)(ws + WS_SSQ), (float*)(ws + WS_SSK)};
        pg8::gemm_phase<EpiProj, pg8::StaticOrder, true, true>(lds3, g, S, E);
    }
    if constexpr (PH == 2) {
        gdn_prep_phase<0>(F, args);
        __syncthreads();
        const int G = F.G, c1 = ((int)blockIdx.x + G - 8 % G) % G, c2 = ((int)blockIdx.x + G - 208 % G) % G;
        { pg8::Gemm g{(const bf16_t*)(ws + WS_CQN), (const bf16_t*)(ws + WS_WUQ), MP, 768, 256, 256, 256, 0};
          pg8::StaticOrder S; S.init(MP, 768, G, c1); EpiB16 E{(bf16_t*)(ws + WS_QH), 768, (const float*)(ws + WS_SSQ), 1.f / 256.f, 4};
          pg8::gemm_phase<EpiB16, pg8::StaticOrder, true, true>(lds3, g, S, E); }
        { pg8::Gemm g{(const bf16_t*)(ws + WS_CKVN), (const bf16_t*)(ws + WS_WUKV), MP, 1024, 256, 256, 256, 0};
          pg8::StaticOrder S; S.init(MP, 1024, G, c2); EpiB16 E{(bf16_t*)(ws + WS_KVB), 1024, (const float*)(ws + WS_SSK), 1.f / 128.f, 4};
          pg8::gemm_phase<EpiB16, pg8::StaticOrder, true, true>(lds3, g, S, E); }
    }
    if constexpr (PH == 3) { for (int t = F.gw; t < (KVROWS / 64) * 8; t += F.NGW) mla_prep2_task(F, args, t); }
    if constexpr (PH == 4) {
        gdn_scan(F, args);
        volatile LAS unsigned* MISC = (volatile LAS unsigned*)(lds3 + MISC_OFF);
        unsigned* ctl = (unsigned*)(ws + WS_CTL);
        unsigned* qhead = ctl + CW_ATTQ;
        bool scan_seen = false;
        for (;;) {
            __syncthreads();
            if (F.tid == 0) MISC[24] = xb_add(qhead, 1u);
            __syncthreads();
            const int k = (int)MISC[24];
            if (k >= 512 + 512) break;
            if (k < 512) { attn_item(F, args, k & 7, 63 - (k >> 3)); continue; }
            if (!scan_seen) {
                if (F.tid == 0) XB_SPIN(xb_ld(ctl + CW_SCANDONE) < 32u, ctl);
                __syncthreads();
                __builtin_amdgcn_fence(__ATOMIC_ACQUIRE, "agent");
                scan_seen = true;
            }
            gdn_out_task(F, args, (k - 512) * 8 + F.wave);
        }
        p0_late_weights<1>(F, args, F.gw, F.NGW, blockIdx.x * 512 + F.tid, F.G * 512);
    }
    if constexpr (PH == 5) {
        pg8::Gemm g{(const bf16_t*)(ws + WS_MIX), (const bf16_t*)(ws + WS_WOUT), MU, 1024, 1024, 1024, 1024, 0};
        pg8::StaticOrder S; S.init(MU, 1024, F.G, (int)blockIdx.x); EpiH1 E{args.out, args.in[0], (bf16_t*)(ws + WS_XN), (float*)(ws + WS_SS4)};
        pg8::gemm_phase<EpiH1, pg8::StaticOrder, true, true>(lds3, g, S, E);
    }
    if constexpr (PH == 6) {
        pg8::Gemm g{(const bf16_t*)(ws + WS_XN), (const bf16_t*)(ws + WS_WPQ), MU, 2048, 1024, 1024, 1024, 0};
        pg8::StaticOrder S; S.init(MU, 2048, F.G, (int)blockIdx.x); EpiB16 E{(bf16_t*)(ws + WS_PQ), 2048, (const float*)(ws + WS_SS4), 1.f / 1024.f, 16};
        pg8::gemm_phase<EpiB16, pg8::StaticOrder, true, true>(lds3, g, S, E);
        __threadfence_block(); __syncthreads();
    }
    if constexpr (PH == 6) {
        pg8::Gemm g{(const bf16_t*)(ws + WS_PQ), (const bf16_t*)(ws + WS_SKB), MU, 2048, 256, 2048, 256, 256};
        pg8::StaticOrder S; S.init(MU, 2048, F.G, (int)blockIdx.x); EpiB16 E{(bf16_t*)(ws + WS_SC), 2048, nullptr, 0.f, 0};
        pg8::gemm_phase<EpiB16, pg8::StaticOrder, true, true>(lds3, g, S, E);
    }
    if constexpr (PH == 7) {
        convert_tables(F, args);
        for (int t = blockIdx.x * 512 + F.tid; t < MU * 8; t += F.G * 512) topk_task(F, args, t);
    }
    if constexpr (PH == 9) { expert_c_pass(F, args); }
    if constexpr (PH == 8 || PH == 10) {
        volatile LAS unsigned* MISC = (volatile LAS unsigned*)(lds3 + MISC_OFF);
        const unsigned x = MISC[16], rank = MISC[17];
        unsigned* bar = (unsigned*)(ws + WS_CTL);
        unsigned nloc = 0, nx = 0, myidx = 0;
#pragma unroll
        for (unsigned j = 0; j < 16; ++j) { const unsigned c = xb_ld(&bar[XB_XCNT(j)]); nx += (c > 0u) ? 1u : 0u; myidx += (c > 0u && j < x) ? 1u : 0u; nloc = (j == x) ? c : nloc; }
        const int wq = __builtin_amdgcn_readfirstlane((int)rank * 8 + F.wave), nw = __builtin_amdgcn_readfirstlane((int)nloc * 8);
        const int xstep = __builtin_amdgcn_readfirstlane((int)nx);
        for (int xv = __builtin_amdgcn_readfirstlane((int)myidx); xv < 8; xv += xstep)
            { if constexpr (PH == 8) expert_phase<true>(F, args, xv, wq, nw); else expert_phase<false>(F, args, xv, wq, nw); }
    }
}
constexpr int NPHASE = 11;
__global__ void __launch_bounds__(512, 2) fwd_kernel(Args args) {
    extern __shared__ __attribute__((aligned(16))) unsigned char lds[];
    Frame F;
    F.lds = lds; F.tid = threadIdx.x; F.lane = F.tid & 63; F.wave = __builtin_amdgcn_readfirstlane(F.tid >> 6);
    F.G = gridDim.x; F.gw = blockIdx.x * 8 + F.wave; F.NGW = F.G * 8;
    volatile LAS unsigned* MISC = (volatile LAS unsigned*)((LAS unsigned char*)lds + MISC_OFF);
    if (F.tid < 32) MISC[F.tid] = 0u;
    __syncthreads();
    unsigned char* ws = args.ws;
    const int lo = args.ph_lo, hi = args.ph_hi;
    XcdBarrier bar; bar.bar = (unsigned*)(ws + WS_CTL); bar.x = 0; bar.st = nullptr;
    if (hi - lo > 1) bar = xcd_barrier_post((unsigned*)(ws + WS_CTL), MISC + 8);
    if (F.tid == 0) { const unsigned x = xb_xcc_id(); MISC[16] = x; MISC[17] = xb_add((unsigned*)(ws + WS_CTL) + 3520 + 64 * x, 1u); }
    __syncthreads();
#define IN(k) (lo <= (k) && (k) < hi)
#define SEAM(k) do { if (IN(k) && IN((k) + 1)) xcd_barrier(bar); } while (0)
    PG8_LAS unsigned char* lds3 = (PG8_LAS unsigned char*)lds;

#ifndef PROBE_REPEAT
#define PROBE_REPEAT -1
#endif
#ifndef PROBE_TIME
#define PROBE_TIME -1
#endif
#ifndef PROBE_TSEL
#define PROBE_TSEL 0
#endif
    unsigned long long pt_ticks = 0ull;
#define PHASE(k) do { unsigned long long pt0_ = 0ull; if (PROBE_TIME == (k)) pt0_ = __builtin_amdgcn_s_memrealtime(); \
        if (IN(k)) { run_phase<k>(F, args, lds3); if (PROBE_REPEAT == (k)) { xcd_barrier(bar); run_phase<(k)>(F, args, lds3); } } \
        if (PROBE_TIME == (k) && PROBE_TSEL == 1) pt_ticks = __builtin_amdgcn_s_memrealtime() - pt0_;     \
        if (PROBE_TIME == (k) && PROBE_TSEL == 2) pt0_ = __builtin_amdgcn_s_memrealtime();                \
        SEAM(k); \
        if (PROBE_TIME == (k) && PROBE_TSEL != 1) pt_ticks = __builtin_amdgcn_s_memrealtime() - pt0_; } while (0)
    PHASE(0); PHASE(1); PHASE(2); PHASE(3); PHASE(4); PHASE(5); PHASE(6); PHASE(7); PHASE(8); PHASE(9); PHASE(10);
#undef PHASE
    if (PROBE_STAGE >= 0) { __syncthreads(); pt_ticks = *(volatile unsigned long long*)(lds + 143360 + 96); }
    if (PROBE_TIME >= 0 || PROBE_STAGE >= 0) { const unsigned long long t0_ = __builtin_amdgcn_s_memrealtime(); while (__builtin_amdgcn_s_memrealtime() - t0_ < 4ull * pt_ticks) __builtin_amdgcn_s_sleep(32); }
#undef IN
#undef SEAM
}

#ifndef N_LAUNCHES
#define N_LAUNCHES 1
#endif
extern "C" void kernel_launch(void* const* d_in, const int* in_sizes, int n_in, void* d_out, int out_size, void* d_ws, size_t ws_size, hipStream_t stream) {
    static int grid = 0;
    if (grid == 0) {
        if (n_in != 20 || out_size != MU * DM || ws_size < WS_END) { fprintf(stderr, "kernel_launch: unexpected shapes (n_in %d out %d ws %zu)\n", n_in, out_size, ws_size); grid = -1; return; }
        int dev = 0, cus = 0, per_cu = 0;
        if (hipGetDevice(&dev) != hipSuccess || hipDeviceGetAttribute(&cus, hipDeviceAttributeMultiprocessorCount, dev) != hipSuccess) { grid = -1; return; }
        if (hipFuncSetAttribute((const void*)fwd_kernel, hipFuncAttributeMaxDynamicSharedMemorySize, LDS_BYTES) != hipSuccess) { fprintf(stderr, "kernel_launch: hipFuncSetAttribute failed\n"); grid = -1; return; }
        if (hipOccupancyMaxActiveBlocksPerMultiprocessor(&per_cu, (const void*)fwd_kernel, 512, LDS_BYTES) != hipSuccess || per_cu < 1) { fprintf(stderr, "kernel_launch: occupancy query says %d\n", per_cu); (void)hipGetLastError(); per_cu = 1; }
        grid = cus;
    }
    if (grid < 0) return;
    (void)hipMemsetAsync((char*)d_ws + WS_CTL, 0, CTL_ZERO_BYTES, stream);
    Args a{};
    for (int i = 0; i < 20; ++i) a.in[i] = (const float*)d_in[i];
    a.out = (float*)d_out; a.ws = (unsigned char*)d_ws;
    for (int li = 0; li < N_LAUNCHES; ++li) {
        a.ph_lo = li * NPHASE / N_LAUNCHES; a.ph_hi = (li + 1) * NPHASE / N_LAUNCHES;
        if (N_LAUNCHES == 1) {
            void* kargs[] = {&a};
            hipError_t e = hipLaunchCooperativeKernel((const void*)fwd_kernel, dim3(grid), dim3(512), kargs, LDS_BYTES, stream);
            if (e != hipSuccess) fprintf(stderr, "cooperative launch failed: %s (grid %d)\n", hipGetErrorString(e), grid);
        } else {
            hipLaunchKernelGGL(fwd_kernel, dim3(grid), dim3(512), LDS_BYTES, stream, a);
        }
    }
}
```

```cpp
#include <hip/hip_runtime.h>
#include <hip/hip_bf16.h>
#include <cstdio>
#include <cstdint>
#include <type_traits>

#define DI __device__ __forceinline__
#define LAS __attribute__((address_space(3)))
#define GAS __attribute__((address_space(1)))

typedef unsigned short bf16_t;
typedef short bf16x8 __attribute__((ext_vector_type(8)));
typedef short s16x4 __attribute__((ext_vector_type(4)));
typedef float f32x4 __attribute__((ext_vector_type(4)));
typedef float f32x16 __attribute__((ext_vector_type(16)));
typedef unsigned u32x4 __attribute__((ext_vector_type(4)));
typedef unsigned u32x2 __attribute__((ext_vector_type(2)));

namespace pg8 {
#define PG8_LAS __attribute__((address_space(3)))
constexpr int BM = 256, BK = 64, HALF = 128, HTB = HALF * BK * 2  , STAGE_BYTES = 8 * HTB, NXCD = 8, WGM = 8;

__host__ __device__ __forceinline__ int lds_byte(int r, int c) { const int st = (r >> 4) * 2 + (c >> 5), rr = r & 15, cc = c & 31, ob = rr * 64 + cc * 2; return st * 1024 + (ob ^ (((ob >> 9) & 1) << 5)); }
__host__ __device__ __forceinline__ void stage_rc(int b, int& R, int& C) { const int st = b / 1024, sb = b % 1024, swz = sb ^ (((sb >> 9) & 1) << 5); R = (st >> 1) * 16 + swz / 64; C = (st & 1) * 32 + (swz % 64) / 2; }
__host__ __device__ __forceinline__ int perm32(int rho) { const int n = rho >> 4, i = rho & 15; return 8 * (i >> 2) + 4 * n + (i & 3); }

struct Unit { int pm, pn; };
struct Gemm { const bf16_t* A; const bf16_t* Bt; int M, N, K, lda, ldb, a_pn_off; };

struct StaticOrder {
    int nM, nN, nwg, G, c;
    __host__ __device__ void init(int M, int N, int G_, int c_) { nM = M / BM; nN = N / BM; nwg = nM * nN; G = G_; c = c_; }
    __host__ __device__ bool next(int i, Unit& u) const {
        const long L = (long)i * G + c; if (L >= nwg) return false;
        int wgid = (int)L; { const int q = nwg / NXCD, r = nwg % NXCD, xcd = wgid % NXCD, off = wgid / NXCD; wgid = (xcd < r ? xcd * (q + 1) : r * (q + 1) + (xcd - r) * q) + off; }
        const int nig = WGM * nN, gid = wgid / nig, fm = gid * WGM, gsz = (nM - fm) < WGM ? (nM - fm) : WGM;
        u.pm = fm + ((wgid % nig) % gsz); u.pn = (wgid % nig) / gsz; return true;
    }
    __device__ __forceinline__ void a_ready(const Unit&) const {}
    __device__ __forceinline__ void done(const Unit&) const {}
};

__device__ __forceinline__ unsigned cvt_pk_bf16(float lo, float hi) { unsigned r; asm volatile("v_cvt_pk_bf16_f32 %0, %1, %2" : "=v"(r) : "v"(lo), "v"(hi)); return r; }

template <class Epi, class Sched, bool ALIGN_EPI = false, bool SP2 = false>
__device__ __forceinline__ void gemm_phase(PG8_LAS unsigned char* lds, const Gemm g, const Sched& S, const Epi& E) {
    const int tid = threadIdx.x, wid = __builtin_amdgcn_readfirstlane(tid >> 6), lane = tid & 63, wr = wid >> 2, wc = wid & 3, fr = lane & 15, fq = lane >> 4;
    const int K = g.K, nt = K / BK;
    unsigned voffA[2], voffB[2];
#pragma unroll
    for (int i = 0; i < 2; ++i) { int R, C; stage_rc(tid * 16 + i * 8192, R, C); const int Rb = Epi::PERM ? ((R & ~31) + perm32(R & 31)) : R;
        voffA[i] = (unsigned)(R * g.lda + C) * 2u; voffB[i] = (unsigned)(Rb * g.ldb + C) * 2u; }
    const size_t kstep = (size_t)(BK * 2);
    const size_t hstepA = (size_t)HALF * g.lda * 2, hstepB = (size_t)HALF * g.ldb * 2;
    const size_t tstepA = 2 * hstepA, tstepB = 2 * hstepB;
    const size_t pnoffA = (size_t)g.a_pn_off * 2;
    const unsigned ldsw = (unsigned)wid * 1024u;
    const int aoff = lds_byte(wr * 64 + fr, fq * 8), boff = lds_byte(wc * 32 + fr, fq * 8);
#define PG8_SA(b, h) (((b) * 2 + (h)) * HTB)
#define PG8_SB(b, h) ((4 + (b) * 2 + (h)) * HTB)
#define PG8_STAGE(bufoff, gbase, voff) do { _Pragma("unroll") for (int _i = 0; _i < 2; ++_i) \
        __builtin_amdgcn_global_load_lds((const unsigned*)((const char*)(gbase) + (voff)[_i]), (PG8_LAS unsigned*)(lds + (bufoff) + ldsw + _i * 8192), 16, 0, 0); } while (0)
#define PG8_LDA(dst, b, h) do { _Pragma("unroll") for (int m = 0; m < 4; ++m) _Pragma("unroll") for (int k = 0; k < 2; ++k) dst[m][k] = *(const PG8_LAS bf16x8*)(lds + PG8_SA(b, h) + aoff + m * 2048 + k * 1024); } while (0)
#define PG8_LDB(dst, b, h) do { _Pragma("unroll") for (int n = 0; n < 2; ++n) _Pragma("unroll") for (int k = 0; k < 2; ++k) dst[n][k] = *(const PG8_LAS bf16x8*)(lds + PG8_SB(b, h) + boff + n * 2048 + k * 1024); } while (0)
#define PG8_MMA(ai, bj, At, Bt) do { __builtin_amdgcn_s_setprio(1); _Pragma("unroll") for (int m = 0; m < 4; ++m) _Pragma("unroll") for (int n = 0; n < 2; ++n) _Pragma("unroll") for (int k = 0; k < 2; ++k) \
        acc[ai][bj][m][n] = __builtin_amdgcn_mfma_f32_16x16x32_bf16(Bt[n][k], At[m][k], acc[ai][bj][m][n], 0, 0, 0); __builtin_amdgcn_s_setprio(0); } while (0)
#define PG8_WAIT_V(n) asm volatile("s_waitcnt vmcnt(" #n ")" ::: "memory")
#define PG8_WAIT_L(n) asm volatile("s_waitcnt lgkmcnt(" #n ")" ::: "memory")
#define PG8_BAR __builtin_amdgcn_s_barrier()
#define PG8_SCHED __builtin_amdgcn_sched_barrier(0)
    Unit cur, nxt; int ui = 0;
    if (!S.next(0, cur)) return;
    f32x4 acc[2][2][4][2];
#pragma unroll
    for (int a = 0; a < 2; ++a)
#pragma unroll
        for (int b = 0; b < 2; ++b)
#pragma unroll
            for (int m = 0; m < 4; ++m)
#pragma unroll
                for (int n = 0; n < 2; ++n) acc[a][b][m][n] = (f32x4){0.f, 0.f, 0.f, 0.f};
    bf16x8 At[4][2], B0[2][2], B1[2][2];
    const char* cA = (const char*)g.A + (size_t)cur.pm * tstepA + (size_t)cur.pn * pnoffA; const char* cB = (const char*)g.Bt + (size_t)cur.pn * tstepB;
    S.a_ready(cur);
    if constexpr (SP2) {
        PG8_STAGE(PG8_SB(0, 0), cB, voffB); PG8_STAGE(PG8_SB(0, 1), cB + hstepB, voffB); PG8_STAGE(PG8_SA(0, 0), cA, voffA); PG8_STAGE(PG8_SA(0, 1), cA + hstepA, voffA);
        if (wr == 1) PG8_BAR;
        PG8_WAIT_V(2); PG8_BAR;
        PG8_STAGE(PG8_SB(1, 0), cB + kstep, voffB); PG8_STAGE(PG8_SA(1, 0), cA + kstep, voffA); PG8_STAGE(PG8_SB(1, 1), cB + hstepB + kstep, voffB);
        PG8_WAIT_V(6); PG8_BAR;
    } else {
        PG8_STAGE(PG8_SB(0, 0), cB, voffB); PG8_STAGE(PG8_SA(0, 0), cA, voffA); PG8_STAGE(PG8_SB(0, 1), cB + hstepB, voffB); PG8_STAGE(PG8_SA(0, 1), cA + hstepA, voffA);
        if (wr == 1) PG8_BAR;
        PG8_WAIT_V(4); PG8_BAR;
        PG8_STAGE(PG8_SB(1, 0), cB + kstep, voffB); PG8_STAGE(PG8_SA(1, 0), cA + kstep, voffA); PG8_STAGE(PG8_SB(1, 1), cB + hstepB + kstep, voffB);
        PG8_WAIT_V(6); PG8_BAR;
    }
    for (;;) {
        const bool has_next = S.next(ui + 1, nxt);
        const char* nA = has_next ? (const char*)g.A + (size_t)nxt.pm * tstepA + (size_t)nxt.pn * pnoffA : cA; const char* nB = has_next ? (const char*)g.Bt + (size_t)nxt.pn * tstepB : cB;
        for (int t = 0; t < nt; t += 2) {
            const bool last = (t == nt - 2);
            const char* a1 = cA + (size_t)(t + 1) * kstep;
            const char* a2 = last ? nA : cA + (size_t)(t + 2) * kstep; const char* b2 = last ? nB : cB + (size_t)(t + 2) * kstep;
            const char* a3 = a2 + kstep; const char* b3 = b2 + kstep;
            if (last && has_next) S.a_ready(nxt);
            if constexpr (SP2) {
            PG8_LDB(B0, 0, 0); PG8_LDB(B1, 0, 1); PG8_SCHED; PG8_LDA(At, 0, 0); PG8_STAGE(PG8_SA(1, 1), a1 + hstepA, voffA);
            PG8_WAIT_V(8); PG8_WAIT_L(0); PG8_BAR; PG8_MMA(0, 0, At, B0); PG8_MMA(0, 1, At, B1); PG8_BAR; PG8_SCHED;
            PG8_LDA(At, 0, 1); PG8_STAGE(PG8_SB(0, 0), b2, voffB); PG8_STAGE(PG8_SB(0, 1), b2 + hstepB, voffB); PG8_STAGE(PG8_SA(0, 0), a2, voffA);
            PG8_WAIT_V(8); PG8_WAIT_L(0); PG8_BAR; PG8_MMA(1, 0, At, B0); PG8_MMA(1, 1, At, B1); PG8_BAR; PG8_SCHED;
            PG8_LDB(B0, 1, 0); PG8_LDB(B1, 1, 1); PG8_SCHED; PG8_LDA(At, 1, 0); PG8_STAGE(PG8_SA(0, 1), a2 + hstepA, voffA);
            PG8_WAIT_V(8); PG8_WAIT_L(0); PG8_BAR; PG8_MMA(0, 0, At, B0); PG8_MMA(0, 1, At, B1); PG8_BAR; PG8_SCHED;
            PG8_LDA(At, 1, 1); PG8_STAGE(PG8_SB(1, 0), b3, voffB); PG8_STAGE(PG8_SB(1, 1), b3 + hstepB, voffB); PG8_STAGE(PG8_SA(1, 0), a3, voffA);
            PG8_WAIT_V(8); PG8_WAIT_L(0); PG8_BAR; PG8_MMA(1, 0, At, B0); PG8_MMA(1, 1, At, B1); PG8_BAR; PG8_SCHED;
            } else {
            PG8_LDB(B0, 0, 0); PG8_SCHED; PG8_LDA(At, 0, 0); PG8_STAGE(PG8_SA(1, 1), a1 + hstepA, voffA);
            PG8_WAIT_L(8); PG8_BAR; PG8_WAIT_L(0); PG8_MMA(0, 0, At, B0); PG8_BAR; PG8_SCHED;
            PG8_LDB(B1, 0, 1); PG8_STAGE(PG8_SB(0, 0), b2, voffB);
            PG8_BAR; PG8_WAIT_L(0); PG8_MMA(0, 1, At, B1); PG8_BAR;
            PG8_LDA(At, 0, 1); PG8_STAGE(PG8_SA(0, 0), a2, voffA);
            PG8_BAR; PG8_WAIT_L(0); PG8_MMA(1, 0, At, B0); PG8_BAR; PG8_SCHED;
            PG8_STAGE(PG8_SB(0, 1), b2 + hstepB, voffB);
            PG8_WAIT_V(6); PG8_BAR; PG8_MMA(1, 1, At, B1); PG8_BAR;
            PG8_LDB(B0, 1, 0); PG8_SCHED; PG8_LDA(At, 1, 0); PG8_STAGE(PG8_SA(0, 1), a2 + hstepA, voffA);
            PG8_WAIT_L(8); PG8_BAR; PG8_WAIT_L(0); PG8_MMA(0, 0, At, B0); PG8_BAR; PG8_SCHED;
            PG8_LDB(B1, 1, 1); PG8_STAGE(PG8_SB(1, 0), b3, voffB);
            PG8_BAR; PG8_WAIT_L(0); PG8_MMA(0, 1, At, B1); PG8_BAR;
            PG8_LDA(At, 1, 1); PG8_STAGE(PG8_SA(1, 0), a3, voffA);
            PG8_BAR; PG8_WAIT_L(0); PG8_MMA(1, 0, At, B0); PG8_BAR; PG8_SCHED;
            PG8_STAGE(PG8_SB(1, 1), b3 + hstepB, voffB);
            PG8_WAIT_V(6); PG8_BAR; PG8_MMA(1, 1, At, B1); PG8_BAR;
            }
        }
        if constexpr (ALIGN_EPI) { if (wr == 0) PG8_BAR; }
        E(acc, cur, wr, wc, fr, fq); S.done(cur);
        if (!has_next) break;
#pragma unroll
        for (int a = 0; a < 2; ++a)
#pragma unroll
            for (int b = 0; b < 2; ++b)
#pragma unroll
                for (int m = 0; m < 4; ++m)
#pragma unroll
                    for (int n = 0; n < 2; ++n) acc[a][b][m][n] = (f32x4){0.f, 0.f, 0.f, 0.f};
        cur = nxt; cA = nA; cB = nB; ++ui;
        if constexpr (ALIGN_EPI) { if (wr == 1) PG8_BAR; }
    }
    PG8_WAIT_V(0);
    if constexpr (!ALIGN_EPI) { if (wr == 0) PG8_BAR; }
    PG8_BAR;
#undef PG8_SA
#undef PG8_SB
#undef PG8_STAGE
#undef PG8_LDA
#undef PG8_LDB
#undef PG8_MMA
#undef PG8_WAIT_V
#undef PG8_WAIT_L
#undef PG8_BAR
#undef PG8_SCHED
}
}

constexpr int DM = 1024;
constexpr int NTOK = 16400;
constexpr int PADL = 48;
constexpr int LPV = 16448;
constexpr int MP = 16640;
constexpr int MU = 16384;
constexpr int NCHUNK = 257;
constexpr int NHEAD = 8;
constexpr int NPROJ = 2560;
constexpr int KVROWS = 16512;
constexpr float EPS = 1e-6f;

constexpr size_t MiB = 1u << 20;
constexpr size_t WS_CTL = 0, CTL_ZERO_BYTES = 64 * 1024;
constexpr size_t WS_SSQ = 128 * 1024;
constexpr size_t WS_SSK = 512 * 1024;
constexpr size_t WS_SS4 = 14 * MiB;
constexpr size_t WS_WIN = 1 * MiB;
constexpr size_t WS_WUQ = 6 * MiB;
constexpr size_t WS_WUKV = 6 * MiB + 512 * 1024;
constexpr size_t WS_WOUT = 7 * MiB;
constexpr size_t WS_WPQ = 9 * MiB;
constexpr size_t WS_SKB = 13 * MiB;
constexpr size_t WS_IDX = 16 * MiB;
constexpr size_t WS_GATE = 24 * MiB;
constexpr size_t WS_HN = 16 * MiB;
constexpr size_t WS_QKVR = 101 * MiB;
constexpr size_t WS_Z = 150 * MiB;
constexpr size_t WS_BA = 245 * MiB;
constexpr size_t WS_GA = 16 * MiB;
constexpr size_t WS_GQ = 33 * MiB;
constexpr size_t WS_GS = 67 * MiB;
constexpr size_t WS_GB = 84 * MiB;
constexpr size_t WS_GO = 50 * MiB;
constexpr size_t WS_MIX = 167 * MiB;
constexpr size_t WS_CQN = 200 * MiB;
constexpr size_t WS_CKVN = 208 * MiB + 512 * 1024;
constexpr size_t WS_QH = 220 * MiB;
constexpr size_t WS_KVB = 167 * MiB;
constexpr size_t WS_Q = 125 * MiB + 512 * 1024;
constexpr size_t WS_K = 101 * MiB;
constexpr size_t WS_VT = 200 * MiB;
constexpr size_t WS_XN = 32 * MiB;
constexpr size_t WS_PQ = 64 * MiB;
constexpr size_t WS_SC = 128 * MiB;
constexpr size_t WS_EU = 96 * MiB;
constexpr size_t WS_EV = 112 * MiB;
constexpr size_t WS_CW = 64 * MiB;
constexpr size_t WS_HP = 128 * MiB;
constexpr size_t WS_KPE = 217 * MiB;
constexpr size_t WS_END = 256 * MiB;
constexpr int CW_ATTQ = 8192;
constexpr int CW_SCANDONE = 8256;

constexpr int LDS_BYTES = 147456;
constexpr int MISC_OFF = 131072 + 12288;

DI unsigned f2bf(float f) { unsigned u = __builtin_bit_cast(unsigned, f); return (u + 0x7fffu + ((u >> 16) & 1u)) >> 16; }
DI unsigned pk2(float lo, float hi) { return f2bf(lo) | (f2bf(hi) << 16); }
DI float bf2f(unsigned b) { return __builtin_bit_cast(float, b << 16); }
DI float bflo(unsigned w) { return __builtin_bit_cast(float, w << 16); }
DI float bfhi(unsigned w) { return __builtin_bit_cast(float, w & 0xffff0000u); }
DI float wave_sum(float v) {
#pragma unroll
    for (int o = 1; o < 64; o <<= 1) v += __shfl_xor(v, o);
    return v;
}
DI float sigmoidf_(float x) { return 1.f / (1.f + __expf(-x)); }
DI float siluf_(float x) { return x / (1.f + __expf(-x)); }

#define XB_TMO      128
#define XB_XCNT(j)  (256  + 64 * (j))
#define XB_XSUB(j)  (1280 + 64 * (j))
#define XB_XGEN(j)  (2304 + 64 * (j))
#define XB_TOP      3328
#define XB_TOPGEN   3392
#define XCD_BAR_WORDS 3456
#define XB_SPIN_CAP (1u << 22)
DI unsigned xb_ld(unsigned* p)              { return __hip_atomic_load(p, __ATOMIC_RELAXED, __HIP_MEMORY_SCOPE_AGENT); }
DI unsigned xb_add(unsigned* p, unsigned v) { return __hip_atomic_fetch_add(p, v, __ATOMIC_RELAXED, __HIP_MEMORY_SCOPE_AGENT); }
DI unsigned xb_xcc_id() { return (unsigned)__builtin_amdgcn_s_getreg((3 << 11) | 20) & 0xFu; }
#define XB_SPIN(cond, bar) do { unsigned _sp = 0; while (cond) { __builtin_amdgcn_s_sleep(1); \
    if ((++_sp & 255u) == 0u) { if (xb_ld(&(bar)[XB_TMO])) break; if (_sp > XB_SPIN_CAP) { atomicAdd(&(bar)[XB_TMO], 1u); break; } } } } while (0)
struct XcdBarrier { unsigned* bar; unsigned x; volatile LAS unsigned* st; };
DI XcdBarrier xcd_barrier_post(unsigned* bar, volatile LAS unsigned* st) {
    XcdBarrier b; b.bar = bar; b.x = xb_xcc_id(); b.st = st;
    if (threadIdx.x == 0) (void)xb_add(&bar[XB_XCNT(b.x)], 1u);
    return b;
}
DI void xcd_barrier_complete(unsigned* bar, unsigned x, unsigned& nloc, unsigned& nx) {
    const unsigned G = gridDim.x * gridDim.y * gridDim.z;
    unsigned sum, cnt, mine, sp = 0u;
    for (;;) {
        sum = 0u; cnt = 0u; mine = 0u;
#pragma unroll
        for (unsigned j = 0; j < 16; ++j) { const unsigned c = xb_ld(&bar[XB_XCNT(j)]); sum += c; cnt += (c > 0u) ? 1u : 0u; mine = (j == x) ? c : mine; }
        if (sum == G) break;
        __builtin_amdgcn_s_sleep(1);
        if ((++sp & 255u) == 0u) { if (xb_ld(&bar[XB_TMO])) break; if (sp > XB_SPIN_CAP) { atomicAdd(&bar[XB_TMO], 1u); break; } }
    }
    nloc = mine > 0u ? mine : 1u; nx = cnt > 0u ? cnt : 1u;
}
DI void xcd_barrier(const XcdBarrier& b) {
    asm volatile("s_waitcnt vmcnt(0)" ::: "memory");
    __syncthreads();
    if (threadIdx.x == 0) {
        unsigned* bar = b.bar;
        __builtin_amdgcn_s_waitcnt(0);
        unsigned nloc = b.st[0], nx = b.st[1];
        if (nloc == 0u) { xcd_barrier_complete(bar, b.x, nloc, nx); b.st[0] = nloc; b.st[1] = nx; }
        const unsigned old = xb_add(&bar[XB_XSUB(b.x)], 1u);
        const unsigned gen = old / nloc;
        if (old + 1u == (gen + 1u) * nloc) {
            __builtin_amdgcn_fence(__ATOMIC_RELEASE, "agent");
            asm volatile("s_waitcnt vmcnt(0)" ::: "memory");
            const unsigned og = xb_add(&bar[XB_TOP], 1u);
            const unsigned tg = og / nx;
            if (og + 1u == (tg + 1u) * nx) xb_add(&bar[XB_TOPGEN], 1u);
            else XB_SPIN(xb_ld(&bar[XB_TOPGEN]) == tg, bar);
            __builtin_amdgcn_fence(__ATOMIC_ACQUIRE, "agent");
            xb_add(&bar[XB_XGEN(b.x)], 1u);
            asm volatile("s_waitcnt vmcnt(0)" ::: "memory");
        } else {
            XB_SPIN(xb_ld(&bar[XB_XGEN(b.x)]) == gen, bar);
            __builtin_amdgcn_fence(__ATOMIC_ACQUIRE, "agent");
            asm volatile("s_waitcnt vmcnt(0)" ::: "memory");
        }
    }
    __syncthreads();
}

struct Args {
    const float* in[20];
    float* out; unsigned char* ws;
    int ph_lo, ph_hi;
};
struct Frame {
    unsigned char* lds;
    int tid, lane, wave, G, gw, NGW;
};

template <class Map>
DI void transpose_item(const float* __restrict__ W, int Nsrc, bf16_t* __restrict__ WT, int ldk, float* scr, int item, int nblk, int lane, Map srcmap, const float* __restrict__ rowscale = nullptr) {
    const int kb = item / nblk, nb = item % nblk, k0 = 64 * kb, n0 = 32 * nb;
    const int ns = srcmap(n0 + (lane & 31));
    float vv[32];
#pragma unroll
    for (int i = 0; i < 32; ++i) { const int kk = 2 * i + (lane >> 5); vv[i] = (ns >= 0) ? W[(size_t)(k0 + kk) * Nsrc + ns] : 0.f; }
    if (rowscale) {
#pragma unroll
        for (int i = 0; i < 32; ++i) vv[i] *= rowscale[k0 + 2 * i + (lane >> 5)];
    }
#pragma unroll
    for (int i = 0; i < 32; ++i) { const int kk = 2 * i + (lane >> 5); scr[kk * 33 + (lane & 31)] = vv[i]; }
    __builtin_amdgcn_s_waitcnt(0); __builtin_amdgcn_wave_barrier();
    const int c = lane & 7;
#pragma unroll
    for (int j = 0; j < 4; ++j) { const int n = (lane >> 3) + 8 * j; const float* s = scr + (8 * c) * 33 + n;
        u32x4 o; o.x = pk2(s[0 * 33], s[1 * 33]); o.y = pk2(s[2 * 33], s[3 * 33]); o.z = pk2(s[4 * 33], s[5 * 33]); o.w = pk2(s[6 * 33], s[7 * 33]);
        *(u32x4*)(WT + (size_t)(n0 + n) * ldk + k0 + 8 * c) = o; }
    __builtin_amdgcn_s_waitcnt(0); __builtin_amdgcn_wave_barrier();
}
struct MapId { DI int operator()(int n) const { return n; } };
struct MapWin {
    DI int operator()(int n) const {
        if (n < 2048) return n;
        if (n < 2304) return n + 16;
        if (n < 2432) return n + 16;
        if (n < 2464) return n + 16;
        if (n < 2472) return n - 416;
        if (n < 2480) return n - 416;
        return -1;
    }
};

template <int PART> DI void p0_late_weights(const Frame& F, const Args& A, int wi, int nwv, int ti, int nth) {
    unsigned char* ws = A.ws;
    float* scr = (float*)(F.lds + F.wave * 16384);
    const float* w_uq = A.in[10]; const float* w_ukv = A.in[11]; const float* w_out = A.in[14]; const float* w_pq = A.in[16]; const float* sub_keys = A.in[17];
    constexpr int I_UQ = 4 * 24, I_UKV = 2 * 32, I_OUT = 16 * 32, I_PQ = 16 * 64;
    constexpr int NITEMS = I_UQ + I_UKV + I_OUT + I_PQ;
    const int lo_ = PART == 0 ? 0 : I_UQ + I_UKV, hi_ = PART == 0 ? I_UQ + I_UKV : NITEMS;
    for (int it = lo_ + wi; it < hi_; it += nwv) {
        int r = it;
        if (r < I_UQ) { transpose_item(w_uq, 768, (bf16_t*)(ws + WS_WUQ), 256, scr, r, 24, F.lane, MapId(), A.in[8]); continue; } r -= I_UQ;
        if (r < I_UKV) { transpose_item(w_ukv, 1024, (bf16_t*)(ws + WS_WUKV), 256, scr, r, 32, F.lane, MapId(), A.in[9]); continue; } r -= I_UKV;
        if (r < I_OUT) { transpose_item(w_out, 1024, (bf16_t*)(ws + WS_WOUT), 1024, scr, r, 32, F.lane, MapId()); continue; } r -= I_OUT;
        transpose_item(w_pq, 2048, (bf16_t*)(ws + WS_WPQ), 1024, scr, r, 64, F.lane, MapId(), A.in[15]);
    }
    const int gt = ti, NGT = nth;
    if (PART == 0) for (int i = gt; i < 1024 * 16; i += NGT) { const int n = i >> 4, c = i & 15; *(u32x4*)((bf16_t*)(ws + WS_WUKV) + (size_t)n * 256 + 128 + c * 8) = (u32x4){0u, 0u, 0u, 0u}; }
    if (PART == 1) for (int i = gt; i < 2048 * 32; i += NGT) {
        const int n = i >> 5, c8 = (i & 31) * 8; const int p = (n >> 7) & 1;
        u32x4 o = (u32x4){0u, 0u, 0u, 0u};
        if ((c8 >> 7) == p) { const float* s = sub_keys + (size_t)n * 128 + (c8 & 127); const f32x4 a = *(const f32x4*)s, b = *(const f32x4*)(s + 4);
            o.x = pk2(a.x, a.y); o.y = pk2(a.z, a.w); o.z = pk2(b.x, b.y); o.w = pk2(b.z, b.w); }
        *(u32x4*)((bf16_t*)(ws + WS_SKB) + (size_t)n * 256 + c8) = o;
    }
}

DI void p0_prologue(const Frame& F, const Args& A) {
    unsigned char* ws = A.ws;
    float* scr = (float*)(F.lds + F.wave * 16384);
    const float* w_in = A.in[3]; const float* w_uq = A.in[10]; const float* w_ukv = A.in[11]; const float* w_out = A.in[14]; const float* w_pq = A.in[16]; const float* sub_keys = A.in[17];
    constexpr int I_IN = 16 * 80;
    for (int it = F.wave * F.G + blockIdx.x; it < I_IN; it += F.NGW) transpose_item(w_in, 2480, (bf16_t*)(ws + WS_WIN), 1024, scr, it, 80, F.lane, MapWin());
    const float* x = A.in[0]; const float* meta = A.in[1]; const float* anorm = A.in[2];
    bf16_t* HN = (bf16_t*)(ws + WS_HN);
    for (int p0 = F.gw; p0 < MP; p0 += 3 * F.NGW) {
        f32x4 v[3][4]; bool ok[3];
#pragma unroll
        for (int r = 0; r < 3; ++r) {
            const int p = p0 + r * F.NGW, t = p - PADL; ok[r] = (p < MP) && t >= 0 && t < NTOK;
            if (ok[r]) { const float* src = (t < 16) ? meta + (size_t)t * DM : x + (size_t)(t - 16) * DM; const f32x4* xr = (const f32x4*)src + F.lane;
#pragma unroll
                for (int j = 0; j < 4; ++j) v[r][j] = xr[64 * j]; }
            else {
#pragma unroll
                for (int j = 0; j < 4; ++j) v[r][j] = (f32x4){0.f, 0.f, 0.f, 0.f}; }
        }
#pragma unroll
        for (int r = 0; r < 3; ++r) {
            const int p = p0 + r * F.NGW; if (p >= MP) continue;
            unsigned long long* o8 = (unsigned long long*)(HN + (size_t)p * DM) + F.lane;
            float s = 0.f;
#pragma unroll
            for (int j = 0; j < 4; ++j) s += (v[r][j].x * v[r][j].x + v[r][j].y * v[r][j].y) + (v[r][j].z * v[r][j].z + v[r][j].w * v[r][j].w);
            const float rstd = ok[r] ? 1.f / sqrtf(wave_sum(s) * (1.f / DM) + EPS) : 0.f;
#pragma unroll
            for (int j = 0; j < 4; ++j) { const f32x4 w = ((const f32x4*)anorm)[64 * j + F.lane];
                o8[64 * j] = (unsigned long long)pk2(v[r][j].x * rstd * w.x, v[r][j].y * rstd * w.y) | ((unsigned long long)pk2(v[r][j].z * rstd * w.z, v[r][j].w * rstd * w.w) << 32); }
        }
    }
}

DI void row_ss_store(const f32x4 (&v)[2][2][4][2], float* SSP, int nslot, int slot, int row0, int fq, bool bj0_only) {
#pragma unroll
    for (int ai = 0; ai < 2; ++ai)
#pragma unroll
        for (int m = 0; m < 4; ++m) {
            float s = 0.f;
#pragma unroll
            for (int bj = 0; bj < 2; ++bj) if (bj == 0 || !bj0_only)
#pragma unroll
                for (int n = 0; n < 2; ++n) { const f32x4 x = v[ai][bj][m][n]; s += (x[0] * x[0] + x[1] * x[1]) + (x[2] * x[2] + x[3] * x[3]); }
            s += __shfl_xor(s, 16); s += __shfl_xor(s, 32);
            if (fq == 0) SSP[(size_t)(row0 + ai * 128 + m * 16) * nslot + slot] = s;
        }
}
DI float ss_sum4(const float* SSP, int row) { const f32x4 a = *(const f32x4*)(SSP + (size_t)row * 4); return (a.x + a.y) + (a.z + a.w); }
DI float ss_sum16(const float* SSP, int row) { const f32x4 a = *(const f32x4*)(SSP + (size_t)row * 16), b = *(const f32x4*)(SSP + (size_t)row * 16 + 4), c = *(const f32x4*)(SSP + (size_t)row * 16 + 8), d = *(const f32x4*)(SSP + (size_t)row * 16 + 12);
    return (((a.x + a.y) + (a.z + a.w)) + ((b.x + b.y) + (b.z + b.w))) + (((c.x + c.y) + (c.z + c.w)) + ((d.x + d.y) + (d.z + d.w))); }
struct EpiProj {
    static constexpr bool PERM = true;
    bf16_t* QKVR; bf16_t* Z; float* BA; bf16_t* CQ16; bf16_t* CKV16; float* KPE; float* SSQ; float* SSK;
    DI void operator()(const f32x4 (&acc)[2][2][4][2], const pg8::Unit& u, int wr, int wc, int fr, int fq) const {
        const int row0 = u.pm * 256 + wr * 64 + fr;
        if (u.pn < 8) {
            bf16_t* base; int ld, colt;
            if (u.pn < 6) { base = QKVR; ld = 1536; colt = u.pn * 256; } else { base = Z; ld = 512; colt = (u.pn - 6) * 256; }
            const int col0 = colt + wc * 32 + 8 * fq;
#pragma unroll
            for (int ai = 0; ai < 2; ++ai)
#pragma unroll
                for (int m = 0; m < 4; ++m) { bf16_t* rowp = base + (size_t)(row0 + ai * 128 + m * 16) * ld + col0;
#pragma unroll
                    for (int bj = 0; bj < 2; ++bj) { const f32x4 v0 = acc[ai][bj][m][0], v1 = acc[ai][bj][m][1];
                        u32x4 w; w.x = pg8::cvt_pk_bf16(v0[0], v0[1]); w.y = pg8::cvt_pk_bf16(v0[2], v0[3]); w.z = pg8::cvt_pk_bf16(v1[0], v1[1]); w.w = pg8::cvt_pk_bf16(v1[2], v1[3]);
                        *(u32x4*)(rowp + bj * 128) = w; } }
        } else {
            const int lcol0 = wc * 32 + 8 * fq;
            bf16_t* b16 = (u.pn == 8) ? CQ16 : CKV16;
#pragma unroll
            for (int ai = 0; ai < 2; ++ai)
#pragma unroll
                for (int m = 0; m < 4; ++m) { const size_t row = (size_t)(row0 + ai * 128 + m * 16);
#pragma unroll
                    for (int bj = 0; bj < 2; ++bj) { const f32x4 v0 = acc[ai][bj][m][0], v1 = acc[ai][bj][m][1];
                        u32x4 w; w.x = pg8::cvt_pk_bf16(v0[0], v0[1]); w.y = pg8::cvt_pk_bf16(v0[2], v0[3]); w.z = pg8::cvt_pk_bf16(v1[0], v1[1]); w.w = pg8::cvt_pk_bf16(v1[2], v1[3]);
                        *(u32x4*)(b16 + row * 256 + lcol0 + bj * 128) = w;
                        if (u.pn == 9 && bj == 1 && wc == 0) { *(f32x4*)(KPE + row * 32 + 8 * fq) = v0; *(f32x4*)(KPE + row * 32 + 8 * fq + 4) = v1; }
                        if (u.pn == 9 && bj == 1 && wc == 1 && fq < 2) { *(f32x4*)(BA + row * 16 + 8 * fq) = v0; *(f32x4*)(BA + row * 16 + 8 * fq + 4) = v1; }
                    } }
            row_ss_store(acc, (u.pn == 8) ? SSQ : SSK, 4, wc, row0, fq, u.pn == 9);
        }
    }
};
struct EpiB16 {
    static constexpr bool PERM = true;
    bf16_t* O; int ldc; const float* SS; float invn; int nslot;
    DI void operator()(const f32x4 (&acc)[2][2][4][2], const pg8::Unit& u, int wr, int wc, int fr, int fq) const {
        const int row0 = u.pm * 256 + wr * 64 + fr, col0 = u.pn * 256 + wc * 32 + 8 * fq;
#pragma unroll
        for (int ai = 0; ai < 2; ++ai)
#pragma unroll
            for (int m = 0; m < 4; ++m) { const int row = row0 + ai * 128 + m * 16; bf16_t* rowp = O + (size_t)row * ldc + col0;
                const float rs = SS ? 1.f / sqrtf((nslot == 16 ? ss_sum16(SS, row) : ss_sum4(SS, row)) * invn + EPS) : 1.f;
#pragma unroll
                for (int bj = 0; bj < 2; ++bj) { const f32x4 v0 = acc[ai][bj][m][0] * rs, v1 = acc[ai][bj][m][1] * rs;
                    u32x4 w; w.x = pg8::cvt_pk_bf16(v0[0], v0[1]); w.y = pg8::cvt_pk_bf16(v0[2], v0[3]); w.z = pg8::cvt_pk_bf16(v1[0], v1[1]); w.w = pg8::cvt_pk_bf16(v1[2], v1[3]);
                    *(u32x4*)(rowp + bj * 128) = w; } }
    }
};
struct EpiH1 {
    static constexpr bool PERM = true;
    float* C; const float* res; bf16_t* H16; float* SS;
    DI void operator()(const f32x4 (&acc)[2][2][4][2], const pg8::Unit& u, int wr, int wc, int fr, int fq) const {
        const int row0 = u.pm * 256 + wr * 64 + fr, col0 = u.pn * 256 + wc * 32 + 8 * fq;
        f32x4 v[2][2][4][2];
#pragma unroll
        for (int ai = 0; ai < 2; ++ai)
#pragma unroll
            for (int m = 0; m < 4; ++m) { const size_t off = (size_t)(row0 + ai * 128 + m * 16) * 1024 + col0;
#pragma unroll
                for (int bj = 0; bj < 2; ++bj) { const f32x4 v0 = acc[ai][bj][m][0] + *(const f32x4*)(res + off + bj * 128), v1 = acc[ai][bj][m][1] + *(const f32x4*)(res + off + bj * 128 + 4);
                    v[ai][bj][m][0] = v0; v[ai][bj][m][1] = v1;
                    u32x4 w; w.x = pg8::cvt_pk_bf16(v0[0], v0[1]); w.y = pg8::cvt_pk_bf16(v0[2], v0[3]); w.z = pg8::cvt_pk_bf16(v1[0], v1[1]); w.w = pg8::cvt_pk_bf16(v1[2], v1[3]);
                    *(u32x4*)(H16 + off + bj * 128) = w; } }
        row_ss_store(v, SS, 16, u.pn * 4 + wc, row0, fq, false);
    }
};
struct EpiF32 {
    static constexpr bool PERM = true;
    float* C; int ldc; const float* res;
    DI void operator()(const f32x4 (&acc)[2][2][4][2], const pg8::Unit& u, int wr, int wc, int fr, int fq) const {
        const int row0 = u.pm * 256 + wr * 64 + fr, col0 = u.pn * 256 + wc * 32 + 8 * fq;
#pragma unroll
        for (int ai = 0; ai < 2; ++ai)
#pragma unroll
            for (int m = 0; m < 4; ++m) { const size_t off = (size_t)(row0 + ai * 128 + m * 16) * ldc + col0;
#pragma unroll
                for (int bj = 0; bj < 2; ++bj) { f32x4 v0 = acc[ai][bj][m][0], v1 = acc[ai][bj][m][1];
                    if (res) { v0 += *(const f32x4*)(res + off + bj * 128); v1 += *(const f32x4*)(res + off + bj * 128 + 4); }
                    *(f32x4*)(C + off + bj * 128) = v0; *(f32x4*)(C + off + bj * 128 + 4) = v1; } }
    }
};

DI f32x16 mfma32(bf16x8 a, bf16x8 b, f32x16 c) { return __builtin_amdgcn_mfma_f32_32x32x16_bf16(a, b, c, 0, 0, 0); }
DI f32x4 mfma16(bf16x8 a, bf16x8 b, f32x4 c) { return __builtin_amdgcn_mfma_f32_16x16x32_bf16(a, b, c, 0, 0, 0); }
DI int crow(int r, int hi) { return (r & 3) + 8 * (r >> 2) + 4 * hi; }
DI f32x16 zero16() { f32x16 z;
#pragma unroll
    for (int i = 0; i < 16; ++i) z[i] = 0.f; return z; }

constexpr int G_KF = 0, G_VF = 16384, G_MF = 32768;
constexpr int G_QB = 50176, G_KB = 59392, G_KBB = 68608;
constexpr int G_QKB = 77824, G_UT = 87040, G_WT = 96256, G_KDT = 105472;
constexpr int G_VEC = 114688;
constexpr int G_RAW = G_QKB;
constexpr int GST = 72;

DI f32x16 mm_quad(const unsigned char* A, const unsigned char* Bt, int qr, int qc, int lane) {
    const int r32 = lane & 31, hh = lane >> 5;
    const unsigned char* ap = A + (32 * qr + r32) * (GST * 2) + hh * 16;
    const unsigned char* bp = Bt + (32 * qc + r32) * (GST * 2) + hh * 16;
    f32x16 acc = zero16();
#pragma unroll
    for (int s = 0; s < 4; ++s) acc = mfma32(*(const bf16x8*)(ap + s * 32), *(const bf16x8*)(bp + s * 32), acc);
    return acc;
}

constexpr int G_RAW2 = 115712;
static_assert(G_RAW2 + 67 * 400 <= 143360, "GDN prep LDS map");
constexpr int G_CONVW = 143360 + 512;

#ifndef PROBE_STAGE
#define PROBE_STAGE -1
#endif
template <int VAR> DI void gdn_prep_phase(const Frame& F, const Args& A) {
    unsigned long long stg_t = 0ull, stg_acc = 0ull;
#define STG(n) do { if (PROBE_STAGE >= 0) { const unsigned long long now_ = __builtin_amdgcn_s_memrealtime(); if (PROBE_STAGE == (n)) stg_acc += now_ - stg_t; stg_t = now_; } } while (0)
    unsigned char* ws = A.ws; unsigned char* lds = F.lds;
    const int tid = F.tid, lane = F.lane, wave = F.wave;
    const bf16_t* QKVR = (const bf16_t*)(ws + WS_QKVR); const float* BA = (const float*)(ws + WS_BA);
    float* KF = (float*)(lds + G_KF); float* VF = (float*)(lds + G_VF); float* MF = (float*)(lds + G_MF);
    float* VEC = (float*)(lds + G_VEC);
    if (VAR == 6) return;
    const int NIT = NCHUNK * 8;
#define LBAR() do { asm volatile("s_waitcnt lgkmcnt(0)" ::: "memory"); __builtin_amdgcn_s_barrier(); asm volatile("" ::: "memory"); } while (0)
#define LAUNDER(dst, src) int dst = (src); asm volatile("" : "+v"(dst))
    int item = blockIdx.x;
    if (item >= NIT) return;
    u32x4 pr[4]; float nb = 0.f, na = 0.f;
    auto raw_fetch = [&](int it) {
        const int c = it >> 3, h = it & 7; LAUNDER(tl, tid);
#pragma unroll
        for (int i = 0; i < 4; ++i) { const int q = tl + 512 * i; pr[i] = (u32x4){0u, 0u, 0u, 0u};
            if (q < 67 * 24) { const int r = q / 24, cc = q % 24, seg = cc >> 3, c8 = cc & 7; const int p = 64 * c - 3 + r;
                if (p >= 0) pr[i] = *(const u32x4*)(QKVR + (size_t)p * 1536 + seg * 512 + h * 64 + c8 * 8); } }
        if (wave == 0) { const int p = 64 * c + lane; nb = BA[(size_t)p * 16 + h]; na = BA[(size_t)p * 16 + 8 + h]; }
    };
    auto raw_park = [&]() {
        LAUNDER(tl, tid);
#pragma unroll
        for (int i = 0; i < 4; ++i) { const int q = tl + 512 * i;
            if (q < 67 * 24) { const int r = q / 24, cc = q % 24, seg = cc >> 3, c8 = cc & 7; *(u32x4*)(lds + G_RAW2 + r * 400 + (seg * 64 + c8 * 8) * 2) = pr[i]; } }
    };
    raw_fetch(item); raw_park();
    float cb = nb, ca = na;
    float* CWL = (float*)(lds + G_CONVW);
    int cw_h = -1;
#pragma unroll 1
    for (; item < NIT; item += F.G) {
        if (PROBE_STAGE >= 0 && stg_t == 0ull) stg_t = __builtin_amdgcn_s_memrealtime();
        const int c = item >> 3, h = item & 7;
        if (h != cw_h) { cw_h = h;
            if (tid < 192) { LAUNDER(t0, tid); const int sg = t0 >> 6, jt = (t0 >> 4) & 3, c4 = t0 & 15; *(f32x4*)(CWL + (sg * 4 + jt) * 64 + 4 * c4) = *(const f32x4*)(A.in[4] + jt * 1536 + sg * 512 + h * 64 + 4 * c4); } }
        const int nxt = item + F.G;
        if (VAR != 5 && nxt < NIT) raw_fetch(nxt);
        if (wave == 0) {
            const int p = 64 * c + lane;
            const float alog = A.in[5][h], dtb = A.in[6][h];
            float beta = sigmoidf_(cb);
            const float xx = ca + dtb; const float sp = xx > 20.f ? xx : log1pf(__expf(xx));
            float g = -__expf(alog) * sp;
            if (p < PADL) { beta = 0.f; g = 0.f; }
            float gc = g;
#pragma unroll
            for (int o = 1; o < 64; o <<= 1) { const float t = __shfl_up(gc, o); if (lane >= o) gc += t; }
            const float glast = __shfl(gc, 63);
            VEC[lane] = gc; VEC[64 + lane] = beta; VEC[128 + lane] = __expf(gc); VEC[192 + lane] = __expf(glast - gc);
        }
        LBAR(); STG(0);
        LAUNDER(t1, tid); const int sub = t1 & 15, grp = t1 >> 4;
#pragma unroll
        for (int sg = 0; sg < ((VAR == 2 || VAR >= 4) ? 0 : 3); ++sg) {
#pragma unroll
            for (int ps = 0; ps < 2; ++ps) {
                const int i = grp + 32 * ps;
                float acc[4] = {0.f, 0.f, 0.f, 0.f};
#pragma unroll
                for (int jt = 0; jt < 4; ++jt) {
                    const f32x4 w = *(const f32x4*)(CWL + (sg * 4 + jt) * 64 + 4 * sub);
                    const u32x2 rv = *(const u32x2*)(lds + G_RAW2 + (i + jt) * 400 + (sg * 64 + 4 * sub) * 2);
                    acc[0] += w.x * bflo(rv.x); acc[1] += w.y * bfhi(rv.x); acc[2] += w.z * bflo(rv.y); acc[3] += w.w * bfhi(rv.y);
                }
                float y[4];
#pragma unroll
                for (int k = 0; k < 4; ++k) y[k] = siluf_(acc[k]);
                if (sg < 2) {
                    float ss = (y[0] * y[0] + y[1] * y[1]) + (y[2] * y[2] + y[3] * y[3]);
                    ss += __shfl_xor(ss, 1); ss += __shfl_xor(ss, 2); ss += __shfl_xor(ss, 4); ss += __shfl_xor(ss, 8);
                    const float rn = 1.f / sqrtf(ss + EPS);
#pragma unroll
                    for (int k = 0; k < 4; ++k) y[k] *= rn;
                }
                if (sg == 0) {
                    u32x2 o; o.x = pk2(y[0] * 0.125f, y[1] * 0.125f); o.y = pk2(y[2] * 0.125f, y[3] * 0.125f);
                    *(u32x2*)(lds + G_QB + i * (GST * 2) + 8 * sub) = o;
                } else if (sg == 1) {
                    const float beta = VEC[64 + i], ekd = VEC[192 + i];
                    *(f32x4*)(KF + i * 64 + 4 * sub) = (f32x4){y[0], y[1], y[2], y[3]};
                    u32x2 o; o.x = pk2(y[0], y[1]); o.y = pk2(y[2], y[3]);
                    *(u32x2*)(lds + G_KB + i * (GST * 2) + 8 * sub) = o;
                    o.x = pk2(y[0] * beta, y[1] * beta); o.y = pk2(y[2] * beta, y[3] * beta);
                    *(u32x2*)(lds + G_KBB + i * (GST * 2) + 8 * sub) = o;
#pragma unroll
                    for (int k = 0; k < 4; ++k) *(bf16_t*)(lds + G_KDT + (4 * sub + k) * (GST * 2) + i * 2) = (bf16_t)f2bf(y[k] * ekd);
                } else {
                    *(f32x4*)(VF + i * 64 + 4 * sub) = (f32x4){y[0], y[1], y[2], y[3]};
                }
            }
        }
        LBAR(); STG(1);
        if (VAR != 3 && VAR < 4) {
            LAUNDER(l3, lane);
            const int prod = wave >> 2, quad = wave & 3, qr = quad >> 1, qc = quad & 1, r32 = l3 & 31, hh = l3 >> 5;
            const f32x16 acc = mm_quad(lds + (prod ? G_QB : G_KBB), lds + G_KB, qr, qc, l3);
            const int j = 32 * qc + r32; const float gcj = VEC[j];
#pragma unroll
            for (int r = 0; r < 16; ++r) {
                const int i = 32 * qr + crow(r, hh);
                if (prod == 0) { MF[i * 68 + j] = (j < i) ? acc[r] * __expf(VEC[i] - gcj) : 0.f; }
                else { *(bf16_t*)(lds + G_QKB + i * (GST * 2) + j * 2) = (bf16_t)f2bf((j <= i) ? acc[r] * __expf(VEC[i] - gcj) : 0.f); }
            }
        }
        LBAR(); STG(2);
        float* DB = (float*)(lds + G_KBB);
        if (VAR != 1 && VAR < 4 && wave == 0) {
            LAUNDER(l4, lane); const int b = l4 >> 4, jc = l4 & 15;
            float d[16];
#pragma unroll
            for (int i = 0; i < 16; ++i) {
                float acc = (i == jc) ? 1.f : 0.f;
                const float* mrow = MF + (16 * b + i) * 68 + 16 * b;
#pragma unroll
                for (int k = 0; k < i; ++k) acc -= mrow[k] * d[k];
                d[i] = acc;
            }
#pragma unroll
            for (int i = 0; i < 16; ++i) DB[(b * 16 + i) * 20 + jc] = d[i];
        }
        LBAR();
        if (VAR != 1 && VAR < 4) {
            LAUNDER(l4, lane); const int cc = l4 & 15, g = l4 >> 4;
            const bool isU = wave < 4; const int col = 16 * (wave & 3) + cc;
            const float* src = (isU ? VF : KF) + col;
            f32x4 X[4];
#pragma unroll
            for (int b = 0; b < 4; ++b) {
                f32x4 acc;
#pragma unroll
                for (int r = 0; r < 4; ++r) { const int i = 16 * b + 4 * g + r; float rv = src[i * 64] * VEC[64 + i]; if (!isU) rv *= VEC[128 + i]; acc[r] = -rv; }
#pragma unroll
                for (int a = 0; a < b; ++a) {
                    const f32x4 lv = *(const f32x4*)(MF + (16 * b + cc) * 68 + 16 * a + 4 * g);
#pragma unroll
                    for (int sp = 0; sp < 4; ++sp) acc = __builtin_amdgcn_mfma_f32_16x16x4f32(lv[sp], X[a][sp], acc, 0, 0, 0);
                }
                const f32x4 dv = *(const f32x4*)(DB + (b * 16 + cc) * 20 + 4 * g);
                f32x4 xb = (f32x4){0.f, 0.f, 0.f, 0.f};
#pragma unroll
                for (int sp = 0; sp < 4; ++sp) xb = __builtin_amdgcn_mfma_f32_16x16x4f32(dv[sp], acc[sp], xb, 0, 0, 0);
                X[b] = -xb;
                unsigned char* dst = lds + (isU ? G_UT : G_WT) + col * (GST * 2) + (16 * b + 4 * g) * 2;
                *(u32x2*)dst = (u32x2){pk2(X[b][0], X[b][1]), pk2(X[b][2], X[b][3])};
            }
        }
        LBAR(); STG(3);
        if (VAR != 3 && VAR < 4) {
            const float gl = VEC[128 + 63];
            bf16_t* GB = (bf16_t*)(ws + WS_GB) + (size_t)item * 4096;
            bf16_t* GQ = (bf16_t*)(ws + (VAR ? WS_GS : WS_GQ)) + (size_t)item * 4096; bf16_t* GO = (bf16_t*)(ws + (VAR ? WS_GS : WS_GO)) + (size_t)item * 4096;
            bf16_t* GAL = (bf16_t*)(lds + G_MF);
            LAUNDER(l5, lane); const int r32 = l5 & 31, hh = l5 >> 5;
#pragma unroll 1
            for (int it = 0; it < 2; ++it) {
                const int task = wave + 8 * it, prod = task >> 2, quad = task & 3, qr = quad >> 1, qc = quad & 1;
                const f32x16 acc = mm_quad(lds + (prod < 2 ? G_KDT : G_QKB), lds + ((prod & 1) ? G_UT : G_WT), qr, qc, l5);
                const int Cc = 32 * qc + r32;
                if (prod == 0) {
#pragma unroll
                    for (int r = 0; r < 16; ++r) {
                        const int R = 32 * qr + crow(r, hh);
                        const float val = ((R == Cc) ? gl : 0.f) - acc[r];
                        const int rb = R >> 4, m = R & 15, q4 = Cc >> 4, g = (Cc >> 2) & 3, rr = Cc & 3, ks = q4 >> 1, jj = 4 * (q4 & 1) + rr, ls = 16 * g + m;
                        GAL[((rb * 2 + ks) * 64 + ls) * 8 + jj] = (bf16_t)f2bf(val);
                    }
                } else if (prod == 1) {
                    const int eslab = Cc >> 4, n = Cc & 15;
#pragma unroll
                    for (int a = 0; a < 4; ++a) {
                        const int R0 = 32 * qr + 8 * a + 4 * hh; const int rb = R0 >> 4, g = (R0 >> 2) & 3, ls = 16 * g + n;
                        *(u32x2*)(GB + ((eslab * 4 + rb) * 64 + ls) * 4) = (u32x2){pk2(acc[4 * a], acc[4 * a + 1]), pk2(acc[4 * a + 2], acc[4 * a + 3])};
                    }
                } else if (prod == 2) {
#pragma unroll
                    for (int r = 0; r < 16; ++r) {
                        const int R = 32 * qr + crow(r, hh);
                        const float qv = bf2f(*(const bf16_t*)(lds + G_QB + R * (GST * 2) + Cc * 2));
                        GQ[R * 64 + Cc] = (bf16_t)f2bf(qv * VEC[128 + R] - acc[r]);
                    }
                } else {
#pragma unroll
                    for (int r = 0; r < 16; ++r) GO[(quad * 16 + r) * 64 + l5] = (bf16_t)f2bf(acc[r]);
                }
            }
        }
        if (VAR != 5 && nxt < NIT) { raw_park(); cb = nb; ca = na; }
        LBAR(); STG(4);
        if (VAR != 5) { LAUNDER(t6, tid); *(u32x4*)((bf16_t*)(ws + (VAR ? WS_GS : WS_GA)) + (size_t)item * 4096 + t6 * 8) = *(const u32x4*)(lds + G_MF + t6 * 16); }
        STG(5);
    }
    if (PROBE_STAGE >= 0 && tid == 0) { *(unsigned long long*)(lds + 143360 + 96) = stg_acc; }
}

constexpr int SC_D = 8, SC_PD = 6, SC_SLOT = 10240;
DI void gdn_scan(const Frame& F, const Args& A) {
    if (blockIdx.x >= 32) return;
    unsigned char* ws = A.ws;
    const int h = blockIdx.x & 7, eslab = blockIdx.x >> 3, lane = F.lane, wave = F.wave, n = lane & 15, g = lane >> 4;
    const unsigned char* GA = ws + WS_GA; const unsigned char* GB = ws + WS_GB; bf16_t* GS = (bf16_t*)(ws + WS_GS);
    LAS unsigned char* ring = (LAS unsigned char*)F.lds;
    const int np = (wave == 0) ? 0 : ((wave - 1 < 3) ? 2 : 1);
    auto issue = [&](int c) {
        const int cc = c < NCHUNK ? c : NCHUNK - 1;
        const size_t item = (size_t)cc * 8 + h;
        LAS unsigned char* slot = ring + (c % SC_D) * SC_SLOT;
#pragma unroll
        for (int i = 0; i < 2; ++i) if (i < np) {
            const int q = (wave - 1) + 7 * i;
            const unsigned char* src = (q < 8) ? GA + item * 8192 + q * 1024 : GB + item * 8192 + eslab * 2048 + (q - 8) * 1024;
            LAS unsigned char* dst = slot + ((q < 8) ? q * 1024 : 8192 + (q - 8) * 1024);
            __builtin_amdgcn_global_load_lds((const unsigned*)(src + lane * 16), (LAS unsigned*)dst, 16, 0, 0);
        }
    };
    for (int c = 0; c < SC_PD; ++c) issue(c);
    f32x4 S[4];
#pragma unroll
    for (int rb = 0; rb < 4; ++rb) S[rb] = (f32x4){0.f, 0.f, 0.f, 0.f};
#pragma unroll 1
    for (int c = 0; c < NCHUNK; ++c) {
        issue(c + SC_PD);
        if (np == 2) asm volatile("s_waitcnt vmcnt(12)" ::: "memory");
        else if (np == 1) asm volatile("s_waitcnt vmcnt(6)" ::: "memory");
        asm volatile("s_waitcnt lgkmcnt(0)" ::: "memory");
        __builtin_amdgcn_s_barrier();
        asm volatile("" ::: "memory");
        if (wave == 0) {
            const LAS unsigned char* slot = ring + (c % SC_D) * SC_SLOT;
            bf16x8 ac[8]; f32x4 bc[4];
#pragma unroll
            for (int q = 0; q < 8; ++q) ac[q] = *(const LAS bf16x8*)(slot + q * 1024 + lane * 16);
#pragma unroll
            for (int rb = 0; rb < 4; ++rb) { const u32x2 w = *(const LAS u32x2*)(slot + 8192 + rb * 512 + lane * 8); bc[rb] = (f32x4){bflo(w.x), bfhi(w.x), bflo(w.y), bfhi(w.y)}; }
            const size_t item = (size_t)c * 8 + h;
            u32x4 p0, p1;
            p0.x = pk2(S[0][0], S[0][1]); p0.y = pk2(S[0][2], S[0][3]); p0.z = pk2(S[1][0], S[1][1]); p0.w = pk2(S[1][2], S[1][3]);
            p1.x = pk2(S[2][0], S[2][1]); p1.y = pk2(S[2][2], S[2][3]); p1.z = pk2(S[3][0], S[3][1]); p1.w = pk2(S[3][2], S[3][3]);
            {
                bf16_t* st = GS + item * 4096 + (16 * eslab + n) * 64 + 4 * g;
                *(u32x2*)(st + 0) = (u32x2){p0.x, p0.y}; *(u32x2*)(st + 16) = (u32x2){p0.z, p0.w};
                *(u32x2*)(st + 32) = (u32x2){p1.x, p1.y}; *(u32x2*)(st + 48) = (u32x2){p1.z, p1.w};
            }
            const bf16x8 b0 = __builtin_bit_cast(bf16x8, p0), b1 = __builtin_bit_cast(bf16x8, p1);
#pragma unroll
            for (int rb = 0; rb < 4; ++rb) {
                f32x4 acc = bc[rb];
                acc = mfma16(ac[rb * 2 + 0], b0, acc);
                acc = mfma16(ac[rb * 2 + 1], b1, acc);
                S[rb] = acc;
            }
        }
    }
    asm volatile("s_waitcnt vmcnt(0) lgkmcnt(0)" ::: "memory");
    __builtin_amdgcn_s_barrier();
    if (F.tid == 0) { __builtin_amdgcn_fence(__ATOMIC_RELEASE, "agent"); (void)xb_add((unsigned*)(ws + WS_CTL) + CW_SCANDONE, 1u); }
}

DI void gdn_out_task(const Frame& F, const Args& A, int task) {
    unsigned char* ws = A.ws;
    const int ihalf = task & 1, item = (task >> 1) + 8, c = item >> 3, h = item & 7, lane = F.lane, r32 = lane & 31, hh = lane >> 5;
    const bf16_t* GQ = (const bf16_t*)(ws + WS_GQ) + (size_t)item * 4096; const bf16_t* GS = (const bf16_t*)(ws + WS_GS) + (size_t)item * 4096;
    const bf16_t* GO = (const bf16_t*)(ws + WS_GO) + (size_t)item * 4096;
    const bf16_t* Z = (const bf16_t*)(ws + WS_Z); bf16_t* MIX = (bf16_t*)(ws + WS_MIX);
    f32x16 acc[2];
#pragma unroll
    for (int eh = 0; eh < 2; ++eh)
#pragma unroll
        for (int r = 0; r < 16; ++r) acc[eh][r] = bf2f(GO[((ihalf * 2 + eh) * 16 + r) * 64 + lane]);
#pragma unroll
    for (int s = 0; s < 4; ++s) {
        const bf16x8 a = *(const bf16x8*)(GQ + (32 * ihalf + r32) * 64 + 16 * s + 8 * hh);
#pragma unroll
        for (int eh = 0; eh < 2; ++eh) {
            const bf16x8 b = *(const bf16x8*)(GS + (32 * eh + r32) * 64 + 16 * s + 8 * hh);
            acc[eh] = mfma32(a, b, acc[eh]);
        }
    }
    const float* gnorm = A.in[7];
    const float w0 = gnorm[r32], w1 = gnorm[32 + r32];
#pragma unroll
    for (int r = 0; r < 16; ++r) {
        float ss = acc[0][r] * acc[0][r] + acc[1][r] * acc[1][r];
        ss += __shfl_xor(ss, 1); ss += __shfl_xor(ss, 2); ss += __shfl_xor(ss, 4); ss += __shfl_xor(ss, 8); ss += __shfl_xor(ss, 16);
        const float rstd = 1.f / sqrtf(ss * (1.f / 64.f) + EPS);
        const int i = 32 * ihalf + crow(r, hh); const int p = 64 * c + i;
        const float z0 = bf2f(Z[(size_t)p * 512 + h * 64 + r32]), z1 = bf2f(Z[(size_t)p * 512 + h * 64 + 32 + r32]);
        bf16_t* o = MIX + (size_t)(p - 64) * 1024 + h * 64;
        o[r32] = (bf16_t)f2bf(acc[0][r] * rstd * w0 * siluf_(z0));
        o[32 + r32] = (bf16_t)f2bf(acc[1][r] * rstd * w1 * siluf_(z1));
    }
}


constexpr float QSCALE = 0.10206207261596577f * 1.4426950408889634f;
DI double rope_inv_rev(int i) {
    const double t8[8] = {0.15915494309189535, 0.08949940160889101, 0.050329212104487035, 0.0283021958306234, 0.015915494309189534, 0.008949940160889102, 0.005032921210448704, 0.00283021958306234};
    double v = t8[0];
#pragma unroll
    for (int k = 1; k < 8; ++k) v = ((i & 7) == k) ? t8[k] : v;
    return (i & 8) ? v * 0.01 : v;
}
constexpr int P2_TS = 136;
constexpr int P2_RS = 272;
#define P2_WSYNC() do { __builtin_amdgcn_s_waitcnt(0); __builtin_amdgcn_wave_barrier(); } while (0)
DI void mla_prep2_task(const Frame& F, const Args& A, int task) {
    unsigned char* ws = A.ws; int lane = F.lane; asm volatile("" : "+v"(lane));
    const int h = task & 7, blk = task >> 3;
    const int p = 64 * blk + lane;
    const bool valid = (p >= PADL) && (p < LPV);
    const float* qn = A.in[12]; const float* kn = A.in[13];
    unsigned char* TS = F.lds + F.wave * (64 * P2_RS);
    unsigned char* trow = TS + lane * P2_RS;
    const double pos = (double)(p - PADL);
    auto rot = [&](int i, float& sn_, float& cs_) { const double rev = pos * rope_inv_rev(i); const float fr = (float)(rev - floor(rev)); sn_ = __builtin_amdgcn_sinf(fr); cs_ = __builtin_amdgcn_cosf(fr); };
    {
        {
            const bf16_t* srcb = (const bf16_t*)(ws + WS_QH) + (size_t)(64 * blk) * 768 + h * 96;
            u32x4 t[12];
#pragma unroll
            for (int i = 0; i < 12; ++i) { const int c = 64 * i + lane, r = c / 12, pc = c % 12; t[i] = *(const u32x4*)(srcb + (size_t)r * 768 + 8 * pc); }
#pragma unroll
            for (int i = 0; i < 12; ++i) { const int c = 64 * i + lane, r = c / 12, pc = c % 12; *(u32x4*)(TS + r * P2_RS + 16 * pc) = t[i]; }
            P2_WSYNC();
        }
        u32x4 w[12];
#pragma unroll
        for (int c = 0; c < 12; ++c) w[c] = *(const u32x4*)(trow + 16 * c);
        float ss = 0.f;
#pragma unroll
        for (int c = 0; c < 12; ++c) { const float a0 = bflo(w[c].x), a1 = bfhi(w[c].x), a2 = bflo(w[c].y), a3 = bfhi(w[c].y), a4 = bflo(w[c].z), a5 = bfhi(w[c].z), a6 = bflo(w[c].w), a7 = bfhi(w[c].w);
            ss += (a0 * a0 + a1 * a1) + (a2 * a2 + a3 * a3) + (a4 * a4 + a5 * a5) + (a6 * a6 + a7 * a7); }
        const float rs = valid ? QSCALE / sqrtf(ss * (1.f / 96.f) + EPS) : 0.f;
        unsigned char* dst = trow;
#pragma unroll
        for (int c = 0; c < 8; ++c) {
            const f32x4 g0 = *(const f32x4*)(qn + 8 * c), g1 = *(const f32x4*)(qn + 8 * c + 4);
            *(u32x4*)(dst + 16 * c) = (u32x4){pk2(bflo(w[c].x) * rs * g0.x, bfhi(w[c].x) * rs * g0.y), pk2(bflo(w[c].y) * rs * g0.z, bfhi(w[c].y) * rs * g0.w),
                                              pk2(bflo(w[c].z) * rs * g1.x, bfhi(w[c].z) * rs * g1.y), pk2(bflo(w[c].w) * rs * g1.z, bfhi(w[c].w) * rs * g1.w)};
        }
#pragma unroll
        for (int c = 0; c < 2; ++c) {
            float x1[8], x2[8];
            const u32x4 wa = w[8 + c], wb = w[10 + c];
            x1[0] = bflo(wa.x); x1[1] = bfhi(wa.x); x1[2] = bflo(wa.y); x1[3] = bfhi(wa.y); x1[4] = bflo(wa.z); x1[5] = bfhi(wa.z); x1[6] = bflo(wa.w); x1[7] = bfhi(wa.w);
            x2[0] = bflo(wb.x); x2[1] = bfhi(wb.x); x2[2] = bflo(wb.y); x2[3] = bfhi(wb.y); x2[4] = bflo(wb.z); x2[5] = bfhi(wb.z); x2[6] = bflo(wb.w); x2[7] = bfhi(wb.w);
            float o1[8], o2[8];
#pragma unroll
            for (int t = 0; t < 8; ++t) { float sn_, cs_; rot(8 * c + t, sn_, cs_); const float a = x1[t] * rs * qn[64 + 8 * c + t], b = x2[t] * rs * qn[80 + 8 * c + t]; o1[t] = a * cs_ - b * sn_; o2[t] = b * cs_ + a * sn_; }
            *(u32x4*)(dst + 2 * (64 + 8 * c)) = (u32x4){pk2(o1[0], o1[1]), pk2(o1[2], o1[3]), pk2(o1[4], o1[5]), pk2(o1[6], o1[7])};
            *(u32x4*)(dst + 2 * (80 + 8 * c)) = (u32x4){pk2(o2[0], o2[1]), pk2(o2[2], o2[3]), pk2(o2[4], o2[5]), pk2(o2[6], o2[7])};
        }
        P2_WSYNC();
        {
            unsigned char* outb = (unsigned char*)((bf16_t*)(ws + WS_Q) + ((size_t)h * KVROWS + 64 * blk) * 96);
            u32x4 t[12];
#pragma unroll
            for (int i = 0; i < 12; ++i) { const int c = 64 * i + lane, r = c / 12, pc = c % 12; t[i] = *(const u32x4*)(TS + r * P2_RS + 16 * pc); }
#pragma unroll
            for (int i = 0; i < 12; ++i) *(u32x4*)(outb + (size_t)(64 * i + lane) * 16) = t[i];
            P2_WSYNC();
        }
    }
    {
        {
            const bf16_t* srcb = (const bf16_t*)(ws + WS_KVB) + (size_t)(64 * blk) * 1024 + h * 128;
            const unsigned char* kpb = (const unsigned char*)((const float*)(ws + WS_KPE) + (size_t)(64 * blk) * 32);
            u32x4 t[8], e8[8];
#pragma unroll
            for (int i = 0; i < 8; ++i) { const int c = 64 * i + lane, r = c >> 3, pc = c & 7; t[i] = *(const u32x4*)(srcb + (size_t)r * 1024 + 8 * pc); e8[i] = *(const u32x4*)(kpb + (size_t)c * 16); }
#pragma unroll
            for (int i = 0; i < 8; ++i) { const int c = 64 * i + lane, r = c >> 3, pc = c & 7; *(u32x4*)(TS + r * P2_RS + 16 * pc) = t[i]; *(u32x4*)(TS + r * P2_RS + 128 + 16 * pc) = e8[i]; }
            P2_WSYNC();
        }
        u32x4 w[8]; f32x4 e[8];
#pragma unroll
        for (int c = 0; c < 8; ++c) { w[c] = *(const u32x4*)(trow + 16 * c); e[c] = *(const f32x4*)(trow + 128 + 16 * c); }
        float ss = 0.f;
#pragma unroll
        for (int c = 0; c < 8; ++c) { const float a0 = bflo(w[c].x), a1 = bfhi(w[c].x), a2 = bflo(w[c].y), a3 = bfhi(w[c].y), a4 = bflo(w[c].z), a5 = bfhi(w[c].z), a6 = bflo(w[c].w), a7 = bfhi(w[c].w);
            ss += (a0 * a0 + a1 * a1) + (a2 * a2 + a3 * a3) + (a4 * a4 + a5 * a5) + (a6 * a6 + a7 * a7);
            ss += (e[c].x * e[c].x + e[c].y * e[c].y) + (e[c].z * e[c].z + e[c].w * e[c].w); }
        const float rs = valid ? 1.f / sqrtf(ss * (1.f / 96.f) + EPS) : 0.f;
        unsigned char* dst = trow;
#pragma unroll
        for (int c = 0; c < 8; ++c) {
            const f32x4 g0 = *(const f32x4*)(kn + 8 * c), g1 = *(const f32x4*)(kn + 8 * c + 4);
            *(u32x4*)(dst + 16 * c) = (u32x4){pk2(bflo(w[c].x) * rs * g0.x, bfhi(w[c].x) * rs * g0.y), pk2(bflo(w[c].y) * rs * g0.z, bfhi(w[c].y) * rs * g0.w),
                                              pk2(bflo(w[c].z) * rs * g1.x, bfhi(w[c].z) * rs * g1.y), pk2(bflo(w[c].w) * rs * g1.z, bfhi(w[c].w) * rs * g1.w)};
        }
#pragma unroll
        for (int c = 0; c < 2; ++c) {
            const float x1[8] = {e[2 * c].x, e[2 * c].y, e[2 * c].z, e[2 * c].w, e[2 * c + 1].x, e[2 * c + 1].y, e[2 * c + 1].z, e[2 * c + 1].w};
            const float x2[8] = {e[4 + 2 * c].x, e[4 + 2 * c].y, e[4 + 2 * c].z, e[4 + 2 * c].w, e[5 + 2 * c].x, e[5 + 2 * c].y, e[5 + 2 * c].z, e[5 + 2 * c].w};
            float o1[8], o2[8];
#pragma unroll
            for (int t = 0; t < 8; ++t) { float sn_, cs_; rot(8 * c + t, sn_, cs_); const float a = x1[t] * rs * kn[64 + 8 * c + t], b = x2[t] * rs * kn[80 + 8 * c + t]; o1[t] = a * cs_ - b * sn_; o2[t] = b * cs_ + a * sn_; }
            *(u32x4*)(dst + 2 * (64 + 8 * c)) = (u32x4){pk2(o1[0], o1[1]), pk2(o1[2], o1[3]), pk2(o1[4], o1[5]), pk2(o1[6], o1[7])};
            *(u32x4*)(dst + 2 * (80 + 8 * c)) = (u32x4){pk2(o2[0], o2[1]), pk2(o2[2], o2[3]), pk2(o2[4], o2[5]), pk2(o2[6], o2[7])};
        }
        P2_WSYNC();
        {
            unsigned char* outb = (unsigned char*)((bf16_t*)(ws + WS_K) + ((size_t)h * KVROWS + 64 * blk) * 96);
            u32x4 t[12];
#pragma unroll
            for (int i = 0; i < 12; ++i) { const int c = 64 * i + lane, r = c / 12, pc = c % 12; t[i] = *(const u32x4*)(TS + r * P2_RS + 16 * pc); }
#pragma unroll
            for (int i = 0; i < 12; ++i) *(u32x4*)(outb + (size_t)(64 * i + lane) * 16) = t[i];
            P2_WSYNC();
        }
    }
    {
        unsigned char* T = TS;
        const bf16_t* src = (const bf16_t*)(ws + WS_KVB) + h * 128 + 64;
#pragma unroll
        for (int it = 0; it < 8; ++it) {
            const int pr = 8 * it + (lane >> 3), ch = lane & 7; const int pp = 64 * blk + pr;
            u32x4 v = (u32x4){0u, 0u, 0u, 0u};
            if (pp >= PADL && pp < LPV) v = *(const u32x4*)(src + (size_t)pp * 1024 + 8 * ch);
            unsigned char* tp = T + (8 * ch) * P2_TS + pr * 2;
            *(bf16_t*)(tp + 0 * P2_TS) = (bf16_t)(v.x & 0xffffu); *(bf16_t*)(tp + 1 * P2_TS) = (bf16_t)(v.x >> 16);
            *(bf16_t*)(tp + 2 * P2_TS) = (bf16_t)(v.y & 0xffffu); *(bf16_t*)(tp + 3 * P2_TS) = (bf16_t)(v.y >> 16);
            *(bf16_t*)(tp + 4 * P2_TS) = (bf16_t)(v.z & 0xffffu); *(bf16_t*)(tp + 5 * P2_TS) = (bf16_t)(v.z >> 16);
            *(bf16_t*)(tp + 6 * P2_TS) = (bf16_t)(v.w & 0xffffu); *(bf16_t*)(tp + 7 * P2_TS) = (bf16_t)(v.w >> 16);
        }
        __builtin_amdgcn_s_waitcnt(0); __builtin_amdgcn_wave_barrier();
        bf16_t* VT = (bf16_t*)(ws + WS_VT) + (size_t)h * 64 * KVROWS + 64 * blk;
#pragma unroll
        for (int it = 0; it < 8; ++it) {
            const int e = 8 * it + (lane >> 3), ch = lane & 7;
            const u32x2 lo = *(const u32x2*)(T + e * P2_TS + 16 * ch), hi = *(const u32x2*)(T + e * P2_TS + 16 * ch + 8);
            *(u32x4*)(VT + (size_t)e * KVROWS + 8 * ch) = (u32x4){lo.x, lo.y, hi.x, hi.y};
        }
        __builtin_amdgcn_s_waitcnt(0); __builtin_amdgcn_wave_barrier();
    }
}

constexpr int A_KSTR = 208;
constexpr int A_VSTR = 136;
constexpr int A_KBYTES = 64 * A_KSTR;
constexpr int A_VBYTES = 64 * A_VSTR;
constexpr int A_BUF = A_KBYTES + A_VBYTES;
DI unsigned cvtpk_s(float lo, float hi) { typedef float f2 __attribute__((ext_vector_type(2))); typedef __bf16 b2 __attribute__((ext_vector_type(2))); f2 v = {lo, hi}; b2 b = __builtin_convertvector(v, b2); return __builtin_bit_cast(unsigned, b); }

DI void attn_item(const Frame& F, const Args& A, int h, int qb) {
    unsigned char* ws = A.ws; unsigned char* lds = F.lds;
    const int tid = F.tid, lane = F.lane, wave = F.wave, r32 = lane & 31, hh = lane >> 5;
    const bf16_t* Qg = (const bf16_t*)(ws + WS_Q) + (size_t)h * KVROWS * 96;
    const bf16_t* Kg = (const bf16_t*)(ws + WS_K) + (size_t)h * KVROWS * 96;
    const bf16_t* Vg = (const bf16_t*)(ws + WS_VT) + (size_t)h * 64 * KVROWS;
    const int p0w = 64 + 256 * qb + 32 * wave;
    const int qp = p0w + r32;
    const int ntile = 4 * qb + 5;
    const int mylast = 1 + 4 * qb + (wave >> 1);
    bf16x8 qf[6];
#pragma unroll
    for (int s = 0; s < 6; ++s) qf[s] = *(const bf16x8*)(Qg + (size_t)qp * 96 + 16 * s + 8 * hh);
    f32x16 ot[2]; ot[0] = zero16(); ot[1] = zero16();
    float mrun = -1e30f, lrun = 0.f;
    const int kr0 = tid / 12, kc0 = tid % 12, kr1 = (tid + 512) / 12, kc1 = (tid + 512) % 12; const bool k1ok = tid < 256;
    const int vr = tid >> 3, vc = tid & 7;
    struct Stg { u32x4 k0, k1, v; };
    Stg sA;
    auto gload = [&](Stg& st, int j) {
        const int kv0 = 64 * j;
        st.k0 = *(const u32x4*)(Kg + (size_t)(kv0 + kr0) * 96 + kc0 * 8);
        if (k1ok) st.k1 = *(const u32x4*)(Kg + (size_t)(kv0 + kr1) * 96 + kc1 * 8);
        st.v = *(const u32x4*)(Vg + (size_t)vr * KVROWS + kv0 + vc * 8);
    };
    auto lstore = [&](const Stg& st, int t) {
        unsigned char* kb = lds + (t % 3) * A_BUF; unsigned char* vb = kb + A_KBYTES;
        *(u32x4*)(kb + kr0 * A_KSTR + kc0 * 16) = st.k0;
        if (k1ok) *(u32x4*)(kb + kr1 * A_KSTR + kc1 * 16) = st.k1;
        *(u32x2*)(vb + vr * A_VSTR + vc * 16) = (u32x2){st.v.x, st.v.y};
        *(u32x2*)(vb + vr * A_VSTR + vc * 16 + 8) = (u32x2){st.v.z, st.v.w};
    };
    auto step = [&](auto FIRSTc, auto LASTc, int t, f32x16 (&C)[2], f32x16 (&P)[2]) {
        if (t + 1 < ntile) gload(sA, t + 1);
        constexpr bool has_cur = !decltype(LASTc)::value, has_prev = !decltype(FIRSTc)::value;
        const unsigned char* kb = lds + (t % 3) * A_BUF;
        const unsigned char* vb = lds + ((t + 2) % 3) * A_BUF + A_KBYTES;
        bf16x8 kf[2][6];
        if constexpr (has_cur) {
            const unsigned char* kp = kb + r32 * A_KSTR + hh * 16;
#pragma unroll
            for (int s = 0; s < 6; ++s) kf[0][s] = *(const bf16x8*)(kp + s * 32);
        }
        float ps0 = 0.f, ps1 = 0.f; u32x4 pw[4]; bf16x8 vfr[4][2];
        auto vload = [&](int g) -> bf16x8 {
            const int f = g >> 1, eh = g & 1, kh2 = f >> 1, s2 = f & 1;
            const unsigned char* vp = vb + (32 * eh + r32) * A_VSTR + (32 * kh2 + 16 * s2 + 4 * hh) * 2;
            const u32x2 lo = *(const u32x2*)vp, hi2 = *(const u32x2*)(vp + 16);
            return __builtin_bit_cast(bf16x8, (u32x4){lo.x, lo.y, hi2.x, hi2.y}); };
        __builtin_amdgcn_sched_barrier(0);
#pragma unroll
        for (int i = 0; i < 12; ++i) {
            const int kh = i / 6, sx = i % 6;
            if constexpr (has_cur) { C[kh] = mfma32(kf[kh][sx], qf[sx], sx == 0 ? zero16() : C[kh]); if (i < 6) kf[1][i] = *(const bf16x8*)(kb + (32 + r32) * A_KSTR + hh * 16 + i * 32); }
            if (has_prev && i < 8) {
                const int f = i >> 1, kh2 = f >> 1, b0 = 8 * (f & 1) + 4 * (i & 1);
                const float v0 = P[kh2][b0], v1 = P[kh2][b0 + 1], v2 = P[kh2][b0 + 2], v3 = P[kh2][b0 + 3];
                ps0 += v0 + v1; ps1 += v2 + v3;
                if (i & 1) { pw[f].z = cvtpk_s(v0, v1); pw[f].w = cvtpk_s(v2, v3); asm volatile("" : "+v"(ps0), "+v"(ps1), "+v"(pw[f].z), "+v"(pw[f].w)); }
                else { pw[f].x = cvtpk_s(v0, v1); pw[f].y = cvtpk_s(v2, v3); asm volatile("" : "+v"(ps0), "+v"(ps1), "+v"(pw[f].x), "+v"(pw[f].y)); }
            }
            if (has_prev && i >= 10) {
                const int g0 = i - 10; vfr[g0 >> 1][g0 & 1] = vload(g0);
            }
            __builtin_amdgcn_sched_barrier(0);
        }
        if (has_prev) lrun += ps0 + ps1;
        float mnew = mrun, alpha = 1.f; bool resc = false;
        if constexpr (has_cur) {
            if (t == 0) {
#pragma unroll
                for (int kh = 0; kh < 2; ++kh)
#pragma unroll
                    for (int r = 0; r < 16; ++r) { const int kv = 32 * kh + crow(r, hh); if (kv < PADL) C[kh][r] = -INFINITY; }
            }
            if (t >= mylast) {
#pragma unroll
                for (int kh = 0; kh < 2; ++kh)
#pragma unroll
                    for (int r = 0; r < 16; ++r) { const int kv = 64 * t + 32 * kh + crow(r, hh); if (kv > qp) C[kh][r] = -INFINITY; }
            }
            float mx = C[0][0];
#pragma unroll
            for (int r = 1; r < 16; ++r) mx = fmaxf(mx, C[0][r]);
#pragma unroll
            for (int r = 0; r < 16; ++r) mx = fmaxf(mx, C[1][r]);
            mx = fmaxf(mx, __shfl_xor(mx, 32));
            mnew = fmaxf(mrun, mx);
            alpha = __builtin_amdgcn_exp2f(mrun - mnew);
            resc = __any(mnew > mrun);
        }
        __builtin_amdgcn_sched_barrier(0);
#pragma unroll
        for (int g = 0; g < 8; ++g) {
            const int f = g >> 1, eh = g & 1;
            if constexpr (has_prev) { ot[eh] = mfma32(vfr[f][eh], __builtin_bit_cast(bf16x8, pw[f]), ot[eh]); if (g + 2 < 8) vfr[(g + 2) >> 1][(g + 2) & 1] = vload(g + 2); }
            if constexpr (has_cur) { const int kh = g >> 2, r0 = 4 * (g & 3);
#pragma unroll
                for (int q = 0; q < 4; ++q) C[kh][r0 + q] = __builtin_amdgcn_exp2f(C[kh][r0 + q] - mnew);
                asm volatile("" : "+v"(C[kh][r0]), "+v"(C[kh][r0 + 1]), "+v"(C[kh][r0 + 2]), "+v"(C[kh][r0 + 3])); }
            __builtin_amdgcn_sched_barrier(0);
        }
        if constexpr (has_cur) {
            if (resc) {
#pragma unroll
                for (int eh = 0; eh < 2; ++eh)
#pragma unroll
                    for (int r = 0; r < 16; ++r) ot[eh][r] *= alpha;
            }
            lrun *= alpha; mrun = mnew;
        }
        if (t + 1 < ntile) lstore(sA, t + 1);
        __syncthreads();
    };
    gload(sA, 0); lstore(sA, 0);
    __syncthreads();
    f32x16 scA[2], scB[2];
    scB[0] = zero16(); scB[1] = zero16();
    {
        using TT = std::integral_constant<bool, true>; using FF = std::integral_constant<bool, false>;
        step(TT{}, FF{}, 0, scA, scB);
#pragma unroll 1
        for (int t = 1; t + 1 < ntile; t += 2) {
            step(FF{}, FF{}, t, scB, scA);
            step(FF{}, FF{}, t + 1, scA, scB);
        }
        step(FF{}, TT{}, ntile, scB, scA);
    }
    const float ltot = lrun + __shfl_xor(lrun, 32);
    const float rl = 1.f / ltot;
    bf16_t* o = (bf16_t*)(ws + WS_MIX) + (size_t)(qp - 64) * 1024 + 512 + h * 64;
#pragma unroll
    for (int eh = 0; eh < 2; ++eh)
#pragma unroll
        for (int a = 0; a < 4; ++a) {
            const int e = 32 * eh + 8 * a + 4 * hh;
            *(u32x2*)(o + e) = (u32x2){pk2(ot[eh][4 * a] * rl, ot[eh][4 * a + 1] * rl), pk2(ot[eh][4 * a + 2] * rl, ot[eh][4 * a + 3] * rl)};
        }
}

DI void xn_rows(const Frame& F, const Args& A, int u0, int stride) {
    f32x4 v[2][4];
#pragma unroll
    for (int r = 0; r < 2; ++r) { const int u = u0 + r * stride; if (u < MU) { const f32x4* xr = (const f32x4*)(A.out + (size_t)u * DM) + F.lane;
#pragma unroll
        for (int j = 0; j < 4; ++j) v[r][j] = xr[64 * j]; } }
#pragma unroll
    for (int r = 0; r < 2; ++r) {
        const int u = u0 + r * stride; if (u >= MU) continue;
        float s = 0.f;
#pragma unroll
        for (int j = 0; j < 4; ++j) s += (v[r][j].x * v[r][j].x + v[r][j].y * v[r][j].y) + (v[r][j].z * v[r][j].z + v[r][j].w * v[r][j].w);
        const float rstd = 1.f / sqrtf(wave_sum(s) * (1.f / DM) + EPS);
        unsigned long long* o8 = (unsigned long long*)((bf16_t*)(A.ws + WS_XN) + (size_t)u * DM) + F.lane;
#pragma unroll
        for (int j = 0; j < 4; ++j) { const f32x4 w = ((const f32x4*)A.in[15])[64 * j + F.lane];
            o8[64 * j] = (unsigned long long)pk2(v[r][j].x * rstd * w.x, v[r][j].y * rstd * w.y) | ((unsigned long long)pk2(v[r][j].z * rstd * w.z, v[r][j].w * rstd * w.w) << 32); }
    }
}

DI unsigned fkey(float v, int idx) { unsigned u = __builtin_bit_cast(unsigned, v); u = (u & 0x80000000u) ? ~u : (u | 0x80000000u); return (u & ~127u) | (unsigned)(127 - idx); }
DI float keyval(unsigned k) { unsigned u = k & ~127u; u = (u & 0x80000000u) ? (u & 0x7fffffffu) : ~u; return __builtin_bit_cast(float, u); }

__device__ const unsigned char PAIR_A[50] = {0,0,0,0,0,0,0,0,0,0,0,0,0,0,0,0, 1,1,1,1,1,1,1,1, 2,2,2,2,2, 3,3,3,3, 4,4,4, 5,5, 6,6, 7,7, 8,9,10,11,12,13,14,15};
__device__ const unsigned char PAIR_B[50] = {0,1,2,3,4,5,6,7,8,9,10,11,12,13,14,15, 0,1,2,3,4,5,6,7, 0,1,2,3,4, 0,1,2,3, 0,1,2, 0,1, 0,1, 0,1, 0,0,0,0,0,0,0,0};

DI void ce_desc(unsigned& a, unsigned& b) { const unsigned mx = a > b ? a : b, mn = a > b ? b : a; a = mx; b = mn; }
template <int BASE, int NK> DI void bitonic_sort16_desc(unsigned (&x)[NK]) {
#pragma unroll
    for (int k = 2; k <= 16; k <<= 1)
#pragma unroll
        for (int j = k >> 1; j > 0; j >>= 1)
#pragma unroll
            for (int i = 0; i < 16; ++i) { const int l = i ^ j; if (l > i) { if ((i & k) == 0) ce_desc(x[BASE + i], x[BASE + l]); else ce_desc(x[BASE + l], x[BASE + i]); } }
}
template <int A0, int B0, int NK> DI void merge_top16(unsigned (&x)[NK]) {
#pragma unroll
    for (int i = 0; i < 16; ++i) { const unsigned p = x[A0 + i], q = x[B0 + 15 - i]; x[A0 + i] = p > q ? p : q; }
#pragma unroll
    for (int j = 8; j > 0; j >>= 1)
#pragma unroll
        for (int i = 0; i < 16; ++i) { const int l = i ^ j; if (l > i) ce_desc(x[A0 + i], x[A0 + l]); }
}
template <int NK> DI void top16_of_128(unsigned (&key)[NK]) {
    bitonic_sort16_desc<0, NK>(key); bitonic_sort16_desc<16, NK>(key); bitonic_sort16_desc<32, NK>(key); bitonic_sort16_desc<48, NK>(key);
    bitonic_sort16_desc<64, NK>(key); bitonic_sort16_desc<80, NK>(key); bitonic_sort16_desc<96, NK>(key); bitonic_sort16_desc<112, NK>(key);
    merge_top16<0, 16, NK>(key); merge_top16<32, 48, NK>(key); merge_top16<64, 80, NK>(key); merge_top16<96, 112, NK>(key);
    merge_top16<0, 32, NK>(key); merge_top16<64, 96, NK>(key);
    merge_top16<0, 64, NK>(key);
}

DI void topk_task(const Frame& F, const Args& A, int task) {
    unsigned char* ws = A.ws; const int tid = F.tid;
    const int u = task >> 3, h = task & 7;
    LAS unsigned* sk = (LAS unsigned*)(LAS unsigned char*)F.lds;
    LAS unsigned* pkk = sk + 16384;
    LAS unsigned* stg = sk + 16384;
    const bf16_t* SCb = (const bf16_t*)(ws + WS_SC) + (size_t)(task & ~511) * 256;
#pragma unroll 1
    for (int half = 0; half < 2; ++half) {
        unsigned key[128];
#pragma unroll
        for (int qb = 0; qb < 2; ++qb) {
            u32x4 pf[8];
#pragma unroll
            for (int k = 0; k < 8; ++k) { const int c = tid + 512 * k; pf[k] = *(const u32x4*)(SCb + (size_t)(c >> 3) * 256 + half * 128 + qb * 64 + (c & 7) * 8); }
#pragma unroll
            for (int k = 0; k < 8; ++k) { const int c = tid + 512 * k; *(LAS u32x4*)(stg + (c >> 3) * 36 + (c & 7) * 4) = pf[k]; }
            __syncthreads();
#pragma unroll
            for (int i = 0; i < 8; ++i) { const u32x4 v = *(const LAS u32x4*)(stg + tid * 36 + 4 * i); const int b0 = 64 * qb + 8 * i;
                key[b0] = fkey(bflo(v.x), b0); key[b0 + 1] = fkey(bfhi(v.x), b0 + 1); key[b0 + 2] = fkey(bflo(v.y), b0 + 2); key[b0 + 3] = fkey(bfhi(v.y), b0 + 3);
                key[b0 + 4] = fkey(bflo(v.z), b0 + 4); key[b0 + 5] = fkey(bfhi(v.z), b0 + 5); key[b0 + 6] = fkey(bflo(v.w), b0 + 6); key[b0 + 7] = fkey(bfhi(v.w), b0 + 7); }
            __syncthreads();
        }
        top16_of_128(key);
#pragma unroll
        for (int r = 0; r < 16; ++r) sk[(half * 16 + r) * 512 + tid] = key[r];
    }
    float v1[16], v2[16];
#pragma unroll
    for (int r = 0; r < 16; ++r) { v1[r] = keyval(sk[r * 512 + tid]); v2[r] = keyval(sk[(16 + r) * 512 + tid]); }
    unsigned ck[64];
#pragma unroll
    for (int c = 50; c < 64; ++c) ck[c] = 0u;
#pragma unroll
    for (int a = 0; a < 16; ++a) {
        const int off = a == 0 ? 0 : a == 1 ? 16 : a == 2 ? 24 : a == 3 ? 29 : a == 4 ? 33 : a == 5 ? 36 : a == 6 ? 38 : a == 7 ? 40 : 42 + (a - 8);
#pragma unroll
        for (int b = 0; b < 16; ++b) if ((a + 1) * (b + 1) <= 16) ck[off + b] = fkey(v1[a] + v2[b], off + b);
    }
    bitonic_sort16_desc<0, 64>(ck); bitonic_sort16_desc<16, 64>(ck); bitonic_sort16_desc<32, 64>(ck); bitonic_sort16_desc<48, 64>(ck);
    merge_top16<0, 16, 64>(ck); merge_top16<32, 48, 64>(ck); merge_top16<0, 32, 64>(ck);
#pragma unroll
    for (int r = 0; r < 16; ++r) pkk[r * 512 + tid] = ck[r];
    const float cmax = keyval(pkk[tid]);
    float ev[16]; float esum = 0.f; int ex[16];
#pragma unroll
    for (int r = 0; r < 16; ++r) {
        const unsigned k = pkk[r * 512 + tid]; const int c = 127 - (int)(k & 127u);
        ev[r] = __expf(keyval(k) - cmax); esum += ev[r];
        const int a = PAIR_A[c], b = PAIR_B[c];
        const int i1 = 127 - (int)(sk[a * 512 + tid] & 127u), i2 = 127 - (int)(sk[(16 + b) * 512 + tid] & 127u);
        ex[r] = i1 * 128 + i2;
    }
    const float rs = 1.f / esum;
    int* IDX = (int*)(ws + WS_IDX) + (size_t)u * 128 + h * 16; float* GATE = (float*)(ws + WS_GATE) + (size_t)u * 128 + h * 16;
#pragma unroll
    for (int r = 0; r < 16; r += 4) {
        *(int4*)(IDX + r) = make_int4(ex[r], ex[r + 1], ex[r + 2], ex[r + 3]);
        *(f32x4*)(GATE + r) = (f32x4){ev[r] * rs, ev[r + 1] * rs, ev[r + 2] * rs, ev[r + 3] * rs};
    }
}

constexpr float EU_SCALE = 64.f, EV_SCALE = 16.f;
DI unsigned pk4_fp8(float a, float b, float c, float d) { int w = 0; w = __builtin_amdgcn_cvt_pk_fp8_f32(a, b, w, false); w = __builtin_amdgcn_cvt_pk_fp8_f32(c, d, w, true); return (unsigned)w; }
DI void convert_tables(const Frame& F, const Args& A) {
    const size_t n16 = (size_t)16384 * 1024 / 16;
    const size_t gt = (size_t)blockIdx.x * 512 + F.tid, NGT = (size_t)F.G * 512;
#pragma unroll 1
    for (int t = 0; t < 2; ++t) {
        const float* src = A.in[18 + t]; unsigned char* dst = A.ws + (t ? WS_EV : WS_EU); const float sc = t ? EV_SCALE : EU_SCALE;
        const float* fn = A.in[15];
        for (size_t i = gt; i < n16; i += NGT) {
            f32x4 a = *(const f32x4*)(src + i * 16) * sc, b = *(const f32x4*)(src + i * 16 + 4) * sc, c = *(const f32x4*)(src + i * 16 + 8) * sc, d = *(const f32x4*)(src + i * 16 + 12) * sc;
            if (t == 0) { const float* g = fn + (i & 63) * 16; a *= *(const f32x4*)g; b *= *(const f32x4*)(g + 4); c *= *(const f32x4*)(g + 8); d *= *(const f32x4*)(g + 12); }
            const size_t e_ = i >> 6, c16_ = i & 63;
            *(u32x4*)(dst + (c16_ >> 3) * ((size_t)16384 * 128) + e_ * 128 + (c16_ & 7) * 16) = (u32x4){pk4_fp8(a.x, a.y, a.z, a.w), pk4_fp8(b.x, b.y, b.z, b.w), pk4_fp8(c.x, c.y, c.z, c.w), pk4_fp8(d.x, d.y, d.z, d.w)};
        }
    }
}

DI float gelu_exact(float x) { return 0.5f * x * (1.f + erff(x * 0.70710678118654752f)); }
typedef float f32x2 __attribute__((ext_vector_type(2)));
#define UNPK16(dst, W_) do { f32x2 _t; \
    _t = __builtin_amdgcn_cvt_pk_f32_fp8((int)(W_).x, false); dst[0] = _t.x; dst[1] = _t.y; _t = __builtin_amdgcn_cvt_pk_f32_fp8((int)(W_).x, true); dst[2] = _t.x; dst[3] = _t.y; \
    _t = __builtin_amdgcn_cvt_pk_f32_fp8((int)(W_).y, false); dst[4] = _t.x; dst[5] = _t.y; _t = __builtin_amdgcn_cvt_pk_f32_fp8((int)(W_).y, true); dst[6] = _t.x; dst[7] = _t.y; \
    _t = __builtin_amdgcn_cvt_pk_f32_fp8((int)(W_).z, false); dst[8] = _t.x; dst[9] = _t.y; _t = __builtin_amdgcn_cvt_pk_f32_fp8((int)(W_).z, true); dst[10] = _t.x; dst[11] = _t.y; \
    _t = __builtin_amdgcn_cvt_pk_f32_fp8((int)(W_).w, false); dst[12] = _t.x; dst[13] = _t.y; _t = __builtin_amdgcn_cvt_pk_f32_fp8((int)(W_).w, true); dst[14] = _t.x; dst[15] = _t.y; } while (0)

#define UNPK16P(dst, W_) do { \
    dst[0] = __builtin_amdgcn_cvt_pk_f32_fp8((int)(W_).x, false); dst[1] = __builtin_amdgcn_cvt_pk_f32_fp8((int)(W_).x, true); \
    dst[2] = __builtin_amdgcn_cvt_pk_f32_fp8((int)(W_).y, false); dst[3] = __builtin_amdgcn_cvt_pk_f32_fp8((int)(W_).y, true); \
    dst[4] = __builtin_amdgcn_cvt_pk_f32_fp8((int)(W_).z, false); dst[5] = __builtin_amdgcn_cvt_pk_f32_fp8((int)(W_).z, true); \
    dst[6] = __builtin_amdgcn_cvt_pk_f32_fp8((int)(W_).w, false); dst[7] = __builtin_amdgcn_cvt_pk_f32_fp8((int)(W_).w, true); } while (0)

template <bool UPH>
DI void expert_phase(const Frame& F, const Args& A, int xv, int wq, int nw) {
    unsigned char* ws = A.ws; const int lane = F.lane, grp = lane >> 3, j = lane & 7;
    const unsigned char* TBL = ws + (UPH ? WS_EU : WS_EV) + (size_t)xv * ((size_t)16384 * 128);
    const unsigned loff = 16u * (unsigned)j;
    const int* IDX = (const int*)(ws + WS_IDX); const float* CW = (const float*)(ws + WS_CW);
    const bf16_t* XN = (const bf16_t*)(ws + WS_XN) + 128 * xv + 16 * j;
    float* HP = (float*)(ws + WS_HP);
    LAS unsigned* ring = (LAS unsigned*)((LAS unsigned char*)F.lds + F.wave * 4096);
    const int nt = (MU - wq + nw - 1) / nw;
    if (nt <= 0) return;
    auto tok = [&](int k) { return __builtin_amdgcn_readfirstlane(wq + (k < nt ? k : nt - 1) * nw); };
    int mi0, mi1; u32x4 mx0, mx1; float mh0, mh1;
    auto meta_load = [&](int k) {
        const int u = tok(k);
        mi0 = IDX[(size_t)u * 128 + lane]; mi1 = IDX[(size_t)u * 128 + 64 + lane];
        if constexpr (UPH) { mx0 = *(const u32x4*)(XN + (size_t)u * DM); mx1 = *(const u32x4*)(XN + (size_t)u * DM + 8); }
        else { mh0 = CW[(size_t)u * 128 + lane]; mh1 = CW[(size_t)u * 128 + 64 + lane]; }
    };
    auto meta_store = [&](int k) {
        LAS unsigned* sl = ring + (k & 3) * 256;
        sl[lane] = (unsigned)mi0; sl[64 + lane] = (unsigned)mi1;
        if constexpr (UPH) { if (grp == 0) { *(LAS u32x4*)(sl + 128 + 8 * j) = mx0; *(LAS u32x4*)(sl + 128 + 8 * j + 4) = mx1; } }
        else { sl[128 + lane] = __builtin_bit_cast(unsigned, mh0); sl[192 + lane] = __builtin_bit_cast(unsigned, mh1); }
    };
    auto gather = [&](u32x4 (&buf)[8], int n) {
        const LAS unsigned* sl = ring + ((n >> 1) & 3) * 256 + 64 * (n & 1) + grp;
#pragma unroll
        for (int i = 0; i < 8; ++i) { const unsigned e = sl[8 * i]; buf[i] = *(const u32x4*)(TBL + ((e << 7) | loff)); }
    };
    const int ocol = 128 * xv + 16 * j + ((lane & 32) ? 8 : 0) + ((lane & 16) ? 4 : 0) + ((lane & 8) ? 2 : 0);
    f32x2 ocur = (f32x2){0.f, 0.f};
    float acc[16];
    float xn[16];
    auto compute = [&](u32x4 (&buf)[8], int n) {
        const int k = n >> 1, hf = n & 1;
        const LAS unsigned* sl = ring + (k & 3) * 256;
        if (hf == 0) {
            if constexpr (UPH) {
                const u32x4 x0 = *(const LAS u32x4*)(sl + 128 + 8 * j), x1 = *(const LAS u32x4*)(sl + 128 + 8 * j + 4);
                xn[0] = bflo(x0.x); xn[1] = bfhi(x0.x); xn[2] = bflo(x0.y); xn[3] = bfhi(x0.y); xn[4] = bflo(x0.z); xn[5] = bfhi(x0.z); xn[6] = bflo(x0.w); xn[7] = bfhi(x0.w);
                xn[8] = bflo(x1.x); xn[9] = bfhi(x1.x); xn[10] = bflo(x1.y); xn[11] = bfhi(x1.y); xn[12] = bflo(x1.z); xn[13] = bfhi(x1.z); xn[14] = bflo(x1.w); xn[15] = bfhi(x1.w);
            } else {
#pragma unroll
                for (int c = 0; c < 16; ++c) acc[c] = 0.f;
                { const unsigned hw = *(const unsigned*)((const bf16_t*)(ws + WS_XN) + (size_t)tok(k) * DM + ocol); ocur = (f32x2){bflo(hw), bfhi(hw)}; }
            }
        }
#pragma unroll
        for (int i = 0; i < 8; ++i) {
            f32x2 f2[8]; UNPK16P(f2, buf[i]);
            if constexpr (UPH) {
                f32x2 a0 = (f32x2){0.f, 0.f}, a1 = (f32x2){0.f, 0.f};
#pragma unroll
                for (int c = 0; c < 8; c += 2) { a0 = __builtin_elementwise_fma(f2[c], (f32x2){xn[2 * c], xn[2 * c + 1]}, a0); a1 = __builtin_elementwise_fma(f2[c + 1], (f32x2){xn[2 * c + 2], xn[2 * c + 3]}, a1); }
                const f32x2 as = a0 + a1;
                if (hf == 0) acc[i] = as.x + as.y; else acc[8 + i] = as.x + as.y;
                if (i < 7) { if (hf == 0) asm volatile("" : "+v"(buf[i + 1].x), "+v"(buf[i + 1].y), "+v"(buf[i + 1].z), "+v"(buf[i + 1].w), "+v"(acc[i]));
                             else asm volatile("" : "+v"(buf[i + 1].x), "+v"(buf[i + 1].y), "+v"(buf[i + 1].z), "+v"(buf[i + 1].w), "+v"(acc[8 + i])); }
            } else {
                const float cw = __builtin_bit_cast(float, sl[128 + 64 * hf + 8 * i + grp]);
                const f32x2 cw2 = (f32x2){cw, cw};
#pragma unroll
                for (int c = 0; c < 8; ++c) { const f32x2 r_ = __builtin_elementwise_fma(f2[c], cw2, (f32x2){acc[2 * c], acc[2 * c + 1]}); acc[2 * c] = r_.x; acc[2 * c + 1] = r_.y; }
                if (i < 7) asm volatile("" : "+v"(buf[i + 1].x), "+v"(buf[i + 1].y), "+v"(buf[i + 1].z), "+v"(buf[i + 1].w),
                                             "+v"(acc[0]), "+v"(acc[1]), "+v"(acc[2]), "+v"(acc[3]), "+v"(acc[4]), "+v"(acc[5]), "+v"(acc[6]), "+v"(acc[7]),
                                             "+v"(acc[8]), "+v"(acc[9]), "+v"(acc[10]), "+v"(acc[11]), "+v"(acc[12]), "+v"(acc[13]), "+v"(acc[14]), "+v"(acc[15]));
            }
            __builtin_amdgcn_sched_barrier(0);
        }
        if (hf == 1 && k < nt) {
            const int u = tok(k);
            float r8[8], r4[4], r2[2];
            if constexpr (UPH) {
                { const bool up = lane & 4;
#pragma unroll
                  for (int i = 0; i < 8; ++i) { const float send = up ? acc[i] : acc[i + 8], keep = up ? acc[i + 8] : acc[i]; r8[i] = keep + __shfl_xor(send, 4); } }
                { const bool up = lane & 2;
#pragma unroll
                  for (int i = 0; i < 4; ++i) { const float send = up ? r8[i] : r8[i + 4], keep = up ? r8[i + 4] : r8[i]; r4[i] = keep + __shfl_xor(send, 2); } }
                { const bool up = lane & 1;
#pragma unroll
                  for (int i = 0; i < 2; ++i) { const float send = up ? r4[i] : r4[i + 2], keep = up ? r4[i + 2] : r4[i]; r2[i] = keep + __shfl_xor(send, 1); } }
                const int st = ((lane & 4) ? 8 : 0) + ((lane & 2) ? 4 : 0) + ((lane & 1) ? 2 : 0);
                float* hp = HP + ((size_t)xv * MU + u) * 128 + grp;
                hp[8 * st] = r2[0]; hp[8 * (st + 1)] = r2[1];
            } else {
                { const bool up = lane & 32;
#pragma unroll
                  for (int c = 0; c < 8; ++c) { const float send = up ? acc[c] : acc[c + 8], keep = up ? acc[c + 8] : acc[c]; r8[c] = keep + __shfl_xor(send, 32); } }
                { const bool up = lane & 16;
#pragma unroll
                  for (int c = 0; c < 4; ++c) { const float send = up ? r8[c] : r8[c + 4], keep = up ? r8[c + 4] : r8[c]; r4[c] = keep + __shfl_xor(send, 16); } }
                { const bool up = lane & 8;
#pragma unroll
                  for (int c = 0; c < 2; ++c) { const float send = up ? r4[c] : r4[c + 2], keep = up ? r4[c + 2] : r4[c]; r2[c] = keep + __shfl_xor(send, 8); } }
                f32x2* o = (f32x2*)(A.out + (size_t)u * DM + ocol);
                f32x2 cur = ocur; cur.x += r2[0]; cur.y += r2[1]; *o = cur;
            }
        }
    };
    meta_load(0); meta_store(0); meta_load(1); meta_store(1); meta_load(2); meta_store(2);
    u32x4 b0[8], b1[8], b2[8];
    gather(b0, 0); gather(b1, 1); gather(b2, 2);
#pragma unroll 1
    for (int k0 = 0; k0 < nt; k0 += 3) {
        const int n0 = 2 * k0;
        meta_load(k0 + 3);
        compute(b0, n0);     gather(b0, n0 + 3);
        compute(b1, n0 + 1); meta_store(k0 + 3); gather(b1, n0 + 4);
        meta_load(k0 + 4);
        compute(b2, n0 + 2); gather(b2, n0 + 5);
        compute(b0, n0 + 3); meta_store(k0 + 4); gather(b0, n0 + 6);
        meta_load(k0 + 5);
        compute(b1, n0 + 4); gather(b1, n0 + 7);
        compute(b2, n0 + 5); meta_store(k0 + 5); gather(b2, n0 + 8);
    }
}


DI void expert_c_pass(const Frame& F, const Args& A) {
    unsigned char* ws = A.ws;
    const float* HP = (const float*)(ws + WS_HP); const float* GATE = (const float*)(ws + WS_GATE); float* CW = (float*)(ws + WS_CW);
    const size_t n4 = (size_t)MU * 128 / 4;
    for (size_t i = (size_t)blockIdx.x * 512 + F.tid; i < n4; i += (size_t)F.G * 512) {
        f32x4 h = *(const f32x4*)(HP + i * 4);
#pragma unroll
        for (int x = 1; x < 8; ++x) h += *(const f32x4*)(HP + (size_t)x * MU * 128 + i * 4);
        const f32x4 g = *(const f32x4*)(GATE + i * 4);
        const float rs = (1.f / EU_SCALE) / sqrtf(ss_sum16((const float*)(ws + WS_SS4), (int)(i >> 5)) * (1.f / DM) + EPS);
        f32x4 c;
        c.x = gelu_exact(h.x * rs) * g.x * (1.f / EV_SCALE); c.y = gelu_exact(h.y * rs) * g.y * (1.f / EV_SCALE);
        c.z = gelu_exact(h.z * rs) * g.z * (1.f / EV_SCALE); c.w = gelu_exact(h.w * rs) * g.w * (1.f / EV_SCALE);
        *(f32x4*)(CW + i * 4) = c;
    }
}
template <int PH> DI void run_phase(const Frame& F, const Args& args, PG8_LAS unsigned char* lds3) {
    unsigned char* ws = args.ws;
    if constexpr (PH == 0) { p0_prologue(F, args); p0_late_weights<0>(F, args, (7 - F.wave) * F.G + blockIdx.x, F.NGW, blockIdx.x * 512 + F.tid, F.G * 512); }
    if constexpr (PH == 1) {
        pg8::Gemm g{(const bf16_t*)(ws + WS_HN), (const bf16_t*)(ws + WS_WIN), MP, NPROJ, 1024, 1024, 1024, 0};
        pg8::StaticOrder S; S.init(MP, NPROJ, F.G, (int)blockIdx.x);
        EpiProj E{(bf16_t*)(ws + WS_QKVR), (bf16_t*)(ws + WS_Z), (float*)(ws + WS_BA), (bf16_t*)(ws + WS_CQN), (bf16_t*)(ws + WS_CKVN), (float*)(ws + WS_KPE), (float*)(ws + WS_SSQ), (float*)(ws + WS_SSK)};
        pg8::gemm_phase<EpiProj, pg8::StaticOrder, true, true>(lds3, g, S, E);
    }
    if constexpr (PH == 2) {
        gdn_prep_phase<0>(F, args);
        __syncthreads();
        const int G = F.G, c1 = ((int)blockIdx.x + G - 8 % G) % G, c2 = ((int)blockIdx.x + G - 208 % G) % G;
        { pg8::Gemm g{(const bf16_t*)(ws + WS_CQN), (const bf16_t*)(ws + WS_WUQ), MP, 768, 256, 256, 256, 0};
          pg8::StaticOrder S; S.init(MP, 768, G, c1); EpiB16 E{(bf16_t*)(ws + WS_QH), 768, (const float*)(ws + WS_SSQ), 1.f / 256.f, 4};
          pg8::gemm_phase<EpiB16, pg8::StaticOrder, true, true>(lds3, g, S, E); }
        { pg8::Gemm g{(const bf16_t*)(ws + WS_CKVN), (const bf16_t*)(ws + WS_WUKV), MP, 1024, 256, 256, 256, 0};
          pg8::StaticOrder S; S.init(MP, 1024, G, c2); EpiB16 E{(bf16_t*)(ws + WS_KVB), 1024, (const float*)(ws + WS_SSK), 1.f / 128.f, 4};
          pg8::gemm_phase<EpiB16, pg8::StaticOrder, true, true>(lds3, g, S, E); }
    }
    if constexpr (PH == 3) { for (int t = F.gw; t < (KVROWS / 64) * 8; t += F.NGW) mla_prep2_task(F, args, t); }
    if constexpr (PH == 4) {
        gdn_scan(F, args);
        volatile LAS unsigned* MISC = (volatile LAS unsigned*)(lds3 + MISC_OFF);
        unsigned* ctl = (unsigned*)(ws + WS_CTL);
        unsigned* qhead = ctl + CW_ATTQ;
        bool scan_seen = false;
        for (;;) {
            __syncthreads();
            if (F.tid == 0) MISC[24] = xb_add(qhead, 1u);
            __syncthreads();
            const int k = (int)MISC[24];
            if (k >= 512 + 512) break;
            if (k < 512) { attn_item(F, args, k & 7, 63 - (k >> 3)); continue; }
            if (!scan_seen) {
                if (F.tid == 0) XB_SPIN(xb_ld(ctl + CW_SCANDONE) < 32u, ctl);
                __syncthreads();
                __builtin_amdgcn_fence(__ATOMIC_ACQUIRE, "agent");
                scan_seen = true;
            }
            gdn_out_task(F, args, (k - 512) * 8 + F.wave);
        }
        p0_late_weights<1>(F, args, F.gw, F.NGW, blockIdx.x * 512 + F.tid, F.G * 512);
    }
    if constexpr (PH == 5) {
        pg8::Gemm g{(const bf16_t*)(ws + WS_MIX), (const bf16_t*)(ws + WS_WOUT), MU, 1024, 1024, 1024, 1024, 0};
        pg8::StaticOrder S; S.init(MU, 1024, F.G, (int)blockIdx.x); EpiH1 E{args.out, args.in[0], (bf16_t*)(ws + WS_XN), (float*)(ws + WS_SS4)};
        pg8::gemm_phase<EpiH1, pg8::StaticOrder, true, true>(lds3, g, S, E);
    }
    if constexpr (PH == 6) {
        pg8::Gemm g{(const bf16_t*)(ws + WS_XN), (const bf16_t*)(ws + WS_WPQ), MU, 2048, 1024, 1024, 1024, 0};
        pg8::StaticOrder S; S.init(MU, 2048, F.G, (int)blockIdx.x); EpiB16 E{(bf16_t*)(ws + WS_PQ), 2048, (const float*)(ws + WS_SS4), 1.f / 1024.f, 16};
        pg8::gemm_phase<EpiB16, pg8::StaticOrder, true, true>(lds3, g, S, E);
        __threadfence_block(); __syncthreads();
    }
    if constexpr (PH == 6) {
        pg8::Gemm g{(const bf16_t*)(ws + WS_PQ), (const bf16_t*)(ws + WS_SKB), MU, 2048, 256, 2048, 256, 256};
        pg8::StaticOrder S; S.init(MU, 2048, F.G, (int)blockIdx.x); EpiB16 E{(bf16_t*)(ws + WS_SC), 2048, nullptr, 0.f, 0};
        pg8::gemm_phase<EpiB16, pg8::StaticOrder, true, true>(lds3, g, S, E);
    }
    if constexpr (PH == 7) {
        convert_tables(F, args);
        for (int t = blockIdx.x * 512 + F.tid; t < MU * 8; t += F.G * 512) topk_task(F, args, t);
    }
    if constexpr (PH == 9) { expert_c_pass(F, args); }
    if constexpr (PH == 8 || PH == 10) {
        volatile LAS unsigned* MISC = (volatile LAS unsigned*)(lds3 + MISC_OFF);
        const unsigned x = MISC[16], rank = MISC[17];
        unsigned* bar = (unsigned*)(ws + WS_CTL);
        unsigned nloc = 0, nx = 0, myidx = 0;
#pragma unroll
        for (unsigned j = 0; j < 16; ++j) { const unsigned c = xb_ld(&bar[XB_XCNT(j)]); nx += (c > 0u) ? 1u : 0u; myidx += (c > 0u && j < x) ? 1u : 0u; nloc = (j == x) ? c : nloc; }
        const int wq = __builtin_amdgcn_readfirstlane((int)rank * 8 + F.wave), nw = __builtin_amdgcn_readfirstlane((int)nloc * 8);
        const int xstep = __builtin_amdgcn_readfirstlane((int)nx);
        for (int xv = __builtin_amdgcn_readfirstlane((int)myidx); xv < 8; xv += xstep)
            { if constexpr (PH == 8) expert_phase<true>(F, args, xv, wq, nw); else expert_phase<false>(F, args, xv, wq, nw); }
    }
}
constexpr int NPHASE = 11;
__global__ void __launch_bounds__(512, 2) fwd_kernel(Args args) {
    extern __shared__ __attribute__((aligned(16))) unsigned char lds[];
    Frame F;
    F.lds = lds; F.tid = threadIdx.x; F.lane = F.tid & 63; F.wave = __builtin_amdgcn_readfirstlane(F.tid >> 6);
    F.G = gridDim.x; F.gw = blockIdx.x * 8 + F.wave; F.NGW = F.G * 8;
    volatile LAS unsigned* MISC = (volatile LAS unsigned*)((LAS unsigned char*)lds + MISC_OFF);
    if (F.tid < 32) MISC[F.tid] = 0u;
    __syncthreads();
    unsigned char* ws = args.ws;
    const int lo = args.ph_lo, hi = args.ph_hi;
    XcdBarrier bar; bar.bar = (unsigned*)(ws + WS_CTL); bar.x = 0; bar.st = nullptr;
    if (hi - lo > 1) bar = xcd_barrier_post((unsigned*)(ws + WS_CTL), MISC + 8);
    if (F.tid == 0) { const unsigned x = xb_xcc_id(); MISC[16] = x; MISC[17] = xb_add((unsigned*)(ws + WS_CTL) + 3520 + 64 * x, 1u); }
    __syncthreads();
#define IN(k) (lo <= (k) && (k) < hi)
#define SEAM(k) do { if (IN(k) && IN((k) + 1)) xcd_barrier(bar); } while (0)
    PG8_LAS unsigned char* lds3 = (PG8_LAS unsigned char*)lds;

#ifndef PROBE_REPEAT
#define PROBE_REPEAT -1
#endif
#ifndef PROBE_TIME
#define PROBE_TIME -1
#endif
#ifndef PROBE_TSEL
#define PROBE_TSEL 0
#endif
    unsigned long long pt_ticks = 0ull;
#define PHASE(k) do { unsigned long long pt0_ = 0ull; if (PROBE_TIME == (k)) pt0_ = __builtin_amdgcn_s_memrealtime(); \
        if (IN(k)) { run_phase<k>(F, args, lds3); if (PROBE_REPEAT == (k)) { xcd_barrier(bar); run_phase<(k)>(F, args, lds3); } } \
        if (PROBE_TIME == (k) && PROBE_TSEL == 1) pt_ticks = __builtin_amdgcn_s_memrealtime() - pt0_;     \
        if (PROBE_TIME == (k) && PROBE_TSEL == 2) pt0_ = __builtin_amdgcn_s_memrealtime();                \
        SEAM(k); \
        if (PROBE_TIME == (k) && PROBE_TSEL != 1) pt_ticks = __builtin_amdgcn_s_memrealtime() - pt0_; } while (0)
    PHASE(0); PHASE(1); PHASE(2); PHASE(3); PHASE(4); PHASE(5); PHASE(6); PHASE(7); PHASE(8); PHASE(9); PHASE(10);
#undef PHASE
    if (PROBE_STAGE >= 0) { __syncthreads(); pt_ticks = *(volatile unsigned long long*)(lds + 143360 + 96); }
    if (PROBE_TIME >= 0 || PROBE_STAGE >= 0) { const unsigned long long t0_ = __builtin_amdgcn_s_memrealtime(); while (__builtin_amdgcn_s_memrealtime() - t0_ < 4ull * pt_ticks) __builtin_amdgcn_s_sleep(32); }
#undef IN
#undef SEAM
}

#ifndef N_LAUNCHES
#define N_LAUNCHES 1
#endif
extern "C" void kernel_launch(void* const* d_in, const int* in_sizes, int n_in, void* d_out, int out_size, void* d_ws, size_t ws_size, hipStream_t stream) {
    static int grid = 0;
    if (grid == 0) {
        if (n_in != 20 || out_size != MU * DM || ws_size < WS_END) { fprintf(stderr, "kernel_launch: unexpected shapes (n_in %d out %d ws %zu)\n", n_in, out_size, ws_size); grid = -1; return; }
        int dev = 0, cus = 0, per_cu = 0;
        if (hipGetDevice(&dev) != hipSuccess || hipDeviceGetAttribute(&cus, hipDeviceAttributeMultiprocessorCount, dev) != hipSuccess) { grid = -1; return; }
        if (hipFuncSetAttribute((const void*)fwd_kernel, hipFuncAttributeMaxDynamicSharedMemorySize, LDS_BYTES) != hipSuccess) { fprintf(stderr, "kernel_launch: hipFuncSetAttribute failed\n"); grid = -1; return; }
        if (hipOccupancyMaxActiveBlocksPerMultiprocessor(&per_cu, (const void*)fwd_kernel, 512, LDS_BYTES) != hipSuccess || per_cu < 1) { fprintf(stderr, "kernel_launch: occupancy query says %d\n", per_cu); (void)hipGetLastError(); per_cu = 1; }
        grid = cus;
    }
    if (grid < 0) return;
    (void)hipMemsetAsync((char*)d_ws + WS_CTL, 0, CTL_ZERO_BYTES, stream);
    Args a{};
    for (int i = 0; i < 20; ++i) a.in[i] = (const float*)d_in[i];
    a.out = (float*)d_out; a.ws = (unsigned char*)d_ws;
    for (int li = 0; li < N_LAUNCHES; ++li) {
        a.ph_lo = li * NPHASE / N_LAUNCHES; a.ph_hi = (li + 1) * NPHASE / N_LAUNCHES;
        if (N_LAUNCHES == 1) {
            void* kargs[] = {&a};
            hipError_t e = hipLaunchCooperativeKernel((const void*)fwd_kernel, dim3(grid), dim3(512), kargs, LDS_BYTES, stream);
            if (e != hipSuccess) fprintf(stderr, "cooperative launch failed: %s (grid %d)\n", hipGetErrorString(e), grid);
        } else {
            hipLaunchKernelGGL(fwd_kernel, dim3(grid), dim3(512), LDS_BYTES, stream, a);
        }
    }
}
```
